# Optimizing an MI355X kernel written in HIP

```python
import math
import jax, jax.numpy as jnp
from jax import lax
import numpy as np

D_MODEL = 1024
BATCH = 16
SEQ = 4096
DEPTH = 4

LRU_WIDTH = D_MODEL // 4
LRU_BLOCKS = 4
LRU_BLOCK = LRU_WIDTH // LRU_BLOCKS
CONV_WIDTH = 4
LRU_C = 8.0
MLSTM_HEADS = 4
MLSTM_HEAD_DIM = D_MODEL // 8
MLSTM_WIDTH = MLSTM_HEADS * MLSTM_HEAD_DIM
MLSTM_CHUNK = 64
GATE_SOFTCAP = 15.0
ATTN_HEADS = 4
ATTN_HEAD_DIM = D_MODEL // 16
ATTN_WIDTH = ATTN_HEADS * ATTN_HEAD_DIM
Q_LORA_RANK = D_MODEL // 4
KV_LORA_RANK = D_MODEL // 8
IDX_HEADS = 8
IDX_DIM = D_MODEL // 32
INDEX_TOPK = 256
Q_BLOCK = 128
REL_BUCKETS = 32
REL_MAX_EXACT = 16
REL_MAX_DIST = 128
D_FF = 4 * D_MODEL
N_ADA = 6
NORM_EPS = 1e-6
IN_SPLITS = (LRU_WIDTH, LRU_WIDTH,
             MLSTM_WIDTH, MLSTM_WIDTH, MLSTM_WIDTH, MLSTM_WIDTH,
             MLSTM_HEADS, MLSTM_HEADS,
             Q_LORA_RANK, KV_LORA_RANK, IDX_DIM, IDX_HEADS)
N_IN = sum(IN_SPLITS)

kernel_name = 'hymba_lru_mlstm_dsa_block'


def rmsnorm(x, w):
    xf = x.astype(jnp.float32)
    y = xf * lax.rsqrt(jnp.mean(xf * xf, axis=-1, keepdims=True) + NORM_EPS)
    return (y * w.astype(jnp.float32)).astype(x.dtype)


def softcap(z):
    return GATE_SOFTCAP * jnp.tanh(z / GATE_SOFTCAP)


def t5_bucket(dist):
    n = jnp.maximum(dist, 0)
    log_ratio = jnp.log(jnp.maximum(n, 1).astype(jnp.float32) / REL_MAX_EXACT) / math.log(REL_MAX_DIST / REL_MAX_EXACT)
    large = REL_MAX_EXACT + (log_ratio * (REL_BUCKETS - REL_MAX_EXACT)).astype(jnp.int32)
    large = jnp.minimum(large, REL_BUCKETS - 1)
    return jnp.where(n < REL_MAX_EXACT, n, large)


def rg_lru_group(xb, yb, conv_w, conv_b, wa, ba, wx, bx, lam):
    B, S, C = xb.shape
    xc = lax.conv_general_dilated(xb, conv_w[:, None, :], window_strides=(1,),
                                  padding=[(CONV_WIDTH - 1, 0)],
                                  dimension_numbers=('NWC', 'WIO', 'NWC'),
                                  feature_group_count=C) + conv_b
    xblk = xc.reshape(B, S, LRU_BLOCKS, LRU_BLOCK)
    r = jax.nn.sigmoid(jnp.einsum('bsni,nij->bsnj', xblk, wa) + ba).reshape(B, S, C)
    gi = jax.nn.sigmoid(jnp.einsum('bsni,nij->bsnj', xblk, wx) + bx).reshape(B, S, C)
    log_a = -LRU_C * r.astype(jnp.float32) * jax.nn.softplus(-lam.astype(jnp.float32))
    a = jnp.exp(log_a)
    u = jnp.sqrt(-jnp.expm1(2.0 * log_a)) * (gi * xc).astype(jnp.float32)

    def combine(left, right):
        a1, b1 = left
        a2, b2 = right
        return a1 * a2, a2 * b1 + b2

    _, h = lax.associative_scan(combine, (a, u), axis=1)
    return jax.nn.gelu(yb) * h.astype(yb.dtype)


def mlstm_chunkwise(q, k, v, i_g, f_g):
    B, S, H, Dh = q.shape
    nc = S // MLSTM_CHUNK
    q = q.astype(jnp.float32) * (Dh ** -0.5)
    k = k.astype(jnp.float32)
    v = v.astype(jnp.float32)
    logf = jax.nn.log_sigmoid(f_g.astype(jnp.float32))
    ig = i_g.astype(jnp.float32)

    def to_chunks(t):
        return t.reshape(B, nc, MLSTM_CHUNK, H, -1).transpose(1, 0, 3, 2, 4)

    def gate_chunks(t):
        return t.reshape(B, nc, MLSTM_CHUNK, H).transpose(1, 0, 3, 2)

    causal = jnp.tril(jnp.ones((MLSTM_CHUNK, MLSTM_CHUNK), dtype=bool))

    def step(carry, inp):
        C, n, m = carry
        qc, kc, vc, ic, lf = inp
        b = jnp.cumsum(lf, axis=-1)
        D = b[..., :, None] - b[..., None, :] + ic[..., None, :]
        D = jnp.where(causal, D, -jnp.inf)
        inter = b + m[..., None]
        m_row = jnp.maximum(inter, jnp.max(D, axis=-1))
        inter_w = jnp.exp(inter - m_row)
        s = jnp.einsum('bhjd,bhtd->bhjt', qc, kc) * jnp.exp(D - m_row[..., None])
        num = jnp.einsum('bhjt,bhtv->bhjv', s, vc) + inter_w[..., None] * jnp.einsum('bhjk,bhkv->bhjv', qc, C)
        den = jnp.sum(s, axis=-1) + inter_w * jnp.einsum('bhjk,bhk->bhj', qc, n)
        h = num / jnp.maximum(jnp.abs(den), jnp.exp(-m_row))[..., None]
        b_last = b[..., -1]
        w_state = b_last[..., None] - b + ic
        m_new = jnp.maximum(b_last + m, jnp.max(w_state, axis=-1))
        decay = jnp.exp(b_last + m - m_new)
        wexp = jnp.exp(w_state - m_new[..., None])
        C_new = decay[..., None, None] * C + jnp.einsum('bht,bhtk,bhtv->bhkv', wexp, kc, vc)
        n_new = decay[..., None] * n + jnp.einsum('bht,bhtk->bhk', wexp, kc)
        return (C_new, n_new, m_new), h

    init = (jnp.zeros((B, H, Dh, Dh), jnp.float32), jnp.zeros((B, H, Dh), jnp.float32),
            jnp.zeros((B, H), jnp.float32))
    _, hs = lax.scan(step, init, (to_chunks(q), to_chunks(k), to_chunks(v), gate_chunks(ig), gate_chunks(logf)))
    return hs.transpose(1, 0, 3, 2, 4).reshape(B, S, H, Dh)


def mlstm_group(m_q, m_k, m_v, m_o, m_i, m_f, bi, bf, norm_w):
    B, S, _ = m_q.shape
    shp = (B, S, MLSTM_HEADS, MLSTM_HEAD_DIM)
    i_g = softcap(m_i.astype(jnp.float32) + bi)
    f_g = softcap(m_f.astype(jnp.float32) + bf)
    h = mlstm_chunkwise(m_q.reshape(shp), m_k.reshape(shp), m_v.reshape(shp), i_g, f_g)
    h = rmsnorm(h, norm_w.reshape(MLSTM_HEADS, MLSTM_HEAD_DIM))
    return jax.nn.sigmoid(m_o) * h.reshape(B, S, MLSTM_WIDTH).astype(m_o.dtype)


def dsa_group(a_q, a_kv, i_k, i_w, w_q_up, w_qidx_up, w_uk, w_uv, q_norm_w, kv_norm_w, rel_bias):
    B, S, _ = a_q.shape
    q_lat = rmsnorm(a_q, q_norm_w)
    c_kv = rmsnorm(a_kv, kv_norm_w)
    q = jnp.einsum('bsr,rhd->bshd', q_lat, w_q_up)
    q_abs = jnp.einsum('bshd,chd->bshc', q, w_uk) * (ATTN_HEAD_DIM ** -0.5)
    q_idx = jnp.einsum('bsr,rhd->bshd', q_lat, w_qidx_up) * (IDX_DIM ** -0.5)
    w_i = i_w * (IDX_HEADS ** -0.5)
    topk = min(INDEX_TOPK, S // 4)
    nblk = S // Q_BLOCK
    s_pos = jnp.arange(S)

    def block(bidx):
        start = bidx * Q_BLOCK
        t_pos = start + jnp.arange(Q_BLOCK)
        qi = lax.dynamic_slice_in_dim(q_idx, start, Q_BLOCK, axis=1)
        wi = lax.dynamic_slice_in_dim(w_i, start, Q_BLOCK, axis=1)
        qa = lax.dynamic_slice_in_dim(q_abs, start, Q_BLOCK, axis=1)
        score = jnp.einsum('bths,bth->bts', jax.nn.relu(jnp.einsum('bthd,bsd->bths', qi, i_k)), wi).astype(jnp.float32)
        score = jnp.where((s_pos[None, :] <= t_pos[:, None])[None], score, -jnp.inf)
        _, sel = lax.top_k(score, topk)
        valid = sel <= t_pos[None, :, None]
        c_sel = jax.vmap(lambda cb, ib: cb[ib])(c_kv, sel)
        logits = jnp.einsum('bthr,btkr->bthk', qa, c_sel).astype(jnp.float32)
        bias = rel_bias[t5_bucket(t_pos[None, :, None] - sel)]
        logits = logits + bias.transpose(0, 1, 3, 2).astype(jnp.float32)
        logits = jnp.where(valid[:, :, None, :], logits, -jnp.inf)
        p = jax.nn.softmax(logits, axis=-1)
        o_lat = jnp.einsum('bthk,btkr->bthr', p, c_sel)
        return jnp.einsum('bthr,rhd->bthd', o_lat, w_uv).astype(a_q.dtype)

    out = lax.map(block, jnp.arange(nblk))
    return out.transpose(1, 0, 2, 3, 4).reshape(B, S, ATTN_WIDTH)


def hybrid_mixer(h, w_in, conv_w, conv_b, lru_wa, lru_ba, lru_wx, lru_bx, lru_lambda,
                 mlstm_bi, mlstm_bf, w_q_up, w_qidx_up, w_uk, w_uv, q_lat_norm_w, kv_lat_norm_w,
                 rel_bias, group_norm_w, w_o):
    proj = h @ w_in
    split_points = np.cumsum(IN_SPLITS)[:-1].tolist()
    (lru_x, lru_y, m_q, m_k, m_v, m_o, m_i, m_f, a_q, a_kv, i_k, i_w) = jnp.split(proj, split_points, axis=-1)
    g_lru, g_m, g_a = jnp.split(group_norm_w, [LRU_WIDTH, LRU_WIDTH + MLSTM_WIDTH])
    y_lru = rmsnorm(rg_lru_group(lru_x, lru_y, conv_w, conv_b, lru_wa, lru_ba, lru_wx, lru_bx, lru_lambda), g_lru)
    y_m = mlstm_group(m_q, m_k, m_v, m_o, m_i, m_f, mlstm_bi, mlstm_bf, g_m)
    y_a = rmsnorm(dsa_group(a_q, a_kv, i_k, i_w, w_q_up, w_qidx_up, w_uk, w_uv,
                            q_lat_norm_w, kv_lat_norm_w, rel_bias), g_a)
    return jnp.concatenate([y_lru, y_m.astype(y_lru.dtype), y_a], axis=-1) @ w_o


def setup_inputs(seed: int = 0) -> dict:
    key = jax.random.key(seed)
    ks = jax.random.split(key, 32)

    def nrm(k, shape, scale):
        return jax.random.normal(k, shape, jnp.float32) * scale

    u = jax.random.uniform(ks[9], (DEPTH, LRU_WIDTH), jnp.float32, minval=0.9, maxval=0.999)
    s = u ** (1.0 / LRU_C)
    return {
        'x': nrm(ks[0], (BATCH, SEQ, D_MODEL), 1.0),
        'c': nrm(ks[1], (BATCH, D_MODEL), 1.0),
        'w_in': nrm(ks[2], (DEPTH, D_MODEL, N_IN), D_MODEL ** -0.5),
        'conv_w': nrm(ks[3], (DEPTH, CONV_WIDTH, LRU_WIDTH), CONV_WIDTH ** -0.5),
        'conv_b': nrm(ks[4], (DEPTH, LRU_WIDTH), 0.01),
        'lru_wa': nrm(ks[5], (DEPTH, LRU_BLOCKS, LRU_BLOCK, LRU_BLOCK), LRU_BLOCK ** -0.5),
        'lru_ba': nrm(ks[6], (DEPTH, LRU_BLOCKS, LRU_BLOCK), 0.01),
        'lru_wx': nrm(ks[7], (DEPTH, LRU_BLOCKS, LRU_BLOCK, LRU_BLOCK), LRU_BLOCK ** -0.5),
        'lru_bx': nrm(ks[8], (DEPTH, LRU_BLOCKS, LRU_BLOCK), 0.01),
        'lru_lambda': jnp.log(s) - jnp.log1p(-s),
        'mlstm_bi': nrm(ks[10], (DEPTH, MLSTM_HEADS), 0.1),
        'mlstm_bf': jnp.linspace(3.0, 6.0, MLSTM_HEADS, dtype=jnp.float32)[None, :] + nrm(ks[11], (DEPTH, MLSTM_HEADS), 0.1),
        'w_q_up': nrm(ks[12], (DEPTH, Q_LORA_RANK, ATTN_HEADS, ATTN_HEAD_DIM), Q_LORA_RANK ** -0.5),
        'w_qidx_up': nrm(ks[13], (DEPTH, Q_LORA_RANK, IDX_HEADS, IDX_DIM), Q_LORA_RANK ** -0.5),
        'w_uk': nrm(ks[14], (DEPTH, KV_LORA_RANK, ATTN_HEADS, ATTN_HEAD_DIM), KV_LORA_RANK ** -0.5),
        'w_uv': nrm(ks[15], (DEPTH, KV_LORA_RANK, ATTN_HEADS, ATTN_HEAD_DIM), KV_LORA_RANK ** -0.5),
        'q_lat_norm_w': 1.0 + nrm(ks[16], (DEPTH, Q_LORA_RANK), 0.02),
        'kv_lat_norm_w': 1.0 + nrm(ks[17], (DEPTH, KV_LORA_RANK), 0.02),
        'rel_bias': nrm(ks[18], (REL_BUCKETS, ATTN_HEADS), 0.5),
        'group_norm_w': 1.0 + nrm(ks[19], (DEPTH, D_MODEL), 0.02),
        'w_o': nrm(ks[20], (DEPTH, D_MODEL, D_MODEL), D_MODEL ** -0.5),
        'w_ada': nrm(ks[21], (DEPTH, D_MODEL, N_ADA * D_MODEL), 0.5 * D_MODEL ** -0.5),
        'b_ada': nrm(ks[22], (DEPTH, N_ADA * D_MODEL), 0.02),
        'norm1_w': 1.0 + nrm(ks[23], (DEPTH, D_MODEL), 0.02),
        'norm2_w': 1.0 + nrm(ks[24], (DEPTH, D_MODEL), 0.02),
        'w_mlp1': nrm(ks[25], (DEPTH, D_MODEL, D_FF), D_MODEL ** -0.5),
        'w_mlp2': nrm(ks[26], (DEPTH, D_FF, D_MODEL), D_FF ** -0.5),
        'final_norm_w': 1.0 + nrm(ks[27], (D_MODEL,), 0.02),
    }


def reference(x, c, w_in, conv_w, conv_b, lru_wa, lru_ba, lru_wx, lru_bx, lru_lambda,
              mlstm_bi, mlstm_bf, w_q_up, w_qidx_up, w_uk, w_uv, q_lat_norm_w, kv_lat_norm_w,
              rel_bias, group_norm_w, w_o, w_ada, b_ada, norm1_w, norm2_w, w_mlp1, w_mlp2,
              final_norm_w):
    c_act = jax.nn.silu(c)
    for l in range(DEPTH):
        mod = c_act @ w_ada[l] + b_ada[l]
        sh1, sc1, g1, sh2, sc2, g2 = jnp.split(mod[:, None, :], N_ADA, axis=-1)
        h = rmsnorm(x, norm1_w[l]) * (1.0 + sc1) + sh1
        mix = hybrid_mixer(h, w_in[l], conv_w[l], conv_b[l], lru_wa[l], lru_ba[l], lru_wx[l], lru_bx[l],
                           lru_lambda[l], mlstm_bi[l], mlstm_bf[l], w_q_up[l], w_qidx_up[l], w_uk[l], w_uv[l],
                           q_lat_norm_w[l], kv_lat_norm_w[l], rel_bias, group_norm_w[l], w_o[l])
        x = x + g1 * mix
        h = rmsnorm(x, norm2_w[l]) * (1.0 + sc2) + sh2
        x = x + g2 * (jnp.square(jax.nn.relu(h @ w_mlp1[l])) @ w_mlp2[l])
    return rmsnorm(x, final_norm_w)
```

```cpp
#ifndef HOST_EMU
#include <hip/hip_runtime.h>
#include <cstdio>
#include <cstdint>
#define DEV __device__ __forceinline__
#define LAS __attribute__((address_space(3)))
#else
#include "emu.h"
#endif

#ifndef HOST_EMU
#define SYNC() __syncthreads()
#define NOPACK(x) asm("" : "+v"(x))
#define LAUNDER_V(x) asm volatile("" : "+v"(x))
#define WAVE_LDS_FENCE() asm volatile("s_waitcnt lgkmcnt(0)" ::: "memory")
template <class T> DEV T SHFL(T v, int s) { return __shfl(v, s); }
template <class T> DEV T SHFL_XOR(T v, int m) { return __shfl_xor(v, m); }
template <class T> DEV T SHFL_UP(T v, int d) { return __shfl_up(v, d); }
template <class T> DEV T SHFL_DOWN(T v, int d) { return __shfl_down(v, d); }
typedef short bf16x8_ __attribute__((ext_vector_type(8)));
typedef float f32x4_ __attribute__((ext_vector_type(4)));
typedef short v4i16_t __attribute__((ext_vector_type(4)));
DEV f32x4_ MFMA16(bf16x8_ a, bf16x8_ b, f32x4_ c) { return __builtin_amdgcn_mfma_f32_16x16x32_bf16(a, b, c, 0, 0, 0); }
DEV v4i16_t TR16(const void* p) { return __builtin_amdgcn_ds_read_tr16_b64_v4i16((LAS v4i16_t*)(p)); }
#endif


typedef unsigned short bf16;
typedef short bf16x8 __attribute__((ext_vector_type(8)));
typedef short s16x4 __attribute__((ext_vector_type(4)));
typedef float f32x4 __attribute__((ext_vector_type(4)));
typedef unsigned u32x4 __attribute__((ext_vector_type(4)));
typedef unsigned u32x2 __attribute__((ext_vector_type(2)));

constexpr int BATCH = 16, SEQ = 4096, DM = 1024, DEPTH = 4, MTOK = BATCH * SEQ;
constexpr int NPROJ = 3072, DFF = 4096, NADA = 6 * DM;
constexpr int PC_LX = 0, PC_LY = 256, PC_MQ = 512, PC_MK = 1024, PC_MV = 1536, PC_MO = 2048, PC_AQ = 2560, PC_AKV = 2816, PC_IK = 2944, PC_IW = 2976, PC_MI = 2984, PC_MF = 2988;
constexpr float NORM_EPS = 1e-6f;

constexpr size_t MiB = 1u << 20;
constexpr size_t WS_CTL = 0, CTL_ZERO_BYTES = 1 * MiB;
constexpr size_t WS_MOD = 1 * MiB;
constexpr size_t WS_WQC = 3 * MiB;
constexpr size_t WS_WG = 5 * MiB;
constexpr size_t WS_WUVT = 6 * MiB;
constexpr size_t WS_WIN = 8 * MiB;
constexpr size_t WS_WO = 32 * MiB;
constexpr size_t WS_W1 = 40 * MiB;
constexpr size_t WS_W2 = 72 * MiB;
constexpr size_t WS_XN = 104 * MiB;
constexpr size_t WS_QL = WS_XN, WS_CKV = WS_XN + 32 * MiB, WS_QIDX = WS_XN + 48 * MiB, WS_KIDX = WS_XN + 80 * MiB, WS_WI = WS_XN + 84 * MiB, WS_GT = WS_XN + 86 * MiB;
constexpr size_t WS_CAT = 232 * MiB;
constexpr size_t WS_PROJ = 360 * MiB;
constexpr size_t WS_HB = 360 * MiB;
constexpr size_t WS_QABS = 744 * MiB;
constexpr size_t WS_HLOC = 808 * MiB, WS_CPA = 840 * MiB;
constexpr size_t WS_LSUM = 872 * MiB;
constexpr size_t WS_HM = 874 * MiB;
constexpr size_t WS_MG = 940 * MiB;
constexpr size_t WS_WP = 2 * MiB + 512 * 1024;
constexpr size_t WS_SHW = 6 * MiB + 256 * 1024;
constexpr size_t WS_RSP = 1000 * MiB;
constexpr size_t WS_CARRY = 948 * MiB;
constexpr int NSHW = NPROJ + DFF;
constexpr size_t WS_END = 1024 * MiB;
static_assert(WS_HM + (size_t)MTOK * 512 * 2 <= WS_END && WS_HB + (size_t)MTOK * DFF * 2 <= WS_HLOC + 64 * MiB, "ws map");

constexpr int CW_TMO = 0, CW_BAR = 4096;

#ifndef HOST_EMU
typedef __bf16 hwbf2_t __attribute__((ext_vector_type(2)));
typedef float hwf2_t __attribute__((ext_vector_type(2)));
DEV unsigned f2bf(float f) { return (unsigned)__builtin_bit_cast(unsigned short, (__bf16)f); }
DEV unsigned pk2(float lo, float hi) { const hwf2_t v = {lo, hi}; return __builtin_bit_cast(unsigned, __builtin_convertvector(v, hwbf2_t)); }
#else
DEV unsigned f2bf(float f) { unsigned u = __builtin_bit_cast(unsigned, f); return (u + 0x7fffu + ((u >> 16) & 1u)) >> 16; }
DEV unsigned pk2(float lo, float hi) { return f2bf(lo) | (f2bf(hi) << 16); }
#endif
DEV float bf2f(unsigned h) { return __builtin_bit_cast(float, h << 16); }
DEV float bflo(unsigned w) { return __builtin_bit_cast(float, w << 16); }
DEV float bfhi(unsigned w) { return __builtin_bit_cast(float, w & 0xffff0000u); }
DEV float wave_sum(float v) {
#pragma unroll
    for (int o = 1; o < 64; o <<= 1) v += SHFL_XOR(v, o);
    return v;
}
#ifndef HOST_EMU
DEV float FEXP(float x) { return __expf(x); }
DEV float FEXP2(float x) { return __builtin_amdgcn_exp2f(x); }
DEV float FRCP(float x) { return __builtin_amdgcn_rcpf(x); }
DEV float FSQRT(float x) { return __builtin_amdgcn_sqrtf(x); }
DEV float RSQ(float x) { return __builtin_amdgcn_rsqf(x); }
DEV float FLOG(float x) { return __logf(x); }
#else
DEV float FEXP(float x) { return expf(x); }
DEV float FEXP2(float x) { return exp2f(x); }
DEV float FRCP(float x) { return 1.0f / x; }
DEV float FSQRT(float x) { return sqrtf(x); }
DEV float RSQ(float x) { return 1.0f / sqrtf(x); }
DEV float FLOG(float x) { return logf(x); }
#endif
#ifndef HOST_EMU
DEV int UNI(int x) { return __builtin_amdgcn_readfirstlane(x); }
#else
DEV int UNI(int x) { return x; }
#endif
DEV float RELU(float x) { const int b = __builtin_bit_cast(int, x); return __builtin_bit_cast(float, b > 0 ? b : 0); }
DEV float sigmoidf_(float z) { return 1.0f / (1.0f + expf(-z)); }
DEV float fsigmoid(float z) { return FRCP(1.0f + FEXP(-z)); }
DEV float one_minus_exp(float x) {
    const float s = -x * (1.0f + x * (0.5f + x * (0.16666667f + x * 0.041666668f)));
    return x > -0.05f ? s : 1.0f - FEXP(x);
}

struct Args { const float* in[28]; float* out; unsigned char* ws; int ph_lo, ph_hi; };
struct Ctx {
    char* lds; int tid, lane, wave, G, bid;
    const Args* A;
    unsigned char* ws;
};

constexpr int PTR_OFF = 131072 + 512;
#ifndef HOST_EMU
DEV const float* PIN(const Ctx& F, int i) { const unsigned long long v = ((const unsigned long long*)(F.lds + PTR_OFF))[i];
    const unsigned lo = __builtin_amdgcn_readfirstlane((unsigned)v), hi = __builtin_amdgcn_readfirstlane((unsigned)(v >> 32)); return (const float*)(const __attribute__((address_space(1))) float*)(((unsigned long long)hi << 32) | lo); }
DEV float* POUT(const Ctx& F) { return (float*)PIN(F, 28); }
#else
DEV const float* PIN(const Ctx& F, int i) { return F.A->in[i]; }
DEV float* POUT(const Ctx& F) { return POUT(F); }
#endif
enum { I_X = 0, I_C, I_WIN, I_CONVW, I_CONVB, I_WA, I_BA, I_WX, I_BX, I_LAM, I_BI, I_BF, I_WQUP, I_WQIDX, I_WUK, I_WUV, I_QNW, I_KVNW, I_RELB, I_GNW, I_WO, I_WADA, I_BADA, I_N1W, I_N2W, I_W1, I_W2, I_FNW };

DEV int win_srccol(int n) {
    if (n < 2560) return n;
    if (n < PC_AKV) return 2568 + (n - PC_AQ);
    if (n < PC_IK) return 2824 + (n - PC_AKV);
    if (n < PC_IW) return 2952 + (n - PC_IK);
    if (n < PC_MI) return 2984 + (n - PC_IW);
    if (n < PC_MF) return 2560 + (n - PC_MI);
    if (n < 2992) return 2564 + (n - PC_MF);
    return -1;
}
template <bool MAPPED>
DEV void p0_transpose_item(const float* W, int K, int N, int NT, bf16* WT, float* scr, int item, int lane) {
    const int nblk = NT / 32, kb = item / nblk, nb = item % nblk, k0 = 64 * kb, n0 = 32 * nb;
    int sc = n0 + (lane & 31); if (MAPPED) sc = win_srccol(sc);
#pragma unroll 8
    for (int i = 0; i < 32; ++i) { const int kk = 2 * i + (lane >> 5); scr[kk * 33 + (lane & 31)] = sc >= 0 ? W[(size_t)(k0 + kk) * N + sc] : 0.f; }
    WAVE_LDS_FENCE();
    const int c = lane & 7;
#pragma unroll
    for (int j = 0; j < 4; ++j) { const int n = (lane >> 3) + 8 * j; const float* s = scr + (8 * c) * 33 + n;
        u32x4 o; o.x = pk2(s[0 * 33], s[1 * 33]); o.y = pk2(s[2 * 33], s[3 * 33]); o.z = pk2(s[4 * 33], s[5 * 33]); o.w = pk2(s[6 * 33], s[7 * 33]);
        *(u32x4*)(WT + (size_t)(n0 + n) * K + k0 + 8 * c) = o; }
    WAVE_LDS_FENCE();
}

DEV void ph_prologue(const Ctx& F) {
    const int gt = F.bid * 512 + F.tid, NGT = F.G * 512;
    float* CACT = (float*)F.lds;
    for (int i = F.tid; i < BATCH * DM; i += 512) { const float cv = PIN(F, I_C)[i]; CACT[i] = cv * sigmoidf_(cv); }
    SYNC();
    for (int e = gt; e < DEPTH * NADA * 4; e += NGT) {
        const int j = e % NADA, bq = (e / NADA) & 3, l = e / (NADA * 4);
        const float* w = PIN(F, I_WADA) + (size_t)l * DM * NADA + j;
        const float* c = CACT + bq * 4 * DM;
        float a0 = 0.f, a1 = 0.f, a2 = 0.f, a3 = 0.f;
#pragma unroll 32
        for (int k = 0; k < DM; ++k) { const float wv = w[(size_t)k * NADA];
            a0 += c[k] * wv; a1 += c[DM + k] * wv; a2 += c[2 * DM + k] * wv; a3 += c[3 * DM + k] * wv; }
        const float bb = PIN(F, I_BADA)[(size_t)l * NADA + j];
        float* mo = (float*)(F.ws + WS_MOD) + ((size_t)l * BATCH + bq * 4) * NADA + j;
        mo[0] = a0 + bb; mo[NADA] = a1 + bb; mo[2 * NADA] = a2 + bb; mo[3 * NADA] = a3 + bb;
    }
    for (int e = gt; e < DEPTH * 2 * 4 * 64 * 64; e += NGT) {
        const int i = e & 63, j = (e >> 6) & 63, blk = (e >> 12) & 3, g = (e >> 14) & 1, l = e >> 15;
        const float* src = PIN(F, g ? I_WX : I_WA) + (((size_t)l * 4 + blk) * 64 + i) * 64 + j;
        ((bf16*)(F.ws + WS_WG))[e] = (bf16)f2bf(*src);
    }
    for (int e = gt; e < DEPTH * 4 * 64 * 128; e += NGT) {
        const int r = e & 127, d = (e >> 7) & 63, h = (e >> 13) & 3, l = e >> 15;
        ((bf16*)(F.ws + WS_WUVT))[e] = (bf16)f2bf(PIN(F, I_WUV)[(((size_t)l * 128 + r) * 4 + h) * 64 + d]);
    }
    for (int e = gt; e < DEPTH * 768 * 256; e += NGT) {
        const int r = e & 255, n = (e >> 8) % 768, l = e / (768 * 256);
        float v;
        if (n < 512) { const int h = n >> 7, c = n & 127; const f32x4* q = (const f32x4*)(PIN(F, I_WQUP) + ((size_t)l * 256 + r) * 256 + h * 64); const f32x4* k = (const f32x4*)(PIN(F, I_WUK) + ((size_t)l * 128 + c) * 256 + h * 64);
            float s = 0.f;
#pragma unroll
            for (int d = 0; d < 16; ++d) { const f32x4 a = q[d], bq4 = k[d]; s += (a.x * bq4.x + a.y * bq4.y) + (a.z * bq4.z + a.w * bq4.w); }
            v = s * (0.125f * 1.4426950408889634f); }
        else v = PIN(F, I_WQIDX)[((size_t)l * 256 + r) * 256 + (n - 512)] * 0.17677669529663687f;
        ((bf16*)(F.ws + WS_WQC))[e] = (bf16)f2bf(v);
    }
    SYNC();
    float* scr = (float*)(F.lds + F.wave * 16384);
    const int gw = F.bid * 8 + F.wave, NGW = F.G * 8;
    constexpr int I_IN = (DM / 64) * (NPROJ / 32), I_O = (DM / 64) * (DM / 32), I_1 = (DM / 64) * (DFF / 32), I_2 = (DFF / 64) * (DM / 32);
    constexpr int PER_L = I_IN + I_O + I_1 + I_2;
    for (int it = gw; it < DEPTH * PER_L; it += NGW) {
        const int l = it / PER_L; int r = it % PER_L;
        if (r < I_IN) { p0_transpose_item<true>(PIN(F, I_WIN) + (size_t)l * DM * 2992, DM, 2992, NPROJ, (bf16*)(F.ws + WS_WIN) + (size_t)l * NPROJ * DM, scr, r, F.lane); continue; } r -= I_IN;
        if (r < I_O) { p0_transpose_item<false>(PIN(F, I_WO) + (size_t)l * DM * DM, DM, DM, DM, (bf16*)(F.ws + WS_WO) + (size_t)l * DM * DM, scr, r, F.lane); continue; } r -= I_O;
        if (r < I_1) { p0_transpose_item<false>(PIN(F, I_W1) + (size_t)l * DM * DFF, DM, DFF, DFF, (bf16*)(F.ws + WS_W1) + (size_t)l * DFF * DM, scr, r, F.lane); continue; } r -= I_1;
        p0_transpose_item<false>(PIN(F, I_W2) + (size_t)l * DFF * DM, DFF, DM, DM, (bf16*)(F.ws + WS_W2) + (size_t)l * DM * DFF, scr, r, F.lane);
    }
}

DEV void ph_xs0(const Ctx& F, const float* xsrc, const float* nw, const float* modl, int sc_off, bf16* XS, float* RSP) {
    const int gw = F.bid * 8 + F.wave, NGW = F.G * 8;
    f32x4 wv[4];
#pragma unroll
    for (int j = 0; j < 4; ++j) wv[j] = *(const f32x4*)(nw + 4 * F.lane + 256 * j);
    f32x4 v[2][4], vn[2][4];
#pragma unroll
    for (int q = 0; q < 2; ++q) { const int m = gw + q * NGW; const f32x4* xr = (const f32x4*)(xsrc + (size_t)(m < MTOK ? m : 0) * DM) + F.lane;
#pragma unroll
        for (int j = 0; j < 4; ++j) v[q][j] = xr[64 * j]; }
    for (int m0 = gw; m0 < MTOK; m0 += 2 * NGW) {
        f32x4 sc[2][4];
#pragma unroll
        for (int q = 0; q < 2; ++q) { const int m = m0 + q * NGW; const float* mb = modl + (size_t)((m < MTOK ? m : 0) >> 12) * NADA + 4 * F.lane;
#pragma unroll
            for (int j = 0; j < 4; ++j) sc[q][j] = *(const f32x4*)(mb + sc_off + 256 * j); }
#pragma unroll
        for (int q = 0; q < 2; ++q) { const int m = m0 + (2 + q) * NGW; const f32x4* xr = (const f32x4*)(xsrc + (size_t)(m < MTOK ? m : 0) * DM) + F.lane;
#pragma unroll
            for (int j = 0; j < 4; ++j) vn[q][j] = xr[64 * j]; }
        float s[2];
#pragma unroll
        for (int q = 0; q < 2; ++q) { float a = 0.f;
#pragma unroll
            for (int j = 0; j < 4; ++j) a += (v[q][j].x * v[q][j].x + v[q][j].y * v[q][j].y) + (v[q][j].z * v[q][j].z + v[q][j].w * v[q][j].w);
            s[q] = a; }
#pragma unroll
        for (int o = 1; o < 64; o <<= 1) { s[0] += SHFL_XOR(s[0], o); s[1] += SHFL_XOR(s[1], o); }
#pragma unroll
        for (int q = 0; q < 2; ++q) { const int m = m0 + q * NGW; if (m >= MTOK) break;
            if (F.lane < 16) RSP[(size_t)m * 16 + F.lane] = F.lane == 0 ? s[q] : 0.f;
            u32x2* o8 = (u32x2*)(XS + (size_t)m * DM) + F.lane;
#pragma unroll
            for (int j = 0; j < 4; ++j) { const f32x4 y = v[q][j] * (wv[j] * (1.0f + sc[q][j]));
                u32x2 p; p.x = pk2(y.x, y.y); p.y = pk2(y.z, y.w); o8[64 * j] = p; } }
#pragma unroll
        for (int q = 0; q < 2; ++q)
#pragma unroll
            for (int j = 0; j < 4; ++j) v[q][j] = vn[q][j];
    }
}
DEV void ph_shw(const Ctx& F) {
    const int gt = F.bid * 512 + F.tid, NGT = F.G * 512;
    for (int e = gt; e < DEPTH * 2 * BATCH * (DM / 4); e += NGT) {
        const int c4 = e & 255, b = (e >> 8) & 15, w = (e >> 12) & 1, l = e >> 13;
        const f32x4 nwv = *(const f32x4*)(PIN(F, w ? I_N2W : I_N1W) + l * DM + 4 * c4);
        const f32x4 sc = *(const f32x4*)((const float*)(F.ws + WS_MOD) + ((size_t)l * BATCH + b) * NADA + (w ? 4 * DM : DM) + 4 * c4);
        ((f32x4*)(F.ws + WS_WP))[e] = nwv * (1.0f + sc);
    }
    const int gw = F.bid * 8 + F.wave, NGW = F.G * 8, i16 = F.lane & 15, kq = 8 * (F.lane >> 4);
    for (int it = gw; it < DEPTH * (NSHW / 16); it += NGW) {
        const int l = it / (NSHW / 16), n0 = (it % (NSHW / 16)) * 16;
        const bool mlp = n0 >= NPROJ;
        const bf16* Wr = mlp ? (const bf16*)(F.ws + WS_W1) + ((size_t)l * DFF + (n0 - NPROJ) + i16) * DM : (const bf16*)(F.ws + WS_WIN) + ((size_t)l * NPROJ + n0 + i16) * DM;
        const float* sh = (const float*)(F.ws + WS_MOD) + ((size_t)l * BATCH + i16) * NADA + (mlp ? 3 * DM : 0);
        f32x4 acc0 = {0.f, 0.f, 0.f, 0.f}, acc1 = {0.f, 0.f, 0.f, 0.f};
#pragma unroll 4
        for (int s = 0; s < DM / 32; ++s) {
            const bf16x8 B = *(const bf16x8*)(Wr + 32 * s + kq);
            const f32x4 a0 = *(const f32x4*)(sh + 32 * s + kq), a1 = *(const f32x4*)(sh + 32 * s + kq + 4);
            bf16x8 Ah, Al;
#pragma unroll
            for (int j = 0; j < 8; ++j) { const float a = j < 4 ? a0[j] : a1[j - 4]; const unsigned h = f2bf(a); Ah[j] = (short)h; Al[j] = (short)f2bf(a - bf2f(h)); }
            acc0 = MFMA16(Ah, B, acc0); acc1 = MFMA16(Al, B, acc1);
        }
        float* o = (float*)(F.ws + WS_SHW) + ((size_t)l * BATCH + 4 * (F.lane >> 4)) * NSHW + n0 + i16;
#pragma unroll
        for (int r = 0; r < 4; ++r) o[(size_t)r * NSHW] = acc0[r] + acc1[r];
    }
}
DEV void ph_normmod(const Ctx& F, const float* xsrc, const float* nw, const float* modl, int sh_off, int sc_off, bf16* XN) {
    const int gw = F.bid * 8 + F.wave, NGW = F.G * 8;
    f32x4 wv[4];
#pragma unroll
    for (int j = 0; j < 4; ++j) wv[j] = *(const f32x4*)(nw + 4 * F.lane + 256 * j);
    f32x4 v[2][4], vn[2][4];
#pragma unroll
    for (int q = 0; q < 2; ++q) { const int m = gw + q * NGW; const f32x4* xr = (const f32x4*)(xsrc + (size_t)(m < MTOK ? m : 0) * DM) + F.lane;
#pragma unroll
        for (int j = 0; j < 4; ++j) v[q][j] = xr[64 * j]; }
    for (int m0 = gw; m0 < MTOK; m0 += 2 * NGW) {
        f32x4 sc[2][4], sh[2][4];
#pragma unroll
        for (int q = 0; q < 2; ++q) { const int m = m0 + q * NGW; const float* mb = modl + (size_t)((m < MTOK ? m : 0) >> 12) * NADA + 4 * F.lane;
#pragma unroll
            for (int j = 0; j < 4; ++j) { sc[q][j] = *(const f32x4*)(mb + sc_off + 256 * j); sh[q][j] = *(const f32x4*)(mb + sh_off + 256 * j); } }
#pragma unroll
        for (int q = 0; q < 2; ++q) { const int m = m0 + (2 + q) * NGW; const f32x4* xr = (const f32x4*)(xsrc + (size_t)(m < MTOK ? m : 0) * DM) + F.lane;
#pragma unroll
            for (int j = 0; j < 4; ++j) vn[q][j] = xr[64 * j]; }
        float s[2];
#pragma unroll
        for (int q = 0; q < 2; ++q) { float a = 0.f;
#pragma unroll
            for (int j = 0; j < 4; ++j) a += (v[q][j].x * v[q][j].x + v[q][j].y * v[q][j].y) + (v[q][j].z * v[q][j].z + v[q][j].w * v[q][j].w);
            s[q] = a; }
#pragma unroll
        for (int o = 1; o < 64; o <<= 1) { s[0] += SHFL_XOR(s[0], o); s[1] += SHFL_XOR(s[1], o); }
#pragma unroll
        for (int q = 0; q < 2; ++q) { const int m = m0 + q * NGW; if (m >= MTOK) break;
            const float rs = RSQ(s[q] * (1.0f / DM) + NORM_EPS);
            u32x2* o8 = (u32x2*)(XN + (size_t)m * DM) + F.lane;
#pragma unroll
            for (int j = 0; j < 4; ++j) { const f32x4 y = v[q][j] * rs * wv[j] * (1.0f + sc[q][j]) + sh[q][j];
                u32x2 p; p.x = pk2(y.x, y.y); p.y = pk2(y.z, y.w); o8[64 * j] = p; } }
#pragma unroll
        for (int q = 0; q < 2; ++q)
#pragma unroll
            for (int j = 0; j < 4; ++j) v[q][j] = vn[q][j];
    }
}
DEV void ph_finalnorm(const Ctx& F, const float* xsrc, const float* nw, float* out) {
    const int gw = F.bid * 8 + F.wave, NGW = F.G * 8;
    f32x4 wv[4];
#pragma unroll
    for (int j = 0; j < 4; ++j) wv[j] = *(const f32x4*)(nw + 4 * F.lane + 256 * j);
    f32x4 v[2][4], vn[2][4];
#pragma unroll
    for (int q = 0; q < 2; ++q) { const int m = gw + q * NGW; const f32x4* xr = (const f32x4*)(xsrc + (size_t)(m < MTOK ? m : 0) * DM) + F.lane;
#pragma unroll
        for (int j = 0; j < 4; ++j) v[q][j] = xr[64 * j]; }
    for (int m0 = gw; m0 < MTOK; m0 += 2 * NGW) {
#pragma unroll
        for (int q = 0; q < 2; ++q) { const int m = m0 + (2 + q) * NGW; const f32x4* xr = (const f32x4*)(xsrc + (size_t)(m < MTOK ? m : 0) * DM) + F.lane;
#pragma unroll
            for (int j = 0; j < 4; ++j) vn[q][j] = xr[64 * j]; }
        float s[2];
#pragma unroll
        for (int q = 0; q < 2; ++q) { float a = 0.f;
#pragma unroll
            for (int j = 0; j < 4; ++j) a += (v[q][j].x * v[q][j].x + v[q][j].y * v[q][j].y) + (v[q][j].z * v[q][j].z + v[q][j].w * v[q][j].w);
            s[q] = a; }
#pragma unroll
        for (int o = 1; o < 64; o <<= 1) { s[0] += SHFL_XOR(s[0], o); s[1] += SHFL_XOR(s[1], o); }
#pragma unroll
        for (int q = 0; q < 2; ++q) { const int m = m0 + q * NGW; if (m >= MTOK) break;
            const float rs = RSQ(s[q] * (1.0f / DM) + NORM_EPS);
            f32x4* o = (f32x4*)(out + (size_t)m * DM) + F.lane;
#pragma unroll
            for (int j = 0; j < 4; ++j) o[64 * j] = v[q][j] * rs * wv[j]; }
#pragma unroll
        for (int q = 0; q < 2; ++q)
#pragma unroll
            for (int j = 0; j < 4; ++j) v[q][j] = vn[q][j];
    }
}
DEV void ph_finalnorm16(const Ctx& F, const bf16* x16, const float* nw, float* out) {
    const int gw = F.bid * 8 + F.wave, NGW = F.G * 8;
    f32x4 wv[2][2];
#pragma unroll
    for (int j = 0; j < 2; ++j) { wv[j][0] = *(const f32x4*)(nw + 8 * F.lane + 512 * j); wv[j][1] = *(const f32x4*)(nw + 8 * F.lane + 512 * j + 4); }
    u32x4 v[4][2], vn[4][2];
#pragma unroll
    for (int q = 0; q < 4; ++q) { const int m = gw + q * NGW; const bf16* xr = x16 + (size_t)(m < MTOK ? m : 0) * DM + 8 * F.lane;
        v[q][0] = *(const u32x4*)xr; v[q][1] = *(const u32x4*)(xr + 512); }
    for (int m0 = gw; m0 < MTOK; m0 += 4 * NGW) {
#pragma unroll
        for (int q = 0; q < 4; ++q) { const int m = m0 + (4 + q) * NGW; const bf16* xr = x16 + (size_t)(m < MTOK ? m : 0) * DM + 8 * F.lane;
            vn[q][0] = *(const u32x4*)xr; vn[q][1] = *(const u32x4*)(xr + 512); }
        float s[4];
#pragma unroll
        for (int q = 0; q < 4; ++q) { float a = 0.f;
#pragma unroll
            for (int j = 0; j < 2; ++j) { const u32x4 r = v[q][j];
                a += ((bflo(r.x) * bflo(r.x) + bfhi(r.x) * bfhi(r.x)) + (bflo(r.y) * bflo(r.y) + bfhi(r.y) * bfhi(r.y))) + ((bflo(r.z) * bflo(r.z) + bfhi(r.z) * bfhi(r.z)) + (bflo(r.w) * bflo(r.w) + bfhi(r.w) * bfhi(r.w))); }
            s[q] = a; }
#pragma unroll
        for (int o = 1; o < 64; o <<= 1) {
#pragma unroll
            for (int q = 0; q < 4; ++q) s[q] += SHFL_XOR(s[q], o); }
#pragma unroll
        for (int q = 0; q < 4; ++q) { const int m = m0 + q * NGW; if (m >= MTOK) break;
            const float rs = RSQ(s[q] * (1.0f / DM) + NORM_EPS);
            float* o = out + (size_t)m * DM + 8 * F.lane;
#pragma unroll
            for (int j = 0; j < 2; ++j) { const u32x4 r = v[q][j];
                *(f32x4*)(o + 512 * j) = (f32x4){bflo(r.x), bfhi(r.x), bflo(r.y), bfhi(r.y)} * rs * wv[j][0];
                *(f32x4*)(o + 512 * j + 4) = (f32x4){bflo(r.z), bfhi(r.z), bflo(r.w), bfhi(r.w)} * rs * wv[j][1]; } }
#pragma unroll
        for (int q = 0; q < 4; ++q) { v[q][0] = vn[q][0]; v[q][1] = vn[q][1]; }
    }
}
DEV void ph_zero_cat(const Ctx& F, int c0, int nq) {
    const int gw = F.bid * 8 + F.wave, NGW = F.G * 8;
    bf16* CAT = (bf16*)(F.ws + WS_CAT);
    for (int m = gw; m < MTOK; m += NGW) for (int q = 0; q < nq; ++q) *(u32x2*)(CAT + (size_t)m * DM + c0 + 256 * q + 4 * F.lane) = (u32x2){0u, 0u};
}
DEV float softcap15(float z) { return 15.0f * tanhf(z * (1.0f / 15.0f)); }
DEV float logsigmoidf_(float x) { return x >= 0.f ? -log1pf(expf(-x)) : x - log1pf(expf(x)); }
DEV void ph_prep(const Ctx& F, int l) {
    const int gw = F.bid * 8 + F.wave, NGW = F.G * 8, lane = F.lane;
    const bf16* PROJ = (const bf16*)(F.ws + WS_PROJ);
    bf16* QL = (bf16*)(F.ws + WS_QL); bf16* CKV = (bf16*)(F.ws + WS_CKV); bf16* KIDX = (bf16*)(F.ws + WS_KIDX);
    float* WI = (float*)(F.ws + WS_WI);
    const f32x4 qn = *(const f32x4*)(PIN(F, I_QNW) + l * 256 + 4 * lane);
    const float kn0 = PIN(F, I_KVNW)[l * 128 + 2 * lane], kn1 = PIN(F, I_KVNW)[l * 128 + 2 * lane + 1];
    u32x2 ra4[4], ran[4]; unsigned rk4[4], rx4[4], rkn[4], rxn[4];
#define PREP_LOAD(RA, RK, RX, M0) do { _Pragma("unroll") for (int q = 0; q < 4; ++q) { const int mm = (M0) + q * NGW; const bf16* pr = PROJ + (size_t)(mm < MTOK ? mm : 0) * NPROJ; \
            RA[q] = *(const u32x2*)(pr + PC_AQ + 4 * lane); RK[q] = *(const unsigned*)(pr + PC_AKV + 2 * lane); \
            RX[q] = lane < 16 ? *(const unsigned*)(pr + PC_IK + 2 * lane) : (lane < 24 ? (unsigned)pr[PC_IW + (lane - 16)] : 0u); } } while (0)
    PREP_LOAD(ra4, rk4, rx4, gw);
    for (int m0 = gw; m0 < MTOK; m0 += 4 * NGW) {
        PREP_LOAD(ran, rkn, rxn, m0 + 4 * NGW);
#pragma unroll
        for (int q = 0; q < 4; ++q) { const int m = m0 + q * NGW; if (m >= MTOK) break;
            const u32x2 ra = ra4[q]; const unsigned rk = rk4[q];
            const float a0 = bflo(ra.x), a1 = bfhi(ra.x), a2 = bflo(ra.y), a3 = bfhi(ra.y);
            const float k0 = bflo(rk), k1 = bfhi(rk);
            const float sq = wave_sum((a0 * a0 + a1 * a1) + (a2 * a2 + a3 * a3)), sk = wave_sum(k0 * k0 + k1 * k1);
            const float rq = RSQ(sq * (1.0f / 256.0f) + NORM_EPS), rk2 = RSQ(sk * (1.0f / 128.0f) + NORM_EPS);
            u32x2 oq; oq.x = pk2(a0 * rq * qn.x, a1 * rq * qn.y); oq.y = pk2(a2 * rq * qn.z, a3 * rq * qn.w);
            *(u32x2*)(QL + (size_t)m * 256 + 4 * lane) = oq;
            *(unsigned*)(CKV + (size_t)m * 128 + 2 * lane) = pk2(k0 * rk2 * kn0, k1 * rk2 * kn1);
            if (lane < 16) *(unsigned*)(KIDX + (size_t)m * 32 + 2 * lane) = rx4[q];
            else if (lane < 24) WI[(size_t)m * 8 + (lane - 16)] = bf2f(rx4[q]); }
#pragma unroll
        for (int q = 0; q < 4; ++q) { ra4[q] = ran[q]; rk4[q] = rkn[q]; rx4[q] = rxn[q]; }
    }
#undef PREP_LOAD
}

constexpr int XB_STRIDE = 264;
DEV void ph_lru1(const Ctx& F, int l) {
    const int tid = F.tid, lane = F.lane, w = F.wave, i16 = lane & 15, g = lane >> 4;
    bf16* XB = (bf16*)F.lds;
    float* XF = (float*)(F.lds + 64 * XB_STRIDE * 2);
    const bf16* PROJ = (const bf16*)(F.ws + WS_PROJ);
    bf16* HLOC = (bf16*)(F.ws + WS_HLOC); bf16* CPA = (bf16*)(F.ws + WS_CPA); float* LSUM = (float*)(F.ws + WS_LSUM);
    const int blk = w & 3, nh = w >> 2;
    const bf16* WG = (const bf16*)(F.ws + WS_WG) + (size_t)l * 2 * 4 * 4096;
    bf16x8 Bf[2][2][2];
#pragma unroll
    for (int gg = 0; gg < 2; ++gg)
#pragma unroll
        for (int nt = 0; nt < 2; ++nt)
#pragma unroll
            for (int ks = 0; ks < 2; ++ks) Bf[gg][nt][ks] = *(const bf16x8*)(WG + ((size_t)(gg * 4 + blk) * 64 + (2 * nh + nt) * 16 + i16) * 64 + ks * 32 + 8 * g);
    float ba[2], bx[2], sp[2];
#pragma unroll
    for (int nt = 0; nt < 2; ++nt) { const int ch = blk * 64 + (2 * nh + nt) * 16 + i16;
        ba[nt] = PIN(F, I_BA)[l * 256 + ch]; bx[nt] = PIN(F, I_BX)[l * 256 + ch];
        const float lam = PIN(F, I_LAM)[l * 256 + ch]; sp[nt] = lam > 0.f ? log1pf(expf(-lam)) : -lam + log1pf(expf(lam)); }
    const int ch2 = tid & 127, tg = tid >> 7;
    float cw[4][2], cb[2];
#pragma unroll
    for (int j = 0; j < 4; ++j) { cw[j][0] = PIN(F, I_CONVW)[(l * 4 + j) * 256 + 2 * ch2]; cw[j][1] = PIN(F, I_CONVW)[(l * 4 + j) * 256 + 2 * ch2 + 1]; }
    cb[0] = PIN(F, I_CONVB)[l * 256 + 2 * ch2]; cb[1] = PIN(F, I_CONVB)[l * 256 + 2 * ch2 + 1];

    for (int u = F.bid; u < BATCH * 64; u += F.G) {
        const int b = u >> 6, c = u & 63, t0 = c * 64; const size_t m0 = (size_t)b * SEQ + t0;
        {
            float w0[2] = {0.f, 0.f}, w1[2] = {0.f, 0.f}, w2[2] = {0.f, 0.f};
            const int tl0 = tg * 16;
#pragma unroll
            for (int j = 0; j < 3; ++j) { const int t = t0 + tl0 - 3 + j; float v0 = 0.f, v1 = 0.f;
                if (t >= 0) { const unsigned r = *(const unsigned*)(PROJ + ((size_t)b * SEQ + t) * NPROJ + PC_LX + 2 * ch2); v0 = bflo(r); v1 = bfhi(r); }
                if (j == 0) { w0[0] = v0; w0[1] = v1; } else if (j == 1) { w1[0] = v0; w1[1] = v1; } else { w2[0] = v0; w2[1] = v1; } }
#pragma unroll
            for (int tt = 0; tt < 16; ++tt) { const int tl = tl0 + tt;
                const unsigned r = *(const unsigned*)(PROJ + (m0 + tl) * NPROJ + PC_LX + 2 * ch2);
                const float v0 = bflo(r), v1 = bfhi(r);
                const float x0 = cw[0][0] * w0[0] + cw[1][0] * w1[0] + cw[2][0] * w2[0] + cw[3][0] * v0 + cb[0];
                const float x1 = cw[0][1] * w0[1] + cw[1][1] * w1[1] + cw[2][1] * w2[1] + cw[3][1] * v1 + cb[1];
                *(unsigned*)(XB + tl * XB_STRIDE + 2 * ch2) = pk2(x0, x1);
                XF[tl * 256 + 2 * ch2] = x0; XF[tl * 256 + 2 * ch2 + 1] = x1;
                w0[0] = w1[0]; w0[1] = w1[1]; w1[0] = w2[0]; w1[1] = w2[1]; w2[0] = v0; w2[1] = v1; }
        }
        SYNC();
        float CA[2] = {1.f, 1.f}, CU[2] = {0.f, 0.f};
#pragma unroll 1
        for (int m = 0; m < 4; ++m) {
            f32x4 acc[2][2];
#pragma unroll
            for (int gg = 0; gg < 2; ++gg)
#pragma unroll
                for (int nt = 0; nt < 2; ++nt) acc[gg][nt] = (f32x4){0.f, 0.f, 0.f, 0.f};
#pragma unroll
            for (int ks = 0; ks < 2; ++ks) { const bf16x8 A = *(const bf16x8*)(XB + (m * 16 + i16) * XB_STRIDE + blk * 64 + ks * 32 + 8 * g);
#pragma unroll
                for (int gg = 0; gg < 2; ++gg)
#pragma unroll
                    for (int nt = 0; nt < 2; ++nt) acc[gg][nt] = MFMA16(A, Bf[gg][nt][ks], acc[gg][nt]); }
#pragma unroll
            for (int nt = 0; nt < 2; ++nt) {
                const int ch = blk * 64 + (2 * nh + nt) * 16 + i16;
                float P[4], H[4]; float pa = 1.f, hu = 0.f;
#pragma unroll
                for (int r = 0; r < 4; ++r) { const int tok = m * 16 + 4 * g + r;
                    const float rg = fsigmoid(acc[0][nt][r] + ba[nt]), gi = fsigmoid(acc[1][nt][r] + bx[nt]);
                    const float la = -8.0f * rg * sp[nt], a = FEXP(la), uu = FSQRT(one_minus_exp(2.0f * la)) * (gi * XF[tok * 256 + ch]);
                    pa = a * pa; hu = a * hu + uu; P[r] = pa; H[r] = hu; }
                float EA = 1.f, EU = 0.f, TA = 1.f, TU = 0.f;
#pragma unroll
                for (int gg = 0; gg < 4; ++gg) { const float ta = SHFL(pa, i16 + 16 * gg), tu = SHFL(hu, i16 + 16 * gg);
                    if (gg < g) { EU = ta * EU + tu; EA = ta * EA; }
                    TU = ta * TU + tu; TA = ta * TA; }
                const float XA = EA * CA[nt], XU = EA * CU[nt] + EU;
#pragma unroll
                for (int r = 0; r < 4; ++r) { const int tok = m * 16 + 4 * g + r;
                    HLOC[(m0 + tok) * 256 + ch] = (bf16)f2bf(P[r] * XU + H[r]); CPA[(m0 + tok) * 256 + ch] = (bf16)f2bf(P[r] * XA); }
                CU[nt] = TA * CU[nt] + TU; CA[nt] = TA * CA[nt];
            }
        }
        if (g == 0) {
#pragma unroll
            for (int nt = 0; nt < 2; ++nt) { const int ch = blk * 64 + (2 * nh + nt) * 16 + i16;
                LSUM[((size_t)b * 64 + c) * 256 + ch] = CA[nt]; LSUM[(size_t)BATCH * 64 * 256 + ((size_t)b * 64 + c) * 256 + ch] = CU[nt]; }
        }
        SYNC();
    }
}

DEV float gelu_tanh(float x) { const float z = 0.7978845608028654f * (x + 0.044715f * x * x * x); return x * FRCP(1.0f + FEXP(-2.0f * z)); }
DEV void ph_carry(const Ctx& F) {
    if (F.wave != 0) return;
    const float* LSUM = (const float*)(F.ws + WS_LSUM); float* CARRY = (float*)(F.ws + WS_CARRY);
    const int seg = F.lane & 3;
    for (int chain = F.bid * 16 + (F.lane >> 2); chain < BATCH * 256; chain += F.G * 16) {
        const int b = chain >> 8, ch = chain & 255; const size_t o0 = ((size_t)b * 64 + seg * 16) * 256 + ch;
        float a[16], hb[16];
#pragma unroll
        for (int i = 0; i < 16; ++i) { a[i] = LSUM[o0 + (size_t)i * 256]; hb[i] = LSUM[(size_t)BATCH * 64 * 256 + o0 + (size_t)i * 256]; }
        float hp[16], ap[16], hl = 0.f, al = 1.f;
#pragma unroll
        for (int i = 0; i < 16; ++i) { hp[i] = hl; ap[i] = al; hl = a[i] * hl + hb[i]; al = a[i] * al; }
        float cin = 0.f;
#pragma unroll
        for (int s2 = 0; s2 < 3; ++s2) { const float as = SHFL(al, (F.lane & ~3) + s2), hs = SHFL(hl, (F.lane & ~3) + s2); if (s2 < seg) cin = as * cin + hs; }
#pragma unroll
        for (int i = 0; i < 16; ++i) CARRY[o0 + (size_t)i * 256] = ap[i] * cin + hp[i];
    }
}
DEV void ph_lru2(const Ctx& F, int l) {
    const int tid = F.tid, lane = F.lane, w = F.wave;
    const bf16* PROJ = (const bf16*)(F.ws + WS_PROJ); const bf16* HLOC = (const bf16*)(F.ws + WS_HLOC); const bf16* CPA = (const bf16*)(F.ws + WS_CPA);
    const float* CARRY = (const float*)(F.ws + WS_CARRY); bf16* CAT = (bf16*)(F.ws + WS_CAT);
    const f32x4 gw4 = *(const f32x4*)(PIN(F, I_GNW) + l * DM + 4 * lane);
    for (int u = F.bid; u < BATCH * 64; u += F.G) {
        const int b = u >> 6, c = u & 63; const size_t m0 = (size_t)b * SEQ + c * 64;
        const f32x4 car = *(const f32x4*)(CARRY + (size_t)u * 256 + 4 * lane);
        u32x2 hl8[8], cp8[8], ly8[8];
#pragma unroll
        for (int tt = 0; tt < 8; ++tt) { const size_t m = m0 + w * 8 + tt;
            hl8[tt] = *(const u32x2*)(HLOC + m * 256 + 4 * lane); cp8[tt] = *(const u32x2*)(CPA + m * 256 + 4 * lane); ly8[tt] = *(const u32x2*)(PROJ + m * NPROJ + PC_LY + 4 * lane); }
#pragma unroll
        for (int tt = 0; tt < 8; ++tt) { const size_t m = m0 + w * 8 + tt; const u32x2 hl = hl8[tt], cp = cp8[tt], ly = ly8[tt];
            float v0 = (bflo(hl.x) + bflo(cp.x) * car.x) * gelu_tanh(bflo(ly.x));
            float v1 = (bfhi(hl.x) + bfhi(cp.x) * car.y) * gelu_tanh(bfhi(ly.x));
            float v2 = (bflo(hl.y) + bflo(cp.y) * car.z) * gelu_tanh(bflo(ly.y));
            float v3 = (bfhi(hl.y) + bfhi(cp.y) * car.w) * gelu_tanh(bfhi(ly.y));
            const float rs = RSQ(wave_sum((v0 * v0 + v1 * v1) + (v2 * v2 + v3 * v3)) * (1.0f / 256.0f) + NORM_EPS);
            u32x2 o; o.x = pk2(v0 * rs * gw4.x, v1 * rs * gw4.y); o.y = pk2(v2 * rs * gw4.z, v3 * rs * gw4.w);
            *(u32x2*)(CAT + m * DM + 4 * lane) = o; }
    }
}

constexpr int QS_STRIDE = 136, VE_STRIDE = 56;
DEV void ph_mlstm(const Ctx& F, int l) {
    const int tid = F.tid, lane = F.lane, w = F.wave, i16 = lane & 15, g = lane >> 4;
    bf16* QsB = (bf16*)F.lds;
    bf16* KsB = QsB + 2 * 64 * QS_STRIDE;
    bf16* VE = KsB + 2 * 64 * QS_STRIDE;
    bf16* VW = VE + 64 * VE_STRIDE;
    bf16* CsB = VW + 64 * VE_STRIDE;
    float* BCB = (float*)(CsB + 2 * 128 * VE_STRIDE);
    float* BIB = BCB + 128;
    const bf16* PROJ = (const bf16*)(F.ws + WS_PROJ); bf16* HM = (bf16*)(F.ws + WS_HM);
    const float qscale = 0.08838834764831845f;
    const int jt = w & 3, half = w >> 2;
    for (int u = F.bid; u < BATCH * 4 * 4; u += F.G) {
        const int b = u >> 4, h = (u >> 2) & 3, vs = u & 3;
        const float gbi = PIN(F, I_BI)[l * 4 + h], gbf = PIN(F, I_BF)[l * 4 + h];
        f32x4 accC[3];
#pragma unroll
        for (int nt = 0; nt < 3; ++nt) accC[nt] = (f32x4){0.f, 0.f, 0.f, 0.f};
        float* BCg = (float*)(F.ws + WS_MG) + (size_t)u * 8192; float* BIg = BCg + 4096;
        unsigned gri[8], grf[8];
#pragma unroll
        for (int k = 0; k < 8; ++k) { const bf16* pr = PROJ + ((size_t)b * SEQ + (8 * k + w) * 64 + lane) * NPROJ; gri[k] = pr[PC_MI + h]; grf[k] = pr[PC_MF + h]; }
#pragma unroll
        for (int k = 0; k < 8; ++k) { const int tok = (8 * k + w) * 64 + lane;
            const float zi = (bf2f(gri[k]) + gbi) * (1.0f / 15.0f), zf = (bf2f(grf[k]) + gbf) * (1.0f / 15.0f);
            const float ig = 15.0f - 30.0f * FRCP(FEXP(2.0f * zi) + 1.0f), fg = 15.0f - 30.0f * FRCP(FEXP(2.0f * zf) + 1.0f);
            float s = -FLOG(1.0f + FEXP(-fg));
#pragma unroll
            for (int o = 1; o < 64; o <<= 1) { const float t = SHFL_UP(s, o); if (lane >= o) s += t; }
            BCg[tok] = s; BIg[tok] = s - ig; }
        SYNC();
        u32x4 rq[2], rk[2]; u32x2 rvv; float rgc = 0.f, rgb = 0.f;
        {
            const size_t m0 = (size_t)b * SEQ;
#pragma unroll
            for (int i = 0; i < 2; ++i) { const int idx = tid + 512 * i, row = idx >> 4, ck = idx & 15;
                rq[i] = *(const u32x4*)(PROJ + (m0 + row) * NPROJ + PC_MQ + h * 128 + 8 * ck); rk[i] = *(const u32x4*)(PROJ + (m0 + row) * NPROJ + PC_MK + h * 128 + 8 * ck); }
            rvv = *(const u32x2*)(PROJ + (m0 + (tid >> 3)) * NPROJ + PC_MV + h * 128 + vs * 32 + 4 * (tid & 7));
            if (tid < 64) { rgc = BCg[tid]; rgb = BIg[tid]; }
        }
        for (int c = 0; c < 64; ++c) {
            const size_t m0 = (size_t)b * SEQ + c * 64; const int buf = c & 1;
            bf16* Qs = QsB + buf * 64 * QS_STRIDE; bf16* Ks = KsB + buf * 64 * QS_STRIDE; const bf16* Cs = CsB + buf * 128 * VE_STRIDE; bf16* Cn = CsB + (buf ^ 1) * 128 * VE_STRIDE;
            float* BC = BCB + buf * 64; float* BI = BIB + buf * 64;
#pragma unroll
            for (int i = 0; i < 2; ++i) { const int idx = tid + 512 * i, row = idx >> 4, ck = idx & 15;
                *(u32x4*)(Qs + row * QS_STRIDE + 8 * ck) = rq[i]; *(u32x4*)(Ks + row * QS_STRIDE + 8 * ck) = rk[i]; }
            if (tid < 64) { BC[tid] = rgc; BI[tid] = rgb; }
            SYNC();
            {
                const int row = tid >> 3, cg = tid & 7;
                const u32x2 rv = rvv;
                const float wt = FEXP(BC[63] - BI[row]);
                *(u32x2*)(VE + row * VE_STRIDE + 4 * cg) = rv;
                u32x2 sv; sv.x = pk2(bflo(rv.x) * wt, bfhi(rv.x) * wt); sv.y = pk2(bflo(rv.y) * wt, bfhi(rv.y) * wt);
                *(u32x2*)(VW + row * VE_STRIDE + 4 * cg) = sv;
                if (cg == 0) { unsigned one_ = 0x3f80u; LAUNDER_V(one_); u32x4 z = (u32x4){one_, 0u, 0u, 0u}; *(u32x4*)(VE + row * VE_STRIDE + 32) = z; *(u32x4*)(VE + row * VE_STRIDE + 40) = (u32x4){0u, 0u, 0u, 0u};
                    z.x = f2bf(wt); *(u32x4*)(VW + row * VE_STRIDE + 32) = z; *(u32x4*)(VW + row * VE_STRIDE + 40) = (u32x4){0u, 0u, 0u, 0u}; }
            }
            if (c + 1 < 64) {
                const size_t m1 = m0 + 64;
#pragma unroll
                for (int i = 0; i < 2; ++i) { const int idx = tid + 512 * i, row = idx >> 4, ck = idx & 15;
                    rq[i] = *(const u32x4*)(PROJ + (m1 + row) * NPROJ + PC_MQ + h * 128 + 8 * ck); rk[i] = *(const u32x4*)(PROJ + (m1 + row) * NPROJ + PC_MK + h * 128 + 8 * ck); }
                rvv = *(const u32x2*)(PROJ + (m1 + (tid >> 3)) * NPROJ + PC_MV + h * 128 + vs * 32 + 4 * (tid & 7));
                if (tid < 64) { rgc = BCg[(c + 1) * 64 + tid]; rgb = BIg[(c + 1) * 64 + tid]; }
            }
            SYNC();
            f32x4 Z[2] = {(f32x4){0.f, 0.f, 0.f, 0.f}, (f32x4){0.f, 0.f, 0.f, 0.f}};
            {
                bf16x8 Bq[4];
#pragma unroll
                for (int ks = 0; ks < 4; ++ks) Bq[ks] = *(const bf16x8*)(Qs + (16 * jt + i16) * QS_STRIDE + 32 * ks + 8 * g);
                const float bj = BC[16 * jt + i16];
                unsigned pk[4][2];
#pragma unroll
                for (int tt = 0; tt < 4; ++tt) {
                    if (tt <= jt) {
                        f32x4 X = (f32x4){0.f, 0.f, 0.f, 0.f};
#pragma unroll
                        for (int ks = 0; ks < 4; ++ks) X = MFMA16(*(const bf16x8*)(Ks + (16 * tt + i16) * QS_STRIDE + 32 * ks + 8 * g), Bq[ks], X);
                        float p[4]; const f32x4 bi4 = *(const f32x4*)(BI + 16 * tt + 4 * g);
#pragma unroll
                        for (int r = 0; r < 4; ++r) { const float pv = X[r] * qscale * FEXP(fminf(bj - bi4[r], 60.0f));
                            p[r] = (tt < jt || 4 * g + r <= i16) ? pv : 0.f; }
                        pk[tt][0] = pk2(p[0], p[1]); pk[tt][1] = pk2(p[2], p[3]);
                    } else { pk[tt][0] = 0u; pk[tt][1] = 0u; }
                }
#pragma unroll
                for (int pr = 0; pr < 2; ++pr) {
                    if (2 * pr <= jt) {
                        u32x4 aw = (u32x4){pk[2 * pr][0], pk[2 * pr][1], pk[2 * pr + 1][0], pk[2 * pr + 1][1]};
                        const bf16x8 A = __builtin_bit_cast(bf16x8, aw);
#pragma unroll
                        for (int n = 0; n < 2; ++n) { const int ntc = n ? 2 : half;
                            const s16x4 lo = TR16(VE + (32 * pr + 4 * g + (i16 >> 2)) * VE_STRIDE + 16 * ntc + 4 * (i16 & 3));
                            const s16x4 hi = TR16(VE + (32 * pr + 16 + 4 * g + (i16 >> 2)) * VE_STRIDE + 16 * ntc + 4 * (i16 & 3));
                            const bf16x8 B = (bf16x8){lo[0], lo[1], lo[2], lo[3], hi[0], hi[1], hi[2], hi[3]};
                            Z[n] = MFMA16(A, B, Z[n]); }
#ifndef HOST_EMU
                        asm volatile("" :: "v"(aw));
#endif
                    }
                }
            }
            if (c > 0) {
                f32x4 Z2[2] = {(f32x4){0.f, 0.f, 0.f, 0.f}, (f32x4){0.f, 0.f, 0.f, 0.f}};
#pragma unroll
                for (int ks = 0; ks < 4; ++ks) { const bf16x8 A = *(const bf16x8*)(Qs + (16 * jt + i16) * QS_STRIDE + 32 * ks + 8 * g);
#pragma unroll
                    for (int n = 0; n < 2; ++n) { const int ntc = n ? 2 : half;
                        const s16x4 lo = TR16(Cs + (32 * ks + 8 * g + (i16 >> 2)) * VE_STRIDE + 16 * ntc + 4 * (i16 & 3));
                        const s16x4 hi = TR16(Cs + (32 * ks + 8 * g + 4 + (i16 >> 2)) * VE_STRIDE + 16 * ntc + 4 * (i16 & 3));
                        const bf16x8 B = (bf16x8){lo[0], lo[1], lo[2], lo[3], hi[0], hi[1], hi[2], hi[3]};
                        Z2[n] = MFMA16(A, B, Z2[n]); } }
                const f32x4 bc4 = *(const f32x4*)(BC + 16 * jt + 4 * g);
#pragma unroll
                for (int r = 0; r < 4; ++r) { const float f = qscale * FEXP(bc4[r]); Z[0][r] += f * Z2[0][r]; Z[1][r] += f * Z2[1][r]; }
            }
#pragma unroll
            for (int r = 0; r < 4; ++r) { const int j = 16 * jt + 4 * g + r; const float dn = FRCP(fmaxf(fabsf(SHFL(Z[1][r], lane & 48)), 1.0f));
                HM[(m0 + j) * 512 + h * 128 + vs * 32 + 16 * half + i16] = (bf16)f2bf(Z[0][r] * dn); }
            {
                const float dec = FEXP(BC[63]);
#pragma unroll
                for (int nt = 0; nt < 3; ++nt) accC[nt] = accC[nt] * dec;
#pragma unroll
                for (int ks = 0; ks < 2; ++ks) {
                    const s16x4 alo = TR16(Ks + (32 * ks + 8 * g + (i16 >> 2)) * QS_STRIDE + 16 * w + 4 * (i16 & 3));
                    const s16x4 ahi = TR16(Ks + (32 * ks + 8 * g + 4 + (i16 >> 2)) * QS_STRIDE + 16 * w + 4 * (i16 & 3));
                    const bf16x8 A = (bf16x8){alo[0], alo[1], alo[2], alo[3], ahi[0], ahi[1], ahi[2], ahi[3]};
#pragma unroll
                    for (int nt = 0; nt < 3; ++nt) {
                        const s16x4 lo = TR16(VW + (32 * ks + 8 * g + (i16 >> 2)) * VE_STRIDE + 16 * nt + 4 * (i16 & 3));
                        const s16x4 hi = TR16(VW + (32 * ks + 8 * g + 4 + (i16 >> 2)) * VE_STRIDE + 16 * nt + 4 * (i16 & 3));
                        const bf16x8 B = (bf16x8){lo[0], lo[1], lo[2], lo[3], hi[0], hi[1], hi[2], hi[3]};
                        const f32x4 cold = accC[nt]; accC[nt] = MFMA16(A, B, cold);
#ifndef HOST_EMU
                        asm volatile("" :: "v"(cold), "v"(A), "v"(B));
#endif
                    }
                }
#pragma unroll
                for (int nt = 0; nt < 3; ++nt)
#pragma unroll
                    for (int r = 0; r < 4; ++r) Cn[(16 * w + 4 * g + r) * VE_STRIDE + 16 * nt + i16] = (bf16)f2bf(accC[nt][r]);
            }
        }
        SYNC();
    }
}

DEV void ph_mfin(const Ctx& F, int l) {
    const int gw = F.bid * 8 + F.wave, NGW = F.G * 8, lane = F.lane;
    const bf16* PROJ = (const bf16*)(F.ws + WS_PROJ); const bf16* HM = (const bf16*)(F.ws + WS_HM); bf16* CAT = (bf16*)(F.ws + WS_CAT);
    float gm[8];
#pragma unroll
    for (int j = 0; j < 8; ++j) gm[j] = PIN(F, I_GNW)[l * DM + 256 + 8 * lane + j];
    u32x4 hv4[4], ov4[4], hvn[4], ovn[4];
#define MFIN_LOAD(HV, OV, M0) do { _Pragma("unroll") for (int q = 0; q < 4; ++q) { const int mm = (M0) + q * NGW; const size_t ms = (size_t)(mm < MTOK ? mm : 0); \
            HV[q] = *(const u32x4*)(HM + ms * 512 + 8 * lane); OV[q] = *(const u32x4*)(PROJ + ms * NPROJ + PC_MO + 8 * lane); } } while (0)
    MFIN_LOAD(hv4, ov4, gw);
    for (int m0 = gw; m0 < MTOK; m0 += 4 * NGW) {
        MFIN_LOAD(hvn, ovn, m0 + 4 * NGW);
#pragma unroll
        for (int q = 0; q < 4; ++q) { const int m = m0 + q * NGW; if (m >= MTOK) break;
            const u32x4 hv = hv4[q], ov = ov4[q];
            float v[8] = {bflo(hv.x), bfhi(hv.x), bflo(hv.y), bfhi(hv.y), bflo(hv.z), bfhi(hv.z), bflo(hv.w), bfhi(hv.w)};
            const float o[8] = {bflo(ov.x), bfhi(ov.x), bflo(ov.y), bfhi(ov.y), bflo(ov.z), bfhi(ov.z), bflo(ov.w), bfhi(ov.w)};
            float s = 0.f;
#pragma unroll
            for (int j = 0; j < 8; ++j) s += v[j] * v[j];
            s += SHFL_XOR(s, 1); s += SHFL_XOR(s, 2); s += SHFL_XOR(s, 4); s += SHFL_XOR(s, 8);
            const float rs = RSQ(s * (1.0f / 128.0f) + NORM_EPS);
            u32x4 r;
            r.x = pk2(v[0] * rs * gm[0] * fsigmoid(o[0]), v[1] * rs * gm[1] * fsigmoid(o[1]));
            r.y = pk2(v[2] * rs * gm[2] * fsigmoid(o[2]), v[3] * rs * gm[3] * fsigmoid(o[3]));
            r.z = pk2(v[4] * rs * gm[4] * fsigmoid(o[4]), v[5] * rs * gm[5] * fsigmoid(o[5]));
            r.w = pk2(v[6] * rs * gm[6] * fsigmoid(o[6]), v[7] * rs * gm[7] * fsigmoid(o[7]));
            *(u32x4*)(CAT + (size_t)m * DM + 256 + 8 * lane) = r; }
#pragma unroll
        for (int q = 0; q < 4; ++q) { hv4[q] = hvn[q]; ov4[q] = ovn[q]; }
    }
#undef MFIN_LOAD
}

constexpr int DS_HIST = 0;
constexpr int DS_MASK = 49152;
constexpr int DS_CAND = 65536;
constexpr int DS_SELL = 102400;
constexpr int DS_META = 118784;
constexpr int DS_RB = DS_META + 512;
constexpr int DS_SS = DS_RB + 2048;
constexpr int DS_SLOT = 12800;
constexpr int NBIN = 768, CAND_CAP = 128;
__device__ const unsigned char T5B[114] = {0, 1, 2, 3, 4, 5, 6, 7, 8, 9, 10, 11, 12, 13, 14, 15, 16, 16, 16, 17, 17, 18, 18, 18, 19, 19, 19, 20, 20, 20, 20, 21, 21, 21, 21, 22, 22, 22, 22, 22, 23, 23, 23, 23, 23, 23, 24, 24, 24, 24, 24, 24, 25, 25, 25, 25, 25, 25, 25, 26, 26, 26, 26, 26, 26, 26, 26, 27, 27, 27, 27, 27, 27, 27, 27, 27, 27, 28, 28, 28, 28, 28, 28, 28, 28, 28, 28, 29, 29, 29, 29, 29, 29, 29, 29, 29, 29, 29, 29, 30, 30, 30, 30, 30, 30, 30, 30, 30, 30, 30, 30, 30, 30, 31};

DEV int score_bin(float sc) {
    const unsigned u = __builtin_bit_cast(unsigned, sc);
    int e = (int)((u >> 18) & 0x1FFFu) - 119 * 32; e = e < 0 ? 0 : (e > 383 ? 383 : e);
    return (u >> 31) ? 383 - e : 384 + e;
}
DEV unsigned score_key(float sc) { const unsigned u = __builtin_bit_cast(unsigned, sc); return (u >> 31) ? ~u : (u | 0x80000000u); }


DEV f32x4 dsa_score_tile(const bf16x8 A, const bf16x8 (&QS)[2], const bf16x8 (&Bq)[8], const float (&wq)[8]) {
    f32x4 sc = (f32x4){0.f, 0.f, 0.f, 0.f};
#pragma unroll
    for (int h = 0; h < 8; ++h) { const f32x4 d = MFMA16(A, Bq[h], (f32x4){0.f, 0.f, 0.f, 0.f});
#pragma unroll
        for (int r = 0; r < 4; ++r) { sc[r] += wq[h] * RELU(d[r]); NOPACK(sc[r]); } }
    return sc;
}
DEV void ph_dsa(const Ctx& F, int l) {
    const int tid = F.tid, lane = F.lane, w = F.wave, i16 = lane & 15, g = lane >> 4;
    unsigned* HIST = (unsigned*)(F.lds + DS_HIST); unsigned* MASK = (unsigned*)(F.lds + DS_MASK); u32x2* CAND = (u32x2*)(F.lds + DS_CAND);
    unsigned short* SELL = (unsigned short*)(F.lds + DS_SELL); int* BST = (int*)(F.lds + DS_META); int* NAB = BST + 32; int* NCAND = BST + 64; int* NSEL = BST + 96;
    float* RB = (float*)(F.lds + DS_RB);
    const bf16* QIDX = (const bf16*)(F.ws + WS_QIDX); const bf16* KIDX = (const bf16*)(F.ws + WS_KIDX); const float* WI = (const float*)(F.ws + WS_WI);
    const bf16* QABS = (const bf16*)(F.ws + WS_QABS); const bf16* CKV = (const bf16*)(F.ws + WS_CKV); bf16* CAT = (bf16*)(F.ws + WS_CAT);
    const bf16* WUVT = (const bf16*)(F.ws + WS_WUVT) + (size_t)l * 4 * 64 * 128; float* SS = (float*)(F.lds + DS_SS);
    for (int e = tid; e < 114 * 4; e += 512) RB[e] = PIN(F, I_RELB)[T5B[e >> 2] * 4 + (e & 3)] * 1.4426950408889634f;
    SYNC();
    for (int ui = F.bid; ui < BATCH * 128; ui += F.G) {
        int b, qt; { const int wv = ui & 255, k = ui >> 8, r = wv & 15; b = wv >> 4; qt = (k & 1) ? (32 * (k >> 1) + 31 - r) : (32 * (k >> 1) + r); }
        const int t0 = 32 * qt, nkt = 2 * qt + 2; const size_t mb = (size_t)b * SEQ;
        const int nt = w & 1;
        bf16x8 Bq[8]; float wq[8];
        { const size_t mq = mb + t0 + 16 * nt + i16;
#pragma unroll
            for (int h = 0; h < 8; ++h) { Bq[h] = *(const bf16x8*)(QIDX + mq * 256 + 32 * h + 8 * g); wq[h] = WI[mq * 8 + h]; } }
        bf16x8 QS[2];
#pragma unroll
        for (int j = 0; j < 8; ++j) { float s = 0.f;
#pragma unroll
            for (int h = 0; h < 8; ++h) s += wq[h] * bf2f((unsigned)(unsigned short)Bq[h][j]);
            const unsigned hi = f2bf(s); QS[0][j] = (short)hi; QS[1][j] = (short)f2bf(s - bf2f(hi)); }
        for (int e = tid; e < 16 * NBIN; e += 512) HIST[e] = 0u;
        for (int e = tid; e < 32 * 128; e += 512) MASK[e] = 0u;
        if (tid < 32) NCAND[tid] = 0;
        SYNC();
        bf16x8 Apre = *(const bf16x8*)(KIDX + (mb + 16 * (w >> 1) + i16) * 32 + 8 * g);
        for (int kt = w >> 1; kt < nkt; kt += 4) {
            const bf16x8 A = Apre;
            { const int kn = kt + 4 < nkt ? kt + 4 : kt; Apre = *(const bf16x8*)(KIDX + (mb + 16 * kn + i16) * 32 + 8 * g); }
            const f32x4 sc = dsa_score_tile(A, QS, Bq, wq);
            const unsigned inc = nt ? 65536u : 1u;
            if (kt < 2 * qt) {
#pragma unroll
                for (int r = 0; r < 4; ++r) atomicAdd(&HIST[i16 * NBIN + score_bin(sc[r] + 0.0f)], inc);
            } else {
                const int t = t0 + 16 * nt + i16;
#pragma unroll
                for (int r = 0; r < 4; ++r) { const int s = 16 * kt + 4 * g + r;
                    if (s <= t) atomicAdd(&HIST[i16 * NBIN + score_bin(sc[r] + 0.0f)], inc); }
            }
        }
        SYNC();
#pragma unroll 1
        for (int rr = 0; rr < 4; ++rr) {
            const int row = 4 * w + rr, t = t0 + row;
            if (t < 256) { if (lane == 0) { BST[row] = -1; NAB[row] = t + 1; } continue; }
            const int sh = (row >> 4) * 16; const unsigned* hp = HIST + (row & 15) * NBIN + 12 * lane;
            int cnt[12]; int tot = 0;
#pragma unroll
            for (int i = 0; i < 12; ++i) { cnt[i] = (int)((hp[i] >> sh) & 0xFFFFu); tot += cnt[i]; }
            int suf = tot;
#pragma unroll
            for (int o = 1; o < 64; o <<= 1) { const int v = SHFL_DOWN(suf, o); if (lane + o < 64) suf += v; }
            const int above = suf - tot;
            if (above < 256 && above + tot >= 256) {
                int run = above, bs = -1, na = 0; bool done = false;
#pragma unroll
                for (int i = 11; i >= 0; --i) { if (!done) { if (run + cnt[i] >= 256) { bs = 12 * lane + i; na = run; done = true; } else run += cnt[i]; } }
                BST[row] = bs; NAB[row] = na;
            }
        }
        SYNC();
        Apre = *(const bf16x8*)(KIDX + (mb + 16 * (w >> 1) + i16) * 32 + 8 * g);
        { const int row = 16 * nt + i16, t = t0 + row, bs = BST[row];
        for (int kt = w >> 1; kt < nkt; kt += 4) {
            const bf16x8 A = Apre;
            { const int kn = kt + 4 < nkt ? kt + 4 : kt; Apre = *(const bf16x8*)(KIDX + (mb + 16 * kn + i16) * 32 + 8 * g); }
            const bool full = kt < 2 * qt;
            const f32x4 sc = dsa_score_tile(A, QS, Bq, wq);
#pragma unroll
            for (int r = 0; r < 4; ++r) { const int s = 16 * kt + 4 * g + r;
                if (full || s <= t) { const float v = sc[r] + 0.0f; const int bn = score_bin(v);
                    if (bn > bs) atomicOr(&MASK[row * 128 + (s >> 5)], 1u << (s & 31));
                    else if (bn == bs) { const int pos = (int)atomicAdd((unsigned*)&NCAND[row], 1u); if (pos < CAND_CAP) CAND[row * CAND_CAP + pos] = (u32x2){score_key(v), (unsigned)s}; } } }
        } }
        SYNC();
#pragma unroll 1
        for (int rr = 0; rr < 4; ++rr) {
            const int row = 4 * w + rr; if (BST[row] < 0) continue;
            const int n = NCAND[row] < CAND_CAP ? NCAND[row] : CAND_CAP, need = 256 - NAB[row];
            for (int i = lane; i < n; i += 64) { const u32x2 me = CAND[row * CAND_CAP + i]; int rank = 0;
                for (int j = 0; j < n; ++j) { const u32x2 o = CAND[row * CAND_CAP + j]; rank += (o.x > me.x || (o.x == me.x && o.y < me.y)) ? 1 : 0; }
#ifndef DSA_DBG_NOCAND
                if (rank < need) atomicOr(&MASK[row * 128 + (me.y >> 5)], 1u << (me.y & 31));
#endif
            }
        }
        SYNC();
#ifdef DSA_DBG_SEL
        for (int e = tid; e < 32 * 128; e += 512) { const int row = e >> 7, wi = e & 127, t = t0 + row, lo = t - 255 < 0 ? 0 : t - 255; unsigned m = 0u;
            for (int bq = 0; bq < 32; ++bq) { const int s = 32 * wi + bq; if (s >= lo && s <= t) m |= 1u << bq; }
            MASK[e] = m; }
        SYNC();
#endif
#pragma unroll 1
        for (int rr = 0; rr < 4; ++rr) {
            const int row = 4 * w + rr;
            unsigned w0 = MASK[row * 128 + 2 * lane], w1 = MASK[row * 128 + 2 * lane + 1];
            const int c = __builtin_popcount(w0) + __builtin_popcount(w1);
            int inc = c;
#pragma unroll
            for (int o = 1; o < 64; o <<= 1) { const int v = SHFL_UP(inc, o); if (lane >= o) inc += v; }
            int pos = inc - c;
            while (w0) { const int bt = __builtin_ctz(w0); w0 &= w0 - 1; if (pos < 256) SELL[row * 256 + pos] = (unsigned short)(64 * lane + bt); ++pos; }
            while (w1) { const int bt = __builtin_ctz(w1); w1 &= w1 - 1; if (pos < 256) SELL[row * 256 + pos] = (unsigned short)(64 * lane + 32 + bt); ++pos; }
            if (lane == 63) NSEL[row] = inc < 256 ? inc : 256;
        }
        SYNC();
        bf16* TL = (bf16*)(F.lds + w * DS_SLOT); bf16* OLw = (bf16*)(F.lds + w * DS_SLOT + 8704);
#pragma unroll 1
        for (int rr = 0; rr < 4; ++rr) {
            const int row = 4 * w + rr, t = t0 + row, ns = UNI(NSEL[row]); const size_t mt = mb + t;
            const unsigned short* sl = SELL + row * 256;
            bf16x8 Bh[4];
#pragma unroll
            for (int ks = 0; ks < 4; ++ks) Bh[ks] = i16 < 4 ? *(const bf16x8*)(QABS + mt * 512 + i16 * 128 + 32 * ks + 8 * g) : (bf16x8){0, 0, 0, 0, 0, 0, 0, 0};
            f32x4 O[8];
#pragma unroll
            for (int nt = 0; nt < 8; ++nt) O[nt] = (f32x4){0.f, 0.f, 0.f, 0.f};
            float mrun = -1e30f, lrun = 0.f;
            const float bfar = RB[113 * 4 + (i16 & 3)];
            const int nch = (ns + 31) >> 5;
            u32x4 gvA[8];
#define ATT_LOAD(GV, CK, FULL) do { int sidx[8]; \
                _Pragma("unroll") for (int i = 0; i < 8; ++i) sidx[i] = (int)sl[32 * (CK) + 4 * i + g];            \
                _Pragma("unroll") for (int i = 0; i < 8; ++i) { const int kp = 32 * (CK) + 4 * i + g; sidx[i] = (FULL || kp < ns) ? sidx[i] : 0; } \
                _Pragma("unroll") for (int i = 0; i < 8; ++i) GV[i] = *(const u32x4*)(CKV + (mb + sidx[i]) * 128 + 8 * i16); } while (0)
#define ATT_STEP(GV, CK, FULL) do { const int ck = (CK); \
                _Pragma("unroll") for (int i = 0; i < 8; ++i) *(u32x4*)(TL + (4 * i + g) * 136 + 8 * i16) = GV[i]; \
                const u32x2 sk0 = *(const u32x2*)(sl + 32 * ck + 4 * g), sk1 = *(const u32x2*)(sl + 32 * ck + 16 + 4 * g); \
                WAVE_LDS_FENCE(); \
                if (ck + 1 < nch) ATT_LOAD(GV, ck + 1, FULL); \
                float bia[2][4]; \
                if (FULL && t - UNI((int)sl[32 * ck + 31]) >= 113) {                   \
                _Pragma("unroll") for (int kt = 0; kt < 2; ++kt) \
                _Pragma("unroll") for (int r = 0; r < 4; ++r) bia[kt][r] = bfar; \
                } else { \
                _Pragma("unroll") for (int kt = 0; kt < 2; ++kt) \
                _Pragma("unroll") for (int r = 0; r < 4; ++r) { const unsigned wd = kt ? (r < 2 ? sk1.x : sk1.y) : (r < 2 ? sk0.x : sk0.y); \
                        int dist = t - (int)((wd >> (16 * (r & 1))) & 0xffffu); dist = dist < 0 ? 0 : (dist > 113 ? 113 : dist); \
                        bia[kt][r] = RB[dist * 4 + (i16 & 3)]; } } \
                f32x4 lg[2]; \
                _Pragma("unroll") for (int kt = 0; kt < 2; ++kt) { lg[kt] = (f32x4){0.f, 0.f, 0.f, 0.f}; \
                _Pragma("unroll") for (int ks = 0; ks < 4; ++ks) lg[kt] = MFMA16(*(const bf16x8*)(TL + (16 * kt + i16) * 136 + 32 * ks + 8 * g), Bh[ks], lg[kt]); } \
                float cm = -1e30f; \
                _Pragma("unroll") for (int kt = 0; kt < 2; ++kt) \
                _Pragma("unroll") for (int r = 0; r < 4; ++r) { const int kp = 32 * ck + 16 * kt + 4 * g + r; \
                        lg[kt][r] = (FULL || kp < ns) ? lg[kt][r] + bia[kt][r] : -1e30f; cm = fmaxf(cm, lg[kt][r]); } \
                if (ck == 0) { cm = fmaxf(cm, SHFL_XOR(cm, 16)); cm = fmaxf(cm, SHFL_XOR(cm, 32)); mrun = cm; } \
                float p[2][4]; \
                _Pragma("unroll") for (int kt = 0; kt < 2; ++kt) \
                _Pragma("unroll") for (int r = 0; r < 4; ++r) { p[kt][r] = (FULL || lg[kt][r] > -1e29f) ? FEXP2(lg[kt][r] - mrun) : 0.f; lrun += p[kt][r]; } \
                u32x4 aw = (u32x4){0u, 0u, 0u, 0u}; \
                if (i16 < 4) aw = (u32x4){pk2(p[0][0], p[0][1]), pk2(p[0][2], p[0][3]), pk2(p[1][0], p[1][1]), pk2(p[1][2], p[1][3])}; \
                const bf16x8 A = __builtin_bit_cast(bf16x8, aw); \
                _Pragma("unroll") for (int nt = 0; nt < 8; ++nt) { \
                    const s16x4 lo = TR16(TL + (4 * g + (i16 >> 2)) * 136 + 16 * nt + 4 * (i16 & 3)); \
                    const s16x4 hi = TR16(TL + (16 + 4 * g + (i16 >> 2)) * 136 + 16 * nt + 4 * (i16 & 3)); \
                    const bf16x8 B = (bf16x8){lo[0], lo[1], lo[2], lo[3], hi[0], hi[1], hi[2], hi[3]}; \
                    O[nt] = MFMA16(A, B, O[nt]); } \
                WAVE_LDS_FENCE(); } while (0)
            if (ns == 256) { ATT_LOAD(gvA, 0, true); for (int ck2 = 0; ck2 < 8; ++ck2) ATT_STEP(gvA, ck2, true); }
            else { ATT_LOAD(gvA, 0, false); for (int ck2 = 0; ck2 < nch; ++ck2) ATT_STEP(gvA, ck2, false); }
#undef ATT_STEP
#undef ATT_LOAD
            lrun += SHFL_XOR(lrun, 16); lrun += SHFL_XOR(lrun, 32);
            float li[4];
#pragma unroll
            for (int r = 0; r < 4; ++r) li[r] = FRCP(SHFL(lrun, r));
            if (g == 0) {
#pragma unroll
                for (int nt = 0; nt < 8; ++nt)
#pragma unroll
                    for (int r = 0; r < 4; ++r) OLw[(rr * 4 + r) * 128 + 16 * nt + i16] = (bf16)f2bf(O[nt][r] * li[r]);
            }
        }
        SYNC();
        {
            const int h = w >> 1, mtile = w & 1, q = 16 * mtile + i16;
            const bf16* olq = (const bf16*)(F.lds + (q >> 2) * DS_SLOT + 8704) + ((q & 3) * 4 + h) * 128;
            float gaw[4];
#pragma unroll
            for (int nt = 0; nt < 4; ++nt) gaw[nt] = PIN(F, I_GNW)[l * DM + 768 + h * 64 + 16 * nt + i16];
            f32x4 acc[4];
#pragma unroll
            for (int nt = 0; nt < 4; ++nt) acc[nt] = (f32x4){0.f, 0.f, 0.f, 0.f};
#pragma unroll
            for (int ks = 0; ks < 4; ++ks) { const bf16x8 A = *(const bf16x8*)(olq + 32 * ks + 8 * g);
#pragma unroll
                for (int nt = 0; nt < 4; ++nt) acc[nt] = MFMA16(A, *(const bf16x8*)(WUVT + ((size_t)(h * 64 + 16 * nt + i16)) * 128 + 32 * ks + 8 * g), acc[nt]); }
#pragma unroll
            for (int r = 0; r < 4; ++r) { float s = (acc[0][r] * acc[0][r] + acc[1][r] * acc[1][r]) + (acc[2][r] * acc[2][r] + acc[3][r] * acc[3][r]);
                s += SHFL_XOR(s, 1); s += SHFL_XOR(s, 2); s += SHFL_XOR(s, 4); s += SHFL_XOR(s, 8);
                if (i16 == 0) SS[(16 * mtile + 4 * g + r) * 4 + h] = s; }
            SYNC();
#pragma unroll
            for (int r = 0; r < 4; ++r) { const int qq = 16 * mtile + 4 * g + r; const f32x4 s4 = *(const f32x4*)(SS + qq * 4);
                const float rs = RSQ(((s4.x + s4.y) + (s4.z + s4.w)) * (1.0f / 256.0f) + NORM_EPS);
                bf16* dst = CAT + (mb + t0 + qq) * DM + 768 + h * 64 + i16;
#pragma unroll
                for (int nt = 0; nt < 4; ++nt) dst[16 * nt] = (bf16)f2bf(acc[nt][r] * rs * gaw[nt]); }
        }
        SYNC();
    }
}
#ifndef HOST_EMU
namespace pg8 {
#define PG8_LAS __attribute__((address_space(3)))
typedef unsigned short bf16_t;
typedef short bf16x8 __attribute__((ext_vector_type(8)));
typedef float f32x4 __attribute__((ext_vector_type(4)));
typedef unsigned u32x4 __attribute__((ext_vector_type(4)));
constexpr int BM = 256, BK = 64, HALF = 128, HTB = HALF * BK * 2  , STAGE_BYTES = 8 * HTB, NXCD = 8, WGM = 8;

__host__ __device__ __forceinline__ int lds_byte(int r, int c) { const int st = (r >> 4) * 2 + (c >> 5), rr = r & 15, cc = c & 31, ob = rr * 64 + cc * 2; return st * 1024 + (ob ^ (((ob >> 9) & 1) << 5)); }
__host__ __device__ __forceinline__ void stage_rc(int b, int& R, int& C) { const int st = b / 1024, sb = b % 1024, swz = sb ^ (((sb >> 9) & 1) << 5); R = (st >> 1) * 16 + swz / 64; C = (st & 1) * 32 + (swz % 64) / 2; }
__host__ __device__ __forceinline__ int perm32(int rho) { const int n = rho >> 4, i = rho & 15; return 8 * (i >> 2) + 4 * n + (i & 3); }

struct Unit { int pm, pn; };
struct Gemm { const bf16_t* A; const bf16_t* Bt; int M, N, K; };

struct StaticOrder {
    int nM, nN, nwg, G, c;
    __host__ __device__ void init(int M, int N, int G_, int c_) { nM = M / BM; nN = N / BM; nwg = nM * nN; G = G_; c = c_; }
    __host__ __device__ bool next(int i, Unit& u) const {
        const long L = (long)i * G + c; if (L >= nwg) return false;
        int wgid = (int)L; { const int q = nwg / NXCD, r = nwg % NXCD, xcd = wgid % NXCD, off = wgid / NXCD; wgid = (xcd < r ? xcd * (q + 1) : r * (q + 1) + (xcd - r) * q) + off; }
        const int nig = WGM * nN, gid = wgid / nig, fm = gid * WGM, gsz = (nM - fm) < WGM ? (nM - fm) : WGM;
        u.pm = fm + ((wgid % nig) % gsz); u.pn = (wgid % nig) / gsz; return true;
    }
    __device__ __forceinline__ void a_ready(const Unit&) const {}
    __device__ __forceinline__ void done(const Unit&) const {}
};
__device__ __forceinline__ unsigned cvt_pk_bf16(float lo, float hi) { unsigned r; asm volatile("v_cvt_pk_bf16_f32 %0, %1, %2" : "=v"(r) : "v"(lo), "v"(hi)); return r; }
template <class Epi, class Sched, bool ALIGN_EPI = false, bool SP2 = false>
__device__ __forceinline__ void gemm_phase(PG8_LAS unsigned char* lds, const Gemm g, const Sched& S, const Epi& E, const int tid_in) {
    const int tid = tid_in, wid = __builtin_amdgcn_readfirstlane(tid >> 6), lane = tid & 63, wr = wid >> 2, wc = wid & 3, fr = lane & 15, fq = lane >> 4;
    const int K = g.K, nt = K / BK;
    unsigned voffA[2], voffB[2];
#pragma unroll
    for (int i = 0; i < 2; ++i) { int R, C; stage_rc(tid * 16 + i * 8192, R, C); const int Rb = Epi::PERM ? ((R & ~31) + perm32(R & 31)) : R;
        voffA[i] = (unsigned)(R * K + C) * 2u; voffB[i] = (unsigned)(Rb * K + C) * 2u; }
    const size_t kstep = (size_t)(BK * 2);
    const size_t hstep = (size_t)HALF * K * 2;
    const size_t tstep = 2 * hstep;
    const unsigned ldsw = (unsigned)wid * 1024u;
    const int aoff = lds_byte(wr * 64 + fr, fq * 8), boff = lds_byte(wc * 32 + fr, fq * 8);
#define PG8_SA(b, h) (((b) * 2 + (h)) * HTB)
#define PG8_SB(b, h) ((4 + (b) * 2 + (h)) * HTB)
#define PG8_STAGE(bufoff, gbase, voff) do { _Pragma("unroll") for (int _i = 0; _i < 2; ++_i) \
        __builtin_amdgcn_global_load_lds((const unsigned*)((const char*)(gbase) + (voff)[_i]), (PG8_LAS unsigned*)(lds + (bufoff) + ldsw + _i * 8192), 16, 0, 0); } while (0)
#define PG8_LDA(dst, b, h) do { _Pragma("unroll") for (int m = 0; m < 4; ++m) _Pragma("unroll") for (int k = 0; k < 2; ++k) dst[m][k] = *(const PG8_LAS bf16x8*)(lds + PG8_SA(b, h) + aoff + m * 2048 + k * 1024); } while (0)
#define PG8_LDB(dst, b, h) do { _Pragma("unroll") for (int n = 0; n < 2; ++n) _Pragma("unroll") for (int k = 0; k < 2; ++k) dst[n][k] = *(const PG8_LAS bf16x8*)(lds + PG8_SB(b, h) + boff + n * 2048 + k * 1024); } while (0)
#define PG8_MMA(ai, bj, At, Bt) do { __builtin_amdgcn_s_setprio(1); _Pragma("unroll") for (int m = 0; m < 4; ++m) _Pragma("unroll") for (int n = 0; n < 2; ++n) _Pragma("unroll") for (int k = 0; k < 2; ++k) \
        acc[ai][bj][m][n] = __builtin_amdgcn_mfma_f32_16x16x32_bf16(Bt[n][k], At[m][k], acc[ai][bj][m][n], 0, 0, 0); __builtin_amdgcn_s_setprio(0); } while (0)
#define PG8_WAIT_V(n) asm volatile("s_waitcnt vmcnt(" #n ")" ::: "memory")
#define PG8_WAIT_L(n) asm volatile("s_waitcnt lgkmcnt(" #n ")" ::: "memory")
#define PG8_BAR __builtin_amdgcn_s_barrier()
#define PG8_SCHED __builtin_amdgcn_sched_barrier(0)
    Unit cur, nxt; int ui = 0;
    if (!S.next(0, cur)) return;
    f32x4 acc[2][2][4][2];
#pragma unroll
    for (int a = 0; a < 2; ++a)
#pragma unroll
        for (int b = 0; b < 2; ++b)
#pragma unroll
            for (int m = 0; m < 4; ++m)
#pragma unroll
                for (int n = 0; n < 2; ++n) acc[a][b][m][n] = (f32x4){0.f, 0.f, 0.f, 0.f};
    bf16x8 At[4][2], B0[2][2], B1[2][2];
    const char* cA = (const char*)g.A + (size_t)cur.pm * tstep; const char* cB = (const char*)g.Bt + (size_t)cur.pn * tstep;
    S.a_ready(cur);
    if constexpr (SP2) {
        PG8_STAGE(PG8_SB(0, 0), cB, voffB); PG8_STAGE(PG8_SB(0, 1), cB + hstep, voffB); PG8_STAGE(PG8_SA(0, 0), cA, voffA); PG8_STAGE(PG8_SA(0, 1), cA + hstep, voffA);
        if (wr == 1) PG8_BAR;
        PG8_WAIT_V(2); PG8_BAR;
        PG8_STAGE(PG8_SB(1, 0), cB + kstep, voffB); PG8_STAGE(PG8_SA(1, 0), cA + kstep, voffA); PG8_STAGE(PG8_SB(1, 1), cB + hstep + kstep, voffB);
        PG8_WAIT_V(6); PG8_BAR;
    } else {
        PG8_STAGE(PG8_SB(0, 0), cB, voffB); PG8_STAGE(PG8_SA(0, 0), cA, voffA); PG8_STAGE(PG8_SB(0, 1), cB + hstep, voffB); PG8_STAGE(PG8_SA(0, 1), cA + hstep, voffA);
        if (wr == 1) PG8_BAR;
        PG8_WAIT_V(4); PG8_BAR;
        PG8_STAGE(PG8_SB(1, 0), cB + kstep, voffB); PG8_STAGE(PG8_SA(1, 0), cA + kstep, voffA); PG8_STAGE(PG8_SB(1, 1), cB + hstep + kstep, voffB);
        PG8_WAIT_V(6); PG8_BAR;
    }
    for (;;) {
        const bool has_next = S.next(ui + 1, nxt);
        const char* nA = has_next ? (const char*)g.A + (size_t)nxt.pm * tstep : cA; const char* nB = has_next ? (const char*)g.Bt + (size_t)nxt.pn * tstep : cB;
#pragma unroll 1
        for (int t = 0; t < nt; t += 2) {
            const bool last = (t == nt - 2);
            const char* a1 = cA + (size_t)(t + 1) * kstep;
            const char* a2 = last ? nA : cA + (size_t)(t + 2) * kstep; const char* b2 = last ? nB : cB + (size_t)(t + 2) * kstep;
            const char* a3 = a2 + kstep; const char* b3 = b2 + kstep;
            if (last && has_next) S.a_ready(nxt);
            if constexpr (Epi::NORM) { if (t == 2) E.prefetch(cur, tid, wid); if (t == 4) E.reduce_rs(tid); }
            if constexpr (SP2) {
            PG8_LDB(B0, 0, 0); PG8_LDB(B1, 0, 1); PG8_SCHED; PG8_LDA(At, 0, 0); PG8_STAGE(PG8_SA(1, 1), a1 + hstep, voffA);
            PG8_WAIT_V(8); PG8_WAIT_L(0); PG8_BAR; PG8_MMA(0, 0, At, B0); PG8_MMA(0, 1, At, B1); PG8_BAR; PG8_SCHED;
            PG8_LDA(At, 0, 1); PG8_STAGE(PG8_SB(0, 0), b2, voffB); PG8_STAGE(PG8_SB(0, 1), b2 + hstep, voffB); PG8_STAGE(PG8_SA(0, 0), a2, voffA);
            PG8_WAIT_V(8); PG8_WAIT_L(0); PG8_BAR; PG8_MMA(1, 0, At, B0); PG8_MMA(1, 1, At, B1); PG8_BAR; PG8_SCHED;
            PG8_LDB(B0, 1, 0); PG8_LDB(B1, 1, 1); PG8_SCHED; PG8_LDA(At, 1, 0); PG8_STAGE(PG8_SA(0, 1), a2 + hstep, voffA);
            PG8_WAIT_V(8); PG8_WAIT_L(0); PG8_BAR; PG8_MMA(0, 0, At, B0); PG8_MMA(0, 1, At, B1); PG8_BAR; PG8_SCHED;
            PG8_LDA(At, 1, 1); PG8_STAGE(PG8_SB(1, 0), b3, voffB); PG8_STAGE(PG8_SB(1, 1), b3 + hstep, voffB); PG8_STAGE(PG8_SA(1, 0), a3, voffA);
            PG8_WAIT_V(8); PG8_WAIT_L(0); PG8_BAR; PG8_MMA(1, 0, At, B0); PG8_MMA(1, 1, At, B1); PG8_BAR; PG8_SCHED;
            } else {
            PG8_LDB(B0, 0, 0); PG8_SCHED; PG8_LDA(At, 0, 0); PG8_STAGE(PG8_SA(1, 1), a1 + hstep, voffA);
            PG8_WAIT_L(8); PG8_BAR; PG8_WAIT_L(0); PG8_MMA(0, 0, At, B0); PG8_BAR; PG8_SCHED;
            PG8_LDB(B1, 0, 1); PG8_STAGE(PG8_SB(0, 0), b2, voffB);
            PG8_BAR; PG8_WAIT_L(0); PG8_MMA(0, 1, At, B1); PG8_BAR;
            PG8_LDA(At, 0, 1); PG8_STAGE(PG8_SA(0, 0), a2, voffA);
            PG8_BAR; PG8_WAIT_L(0); PG8_MMA(1, 0, At, B0); PG8_BAR; PG8_SCHED;
            PG8_STAGE(PG8_SB(0, 1), b2 + hstep, voffB);
            PG8_WAIT_V(6); PG8_BAR; PG8_MMA(1, 1, At, B1); PG8_BAR;
            PG8_LDB(B0, 1, 0); PG8_SCHED; PG8_LDA(At, 1, 0); PG8_STAGE(PG8_SA(0, 1), a2 + hstep, voffA);
            PG8_WAIT_L(8); PG8_BAR; PG8_WAIT_L(0); PG8_MMA(0, 0, At, B0); PG8_BAR; PG8_SCHED;
            PG8_LDB(B1, 1, 1); PG8_STAGE(PG8_SB(1, 0), b3, voffB);
            PG8_BAR; PG8_WAIT_L(0); PG8_MMA(0, 1, At, B1); PG8_BAR;
            PG8_LDA(At, 1, 1); PG8_STAGE(PG8_SA(1, 0), a3, voffA);
            PG8_BAR; PG8_WAIT_L(0); PG8_MMA(1, 0, At, B0); PG8_BAR; PG8_SCHED;
            PG8_STAGE(PG8_SB(1, 1), b3 + hstep, voffB);
            PG8_WAIT_V(6); PG8_BAR; PG8_MMA(1, 1, At, B1); PG8_BAR;
            }
        }
        if constexpr (ALIGN_EPI) { if (wr == 0) PG8_BAR; }
        if constexpr (!Epi::AFTER_DRAIN) { E(acc, cur, wr, wc, fr, fq); S.done(cur); }
        if (!has_next) break;
#pragma unroll
        for (int a = 0; a < 2; ++a)
#pragma unroll
            for (int b = 0; b < 2; ++b)
#pragma unroll
                for (int m = 0; m < 4; ++m)
#pragma unroll
                    for (int n = 0; n < 2; ++n) acc[a][b][m][n] = (f32x4){0.f, 0.f, 0.f, 0.f};
        cur = nxt; cA = nA; cB = nB; ++ui;
        if constexpr (ALIGN_EPI) { if (wr == 1) PG8_BAR; }
    }
    PG8_WAIT_V(0);
    if constexpr (!ALIGN_EPI) { if (wr == 0) PG8_BAR; }
    PG8_BAR;
    if constexpr (Epi::AFTER_DRAIN) { E.fused(acc, cur, wr, wc, fr, fq, lds, wid, lane); S.done(cur); }
#undef PG8_SA
#undef PG8_SB
#undef PG8_STAGE
#undef PG8_LDA
#undef PG8_LDB
#undef PG8_MMA
#undef PG8_WAIT_V
#undef PG8_WAIT_L
#undef PG8_BAR
#undef PG8_SCHED
}
}
namespace pg8 {
template <int ACT  > struct EpiRoute {
    static constexpr bool PERM = true, AFTER_DRAIN = false, NORM = false;
    bf16_t* O0; int ld0; bf16_t* O1; int ld1; int split;
    __device__ __forceinline__ void operator()(const f32x4 (&acc)[2][2][4][2], const Unit& u, int wr, int wc, int fr, int fq) const {
        const int row0 = u.pm * BM + wr * 64 + fr; const bool first = u.pn < split;
        bf16_t* base = first ? O0 : O1; const int ld = first ? ld0 : ld1; const int col0 = (first ? u.pn : u.pn - split) * BM + wc * 32 + 8 * fq;
#pragma unroll
        for (int ai = 0; ai < 2; ++ai)
#pragma unroll
            for (int m = 0; m < 4; ++m) { bf16_t* rowp = base + (size_t)(row0 + ai * HALF + m * 16) * ld + col0;
#pragma unroll
                for (int bj = 0; bj < 2; ++bj) { f32x4 v0 = acc[ai][bj][m][0], v1 = acc[ai][bj][m][1];
                    if (ACT == 1) {
#pragma unroll
                        for (int e = 0; e < 4; ++e) { const float a = fmaxf(v0[e], 0.f), b = fmaxf(v1[e], 0.f); v0[e] = a * a; v1[e] = b * b; } }
                    u32x4 w; w.x = cvt_pk_bf16(v0[0], v0[1]); w.y = cvt_pk_bf16(v0[2], v0[3]); w.z = cvt_pk_bf16(v1[0], v1[1]); w.w = cvt_pk_bf16(v1[2], v1[3]);
                    *(u32x4*)(rowp + bj * HALF) = w; } }
    }
};
struct EpiResid {
    static constexpr bool PERM = true, AFTER_DRAIN = false, NORM = false;
    const float* xsrc; float* xdst; const float* gate;
    __device__ __forceinline__ void operator()(const f32x4 (&acc)[2][2][4][2], const Unit& u, int wr, int wc, int fr, int fq) const {
        const int row0 = u.pm * BM + wr * 64 + fr, col0 = u.pn * BM + wc * 32 + 8 * fq, b = (u.pm * BM) >> 12;
        f32x4 gv[2][2];
#pragma unroll
        for (int bj = 0; bj < 2; ++bj)
#pragma unroll
            for (int n = 0; n < 2; ++n) gv[bj][n] = *(const f32x4*)(gate + (size_t)b * 6144 + col0 + bj * HALF + 4 * n);
#pragma unroll
        for (int ai = 0; ai < 2; ++ai)
#pragma unroll
            for (int m = 0; m < 4; ++m) { const size_t off = (size_t)(row0 + ai * HALF + m * 16) * 1024 + col0;
#pragma unroll
                for (int bj = 0; bj < 2; ++bj)
#pragma unroll
                    for (int n = 0; n < 2; ++n) { const f32x4 xs = *(const f32x4*)(xsrc + off + bj * HALF + 4 * n);
                        *(f32x4*)(xdst + off + bj * HALF + 4 * n) = xs + gv[bj][n] * acc[ai][bj][m][n]; }
                if (m & 1) asm volatile("" ::: "memory"); }
    }
};
constexpr int EPI_OFF = 133120;
template <int ACT  > struct EpiRouteN {
    static constexpr bool PERM = true, AFTER_DRAIN = false, NORM = true;
    bf16_t* O; int ld; const float* RSP; const float* shw; PG8_LAS unsigned char* lds;
    __device__ __forceinline__ void prefetch(const Unit& u, int tid, int wid) const {
        const char* src = (const char*)RSP + (size_t)u.pm * (BM * 64) + (size_t)tid * 16;
#pragma unroll
        for (int i = 0; i < 2; ++i) __builtin_amdgcn_global_load_lds((const unsigned*)(src + i * 8192), (PG8_LAS unsigned*)(lds + EPI_OFF + wid * 1024 + i * 8192), 16, 0, 0);
        if (wid == 0) { const char* s2 = (const char*)(shw + (size_t)((u.pm * BM) >> 12) * NSHW + u.pn * BM) + (size_t)(tid & 63) * 16;
            __builtin_amdgcn_global_load_lds((const unsigned*)s2, (PG8_LAS unsigned*)(lds + EPI_OFF + 16384), 16, 0, 0); }
    }
    __device__ __forceinline__ void reduce_rs(int tid) const {
        if (tid < 256) { const PG8_LAS f32x4* p = (const PG8_LAS f32x4*)(lds + EPI_OFF + tid * 64); const f32x4 a = p[0], b = p[1], c = p[2], d = p[3];
            const float s = (((a.x + a.y) + (a.z + a.w)) + ((b.x + b.y) + (b.z + b.w))) + (((c.x + c.y) + (c.z + c.w)) + ((d.x + d.y) + (d.z + d.w)));
            *(PG8_LAS float*)(lds + EPI_OFF + 17408 + tid * 4) = __builtin_amdgcn_rsqf(s * (1.0f / 1024.0f) + 1e-6f); }
    }
    __device__ __forceinline__ void operator()(const f32x4 (&acc)[2][2][4][2], const Unit& u, int wr, int wc, int fr, int fq) const {
        const int row0 = u.pm * BM + wr * 64 + fr, col0 = u.pn * BM + wc * 32 + 8 * fq;
        const PG8_LAS unsigned char* ep = lds + EPI_OFF;
        float rs[2][4];
#pragma unroll
        for (int ai = 0; ai < 2; ++ai)
#pragma unroll
            for (int m = 0; m < 4; ++m) rs[ai][m] = *(const PG8_LAS float*)(ep + 17408 + (wr * 64 + fr + ai * HALF + m * 16) * 4);
        f32x4 sv[2][2];
#pragma unroll
        for (int bj = 0; bj < 2; ++bj)
#pragma unroll
            for (int n = 0; n < 2; ++n) sv[bj][n] = *(const PG8_LAS f32x4*)(ep + 16384 + (bj * HALF + wc * 32 + 8 * fq + 4 * n) * 4);
#pragma unroll
        for (int ai = 0; ai < 2; ++ai)
#pragma unroll
            for (int m = 0; m < 4; ++m) { bf16_t* rowp = O + (size_t)(row0 + ai * HALF + m * 16) * ld + col0;
#pragma unroll
                for (int bj = 0; bj < 2; ++bj) { f32x4 v0 = acc[ai][bj][m][0] * rs[ai][m] + sv[bj][0], v1 = acc[ai][bj][m][1] * rs[ai][m] + sv[bj][1];
                    if (ACT == 1) {
#pragma unroll
                        for (int e = 0; e < 4; ++e) { const float a = fmaxf(v0[e], 0.f), b = fmaxf(v1[e], 0.f); v0[e] = a * a; v1[e] = b * b; } }
                    u32x4 w; w.x = cvt_pk_bf16(v0[0], v0[1]); w.y = cvt_pk_bf16(v0[2], v0[3]); w.z = cvt_pk_bf16(v1[0], v1[1]); w.w = cvt_pk_bf16(v1[2], v1[3]);
                    *(u32x4*)(rowp + bj * HALF) = w; } }
    }
};
template <bool SRCF, bool DSTF> struct EpiResidXS {
    static constexpr bool PERM = true, AFTER_DRAIN = false, NORM = false;
    const void* xsrc; void* xdst; const float* gate; const float* wp; bf16_t* XS; float* RSP; int doxs, srcf32, dstf32;
    __device__ __forceinline__ void operator()(const f32x4 (&acc)[2][2][4][2], const Unit& u, int wr, int wc, int fr, int fq) const {
        const int row0 = u.pm * BM + wr * 64 + fr, col0 = u.pn * BM + wc * 32 + 8 * fq, b = (u.pm * BM) >> 12;
        f32x4 gv[2][2], wv[2][2]; float ssv[2][4];
#pragma unroll
        for (int bj = 0; bj < 2; ++bj)
#pragma unroll
            for (int n = 0; n < 2; ++n) { gv[bj][n] = *(const f32x4*)(gate + (size_t)b * 6144 + col0 + bj * HALF + 4 * n);
                wv[bj][n] = doxs ? *(const f32x4*)(wp + (size_t)b * 1024 + col0 + bj * HALF + 4 * n) : (f32x4){0.f, 0.f, 0.f, 0.f}; }
#pragma unroll
        for (int ai = 0; ai < 2; ++ai)
#pragma unroll
            for (int m = 0; m < 4; ++m) { const int row = row0 + ai * HALF + m * 16; const size_t off = (size_t)row * 1024 + col0; float ss = 0.f;
#pragma unroll
                for (int bj = 0; bj < 2; ++bj) { f32x4 x0, x1;
                    if (SRCF && srcf32) { x0 = *(const f32x4*)((const float*)xsrc + off + bj * HALF); x1 = *(const f32x4*)((const float*)xsrc + off + bj * HALF + 4); }
                    else { const u32x4 r = *(const u32x4*)((const bf16_t*)xsrc + off + bj * HALF);
                        x0 = (f32x4){bflo(r.x), bfhi(r.x), bflo(r.y), bfhi(r.y)}; x1 = (f32x4){bflo(r.z), bfhi(r.z), bflo(r.w), bfhi(r.w)}; }
                    const f32x4 y0 = x0 + gv[bj][0] * acc[ai][bj][m][0], y1 = x1 + gv[bj][1] * acc[ai][bj][m][1];
                    ss += ((y0.x * y0.x + y0.y * y0.y) + (y0.z * y0.z + y0.w * y0.w)) + ((y1.x * y1.x + y1.y * y1.y) + (y1.z * y1.z + y1.w * y1.w));
                    if (DSTF && dstf32) { *(f32x4*)((float*)xdst + off + bj * HALF) = y0; *(f32x4*)((float*)xdst + off + bj * HALF + 4) = y1; }
                    else { u32x4 w; w.x = cvt_pk_bf16(y0[0], y0[1]); w.y = cvt_pk_bf16(y0[2], y0[3]); w.z = cvt_pk_bf16(y1[0], y1[1]); w.w = cvt_pk_bf16(y1[2], y1[3]);
                        *(u32x4*)((bf16_t*)xdst + off + bj * HALF) = w; }
                    if (doxs) { const f32x4 a = y0 * wv[bj][0], c = y1 * wv[bj][1];
                        u32x4 w; w.x = cvt_pk_bf16(a[0], a[1]); w.y = cvt_pk_bf16(a[2], a[3]); w.z = cvt_pk_bf16(c[0], c[1]); w.w = cvt_pk_bf16(c[2], c[3]);
                        *(u32x4*)(XS + off + bj * HALF) = w; } }
                ssv[ai][m] = ss;
                if (m & 1) asm volatile("" ::: "memory"); }
        if (doxs) { float t1[2][4];
#pragma unroll
            for (int ai = 0; ai < 2; ++ai)
#pragma unroll
                for (int m = 0; m < 4; ++m) t1[ai][m] = __shfl_xor(ssv[ai][m], 16);
#pragma unroll
            for (int ai = 0; ai < 2; ++ai)
#pragma unroll
                for (int m = 0; m < 4; ++m) { ssv[ai][m] += t1[ai][m]; t1[ai][m] = __shfl_xor(ssv[ai][m], 32); }
            if (fq == 0) {
#pragma unroll
                for (int ai = 0; ai < 2; ++ai)
#pragma unroll
                    for (int m = 0; m < 4; ++m) RSP[(size_t)(row0 + ai * HALF + m * 16) * 16 + u.pn * 4 + wc] = ssv[ai][m] + t1[ai][m]; } }
    }
};
}

#define RLX_AGENT __ATOMIC_RELAXED, __HIP_MEMORY_SCOPE_AGENT
#define XB_TMO      128
#define XB_XCNT(j)  (256  + 64 * (j))
#define XB_XSUB(j)  (1280 + 64 * (j))
#define XB_XGEN(j)  (2304 + 64 * (j))
#define XB_TOP      3328
#define XB_TOPGEN   3392
#define XCD_BAR_WORDS 3456
#define XB_SPIN_CAP (1u << 24)

__device__ __forceinline__ unsigned xb_ld(unsigned* p)              { return __hip_atomic_load(p, __ATOMIC_RELAXED, __HIP_MEMORY_SCOPE_AGENT); }
__device__ __forceinline__ unsigned xb_add(unsigned* p, unsigned v) { return __hip_atomic_fetch_add(p, v, __ATOMIC_RELAXED, __HIP_MEMORY_SCOPE_AGENT); }
__device__ __forceinline__ unsigned xb_xcc_id() { return (unsigned)__builtin_amdgcn_s_getreg((3 << 11) | 20) & 0xFu; }
#define XB_SPIN(cond, bar) do { unsigned _sp = 0; while (cond) { __builtin_amdgcn_s_sleep(1); \
    if ((++_sp & 255u) == 0u) { if (xb_ld(&(bar)[XB_TMO])) break; if (_sp > XB_SPIN_CAP) { atomicAdd(&(bar)[XB_TMO], 1u); break; } } } } while (0)

struct XcdBarrier {
    unsigned* bar; unsigned x;
    volatile LAS unsigned* st;
};

__device__ __forceinline__ XcdBarrier xcd_barrier_post(unsigned* bar, volatile LAS unsigned* st) {
    XcdBarrier b; b.bar = bar; b.x = xb_xcc_id(); b.st = st;
    if (threadIdx.x == 0) (void)xb_add(&bar[XB_XCNT(b.x)], 1u);
    return b;
}
__device__ __forceinline__ void xcd_barrier_complete(unsigned* bar, unsigned x, unsigned& nloc, unsigned& nx) {
    const unsigned G = gridDim.x * gridDim.y * gridDim.z;
    unsigned sum, cnt, mine, sp = 0u;
    for (;;) {
        sum = 0u; cnt = 0u; mine = 0u;
#pragma unroll
        for (unsigned j = 0; j < 16; ++j) { const unsigned c = xb_ld(&bar[XB_XCNT(j)]); sum += c; cnt += (c > 0u) ? 1u : 0u; mine = (j == x) ? c : mine; }
        if (sum == G) break;
        __builtin_amdgcn_s_sleep(1);
        if ((++sp & 255u) == 0u) { if (xb_ld(&bar[XB_TMO])) break; if (sp > XB_SPIN_CAP) { atomicAdd(&bar[XB_TMO], 1u); break; } }
    }
    nloc = mine > 0u ? mine : 1u; nx = cnt > 0u ? cnt : 1u;
}

__device__ __forceinline__ void xcd_barrier(const XcdBarrier& b) {
    asm volatile("s_waitcnt vmcnt(0)" ::: "memory");
    __syncthreads();
    if (threadIdx.x == 0) {
        unsigned* bar = b.bar;
        __builtin_amdgcn_s_waitcnt(0);
        unsigned nloc = b.st[0], nx = b.st[1];
        if (nloc == 0u) { xcd_barrier_complete(bar, b.x, nloc, nx); b.st[0] = nloc; b.st[1] = nx; }
        const unsigned old = xb_add(&bar[XB_XSUB(b.x)], 1u);
        const unsigned gen = old / nloc;
        if (old + 1u == (gen + 1u) * nloc) {
            __builtin_amdgcn_fence(__ATOMIC_RELEASE, "agent");
            asm volatile("s_waitcnt vmcnt(0)" ::: "memory");
            const unsigned og = xb_add(&bar[XB_TOP], 1u);
            const unsigned tg = og / nx;
            if (og + 1u == (tg + 1u) * nx) xb_add(&bar[XB_TOPGEN], 1u);
            else XB_SPIN(xb_ld(&bar[XB_TOPGEN]) == tg, bar);
            __builtin_amdgcn_fence(__ATOMIC_ACQUIRE, "agent");
            xb_add(&bar[XB_XGEN(b.x)], 1u);
            asm volatile("s_waitcnt vmcnt(0)" ::: "memory");
        } else {
            XB_SPIN(xb_ld(&bar[XB_XGEN(b.x)]) == gen, bar);
            __builtin_amdgcn_fence(__ATOMIC_ACQUIRE, "agent");
            asm volatile("s_waitcnt vmcnt(0)" ::: "memory");
        }
    }
    __syncthreads();
}

#ifndef PH_MASK
#define PH_MASK 0xFFFFF
#endif
#define EN(b) if constexpr ((PH_MASK >> (b)) & 1)
#ifndef DUP_MASK
#define DUP_MASK 0
#endif
#define DUP(b) if constexpr ((DUP_MASK >> (b)) & 1)
#define DBG_DIGEST_N 256
#define DBG_DIGEST_VAL(m, c) bf2f(((const bf16*)(wsp + WS_CAT))[(size_t)(m) * DM + 768 + (c)])
#ifndef DBG_PH_HI
#define DBG_PH_HI NPHASE
#endif
#ifndef MK_MULTI
#define MK_MULTI 0
#endif
constexpr int LDS_BYTES = 151552, MISC_OFF = 131072 + 320;
#ifndef DBG_LAYERS
#define DBG_LAYERS 4
#define DBG_L0 0
#endif
constexpr int NPHASE = 3 + 7 * DBG_LAYERS;
__global__ void __launch_bounds__(512, 2) hymba_fwd(Args a) {
    extern __shared__ __attribute__((aligned(16))) unsigned char lds[];
    Ctx F0;
    Ctx& F = F0;
    F.lds = (char*)lds; F.tid = threadIdx.x; F.lane = F.tid & 63; F.wave = __builtin_amdgcn_readfirstlane(F.tid >> 6); F.G = gridDim.x; F.bid = blockIdx.x;
    F.A = nullptr; F.ws = a.ws;
    if (F.tid < 29) ((unsigned long long*)(lds + PTR_OFF))[F.tid] = F.tid < 28 ? (unsigned long long)a.in[F.tid] : (unsigned long long)a.out;
    volatile LAS unsigned* MISC = (volatile LAS unsigned*)((LAS unsigned char*)lds + MISC_OFF);
    if (F.tid < 32) MISC[F.tid] = 0u;
    __syncthreads();
    unsigned* ctl = (unsigned*)(a.ws + WS_CTL);
    XcdBarrier bar; bar.bar = ctl + CW_BAR; bar.x = 0; bar.st = nullptr;
    if (!MK_MULTI) bar = xcd_barrier_post(ctl + CW_BAR, MISC + 8);
    const int lo = a.ph_lo, hi = a.ph_hi;
    int ph = 0;
#define PH_BEGIN if (lo <= ph && ph < hi) { Ctx F = F0; unsigned long long wsl_ = (unsigned long long)F0.ws; asm volatile("" : "+v"(F.tid), "+s"(F.bid), "+s"(F.G), "+s"(wsl_)); F.ws = (unsigned char*)(__attribute__((address_space(1))) unsigned char*)wsl_; F.lane = F.tid & 63; F.wave = __builtin_amdgcn_readfirstlane(F.tid >> 6); unsigned char* const wsp = F.ws; (void)wsp;
#define PH_END   if (!MK_MULTI && ph + 1 < hi) { XcdBarrier bb = bar; asm volatile("" : "+s"(bb.bar), "+s"(bb.x)); xcd_barrier(bb); } else __syncthreads(); } ++ph;
    PG8_LAS unsigned char* glds = (PG8_LAS unsigned char*)lds;
#define XN ((bf16*)(wsp + WS_XN))
#define PROJ ((bf16*)(wsp + WS_PROJ))
#define CAT ((bf16*)(wsp + WS_CAT))
#define HB ((bf16*)(wsp + WS_HB))
    PH_BEGIN EN(0) ph_prologue(F); DUP(0) { __syncthreads(); ph_prologue(F); } PH_END
    PH_BEGIN EN(1) { ph_shw(F); ph_xs0(F, PIN(F, I_X), PIN(F, I_N1W) + DBG_L0 * DM, (const float*)(wsp + WS_MOD) + (size_t)DBG_L0 * BATCH * NADA, DM, XN, (float*)(wsp + WS_RSP)); } PH_END
    for (int l_ = 0; l_ < DBG_LAYERS; ++l_) { const int l = l_ + DBG_L0;
        #define modl ((const float*)(wsp + WS_MOD) + (size_t)l * BATCH * NADA)
        #define xsrc (l_ == 0 ? PIN(F, I_X) : (const float*)POUT(F))
        PH_BEGIN
#if defined(PROBE_GA)
            { pg8::Gemm g{XN, (const bf16*)(wsp + WS_WIN) + (size_t)l * NPROJ * DM, MTOK, NPROJ, DM}; pg8::StaticOrder S; S.init(MTOK, NPROJ, F.G, F.bid);
            pg8::EpiRoute<0> E{PROJ, NPROJ, PROJ, NPROJ, 1 << 20};
            pg8::gemm_phase<pg8::EpiRoute<0>, pg8::StaticOrder, true, true>(glds, g, S, E, F.tid); } __syncthreads();
#elif defined(PROBE_GB)
            { pg8::Gemm g{XN, (const bf16*)(wsp + WS_WIN) + (size_t)l * NPROJ * DM, MTOK, NPROJ, DM}; pg8::StaticOrder S; S.init(MTOK, NPROJ, F.G, F.bid);
            pg8::EpiRouteN<0> E{PROJ, NPROJ, (const float*)(wsp + WS_RSP), (const float*)(wsp + WS_SHW) + (size_t)l * BATCH * NSHW, glds};
            pg8::gemm_phase<pg8::EpiRouteN<0>, pg8::StaticOrder, true, true>(glds, g, S, E, F.tid); } __syncthreads();
#endif
        EN(2) { pg8::Gemm g{XN, (const bf16*)(wsp + WS_WIN) + (size_t)l * NPROJ * DM, MTOK, NPROJ, DM}; pg8::StaticOrder S; S.init(MTOK, NPROJ, F.G, F.bid);
            pg8::EpiRouteN<0> E{PROJ, NPROJ, (const float*)(wsp + WS_RSP), (const float*)(wsp + WS_SHW) + (size_t)l * BATCH * NSHW, glds};
            pg8::gemm_phase<pg8::EpiRouteN<0>, pg8::StaticOrder, true, true>(glds, g, S, E, F.tid); } PH_END
        PH_BEGIN EN(3) ph_prep(F, l); DUP(3) ph_prep(F, l); EN(4) ph_lru1(F, l); DUP(4) ph_lru1(F, l); EN(5) ph_mlstm(F, l); DUP(5) ph_mlstm(F, l); PH_END
        PH_BEGIN EN(6) { ph_carry(F); pg8::Gemm g{(const bf16*)(wsp + WS_QL), (const bf16*)(wsp + WS_WQC) + (size_t)l * 768 * 256, MTOK, 768, 256}; pg8::StaticOrder S; S.init(MTOK, 768, F.G, F.bid);
            pg8::EpiRoute<0> E{(bf16*)(wsp + WS_QABS), 512, (bf16*)(wsp + WS_QIDX), 256, 2};
            pg8::gemm_phase<pg8::EpiRoute<0>, pg8::StaticOrder, true, true>(glds, g, S, E, F.tid); } PH_END
        PH_BEGIN EN(7) ph_dsa(F, l); DUP(7) ph_dsa(F, l); EN(8) ph_lru2(F, l); DUP(8) ph_lru2(F, l); EN(9) ph_mfin(F, l); DUP(9) ph_mfin(F, l); PH_END
        PH_BEGIN EN(10) { pg8::Gemm g{CAT, (const bf16*)(wsp + WS_WO) + (size_t)l * DM * DM, MTOK, DM, DM}; pg8::StaticOrder S; S.init(MTOK, DM, F.G, F.bid);
            pg8::EpiResidXS<true, false> E{l_ == 0 ? (const void*)PIN(F, I_X) : (const void*)POUT(F), (void*)POUT(F), modl + 2 * DM, (const float*)(wsp + WS_WP) + (size_t)(l * 2 + 1) * BATCH * DM, XN, (float*)(wsp + WS_RSP), 1, l_ == 0, 0};
            pg8::gemm_phase<pg8::EpiResidXS<true, false>, pg8::StaticOrder, true, true>(glds, g, S, E, F.tid); } PH_END
        PH_BEGIN EN(12) { pg8::Gemm g{XN, (const bf16*)(wsp + WS_W1) + (size_t)l * DFF * DM, MTOK, DFF, DM}; pg8::StaticOrder S; S.init(MTOK, DFF, F.G, F.bid);
            pg8::EpiRouteN<1> E{HB, DFF, (const float*)(wsp + WS_RSP), (const float*)(wsp + WS_SHW) + (size_t)l * BATCH * NSHW + NPROJ, glds};
            pg8::gemm_phase<pg8::EpiRouteN<1>, pg8::StaticOrder, true, true>(glds, g, S, E, F.tid); } PH_END
        PH_BEGIN EN(13) { pg8::Gemm g{HB, (const bf16*)(wsp + WS_W2) + (size_t)l * DM * DFF, MTOK, DM, DFF}; pg8::StaticOrder S; S.init(MTOK, DM, F.G, F.bid);
            const int nl = l + 1 < DEPTH ? l + 1 : l;
            const bool lastl = l_ + 1 >= DBG_LAYERS;
            pg8::EpiResidXS<false, false> E{(const void*)POUT(F), lastl ? (void*)XN : (void*)POUT(F), modl + 5 * DM, (const float*)(wsp + WS_WP) + (size_t)(nl * 2) * BATCH * DM, XN, (float*)(wsp + WS_RSP), lastl ? 0 : 1, 0, 0};
            pg8::gemm_phase<pg8::EpiResidXS<false, false>, pg8::StaticOrder, true, true>(glds, g, S, E, F.tid); } PH_END
    }
#ifdef DBG_DIGEST
    PH_BEGIN { const int gw = F.bid * 8 + F.wave, NGW = F.G * 8; float* o = POUT(F);
        for (int m = gw; m < MTOK; m += NGW) for (int j = 0; j < 16; ++j) { const int c = F.lane + 64 * j; float v = 0.f;
            if (c < DBG_DIGEST_N) { v = DBG_DIGEST_VAL(m, c) * 4096.0f; v = v - floorf(v); }
            o[(size_t)m * DM + c] = v; } } PH_END
#else
    PH_BEGIN EN(14) ph_finalnorm16(F, XN, PIN(F, I_FNW), POUT(F)); PH_END
#endif
}

extern "C" void kernel_launch(void* const* d_in, const int* in_sizes, int n_in, void* d_out, int out_size, void* d_ws, size_t ws_size, hipStream_t stream) {
    static int grid = 0;
    if (grid == 0) {
        if (n_in != 28 || in_sizes[0] != MTOK * DM || out_size != MTOK * DM || ws_size < WS_END) { fprintf(stderr, "kernel_launch: unexpected shapes (n_in %d, in0 %d, out %d, ws %zu)\n", n_in, n_in > 0 ? in_sizes[0] : -1, out_size, ws_size); grid = -1; return; }
        int dev = 0, cus = 0, per_cu = 0;
        if (hipGetDevice(&dev) != hipSuccess || hipDeviceGetAttribute(&cus, hipDeviceAttributeMultiprocessorCount, dev) != hipSuccess) { grid = -1; return; }
        if (hipFuncSetAttribute((const void*)hymba_fwd, hipFuncAttributeMaxDynamicSharedMemorySize, LDS_BYTES) != hipSuccess) { fprintf(stderr, "kernel_launch: hipFuncSetAttribute failed\n"); grid = -1; return; }
        if (hipOccupancyMaxActiveBlocksPerMultiprocessor(&per_cu, (const void*)hymba_fwd, 512, LDS_BYTES) != hipSuccess || per_cu < 1) { fprintf(stderr, "kernel_launch: occupancy query says %d\n", per_cu); }
        (void)hipGetLastError();
        grid = cus;
    }
    if (grid < 0) return;
    if (hipMemsetAsync((char*)d_ws + WS_CTL, 0, CTL_ZERO_BYTES, stream) != hipSuccess) return;
    Args a{};
    for (int i = 0; i < 28; ++i) a.in[i] = (const float*)d_in[i];
    a.out = (float*)d_out; a.ws = (unsigned char*)d_ws;
#if MK_MULTI
    for (int p = 0; p < NPHASE; ++p) { a.ph_lo = p; a.ph_hi = p + 1; hipLaunchKernelGGL(hymba_fwd, dim3(grid), dim3(512), LDS_BYTES, stream, a); }
#else
    a.ph_lo = 0; a.ph_hi = DBG_PH_HI; hipLaunchKernelGGL(hymba_fwd, dim3(grid), dim3(512), LDS_BYTES, stream, a);
#endif
}
#endif
```

```cpp
#ifndef HOST_EMU
#include <hip/hip_runtime.h>
#include <cstdio>
#include <cstdint>
#define DEV __device__ __forceinline__
#define LAS __attribute__((address_space(3)))
#else
#include "emu.h"
#endif

#ifndef HOST_EMU
#define SYNC() __syncthreads()
#define LAUNDER_V(x) asm volatile("" : "+v"(x))
#define WAVE_LDS_FENCE() asm volatile("s_waitcnt lgkmcnt(0)" ::: "memory")
template <class T> DEV T SHFL(T v, int s) { return __shfl(v, s); }
template <class T> DEV T SHFL_XOR(T v, int m) { return __shfl_xor(v, m); }
template <class T> DEV T SHFL_UP(T v, int d) { return __shfl_up(v, d); }
template <class T> DEV T SHFL_DOWN(T v, int d) { return __shfl_down(v, d); }
typedef short bf16x8_ __attribute__((ext_vector_type(8)));
typedef float f32x4_ __attribute__((ext_vector_type(4)));
typedef short v4i16_t __attribute__((ext_vector_type(4)));
DEV f32x4_ MFMA16(bf16x8_ a, bf16x8_ b, f32x4_ c) { return __builtin_amdgcn_mfma_f32_16x16x32_bf16(a, b, c, 0, 0, 0); }
DEV v4i16_t TR16(const void* p) { return __builtin_amdgcn_ds_read_tr16_b64_v4i16((LAS v4i16_t*)(p)); }
#endif


typedef unsigned short bf16;
typedef short bf16x8 __attribute__((ext_vector_type(8)));
typedef short s16x4 __attribute__((ext_vector_type(4)));
typedef float f32x4 __attribute__((ext_vector_type(4)));
typedef unsigned u32x4 __attribute__((ext_vector_type(4)));
typedef unsigned u32x2 __attribute__((ext_vector_type(2)));

constexpr int BATCH = 16, SEQ = 4096, DM = 1024, DEPTH = 4, MTOK = BATCH * SEQ;
constexpr int NPROJ = 3072, DFF = 4096, NADA = 6 * DM;
constexpr int PC_LX = 0, PC_LY = 256, PC_MQ = 512, PC_MK = 1024, PC_MV = 1536, PC_MO = 2048, PC_AQ = 2560, PC_AKV = 2816, PC_IK = 2944, PC_IW = 2976, PC_MI = 2984, PC_MF = 2988;
constexpr float NORM_EPS = 1e-6f;

constexpr size_t MiB = 1u << 20;
constexpr size_t WS_CTL = 0, CTL_ZERO_BYTES = 1 * MiB;
constexpr size_t WS_MOD = 1 * MiB;
constexpr size_t WS_WQC = 3 * MiB;
constexpr size_t WS_WG = 5 * MiB;
constexpr size_t WS_WUVT = 6 * MiB;
constexpr size_t WS_WIN = 8 * MiB;
constexpr size_t WS_WO = 32 * MiB;
constexpr size_t WS_W1 = 40 * MiB;
constexpr size_t WS_W2 = 72 * MiB;
constexpr size_t WS_XN = 104 * MiB;
constexpr size_t WS_QL = WS_XN, WS_CKV = WS_XN + 32 * MiB, WS_QIDX = WS_XN + 48 * MiB, WS_KIDX = WS_XN + 80 * MiB, WS_WI = WS_XN + 84 * MiB, WS_GT = WS_XN + 86 * MiB;
constexpr size_t WS_CAT = 232 * MiB;
constexpr size_t WS_PROJ = 360 * MiB;
constexpr size_t WS_HB = 360 * MiB;
constexpr size_t WS_QABS = 744 * MiB;
constexpr size_t WS_HLOC = 808 * MiB, WS_CPA = 840 * MiB;
constexpr size_t WS_LSUM = 872 * MiB;
constexpr size_t WS_HM = 874 * MiB;
constexpr size_t WS_MG = 940 * MiB;
constexpr size_t WS_WP = 2 * MiB + 512 * 1024;
constexpr size_t WS_SHW = 6 * MiB + 256 * 1024;
constexpr size_t WS_RSP = 1000 * MiB;
constexpr size_t WS_CARRY = 948 * MiB;
constexpr size_t WS_SCR2 = 949 * MiB;
constexpr int NSHW = NPROJ + DFF;
constexpr size_t WS_END = 1024 * MiB;
static_assert(WS_HM + (size_t)MTOK * 512 * 2 <= WS_END && WS_HB + (size_t)MTOK * DFF * 2 <= WS_HLOC + 64 * MiB, "ws map");

constexpr int CW_TMO = 0, CW_BAR = 4096;

#ifndef HOST_EMU
typedef __bf16 hwbf2_t __attribute__((ext_vector_type(2)));
typedef float hwf2_t __attribute__((ext_vector_type(2)));
DEV unsigned f2bf(float f) { return (unsigned)__builtin_bit_cast(unsigned short, (__bf16)f); }
DEV unsigned pk2(float lo, float hi) { const hwf2_t v = {lo, hi}; return __builtin_bit_cast(unsigned, __builtin_convertvector(v, hwbf2_t)); }
#else
DEV unsigned f2bf(float f) { unsigned u = __builtin_bit_cast(unsigned, f); return (u + 0x7fffu + ((u >> 16) & 1u)) >> 16; }
DEV unsigned pk2(float lo, float hi) { return f2bf(lo) | (f2bf(hi) << 16); }
#endif
DEV float bf2f(unsigned h) { return __builtin_bit_cast(float, h << 16); }
DEV float bflo(unsigned w) { return __builtin_bit_cast(float, w << 16); }
DEV float bfhi(unsigned w) { return __builtin_bit_cast(float, w & 0xffff0000u); }
DEV float wave_sum(float v) {
#pragma unroll
    for (int o = 1; o < 64; o <<= 1) v += SHFL_XOR(v, o);
    return v;
}
#ifndef HOST_EMU
DEV float FEXP(float x) { return __expf(x); }
DEV float FEXP2(float x) { return __builtin_amdgcn_exp2f(x); }
DEV float FRCP(float x) { return __builtin_amdgcn_rcpf(x); }
DEV float FSQRT(float x) { return __builtin_amdgcn_sqrtf(x); }
DEV float RSQ(float x) { return __builtin_amdgcn_rsqf(x); }
DEV float FLOG(float x) { return __logf(x); }
#else
DEV float FEXP(float x) { return expf(x); }
DEV float FEXP2(float x) { return exp2f(x); }
DEV float FRCP(float x) { return 1.0f / x; }
DEV float FSQRT(float x) { return sqrtf(x); }
DEV float RSQ(float x) { return 1.0f / sqrtf(x); }
DEV float FLOG(float x) { return logf(x); }
#endif
#ifndef HOST_EMU
DEV int UNI(int x) { return __builtin_amdgcn_readfirstlane(x); }
#else
DEV int UNI(int x) { return x; }
#endif
DEV float RELU(float x) { const int b = __builtin_bit_cast(int, x); return __builtin_bit_cast(float, b > 0 ? b : 0); }
DEV float sigmoidf_(float z) { return 1.0f / (1.0f + expf(-z)); }
DEV float fsigmoid(float z) { return FRCP(1.0f + FEXP(-z)); }
DEV float one_minus_exp(float x) {
    const float s = -x * (1.0f + x * (0.5f + x * (0.16666667f + x * 0.041666668f)));
    return x > -0.05f ? s : 1.0f - FEXP(x);
}

struct Args { const float* in[28]; float* out; unsigned char* ws; int ph_lo, ph_hi; };
struct Ctx {
    char* lds; int tid, lane, wave, G, bid;
    const Args* A;
    unsigned char* ws;
};

constexpr int PTR_OFF = 131072 + 512;
#ifndef HOST_EMU
DEV const float* PIN(const Ctx& F, int i) { const unsigned long long v = ((const unsigned long long*)(F.lds + PTR_OFF))[i];
    const unsigned lo = __builtin_amdgcn_readfirstlane((unsigned)v), hi = __builtin_amdgcn_readfirstlane((unsigned)(v >> 32)); return (const float*)(const __attribute__((address_space(1))) float*)(((unsigned long long)hi << 32) | lo); }
DEV float* POUT(const Ctx& F) { return (float*)PIN(F, 28); }
#else
DEV const float* PIN(const Ctx& F, int i) { return F.A->in[i]; }
DEV float* POUT(const Ctx& F) { return POUT(F); }
#endif
enum { I_X = 0, I_C, I_WIN, I_CONVW, I_CONVB, I_WA, I_BA, I_WX, I_BX, I_LAM, I_BI, I_BF, I_WQUP, I_WQIDX, I_WUK, I_WUV, I_QNW, I_KVNW, I_RELB, I_GNW, I_WO, I_WADA, I_BADA, I_N1W, I_N2W, I_W1, I_W2, I_FNW };

DEV int win_srccol(int n) {
    if (n < 2560) return n;
    if (n < PC_AKV) return 2568 + (n - PC_AQ);
    if (n < PC_IK) return 2824 + (n - PC_AKV);
    if (n < PC_IW) return 2952 + (n - PC_IK);
    if (n < PC_MI) return 2984 + (n - PC_IW);
    if (n < PC_MF) return 2560 + (n - PC_MI);
    if (n < 2992) return 2564 + (n - PC_MF);
    return -1;
}
template <bool MAPPED>
DEV void p0_transpose_item(const float* W, int K, int N, int NT, bf16* WT, float* scr, int item, int lane) {
    const int nblk = NT / 32, kb = item / nblk, nb = item % nblk, k0 = 64 * kb, n0 = 32 * nb;
    int sc = n0 + (lane & 31); if (MAPPED) sc = win_srccol(sc);
#pragma unroll 8
    for (int i = 0; i < 32; ++i) { const int kk = 2 * i + (lane >> 5); scr[kk * 33 + (lane & 31)] = sc >= 0 ? W[(size_t)(k0 + kk) * N + sc] : 0.f; }
    WAVE_LDS_FENCE();
    const int c = lane & 7;
#pragma unroll
    for (int j = 0; j < 4; ++j) { const int n = (lane >> 3) + 8 * j; const float* s = scr + (8 * c) * 33 + n;
        u32x4 o; o.x = pk2(s[0 * 33], s[1 * 33]); o.y = pk2(s[2 * 33], s[3 * 33]); o.z = pk2(s[4 * 33], s[5 * 33]); o.w = pk2(s[6 * 33], s[7 * 33]);
        *(u32x4*)(WT + (size_t)(n0 + n) * K + k0 + 8 * c) = o; }
    WAVE_LDS_FENCE();
}

DEV void ph_prologue(const Ctx& F) {
    const int gt = F.bid * 512 + F.tid, NGT = F.G * 512;
    float* CACT = (float*)F.lds;
    for (int i = F.tid; i < BATCH * DM; i += 512) { const float cv = PIN(F, I_C)[i]; CACT[i] = cv * sigmoidf_(cv); }
    SYNC();
    for (int e = gt; e < DEPTH * NADA * 4; e += NGT) {
        const int j = e % NADA, bq = (e / NADA) & 3, l = e / (NADA * 4);
        const float* w = PIN(F, I_WADA) + (size_t)l * DM * NADA + j;
        const float* c = CACT + bq * 4 * DM;
        float a0 = 0.f, a1 = 0.f, a2 = 0.f, a3 = 0.f;
#pragma unroll 32
        for (int k = 0; k < DM; ++k) { const float wv = w[(size_t)k * NADA];
            a0 += c[k] * wv; a1 += c[DM + k] * wv; a2 += c[2 * DM + k] * wv; a3 += c[3 * DM + k] * wv; }
        const float bb = PIN(F, I_BADA)[(size_t)l * NADA + j];
        float* mo = (float*)(F.ws + WS_MOD) + ((size_t)l * BATCH + bq * 4) * NADA + j;
        mo[0] = a0 + bb; mo[NADA] = a1 + bb; mo[2 * NADA] = a2 + bb; mo[3 * NADA] = a3 + bb;
    }
    for (int e = gt; e < DEPTH * 2 * 4 * 64 * 64; e += NGT) {
        const int i = e & 63, j = (e >> 6) & 63, blk = (e >> 12) & 3, g = (e >> 14) & 1, l = e >> 15;
        const float* src = PIN(F, g ? I_WX : I_WA) + (((size_t)l * 4 + blk) * 64 + i) * 64 + j;
        ((bf16*)(F.ws + WS_WG))[e] = (bf16)f2bf(*src);
    }
    for (int e = gt; e < DEPTH * 4 * 64 * 128; e += NGT) {
        const int r = e & 127, d = (e >> 7) & 63, h = (e >> 13) & 3, l = e >> 15;
        ((bf16*)(F.ws + WS_WUVT))[e] = (bf16)f2bf(PIN(F, I_WUV)[(((size_t)l * 128 + r) * 4 + h) * 64 + d]);
    }
    for (int e = gt; e < DEPTH * 768 * 256; e += NGT) {
        const int r = e & 255, n = (e >> 8) % 768, l = e / (768 * 256);
        float v;
        if (n < 512) { const int h = n >> 7, c = n & 127; const f32x4* q = (const f32x4*)(PIN(F, I_WQUP) + ((size_t)l * 256 + r) * 256 + h * 64); const f32x4* k = (const f32x4*)(PIN(F, I_WUK) + ((size_t)l * 128 + c) * 256 + h * 64);
            float s = 0.f;
#pragma unroll
            for (int d = 0; d < 16; ++d) { const f32x4 a = q[d], bq4 = k[d]; s += (a.x * bq4.x + a.y * bq4.y) + (a.z * bq4.z + a.w * bq4.w); }
            v = s * (0.125f * 1.4426950408889634f); }
        else v = PIN(F, I_WQIDX)[((size_t)l * 256 + r) * 256 + (n - 512)] * 0.17677669529663687f;
        ((bf16*)(F.ws + WS_WQC))[e] = (bf16)f2bf(v);
    }
    SYNC();
    float* scr = (float*)(F.lds + F.wave * 16384);
    const int gw = F.bid * 8 + F.wave, NGW = F.G * 8;
    constexpr int I_IN = (DM / 64) * (NPROJ / 32), I_O = (DM / 64) * (DM / 32), I_1 = (DM / 64) * (DFF / 32), I_2 = (DFF / 64) * (DM / 32);
    constexpr int PER_L = I_IN + I_O + I_1 + I_2;
    for (int it = gw; it < DEPTH * PER_L; it += NGW) {
        const int l = it / PER_L; int r = it % PER_L;
        if (r < I_IN) { p0_transpose_item<true>(PIN(F, I_WIN) + (size_t)l * DM * 2992, DM, 2992, NPROJ, (bf16*)(F.ws + WS_WIN) + (size_t)l * NPROJ * DM, scr, r, F.lane); continue; } r -= I_IN;
        if (r < I_O) { p0_transpose_item<false>(PIN(F, I_WO) + (size_t)l * DM * DM, DM, DM, DM, (bf16*)(F.ws + WS_WO) + (size_t)l * DM * DM, scr, r, F.lane); continue; } r -= I_O;
        if (r < I_1) { p0_transpose_item<false>(PIN(F, I_W1) + (size_t)l * DM * DFF, DM, DFF, DFF, (bf16*)(F.ws + WS_W1) + (size_t)l * DFF * DM, scr, r, F.lane); continue; } r -= I_1;
        p0_transpose_item<false>(PIN(F, I_W2) + (size_t)l * DFF * DM, DFF, DM, DM, (bf16*)(F.ws + WS_W2) + (size_t)l * DM * DFF, scr, r, F.lane);
    }
}

DEV void ph_xs0(const Ctx& F, const float* xsrc, const float* nw, const float* modl, int sc_off, bf16* XS, float* RSP) {
    const int gw = F.bid * 8 + F.wave, NGW = F.G * 8;
    f32x4 wv[4];
#pragma unroll
    for (int j = 0; j < 4; ++j) wv[j] = *(const f32x4*)(nw + 4 * F.lane + 256 * j);
    f32x4 v[2][4], vn[2][4];
#pragma unroll
    for (int q = 0; q < 2; ++q) { const int m = gw + q * NGW; const f32x4* xr = (const f32x4*)(xsrc + (size_t)(m < MTOK ? m : 0) * DM) + F.lane;
#pragma unroll
        for (int j = 0; j < 4; ++j) v[q][j] = xr[64 * j]; }
    for (int m0 = gw; m0 < MTOK; m0 += 2 * NGW) {
        f32x4 sc[2][4];
#pragma unroll
        for (int q = 0; q < 2; ++q) { const int m = m0 + q * NGW; const float* mb = modl + (size_t)((m < MTOK ? m : 0) >> 12) * NADA + 4 * F.lane;
#pragma unroll
            for (int j = 0; j < 4; ++j) sc[q][j] = *(const f32x4*)(mb + sc_off + 256 * j); }
#pragma unroll
        for (int q = 0; q < 2; ++q) { const int m = m0 + (2 + q) * NGW; const f32x4* xr = (const f32x4*)(xsrc + (size_t)(m < MTOK ? m : 0) * DM) + F.lane;
#pragma unroll
            for (int j = 0; j < 4; ++j) vn[q][j] = xr[64 * j]; }
        float s[2];
#pragma unroll
        for (int q = 0; q < 2; ++q) { float a = 0.f;
#pragma unroll
            for (int j = 0; j < 4; ++j) a += (v[q][j].x * v[q][j].x + v[q][j].y * v[q][j].y) + (v[q][j].z * v[q][j].z + v[q][j].w * v[q][j].w);
            s[q] = a; }
#pragma unroll
        for (int o = 1; o < 64; o <<= 1) { s[0] += SHFL_XOR(s[0], o); s[1] += SHFL_XOR(s[1], o); }
#pragma unroll
        for (int q = 0; q < 2; ++q) { const int m = m0 + q * NGW; if (m >= MTOK) break;
            if (F.lane < 16) RSP[(size_t)m * 16 + F.lane] = F.lane == 0 ? s[q] : 0.f;
            u32x2* o8 = (u32x2*)(XS + (size_t)m * DM) + F.lane;
#pragma unroll
            for (int j = 0; j < 4; ++j) { const f32x4 y = v[q][j] * (wv[j] * (1.0f + sc[q][j]));
                u32x2 p; p.x = pk2(y.x, y.y); p.y = pk2(y.z, y.w); o8[64 * j] = p; } }
#pragma unroll
        for (int q = 0; q < 2; ++q)
#pragma unroll
            for (int j = 0; j < 4; ++j) v[q][j] = vn[q][j];
    }
}
DEV void ph_shw(const Ctx& F) {
    const int gt = F.bid * 512 + F.tid, NGT = F.G * 512;
    for (int e = gt; e < DEPTH * 2 * BATCH * (DM / 4); e += NGT) {
        const int c4 = e & 255, b = (e >> 8) & 15, w = (e >> 12) & 1, l = e >> 13;
        const f32x4 nwv = *(const f32x4*)(PIN(F, w ? I_N2W : I_N1W) + l * DM + 4 * c4);
        const f32x4 sc = *(const f32x4*)((const float*)(F.ws + WS_MOD) + ((size_t)l * BATCH + b) * NADA + (w ? 4 * DM : DM) + 4 * c4);
        ((f32x4*)(F.ws + WS_WP))[e] = nwv * (1.0f + sc);
    }
    const int gw = F.bid * 8 + F.wave, NGW = F.G * 8, i16 = F.lane & 15, kq = 8 * (F.lane >> 4);
    for (int it = gw; it < DEPTH * (NSHW / 16); it += NGW) {
        const int l = it / (NSHW / 16), n0 = (it % (NSHW / 16)) * 16;
        const bool mlp = n0 >= NPROJ;
        const bf16* Wr = mlp ? (const bf16*)(F.ws + WS_W1) + ((size_t)l * DFF + (n0 - NPROJ) + i16) * DM : (const bf16*)(F.ws + WS_WIN) + ((size_t)l * NPROJ + n0 + i16) * DM;
        const float* sh = (const float*)(F.ws + WS_MOD) + ((size_t)l * BATCH + i16) * NADA + (mlp ? 3 * DM : 0);
        f32x4 acc0 = {0.f, 0.f, 0.f, 0.f}, acc1 = {0.f, 0.f, 0.f, 0.f};
#pragma unroll 4
        for (int s = 0; s < DM / 32; ++s) {
            const bf16x8 B = *(const bf16x8*)(Wr + 32 * s + kq);
            const f32x4 a0 = *(const f32x4*)(sh + 32 * s + kq), a1 = *(const f32x4*)(sh + 32 * s + kq + 4);
            bf16x8 Ah, Al;
#pragma unroll
            for (int j = 0; j < 8; ++j) { const float a = j < 4 ? a0[j] : a1[j - 4]; const unsigned h = f2bf(a); Ah[j] = (short)h; Al[j] = (short)f2bf(a - bf2f(h)); }
            acc0 = MFMA16(Ah, B, acc0); acc1 = MFMA16(Al, B, acc1);
        }
        float* o = (float*)(F.ws + WS_SHW) + ((size_t)l * BATCH + 4 * (F.lane >> 4)) * NSHW + n0 + i16;
#pragma unroll
        for (int r = 0; r < 4; ++r) o[(size_t)r * NSHW] = acc0[r] + acc1[r];
    }
}
DEV void ph_normmod(const Ctx& F, const float* xsrc, const float* nw, const float* modl, int sh_off, int sc_off, bf16* XN) {
    const int gw = F.bid * 8 + F.wave, NGW = F.G * 8;
    f32x4 wv[4];
#pragma unroll
    for (int j = 0; j < 4; ++j) wv[j] = *(const f32x4*)(nw + 4 * F.lane + 256 * j);
    f32x4 v[2][4], vn[2][4];
#pragma unroll
    for (int q = 0; q < 2; ++q) { const int m = gw + q * NGW; const f32x4* xr = (const f32x4*)(xsrc + (size_t)(m < MTOK ? m : 0) * DM) + F.lane;
#pragma unroll
        for (int j = 0; j < 4; ++j) v[q][j] = xr[64 * j]; }
    for (int m0 = gw; m0 < MTOK; m0 += 2 * NGW) {
        f32x4 sc[2][4], sh[2][4];
#pragma unroll
        for (int q = 0; q < 2; ++q) { const int m = m0 + q * NGW; const float* mb = modl + (size_t)((m < MTOK ? m : 0) >> 12) * NADA + 4 * F.lane;
#pragma unroll
            for (int j = 0; j < 4; ++j) { sc[q][j] = *(const f32x4*)(mb + sc_off + 256 * j); sh[q][j] = *(const f32x4*)(mb + sh_off + 256 * j); } }
#pragma unroll
        for (int q = 0; q < 2; ++q) { const int m = m0 + (2 + q) * NGW; const f32x4* xr = (const f32x4*)(xsrc + (size_t)(m < MTOK ? m : 0) * DM) + F.lane;
#pragma unroll
            for (int j = 0; j < 4; ++j) vn[q][j] = xr[64 * j]; }
        float s[2];
#pragma unroll
        for (int q = 0; q < 2; ++q) { float a = 0.f;
#pragma unroll
            for (int j = 0; j < 4; ++j) a += (v[q][j].x * v[q][j].x + v[q][j].y * v[q][j].y) + (v[q][j].z * v[q][j].z + v[q][j].w * v[q][j].w);
            s[q] = a; }
#pragma unroll
        for (int o = 1; o < 64; o <<= 1) { s[0] += SHFL_XOR(s[0], o); s[1] += SHFL_XOR(s[1], o); }
#pragma unroll
        for (int q = 0; q < 2; ++q) { const int m = m0 + q * NGW; if (m >= MTOK) break;
            const float rs = RSQ(s[q] * (1.0f / DM) + NORM_EPS);
            u32x2* o8 = (u32x2*)(XN + (size_t)m * DM) + F.lane;
#pragma unroll
            for (int j = 0; j < 4; ++j) { const f32x4 y = v[q][j] * rs * wv[j] * (1.0f + sc[q][j]) + sh[q][j];
                u32x2 p; p.x = pk2(y.x, y.y); p.y = pk2(y.z, y.w); o8[64 * j] = p; } }
#pragma unroll
        for (int q = 0; q < 2; ++q)
#pragma unroll
            for (int j = 0; j < 4; ++j) v[q][j] = vn[q][j];
    }
}
DEV void ph_finalnorm(const Ctx& F, const float* xsrc, const float* nw, float* out) {
    const int gw = F.bid * 8 + F.wave, NGW = F.G * 8;
    f32x4 wv[4];
#pragma unroll
    for (int j = 0; j < 4; ++j) wv[j] = *(const f32x4*)(nw + 4 * F.lane + 256 * j);
    f32x4 v[2][4], vn[2][4];
#pragma unroll
    for (int q = 0; q < 2; ++q) { const int m = gw + q * NGW; const f32x4* xr = (const f32x4*)(xsrc + (size_t)(m < MTOK ? m : 0) * DM) + F.lane;
#pragma unroll
        for (int j = 0; j < 4; ++j) v[q][j] = xr[64 * j]; }
    for (int m0 = gw; m0 < MTOK; m0 += 2 * NGW) {
#pragma unroll
        for (int q = 0; q < 2; ++q) { const int m = m0 + (2 + q) * NGW; const f32x4* xr = (const f32x4*)(xsrc + (size_t)(m < MTOK ? m : 0) * DM) + F.lane;
#pragma unroll
            for (int j = 0; j < 4; ++j) vn[q][j] = xr[64 * j]; }
        float s[2];
#pragma unroll
        for (int q = 0; q < 2; ++q) { float a = 0.f;
#pragma unroll
            for (int j = 0; j < 4; ++j) a += (v[q][j].x * v[q][j].x + v[q][j].y * v[q][j].y) + (v[q][j].z * v[q][j].z + v[q][j].w * v[q][j].w);
            s[q] = a; }
#pragma unroll
        for (int o = 1; o < 64; o <<= 1) { s[0] += SHFL_XOR(s[0], o); s[1] += SHFL_XOR(s[1], o); }
#pragma unroll
        for (int q = 0; q < 2; ++q) { const int m = m0 + q * NGW; if (m >= MTOK) break;
            const float rs = RSQ(s[q] * (1.0f / DM) + NORM_EPS);
            f32x4* o = (f32x4*)(out + (size_t)m * DM) + F.lane;
#pragma unroll
            for (int j = 0; j < 4; ++j) o[64 * j] = v[q][j] * rs * wv[j]; }
#pragma unroll
        for (int q = 0; q < 2; ++q)
#pragma unroll
            for (int j = 0; j < 4; ++j) v[q][j] = vn[q][j];
    }
}
DEV void ph_finalnorm16(const Ctx& F, const bf16* x16, const float* nw, float* out) {
    const int gw = F.bid * 8 + F.wave, NGW = F.G * 8;
    f32x4 wv[2][2];
#pragma unroll
    for (int j = 0; j < 2; ++j) { wv[j][0] = *(const f32x4*)(nw + 8 * F.lane + 512 * j); wv[j][1] = *(const f32x4*)(nw + 8 * F.lane + 512 * j + 4); }
    u32x4 v[4][2], vn[4][2];
#pragma unroll
    for (int q = 0; q < 4; ++q) { const int m = gw + q * NGW; const bf16* xr = x16 + (size_t)(m < MTOK ? m : 0) * DM + 8 * F.lane;
        v[q][0] = *(const u32x4*)xr; v[q][1] = *(const u32x4*)(xr + 512); }
    for (int m0 = gw; m0 < MTOK; m0 += 4 * NGW) {
#pragma unroll
        for (int q = 0; q < 4; ++q) { const int m = m0 + (4 + q) * NGW; const bf16* xr = x16 + (size_t)(m < MTOK ? m : 0) * DM + 8 * F.lane;
            vn[q][0] = *(const u32x4*)xr; vn[q][1] = *(const u32x4*)(xr + 512); }
        float s[4];
#pragma unroll
        for (int q = 0; q < 4; ++q) { float a = 0.f;
#pragma unroll
            for (int j = 0; j < 2; ++j) { const u32x4 r = v[q][j];
                a += ((bflo(r.x) * bflo(r.x) + bfhi(r.x) * bfhi(r.x)) + (bflo(r.y) * bflo(r.y) + bfhi(r.y) * bfhi(r.y))) + ((bflo(r.z) * bflo(r.z) + bfhi(r.z) * bfhi(r.z)) + (bflo(r.w) * bflo(r.w) + bfhi(r.w) * bfhi(r.w))); }
            s[q] = a; }
#pragma unroll
        for (int o = 1; o < 64; o <<= 1) {
#pragma unroll
            for (int q = 0; q < 4; ++q) s[q] += SHFL_XOR(s[q], o); }
#pragma unroll
        for (int q = 0; q < 4; ++q) { const int m = m0 + q * NGW; if (m >= MTOK) break;
            const float rs = RSQ(s[q] * (1.0f / DM) + NORM_EPS);
            float* o = out + (size_t)m * DM + 8 * F.lane;
#pragma unroll
            for (int j = 0; j < 2; ++j) { const u32x4 r = v[q][j];
                *(f32x4*)(o + 512 * j) = (f32x4){bflo(r.x), bfhi(r.x), bflo(r.y), bfhi(r.y)} * rs * wv[j][0];
                *(f32x4*)(o + 512 * j + 4) = (f32x4){bflo(r.z), bfhi(r.z), bflo(r.w), bfhi(r.w)} * rs * wv[j][1]; } }
#pragma unroll
        for (int q = 0; q < 4; ++q) { v[q][0] = vn[q][0]; v[q][1] = vn[q][1]; }
    }
}
DEV void ph_zero_cat(const Ctx& F, int c0, int nq) {
    const int gw = F.bid * 8 + F.wave, NGW = F.G * 8;
    bf16* CAT = (bf16*)(F.ws + WS_CAT);
    for (int m = gw; m < MTOK; m += NGW) for (int q = 0; q < nq; ++q) *(u32x2*)(CAT + (size_t)m * DM + c0 + 256 * q + 4 * F.lane) = (u32x2){0u, 0u};
}
DEV float softcap15(float z) { return 15.0f * tanhf(z * (1.0f / 15.0f)); }
DEV float logsigmoidf_(float x) { return x >= 0.f ? -log1pf(expf(-x)) : x - log1pf(expf(x)); }
DEV void ph_prep(const Ctx& F, int l) {
    const int gw = F.bid * 8 + F.wave, NGW = F.G * 8, lane = F.lane;
    const bf16* PROJ = (const bf16*)(F.ws + WS_PROJ);
    bf16* QL = (bf16*)(F.ws + WS_QL); bf16* CKV = (bf16*)(F.ws + WS_CKV); bf16* KIDX = (bf16*)(F.ws + WS_KIDX);
    float* WI = (float*)(F.ws + WS_WI);
    const f32x4 qn = *(const f32x4*)(PIN(F, I_QNW) + l * 256 + 4 * lane);
    const float kn0 = PIN(F, I_KVNW)[l * 128 + 2 * lane], kn1 = PIN(F, I_KVNW)[l * 128 + 2 * lane + 1];
    u32x2 ra4[4], ran[4]; unsigned rk4[4], rx4[4], rkn[4], rxn[4];
#define PREP_LOAD(RA, RK, RX, M0) do { _Pragma("unroll") for (int q = 0; q < 4; ++q) { const int mm = (M0) + q * NGW; const bf16* pr = PROJ + (size_t)(mm < MTOK ? mm : 0) * NPROJ; \
            RA[q] = *(const u32x2*)(pr + PC_AQ + 4 * lane); RK[q] = *(const unsigned*)(pr + PC_AKV + 2 * lane); \
            RX[q] = lane < 16 ? *(const unsigned*)(pr + PC_IK + 2 * lane) : (lane < 24 ? (unsigned)pr[PC_IW + (lane - 16)] : 0u); } } while (0)
    PREP_LOAD(ra4, rk4, rx4, gw);
    for (int m0 = gw; m0 < MTOK; m0 += 4 * NGW) {
        PREP_LOAD(ran, rkn, rxn, m0 + 4 * NGW);
#pragma unroll
        for (int q = 0; q < 4; ++q) { const int m = m0 + q * NGW; if (m >= MTOK) break;
            const u32x2 ra = ra4[q]; const unsigned rk = rk4[q];
            const float a0 = bflo(ra.x), a1 = bfhi(ra.x), a2 = bflo(ra.y), a3 = bfhi(ra.y);
            const float k0 = bflo(rk), k1 = bfhi(rk);
            const float sq = wave_sum((a0 * a0 + a1 * a1) + (a2 * a2 + a3 * a3)), sk = wave_sum(k0 * k0 + k1 * k1);
            const float rq = RSQ(sq * (1.0f / 256.0f) + NORM_EPS), rk2 = RSQ(sk * (1.0f / 128.0f) + NORM_EPS);
            u32x2 oq; oq.x = pk2(a0 * rq * qn.x, a1 * rq * qn.y); oq.y = pk2(a2 * rq * qn.z, a3 * rq * qn.w);
            *(u32x2*)(QL + (size_t)m * 256 + 4 * lane) = oq;
            *(unsigned*)(CKV + (size_t)m * 128 + 2 * lane) = pk2(k0 * rk2 * kn0, k1 * rk2 * kn1);
            if (lane < 16) *(unsigned*)(KIDX + (size_t)m * 32 + 2 * lane) = rx4[q];
            else if (lane < 24) WI[(size_t)m * 8 + (lane - 16)] = bf2f(rx4[q]); }
#pragma unroll
        for (int q = 0; q < 4; ++q) { ra4[q] = ran[q]; rk4[q] = rkn[q]; rx4[q] = rxn[q]; }
    }
#undef PREP_LOAD
}

constexpr int XB_STRIDE = 264;
DEV void ph_lru1(const Ctx& F, int l) {
    const int tid = F.tid, lane = F.lane, w = F.wave, i16 = lane & 15, g = lane >> 4;
    bf16* XB = (bf16*)F.lds;
    float* XF = (float*)(F.lds + 64 * XB_STRIDE * 2);
    const bf16* PROJ = (const bf16*)(F.ws + WS_PROJ);
    bf16* HLOC = (bf16*)(F.ws + WS_HLOC); bf16* CPA = (bf16*)(F.ws + WS_CPA); float* LSUM = (float*)(F.ws + WS_LSUM);
    const int blk = w & 3, nh = w >> 2;
    const bf16* WG = (const bf16*)(F.ws + WS_WG) + (size_t)l * 2 * 4 * 4096;
    bf16x8 Bf[2][2][2];
#pragma unroll
    for (int gg = 0; gg < 2; ++gg)
#pragma unroll
        for (int nt = 0; nt < 2; ++nt)
#pragma unroll
            for (int ks = 0; ks < 2; ++ks) Bf[gg][nt][ks] = *(const bf16x8*)(WG + ((size_t)(gg * 4 + blk) * 64 + (2 * nh + nt) * 16 + i16) * 64 + ks * 32 + 8 * g);
    float ba[2], bx[2], sp[2];
#pragma unroll
    for (int nt = 0; nt < 2; ++nt) { const int ch = blk * 64 + (2 * nh + nt) * 16 + i16;
        ba[nt] = PIN(F, I_BA)[l * 256 + ch]; bx[nt] = PIN(F, I_BX)[l * 256 + ch];
        const float lam = PIN(F, I_LAM)[l * 256 + ch]; sp[nt] = lam > 0.f ? log1pf(expf(-lam)) : -lam + log1pf(expf(lam)); }
    const int ch2 = tid & 127, tg = tid >> 7;
    float cw[4][2], cb[2];
#pragma unroll
    for (int j = 0; j < 4; ++j) { cw[j][0] = PIN(F, I_CONVW)[(l * 4 + j) * 256 + 2 * ch2]; cw[j][1] = PIN(F, I_CONVW)[(l * 4 + j) * 256 + 2 * ch2 + 1]; }
    cb[0] = PIN(F, I_CONVB)[l * 256 + 2 * ch2]; cb[1] = PIN(F, I_CONVB)[l * 256 + 2 * ch2 + 1];

    for (int u = F.bid; u < BATCH * 64; u += F.G) {
        const int b = u >> 6, c = u & 63, t0 = c * 64; const size_t m0 = (size_t)b * SEQ + t0;
        {
            float w0[2] = {0.f, 0.f}, w1[2] = {0.f, 0.f}, w2[2] = {0.f, 0.f};
            const int tl0 = tg * 16;
#pragma unroll
            for (int j = 0; j < 3; ++j) { const int t = t0 + tl0 - 3 + j; float v0 = 0.f, v1 = 0.f;
                if (t >= 0) { const unsigned r = *(const unsigned*)(PROJ + ((size_t)b * SEQ + t) * NPROJ + PC_LX + 2 * ch2); v0 = bflo(r); v1 = bfhi(r); }
                if (j == 0) { w0[0] = v0; w0[1] = v1; } else if (j == 1) { w1[0] = v0; w1[1] = v1; } else { w2[0] = v0; w2[1] = v1; } }
#pragma unroll
            for (int tt = 0; tt < 16; ++tt) { const int tl = tl0 + tt;
                const unsigned r = *(const unsigned*)(PROJ + (m0 + tl) * NPROJ + PC_LX + 2 * ch2);
                const float v0 = bflo(r), v1 = bfhi(r);
                const float x0 = cw[0][0] * w0[0] + cw[1][0] * w1[0] + cw[2][0] * w2[0] + cw[3][0] * v0 + cb[0];
                const float x1 = cw[0][1] * w0[1] + cw[1][1] * w1[1] + cw[2][1] * w2[1] + cw[3][1] * v1 + cb[1];
                *(unsigned*)(XB + tl * XB_STRIDE + 2 * ch2) = pk2(x0, x1);
                XF[tl * 256 + 2 * ch2] = x0; XF[tl * 256 + 2 * ch2 + 1] = x1;
                w0[0] = w1[0]; w0[1] = w1[1]; w1[0] = w2[0]; w1[1] = w2[1]; w2[0] = v0; w2[1] = v1; }
        }
        SYNC();
        float CA[2] = {1.f, 1.f}, CU[2] = {0.f, 0.f};
#pragma unroll 1
        for (int m = 0; m < 4; ++m) {
            f32x4 acc[2][2];
#pragma unroll
            for (int gg = 0; gg < 2; ++gg)
#pragma unroll
                for (int nt = 0; nt < 2; ++nt) acc[gg][nt] = (f32x4){0.f, 0.f, 0.f, 0.f};
#pragma unroll
            for (int ks = 0; ks < 2; ++ks) { const bf16x8 A = *(const bf16x8*)(XB + (m * 16 + i16) * XB_STRIDE + blk * 64 + ks * 32 + 8 * g);
#pragma unroll
                for (int gg = 0; gg < 2; ++gg)
#pragma unroll
                    for (int nt = 0; nt < 2; ++nt) acc[gg][nt] = MFMA16(A, Bf[gg][nt][ks], acc[gg][nt]); }
#pragma unroll
            for (int nt = 0; nt < 2; ++nt) {
                const int ch = blk * 64 + (2 * nh + nt) * 16 + i16;
                float P[4], H[4]; float pa = 1.f, hu = 0.f;
#pragma unroll
                for (int r = 0; r < 4; ++r) { const int tok = m * 16 + 4 * g + r;
                    const float rg = fsigmoid(acc[0][nt][r] + ba[nt]), gi = fsigmoid(acc[1][nt][r] + bx[nt]);
                    const float la = -8.0f * rg * sp[nt], a = FEXP(la), uu = FSQRT(one_minus_exp(2.0f * la)) * (gi * XF[tok * 256 + ch]);
                    pa = a * pa; hu = a * hu + uu; P[r] = pa; H[r] = hu; }
                float EA = 1.f, EU = 0.f, TA = 1.f, TU = 0.f;
#pragma unroll
                for (int gg = 0; gg < 4; ++gg) { const float ta = SHFL(pa, i16 + 16 * gg), tu = SHFL(hu, i16 + 16 * gg);
                    if (gg < g) { EU = ta * EU + tu; EA = ta * EA; }
                    TU = ta * TU + tu; TA = ta * TA; }
                const float XA = EA * CA[nt], XU = EA * CU[nt] + EU;
#pragma unroll
                for (int r = 0; r < 4; ++r) { const int tok = m * 16 + 4 * g + r;
                    HLOC[(m0 + tok) * 256 + ch] = (bf16)f2bf(P[r] * XU + H[r]); CPA[(m0 + tok) * 256 + ch] = (bf16)f2bf(P[r] * XA); }
                CU[nt] = TA * CU[nt] + TU; CA[nt] = TA * CA[nt];
            }
        }
        if (g == 0) {
#pragma unroll
            for (int nt = 0; nt < 2; ++nt) { const int ch = blk * 64 + (2 * nh + nt) * 16 + i16;
                LSUM[((size_t)b * 64 + c) * 256 + ch] = CA[nt]; LSUM[(size_t)BATCH * 64 * 256 + ((size_t)b * 64 + c) * 256 + ch] = CU[nt]; }
        }
        SYNC();
    }
}

DEV float gelu_tanh(float x) { const float z = 0.7978845608028654f * (x + 0.044715f * x * x * x); return x * FRCP(1.0f + FEXP(-2.0f * z)); }
DEV void ph_carry(const Ctx& F) {
    if (F.wave != 0) return;
    const float* LSUM = (const float*)(F.ws + WS_LSUM); float* CARRY = (float*)(F.ws + WS_CARRY);
    const int seg = F.lane & 3;
    for (int chain = F.bid * 16 + (F.lane >> 2); chain < BATCH * 256; chain += F.G * 16) {
        const int b = chain >> 8, ch = chain & 255; const size_t o0 = ((size_t)b * 64 + seg * 16) * 256 + ch;
        float a[16], hb[16];
#pragma unroll
        for (int i = 0; i < 16; ++i) { a[i] = LSUM[o0 + (size_t)i * 256]; hb[i] = LSUM[(size_t)BATCH * 64 * 256 + o0 + (size_t)i * 256]; }
        float hp[16], ap[16], hl = 0.f, al = 1.f;
#pragma unroll
        for (int i = 0; i < 16; ++i) { hp[i] = hl; ap[i] = al; hl = a[i] * hl + hb[i]; al = a[i] * al; }
        float cin = 0.f;
#pragma unroll
        for (int s2 = 0; s2 < 3; ++s2) { const float as = SHFL(al, (F.lane & ~3) + s2), hs = SHFL(hl, (F.lane & ~3) + s2); if (s2 < seg) cin = as * cin + hs; }
#pragma unroll
        for (int i = 0; i < 16; ++i) CARRY[o0 + (size_t)i * 256] = ap[i] * cin + hp[i];
    }
}
DEV void ph_lru2(const Ctx& F, int l) {
    const int tid = F.tid, lane = F.lane, w = F.wave;
    const bf16* PROJ = (const bf16*)(F.ws + WS_PROJ); const bf16* HLOC = (const bf16*)(F.ws + WS_HLOC); const bf16* CPA = (const bf16*)(F.ws + WS_CPA);
    const float* CARRY = (const float*)(F.ws + WS_CARRY); bf16* CAT = (bf16*)(F.ws + WS_CAT);
    const f32x4 gw4 = *(const f32x4*)(PIN(F, I_GNW) + l * DM + 4 * lane);
    for (int u = F.bid; u < BATCH * 64; u += F.G) {
        const int b = u >> 6, c = u & 63; const size_t m0 = (size_t)b * SEQ + c * 64;
        const f32x4 car = *(const f32x4*)(CARRY + (size_t)u * 256 + 4 * lane);
        u32x2 hl8[8], cp8[8], ly8[8];
#pragma unroll
        for (int tt = 0; tt < 8; ++tt) { const size_t m = m0 + w * 8 + tt;
            hl8[tt] = *(const u32x2*)(HLOC + m * 256 + 4 * lane); cp8[tt] = *(const u32x2*)(CPA + m * 256 + 4 * lane); ly8[tt] = *(const u32x2*)(PROJ + m * NPROJ + PC_LY + 4 * lane); }
#pragma unroll
        for (int tt = 0; tt < 8; ++tt) { const size_t m = m0 + w * 8 + tt; const u32x2 hl = hl8[tt], cp = cp8[tt], ly = ly8[tt];
            float v0 = (bflo(hl.x) + bflo(cp.x) * car.x) * gelu_tanh(bflo(ly.x));
            float v1 = (bfhi(hl.x) + bfhi(cp.x) * car.y) * gelu_tanh(bfhi(ly.x));
            float v2 = (bflo(hl.y) + bflo(cp.y) * car.z) * gelu_tanh(bflo(ly.y));
            float v3 = (bfhi(hl.y) + bfhi(cp.y) * car.w) * gelu_tanh(bfhi(ly.y));
            const float rs = RSQ(wave_sum((v0 * v0 + v1 * v1) + (v2 * v2 + v3 * v3)) * (1.0f / 256.0f) + NORM_EPS);
            u32x2 o; o.x = pk2(v0 * rs * gw4.x, v1 * rs * gw4.y); o.y = pk2(v2 * rs * gw4.z, v3 * rs * gw4.w);
            *(u32x2*)(CAT + m * DM + 4 * lane) = o; }
    }
}

constexpr int QS_STRIDE = 136, VE_STRIDE = 56;
DEV void ph_mlstm(const Ctx& F, int l) {
    const int tid = F.tid, lane = F.lane, w = F.wave, i16 = lane & 15, g = lane >> 4;
    bf16* QsB = (bf16*)F.lds;
    bf16* KsB = QsB + 2 * 64 * QS_STRIDE;
    bf16* VE = KsB + 2 * 64 * QS_STRIDE;
    bf16* VW = VE + 64 * VE_STRIDE;
    bf16* CsB = VW + 64 * VE_STRIDE;
    float* BCB = (float*)(CsB + 2 * 128 * VE_STRIDE);
    float* BIB = BCB + 128;
    const bf16* PROJ = (const bf16*)(F.ws + WS_PROJ); bf16* HM = (bf16*)(F.ws + WS_HM);
    const float qscale = 0.08838834764831845f;
    const int jt = w & 3, half = w >> 2;
    for (int u = F.bid; u < BATCH * 4 * 4; u += F.G) {
        const int b = u >> 4, h = (u >> 2) & 3, vs = u & 3;
        const float gbi = PIN(F, I_BI)[l * 4 + h], gbf = PIN(F, I_BF)[l * 4 + h];
        f32x4 accC[3];
#pragma unroll
        for (int nt = 0; nt < 3; ++nt) accC[nt] = (f32x4){0.f, 0.f, 0.f, 0.f};
        float* BCg = (float*)(F.ws + WS_MG) + (size_t)u * 8192; float* BIg = BCg + 4096;
        unsigned gri[8], grf[8];
#pragma unroll
        for (int k = 0; k < 8; ++k) { const bf16* pr = PROJ + ((size_t)b * SEQ + (8 * k + w) * 64 + lane) * NPROJ; gri[k] = pr[PC_MI + h]; grf[k] = pr[PC_MF + h]; }
#pragma unroll
        for (int k = 0; k < 8; ++k) { const int tok = (8 * k + w) * 64 + lane;
            const float zi = (bf2f(gri[k]) + gbi) * (1.0f / 15.0f), zf = (bf2f(grf[k]) + gbf) * (1.0f / 15.0f);
            const float ig = 15.0f - 30.0f * FRCP(FEXP(2.0f * zi) + 1.0f), fg = 15.0f - 30.0f * FRCP(FEXP(2.0f * zf) + 1.0f);
            float s = -FLOG(1.0f + FEXP(-fg));
#pragma unroll
            for (int o = 1; o < 64; o <<= 1) { const float t = SHFL_UP(s, o); if (lane >= o) s += t; }
            BCg[tok] = s; BIg[tok] = s - ig; }
        SYNC();
        u32x4 rq[2], rk[2]; u32x2 rvv; float rgc = 0.f, rgb = 0.f;
        {
            const size_t m0 = (size_t)b * SEQ;
#pragma unroll
            for (int i = 0; i < 2; ++i) { const int idx = tid + 512 * i, row = idx >> 4, ck = idx & 15;
                rq[i] = *(const u32x4*)(PROJ + (m0 + row) * NPROJ + PC_MQ + h * 128 + 8 * ck); rk[i] = *(const u32x4*)(PROJ + (m0 + row) * NPROJ + PC_MK + h * 128 + 8 * ck); }
            rvv = *(const u32x2*)(PROJ + (m0 + (tid >> 3)) * NPROJ + PC_MV + h * 128 + vs * 32 + 4 * (tid & 7));
            if (tid < 64) { rgc = BCg[tid]; rgb = BIg[tid]; }
        }
        for (int c = 0; c < 64; ++c) {
            const size_t m0 = (size_t)b * SEQ + c * 64; const int buf = c & 1;
            bf16* Qs = QsB + buf * 64 * QS_STRIDE; bf16* Ks = KsB + buf * 64 * QS_STRIDE; const bf16* Cs = CsB + buf * 128 * VE_STRIDE; bf16* Cn = CsB + (buf ^ 1) * 128 * VE_STRIDE;
            float* BC = BCB + buf * 64; float* BI = BIB + buf * 64;
#pragma unroll
            for (int i = 0; i < 2; ++i) { const int idx = tid + 512 * i, row = idx >> 4, ck = idx & 15;
                *(u32x4*)(Qs + row * QS_STRIDE + 8 * ck) = rq[i]; *(u32x4*)(Ks + row * QS_STRIDE + 8 * ck) = rk[i]; }
            if (tid < 64) { BC[tid] = rgc; BI[tid] = rgb; }
            SYNC();
            {
                const int row = tid >> 3, cg = tid & 7;
                const u32x2 rv = rvv;
                const float wt = FEXP(BC[63] - BI[row]);
                *(u32x2*)(VE + row * VE_STRIDE + 4 * cg) = rv;
                u32x2 sv; sv.x = pk2(bflo(rv.x) * wt, bfhi(rv.x) * wt); sv.y = pk2(bflo(rv.y) * wt, bfhi(rv.y) * wt);
                *(u32x2*)(VW + row * VE_STRIDE + 4 * cg) = sv;
                if (cg == 0) { unsigned one_ = 0x3f80u; LAUNDER_V(one_); u32x4 z = (u32x4){one_, 0u, 0u, 0u}; *(u32x4*)(VE + row * VE_STRIDE + 32) = z; *(u32x4*)(VE + row * VE_STRIDE + 40) = (u32x4){0u, 0u, 0u, 0u};
                    z.x = f2bf(wt); *(u32x4*)(VW + row * VE_STRIDE + 32) = z; *(u32x4*)(VW + row * VE_STRIDE + 40) = (u32x4){0u, 0u, 0u, 0u}; }
            }
            if (c + 1 < 64) {
                const size_t m1 = m0 + 64;
#pragma unroll
                for (int i = 0; i < 2; ++i) { const int idx = tid + 512 * i, row = idx >> 4, ck = idx & 15;
                    rq[i] = *(const u32x4*)(PROJ + (m1 + row) * NPROJ + PC_MQ + h * 128 + 8 * ck); rk[i] = *(const u32x4*)(PROJ + (m1 + row) * NPROJ + PC_MK + h * 128 + 8 * ck); }
                rvv = *(const u32x2*)(PROJ + (m1 + (tid >> 3)) * NPROJ + PC_MV + h * 128 + vs * 32 + 4 * (tid & 7));
                if (tid < 64) { rgc = BCg[(c + 1) * 64 + tid]; rgb = BIg[(c + 1) * 64 + tid]; }
            }
            SYNC();
            f32x4 Z[2] = {(f32x4){0.f, 0.f, 0.f, 0.f}, (f32x4){0.f, 0.f, 0.f, 0.f}};
            {
                bf16x8 Bq[4];
#pragma unroll
                for (int ks = 0; ks < 4; ++ks) Bq[ks] = *(const bf16x8*)(Qs + (16 * jt + i16) * QS_STRIDE + 32 * ks + 8 * g);
                const float bj = BC[16 * jt + i16];
                unsigned pk[4][2];
#pragma unroll
                for (int tt = 0; tt < 4; ++tt) {
                    if (tt <= jt) {
                        f32x4 X = (f32x4){0.f, 0.f, 0.f, 0.f};
#pragma unroll
                        for (int ks = 0; ks < 4; ++ks) X = MFMA16(*(const bf16x8*)(Ks + (16 * tt + i16) * QS_STRIDE + 32 * ks + 8 * g), Bq[ks], X);
                        float p[4]; const f32x4 bi4 = *(const f32x4*)(BI + 16 * tt + 4 * g);
#pragma unroll
                        for (int r = 0; r < 4; ++r) { const float pv = X[r] * qscale * FEXP(fminf(bj - bi4[r], 60.0f));
                            p[r] = (tt < jt || 4 * g + r <= i16) ? pv : 0.f; }
                        pk[tt][0] = pk2(p[0], p[1]); pk[tt][1] = pk2(p[2], p[3]);
                    } else { pk[tt][0] = 0u; pk[tt][1] = 0u; }
                }
#pragma unroll
                for (int pr = 0; pr < 2; ++pr) {
                    if (2 * pr <= jt) {
                        u32x4 aw = (u32x4){pk[2 * pr][0], pk[2 * pr][1], pk[2 * pr + 1][0], pk[2 * pr + 1][1]};
                        const bf16x8 A = __builtin_bit_cast(bf16x8, aw);
#pragma unroll
                        for (int n = 0; n < 2; ++n) { const int ntc = n ? 2 : half;
                            const s16x4 lo = TR16(VE + (32 * pr + 4 * g + (i16 >> 2)) * VE_STRIDE + 16 * ntc + 4 * (i16 & 3));
                            const s16x4 hi = TR16(VE + (32 * pr + 16 + 4 * g + (i16 >> 2)) * VE_STRIDE + 16 * ntc + 4 * (i16 & 3));
                            const bf16x8 B = (bf16x8){lo[0], lo[1], lo[2], lo[3], hi[0], hi[1], hi[2], hi[3]};
                            Z[n] = MFMA16(A, B, Z[n]); }
#ifndef HOST_EMU
                        asm volatile("" :: "v"(aw));
#endif
                    }
                }
            }
            if (c > 0) {
                f32x4 Z2[2] = {(f32x4){0.f, 0.f, 0.f, 0.f}, (f32x4){0.f, 0.f, 0.f, 0.f}};
#pragma unroll
                for (int ks = 0; ks < 4; ++ks) { const bf16x8 A = *(const bf16x8*)(Qs + (16 * jt + i16) * QS_STRIDE + 32 * ks + 8 * g);
#pragma unroll
                    for (int n = 0; n < 2; ++n) { const int ntc = n ? 2 : half;
                        const s16x4 lo = TR16(Cs + (32 * ks + 8 * g + (i16 >> 2)) * VE_STRIDE + 16 * ntc + 4 * (i16 & 3));
                        const s16x4 hi = TR16(Cs + (32 * ks + 8 * g + 4 + (i16 >> 2)) * VE_STRIDE + 16 * ntc + 4 * (i16 & 3));
                        const bf16x8 B = (bf16x8){lo[0], lo[1], lo[2], lo[3], hi[0], hi[1], hi[2], hi[3]};
                        Z2[n] = MFMA16(A, B, Z2[n]); } }
                const f32x4 bc4 = *(const f32x4*)(BC + 16 * jt + 4 * g);
#pragma unroll
                for (int r = 0; r < 4; ++r) { const float f = qscale * FEXP(bc4[r]); Z[0][r] += f * Z2[0][r]; Z[1][r] += f * Z2[1][r]; }
            }
#pragma unroll
            for (int r = 0; r < 4; ++r) { const int j = 16 * jt + 4 * g + r; const float dn = FRCP(fmaxf(fabsf(SHFL(Z[1][r], lane & 48)), 1.0f));
                HM[(m0 + j) * 512 + h * 128 + vs * 32 + 16 * half + i16] = (bf16)f2bf(Z[0][r] * dn); }
            {
                const float dec = FEXP(BC[63]);
#pragma unroll
                for (int nt = 0; nt < 3; ++nt) accC[nt] = accC[nt] * dec;
#pragma unroll
                for (int ks = 0; ks < 2; ++ks) {
                    const s16x4 alo = TR16(Ks + (32 * ks + 8 * g + (i16 >> 2)) * QS_STRIDE + 16 * w + 4 * (i16 & 3));
                    const s16x4 ahi = TR16(Ks + (32 * ks + 8 * g + 4 + (i16 >> 2)) * QS_STRIDE + 16 * w + 4 * (i16 & 3));
                    const bf16x8 A = (bf16x8){alo[0], alo[1], alo[2], alo[3], ahi[0], ahi[1], ahi[2], ahi[3]};
#pragma unroll
                    for (int nt = 0; nt < 3; ++nt) {
                        const s16x4 lo = TR16(VW + (32 * ks + 8 * g + (i16 >> 2)) * VE_STRIDE + 16 * nt + 4 * (i16 & 3));
                        const s16x4 hi = TR16(VW + (32 * ks + 8 * g + 4 + (i16 >> 2)) * VE_STRIDE + 16 * nt + 4 * (i16 & 3));
                        const bf16x8 B = (bf16x8){lo[0], lo[1], lo[2], lo[3], hi[0], hi[1], hi[2], hi[3]};
                        const f32x4 cold = accC[nt]; accC[nt] = MFMA16(A, B, cold);
#ifndef HOST_EMU
                        asm volatile("" :: "v"(cold), "v"(A), "v"(B));
#endif
                    }
                }
#pragma unroll
                for (int nt = 0; nt < 3; ++nt)
#pragma unroll
                    for (int r = 0; r < 4; ++r) Cn[(16 * w + 4 * g + r) * VE_STRIDE + 16 * nt + i16] = (bf16)f2bf(accC[nt][r]);
            }
        }
        SYNC();
    }
}

DEV void ph_mfin(const Ctx& F, int l) {
    const int gw = F.bid * 8 + F.wave, NGW = F.G * 8, lane = F.lane;
    const bf16* PROJ = (const bf16*)(F.ws + WS_PROJ); const bf16* HM = (const bf16*)(F.ws + WS_HM); bf16* CAT = (bf16*)(F.ws + WS_CAT);
    float gm[8];
#pragma unroll
    for (int j = 0; j < 8; ++j) gm[j] = PIN(F, I_GNW)[l * DM + 256 + 8 * lane + j];
    u32x4 hv4[4], ov4[4], hvn[4], ovn[4];
#define MFIN_LOAD(HV, OV, M0) do { _Pragma("unroll") for (int q = 0; q < 4; ++q) { const int mm = (M0) + q * NGW; const size_t ms = (size_t)(mm < MTOK ? mm : 0); \
            HV[q] = *(const u32x4*)(HM + ms * 512 + 8 * lane); OV[q] = *(const u32x4*)(PROJ + ms * NPROJ + PC_MO + 8 * lane); } } while (0)
    MFIN_LOAD(hv4, ov4, gw);
    for (int m0 = gw; m0 < MTOK; m0 += 4 * NGW) {
        MFIN_LOAD(hvn, ovn, m0 + 4 * NGW);
#pragma unroll
        for (int q = 0; q < 4; ++q) { const int m = m0 + q * NGW; if (m >= MTOK) break;
            const u32x4 hv = hv4[q], ov = ov4[q];
            float v[8] = {bflo(hv.x), bfhi(hv.x), bflo(hv.y), bfhi(hv.y), bflo(hv.z), bfhi(hv.z), bflo(hv.w), bfhi(hv.w)};
            const float o[8] = {bflo(ov.x), bfhi(ov.x), bflo(ov.y), bfhi(ov.y), bflo(ov.z), bfhi(ov.z), bflo(ov.w), bfhi(ov.w)};
            float s = 0.f;
#pragma unroll
            for (int j = 0; j < 8; ++j) s += v[j] * v[j];
            s += SHFL_XOR(s, 1); s += SHFL_XOR(s, 2); s += SHFL_XOR(s, 4); s += SHFL_XOR(s, 8);
            const float rs = RSQ(s * (1.0f / 128.0f) + NORM_EPS);
            u32x4 r;
            r.x = pk2(v[0] * rs * gm[0] * fsigmoid(o[0]), v[1] * rs * gm[1] * fsigmoid(o[1]));
            r.y = pk2(v[2] * rs * gm[2] * fsigmoid(o[2]), v[3] * rs * gm[3] * fsigmoid(o[3]));
            r.z = pk2(v[4] * rs * gm[4] * fsigmoid(o[4]), v[5] * rs * gm[5] * fsigmoid(o[5]));
            r.w = pk2(v[6] * rs * gm[6] * fsigmoid(o[6]), v[7] * rs * gm[7] * fsigmoid(o[7]));
            *(u32x4*)(CAT + (size_t)m * DM + 256 + 8 * lane) = r; }
#pragma unroll
        for (int q = 0; q < 4; ++q) { hv4[q] = hvn[q]; ov4[q] = ovn[q]; }
    }
#undef MFIN_LOAD
}

constexpr int DS_HIST = 0;
constexpr int DS_MASK = 49152;
constexpr int DS_CAND = 65536;
constexpr int DS_SELL = 102400;
constexpr int DS_META = 118784;
constexpr int DS_RB = DS_META + 512;
constexpr int DS_SS = DS_RB + 2048;
constexpr int DS_SLOT = 12800;
constexpr int NBIN = 768, CAND_CAP = 128;
__device__ const unsigned char T5B[114] = {0, 1, 2, 3, 4, 5, 6, 7, 8, 9, 10, 11, 12, 13, 14, 15, 16, 16, 16, 17, 17, 18, 18, 18, 19, 19, 19, 20, 20, 20, 20, 21, 21, 21, 21, 22, 22, 22, 22, 22, 23, 23, 23, 23, 23, 23, 24, 24, 24, 24, 24, 24, 25, 25, 25, 25, 25, 25, 25, 26, 26, 26, 26, 26, 26, 26, 26, 27, 27, 27, 27, 27, 27, 27, 27, 27, 27, 28, 28, 28, 28, 28, 28, 28, 28, 28, 28, 29, 29, 29, 29, 29, 29, 29, 29, 29, 29, 29, 29, 30, 30, 30, 30, 30, 30, 30, 30, 30, 30, 30, 30, 30, 30, 31};

DEV int score_bin(float sc) {
    const unsigned u = __builtin_bit_cast(unsigned, sc);
    int e = (int)((u >> 18) & 0x1FFFu) - 119 * 32; e = e < 0 ? 0 : (e > 383 ? 383 : e);
    return (u >> 31) ? 383 - e : 384 + e;
}
DEV unsigned score_key(float sc) { const unsigned u = __builtin_bit_cast(unsigned, sc); return (u >> 31) ? ~u : (u | 0x80000000u); }
DEV unsigned score_code(float sc) {
    const unsigned u = __builtin_bit_cast(unsigned, sc);
    int e = (int)((u >> 18) & 0x1FFFu) - 119 * 32; e = e < 0 ? 0 : (e > 383 ? 383 : e);
    return ((u >> 16) & 0x8000u) | ((unsigned)e << 6) | ((u >> 12) & 63u);
}
DEV int code_bin(unsigned c) { const int e = (int)((c >> 6) & 0x1FFu); return (c & 0x8000u) ? 383 - e : 384 + e; }
DEV unsigned code_key(unsigned c) { return (c & 0x8000u) ? 63u - (c & 63u) : (c & 63u); }


DEV f32x4 dsa_score_tile(const bf16x8 A, const bf16x8 (&QS)[2], const bf16x8 (&Bq)[8], const float (&wq)[8]) {
    f32x4 sc = (f32x4){0.f, 0.f, 0.f, 0.f};
#pragma unroll
    for (int h = 0; h < 8; ++h) { const f32x4 d = MFMA16(A, Bq[h], (f32x4){0.f, 0.f, 0.f, 0.f});
#pragma unroll
        for (int r = 0; r < 4; ++r) sc[r] += wq[h] * RELU(d[r]); }
    return sc;
}
DEV void ph_dsa(const Ctx& F, int l) {
    const int tid = F.tid, lane = F.lane, w = F.wave, i16 = lane & 15, g = lane >> 4;
    unsigned* HIST = (unsigned*)(F.lds + DS_HIST); unsigned* MASK = (unsigned*)(F.lds + DS_MASK); u32x2* CAND = (u32x2*)(F.lds + DS_CAND);
    unsigned short* SELL = (unsigned short*)(F.lds + DS_SELL); int* BST = (int*)(F.lds + DS_META); int* NAB = BST + 32; int* NCAND = BST + 64; int* NSEL = BST + 96;
    float* RB = (float*)(F.lds + DS_RB);
    const bf16* QIDX = (const bf16*)(F.ws + WS_QIDX); const bf16* KIDX = (const bf16*)(F.ws + WS_KIDX); const float* WI = (const float*)(F.ws + WS_WI);
    const bf16* QABS = (const bf16*)(F.ws + WS_QABS); const bf16* CKV = (const bf16*)(F.ws + WS_CKV); bf16* CAT = (bf16*)(F.ws + WS_CAT);
    const bf16* WUVT = (const bf16*)(F.ws + WS_WUVT) + (size_t)l * 4 * 64 * 128; float* SS = (float*)(F.lds + DS_SS);
    for (int e = tid; e < 114 * 4; e += 512) RB[e] = PIN(F, I_RELB)[T5B[e >> 2] * 4 + (e & 3)] * 1.4426950408889634f;
    SYNC();
    for (int ui = F.bid; ui < BATCH * 128; ui += F.G) {
        int b, qt; { const int wv = ui & 255, k = ui >> 8, r = wv & 15; b = wv >> 4; qt = (k & 1) ? (32 * (k >> 1) + 31 - r) : (32 * (k >> 1) + r); }
        const int t0 = 32 * qt, nkt = 2 * qt + 2; const size_t mb = (size_t)b * SEQ;
        const int nt = w & 1;
        u32x2* sw = (u32x2*)(F.ws + (F.bid < 128 ? WS_QL + (size_t)F.bid * 262144 : WS_SCR2 + (size_t)(F.bid - 128) * 262144) + (size_t)w * 32768) + lane;
        bf16x8 Bq[8]; float wq[8];
        { const size_t mq = mb + t0 + 16 * nt + i16;
#pragma unroll
            for (int h = 0; h < 8; ++h) { Bq[h] = *(const bf16x8*)(QIDX + mq * 256 + 32 * h + 8 * g); wq[h] = WI[mq * 8 + h]; } }
        bf16x8 QS[2];
#pragma unroll
        for (int j = 0; j < 8; ++j) { float s = 0.f;
#pragma unroll
            for (int h = 0; h < 8; ++h) s += wq[h] * bf2f((unsigned)(unsigned short)Bq[h][j]);
            const unsigned hi = f2bf(s); QS[0][j] = (short)hi; QS[1][j] = (short)f2bf(s - bf2f(hi)); }
        for (int e = tid; e < 16 * NBIN; e += 512) HIST[e] = 0u;
        for (int e = tid; e < 32 * 128; e += 512) MASK[e] = 0u;
        if (tid < 32) NCAND[tid] = 0;
        SYNC();
        bf16x8 Apre = *(const bf16x8*)(KIDX + (mb + 16 * (w >> 1) + i16) * 32 + 8 * g);
        for (int kt = w >> 1; kt < nkt; kt += 4) {
            const bf16x8 A = Apre;
            { const int kn = kt + 4 < nkt ? kt + 4 : kt; Apre = *(const bf16x8*)(KIDX + (mb + 16 * kn + i16) * 32 + 8 * g); }
            const f32x4 sc = dsa_score_tile(A, QS, Bq, wq);
            unsigned cd[4];
#pragma unroll
            for (int r = 0; r < 4; ++r) cd[r] = score_code(sc[r] + 0.0f);
            { u32x2 pk; pk.x = cd[0] | (cd[1] << 16); pk.y = cd[2] | (cd[3] << 16); sw[(size_t)((kt - (w >> 1)) >> 2) * 64] = pk; }
            const unsigned inc = nt ? 65536u : 1u;
            if (kt < 2 * qt) {
#pragma unroll
                for (int r = 0; r < 4; ++r) atomicAdd(&HIST[i16 * NBIN + code_bin(cd[r])], inc);
            } else {
                const int t = t0 + 16 * nt + i16;
#pragma unroll
                for (int r = 0; r < 4; ++r) { const int s = 16 * kt + 4 * g + r;
                    if (s <= t) atomicAdd(&HIST[i16 * NBIN + code_bin(cd[r])], inc); }
            }
        }
        SYNC();
#pragma unroll 1
        for (int rr = 0; rr < 4; ++rr) {
            const int row = 4 * w + rr, t = t0 + row;
            if (t < 256) { if (lane == 0) { BST[row] = -1; NAB[row] = t + 1; } continue; }
            const int sh = (row >> 4) * 16; const unsigned* hp = HIST + (row & 15) * NBIN + 12 * lane;
            int cnt[12]; int tot = 0;
#pragma unroll
            for (int i = 0; i < 12; ++i) { cnt[i] = (int)((hp[i] >> sh) & 0xFFFFu); tot += cnt[i]; }
            int suf = tot;
#pragma unroll
            for (int o = 1; o < 64; o <<= 1) { const int v = SHFL_DOWN(suf, o); if (lane + o < 64) suf += v; }
            const int above = suf - tot;
            if (above < 256 && above + tot >= 256) {
                int run = above, bs = -1, na = 0; bool done = false;
#pragma unroll
                for (int i = 11; i >= 0; --i) { if (!done) { if (run + cnt[i] >= 256) { bs = 12 * lane + i; na = run; done = true; } else run += cnt[i]; } }
                BST[row] = bs; NAB[row] = na;
            }
        }
        SYNC();
        { const int row = 16 * nt + i16, t = t0 + row, bs = BST[row];
        const int ntl = nkt > (w >> 1) ? ((nkt - 1 - (w >> 1)) >> 2) + 1 : 0;
        u32x2 P0 = sw[0], P1 = sw[(size_t)(1 < ntl ? 1 : 0) * 64];
        for (int j = 0; j < ntl; ++j) { const int kt = (w >> 1) + 4 * j;
            const u32x2 pc = P0; P0 = P1; P1 = sw[(size_t)(j + 2 < ntl ? j + 2 : j) * 64];
            const bool full = kt < 2 * qt;
#pragma unroll
            for (int r = 0; r < 4; ++r) { const int s = 16 * kt + 4 * g + r;
                if (full || s <= t) { const unsigned wd = r < 2 ? pc.x : pc.y; const unsigned c = (r & 1) ? (wd >> 16) : (wd & 0xffffu); const int bn = code_bin(c);
                    if (bn > bs) atomicOr(&MASK[row * 128 + (s >> 5)], 1u << (s & 31));
                    else if (bn == bs) { const int pos = (int)atomicAdd((unsigned*)&NCAND[row], 1u); if (pos < CAND_CAP) CAND[row * CAND_CAP + pos] = (u32x2){code_key(c), (unsigned)s}; } } }
        } }
        SYNC();
#pragma unroll 1
        for (int rr = 0; rr < 4; ++rr) {
            const int row = 4 * w + rr; if (BST[row] < 0) continue;
            const int n = NCAND[row] < CAND_CAP ? NCAND[row] : CAND_CAP, need = 256 - NAB[row];
            for (int i = lane; i < n; i += 64) { const u32x2 me = CAND[row * CAND_CAP + i]; int rank = 0;
                for (int j = 0; j < n; ++j) { const u32x2 o = CAND[row * CAND_CAP + j]; rank += (o.x > me.x || (o.x == me.x && o.y < me.y)) ? 1 : 0; }
#ifndef DSA_DBG_NOCAND
                if (rank < need) atomicOr(&MASK[row * 128 + (me.y >> 5)], 1u << (me.y & 31));
#endif
            }
        }
        SYNC();
#ifdef DSA_DBG_SEL
        for (int e = tid; e < 32 * 128; e += 512) { const int row = e >> 7, wi = e & 127, t = t0 + row, lo = t - 255 < 0 ? 0 : t - 255; unsigned m = 0u;
            for (int bq = 0; bq < 32; ++bq) { const int s = 32 * wi + bq; if (s >= lo && s <= t) m |= 1u << bq; }
            MASK[e] = m; }
        SYNC();
#endif
#pragma unroll 1
        for (int rr = 0; rr < 4; ++rr) {
            const int row = 4 * w + rr;
            unsigned w0 = MASK[row * 128 + 2 * lane], w1 = MASK[row * 128 + 2 * lane + 1];
            const int c = __builtin_popcount(w0) + __builtin_popcount(w1);
            int inc = c;
#pragma unroll
            for (int o = 1; o < 64; o <<= 1) { const int v = SHFL_UP(inc, o); if (lane >= o) inc += v; }
            int pos = inc - c;
            while (w0) { const int bt = __builtin_ctz(w0); w0 &= w0 - 1; if (pos < 256) SELL[row * 256 + pos] = (unsigned short)(64 * lane + bt); ++pos; }
            while (w1) { const int bt = __builtin_ctz(w1); w1 &= w1 - 1; if (pos < 256) SELL[row * 256 + pos] = (unsigned short)(64 * lane + 32 + bt); ++pos; }
            if (lane == 63) NSEL[row] = inc < 256 ? inc : 256;
        }
        SYNC();
        bf16* TL = (bf16*)(F.lds + w * DS_SLOT); bf16* OLw = (bf16*)(F.lds + w * DS_SLOT + 8704);
#pragma unroll 1
        for (int rr = 0; rr < 4; ++rr) {
            const int row = 4 * w + rr, t = t0 + row, ns = UNI(NSEL[row]); const size_t mt = mb + t;
            const unsigned short* sl = SELL + row * 256;
            bf16x8 Bh[4];
#pragma unroll
            for (int ks = 0; ks < 4; ++ks) Bh[ks] = i16 < 4 ? *(const bf16x8*)(QABS + mt * 512 + i16 * 128 + 32 * ks + 8 * g) : (bf16x8){0, 0, 0, 0, 0, 0, 0, 0};
            f32x4 O[8];
#pragma unroll
            for (int nt = 0; nt < 8; ++nt) O[nt] = (f32x4){0.f, 0.f, 0.f, 0.f};
            float mrun = -1e30f, lrun = 0.f;
            const float bfar = RB[113 * 4 + (i16 & 3)];
            const int nch = (ns + 31) >> 5;
            u32x4 gvA[8];
#define ATT_LOAD(GV, CK, FULL) do { int sidx[8]; \
                _Pragma("unroll") for (int i = 0; i < 8; ++i) sidx[i] = (int)sl[32 * (CK) + 4 * i + g];            \
                _Pragma("unroll") for (int i = 0; i < 8; ++i) { const int kp = 32 * (CK) + 4 * i + g; sidx[i] = (FULL || kp < ns) ? sidx[i] : 0; } \
                _Pragma("unroll") for (int i = 0; i < 8; ++i) GV[i] = *(const u32x4*)(CKV + (mb + sidx[i]) * 128 + 8 * i16); } while (0)
#define ATT_STEP(GV, CK, FULL) do { const int ck = (CK); \
                _Pragma("unroll") for (int i = 0; i < 8; ++i) *(u32x4*)(TL + (4 * i + g) * 136 + 8 * i16) = GV[i]; \
                const u32x2 sk0 = *(const u32x2*)(sl + 32 * ck + 4 * g), sk1 = *(const u32x2*)(sl + 32 * ck + 16 + 4 * g); \
                WAVE_LDS_FENCE(); \
                if (ck + 1 < nch) ATT_LOAD(GV, ck + 1, FULL); \
                float bia[2][4]; \
                if (FULL && t - UNI((int)sl[32 * ck + 31]) >= 113) {                   \
                _Pragma("unroll") for (int kt = 0; kt < 2; ++kt) \
                _Pragma("unroll") for (int r = 0; r < 4; ++r) bia[kt][r] = bfar; \
                } else { \
                _Pragma("unroll") for (int kt = 0; kt < 2; ++kt) \
                _Pragma("unroll") for (int r = 0; r < 4; ++r) { const unsigned wd = kt ? (r < 2 ? sk1.x : sk1.y) : (r < 2 ? sk0.x : sk0.y); \
                        int dist = t - (int)((wd >> (16 * (r & 1))) & 0xffffu); dist = dist < 0 ? 0 : (dist > 113 ? 113 : dist); \
                        bia[kt][r] = RB[dist * 4 + (i16 & 3)]; } } \
                f32x4 lg[2]; \
                _Pragma("unroll") for (int kt = 0; kt < 2; ++kt) { lg[kt] = (f32x4){0.f, 0.f, 0.f, 0.f}; \
                _Pragma("unroll") for (int ks = 0; ks < 4; ++ks) lg[kt] = MFMA16(*(const bf16x8*)(TL + (16 * kt + i16) * 136 + 32 * ks + 8 * g), Bh[ks], lg[kt]); } \
                float cm = -1e30f; \
                _Pragma("unroll") for (int kt = 0; kt < 2; ++kt) \
                _Pragma("unroll") for (int r = 0; r < 4; ++r) { const int kp = 32 * ck + 16 * kt + 4 * g + r; \
                        lg[kt][r] = (FULL || kp < ns) ? lg[kt][r] + bia[kt][r] : -1e30f; cm = fmaxf(cm, lg[kt][r]); } \
                if (ck == 0) { cm = fmaxf(cm, SHFL_XOR(cm, 16)); cm = fmaxf(cm, SHFL_XOR(cm, 32)); mrun = cm; } \
                float p[2][4]; \
                _Pragma("unroll") for (int kt = 0; kt < 2; ++kt) \
                _Pragma("unroll") for (int r = 0; r < 4; ++r) { p[kt][r] = (FULL || lg[kt][r] > -1e29f) ? FEXP2(lg[kt][r] - mrun) : 0.f; lrun += p[kt][r]; } \
                u32x4 aw = (u32x4){0u, 0u, 0u, 0u}; \
                if (i16 < 4) aw = (u32x4){pk2(p[0][0], p[0][1]), pk2(p[0][2], p[0][3]), pk2(p[1][0], p[1][1]), pk2(p[1][2], p[1][3])}; \
                const bf16x8 A = __builtin_bit_cast(bf16x8, aw); \
                _Pragma("unroll") for (int nt = 0; nt < 8; ++nt) { \
                    const s16x4 lo = TR16(TL + (4 * g + (i16 >> 2)) * 136 + 16 * nt + 4 * (i16 & 3)); \
                    const s16x4 hi = TR16(TL + (16 + 4 * g + (i16 >> 2)) * 136 + 16 * nt + 4 * (i16 & 3)); \
                    const bf16x8 B = (bf16x8){lo[0], lo[1], lo[2], lo[3], hi[0], hi[1], hi[2], hi[3]}; \
                    O[nt] = MFMA16(A, B, O[nt]); } \
                WAVE_LDS_FENCE(); } while (0)
            if (ns == 256) { ATT_LOAD(gvA, 0, true); for (int ck2 = 0; ck2 < 8; ++ck2) ATT_STEP(gvA, ck2, true); }
            else { ATT_LOAD(gvA, 0, false); for (int ck2 = 0; ck2 < nch; ++ck2) ATT_STEP(gvA, ck2, false); }
#undef ATT_STEP
#undef ATT_LOAD
            lrun += SHFL_XOR(lrun, 16); lrun += SHFL_XOR(lrun, 32);
            float li[4];
#pragma unroll
            for (int r = 0; r < 4; ++r) li[r] = FRCP(SHFL(lrun, r));
            if (g == 0) {
#pragma unroll
                for (int nt = 0; nt < 8; ++nt)
#pragma unroll
                    for (int r = 0; r < 4; ++r) OLw[(rr * 4 + r) * 128 + 16 * nt + i16] = (bf16)f2bf(O[nt][r] * li[r]);
            }
        }
        SYNC();
        {
            const int h = w >> 1, mtile = w & 1, q = 16 * mtile + i16;
            const bf16* olq = (const bf16*)(F.lds + (q >> 2) * DS_SLOT + 8704) + ((q & 3) * 4 + h) * 128;
            float gaw[4];
#pragma unroll
            for (int nt = 0; nt < 4; ++nt) gaw[nt] = PIN(F, I_GNW)[l * DM + 768 + h * 64 + 16 * nt + i16];
            f32x4 acc[4];
#pragma unroll
            for (int nt = 0; nt < 4; ++nt) acc[nt] = (f32x4){0.f, 0.f, 0.f, 0.f};
#pragma unroll
            for (int ks = 0; ks < 4; ++ks) { const bf16x8 A = *(const bf16x8*)(olq + 32 * ks + 8 * g);
#pragma unroll
                for (int nt = 0; nt < 4; ++nt) acc[nt] = MFMA16(A, *(const bf16x8*)(WUVT + ((size_t)(h * 64 + 16 * nt + i16)) * 128 + 32 * ks + 8 * g), acc[nt]); }
#pragma unroll
            for (int r = 0; r < 4; ++r) { float s = (acc[0][r] * acc[0][r] + acc[1][r] * acc[1][r]) + (acc[2][r] * acc[2][r] + acc[3][r] * acc[3][r]);
                s += SHFL_XOR(s, 1); s += SHFL_XOR(s, 2); s += SHFL_XOR(s, 4); s += SHFL_XOR(s, 8);
                if (i16 == 0) SS[(16 * mtile + 4 * g + r) * 4 + h] = s; }
            SYNC();
#pragma unroll
            for (int r = 0; r < 4; ++r) { const int qq = 16 * mtile + 4 * g + r; const f32x4 s4 = *(const f32x4*)(SS + qq * 4);
                const float rs = RSQ(((s4.x + s4.y) + (s4.z + s4.w)) * (1.0f / 256.0f) + NORM_EPS);
                bf16* dst = CAT + (mb + t0 + qq) * DM + 768 + h * 64 + i16;
#pragma unroll
                for (int nt = 0; nt < 4; ++nt) dst[16 * nt] = (bf16)f2bf(acc[nt][r] * rs * gaw[nt]); }
        }
        SYNC();
    }
}
#ifndef HOST_EMU
namespace pg8 {
#define PG8_LAS __attribute__((address_space(3)))
typedef unsigned short bf16_t;
typedef short bf16x8 __attribute__((ext_vector_type(8)));
typedef float f32x4 __attribute__((ext_vector_type(4)));
typedef unsigned u32x4 __attribute__((ext_vector_type(4)));
constexpr int BM = 256, BK = 64, HALF = 128, HTB = HALF * BK * 2  , STAGE_BYTES = 8 * HTB, NXCD = 8, WGM = 8;

__host__ __device__ __forceinline__ int lds_byte(int r, int c) { const int st = (r >> 4) * 2 + (c >> 5), rr = r & 15, cc = c & 31, ob = rr * 64 + cc * 2; return st * 1024 + (ob ^ (((ob >> 9) & 1) << 5)); }
__host__ __device__ __forceinline__ void stage_rc(int b, int& R, int& C) { const int st = b / 1024, sb = b % 1024, swz = sb ^ (((sb >> 9) & 1) << 5); R = (st >> 1) * 16 + swz / 64; C = (st & 1) * 32 + (swz % 64) / 2; }
__host__ __device__ __forceinline__ int perm32(int rho) { const int n = rho >> 4, i = rho & 15; return 8 * (i >> 2) + 4 * n + (i & 3); }

struct Unit { int pm, pn; };
struct Gemm { const bf16_t* A; const bf16_t* Bt; int M, N, K; };

struct StaticOrder {
    int nM, nN, nwg, G, c;
    __host__ __device__ void init(int M, int N, int G_, int c_) { nM = M / BM; nN = N / BM; nwg = nM * nN; G = G_; c = c_; }
    __host__ __device__ bool next(int i, Unit& u) const {
        const long L = (long)i * G + c; if (L >= nwg) return false;
        int wgid = (int)L; { const int q = nwg / NXCD, r = nwg % NXCD, xcd = wgid % NXCD, off = wgid / NXCD; wgid = (xcd < r ? xcd * (q + 1) : r * (q + 1) + (xcd - r) * q) + off; }
        const int nig = WGM * nN, gid = wgid / nig, fm = gid * WGM, gsz = (nM - fm) < WGM ? (nM - fm) : WGM;
        u.pm = fm + ((wgid % nig) % gsz); u.pn = (wgid % nig) / gsz; return true;
    }
    __device__ __forceinline__ void a_ready(const Unit&) const {}
    __device__ __forceinline__ void done(const Unit&) const {}
};
__device__ __forceinline__ unsigned cvt_pk_bf16(float lo, float hi) { unsigned r; asm volatile("v_cvt_pk_bf16_f32 %0, %1, %2" : "=v"(r) : "v"(lo), "v"(hi)); return r; }
template <class Epi, class Sched, bool ALIGN_EPI = false, bool SP2 = false>
__device__ __forceinline__ void gemm_phase(PG8_LAS unsigned char* lds, const Gemm g, const Sched& S, const Epi& E, const int tid_in) {
    const int tid = tid_in, wid = __builtin_amdgcn_readfirstlane(tid >> 6), lane = tid & 63, wr = wid >> 2, wc = wid & 3, fr = lane & 15, fq = lane >> 4;
    const int K = g.K, nt = K / BK;
    unsigned voffA[2], voffB[2];
#pragma unroll
    for (int i = 0; i < 2; ++i) { int R, C; stage_rc(tid * 16 + i * 8192, R, C); const int Rb = Epi::PERM ? ((R & ~31) + perm32(R & 31)) : R;
        voffA[i] = (unsigned)(R * K + C) * 2u; voffB[i] = (unsigned)(Rb * K + C) * 2u; }
    const size_t kstep = (size_t)(BK * 2);
    const size_t hstep = (size_t)HALF * K * 2;
    const size_t tstep = 2 * hstep;
    const unsigned ldsw = (unsigned)wid * 1024u;
    const int aoff = lds_byte(wr * 64 + fr, fq * 8), boff = lds_byte(wc * 32 + fr, fq * 8);
#define PG8_SA(b, h) (((b) * 2 + (h)) * HTB)
#define PG8_SB(b, h) ((4 + (b) * 2 + (h)) * HTB)
#define PG8_STAGE(bufoff, gbase, voff) do { _Pragma("unroll") for (int _i = 0; _i < 2; ++_i) \
        __builtin_amdgcn_global_load_lds((const unsigned*)((const char*)(gbase) + (voff)[_i]), (PG8_LAS unsigned*)(lds + (bufoff) + ldsw + _i * 8192), 16, 0, 0); } while (0)
#define PG8_LDA(dst, b, h) do { _Pragma("unroll") for (int m = 0; m < 4; ++m) _Pragma("unroll") for (int k = 0; k < 2; ++k) dst[m][k] = *(const PG8_LAS bf16x8*)(lds + PG8_SA(b, h) + aoff + m * 2048 + k * 1024); } while (0)
#define PG8_LDB(dst, b, h) do { _Pragma("unroll") for (int n = 0; n < 2; ++n) _Pragma("unroll") for (int k = 0; k < 2; ++k) dst[n][k] = *(const PG8_LAS bf16x8*)(lds + PG8_SB(b, h) + boff + n * 2048 + k * 1024); } while (0)
#define PG8_MMA(ai, bj, At, Bt) do { __builtin_amdgcn_s_setprio(1); _Pragma("unroll") for (int m = 0; m < 4; ++m) _Pragma("unroll") for (int n = 0; n < 2; ++n) _Pragma("unroll") for (int k = 0; k < 2; ++k) \
        acc[ai][bj][m][n] = __builtin_amdgcn_mfma_f32_16x16x32_bf16(Bt[n][k], At[m][k], acc[ai][bj][m][n], 0, 0, 0); __builtin_amdgcn_s_setprio(0); } while (0)
#define PG8_WAIT_V(n) asm volatile("s_waitcnt vmcnt(" #n ")" ::: "memory")
#define PG8_WAIT_L(n) asm volatile("s_waitcnt lgkmcnt(" #n ")" ::: "memory")
#define PG8_BAR __builtin_amdgcn_s_barrier()
#define PG8_SCHED __builtin_amdgcn_sched_barrier(0)
    Unit cur, nxt; int ui = 0;
    if (!S.next(0, cur)) return;
    f32x4 acc[2][2][4][2];
#pragma unroll
    for (int a = 0; a < 2; ++a)
#pragma unroll
        for (int b = 0; b < 2; ++b)
#pragma unroll
            for (int m = 0; m < 4; ++m)
#pragma unroll
                for (int n = 0; n < 2; ++n) acc[a][b][m][n] = (f32x4){0.f, 0.f, 0.f, 0.f};
    bf16x8 At[4][2], B0[2][2], B1[2][2];
    const char* cA = (const char*)g.A + (size_t)cur.pm * tstep; const char* cB = (const char*)g.Bt + (size_t)cur.pn * tstep;
    S.a_ready(cur);
    if constexpr (SP2) {
        PG8_STAGE(PG8_SB(0, 0), cB, voffB); PG8_STAGE(PG8_SB(0, 1), cB + hstep, voffB); PG8_STAGE(PG8_SA(0, 0), cA, voffA); PG8_STAGE(PG8_SA(0, 1), cA + hstep, voffA);
        if (wr == 1) PG8_BAR;
        PG8_WAIT_V(2); PG8_BAR;
        PG8_STAGE(PG8_SB(1, 0), cB + kstep, voffB); PG8_STAGE(PG8_SA(1, 0), cA + kstep, voffA); PG8_STAGE(PG8_SB(1, 1), cB + hstep + kstep, voffB);
        PG8_WAIT_V(6); PG8_BAR;
    } else {
        PG8_STAGE(PG8_SB(0, 0), cB, voffB); PG8_STAGE(PG8_SA(0, 0), cA, voffA); PG8_STAGE(PG8_SB(0, 1), cB + hstep, voffB); PG8_STAGE(PG8_SA(0, 1), cA + hstep, voffA);
        if (wr == 1) PG8_BAR;
        PG8_WAIT_V(4); PG8_BAR;
        PG8_STAGE(PG8_SB(1, 0), cB + kstep, voffB); PG8_STAGE(PG8_SA(1, 0), cA + kstep, voffA); PG8_STAGE(PG8_SB(1, 1), cB + hstep + kstep, voffB);
        PG8_WAIT_V(6); PG8_BAR;
    }
    for (;;) {
        const bool has_next = S.next(ui + 1, nxt);
        const char* nA = has_next ? (const char*)g.A + (size_t)nxt.pm * tstep : cA; const char* nB = has_next ? (const char*)g.Bt + (size_t)nxt.pn * tstep : cB;
#pragma unroll 1
        for (int t = 0; t < nt; t += 2) {
            const bool last = (t == nt - 2);
            const char* a1 = cA + (size_t)(t + 1) * kstep;
            const char* a2 = last ? nA : cA + (size_t)(t + 2) * kstep; const char* b2 = last ? nB : cB + (size_t)(t + 2) * kstep;
            const char* a3 = a2 + kstep; const char* b3 = b2 + kstep;
            if (last && has_next) S.a_ready(nxt);
            if constexpr (Epi::NORM) { if (t == 2) E.prefetch(cur, tid, wid); if (t == 4) E.reduce_rs(tid); }
            if constexpr (SP2) {
            PG8_LDB(B0, 0, 0); PG8_LDB(B1, 0, 1); PG8_SCHED; PG8_LDA(At, 0, 0); PG8_STAGE(PG8_SA(1, 1), a1 + hstep, voffA);
            PG8_WAIT_V(8); PG8_WAIT_L(0); PG8_BAR; PG8_MMA(0, 0, At, B0); PG8_MMA(0, 1, At, B1); PG8_BAR; PG8_SCHED;
            PG8_LDA(At, 0, 1); PG8_STAGE(PG8_SB(0, 0), b2, voffB); PG8_STAGE(PG8_SB(0, 1), b2 + hstep, voffB); PG8_STAGE(PG8_SA(0, 0), a2, voffA);
            PG8_WAIT_V(8); PG8_WAIT_L(0); PG8_BAR; PG8_MMA(1, 0, At, B0); PG8_MMA(1, 1, At, B1); PG8_BAR; PG8_SCHED;
            PG8_LDB(B0, 1, 0); PG8_LDB(B1, 1, 1); PG8_SCHED; PG8_LDA(At, 1, 0); PG8_STAGE(PG8_SA(0, 1), a2 + hstep, voffA);
            PG8_WAIT_V(8); PG8_WAIT_L(0); PG8_BAR; PG8_MMA(0, 0, At, B0); PG8_MMA(0, 1, At, B1); PG8_BAR; PG8_SCHED;
            PG8_LDA(At, 1, 1); PG8_STAGE(PG8_SB(1, 0), b3, voffB); PG8_STAGE(PG8_SB(1, 1), b3 + hstep, voffB); PG8_STAGE(PG8_SA(1, 0), a3, voffA);
            PG8_WAIT_V(8); PG8_WAIT_L(0); PG8_BAR; PG8_MMA(1, 0, At, B0); PG8_MMA(1, 1, At, B1); PG8_BAR; PG8_SCHED;
            } else {
            PG8_LDB(B0, 0, 0); PG8_SCHED; PG8_LDA(At, 0, 0); PG8_STAGE(PG8_SA(1, 1), a1 + hstep, voffA);
            PG8_WAIT_L(8); PG8_BAR; PG8_WAIT_L(0); PG8_MMA(0, 0, At, B0); PG8_BAR; PG8_SCHED;
            PG8_LDB(B1, 0, 1); PG8_STAGE(PG8_SB(0, 0), b2, voffB);
            PG8_BAR; PG8_WAIT_L(0); PG8_MMA(0, 1, At, B1); PG8_BAR;
            PG8_LDA(At, 0, 1); PG8_STAGE(PG8_SA(0, 0), a2, voffA);
            PG8_BAR; PG8_WAIT_L(0); PG8_MMA(1, 0, At, B0); PG8_BAR; PG8_SCHED;
            PG8_STAGE(PG8_SB(0, 1), b2 + hstep, voffB);
            PG8_WAIT_V(6); PG8_BAR; PG8_MMA(1, 1, At, B1); PG8_BAR;
            PG8_LDB(B0, 1, 0); PG8_SCHED; PG8_LDA(At, 1, 0); PG8_STAGE(PG8_SA(0, 1), a2 + hstep, voffA);
            PG8_WAIT_L(8); PG8_BAR; PG8_WAIT_L(0); PG8_MMA(0, 0, At, B0); PG8_BAR; PG8_SCHED;
            PG8_LDB(B1, 1, 1); PG8_STAGE(PG8_SB(1, 0), b3, voffB);
            PG8_BAR; PG8_WAIT_L(0); PG8_MMA(0, 1, At, B1); PG8_BAR;
            PG8_LDA(At, 1, 1); PG8_STAGE(PG8_SA(1, 0), a3, voffA);
            PG8_BAR; PG8_WAIT_L(0); PG8_MMA(1, 0, At, B0); PG8_BAR; PG8_SCHED;
            PG8_STAGE(PG8_SB(1, 1), b3 + hstep, voffB);
            PG8_WAIT_V(6); PG8_BAR; PG8_MMA(1, 1, At, B1); PG8_BAR;
            }
        }
        if constexpr (ALIGN_EPI) { if (wr == 0) PG8_BAR; }
        if constexpr (!Epi::AFTER_DRAIN) { E(acc, cur, wr, wc, fr, fq); S.done(cur); }
        if (!has_next) break;
#pragma unroll
        for (int a = 0; a < 2; ++a)
#pragma unroll
            for (int b = 0; b < 2; ++b)
#pragma unroll
                for (int m = 0; m < 4; ++m)
#pragma unroll
                    for (int n = 0; n < 2; ++n) acc[a][b][m][n] = (f32x4){0.f, 0.f, 0.f, 0.f};
        cur = nxt; cA = nA; cB = nB; ++ui;
        if constexpr (ALIGN_EPI) { if (wr == 1) PG8_BAR; }
    }
    PG8_WAIT_V(0);
    if constexpr (!ALIGN_EPI) { if (wr == 0) PG8_BAR; }
    PG8_BAR;
    if constexpr (Epi::AFTER_DRAIN) { E.fused(acc, cur, wr, wc, fr, fq, lds, wid, lane); S.done(cur); }
#undef PG8_SA
#undef PG8_SB
#undef PG8_STAGE
#undef PG8_LDA
#undef PG8_LDB
#undef PG8_MMA
#undef PG8_WAIT_V
#undef PG8_WAIT_L
#undef PG8_BAR
#undef PG8_SCHED
}
}
namespace pg8 {
template <int ACT  > struct EpiRoute {
    static constexpr bool PERM = true, AFTER_DRAIN = false, NORM = false;
    bf16_t* O0; int ld0; bf16_t* O1; int ld1; int split;
    __device__ __forceinline__ void operator()(const f32x4 (&acc)[2][2][4][2], const Unit& u, int wr, int wc, int fr, int fq) const {
        const int row0 = u.pm * BM + wr * 64 + fr; const bool first = u.pn < split;
        bf16_t* base = first ? O0 : O1; const int ld = first ? ld0 : ld1; const int col0 = (first ? u.pn : u.pn - split) * BM + wc * 32 + 8 * fq;
#pragma unroll
        for (int ai = 0; ai < 2; ++ai)
#pragma unroll
            for (int m = 0; m < 4; ++m) { bf16_t* rowp = base + (size_t)(row0 + ai * HALF + m * 16) * ld + col0;
#pragma unroll
                for (int bj = 0; bj < 2; ++bj) { f32x4 v0 = acc[ai][bj][m][0], v1 = acc[ai][bj][m][1];
                    if (ACT == 1) {
#pragma unroll
                        for (int e = 0; e < 4; ++e) { const float a = fmaxf(v0[e], 0.f), b = fmaxf(v1[e], 0.f); v0[e] = a * a; v1[e] = b * b; } }
                    u32x4 w; w.x = cvt_pk_bf16(v0[0], v0[1]); w.y = cvt_pk_bf16(v0[2], v0[3]); w.z = cvt_pk_bf16(v1[0], v1[1]); w.w = cvt_pk_bf16(v1[2], v1[3]);
                    *(u32x4*)(rowp + bj * HALF) = w; } }
    }
};
struct EpiResid {
    static constexpr bool PERM = true, AFTER_DRAIN = false, NORM = false;
    const float* xsrc; float* xdst; const float* gate;
    __device__ __forceinline__ void operator()(const f32x4 (&acc)[2][2][4][2], const Unit& u, int wr, int wc, int fr, int fq) const {
        const int row0 = u.pm * BM + wr * 64 + fr, col0 = u.pn * BM + wc * 32 + 8 * fq, b = (u.pm * BM) >> 12;
        f32x4 gv[2][2];
#pragma unroll
        for (int bj = 0; bj < 2; ++bj)
#pragma unroll
            for (int n = 0; n < 2; ++n) gv[bj][n] = *(const f32x4*)(gate + (size_t)b * 6144 + col0 + bj * HALF + 4 * n);
#pragma unroll
        for (int ai = 0; ai < 2; ++ai)
#pragma unroll
            for (int m = 0; m < 4; ++m) { const size_t off = (size_t)(row0 + ai * HALF + m * 16) * 1024 + col0;
#pragma unroll
                for (int bj = 0; bj < 2; ++bj)
#pragma unroll
                    for (int n = 0; n < 2; ++n) { const f32x4 xs = *(const f32x4*)(xsrc + off + bj * HALF + 4 * n);
                        *(f32x4*)(xdst + off + bj * HALF + 4 * n) = xs + gv[bj][n] * acc[ai][bj][m][n]; }
                if (m & 1) asm volatile("" ::: "memory"); }
    }
};
constexpr int EPI_OFF = 133120;
template <int ACT  > struct EpiRouteN {
    static constexpr bool PERM = true, AFTER_DRAIN = false, NORM = true;
    bf16_t* O; int ld; const float* RSP; const float* shw; PG8_LAS unsigned char* lds;
    __device__ __forceinline__ void prefetch(const Unit& u, int tid, int wid) const {
        const char* src = (const char*)RSP + (size_t)u.pm * (BM * 64) + (size_t)tid * 16;
#pragma unroll
        for (int i = 0; i < 2; ++i) __builtin_amdgcn_global_load_lds((const unsigned*)(src + i * 8192), (PG8_LAS unsigned*)(lds + EPI_OFF + wid * 1024 + i * 8192), 16, 0, 0);
        if (wid == 0) { const char* s2 = (const char*)(shw + (size_t)((u.pm * BM) >> 12) * NSHW + u.pn * BM) + (size_t)(tid & 63) * 16;
            __builtin_amdgcn_global_load_lds((const unsigned*)s2, (PG8_LAS unsigned*)(lds + EPI_OFF + 16384), 16, 0, 0); }
    }
    __device__ __forceinline__ void reduce_rs(int tid) const {
        if (tid < 256) { const PG8_LAS f32x4* p = (const PG8_LAS f32x4*)(lds + EPI_OFF + tid * 64); const f32x4 a = p[0], b = p[1], c = p[2], d = p[3];
            const float s = (((a.x + a.y) + (a.z + a.w)) + ((b.x + b.y) + (b.z + b.w))) + (((c.x + c.y) + (c.z + c.w)) + ((d.x + d.y) + (d.z + d.w)));
            *(PG8_LAS float*)(lds + EPI_OFF + 17408 + tid * 4) = __builtin_amdgcn_rsqf(s * (1.0f / 1024.0f) + 1e-6f); }
    }
    __device__ __forceinline__ void operator()(const f32x4 (&acc)[2][2][4][2], const Unit& u, int wr, int wc, int fr, int fq) const {
        const int row0 = u.pm * BM + wr * 64 + fr, col0 = u.pn * BM + wc * 32 + 8 * fq;
        const PG8_LAS unsigned char* ep = lds + EPI_OFF;
        float rs[2][4];
#pragma unroll
        for (int ai = 0; ai < 2; ++ai)
#pragma unroll
            for (int m = 0; m < 4; ++m) rs[ai][m] = *(const PG8_LAS float*)(ep + 17408 + (wr * 64 + fr + ai * HALF + m * 16) * 4);
        f32x4 sv[2][2];
#pragma unroll
        for (int bj = 0; bj < 2; ++bj)
#pragma unroll
            for (int n = 0; n < 2; ++n) sv[bj][n] = *(const PG8_LAS f32x4*)(ep + 16384 + (bj * HALF + wc * 32 + 8 * fq + 4 * n) * 4);
#pragma unroll
        for (int ai = 0; ai < 2; ++ai)
#pragma unroll
            for (int m = 0; m < 4; ++m) { bf16_t* rowp = O + (size_t)(row0 + ai * HALF + m * 16) * ld + col0;
#pragma unroll
                for (int bj = 0; bj < 2; ++bj) { f32x4 v0 = acc[ai][bj][m][0] * rs[ai][m] + sv[bj][0], v1 = acc[ai][bj][m][1] * rs[ai][m] + sv[bj][1];
                    if (ACT == 1) {
#pragma unroll
                        for (int e = 0; e < 4; ++e) { const float a = fmaxf(v0[e], 0.f), b = fmaxf(v1[e], 0.f); v0[e] = a * a; v1[e] = b * b; } }
                    u32x4 w; w.x = cvt_pk_bf16(v0[0], v0[1]); w.y = cvt_pk_bf16(v0[2], v0[3]); w.z = cvt_pk_bf16(v1[0], v1[1]); w.w = cvt_pk_bf16(v1[2], v1[3]);
                    *(u32x4*)(rowp + bj * HALF) = w; } }
    }
};
template <bool SRCF, bool DSTF> struct EpiResidXS {
    static constexpr bool PERM = true, AFTER_DRAIN = false, NORM = false;
    const void* xsrc; void* xdst; const float* gate; const float* wp; bf16_t* XS; float* RSP; int doxs, srcf32, dstf32;
    __device__ __forceinline__ void operator()(const f32x4 (&acc)[2][2][4][2], const Unit& u, int wr, int wc, int fr, int fq) const {
        const int row0 = u.pm * BM + wr * 64 + fr, col0 = u.pn * BM + wc * 32 + 8 * fq, b = (u.pm * BM) >> 12;
        f32x4 gv[2][2], wv[2][2]; float ssv[2][4];
#pragma unroll
        for (int bj = 0; bj < 2; ++bj)
#pragma unroll
            for (int n = 0; n < 2; ++n) { gv[bj][n] = *(const f32x4*)(gate + (size_t)b * 6144 + col0 + bj * HALF + 4 * n);
                wv[bj][n] = doxs ? *(const f32x4*)(wp + (size_t)b * 1024 + col0 + bj * HALF + 4 * n) : (f32x4){0.f, 0.f, 0.f, 0.f}; }
#pragma unroll
        for (int ai = 0; ai < 2; ++ai)
#pragma unroll
            for (int m = 0; m < 4; ++m) { const int row = row0 + ai * HALF + m * 16; const size_t off = (size_t)row * 1024 + col0; float ss = 0.f;
#pragma unroll
                for (int bj = 0; bj < 2; ++bj) { f32x4 x0, x1;
                    if (SRCF && srcf32) { x0 = *(const f32x4*)((const float*)xsrc + off + bj * HALF); x1 = *(const f32x4*)((const float*)xsrc + off + bj * HALF + 4); }
                    else { const u32x4 r = *(const u32x4*)((const bf16_t*)xsrc + off + bj * HALF);
                        x0 = (f32x4){bflo(r.x), bfhi(r.x), bflo(r.y), bfhi(r.y)}; x1 = (f32x4){bflo(r.z), bfhi(r.z), bflo(r.w), bfhi(r.w)}; }
                    const f32x4 y0 = x0 + gv[bj][0] * acc[ai][bj][m][0], y1 = x1 + gv[bj][1] * acc[ai][bj][m][1];
                    ss += ((y0.x * y0.x + y0.y * y0.y) + (y0.z * y0.z + y0.w * y0.w)) + ((y1.x * y1.x + y1.y * y1.y) + (y1.z * y1.z + y1.w * y1.w));
                    if (DSTF && dstf32) { *(f32x4*)((float*)xdst + off + bj * HALF) = y0; *(f32x4*)((float*)xdst + off + bj * HALF + 4) = y1; }
                    else { u32x4 w; w.x = cvt_pk_bf16(y0[0], y0[1]); w.y = cvt_pk_bf16(y0[2], y0[3]); w.z = cvt_pk_bf16(y1[0], y1[1]); w.w = cvt_pk_bf16(y1[2], y1[3]);
                        *(u32x4*)((bf16_t*)xdst + off + bj * HALF) = w; }
                    if (doxs) { const f32x4 a = y0 * wv[bj][0], c = y1 * wv[bj][1];
                        u32x4 w; w.x = cvt_pk_bf16(a[0], a[1]); w.y = cvt_pk_bf16(a[2], a[3]); w.z = cvt_pk_bf16(c[0], c[1]); w.w = cvt_pk_bf16(c[2], c[3]);
                        *(u32x4*)(XS + off + bj * HALF) = w; } }
                ssv[ai][m] = ss;
                if (m & 1) asm volatile("" ::: "memory"); }
        if (doxs) { float t1[2][4];
#pragma unroll
            for (int ai = 0; ai < 2; ++ai)
#pragma unroll
                for (int m = 0; m < 4; ++m) t1[ai][m] = __shfl_xor(ssv[ai][m], 16);
#pragma unroll
            for (int ai = 0; ai < 2; ++ai)
#pragma unroll
                for (int m = 0; m < 4; ++m) { ssv[ai][m] += t1[ai][m]; t1[ai][m] = __shfl_xor(ssv[ai][m], 32); }
            if (fq == 0) {
#pragma unroll
                for (int ai = 0; ai < 2; ++ai)
#pragma unroll
                    for (int m = 0; m < 4; ++m) RSP[(size_t)(row0 + ai * HALF + m * 16) * 16 + u.pn * 4 + wc] = ssv[ai][m] + t1[ai][m]; } }
    }
};
}

#define RLX_AGENT __ATOMIC_RELAXED, __HIP_MEMORY_SCOPE_AGENT
#define XB_TMO      128
#define XB_XCNT(j)  (256  + 64 * (j))
#define XB_XSUB(j)  (1280 + 64 * (j))
#define XB_XGEN(j)  (2304 + 64 * (j))
#define XB_TOP      3328
#define XB_TOPGEN   3392
#define XCD_BAR_WORDS 3456
#define XB_SPIN_CAP (1u << 24)

__device__ __forceinline__ unsigned xb_ld(unsigned* p)              { return __hip_atomic_load(p, __ATOMIC_RELAXED, __HIP_MEMORY_SCOPE_AGENT); }
__device__ __forceinline__ unsigned xb_add(unsigned* p, unsigned v) { return __hip_atomic_fetch_add(p, v, __ATOMIC_RELAXED, __HIP_MEMORY_SCOPE_AGENT); }
__device__ __forceinline__ unsigned xb_xcc_id() { return (unsigned)__builtin_amdgcn_s_getreg((3 << 11) | 20) & 0xFu; }
#define XB_SPIN(cond, bar) do { unsigned _sp = 0; while (cond) { __builtin_amdgcn_s_sleep(1); \
    if ((++_sp & 255u) == 0u) { if (xb_ld(&(bar)[XB_TMO])) break; if (_sp > XB_SPIN_CAP) { atomicAdd(&(bar)[XB_TMO], 1u); break; } } } } while (0)

struct XcdBarrier {
    unsigned* bar; unsigned x;
    volatile LAS unsigned* st;
};

__device__ __forceinline__ XcdBarrier xcd_barrier_post(unsigned* bar, volatile LAS unsigned* st) {
    XcdBarrier b; b.bar = bar; b.x = xb_xcc_id(); b.st = st;
    if (threadIdx.x == 0) (void)xb_add(&bar[XB_XCNT(b.x)], 1u);
    return b;
}
__device__ __forceinline__ void xcd_barrier_complete(unsigned* bar, unsigned x, unsigned& nloc, unsigned& nx) {
    const unsigned G = gridDim.x * gridDim.y * gridDim.z;
    unsigned sum, cnt, mine, sp = 0u;
    for (;;) {
        sum = 0u; cnt = 0u; mine = 0u;
#pragma unroll
        for (unsigned j = 0; j < 16; ++j) { const unsigned c = xb_ld(&bar[XB_XCNT(j)]); sum += c; cnt += (c > 0u) ? 1u : 0u; mine = (j == x) ? c : mine; }
        if (sum == G) break;
        __builtin_amdgcn_s_sleep(1);
        if ((++sp & 255u) == 0u) { if (xb_ld(&bar[XB_TMO])) break; if (sp > XB_SPIN_CAP) { atomicAdd(&bar[XB_TMO], 1u); break; } }
    }
    nloc = mine > 0u ? mine : 1u; nx = cnt > 0u ? cnt : 1u;
}

__device__ __forceinline__ void xcd_barrier(const XcdBarrier& b) {
    asm volatile("s_waitcnt vmcnt(0)" ::: "memory");
    __syncthreads();
    if (threadIdx.x == 0) {
        unsigned* bar = b.bar;
        __builtin_amdgcn_s_waitcnt(0);
        unsigned nloc = b.st[0], nx = b.st[1];
        if (nloc == 0u) { xcd_barrier_complete(bar, b.x, nloc, nx); b.st[0] = nloc; b.st[1] = nx; }
        const unsigned old = xb_add(&bar[XB_XSUB(b.x)], 1u);
        const unsigned gen = old / nloc;
        if (old + 1u == (gen + 1u) * nloc) {
            __builtin_amdgcn_fence(__ATOMIC_RELEASE, "agent");
            asm volatile("s_waitcnt vmcnt(0)" ::: "memory");
            const unsigned og = xb_add(&bar[XB_TOP], 1u);
            const unsigned tg = og / nx;
            if (og + 1u == (tg + 1u) * nx) xb_add(&bar[XB_TOPGEN], 1u);
            else XB_SPIN(xb_ld(&bar[XB_TOPGEN]) == tg, bar);
            __builtin_amdgcn_fence(__ATOMIC_ACQUIRE, "agent");
            xb_add(&bar[XB_XGEN(b.x)], 1u);
            asm volatile("s_waitcnt vmcnt(0)" ::: "memory");
        } else {
            XB_SPIN(xb_ld(&bar[XB_XGEN(b.x)]) == gen, bar);
            __builtin_amdgcn_fence(__ATOMIC_ACQUIRE, "agent");
            asm volatile("s_waitcnt vmcnt(0)" ::: "memory");
        }
    }
    __syncthreads();
}

#ifndef PH_MASK
#define PH_MASK 0xFFFFF
#endif
#define EN(b) if constexpr ((PH_MASK >> (b)) & 1)
#ifndef DUP_MASK
#define DUP_MASK 0
#endif
#define DUP(b) if constexpr ((DUP_MASK >> (b)) & 1)
#define DBG_DIGEST_N 256
#define DBG_DIGEST_VAL(m, c) bf2f(((const bf16*)(wsp + WS_CAT))[(size_t)(m) * DM + 768 + (c)])
#ifndef DBG_PH_HI
#define DBG_PH_HI NPHASE
#endif
#ifndef MK_MULTI
#define MK_MULTI 0
#endif
constexpr int LDS_BYTES = 151552, MISC_OFF = 131072 + 320;
#ifndef DBG_LAYERS
#define DBG_LAYERS 4
#define DBG_L0 0
#endif
constexpr int NPHASE = 3 + 7 * DBG_LAYERS;
__global__ void __launch_bounds__(512, 2) hymba_fwd(Args a) {
    extern __shared__ __attribute__((aligned(16))) unsigned char lds[];
    Ctx F0;
    Ctx& F = F0;
    F.lds = (char*)lds; F.tid = threadIdx.x; F.lane = F.tid & 63; F.wave = __builtin_amdgcn_readfirstlane(F.tid >> 6); F.G = gridDim.x; F.bid = blockIdx.x;
    F.A = nullptr; F.ws = a.ws;
    if (F.tid < 29) ((unsigned long long*)(lds + PTR_OFF))[F.tid] = F.tid < 28 ? (unsigned long long)a.in[F.tid] : (unsigned long long)a.out;
    volatile LAS unsigned* MISC = (volatile LAS unsigned*)((LAS unsigned char*)lds + MISC_OFF);
    if (F.tid < 32) MISC[F.tid] = 0u;
    __syncthreads();
    unsigned* ctl = (unsigned*)(a.ws + WS_CTL);
    XcdBarrier bar; bar.bar = ctl + CW_BAR; bar.x = 0; bar.st = nullptr;
    if (!MK_MULTI) bar = xcd_barrier_post(ctl + CW_BAR, MISC + 8);
    const int lo = a.ph_lo, hi = a.ph_hi;
    int ph = 0;
#define PH_BEGIN if (lo <= ph && ph < hi) { Ctx F = F0; unsigned long long wsl_ = (unsigned long long)F0.ws; asm volatile("" : "+v"(F.tid), "+s"(F.bid), "+s"(F.G), "+s"(wsl_)); F.ws = (unsigned char*)(__attribute__((address_space(1))) unsigned char*)wsl_; F.lane = F.tid & 63; F.wave = __builtin_amdgcn_readfirstlane(F.tid >> 6); unsigned char* const wsp = F.ws; (void)wsp;
#define PH_END   if (!MK_MULTI && ph + 1 < hi) { XcdBarrier bb = bar; asm volatile("" : "+s"(bb.bar), "+s"(bb.x)); xcd_barrier(bb); } else __syncthreads(); } ++ph;
    PG8_LAS unsigned char* glds = (PG8_LAS unsigned char*)lds;
#define XN ((bf16*)(wsp + WS_XN))
#define PROJ ((bf16*)(wsp + WS_PROJ))
#define CAT ((bf16*)(wsp + WS_CAT))
#define HB ((bf16*)(wsp + WS_HB))
    PH_BEGIN EN(0) ph_prologue(F); DUP(0) { __syncthreads(); ph_prologue(F); } PH_END
    PH_BEGIN EN(1) { ph_shw(F); ph_xs0(F, PIN(F, I_X), PIN(F, I_N1W) + DBG_L0 * DM, (const float*)(wsp + WS_MOD) + (size_t)DBG_L0 * BATCH * NADA, DM, XN, (float*)(wsp + WS_RSP)); } PH_END
    for (int l_ = 0; l_ < DBG_LAYERS; ++l_) { const int l = l_ + DBG_L0;
        #define modl ((const float*)(wsp + WS_MOD) + (size_t)l * BATCH * NADA)
        #define xsrc (l_ == 0 ? PIN(F, I_X) : (const float*)POUT(F))
        PH_BEGIN
#if defined(PROBE_GA)
            { pg8::Gemm g{XN, (const bf16*)(wsp + WS_WIN) + (size_t)l * NPROJ * DM, MTOK, NPROJ, DM}; pg8::StaticOrder S; S.init(MTOK, NPROJ, F.G, F.bid);
            pg8::EpiRoute<0> E{PROJ, NPROJ, PROJ, NPROJ, 1 << 20};
            pg8::gemm_phase<pg8::EpiRoute<0>, pg8::StaticOrder, true, true>(glds, g, S, E, F.tid); } __syncthreads();
#elif defined(PROBE_GB)
            { pg8::Gemm g{XN, (const bf16*)(wsp + WS_WIN) + (size_t)l * NPROJ * DM, MTOK, NPROJ, DM}; pg8::StaticOrder S; S.init(MTOK, NPROJ, F.G, F.bid);
            pg8::EpiRouteN<0> E{PROJ, NPROJ, (const float*)(wsp + WS_RSP), (const float*)(wsp + WS_SHW) + (size_t)l * BATCH * NSHW, glds};
            pg8::gemm_phase<pg8::EpiRouteN<0>, pg8::StaticOrder, true, true>(glds, g, S, E, F.tid); } __syncthreads();
#endif
        EN(2) { pg8::Gemm g{XN, (const bf16*)(wsp + WS_WIN) + (size_t)l * NPROJ * DM, MTOK, NPROJ, DM}; pg8::StaticOrder S; S.init(MTOK, NPROJ, F.G, F.bid);
            pg8::EpiRouteN<0> E{PROJ, NPROJ, (const float*)(wsp + WS_RSP), (const float*)(wsp + WS_SHW) + (size_t)l * BATCH * NSHW, glds};
            pg8::gemm_phase<pg8::EpiRouteN<0>, pg8::StaticOrder, true, true>(glds, g, S, E, F.tid); } PH_END
        PH_BEGIN EN(3) ph_prep(F, l); DUP(3) ph_prep(F, l); EN(4) ph_lru1(F, l); DUP(4) ph_lru1(F, l); EN(5) ph_mlstm(F, l); DUP(5) ph_mlstm(F, l); PH_END
        PH_BEGIN EN(6) { ph_carry(F); pg8::Gemm g{(const bf16*)(wsp + WS_QL), (const bf16*)(wsp + WS_WQC) + (size_t)l * 768 * 256, MTOK, 768, 256}; pg8::StaticOrder S; S.init(MTOK, 768, F.G, F.bid);
            pg8::EpiRoute<0> E{(bf16*)(wsp + WS_QABS), 512, (bf16*)(wsp + WS_QIDX), 256, 2};
            pg8::gemm_phase<pg8::EpiRoute<0>, pg8::StaticOrder, true, true>(glds, g, S, E, F.tid); } PH_END
        PH_BEGIN EN(7) ph_dsa(F, l); DUP(7) ph_dsa(F, l); EN(8) ph_lru2(F, l); DUP(8) ph_lru2(F, l); EN(9) ph_mfin(F, l); DUP(9) ph_mfin(F, l); PH_END
        PH_BEGIN EN(10) { pg8::Gemm g{CAT, (const bf16*)(wsp + WS_WO) + (size_t)l * DM * DM, MTOK, DM, DM}; pg8::StaticOrder S; S.init(MTOK, DM, F.G, F.bid);
            pg8::EpiResidXS<true, false> E{l_ == 0 ? (const void*)PIN(F, I_X) : (const void*)POUT(F), (void*)POUT(F), modl + 2 * DM, (const float*)(wsp + WS_WP) + (size_t)(l * 2 + 1) * BATCH * DM, XN, (float*)(wsp + WS_RSP), 1, l_ == 0, 0};
            pg8::gemm_phase<pg8::EpiResidXS<true, false>, pg8::StaticOrder, true, true>(glds, g, S, E, F.tid); } PH_END
        PH_BEGIN EN(12) { pg8::Gemm g{XN, (const bf16*)(wsp + WS_W1) + (size_t)l * DFF * DM, MTOK, DFF, DM}; pg8::StaticOrder S; S.init(MTOK, DFF, F.G, F.bid);
            pg8::EpiRouteN<1> E{HB, DFF, (const float*)(wsp + WS_RSP), (const float*)(wsp + WS_SHW) + (size_t)l * BATCH * NSHW + NPROJ, glds};
            pg8::gemm_phase<pg8::EpiRouteN<1>, pg8::StaticOrder, true, true>(glds, g, S, E, F.tid); } PH_END
        PH_BEGIN EN(13) { pg8::Gemm g{HB, (const bf16*)(wsp + WS_W2) + (size_t)l * DM * DFF, MTOK, DM, DFF}; pg8::StaticOrder S; S.init(MTOK, DM, F.G, F.bid);
            const int nl = l + 1 < DEPTH ? l + 1 : l;
            const bool lastl = l_ + 1 >= DBG_LAYERS;
            pg8::EpiResidXS<false, false> E{(const void*)POUT(F), lastl ? (void*)XN : (void*)POUT(F), modl + 5 * DM, (const float*)(wsp + WS_WP) + (size_t)(nl * 2) * BATCH * DM, XN, (float*)(wsp + WS_RSP), lastl ? 0 : 1, 0, 0};
            pg8::gemm_phase<pg8::EpiResidXS<false, false>, pg8::StaticOrder, true, true>(glds, g, S, E, F.tid); } PH_END
    }
#ifdef DBG_DIGEST
    PH_BEGIN { const int gw = F.bid * 8 + F.wave, NGW = F.G * 8; float* o = POUT(F);
        for (int m = gw; m < MTOK; m += NGW) for (int j = 0; j < 16; ++j) { const int c = F.lane + 64 * j; float v = 0.f;
            if (c < DBG_DIGEST_N) { v = DBG_DIGEST_VAL(m, c) * 4096.0f; v = v - floorf(v); }
            o[(size_t)m * DM + c] = v; } } PH_END
#else
    PH_BEGIN EN(14) ph_finalnorm16(F, XN, PIN(F, I_FNW), POUT(F)); PH_END
#endif
}

extern "C" void kernel_launch(void* const* d_in, const int* in_sizes, int n_in, void* d_out, int out_size, void* d_ws, size_t ws_size, hipStream_t stream) {
    static int grid = 0;
    if (grid == 0) {
        if (n_in != 28 || in_sizes[0] != MTOK * DM || out_size != MTOK * DM || ws_size < WS_END) { fprintf(stderr, "kernel_launch: unexpected shapes (n_in %d, in0 %d, out %d, ws %zu)\n", n_in, n_in > 0 ? in_sizes[0] : -1, out_size, ws_size); grid = -1; return; }
        int dev = 0, cus = 0, per_cu = 0;
        if (hipGetDevice(&dev) != hipSuccess || hipDeviceGetAttribute(&cus, hipDeviceAttributeMultiprocessorCount, dev) != hipSuccess) { grid = -1; return; }
        if (hipFuncSetAttribute((const void*)hymba_fwd, hipFuncAttributeMaxDynamicSharedMemorySize, LDS_BYTES) != hipSuccess) { fprintf(stderr, "kernel_launch: hipFuncSetAttribute failed\n"); grid = -1; return; }
        if (hipOccupancyMaxActiveBlocksPerMultiprocessor(&per_cu, (const void*)hymba_fwd, 512, LDS_BYTES) != hipSuccess || per_cu < 1) { fprintf(stderr, "kernel_launch: occupancy query says %d\n", per_cu); }
        (void)hipGetLastError();
        grid = cus;
    }
    if (grid < 0) return;
    if (hipMemsetAsync((char*)d_ws + WS_CTL, 0, CTL_ZERO_BYTES, stream) != hipSuccess) return;
    Args a{};
    for (int i = 0; i < 28; ++i) a.in[i] = (const float*)d_in[i];
    a.out = (float*)d_out; a.ws = (unsigned char*)d_ws;
#if MK_MULTI
    for (int p = 0; p < NPHASE; ++p) { a.ph_lo = p; a.ph_hi = p + 1; hipLaunchKernelGGL(hymba_fwd, dim3(grid), dim3(512), LDS_BYTES, stream, a); }
#else
    a.ph_lo = 0; a.ph_hi = DBG_PH_HI; hipLaunchKernelGGL(hymba_fwd, dim3(grid), dim3(512), LDS_BYTES, stream, a);
#endif
}
#endif
```

```cpp
#ifndef HOST_EMU
#include <hip/hip_runtime.h>
#include <cstdio>
#include <cstdint>
#define DEV __device__ __forceinline__
#define LAS __attribute__((address_space(3)))
#else
#include "emu.h"
#endif

#ifndef HOST_EMU
#define SYNC() __syncthreads()
#define LAUNDER_V(x) asm volatile("" : "+v"(x))
#define WAVE_LDS_FENCE() asm volatile("s_waitcnt lgkmcnt(0)" ::: "memory")
template <class T> DEV T SHFL(T v, int s) { return __shfl(v, s); }
template <class T> DEV T SHFL_XOR(T v, int m) { return __shfl_xor(v, m); }
template <class T> DEV T SHFL_UP(T v, int d) { return __shfl_up(v, d); }
template <class T> DEV T SHFL_DOWN(T v, int d) { return __shfl_down(v, d); }
typedef short bf16x8_ __attribute__((ext_vector_type(8)));
typedef float f32x4_ __attribute__((ext_vector_type(4)));
typedef short v4i16_t __attribute__((ext_vector_type(4)));
DEV f32x4_ MFMA16(bf16x8_ a, bf16x8_ b, f32x4_ c) { return __builtin_amdgcn_mfma_f32_16x16x32_bf16(a, b, c, 0, 0, 0); }
DEV v4i16_t TR16(const void* p) { return __builtin_amdgcn_ds_read_tr16_b64_v4i16((LAS v4i16_t*)(p)); }
#endif


typedef unsigned short bf16;
typedef short bf16x8 __attribute__((ext_vector_type(8)));
typedef short s16x4 __attribute__((ext_vector_type(4)));
typedef float f32x4 __attribute__((ext_vector_type(4)));
typedef unsigned u32x4 __attribute__((ext_vector_type(4)));
typedef unsigned u32x2 __attribute__((ext_vector_type(2)));

constexpr int BATCH = 16, SEQ = 4096, DM = 1024, DEPTH = 4, MTOK = BATCH * SEQ;
constexpr int NPROJ = 3072, DFF = 4096, NADA = 6 * DM;
constexpr int PC_LX = 0, PC_LY = 256, PC_MQ = 512, PC_MK = 1024, PC_MV = 1536, PC_MO = 2048, PC_AQ = 2560, PC_AKV = 2816, PC_IK = 2944, PC_IW = 2976, PC_MI = 2984, PC_MF = 2988;
constexpr float NORM_EPS = 1e-6f;

constexpr size_t MiB = 1u << 20;
constexpr size_t WS_CTL = 0, CTL_ZERO_BYTES = 1 * MiB;
constexpr size_t WS_MOD = 1 * MiB;
constexpr size_t WS_WQC = 3 * MiB;
constexpr size_t WS_WG = 5 * MiB;
constexpr size_t WS_WUVT = 6 * MiB;
constexpr size_t WS_WIN = 8 * MiB;
constexpr size_t WS_WO = 32 * MiB;
constexpr size_t WS_W1 = 40 * MiB;
constexpr size_t WS_W2 = 72 * MiB;
constexpr size_t WS_XN = 104 * MiB;
constexpr size_t WS_QL = WS_XN, WS_CKV = WS_XN + 32 * MiB, WS_QIDX = WS_XN + 48 * MiB, WS_KIDX = WS_XN + 80 * MiB, WS_WI = WS_XN + 84 * MiB, WS_GT = WS_XN + 86 * MiB;
constexpr size_t WS_CAT = 232 * MiB;
constexpr size_t WS_PROJ = 360 * MiB;
constexpr size_t WS_HB = 360 * MiB;
constexpr size_t WS_QABS = 744 * MiB;
constexpr size_t WS_HLOC = 808 * MiB, WS_CPA = 840 * MiB;
constexpr size_t WS_LSUM = 872 * MiB;
constexpr size_t WS_HM = 874 * MiB;
constexpr size_t WS_MG = 940 * MiB;
constexpr size_t WS_WP = 2 * MiB + 512 * 1024;
constexpr size_t WS_SHW = 6 * MiB + 256 * 1024;
constexpr size_t WS_RSP = 1000 * MiB;
constexpr size_t WS_CARRY = 948 * MiB;
constexpr size_t WS_SCR2 = 949 * MiB;
constexpr int NSHW = NPROJ + DFF;
constexpr size_t WS_END = 1024 * MiB;
static_assert(WS_HM + (size_t)MTOK * 512 * 2 <= WS_END && WS_HB + (size_t)MTOK * DFF * 2 <= WS_HLOC + 64 * MiB, "ws map");

constexpr int CW_TMO = 0, CW_BAR = 4096;

#ifndef HOST_EMU
typedef __bf16 hwbf2_t __attribute__((ext_vector_type(2)));
typedef float hwf2_t __attribute__((ext_vector_type(2)));
DEV unsigned f2bf(float f) { return (unsigned)__builtin_bit_cast(unsigned short, (__bf16)f); }
DEV unsigned pk2(float lo, float hi) { const hwf2_t v = {lo, hi}; return __builtin_bit_cast(unsigned, __builtin_convertvector(v, hwbf2_t)); }
#else
DEV unsigned f2bf(float f) { unsigned u = __builtin_bit_cast(unsigned, f); return (u + 0x7fffu + ((u >> 16) & 1u)) >> 16; }
DEV unsigned pk2(float lo, float hi) { return f2bf(lo) | (f2bf(hi) << 16); }
#endif
DEV float bf2f(unsigned h) { return __builtin_bit_cast(float, h << 16); }
DEV float bflo(unsigned w) { return __builtin_bit_cast(float, w << 16); }
DEV float bfhi(unsigned w) { return __builtin_bit_cast(float, w & 0xffff0000u); }
DEV float wave_sum(float v) {
#pragma unroll
    for (int o = 1; o < 64; o <<= 1) v += SHFL_XOR(v, o);
    return v;
}
#ifndef HOST_EMU
DEV float FEXP(float x) { return __expf(x); }
DEV float FEXP2(float x) { return __builtin_amdgcn_exp2f(x); }
DEV float FRCP(float x) { return __builtin_amdgcn_rcpf(x); }
DEV float FSQRT(float x) { return __builtin_amdgcn_sqrtf(x); }
DEV float RSQ(float x) { return __builtin_amdgcn_rsqf(x); }
DEV float FLOG(float x) { return __logf(x); }
#else
DEV float FEXP(float x) { return expf(x); }
DEV float FEXP2(float x) { return exp2f(x); }
DEV float FRCP(float x) { return 1.0f / x; }
DEV float FSQRT(float x) { return sqrtf(x); }
DEV float RSQ(float x) { return 1.0f / sqrtf(x); }
DEV float FLOG(float x) { return logf(x); }
#endif
#ifndef HOST_EMU
DEV int UNI(int x) { return __builtin_amdgcn_readfirstlane(x); }
#else
DEV int UNI(int x) { return x; }
#endif
#ifndef HOST_EMU
#define GAS __attribute__((address_space(1)))
DEV const GAS char* UNIP(const void* p) { const unsigned long long v = (unsigned long long)p; const unsigned lo = __builtin_amdgcn_readfirstlane((unsigned)v), hi = __builtin_amdgcn_readfirstlane((unsigned)(v >> 32));
    return (const GAS char*)(((unsigned long long)hi << 32) | lo); }
#else
#define GAS
DEV const char* UNIP(const void* p) { return (const char*)p; }
#endif
DEV float RELU(float x) { const int b = __builtin_bit_cast(int, x); return __builtin_bit_cast(float, b > 0 ? b : 0); }
DEV float sigmoidf_(float z) { return 1.0f / (1.0f + expf(-z)); }
DEV float fsigmoid(float z) { return FRCP(1.0f + FEXP(-z)); }
DEV float one_minus_exp(float x) {
    const float s = -x * (1.0f + x * (0.5f + x * (0.16666667f + x * 0.041666668f)));
    return x > -0.05f ? s : 1.0f - FEXP(x);
}

struct Args { const float* in[28]; float* out; unsigned char* ws; int ph_lo, ph_hi; };
struct Ctx {
    char* lds; int tid, lane, wave, G, bid;
    const Args* A;
    unsigned char* ws;
};

constexpr int PTR_OFF = 131072 + 512;
#ifndef HOST_EMU
DEV const float* PIN(const Ctx& F, int i) { const unsigned long long v = ((const unsigned long long*)(F.lds + PTR_OFF))[i];
    const unsigned lo = __builtin_amdgcn_readfirstlane((unsigned)v), hi = __builtin_amdgcn_readfirstlane((unsigned)(v >> 32)); return (const float*)(const __attribute__((address_space(1))) float*)(((unsigned long long)hi << 32) | lo); }
DEV float* POUT(const Ctx& F) { return (float*)PIN(F, 28); }
#else
DEV const float* PIN(const Ctx& F, int i) { return F.A->in[i]; }
DEV float* POUT(const Ctx& F) { return POUT(F); }
#endif
enum { I_X = 0, I_C, I_WIN, I_CONVW, I_CONVB, I_WA, I_BA, I_WX, I_BX, I_LAM, I_BI, I_BF, I_WQUP, I_WQIDX, I_WUK, I_WUV, I_QNW, I_KVNW, I_RELB, I_GNW, I_WO, I_WADA, I_BADA, I_N1W, I_N2W, I_W1, I_W2, I_FNW };

DEV int win_srccol(int n) {
    if (n < 2560) return n;
    if (n < PC_AKV) return 2568 + (n - PC_AQ);
    if (n < PC_IK) return 2824 + (n - PC_AKV);
    if (n < PC_IW) return 2952 + (n - PC_IK);
    if (n < PC_MI) return 2984 + (n - PC_IW);
    if (n < PC_MF) return 2560 + (n - PC_MI);
    if (n < 2992) return 2564 + (n - PC_MF);
    return -1;
}
template <bool MAPPED>
DEV void p0_transpose_item(const float* W, int K, int N, int NT, bf16* WT, float* scr, int item, int lane) {
    const int nblk = NT / 32, kb = item / nblk, nb = item % nblk, k0 = 64 * kb, n0 = 32 * nb;
    int sc = n0 + (lane & 31); if (MAPPED) sc = win_srccol(sc);
#pragma unroll 8
    for (int i = 0; i < 32; ++i) { const int kk = 2 * i + (lane >> 5); scr[kk * 33 + (lane & 31)] = sc >= 0 ? W[(size_t)(k0 + kk) * N + sc] : 0.f; }
    WAVE_LDS_FENCE();
    const int c = lane & 7;
#pragma unroll
    for (int j = 0; j < 4; ++j) { const int n = (lane >> 3) + 8 * j; const float* s = scr + (8 * c) * 33 + n;
        u32x4 o; o.x = pk2(s[0 * 33], s[1 * 33]); o.y = pk2(s[2 * 33], s[3 * 33]); o.z = pk2(s[4 * 33], s[5 * 33]); o.w = pk2(s[6 * 33], s[7 * 33]);
        *(u32x4*)(WT + (size_t)(n0 + n) * K + k0 + 8 * c) = o; }
    WAVE_LDS_FENCE();
}

DEV void ph_prologue(const Ctx& F) {
    const int gt = F.bid * 512 + F.tid, NGT = F.G * 512;
    float* CACT = (float*)F.lds;
    for (int i = F.tid; i < BATCH * DM; i += 512) { const float cv = PIN(F, I_C)[i]; CACT[i] = cv * sigmoidf_(cv); }
    SYNC();
    for (int e = gt; e < DEPTH * NADA * 4; e += NGT) {
        const int j = e % NADA, bq = (e / NADA) & 3, l = e / (NADA * 4);
        const float* w = PIN(F, I_WADA) + (size_t)l * DM * NADA + j;
        const float* c = CACT + bq * 4 * DM;
        float a0 = 0.f, a1 = 0.f, a2 = 0.f, a3 = 0.f;
#pragma unroll 32
        for (int k = 0; k < DM; ++k) { const float wv = w[(size_t)k * NADA];
            a0 += c[k] * wv; a1 += c[DM + k] * wv; a2 += c[2 * DM + k] * wv; a3 += c[3 * DM + k] * wv; }
        const float bb = PIN(F, I_BADA)[(size_t)l * NADA + j];
        float* mo = (float*)(F.ws + WS_MOD) + ((size_t)l * BATCH + bq * 4) * NADA + j;
        mo[0] = a0 + bb; mo[NADA] = a1 + bb; mo[2 * NADA] = a2 + bb; mo[3 * NADA] = a3 + bb;
    }
    for (int e = gt; e < DEPTH * 2 * 4 * 64 * 64; e += NGT) {
        const int i = e & 63, j = (e >> 6) & 63, blk = (e >> 12) & 3, g = (e >> 14) & 1, l = e >> 15;
        const float* src = PIN(F, g ? I_WX : I_WA) + (((size_t)l * 4 + blk) * 64 + i) * 64 + j;
        ((bf16*)(F.ws + WS_WG))[e] = (bf16)f2bf(*src);
    }
    for (int e = gt; e < DEPTH * 4 * 64 * 128; e += NGT) {
        const int r = e & 127, d = (e >> 7) & 63, h = (e >> 13) & 3, l = e >> 15;
        ((bf16*)(F.ws + WS_WUVT))[e] = (bf16)f2bf(PIN(F, I_WUV)[(((size_t)l * 128 + r) * 4 + h) * 64 + d]);
    }
    for (int e = gt; e < DEPTH * 768 * 256; e += NGT) {
        const int r = e & 255, n = (e >> 8) % 768, l = e / (768 * 256);
        float v;
        if (n < 512) { const int h = n >> 7, c = n & 127; const f32x4* q = (const f32x4*)(PIN(F, I_WQUP) + ((size_t)l * 256 + r) * 256 + h * 64); const f32x4* k = (const f32x4*)(PIN(F, I_WUK) + ((size_t)l * 128 + c) * 256 + h * 64);
            float s = 0.f;
#pragma unroll
            for (int d = 0; d < 16; ++d) { const f32x4 a = q[d], bq4 = k[d]; s += (a.x * bq4.x + a.y * bq4.y) + (a.z * bq4.z + a.w * bq4.w); }
            v = s * (0.125f * 1.4426950408889634f); }
        else v = PIN(F, I_WQIDX)[((size_t)l * 256 + r) * 256 + (n - 512)] * 0.17677669529663687f;
        ((bf16*)(F.ws + WS_WQC))[e] = (bf16)f2bf(v);
    }
    SYNC();
    float* scr = (float*)(F.lds + F.wave * 16384);
    const int gw = F.bid * 8 + F.wave, NGW = F.G * 8;
    constexpr int I_IN = (DM / 64) * (NPROJ / 32), I_O = (DM / 64) * (DM / 32), I_1 = (DM / 64) * (DFF / 32), I_2 = (DFF / 64) * (DM / 32);
    constexpr int PER_L = I_IN + I_O + I_1 + I_2;
    for (int it = gw; it < DEPTH * PER_L; it += NGW) {
        const int l = it / PER_L; int r = it % PER_L;
        if (r < I_IN) { p0_transpose_item<true>(PIN(F, I_WIN) + (size_t)l * DM * 2992, DM, 2992, NPROJ, (bf16*)(F.ws + WS_WIN) + (size_t)l * NPROJ * DM, scr, r, F.lane); continue; } r -= I_IN;
        if (r < I_O) { p0_transpose_item<false>(PIN(F, I_WO) + (size_t)l * DM * DM, DM, DM, DM, (bf16*)(F.ws + WS_WO) + (size_t)l * DM * DM, scr, r, F.lane); continue; } r -= I_O;
        if (r < I_1) { p0_transpose_item<false>(PIN(F, I_W1) + (size_t)l * DM * DFF, DM, DFF, DFF, (bf16*)(F.ws + WS_W1) + (size_t)l * DFF * DM, scr, r, F.lane); continue; } r -= I_1;
        p0_transpose_item<false>(PIN(F, I_W2) + (size_t)l * DFF * DM, DFF, DM, DM, (bf16*)(F.ws + WS_W2) + (size_t)l * DM * DFF, scr, r, F.lane);
    }
}

DEV void ph_xs0(const Ctx& F, const float* xsrc, const float* nw, const float* modl, int sc_off, bf16* XS, float* RSP) {
    const int gw = F.bid * 8 + F.wave, NGW = F.G * 8;
    f32x4 wv[4];
#pragma unroll
    for (int j = 0; j < 4; ++j) wv[j] = *(const f32x4*)(nw + 4 * F.lane + 256 * j);
    f32x4 v[2][4], vn[2][4];
#pragma unroll
    for (int q = 0; q < 2; ++q) { const int m = gw + q * NGW; const f32x4* xr = (const f32x4*)(xsrc + (size_t)(m < MTOK ? m : 0) * DM) + F.lane;
#pragma unroll
        for (int j = 0; j < 4; ++j) v[q][j] = xr[64 * j]; }
    for (int m0 = gw; m0 < MTOK; m0 += 2 * NGW) {
        f32x4 sc[2][4];
#pragma unroll
        for (int q = 0; q < 2; ++q) { const int m = m0 + q * NGW; const float* mb = modl + (size_t)((m < MTOK ? m : 0) >> 12) * NADA + 4 * F.lane;
#pragma unroll
            for (int j = 0; j < 4; ++j) sc[q][j] = *(const f32x4*)(mb + sc_off + 256 * j); }
#pragma unroll
        for (int q = 0; q < 2; ++q) { const int m = m0 + (2 + q) * NGW; const f32x4* xr = (const f32x4*)(xsrc + (size_t)(m < MTOK ? m : 0) * DM) + F.lane;
#pragma unroll
            for (int j = 0; j < 4; ++j) vn[q][j] = xr[64 * j]; }
        float s[2];
#pragma unroll
        for (int q = 0; q < 2; ++q) { float a = 0.f;
#pragma unroll
            for (int j = 0; j < 4; ++j) a += (v[q][j].x * v[q][j].x + v[q][j].y * v[q][j].y) + (v[q][j].z * v[q][j].z + v[q][j].w * v[q][j].w);
            s[q] = a; }
#pragma unroll
        for (int o = 1; o < 64; o <<= 1) { s[0] += SHFL_XOR(s[0], o); s[1] += SHFL_XOR(s[1], o); }
#pragma unroll
        for (int q = 0; q < 2; ++q) { const int m = m0 + q * NGW; if (m >= MTOK) break;
            if (F.lane < 16) RSP[(size_t)m * 16 + F.lane] = F.lane == 0 ? s[q] : 0.f;
            u32x2* o8 = (u32x2*)(XS + (size_t)m * DM) + F.lane;
#pragma unroll
            for (int j = 0; j < 4; ++j) { const f32x4 y = v[q][j] * (wv[j] * (1.0f + sc[q][j]));
                u32x2 p; p.x = pk2(y.x, y.y); p.y = pk2(y.z, y.w); o8[64 * j] = p; } }
#pragma unroll
        for (int q = 0; q < 2; ++q)
#pragma unroll
            for (int j = 0; j < 4; ++j) v[q][j] = vn[q][j];
    }
}
DEV void ph_shw(const Ctx& F) {
    const int gt = F.bid * 512 + F.tid, NGT = F.G * 512;
    for (int e = gt; e < DEPTH * 2 * BATCH * (DM / 4); e += NGT) {
        const int c4 = e & 255, b = (e >> 8) & 15, w = (e >> 12) & 1, l = e >> 13;
        const f32x4 nwv = *(const f32x4*)(PIN(F, w ? I_N2W : I_N1W) + l * DM + 4 * c4);
        const f32x4 sc = *(const f32x4*)((const float*)(F.ws + WS_MOD) + ((size_t)l * BATCH + b) * NADA + (w ? 4 * DM : DM) + 4 * c4);
        ((f32x4*)(F.ws + WS_WP))[e] = nwv * (1.0f + sc);
    }
    const int gw = F.bid * 8 + F.wave, NGW = F.G * 8, i16 = F.lane & 15, kq = 8 * (F.lane >> 4);
    for (int it = gw; it < DEPTH * (NSHW / 16); it += NGW) {
        const int l = it / (NSHW / 16), n0 = (it % (NSHW / 16)) * 16;
        const bool mlp = n0 >= NPROJ;
        const bf16* Wr = mlp ? (const bf16*)(F.ws + WS_W1) + ((size_t)l * DFF + (n0 - NPROJ) + i16) * DM : (const bf16*)(F.ws + WS_WIN) + ((size_t)l * NPROJ + n0 + i16) * DM;
        const float* sh = (const float*)(F.ws + WS_MOD) + ((size_t)l * BATCH + i16) * NADA + (mlp ? 3 * DM : 0);
        f32x4 acc0 = {0.f, 0.f, 0.f, 0.f}, acc1 = {0.f, 0.f, 0.f, 0.f};
#pragma unroll 4
        for (int s = 0; s < DM / 32; ++s) {
            const bf16x8 B = *(const bf16x8*)(Wr + 32 * s + kq);
            const f32x4 a0 = *(const f32x4*)(sh + 32 * s + kq), a1 = *(const f32x4*)(sh + 32 * s + kq + 4);
            bf16x8 Ah, Al;
#pragma unroll
            for (int j = 0; j < 8; ++j) { const float a = j < 4 ? a0[j] : a1[j - 4]; const unsigned h = f2bf(a); Ah[j] = (short)h; Al[j] = (short)f2bf(a - bf2f(h)); }
            acc0 = MFMA16(Ah, B, acc0); acc1 = MFMA16(Al, B, acc1);
        }
        float* o = (float*)(F.ws + WS_SHW) + ((size_t)l * BATCH + 4 * (F.lane >> 4)) * NSHW + n0 + i16;
#pragma unroll
        for (int r = 0; r < 4; ++r) o[(size_t)r * NSHW] = acc0[r] + acc1[r];
    }
}
DEV void ph_normmod(const Ctx& F, const float* xsrc, const float* nw, const float* modl, int sh_off, int sc_off, bf16* XN) {
    const int gw = F.bid * 8 + F.wave, NGW = F.G * 8;
    f32x4 wv[4];
#pragma unroll
    for (int j = 0; j < 4; ++j) wv[j] = *(const f32x4*)(nw + 4 * F.lane + 256 * j);
    f32x4 v[2][4], vn[2][4];
#pragma unroll
    for (int q = 0; q < 2; ++q) { const int m = gw + q * NGW; const f32x4* xr = (const f32x4*)(xsrc + (size_t)(m < MTOK ? m : 0) * DM) + F.lane;
#pragma unroll
        for (int j = 0; j < 4; ++j) v[q][j] = xr[64 * j]; }
    for (int m0 = gw; m0 < MTOK; m0 += 2 * NGW) {
        f32x4 sc[2][4], sh[2][4];
#pragma unroll
        for (int q = 0; q < 2; ++q) { const int m = m0 + q * NGW; const float* mb = modl + (size_t)((m < MTOK ? m : 0) >> 12) * NADA + 4 * F.lane;
#pragma unroll
            for (int j = 0; j < 4; ++j) { sc[q][j] = *(const f32x4*)(mb + sc_off + 256 * j); sh[q][j] = *(const f32x4*)(mb + sh_off + 256 * j); } }
#pragma unroll
        for (int q = 0; q < 2; ++q) { const int m = m0 + (2 + q) * NGW; const f32x4* xr = (const f32x4*)(xsrc + (size_t)(m < MTOK ? m : 0) * DM) + F.lane;
#pragma unroll
            for (int j = 0; j < 4; ++j) vn[q][j] = xr[64 * j]; }
        float s[2];
#pragma unroll
        for (int q = 0; q < 2; ++q) { float a = 0.f;
#pragma unroll
            for (int j = 0; j < 4; ++j) a += (v[q][j].x * v[q][j].x + v[q][j].y * v[q][j].y) + (v[q][j].z * v[q][j].z + v[q][j].w * v[q][j].w);
            s[q] = a; }
#pragma unroll
        for (int o = 1; o < 64; o <<= 1) { s[0] += SHFL_XOR(s[0], o); s[1] += SHFL_XOR(s[1], o); }
#pragma unroll
        for (int q = 0; q < 2; ++q) { const int m = m0 + q * NGW; if (m >= MTOK) break;
            const float rs = RSQ(s[q] * (1.0f / DM) + NORM_EPS);
            u32x2* o8 = (u32x2*)(XN + (size_t)m * DM) + F.lane;
#pragma unroll
            for (int j = 0; j < 4; ++j) { const f32x4 y = v[q][j] * rs * wv[j] * (1.0f + sc[q][j]) + sh[q][j];
                u32x2 p; p.x = pk2(y.x, y.y); p.y = pk2(y.z, y.w); o8[64 * j] = p; } }
#pragma unroll
        for (int q = 0; q < 2; ++q)
#pragma unroll
            for (int j = 0; j < 4; ++j) v[q][j] = vn[q][j];
    }
}
DEV void ph_finalnorm(const Ctx& F, const float* xsrc, const float* nw, float* out) {
    const int gw = F.bid * 8 + F.wave, NGW = F.G * 8;
    f32x4 wv[4];
#pragma unroll
    for (int j = 0; j < 4; ++j) wv[j] = *(const f32x4*)(nw + 4 * F.lane + 256 * j);
    f32x4 v[2][4], vn[2][4];
#pragma unroll
    for (int q = 0; q < 2; ++q) { const int m = gw + q * NGW; const f32x4* xr = (const f32x4*)(xsrc + (size_t)(m < MTOK ? m : 0) * DM) + F.lane;
#pragma unroll
        for (int j = 0; j < 4; ++j) v[q][j] = xr[64 * j]; }
    for (int m0 = gw; m0 < MTOK; m0 += 2 * NGW) {
#pragma unroll
        for (int q = 0; q < 2; ++q) { const int m = m0 + (2 + q) * NGW; const f32x4* xr = (const f32x4*)(xsrc + (size_t)(m < MTOK ? m : 0) * DM) + F.lane;
#pragma unroll
            for (int j = 0; j < 4; ++j) vn[q][j] = xr[64 * j]; }
        float s[2];
#pragma unroll
        for (int q = 0; q < 2; ++q) { float a = 0.f;
#pragma unroll
            for (int j = 0; j < 4; ++j) a += (v[q][j].x * v[q][j].x + v[q][j].y * v[q][j].y) + (v[q][j].z * v[q][j].z + v[q][j].w * v[q][j].w);
            s[q] = a; }
#pragma unroll
        for (int o = 1; o < 64; o <<= 1) { s[0] += SHFL_XOR(s[0], o); s[1] += SHFL_XOR(s[1], o); }
#pragma unroll
        for (int q = 0; q < 2; ++q) { const int m = m0 + q * NGW; if (m >= MTOK) break;
            const float rs = RSQ(s[q] * (1.0f / DM) + NORM_EPS);
            f32x4* o = (f32x4*)(out + (size_t)m * DM) + F.lane;
#pragma unroll
            for (int j = 0; j < 4; ++j) o[64 * j] = v[q][j] * rs * wv[j]; }
#pragma unroll
        for (int q = 0; q < 2; ++q)
#pragma unroll
            for (int j = 0; j < 4; ++j) v[q][j] = vn[q][j];
    }
}
DEV void ph_finalnorm16(const Ctx& F, const bf16* x16, const float* nw, float* out) {
    const int gw = F.bid * 8 + F.wave, NGW = F.G * 8;
    f32x4 wv[2][2];
#pragma unroll
    for (int j = 0; j < 2; ++j) { wv[j][0] = *(const f32x4*)(nw + 8 * F.lane + 512 * j); wv[j][1] = *(const f32x4*)(nw + 8 * F.lane + 512 * j + 4); }
    u32x4 v[4][2], vn[4][2];
#pragma unroll
    for (int q = 0; q < 4; ++q) { const int m = gw + q * NGW; const bf16* xr = x16 + (size_t)(m < MTOK ? m : 0) * DM + 8 * F.lane;
        v[q][0] = *(const u32x4*)xr; v[q][1] = *(const u32x4*)(xr + 512); }
    for (int m0 = gw; m0 < MTOK; m0 += 4 * NGW) {
#pragma unroll
        for (int q = 0; q < 4; ++q) { const int m = m0 + (4 + q) * NGW; const bf16* xr = x16 + (size_t)(m < MTOK ? m : 0) * DM + 8 * F.lane;
            vn[q][0] = *(const u32x4*)xr; vn[q][1] = *(const u32x4*)(xr + 512); }
        float s[4];
#pragma unroll
        for (int q = 0; q < 4; ++q) { float a = 0.f;
#pragma unroll
            for (int j = 0; j < 2; ++j) { const u32x4 r = v[q][j];
                a += ((bflo(r.x) * bflo(r.x) + bfhi(r.x) * bfhi(r.x)) + (bflo(r.y) * bflo(r.y) + bfhi(r.y) * bfhi(r.y))) + ((bflo(r.z) * bflo(r.z) + bfhi(r.z) * bfhi(r.z)) + (bflo(r.w) * bflo(r.w) + bfhi(r.w) * bfhi(r.w))); }
            s[q] = a; }
#pragma unroll
        for (int o = 1; o < 64; o <<= 1) {
#pragma unroll
            for (int q = 0; q < 4; ++q) s[q] += SHFL_XOR(s[q], o); }
#pragma unroll
        for (int q = 0; q < 4; ++q) { const int m = m0 + q * NGW; if (m >= MTOK) break;
            const float rs = RSQ(s[q] * (1.0f / DM) + NORM_EPS);
            float* o = out + (size_t)m * DM + 8 * F.lane;
#pragma unroll
            for (int j = 0; j < 2; ++j) { const u32x4 r = v[q][j];
                *(f32x4*)(o + 512 * j) = (f32x4){bflo(r.x), bfhi(r.x), bflo(r.y), bfhi(r.y)} * rs * wv[j][0];
                *(f32x4*)(o + 512 * j + 4) = (f32x4){bflo(r.z), bfhi(r.z), bflo(r.w), bfhi(r.w)} * rs * wv[j][1]; } }
#pragma unroll
        for (int q = 0; q < 4; ++q) { v[q][0] = vn[q][0]; v[q][1] = vn[q][1]; }
    }
}
DEV void ph_zero_cat(const Ctx& F, int c0, int nq) {
    const int gw = F.bid * 8 + F.wave, NGW = F.G * 8;
    bf16* CAT = (bf16*)(F.ws + WS_CAT);
    for (int m = gw; m < MTOK; m += NGW) for (int q = 0; q < nq; ++q) *(u32x2*)(CAT + (size_t)m * DM + c0 + 256 * q + 4 * F.lane) = (u32x2){0u, 0u};
}
DEV float softcap15(float z) { return 15.0f * tanhf(z * (1.0f / 15.0f)); }
DEV float logsigmoidf_(float x) { return x >= 0.f ? -log1pf(expf(-x)) : x - log1pf(expf(x)); }
DEV void ph_prep(const Ctx& F, int l) {
    const int gw = F.bid * 8 + F.wave, NGW = F.G * 8, lane = F.lane;
    const bf16* PROJ = (const bf16*)(F.ws + WS_PROJ);
    bf16* QL = (bf16*)(F.ws + WS_QL); bf16* CKV = (bf16*)(F.ws + WS_CKV); bf16* KIDX = (bf16*)(F.ws + WS_KIDX);
    float* WI = (float*)(F.ws + WS_WI);
    const f32x4 qn = *(const f32x4*)(PIN(F, I_QNW) + l * 256 + 4 * lane);
    const float kn0 = PIN(F, I_KVNW)[l * 128 + 2 * lane], kn1 = PIN(F, I_KVNW)[l * 128 + 2 * lane + 1];
    u32x2 ra4[4], ran[4]; unsigned rk4[4], rx4[4], rkn[4], rxn[4];
#define PREP_LOAD(RA, RK, RX, M0) do { _Pragma("unroll") for (int q = 0; q < 4; ++q) { const int mm = (M0) + q * NGW; const bf16* pr = PROJ + (size_t)(mm < MTOK ? mm : 0) * NPROJ; \
            RA[q] = *(const u32x2*)(pr + PC_AQ + 4 * lane); RK[q] = *(const unsigned*)(pr + PC_AKV + 2 * lane); \
            RX[q] = lane < 16 ? *(const unsigned*)(pr + PC_IK + 2 * lane) : (lane < 24 ? (unsigned)pr[PC_IW + (lane - 16)] : 0u); } } while (0)
    PREP_LOAD(ra4, rk4, rx4, gw);
    for (int m0 = gw; m0 < MTOK; m0 += 4 * NGW) {
        PREP_LOAD(ran, rkn, rxn, m0 + 4 * NGW);
#pragma unroll
        for (int q = 0; q < 4; ++q) { const int m = m0 + q * NGW; if (m >= MTOK) break;
            const u32x2 ra = ra4[q]; const unsigned rk = rk4[q];
            const float a0 = bflo(ra.x), a1 = bfhi(ra.x), a2 = bflo(ra.y), a3 = bfhi(ra.y);
            const float k0 = bflo(rk), k1 = bfhi(rk);
            const float sq = wave_sum((a0 * a0 + a1 * a1) + (a2 * a2 + a3 * a3)), sk = wave_sum(k0 * k0 + k1 * k1);
            const float rq = RSQ(sq * (1.0f / 256.0f) + NORM_EPS), rk2 = RSQ(sk * (1.0f / 128.0f) + NORM_EPS);
            u32x2 oq; oq.x = pk2(a0 * rq * qn.x, a1 * rq * qn.y); oq.y = pk2(a2 * rq * qn.z, a3 * rq * qn.w);
            *(u32x2*)(QL + (size_t)m * 256 + 4 * lane) = oq;
            *(unsigned*)(CKV + (size_t)m * 128 + 2 * lane) = pk2(k0 * rk2 * kn0, k1 * rk2 * kn1);
            if (lane < 16) *(unsigned*)(KIDX + (size_t)m * 32 + 2 * lane) = rx4[q];
            else if (lane < 24) WI[(size_t)m * 8 + (lane - 16)] = bf2f(rx4[q]); }
#pragma unroll
        for (int q = 0; q < 4; ++q) { ra4[q] = ran[q]; rk4[q] = rkn[q]; rx4[q] = rxn[q]; }
    }
#undef PREP_LOAD
}

constexpr int XB_STRIDE = 264;
DEV void ph_lru1(const Ctx& F, int l) {
    const int tid = F.tid, lane = F.lane, w = F.wave, i16 = lane & 15, g = lane >> 4;
    bf16* XB = (bf16*)F.lds;
    float* XF = (float*)(F.lds + 64 * XB_STRIDE * 2);
    const bf16* PROJ = (const bf16*)(F.ws + WS_PROJ);
    bf16* HLOC = (bf16*)(F.ws + WS_HLOC); bf16* CPA = (bf16*)(F.ws + WS_CPA); float* LSUM = (float*)(F.ws + WS_LSUM);
    const int blk = w & 3, nh = w >> 2;
    const bf16* WG = (const bf16*)(F.ws + WS_WG) + (size_t)l * 2 * 4 * 4096;
    bf16x8 Bf[2][2][2];
#pragma unroll
    for (int gg = 0; gg < 2; ++gg)
#pragma unroll
        for (int nt = 0; nt < 2; ++nt)
#pragma unroll
            for (int ks = 0; ks < 2; ++ks) Bf[gg][nt][ks] = *(const bf16x8*)(WG + ((size_t)(gg * 4 + blk) * 64 + (2 * nh + nt) * 16 + i16) * 64 + ks * 32 + 8 * g);
    float ba[2], bx[2], sp[2];
#pragma unroll
    for (int nt = 0; nt < 2; ++nt) { const int ch = blk * 64 + (2 * nh + nt) * 16 + i16;
        ba[nt] = PIN(F, I_BA)[l * 256 + ch]; bx[nt] = PIN(F, I_BX)[l * 256 + ch];
        const float lam = PIN(F, I_LAM)[l * 256 + ch]; sp[nt] = lam > 0.f ? log1pf(expf(-lam)) : -lam + log1pf(expf(lam)); }
    const int ch2 = tid & 127, tg = tid >> 7;
    float cw[4][2], cb[2];
#pragma unroll
    for (int j = 0; j < 4; ++j) { cw[j][0] = PIN(F, I_CONVW)[(l * 4 + j) * 256 + 2 * ch2]; cw[j][1] = PIN(F, I_CONVW)[(l * 4 + j) * 256 + 2 * ch2 + 1]; }
    cb[0] = PIN(F, I_CONVB)[l * 256 + 2 * ch2]; cb[1] = PIN(F, I_CONVB)[l * 256 + 2 * ch2 + 1];

    for (int u = F.bid; u < BATCH * 64; u += F.G) {
        const int b = u >> 6, c = u & 63, t0 = c * 64; const size_t m0 = (size_t)b * SEQ + t0;
        {
            float w0[2] = {0.f, 0.f}, w1[2] = {0.f, 0.f}, w2[2] = {0.f, 0.f};
            const int tl0 = tg * 16;
#pragma unroll
            for (int j = 0; j < 3; ++j) { const int t = t0 + tl0 - 3 + j; float v0 = 0.f, v1 = 0.f;
                if (t >= 0) { const unsigned r = *(const unsigned*)(PROJ + ((size_t)b * SEQ + t) * NPROJ + PC_LX + 2 * ch2); v0 = bflo(r); v1 = bfhi(r); }
                if (j == 0) { w0[0] = v0; w0[1] = v1; } else if (j == 1) { w1[0] = v0; w1[1] = v1; } else { w2[0] = v0; w2[1] = v1; } }
#pragma unroll
            for (int tt = 0; tt < 16; ++tt) { const int tl = tl0 + tt;
                const unsigned r = *(const unsigned*)(PROJ + (m0 + tl) * NPROJ + PC_LX + 2 * ch2);
                const float v0 = bflo(r), v1 = bfhi(r);
                const float x0 = cw[0][0] * w0[0] + cw[1][0] * w1[0] + cw[2][0] * w2[0] + cw[3][0] * v0 + cb[0];
                const float x1 = cw[0][1] * w0[1] + cw[1][1] * w1[1] + cw[2][1] * w2[1] + cw[3][1] * v1 + cb[1];
                *(unsigned*)(XB + tl * XB_STRIDE + 2 * ch2) = pk2(x0, x1);
                XF[tl * 256 + 2 * ch2] = x0; XF[tl * 256 + 2 * ch2 + 1] = x1;
                w0[0] = w1[0]; w0[1] = w1[1]; w1[0] = w2[0]; w1[1] = w2[1]; w2[0] = v0; w2[1] = v1; }
        }
        SYNC();
        float CA[2] = {1.f, 1.f}, CU[2] = {0.f, 0.f};
#pragma unroll 1
        for (int m = 0; m < 4; ++m) {
            f32x4 acc[2][2];
#pragma unroll
            for (int gg = 0; gg < 2; ++gg)
#pragma unroll
                for (int nt = 0; nt < 2; ++nt) acc[gg][nt] = (f32x4){0.f, 0.f, 0.f, 0.f};
#pragma unroll
            for (int ks = 0; ks < 2; ++ks) { const bf16x8 A = *(const bf16x8*)(XB + (m * 16 + i16) * XB_STRIDE + blk * 64 + ks * 32 + 8 * g);
#pragma unroll
                for (int gg = 0; gg < 2; ++gg)
#pragma unroll
                    for (int nt = 0; nt < 2; ++nt) acc[gg][nt] = MFMA16(A, Bf[gg][nt][ks], acc[gg][nt]); }
#pragma unroll
            for (int nt = 0; nt < 2; ++nt) {
                const int ch = blk * 64 + (2 * nh + nt) * 16 + i16;
                float P[4], H[4]; float pa = 1.f, hu = 0.f;
#pragma unroll
                for (int r = 0; r < 4; ++r) { const int tok = m * 16 + 4 * g + r;
                    const float rg = fsigmoid(acc[0][nt][r] + ba[nt]), gi = fsigmoid(acc[1][nt][r] + bx[nt]);
                    const float la = -8.0f * rg * sp[nt], a = FEXP(la), uu = FSQRT(one_minus_exp(2.0f * la)) * (gi * XF[tok * 256 + ch]);
                    pa = a * pa; hu = a * hu + uu; P[r] = pa; H[r] = hu; }
                float EA = 1.f, EU = 0.f, TA = 1.f, TU = 0.f;
#pragma unroll
                for (int gg = 0; gg < 4; ++gg) { const float ta = SHFL(pa, i16 + 16 * gg), tu = SHFL(hu, i16 + 16 * gg);
                    if (gg < g) { EU = ta * EU + tu; EA = ta * EA; }
                    TU = ta * TU + tu; TA = ta * TA; }
                const float XA = EA * CA[nt], XU = EA * CU[nt] + EU;
#pragma unroll
                for (int r = 0; r < 4; ++r) { const int tok = m * 16 + 4 * g + r;
                    HLOC[(m0 + tok) * 256 + ch] = (bf16)f2bf(P[r] * XU + H[r]); CPA[(m0 + tok) * 256 + ch] = (bf16)f2bf(P[r] * XA); }
                CU[nt] = TA * CU[nt] + TU; CA[nt] = TA * CA[nt];
            }
        }
        if (g == 0) {
#pragma unroll
            for (int nt = 0; nt < 2; ++nt) { const int ch = blk * 64 + (2 * nh + nt) * 16 + i16;
                LSUM[((size_t)b * 64 + c) * 256 + ch] = CA[nt]; LSUM[(size_t)BATCH * 64 * 256 + ((size_t)b * 64 + c) * 256 + ch] = CU[nt]; }
        }
        SYNC();
    }
}

DEV float gelu_tanh(float x) { const float z = 0.7978845608028654f * (x + 0.044715f * x * x * x); return x * FRCP(1.0f + FEXP(-2.0f * z)); }
DEV void ph_carry(const Ctx& F) {
    if (F.wave != 0) return;
    const float* LSUM = (const float*)(F.ws + WS_LSUM); float* CARRY = (float*)(F.ws + WS_CARRY);
    const int seg = F.lane & 3;
    for (int chain = F.bid * 16 + (F.lane >> 2); chain < BATCH * 256; chain += F.G * 16) {
        const int b = chain >> 8, ch = chain & 255; const size_t o0 = ((size_t)b * 64 + seg * 16) * 256 + ch;
        float a[16], hb[16];
#pragma unroll
        for (int i = 0; i < 16; ++i) { a[i] = LSUM[o0 + (size_t)i * 256]; hb[i] = LSUM[(size_t)BATCH * 64 * 256 + o0 + (size_t)i * 256]; }
        float hp[16], ap[16], hl = 0.f, al = 1.f;
#pragma unroll
        for (int i = 0; i < 16; ++i) { hp[i] = hl; ap[i] = al; hl = a[i] * hl + hb[i]; al = a[i] * al; }
        float cin = 0.f;
#pragma unroll
        for (int s2 = 0; s2 < 3; ++s2) { const float as = SHFL(al, (F.lane & ~3) + s2), hs = SHFL(hl, (F.lane & ~3) + s2); if (s2 < seg) cin = as * cin + hs; }
#pragma unroll
        for (int i = 0; i < 16; ++i) CARRY[o0 + (size_t)i * 256] = ap[i] * cin + hp[i];
    }
}
DEV void ph_lru2(const Ctx& F, int l) {
    const int tid = F.tid, lane = F.lane, w = F.wave;
    const bf16* PROJ = (const bf16*)(F.ws + WS_PROJ); const bf16* HLOC = (const bf16*)(F.ws + WS_HLOC); const bf16* CPA = (const bf16*)(F.ws + WS_CPA);
    const float* CARRY = (const float*)(F.ws + WS_CARRY); bf16* CAT = (bf16*)(F.ws + WS_CAT);
    const f32x4 gw4 = *(const f32x4*)(PIN(F, I_GNW) + l * DM + 4 * lane);
    for (int u = F.bid; u < BATCH * 64; u += F.G) {
        const int b = u >> 6, c = u & 63; const size_t m0 = (size_t)b * SEQ + c * 64;
        const f32x4 car = *(const f32x4*)(CARRY + (size_t)u * 256 + 4 * lane);
        u32x2 hl8[8], cp8[8], ly8[8];
#pragma unroll
        for (int tt = 0; tt < 8; ++tt) { const size_t m = m0 + w * 8 + tt;
            hl8[tt] = *(const u32x2*)(HLOC + m * 256 + 4 * lane); cp8[tt] = *(const u32x2*)(CPA + m * 256 + 4 * lane); ly8[tt] = *(const u32x2*)(PROJ + m * NPROJ + PC_LY + 4 * lane); }
#pragma unroll
        for (int tt = 0; tt < 8; ++tt) { const size_t m = m0 + w * 8 + tt; const u32x2 hl = hl8[tt], cp = cp8[tt], ly = ly8[tt];
            float v0 = (bflo(hl.x) + bflo(cp.x) * car.x) * gelu_tanh(bflo(ly.x));
            float v1 = (bfhi(hl.x) + bfhi(cp.x) * car.y) * gelu_tanh(bfhi(ly.x));
            float v2 = (bflo(hl.y) + bflo(cp.y) * car.z) * gelu_tanh(bflo(ly.y));
            float v3 = (bfhi(hl.y) + bfhi(cp.y) * car.w) * gelu_tanh(bfhi(ly.y));
            const float rs = RSQ(wave_sum((v0 * v0 + v1 * v1) + (v2 * v2 + v3 * v3)) * (1.0f / 256.0f) + NORM_EPS);
            u32x2 o; o.x = pk2(v0 * rs * gw4.x, v1 * rs * gw4.y); o.y = pk2(v2 * rs * gw4.z, v3 * rs * gw4.w);
            *(u32x2*)(CAT + m * DM + 4 * lane) = o; }
    }
}

constexpr int QS_STRIDE = 136, VE_STRIDE = 56;
DEV void ph_mlstm(const Ctx& F, int l) {
    const int tid = F.tid, lane = F.lane, w = F.wave, i16 = lane & 15, g = lane >> 4;
    bf16* QsB = (bf16*)F.lds;
    bf16* KsB = QsB + 2 * 64 * QS_STRIDE;
    bf16* VE = KsB + 2 * 64 * QS_STRIDE;
    bf16* VW = VE + 64 * VE_STRIDE;
    bf16* CsB = VW + 64 * VE_STRIDE;
    float* BCB = (float*)(CsB + 2 * 128 * VE_STRIDE);
    float* BIB = BCB + 128;
    const bf16* PROJ = (const bf16*)(F.ws + WS_PROJ); bf16* HM = (bf16*)(F.ws + WS_HM);
    const float qscale = 0.08838834764831845f;
    const int jt = w & 3, half = w >> 2;
    for (int u = F.bid; u < BATCH * 4 * 4; u += F.G) {
        const int b = u >> 4, h = (u >> 2) & 3, vs = u & 3;
        const float gbi = PIN(F, I_BI)[l * 4 + h], gbf = PIN(F, I_BF)[l * 4 + h];
        f32x4 accC[3];
#pragma unroll
        for (int nt = 0; nt < 3; ++nt) accC[nt] = (f32x4){0.f, 0.f, 0.f, 0.f};
        float* BCg = (float*)(F.ws + WS_MG) + (size_t)u * 8192; float* BIg = BCg + 4096;
        unsigned gri[8], grf[8];
#pragma unroll
        for (int k = 0; k < 8; ++k) { const bf16* pr = PROJ + ((size_t)b * SEQ + (8 * k + w) * 64 + lane) * NPROJ; gri[k] = pr[PC_MI + h]; grf[k] = pr[PC_MF + h]; }
#pragma unroll
        for (int k = 0; k < 8; ++k) { const int tok = (8 * k + w) * 64 + lane;
            const float zi = (bf2f(gri[k]) + gbi) * (1.0f / 15.0f), zf = (bf2f(grf[k]) + gbf) * (1.0f / 15.0f);
            const float ig = 15.0f - 30.0f * FRCP(FEXP(2.0f * zi) + 1.0f), fg = 15.0f - 30.0f * FRCP(FEXP(2.0f * zf) + 1.0f);
            float s = -FLOG(1.0f + FEXP(-fg));
#pragma unroll
            for (int o = 1; o < 64; o <<= 1) { const float t = SHFL_UP(s, o); if (lane >= o) s += t; }
            BCg[tok] = s; BIg[tok] = s - ig; }
        SYNC();
        u32x4 rq[2], rk[2]; u32x2 rvv; float rgc = 0.f, rgb = 0.f;
        {
            const size_t m0 = (size_t)b * SEQ;
#pragma unroll
            for (int i = 0; i < 2; ++i) { const int idx = tid + 512 * i, row = idx >> 4, ck = idx & 15;
                rq[i] = *(const u32x4*)(PROJ + (m0 + row) * NPROJ + PC_MQ + h * 128 + 8 * ck); rk[i] = *(const u32x4*)(PROJ + (m0 + row) * NPROJ + PC_MK + h * 128 + 8 * ck); }
            rvv = *(const u32x2*)(PROJ + (m0 + (tid >> 3)) * NPROJ + PC_MV + h * 128 + vs * 32 + 4 * (tid & 7));
            if (tid < 64) { rgc = BCg[tid]; rgb = BIg[tid]; }
        }
        for (int c = 0; c < 64; ++c) {
            const size_t m0 = (size_t)b * SEQ + c * 64; const int buf = c & 1;
            bf16* Qs = QsB + buf * 64 * QS_STRIDE; bf16* Ks = KsB + buf * 64 * QS_STRIDE; const bf16* Cs = CsB + buf * 128 * VE_STRIDE; bf16* Cn = CsB + (buf ^ 1) * 128 * VE_STRIDE;
            float* BC = BCB + buf * 64; float* BI = BIB + buf * 64;
#pragma unroll
            for (int i = 0; i < 2; ++i) { const int idx = tid + 512 * i, row = idx >> 4, ck = idx & 15;
                *(u32x4*)(Qs + row * QS_STRIDE + 8 * ck) = rq[i]; *(u32x4*)(Ks + row * QS_STRIDE + 8 * ck) = rk[i]; }
            if (tid < 64) { BC[tid] = rgc; BI[tid] = rgb; }
            SYNC();
            {
                const int row = tid >> 3, cg = tid & 7;
                const u32x2 rv = rvv;
                const float wt = FEXP(BC[63] - BI[row]);
                *(u32x2*)(VE + row * VE_STRIDE + 4 * cg) = rv;
                u32x2 sv; sv.x = pk2(bflo(rv.x) * wt, bfhi(rv.x) * wt); sv.y = pk2(bflo(rv.y) * wt, bfhi(rv.y) * wt);
                *(u32x2*)(VW + row * VE_STRIDE + 4 * cg) = sv;
                if (cg == 0) { unsigned one_ = 0x3f80u; LAUNDER_V(one_); u32x4 z = (u32x4){one_, 0u, 0u, 0u}; *(u32x4*)(VE + row * VE_STRIDE + 32) = z; *(u32x4*)(VE + row * VE_STRIDE + 40) = (u32x4){0u, 0u, 0u, 0u};
                    z.x = f2bf(wt); *(u32x4*)(VW + row * VE_STRIDE + 32) = z; *(u32x4*)(VW + row * VE_STRIDE + 40) = (u32x4){0u, 0u, 0u, 0u}; }
            }
            if (c + 1 < 64) {
                const size_t m1 = m0 + 64;
#pragma unroll
                for (int i = 0; i < 2; ++i) { const int idx = tid + 512 * i, row = idx >> 4, ck = idx & 15;
                    rq[i] = *(const u32x4*)(PROJ + (m1 + row) * NPROJ + PC_MQ + h * 128 + 8 * ck); rk[i] = *(const u32x4*)(PROJ + (m1 + row) * NPROJ + PC_MK + h * 128 + 8 * ck); }
                rvv = *(const u32x2*)(PROJ + (m1 + (tid >> 3)) * NPROJ + PC_MV + h * 128 + vs * 32 + 4 * (tid & 7));
                if (tid < 64) { rgc = BCg[(c + 1) * 64 + tid]; rgb = BIg[(c + 1) * 64 + tid]; }
            }
            SYNC();
            f32x4 Z[2] = {(f32x4){0.f, 0.f, 0.f, 0.f}, (f32x4){0.f, 0.f, 0.f, 0.f}};
            {
                bf16x8 Bq[4];
#pragma unroll
                for (int ks = 0; ks < 4; ++ks) Bq[ks] = *(const bf16x8*)(Qs + (16 * jt + i16) * QS_STRIDE + 32 * ks + 8 * g);
                const float bj = BC[16 * jt + i16];
                unsigned pk[4][2];
#pragma unroll
                for (int tt = 0; tt < 4; ++tt) {
                    if (tt <= jt) {
                        f32x4 X = (f32x4){0.f, 0.f, 0.f, 0.f};
#pragma unroll
                        for (int ks = 0; ks < 4; ++ks) X = MFMA16(*(const bf16x8*)(Ks + (16 * tt + i16) * QS_STRIDE + 32 * ks + 8 * g), Bq[ks], X);
                        float p[4]; const f32x4 bi4 = *(const f32x4*)(BI + 16 * tt + 4 * g);
#pragma unroll
                        for (int r = 0; r < 4; ++r) { const float pv = X[r] * qscale * FEXP(fminf(bj - bi4[r], 60.0f));
                            p[r] = (tt < jt || 4 * g + r <= i16) ? pv : 0.f; }
                        pk[tt][0] = pk2(p[0], p[1]); pk[tt][1] = pk2(p[2], p[3]);
                    } else { pk[tt][0] = 0u; pk[tt][1] = 0u; }
                }
#pragma unroll
                for (int pr = 0; pr < 2; ++pr) {
                    if (2 * pr <= jt) {
                        u32x4 aw = (u32x4){pk[2 * pr][0], pk[2 * pr][1], pk[2 * pr + 1][0], pk[2 * pr + 1][1]};
                        const bf16x8 A = __builtin_bit_cast(bf16x8, aw);
#pragma unroll
                        for (int n = 0; n < 2; ++n) { const int ntc = n ? 2 : half;
                            const s16x4 lo = TR16(VE + (32 * pr + 4 * g + (i16 >> 2)) * VE_STRIDE + 16 * ntc + 4 * (i16 & 3));
                            const s16x4 hi = TR16(VE + (32 * pr + 16 + 4 * g + (i16 >> 2)) * VE_STRIDE + 16 * ntc + 4 * (i16 & 3));
                            const bf16x8 B = (bf16x8){lo[0], lo[1], lo[2], lo[3], hi[0], hi[1], hi[2], hi[3]};
                            Z[n] = MFMA16(A, B, Z[n]); }
#ifndef HOST_EMU
                        asm volatile("" :: "v"(aw));
#endif
                    }
                }
            }
            if (c > 0) {
                f32x4 Z2[2] = {(f32x4){0.f, 0.f, 0.f, 0.f}, (f32x4){0.f, 0.f, 0.f, 0.f}};
#pragma unroll
                for (int ks = 0; ks < 4; ++ks) { const bf16x8 A = *(const bf16x8*)(Qs + (16 * jt + i16) * QS_STRIDE + 32 * ks + 8 * g);
#pragma unroll
                    for (int n = 0; n < 2; ++n) { const int ntc = n ? 2 : half;
                        const s16x4 lo = TR16(Cs + (32 * ks + 8 * g + (i16 >> 2)) * VE_STRIDE + 16 * ntc + 4 * (i16 & 3));
                        const s16x4 hi = TR16(Cs + (32 * ks + 8 * g + 4 + (i16 >> 2)) * VE_STRIDE + 16 * ntc + 4 * (i16 & 3));
                        const bf16x8 B = (bf16x8){lo[0], lo[1], lo[2], lo[3], hi[0], hi[1], hi[2], hi[3]};
                        Z2[n] = MFMA16(A, B, Z2[n]); } }
                const f32x4 bc4 = *(const f32x4*)(BC + 16 * jt + 4 * g);
#pragma unroll
                for (int r = 0; r < 4; ++r) { const float f = qscale * FEXP(bc4[r]); Z[0][r] += f * Z2[0][r]; Z[1][r] += f * Z2[1][r]; }
            }
#pragma unroll
            for (int r = 0; r < 4; ++r) { const int j = 16 * jt + 4 * g + r; const float dn = FRCP(fmaxf(fabsf(SHFL(Z[1][r], lane & 48)), 1.0f));
                HM[(m0 + j) * 512 + h * 128 + vs * 32 + 16 * half + i16] = (bf16)f2bf(Z[0][r] * dn); }
            {
                const float dec = FEXP(BC[63]);
#pragma unroll
                for (int nt = 0; nt < 3; ++nt) accC[nt] = accC[nt] * dec;
#pragma unroll
                for (int ks = 0; ks < 2; ++ks) {
                    const s16x4 alo = TR16(Ks + (32 * ks + 8 * g + (i16 >> 2)) * QS_STRIDE + 16 * w + 4 * (i16 & 3));
                    const s16x4 ahi = TR16(Ks + (32 * ks + 8 * g + 4 + (i16 >> 2)) * QS_STRIDE + 16 * w + 4 * (i16 & 3));
                    const bf16x8 A = (bf16x8){alo[0], alo[1], alo[2], alo[3], ahi[0], ahi[1], ahi[2], ahi[3]};
#pragma unroll
                    for (int nt = 0; nt < 3; ++nt) {
                        const s16x4 lo = TR16(VW + (32 * ks + 8 * g + (i16 >> 2)) * VE_STRIDE + 16 * nt + 4 * (i16 & 3));
                        const s16x4 hi = TR16(VW + (32 * ks + 8 * g + 4 + (i16 >> 2)) * VE_STRIDE + 16 * nt + 4 * (i16 & 3));
                        const bf16x8 B = (bf16x8){lo[0], lo[1], lo[2], lo[3], hi[0], hi[1], hi[2], hi[3]};
                        const f32x4 cold = accC[nt]; accC[nt] = MFMA16(A, B, cold);
#ifndef HOST_EMU
                        asm volatile("" :: "v"(cold), "v"(A), "v"(B));
#endif
                    }
                }
#pragma unroll
                for (int nt = 0; nt < 3; ++nt)
#pragma unroll
                    for (int r = 0; r < 4; ++r) Cn[(16 * w + 4 * g + r) * VE_STRIDE + 16 * nt + i16] = (bf16)f2bf(accC[nt][r]);
            }
        }
        SYNC();
    }
}

DEV void ph_mfin(const Ctx& F, int l) {
    const int gw = F.bid * 8 + F.wave, NGW = F.G * 8, lane = F.lane;
    const bf16* PROJ = (const bf16*)(F.ws + WS_PROJ); const bf16* HM = (const bf16*)(F.ws + WS_HM); bf16* CAT = (bf16*)(F.ws + WS_CAT);
    float gm[8];
#pragma unroll
    for (int j = 0; j < 8; ++j) gm[j] = PIN(F, I_GNW)[l * DM + 256 + 8 * lane + j];
    u32x4 hv4[4], ov4[4], hvn[4], ovn[4];
#define MFIN_LOAD(HV, OV, M0) do { _Pragma("unroll") for (int q = 0; q < 4; ++q) { const int mm = (M0) + q * NGW; const size_t ms = (size_t)(mm < MTOK ? mm : 0); \
            HV[q] = *(const u32x4*)(HM + ms * 512 + 8 * lane); OV[q] = *(const u32x4*)(PROJ + ms * NPROJ + PC_MO + 8 * lane); } } while (0)
    MFIN_LOAD(hv4, ov4, gw);
    for (int m0 = gw; m0 < MTOK; m0 += 4 * NGW) {
        MFIN_LOAD(hvn, ovn, m0 + 4 * NGW);
#pragma unroll
        for (int q = 0; q < 4; ++q) { const int m = m0 + q * NGW; if (m >= MTOK) break;
            const u32x4 hv = hv4[q], ov = ov4[q];
            float v[8] = {bflo(hv.x), bfhi(hv.x), bflo(hv.y), bfhi(hv.y), bflo(hv.z), bfhi(hv.z), bflo(hv.w), bfhi(hv.w)};
            const float o[8] = {bflo(ov.x), bfhi(ov.x), bflo(ov.y), bfhi(ov.y), bflo(ov.z), bfhi(ov.z), bflo(ov.w), bfhi(ov.w)};
            float s = 0.f;
#pragma unroll
            for (int j = 0; j < 8; ++j) s += v[j] * v[j];
            s += SHFL_XOR(s, 1); s += SHFL_XOR(s, 2); s += SHFL_XOR(s, 4); s += SHFL_XOR(s, 8);
            const float rs = RSQ(s * (1.0f / 128.0f) + NORM_EPS);
            u32x4 r;
            r.x = pk2(v[0] * rs * gm[0] * fsigmoid(o[0]), v[1] * rs * gm[1] * fsigmoid(o[1]));
            r.y = pk2(v[2] * rs * gm[2] * fsigmoid(o[2]), v[3] * rs * gm[3] * fsigmoid(o[3]));
            r.z = pk2(v[4] * rs * gm[4] * fsigmoid(o[4]), v[5] * rs * gm[5] * fsigmoid(o[5]));
            r.w = pk2(v[6] * rs * gm[6] * fsigmoid(o[6]), v[7] * rs * gm[7] * fsigmoid(o[7]));
            *(u32x4*)(CAT + (size_t)m * DM + 256 + 8 * lane) = r; }
#pragma unroll
        for (int q = 0; q < 4; ++q) { hv4[q] = hvn[q]; ov4[q] = ovn[q]; }
    }
#undef MFIN_LOAD
}

constexpr int DS_HIST = 0;
constexpr int DS_MASK = 49152;
constexpr int DS_CAND = 65536;
constexpr int DS_SELL = 102400;
constexpr int DS_META = 118784;
constexpr int DS_RB = DS_META + 512;
constexpr int DS_SS = DS_RB + 2048;
constexpr int DS_SLOT = 12800;
constexpr int NBIN = 768, CAND_CAP = 128;
__device__ const unsigned char T5B[114] = {0, 1, 2, 3, 4, 5, 6, 7, 8, 9, 10, 11, 12, 13, 14, 15, 16, 16, 16, 17, 17, 18, 18, 18, 19, 19, 19, 20, 20, 20, 20, 21, 21, 21, 21, 22, 22, 22, 22, 22, 23, 23, 23, 23, 23, 23, 24, 24, 24, 24, 24, 24, 25, 25, 25, 25, 25, 25, 25, 26, 26, 26, 26, 26, 26, 26, 26, 27, 27, 27, 27, 27, 27, 27, 27, 27, 27, 28, 28, 28, 28, 28, 28, 28, 28, 28, 28, 29, 29, 29, 29, 29, 29, 29, 29, 29, 29, 29, 29, 30, 30, 30, 30, 30, 30, 30, 30, 30, 30, 30, 30, 30, 30, 31};

DEV int score_bin(float sc) {
    const unsigned u = __builtin_bit_cast(unsigned, sc);
    int e = (int)((u >> 18) & 0x1FFFu) - 119 * 32; e = e < 0 ? 0 : (e > 383 ? 383 : e);
    return (u >> 31) ? 383 - e : 384 + e;
}
DEV unsigned score_key(float sc) { const unsigned u = __builtin_bit_cast(unsigned, sc); return (u >> 31) ? ~u : (u | 0x80000000u); }
DEV unsigned score_code(float sc) {
    const unsigned u = __builtin_bit_cast(unsigned, sc);
    int e = (int)((u >> 18) & 0x1FFFu) - 119 * 32; e = e < 0 ? 0 : (e > 383 ? 383 : e);
    return ((u >> 16) & 0x8000u) | ((unsigned)e << 6) | ((u >> 12) & 63u);
}
DEV int code_bin(unsigned c) { const int e = (int)((c >> 6) & 0x1FFu); return (c & 0x8000u) ? 383 - e : 384 + e; }
DEV unsigned code_key(unsigned c) { return (c & 0x8000u) ? 63u - (c & 63u) : (c & 63u); }


DEV f32x4 dsa_score_tile(const bf16x8 A, const bf16x8 (&QS)[2], const bf16x8 (&Bq)[8], const float (&wq)[8]) {
    f32x4 sc = (f32x4){0.f, 0.f, 0.f, 0.f};
#pragma unroll
    for (int h = 0; h < 8; ++h) { const f32x4 d = MFMA16(A, Bq[h], (f32x4){0.f, 0.f, 0.f, 0.f});
#pragma unroll
        for (int r = 0; r < 4; ++r) sc[r] += wq[h] * RELU(d[r]); }
    return sc;
}
DEV void ph_dsa(const Ctx& F, int l) {
    const int tid = F.tid, lane = F.lane, w = F.wave, i16 = lane & 15, g = lane >> 4;
    unsigned* HIST = (unsigned*)(F.lds + DS_HIST); unsigned* MASK = (unsigned*)(F.lds + DS_MASK); u32x2* CAND = (u32x2*)(F.lds + DS_CAND);
    unsigned short* SELL = (unsigned short*)(F.lds + DS_SELL); int* BST = (int*)(F.lds + DS_META); int* NAB = BST + 32; int* NCAND = BST + 64; int* NSEL = BST + 96;
    float* RB = (float*)(F.lds + DS_RB);
    const bf16* QIDX = (const bf16*)(F.ws + WS_QIDX); const bf16* KIDX = (const bf16*)(F.ws + WS_KIDX); const float* WI = (const float*)(F.ws + WS_WI);
    const bf16* QABS = (const bf16*)(F.ws + WS_QABS); const bf16* CKV = (const bf16*)(F.ws + WS_CKV); bf16* CAT = (bf16*)(F.ws + WS_CAT);
    const bf16* WUVT = (const bf16*)(F.ws + WS_WUVT) + (size_t)l * 4 * 64 * 128; float* SS = (float*)(F.lds + DS_SS);
    for (int e = tid; e < 114 * 4; e += 512) RB[e] = PIN(F, I_RELB)[T5B[e >> 2] * 4 + (e & 3)] * 1.4426950408889634f;
    SYNC();
    for (int ui = F.bid; ui < BATCH * 128; ui += F.G) {
        int b, qt; { const int wv = ui & 255, k = ui >> 8, r = wv & 15; b = wv >> 4; qt = (k & 1) ? (32 * (k >> 1) + 31 - r) : (32 * (k >> 1) + r); }
        const int t0 = 32 * qt, nkt = 2 * qt + 2; const size_t mb = (size_t)b * SEQ;
        const GAS char* const ckvb = UNIP(CKV + mb * 128);
        const int nt = w & 1;
        u32x2* sw = (u32x2*)(F.ws + (F.bid < 128 ? WS_QL + (size_t)F.bid * 262144 : WS_SCR2 + (size_t)(F.bid - 128) * 262144) + (size_t)w * 32768) + lane;
        bf16x8 Bq[8]; float wq[8];
        { const size_t mq = mb + t0 + 16 * nt + i16;
#pragma unroll
            for (int h = 0; h < 8; ++h) { Bq[h] = *(const bf16x8*)(QIDX + mq * 256 + 32 * h + 8 * g); wq[h] = WI[mq * 8 + h]; } }
        bf16x8 QS[2];
#pragma unroll
        for (int j = 0; j < 8; ++j) { float s = 0.f;
#pragma unroll
            for (int h = 0; h < 8; ++h) s += wq[h] * bf2f((unsigned)(unsigned short)Bq[h][j]);
            const unsigned hi = f2bf(s); QS[0][j] = (short)hi; QS[1][j] = (short)f2bf(s - bf2f(hi)); }
        for (int e = tid; e < 16 * NBIN; e += 512) HIST[e] = 0u;
        for (int e = tid; e < 32 * 128; e += 512) MASK[e] = 0u;
        if (tid < 32) NCAND[tid] = 0;
        SYNC();
        bf16x8 Apre = *(const bf16x8*)(KIDX + (mb + 16 * (w >> 1) + i16) * 32 + 8 * g);
        for (int kt = w >> 1; kt < nkt; kt += 4) {
            const bf16x8 A = Apre;
            { const int kn = kt + 4 < nkt ? kt + 4 : kt; Apre = *(const bf16x8*)(KIDX + (mb + 16 * kn + i16) * 32 + 8 * g); }
            const f32x4 sc = dsa_score_tile(A, QS, Bq, wq);
            unsigned cd[4];
#pragma unroll
            for (int r = 0; r < 4; ++r) cd[r] = score_code(sc[r] + 0.0f);
            { u32x2 pk; pk.x = cd[0] | (cd[1] << 16); pk.y = cd[2] | (cd[3] << 16); sw[(size_t)((kt - (w >> 1)) >> 2) * 64] = pk; }
            const unsigned inc = nt ? 65536u : 1u;
            if (kt < 2 * qt) {
#pragma unroll
                for (int r = 0; r < 4; ++r) atomicAdd(&HIST[i16 * NBIN + code_bin(cd[r])], inc);
            } else {
                const int t = t0 + 16 * nt + i16;
#pragma unroll
                for (int r = 0; r < 4; ++r) { const int s = 16 * kt + 4 * g + r;
                    if (s <= t) atomicAdd(&HIST[i16 * NBIN + code_bin(cd[r])], inc); }
            }
        }
        SYNC();
#pragma unroll 1
        for (int rr = 0; rr < 4; ++rr) {
            const int row = 4 * w + rr, t = t0 + row;
            if (t < 256) { if (lane == 0) { BST[row] = -1; NAB[row] = t + 1; } continue; }
            const int sh = (row >> 4) * 16; const unsigned* hp = HIST + (row & 15) * NBIN + 12 * lane;
            int cnt[12]; int tot = 0;
#pragma unroll
            for (int i = 0; i < 12; ++i) { cnt[i] = (int)((hp[i] >> sh) & 0xFFFFu); tot += cnt[i]; }
            int suf = tot;
#pragma unroll
            for (int o = 1; o < 64; o <<= 1) { const int v = SHFL_DOWN(suf, o); if (lane + o < 64) suf += v; }
            const int above = suf - tot;
            if (above < 256 && above + tot >= 256) {
                int run = above, bs = -1, na = 0; bool done = false;
#pragma unroll
                for (int i = 11; i >= 0; --i) { if (!done) { if (run + cnt[i] >= 256) { bs = 12 * lane + i; na = run; done = true; } else run += cnt[i]; } }
                BST[row] = bs; NAB[row] = na;
            }
        }
        SYNC();
        { const int row = 16 * nt + i16, t = t0 + row, bs = BST[row];
        const int ntl = nkt > (w >> 1) ? ((nkt - 1 - (w >> 1)) >> 2) + 1 : 0;
        u32x2 P0 = sw[0], P1 = sw[(size_t)(1 < ntl ? 1 : 0) * 64];
        for (int j = 0; j < ntl; ++j) { const int kt = (w >> 1) + 4 * j;
            const u32x2 pc = P0; P0 = P1; P1 = sw[(size_t)(j + 2 < ntl ? j + 2 : j) * 64];
            const bool full = kt < 2 * qt;
#pragma unroll
            for (int r = 0; r < 4; ++r) { const int s = 16 * kt + 4 * g + r;
                if (full || s <= t) { const unsigned wd = r < 2 ? pc.x : pc.y; const unsigned c = (r & 1) ? (wd >> 16) : (wd & 0xffffu); const int bn = code_bin(c);
                    if (bn > bs) atomicOr(&MASK[row * 128 + (s >> 5)], 1u << (s & 31));
                    else if (bn == bs) { const int pos = (int)atomicAdd((unsigned*)&NCAND[row], 1u); if (pos < CAND_CAP) CAND[row * CAND_CAP + pos] = (u32x2){code_key(c), (unsigned)s}; } } }
        } }
        SYNC();
#pragma unroll 1
        for (int rr = 0; rr < 4; ++rr) {
            const int row = 4 * w + rr; if (BST[row] < 0) continue;
            const int n = NCAND[row] < CAND_CAP ? NCAND[row] : CAND_CAP, need = 256 - NAB[row];
            for (int i = lane; i < n; i += 64) { const u32x2 me = CAND[row * CAND_CAP + i]; int rank = 0;
                for (int j = 0; j < n; ++j) { const u32x2 o = CAND[row * CAND_CAP + j]; rank += (o.x > me.x || (o.x == me.x && o.y < me.y)) ? 1 : 0; }
#ifndef DSA_DBG_NOCAND
                if (rank < need) atomicOr(&MASK[row * 128 + (me.y >> 5)], 1u << (me.y & 31));
#endif
            }
        }
        SYNC();
#ifdef DSA_DBG_SEL
        for (int e = tid; e < 32 * 128; e += 512) { const int row = e >> 7, wi = e & 127, t = t0 + row, lo = t - 255 < 0 ? 0 : t - 255; unsigned m = 0u;
            for (int bq = 0; bq < 32; ++bq) { const int s = 32 * wi + bq; if (s >= lo && s <= t) m |= 1u << bq; }
            MASK[e] = m; }
        SYNC();
#endif
#pragma unroll 1
        for (int rr = 0; rr < 4; ++rr) {
            const int row = 4 * w + rr;
            unsigned w0 = MASK[row * 128 + 2 * lane], w1 = MASK[row * 128 + 2 * lane + 1];
            const int c = __builtin_popcount(w0) + __builtin_popcount(w1);
            int inc = c;
#pragma unroll
            for (int o = 1; o < 64; o <<= 1) { const int v = SHFL_UP(inc, o); if (lane >= o) inc += v; }
            int pos = inc - c;
            while (w0) { const int bt = __builtin_ctz(w0); w0 &= w0 - 1; if (pos < 256) SELL[row * 256 + pos] = (unsigned short)(64 * lane + bt); ++pos; }
            while (w1) { const int bt = __builtin_ctz(w1); w1 &= w1 - 1; if (pos < 256) SELL[row * 256 + pos] = (unsigned short)(64 * lane + 32 + bt); ++pos; }
            if (lane == 63) NSEL[row] = inc < 256 ? inc : 256;
        }
        SYNC();
        bf16* TL = (bf16*)(F.lds + w * DS_SLOT); bf16* OLw = (bf16*)(F.lds + w * DS_SLOT + 8704);
#pragma unroll 1
        for (int rr = 0; rr < 4; ++rr) {
            const int row = 4 * w + rr, t = t0 + row, ns = UNI(NSEL[row]); const size_t mt = mb + t;
            const unsigned short* sl = SELL + row * 256;
            bf16x8 Bh[4];
#pragma unroll
            for (int ks = 0; ks < 4; ++ks) Bh[ks] = i16 < 4 ? *(const bf16x8*)(QABS + mt * 512 + i16 * 128 + 32 * ks + 8 * g) : (bf16x8){0, 0, 0, 0, 0, 0, 0, 0};
            f32x4 O[8];
#pragma unroll
            for (int nt = 0; nt < 8; ++nt) O[nt] = (f32x4){0.f, 0.f, 0.f, 0.f};
            float mrun = -1e30f, lrun = 0.f;
            const float bfar = RB[113 * 4 + (i16 & 3)];
            const int nch = (ns + 31) >> 5;
            u32x4 gvA[8];
#define ATT_LOAD(GV, CK, FULL) do { int sidx[8]; \
                _Pragma("unroll") for (int i = 0; i < 8; ++i) sidx[i] = (int)sl[32 * (CK) + 4 * i + g];            \
                _Pragma("unroll") for (int i = 0; i < 8; ++i) { const int kp = 32 * (CK) + 4 * i + g; sidx[i] = (FULL || kp < ns) ? sidx[i] : 0; } \
                _Pragma("unroll") for (int i = 0; i < 8; ++i) GV[i] = *(const GAS u32x4*)(ckvb + (((unsigned)sidx[i] << 8) + 16u * (unsigned)i16)); } while (0)
#define ATT_STEP(GV, CK, FULL) do { const int ck = (CK); \
                _Pragma("unroll") for (int i = 0; i < 8; ++i) *(u32x4*)(TL + (4 * i + g) * 136 + 8 * i16) = GV[i]; \
                const u32x2 sk0 = *(const u32x2*)(sl + 32 * ck + 4 * g), sk1 = *(const u32x2*)(sl + 32 * ck + 16 + 4 * g); \
                WAVE_LDS_FENCE(); \
                if (ck + 1 < nch) ATT_LOAD(GV, ck + 1, FULL); \
                float bia[2][4]; \
                if (FULL && t - UNI((int)sl[32 * ck + 31]) >= 113) {                   \
                _Pragma("unroll") for (int kt = 0; kt < 2; ++kt) \
                _Pragma("unroll") for (int r = 0; r < 4; ++r) bia[kt][r] = bfar; \
                } else { \
                _Pragma("unroll") for (int kt = 0; kt < 2; ++kt) \
                _Pragma("unroll") for (int r = 0; r < 4; ++r) { const unsigned wd = kt ? (r < 2 ? sk1.x : sk1.y) : (r < 2 ? sk0.x : sk0.y); \
                        int dist = t - (int)((wd >> (16 * (r & 1))) & 0xffffu); dist = dist < 0 ? 0 : (dist > 113 ? 113 : dist); \
                        bia[kt][r] = RB[dist * 4 + (i16 & 3)]; } } \
                f32x4 lg[2]; \
                _Pragma("unroll") for (int kt = 0; kt < 2; ++kt) { lg[kt] = (f32x4){0.f, 0.f, 0.f, 0.f}; \
                _Pragma("unroll") for (int ks = 0; ks < 4; ++ks) lg[kt] = MFMA16(*(const bf16x8*)(TL + (16 * kt + i16) * 136 + 32 * ks + 8 * g), Bh[ks], lg[kt]); } \
                float cm = -1e30f; \
                _Pragma("unroll") for (int kt = 0; kt < 2; ++kt) \
                _Pragma("unroll") for (int r = 0; r < 4; ++r) { const int kp = 32 * ck + 16 * kt + 4 * g + r; \
                        lg[kt][r] = (FULL || kp < ns) ? lg[kt][r] + bia[kt][r] : -1e30f; cm = fmaxf(cm, lg[kt][r]); } \
                if (ck == 0) { cm = fmaxf(cm, SHFL_XOR(cm, 16)); cm = fmaxf(cm, SHFL_XOR(cm, 32)); mrun = cm; } \
                float p[2][4]; \
                _Pragma("unroll") for (int kt = 0; kt < 2; ++kt) \
                _Pragma("unroll") for (int r = 0; r < 4; ++r) { p[kt][r] = (FULL || lg[kt][r] > -1e29f) ? FEXP2(lg[kt][r] - mrun) : 0.f; lrun += p[kt][r]; } \
                u32x4 aw = (u32x4){0u, 0u, 0u, 0u}; \
                if (i16 < 4) aw = (u32x4){pk2(p[0][0], p[0][1]), pk2(p[0][2], p[0][3]), pk2(p[1][0], p[1][1]), pk2(p[1][2], p[1][3])}; \
                const bf16x8 A = __builtin_bit_cast(bf16x8, aw); \
                _Pragma("unroll") for (int nt = 0; nt < 8; ++nt) { \
                    const s16x4 lo = TR16(TL + (4 * g + (i16 >> 2)) * 136 + 16 * nt + 4 * (i16 & 3)); \
                    const s16x4 hi = TR16(TL + (16 + 4 * g + (i16 >> 2)) * 136 + 16 * nt + 4 * (i16 & 3)); \
                    const bf16x8 B = (bf16x8){lo[0], lo[1], lo[2], lo[3], hi[0], hi[1], hi[2], hi[3]}; \
                    O[nt] = MFMA16(A, B, O[nt]); } \
                WAVE_LDS_FENCE(); } while (0)
            if (ns == 256) { ATT_LOAD(gvA, 0, true); for (int ck2 = 0; ck2 < 8; ++ck2) ATT_STEP(gvA, ck2, true); }
            else { ATT_LOAD(gvA, 0, false); for (int ck2 = 0; ck2 < nch; ++ck2) ATT_STEP(gvA, ck2, false); }
#undef ATT_STEP
#undef ATT_LOAD
            lrun += SHFL_XOR(lrun, 16); lrun += SHFL_XOR(lrun, 32);
            float li[4];
#pragma unroll
            for (int r = 0; r < 4; ++r) li[r] = FRCP(SHFL(lrun, r));
            if (g == 0) {
#pragma unroll
                for (int nt = 0; nt < 8; ++nt)
#pragma unroll
                    for (int r = 0; r < 4; ++r) OLw[(rr * 4 + r) * 128 + 16 * nt + i16] = (bf16)f2bf(O[nt][r] * li[r]);
            }
        }
        SYNC();
        {
            const int h = w >> 1, mtile = w & 1, q = 16 * mtile + i16;
            const bf16* olq = (const bf16*)(F.lds + (q >> 2) * DS_SLOT + 8704) + ((q & 3) * 4 + h) * 128;
            float gaw[4];
#pragma unroll
            for (int nt = 0; nt < 4; ++nt) gaw[nt] = PIN(F, I_GNW)[l * DM + 768 + h * 64 + 16 * nt + i16];
            f32x4 acc[4];
#pragma unroll
            for (int nt = 0; nt < 4; ++nt) acc[nt] = (f32x4){0.f, 0.f, 0.f, 0.f};
#pragma unroll
            for (int ks = 0; ks < 4; ++ks) { const bf16x8 A = *(const bf16x8*)(olq + 32 * ks + 8 * g);
#pragma unroll
                for (int nt = 0; nt < 4; ++nt) acc[nt] = MFMA16(A, *(const bf16x8*)(WUVT + ((size_t)(h * 64 + 16 * nt + i16)) * 128 + 32 * ks + 8 * g), acc[nt]); }
#pragma unroll
            for (int r = 0; r < 4; ++r) { float s = (acc[0][r] * acc[0][r] + acc[1][r] * acc[1][r]) + (acc[2][r] * acc[2][r] + acc[3][r] * acc[3][r]);
                s += SHFL_XOR(s, 1); s += SHFL_XOR(s, 2); s += SHFL_XOR(s, 4); s += SHFL_XOR(s, 8);
                if (i16 == 0) SS[(16 * mtile + 4 * g + r) * 4 + h] = s; }
            SYNC();
#pragma unroll
            for (int r = 0; r < 4; ++r) { const int qq = 16 * mtile + 4 * g + r; const f32x4 s4 = *(const f32x4*)(SS + qq * 4);
                const float rs = RSQ(((s4.x + s4.y) + (s4.z + s4.w)) * (1.0f / 256.0f) + NORM_EPS);
                bf16* dst = CAT + (mb + t0 + qq) * DM + 768 + h * 64 + i16;
#pragma unroll
                for (int nt = 0; nt < 4; ++nt) dst[16 * nt] = (bf16)f2bf(acc[nt][r] * rs * gaw[nt]); }
        }
        SYNC();
    }
}
#ifndef HOST_EMU
namespace pg8 {
#define PG8_LAS __attribute__((address_space(3)))
typedef unsigned short bf16_t;
typedef short bf16x8 __attribute__((ext_vector_type(8)));
typedef float f32x4 __attribute__((ext_vector_type(4)));
typedef unsigned u32x4 __attribute__((ext_vector_type(4)));
constexpr int BM = 256, BK = 64, HALF = 128, HTB = HALF * BK * 2  , STAGE_BYTES = 8 * HTB, NXCD = 8, WGM = 8;

__host__ __device__ __forceinline__ int lds_byte(int r, int c) { const int st = (r >> 4) * 2 + (c >> 5), rr = r & 15, cc = c & 31, ob = rr * 64 + cc * 2; return st * 1024 + (ob ^ (((ob >> 9) & 1) << 5)); }
__host__ __device__ __forceinline__ void stage_rc(int b, int& R, int& C) { const int st = b / 1024, sb = b % 1024, swz = sb ^ (((sb >> 9) & 1) << 5); R = (st >> 1) * 16 + swz / 64; C = (st & 1) * 32 + (swz % 64) / 2; }
__host__ __device__ __forceinline__ int perm32(int rho) { const int n = rho >> 4, i = rho & 15; return 8 * (i >> 2) + 4 * n + (i & 3); }

struct Unit { int pm, pn; };
struct Gemm { const bf16_t* A; const bf16_t* Bt; int M, N, K; };

struct StaticOrder {
    int nM, nN, nwg, G, c;
    __host__ __device__ void init(int M, int N, int G_, int c_) { nM = M / BM; nN = N / BM; nwg = nM * nN; G = G_; c = c_; }
    __host__ __device__ bool next(int i, Unit& u) const {
        const long L = (long)i * G + c; if (L >= nwg) return false;
        int wgid = (int)L; { const int q = nwg / NXCD, r = nwg % NXCD, xcd = wgid % NXCD, off = wgid / NXCD; wgid = (xcd < r ? xcd * (q + 1) : r * (q + 1) + (xcd - r) * q) + off; }
        const int nig = WGM * nN, gid = wgid / nig, fm = gid * WGM, gsz = (nM - fm) < WGM ? (nM - fm) : WGM;
        u.pm = fm + ((wgid % nig) % gsz); u.pn = (wgid % nig) / gsz; return true;
    }
    __device__ __forceinline__ void a_ready(const Unit&) const {}
    __device__ __forceinline__ void done(const Unit&) const {}
};
__device__ __forceinline__ unsigned cvt_pk_bf16(float lo, float hi) { unsigned r; asm volatile("v_cvt_pk_bf16_f32 %0, %1, %2" : "=v"(r) : "v"(lo), "v"(hi)); return r; }
template <class Epi, class Sched, bool ALIGN_EPI = false, bool SP2 = false>
__device__ __forceinline__ void gemm_phase(PG8_LAS unsigned char* lds, const Gemm g, const Sched& S, const Epi& E, const int tid_in) {
    const int tid = tid_in, wid = __builtin_amdgcn_readfirstlane(tid >> 6), lane = tid & 63, wr = wid >> 2, wc = wid & 3, fr = lane & 15, fq = lane >> 4;
    const int K = g.K, nt = K / BK;
    unsigned voffA[2], voffB[2];
#pragma unroll
    for (int i = 0; i < 2; ++i) { int R, C; stage_rc(tid * 16 + i * 8192, R, C); const int Rb = Epi::PERM ? ((R & ~31) + perm32(R & 31)) : R;
        voffA[i] = (unsigned)(R * K + C) * 2u; voffB[i] = (unsigned)(Rb * K + C) * 2u; }
    const size_t kstep = (size_t)(BK * 2);
    const size_t hstep = (size_t)HALF * K * 2;
    const size_t tstep = 2 * hstep;
    const unsigned ldsw = (unsigned)wid * 1024u;
    const int aoff = lds_byte(wr * 64 + fr, fq * 8), boff = lds_byte(wc * 32 + fr, fq * 8);
#define PG8_SA(b, h) (((b) * 2 + (h)) * HTB)
#define PG8_SB(b, h) ((4 + (b) * 2 + (h)) * HTB)
#define PG8_STAGE(bufoff, gbase, voff) do { _Pragma("unroll") for (int _i = 0; _i < 2; ++_i) \
        __builtin_amdgcn_global_load_lds((const unsigned*)((const char*)(gbase) + (voff)[_i]), (PG8_LAS unsigned*)(lds + (bufoff) + ldsw + _i * 8192), 16, 0, 0); } while (0)
#define PG8_LDA(dst, b, h) do { _Pragma("unroll") for (int m = 0; m < 4; ++m) _Pragma("unroll") for (int k = 0; k < 2; ++k) dst[m][k] = *(const PG8_LAS bf16x8*)(lds + PG8_SA(b, h) + aoff + m * 2048 + k * 1024); } while (0)
#define PG8_LDB(dst, b, h) do { _Pragma("unroll") for (int n = 0; n < 2; ++n) _Pragma("unroll") for (int k = 0; k < 2; ++k) dst[n][k] = *(const PG8_LAS bf16x8*)(lds + PG8_SB(b, h) + boff + n * 2048 + k * 1024); } while (0)
#define PG8_MMA(ai, bj, At, Bt) do { __builtin_amdgcn_s_setprio(1); _Pragma("unroll") for (int m = 0; m < 4; ++m) _Pragma("unroll") for (int n = 0; n < 2; ++n) _Pragma("unroll") for (int k = 0; k < 2; ++k) \
        acc[ai][bj][m][n] = __builtin_amdgcn_mfma_f32_16x16x32_bf16(Bt[n][k], At[m][k], acc[ai][bj][m][n], 0, 0, 0); __builtin_amdgcn_s_setprio(0); } while (0)
#define PG8_WAIT_V(n) asm volatile("s_waitcnt vmcnt(" #n ")" ::: "memory")
#define PG8_WAIT_L(n) asm volatile("s_waitcnt lgkmcnt(" #n ")" ::: "memory")
#define PG8_BAR __builtin_amdgcn_s_barrier()
#define PG8_SCHED __builtin_amdgcn_sched_barrier(0)
    Unit cur, nxt; int ui = 0;
    if (!S.next(0, cur)) return;
    f32x4 acc[2][2][4][2];
#pragma unroll
    for (int a = 0; a < 2; ++a)
#pragma unroll
        for (int b = 0; b < 2; ++b)
#pragma unroll
            for (int m = 0; m < 4; ++m)
#pragma unroll
                for (int n = 0; n < 2; ++n) acc[a][b][m][n] = (f32x4){0.f, 0.f, 0.f, 0.f};
    bf16x8 At[4][2], B0[2][2], B1[2][2];
    const char* cA = (const char*)g.A + (size_t)cur.pm * tstep; const char* cB = (const char*)g.Bt + (size_t)cur.pn * tstep;
    S.a_ready(cur);
    if constexpr (SP2) {
        PG8_STAGE(PG8_SB(0, 0), cB, voffB); PG8_STAGE(PG8_SB(0, 1), cB + hstep, voffB); PG8_STAGE(PG8_SA(0, 0), cA, voffA); PG8_STAGE(PG8_SA(0, 1), cA + hstep, voffA);
        if (wr == 1) PG8_BAR;
        PG8_WAIT_V(2); PG8_BAR;
        PG8_STAGE(PG8_SB(1, 0), cB + kstep, voffB); PG8_STAGE(PG8_SA(1, 0), cA + kstep, voffA); PG8_STAGE(PG8_SB(1, 1), cB + hstep + kstep, voffB);
        PG8_WAIT_V(6); PG8_BAR;
    } else {
        PG8_STAGE(PG8_SB(0, 0), cB, voffB); PG8_STAGE(PG8_SA(0, 0), cA, voffA); PG8_STAGE(PG8_SB(0, 1), cB + hstep, voffB); PG8_STAGE(PG8_SA(0, 1), cA + hstep, voffA);
        if (wr == 1) PG8_BAR;
        PG8_WAIT_V(4); PG8_BAR;
        PG8_STAGE(PG8_SB(1, 0), cB + kstep, voffB); PG8_STAGE(PG8_SA(1, 0), cA + kstep, voffA); PG8_STAGE(PG8_SB(1, 1), cB + hstep + kstep, voffB);
        PG8_WAIT_V(6); PG8_BAR;
    }
    for (;;) {
        const bool has_next = S.next(ui + 1, nxt);
        const char* nA = has_next ? (const char*)g.A + (size_t)nxt.pm * tstep : cA; const char* nB = has_next ? (const char*)g.Bt + (size_t)nxt.pn * tstep : cB;
#pragma unroll 1
        for (int t = 0; t < nt; t += 2) {
            const bool last = (t == nt - 2);
            const char* a1 = cA + (size_t)(t + 1) * kstep;
            const char* a2 = last ? nA : cA + (size_t)(t + 2) * kstep; const char* b2 = last ? nB : cB + (size_t)(t + 2) * kstep;
            const char* a3 = a2 + kstep; const char* b3 = b2 + kstep;
            if (last && has_next) S.a_ready(nxt);
            if constexpr (Epi::NORM) { if (t == 2) E.prefetch(cur, tid, wid); if (t == 4) E.reduce_rs(tid); }
            if constexpr (SP2) {
            PG8_LDB(B0, 0, 0); PG8_LDB(B1, 0, 1); PG8_SCHED; PG8_LDA(At, 0, 0); PG8_STAGE(PG8_SA(1, 1), a1 + hstep, voffA);
            PG8_WAIT_V(8); PG8_WAIT_L(0); PG8_BAR; PG8_MMA(0, 0, At, B0); PG8_MMA(0, 1, At, B1); PG8_BAR; PG8_SCHED;
            PG8_LDA(At, 0, 1); PG8_STAGE(PG8_SB(0, 0), b2, voffB); PG8_STAGE(PG8_SB(0, 1), b2 + hstep, voffB); PG8_STAGE(PG8_SA(0, 0), a2, voffA);
            PG8_WAIT_V(8); PG8_WAIT_L(0); PG8_BAR; PG8_MMA(1, 0, At, B0); PG8_MMA(1, 1, At, B1); PG8_BAR; PG8_SCHED;
            PG8_LDB(B0, 1, 0); PG8_LDB(B1, 1, 1); PG8_SCHED; PG8_LDA(At, 1, 0); PG8_STAGE(PG8_SA(0, 1), a2 + hstep, voffA);
            PG8_WAIT_V(8); PG8_WAIT_L(0); PG8_BAR; PG8_MMA(0, 0, At, B0); PG8_MMA(0, 1, At, B1); PG8_BAR; PG8_SCHED;
            PG8_LDA(At, 1, 1); PG8_STAGE(PG8_SB(1, 0), b3, voffB); PG8_STAGE(PG8_SB(1, 1), b3 + hstep, voffB); PG8_STAGE(PG8_SA(1, 0), a3, voffA);
            PG8_WAIT_V(8); PG8_WAIT_L(0); PG8_BAR; PG8_MMA(1, 0, At, B0); PG8_MMA(1, 1, At, B1); PG8_BAR; PG8_SCHED;
            } else {
            PG8_LDB(B0, 0, 0); PG8_SCHED; PG8_LDA(At, 0, 0); PG8_STAGE(PG8_SA(1, 1), a1 + hstep, voffA);
            PG8_WAIT_L(8); PG8_BAR; PG8_WAIT_L(0); PG8_MMA(0, 0, At, B0); PG8_BAR; PG8_SCHED;
            PG8_LDB(B1, 0, 1); PG8_STAGE(PG8_SB(0, 0), b2, voffB);
            PG8_BAR; PG8_WAIT_L(0); PG8_MMA(0, 1, At, B1); PG8_BAR;
            PG8_LDA(At, 0, 1); PG8_STAGE(PG8_SA(0, 0), a2, voffA);
            PG8_BAR; PG8_WAIT_L(0); PG8_MMA(1, 0, At, B0); PG8_BAR; PG8_SCHED;
            PG8_STAGE(PG8_SB(0, 1), b2 + hstep, voffB);
            PG8_WAIT_V(6); PG8_BAR; PG8_MMA(1, 1, At, B1); PG8_BAR;
            PG8_LDB(B0, 1, 0); PG8_SCHED; PG8_LDA(At, 1, 0); PG8_STAGE(PG8_SA(0, 1), a2 + hstep, voffA);
            PG8_WAIT_L(8); PG8_BAR; PG8_WAIT_L(0); PG8_MMA(0, 0, At, B0); PG8_BAR; PG8_SCHED;
            PG8_LDB(B1, 1, 1); PG8_STAGE(PG8_SB(1, 0), b3, voffB);
            PG8_BAR; PG8_WAIT_L(0); PG8_MMA(0, 1, At, B1); PG8_BAR;
            PG8_LDA(At, 1, 1); PG8_STAGE(PG8_SA(1, 0), a3, voffA);
            PG8_BAR; PG8_WAIT_L(0); PG8_MMA(1, 0, At, B0); PG8_BAR; PG8_SCHED;
            PG8_STAGE(PG8_SB(1, 1), b3 + hstep, voffB);
            PG8_WAIT_V(6); PG8_BAR; PG8_MMA(1, 1, At, B1); PG8_BAR;
            }
        }
        if constexpr (ALIGN_EPI) { if (wr == 0) PG8_BAR; }
        if constexpr (!Epi::AFTER_DRAIN) { E(acc, cur, wr, wc, fr, fq); S.done(cur); }
        if (!has_next) break;
#pragma unroll
        for (int a = 0; a < 2; ++a)
#pragma unroll
            for (int b = 0; b < 2; ++b)
#pragma unroll
                for (int m = 0; m < 4; ++m)
#pragma unroll
                    for (int n = 0; n < 2; ++n) acc[a][b][m][n] = (f32x4){0.f, 0.f, 0.f, 0.f};
        cur = nxt; cA = nA; cB = nB; ++ui;
        if constexpr (ALIGN_EPI) { if (wr == 1) PG8_BAR; }
    }
    PG8_WAIT_V(0);
    if constexpr (!ALIGN_EPI) { if (wr == 0) PG8_BAR; }
    PG8_BAR;
    if constexpr (Epi::AFTER_DRAIN) { E.fused(acc, cur, wr, wc, fr, fq, lds, wid, lane); S.done(cur); }
#undef PG8_SA
#undef PG8_SB
#undef PG8_STAGE
#undef PG8_LDA
#undef PG8_LDB
#undef PG8_MMA
#undef PG8_WAIT_V
#undef PG8_WAIT_L
#undef PG8_BAR
#undef PG8_SCHED
}
}
namespace pg8 {
template <int ACT  > struct EpiRoute {
    static constexpr bool PERM = true, AFTER_DRAIN = false, NORM = false;
    bf16_t* O0; int ld0; bf16_t* O1; int ld1; int split;
    __device__ __forceinline__ void operator()(const f32x4 (&acc)[2][2][4][2], const Unit& u, int wr, int wc, int fr, int fq) const {
        const int row0 = u.pm * BM + wr * 64 + fr; const bool first = u.pn < split;
        bf16_t* base = first ? O0 : O1; const int ld = first ? ld0 : ld1; const int col0 = (first ? u.pn : u.pn - split) * BM + wc * 32 + 8 * fq;
#pragma unroll
        for (int ai = 0; ai < 2; ++ai)
#pragma unroll
            for (int m = 0; m < 4; ++m) { bf16_t* rowp = base + (size_t)(row0 + ai * HALF + m * 16) * ld + col0;
#pragma unroll
                for (int bj = 0; bj < 2; ++bj) { f32x4 v0 = acc[ai][bj][m][0], v1 = acc[ai][bj][m][1];
                    if (ACT == 1) {
#pragma unroll
                        for (int e = 0; e < 4; ++e) { const float a = fmaxf(v0[e], 0.f), b = fmaxf(v1[e], 0.f); v0[e] = a * a; v1[e] = b * b; } }
                    u32x4 w; w.x = cvt_pk_bf16(v0[0], v0[1]); w.y = cvt_pk_bf16(v0[2], v0[3]); w.z = cvt_pk_bf16(v1[0], v1[1]); w.w = cvt_pk_bf16(v1[2], v1[3]);
                    *(u32x4*)(rowp + bj * HALF) = w; } }
    }
};
struct EpiResid {
    static constexpr bool PERM = true, AFTER_DRAIN = false, NORM = false;
    const float* xsrc; float* xdst; const float* gate;
    __device__ __forceinline__ void operator()(const f32x4 (&acc)[2][2][4][2], const Unit& u, int wr, int wc, int fr, int fq) const {
        const int row0 = u.pm * BM + wr * 64 + fr, col0 = u.pn * BM + wc * 32 + 8 * fq, b = (u.pm * BM) >> 12;
        f32x4 gv[2][2];
#pragma unroll
        for (int bj = 0; bj < 2; ++bj)
#pragma unroll
            for (int n = 0; n < 2; ++n) gv[bj][n] = *(const f32x4*)(gate + (size_t)b * 6144 + col0 + bj * HALF + 4 * n);
#pragma unroll
        for (int ai = 0; ai < 2; ++ai)
#pragma unroll
            for (int m = 0; m < 4; ++m) { const size_t off = (size_t)(row0 + ai * HALF + m * 16) * 1024 + col0;
#pragma unroll
                for (int bj = 0; bj < 2; ++bj)
#pragma unroll
                    for (int n = 0; n < 2; ++n) { const f32x4 xs = *(const f32x4*)(xsrc + off + bj * HALF + 4 * n);
                        *(f32x4*)(xdst + off + bj * HALF + 4 * n) = xs + gv[bj][n] * acc[ai][bj][m][n]; }
                if (m & 1) asm volatile("" ::: "memory"); }
    }
};
constexpr int EPI_OFF = 133120;
template <int ACT  > struct EpiRouteN {
    static constexpr bool PERM = true, AFTER_DRAIN = false, NORM = true;
    bf16_t* O; int ld; const float* RSP; const float* shw; PG8_LAS unsigned char* lds;
    __device__ __forceinline__ void prefetch(const Unit& u, int tid, int wid) const {
        const char* src = (const char*)RSP + (size_t)u.pm * (BM * 64) + (size_t)tid * 16;
#pragma unroll
        for (int i = 0; i < 2; ++i) __builtin_amdgcn_global_load_lds((const unsigned*)(src + i * 8192), (PG8_LAS unsigned*)(lds + EPI_OFF + wid * 1024 + i * 8192), 16, 0, 0);
        if (wid == 0) { const char* s2 = (const char*)(shw + (size_t)((u.pm * BM) >> 12) * NSHW + u.pn * BM) + (size_t)(tid & 63) * 16;
            __builtin_amdgcn_global_load_lds((const unsigned*)s2, (PG8_LAS unsigned*)(lds + EPI_OFF + 16384), 16, 0, 0); }
    }
    __device__ __forceinline__ void reduce_rs(int tid) const {
        if (tid < 256) { const PG8_LAS f32x4* p = (const PG8_LAS f32x4*)(lds + EPI_OFF + tid * 64); const f32x4 a = p[0], b = p[1], c = p[2], d = p[3];
            const float s = (((a.x + a.y) + (a.z + a.w)) + ((b.x + b.y) + (b.z + b.w))) + (((c.x + c.y) + (c.z + c.w)) + ((d.x + d.y) + (d.z + d.w)));
            *(PG8_LAS float*)(lds + EPI_OFF + 17408 + tid * 4) = __builtin_amdgcn_rsqf(s * (1.0f / 1024.0f) + 1e-6f); }
    }
    __device__ __forceinline__ void operator()(const f32x4 (&acc)[2][2][4][2], const Unit& u, int wr, int wc, int fr, int fq) const {
        const int row0 = u.pm * BM + wr * 64 + fr, col0 = u.pn * BM + wc * 32 + 8 * fq;
        const PG8_LAS unsigned char* ep = lds + EPI_OFF;
        float rs[2][4];
#pragma unroll
        for (int ai = 0; ai < 2; ++ai)
#pragma unroll
            for (int m = 0; m < 4; ++m) rs[ai][m] = *(const PG8_LAS float*)(ep + 17408 + (wr * 64 + fr + ai * HALF + m * 16) * 4);
        f32x4 sv[2][2];
#pragma unroll
        for (int bj = 0; bj < 2; ++bj)
#pragma unroll
            for (int n = 0; n < 2; ++n) sv[bj][n] = *(const PG8_LAS f32x4*)(ep + 16384 + (bj * HALF + wc * 32 + 8 * fq + 4 * n) * 4);
#pragma unroll
        for (int ai = 0; ai < 2; ++ai)
#pragma unroll
            for (int m = 0; m < 4; ++m) { bf16_t* rowp = O + (size_t)(row0 + ai * HALF + m * 16) * ld + col0;
#pragma unroll
                for (int bj = 0; bj < 2; ++bj) { f32x4 v0 = acc[ai][bj][m][0] * rs[ai][m] + sv[bj][0], v1 = acc[ai][bj][m][1] * rs[ai][m] + sv[bj][1];
                    if (ACT == 1) {
#pragma unroll
                        for (int e = 0; e < 4; ++e) { const float a = fmaxf(v0[e], 0.f), b = fmaxf(v1[e], 0.f); v0[e] = a * a; v1[e] = b * b; } }
                    u32x4 w; w.x = cvt_pk_bf16(v0[0], v0[1]); w.y = cvt_pk_bf16(v0[2], v0[3]); w.z = cvt_pk_bf16(v1[0], v1[1]); w.w = cvt_pk_bf16(v1[2], v1[3]);
                    *(u32x4*)(rowp + bj * HALF) = w; } }
    }
};
template <bool SRCF, bool DSTF> struct EpiResidXS {
    static constexpr bool PERM = true, AFTER_DRAIN = false, NORM = false;
    const void* xsrc; void* xdst; const float* gate; const float* wp; bf16_t* XS; float* RSP; int doxs, srcf32, dstf32;
    __device__ __forceinline__ void operator()(const f32x4 (&acc)[2][2][4][2], const Unit& u, int wr, int wc, int fr, int fq) const {
        const int row0 = u.pm * BM + wr * 64 + fr, col0 = u.pn * BM + wc * 32 + 8 * fq, b = (u.pm * BM) >> 12;
        f32x4 gv[2][2], wv[2][2]; float ssv[2][4];
#pragma unroll
        for (int bj = 0; bj < 2; ++bj)
#pragma unroll
            for (int n = 0; n < 2; ++n) { gv[bj][n] = *(const f32x4*)(gate + (size_t)b * 6144 + col0 + bj * HALF + 4 * n);
                wv[bj][n] = doxs ? *(const f32x4*)(wp + (size_t)b * 1024 + col0 + bj * HALF + 4 * n) : (f32x4){0.f, 0.f, 0.f, 0.f}; }
#pragma unroll
        for (int ai = 0; ai < 2; ++ai)
#pragma unroll
            for (int m = 0; m < 4; ++m) { const int row = row0 + ai * HALF + m * 16; const size_t off = (size_t)row * 1024 + col0; float ss = 0.f;
#pragma unroll
                for (int bj = 0; bj < 2; ++bj) { f32x4 x0, x1;
                    if (SRCF && srcf32) { x0 = *(const f32x4*)((const float*)xsrc + off + bj * HALF); x1 = *(const f32x4*)((const float*)xsrc + off + bj * HALF + 4); }
                    else { const u32x4 r = *(const u32x4*)((const bf16_t*)xsrc + off + bj * HALF);
                        x0 = (f32x4){bflo(r.x), bfhi(r.x), bflo(r.y), bfhi(r.y)}; x1 = (f32x4){bflo(r.z), bfhi(r.z), bflo(r.w), bfhi(r.w)}; }
                    const f32x4 y0 = x0 + gv[bj][0] * acc[ai][bj][m][0], y1 = x1 + gv[bj][1] * acc[ai][bj][m][1];
                    ss += ((y0.x * y0.x + y0.y * y0.y) + (y0.z * y0.z + y0.w * y0.w)) + ((y1.x * y1.x + y1.y * y1.y) + (y1.z * y1.z + y1.w * y1.w));
                    if (DSTF && dstf32) { *(f32x4*)((float*)xdst + off + bj * HALF) = y0; *(f32x4*)((float*)xdst + off + bj * HALF + 4) = y1; }
                    else { u32x4 w; w.x = cvt_pk_bf16(y0[0], y0[1]); w.y = cvt_pk_bf16(y0[2], y0[3]); w.z = cvt_pk_bf16(y1[0], y1[1]); w.w = cvt_pk_bf16(y1[2], y1[3]);
                        *(u32x4*)((bf16_t*)xdst + off + bj * HALF) = w; }
                    if (doxs) { const f32x4 a = y0 * wv[bj][0], c = y1 * wv[bj][1];
                        u32x4 w; w.x = cvt_pk_bf16(a[0], a[1]); w.y = cvt_pk_bf16(a[2], a[3]); w.z = cvt_pk_bf16(c[0], c[1]); w.w = cvt_pk_bf16(c[2], c[3]);
                        *(u32x4*)(XS + off + bj * HALF) = w; } }
                ssv[ai][m] = ss;
                if (m & 1) asm volatile("" ::: "memory"); }
        if (doxs) { float t1[2][4];
#pragma unroll
            for (int ai = 0; ai < 2; ++ai)
#pragma unroll
                for (int m = 0; m < 4; ++m) t1[ai][m] = __shfl_xor(ssv[ai][m], 16);
#pragma unroll
            for (int ai = 0; ai < 2; ++ai)
#pragma unroll
                for (int m = 0; m < 4; ++m) { ssv[ai][m] += t1[ai][m]; t1[ai][m] = __shfl_xor(ssv[ai][m], 32); }
            if (fq == 0) {
#pragma unroll
                for (int ai = 0; ai < 2; ++ai)
#pragma unroll
                    for (int m = 0; m < 4; ++m) RSP[(size_t)(row0 + ai * HALF + m * 16) * 16 + u.pn * 4 + wc] = ssv[ai][m] + t1[ai][m]; } }
    }
};
}

#define RLX_AGENT __ATOMIC_RELAXED, __HIP_MEMORY_SCOPE_AGENT
#define XB_TMO      128
#define XB_XCNT(j)  (256  + 64 * (j))
#define XB_XSUB(j)  (1280 + 64 * (j))
#define XB_XGEN(j)  (2304 + 64 * (j))
#define XB_TOP      3328
#define XB_TOPGEN   3392
#define XCD_BAR_WORDS 3456
#define XB_SPIN_CAP (1u << 24)

__device__ __forceinline__ unsigned xb_ld(unsigned* p)              { return __hip_atomic_load(p, __ATOMIC_RELAXED, __HIP_MEMORY_SCOPE_AGENT); }
__device__ __forceinline__ unsigned xb_add(unsigned* p, unsigned v) { return __hip_atomic_fetch_add(p, v, __ATOMIC_RELAXED, __HIP_MEMORY_SCOPE_AGENT); }
__device__ __forceinline__ unsigned xb_xcc_id() { return (unsigned)__builtin_amdgcn_s_getreg((3 << 11) | 20) & 0xFu; }
#define XB_SPIN(cond, bar) do { unsigned _sp = 0; while (cond) { __builtin_amdgcn_s_sleep(1); \
    if ((++_sp & 255u) == 0u) { if (xb_ld(&(bar)[XB_TMO])) break; if (_sp > XB_SPIN_CAP) { atomicAdd(&(bar)[XB_TMO], 1u); break; } } } } while (0)

struct XcdBarrier {
    unsigned* bar; unsigned x;
    volatile LAS unsigned* st;
};

__device__ __forceinline__ XcdBarrier xcd_barrier_post(unsigned* bar, volatile LAS unsigned* st) {
    XcdBarrier b; b.bar = bar; b.x = xb_xcc_id(); b.st = st;
    if (threadIdx.x == 0) (void)xb_add(&bar[XB_XCNT(b.x)], 1u);
    return b;
}
__device__ __forceinline__ void xcd_barrier_complete(unsigned* bar, unsigned x, unsigned& nloc, unsigned& nx) {
    const unsigned G = gridDim.x * gridDim.y * gridDim.z;
    unsigned sum, cnt, mine, sp = 0u;
    for (;;) {
        sum = 0u; cnt = 0u; mine = 0u;
#pragma unroll
        for (unsigned j = 0; j < 16; ++j) { const unsigned c = xb_ld(&bar[XB_XCNT(j)]); sum += c; cnt += (c > 0u) ? 1u : 0u; mine = (j == x) ? c : mine; }
        if (sum == G) break;
        __builtin_amdgcn_s_sleep(1);
        if ((++sp & 255u) == 0u) { if (xb_ld(&bar[XB_TMO])) break; if (sp > XB_SPIN_CAP) { atomicAdd(&bar[XB_TMO], 1u); break; } }
    }
    nloc = mine > 0u ? mine : 1u; nx = cnt > 0u ? cnt : 1u;
}

__device__ __forceinline__ void xcd_barrier(const XcdBarrier& b) {
    asm volatile("s_waitcnt vmcnt(0)" ::: "memory");
    __syncthreads();
    if (threadIdx.x == 0) {
        unsigned* bar = b.bar;
        __builtin_amdgcn_s_waitcnt(0);
        unsigned nloc = b.st[0], nx = b.st[1];
        if (nloc == 0u) { xcd_barrier_complete(bar, b.x, nloc, nx); b.st[0] = nloc; b.st[1] = nx; }
        const unsigned old = xb_add(&bar[XB_XSUB(b.x)], 1u);
        const unsigned gen = old / nloc;
        if (old + 1u == (gen + 1u) * nloc) {
            __builtin_amdgcn_fence(__ATOMIC_RELEASE, "agent");
            asm volatile("s_waitcnt vmcnt(0)" ::: "memory");
            const unsigned og = xb_add(&bar[XB_TOP], 1u);
            const unsigned tg = og / nx;
            if (og + 1u == (tg + 1u) * nx) xb_add(&bar[XB_TOPGEN], 1u);
            else XB_SPIN(xb_ld(&bar[XB_TOPGEN]) == tg, bar);
            __builtin_amdgcn_fence(__ATOMIC_ACQUIRE, "agent");
            xb_add(&bar[XB_XGEN(b.x)], 1u);
            asm volatile("s_waitcnt vmcnt(0)" ::: "memory");
        } else {
            XB_SPIN(xb_ld(&bar[XB_XGEN(b.x)]) == gen, bar);
            __builtin_amdgcn_fence(__ATOMIC_ACQUIRE, "agent");
            asm volatile("s_waitcnt vmcnt(0)" ::: "memory");
        }
    }
    __syncthreads();
}

#ifndef PH_MASK
#define PH_MASK 0xFFFFF
#endif
#define EN(b) if constexpr ((PH_MASK >> (b)) & 1)
#ifndef DUP_MASK
#define DUP_MASK 0
#endif
#define DUP(b) if constexpr ((DUP_MASK >> (b)) & 1)
#define DBG_DIGEST_N 256
#define DBG_DIGEST_VAL(m, c) bf2f(((const bf16*)(wsp + WS_CAT))[(size_t)(m) * DM + 768 + (c)])
#ifndef DBG_PH_HI
#define DBG_PH_HI NPHASE
#endif
#ifndef MK_MULTI
#define MK_MULTI 0
#endif
constexpr int LDS_BYTES = 151552, MISC_OFF = 131072 + 320;
#ifndef DBG_LAYERS
#define DBG_LAYERS 4
#define DBG_L0 0
#endif
constexpr int NPHASE = 3 + 7 * DBG_LAYERS;
__global__ void __launch_bounds__(512, 2) hymba_fwd(Args a) {
    extern __shared__ __attribute__((aligned(16))) unsigned char lds[];
    Ctx F0;
    Ctx& F = F0;
    F.lds = (char*)lds; F.tid = threadIdx.x; F.lane = F.tid & 63; F.wave = __builtin_amdgcn_readfirstlane(F.tid >> 6); F.G = gridDim.x; F.bid = blockIdx.x;
    F.A = nullptr; F.ws = a.ws;
    if (F.tid < 29) ((unsigned long long*)(lds + PTR_OFF))[F.tid] = F.tid < 28 ? (unsigned long long)a.in[F.tid] : (unsigned long long)a.out;
    volatile LAS unsigned* MISC = (volatile LAS unsigned*)((LAS unsigned char*)lds + MISC_OFF);
    if (F.tid < 32) MISC[F.tid] = 0u;
    __syncthreads();
    unsigned* ctl = (unsigned*)(a.ws + WS_CTL);
    XcdBarrier bar; bar.bar = ctl + CW_BAR; bar.x = 0; bar.st = nullptr;
    if (!MK_MULTI) bar = xcd_barrier_post(ctl + CW_BAR, MISC + 8);
    const int lo = a.ph_lo, hi = a.ph_hi;
    int ph = 0;
#define PH_BEGIN if (lo <= ph && ph < hi) { Ctx F = F0; unsigned long long wsl_ = (unsigned long long)F0.ws; asm volatile("" : "+v"(F.tid), "+s"(F.bid), "+s"(F.G), "+s"(wsl_)); F.ws = (unsigned char*)(__attribute__((address_space(1))) unsigned char*)wsl_; F.lane = F.tid & 63; F.wave = __builtin_amdgcn_readfirstlane(F.tid >> 6); unsigned char* const wsp = F.ws; (void)wsp;
#define PH_END   if (!MK_MULTI && ph + 1 < hi) { XcdBarrier bb = bar; asm volatile("" : "+s"(bb.bar), "+s"(bb.x)); xcd_barrier(bb); } else __syncthreads(); } ++ph;
    PG8_LAS unsigned char* glds = (PG8_LAS unsigned char*)lds;
#define XN ((bf16*)(wsp + WS_XN))
#define PROJ ((bf16*)(wsp + WS_PROJ))
#define CAT ((bf16*)(wsp + WS_CAT))
#define HB ((bf16*)(wsp + WS_HB))
    PH_BEGIN EN(0) ph_prologue(F); DUP(0) { __syncthreads(); ph_prologue(F); } PH_END
    PH_BEGIN EN(1) { ph_shw(F); ph_xs0(F, PIN(F, I_X), PIN(F, I_N1W) + DBG_L0 * DM, (const float*)(wsp + WS_MOD) + (size_t)DBG_L0 * BATCH * NADA, DM, XN, (float*)(wsp + WS_RSP)); } PH_END
    for (int l_ = 0; l_ < DBG_LAYERS; ++l_) { const int l = l_ + DBG_L0;
        #define modl ((const float*)(wsp + WS_MOD) + (size_t)l * BATCH * NADA)
        #define xsrc (l_ == 0 ? PIN(F, I_X) : (const float*)POUT(F))
        PH_BEGIN
#if defined(PROBE_GA)
            { pg8::Gemm g{XN, (const bf16*)(wsp + WS_WIN) + (size_t)l * NPROJ * DM, MTOK, NPROJ, DM}; pg8::StaticOrder S; S.init(MTOK, NPROJ, F.G, F.bid);
            pg8::EpiRoute<0> E{PROJ, NPROJ, PROJ, NPROJ, 1 << 20};
            pg8::gemm_phase<pg8::EpiRoute<0>, pg8::StaticOrder, true, true>(glds, g, S, E, F.tid); } __syncthreads();
#elif defined(PROBE_GB)
            { pg8::Gemm g{XN, (const bf16*)(wsp + WS_WIN) + (size_t)l * NPROJ * DM, MTOK, NPROJ, DM}; pg8::StaticOrder S; S.init(MTOK, NPROJ, F.G, F.bid);
            pg8::EpiRouteN<0> E{PROJ, NPROJ, (const float*)(wsp + WS_RSP), (const float*)(wsp + WS_SHW) + (size_t)l * BATCH * NSHW, glds};
            pg8::gemm_phase<pg8::EpiRouteN<0>, pg8::StaticOrder, true, true>(glds, g, S, E, F.tid); } __syncthreads();
#endif
        EN(2) { pg8::Gemm g{XN, (const bf16*)(wsp + WS_WIN) + (size_t)l * NPROJ * DM, MTOK, NPROJ, DM}; pg8::StaticOrder S; S.init(MTOK, NPROJ, F.G, F.bid);
            pg8::EpiRouteN<0> E{PROJ, NPROJ, (const float*)(wsp + WS_RSP), (const float*)(wsp + WS_SHW) + (size_t)l * BATCH * NSHW, glds};
            pg8::gemm_phase<pg8::EpiRouteN<0>, pg8::StaticOrder, true, true>(glds, g, S, E, F.tid); } PH_END
        PH_BEGIN EN(3) ph_prep(F, l); DUP(3) ph_prep(F, l); EN(4) ph_lru1(F, l); DUP(4) ph_lru1(F, l); EN(5) ph_mlstm(F, l); DUP(5) ph_mlstm(F, l); PH_END
        PH_BEGIN EN(6) { ph_carry(F); pg8::Gemm g{(const bf16*)(wsp + WS_QL), (const bf16*)(wsp + WS_WQC) + (size_t)l * 768 * 256, MTOK, 768, 256}; pg8::StaticOrder S; S.init(MTOK, 768, F.G, F.bid);
            pg8::EpiRoute<0> E{(bf16*)(wsp + WS_QABS), 512, (bf16*)(wsp + WS_QIDX), 256, 2};
            pg8::gemm_phase<pg8::EpiRoute<0>, pg8::StaticOrder, true, true>(glds, g, S, E, F.tid); } PH_END
        PH_BEGIN EN(7) ph_dsa(F, l); DUP(7) ph_dsa(F, l); EN(8) ph_lru2(F, l); DUP(8) ph_lru2(F, l); EN(9) ph_mfin(F, l); DUP(9) ph_mfin(F, l); PH_END
        PH_BEGIN EN(10) { pg8::Gemm g{CAT, (const bf16*)(wsp + WS_WO) + (size_t)l * DM * DM, MTOK, DM, DM}; pg8::StaticOrder S; S.init(MTOK, DM, F.G, F.bid);
            pg8::EpiResidXS<true, false> E{l_ == 0 ? (const void*)PIN(F, I_X) : (const void*)POUT(F), (void*)POUT(F), modl + 2 * DM, (const float*)(wsp + WS_WP) + (size_t)(l * 2 + 1) * BATCH * DM, XN, (float*)(wsp + WS_RSP), 1, l_ == 0, 0};
            pg8::gemm_phase<pg8::EpiResidXS<true, false>, pg8::StaticOrder, true, true>(glds, g, S, E, F.tid); } PH_END
        PH_BEGIN EN(12) { pg8::Gemm g{XN, (const bf16*)(wsp + WS_W1) + (size_t)l * DFF * DM, MTOK, DFF, DM}; pg8::StaticOrder S; S.init(MTOK, DFF, F.G, F.bid);
            pg8::EpiRouteN<1> E{HB, DFF, (const float*)(wsp + WS_RSP), (const float*)(wsp + WS_SHW) + (size_t)l * BATCH * NSHW + NPROJ, glds};
            pg8::gemm_phase<pg8::EpiRouteN<1>, pg8::StaticOrder, true, true>(glds, g, S, E, F.tid); } PH_END
        PH_BEGIN EN(13) { pg8::Gemm g{HB, (const bf16*)(wsp + WS_W2) + (size_t)l * DM * DFF, MTOK, DM, DFF}; pg8::StaticOrder S; S.init(MTOK, DM, F.G, F.bid);
            const int nl = l + 1 < DEPTH ? l + 1 : l;
            const bool lastl = l_ + 1 >= DBG_LAYERS;
            pg8::EpiResidXS<false, false> E{(const void*)POUT(F), lastl ? (void*)XN : (void*)POUT(F), modl + 5 * DM, (const float*)(wsp + WS_WP) + (size_t)(nl * 2) * BATCH * DM, XN, (float*)(wsp + WS_RSP), lastl ? 0 : 1, 0, 0};
            pg8::gemm_phase<pg8::EpiResidXS<false, false>, pg8::StaticOrder, true, true>(glds, g, S, E, F.tid); } PH_END
    }
#ifdef DBG_DIGEST
    PH_BEGIN { const int gw = F.bid * 8 + F.wave, NGW = F.G * 8; float* o = POUT(F);
        for (int m = gw; m < MTOK; m += NGW) for (int j = 0; j < 16; ++j) { const int c = F.lane + 64 * j; float v = 0.f;
            if (c < DBG_DIGEST_N) { v = DBG_DIGEST_VAL(m, c) * 4096.0f; v = v - floorf(v); }
            o[(size_t)m * DM + c] = v; } } PH_END
#else
    PH_BEGIN EN(14) ph_finalnorm16(F, XN, PIN(F, I_FNW), POUT(F)); PH_END
#endif
}

extern "C" void kernel_launch(void* const* d_in, const int* in_sizes, int n_in, void* d_out, int out_size, void* d_ws, size_t ws_size, hipStream_t stream) {
    static int grid = 0;
    if (grid == 0) {
        if (n_in != 28 || in_sizes[0] != MTOK * DM || out_size != MTOK * DM || ws_size < WS_END) { fprintf(stderr, "kernel_launch: unexpected shapes (n_in %d, in0 %d, out %d, ws %zu)\n", n_in, n_in > 0 ? in_sizes[0] : -1, out_size, ws_size); grid = -1; return; }
        int dev = 0, cus = 0, per_cu = 0;
        if (hipGetDevice(&dev) != hipSuccess || hipDeviceGetAttribute(&cus, hipDeviceAttributeMultiprocessorCount, dev) != hipSuccess) { grid = -1; return; }
        if (hipFuncSetAttribute((const void*)hymba_fwd, hipFuncAttributeMaxDynamicSharedMemorySize, LDS_BYTES) != hipSuccess) { fprintf(stderr, "kernel_launch: hipFuncSetAttribute failed\n"); grid = -1; return; }
        if (hipOccupancyMaxActiveBlocksPerMultiprocessor(&per_cu, (const void*)hymba_fwd, 512, LDS_BYTES) != hipSuccess || per_cu < 1) { fprintf(stderr, "kernel_launch: occupancy query says %d\n", per_cu); }
        (void)hipGetLastError();
        grid = cus;
    }
    if (grid < 0) return;
    if (hipMemsetAsync((char*)d_ws + WS_CTL, 0, CTL_ZERO_BYTES, stream) != hipSuccess) return;
    Args a{};
    for (int i = 0; i < 28; ++i) a.in[i] = (const float*)d_in[i];
    a.out = (float*)d_out; a.ws = (unsigned char*)d_ws;
#if MK_MULTI
    for (int p = 0; p < NPHASE; ++p) { a.ph_lo = p; a.ph_hi = p + 1; hipLaunchKernelGGL(hymba_fwd, dim3(grid), dim3(512), LDS_BYTES, stream, a); }
#else
    a.ph_lo = 0; a.ph_hi = DBG_PH_HI; hipLaunchKernelGGL(hymba_fwd, dim3(grid), dim3(512), LDS_BYTES, stream, a);
#endif
}
#endif
```

```cpp
#ifndef HOST_EMU
#include <hip/hip_runtime.h>
#include <cstdio>
#include <cstdint>
#define DEV __device__ __forceinline__
#define LAS __attribute__((address_space(3)))
#else
#include "emu.h"
#endif

#ifndef HOST_EMU
#define SYNC() __syncthreads()
#define LAUNDER_V(x) asm volatile("" : "+v"(x))
#define WAVE_LDS_FENCE() asm volatile("s_waitcnt lgkmcnt(0)" ::: "memory")
template <class T> DEV T SHFL(T v, int s) { return __shfl(v, s); }
template <class T> DEV T SHFL_XOR(T v, int m) { return __shfl_xor(v, m); }
template <class T> DEV T SHFL_UP(T v, int d) { return __shfl_up(v, d); }
template <class T> DEV T SHFL_DOWN(T v, int d) { return __shfl_down(v, d); }
typedef short bf16x8_ __attribute__((ext_vector_type(8)));
typedef float f32x4_ __attribute__((ext_vector_type(4)));
typedef short v4i16_t __attribute__((ext_vector_type(4)));
DEV f32x4_ MFMA16(bf16x8_ a, bf16x8_ b, f32x4_ c) { return __builtin_amdgcn_mfma_f32_16x16x32_bf16(a, b, c, 0, 0, 0); }
DEV v4i16_t TR16(const void* p) { return __builtin_amdgcn_ds_read_tr16_b64_v4i16((LAS v4i16_t*)(p)); }
#endif


typedef unsigned short bf16;
typedef short bf16x8 __attribute__((ext_vector_type(8)));
typedef short s16x4 __attribute__((ext_vector_type(4)));
typedef float f32x4 __attribute__((ext_vector_type(4)));
typedef unsigned u32x4 __attribute__((ext_vector_type(4)));
typedef unsigned u32x2 __attribute__((ext_vector_type(2)));

constexpr int BATCH = 16, SEQ = 4096, DM = 1024, DEPTH = 4, MTOK = BATCH * SEQ;
constexpr int NPROJ = 3072, DFF = 4096, NADA = 6 * DM;
constexpr int PC_LX = 0, PC_LY = 256, PC_MQ = 512, PC_MK = 1024, PC_MV = 1536, PC_MO = 2048, PC_AQ = 2560, PC_AKV = 2816, PC_IK = 2944, PC_IW = 2976, PC_MI = 2984, PC_MF = 2988;
constexpr float NORM_EPS = 1e-6f;

constexpr size_t MiB = 1u << 20;
constexpr size_t WS_CTL = 0, CTL_ZERO_BYTES = 1 * MiB;
constexpr size_t WS_MOD = 1 * MiB;
constexpr size_t WS_WQC = 3 * MiB;
constexpr size_t WS_WG = 5 * MiB;
constexpr size_t WS_WUVT = 6 * MiB;
constexpr size_t WS_WIN = 8 * MiB;
constexpr size_t WS_WO = 32 * MiB;
constexpr size_t WS_W1 = 40 * MiB;
constexpr size_t WS_W2 = 72 * MiB;
constexpr size_t WS_XN = 104 * MiB;
constexpr size_t WS_QL = WS_XN, WS_CKV = WS_XN + 32 * MiB, WS_QIDX = WS_XN + 48 * MiB, WS_KIDX = WS_XN + 80 * MiB, WS_WI = WS_XN + 84 * MiB, WS_GT = WS_XN + 86 * MiB;
constexpr size_t WS_CAT = 232 * MiB;
constexpr size_t WS_PROJ = 360 * MiB;
constexpr size_t WS_HB = 360 * MiB;
constexpr size_t WS_QABS = 744 * MiB;
constexpr size_t WS_HLOC = 808 * MiB, WS_CPA = 840 * MiB;
constexpr size_t WS_LSUM = 872 * MiB;
constexpr size_t WS_HM = 874 * MiB;
constexpr size_t WS_MG = 940 * MiB;
constexpr size_t WS_WP = 2 * MiB + 512 * 1024;
constexpr size_t WS_SHW = 6 * MiB + 256 * 1024;
constexpr size_t WS_RSP = 1000 * MiB;
constexpr size_t WS_CARRY = 948 * MiB;
constexpr size_t WS_SCR2 = 949 * MiB;
constexpr int NSHW = NPROJ + DFF;
constexpr size_t WS_END = 1024 * MiB;
static_assert(WS_HM + (size_t)MTOK * 512 * 2 <= WS_END && WS_HB + (size_t)MTOK * DFF * 2 <= WS_HLOC + 64 * MiB, "ws map");

constexpr int CW_TMO = 0, CW_BAR = 4096;

#ifndef HOST_EMU
typedef __bf16 hwbf2_t __attribute__((ext_vector_type(2)));
typedef float hwf2_t __attribute__((ext_vector_type(2)));
DEV unsigned f2bf(float f) { return (unsigned)__builtin_bit_cast(unsigned short, (__bf16)f); }
DEV unsigned pk2(float lo, float hi) { const hwf2_t v = {lo, hi}; return __builtin_bit_cast(unsigned, __builtin_convertvector(v, hwbf2_t)); }
#else
DEV unsigned f2bf(float f) { unsigned u = __builtin_bit_cast(unsigned, f); return (u + 0x7fffu + ((u >> 16) & 1u)) >> 16; }
DEV unsigned pk2(float lo, float hi) { return f2bf(lo) | (f2bf(hi) << 16); }
#endif
DEV float bf2f(unsigned h) { return __builtin_bit_cast(float, h << 16); }
DEV float bflo(unsigned w) { return __builtin_bit_cast(float, w << 16); }
DEV float bfhi(unsigned w) { return __builtin_bit_cast(float, w & 0xffff0000u); }
DEV float wave_sum(float v) {
#pragma unroll
    for (int o = 1; o < 64; o <<= 1) v += SHFL_XOR(v, o);
    return v;
}
#ifndef HOST_EMU
DEV float FEXP(float x) { return __expf(x); }
DEV float FEXP2(float x) { return __builtin_amdgcn_exp2f(x); }
DEV float FRCP(float x) { return __builtin_amdgcn_rcpf(x); }
DEV float FSQRT(float x) { return __builtin_amdgcn_sqrtf(x); }
DEV float RSQ(float x) { return __builtin_amdgcn_rsqf(x); }
DEV float FLOG(float x) { return __logf(x); }
#else
DEV float FEXP(float x) { return expf(x); }
DEV float FEXP2(float x) { return exp2f(x); }
DEV float FRCP(float x) { return 1.0f / x; }
DEV float FSQRT(float x) { return sqrtf(x); }
DEV float RSQ(float x) { return 1.0f / sqrtf(x); }
DEV float FLOG(float x) { return logf(x); }
#endif
#ifndef HOST_EMU
DEV int UNI(int x) { return __builtin_amdgcn_readfirstlane(x); }
#else
DEV int UNI(int x) { return x; }
#endif
#ifndef HOST_EMU
#define GAS __attribute__((address_space(1)))
DEV const GAS char* UNIP(const void* p) { const unsigned long long v = (unsigned long long)p; const unsigned lo = __builtin_amdgcn_readfirstlane((unsigned)v), hi = __builtin_amdgcn_readfirstlane((unsigned)(v >> 32));
    return (const GAS char*)(((unsigned long long)hi << 32) | lo); }
#else
#define GAS
DEV const char* UNIP(const void* p) { return (const char*)p; }
#endif
DEV float RELU(float x) { const int b = __builtin_bit_cast(int, x); return __builtin_bit_cast(float, b > 0 ? b : 0); }
DEV float sigmoidf_(float z) { return 1.0f / (1.0f + expf(-z)); }
DEV float fsigmoid(float z) { return FRCP(1.0f + FEXP(-z)); }
DEV float one_minus_exp(float x) {
    const float s = -x * (1.0f + x * (0.5f + x * (0.16666667f + x * 0.041666668f)));
    return x > -0.05f ? s : 1.0f - FEXP(x);
}

struct Args { const float* in[28]; float* out; unsigned char* ws; int ph_lo, ph_hi; };
struct Ctx {
    char* lds; int tid, lane, wave, G, bid;
    const Args* A;
    unsigned char* ws;
};

constexpr int PTR_OFF = 131072 + 512;
#ifndef HOST_EMU
DEV const float* PIN(const Ctx& F, int i) { const unsigned long long v = ((const unsigned long long*)(F.lds + PTR_OFF))[i];
    const unsigned lo = __builtin_amdgcn_readfirstlane((unsigned)v), hi = __builtin_amdgcn_readfirstlane((unsigned)(v >> 32)); return (const float*)(const __attribute__((address_space(1))) float*)(((unsigned long long)hi << 32) | lo); }
DEV float* POUT(const Ctx& F) { return (float*)PIN(F, 28); }
#else
DEV const float* PIN(const Ctx& F, int i) { return F.A->in[i]; }
DEV float* POUT(const Ctx& F) { return POUT(F); }
#endif
enum { I_X = 0, I_C, I_WIN, I_CONVW, I_CONVB, I_WA, I_BA, I_WX, I_BX, I_LAM, I_BI, I_BF, I_WQUP, I_WQIDX, I_WUK, I_WUV, I_QNW, I_KVNW, I_RELB, I_GNW, I_WO, I_WADA, I_BADA, I_N1W, I_N2W, I_W1, I_W2, I_FNW };

DEV int win_srccol(int n) {
    if (n < 2560) return n;
    if (n < PC_AKV) return 2568 + (n - PC_AQ);
    if (n < PC_IK) return 2824 + (n - PC_AKV);
    if (n < PC_IW) return 2952 + (n - PC_IK);
    if (n < PC_MI) return 2984 + (n - PC_IW);
    if (n < PC_MF) return 2560 + (n - PC_MI);
    if (n < 2992) return 2564 + (n - PC_MF);
    return -1;
}
template <bool MAPPED>
DEV void p0_transpose_item(const float* W, int K, int N, int NT, bf16* WT, float* scr, int item, int lane) {
    const int nblk = NT / 32, kb = item / nblk, nb = item % nblk, k0 = 64 * kb, n0 = 32 * nb;
    int sc = n0 + (lane & 31); if (MAPPED) sc = win_srccol(sc);
#pragma unroll 8
    for (int i = 0; i < 32; ++i) { const int kk = 2 * i + (lane >> 5); scr[kk * 33 + (lane & 31)] = sc >= 0 ? W[(size_t)(k0 + kk) * N + sc] : 0.f; }
    WAVE_LDS_FENCE();
    const int c = lane & 7;
#pragma unroll
    for (int j = 0; j < 4; ++j) { const int n = (lane >> 3) + 8 * j; const float* s = scr + (8 * c) * 33 + n;
        u32x4 o; o.x = pk2(s[0 * 33], s[1 * 33]); o.y = pk2(s[2 * 33], s[3 * 33]); o.z = pk2(s[4 * 33], s[5 * 33]); o.w = pk2(s[6 * 33], s[7 * 33]);
        *(u32x4*)(WT + (size_t)(n0 + n) * K + k0 + 8 * c) = o; }
    WAVE_LDS_FENCE();
}

DEV void ph_prologue(const Ctx& F) {
    const int gt = F.bid * 512 + F.tid, NGT = F.G * 512;
    float* CACT = (float*)F.lds;
    for (int i = F.tid; i < BATCH * DM; i += 512) { const float cv = PIN(F, I_C)[i]; CACT[i] = cv * sigmoidf_(cv); }
    SYNC();
    for (int e = gt; e < DEPTH * NADA * 4; e += NGT) {
        const int j = e % NADA, bq = (e / NADA) & 3, l = e / (NADA * 4);
        const float* w = PIN(F, I_WADA) + (size_t)l * DM * NADA + j;
        const float* c = CACT + bq * 4 * DM;
        float a0 = 0.f, a1 = 0.f, a2 = 0.f, a3 = 0.f;
#pragma unroll 32
        for (int k = 0; k < DM; ++k) { const float wv = w[(size_t)k * NADA];
            a0 += c[k] * wv; a1 += c[DM + k] * wv; a2 += c[2 * DM + k] * wv; a3 += c[3 * DM + k] * wv; }
        const float bb = PIN(F, I_BADA)[(size_t)l * NADA + j];
        float* mo = (float*)(F.ws + WS_MOD) + ((size_t)l * BATCH + bq * 4) * NADA + j;
        mo[0] = a0 + bb; mo[NADA] = a1 + bb; mo[2 * NADA] = a2 + bb; mo[3 * NADA] = a3 + bb;
    }
    for (int e = gt; e < DEPTH * 2 * 4 * 64 * 64; e += NGT) {
        const int i = e & 63, j = (e >> 6) & 63, blk = (e >> 12) & 3, g = (e >> 14) & 1, l = e >> 15;
        const float* src = PIN(F, g ? I_WX : I_WA) + (((size_t)l * 4 + blk) * 64 + i) * 64 + j;
        ((bf16*)(F.ws + WS_WG))[e] = (bf16)f2bf(*src);
    }
    for (int e = gt; e < DEPTH * 4 * 64 * 128; e += NGT) {
        const int r = e & 127, d = (e >> 7) & 63, h = (e >> 13) & 3, l = e >> 15;
        ((bf16*)(F.ws + WS_WUVT))[e] = (bf16)f2bf(PIN(F, I_WUV)[(((size_t)l * 128 + r) * 4 + h) * 64 + d]);
    }
    for (int e = gt; e < DEPTH * 768 * 256; e += NGT) {
        const int r = e & 255, n = (e >> 8) % 768, l = e / (768 * 256);
        float v;
        if (n < 512) { const int h = n >> 7, c = n & 127; const f32x4* q = (const f32x4*)(PIN(F, I_WQUP) + ((size_t)l * 256 + r) * 256 + h * 64); const f32x4* k = (const f32x4*)(PIN(F, I_WUK) + ((size_t)l * 128 + c) * 256 + h * 64);
            float s = 0.f;
#pragma unroll
            for (int d = 0; d < 16; ++d) { const f32x4 a = q[d], bq4 = k[d]; s += (a.x * bq4.x + a.y * bq4.y) + (a.z * bq4.z + a.w * bq4.w); }
            v = s * (0.125f * 1.4426950408889634f); }
        else v = PIN(F, I_WQIDX)[((size_t)l * 256 + r) * 256 + (n - 512)] * 0.17677669529663687f;
        ((bf16*)(F.ws + WS_WQC))[e] = (bf16)f2bf(v);
    }
    SYNC();
    float* scr = (float*)(F.lds + F.wave * 16384);
    const int gw = F.bid * 8 + F.wave, NGW = F.G * 8;
    constexpr int I_IN = (DM / 64) * (NPROJ / 32), I_O = (DM / 64) * (DM / 32), I_1 = (DM / 64) * (DFF / 32), I_2 = (DFF / 64) * (DM / 32);
    constexpr int PER_L = I_IN + I_O + I_1 + I_2;
    for (int it = gw; it < DEPTH * PER_L; it += NGW) {
        const int l = it / PER_L; int r = it % PER_L;
        if (r < I_IN) { p0_transpose_item<true>(PIN(F, I_WIN) + (size_t)l * DM * 2992, DM, 2992, NPROJ, (bf16*)(F.ws + WS_WIN) + (size_t)l * NPROJ * DM, scr, r, F.lane); continue; } r -= I_IN;
        if (r < I_O) { p0_transpose_item<false>(PIN(F, I_WO) + (size_t)l * DM * DM, DM, DM, DM, (bf16*)(F.ws + WS_WO) + (size_t)l * DM * DM, scr, r, F.lane); continue; } r -= I_O;
        if (r < I_1) { p0_transpose_item<false>(PIN(F, I_W1) + (size_t)l * DM * DFF, DM, DFF, DFF, (bf16*)(F.ws + WS_W1) + (size_t)l * DFF * DM, scr, r, F.lane); continue; } r -= I_1;
        p0_transpose_item<false>(PIN(F, I_W2) + (size_t)l * DFF * DM, DFF, DM, DM, (bf16*)(F.ws + WS_W2) + (size_t)l * DM * DFF, scr, r, F.lane);
    }
}

DEV void ph_xs0(const Ctx& F, const float* xsrc, const float* nw, const float* modl, int sc_off, bf16* XS, float* RSP) {
    const int gw = F.bid * 8 + F.wave, NGW = F.G * 8;
    f32x4 wv[4];
#pragma unroll
    for (int j = 0; j < 4; ++j) wv[j] = *(const f32x4*)(nw + 4 * F.lane + 256 * j);
    f32x4 v[2][4], vn[2][4];
#pragma unroll
    for (int q = 0; q < 2; ++q) { const int m = gw + q * NGW; const f32x4* xr = (const f32x4*)(xsrc + (size_t)(m < MTOK ? m : 0) * DM) + F.lane;
#pragma unroll
        for (int j = 0; j < 4; ++j) v[q][j] = xr[64 * j]; }
    for (int m0 = gw; m0 < MTOK; m0 += 2 * NGW) {
        f32x4 sc[2][4];
#pragma unroll
        for (int q = 0; q < 2; ++q) { const int m = m0 + q * NGW; const float* mb = modl + (size_t)((m < MTOK ? m : 0) >> 12) * NADA + 4 * F.lane;
#pragma unroll
            for (int j = 0; j < 4; ++j) sc[q][j] = *(const f32x4*)(mb + sc_off + 256 * j); }
#pragma unroll
        for (int q = 0; q < 2; ++q) { const int m = m0 + (2 + q) * NGW; const f32x4* xr = (const f32x4*)(xsrc + (size_t)(m < MTOK ? m : 0) * DM) + F.lane;
#pragma unroll
            for (int j = 0; j < 4; ++j) vn[q][j] = xr[64 * j]; }
        float s[2];
#pragma unroll
        for (int q = 0; q < 2; ++q) { float a = 0.f;
#pragma unroll
            for (int j = 0; j < 4; ++j) a += (v[q][j].x * v[q][j].x + v[q][j].y * v[q][j].y) + (v[q][j].z * v[q][j].z + v[q][j].w * v[q][j].w);
            s[q] = a; }
#pragma unroll
        for (int o = 1; o < 64; o <<= 1) { s[0] += SHFL_XOR(s[0], o); s[1] += SHFL_XOR(s[1], o); }
#pragma unroll
        for (int q = 0; q < 2; ++q) { const int m = m0 + q * NGW; if (m >= MTOK) break;
            if (F.lane < 16) RSP[(size_t)m * 16 + F.lane] = F.lane == 0 ? s[q] : 0.f;
            u32x2* o8 = (u32x2*)(XS + (size_t)m * DM) + F.lane;
#pragma unroll
            for (int j = 0; j < 4; ++j) { const f32x4 y = v[q][j] * (wv[j] * (1.0f + sc[q][j]));
                u32x2 p; p.x = pk2(y.x, y.y); p.y = pk2(y.z, y.w); o8[64 * j] = p; } }
#pragma unroll
        for (int q = 0; q < 2; ++q)
#pragma unroll
            for (int j = 0; j < 4; ++j) v[q][j] = vn[q][j];
    }
}
DEV void ph_shw(const Ctx& F) {
    const int gt = F.bid * 512 + F.tid, NGT = F.G * 512;
    for (int e = gt; e < DEPTH * 2 * BATCH * (DM / 4); e += NGT) {
        const int c4 = e & 255, b = (e >> 8) & 15, w = (e >> 12) & 1, l = e >> 13;
        const f32x4 nwv = *(const f32x4*)(PIN(F, w ? I_N2W : I_N1W) + l * DM + 4 * c4);
        const f32x4 sc = *(const f32x4*)((const float*)(F.ws + WS_MOD) + ((size_t)l * BATCH + b) * NADA + (w ? 4 * DM : DM) + 4 * c4);
        ((f32x4*)(F.ws + WS_WP))[e] = nwv * (1.0f + sc);
    }
    const int gw = F.bid * 8 + F.wave, NGW = F.G * 8, i16 = F.lane & 15, kq = 8 * (F.lane >> 4);
    for (int it = gw; it < DEPTH * (NSHW / 16); it += NGW) {
        const int l = it / (NSHW / 16), n0 = (it % (NSHW / 16)) * 16;
        const bool mlp = n0 >= NPROJ;
        const bf16* Wr = mlp ? (const bf16*)(F.ws + WS_W1) + ((size_t)l * DFF + (n0 - NPROJ) + i16) * DM : (const bf16*)(F.ws + WS_WIN) + ((size_t)l * NPROJ + n0 + i16) * DM;
        const float* sh = (const float*)(F.ws + WS_MOD) + ((size_t)l * BATCH + i16) * NADA + (mlp ? 3 * DM : 0);
        f32x4 acc0 = {0.f, 0.f, 0.f, 0.f}, acc1 = {0.f, 0.f, 0.f, 0.f};
#pragma unroll 4
        for (int s = 0; s < DM / 32; ++s) {
            const bf16x8 B = *(const bf16x8*)(Wr + 32 * s + kq);
            const f32x4 a0 = *(const f32x4*)(sh + 32 * s + kq), a1 = *(const f32x4*)(sh + 32 * s + kq + 4);
            bf16x8 Ah, Al;
#pragma unroll
            for (int j = 0; j < 8; ++j) { const float a = j < 4 ? a0[j] : a1[j - 4]; const unsigned h = f2bf(a); Ah[j] = (short)h; Al[j] = (short)f2bf(a - bf2f(h)); }
            acc0 = MFMA16(Ah, B, acc0); acc1 = MFMA16(Al, B, acc1);
        }
        float* o = (float*)(F.ws + WS_SHW) + ((size_t)l * BATCH + 4 * (F.lane >> 4)) * NSHW + n0 + i16;
#pragma unroll
        for (int r = 0; r < 4; ++r) o[(size_t)r * NSHW] = acc0[r] + acc1[r];
    }
}
DEV void ph_normmod(const Ctx& F, const float* xsrc, const float* nw, const float* modl, int sh_off, int sc_off, bf16* XN) {
    const int gw = F.bid * 8 + F.wave, NGW = F.G * 8;
    f32x4 wv[4];
#pragma unroll
    for (int j = 0; j < 4; ++j) wv[j] = *(const f32x4*)(nw + 4 * F.lane + 256 * j);
    f32x4 v[2][4], vn[2][4];
#pragma unroll
    for (int q = 0; q < 2; ++q) { const int m = gw + q * NGW; const f32x4* xr = (const f32x4*)(xsrc + (size_t)(m < MTOK ? m : 0) * DM) + F.lane;
#pragma unroll
        for (int j = 0; j < 4; ++j) v[q][j] = xr[64 * j]; }
    for (int m0 = gw; m0 < MTOK; m0 += 2 * NGW) {
        f32x4 sc[2][4], sh[2][4];
#pragma unroll
        for (int q = 0; q < 2; ++q) { const int m = m0 + q * NGW; const float* mb = modl + (size_t)((m < MTOK ? m : 0) >> 12) * NADA + 4 * F.lane;
#pragma unroll
            for (int j = 0; j < 4; ++j) { sc[q][j] = *(const f32x4*)(mb + sc_off + 256 * j); sh[q][j] = *(const f32x4*)(mb + sh_off + 256 * j); } }
#pragma unroll
        for (int q = 0; q < 2; ++q) { const int m = m0 + (2 + q) * NGW; const f32x4* xr = (const f32x4*)(xsrc + (size_t)(m < MTOK ? m : 0) * DM) + F.lane;
#pragma unroll
            for (int j = 0; j < 4; ++j) vn[q][j] = xr[64 * j]; }
        float s[2];
#pragma unroll
        for (int q = 0; q < 2; ++q) { float a = 0.f;
#pragma unroll
            for (int j = 0; j < 4; ++j) a += (v[q][j].x * v[q][j].x + v[q][j].y * v[q][j].y) + (v[q][j].z * v[q][j].z + v[q][j].w * v[q][j].w);
            s[q] = a; }
#pragma unroll
        for (int o = 1; o < 64; o <<= 1) { s[0] += SHFL_XOR(s[0], o); s[1] += SHFL_XOR(s[1], o); }
#pragma unroll
        for (int q = 0; q < 2; ++q) { const int m = m0 + q * NGW; if (m >= MTOK) break;
            const float rs = RSQ(s[q] * (1.0f / DM) + NORM_EPS);
            u32x2* o8 = (u32x2*)(XN + (size_t)m * DM) + F.lane;
#pragma unroll
            for (int j = 0; j < 4; ++j) { const f32x4 y = v[q][j] * rs * wv[j] * (1.0f + sc[q][j]) + sh[q][j];
                u32x2 p; p.x = pk2(y.x, y.y); p.y = pk2(y.z, y.w); o8[64 * j] = p; } }
#pragma unroll
        for (int q = 0; q < 2; ++q)
#pragma unroll
            for (int j = 0; j < 4; ++j) v[q][j] = vn[q][j];
    }
}
DEV void ph_finalnorm(const Ctx& F, const float* xsrc, const float* nw, float* out) {
    const int gw = F.bid * 8 + F.wave, NGW = F.G * 8;
    f32x4 wv[4];
#pragma unroll
    for (int j = 0; j < 4; ++j) wv[j] = *(const f32x4*)(nw + 4 * F.lane + 256 * j);
    f32x4 v[2][4], vn[2][4];
#pragma unroll
    for (int q = 0; q < 2; ++q) { const int m = gw + q * NGW; const f32x4* xr = (const f32x4*)(xsrc + (size_t)(m < MTOK ? m : 0) * DM) + F.lane;
#pragma unroll
        for (int j = 0; j < 4; ++j) v[q][j] = xr[64 * j]; }
    for (int m0 = gw; m0 < MTOK; m0 += 2 * NGW) {
#pragma unroll
        for (int q = 0; q < 2; ++q) { const int m = m0 + (2 + q) * NGW; const f32x4* xr = (const f32x4*)(xsrc + (size_t)(m < MTOK ? m : 0) * DM) + F.lane;
#pragma unroll
            for (int j = 0; j < 4; ++j) vn[q][j] = xr[64 * j]; }
        float s[2];
#pragma unroll
        for (int q = 0; q < 2; ++q) { float a = 0.f;
#pragma unroll
            for (int j = 0; j < 4; ++j) a += (v[q][j].x * v[q][j].x + v[q][j].y * v[q][j].y) + (v[q][j].z * v[q][j].z + v[q][j].w * v[q][j].w);
            s[q] = a; }
#pragma unroll
        for (int o = 1; o < 64; o <<= 1) { s[0] += SHFL_XOR(s[0], o); s[1] += SHFL_XOR(s[1], o); }
#pragma unroll
        for (int q = 0; q < 2; ++q) { const int m = m0 + q * NGW; if (m >= MTOK) break;
            const float rs = RSQ(s[q] * (1.0f / DM) + NORM_EPS);
            f32x4* o = (f32x4*)(out + (size_t)m * DM) + F.lane;
#pragma unroll
            for (int j = 0; j < 4; ++j) o[64 * j] = v[q][j] * rs * wv[j]; }
#pragma unroll
        for (int q = 0; q < 2; ++q)
#pragma unroll
            for (int j = 0; j < 4; ++j) v[q][j] = vn[q][j];
    }
}
DEV void ph_finalnorm16(const Ctx& F, const bf16* x16, const float* nw, float* out) {
    const int gw = F.bid * 8 + F.wave, NGW = F.G * 8;
    f32x4 wv[2][2];
#pragma unroll
    for (int j = 0; j < 2; ++j) { wv[j][0] = *(const f32x4*)(nw + 8 * F.lane + 512 * j); wv[j][1] = *(const f32x4*)(nw + 8 * F.lane + 512 * j + 4); }
    u32x4 v[4][2], vn[4][2];
#pragma unroll
    for (int q = 0; q < 4; ++q) { const int m = gw + q * NGW; const bf16* xr = x16 + (size_t)(m < MTOK ? m : 0) * DM + 8 * F.lane;
        v[q][0] = *(const u32x4*)xr; v[q][1] = *(const u32x4*)(xr + 512); }
    for (int m0 = gw; m0 < MTOK; m0 += 4 * NGW) {
#pragma unroll
        for (int q = 0; q < 4; ++q) { const int m = m0 + (4 + q) * NGW; const bf16* xr = x16 + (size_t)(m < MTOK ? m : 0) * DM + 8 * F.lane;
            vn[q][0] = *(const u32x4*)xr; vn[q][1] = *(const u32x4*)(xr + 512); }
        float s[4];
#pragma unroll
        for (int q = 0; q < 4; ++q) { float a = 0.f;
#pragma unroll
            for (int j = 0; j < 2; ++j) { const u32x4 r = v[q][j];
                a += ((bflo(r.x) * bflo(r.x) + bfhi(r.x) * bfhi(r.x)) + (bflo(r.y) * bflo(r.y) + bfhi(r.y) * bfhi(r.y))) + ((bflo(r.z) * bflo(r.z) + bfhi(r.z) * bfhi(r.z)) + (bflo(r.w) * bflo(r.w) + bfhi(r.w) * bfhi(r.w))); }
            s[q] = a; }
#pragma unroll
        for (int o = 1; o < 64; o <<= 1) {
#pragma unroll
            for (int q = 0; q < 4; ++q) s[q] += SHFL_XOR(s[q], o); }
#pragma unroll
        for (int q = 0; q < 4; ++q) { const int m = m0 + q * NGW; if (m >= MTOK) break;
            const float rs = RSQ(s[q] * (1.0f / DM) + NORM_EPS);
            float* o = out + (size_t)m * DM + 8 * F.lane;
#pragma unroll
            for (int j = 0; j < 2; ++j) { const u32x4 r = v[q][j];
                *(f32x4*)(o + 512 * j) = (f32x4){bflo(r.x), bfhi(r.x), bflo(r.y), bfhi(r.y)} * rs * wv[j][0];
                *(f32x4*)(o + 512 * j + 4) = (f32x4){bflo(r.z), bfhi(r.z), bflo(r.w), bfhi(r.w)} * rs * wv[j][1]; } }
#pragma unroll
        for (int q = 0; q < 4; ++q) { v[q][0] = vn[q][0]; v[q][1] = vn[q][1]; }
    }
}
DEV void ph_zero_cat(const Ctx& F, int c0, int nq) {
    const int gw = F.bid * 8 + F.wave, NGW = F.G * 8;
    bf16* CAT = (bf16*)(F.ws + WS_CAT);
    for (int m = gw; m < MTOK; m += NGW) for (int q = 0; q < nq; ++q) *(u32x2*)(CAT + (size_t)m * DM + c0 + 256 * q + 4 * F.lane) = (u32x2){0u, 0u};
}
DEV float softcap15(float z) { return 15.0f * tanhf(z * (1.0f / 15.0f)); }
DEV float logsigmoidf_(float x) { return x >= 0.f ? -log1pf(expf(-x)) : x - log1pf(expf(x)); }
DEV void ph_prep(const Ctx& F, int l) {
    const int gw = F.bid * 8 + F.wave, NGW = F.G * 8, lane = F.lane;
    const bf16* PROJ = (const bf16*)(F.ws + WS_PROJ);
    bf16* QL = (bf16*)(F.ws + WS_QL); bf16* CKV = (bf16*)(F.ws + WS_CKV); bf16* KIDX = (bf16*)(F.ws + WS_KIDX);
    float* WI = (float*)(F.ws + WS_WI);
    const f32x4 qn = *(const f32x4*)(PIN(F, I_QNW) + l * 256 + 4 * lane);
    const float kn0 = PIN(F, I_KVNW)[l * 128 + 2 * lane], kn1 = PIN(F, I_KVNW)[l * 128 + 2 * lane + 1];
    u32x2 ra4[4], ran[4]; unsigned rk4[4], rx4[4], rkn[4], rxn[4];
#define PREP_LOAD(RA, RK, RX, M0) do { _Pragma("unroll") for (int q = 0; q < 4; ++q) { const int mm = (M0) + q * NGW; const bf16* pr = PROJ + (size_t)(mm < MTOK ? mm : 0) * NPROJ; \
            RA[q] = *(const u32x2*)(pr + PC_AQ + 4 * lane); RK[q] = *(const unsigned*)(pr + PC_AKV + 2 * lane); \
            RX[q] = lane < 16 ? *(const unsigned*)(pr + PC_IK + 2 * lane) : (lane < 24 ? (unsigned)pr[PC_IW + (lane - 16)] : 0u); } } while (0)
    PREP_LOAD(ra4, rk4, rx4, gw);
    for (int m0 = gw; m0 < MTOK; m0 += 4 * NGW) {
        PREP_LOAD(ran, rkn, rxn, m0 + 4 * NGW);
#pragma unroll
        for (int q = 0; q < 4; ++q) { const int m = m0 + q * NGW; if (m >= MTOK) break;
            const u32x2 ra = ra4[q]; const unsigned rk = rk4[q];
            const float a0 = bflo(ra.x), a1 = bfhi(ra.x), a2 = bflo(ra.y), a3 = bfhi(ra.y);
            const float k0 = bflo(rk), k1 = bfhi(rk);
            const float sq = wave_sum((a0 * a0 + a1 * a1) + (a2 * a2 + a3 * a3)), sk = wave_sum(k0 * k0 + k1 * k1);
            const float rq = RSQ(sq * (1.0f / 256.0f) + NORM_EPS), rk2 = RSQ(sk * (1.0f / 128.0f) + NORM_EPS);
            u32x2 oq; oq.x = pk2(a0 * rq * qn.x, a1 * rq * qn.y); oq.y = pk2(a2 * rq * qn.z, a3 * rq * qn.w);
            *(u32x2*)(QL + (size_t)m * 256 + 4 * lane) = oq;
            *(unsigned*)(CKV + (size_t)m * 128 + 2 * lane) = pk2(k0 * rk2 * kn0, k1 * rk2 * kn1);
            if (lane < 16) *(unsigned*)(KIDX + (size_t)m * 32 + 2 * lane) = rx4[q];
            else if (lane < 24) WI[(size_t)m * 8 + (lane - 16)] = bf2f(rx4[q]); }
#pragma unroll
        for (int q = 0; q < 4; ++q) { ra4[q] = ran[q]; rk4[q] = rkn[q]; rx4[q] = rxn[q]; }
    }
#undef PREP_LOAD
}

constexpr int XB_STRIDE = 264;
DEV void ph_lru1(const Ctx& F, int l) {
    const int tid = F.tid, lane = F.lane, w = F.wave, i16 = lane & 15, g = lane >> 4;
    bf16* XB = (bf16*)F.lds;
    float* XF = (float*)(F.lds + 64 * XB_STRIDE * 2);
    const bf16* PROJ = (const bf16*)(F.ws + WS_PROJ);
    bf16* HLOC = (bf16*)(F.ws + WS_HLOC); bf16* CPA = (bf16*)(F.ws + WS_CPA); float* LSUM = (float*)(F.ws + WS_LSUM);
    const int blk = w & 3, nh = w >> 2;
    const bf16* WG = (const bf16*)(F.ws + WS_WG) + (size_t)l * 2 * 4 * 4096;
    bf16x8 Bf[2][2][2];
#pragma unroll
    for (int gg = 0; gg < 2; ++gg)
#pragma unroll
        for (int nt = 0; nt < 2; ++nt)
#pragma unroll
            for (int ks = 0; ks < 2; ++ks) Bf[gg][nt][ks] = *(const bf16x8*)(WG + ((size_t)(gg * 4 + blk) * 64 + nh * 32 + 2 * i16 + nt) * 64 + ks * 32 + 8 * g);
    float ba[2], bx[2], sp[2];
#pragma unroll
    for (int nt = 0; nt < 2; ++nt) { const int ch = blk * 64 + nh * 32 + 2 * i16 + nt;
        ba[nt] = PIN(F, I_BA)[l * 256 + ch]; bx[nt] = PIN(F, I_BX)[l * 256 + ch];
        const float lam = PIN(F, I_LAM)[l * 256 + ch]; sp[nt] = lam > 0.f ? log1pf(expf(-lam)) : -lam + log1pf(expf(lam)); }
    const int ch2 = tid & 127, tg = tid >> 7;
    float cw[4][2], cb[2];
#pragma unroll
    for (int j = 0; j < 4; ++j) { cw[j][0] = PIN(F, I_CONVW)[(l * 4 + j) * 256 + 2 * ch2]; cw[j][1] = PIN(F, I_CONVW)[(l * 4 + j) * 256 + 2 * ch2 + 1]; }
    cb[0] = PIN(F, I_CONVB)[l * 256 + 2 * ch2]; cb[1] = PIN(F, I_CONVB)[l * 256 + 2 * ch2 + 1];

    for (int u = F.bid; u < BATCH * 64; u += F.G) {
        const int b = u >> 6, c = u & 63, t0 = c * 64; const size_t m0 = (size_t)b * SEQ + t0;
        {
            const int tl0 = tg * 16;
            unsigned rv[19];
#pragma unroll
            for (int j = 0; j < 3; ++j) { const int t = t0 + tl0 - 3 + j; rv[j] = t >= 0 ? *(const unsigned*)(PROJ + ((size_t)b * SEQ + t) * NPROJ + PC_LX + 2 * ch2) : 0u; }
#pragma unroll
            for (int tt = 0; tt < 16; ++tt) rv[3 + tt] = *(const unsigned*)(PROJ + (m0 + tl0 + tt) * NPROJ + PC_LX + 2 * ch2);
#pragma unroll
            for (int tt = 0; tt < 16; ++tt) { const int tl = tl0 + tt;
                const float x0 = cw[0][0] * bflo(rv[tt]) + cw[1][0] * bflo(rv[tt + 1]) + cw[2][0] * bflo(rv[tt + 2]) + cw[3][0] * bflo(rv[tt + 3]) + cb[0];
                const float x1 = cw[0][1] * bfhi(rv[tt]) + cw[1][1] * bfhi(rv[tt + 1]) + cw[2][1] * bfhi(rv[tt + 2]) + cw[3][1] * bfhi(rv[tt + 3]) + cb[1];
                *(unsigned*)(XB + tl * XB_STRIDE + 2 * ch2) = pk2(x0, x1);
                XF[tl * 256 + 2 * ch2] = x0; XF[tl * 256 + 2 * ch2 + 1] = x1; }
        }
        SYNC();
        float CA[2] = {1.f, 1.f}, CU[2] = {0.f, 0.f};
#pragma unroll 1
        for (int m = 0; m < 4; ++m) {
            f32x4 acc[2][2];
#pragma unroll
            for (int gg = 0; gg < 2; ++gg)
#pragma unroll
                for (int nt = 0; nt < 2; ++nt) acc[gg][nt] = (f32x4){0.f, 0.f, 0.f, 0.f};
#pragma unroll
            for (int ks = 0; ks < 2; ++ks) { const bf16x8 A = *(const bf16x8*)(XB + (m * 16 + i16) * XB_STRIDE + blk * 64 + ks * 32 + 8 * g);
#pragma unroll
                for (int gg = 0; gg < 2; ++gg)
#pragma unroll
                    for (int nt = 0; nt < 2; ++nt) acc[gg][nt] = MFMA16(A, Bf[gg][nt][ks], acc[gg][nt]); }
            float HL[2][4], CP[2][4];
            const int chb = blk * 64 + nh * 32 + 2 * i16;
            float xf[4][2];
#pragma unroll
            for (int r = 0; r < 4; ++r) { const float* xp = XF + (m * 16 + 4 * g + r) * 256 + chb; xf[r][0] = xp[0]; xf[r][1] = xp[1]; }
#pragma unroll
            for (int nt = 0; nt < 2; ++nt) {
                float P[4], H[4]; float pa = 1.f, hu = 0.f;
#pragma unroll
                for (int r = 0; r < 4; ++r) {
                    const float rg = fsigmoid(acc[0][nt][r] + ba[nt]), gi = fsigmoid(acc[1][nt][r] + bx[nt]);
                    const float la = -8.0f * rg * sp[nt], a = FEXP(la), uu = FSQRT((1.0f - a) * (1.0f + a)) * (gi * xf[r][nt]);
                    pa = a * pa; hu = a * hu + uu; P[r] = pa; H[r] = hu;
                    }
                float EA = 1.f, EU = 0.f, TA = 1.f, TU = 0.f;
#pragma unroll
                for (int gg = 0; gg < 4; ++gg) { const float ta = SHFL(pa, i16 + 16 * gg), tu = SHFL(hu, i16 + 16 * gg);
                    if (gg < g) { EU = ta * EU + tu; EA = ta * EA; }
                    TU = ta * TU + tu; TA = ta * TA; }
                const float XA = EA * CA[nt], XU = EA * CU[nt] + EU;
#pragma unroll
                for (int r = 0; r < 4; ++r) { HL[nt][r] = P[r] * XU + H[r]; CP[nt][r] = P[r] * XA; }
                CU[nt] = TA * CU[nt] + TU; CA[nt] = TA * CA[nt];
            }
#pragma unroll
            for (int r = 0; r < 4; ++r) { const size_t o = (m0 + m * 16 + 4 * g + r) * 256 + chb;
                *(unsigned*)(HLOC + o) = pk2(HL[0][r], HL[1][r]); *(unsigned*)(CPA + o) = pk2(CP[0][r], CP[1][r]); }
        }
        if (g == 0) {
#pragma unroll
            for (int nt = 0; nt < 2; ++nt) { const int ch = blk * 64 + nh * 32 + 2 * i16 + nt;
                LSUM[((size_t)b * 64 + c) * 256 + ch] = CA[nt]; LSUM[(size_t)BATCH * 64 * 256 + ((size_t)b * 64 + c) * 256 + ch] = CU[nt]; }
        }
        SYNC();
    }
}

DEV float gelu_tanh(float x) { const float z = 0.7978845608028654f * (x + 0.044715f * x * x * x); return x * FRCP(1.0f + FEXP(-2.0f * z)); }
DEV void ph_carry(const Ctx& F) {
    if (F.wave != 0) return;
    const float* LSUM = (const float*)(F.ws + WS_LSUM); float* CARRY = (float*)(F.ws + WS_CARRY);
    const int seg = F.lane & 3;
    for (int chain = F.bid * 16 + (F.lane >> 2); chain < BATCH * 256; chain += F.G * 16) {
        const int b = chain >> 8, ch = chain & 255; const size_t o0 = ((size_t)b * 64 + seg * 16) * 256 + ch;
        float a[16], hb[16];
#pragma unroll
        for (int i = 0; i < 16; ++i) { a[i] = LSUM[o0 + (size_t)i * 256]; hb[i] = LSUM[(size_t)BATCH * 64 * 256 + o0 + (size_t)i * 256]; }
        float hp[16], ap[16], hl = 0.f, al = 1.f;
#pragma unroll
        for (int i = 0; i < 16; ++i) { hp[i] = hl; ap[i] = al; hl = a[i] * hl + hb[i]; al = a[i] * al; }
        float cin = 0.f;
#pragma unroll
        for (int s2 = 0; s2 < 3; ++s2) { const float as = SHFL(al, (F.lane & ~3) + s2), hs = SHFL(hl, (F.lane & ~3) + s2); if (s2 < seg) cin = as * cin + hs; }
#pragma unroll
        for (int i = 0; i < 16; ++i) CARRY[o0 + (size_t)i * 256] = ap[i] * cin + hp[i];
    }
}
DEV void ph_lru2(const Ctx& F, int l) {
    const int tid = F.tid, lane = F.lane, w = F.wave;
    const bf16* PROJ = (const bf16*)(F.ws + WS_PROJ); const bf16* HLOC = (const bf16*)(F.ws + WS_HLOC); const bf16* CPA = (const bf16*)(F.ws + WS_CPA);
    const float* CARRY = (const float*)(F.ws + WS_CARRY); bf16* CAT = (bf16*)(F.ws + WS_CAT);
    const f32x4 gw4 = *(const f32x4*)(PIN(F, I_GNW) + l * DM + 4 * lane);
    for (int u = F.bid; u < BATCH * 64; u += F.G) {
        const int b = u >> 6, c = u & 63; const size_t m0 = (size_t)b * SEQ + c * 64;
        const f32x4 car = *(const f32x4*)(CARRY + (size_t)u * 256 + 4 * lane);
        u32x2 hl8[8], cp8[8], ly8[8];
#pragma unroll
        for (int tt = 0; tt < 8; ++tt) { const size_t m = m0 + w * 8 + tt;
            hl8[tt] = *(const u32x2*)(HLOC + m * 256 + 4 * lane); cp8[tt] = *(const u32x2*)(CPA + m * 256 + 4 * lane); ly8[tt] = *(const u32x2*)(PROJ + m * NPROJ + PC_LY + 4 * lane); }
#pragma unroll
        for (int tt = 0; tt < 8; ++tt) { const size_t m = m0 + w * 8 + tt; const u32x2 hl = hl8[tt], cp = cp8[tt], ly = ly8[tt];
            float v0 = (bflo(hl.x) + bflo(cp.x) * car.x) * gelu_tanh(bflo(ly.x));
            float v1 = (bfhi(hl.x) + bfhi(cp.x) * car.y) * gelu_tanh(bfhi(ly.x));
            float v2 = (bflo(hl.y) + bflo(cp.y) * car.z) * gelu_tanh(bflo(ly.y));
            float v3 = (bfhi(hl.y) + bfhi(cp.y) * car.w) * gelu_tanh(bfhi(ly.y));
            const float rs = RSQ(wave_sum((v0 * v0 + v1 * v1) + (v2 * v2 + v3 * v3)) * (1.0f / 256.0f) + NORM_EPS);
            u32x2 o; o.x = pk2(v0 * rs * gw4.x, v1 * rs * gw4.y); o.y = pk2(v2 * rs * gw4.z, v3 * rs * gw4.w);
            *(u32x2*)(CAT + m * DM + 4 * lane) = o; }
    }
}

constexpr int QS_STRIDE = 136, VE_STRIDE = 56;
DEV void ph_mlstm(const Ctx& F, int l) {
    const int tid = F.tid, lane = F.lane, w = F.wave, i16 = lane & 15, g = lane >> 4;
    bf16* QsB = (bf16*)F.lds;
    bf16* KsB = QsB + 2 * 64 * QS_STRIDE;
    bf16* VE = KsB + 2 * 64 * QS_STRIDE;
    bf16* VW = VE + 64 * VE_STRIDE;
    bf16* CsB = VW + 64 * VE_STRIDE;
    float* BCB = (float*)(CsB + 2 * 128 * VE_STRIDE);
    float* BIB = BCB + 128;
    const bf16* PROJ = (const bf16*)(F.ws + WS_PROJ); bf16* HM = (bf16*)(F.ws + WS_HM);
    const float qscale = 0.08838834764831845f;
    const int jt = w & 3, half = w >> 2;
    for (int u = F.bid; u < BATCH * 4 * 4; u += F.G) {
        const int b = u >> 4, h = (u >> 2) & 3, vs = u & 3;
        const float gbi = PIN(F, I_BI)[l * 4 + h], gbf = PIN(F, I_BF)[l * 4 + h];
        f32x4 accC[3];
#pragma unroll
        for (int nt = 0; nt < 3; ++nt) accC[nt] = (f32x4){0.f, 0.f, 0.f, 0.f};
        float* BCg = (float*)(F.ws + WS_MG) + (size_t)u * 8192; float* BIg = BCg + 4096;
        unsigned gri[8], grf[8];
#pragma unroll
        for (int k = 0; k < 8; ++k) { const bf16* pr = PROJ + ((size_t)b * SEQ + (8 * k + w) * 64 + lane) * NPROJ; gri[k] = pr[PC_MI + h]; grf[k] = pr[PC_MF + h]; }
#pragma unroll
        for (int k = 0; k < 8; ++k) { const int tok = (8 * k + w) * 64 + lane;
            const float zi = (bf2f(gri[k]) + gbi) * (1.0f / 15.0f), zf = (bf2f(grf[k]) + gbf) * (1.0f / 15.0f);
            const float ig = 15.0f - 30.0f * FRCP(FEXP(2.0f * zi) + 1.0f), fg = 15.0f - 30.0f * FRCP(FEXP(2.0f * zf) + 1.0f);
            float s = -FLOG(1.0f + FEXP(-fg));
#pragma unroll
            for (int o = 1; o < 64; o <<= 1) { const float t = SHFL_UP(s, o); if (lane >= o) s += t; }
            BCg[tok] = s; BIg[tok] = s - ig; }
        SYNC();
        u32x4 rq[2], rk[2]; u32x2 rvv; float rgc = 0.f, rgb = 0.f;
        {
            const size_t m0 = (size_t)b * SEQ;
#pragma unroll
            for (int i = 0; i < 2; ++i) { const int idx = tid + 512 * i, row = idx >> 4, ck = idx & 15;
                rq[i] = *(const u32x4*)(PROJ + (m0 + row) * NPROJ + PC_MQ + h * 128 + 8 * ck); rk[i] = *(const u32x4*)(PROJ + (m0 + row) * NPROJ + PC_MK + h * 128 + 8 * ck); }
            rvv = *(const u32x2*)(PROJ + (m0 + (tid >> 3)) * NPROJ + PC_MV + h * 128 + vs * 32 + 4 * (tid & 7));
            if (tid < 64) { rgc = BCg[tid]; rgb = BIg[tid]; }
        }
        for (int c = 0; c < 64; ++c) {
            const size_t m0 = (size_t)b * SEQ + c * 64; const int buf = c & 1;
            bf16* Qs = QsB + buf * 64 * QS_STRIDE; bf16* Ks = KsB + buf * 64 * QS_STRIDE; const bf16* Cs = CsB + buf * 128 * VE_STRIDE; bf16* Cn = CsB + (buf ^ 1) * 128 * VE_STRIDE;
            float* BC = BCB + buf * 64; float* BI = BIB + buf * 64;
#pragma unroll
            for (int i = 0; i < 2; ++i) { const int idx = tid + 512 * i, row = idx >> 4, ck = idx & 15;
                *(u32x4*)(Qs + row * QS_STRIDE + 8 * ck) = rq[i]; *(u32x4*)(Ks + row * QS_STRIDE + 8 * ck) = rk[i]; }
            if (tid < 64) { BC[tid] = rgc; BI[tid] = rgb; }
            SYNC();
            {
                const int row = tid >> 3, cg = tid & 7;
                const u32x2 rv = rvv;
                const float wt = FEXP(BC[63] - BI[row]);
                *(u32x2*)(VE + row * VE_STRIDE + 4 * cg) = rv;
                u32x2 sv; sv.x = pk2(bflo(rv.x) * wt, bfhi(rv.x) * wt); sv.y = pk2(bflo(rv.y) * wt, bfhi(rv.y) * wt);
                *(u32x2*)(VW + row * VE_STRIDE + 4 * cg) = sv;
                if (cg == 0) { unsigned one_ = 0x3f80u; LAUNDER_V(one_); u32x4 z = (u32x4){one_, 0u, 0u, 0u}; *(u32x4*)(VE + row * VE_STRIDE + 32) = z; *(u32x4*)(VE + row * VE_STRIDE + 40) = (u32x4){0u, 0u, 0u, 0u};
                    z.x = f2bf(wt); *(u32x4*)(VW + row * VE_STRIDE + 32) = z; *(u32x4*)(VW + row * VE_STRIDE + 40) = (u32x4){0u, 0u, 0u, 0u}; }
            }
            if (c + 1 < 64) {
                const size_t m1 = m0 + 64;
#pragma unroll
                for (int i = 0; i < 2; ++i) { const int idx = tid + 512 * i, row = idx >> 4, ck = idx & 15;
                    rq[i] = *(const u32x4*)(PROJ + (m1 + row) * NPROJ + PC_MQ + h * 128 + 8 * ck); rk[i] = *(const u32x4*)(PROJ + (m1 + row) * NPROJ + PC_MK + h * 128 + 8 * ck); }
                rvv = *(const u32x2*)(PROJ + (m1 + (tid >> 3)) * NPROJ + PC_MV + h * 128 + vs * 32 + 4 * (tid & 7));
                if (tid < 64) { rgc = BCg[(c + 1) * 64 + tid]; rgb = BIg[(c + 1) * 64 + tid]; }
            }
            SYNC();
            f32x4 Z[2] = {(f32x4){0.f, 0.f, 0.f, 0.f}, (f32x4){0.f, 0.f, 0.f, 0.f}};
            {
                bf16x8 Bq[4];
#pragma unroll
                for (int ks = 0; ks < 4; ++ks) Bq[ks] = *(const bf16x8*)(Qs + (16 * jt + i16) * QS_STRIDE + 32 * ks + 8 * g);
                const float bj = BC[16 * jt + i16];
                unsigned pk[4][2];
#pragma unroll
                for (int tt = 0; tt < 4; ++tt) {
                    if (tt <= jt) {
                        f32x4 X = (f32x4){0.f, 0.f, 0.f, 0.f};
#pragma unroll
                        for (int ks = 0; ks < 4; ++ks) X = MFMA16(*(const bf16x8*)(Ks + (16 * tt + i16) * QS_STRIDE + 32 * ks + 8 * g), Bq[ks], X);
                        float p[4]; const f32x4 bi4 = *(const f32x4*)(BI + 16 * tt + 4 * g);
#pragma unroll
                        for (int r = 0; r < 4; ++r) { const float pv = X[r] * qscale * FEXP(fminf(bj - bi4[r], 60.0f));
                            p[r] = (tt < jt || 4 * g + r <= i16) ? pv : 0.f; }
                        pk[tt][0] = pk2(p[0], p[1]); pk[tt][1] = pk2(p[2], p[3]);
                    } else { pk[tt][0] = 0u; pk[tt][1] = 0u; }
                }
#pragma unroll
                for (int pr = 0; pr < 2; ++pr) {
                    if (2 * pr <= jt) {
                        u32x4 aw = (u32x4){pk[2 * pr][0], pk[2 * pr][1], pk[2 * pr + 1][0], pk[2 * pr + 1][1]};
                        const bf16x8 A = __builtin_bit_cast(bf16x8, aw);
#pragma unroll
                        for (int n = 0; n < 2; ++n) { const int ntc = n ? 2 : half;
                            const s16x4 lo = TR16(VE + (32 * pr + 4 * g + (i16 >> 2)) * VE_STRIDE + 16 * ntc + 4 * (i16 & 3));
                            const s16x4 hi = TR16(VE + (32 * pr + 16 + 4 * g + (i16 >> 2)) * VE_STRIDE + 16 * ntc + 4 * (i16 & 3));
                            const bf16x8 B = (bf16x8){lo[0], lo[1], lo[2], lo[3], hi[0], hi[1], hi[2], hi[3]};
                            Z[n] = MFMA16(A, B, Z[n]); }
#ifndef HOST_EMU
                        asm volatile("" :: "v"(aw));
#endif
                    }
                }
            }
            if (c > 0) {
                f32x4 Z2[2] = {(f32x4){0.f, 0.f, 0.f, 0.f}, (f32x4){0.f, 0.f, 0.f, 0.f}};
#pragma unroll
                for (int ks = 0; ks < 4; ++ks) { const bf16x8 A = *(const bf16x8*)(Qs + (16 * jt + i16) * QS_STRIDE + 32 * ks + 8 * g);
#pragma unroll
                    for (int n = 0; n < 2; ++n) { const int ntc = n ? 2 : half;
                        const s16x4 lo = TR16(Cs + (32 * ks + 8 * g + (i16 >> 2)) * VE_STRIDE + 16 * ntc + 4 * (i16 & 3));
                        const s16x4 hi = TR16(Cs + (32 * ks + 8 * g + 4 + (i16 >> 2)) * VE_STRIDE + 16 * ntc + 4 * (i16 & 3));
                        const bf16x8 B = (bf16x8){lo[0], lo[1], lo[2], lo[3], hi[0], hi[1], hi[2], hi[3]};
                        Z2[n] = MFMA16(A, B, Z2[n]); } }
                const f32x4 bc4 = *(const f32x4*)(BC + 16 * jt + 4 * g);
#pragma unroll
                for (int r = 0; r < 4; ++r) { const float f = qscale * FEXP(bc4[r]); Z[0][r] += f * Z2[0][r]; Z[1][r] += f * Z2[1][r]; }
            }
#pragma unroll
            for (int r = 0; r < 4; ++r) { const int j = 16 * jt + 4 * g + r; const float dn = FRCP(fmaxf(fabsf(SHFL(Z[1][r], lane & 48)), 1.0f));
                HM[(m0 + j) * 512 + h * 128 + vs * 32 + 16 * half + i16] = (bf16)f2bf(Z[0][r] * dn); }
            {
                const float dec = FEXP(BC[63]);
#pragma unroll
                for (int nt = 0; nt < 3; ++nt) accC[nt] = accC[nt] * dec;
#pragma unroll
                for (int ks = 0; ks < 2; ++ks) {
                    const s16x4 alo = TR16(Ks + (32 * ks + 8 * g + (i16 >> 2)) * QS_STRIDE + 16 * w + 4 * (i16 & 3));
                    const s16x4 ahi = TR16(Ks + (32 * ks + 8 * g + 4 + (i16 >> 2)) * QS_STRIDE + 16 * w + 4 * (i16 & 3));
                    const bf16x8 A = (bf16x8){alo[0], alo[1], alo[2], alo[3], ahi[0], ahi[1], ahi[2], ahi[3]};
#pragma unroll
                    for (int nt = 0; nt < 3; ++nt) {
                        const s16x4 lo = TR16(VW + (32 * ks + 8 * g + (i16 >> 2)) * VE_STRIDE + 16 * nt + 4 * (i16 & 3));
                        const s16x4 hi = TR16(VW + (32 * ks + 8 * g + 4 + (i16 >> 2)) * VE_STRIDE + 16 * nt + 4 * (i16 & 3));
                        const bf16x8 B = (bf16x8){lo[0], lo[1], lo[2], lo[3], hi[0], hi[1], hi[2], hi[3]};
                        const f32x4 cold = accC[nt]; accC[nt] = MFMA16(A, B, cold);
#ifndef HOST_EMU
                        asm volatile("" :: "v"(cold), "v"(A), "v"(B));
#endif
                    }
                }
#pragma unroll
                for (int nt = 0; nt < 3; ++nt)
#pragma unroll
                    for (int r = 0; r < 4; ++r) Cn[(16 * w + 4 * g + r) * VE_STRIDE + 16 * nt + i16] = (bf16)f2bf(accC[nt][r]);
            }
        }
        SYNC();
    }
}

DEV void ph_mfin(const Ctx& F, int l) {
    const int gw = F.bid * 8 + F.wave, NGW = F.G * 8, lane = F.lane;
    const bf16* PROJ = (const bf16*)(F.ws + WS_PROJ); const bf16* HM = (const bf16*)(F.ws + WS_HM); bf16* CAT = (bf16*)(F.ws + WS_CAT);
    float gm[8];
#pragma unroll
    for (int j = 0; j < 8; ++j) gm[j] = PIN(F, I_GNW)[l * DM + 256 + 8 * lane + j];
    u32x4 hv4[4], ov4[4], hvn[4], ovn[4];
#define MFIN_LOAD(HV, OV, M0) do { _Pragma("unroll") for (int q = 0; q < 4; ++q) { const int mm = (M0) + q * NGW; const size_t ms = (size_t)(mm < MTOK ? mm : 0); \
            HV[q] = *(const u32x4*)(HM + ms * 512 + 8 * lane); OV[q] = *(const u32x4*)(PROJ + ms * NPROJ + PC_MO + 8 * lane); } } while (0)
    MFIN_LOAD(hv4, ov4, gw);
    for (int m0 = gw; m0 < MTOK; m0 += 4 * NGW) {
        MFIN_LOAD(hvn, ovn, m0 + 4 * NGW);
#pragma unroll
        for (int q = 0; q < 4; ++q) { const int m = m0 + q * NGW; if (m >= MTOK) break;
            const u32x4 hv = hv4[q], ov = ov4[q];
            float v[8] = {bflo(hv.x), bfhi(hv.x), bflo(hv.y), bfhi(hv.y), bflo(hv.z), bfhi(hv.z), bflo(hv.w), bfhi(hv.w)};
            const float o[8] = {bflo(ov.x), bfhi(ov.x), bflo(ov.y), bfhi(ov.y), bflo(ov.z), bfhi(ov.z), bflo(ov.w), bfhi(ov.w)};
            float s = 0.f;
#pragma unroll
            for (int j = 0; j < 8; ++j) s += v[j] * v[j];
            s += SHFL_XOR(s, 1); s += SHFL_XOR(s, 2); s += SHFL_XOR(s, 4); s += SHFL_XOR(s, 8);
            const float rs = RSQ(s * (1.0f / 128.0f) + NORM_EPS);
            u32x4 r;
            r.x = pk2(v[0] * rs * gm[0] * fsigmoid(o[0]), v[1] * rs * gm[1] * fsigmoid(o[1]));
            r.y = pk2(v[2] * rs * gm[2] * fsigmoid(o[2]), v[3] * rs * gm[3] * fsigmoid(o[3]));
            r.z = pk2(v[4] * rs * gm[4] * fsigmoid(o[4]), v[5] * rs * gm[5] * fsigmoid(o[5]));
            r.w = pk2(v[6] * rs * gm[6] * fsigmoid(o[6]), v[7] * rs * gm[7] * fsigmoid(o[7]));
            *(u32x4*)(CAT + (size_t)m * DM + 256 + 8 * lane) = r; }
#pragma unroll
        for (int q = 0; q < 4; ++q) { hv4[q] = hvn[q]; ov4[q] = ovn[q]; }
    }
#undef MFIN_LOAD
}

constexpr int DS_HIST = 0;
constexpr int DS_MASK = 49152;
constexpr int DS_CAND = 65536;
constexpr int DS_SELL = 102400;
constexpr int DS_META = 118784;
constexpr int DS_RB = DS_META + 512;
constexpr int DS_SS = DS_RB + 2048;
constexpr int DS_SLOT = 12800;
constexpr int NBIN = 768, CAND_CAP = 128;
__device__ const unsigned char T5B[114] = {0, 1, 2, 3, 4, 5, 6, 7, 8, 9, 10, 11, 12, 13, 14, 15, 16, 16, 16, 17, 17, 18, 18, 18, 19, 19, 19, 20, 20, 20, 20, 21, 21, 21, 21, 22, 22, 22, 22, 22, 23, 23, 23, 23, 23, 23, 24, 24, 24, 24, 24, 24, 25, 25, 25, 25, 25, 25, 25, 26, 26, 26, 26, 26, 26, 26, 26, 27, 27, 27, 27, 27, 27, 27, 27, 27, 27, 28, 28, 28, 28, 28, 28, 28, 28, 28, 28, 29, 29, 29, 29, 29, 29, 29, 29, 29, 29, 29, 29, 30, 30, 30, 30, 30, 30, 30, 30, 30, 30, 30, 30, 30, 30, 31};

DEV int score_bin(float sc) {
    const unsigned u = __builtin_bit_cast(unsigned, sc);
    int e = (int)((u >> 18) & 0x1FFFu) - 119 * 32; e = e < 0 ? 0 : (e > 383 ? 383 : e);
    return (u >> 31) ? 383 - e : 384 + e;
}
DEV unsigned score_key(float sc) { const unsigned u = __builtin_bit_cast(unsigned, sc); return (u >> 31) ? ~u : (u | 0x80000000u); }
DEV unsigned score_code(float sc) {
    const unsigned u = __builtin_bit_cast(unsigned, sc);
    int e = (int)((u >> 18) & 0x1FFFu) - 119 * 32; e = e < 0 ? 0 : (e > 383 ? 383 : e);
    return ((u >> 16) & 0x8000u) | ((unsigned)e << 6) | ((u >> 12) & 63u);
}
DEV int code_bin(unsigned c) { const int e = (int)((c >> 6) & 0x1FFu); return (c & 0x8000u) ? 383 - e : 384 + e; }
DEV unsigned code_key(unsigned c) { return (c & 0x8000u) ? 63u - (c & 63u) : (c & 63u); }


DEV f32x4 dsa_score_tile(const bf16x8 A, const bf16x8 (&QS)[2], const bf16x8 (&Bq)[8], const float (&wq)[8]) {
    f32x4 sc = (f32x4){0.f, 0.f, 0.f, 0.f};
#pragma unroll
    for (int h = 0; h < 8; ++h) { const f32x4 d = MFMA16(A, Bq[h], (f32x4){0.f, 0.f, 0.f, 0.f});
#pragma unroll
        for (int r = 0; r < 4; ++r) sc[r] += wq[h] * RELU(d[r]); }
    return sc;
}
DEV void ph_dsa(const Ctx& F, int l) {
    const int tid = F.tid, lane = F.lane, w = F.wave, i16 = lane & 15, g = lane >> 4;
    unsigned* HIST = (unsigned*)(F.lds + DS_HIST); unsigned* MASK = (unsigned*)(F.lds + DS_MASK); u32x2* CAND = (u32x2*)(F.lds + DS_CAND);
    unsigned short* SELL = (unsigned short*)(F.lds + DS_SELL); int* BST = (int*)(F.lds + DS_META); int* NAB = BST + 32; int* NCAND = BST + 64; int* NSEL = BST + 96;
    float* RB = (float*)(F.lds + DS_RB);
    const bf16* QIDX = (const bf16*)(F.ws + WS_QIDX); const bf16* KIDX = (const bf16*)(F.ws + WS_KIDX); const float* WI = (const float*)(F.ws + WS_WI);
    const bf16* QABS = (const bf16*)(F.ws + WS_QABS); const bf16* CKV = (const bf16*)(F.ws + WS_CKV); bf16* CAT = (bf16*)(F.ws + WS_CAT);
    const bf16* WUVT = (const bf16*)(F.ws + WS_WUVT) + (size_t)l * 4 * 64 * 128; float* SS = (float*)(F.lds + DS_SS);
    for (int e = tid; e < 114 * 4; e += 512) RB[e] = PIN(F, I_RELB)[T5B[e >> 2] * 4 + (e & 3)] * 1.4426950408889634f;
    SYNC();
    for (int ui = F.bid; ui < BATCH * 128; ui += F.G) {
        int b, qt; { const int wv = ui & 255, k = ui >> 8, r = wv & 15; b = wv >> 4; qt = (k & 1) ? (32 * (k >> 1) + 31 - r) : (32 * (k >> 1) + r); }
        const int t0 = 32 * qt, nkt = 2 * qt + 2; const size_t mb = (size_t)b * SEQ;
        const GAS char* const ckvb = UNIP(CKV + mb * 128);
        const int nt = w & 1;
        u32x2* sw = (u32x2*)(F.ws + (F.bid < 128 ? WS_QL + (size_t)F.bid * 262144 : WS_SCR2 + (size_t)(F.bid - 128) * 262144) + (size_t)w * 32768) + lane;
        bf16x8 Bq[8]; float wq[8];
        { const size_t mq = mb + t0 + 16 * nt + i16;
#pragma unroll
            for (int h = 0; h < 8; ++h) { Bq[h] = *(const bf16x8*)(QIDX + mq * 256 + 32 * h + 8 * g); wq[h] = WI[mq * 8 + h]; } }
        bf16x8 QS[2];
#pragma unroll
        for (int j = 0; j < 8; ++j) { float s = 0.f;
#pragma unroll
            for (int h = 0; h < 8; ++h) s += wq[h] * bf2f((unsigned)(unsigned short)Bq[h][j]);
            const unsigned hi = f2bf(s); QS[0][j] = (short)hi; QS[1][j] = (short)f2bf(s - bf2f(hi)); }
        for (int e = tid; e < 16 * NBIN; e += 512) HIST[e] = 0u;
        for (int e = tid; e < 32 * 128; e += 512) MASK[e] = 0u;
        if (tid < 32) NCAND[tid] = 0;
        SYNC();
        bf16x8 Apre = *(const bf16x8*)(KIDX + (mb + 16 * (w >> 1) + i16) * 32 + 8 * g);
        for (int kt = w >> 1; kt < nkt; kt += 4) {
            const bf16x8 A = Apre;
            { const int kn = kt + 4 < nkt ? kt + 4 : kt; Apre = *(const bf16x8*)(KIDX + (mb + 16 * kn + i16) * 32 + 8 * g); }
            const f32x4 sc = dsa_score_tile(A, QS, Bq, wq);
            unsigned cd[4];
#pragma unroll
            for (int r = 0; r < 4; ++r) cd[r] = score_code(sc[r] + 0.0f);
            { u32x2 pk; pk.x = cd[0] | (cd[1] << 16); pk.y = cd[2] | (cd[3] << 16); sw[(size_t)((kt - (w >> 1)) >> 2) * 64] = pk; }
            const unsigned inc = nt ? 65536u : 1u;
            if (kt < 2 * qt) {
#pragma unroll
                for (int r = 0; r < 4; ++r) atomicAdd(&HIST[i16 * NBIN + code_bin(cd[r])], inc);
            } else {
                const int t = t0 + 16 * nt + i16;
#pragma unroll
                for (int r = 0; r < 4; ++r) { const int s = 16 * kt + 4 * g + r;
                    if (s <= t) atomicAdd(&HIST[i16 * NBIN + code_bin(cd[r])], inc); }
            }
        }
        SYNC();
#pragma unroll 1
        for (int rr = 0; rr < 4; ++rr) {
            const int row = 4 * w + rr, t = t0 + row;
            if (t < 256) { if (lane == 0) { BST[row] = -1; NAB[row] = t + 1; } continue; }
            const int sh = (row >> 4) * 16; const unsigned* hp = HIST + (row & 15) * NBIN + 12 * lane;
            int cnt[12]; int tot = 0;
#pragma unroll
            for (int i = 0; i < 12; ++i) { cnt[i] = (int)((hp[i] >> sh) & 0xFFFFu); tot += cnt[i]; }
            int suf = tot;
#pragma unroll
            for (int o = 1; o < 64; o <<= 1) { const int v = SHFL_DOWN(suf, o); if (lane + o < 64) suf += v; }
            const int above = suf - tot;
            if (above < 256 && above + tot >= 256) {
                int run = above, bs = -1, na = 0; bool done = false;
#pragma unroll
                for (int i = 11; i >= 0; --i) { if (!done) { if (run + cnt[i] >= 256) { bs = 12 * lane + i; na = run; done = true; } else run += cnt[i]; } }
                BST[row] = bs; NAB[row] = na;
            }
        }
        SYNC();
        { const int row = 16 * nt + i16, t = t0 + row, bs = BST[row];
        const int ntl = nkt > (w >> 1) ? ((nkt - 1 - (w >> 1)) >> 2) + 1 : 0;
        u32x2 P0 = sw[0], P1 = sw[(size_t)(1 < ntl ? 1 : 0) * 64];
        for (int j = 0; j < ntl; ++j) { const int kt = (w >> 1) + 4 * j;
            const u32x2 pc = P0; P0 = P1; P1 = sw[(size_t)(j + 2 < ntl ? j + 2 : j) * 64];
            const bool full = kt < 2 * qt;
#pragma unroll
            for (int r = 0; r < 4; ++r) { const int s = 16 * kt + 4 * g + r;
                if (full || s <= t) { const unsigned wd = r < 2 ? pc.x : pc.y; const unsigned c = (r & 1) ? (wd >> 16) : (wd & 0xffffu); const int bn = code_bin(c);
                    if (bn > bs) atomicOr(&MASK[row * 128 + (s >> 5)], 1u << (s & 31));
                    else if (bn == bs) { const int pos = (int)atomicAdd((unsigned*)&NCAND[row], 1u); if (pos < CAND_CAP) CAND[row * CAND_CAP + pos] = (u32x2){code_key(c), (unsigned)s}; } } }
        } }
        SYNC();
#pragma unroll 1
        for (int rr = 0; rr < 4; ++rr) {
            const int row = 4 * w + rr; if (BST[row] < 0) continue;
            const int n = NCAND[row] < CAND_CAP ? NCAND[row] : CAND_CAP, need = 256 - NAB[row];
            for (int i = lane; i < n; i += 64) { const u32x2 me = CAND[row * CAND_CAP + i]; int rank = 0;
                for (int j = 0; j < n; ++j) { const u32x2 o = CAND[row * CAND_CAP + j]; rank += (o.x > me.x || (o.x == me.x && o.y < me.y)) ? 1 : 0; }
#ifndef DSA_DBG_NOCAND
                if (rank < need) atomicOr(&MASK[row * 128 + (me.y >> 5)], 1u << (me.y & 31));
#endif
            }
        }
        SYNC();
#ifdef DSA_DBG_SEL
        for (int e = tid; e < 32 * 128; e += 512) { const int row = e >> 7, wi = e & 127, t = t0 + row, lo = t - 255 < 0 ? 0 : t - 255; unsigned m = 0u;
            for (int bq = 0; bq < 32; ++bq) { const int s = 32 * wi + bq; if (s >= lo && s <= t) m |= 1u << bq; }
            MASK[e] = m; }
        SYNC();
#endif
#pragma unroll 1
        for (int rr = 0; rr < 4; ++rr) {
            const int row = 4 * w + rr;
            unsigned w0 = MASK[row * 128 + 2 * lane], w1 = MASK[row * 128 + 2 * lane + 1];
            const int c = __builtin_popcount(w0) + __builtin_popcount(w1);
            int inc = c;
#pragma unroll
            for (int o = 1; o < 64; o <<= 1) { const int v = SHFL_UP(inc, o); if (lane >= o) inc += v; }
            int pos = inc - c;
            while (w0) { const int bt = __builtin_ctz(w0); w0 &= w0 - 1; if (pos < 256) SELL[row * 256 + pos] = (unsigned short)(64 * lane + bt); ++pos; }
            while (w1) { const int bt = __builtin_ctz(w1); w1 &= w1 - 1; if (pos < 256) SELL[row * 256 + pos] = (unsigned short)(64 * lane + 32 + bt); ++pos; }
            if (lane == 63) NSEL[row] = inc < 256 ? inc : 256;
        }
        SYNC();
        bf16* TL = (bf16*)(F.lds + w * DS_SLOT); bf16* OLw = (bf16*)(F.lds + w * DS_SLOT + 8704);
#pragma unroll 1
        for (int rr = 0; rr < 4; ++rr) {
            const int row = 4 * w + rr, t = t0 + row, ns = UNI(NSEL[row]); const size_t mt = mb + t;
            const unsigned short* sl = SELL + row * 256;
            bf16x8 Bh[4];
#pragma unroll
            for (int ks = 0; ks < 4; ++ks) Bh[ks] = i16 < 4 ? *(const bf16x8*)(QABS + mt * 512 + i16 * 128 + 32 * ks + 8 * g) : (bf16x8){0, 0, 0, 0, 0, 0, 0, 0};
            f32x4 O[8];
#pragma unroll
            for (int nt = 0; nt < 8; ++nt) O[nt] = (f32x4){0.f, 0.f, 0.f, 0.f};
            float mrun = -1e30f, lrun = 0.f;
            const float bfar = RB[113 * 4 + (i16 & 3)];
            const int nch = (ns + 31) >> 5;
            u32x4 gvA[8];
#define ATT_LOAD(GV, CK, FULL) do { int sidx[8]; \
                _Pragma("unroll") for (int i = 0; i < 8; ++i) sidx[i] = (int)sl[32 * (CK) + 4 * i + g];            \
                _Pragma("unroll") for (int i = 0; i < 8; ++i) { const int kp = 32 * (CK) + 4 * i + g; sidx[i] = (FULL || kp < ns) ? sidx[i] : 0; } \
                _Pragma("unroll") for (int i = 0; i < 8; ++i) GV[i] = *(const GAS u32x4*)(ckvb + (((unsigned)sidx[i] << 8) + 16u * (unsigned)i16)); } while (0)
#define ATT_STEP(GV, CK, FULL) do { const int ck = (CK); \
                _Pragma("unroll") for (int i = 0; i < 8; ++i) *(u32x4*)(TL + (4 * i + g) * 136 + 8 * i16) = GV[i]; \
                const u32x2 sk0 = *(const u32x2*)(sl + 32 * ck + 4 * g), sk1 = *(const u32x2*)(sl + 32 * ck + 16 + 4 * g); \
                WAVE_LDS_FENCE(); \
                if (ck + 1 < nch) ATT_LOAD(GV, ck + 1, FULL); \
                float bia[2][4]; \
                if (FULL && t - UNI((int)sl[32 * ck + 31]) >= 113) {                   \
                _Pragma("unroll") for (int kt = 0; kt < 2; ++kt) \
                _Pragma("unroll") for (int r = 0; r < 4; ++r) bia[kt][r] = bfar; \
                } else { \
                _Pragma("unroll") for (int kt = 0; kt < 2; ++kt) \
                _Pragma("unroll") for (int r = 0; r < 4; ++r) { const unsigned wd = kt ? (r < 2 ? sk1.x : sk1.y) : (r < 2 ? sk0.x : sk0.y); \
                        int dist = t - (int)((wd >> (16 * (r & 1))) & 0xffffu); dist = dist < 0 ? 0 : (dist > 113 ? 113 : dist); \
                        bia[kt][r] = RB[dist * 4 + (i16 & 3)]; } } \
                f32x4 lg[2]; \
                _Pragma("unroll") for (int kt = 0; kt < 2; ++kt) { lg[kt] = (f32x4){0.f, 0.f, 0.f, 0.f}; \
                _Pragma("unroll") for (int ks = 0; ks < 4; ++ks) lg[kt] = MFMA16(*(const bf16x8*)(TL + (16 * kt + i16) * 136 + 32 * ks + 8 * g), Bh[ks], lg[kt]); } \
                float cm = -1e30f; \
                _Pragma("unroll") for (int kt = 0; kt < 2; ++kt) \
                _Pragma("unroll") for (int r = 0; r < 4; ++r) { const int kp = 32 * ck + 16 * kt + 4 * g + r; \
                        lg[kt][r] = (FULL || kp < ns) ? lg[kt][r] + bia[kt][r] : -1e30f; cm = fmaxf(cm, lg[kt][r]); } \
                if (ck == 0) { cm = fmaxf(cm, SHFL_XOR(cm, 16)); cm = fmaxf(cm, SHFL_XOR(cm, 32)); mrun = cm; } \
                float p[2][4]; \
                _Pragma("unroll") for (int kt = 0; kt < 2; ++kt) \
                _Pragma("unroll") for (int r = 0; r < 4; ++r) { p[kt][r] = (FULL || lg[kt][r] > -1e29f) ? FEXP2(lg[kt][r] - mrun) : 0.f; lrun += p[kt][r]; } \
                u32x4 aw = (u32x4){0u, 0u, 0u, 0u}; \
                if (i16 < 4) aw = (u32x4){pk2(p[0][0], p[0][1]), pk2(p[0][2], p[0][3]), pk2(p[1][0], p[1][1]), pk2(p[1][2], p[1][3])}; \
                const bf16x8 A = __builtin_bit_cast(bf16x8, aw); \
                _Pragma("unroll") for (int nt = 0; nt < 8; ++nt) { \
                    const s16x4 lo = TR16(TL + (4 * g + (i16 >> 2)) * 136 + 16 * nt + 4 * (i16 & 3)); \
                    const s16x4 hi = TR16(TL + (16 + 4 * g + (i16 >> 2)) * 136 + 16 * nt + 4 * (i16 & 3)); \
                    const bf16x8 B = (bf16x8){lo[0], lo[1], lo[2], lo[3], hi[0], hi[1], hi[2], hi[3]}; \
                    O[nt] = MFMA16(A, B, O[nt]); } \
                WAVE_LDS_FENCE(); } while (0)
            if (ns == 256) { ATT_LOAD(gvA, 0, true); for (int ck2 = 0; ck2 < 8; ++ck2) ATT_STEP(gvA, ck2, true); }
            else { ATT_LOAD(gvA, 0, false); for (int ck2 = 0; ck2 < nch; ++ck2) ATT_STEP(gvA, ck2, false); }
#undef ATT_STEP
#undef ATT_LOAD
            lrun += SHFL_XOR(lrun, 16); lrun += SHFL_XOR(lrun, 32);
            float li[4];
#pragma unroll
            for (int r = 0; r < 4; ++r) li[r] = FRCP(SHFL(lrun, r));
            if (g == 0) {
#pragma unroll
                for (int nt = 0; nt < 8; ++nt)
#pragma unroll
                    for (int r = 0; r < 4; ++r) OLw[(rr * 4 + r) * 128 + 16 * nt + i16] = (bf16)f2bf(O[nt][r] * li[r]);
            }
        }
        SYNC();
        {
            const int h = w >> 1, mtile = w & 1, q = 16 * mtile + i16;
            const bf16* olq = (const bf16*)(F.lds + (q >> 2) * DS_SLOT + 8704) + ((q & 3) * 4 + h) * 128;
            float gaw[4];
#pragma unroll
            for (int nt = 0; nt < 4; ++nt) gaw[nt] = PIN(F, I_GNW)[l * DM + 768 + h * 64 + 16 * nt + i16];
            f32x4 acc[4];
#pragma unroll
            for (int nt = 0; nt < 4; ++nt) acc[nt] = (f32x4){0.f, 0.f, 0.f, 0.f};
#pragma unroll
            for (int ks = 0; ks < 4; ++ks) { const bf16x8 A = *(const bf16x8*)(olq + 32 * ks + 8 * g);
#pragma unroll
                for (int nt = 0; nt < 4; ++nt) acc[nt] = MFMA16(A, *(const bf16x8*)(WUVT + ((size_t)(h * 64 + 16 * nt + i16)) * 128 + 32 * ks + 8 * g), acc[nt]); }
#pragma unroll
            for (int r = 0; r < 4; ++r) { float s = (acc[0][r] * acc[0][r] + acc[1][r] * acc[1][r]) + (acc[2][r] * acc[2][r] + acc[3][r] * acc[3][r]);
                s += SHFL_XOR(s, 1); s += SHFL_XOR(s, 2); s += SHFL_XOR(s, 4); s += SHFL_XOR(s, 8);
                if (i16 == 0) SS[(16 * mtile + 4 * g + r) * 4 + h] = s; }
            SYNC();
#pragma unroll
            for (int r = 0; r < 4; ++r) { const int qq = 16 * mtile + 4 * g + r; const f32x4 s4 = *(const f32x4*)(SS + qq * 4);
                const float rs = RSQ(((s4.x + s4.y) + (s4.z + s4.w)) * (1.0f / 256.0f) + NORM_EPS);
                bf16* dst = CAT + (mb + t0 + qq) * DM + 768 + h * 64 + i16;
#pragma unroll
                for (int nt = 0; nt < 4; ++nt) dst[16 * nt] = (bf16)f2bf(acc[nt][r] * rs * gaw[nt]); }
        }
        SYNC();
    }
}
#ifndef HOST_EMU
namespace pg8 {
#define PG8_LAS __attribute__((address_space(3)))
typedef unsigned short bf16_t;
typedef short bf16x8 __attribute__((ext_vector_type(8)));
typedef float f32x4 __attribute__((ext_vector_type(4)));
typedef unsigned u32x4 __attribute__((ext_vector_type(4)));
constexpr int BM = 256, BK = 64, HALF = 128, HTB = HALF * BK * 2  , STAGE_BYTES = 8 * HTB, NXCD = 8, WGM = 8;

__host__ __device__ __forceinline__ int lds_byte(int r, int c) { const int st = (r >> 4) * 2 + (c >> 5), rr = r & 15, cc = c & 31, ob = rr * 64 + cc * 2; return st * 1024 + (ob ^ (((ob >> 9) & 1) << 5)); }
__host__ __device__ __forceinline__ void stage_rc(int b, int& R, int& C) { const int st = b / 1024, sb = b % 1024, swz = sb ^ (((sb >> 9) & 1) << 5); R = (st >> 1) * 16 + swz / 64; C = (st & 1) * 32 + (swz % 64) / 2; }
__host__ __device__ __forceinline__ int perm32(int rho) { const int n = rho >> 4, i = rho & 15; return 8 * (i >> 2) + 4 * n + (i & 3); }

struct Unit { int pm, pn; };
struct Gemm { const bf16_t* A; const bf16_t* Bt; int M, N, K; };

struct StaticOrder {
    int nM, nN, nwg, G, c;
    __host__ __device__ void init(int M, int N, int G_, int c_) { nM = M / BM; nN = N / BM; nwg = nM * nN; G = G_; c = c_; }
    __host__ __device__ bool next(int i, Unit& u) const {
        const long L = (long)i * G + c; if (L >= nwg) return false;
        int wgid = (int)L; { const int q = nwg / NXCD, r = nwg % NXCD, xcd = wgid % NXCD, off = wgid / NXCD; wgid = (xcd < r ? xcd * (q + 1) : r * (q + 1) + (xcd - r) * q) + off; }
        const int nig = WGM * nN, gid = wgid / nig, fm = gid * WGM, gsz = (nM - fm) < WGM ? (nM - fm) : WGM;
        u.pm = fm + ((wgid % nig) % gsz); u.pn = (wgid % nig) / gsz; return true;
    }
    __device__ __forceinline__ void a_ready(const Unit&) const {}
    __device__ __forceinline__ void done(const Unit&) const {}
};
__device__ __forceinline__ unsigned cvt_pk_bf16(float lo, float hi) { unsigned r; asm volatile("v_cvt_pk_bf16_f32 %0, %1, %2" : "=v"(r) : "v"(lo), "v"(hi)); return r; }
template <class Epi, class Sched, bool ALIGN_EPI = false, bool SP2 = false>
__device__ __forceinline__ void gemm_phase(PG8_LAS unsigned char* lds, const Gemm g, const Sched& S, const Epi& E, const int tid_in) {
    const int tid = tid_in, wid = __builtin_amdgcn_readfirstlane(tid >> 6), lane = tid & 63, wr = wid >> 2, wc = wid & 3, fr = lane & 15, fq = lane >> 4;
    const int K = g.K, nt = K / BK;
    unsigned voffA[2], voffB[2];
#pragma unroll
    for (int i = 0; i < 2; ++i) { int R, C; stage_rc(tid * 16 + i * 8192, R, C); const int Rb = Epi::PERM ? ((R & ~31) + perm32(R & 31)) : R;
        voffA[i] = (unsigned)(R * K + C) * 2u; voffB[i] = (unsigned)(Rb * K + C) * 2u; }
    const size_t kstep = (size_t)(BK * 2);
    const size_t hstep = (size_t)HALF * K * 2;
    const size_t tstep = 2 * hstep;
    const unsigned ldsw = (unsigned)wid * 1024u;
    const int aoff = lds_byte(wr * 64 + fr, fq * 8), boff = lds_byte(wc * 32 + fr, fq * 8);
#define PG8_SA(b, h) (((b) * 2 + (h)) * HTB)
#define PG8_SB(b, h) ((4 + (b) * 2 + (h)) * HTB)
#define PG8_STAGE(bufoff, gbase, voff) do { _Pragma("unroll") for (int _i = 0; _i < 2; ++_i) \
        __builtin_amdgcn_global_load_lds((const unsigned*)((const char*)(gbase) + (voff)[_i]), (PG8_LAS unsigned*)(lds + (bufoff) + ldsw + _i * 8192), 16, 0, 0); } while (0)
#define PG8_LDA(dst, b, h) do { _Pragma("unroll") for (int m = 0; m < 4; ++m) _Pragma("unroll") for (int k = 0; k < 2; ++k) dst[m][k] = *(const PG8_LAS bf16x8*)(lds + PG8_SA(b, h) + aoff + m * 2048 + k * 1024); } while (0)
#define PG8_LDB(dst, b, h) do { _Pragma("unroll") for (int n = 0; n < 2; ++n) _Pragma("unroll") for (int k = 0; k < 2; ++k) dst[n][k] = *(const PG8_LAS bf16x8*)(lds + PG8_SB(b, h) + boff + n * 2048 + k * 1024); } while (0)
#define PG8_MMA(ai, bj, At, Bt) do { __builtin_amdgcn_s_setprio(1); _Pragma("unroll") for (int m = 0; m < 4; ++m) _Pragma("unroll") for (int n = 0; n < 2; ++n) _Pragma("unroll") for (int k = 0; k < 2; ++k) \
        acc[ai][bj][m][n] = __builtin_amdgcn_mfma_f32_16x16x32_bf16(Bt[n][k], At[m][k], acc[ai][bj][m][n], 0, 0, 0); __builtin_amdgcn_s_setprio(0); } while (0)
#define PG8_WAIT_V(n) asm volatile("s_waitcnt vmcnt(" #n ")" ::: "memory")
#define PG8_WAIT_L(n) asm volatile("s_waitcnt lgkmcnt(" #n ")" ::: "memory")
#define PG8_BAR __builtin_amdgcn_s_barrier()
#define PG8_SCHED __builtin_amdgcn_sched_barrier(0)
    Unit cur, nxt; int ui = 0;
    if (!S.next(0, cur)) return;
    f32x4 acc[2][2][4][2];
#pragma unroll
    for (int a = 0; a < 2; ++a)
#pragma unroll
        for (int b = 0; b < 2; ++b)
#pragma unroll
            for (int m = 0; m < 4; ++m)
#pragma unroll
                for (int n = 0; n < 2; ++n) acc[a][b][m][n] = (f32x4){0.f, 0.f, 0.f, 0.f};
    bf16x8 At[4][2], B0[2][2], B1[2][2];
    const char* cA = (const char*)g.A + (size_t)cur.pm * tstep; const char* cB = (const char*)g.Bt + (size_t)cur.pn * tstep;
    S.a_ready(cur);
    if constexpr (SP2) {
        PG8_STAGE(PG8_SB(0, 0), cB, voffB); PG8_STAGE(PG8_SB(0, 1), cB + hstep, voffB); PG8_STAGE(PG8_SA(0, 0), cA, voffA); PG8_STAGE(PG8_SA(0, 1), cA + hstep, voffA);
        if (wr == 1) PG8_BAR;
        PG8_WAIT_V(2); PG8_BAR;
        PG8_STAGE(PG8_SB(1, 0), cB + kstep, voffB); PG8_STAGE(PG8_SA(1, 0), cA + kstep, voffA); PG8_STAGE(PG8_SB(1, 1), cB + hstep + kstep, voffB);
        PG8_WAIT_V(6); PG8_BAR;
    } else {
        PG8_STAGE(PG8_SB(0, 0), cB, voffB); PG8_STAGE(PG8_SA(0, 0), cA, voffA); PG8_STAGE(PG8_SB(0, 1), cB + hstep, voffB); PG8_STAGE(PG8_SA(0, 1), cA + hstep, voffA);
        if (wr == 1) PG8_BAR;
        PG8_WAIT_V(4); PG8_BAR;
        PG8_STAGE(PG8_SB(1, 0), cB + kstep, voffB); PG8_STAGE(PG8_SA(1, 0), cA + kstep, voffA); PG8_STAGE(PG8_SB(1, 1), cB + hstep + kstep, voffB);
        PG8_WAIT_V(6); PG8_BAR;
    }
    for (;;) {
        const bool has_next = S.next(ui + 1, nxt);
        const char* nA = has_next ? (const char*)g.A + (size_t)nxt.pm * tstep : cA; const char* nB = has_next ? (const char*)g.Bt + (size_t)nxt.pn * tstep : cB;
#pragma unroll 1
        for (int t = 0; t < nt; t += 2) {
            const bool last = (t == nt - 2);
            const char* a1 = cA + (size_t)(t + 1) * kstep;
            const char* a2 = last ? nA : cA + (size_t)(t + 2) * kstep; const char* b2 = last ? nB : cB + (size_t)(t + 2) * kstep;
            const char* a3 = a2 + kstep; const char* b3 = b2 + kstep;
            if (last && has_next) S.a_ready(nxt);
            if constexpr (Epi::NORM) { if (t == 2) E.prefetch(cur, tid, wid); if (t == 4) E.reduce_rs(tid); }
            if constexpr (SP2) {
            PG8_LDB(B0, 0, 0); PG8_LDB(B1, 0, 1); PG8_SCHED; PG8_LDA(At, 0, 0); PG8_STAGE(PG8_SA(1, 1), a1 + hstep, voffA);
            PG8_WAIT_V(8); PG8_WAIT_L(0); PG8_BAR; PG8_MMA(0, 0, At, B0); PG8_MMA(0, 1, At, B1); PG8_BAR; PG8_SCHED;
            PG8_LDA(At, 0, 1); PG8_STAGE(PG8_SB(0, 0), b2, voffB); PG8_STAGE(PG8_SB(0, 1), b2 + hstep, voffB); PG8_STAGE(PG8_SA(0, 0), a2, voffA);
            PG8_WAIT_V(8); PG8_WAIT_L(0); PG8_BAR; PG8_MMA(1, 0, At, B0); PG8_MMA(1, 1, At, B1); PG8_BAR; PG8_SCHED;
            PG8_LDB(B0, 1, 0); PG8_LDB(B1, 1, 1); PG8_SCHED; PG8_LDA(At, 1, 0); PG8_STAGE(PG8_SA(0, 1), a2 + hstep, voffA);
            PG8_WAIT_V(8); PG8_WAIT_L(0); PG8_BAR; PG8_MMA(0, 0, At, B0); PG8_MMA(0, 1, At, B1); PG8_BAR; PG8_SCHED;
            PG8_LDA(At, 1, 1); PG8_STAGE(PG8_SB(1, 0), b3, voffB); PG8_STAGE(PG8_SB(1, 1), b3 + hstep, voffB); PG8_STAGE(PG8_SA(1, 0), a3, voffA);
            PG8_WAIT_V(8); PG8_WAIT_L(0); PG8_BAR; PG8_MMA(1, 0, At, B0); PG8_MMA(1, 1, At, B1); PG8_BAR; PG8_SCHED;
            } else {
            PG8_LDB(B0, 0, 0); PG8_SCHED; PG8_LDA(At, 0, 0); PG8_STAGE(PG8_SA(1, 1), a1 + hstep, voffA);
            PG8_WAIT_L(8); PG8_BAR; PG8_WAIT_L(0); PG8_MMA(0, 0, At, B0); PG8_BAR; PG8_SCHED;
            PG8_LDB(B1, 0, 1); PG8_STAGE(PG8_SB(0, 0), b2, voffB);
            PG8_BAR; PG8_WAIT_L(0); PG8_MMA(0, 1, At, B1); PG8_BAR;
            PG8_LDA(At, 0, 1); PG8_STAGE(PG8_SA(0, 0), a2, voffA);
            PG8_BAR; PG8_WAIT_L(0); PG8_MMA(1, 0, At, B0); PG8_BAR; PG8_SCHED;
            PG8_STAGE(PG8_SB(0, 1), b2 + hstep, voffB);
            PG8_WAIT_V(6); PG8_BAR; PG8_MMA(1, 1, At, B1); PG8_BAR;
            PG8_LDB(B0, 1, 0); PG8_SCHED; PG8_LDA(At, 1, 0); PG8_STAGE(PG8_SA(0, 1), a2 + hstep, voffA);
            PG8_WAIT_L(8); PG8_BAR; PG8_WAIT_L(0); PG8_MMA(0, 0, At, B0); PG8_BAR; PG8_SCHED;
            PG8_LDB(B1, 1, 1); PG8_STAGE(PG8_SB(1, 0), b3, voffB);
            PG8_BAR; PG8_WAIT_L(0); PG8_MMA(0, 1, At, B1); PG8_BAR;
            PG8_LDA(At, 1, 1); PG8_STAGE(PG8_SA(1, 0), a3, voffA);
            PG8_BAR; PG8_WAIT_L(0); PG8_MMA(1, 0, At, B0); PG8_BAR; PG8_SCHED;
            PG8_STAGE(PG8_SB(1, 1), b3 + hstep, voffB);
            PG8_WAIT_V(6); PG8_BAR; PG8_MMA(1, 1, At, B1); PG8_BAR;
            }
        }
        if constexpr (ALIGN_EPI) { if (wr == 0) PG8_BAR; }
        if constexpr (!Epi::AFTER_DRAIN) { E(acc, cur, wr, wc, fr, fq); S.done(cur); }
        if (!has_next) break;
#pragma unroll
        for (int a = 0; a < 2; ++a)
#pragma unroll
            for (int b = 0; b < 2; ++b)
#pragma unroll
                for (int m = 0; m < 4; ++m)
#pragma unroll
                    for (int n = 0; n < 2; ++n) acc[a][b][m][n] = (f32x4){0.f, 0.f, 0.f, 0.f};
        cur = nxt; cA = nA; cB = nB; ++ui;
        if constexpr (ALIGN_EPI) { if (wr == 1) PG8_BAR; }
    }
    PG8_WAIT_V(0);
    if constexpr (!ALIGN_EPI) { if (wr == 0) PG8_BAR; }
    PG8_BAR;
    if constexpr (Epi::AFTER_DRAIN) { E.fused(acc, cur, wr, wc, fr, fq, lds, wid, lane); S.done(cur); }
#undef PG8_SA
#undef PG8_SB
#undef PG8_STAGE
#undef PG8_LDA
#undef PG8_LDB
#undef PG8_MMA
#undef PG8_WAIT_V
#undef PG8_WAIT_L
#undef PG8_BAR
#undef PG8_SCHED
}
}
namespace pg8 {
template <int ACT  > struct EpiRoute {
    static constexpr bool PERM = true, AFTER_DRAIN = false, NORM = false;
    bf16_t* O0; int ld0; bf16_t* O1; int ld1; int split;
    __device__ __forceinline__ void operator()(const f32x4 (&acc)[2][2][4][2], const Unit& u, int wr, int wc, int fr, int fq) const {
        const int row0 = u.pm * BM + wr * 64 + fr; const bool first = u.pn < split;
        bf16_t* base = first ? O0 : O1; const int ld = first ? ld0 : ld1; const int col0 = (first ? u.pn : u.pn - split) * BM + wc * 32 + 8 * fq;
#pragma unroll
        for (int ai = 0; ai < 2; ++ai)
#pragma unroll
            for (int m = 0; m < 4; ++m) { bf16_t* rowp = base + (size_t)(row0 + ai * HALF + m * 16) * ld + col0;
#pragma unroll
                for (int bj = 0; bj < 2; ++bj) { f32x4 v0 = acc[ai][bj][m][0], v1 = acc[ai][bj][m][1];
                    if (ACT == 1) {
#pragma unroll
                        for (int e = 0; e < 4; ++e) { const float a = fmaxf(v0[e], 0.f), b = fmaxf(v1[e], 0.f); v0[e] = a * a; v1[e] = b * b; } }
                    u32x4 w; w.x = cvt_pk_bf16(v0[0], v0[1]); w.y = cvt_pk_bf16(v0[2], v0[3]); w.z = cvt_pk_bf16(v1[0], v1[1]); w.w = cvt_pk_bf16(v1[2], v1[3]);
                    *(u32x4*)(rowp + bj * HALF) = w; } }
    }
};
struct EpiResid {
    static constexpr bool PERM = true, AFTER_DRAIN = false, NORM = false;
    const float* xsrc; float* xdst; const float* gate;
    __device__ __forceinline__ void operator()(const f32x4 (&acc)[2][2][4][2], const Unit& u, int wr, int wc, int fr, int fq) const {
        const int row0 = u.pm * BM + wr * 64 + fr, col0 = u.pn * BM + wc * 32 + 8 * fq, b = (u.pm * BM) >> 12;
        f32x4 gv[2][2];
#pragma unroll
        for (int bj = 0; bj < 2; ++bj)
#pragma unroll
            for (int n = 0; n < 2; ++n) gv[bj][n] = *(const f32x4*)(gate + (size_t)b * 6144 + col0 + bj * HALF + 4 * n);
#pragma unroll
        for (int ai = 0; ai < 2; ++ai)
#pragma unroll
            for (int m = 0; m < 4; ++m) { const size_t off = (size_t)(row0 + ai * HALF + m * 16) * 1024 + col0;
#pragma unroll
                for (int bj = 0; bj < 2; ++bj)
#pragma unroll
                    for (int n = 0; n < 2; ++n) { const f32x4 xs = *(const f32x4*)(xsrc + off + bj * HALF + 4 * n);
                        *(f32x4*)(xdst + off + bj * HALF + 4 * n) = xs + gv[bj][n] * acc[ai][bj][m][n]; }
                if (m & 1) asm volatile("" ::: "memory"); }
    }
};
constexpr int EPI_OFF = 133120;
template <int ACT  > struct EpiRouteN {
    static constexpr bool PERM = true, AFTER_DRAIN = false, NORM = true;
    bf16_t* O; int ld; const float* RSP; const float* shw; PG8_LAS unsigned char* lds;
    __device__ __forceinline__ void prefetch(const Unit& u, int tid, int wid) const {
        const char* src = (const char*)RSP + (size_t)u.pm * (BM * 64) + (size_t)tid * 16;
#pragma unroll
        for (int i = 0; i < 2; ++i) __builtin_amdgcn_global_load_lds((const unsigned*)(src + i * 8192), (PG8_LAS unsigned*)(lds + EPI_OFF + wid * 1024 + i * 8192), 16, 0, 0);
        if (wid == 0) { const char* s2 = (const char*)(shw + (size_t)((u.pm * BM) >> 12) * NSHW + u.pn * BM) + (size_t)(tid & 63) * 16;
            __builtin_amdgcn_global_load_lds((const unsigned*)s2, (PG8_LAS unsigned*)(lds + EPI_OFF + 16384), 16, 0, 0); }
    }
    __device__ __forceinline__ void reduce_rs(int tid) const {
        if (tid < 256) { const PG8_LAS f32x4* p = (const PG8_LAS f32x4*)(lds + EPI_OFF + tid * 64); const f32x4 a = p[0], b = p[1], c = p[2], d = p[3];
            const float s = (((a.x + a.y) + (a.z + a.w)) + ((b.x + b.y) + (b.z + b.w))) + (((c.x + c.y) + (c.z + c.w)) + ((d.x + d.y) + (d.z + d.w)));
            *(PG8_LAS float*)(lds + EPI_OFF + 17408 + tid * 4) = __builtin_amdgcn_rsqf(s * (1.0f / 1024.0f) + 1e-6f); }
    }
    __device__ __forceinline__ void operator()(const f32x4 (&acc)[2][2][4][2], const Unit& u, int wr, int wc, int fr, int fq) const {
        const int row0 = u.pm * BM + wr * 64 + fr, col0 = u.pn * BM + wc * 32 + 8 * fq;
        const PG8_LAS unsigned char* ep = lds + EPI_OFF;
        float rs[2][4];
#pragma unroll
        for (int ai = 0; ai < 2; ++ai)
#pragma unroll
            for (int m = 0; m < 4; ++m) rs[ai][m] = *(const PG8_LAS float*)(ep + 17408 + (wr * 64 + fr + ai * HALF + m * 16) * 4);
        f32x4 sv[2][2];
#pragma unroll
        for (int bj = 0; bj < 2; ++bj)
#pragma unroll
            for (int n = 0; n < 2; ++n) sv[bj][n] = *(const PG8_LAS f32x4*)(ep + 16384 + (bj * HALF + wc * 32 + 8 * fq + 4 * n) * 4);
#pragma unroll
        for (int ai = 0; ai < 2; ++ai)
#pragma unroll
            for (int m = 0; m < 4; ++m) { bf16_t* rowp = O + (size_t)(row0 + ai * HALF + m * 16) * ld + col0;
#pragma unroll
                for (int bj = 0; bj < 2; ++bj) { f32x4 v0 = acc[ai][bj][m][0] * rs[ai][m] + sv[bj][0], v1 = acc[ai][bj][m][1] * rs[ai][m] + sv[bj][1];
                    if (ACT == 1) {
#pragma unroll
                        for (int e = 0; e < 4; ++e) { const float a = fmaxf(v0[e], 0.f), b = fmaxf(v1[e], 0.f); v0[e] = a * a; v1[e] = b * b; } }
                    u32x4 w; w.x = cvt_pk_bf16(v0[0], v0[1]); w.y = cvt_pk_bf16(v0[2], v0[3]); w.z = cvt_pk_bf16(v1[0], v1[1]); w.w = cvt_pk_bf16(v1[2], v1[3]);
                    *(u32x4*)(rowp + bj * HALF) = w; } }
    }
};
template <bool SRCF, bool DSTF> struct EpiResidXS {
    static constexpr bool PERM = true, AFTER_DRAIN = false, NORM = false;
    const void* xsrc; void* xdst; const float* gate; const float* wp; bf16_t* XS; float* RSP; int doxs, srcf32, dstf32;
    __device__ __forceinline__ void operator()(const f32x4 (&acc)[2][2][4][2], const Unit& u, int wr, int wc, int fr, int fq) const {
        const int row0 = u.pm * BM + wr * 64 + fr, col0 = u.pn * BM + wc * 32 + 8 * fq, b = (u.pm * BM) >> 12;
        f32x4 gv[2][2], wv[2][2]; float ssv[2][4];
#pragma unroll
        for (int bj = 0; bj < 2; ++bj)
#pragma unroll
            for (int n = 0; n < 2; ++n) { gv[bj][n] = *(const f32x4*)(gate + (size_t)b * 6144 + col0 + bj * HALF + 4 * n);
                wv[bj][n] = doxs ? *(const f32x4*)(wp + (size_t)b * 1024 + col0 + bj * HALF + 4 * n) : (f32x4){0.f, 0.f, 0.f, 0.f}; }
#pragma unroll
        for (int ai = 0; ai < 2; ++ai)
#pragma unroll
            for (int m = 0; m < 4; ++m) { const int row = row0 + ai * HALF + m * 16; const size_t off = (size_t)row * 1024 + col0; float ss = 0.f;
#pragma unroll
                for (int bj = 0; bj < 2; ++bj) { f32x4 x0, x1;
                    if (SRCF && srcf32) { x0 = *(const f32x4*)((const float*)xsrc + off + bj * HALF); x1 = *(const f32x4*)((const float*)xsrc + off + bj * HALF + 4); }
                    else { const u32x4 r = *(const u32x4*)((const bf16_t*)xsrc + off + bj * HALF);
                        x0 = (f32x4){bflo(r.x), bfhi(r.x), bflo(r.y), bfhi(r.y)}; x1 = (f32x4){bflo(r.z), bfhi(r.z), bflo(r.w), bfhi(r.w)}; }
                    const f32x4 y0 = x0 + gv[bj][0] * acc[ai][bj][m][0], y1 = x1 + gv[bj][1] * acc[ai][bj][m][1];
                    ss += ((y0.x * y0.x + y0.y * y0.y) + (y0.z * y0.z + y0.w * y0.w)) + ((y1.x * y1.x + y1.y * y1.y) + (y1.z * y1.z + y1.w * y1.w));
                    if (DSTF && dstf32) { *(f32x4*)((float*)xdst + off + bj * HALF) = y0; *(f32x4*)((float*)xdst + off + bj * HALF + 4) = y1; }
                    else { u32x4 w; w.x = cvt_pk_bf16(y0[0], y0[1]); w.y = cvt_pk_bf16(y0[2], y0[3]); w.z = cvt_pk_bf16(y1[0], y1[1]); w.w = cvt_pk_bf16(y1[2], y1[3]);
                        *(u32x4*)((bf16_t*)xdst + off + bj * HALF) = w; }
                    if (doxs) { const f32x4 a = y0 * wv[bj][0], c = y1 * wv[bj][1];
                        u32x4 w; w.x = cvt_pk_bf16(a[0], a[1]); w.y = cvt_pk_bf16(a[2], a[3]); w.z = cvt_pk_bf16(c[0], c[1]); w.w = cvt_pk_bf16(c[2], c[3]);
                        *(u32x4*)(XS + off + bj * HALF) = w; } }
                ssv[ai][m] = ss;
                if (m & 1) asm volatile("" ::: "memory"); }
        if (doxs) { float t1[2][4];
#pragma unroll
            for (int ai = 0; ai < 2; ++ai)
#pragma unroll
                for (int m = 0; m < 4; ++m) t1[ai][m] = __shfl_xor(ssv[ai][m], 16);
#pragma unroll
            for (int ai = 0; ai < 2; ++ai)
#pragma unroll
                for (int m = 0; m < 4; ++m) { ssv[ai][m] += t1[ai][m]; t1[ai][m] = __shfl_xor(ssv[ai][m], 32); }
            if (fq == 0) {
#pragma unroll
                for (int ai = 0; ai < 2; ++ai)
#pragma unroll
                    for (int m = 0; m < 4; ++m) RSP[(size_t)(row0 + ai * HALF + m * 16) * 16 + u.pn * 4 + wc] = ssv[ai][m] + t1[ai][m]; } }
    }
};
}

#define RLX_AGENT __ATOMIC_RELAXED, __HIP_MEMORY_SCOPE_AGENT
#define XB_TMO      128
#define XB_XCNT(j)  (256  + 64 * (j))
#define XB_XSUB(j)  (1280 + 64 * (j))
#define XB_XGEN(j)  (2304 + 64 * (j))
#define XB_TOP      3328
#define XB_TOPGEN   3392
#define XCD_BAR_WORDS 3456
#define XB_SPIN_CAP (1u << 24)

__device__ __forceinline__ unsigned xb_ld(unsigned* p)              { return __hip_atomic_load(p, __ATOMIC_RELAXED, __HIP_MEMORY_SCOPE_AGENT); }
__device__ __forceinline__ unsigned xb_add(unsigned* p, unsigned v) { return __hip_atomic_fetch_add(p, v, __ATOMIC_RELAXED, __HIP_MEMORY_SCOPE_AGENT); }
__device__ __forceinline__ unsigned xb_xcc_id() { return (unsigned)__builtin_amdgcn_s_getreg((3 << 11) | 20) & 0xFu; }
#define XB_SPIN(cond, bar) do { unsigned _sp = 0; while (cond) { __builtin_amdgcn_s_sleep(1); \
    if ((++_sp & 255u) == 0u) { if (xb_ld(&(bar)[XB_TMO])) break; if (_sp > XB_SPIN_CAP) { atomicAdd(&(bar)[XB_TMO], 1u); break; } } } } while (0)

struct XcdBarrier {
    unsigned* bar; unsigned x;
    volatile LAS unsigned* st;
};

__device__ __forceinline__ XcdBarrier xcd_barrier_post(unsigned* bar, volatile LAS unsigned* st) {
    XcdBarrier b; b.bar = bar; b.x = xb_xcc_id(); b.st = st;
    if (threadIdx.x == 0) (void)xb_add(&bar[XB_XCNT(b.x)], 1u);
    return b;
}
__device__ __forceinline__ void xcd_barrier_complete(unsigned* bar, unsigned x, unsigned& nloc, unsigned& nx) {
    const unsigned G = gridDim.x * gridDim.y * gridDim.z;
    unsigned sum, cnt, mine, sp = 0u;
    for (;;) {
        sum = 0u; cnt = 0u; mine = 0u;
#pragma unroll
        for (unsigned j = 0; j < 16; ++j) { const unsigned c = xb_ld(&bar[XB_XCNT(j)]); sum += c; cnt += (c > 0u) ? 1u : 0u; mine = (j == x) ? c : mine; }
        if (sum == G) break;
        __builtin_amdgcn_s_sleep(1);
        if ((++sp & 255u) == 0u) { if (xb_ld(&bar[XB_TMO])) break; if (sp > XB_SPIN_CAP) { atomicAdd(&bar[XB_TMO], 1u); break; } }
    }
    nloc = mine > 0u ? mine : 1u; nx = cnt > 0u ? cnt : 1u;
}

__device__ __forceinline__ void xcd_barrier(const XcdBarrier& b) {
    asm volatile("s_waitcnt vmcnt(0)" ::: "memory");
    __syncthreads();
    if (threadIdx.x == 0) {
        unsigned* bar = b.bar;
        __builtin_amdgcn_s_waitcnt(0);
        unsigned nloc = b.st[0], nx = b.st[1];
        if (nloc == 0u) { xcd_barrier_complete(bar, b.x, nloc, nx); b.st[0] = nloc; b.st[1] = nx; }
        const unsigned old = xb_add(&bar[XB_XSUB(b.x)], 1u);
        const unsigned gen = old / nloc;
        if (old + 1u == (gen + 1u) * nloc) {
            __builtin_amdgcn_fence(__ATOMIC_RELEASE, "agent");
            asm volatile("s_waitcnt vmcnt(0)" ::: "memory");
            const unsigned og = xb_add(&bar[XB_TOP], 1u);
            const unsigned tg = og / nx;
            if (og + 1u == (tg + 1u) * nx) xb_add(&bar[XB_TOPGEN], 1u);
            else XB_SPIN(xb_ld(&bar[XB_TOPGEN]) == tg, bar);
            __builtin_amdgcn_fence(__ATOMIC_ACQUIRE, "agent");
            xb_add(&bar[XB_XGEN(b.x)], 1u);
            asm volatile("s_waitcnt vmcnt(0)" ::: "memory");
        } else {
            XB_SPIN(xb_ld(&bar[XB_XGEN(b.x)]) == gen, bar);
            __builtin_amdgcn_fence(__ATOMIC_ACQUIRE, "agent");
            asm volatile("s_waitcnt vmcnt(0)" ::: "memory");
        }
    }
    __syncthreads();
}

#ifndef PH_MASK
#define PH_MASK 0xFFFFF
#endif
#define EN(b) if constexpr ((PH_MASK >> (b)) & 1)
#ifndef DUP_MASK
#define DUP_MASK 0
#endif
#define DUP(b) if constexpr ((DUP_MASK >> (b)) & 1)
#define DBG_DIGEST_N 256
#define DBG_DIGEST_VAL(m, c) bf2f(((const bf16*)(wsp + WS_CAT))[(size_t)(m) * DM + 768 + (c)])
#ifndef DBG_PH_HI
#define DBG_PH_HI NPHASE
#endif
#ifndef MK_MULTI
#define MK_MULTI 0
#endif
constexpr int LDS_BYTES = 151552, MISC_OFF = 131072 + 320;
#ifndef DBG_LAYERS
#define DBG_LAYERS 4
#define DBG_L0 0
#endif
constexpr int NPHASE = 3 + 7 * DBG_LAYERS;
__global__ void __launch_bounds__(512, 2) hymba_fwd(Args a) {
    extern __shared__ __attribute__((aligned(16))) unsigned char lds[];
    Ctx F0;
    Ctx& F = F0;
    F.lds = (char*)lds; F.tid = threadIdx.x; F.lane = F.tid & 63; F.wave = __builtin_amdgcn_readfirstlane(F.tid >> 6); F.G = gridDim.x; F.bid = blockIdx.x;
    F.A = nullptr; F.ws = a.ws;
    if (F.tid < 29) ((unsigned long long*)(lds + PTR_OFF))[F.tid] = F.tid < 28 ? (unsigned long long)a.in[F.tid] : (unsigned long long)a.out;
    volatile LAS unsigned* MISC = (volatile LAS unsigned*)((LAS unsigned char*)lds + MISC_OFF);
    if (F.tid < 32) MISC[F.tid] = 0u;
    __syncthreads();
    unsigned* ctl = (unsigned*)(a.ws + WS_CTL);
    XcdBarrier bar; bar.bar = ctl + CW_BAR; bar.x = 0; bar.st = nullptr;
    if (!MK_MULTI) bar = xcd_barrier_post(ctl + CW_BAR, MISC + 8);
    const int lo = a.ph_lo, hi = a.ph_hi;
    int ph = 0;
#define PH_BEGIN if (lo <= ph && ph < hi) { Ctx F = F0; unsigned long long wsl_ = (unsigned long long)F0.ws; asm volatile("" : "+v"(F.tid), "+s"(F.bid), "+s"(F.G), "+s"(wsl_)); F.ws = (unsigned char*)(__attribute__((address_space(1))) unsigned char*)wsl_; F.lane = F.tid & 63; F.wave = __builtin_amdgcn_readfirstlane(F.tid >> 6); unsigned char* const wsp = F.ws; (void)wsp;
#define PH_END   if (!MK_MULTI && ph + 1 < hi) { XcdBarrier bb = bar; asm volatile("" : "+s"(bb.bar), "+s"(bb.x)); xcd_barrier(bb); } else __syncthreads(); } ++ph;
    PG8_LAS unsigned char* glds = (PG8_LAS unsigned char*)lds;
#define XN ((bf16*)(wsp + WS_XN))
#define PROJ ((bf16*)(wsp + WS_PROJ))
#define CAT ((bf16*)(wsp + WS_CAT))
#define HB ((bf16*)(wsp + WS_HB))
    PH_BEGIN EN(0) ph_prologue(F); DUP(0) { __syncthreads(); ph_prologue(F); } PH_END
    PH_BEGIN EN(1) { ph_shw(F); ph_xs0(F, PIN(F, I_X), PIN(F, I_N1W) + DBG_L0 * DM, (const float*)(wsp + WS_MOD) + (size_t)DBG_L0 * BATCH * NADA, DM, XN, (float*)(wsp + WS_RSP)); } PH_END
    for (int l_ = 0; l_ < DBG_LAYERS; ++l_) { const int l = l_ + DBG_L0;
        #define modl ((const float*)(wsp + WS_MOD) + (size_t)l * BATCH * NADA)
        #define xsrc (l_ == 0 ? PIN(F, I_X) : (const float*)POUT(F))
        PH_BEGIN
#if defined(PROBE_GA)
            { pg8::Gemm g{XN, (const bf16*)(wsp + WS_WIN) + (size_t)l * NPROJ * DM, MTOK, NPROJ, DM}; pg8::StaticOrder S; S.init(MTOK, NPROJ, F.G, F.bid);
            pg8::EpiRoute<0> E{PROJ, NPROJ, PROJ, NPROJ, 1 << 20};
            pg8::gemm_phase<pg8::EpiRoute<0>, pg8::StaticOrder, true, true>(glds, g, S, E, F.tid); } __syncthreads();
#elif defined(PROBE_GB)
            { pg8::Gemm g{XN, (const bf16*)(wsp + WS_WIN) + (size_t)l * NPROJ * DM, MTOK, NPROJ, DM}; pg8::StaticOrder S; S.init(MTOK, NPROJ, F.G, F.bid);
            pg8::EpiRouteN<0> E{PROJ, NPROJ, (const float*)(wsp + WS_RSP), (const float*)(wsp + WS_SHW) + (size_t)l * BATCH * NSHW, glds};
            pg8::gemm_phase<pg8::EpiRouteN<0>, pg8::StaticOrder, true, true>(glds, g, S, E, F.tid); } __syncthreads();
#endif
        EN(2) { pg8::Gemm g{XN, (const bf16*)(wsp + WS_WIN) + (size_t)l * NPROJ * DM, MTOK, NPROJ, DM}; pg8::StaticOrder S; S.init(MTOK, NPROJ, F.G, F.bid);
            pg8::EpiRouteN<0> E{PROJ, NPROJ, (const float*)(wsp + WS_RSP), (const float*)(wsp + WS_SHW) + (size_t)l * BATCH * NSHW, glds};
            pg8::gemm_phase<pg8::EpiRouteN<0>, pg8::StaticOrder, true, true>(glds, g, S, E, F.tid); } PH_END
        PH_BEGIN EN(3) ph_prep(F, l); DUP(3) ph_prep(F, l); EN(4) ph_lru1(F, l); DUP(4) ph_lru1(F, l); EN(5) ph_mlstm(F, l); DUP(5) ph_mlstm(F, l); PH_END
        PH_BEGIN EN(6) { ph_carry(F); pg8::Gemm g{(const bf16*)(wsp + WS_QL), (const bf16*)(wsp + WS_WQC) + (size_t)l * 768 * 256, MTOK, 768, 256}; pg8::StaticOrder S; S.init(MTOK, 768, F.G, F.bid);
            pg8::EpiRoute<0> E{(bf16*)(wsp + WS_QABS), 512, (bf16*)(wsp + WS_QIDX), 256, 2};
            pg8::gemm_phase<pg8::EpiRoute<0>, pg8::StaticOrder, true, true>(glds, g, S, E, F.tid); } PH_END
        PH_BEGIN EN(7) ph_dsa(F, l); DUP(7) ph_dsa(F, l); EN(8) ph_lru2(F, l); DUP(8) ph_lru2(F, l); EN(9) ph_mfin(F, l); DUP(9) ph_mfin(F, l); PH_END
        PH_BEGIN EN(10) { pg8::Gemm g{CAT, (const bf16*)(wsp + WS_WO) + (size_t)l * DM * DM, MTOK, DM, DM}; pg8::StaticOrder S; S.init(MTOK, DM, F.G, F.bid);
            pg8::EpiResidXS<true, false> E{l_ == 0 ? (const void*)PIN(F, I_X) : (const void*)POUT(F), (void*)POUT(F), modl + 2 * DM, (const float*)(wsp + WS_WP) + (size_t)(l * 2 + 1) * BATCH * DM, XN, (float*)(wsp + WS_RSP), 1, l_ == 0, 0};
            pg8::gemm_phase<pg8::EpiResidXS<true, false>, pg8::StaticOrder, true, true>(glds, g, S, E, F.tid); } PH_END
        PH_BEGIN EN(12) { pg8::Gemm g{XN, (const bf16*)(wsp + WS_W1) + (size_t)l * DFF * DM, MTOK, DFF, DM}; pg8::StaticOrder S; S.init(MTOK, DFF, F.G, F.bid);
            pg8::EpiRouteN<1> E{HB, DFF, (const float*)(wsp + WS_RSP), (const float*)(wsp + WS_SHW) + (size_t)l * BATCH * NSHW + NPROJ, glds};
            pg8::gemm_phase<pg8::EpiRouteN<1>, pg8::StaticOrder, true, true>(glds, g, S, E, F.tid); } PH_END
        PH_BEGIN EN(13) { pg8::Gemm g{HB, (const bf16*)(wsp + WS_W2) + (size_t)l * DM * DFF, MTOK, DM, DFF}; pg8::StaticOrder S; S.init(MTOK, DM, F.G, F.bid);
            const int nl = l + 1 < DEPTH ? l + 1 : l;
            const bool lastl = l_ + 1 >= DBG_LAYERS;
            pg8::EpiResidXS<false, false> E{(const void*)POUT(F), lastl ? (void*)XN : (void*)POUT(F), modl + 5 * DM, (const float*)(wsp + WS_WP) + (size_t)(nl * 2) * BATCH * DM, XN, (float*)(wsp + WS_RSP), lastl ? 0 : 1, 0, 0};
            pg8::gemm_phase<pg8::EpiResidXS<false, false>, pg8::StaticOrder, true, true>(glds, g, S, E, F.tid); } PH_END
    }
#ifdef DBG_DIGEST
    PH_BEGIN { const int gw = F.bid * 8 + F.wave, NGW = F.G * 8; float* o = POUT(F);
        for (int m = gw; m < MTOK; m += NGW) for (int j = 0; j < 16; ++j) { const int c = F.lane + 64 * j; float v = 0.f;
            if (c < DBG_DIGEST_N) { v = DBG_DIGEST_VAL(m, c) * 4096.0f; v = v - floorf(v); }
            o[(size_t)m * DM + c] = v; } } PH_END
#else
    PH_BEGIN EN(14) ph_finalnorm16(F, XN, PIN(F, I_FNW), POUT(F)); PH_END
#endif
}

extern "C" void kernel_launch(void* const* d_in, const int* in_sizes, int n_in, void* d_out, int out_size, void* d_ws, size_t ws_size, hipStream_t stream) {
    static int grid = 0;
    if (grid == 0) {
        if (n_in != 28 || in_sizes[0] != MTOK * DM || out_size != MTOK * DM || ws_size < WS_END) { fprintf(stderr, "kernel_launch: unexpected shapes (n_in %d, in0 %d, out %d, ws %zu)\n", n_in, n_in > 0 ? in_sizes[0] : -1, out_size, ws_size); grid = -1; return; }
        int dev = 0, cus = 0, per_cu = 0;
        if (hipGetDevice(&dev) != hipSuccess || hipDeviceGetAttribute(&cus, hipDeviceAttributeMultiprocessorCount, dev) != hipSuccess) { grid = -1; return; }
        if (hipFuncSetAttribute((const void*)hymba_fwd, hipFuncAttributeMaxDynamicSharedMemorySize, LDS_BYTES) != hipSuccess) { fprintf(stderr, "kernel_launch: hipFuncSetAttribute failed\n"); grid = -1; return; }
        if (hipOccupancyMaxActiveBlocksPerMultiprocessor(&per_cu, (const void*)hymba_fwd, 512, LDS_BYTES) != hipSuccess || per_cu < 1) { fprintf(stderr, "kernel_launch: occupancy query says %d\n", per_cu); }
        (void)hipGetLastError();
        grid = cus;
    }
    if (grid < 0) return;
    if (hipMemsetAsync((char*)d_ws + WS_CTL, 0, CTL_ZERO_BYTES, stream) != hipSuccess) return;
    Args a{};
    for (int i = 0; i < 28; ++i) a.in[i] = (const float*)d_in[i];
    a.out = (float*)d_out; a.ws = (unsigned char*)d_ws;
#if MK_MULTI
    for (int p = 0; p < NPHASE; ++p) { a.ph_lo = p; a.ph_hi = p + 1; hipLaunchKernelGGL(hymba_fwd, dim3(grid), dim3(512), LDS_BYTES, stream, a); }
#else
    a.ph_lo = 0; a.ph_hi = DBG_PH_HI; hipLaunchKernelGGL(hymba_fwd, dim3(grid), dim3(512), LDS_BYTES, stream, a);
#endif
}
#endif
```

```cpp
#ifndef HOST_EMU
#include <hip/hip_runtime.h>
#include <cstdio>
#include <cstdint>
#define DEV __device__ __forceinline__
#define LAS __attribute__((address_space(3)))
#else
#include "emu.h"
#endif

#ifndef HOST_EMU
#define SYNC() __syncthreads()
#define LAUNDER_V(x) asm volatile("" : "+v"(x))
#define WAVE_LDS_FENCE() asm volatile("s_waitcnt lgkmcnt(0)" ::: "memory")
template <class T> DEV T SHFL(T v, int s) { return __shfl(v, s); }
template <class T> DEV T SHFL_XOR(T v, int m) { return __shfl_xor(v, m); }
template <class T> DEV T SHFL_UP(T v, int d) { return __shfl_up(v, d); }
template <class T> DEV T SHFL_DOWN(T v, int d) { return __shfl_down(v, d); }
typedef short bf16x8_ __attribute__((ext_vector_type(8)));
typedef float f32x4_ __attribute__((ext_vector_type(4)));
typedef short v4i16_t __attribute__((ext_vector_type(4)));
DEV f32x4_ MFMA16(bf16x8_ a, bf16x8_ b, f32x4_ c) { return __builtin_amdgcn_mfma_f32_16x16x32_bf16(a, b, c, 0, 0, 0); }
DEV v4i16_t TR16(const void* p) { return __builtin_amdgcn_ds_read_tr16_b64_v4i16((LAS v4i16_t*)(p)); }
#endif


typedef unsigned short bf16;
typedef short bf16x8 __attribute__((ext_vector_type(8)));
typedef short s16x4 __attribute__((ext_vector_type(4)));
typedef float f32x4 __attribute__((ext_vector_type(4)));
typedef unsigned u32x4 __attribute__((ext_vector_type(4)));
typedef unsigned u32x2 __attribute__((ext_vector_type(2)));

constexpr int BATCH = 16, SEQ = 4096, DM = 1024, DEPTH = 4, MTOK = BATCH * SEQ;
constexpr int NPROJ = 3072, DFF = 4096, NADA = 6 * DM;
constexpr int PC_LX = 0, PC_LY = 256, PC_MQ = 512, PC_MK = 1024, PC_MV = 1536, PC_MO = 2048, PC_AQ = 2560, PC_AKV = 2816, PC_IK = 2944, PC_IW = 2976, PC_MI = 2984, PC_MF = 2988;
constexpr float NORM_EPS = 1e-6f;

constexpr size_t MiB = 1u << 20;
constexpr size_t WS_CTL = 0, CTL_ZERO_BYTES = 1 * MiB;
constexpr size_t WS_MOD = 1 * MiB;
constexpr size_t WS_WQC = 3 * MiB;
constexpr size_t WS_WG = 5 * MiB;
constexpr size_t WS_WUVT = 6 * MiB;
constexpr size_t WS_WIN = 8 * MiB;
constexpr size_t WS_WO = 32 * MiB;
constexpr size_t WS_W1 = 40 * MiB;
constexpr size_t WS_W2 = 72 * MiB;
constexpr size_t WS_XN = 104 * MiB;
constexpr size_t WS_QL = WS_XN, WS_CKV = WS_XN + 32 * MiB, WS_QIDX = WS_XN + 48 * MiB, WS_KIDX = WS_XN + 80 * MiB, WS_WI = WS_XN + 84 * MiB, WS_GT = WS_XN + 86 * MiB;
constexpr size_t WS_CAT = 232 * MiB;
constexpr size_t WS_PROJ = 360 * MiB;
constexpr size_t WS_HB = 360 * MiB;
constexpr size_t WS_QABS = 744 * MiB;
constexpr size_t WS_HLOC = 808 * MiB, WS_CPA = 840 * MiB;
constexpr size_t WS_LSUM = 872 * MiB;
constexpr size_t WS_HM = 874 * MiB;
constexpr size_t WS_MG = 940 * MiB;
constexpr size_t WS_WP = 2 * MiB + 512 * 1024;
constexpr size_t WS_SHW = 6 * MiB + 256 * 1024;
constexpr size_t WS_RSP = 1000 * MiB;
constexpr size_t WS_CARRY = 948 * MiB;
constexpr size_t WS_SCR2 = 949 * MiB;
constexpr int NSHW = NPROJ + DFF;
constexpr size_t WS_END = 1024 * MiB;
static_assert(WS_HM + (size_t)MTOK * 512 * 2 <= WS_END && WS_HB + (size_t)MTOK * DFF * 2 <= WS_HLOC + 64 * MiB, "ws map");

constexpr int CW_TMO = 0, CW_BAR = 4096;

#ifndef HOST_EMU
typedef __bf16 hwbf2_t __attribute__((ext_vector_type(2)));
typedef float hwf2_t __attribute__((ext_vector_type(2)));
DEV unsigned f2bf(float f) { return (unsigned)__builtin_bit_cast(unsigned short, (__bf16)f); }
DEV unsigned pk2(float lo, float hi) { const hwf2_t v = {lo, hi}; return __builtin_bit_cast(unsigned, __builtin_convertvector(v, hwbf2_t)); }
#else
DEV unsigned f2bf(float f) { unsigned u = __builtin_bit_cast(unsigned, f); return (u + 0x7fffu + ((u >> 16) & 1u)) >> 16; }
DEV unsigned pk2(float lo, float hi) { return f2bf(lo) | (f2bf(hi) << 16); }
#endif
DEV float bf2f(unsigned h) { return __builtin_bit_cast(float, h << 16); }
DEV float bflo(unsigned w) { return __builtin_bit_cast(float, w << 16); }
DEV float bfhi(unsigned w) { return __builtin_bit_cast(float, w & 0xffff0000u); }
DEV float wave_sum(float v) {
#pragma unroll
    for (int o = 1; o < 64; o <<= 1) v += SHFL_XOR(v, o);
    return v;
}
#ifndef HOST_EMU
DEV float FEXP(float x) { return __expf(x); }
DEV float FEXP2(float x) { return __builtin_amdgcn_exp2f(x); }
DEV float FRCP(float x) { return __builtin_amdgcn_rcpf(x); }
DEV float FSQRT(float x) { return __builtin_amdgcn_sqrtf(x); }
DEV float RSQ(float x) { return __builtin_amdgcn_rsqf(x); }
DEV float FLOG(float x) { return __logf(x); }
#else
DEV float FEXP(float x) { return expf(x); }
DEV float FEXP2(float x) { return exp2f(x); }
DEV float FRCP(float x) { return 1.0f / x; }
DEV float FSQRT(float x) { return sqrtf(x); }
DEV float RSQ(float x) { return 1.0f / sqrtf(x); }
DEV float FLOG(float x) { return logf(x); }
#endif
#ifndef HOST_EMU
DEV int UNI(int x) { return __builtin_amdgcn_readfirstlane(x); }
#else
DEV int UNI(int x) { return x; }
#endif
#ifndef HOST_EMU
#define GAS __attribute__((address_space(1)))
DEV const GAS char* UNIP(const void* p) { const unsigned long long v = (unsigned long long)p; const unsigned lo = __builtin_amdgcn_readfirstlane((unsigned)v), hi = __builtin_amdgcn_readfirstlane((unsigned)(v >> 32));
    return (const GAS char*)(((unsigned long long)hi << 32) | lo); }
#else
#define GAS
DEV const char* UNIP(const void* p) { return (const char*)p; }
#endif
DEV float RELU(float x) { const int b = __builtin_bit_cast(int, x); return __builtin_bit_cast(float, b > 0 ? b : 0); }
DEV float sigmoidf_(float z) { return 1.0f / (1.0f + expf(-z)); }
DEV float fsigmoid(float z) { return FRCP(1.0f + FEXP(-z)); }
DEV float one_minus_exp(float x) {
    const float s = -x * (1.0f + x * (0.5f + x * (0.16666667f + x * 0.041666668f)));
    return x > -0.05f ? s : 1.0f - FEXP(x);
}

struct Args { const float* in[28]; float* out; unsigned char* ws; int ph_lo, ph_hi; };
struct Ctx {
    char* lds; int tid, lane, wave, G, bid;
    const Args* A;
    unsigned char* ws;
};

constexpr int PTR_OFF = 131072 + 512;
#ifndef HOST_EMU
DEV const float* PIN(const Ctx& F, int i) { const unsigned long long v = ((const unsigned long long*)(F.lds + PTR_OFF))[i];
    const unsigned lo = __builtin_amdgcn_readfirstlane((unsigned)v), hi = __builtin_amdgcn_readfirstlane((unsigned)(v >> 32)); return (const float*)(const __attribute__((address_space(1))) float*)(((unsigned long long)hi << 32) | lo); }
DEV float* POUT(const Ctx& F) { return (float*)PIN(F, 28); }
#else
DEV const float* PIN(const Ctx& F, int i) { return F.A->in[i]; }
DEV float* POUT(const Ctx& F) { return POUT(F); }
#endif
enum { I_X = 0, I_C, I_WIN, I_CONVW, I_CONVB, I_WA, I_BA, I_WX, I_BX, I_LAM, I_BI, I_BF, I_WQUP, I_WQIDX, I_WUK, I_WUV, I_QNW, I_KVNW, I_RELB, I_GNW, I_WO, I_WADA, I_BADA, I_N1W, I_N2W, I_W1, I_W2, I_FNW };

DEV int win_srccol(int n) {
    if (n < 2560) return n;
    if (n < PC_AKV) return 2568 + (n - PC_AQ);
    if (n < PC_IK) return 2824 + (n - PC_AKV);
    if (n < PC_IW) return 2952 + (n - PC_IK);
    if (n < PC_MI) return 2984 + (n - PC_IW);
    if (n < PC_MF) return 2560 + (n - PC_MI);
    if (n < 2992) return 2564 + (n - PC_MF);
    return -1;
}
template <bool MAPPED>
DEV void p0_transpose_item(const float* W, int K, int N, int NT, bf16* WT, float* scr, int item, int lane) {
    const int nblk = NT / 32, kb = item / nblk, nb = item % nblk, k0 = 64 * kb, n0 = 32 * nb;
    int sc = n0 + (lane & 31); if (MAPPED) sc = win_srccol(sc);
#pragma unroll 8
    for (int i = 0; i < 32; ++i) { const int kk = 2 * i + (lane >> 5); const float v = W[(size_t)(k0 + kk) * N + (sc >= 0 ? sc : 0)]; scr[kk * 33 + (lane & 31)] = sc >= 0 ? v : 0.f; }
    WAVE_LDS_FENCE();
    const int c = lane & 7;
#pragma unroll
    for (int j = 0; j < 4; ++j) { const int n = (lane >> 3) + 8 * j; const float* s = scr + (8 * c) * 33 + n;
        u32x4 o; o.x = pk2(s[0 * 33], s[1 * 33]); o.y = pk2(s[2 * 33], s[3 * 33]); o.z = pk2(s[4 * 33], s[5 * 33]); o.w = pk2(s[6 * 33], s[7 * 33]);
        *(u32x4*)(WT + (size_t)(n0 + n) * K + k0 + 8 * c) = o; }
    WAVE_LDS_FENCE();
}

DEV void ph_prologue(const Ctx& F) {
    const int gt = F.bid * 512 + F.tid, NGT = F.G * 512;
    float* CACT = (float*)F.lds;
    for (int i = F.tid; i < BATCH * DM; i += 512) { const float cv = PIN(F, I_C)[i]; CACT[i] = cv * sigmoidf_(cv); }
    SYNC();
    for (int e = gt; e < DEPTH * NADA * 4; e += NGT) {
        const int j = e % NADA, bq = (e / NADA) & 3, l = e / (NADA * 4);
        const float* w = PIN(F, I_WADA) + (size_t)l * DM * NADA + j;
        const float* c = CACT + bq * 4 * DM;
        float a0 = 0.f, a1 = 0.f, a2 = 0.f, a3 = 0.f;
#pragma unroll 32
        for (int k = 0; k < DM; ++k) { const float wv = w[(size_t)k * NADA];
            a0 += c[k] * wv; a1 += c[DM + k] * wv; a2 += c[2 * DM + k] * wv; a3 += c[3 * DM + k] * wv; }
        const float bb = PIN(F, I_BADA)[(size_t)l * NADA + j];
        float* mo = (float*)(F.ws + WS_MOD) + ((size_t)l * BATCH + bq * 4) * NADA + j;
        mo[0] = a0 + bb; mo[NADA] = a1 + bb; mo[2 * NADA] = a2 + bb; mo[3 * NADA] = a3 + bb;
    }
    for (int e = gt; e < DEPTH * 2 * 4 * 64 * 64; e += NGT) {
        const int i = e & 63, j = (e >> 6) & 63, blk = (e >> 12) & 3, g = (e >> 14) & 1, l = e >> 15;
        const float* src = PIN(F, g ? I_WX : I_WA) + (((size_t)l * 4 + blk) * 64 + i) * 64 + j;
        ((bf16*)(F.ws + WS_WG))[e] = (bf16)f2bf(*src);
    }
    for (int e = gt; e < DEPTH * 4 * 64 * 128; e += NGT) {
        const int r = e & 127, d = (e >> 7) & 63, h = (e >> 13) & 3, l = e >> 15;
        ((bf16*)(F.ws + WS_WUVT))[e] = (bf16)f2bf(PIN(F, I_WUV)[(((size_t)l * 128 + r) * 4 + h) * 64 + d]);
    }
    for (int e = gt; e < DEPTH * 768 * 256; e += NGT) {
        const int r = e & 255, n = (e >> 8) % 768, l = e / (768 * 256);
        float v;
        if (n < 512) { const int h = n >> 7, c = n & 127; const f32x4* q = (const f32x4*)(PIN(F, I_WQUP) + ((size_t)l * 256 + r) * 256 + h * 64); const f32x4* k = (const f32x4*)(PIN(F, I_WUK) + ((size_t)l * 128 + c) * 256 + h * 64);
            float s = 0.f;
#pragma unroll
            for (int d = 0; d < 16; ++d) { const f32x4 a = q[d], bq4 = k[d]; s += (a.x * bq4.x + a.y * bq4.y) + (a.z * bq4.z + a.w * bq4.w); }
            v = s * (0.125f * 1.4426950408889634f); }
        else v = PIN(F, I_WQIDX)[((size_t)l * 256 + r) * 256 + (n - 512)] * 0.17677669529663687f;
        ((bf16*)(F.ws + WS_WQC))[e] = (bf16)f2bf(v);
    }
    SYNC();
    float* scr = (float*)(F.lds + F.wave * 16384);
    const int gw = F.bid * 8 + F.wave, NGW = F.G * 8;
    constexpr int I_IN = (DM / 64) * (NPROJ / 32), I_O = (DM / 64) * (DM / 32), I_1 = (DM / 64) * (DFF / 32), I_2 = (DFF / 64) * (DM / 32);
    constexpr int PER_L = I_IN + I_O + I_1 + I_2;
    for (int it = gw; it < DEPTH * PER_L; it += NGW) {
        const int l = it / PER_L; int r = it % PER_L;
        if (r < I_IN) { p0_transpose_item<true>(PIN(F, I_WIN) + (size_t)l * DM * 2992, DM, 2992, NPROJ, (bf16*)(F.ws + WS_WIN) + (size_t)l * NPROJ * DM, scr, r, F.lane); continue; } r -= I_IN;
        if (r < I_O) { p0_transpose_item<false>(PIN(F, I_WO) + (size_t)l * DM * DM, DM, DM, DM, (bf16*)(F.ws + WS_WO) + (size_t)l * DM * DM, scr, r, F.lane); continue; } r -= I_O;
        if (r < I_1) { p0_transpose_item<false>(PIN(F, I_W1) + (size_t)l * DM * DFF, DM, DFF, DFF, (bf16*)(F.ws + WS_W1) + (size_t)l * DFF * DM, scr, r, F.lane); continue; } r -= I_1;
        p0_transpose_item<false>(PIN(F, I_W2) + (size_t)l * DFF * DM, DFF, DM, DM, (bf16*)(F.ws + WS_W2) + (size_t)l * DM * DFF, scr, r, F.lane);
    }
}

DEV void ph_xs0(const Ctx& F, const float* xsrc, const float* nw, const float* modl, int sc_off, bf16* XS, float* RSP, bf16* X16) {
    const int gw = F.bid * 8 + F.wave, NGW = F.G * 8;
    f32x4 wv[4];
#pragma unroll
    for (int j = 0; j < 4; ++j) wv[j] = *(const f32x4*)(nw + 4 * F.lane + 256 * j);
    f32x4 v[2][4], vn[2][4];
#pragma unroll
    for (int q = 0; q < 2; ++q) { const int m = gw + q * NGW; const f32x4* xr = (const f32x4*)(xsrc + (size_t)(m < MTOK ? m : 0) * DM) + F.lane;
#pragma unroll
        for (int j = 0; j < 4; ++j) v[q][j] = xr[64 * j]; }
    for (int m0 = gw; m0 < MTOK; m0 += 2 * NGW) {
        f32x4 sc[2][4];
#pragma unroll
        for (int q = 0; q < 2; ++q) { const int m = m0 + q * NGW; const float* mb = modl + (size_t)((m < MTOK ? m : 0) >> 12) * NADA + 4 * F.lane;
#pragma unroll
            for (int j = 0; j < 4; ++j) sc[q][j] = *(const f32x4*)(mb + sc_off + 256 * j); }
#pragma unroll
        for (int q = 0; q < 2; ++q) { const int m = m0 + (2 + q) * NGW; const f32x4* xr = (const f32x4*)(xsrc + (size_t)(m < MTOK ? m : 0) * DM) + F.lane;
#pragma unroll
            for (int j = 0; j < 4; ++j) vn[q][j] = xr[64 * j]; }
        float s[2];
#pragma unroll
        for (int q = 0; q < 2; ++q) { float a = 0.f;
#pragma unroll
            for (int j = 0; j < 4; ++j) a += (v[q][j].x * v[q][j].x + v[q][j].y * v[q][j].y) + (v[q][j].z * v[q][j].z + v[q][j].w * v[q][j].w);
            s[q] = a; }
#pragma unroll
        for (int o = 1; o < 64; o <<= 1) { s[0] += SHFL_XOR(s[0], o); s[1] += SHFL_XOR(s[1], o); }
#pragma unroll
        for (int q = 0; q < 2; ++q) { const int m = m0 + q * NGW; if (m >= MTOK) break;
            if (F.lane < 16) RSP[(size_t)m * 16 + F.lane] = F.lane == 0 ? s[q] : 0.f;
            u32x2* o8 = (u32x2*)(XS + (size_t)m * DM) + F.lane; u32x2* x8 = (u32x2*)(X16 + (size_t)m * DM) + F.lane;
#pragma unroll
            for (int j = 0; j < 4; ++j) { const f32x4 y = v[q][j] * (wv[j] * (1.0f + sc[q][j]));
                u32x2 p; p.x = pk2(y.x, y.y); p.y = pk2(y.z, y.w); o8[64 * j] = p;
                u32x2 c; c.x = pk2(v[q][j].x, v[q][j].y); c.y = pk2(v[q][j].z, v[q][j].w); x8[64 * j] = c; } }
#pragma unroll
        for (int q = 0; q < 2; ++q)
#pragma unroll
            for (int j = 0; j < 4; ++j) v[q][j] = vn[q][j];
    }
}
DEV void ph_shw(const Ctx& F) {
    const int gt = F.bid * 512 + F.tid, NGT = F.G * 512;
    for (int e = gt; e < DEPTH * 2 * BATCH * (DM / 4); e += NGT) {
        const int c4 = e & 255, b = (e >> 8) & 15, w = (e >> 12) & 1, l = e >> 13;
        const f32x4 nwv = *(const f32x4*)(PIN(F, w ? I_N2W : I_N1W) + l * DM + 4 * c4);
        const f32x4 sc = *(const f32x4*)((const float*)(F.ws + WS_MOD) + ((size_t)l * BATCH + b) * NADA + (w ? 4 * DM : DM) + 4 * c4);
        ((f32x4*)(F.ws + WS_WP))[e] = nwv * (1.0f + sc);
    }
    const int gw = F.bid * 8 + F.wave, NGW = F.G * 8, i16 = F.lane & 15, kq = 8 * (F.lane >> 4);
    for (int it = gw; it < DEPTH * (NSHW / 16); it += NGW) {
        const int l = it / (NSHW / 16), n0 = (it % (NSHW / 16)) * 16;
        const bool mlp = n0 >= NPROJ;
        const bf16* Wr = mlp ? (const bf16*)(F.ws + WS_W1) + ((size_t)l * DFF + (n0 - NPROJ) + i16) * DM : (const bf16*)(F.ws + WS_WIN) + ((size_t)l * NPROJ + n0 + i16) * DM;
        const float* sh = (const float*)(F.ws + WS_MOD) + ((size_t)l * BATCH + i16) * NADA + (mlp ? 3 * DM : 0);
        f32x4 acc0 = {0.f, 0.f, 0.f, 0.f}, acc1 = {0.f, 0.f, 0.f, 0.f};
#pragma unroll 4
        for (int s = 0; s < DM / 32; ++s) {
            const bf16x8 B = *(const bf16x8*)(Wr + 32 * s + kq);
            const f32x4 a0 = *(const f32x4*)(sh + 32 * s + kq), a1 = *(const f32x4*)(sh + 32 * s + kq + 4);
            bf16x8 Ah, Al;
#pragma unroll
            for (int j = 0; j < 8; ++j) { const float a = j < 4 ? a0[j] : a1[j - 4]; const unsigned h = f2bf(a); Ah[j] = (short)h; Al[j] = (short)f2bf(a - bf2f(h)); }
            acc0 = MFMA16(Ah, B, acc0); acc1 = MFMA16(Al, B, acc1);
        }
        float* o = (float*)(F.ws + WS_SHW) + ((size_t)l * BATCH + 4 * (F.lane >> 4)) * NSHW + n0 + i16;
#pragma unroll
        for (int r = 0; r < 4; ++r) o[(size_t)r * NSHW] = acc0[r] + acc1[r];
    }
}
DEV void ph_normmod(const Ctx& F, const float* xsrc, const float* nw, const float* modl, int sh_off, int sc_off, bf16* XN) {
    const int gw = F.bid * 8 + F.wave, NGW = F.G * 8;
    f32x4 wv[4];
#pragma unroll
    for (int j = 0; j < 4; ++j) wv[j] = *(const f32x4*)(nw + 4 * F.lane + 256 * j);
    f32x4 v[2][4], vn[2][4];
#pragma unroll
    for (int q = 0; q < 2; ++q) { const int m = gw + q * NGW; const f32x4* xr = (const f32x4*)(xsrc + (size_t)(m < MTOK ? m : 0) * DM) + F.lane;
#pragma unroll
        for (int j = 0; j < 4; ++j) v[q][j] = xr[64 * j]; }
    for (int m0 = gw; m0 < MTOK; m0 += 2 * NGW) {
        f32x4 sc[2][4], sh[2][4];
#pragma unroll
        for (int q = 0; q < 2; ++q) { const int m = m0 + q * NGW; const float* mb = modl + (size_t)((m < MTOK ? m : 0) >> 12) * NADA + 4 * F.lane;
#pragma unroll
            for (int j = 0; j < 4; ++j) { sc[q][j] = *(const f32x4*)(mb + sc_off + 256 * j); sh[q][j] = *(const f32x4*)(mb + sh_off + 256 * j); } }
#pragma unroll
        for (int q = 0; q < 2; ++q) { const int m = m0 + (2 + q) * NGW; const f32x4* xr = (const f32x4*)(xsrc + (size_t)(m < MTOK ? m : 0) * DM) + F.lane;
#pragma unroll
            for (int j = 0; j < 4; ++j) vn[q][j] = xr[64 * j]; }
        float s[2];
#pragma unroll
        for (int q = 0; q < 2; ++q) { float a = 0.f;
#pragma unroll
            for (int j = 0; j < 4; ++j) a += (v[q][j].x * v[q][j].x + v[q][j].y * v[q][j].y) + (v[q][j].z * v[q][j].z + v[q][j].w * v[q][j].w);
            s[q] = a; }
#pragma unroll
        for (int o = 1; o < 64; o <<= 1) { s[0] += SHFL_XOR(s[0], o); s[1] += SHFL_XOR(s[1], o); }
#pragma unroll
        for (int q = 0; q < 2; ++q) { const int m = m0 + q * NGW; if (m >= MTOK) break;
            const float rs = RSQ(s[q] * (1.0f / DM) + NORM_EPS);
            u32x2* o8 = (u32x2*)(XN + (size_t)m * DM) + F.lane;
#pragma unroll
            for (int j = 0; j < 4; ++j) { const f32x4 y = v[q][j] * rs * wv[j] * (1.0f + sc[q][j]) + sh[q][j];
                u32x2 p; p.x = pk2(y.x, y.y); p.y = pk2(y.z, y.w); o8[64 * j] = p; } }
#pragma unroll
        for (int q = 0; q < 2; ++q)
#pragma unroll
            for (int j = 0; j < 4; ++j) v[q][j] = vn[q][j];
    }
}
DEV void ph_finalnorm(const Ctx& F, const float* xsrc, const float* nw, float* out) {
    const int gw = F.bid * 8 + F.wave, NGW = F.G * 8;
    f32x4 wv[4];
#pragma unroll
    for (int j = 0; j < 4; ++j) wv[j] = *(const f32x4*)(nw + 4 * F.lane + 256 * j);
    f32x4 v[2][4], vn[2][4];
#pragma unroll
    for (int q = 0; q < 2; ++q) { const int m = gw + q * NGW; const f32x4* xr = (const f32x4*)(xsrc + (size_t)(m < MTOK ? m : 0) * DM) + F.lane;
#pragma unroll
        for (int j = 0; j < 4; ++j) v[q][j] = xr[64 * j]; }
    for (int m0 = gw; m0 < MTOK; m0 += 2 * NGW) {
#pragma unroll
        for (int q = 0; q < 2; ++q) { const int m = m0 + (2 + q) * NGW; const f32x4* xr = (const f32x4*)(xsrc + (size_t)(m < MTOK ? m : 0) * DM) + F.lane;
#pragma unroll
            for (int j = 0; j < 4; ++j) vn[q][j] = xr[64 * j]; }
        float s[2];
#pragma unroll
        for (int q = 0; q < 2; ++q) { float a = 0.f;
#pragma unroll
            for (int j = 0; j < 4; ++j) a += (v[q][j].x * v[q][j].x + v[q][j].y * v[q][j].y) + (v[q][j].z * v[q][j].z + v[q][j].w * v[q][j].w);
            s[q] = a; }
#pragma unroll
        for (int o = 1; o < 64; o <<= 1) { s[0] += SHFL_XOR(s[0], o); s[1] += SHFL_XOR(s[1], o); }
#pragma unroll
        for (int q = 0; q < 2; ++q) { const int m = m0 + q * NGW; if (m >= MTOK) break;
            const float rs = RSQ(s[q] * (1.0f / DM) + NORM_EPS);
            f32x4* o = (f32x4*)(out + (size_t)m * DM) + F.lane;
#pragma unroll
            for (int j = 0; j < 4; ++j) o[64 * j] = v[q][j] * rs * wv[j]; }
#pragma unroll
        for (int q = 0; q < 2; ++q)
#pragma unroll
            for (int j = 0; j < 4; ++j) v[q][j] = vn[q][j];
    }
}
DEV void ph_finalnorm16(const Ctx& F, const bf16* x16, const float* nw, float* out) {
    const int gw = F.bid * 8 + F.wave, NGW = F.G * 8;
    f32x4 wv[2][2];
#pragma unroll
    for (int j = 0; j < 2; ++j) { wv[j][0] = *(const f32x4*)(nw + 8 * F.lane + 512 * j); wv[j][1] = *(const f32x4*)(nw + 8 * F.lane + 512 * j + 4); }
    u32x4 v[4][2], vn[4][2];
#pragma unroll
    for (int q = 0; q < 4; ++q) { const int m = gw + q * NGW; const bf16* xr = x16 + (size_t)(m < MTOK ? m : 0) * DM + 8 * F.lane;
        v[q][0] = *(const u32x4*)xr; v[q][1] = *(const u32x4*)(xr + 512); }
    for (int m0 = gw; m0 < MTOK; m0 += 4 * NGW) {
#pragma unroll
        for (int q = 0; q < 4; ++q) { const int m = m0 + (4 + q) * NGW; const bf16* xr = x16 + (size_t)(m < MTOK ? m : 0) * DM + 8 * F.lane;
            vn[q][0] = *(const u32x4*)xr; vn[q][1] = *(const u32x4*)(xr + 512); }
        float s[4];
#pragma unroll
        for (int q = 0; q < 4; ++q) { float a = 0.f;
#pragma unroll
            for (int j = 0; j < 2; ++j) { const u32x4 r = v[q][j];
                a += ((bflo(r.x) * bflo(r.x) + bfhi(r.x) * bfhi(r.x)) + (bflo(r.y) * bflo(r.y) + bfhi(r.y) * bfhi(r.y))) + ((bflo(r.z) * bflo(r.z) + bfhi(r.z) * bfhi(r.z)) + (bflo(r.w) * bflo(r.w) + bfhi(r.w) * bfhi(r.w))); }
            s[q] = a; }
#pragma unroll
        for (int o = 1; o < 64; o <<= 1) {
#pragma unroll
            for (int q = 0; q < 4; ++q) s[q] += SHFL_XOR(s[q], o); }
#pragma unroll
        for (int q = 0; q < 4; ++q) { const int m = m0 + q * NGW; if (m >= MTOK) break;
            const float rs = RSQ(s[q] * (1.0f / DM) + NORM_EPS);
            float* o = out + (size_t)m * DM + 8 * F.lane;
#pragma unroll
            for (int j = 0; j < 2; ++j) { const u32x4 r = v[q][j];
                *(f32x4*)(o + 512 * j) = (f32x4){bflo(r.x), bfhi(r.x), bflo(r.y), bfhi(r.y)} * rs * wv[j][0];
                *(f32x4*)(o + 512 * j + 4) = (f32x4){bflo(r.z), bfhi(r.z), bflo(r.w), bfhi(r.w)} * rs * wv[j][1]; } }
#pragma unroll
        for (int q = 0; q < 4; ++q) { v[q][0] = vn[q][0]; v[q][1] = vn[q][1]; }
    }
}
DEV void ph_zero_cat(const Ctx& F, int c0, int nq) {
    const int gw = F.bid * 8 + F.wave, NGW = F.G * 8;
    bf16* CAT = (bf16*)(F.ws + WS_CAT);
    for (int m = gw; m < MTOK; m += NGW) for (int q = 0; q < nq; ++q) *(u32x2*)(CAT + (size_t)m * DM + c0 + 256 * q + 4 * F.lane) = (u32x2){0u, 0u};
}
DEV float softcap15(float z) { return 15.0f * tanhf(z * (1.0f / 15.0f)); }
DEV float logsigmoidf_(float x) { return x >= 0.f ? -log1pf(expf(-x)) : x - log1pf(expf(x)); }
DEV void ph_prep(const Ctx& F, int l) {
    const int gw = F.bid * 8 + F.wave, NGW = F.G * 8, lane = F.lane;
    const bf16* PROJ = (const bf16*)(F.ws + WS_PROJ);
    bf16* QL = (bf16*)(F.ws + WS_QL); bf16* CKV = (bf16*)(F.ws + WS_CKV); bf16* KIDX = (bf16*)(F.ws + WS_KIDX);
    float* WI = (float*)(F.ws + WS_WI);
    const f32x4 qn = *(const f32x4*)(PIN(F, I_QNW) + l * 256 + 4 * lane);
    const float kn0 = PIN(F, I_KVNW)[l * 128 + 2 * lane], kn1 = PIN(F, I_KVNW)[l * 128 + 2 * lane + 1];
    u32x2 ra4[4], ran[4]; unsigned rk4[4], rx4[4], rkn[4], rxn[4];
#define PREP_LOAD(RA, RK, RX, M0) do { _Pragma("unroll") for (int q = 0; q < 4; ++q) { const int mm = (M0) + q * NGW; const bf16* pr = PROJ + (size_t)(mm < MTOK ? mm : 0) * NPROJ; \
            RA[q] = *(const u32x2*)(pr + PC_AQ + 4 * lane); RK[q] = *(const unsigned*)(pr + PC_AKV + 2 * lane); \
            RX[q] = lane < 16 ? *(const unsigned*)(pr + PC_IK + 2 * lane) : (lane < 24 ? (unsigned)pr[PC_IW + (lane - 16)] : 0u); } } while (0)
    PREP_LOAD(ra4, rk4, rx4, gw);
    for (int m0 = gw; m0 < MTOK; m0 += 4 * NGW) {
        PREP_LOAD(ran, rkn, rxn, m0 + 4 * NGW);
#pragma unroll
        for (int q = 0; q < 4; ++q) { const int m = m0 + q * NGW; if (m >= MTOK) break;
            const u32x2 ra = ra4[q]; const unsigned rk = rk4[q];
            const float a0 = bflo(ra.x), a1 = bfhi(ra.x), a2 = bflo(ra.y), a3 = bfhi(ra.y);
            const float k0 = bflo(rk), k1 = bfhi(rk);
            const float sq = wave_sum((a0 * a0 + a1 * a1) + (a2 * a2 + a3 * a3)), sk = wave_sum(k0 * k0 + k1 * k1);
            const float rq = RSQ(sq * (1.0f / 256.0f) + NORM_EPS), rk2 = RSQ(sk * (1.0f / 128.0f) + NORM_EPS);
            u32x2 oq; oq.x = pk2(a0 * rq * qn.x, a1 * rq * qn.y); oq.y = pk2(a2 * rq * qn.z, a3 * rq * qn.w);
            *(u32x2*)(QL + (size_t)m * 256 + 4 * lane) = oq;
            *(unsigned*)(CKV + (size_t)m * 128 + 2 * lane) = pk2(k0 * rk2 * kn0, k1 * rk2 * kn1);
            if (lane < 16) *(unsigned*)(KIDX + (size_t)m * 32 + 2 * lane) = rx4[q];
            else if (lane < 24) WI[(size_t)m * 8 + (lane - 16)] = bf2f(rx4[q]); }
#pragma unroll
        for (int q = 0; q < 4; ++q) { ra4[q] = ran[q]; rk4[q] = rkn[q]; rx4[q] = rxn[q]; }
    }
#undef PREP_LOAD
}

constexpr int XB_STRIDE = 264;
DEV void ph_lru1(const Ctx& F, int l) {
    const int tid = F.tid, lane = F.lane, w = F.wave, i16 = lane & 15, g = lane >> 4;
    bf16* XB = (bf16*)F.lds;
    float* XF = (float*)(F.lds + 64 * XB_STRIDE * 2);
    const bf16* PROJ = (const bf16*)(F.ws + WS_PROJ);
    bf16* HLOC = (bf16*)(F.ws + WS_HLOC); bf16* CPA = (bf16*)(F.ws + WS_CPA); float* LSUM = (float*)(F.ws + WS_LSUM);
    const int blk = w & 3, nh = w >> 2;
    const bf16* WG = (const bf16*)(F.ws + WS_WG) + (size_t)l * 2 * 4 * 4096;
    bf16x8 Bf[2][2][2];
#pragma unroll
    for (int gg = 0; gg < 2; ++gg)
#pragma unroll
        for (int nt = 0; nt < 2; ++nt)
#pragma unroll
            for (int ks = 0; ks < 2; ++ks) Bf[gg][nt][ks] = *(const bf16x8*)(WG + ((size_t)(gg * 4 + blk) * 64 + nh * 32 + 2 * i16 + nt) * 64 + ks * 32 + 8 * g);
    float ba[2], bx[2], sp[2];
#pragma unroll
    for (int nt = 0; nt < 2; ++nt) { const int ch = blk * 64 + nh * 32 + 2 * i16 + nt;
        ba[nt] = PIN(F, I_BA)[l * 256 + ch]; bx[nt] = PIN(F, I_BX)[l * 256 + ch];
        const float lam = PIN(F, I_LAM)[l * 256 + ch]; sp[nt] = lam > 0.f ? log1pf(expf(-lam)) : -lam + log1pf(expf(lam)); }
    const int ch2 = tid & 127, tg = tid >> 7;
    float cw[4][2], cb[2];
#pragma unroll
    for (int j = 0; j < 4; ++j) { cw[j][0] = PIN(F, I_CONVW)[(l * 4 + j) * 256 + 2 * ch2]; cw[j][1] = PIN(F, I_CONVW)[(l * 4 + j) * 256 + 2 * ch2 + 1]; }
    cb[0] = PIN(F, I_CONVB)[l * 256 + 2 * ch2]; cb[1] = PIN(F, I_CONVB)[l * 256 + 2 * ch2 + 1];

    for (int u = F.bid; u < BATCH * 64; u += F.G) {
        const int b = u >> 6, c = u & 63, t0 = c * 64; const size_t m0 = (size_t)b * SEQ + t0;
        {
            const int tl0 = tg * 16;
            unsigned rv[19];
#pragma unroll
            for (int j = 0; j < 3; ++j) { const int t = t0 + tl0 - 3 + j; rv[j] = t >= 0 ? *(const unsigned*)(PROJ + ((size_t)b * SEQ + t) * NPROJ + PC_LX + 2 * ch2) : 0u; }
#pragma unroll
            for (int tt = 0; tt < 16; ++tt) rv[3 + tt] = *(const unsigned*)(PROJ + (m0 + tl0 + tt) * NPROJ + PC_LX + 2 * ch2);
#pragma unroll
            for (int tt = 0; tt < 16; ++tt) { const int tl = tl0 + tt;
                const float x0 = cw[0][0] * bflo(rv[tt]) + cw[1][0] * bflo(rv[tt + 1]) + cw[2][0] * bflo(rv[tt + 2]) + cw[3][0] * bflo(rv[tt + 3]) + cb[0];
                const float x1 = cw[0][1] * bfhi(rv[tt]) + cw[1][1] * bfhi(rv[tt + 1]) + cw[2][1] * bfhi(rv[tt + 2]) + cw[3][1] * bfhi(rv[tt + 3]) + cb[1];
                *(unsigned*)(XB + tl * XB_STRIDE + 2 * ch2) = pk2(x0, x1);
                XF[tl * 256 + 2 * ch2] = x0; XF[tl * 256 + 2 * ch2 + 1] = x1; }
        }
        SYNC();
        float CA[2] = {1.f, 1.f}, CU[2] = {0.f, 0.f};
#pragma unroll 1
        for (int m = 0; m < 4; ++m) {
            f32x4 acc[2][2];
#pragma unroll
            for (int gg = 0; gg < 2; ++gg)
#pragma unroll
                for (int nt = 0; nt < 2; ++nt) acc[gg][nt] = (f32x4){0.f, 0.f, 0.f, 0.f};
#pragma unroll
            for (int ks = 0; ks < 2; ++ks) { const bf16x8 A = *(const bf16x8*)(XB + (m * 16 + i16) * XB_STRIDE + blk * 64 + ks * 32 + 8 * g);
#pragma unroll
                for (int gg = 0; gg < 2; ++gg)
#pragma unroll
                    for (int nt = 0; nt < 2; ++nt) acc[gg][nt] = MFMA16(A, Bf[gg][nt][ks], acc[gg][nt]); }
            float HL[2][4], CP[2][4];
            const int chb = blk * 64 + nh * 32 + 2 * i16;
            float xf[4][2];
#pragma unroll
            for (int r = 0; r < 4; ++r) { const float* xp = XF + (m * 16 + 4 * g + r) * 256 + chb; xf[r][0] = xp[0]; xf[r][1] = xp[1]; }
#pragma unroll
            for (int nt = 0; nt < 2; ++nt) {
                float P[4], H[4]; float pa = 1.f, hu = 0.f;
#pragma unroll
                for (int r = 0; r < 4; ++r) {
                    const float rg = fsigmoid(acc[0][nt][r] + ba[nt]), gi = fsigmoid(acc[1][nt][r] + bx[nt]);
                    const float la = -8.0f * rg * sp[nt], a = FEXP(la), uu = FSQRT((1.0f - a) * (1.0f + a)) * (gi * xf[r][nt]);
                    pa = a * pa; hu = a * hu + uu; P[r] = pa; H[r] = hu;
                    }
                float EA = 1.f, EU = 0.f, TA = 1.f, TU = 0.f;
#pragma unroll
                for (int gg = 0; gg < 4; ++gg) { const float ta = SHFL(pa, i16 + 16 * gg), tu = SHFL(hu, i16 + 16 * gg);
                    if (gg < g) { EU = ta * EU + tu; EA = ta * EA; }
                    TU = ta * TU + tu; TA = ta * TA; }
                const float XA = EA * CA[nt], XU = EA * CU[nt] + EU;
#pragma unroll
                for (int r = 0; r < 4; ++r) { HL[nt][r] = P[r] * XU + H[r]; CP[nt][r] = P[r] * XA; }
                CU[nt] = TA * CU[nt] + TU; CA[nt] = TA * CA[nt];
            }
#pragma unroll
            for (int r = 0; r < 4; ++r) { const size_t o = (m0 + m * 16 + 4 * g + r) * 256 + chb;
                *(unsigned*)(HLOC + o) = pk2(HL[0][r], HL[1][r]); *(unsigned*)(CPA + o) = pk2(CP[0][r], CP[1][r]); }
        }
        if (g == 0) {
#pragma unroll
            for (int nt = 0; nt < 2; ++nt) { const int ch = blk * 64 + nh * 32 + 2 * i16 + nt;
                LSUM[((size_t)b * 64 + c) * 256 + ch] = CA[nt]; LSUM[(size_t)BATCH * 64 * 256 + ((size_t)b * 64 + c) * 256 + ch] = CU[nt]; }
        }
        SYNC();
    }
}

DEV float gelu_tanh(float x) { const float z = 0.7978845608028654f * (x + 0.044715f * x * x * x); return x * FRCP(1.0f + FEXP(-2.0f * z)); }
DEV void ph_carry(const Ctx& F) {
    if (F.wave != 0) return;
    const float* LSUM = (const float*)(F.ws + WS_LSUM); float* CARRY = (float*)(F.ws + WS_CARRY);
    const int seg = F.lane & 3;
    for (int chain = F.bid * 16 + (F.lane >> 2); chain < BATCH * 256; chain += F.G * 16) {
        const int b = chain >> 8, ch = chain & 255; const size_t o0 = ((size_t)b * 64 + seg * 16) * 256 + ch;
        float a[16], hb[16];
#pragma unroll
        for (int i = 0; i < 16; ++i) { a[i] = LSUM[o0 + (size_t)i * 256]; hb[i] = LSUM[(size_t)BATCH * 64 * 256 + o0 + (size_t)i * 256]; }
        float hp[16], ap[16], hl = 0.f, al = 1.f;
#pragma unroll
        for (int i = 0; i < 16; ++i) { hp[i] = hl; ap[i] = al; hl = a[i] * hl + hb[i]; al = a[i] * al; }
        float cin = 0.f;
#pragma unroll
        for (int s2 = 0; s2 < 3; ++s2) { const float as = SHFL(al, (F.lane & ~3) + s2), hs = SHFL(hl, (F.lane & ~3) + s2); if (s2 < seg) cin = as * cin + hs; }
#pragma unroll
        for (int i = 0; i < 16; ++i) CARRY[o0 + (size_t)i * 256] = ap[i] * cin + hp[i];
    }
}
DEV void ph_lru2(const Ctx& F, int l) {
    const int tid = F.tid, lane = F.lane, w = F.wave;
    const bf16* PROJ = (const bf16*)(F.ws + WS_PROJ); const bf16* HLOC = (const bf16*)(F.ws + WS_HLOC); const bf16* CPA = (const bf16*)(F.ws + WS_CPA);
    const float* CARRY = (const float*)(F.ws + WS_CARRY); bf16* CAT = (bf16*)(F.ws + WS_CAT);
    const f32x4 gw4 = *(const f32x4*)(PIN(F, I_GNW) + l * DM + 4 * lane);
    for (int u = F.bid; u < BATCH * 64; u += F.G) {
        const int b = u >> 6, c = u & 63; const size_t m0 = (size_t)b * SEQ + c * 64;
        const f32x4 car = *(const f32x4*)(CARRY + (size_t)u * 256 + 4 * lane);
        u32x2 hl8[8], cp8[8], ly8[8];
#pragma unroll
        for (int tt = 0; tt < 8; ++tt) { const size_t m = m0 + w * 8 + tt;
            hl8[tt] = *(const u32x2*)(HLOC + m * 256 + 4 * lane); cp8[tt] = *(const u32x2*)(CPA + m * 256 + 4 * lane); ly8[tt] = *(const u32x2*)(PROJ + m * NPROJ + PC_LY + 4 * lane); }
#pragma unroll
        for (int tt = 0; tt < 8; ++tt) { const size_t m = m0 + w * 8 + tt; const u32x2 hl = hl8[tt], cp = cp8[tt], ly = ly8[tt];
            float v0 = (bflo(hl.x) + bflo(cp.x) * car.x) * gelu_tanh(bflo(ly.x));
            float v1 = (bfhi(hl.x) + bfhi(cp.x) * car.y) * gelu_tanh(bfhi(ly.x));
            float v2 = (bflo(hl.y) + bflo(cp.y) * car.z) * gelu_tanh(bflo(ly.y));
            float v3 = (bfhi(hl.y) + bfhi(cp.y) * car.w) * gelu_tanh(bfhi(ly.y));
            const float rs = RSQ(wave_sum((v0 * v0 + v1 * v1) + (v2 * v2 + v3 * v3)) * (1.0f / 256.0f) + NORM_EPS);
            u32x2 o; o.x = pk2(v0 * rs * gw4.x, v1 * rs * gw4.y); o.y = pk2(v2 * rs * gw4.z, v3 * rs * gw4.w);
            *(u32x2*)(CAT + m * DM + 4 * lane) = o; }
    }
}

constexpr int QS_STRIDE = 136, VE_STRIDE = 56;
DEV void ph_mlstm(const Ctx& F, int l) {
    const int tid = F.tid, lane = F.lane, w = F.wave, i16 = lane & 15, g = lane >> 4;
    bf16* QsB = (bf16*)F.lds;
    bf16* KsB = QsB + 2 * 64 * QS_STRIDE;
    bf16* VE = KsB + 2 * 64 * QS_STRIDE;
    bf16* VW = VE + 64 * VE_STRIDE;
    bf16* CsB = VW + 64 * VE_STRIDE;
    float* BCB = (float*)(CsB + 2 * 128 * VE_STRIDE);
    float* BIB = BCB + 128;
    const bf16* PROJ = (const bf16*)(F.ws + WS_PROJ); bf16* HM = (bf16*)(F.ws + WS_HM);
    const float qscale = 0.08838834764831845f;
    const int jt = w & 3, half = w >> 2;
    for (int u = F.bid; u < BATCH * 4 * 4; u += F.G) {
        const int b = u >> 4, h = (u >> 2) & 3, vs = u & 3;
        const float gbi = PIN(F, I_BI)[l * 4 + h], gbf = PIN(F, I_BF)[l * 4 + h];
        f32x4 accC[3];
#pragma unroll
        for (int nt = 0; nt < 3; ++nt) accC[nt] = (f32x4){0.f, 0.f, 0.f, 0.f};
        float* BCg = (float*)(F.ws + WS_MG) + (size_t)u * 8192; float* BIg = BCg + 4096;
        unsigned gri[8], grf[8];
#pragma unroll
        for (int k = 0; k < 8; ++k) { const bf16* pr = PROJ + ((size_t)b * SEQ + (8 * k + w) * 64 + lane) * NPROJ; gri[k] = pr[PC_MI + h]; grf[k] = pr[PC_MF + h]; }
#pragma unroll
        for (int k = 0; k < 8; ++k) { const int tok = (8 * k + w) * 64 + lane;
            const float zi = (bf2f(gri[k]) + gbi) * (1.0f / 15.0f), zf = (bf2f(grf[k]) + gbf) * (1.0f / 15.0f);
            const float ig = 15.0f - 30.0f * FRCP(FEXP(2.0f * zi) + 1.0f), fg = 15.0f - 30.0f * FRCP(FEXP(2.0f * zf) + 1.0f);
            float s = -FLOG(1.0f + FEXP(-fg));
#pragma unroll
            for (int o = 1; o < 64; o <<= 1) { const float t = SHFL_UP(s, o); if (lane >= o) s += t; }
            BCg[tok] = s; BIg[tok] = s - ig; }
        SYNC();
        u32x4 rq[2], rk[2]; u32x2 rvv; float rgc = 0.f, rgb = 0.f;
        {
            const size_t m0 = (size_t)b * SEQ;
#pragma unroll
            for (int i = 0; i < 2; ++i) { const int idx = tid + 512 * i, row = idx >> 4, ck = idx & 15;
                rq[i] = *(const u32x4*)(PROJ + (m0 + row) * NPROJ + PC_MQ + h * 128 + 8 * ck); rk[i] = *(const u32x4*)(PROJ + (m0 + row) * NPROJ + PC_MK + h * 128 + 8 * ck); }
            rvv = *(const u32x2*)(PROJ + (m0 + (tid >> 3)) * NPROJ + PC_MV + h * 128 + vs * 32 + 4 * (tid & 7));
            if (tid < 64) { rgc = BCg[tid]; rgb = BIg[tid]; }
        }
        for (int c = 0; c < 64; ++c) {
            const size_t m0 = (size_t)b * SEQ + c * 64; const int buf = c & 1;
            bf16* Qs = QsB + buf * 64 * QS_STRIDE; bf16* Ks = KsB + buf * 64 * QS_STRIDE; const bf16* Cs = CsB + buf * 128 * VE_STRIDE; bf16* Cn = CsB + (buf ^ 1) * 128 * VE_STRIDE;
            float* BC = BCB + buf * 64; float* BI = BIB + buf * 64;
#pragma unroll
            for (int i = 0; i < 2; ++i) { const int idx = tid + 512 * i, row = idx >> 4, ck = idx & 15;
                *(u32x4*)(Qs + row * QS_STRIDE + 8 * ck) = rq[i]; *(u32x4*)(Ks + row * QS_STRIDE + 8 * ck) = rk[i]; }
            if (tid < 64) { BC[tid] = rgc; BI[tid] = rgb; }
            SYNC();
            {
                const int row = tid >> 3, cg = tid & 7;
                const u32x2 rv = rvv;
                const float wt = FEXP(BC[63] - BI[row]);
                *(u32x2*)(VE + row * VE_STRIDE + 4 * cg) = rv;
                u32x2 sv; sv.x = pk2(bflo(rv.x) * wt, bfhi(rv.x) * wt); sv.y = pk2(bflo(rv.y) * wt, bfhi(rv.y) * wt);
                *(u32x2*)(VW + row * VE_STRIDE + 4 * cg) = sv;
                if (cg == 0) { unsigned one_ = 0x3f80u; LAUNDER_V(one_); u32x4 z = (u32x4){one_, 0u, 0u, 0u}; *(u32x4*)(VE + row * VE_STRIDE + 32) = z; *(u32x4*)(VE + row * VE_STRIDE + 40) = (u32x4){0u, 0u, 0u, 0u};
                    z.x = f2bf(wt); *(u32x4*)(VW + row * VE_STRIDE + 32) = z; *(u32x4*)(VW + row * VE_STRIDE + 40) = (u32x4){0u, 0u, 0u, 0u}; }
            }
            if (c + 1 < 64) {
                const size_t m1 = m0 + 64;
#pragma unroll
                for (int i = 0; i < 2; ++i) { const int idx = tid + 512 * i, row = idx >> 4, ck = idx & 15;
                    rq[i] = *(const u32x4*)(PROJ + (m1 + row) * NPROJ + PC_MQ + h * 128 + 8 * ck); rk[i] = *(const u32x4*)(PROJ + (m1 + row) * NPROJ + PC_MK + h * 128 + 8 * ck); }
                rvv = *(const u32x2*)(PROJ + (m1 + (tid >> 3)) * NPROJ + PC_MV + h * 128 + vs * 32 + 4 * (tid & 7));
                if (tid < 64) { rgc = BCg[(c + 1) * 64 + tid]; rgb = BIg[(c + 1) * 64 + tid]; }
            }
            SYNC();
            f32x4 Z[2] = {(f32x4){0.f, 0.f, 0.f, 0.f}, (f32x4){0.f, 0.f, 0.f, 0.f}};
            {
                bf16x8 Bq[4];
#pragma unroll
                for (int ks = 0; ks < 4; ++ks) Bq[ks] = *(const bf16x8*)(Qs + (16 * jt + i16) * QS_STRIDE + 32 * ks + 8 * g);
                const float bj = BC[16 * jt + i16];
                unsigned pk[4][2];
#pragma unroll
                for (int tt = 0; tt < 4; ++tt) {
                    if (tt <= jt) {
                        f32x4 X = (f32x4){0.f, 0.f, 0.f, 0.f};
#pragma unroll
                        for (int ks = 0; ks < 4; ++ks) X = MFMA16(*(const bf16x8*)(Ks + (16 * tt + i16) * QS_STRIDE + 32 * ks + 8 * g), Bq[ks], X);
                        float p[4]; const f32x4 bi4 = *(const f32x4*)(BI + 16 * tt + 4 * g);
#pragma unroll
                        for (int r = 0; r < 4; ++r) { const float pv = X[r] * qscale * FEXP(fminf(bj - bi4[r], 60.0f));
                            p[r] = (tt < jt || 4 * g + r <= i16) ? pv : 0.f; }
                        pk[tt][0] = pk2(p[0], p[1]); pk[tt][1] = pk2(p[2], p[3]);
                    } else { pk[tt][0] = 0u; pk[tt][1] = 0u; }
                }
#pragma unroll
                for (int pr = 0; pr < 2; ++pr) {
                    if (2 * pr <= jt) {
                        u32x4 aw = (u32x4){pk[2 * pr][0], pk[2 * pr][1], pk[2 * pr + 1][0], pk[2 * pr + 1][1]};
                        const bf16x8 A = __builtin_bit_cast(bf16x8, aw);
#pragma unroll
                        for (int n = 0; n < 2; ++n) { const int ntc = n ? 2 : half;
                            const s16x4 lo = TR16(VE + (32 * pr + 4 * g + (i16 >> 2)) * VE_STRIDE + 16 * ntc + 4 * (i16 & 3));
                            const s16x4 hi = TR16(VE + (32 * pr + 16 + 4 * g + (i16 >> 2)) * VE_STRIDE + 16 * ntc + 4 * (i16 & 3));
                            const bf16x8 B = (bf16x8){lo[0], lo[1], lo[2], lo[3], hi[0], hi[1], hi[2], hi[3]};
                            Z[n] = MFMA16(A, B, Z[n]); }
#ifndef HOST_EMU
                        asm volatile("" :: "v"(aw));
#endif
                    }
                }
            }
            if (c > 0) {
                f32x4 Z2[2] = {(f32x4){0.f, 0.f, 0.f, 0.f}, (f32x4){0.f, 0.f, 0.f, 0.f}};
#pragma unroll
                for (int ks = 0; ks < 4; ++ks) { const bf16x8 A = *(const bf16x8*)(Qs + (16 * jt + i16) * QS_STRIDE + 32 * ks + 8 * g);
#pragma unroll
                    for (int n = 0; n < 2; ++n) { const int ntc = n ? 2 : half;
                        const s16x4 lo = TR16(Cs + (32 * ks + 8 * g + (i16 >> 2)) * VE_STRIDE + 16 * ntc + 4 * (i16 & 3));
                        const s16x4 hi = TR16(Cs + (32 * ks + 8 * g + 4 + (i16 >> 2)) * VE_STRIDE + 16 * ntc + 4 * (i16 & 3));
                        const bf16x8 B = (bf16x8){lo[0], lo[1], lo[2], lo[3], hi[0], hi[1], hi[2], hi[3]};
                        Z2[n] = MFMA16(A, B, Z2[n]); } }
                const f32x4 bc4 = *(const f32x4*)(BC + 16 * jt + 4 * g);
#pragma unroll
                for (int r = 0; r < 4; ++r) { const float f = qscale * FEXP(bc4[r]); Z[0][r] += f * Z2[0][r]; Z[1][r] += f * Z2[1][r]; }
            }
#pragma unroll
            for (int r = 0; r < 4; ++r) { const int j = 16 * jt + 4 * g + r; const float dn = FRCP(fmaxf(fabsf(SHFL(Z[1][r], lane & 48)), 1.0f));
                HM[(m0 + j) * 512 + h * 128 + vs * 32 + 16 * half + i16] = (bf16)f2bf(Z[0][r] * dn); }
            {
                const float dec = FEXP(BC[63]);
#pragma unroll
                for (int nt = 0; nt < 3; ++nt) accC[nt] = accC[nt] * dec;
#pragma unroll
                for (int ks = 0; ks < 2; ++ks) {
                    const s16x4 alo = TR16(Ks + (32 * ks + 8 * g + (i16 >> 2)) * QS_STRIDE + 16 * w + 4 * (i16 & 3));
                    const s16x4 ahi = TR16(Ks + (32 * ks + 8 * g + 4 + (i16 >> 2)) * QS_STRIDE + 16 * w + 4 * (i16 & 3));
                    const bf16x8 A = (bf16x8){alo[0], alo[1], alo[2], alo[3], ahi[0], ahi[1], ahi[2], ahi[3]};
#pragma unroll
                    for (int nt = 0; nt < 3; ++nt) {
                        const s16x4 lo = TR16(VW + (32 * ks + 8 * g + (i16 >> 2)) * VE_STRIDE + 16 * nt + 4 * (i16 & 3));
                        const s16x4 hi = TR16(VW + (32 * ks + 8 * g + 4 + (i16 >> 2)) * VE_STRIDE + 16 * nt + 4 * (i16 & 3));
                        const bf16x8 B = (bf16x8){lo[0], lo[1], lo[2], lo[3], hi[0], hi[1], hi[2], hi[3]};
                        const f32x4 cold = accC[nt]; accC[nt] = MFMA16(A, B, cold);
#ifndef HOST_EMU
                        asm volatile("" :: "v"(cold), "v"(A), "v"(B));
#endif
                    }
                }
#pragma unroll
                for (int nt = 0; nt < 3; ++nt)
#pragma unroll
                    for (int r = 0; r < 4; ++r) Cn[(16 * w + 4 * g + r) * VE_STRIDE + 16 * nt + i16] = (bf16)f2bf(accC[nt][r]);
            }
        }
        SYNC();
    }
}

DEV void ph_mfin(const Ctx& F, int l) {
    const int gw = F.bid * 8 + F.wave, NGW = F.G * 8, lane = F.lane;
    const bf16* PROJ = (const bf16*)(F.ws + WS_PROJ); const bf16* HM = (const bf16*)(F.ws + WS_HM); bf16* CAT = (bf16*)(F.ws + WS_CAT);
    float gm[8];
#pragma unroll
    for (int j = 0; j < 8; ++j) gm[j] = PIN(F, I_GNW)[l * DM + 256 + 8 * lane + j];
    u32x4 hv4[4], ov4[4], hvn[4], ovn[4];
#define MFIN_LOAD(HV, OV, M0) do { _Pragma("unroll") for (int q = 0; q < 4; ++q) { const int mm = (M0) + q * NGW; const size_t ms = (size_t)(mm < MTOK ? mm : 0); \
            HV[q] = *(const u32x4*)(HM + ms * 512 + 8 * lane); OV[q] = *(const u32x4*)(PROJ + ms * NPROJ + PC_MO + 8 * lane); } } while (0)
    MFIN_LOAD(hv4, ov4, gw);
    for (int m0 = gw; m0 < MTOK; m0 += 4 * NGW) {
        MFIN_LOAD(hvn, ovn, m0 + 4 * NGW);
#pragma unroll
        for (int q = 0; q < 4; ++q) { const int m = m0 + q * NGW; if (m >= MTOK) break;
            const u32x4 hv = hv4[q], ov = ov4[q];
            float v[8] = {bflo(hv.x), bfhi(hv.x), bflo(hv.y), bfhi(hv.y), bflo(hv.z), bfhi(hv.z), bflo(hv.w), bfhi(hv.w)};
            const float o[8] = {bflo(ov.x), bfhi(ov.x), bflo(ov.y), bfhi(ov.y), bflo(ov.z), bfhi(ov.z), bflo(ov.w), bfhi(ov.w)};
            float s = 0.f;
#pragma unroll
            for (int j = 0; j < 8; ++j) s += v[j] * v[j];
            s += SHFL_XOR(s, 1); s += SHFL_XOR(s, 2); s += SHFL_XOR(s, 4); s += SHFL_XOR(s, 8);
            const float rs = RSQ(s * (1.0f / 128.0f) + NORM_EPS);
            u32x4 r;
            r.x = pk2(v[0] * rs * gm[0] * fsigmoid(o[0]), v[1] * rs * gm[1] * fsigmoid(o[1]));
            r.y = pk2(v[2] * rs * gm[2] * fsigmoid(o[2]), v[3] * rs * gm[3] * fsigmoid(o[3]));
            r.z = pk2(v[4] * rs * gm[4] * fsigmoid(o[4]), v[5] * rs * gm[5] * fsigmoid(o[5]));
            r.w = pk2(v[6] * rs * gm[6] * fsigmoid(o[6]), v[7] * rs * gm[7] * fsigmoid(o[7]));
            *(u32x4*)(CAT + (size_t)m * DM + 256 + 8 * lane) = r; }
#pragma unroll
        for (int q = 0; q < 4; ++q) { hv4[q] = hvn[q]; ov4[q] = ovn[q]; }
    }
#undef MFIN_LOAD
}

constexpr int DS_HIST = 0;
constexpr int DS_MASK = 49152;
constexpr int DS_CAND = 65536;
constexpr int DS_SELL = 102400;
constexpr int DS_META = 118784;
constexpr int DS_RB = DS_META + 512;
constexpr int DS_SS = DS_RB + 2048;
constexpr int DS_SLOT = 12800;
constexpr int NBIN = 768, CAND_CAP = 128;
__device__ const unsigned char T5B[114] = {0, 1, 2, 3, 4, 5, 6, 7, 8, 9, 10, 11, 12, 13, 14, 15, 16, 16, 16, 17, 17, 18, 18, 18, 19, 19, 19, 20, 20, 20, 20, 21, 21, 21, 21, 22, 22, 22, 22, 22, 23, 23, 23, 23, 23, 23, 24, 24, 24, 24, 24, 24, 25, 25, 25, 25, 25, 25, 25, 26, 26, 26, 26, 26, 26, 26, 26, 27, 27, 27, 27, 27, 27, 27, 27, 27, 27, 28, 28, 28, 28, 28, 28, 28, 28, 28, 28, 29, 29, 29, 29, 29, 29, 29, 29, 29, 29, 29, 29, 30, 30, 30, 30, 30, 30, 30, 30, 30, 30, 30, 30, 30, 30, 31};

DEV int score_bin(float sc) {
    const unsigned u = __builtin_bit_cast(unsigned, sc);
    int e = (int)((u >> 18) & 0x1FFFu) - 119 * 32; e = e < 0 ? 0 : (e > 383 ? 383 : e);
    return (u >> 31) ? 383 - e : 384 + e;
}
DEV unsigned score_key(float sc) { const unsigned u = __builtin_bit_cast(unsigned, sc); return (u >> 31) ? ~u : (u | 0x80000000u); }
DEV unsigned score_code(float sc) {
    const unsigned u = __builtin_bit_cast(unsigned, sc);
    int e = (int)((u >> 18) & 0x1FFFu) - 119 * 32; e = e < 0 ? 0 : (e > 383 ? 383 : e);
    return ((u >> 16) & 0x8000u) | ((unsigned)e << 6) | ((u >> 12) & 63u);
}
DEV int code_bin(unsigned c) { const int e = (int)((c >> 6) & 0x1FFu); return (c & 0x8000u) ? 383 - e : 384 + e; }
DEV unsigned code_key(unsigned c) { return (c & 0x8000u) ? 63u - (c & 63u) : (c & 63u); }


DEV f32x4 dsa_score_tile(const bf16x8 A, const bf16x8 (&QS)[2], const bf16x8 (&Bq)[8], const float (&wq)[8]) {
    f32x4 sc = (f32x4){0.f, 0.f, 0.f, 0.f};
#pragma unroll
    for (int h = 0; h < 8; ++h) { const f32x4 d = MFMA16(A, Bq[h], (f32x4){0.f, 0.f, 0.f, 0.f});
#pragma unroll
        for (int r = 0; r < 4; ++r) sc[r] += wq[h] * RELU(d[r]); }
    return sc;
}
DEV void ph_dsa(const Ctx& F, int l) {
    const int tid = F.tid, lane = F.lane, w = F.wave, i16 = lane & 15, g = lane >> 4;
    unsigned* HIST = (unsigned*)(F.lds + DS_HIST); unsigned* MASK = (unsigned*)(F.lds + DS_MASK); u32x2* CAND = (u32x2*)(F.lds + DS_CAND);
    unsigned short* SELL = (unsigned short*)(F.lds + DS_SELL); int* BST = (int*)(F.lds + DS_META); int* NAB = BST + 32; int* NCAND = BST + 64; int* NSEL = BST + 96;
    float* RB = (float*)(F.lds + DS_RB);
    const bf16* QIDX = (const bf16*)(F.ws + WS_QIDX); const bf16* KIDX = (const bf16*)(F.ws + WS_KIDX); const float* WI = (const float*)(F.ws + WS_WI);
    const bf16* QABS = (const bf16*)(F.ws + WS_QABS); const bf16* CKV = (const bf16*)(F.ws + WS_CKV); bf16* CAT = (bf16*)(F.ws + WS_CAT);
    const bf16* WUVT = (const bf16*)(F.ws + WS_WUVT) + (size_t)l * 4 * 64 * 128; float* SS = (float*)(F.lds + DS_SS);
    for (int e = tid; e < 114 * 4; e += 512) RB[e] = PIN(F, I_RELB)[T5B[e >> 2] * 4 + (e & 3)] * 1.4426950408889634f;
    SYNC();
    for (int ui = F.bid; ui < BATCH * 128; ui += F.G) {
        int b, qt; { const int wv = ui & 255, k = ui >> 8, r = wv & 15; b = wv >> 4; qt = (k & 1) ? (32 * (k >> 1) + 31 - r) : (32 * (k >> 1) + r); }
        const int t0 = 32 * qt, nkt = 2 * qt + 2; const size_t mb = (size_t)b * SEQ;
        const GAS char* const ckvb = UNIP(CKV + mb * 128);
        const int nt = w & 1;
        u32x2* sw = (u32x2*)(F.ws + (F.bid < 128 ? WS_QL + (size_t)F.bid * 262144 : WS_SCR2 + (size_t)(F.bid - 128) * 262144) + (size_t)w * 32768) + lane;
        bf16x8 Bq[8]; float wq[8];
        { const size_t mq = mb + t0 + 16 * nt + i16;
#pragma unroll
            for (int h = 0; h < 8; ++h) { Bq[h] = *(const bf16x8*)(QIDX + mq * 256 + 32 * h + 8 * g); wq[h] = WI[mq * 8 + h]; } }
        bf16x8 QS[2];
#pragma unroll
        for (int j = 0; j < 8; ++j) { float s = 0.f;
#pragma unroll
            for (int h = 0; h < 8; ++h) s += wq[h] * bf2f((unsigned)(unsigned short)Bq[h][j]);
            const unsigned hi = f2bf(s); QS[0][j] = (short)hi; QS[1][j] = (short)f2bf(s - bf2f(hi)); }
        for (int e = tid; e < 16 * NBIN; e += 512) HIST[e] = 0u;
        for (int e = tid; e < 32 * 128; e += 512) MASK[e] = 0u;
        if (tid < 32) NCAND[tid] = 0;
        SYNC();
        bf16x8 Apre = *(const bf16x8*)(KIDX + (mb + 16 * (w >> 1) + i16) * 32 + 8 * g);
        for (int kt = w >> 1; kt < nkt; kt += 4) {
            const bf16x8 A = Apre;
            { const int kn = kt + 4 < nkt ? kt + 4 : kt; Apre = *(const bf16x8*)(KIDX + (mb + 16 * kn + i16) * 32 + 8 * g); }
            const f32x4 sc = dsa_score_tile(A, QS, Bq, wq);
            unsigned cd[4];
#pragma unroll
            for (int r = 0; r < 4; ++r) cd[r] = score_code(sc[r] + 0.0f);
            { u32x2 pk; pk.x = cd[0] | (cd[1] << 16); pk.y = cd[2] | (cd[3] << 16); sw[(size_t)((kt - (w >> 1)) >> 2) * 64] = pk; }
            const unsigned inc = nt ? 65536u : 1u;
            if (kt < 2 * qt) {
#pragma unroll
                for (int r = 0; r < 4; ++r) atomicAdd(&HIST[i16 * NBIN + code_bin(cd[r])], inc);
            } else {
                const int t = t0 + 16 * nt + i16;
#pragma unroll
                for (int r = 0; r < 4; ++r) { const int s = 16 * kt + 4 * g + r;
                    if (s <= t) atomicAdd(&HIST[i16 * NBIN + code_bin(cd[r])], inc); }
            }
        }
        SYNC();
#pragma unroll 1
        for (int rr = 0; rr < 4; ++rr) {
            const int row = 4 * w + rr, t = t0 + row;
            if (t < 256) { if (lane == 0) { BST[row] = -1; NAB[row] = t + 1; } continue; }
            const int sh = (row >> 4) * 16; const unsigned* hp = HIST + (row & 15) * NBIN + 12 * lane;
            int cnt[12]; int tot = 0;
#pragma unroll
            for (int i = 0; i < 12; ++i) { cnt[i] = (int)((hp[i] >> sh) & 0xFFFFu); tot += cnt[i]; }
            int suf = tot;
#pragma unroll
            for (int o = 1; o < 64; o <<= 1) { const int v = SHFL_DOWN(suf, o); if (lane + o < 64) suf += v; }
            const int above = suf - tot;
            if (above < 256 && above + tot >= 256) {
                int run = above, bs = -1, na = 0; bool done = false;
#pragma unroll
                for (int i = 11; i >= 0; --i) { if (!done) { if (run + cnt[i] >= 256) { bs = 12 * lane + i; na = run; done = true; } else run += cnt[i]; } }
                BST[row] = bs; NAB[row] = na;
            }
        }
        SYNC();
        { const int row = 16 * nt + i16, t = t0 + row, bs = BST[row];
        const int ntl = nkt > (w >> 1) ? ((nkt - 1 - (w >> 1)) >> 2) + 1 : 0;
        u32x2 P0 = sw[0], P1 = sw[(size_t)(1 < ntl ? 1 : 0) * 64];
        for (int j = 0; j < ntl; ++j) { const int kt = (w >> 1) + 4 * j;
            const u32x2 pc = P0; P0 = P1; P1 = sw[(size_t)(j + 2 < ntl ? j + 2 : j) * 64];
            const bool full = kt < 2 * qt;
#pragma unroll
            for (int r = 0; r < 4; ++r) { const int s = 16 * kt + 4 * g + r;
                if (full || s <= t) { const unsigned wd = r < 2 ? pc.x : pc.y; const unsigned c = (r & 1) ? (wd >> 16) : (wd & 0xffffu); const int bn = code_bin(c);
                    if (bn > bs) atomicOr(&MASK[row * 128 + (s >> 5)], 1u << (s & 31));
                    else if (bn == bs) { const int pos = (int)atomicAdd((unsigned*)&NCAND[row], 1u); if (pos < CAND_CAP) CAND[row * CAND_CAP + pos] = (u32x2){code_key(c), (unsigned)s}; } } }
        } }
        SYNC();
#pragma unroll 1
        for (int rr = 0; rr < 4; ++rr) {
            const int row = 4 * w + rr; if (BST[row] < 0) continue;
            const int n = NCAND[row] < CAND_CAP ? NCAND[row] : CAND_CAP, need = 256 - NAB[row];
            for (int i = lane; i < n; i += 64) { const u32x2 me = CAND[row * CAND_CAP + i]; int rank = 0;
                for (int j = 0; j < n; ++j) { const u32x2 o = CAND[row * CAND_CAP + j]; rank += (o.x > me.x || (o.x == me.x && o.y < me.y)) ? 1 : 0; }
#ifndef DSA_DBG_NOCAND
                if (rank < need) atomicOr(&MASK[row * 128 + (me.y >> 5)], 1u << (me.y & 31));
#endif
            }
        }
        SYNC();
#ifdef DSA_DBG_SEL
        for (int e = tid; e < 32 * 128; e += 512) { const int row = e >> 7, wi = e & 127, t = t0 + row, lo = t - 255 < 0 ? 0 : t - 255; unsigned m = 0u;
            for (int bq = 0; bq < 32; ++bq) { const int s = 32 * wi + bq; if (s >= lo && s <= t) m |= 1u << bq; }
            MASK[e] = m; }
        SYNC();
#endif
#pragma unroll 1
        for (int rr = 0; rr < 4; ++rr) {
            const int row = 4 * w + rr;
            unsigned w0 = MASK[row * 128 + 2 * lane], w1 = MASK[row * 128 + 2 * lane + 1];
            const int c = __builtin_popcount(w0) + __builtin_popcount(w1);
            int inc = c;
#pragma unroll
            for (int o = 1; o < 64; o <<= 1) { const int v = SHFL_UP(inc, o); if (lane >= o) inc += v; }
            int pos = inc - c;
            while (w0) { const int bt = __builtin_ctz(w0); w0 &= w0 - 1; if (pos < 256) SELL[row * 256 + pos] = (unsigned short)(64 * lane + bt); ++pos; }
            while (w1) { const int bt = __builtin_ctz(w1); w1 &= w1 - 1; if (pos < 256) SELL[row * 256 + pos] = (unsigned short)(64 * lane + 32 + bt); ++pos; }
            if (lane == 63) NSEL[row] = inc < 256 ? inc : 256;
        }
        SYNC();
        bf16* TL = (bf16*)(F.lds + w * DS_SLOT); bf16* OLw = (bf16*)(F.lds + w * DS_SLOT + 8704);
#pragma unroll 1
        for (int rr = 0; rr < 4; ++rr) {
            const int row = 4 * w + rr, t = t0 + row, ns = UNI(NSEL[row]); const size_t mt = mb + t;
            const unsigned short* sl = SELL + row * 256;
            bf16x8 Bh[4];
#pragma unroll
            for (int ks = 0; ks < 4; ++ks) Bh[ks] = i16 < 4 ? *(const bf16x8*)(QABS + mt * 512 + i16 * 128 + 32 * ks + 8 * g) : (bf16x8){0, 0, 0, 0, 0, 0, 0, 0};
            f32x4 O[8];
#pragma unroll
            for (int nt = 0; nt < 8; ++nt) O[nt] = (f32x4){0.f, 0.f, 0.f, 0.f};
            float mrun = -1e30f, lrun = 0.f;
            const float bfar = RB[113 * 4 + (i16 & 3)];
            const int nch = (ns + 31) >> 5;
            u32x4 gvA[8];
#define ATT_LOAD(GV, CK, FULL) do { int sidx[8]; \
                _Pragma("unroll") for (int i = 0; i < 8; ++i) sidx[i] = (int)sl[32 * (CK) + 4 * i + g];            \
                _Pragma("unroll") for (int i = 0; i < 8; ++i) { const int kp = 32 * (CK) + 4 * i + g; sidx[i] = (FULL || kp < ns) ? sidx[i] : 0; } \
                _Pragma("unroll") for (int i = 0; i < 8; ++i) GV[i] = *(const GAS u32x4*)(ckvb + (((unsigned)sidx[i] << 8) + 16u * (unsigned)i16)); } while (0)
#define ATT_STEP(GV, CK, FULL) do { const int ck = (CK); \
                _Pragma("unroll") for (int i = 0; i < 8; ++i) *(u32x4*)(TL + (4 * i + g) * 136 + 8 * i16) = GV[i]; \
                const u32x2 sk0 = *(const u32x2*)(sl + 32 * ck + 4 * g), sk1 = *(const u32x2*)(sl + 32 * ck + 16 + 4 * g); \
                WAVE_LDS_FENCE(); \
                if (ck + 1 < nch) ATT_LOAD(GV, ck + 1, FULL); \
                float bia[2][4]; \
                if (FULL && t - UNI((int)sl[32 * ck + 31]) >= 113) {                   \
                _Pragma("unroll") for (int kt = 0; kt < 2; ++kt) \
                _Pragma("unroll") for (int r = 0; r < 4; ++r) bia[kt][r] = bfar; \
                } else { \
                _Pragma("unroll") for (int kt = 0; kt < 2; ++kt) \
                _Pragma("unroll") for (int r = 0; r < 4; ++r) { const unsigned wd = kt ? (r < 2 ? sk1.x : sk1.y) : (r < 2 ? sk0.x : sk0.y); \
                        int dist = t - (int)((wd >> (16 * (r & 1))) & 0xffffu); dist = dist < 0 ? 0 : (dist > 113 ? 113 : dist); \
                        bia[kt][r] = RB[dist * 4 + (i16 & 3)]; } } \
                f32x4 lg[2]; \
                _Pragma("unroll") for (int kt = 0; kt < 2; ++kt) { lg[kt] = (f32x4){0.f, 0.f, 0.f, 0.f}; \
                _Pragma("unroll") for (int ks = 0; ks < 4; ++ks) lg[kt] = MFMA16(*(const bf16x8*)(TL + (16 * kt + i16) * 136 + 32 * ks + 8 * g), Bh[ks], lg[kt]); } \
                float cm = -1e30f; \
                _Pragma("unroll") for (int kt = 0; kt < 2; ++kt) \
                _Pragma("unroll") for (int r = 0; r < 4; ++r) { const int kp = 32 * ck + 16 * kt + 4 * g + r; \
                        lg[kt][r] = (FULL || kp < ns) ? lg[kt][r] + bia[kt][r] : -1e30f; cm = fmaxf(cm, lg[kt][r]); } \
                if (ck == 0) { cm = fmaxf(cm, SHFL_XOR(cm, 16)); cm = fmaxf(cm, SHFL_XOR(cm, 32)); mrun = cm; } \
                float p[2][4]; \
                _Pragma("unroll") for (int kt = 0; kt < 2; ++kt) \
                _Pragma("unroll") for (int r = 0; r < 4; ++r) { p[kt][r] = (FULL || lg[kt][r] > -1e29f) ? FEXP2(lg[kt][r] - mrun) : 0.f; lrun += p[kt][r]; } \
                u32x4 aw = (u32x4){0u, 0u, 0u, 0u}; \
                if (i16 < 4) aw = (u32x4){pk2(p[0][0], p[0][1]), pk2(p[0][2], p[0][3]), pk2(p[1][0], p[1][1]), pk2(p[1][2], p[1][3])}; \
                const bf16x8 A = __builtin_bit_cast(bf16x8, aw); \
                _Pragma("unroll") for (int nt = 0; nt < 8; ++nt) { \
                    const s16x4 lo = TR16(TL + (4 * g + (i16 >> 2)) * 136 + 16 * nt + 4 * (i16 & 3)); \
                    const s16x4 hi = TR16(TL + (16 + 4 * g + (i16 >> 2)) * 136 + 16 * nt + 4 * (i16 & 3)); \
                    const bf16x8 B = (bf16x8){lo[0], lo[1], lo[2], lo[3], hi[0], hi[1], hi[2], hi[3]}; \
                    O[nt] = MFMA16(A, B, O[nt]); } \
                WAVE_LDS_FENCE(); } while (0)
            if (ns == 256) { ATT_LOAD(gvA, 0, true); for (int ck2 = 0; ck2 < 8; ++ck2) ATT_STEP(gvA, ck2, true); }
            else { ATT_LOAD(gvA, 0, false); for (int ck2 = 0; ck2 < nch; ++ck2) ATT_STEP(gvA, ck2, false); }
#undef ATT_STEP
#undef ATT_LOAD
            lrun += SHFL_XOR(lrun, 16); lrun += SHFL_XOR(lrun, 32);
            float li[4];
#pragma unroll
            for (int r = 0; r < 4; ++r) li[r] = FRCP(SHFL(lrun, r));
            if (g == 0) {
#pragma unroll
                for (int nt = 0; nt < 8; ++nt)
#pragma unroll
                    for (int r = 0; r < 4; ++r) OLw[(rr * 4 + r) * 128 + 16 * nt + i16] = (bf16)f2bf(O[nt][r] * li[r]);
            }
        }
        bf16x8 Wf[4][4];
#pragma unroll
        for (int ks = 0; ks < 4; ++ks)
#pragma unroll
            for (int nt = 0; nt < 4; ++nt) Wf[ks][nt] = *(const bf16x8*)(WUVT + ((size_t)((w >> 1) * 64 + 16 * nt + i16)) * 128 + 32 * ks + 8 * g);
        SYNC();
        {
            const int h = w >> 1, mtile = w & 1, q = 16 * mtile + i16;
            const bf16* olq = (const bf16*)(F.lds + (q >> 2) * DS_SLOT + 8704) + ((q & 3) * 4 + h) * 128;
            float gaw[4];
#pragma unroll
            for (int nt = 0; nt < 4; ++nt) gaw[nt] = PIN(F, I_GNW)[l * DM + 768 + h * 64 + 16 * nt + i16];
            f32x4 acc[4];
#pragma unroll
            for (int nt = 0; nt < 4; ++nt) acc[nt] = (f32x4){0.f, 0.f, 0.f, 0.f};
#pragma unroll
            for (int ks = 0; ks < 4; ++ks) { const bf16x8 A = *(const bf16x8*)(olq + 32 * ks + 8 * g);
#pragma unroll
                for (int nt = 0; nt < 4; ++nt) acc[nt] = MFMA16(A, Wf[ks][nt], acc[nt]); }
#pragma unroll
            for (int r = 0; r < 4; ++r) { float s = (acc[0][r] * acc[0][r] + acc[1][r] * acc[1][r]) + (acc[2][r] * acc[2][r] + acc[3][r] * acc[3][r]);
                s += SHFL_XOR(s, 1); s += SHFL_XOR(s, 2); s += SHFL_XOR(s, 4); s += SHFL_XOR(s, 8);
                if (i16 == 0) SS[(16 * mtile + 4 * g + r) * 4 + h] = s; }
            SYNC();
#pragma unroll
            for (int r = 0; r < 4; ++r) { const int qq = 16 * mtile + 4 * g + r; const f32x4 s4 = *(const f32x4*)(SS + qq * 4);
                const float rs = RSQ(((s4.x + s4.y) + (s4.z + s4.w)) * (1.0f / 256.0f) + NORM_EPS);
                bf16* dst = CAT + (mb + t0 + qq) * DM + 768 + h * 64 + i16;
#pragma unroll
                for (int nt = 0; nt < 4; ++nt) dst[16 * nt] = (bf16)f2bf(acc[nt][r] * rs * gaw[nt]); }
        }
        SYNC();
    }
}
#ifndef HOST_EMU
namespace pg8 {
#define PG8_LAS __attribute__((address_space(3)))
typedef unsigned short bf16_t;
typedef short bf16x8 __attribute__((ext_vector_type(8)));
typedef float f32x4 __attribute__((ext_vector_type(4)));
typedef unsigned u32x4 __attribute__((ext_vector_type(4)));
constexpr int BM = 256, BK = 64, HALF = 128, HTB = HALF * BK * 2  , STAGE_BYTES = 8 * HTB, NXCD = 8, WGM = 8;

__host__ __device__ __forceinline__ int lds_byte(int r, int c) { const int st = (r >> 4) * 2 + (c >> 5), rr = r & 15, cc = c & 31, ob = rr * 64 + cc * 2; return st * 1024 + (ob ^ (((ob >> 9) & 1) << 5)); }
__host__ __device__ __forceinline__ void stage_rc(int b, int& R, int& C) { const int st = b / 1024, sb = b % 1024, swz = sb ^ (((sb >> 9) & 1) << 5); R = (st >> 1) * 16 + swz / 64; C = (st & 1) * 32 + (swz % 64) / 2; }
__host__ __device__ __forceinline__ int perm32(int rho) { const int n = rho >> 4, i = rho & 15; return 8 * (i >> 2) + 4 * n + (i & 3); }

struct Unit { int pm, pn; };
struct Gemm { const bf16_t* A; const bf16_t* Bt; int M, N, K; };

struct StaticOrder {
    int nM, nN, nwg, G, c;
    __host__ __device__ void init(int M, int N, int G_, int c_) { nM = M / BM; nN = N / BM; nwg = nM * nN; G = G_; c = c_; }
    __host__ __device__ bool next(int i, Unit& u) const {
        const long L = (long)i * G + c; if (L >= nwg) return false;
        int wgid = (int)L; { const int q = nwg / NXCD, r = nwg % NXCD, xcd = wgid % NXCD, off = wgid / NXCD; wgid = (xcd < r ? xcd * (q + 1) : r * (q + 1) + (xcd - r) * q) + off; }
        const int nig = WGM * nN, gid = wgid / nig, fm = gid * WGM, gsz = (nM - fm) < WGM ? (nM - fm) : WGM;
        u.pm = fm + ((wgid % nig) % gsz); u.pn = (wgid % nig) / gsz; return true;
    }
    __device__ __forceinline__ void a_ready(const Unit&) const {}
    __device__ __forceinline__ void done(const Unit&) const {}
};
__device__ __forceinline__ unsigned cvt_pk_bf16(float lo, float hi) { unsigned r; asm volatile("v_cvt_pk_bf16_f32 %0, %1, %2" : "=v"(r) : "v"(lo), "v"(hi)); return r; }
template <class Epi, class Sched, bool ALIGN_EPI = false, bool SP2 = false>
__device__ __forceinline__ void gemm_phase(PG8_LAS unsigned char* lds, const Gemm g, const Sched& S, const Epi& E, const int tid_in) {
    const int tid = tid_in, wid = __builtin_amdgcn_readfirstlane(tid >> 6), lane = tid & 63, wr = wid >> 2, wc = wid & 3, fr = lane & 15, fq = lane >> 4;
    const int K = g.K, nt = K / BK;
    unsigned voffA[2], voffB[2];
#pragma unroll
    for (int i = 0; i < 2; ++i) { int R, C; stage_rc(tid * 16 + i * 8192, R, C); const int Rb = Epi::PERM ? ((R & ~31) + perm32(R & 31)) : R;
        voffA[i] = (unsigned)(R * K + C) * 2u; voffB[i] = (unsigned)(Rb * K + C) * 2u; }
    const size_t kstep = (size_t)(BK * 2);
    const size_t hstep = (size_t)HALF * K * 2;
    const size_t tstep = 2 * hstep;
    const unsigned ldsw = (unsigned)wid * 1024u;
    const int aoff = lds_byte(wr * 64 + fr, fq * 8), boff = lds_byte(wc * 32 + fr, fq * 8);
#define PG8_SA(b, h) (((b) * 2 + (h)) * HTB)
#define PG8_SB(b, h) ((4 + (b) * 2 + (h)) * HTB)
#define PG8_STAGE(bufoff, gbase, voff) do { _Pragma("unroll") for (int _i = 0; _i < 2; ++_i) \
        __builtin_amdgcn_global_load_lds((const unsigned*)((const char*)(gbase) + (voff)[_i]), (PG8_LAS unsigned*)(lds + (bufoff) + ldsw + _i * 8192), 16, 0, 0); } while (0)
#define PG8_LDA(dst, b, h) do { _Pragma("unroll") for (int m = 0; m < 4; ++m) _Pragma("unroll") for (int k = 0; k < 2; ++k) dst[m][k] = *(const PG8_LAS bf16x8*)(lds + PG8_SA(b, h) + aoff + m * 2048 + k * 1024); } while (0)
#define PG8_LDB(dst, b, h) do { _Pragma("unroll") for (int n = 0; n < 2; ++n) _Pragma("unroll") for (int k = 0; k < 2; ++k) dst[n][k] = *(const PG8_LAS bf16x8*)(lds + PG8_SB(b, h) + boff + n * 2048 + k * 1024); } while (0)
#define PG8_MMA(ai, bj, At, Bt) do { __builtin_amdgcn_s_setprio(1); _Pragma("unroll") for (int m = 0; m < 4; ++m) _Pragma("unroll") for (int n = 0; n < 2; ++n) _Pragma("unroll") for (int k = 0; k < 2; ++k) \
        acc[ai][bj][m][n] = __builtin_amdgcn_mfma_f32_16x16x32_bf16(Bt[n][k], At[m][k], acc[ai][bj][m][n], 0, 0, 0); __builtin_amdgcn_s_setprio(0); } while (0)
#define PG8_WAIT_V(n) asm volatile("s_waitcnt vmcnt(" #n ")" ::: "memory")
#define PG8_WAIT_L(n) asm volatile("s_waitcnt lgkmcnt(" #n ")" ::: "memory")
#define PG8_BAR __builtin_amdgcn_s_barrier()
#define PG8_SCHED __builtin_amdgcn_sched_barrier(0)
    Unit cur, nxt; int ui = 0;
    if (!S.next(0, cur)) return;
    f32x4 acc[2][2][4][2];
#pragma unroll
    for (int a = 0; a < 2; ++a)
#pragma unroll
        for (int b = 0; b < 2; ++b)
#pragma unroll
            for (int m = 0; m < 4; ++m)
#pragma unroll
                for (int n = 0; n < 2; ++n) acc[a][b][m][n] = (f32x4){0.f, 0.f, 0.f, 0.f};
    bf16x8 At[4][2], B0[2][2], B1[2][2];
    const char* cA = (const char*)g.A + (size_t)cur.pm * tstep; const char* cB = (const char*)g.Bt + (size_t)cur.pn * tstep;
    S.a_ready(cur);
    if constexpr (SP2) {
        PG8_STAGE(PG8_SB(0, 0), cB, voffB); PG8_STAGE(PG8_SB(0, 1), cB + hstep, voffB); PG8_STAGE(PG8_SA(0, 0), cA, voffA); PG8_STAGE(PG8_SA(0, 1), cA + hstep, voffA);
        if (wr == 1) PG8_BAR;
        PG8_WAIT_V(2); PG8_BAR;
        PG8_STAGE(PG8_SB(1, 0), cB + kstep, voffB); PG8_STAGE(PG8_SA(1, 0), cA + kstep, voffA); PG8_STAGE(PG8_SB(1, 1), cB + hstep + kstep, voffB);
        PG8_WAIT_V(6); PG8_BAR;
    } else {
        PG8_STAGE(PG8_SB(0, 0), cB, voffB); PG8_STAGE(PG8_SA(0, 0), cA, voffA); PG8_STAGE(PG8_SB(0, 1), cB + hstep, voffB); PG8_STAGE(PG8_SA(0, 1), cA + hstep, voffA);
        if (wr == 1) PG8_BAR;
        PG8_WAIT_V(4); PG8_BAR;
        PG8_STAGE(PG8_SB(1, 0), cB + kstep, voffB); PG8_STAGE(PG8_SA(1, 0), cA + kstep, voffA); PG8_STAGE(PG8_SB(1, 1), cB + hstep + kstep, voffB);
        PG8_WAIT_V(6); PG8_BAR;
    }
    for (;;) {
        const bool has_next = S.next(ui + 1, nxt);
        const char* nA = has_next ? (const char*)g.A + (size_t)nxt.pm * tstep : cA; const char* nB = has_next ? (const char*)g.Bt + (size_t)nxt.pn * tstep : cB;
#pragma unroll 1
        for (int t = 0; t < nt; t += 2) {
            const bool last = (t == nt - 2);
            const char* a1 = cA + (size_t)(t + 1) * kstep;
            const char* a2 = last ? nA : cA + (size_t)(t + 2) * kstep; const char* b2 = last ? nB : cB + (size_t)(t + 2) * kstep;
            const char* a3 = a2 + kstep; const char* b3 = b2 + kstep;
            if (last && has_next) S.a_ready(nxt);
            if constexpr (Epi::NORM) { if (t == 2) E.prefetch(cur, tid, wid); if (t == 4) E.reduce_rs(tid); }
            if constexpr (SP2) {
            PG8_LDB(B0, 0, 0); PG8_LDB(B1, 0, 1); PG8_SCHED; PG8_LDA(At, 0, 0); PG8_STAGE(PG8_SA(1, 1), a1 + hstep, voffA);
            PG8_WAIT_V(8); PG8_WAIT_L(0); PG8_BAR; PG8_MMA(0, 0, At, B0); PG8_MMA(0, 1, At, B1); PG8_BAR; PG8_SCHED;
            PG8_LDA(At, 0, 1); PG8_STAGE(PG8_SB(0, 0), b2, voffB); PG8_STAGE(PG8_SB(0, 1), b2 + hstep, voffB); PG8_STAGE(PG8_SA(0, 0), a2, voffA);
            PG8_WAIT_V(8); PG8_WAIT_L(0); PG8_BAR; PG8_MMA(1, 0, At, B0); PG8_MMA(1, 1, At, B1); PG8_BAR; PG8_SCHED;
            PG8_LDB(B0, 1, 0); PG8_LDB(B1, 1, 1); PG8_SCHED; PG8_LDA(At, 1, 0); PG8_STAGE(PG8_SA(0, 1), a2 + hstep, voffA);
            PG8_WAIT_V(8); PG8_WAIT_L(0); PG8_BAR; PG8_MMA(0, 0, At, B0); PG8_MMA(0, 1, At, B1); PG8_BAR; PG8_SCHED;
            PG8_LDA(At, 1, 1); PG8_STAGE(PG8_SB(1, 0), b3, voffB); PG8_STAGE(PG8_SB(1, 1), b3 + hstep, voffB); PG8_STAGE(PG8_SA(1, 0), a3, voffA);
            PG8_WAIT_V(8); PG8_WAIT_L(0); PG8_BAR; PG8_MMA(1, 0, At, B0); PG8_MMA(1, 1, At, B1); PG8_BAR; PG8_SCHED;
            } else {
            PG8_LDB(B0, 0, 0); PG8_SCHED; PG8_LDA(At, 0, 0); PG8_STAGE(PG8_SA(1, 1), a1 + hstep, voffA);
            PG8_WAIT_L(8); PG8_BAR; PG8_WAIT_L(0); PG8_MMA(0, 0, At, B0); PG8_BAR; PG8_SCHED;
            PG8_LDB(B1, 0, 1); PG8_STAGE(PG8_SB(0, 0), b2, voffB);
            PG8_BAR; PG8_WAIT_L(0); PG8_MMA(0, 1, At, B1); PG8_BAR;
            PG8_LDA(At, 0, 1); PG8_STAGE(PG8_SA(0, 0), a2, voffA);
            PG8_BAR; PG8_WAIT_L(0); PG8_MMA(1, 0, At, B0); PG8_BAR; PG8_SCHED;
            PG8_STAGE(PG8_SB(0, 1), b2 + hstep, voffB);
            PG8_WAIT_V(6); PG8_BAR; PG8_MMA(1, 1, At, B1); PG8_BAR;
            PG8_LDB(B0, 1, 0); PG8_SCHED; PG8_LDA(At, 1, 0); PG8_STAGE(PG8_SA(0, 1), a2 + hstep, voffA);
            PG8_WAIT_L(8); PG8_BAR; PG8_WAIT_L(0); PG8_MMA(0, 0, At, B0); PG8_BAR; PG8_SCHED;
            PG8_LDB(B1, 1, 1); PG8_STAGE(PG8_SB(1, 0), b3, voffB);
            PG8_BAR; PG8_WAIT_L(0); PG8_MMA(0, 1, At, B1); PG8_BAR;
            PG8_LDA(At, 1, 1); PG8_STAGE(PG8_SA(1, 0), a3, voffA);
            PG8_BAR; PG8_WAIT_L(0); PG8_MMA(1, 0, At, B0); PG8_BAR; PG8_SCHED;
            PG8_STAGE(PG8_SB(1, 1), b3 + hstep, voffB);
            PG8_WAIT_V(6); PG8_BAR; PG8_MMA(1, 1, At, B1); PG8_BAR;
            }
        }
        if constexpr (ALIGN_EPI) { if (wr == 0) PG8_BAR; }
        if constexpr (!Epi::AFTER_DRAIN) { E(acc, cur, wr, wc, fr, fq); S.done(cur); }
        if (!has_next) break;
#pragma unroll
        for (int a = 0; a < 2; ++a)
#pragma unroll
            for (int b = 0; b < 2; ++b)
#pragma unroll
                for (int m = 0; m < 4; ++m)
#pragma unroll
                    for (int n = 0; n < 2; ++n) acc[a][b][m][n] = (f32x4){0.f, 0.f, 0.f, 0.f};
        cur = nxt; cA = nA; cB = nB; ++ui;
        if constexpr (ALIGN_EPI) { if (wr == 1) PG8_BAR; }
    }
    PG8_WAIT_V(0);
    if constexpr (!ALIGN_EPI) { if (wr == 0) PG8_BAR; }
    PG8_BAR;
    if constexpr (Epi::AFTER_DRAIN) { E.fused(acc, cur, wr, wc, fr, fq, lds, wid, lane); S.done(cur); }
#undef PG8_SA
#undef PG8_SB
#undef PG8_STAGE
#undef PG8_LDA
#undef PG8_LDB
#undef PG8_MMA
#undef PG8_WAIT_V
#undef PG8_WAIT_L
#undef PG8_BAR
#undef PG8_SCHED
}
}
namespace pg8 {
template <int ACT  > struct EpiRoute {
    static constexpr bool PERM = true, AFTER_DRAIN = false, NORM = false;
    bf16_t* O0; int ld0; bf16_t* O1; int ld1; int split;
    __device__ __forceinline__ void operator()(const f32x4 (&acc)[2][2][4][2], const Unit& u, int wr, int wc, int fr, int fq) const {
        const int row0 = u.pm * BM + wr * 64 + fr; const bool first = u.pn < split;
        bf16_t* base = first ? O0 : O1; const int ld = first ? ld0 : ld1; const int col0 = (first ? u.pn : u.pn - split) * BM + wc * 32 + 8 * fq;
#pragma unroll
        for (int ai = 0; ai < 2; ++ai)
#pragma unroll
            for (int m = 0; m < 4; ++m) { bf16_t* rowp = base + (size_t)(row0 + ai * HALF + m * 16) * ld + col0;
#pragma unroll
                for (int bj = 0; bj < 2; ++bj) { f32x4 v0 = acc[ai][bj][m][0], v1 = acc[ai][bj][m][1];
                    if (ACT == 1) {
#pragma unroll
                        for (int e = 0; e < 4; ++e) { const float a = fmaxf(v0[e], 0.f), b = fmaxf(v1[e], 0.f); v0[e] = a * a; v1[e] = b * b; } }
                    u32x4 w; w.x = cvt_pk_bf16(v0[0], v0[1]); w.y = cvt_pk_bf16(v0[2], v0[3]); w.z = cvt_pk_bf16(v1[0], v1[1]); w.w = cvt_pk_bf16(v1[2], v1[3]);
                    *(u32x4*)(rowp + bj * HALF) = w; } }
    }
};
struct EpiResid {
    static constexpr bool PERM = true, AFTER_DRAIN = false, NORM = false;
    const float* xsrc; float* xdst; const float* gate;
    __device__ __forceinline__ void operator()(const f32x4 (&acc)[2][2][4][2], const Unit& u, int wr, int wc, int fr, int fq) const {
        const int row0 = u.pm * BM + wr * 64 + fr, col0 = u.pn * BM + wc * 32 + 8 * fq, b = (u.pm * BM) >> 12;
        f32x4 gv[2][2];
#pragma unroll
        for (int bj = 0; bj < 2; ++bj)
#pragma unroll
            for (int n = 0; n < 2; ++n) gv[bj][n] = *(const f32x4*)(gate + (size_t)b * 6144 + col0 + bj * HALF + 4 * n);
#pragma unroll
        for (int ai = 0; ai < 2; ++ai)
#pragma unroll
            for (int m = 0; m < 4; ++m) { const size_t off = (size_t)(row0 + ai * HALF + m * 16) * 1024 + col0;
#pragma unroll
                for (int bj = 0; bj < 2; ++bj)
#pragma unroll
                    for (int n = 0; n < 2; ++n) { const f32x4 xs = *(const f32x4*)(xsrc + off + bj * HALF + 4 * n);
                        *(f32x4*)(xdst + off + bj * HALF + 4 * n) = xs + gv[bj][n] * acc[ai][bj][m][n]; }
                if (m & 1) asm volatile("" ::: "memory"); }
    }
};
constexpr int EPI_OFF = 133120;
template <int ACT  > struct EpiRouteN {
    static constexpr bool PERM = true, AFTER_DRAIN = false, NORM = true;
    bf16_t* O; int ld; const float* RSP; const float* shw; PG8_LAS unsigned char* lds;
    __device__ __forceinline__ void prefetch(const Unit& u, int tid, int wid) const {
        const char* src = (const char*)RSP + (size_t)u.pm * (BM * 64) + (size_t)tid * 16;
#pragma unroll
        for (int i = 0; i < 2; ++i) __builtin_amdgcn_global_load_lds((const unsigned*)(src + i * 8192), (PG8_LAS unsigned*)(lds + EPI_OFF + wid * 1024 + i * 8192), 16, 0, 0);
        if (wid == 0) { const char* s2 = (const char*)(shw + (size_t)((u.pm * BM) >> 12) * NSHW + u.pn * BM) + (size_t)(tid & 63) * 16;
            __builtin_amdgcn_global_load_lds((const unsigned*)s2, (PG8_LAS unsigned*)(lds + EPI_OFF + 16384), 16, 0, 0); }
    }
    __device__ __forceinline__ void reduce_rs(int tid) const {
        if (tid < 256) { const PG8_LAS f32x4* p = (const PG8_LAS f32x4*)(lds + EPI_OFF + tid * 64); const f32x4 a = p[0], b = p[1], c = p[2], d = p[3];
            const float s = (((a.x + a.y) + (a.z + a.w)) + ((b.x + b.y) + (b.z + b.w))) + (((c.x + c.y) + (c.z + c.w)) + ((d.x + d.y) + (d.z + d.w)));
            *(PG8_LAS float*)(lds + EPI_OFF + 17408 + tid * 4) = __builtin_amdgcn_rsqf(s * (1.0f / 1024.0f) + 1e-6f); }
    }
    __device__ __forceinline__ void operator()(const f32x4 (&acc)[2][2][4][2], const Unit& u, int wr, int wc, int fr, int fq) const {
        const int row0 = u.pm * BM + wr * 64 + fr, col0 = u.pn * BM + wc * 32 + 8 * fq;
        const PG8_LAS unsigned char* ep = lds + EPI_OFF;
        float rs[2][4];
#pragma unroll
        for (int ai = 0; ai < 2; ++ai)
#pragma unroll
            for (int m = 0; m < 4; ++m) rs[ai][m] = *(const PG8_LAS float*)(ep + 17408 + (wr * 64 + fr + ai * HALF + m * 16) * 4);
        f32x4 sv[2][2];
#pragma unroll
        for (int bj = 0; bj < 2; ++bj)
#pragma unroll
            for (int n = 0; n < 2; ++n) sv[bj][n] = *(const PG8_LAS f32x4*)(ep + 16384 + (bj * HALF + wc * 32 + 8 * fq + 4 * n) * 4);
#pragma unroll
        for (int ai = 0; ai < 2; ++ai)
#pragma unroll
            for (int m = 0; m < 4; ++m) { bf16_t* rowp = O + (size_t)(row0 + ai * HALF + m * 16) * ld + col0;
#pragma unroll
                for (int bj = 0; bj < 2; ++bj) { f32x4 v0 = acc[ai][bj][m][0] * rs[ai][m] + sv[bj][0], v1 = acc[ai][bj][m][1] * rs[ai][m] + sv[bj][1];
                    if (ACT == 1) {
#pragma unroll
                        for (int e = 0; e < 4; ++e) { const float a = fmaxf(v0[e], 0.f), b = fmaxf(v1[e], 0.f); v0[e] = a * a; v1[e] = b * b; } }
                    u32x4 w; w.x = cvt_pk_bf16(v0[0], v0[1]); w.y = cvt_pk_bf16(v0[2], v0[3]); w.z = cvt_pk_bf16(v1[0], v1[1]); w.w = cvt_pk_bf16(v1[2], v1[3]);
                    *(u32x4*)(rowp + bj * HALF) = w; } }
    }
};
template <bool MAYSKIP> struct EpiResidXS {
    static constexpr bool PERM = true, AFTER_DRAIN = false, NORM = false;
    const bf16_t* xsrc; bf16_t* xdst; const float* gate; const float* wp; bf16_t* XS; float* RSP; int doxs;
    template <bool DOXS> __device__ __forceinline__ void body(const f32x4 (&acc)[2][2][4][2], const Unit& u, int wr, int wc, int fr, int fq) const {
        const int row0 = u.pm * BM + wr * 64 + fr, col0 = u.pn * BM + wc * 32 + 8 * fq, b = (u.pm * BM) >> 12;
        f32x4 gv[2][2], wv[2][2]; float ssv[2][4];
#pragma unroll
        for (int bj = 0; bj < 2; ++bj)
#pragma unroll
            for (int n = 0; n < 2; ++n) { gv[bj][n] = *(const f32x4*)(gate + (size_t)b * 6144 + col0 + bj * HALF + 4 * n);
                if (DOXS) wv[bj][n] = *(const f32x4*)(wp + (size_t)b * 1024 + col0 + bj * HALF + 4 * n); }
#pragma unroll
        for (int aim = 0; aim < 4; ++aim) { const int ai = aim >> 1, m0_ = (aim & 1) * 2;
            u32x4 xr[4][2];
#pragma unroll
            for (int m = m0_; m < m0_ + 2; ++m)
#pragma unroll
                for (int bj = 0; bj < 2; ++bj) xr[m][bj] = *(const u32x4*)(xsrc + (size_t)(row0 + ai * HALF + m * 16) * 1024 + col0 + bj * HALF);
#pragma unroll
            for (int m = m0_; m < m0_ + 2; ++m) { const size_t off = (size_t)(row0 + ai * HALF + m * 16) * 1024 + col0; float ss = 0.f;
#pragma unroll
                for (int bj = 0; bj < 2; ++bj) { const u32x4 r = xr[m][bj];
                    const f32x4 x0 = (f32x4){bflo(r.x), bfhi(r.x), bflo(r.y), bfhi(r.y)}, x1 = (f32x4){bflo(r.z), bfhi(r.z), bflo(r.w), bfhi(r.w)};
                    const f32x4 y0 = x0 + gv[bj][0] * acc[ai][bj][m][0], y1 = x1 + gv[bj][1] * acc[ai][bj][m][1];
                    u32x4 w; w.x = cvt_pk_bf16(y0[0], y0[1]); w.y = cvt_pk_bf16(y0[2], y0[3]); w.z = cvt_pk_bf16(y1[0], y1[1]); w.w = cvt_pk_bf16(y1[2], y1[3]);
                    *(u32x4*)(xdst + off + bj * HALF) = w;
                    if (DOXS) { const f32x4 a = y0 * wv[bj][0], c = y1 * wv[bj][1];
                        u32x4 v; v.x = cvt_pk_bf16(a[0], a[1]); v.y = cvt_pk_bf16(a[2], a[3]); v.z = cvt_pk_bf16(c[0], c[1]); v.w = cvt_pk_bf16(c[2], c[3]);
                        *(u32x4*)(XS + off + bj * HALF) = v;
                        ss += ((y0.x * y0.x + y0.y * y0.y) + (y0.z * y0.z + y0.w * y0.w)) + ((y1.x * y1.x + y1.y * y1.y) + (y1.z * y1.z + y1.w * y1.w)); } }
                ssv[ai][m] = ss; }
            asm volatile("" ::: "memory"); }
        if (DOXS) { float t1[2][4];
#pragma unroll
            for (int ai = 0; ai < 2; ++ai)
#pragma unroll
                for (int m = 0; m < 4; ++m) t1[ai][m] = __shfl_xor(ssv[ai][m], 16);
#pragma unroll
            for (int ai = 0; ai < 2; ++ai)
#pragma unroll
                for (int m = 0; m < 4; ++m) { ssv[ai][m] += t1[ai][m]; t1[ai][m] = __shfl_xor(ssv[ai][m], 32); }
            if (fq == 0) {
#pragma unroll
                for (int ai = 0; ai < 2; ++ai)
#pragma unroll
                    for (int m = 0; m < 4; ++m) RSP[(size_t)(row0 + ai * HALF + m * 16) * 16 + u.pn * 4 + wc] = ssv[ai][m] + t1[ai][m]; } }
    }
    __device__ __forceinline__ void operator()(const f32x4 (&acc)[2][2][4][2], const Unit& u, int wr, int wc, int fr, int fq) const {
        if (!MAYSKIP || doxs) body<true>(acc, u, wr, wc, fr, fq); else body<false>(acc, u, wr, wc, fr, fq);
    }
};
}

#define RLX_AGENT __ATOMIC_RELAXED, __HIP_MEMORY_SCOPE_AGENT
#define XB_TMO      128
#define XB_XCNT(j)  (256  + 64 * (j))
#define XB_XSUB(j)  (1280 + 64 * (j))
#define XB_XGEN(j)  (2304 + 64 * (j))
#define XB_TOP      3328
#define XB_TOPGEN   3392
#define XCD_BAR_WORDS 3456
#define XB_SPIN_CAP (1u << 24)

__device__ __forceinline__ unsigned xb_ld(unsigned* p)              { return __hip_atomic_load(p, __ATOMIC_RELAXED, __HIP_MEMORY_SCOPE_AGENT); }
__device__ __forceinline__ unsigned xb_add(unsigned* p, unsigned v) { return __hip_atomic_fetch_add(p, v, __ATOMIC_RELAXED, __HIP_MEMORY_SCOPE_AGENT); }
__device__ __forceinline__ unsigned xb_xcc_id() { return (unsigned)__builtin_amdgcn_s_getreg((3 << 11) | 20) & 0xFu; }
#define XB_SPIN(cond, bar) do { unsigned _sp = 0; while (cond) { __builtin_amdgcn_s_sleep(1); \
    if ((++_sp & 255u) == 0u) { if (xb_ld(&(bar)[XB_TMO])) break; if (_sp > XB_SPIN_CAP) { atomicAdd(&(bar)[XB_TMO], 1u); break; } } } } while (0)

struct XcdBarrier {
    unsigned* bar; unsigned x;
    volatile LAS unsigned* st;
};

__device__ __forceinline__ XcdBarrier xcd_barrier_post(unsigned* bar, volatile LAS unsigned* st) {
    XcdBarrier b; b.bar = bar; b.x = xb_xcc_id(); b.st = st;
    if (threadIdx.x == 0) (void)xb_add(&bar[XB_XCNT(b.x)], 1u);
    return b;
}
__device__ __forceinline__ void xcd_barrier_complete(unsigned* bar, unsigned x, unsigned& nloc, unsigned& nx) {
    const unsigned G = gridDim.x * gridDim.y * gridDim.z;
    unsigned sum, cnt, mine, sp = 0u;
    for (;;) {
        sum = 0u; cnt = 0u; mine = 0u;
#pragma unroll
        for (unsigned j = 0; j < 16; ++j) { const unsigned c = xb_ld(&bar[XB_XCNT(j)]); sum += c; cnt += (c > 0u) ? 1u : 0u; mine = (j == x) ? c : mine; }
        if (sum == G) break;
        __builtin_amdgcn_s_sleep(1);
        if ((++sp & 255u) == 0u) { if (xb_ld(&bar[XB_TMO])) break; if (sp > XB_SPIN_CAP) { atomicAdd(&bar[XB_TMO], 1u); break; } }
    }
    nloc = mine > 0u ? mine : 1u; nx = cnt > 0u ? cnt : 1u;
}

__device__ __forceinline__ void xcd_barrier(const XcdBarrier& b) {
    asm volatile("s_waitcnt vmcnt(0)" ::: "memory");
    __syncthreads();
    if (threadIdx.x == 0) {
        unsigned* bar = b.bar;
        __builtin_amdgcn_s_waitcnt(0);
        unsigned nloc = b.st[0], nx = b.st[1];
        if (nloc == 0u) { xcd_barrier_complete(bar, b.x, nloc, nx); b.st[0] = nloc; b.st[1] = nx; }
        const unsigned old = xb_add(&bar[XB_XSUB(b.x)], 1u);
        const unsigned gen = old / nloc;
        if (old + 1u == (gen + 1u) * nloc) {
            __builtin_amdgcn_fence(__ATOMIC_RELEASE, "agent");
            asm volatile("s_waitcnt vmcnt(0)" ::: "memory");
            const unsigned og = xb_add(&bar[XB_TOP], 1u);
            const unsigned tg = og / nx;
            if (og + 1u == (tg + 1u) * nx) xb_add(&bar[XB_TOPGEN], 1u);
            else XB_SPIN(xb_ld(&bar[XB_TOPGEN]) == tg, bar);
            __builtin_amdgcn_fence(__ATOMIC_ACQUIRE, "agent");
            xb_add(&bar[XB_XGEN(b.x)], 1u);
            asm volatile("s_waitcnt vmcnt(0)" ::: "memory");
        } else {
            XB_SPIN(xb_ld(&bar[XB_XGEN(b.x)]) == gen, bar);
            __builtin_amdgcn_fence(__ATOMIC_ACQUIRE, "agent");
            asm volatile("s_waitcnt vmcnt(0)" ::: "memory");
        }
    }
    __syncthreads();
}

#ifndef PH_MASK
#define PH_MASK 0xFFFFF
#endif
#define EN(b) if constexpr ((PH_MASK >> (b)) & 1)
#ifndef DUP_MASK
#define DUP_MASK 0
#endif
#define DUP(b) if constexpr ((DUP_MASK >> (b)) & 1)
#define DBG_DIGEST_N 256
#define DBG_DIGEST_VAL(m, c) bf2f(((const bf16*)(wsp + WS_CAT))[(size_t)(m) * DM + 768 + (c)])
#ifndef DBG_PH_HI
#define DBG_PH_HI NPHASE
#endif
#ifndef MK_MULTI
#define MK_MULTI 0
#endif
constexpr int LDS_BYTES = 151552, MISC_OFF = 131072 + 320;
#ifndef DBG_LAYERS
#define DBG_LAYERS 4
#define DBG_L0 0
#endif
constexpr int NPHASE = 3 + 7 * DBG_LAYERS;
__global__ void __launch_bounds__(512, 2) hymba_fwd(Args a) {
    extern __shared__ __attribute__((aligned(16))) unsigned char lds[];
    Ctx F0;
    Ctx& F = F0;
    F.lds = (char*)lds; F.tid = threadIdx.x; F.lane = F.tid & 63; F.wave = __builtin_amdgcn_readfirstlane(F.tid >> 6); F.G = gridDim.x; F.bid = blockIdx.x;
    F.A = nullptr; F.ws = a.ws;
    if (F.tid < 29) ((unsigned long long*)(lds + PTR_OFF))[F.tid] = F.tid < 28 ? (unsigned long long)a.in[F.tid] : (unsigned long long)a.out;
    volatile LAS unsigned* MISC = (volatile LAS unsigned*)((LAS unsigned char*)lds + MISC_OFF);
    if (F.tid < 32) MISC[F.tid] = 0u;
    __syncthreads();
    unsigned* ctl = (unsigned*)(a.ws + WS_CTL);
    XcdBarrier bar; bar.bar = ctl + CW_BAR; bar.x = 0; bar.st = nullptr;
    if (!MK_MULTI) bar = xcd_barrier_post(ctl + CW_BAR, MISC + 8);
    const int lo = a.ph_lo, hi = a.ph_hi;
    int ph = 0;
#define PH_BEGIN if (lo <= ph && ph < hi) { Ctx F = F0; unsigned long long wsl_ = (unsigned long long)F0.ws; asm volatile("" : "+v"(F.tid), "+s"(F.bid), "+s"(F.G), "+s"(wsl_)); F.ws = (unsigned char*)(__attribute__((address_space(1))) unsigned char*)wsl_; F.lane = F.tid & 63; F.wave = __builtin_amdgcn_readfirstlane(F.tid >> 6); unsigned char* const wsp = F.ws; (void)wsp;
#define PH_END   if (!MK_MULTI && ph + 1 < hi) { XcdBarrier bb = bar; asm volatile("" : "+s"(bb.bar), "+s"(bb.x)); xcd_barrier(bb); } else __syncthreads(); } ++ph;
    PG8_LAS unsigned char* glds = (PG8_LAS unsigned char*)lds;
#define XN ((bf16*)(wsp + WS_XN))
#define PROJ ((bf16*)(wsp + WS_PROJ))
#define CAT ((bf16*)(wsp + WS_CAT))
#define HB ((bf16*)(wsp + WS_HB))
    PH_BEGIN EN(0) ph_prologue(F); DUP(0) { __syncthreads(); ph_prologue(F); } PH_END
    PH_BEGIN EN(1) { ph_shw(F); ph_xs0(F, PIN(F, I_X), PIN(F, I_N1W) + DBG_L0 * DM, (const float*)(wsp + WS_MOD) + (size_t)DBG_L0 * BATCH * NADA, DM, XN, (float*)(wsp + WS_RSP), (bf16*)POUT(F)); } PH_END
    for (int l_ = 0; l_ < DBG_LAYERS; ++l_) { const int l = l_ + DBG_L0;
        #define modl ((const float*)(wsp + WS_MOD) + (size_t)l * BATCH * NADA)
        #define xsrc (l_ == 0 ? PIN(F, I_X) : (const float*)POUT(F))
        PH_BEGIN
#if defined(PROBE_GA)
            { pg8::Gemm g{XN, (const bf16*)(wsp + WS_WIN) + (size_t)l * NPROJ * DM, MTOK, NPROJ, DM}; pg8::StaticOrder S; S.init(MTOK, NPROJ, F.G, F.bid);
            pg8::EpiRoute<0> E{PROJ, NPROJ, PROJ, NPROJ, 1 << 20};
            pg8::gemm_phase<pg8::EpiRoute<0>, pg8::StaticOrder, true, true>(glds, g, S, E, F.tid); } __syncthreads();
#elif defined(PROBE_GB)
            { pg8::Gemm g{XN, (const bf16*)(wsp + WS_WIN) + (size_t)l * NPROJ * DM, MTOK, NPROJ, DM}; pg8::StaticOrder S; S.init(MTOK, NPROJ, F.G, F.bid);
            pg8::EpiRouteN<0> E{PROJ, NPROJ, (const float*)(wsp + WS_RSP), (const float*)(wsp + WS_SHW) + (size_t)l * BATCH * NSHW, glds};
            pg8::gemm_phase<pg8::EpiRouteN<0>, pg8::StaticOrder, true, true>(glds, g, S, E, F.tid); } __syncthreads();
#endif
        EN(2) { pg8::Gemm g{XN, (const bf16*)(wsp + WS_WIN) + (size_t)l * NPROJ * DM, MTOK, NPROJ, DM}; pg8::StaticOrder S; S.init(MTOK, NPROJ, F.G, F.bid);
            pg8::EpiRouteN<0> E{PROJ, NPROJ, (const float*)(wsp + WS_RSP), (const float*)(wsp + WS_SHW) + (size_t)l * BATCH * NSHW, glds};
            pg8::gemm_phase<pg8::EpiRouteN<0>, pg8::StaticOrder, true, true>(glds, g, S, E, F.tid); } PH_END
        PH_BEGIN EN(3) ph_prep(F, l); DUP(3) ph_prep(F, l); EN(4) ph_lru1(F, l); DUP(4) ph_lru1(F, l); EN(5) ph_mlstm(F, l); DUP(5) ph_mlstm(F, l); PH_END
        PH_BEGIN EN(6) { ph_carry(F); pg8::Gemm g{(const bf16*)(wsp + WS_QL), (const bf16*)(wsp + WS_WQC) + (size_t)l * 768 * 256, MTOK, 768, 256}; pg8::StaticOrder S; S.init(MTOK, 768, F.G, F.bid);
            pg8::EpiRoute<0> E{(bf16*)(wsp + WS_QABS), 512, (bf16*)(wsp + WS_QIDX), 256, 2};
            pg8::gemm_phase<pg8::EpiRoute<0>, pg8::StaticOrder, true, true>(glds, g, S, E, F.tid); } PH_END
        PH_BEGIN EN(7) ph_dsa(F, l); DUP(7) ph_dsa(F, l); EN(8) ph_lru2(F, l); DUP(8) ph_lru2(F, l); EN(9) ph_mfin(F, l); DUP(9) ph_mfin(F, l); PH_END
        PH_BEGIN EN(10) { pg8::Gemm g{CAT, (const bf16*)(wsp + WS_WO) + (size_t)l * DM * DM, MTOK, DM, DM}; pg8::StaticOrder S; S.init(MTOK, DM, F.G, F.bid);
            pg8::EpiResidXS<false> E{(const pg8::bf16_t*)POUT(F), (pg8::bf16_t*)POUT(F), modl + 2 * DM, (const float*)(wsp + WS_WP) + (size_t)(l * 2 + 1) * BATCH * DM, XN, (float*)(wsp + WS_RSP), 1};
            pg8::gemm_phase<pg8::EpiResidXS<false>, pg8::StaticOrder, true, true>(glds, g, S, E, F.tid); } PH_END
        PH_BEGIN EN(12) { pg8::Gemm g{XN, (const bf16*)(wsp + WS_W1) + (size_t)l * DFF * DM, MTOK, DFF, DM}; pg8::StaticOrder S; S.init(MTOK, DFF, F.G, F.bid);
            pg8::EpiRouteN<1> E{HB, DFF, (const float*)(wsp + WS_RSP), (const float*)(wsp + WS_SHW) + (size_t)l * BATCH * NSHW + NPROJ, glds};
            pg8::gemm_phase<pg8::EpiRouteN<1>, pg8::StaticOrder, true, true>(glds, g, S, E, F.tid); } PH_END
        PH_BEGIN EN(13) { pg8::Gemm g{HB, (const bf16*)(wsp + WS_W2) + (size_t)l * DM * DFF, MTOK, DM, DFF}; pg8::StaticOrder S; S.init(MTOK, DM, F.G, F.bid);
            const int nl = l + 1 < DEPTH ? l + 1 : l;
            const bool lastl = l_ + 1 >= DBG_LAYERS;
            pg8::EpiResidXS<true> E{(const pg8::bf16_t*)POUT(F), lastl ? (pg8::bf16_t*)XN : (pg8::bf16_t*)POUT(F), modl + 5 * DM, (const float*)(wsp + WS_WP) + (size_t)(nl * 2) * BATCH * DM, XN, (float*)(wsp + WS_RSP), lastl ? 0 : 1};
            pg8::gemm_phase<pg8::EpiResidXS<true>, pg8::StaticOrder, true, true>(glds, g, S, E, F.tid); } PH_END
    }
#ifdef DBG_DIGEST
    PH_BEGIN { const int gw = F.bid * 8 + F.wave, NGW = F.G * 8; float* o = POUT(F);
        for (int m = gw; m < MTOK; m += NGW) for (int j = 0; j < 16; ++j) { const int c = F.lane + 64 * j; float v = 0.f;
            if (c < DBG_DIGEST_N) { v = DBG_DIGEST_VAL(m, c) * 4096.0f; v = v - floorf(v); }
            o[(size_t)m * DM + c] = v; } } PH_END
#else
    PH_BEGIN EN(14) ph_finalnorm16(F, XN, PIN(F, I_FNW), POUT(F)); PH_END
#endif
}

extern "C" void kernel_launch(void* const* d_in, const int* in_sizes, int n_in, void* d_out, int out_size, void* d_ws, size_t ws_size, hipStream_t stream) {
    static int grid = 0;
    if (grid == 0) {
        if (n_in != 28 || in_sizes[0] != MTOK * DM || out_size != MTOK * DM || ws_size < WS_END) { fprintf(stderr, "kernel_launch: unexpected shapes (n_in %d, in0 %d, out %d, ws %zu)\n", n_in, n_in > 0 ? in_sizes[0] : -1, out_size, ws_size); grid = -1; return; }
        int dev = 0, cus = 0, per_cu = 0;
        if (hipGetDevice(&dev) != hipSuccess || hipDeviceGetAttribute(&cus, hipDeviceAttributeMultiprocessorCount, dev) != hipSuccess) { grid = -1; return; }
        if (hipFuncSetAttribute((const void*)hymba_fwd, hipFuncAttributeMaxDynamicSharedMemorySize, LDS_BYTES) != hipSuccess) { fprintf(stderr, "kernel_launch: hipFuncSetAttribute failed\n"); grid = -1; return; }
        if (hipOccupancyMaxActiveBlocksPerMultiprocessor(&per_cu, (const void*)hymba_fwd, 512, LDS_BYTES) != hipSuccess || per_cu < 1) { fprintf(stderr, "kernel_launch: occupancy query says %d\n", per_cu); }
        (void)hipGetLastError();
        grid = cus;
    }
    if (grid < 0) return;
    if (hipMemsetAsync((char*)d_ws + WS_CTL, 0, CTL_ZERO_BYTES, stream) != hipSuccess) return;
    Args a{};
    for (int i = 0; i < 28; ++i) a.in[i] = (const float*)d_in[i];
    a.out = (float*)d_out; a.ws = (unsigned char*)d_ws;
#if MK_MULTI
    for (int p = 0; p < NPHASE; ++p) { a.ph_lo = p; a.ph_hi = p + 1; hipLaunchKernelGGL(hymba_fwd, dim3(grid), dim3(512), LDS_BYTES, stream, a); }
#else
    a.ph_lo = 0; a.ph_hi = DBG_PH_HI; hipLaunchKernelGGL(hymba_fwd, dim3(grid), dim3(512), LDS_BYTES, stream, a);
#endif
}
#endif
```

```cpp
#ifndef HOST_EMU
#include <hip/hip_runtime.h>
#include <cstdio>
#include <cstdint>
#define DEV __device__ __forceinline__
#define LAS __attribute__((address_space(3)))
#else
#include "emu.h"
#endif

#ifndef HOST_EMU
#define SYNC() __syncthreads()
#define LAUNDER_V(x) asm volatile("" : "+v"(x))
#define WAVE_LDS_FENCE() asm volatile("s_waitcnt lgkmcnt(0)" ::: "memory")
template <class T> DEV T SHFL(T v, int s) { return __shfl(v, s); }
template <class T> DEV T SHFL_XOR(T v, int m) { return __shfl_xor(v, m); }
template <class T> DEV T SHFL_UP(T v, int d) { return __shfl_up(v, d); }
template <class T> DEV T SHFL_DOWN(T v, int d) { return __shfl_down(v, d); }
typedef short bf16x8_ __attribute__((ext_vector_type(8)));
typedef float f32x4_ __attribute__((ext_vector_type(4)));
typedef short v4i16_t __attribute__((ext_vector_type(4)));
DEV f32x4_ MFMA16(bf16x8_ a, bf16x8_ b, f32x4_ c) { return __builtin_amdgcn_mfma_f32_16x16x32_bf16(a, b, c, 0, 0, 0); }
DEV v4i16_t TR16(const void* p) { return __builtin_amdgcn_ds_read_tr16_b64_v4i16((LAS v4i16_t*)(p)); }
#endif


typedef unsigned short bf16;
typedef short bf16x8 __attribute__((ext_vector_type(8)));
typedef short s16x4 __attribute__((ext_vector_type(4)));
typedef float f32x4 __attribute__((ext_vector_type(4)));
typedef unsigned u32x4 __attribute__((ext_vector_type(4)));
typedef unsigned u32x2 __attribute__((ext_vector_type(2)));

constexpr int BATCH = 16, SEQ = 4096, DM = 1024, DEPTH = 4, MTOK = BATCH * SEQ;
constexpr int NPROJ = 3072, DFF = 4096, NADA = 6 * DM;
constexpr int PC_LX = 0, PC_LY = 256, PC_MQ = 512, PC_MK = 1024, PC_MV = 1536, PC_MO = 2048, PC_AQ = 2560, PC_AKV = 2816, PC_IK = 2944, PC_IW = 2976, PC_MI = 2984, PC_MF = 2988;
constexpr float NORM_EPS = 1e-6f;

constexpr size_t MiB = 1u << 20;
constexpr size_t WS_CTL = 0, CTL_ZERO_BYTES = 1 * MiB;
constexpr size_t WS_MOD = 1 * MiB;
constexpr size_t WS_WQC = 3 * MiB;
constexpr size_t WS_WG = 5 * MiB;
constexpr size_t WS_WUVT = 6 * MiB;
constexpr size_t WS_WIN = 8 * MiB;
constexpr size_t WS_WO = 32 * MiB;
constexpr size_t WS_W1 = 40 * MiB;
constexpr size_t WS_W2 = 72 * MiB;
constexpr size_t WS_XN = 104 * MiB;
constexpr size_t WS_QL = WS_XN, WS_CKV = WS_XN + 32 * MiB, WS_QIDX = WS_XN + 48 * MiB, WS_KIDX = WS_XN + 80 * MiB, WS_WI = WS_XN + 84 * MiB, WS_GT = WS_XN + 86 * MiB;
constexpr size_t WS_CAT = 232 * MiB;
constexpr size_t WS_PROJ = 360 * MiB;
constexpr size_t WS_HB = 360 * MiB;
constexpr size_t WS_QABS = 744 * MiB;
constexpr size_t WS_HLOC = 808 * MiB, WS_CPA = 840 * MiB;
constexpr size_t WS_LSUM = 872 * MiB;
constexpr size_t WS_HM = 874 * MiB;
constexpr size_t WS_MG = 940 * MiB;
constexpr size_t WS_WP = 2 * MiB + 512 * 1024;
constexpr size_t WS_SHW = 6 * MiB + 256 * 1024;
constexpr size_t WS_RSP = 1000 * MiB;
constexpr size_t WS_CARRY = 948 * MiB;
constexpr size_t WS_SCR2 = 949 * MiB;
constexpr int NSHW = NPROJ + DFF;
constexpr size_t WS_END = 1024 * MiB;
static_assert(WS_HM + (size_t)MTOK * 512 * 2 <= WS_END && WS_HB + (size_t)MTOK * DFF * 2 <= WS_HLOC + 64 * MiB, "ws map");

constexpr int CW_TMO = 0, CW_BAR = 4096;

#ifndef HOST_EMU
typedef __bf16 hwbf2_t __attribute__((ext_vector_type(2)));
typedef float hwf2_t __attribute__((ext_vector_type(2)));
DEV unsigned f2bf(float f) { return (unsigned)__builtin_bit_cast(unsigned short, (__bf16)f); }
DEV unsigned pk2(float lo, float hi) { const hwf2_t v = {lo, hi}; return __builtin_bit_cast(unsigned, __builtin_convertvector(v, hwbf2_t)); }
#else
DEV unsigned f2bf(float f) { unsigned u = __builtin_bit_cast(unsigned, f); return (u + 0x7fffu + ((u >> 16) & 1u)) >> 16; }
DEV unsigned pk2(float lo, float hi) { return f2bf(lo) | (f2bf(hi) << 16); }
#endif
DEV float bf2f(unsigned h) { return __builtin_bit_cast(float, h << 16); }
DEV float bflo(unsigned w) { return __builtin_bit_cast(float, w << 16); }
DEV float bfhi(unsigned w) { return __builtin_bit_cast(float, w & 0xffff0000u); }
DEV float wave_sum(float v) {
#pragma unroll
    for (int o = 1; o < 64; o <<= 1) v += SHFL_XOR(v, o);
    return v;
}
#ifndef HOST_EMU
DEV float FEXP(float x) { return __expf(x); }
DEV float FEXP2(float x) { return __builtin_amdgcn_exp2f(x); }
DEV float FRCP(float x) { return __builtin_amdgcn_rcpf(x); }
DEV float FSQRT(float x) { return __builtin_amdgcn_sqrtf(x); }
DEV float RSQ(float x) { return __builtin_amdgcn_rsqf(x); }
DEV float FLOG(float x) { return __logf(x); }
#else
DEV float FEXP(float x) { return expf(x); }
DEV float FEXP2(float x) { return exp2f(x); }
DEV float FRCP(float x) { return 1.0f / x; }
DEV float FSQRT(float x) { return sqrtf(x); }
DEV float RSQ(float x) { return 1.0f / sqrtf(x); }
DEV float FLOG(float x) { return logf(x); }
#endif
#ifndef HOST_EMU
DEV int UNI(int x) { return __builtin_amdgcn_readfirstlane(x); }
#else
DEV int UNI(int x) { return x; }
#endif
#ifndef HOST_EMU
#define GAS __attribute__((address_space(1)))
DEV const GAS char* UNIP(const void* p) { const unsigned long long v = (unsigned long long)p; const unsigned lo = __builtin_amdgcn_readfirstlane((unsigned)v), hi = __builtin_amdgcn_readfirstlane((unsigned)(v >> 32));
    return (const GAS char*)(((unsigned long long)hi << 32) | lo); }
#else
#define GAS
DEV const char* UNIP(const void* p) { return (const char*)p; }
#endif
DEV float RELU(float x) { const int b = __builtin_bit_cast(int, x); return __builtin_bit_cast(float, b > 0 ? b : 0); }
DEV float sigmoidf_(float z) { return 1.0f / (1.0f + expf(-z)); }
DEV float fsigmoid(float z) { return FRCP(1.0f + FEXP(-z)); }
DEV float one_minus_exp(float x) {
    const float s = -x * (1.0f + x * (0.5f + x * (0.16666667f + x * 0.041666668f)));
    return x > -0.05f ? s : 1.0f - FEXP(x);
}

struct Args { const float* in[28]; float* out; unsigned char* ws; int ph_lo, ph_hi; };
struct Ctx {
    char* lds; int tid, lane, wave, G, bid;
    const Args* A;
    unsigned char* ws;
};

constexpr int PTR_OFF = 131072 + 512;
#ifndef HOST_EMU
DEV const float* PIN(const Ctx& F, int i) { const unsigned long long v = ((const unsigned long long*)(F.lds + PTR_OFF))[i];
    const unsigned lo = __builtin_amdgcn_readfirstlane((unsigned)v), hi = __builtin_amdgcn_readfirstlane((unsigned)(v >> 32)); return (const float*)(const __attribute__((address_space(1))) float*)(((unsigned long long)hi << 32) | lo); }
DEV float* POUT(const Ctx& F) { return (float*)PIN(F, 28); }
#else
DEV const float* PIN(const Ctx& F, int i) { return F.A->in[i]; }
DEV float* POUT(const Ctx& F) { return POUT(F); }
#endif
enum { I_X = 0, I_C, I_WIN, I_CONVW, I_CONVB, I_WA, I_BA, I_WX, I_BX, I_LAM, I_BI, I_BF, I_WQUP, I_WQIDX, I_WUK, I_WUV, I_QNW, I_KVNW, I_RELB, I_GNW, I_WO, I_WADA, I_BADA, I_N1W, I_N2W, I_W1, I_W2, I_FNW };

DEV int win_srccol(int n) {
    if (n < 2560) return n;
    if (n < PC_AKV) return 2568 + (n - PC_AQ);
    if (n < PC_IK) return 2824 + (n - PC_AKV);
    if (n < PC_IW) return 2952 + (n - PC_IK);
    if (n < PC_MI) return 2984 + (n - PC_IW);
    if (n < PC_MF) return 2560 + (n - PC_MI);
    if (n < 2992) return 2564 + (n - PC_MF);
    return -1;
}
template <bool MAPPED>
DEV void p0_transpose_item(const float* W, int K, int N, int NT, bf16* WT, float* scr, int item, int lane) {
    const int nblk = NT / 32, kb = item / nblk, nb = item % nblk, k0 = 64 * kb, n0 = 32 * nb;
    int sc = n0 + (lane & 31); if (MAPPED) sc = win_srccol(sc);
#pragma unroll 8
    for (int i = 0; i < 32; ++i) { const int kk = 2 * i + (lane >> 5); const float v = W[(size_t)(k0 + kk) * N + (sc >= 0 ? sc : 0)]; scr[kk * 33 + (lane & 31)] = sc >= 0 ? v : 0.f; }
    WAVE_LDS_FENCE();
    const int c = lane & 7;
#pragma unroll
    for (int j = 0; j < 4; ++j) { const int n = (lane >> 3) + 8 * j; const float* s = scr + (8 * c) * 33 + n;
        u32x4 o; o.x = pk2(s[0 * 33], s[1 * 33]); o.y = pk2(s[2 * 33], s[3 * 33]); o.z = pk2(s[4 * 33], s[5 * 33]); o.w = pk2(s[6 * 33], s[7 * 33]);
        *(u32x4*)(WT + (size_t)(n0 + n) * K + k0 + 8 * c) = o; }
    WAVE_LDS_FENCE();
}

DEV void ph_prologue(const Ctx& F) {
    const int gt = F.bid * 512 + F.tid, NGT = F.G * 512;
    float* CACT = (float*)F.lds;
    for (int i = F.tid; i < BATCH * DM; i += 512) { const float cv = PIN(F, I_C)[i]; CACT[i] = cv * sigmoidf_(cv); }
    SYNC();
    for (int e = gt; e < DEPTH * NADA * 4; e += NGT) {
        const int j = e % NADA, bq = (e / NADA) & 3, l = e / (NADA * 4);
        const float* w = PIN(F, I_WADA) + (size_t)l * DM * NADA + j;
        const float* c = CACT + bq * 4 * DM;
        float a0 = 0.f, a1 = 0.f, a2 = 0.f, a3 = 0.f;
#pragma unroll 32
        for (int k = 0; k < DM; ++k) { const float wv = w[(size_t)k * NADA];
            a0 += c[k] * wv; a1 += c[DM + k] * wv; a2 += c[2 * DM + k] * wv; a3 += c[3 * DM + k] * wv; }
        const float bb = PIN(F, I_BADA)[(size_t)l * NADA + j];
        float* mo = (float*)(F.ws + WS_MOD) + ((size_t)l * BATCH + bq * 4) * NADA + j;
        mo[0] = a0 + bb; mo[NADA] = a1 + bb; mo[2 * NADA] = a2 + bb; mo[3 * NADA] = a3 + bb;
    }
    for (int e = gt; e < DEPTH * 2 * 4 * 64 * 64; e += NGT) {
        const int i = e & 63, j = (e >> 6) & 63, blk = (e >> 12) & 3, g = (e >> 14) & 1, l = e >> 15;
        const float* src = PIN(F, g ? I_WX : I_WA) + (((size_t)l * 4 + blk) * 64 + i) * 64 + j;
        ((bf16*)(F.ws + WS_WG))[e] = (bf16)f2bf(*src);
    }
    for (int e = gt; e < DEPTH * 4 * 64 * 128; e += NGT) {
        const int r = e & 127, d = (e >> 7) & 63, h = (e >> 13) & 3, l = e >> 15;
        ((bf16*)(F.ws + WS_WUVT))[e] = (bf16)f2bf(PIN(F, I_WUV)[(((size_t)l * 128 + r) * 4 + h) * 64 + d]);
    }
    for (int e = gt; e < DEPTH * 768 * 256; e += NGT) {
        const int r = e & 255, n = (e >> 8) % 768, l = e / (768 * 256);
        float v;
        if (n < 512) { const int h = n >> 7, c = n & 127; const f32x4* q = (const f32x4*)(PIN(F, I_WQUP) + ((size_t)l * 256 + r) * 256 + h * 64); const f32x4* k = (const f32x4*)(PIN(F, I_WUK) + ((size_t)l * 128 + c) * 256 + h * 64);
            float s = 0.f;
#pragma unroll
            for (int d = 0; d < 16; ++d) { const f32x4 a = q[d], bq4 = k[d]; s += (a.x * bq4.x + a.y * bq4.y) + (a.z * bq4.z + a.w * bq4.w); }
            v = s * (0.125f * 1.4426950408889634f); }
        else v = PIN(F, I_WQIDX)[((size_t)l * 256 + r) * 256 + (n - 512)] * 0.17677669529663687f;
        ((bf16*)(F.ws + WS_WQC))[e] = (bf16)f2bf(v);
    }
    SYNC();
    float* scr = (float*)(F.lds + F.wave * 16384);
    const int gw = F.bid * 8 + F.wave, NGW = F.G * 8;
    constexpr int I_IN = (DM / 64) * (NPROJ / 32), I_O = (DM / 64) * (DM / 32), I_1 = (DM / 64) * (DFF / 32), I_2 = (DFF / 64) * (DM / 32);
    constexpr int PER_L = I_IN + I_O + I_1 + I_2;
    for (int it = gw; it < DEPTH * PER_L; it += NGW) {
        const int l = it / PER_L; int r = it % PER_L;
        if (r < I_IN) { p0_transpose_item<true>(PIN(F, I_WIN) + (size_t)l * DM * 2992, DM, 2992, NPROJ, (bf16*)(F.ws + WS_WIN) + (size_t)l * NPROJ * DM, scr, r, F.lane); continue; } r -= I_IN;
        if (r < I_O) { p0_transpose_item<false>(PIN(F, I_WO) + (size_t)l * DM * DM, DM, DM, DM, (bf16*)(F.ws + WS_WO) + (size_t)l * DM * DM, scr, r, F.lane); continue; } r -= I_O;
        if (r < I_1) { p0_transpose_item<false>(PIN(F, I_W1) + (size_t)l * DM * DFF, DM, DFF, DFF, (bf16*)(F.ws + WS_W1) + (size_t)l * DFF * DM, scr, r, F.lane); continue; } r -= I_1;
        p0_transpose_item<false>(PIN(F, I_W2) + (size_t)l * DFF * DM, DFF, DM, DM, (bf16*)(F.ws + WS_W2) + (size_t)l * DM * DFF, scr, r, F.lane);
    }
}

DEV void ph_xs0(const Ctx& F, const float* xsrc, const float* nw, const float* modl, int sc_off, bf16* XS, float* RSP, bf16* X16) {
    const int gw = F.bid * 8 + F.wave, NGW = F.G * 8;
    f32x4 wv[4];
#pragma unroll
    for (int j = 0; j < 4; ++j) wv[j] = *(const f32x4*)(nw + 4 * F.lane + 256 * j);
    f32x4 v[2][4], vn[2][4];
#pragma unroll
    for (int q = 0; q < 2; ++q) { const int m = gw + q * NGW; const f32x4* xr = (const f32x4*)(xsrc + (size_t)(m < MTOK ? m : 0) * DM) + F.lane;
#pragma unroll
        for (int j = 0; j < 4; ++j) v[q][j] = xr[64 * j]; }
    for (int m0 = gw; m0 < MTOK; m0 += 2 * NGW) {
        f32x4 sc[2][4];
#pragma unroll
        for (int q = 0; q < 2; ++q) { const int m = m0 + q * NGW; const float* mb = modl + (size_t)((m < MTOK ? m : 0) >> 12) * NADA + 4 * F.lane;
#pragma unroll
            for (int j = 0; j < 4; ++j) sc[q][j] = *(const f32x4*)(mb + sc_off + 256 * j); }
#pragma unroll
        for (int q = 0; q < 2; ++q) { const int m = m0 + (2 + q) * NGW; const f32x4* xr = (const f32x4*)(xsrc + (size_t)(m < MTOK ? m : 0) * DM) + F.lane;
#pragma unroll
            for (int j = 0; j < 4; ++j) vn[q][j] = xr[64 * j]; }
        float s[2];
#pragma unroll
        for (int q = 0; q < 2; ++q) { float a = 0.f;
#pragma unroll
            for (int j = 0; j < 4; ++j) a += (v[q][j].x * v[q][j].x + v[q][j].y * v[q][j].y) + (v[q][j].z * v[q][j].z + v[q][j].w * v[q][j].w);
            s[q] = a; }
#pragma unroll
        for (int o = 1; o < 64; o <<= 1) { s[0] += SHFL_XOR(s[0], o); s[1] += SHFL_XOR(s[1], o); }
#pragma unroll
        for (int q = 0; q < 2; ++q) { const int m = m0 + q * NGW; if (m >= MTOK) break;
            if (F.lane < 16) RSP[(size_t)m * 16 + F.lane] = F.lane == 0 ? s[q] : 0.f;
            u32x2* o8 = (u32x2*)(XS + (size_t)m * DM) + F.lane; u32x2* x8 = (u32x2*)(X16 + (size_t)m * DM) + F.lane;
#pragma unroll
            for (int j = 0; j < 4; ++j) { const f32x4 y = v[q][j] * (wv[j] * (1.0f + sc[q][j]));
                u32x2 p; p.x = pk2(y.x, y.y); p.y = pk2(y.z, y.w); o8[64 * j] = p;
                u32x2 c; c.x = pk2(v[q][j].x, v[q][j].y); c.y = pk2(v[q][j].z, v[q][j].w); x8[64 * j] = c; } }
#pragma unroll
        for (int q = 0; q < 2; ++q)
#pragma unroll
            for (int j = 0; j < 4; ++j) v[q][j] = vn[q][j];
    }
}
DEV void ph_shw(const Ctx& F) {
    const int gt = F.bid * 512 + F.tid, NGT = F.G * 512;
    for (int e = gt; e < DEPTH * 2 * BATCH * (DM / 4); e += NGT) {
        const int c4 = e & 255, b = (e >> 8) & 15, w = (e >> 12) & 1, l = e >> 13;
        const f32x4 nwv = *(const f32x4*)(PIN(F, w ? I_N2W : I_N1W) + l * DM + 4 * c4);
        const f32x4 sc = *(const f32x4*)((const float*)(F.ws + WS_MOD) + ((size_t)l * BATCH + b) * NADA + (w ? 4 * DM : DM) + 4 * c4);
        ((f32x4*)(F.ws + WS_WP))[e] = nwv * (1.0f + sc);
    }
    const int gw = F.bid * 8 + F.wave, NGW = F.G * 8, i16 = F.lane & 15, kq = 8 * (F.lane >> 4);
    for (int it = gw; it < DEPTH * (NSHW / 16); it += NGW) {
        const int l = it / (NSHW / 16), n0 = (it % (NSHW / 16)) * 16;
        const bool mlp = n0 >= NPROJ;
        const bf16* Wr = mlp ? (const bf16*)(F.ws + WS_W1) + ((size_t)l * DFF + (n0 - NPROJ) + i16) * DM : (const bf16*)(F.ws + WS_WIN) + ((size_t)l * NPROJ + n0 + i16) * DM;
        const float* sh = (const float*)(F.ws + WS_MOD) + ((size_t)l * BATCH + i16) * NADA + (mlp ? 3 * DM : 0);
        f32x4 acc0 = {0.f, 0.f, 0.f, 0.f}, acc1 = {0.f, 0.f, 0.f, 0.f};
#pragma unroll 4
        for (int s = 0; s < DM / 32; ++s) {
            const bf16x8 B = *(const bf16x8*)(Wr + 32 * s + kq);
            const f32x4 a0 = *(const f32x4*)(sh + 32 * s + kq), a1 = *(const f32x4*)(sh + 32 * s + kq + 4);
            bf16x8 Ah, Al;
#pragma unroll
            for (int j = 0; j < 8; ++j) { const float a = j < 4 ? a0[j] : a1[j - 4]; const unsigned h = f2bf(a); Ah[j] = (short)h; Al[j] = (short)f2bf(a - bf2f(h)); }
            acc0 = MFMA16(Ah, B, acc0); acc1 = MFMA16(Al, B, acc1);
        }
        float* o = (float*)(F.ws + WS_SHW) + ((size_t)l * BATCH + 4 * (F.lane >> 4)) * NSHW + n0 + i16;
#pragma unroll
        for (int r = 0; r < 4; ++r) o[(size_t)r * NSHW] = acc0[r] + acc1[r];
    }
}
DEV void ph_normmod(const Ctx& F, const float* xsrc, const float* nw, const float* modl, int sh_off, int sc_off, bf16* XN) {
    const int gw = F.bid * 8 + F.wave, NGW = F.G * 8;
    f32x4 wv[4];
#pragma unroll
    for (int j = 0; j < 4; ++j) wv[j] = *(const f32x4*)(nw + 4 * F.lane + 256 * j);
    f32x4 v[2][4], vn[2][4];
#pragma unroll
    for (int q = 0; q < 2; ++q) { const int m = gw + q * NGW; const f32x4* xr = (const f32x4*)(xsrc + (size_t)(m < MTOK ? m : 0) * DM) + F.lane;
#pragma unroll
        for (int j = 0; j < 4; ++j) v[q][j] = xr[64 * j]; }
    for (int m0 = gw; m0 < MTOK; m0 += 2 * NGW) {
        f32x4 sc[2][4], sh[2][4];
#pragma unroll
        for (int q = 0; q < 2; ++q) { const int m = m0 + q * NGW; const float* mb = modl + (size_t)((m < MTOK ? m : 0) >> 12) * NADA + 4 * F.lane;
#pragma unroll
            for (int j = 0; j < 4; ++j) { sc[q][j] = *(const f32x4*)(mb + sc_off + 256 * j); sh[q][j] = *(const f32x4*)(mb + sh_off + 256 * j); } }
#pragma unroll
        for (int q = 0; q < 2; ++q) { const int m = m0 + (2 + q) * NGW; const f32x4* xr = (const f32x4*)(xsrc + (size_t)(m < MTOK ? m : 0) * DM) + F.lane;
#pragma unroll
            for (int j = 0; j < 4; ++j) vn[q][j] = xr[64 * j]; }
        float s[2];
#pragma unroll
        for (int q = 0; q < 2; ++q) { float a = 0.f;
#pragma unroll
            for (int j = 0; j < 4; ++j) a += (v[q][j].x * v[q][j].x + v[q][j].y * v[q][j].y) + (v[q][j].z * v[q][j].z + v[q][j].w * v[q][j].w);
            s[q] = a; }
#pragma unroll
        for (int o = 1; o < 64; o <<= 1) { s[0] += SHFL_XOR(s[0], o); s[1] += SHFL_XOR(s[1], o); }
#pragma unroll
        for (int q = 0; q < 2; ++q) { const int m = m0 + q * NGW; if (m >= MTOK) break;
            const float rs = RSQ(s[q] * (1.0f / DM) + NORM_EPS);
            u32x2* o8 = (u32x2*)(XN + (size_t)m * DM) + F.lane;
#pragma unroll
            for (int j = 0; j < 4; ++j) { const f32x4 y = v[q][j] * rs * wv[j] * (1.0f + sc[q][j]) + sh[q][j];
                u32x2 p; p.x = pk2(y.x, y.y); p.y = pk2(y.z, y.w); o8[64 * j] = p; } }
#pragma unroll
        for (int q = 0; q < 2; ++q)
#pragma unroll
            for (int j = 0; j < 4; ++j) v[q][j] = vn[q][j];
    }
}
DEV void ph_finalnorm(const Ctx& F, const float* xsrc, const float* nw, float* out) {
    const int gw = F.bid * 8 + F.wave, NGW = F.G * 8;
    f32x4 wv[4];
#pragma unroll
    for (int j = 0; j < 4; ++j) wv[j] = *(const f32x4*)(nw + 4 * F.lane + 256 * j);
    f32x4 v[2][4], vn[2][4];
#pragma unroll
    for (int q = 0; q < 2; ++q) { const int m = gw + q * NGW; const f32x4* xr = (const f32x4*)(xsrc + (size_t)(m < MTOK ? m : 0) * DM) + F.lane;
#pragma unroll
        for (int j = 0; j < 4; ++j) v[q][j] = xr[64 * j]; }
    for (int m0 = gw; m0 < MTOK; m0 += 2 * NGW) {
#pragma unroll
        for (int q = 0; q < 2; ++q) { const int m = m0 + (2 + q) * NGW; const f32x4* xr = (const f32x4*)(xsrc + (size_t)(m < MTOK ? m : 0) * DM) + F.lane;
#pragma unroll
            for (int j = 0; j < 4; ++j) vn[q][j] = xr[64 * j]; }
        float s[2];
#pragma unroll
        for (int q = 0; q < 2; ++q) { float a = 0.f;
#pragma unroll
            for (int j = 0; j < 4; ++j) a += (v[q][j].x * v[q][j].x + v[q][j].y * v[q][j].y) + (v[q][j].z * v[q][j].z + v[q][j].w * v[q][j].w);
            s[q] = a; }
#pragma unroll
        for (int o = 1; o < 64; o <<= 1) { s[0] += SHFL_XOR(s[0], o); s[1] += SHFL_XOR(s[1], o); }
#pragma unroll
        for (int q = 0; q < 2; ++q) { const int m = m0 + q * NGW; if (m >= MTOK) break;
            const float rs = RSQ(s[q] * (1.0f / DM) + NORM_EPS);
            f32x4* o = (f32x4*)(out + (size_t)m * DM) + F.lane;
#pragma unroll
            for (int j = 0; j < 4; ++j) o[64 * j] = v[q][j] * rs * wv[j]; }
#pragma unroll
        for (int q = 0; q < 2; ++q)
#pragma unroll
            for (int j = 0; j < 4; ++j) v[q][j] = vn[q][j];
    }
}
DEV void ph_finalnorm16(const Ctx& F, const bf16* x16, const float* nw, float* out) {
    const int gw = F.bid * 8 + F.wave, NGW = F.G * 8;
    f32x4 wv[2][2];
#pragma unroll
    for (int j = 0; j < 2; ++j) { wv[j][0] = *(const f32x4*)(nw + 8 * F.lane + 512 * j); wv[j][1] = *(const f32x4*)(nw + 8 * F.lane + 512 * j + 4); }
    u32x4 v[4][2], vn[4][2];
#pragma unroll
    for (int q = 0; q < 4; ++q) { const int m = gw + q * NGW; const bf16* xr = x16 + (size_t)(m < MTOK ? m : 0) * DM + 8 * F.lane;
        v[q][0] = *(const u32x4*)xr; v[q][1] = *(const u32x4*)(xr + 512); }
    for (int m0 = gw; m0 < MTOK; m0 += 4 * NGW) {
#pragma unroll
        for (int q = 0; q < 4; ++q) { const int m = m0 + (4 + q) * NGW; const bf16* xr = x16 + (size_t)(m < MTOK ? m : 0) * DM + 8 * F.lane;
            vn[q][0] = *(const u32x4*)xr; vn[q][1] = *(const u32x4*)(xr + 512); }
        float s[4];
#pragma unroll
        for (int q = 0; q < 4; ++q) { float a = 0.f;
#pragma unroll
            for (int j = 0; j < 2; ++j) { const u32x4 r = v[q][j];
                a += ((bflo(r.x) * bflo(r.x) + bfhi(r.x) * bfhi(r.x)) + (bflo(r.y) * bflo(r.y) + bfhi(r.y) * bfhi(r.y))) + ((bflo(r.z) * bflo(r.z) + bfhi(r.z) * bfhi(r.z)) + (bflo(r.w) * bflo(r.w) + bfhi(r.w) * bfhi(r.w))); }
            s[q] = a; }
#pragma unroll
        for (int o = 1; o < 64; o <<= 1) {
#pragma unroll
            for (int q = 0; q < 4; ++q) s[q] += SHFL_XOR(s[q], o); }
#pragma unroll
        for (int q = 0; q < 4; ++q) { const int m = m0 + q * NGW; if (m >= MTOK) break;
            const float rs = RSQ(s[q] * (1.0f / DM) + NORM_EPS);
            float* o = out + (size_t)m * DM + 8 * F.lane;
#pragma unroll
            for (int j = 0; j < 2; ++j) { const u32x4 r = v[q][j];
                *(f32x4*)(o + 512 * j) = (f32x4){bflo(r.x), bfhi(r.x), bflo(r.y), bfhi(r.y)} * rs * wv[j][0];
                *(f32x4*)(o + 512 * j + 4) = (f32x4){bflo(r.z), bfhi(r.z), bflo(r.w), bfhi(r.w)} * rs * wv[j][1]; } }
#pragma unroll
        for (int q = 0; q < 4; ++q) { v[q][0] = vn[q][0]; v[q][1] = vn[q][1]; }
    }
}
DEV void ph_zero_cat(const Ctx& F, int c0, int nq) {
    const int gw = F.bid * 8 + F.wave, NGW = F.G * 8;
    bf16* CAT = (bf16*)(F.ws + WS_CAT);
    for (int m = gw; m < MTOK; m += NGW) for (int q = 0; q < nq; ++q) *(u32x2*)(CAT + (size_t)m * DM + c0 + 256 * q + 4 * F.lane) = (u32x2){0u, 0u};
}
DEV float softcap15(float z) { return 15.0f * tanhf(z * (1.0f / 15.0f)); }
DEV float logsigmoidf_(float x) { return x >= 0.f ? -log1pf(expf(-x)) : x - log1pf(expf(x)); }
DEV void ph_prep(const Ctx& F, int l) {
    const int gw = F.bid * 8 + F.wave, NGW = F.G * 8, lane = F.lane;
    const bf16* PROJ = (const bf16*)(F.ws + WS_PROJ);
    bf16* QL = (bf16*)(F.ws + WS_QL); bf16* CKV = (bf16*)(F.ws + WS_CKV); bf16* KIDX = (bf16*)(F.ws + WS_KIDX);
    float* WI = (float*)(F.ws + WS_WI);
    const f32x4 qn = *(const f32x4*)(PIN(F, I_QNW) + l * 256 + 4 * lane);
    const float kn0 = PIN(F, I_KVNW)[l * 128 + 2 * lane], kn1 = PIN(F, I_KVNW)[l * 128 + 2 * lane + 1];
    u32x2 ra4[4], ran[4]; unsigned rk4[4], rx4[4], rkn[4], rxn[4];
#define PREP_LOAD(RA, RK, RX, M0) do { _Pragma("unroll") for (int q = 0; q < 4; ++q) { const int mm = (M0) + q * NGW; const bf16* pr = PROJ + (size_t)(mm < MTOK ? mm : 0) * NPROJ; \
            RA[q] = *(const u32x2*)(pr + PC_AQ + 4 * lane); RK[q] = *(const unsigned*)(pr + PC_AKV + 2 * lane); \
            RX[q] = lane < 16 ? *(const unsigned*)(pr + PC_IK + 2 * lane) : (lane < 24 ? (unsigned)pr[PC_IW + (lane - 16)] : 0u); } } while (0)
    PREP_LOAD(ra4, rk4, rx4, gw);
    for (int m0 = gw; m0 < MTOK; m0 += 4 * NGW) {
        PREP_LOAD(ran, rkn, rxn, m0 + 4 * NGW);
#pragma unroll
        for (int q = 0; q < 4; ++q) { const int m = m0 + q * NGW; if (m >= MTOK) break;
            const u32x2 ra = ra4[q]; const unsigned rk = rk4[q];
            const float a0 = bflo(ra.x), a1 = bfhi(ra.x), a2 = bflo(ra.y), a3 = bfhi(ra.y);
            const float k0 = bflo(rk), k1 = bfhi(rk);
            const float sq = wave_sum((a0 * a0 + a1 * a1) + (a2 * a2 + a3 * a3)), sk = wave_sum(k0 * k0 + k1 * k1);
            const float rq = RSQ(sq * (1.0f / 256.0f) + NORM_EPS), rk2 = RSQ(sk * (1.0f / 128.0f) + NORM_EPS);
            u32x2 oq; oq.x = pk2(a0 * rq * qn.x, a1 * rq * qn.y); oq.y = pk2(a2 * rq * qn.z, a3 * rq * qn.w);
            *(u32x2*)(QL + (size_t)m * 256 + 4 * lane) = oq;
            *(unsigned*)(CKV + (size_t)m * 128 + 2 * lane) = pk2(k0 * rk2 * kn0, k1 * rk2 * kn1);
            if (lane < 16) *(unsigned*)(KIDX + (size_t)m * 32 + 2 * lane) = rx4[q];
            else if (lane < 24) WI[(size_t)m * 8 + (lane - 16)] = bf2f(rx4[q]); }
#pragma unroll
        for (int q = 0; q < 4; ++q) { ra4[q] = ran[q]; rk4[q] = rkn[q]; rx4[q] = rxn[q]; }
    }
#undef PREP_LOAD
}

constexpr int XB_STRIDE = 264;
DEV void ph_lru1(const Ctx& F, int l) {
    const int tid = F.tid, lane = F.lane, w = F.wave, i16 = lane & 15, g = lane >> 4;
    bf16* XB = (bf16*)F.lds;
    float* XF = (float*)(F.lds + 64 * XB_STRIDE * 2);
    const bf16* PROJ = (const bf16*)(F.ws + WS_PROJ);
    bf16* HLOC = (bf16*)(F.ws + WS_HLOC); bf16* CPA = (bf16*)(F.ws + WS_CPA); float* LSUM = (float*)(F.ws + WS_LSUM);
    const int blk = w & 3, nh = w >> 2;
    const bf16* WG = (const bf16*)(F.ws + WS_WG) + (size_t)l * 2 * 4 * 4096;
    bf16x8 Bf[2][2][2];
#pragma unroll
    for (int gg = 0; gg < 2; ++gg)
#pragma unroll
        for (int nt = 0; nt < 2; ++nt)
#pragma unroll
            for (int ks = 0; ks < 2; ++ks) Bf[gg][nt][ks] = *(const bf16x8*)(WG + ((size_t)(gg * 4 + blk) * 64 + nh * 32 + 2 * i16 + nt) * 64 + ks * 32 + 8 * g);
    float ba[2], bx[2], sp[2];
#pragma unroll
    for (int nt = 0; nt < 2; ++nt) { const int ch = blk * 64 + nh * 32 + 2 * i16 + nt;
        ba[nt] = PIN(F, I_BA)[l * 256 + ch]; bx[nt] = PIN(F, I_BX)[l * 256 + ch];
        const float lam = PIN(F, I_LAM)[l * 256 + ch]; sp[nt] = lam > 0.f ? log1pf(expf(-lam)) : -lam + log1pf(expf(lam)); }
    const int ch2 = tid & 127, tg = tid >> 7;
    float cw[4][2], cb[2];
#pragma unroll
    for (int j = 0; j < 4; ++j) { cw[j][0] = PIN(F, I_CONVW)[(l * 4 + j) * 256 + 2 * ch2]; cw[j][1] = PIN(F, I_CONVW)[(l * 4 + j) * 256 + 2 * ch2 + 1]; }
    cb[0] = PIN(F, I_CONVB)[l * 256 + 2 * ch2]; cb[1] = PIN(F, I_CONVB)[l * 256 + 2 * ch2 + 1];

    for (int u = F.bid; u < BATCH * 64; u += F.G) {
        const int b = u >> 6, c = u & 63, t0 = c * 64; const size_t m0 = (size_t)b * SEQ + t0;
        {
            const int tl0 = tg * 16;
            unsigned rv[19];
#pragma unroll
            for (int j = 0; j < 3; ++j) { const int t = t0 + tl0 - 3 + j; rv[j] = t >= 0 ? *(const unsigned*)(PROJ + ((size_t)b * SEQ + t) * NPROJ + PC_LX + 2 * ch2) : 0u; }
#pragma unroll
            for (int tt = 0; tt < 16; ++tt) rv[3 + tt] = *(const unsigned*)(PROJ + (m0 + tl0 + tt) * NPROJ + PC_LX + 2 * ch2);
#pragma unroll
            for (int tt = 0; tt < 16; ++tt) { const int tl = tl0 + tt;
                const float x0 = cw[0][0] * bflo(rv[tt]) + cw[1][0] * bflo(rv[tt + 1]) + cw[2][0] * bflo(rv[tt + 2]) + cw[3][0] * bflo(rv[tt + 3]) + cb[0];
                const float x1 = cw[0][1] * bfhi(rv[tt]) + cw[1][1] * bfhi(rv[tt + 1]) + cw[2][1] * bfhi(rv[tt + 2]) + cw[3][1] * bfhi(rv[tt + 3]) + cb[1];
                *(unsigned*)(XB + tl * XB_STRIDE + 2 * ch2) = pk2(x0, x1);
                XF[tl * 256 + 2 * ch2] = x0; XF[tl * 256 + 2 * ch2 + 1] = x1; }
        }
        SYNC();
        float CA[2] = {1.f, 1.f}, CU[2] = {0.f, 0.f};
#pragma unroll 1
        for (int m = 0; m < 4; ++m) {
            f32x4 acc[2][2];
#pragma unroll
            for (int gg = 0; gg < 2; ++gg)
#pragma unroll
                for (int nt = 0; nt < 2; ++nt) acc[gg][nt] = (f32x4){0.f, 0.f, 0.f, 0.f};
#pragma unroll
            for (int ks = 0; ks < 2; ++ks) { const bf16x8 A = *(const bf16x8*)(XB + (m * 16 + i16) * XB_STRIDE + blk * 64 + ks * 32 + 8 * g);
#pragma unroll
                for (int gg = 0; gg < 2; ++gg)
#pragma unroll
                    for (int nt = 0; nt < 2; ++nt) acc[gg][nt] = MFMA16(A, Bf[gg][nt][ks], acc[gg][nt]); }
            float HL[2][4], CP[2][4];
            const int chb = blk * 64 + nh * 32 + 2 * i16;
            float xf[4][2];
#pragma unroll
            for (int r = 0; r < 4; ++r) { const float* xp = XF + (m * 16 + 4 * g + r) * 256 + chb; xf[r][0] = xp[0]; xf[r][1] = xp[1]; }
#pragma unroll
            for (int nt = 0; nt < 2; ++nt) {
                float P[4], H[4]; float pa = 1.f, hu = 0.f;
#pragma unroll
                for (int r = 0; r < 4; ++r) {
                    const float rg = fsigmoid(acc[0][nt][r] + ba[nt]), gi = fsigmoid(acc[1][nt][r] + bx[nt]);
                    const float la = -8.0f * rg * sp[nt], a = FEXP(la), uu = FSQRT((1.0f - a) * (1.0f + a)) * (gi * xf[r][nt]);
                    pa = a * pa; hu = a * hu + uu; P[r] = pa; H[r] = hu;
                    }
                float EA = 1.f, EU = 0.f, TA = 1.f, TU = 0.f;
#pragma unroll
                for (int gg = 0; gg < 4; ++gg) { const float ta = SHFL(pa, i16 + 16 * gg), tu = SHFL(hu, i16 + 16 * gg);
                    if (gg < g) { EU = ta * EU + tu; EA = ta * EA; }
                    TU = ta * TU + tu; TA = ta * TA; }
                const float XA = EA * CA[nt], XU = EA * CU[nt] + EU;
#pragma unroll
                for (int r = 0; r < 4; ++r) { HL[nt][r] = P[r] * XU + H[r]; CP[nt][r] = P[r] * XA; }
                CU[nt] = TA * CU[nt] + TU; CA[nt] = TA * CA[nt];
            }
#pragma unroll
            for (int r = 0; r < 4; ++r) { const size_t o = (m0 + m * 16 + 4 * g + r) * 256 + chb;
                *(unsigned*)(HLOC + o) = pk2(HL[0][r], HL[1][r]); *(unsigned*)(CPA + o) = pk2(CP[0][r], CP[1][r]); }
        }
        if (g == 0) {
#pragma unroll
            for (int nt = 0; nt < 2; ++nt) { const int ch = blk * 64 + nh * 32 + 2 * i16 + nt;
                LSUM[((size_t)b * 64 + c) * 256 + ch] = CA[nt]; LSUM[(size_t)BATCH * 64 * 256 + ((size_t)b * 64 + c) * 256 + ch] = CU[nt]; }
        }
        SYNC();
    }
}

DEV float gelu_tanh(float x) { const float z = 0.7978845608028654f * (x + 0.044715f * x * x * x); return x * FRCP(1.0f + FEXP(-2.0f * z)); }
DEV void ph_carry(const Ctx& F) {
    if (F.wave != 0) return;
    const float* LSUM = (const float*)(F.ws + WS_LSUM); float* CARRY = (float*)(F.ws + WS_CARRY);
    const int seg = F.lane & 3;
    for (int chain = F.bid * 16 + (F.lane >> 2); chain < BATCH * 256; chain += F.G * 16) {
        const int b = chain >> 8, ch = chain & 255; const size_t o0 = ((size_t)b * 64 + seg * 16) * 256 + ch;
        float a[16], hb[16];
#pragma unroll
        for (int i = 0; i < 16; ++i) { a[i] = LSUM[o0 + (size_t)i * 256]; hb[i] = LSUM[(size_t)BATCH * 64 * 256 + o0 + (size_t)i * 256]; }
        float hp[16], ap[16], hl = 0.f, al = 1.f;
#pragma unroll
        for (int i = 0; i < 16; ++i) { hp[i] = hl; ap[i] = al; hl = a[i] * hl + hb[i]; al = a[i] * al; }
        float cin = 0.f;
#pragma unroll
        for (int s2 = 0; s2 < 3; ++s2) { const float as = SHFL(al, (F.lane & ~3) + s2), hs = SHFL(hl, (F.lane & ~3) + s2); if (s2 < seg) cin = as * cin + hs; }
#pragma unroll
        for (int i = 0; i < 16; ++i) CARRY[o0 + (size_t)i * 256] = ap[i] * cin + hp[i];
    }
}
DEV void ph_lru2(const Ctx& F, int l) {
    const int tid = F.tid, lane = F.lane, w = F.wave;
    const bf16* PROJ = (const bf16*)(F.ws + WS_PROJ); const bf16* HLOC = (const bf16*)(F.ws + WS_HLOC); const bf16* CPA = (const bf16*)(F.ws + WS_CPA);
    const float* CARRY = (const float*)(F.ws + WS_CARRY); bf16* CAT = (bf16*)(F.ws + WS_CAT);
    const f32x4 gw4 = *(const f32x4*)(PIN(F, I_GNW) + l * DM + 4 * lane);
    for (int u = F.bid; u < BATCH * 64; u += F.G) {
        const int b = u >> 6, c = u & 63; const size_t m0 = (size_t)b * SEQ + c * 64;
        const f32x4 car = *(const f32x4*)(CARRY + (size_t)u * 256 + 4 * lane);
        u32x2 hl8[8], cp8[8], ly8[8];
#pragma unroll
        for (int tt = 0; tt < 8; ++tt) { const size_t m = m0 + w * 8 + tt;
            hl8[tt] = *(const u32x2*)(HLOC + m * 256 + 4 * lane); cp8[tt] = *(const u32x2*)(CPA + m * 256 + 4 * lane); ly8[tt] = *(const u32x2*)(PROJ + m * NPROJ + PC_LY + 4 * lane); }
#pragma unroll
        for (int tt = 0; tt < 8; ++tt) { const size_t m = m0 + w * 8 + tt; const u32x2 hl = hl8[tt], cp = cp8[tt], ly = ly8[tt];
            float v0 = (bflo(hl.x) + bflo(cp.x) * car.x) * gelu_tanh(bflo(ly.x));
            float v1 = (bfhi(hl.x) + bfhi(cp.x) * car.y) * gelu_tanh(bfhi(ly.x));
            float v2 = (bflo(hl.y) + bflo(cp.y) * car.z) * gelu_tanh(bflo(ly.y));
            float v3 = (bfhi(hl.y) + bfhi(cp.y) * car.w) * gelu_tanh(bfhi(ly.y));
            const float rs = RSQ(wave_sum((v0 * v0 + v1 * v1) + (v2 * v2 + v3 * v3)) * (1.0f / 256.0f) + NORM_EPS);
            u32x2 o; o.x = pk2(v0 * rs * gw4.x, v1 * rs * gw4.y); o.y = pk2(v2 * rs * gw4.z, v3 * rs * gw4.w);
            *(u32x2*)(CAT + m * DM + 4 * lane) = o; }
    }
}

constexpr int QS_STRIDE = 136, VE_STRIDE = 56;
DEV void ph_mlstm(const Ctx& F, int l) {
    const int tid = F.tid, lane = F.lane, w = F.wave, i16 = lane & 15, g = lane >> 4;
    bf16* QsB = (bf16*)F.lds;
    bf16* KsB = QsB + 2 * 64 * QS_STRIDE;
    bf16* VE = KsB + 2 * 64 * QS_STRIDE;
    bf16* VW = VE + 64 * VE_STRIDE;
    bf16* CsB = VW + 64 * VE_STRIDE;
    float* BCB = (float*)(CsB + 2 * 128 * VE_STRIDE);
    float* BIB = BCB + 128;
    const bf16* PROJ = (const bf16*)(F.ws + WS_PROJ); bf16* HM = (bf16*)(F.ws + WS_HM);
    const float qscale = 0.08838834764831845f;
    const int jt = w & 3, half = w >> 2;
    for (int u = F.bid; u < BATCH * 4 * 4; u += F.G) {
        const int b = u >> 4, h = (u >> 2) & 3, vs = u & 3;
        const float gbi = PIN(F, I_BI)[l * 4 + h], gbf = PIN(F, I_BF)[l * 4 + h];
        f32x4 accC[3];
#pragma unroll
        for (int nt = 0; nt < 3; ++nt) accC[nt] = (f32x4){0.f, 0.f, 0.f, 0.f};
        float* BCg = (float*)(F.ws + WS_MG) + (size_t)u * 8192; float* BIg = BCg + 4096;
        unsigned gri[8], grf[8];
#pragma unroll
        for (int k = 0; k < 8; ++k) { const bf16* pr = PROJ + ((size_t)b * SEQ + (8 * k + w) * 64 + lane) * NPROJ; gri[k] = pr[PC_MI + h]; grf[k] = pr[PC_MF + h]; }
#pragma unroll
        for (int k = 0; k < 8; ++k) { const int tok = (8 * k + w) * 64 + lane;
            const float zi = (bf2f(gri[k]) + gbi) * (1.0f / 15.0f), zf = (bf2f(grf[k]) + gbf) * (1.0f / 15.0f);
            const float ig = 15.0f - 30.0f * FRCP(FEXP(2.0f * zi) + 1.0f), fg = 15.0f - 30.0f * FRCP(FEXP(2.0f * zf) + 1.0f);
            float s = -FLOG(1.0f + FEXP(-fg));
#pragma unroll
            for (int o = 1; o < 64; o <<= 1) { const float t = SHFL_UP(s, o); if (lane >= o) s += t; }
            BCg[tok] = s; BIg[tok] = s - ig; }
        SYNC();
        u32x4 rq[2], rk[2]; u32x2 rvv; float rgc = 0.f, rgb = 0.f;
        {
            const size_t m0 = (size_t)b * SEQ;
#pragma unroll
            for (int i = 0; i < 2; ++i) { const int idx = tid + 512 * i, row = idx >> 4, ck = idx & 15;
                rq[i] = *(const u32x4*)(PROJ + (m0 + row) * NPROJ + PC_MQ + h * 128 + 8 * ck); rk[i] = *(const u32x4*)(PROJ + (m0 + row) * NPROJ + PC_MK + h * 128 + 8 * ck); }
            rvv = *(const u32x2*)(PROJ + (m0 + (tid >> 3)) * NPROJ + PC_MV + h * 128 + vs * 32 + 4 * (tid & 7));
            if (tid < 64) { rgc = BCg[tid]; rgb = BIg[tid]; }
        }
        for (int c = 0; c < 64; ++c) {
            const size_t m0 = (size_t)b * SEQ + c * 64; const int buf = c & 1;
            bf16* Qs = QsB + buf * 64 * QS_STRIDE; bf16* Ks = KsB + buf * 64 * QS_STRIDE; const bf16* Cs = CsB + buf * 128 * VE_STRIDE; bf16* Cn = CsB + (buf ^ 1) * 128 * VE_STRIDE;
            float* BC = BCB + buf * 64; float* BI = BIB + buf * 64;
#pragma unroll
            for (int i = 0; i < 2; ++i) { const int idx = tid + 512 * i, row = idx >> 4, ck = idx & 15;
                *(u32x4*)(Qs + row * QS_STRIDE + 8 * ck) = rq[i]; *(u32x4*)(Ks + row * QS_STRIDE + 8 * ck) = rk[i]; }
            if (tid < 64) { BC[tid] = rgc; BI[tid] = rgb; }
            SYNC();
            {
                const int row = tid >> 3, cg = tid & 7;
                const u32x2 rv = rvv;
                const float wt = FEXP(BC[63] - BI[row]);
                *(u32x2*)(VE + row * VE_STRIDE + 4 * cg) = rv;
                u32x2 sv; sv.x = pk2(bflo(rv.x) * wt, bfhi(rv.x) * wt); sv.y = pk2(bflo(rv.y) * wt, bfhi(rv.y) * wt);
                *(u32x2*)(VW + row * VE_STRIDE + 4 * cg) = sv;
                if (cg == 0) { unsigned one_ = 0x3f80u; LAUNDER_V(one_); u32x4 z = (u32x4){one_, 0u, 0u, 0u}; *(u32x4*)(VE + row * VE_STRIDE + 32) = z; *(u32x4*)(VE + row * VE_STRIDE + 40) = (u32x4){0u, 0u, 0u, 0u};
                    z.x = f2bf(wt); *(u32x4*)(VW + row * VE_STRIDE + 32) = z; *(u32x4*)(VW + row * VE_STRIDE + 40) = (u32x4){0u, 0u, 0u, 0u}; }
            }
            if (c + 1 < 64) {
                const size_t m1 = m0 + 64;
#pragma unroll
                for (int i = 0; i < 2; ++i) { const int idx = tid + 512 * i, row = idx >> 4, ck = idx & 15;
                    rq[i] = *(const u32x4*)(PROJ + (m1 + row) * NPROJ + PC_MQ + h * 128 + 8 * ck); rk[i] = *(const u32x4*)(PROJ + (m1 + row) * NPROJ + PC_MK + h * 128 + 8 * ck); }
                rvv = *(const u32x2*)(PROJ + (m1 + (tid >> 3)) * NPROJ + PC_MV + h * 128 + vs * 32 + 4 * (tid & 7));
                if (tid < 64) { rgc = BCg[(c + 1) * 64 + tid]; rgb = BIg[(c + 1) * 64 + tid]; }
            }
            SYNC();
            f32x4 Z[2] = {(f32x4){0.f, 0.f, 0.f, 0.f}, (f32x4){0.f, 0.f, 0.f, 0.f}};
            {
                bf16x8 Bq[4];
#pragma unroll
                for (int ks = 0; ks < 4; ++ks) Bq[ks] = *(const bf16x8*)(Qs + (16 * jt + i16) * QS_STRIDE + 32 * ks + 8 * g);
                const float bj = BC[16 * jt + i16];
                unsigned pk[4][2];
#pragma unroll
                for (int tt = 0; tt < 4; ++tt) {
                    if (tt <= jt) {
                        f32x4 X = (f32x4){0.f, 0.f, 0.f, 0.f};
#pragma unroll
                        for (int ks = 0; ks < 4; ++ks) X = MFMA16(*(const bf16x8*)(Ks + (16 * tt + i16) * QS_STRIDE + 32 * ks + 8 * g), Bq[ks], X);
                        float p[4]; const f32x4 bi4 = *(const f32x4*)(BI + 16 * tt + 4 * g);
#pragma unroll
                        for (int r = 0; r < 4; ++r) { const float pv = X[r] * qscale * FEXP(fminf(bj - bi4[r], 60.0f));
                            p[r] = (tt < jt || 4 * g + r <= i16) ? pv : 0.f; }
                        pk[tt][0] = pk2(p[0], p[1]); pk[tt][1] = pk2(p[2], p[3]);
                    } else { pk[tt][0] = 0u; pk[tt][1] = 0u; }
                }
#pragma unroll
                for (int pr = 0; pr < 2; ++pr) {
                    if (2 * pr <= jt) {
                        u32x4 aw = (u32x4){pk[2 * pr][0], pk[2 * pr][1], pk[2 * pr + 1][0], pk[2 * pr + 1][1]};
                        const bf16x8 A = __builtin_bit_cast(bf16x8, aw);
#pragma unroll
                        for (int n = 0; n < 2; ++n) { const int ntc = n ? 2 : half;
                            const s16x4 lo = TR16(VE + (32 * pr + 4 * g + (i16 >> 2)) * VE_STRIDE + 16 * ntc + 4 * (i16 & 3));
                            const s16x4 hi = TR16(VE + (32 * pr + 16 + 4 * g + (i16 >> 2)) * VE_STRIDE + 16 * ntc + 4 * (i16 & 3));
                            const bf16x8 B = (bf16x8){lo[0], lo[1], lo[2], lo[3], hi[0], hi[1], hi[2], hi[3]};
                            Z[n] = MFMA16(A, B, Z[n]); }
#ifndef HOST_EMU
                        asm volatile("" :: "v"(aw));
#endif
                    }
                }
            }
            if (c > 0) {
                f32x4 Z2[2] = {(f32x4){0.f, 0.f, 0.f, 0.f}, (f32x4){0.f, 0.f, 0.f, 0.f}};
#pragma unroll
                for (int ks = 0; ks < 4; ++ks) { const bf16x8 A = *(const bf16x8*)(Qs + (16 * jt + i16) * QS_STRIDE + 32 * ks + 8 * g);
#pragma unroll
                    for (int n = 0; n < 2; ++n) { const int ntc = n ? 2 : half;
                        const s16x4 lo = TR16(Cs + (32 * ks + 8 * g + (i16 >> 2)) * VE_STRIDE + 16 * ntc + 4 * (i16 & 3));
                        const s16x4 hi = TR16(Cs + (32 * ks + 8 * g + 4 + (i16 >> 2)) * VE_STRIDE + 16 * ntc + 4 * (i16 & 3));
                        const bf16x8 B = (bf16x8){lo[0], lo[1], lo[2], lo[3], hi[0], hi[1], hi[2], hi[3]};
                        Z2[n] = MFMA16(A, B, Z2[n]); } }
                const f32x4 bc4 = *(const f32x4*)(BC + 16 * jt + 4 * g);
#pragma unroll
                for (int r = 0; r < 4; ++r) { const float f = qscale * FEXP(bc4[r]); Z[0][r] += f * Z2[0][r]; Z[1][r] += f * Z2[1][r]; }
            }
#pragma unroll
            for (int r = 0; r < 4; ++r) { const int j = 16 * jt + 4 * g + r; const float dn = FRCP(fmaxf(fabsf(SHFL(Z[1][r], lane & 48)), 1.0f));
                HM[(m0 + j) * 512 + h * 128 + vs * 32 + 16 * half + i16] = (bf16)f2bf(Z[0][r] * dn); }
            {
                const float dec = FEXP(BC[63]);
#pragma unroll
                for (int nt = 0; nt < 3; ++nt) accC[nt] = accC[nt] * dec;
#pragma unroll
                for (int ks = 0; ks < 2; ++ks) {
                    const s16x4 alo = TR16(Ks + (32 * ks + 8 * g + (i16 >> 2)) * QS_STRIDE + 16 * w + 4 * (i16 & 3));
                    const s16x4 ahi = TR16(Ks + (32 * ks + 8 * g + 4 + (i16 >> 2)) * QS_STRIDE + 16 * w + 4 * (i16 & 3));
                    const bf16x8 A = (bf16x8){alo[0], alo[1], alo[2], alo[3], ahi[0], ahi[1], ahi[2], ahi[3]};
#pragma unroll
                    for (int nt = 0; nt < 3; ++nt) {
                        const s16x4 lo = TR16(VW + (32 * ks + 8 * g + (i16 >> 2)) * VE_STRIDE + 16 * nt + 4 * (i16 & 3));
                        const s16x4 hi = TR16(VW + (32 * ks + 8 * g + 4 + (i16 >> 2)) * VE_STRIDE + 16 * nt + 4 * (i16 & 3));
                        const bf16x8 B = (bf16x8){lo[0], lo[1], lo[2], lo[3], hi[0], hi[1], hi[2], hi[3]};
                        const f32x4 cold = accC[nt]; accC[nt] = MFMA16(A, B, cold);
#ifndef HOST_EMU
                        asm volatile("" :: "v"(cold), "v"(A), "v"(B));
#endif
                    }
                }
#pragma unroll
                for (int nt = 0; nt < 3; ++nt)
#pragma unroll
                    for (int r = 0; r < 4; ++r) Cn[(16 * w + 4 * g + r) * VE_STRIDE + 16 * nt + i16] = (bf16)f2bf(accC[nt][r]);
            }
        }
        SYNC();
    }
}

DEV void ph_mfin(const Ctx& F, int l) {
    const int gw = F.bid * 8 + F.wave, NGW = F.G * 8, lane = F.lane;
    const bf16* PROJ = (const bf16*)(F.ws + WS_PROJ); const bf16* HM = (const bf16*)(F.ws + WS_HM); bf16* CAT = (bf16*)(F.ws + WS_CAT);
    float gm[8];
#pragma unroll
    for (int j = 0; j < 8; ++j) gm[j] = PIN(F, I_GNW)[l * DM + 256 + 8 * lane + j];
    u32x4 hv4[4], ov4[4], hvn[4], ovn[4];
#define MFIN_LOAD(HV, OV, M0) do { _Pragma("unroll") for (int q = 0; q < 4; ++q) { const int mm = (M0) + q * NGW; const size_t ms = (size_t)(mm < MTOK ? mm : 0); \
            HV[q] = *(const u32x4*)(HM + ms * 512 + 8 * lane); OV[q] = *(const u32x4*)(PROJ + ms * NPROJ + PC_MO + 8 * lane); } } while (0)
    MFIN_LOAD(hv4, ov4, gw);
    for (int m0 = gw; m0 < MTOK; m0 += 4 * NGW) {
        MFIN_LOAD(hvn, ovn, m0 + 4 * NGW);
#pragma unroll
        for (int q = 0; q < 4; ++q) { const int m = m0 + q * NGW; if (m >= MTOK) break;
            const u32x4 hv = hv4[q], ov = ov4[q];
            float v[8] = {bflo(hv.x), bfhi(hv.x), bflo(hv.y), bfhi(hv.y), bflo(hv.z), bfhi(hv.z), bflo(hv.w), bfhi(hv.w)};
            const float o[8] = {bflo(ov.x), bfhi(ov.x), bflo(ov.y), bfhi(ov.y), bflo(ov.z), bfhi(ov.z), bflo(ov.w), bfhi(ov.w)};
            float s = 0.f;
#pragma unroll
            for (int j = 0; j < 8; ++j) s += v[j] * v[j];
            s += SHFL_XOR(s, 1); s += SHFL_XOR(s, 2); s += SHFL_XOR(s, 4); s += SHFL_XOR(s, 8);
            const float rs = RSQ(s * (1.0f / 128.0f) + NORM_EPS);
            u32x4 r;
            r.x = pk2(v[0] * rs * gm[0] * fsigmoid(o[0]), v[1] * rs * gm[1] * fsigmoid(o[1]));
            r.y = pk2(v[2] * rs * gm[2] * fsigmoid(o[2]), v[3] * rs * gm[3] * fsigmoid(o[3]));
            r.z = pk2(v[4] * rs * gm[4] * fsigmoid(o[4]), v[5] * rs * gm[5] * fsigmoid(o[5]));
            r.w = pk2(v[6] * rs * gm[6] * fsigmoid(o[6]), v[7] * rs * gm[7] * fsigmoid(o[7]));
            *(u32x4*)(CAT + (size_t)m * DM + 256 + 8 * lane) = r; }
#pragma unroll
        for (int q = 0; q < 4; ++q) { hv4[q] = hvn[q]; ov4[q] = ovn[q]; }
    }
#undef MFIN_LOAD
}

constexpr int DS_HIST = 0;
constexpr int DS_MASK = 49152;
constexpr int DS_CAND = 65536;
constexpr int DS_SELL = 102400;
constexpr int DS_META = 118784;
constexpr int DS_RB = DS_META + 512;
constexpr int DS_SS = DS_RB + 2048;
constexpr int DS_SLOT = 12800;
constexpr int NBIN = 768, CAND_CAP = 128;
__device__ const unsigned char T5B[114] = {0, 1, 2, 3, 4, 5, 6, 7, 8, 9, 10, 11, 12, 13, 14, 15, 16, 16, 16, 17, 17, 18, 18, 18, 19, 19, 19, 20, 20, 20, 20, 21, 21, 21, 21, 22, 22, 22, 22, 22, 23, 23, 23, 23, 23, 23, 24, 24, 24, 24, 24, 24, 25, 25, 25, 25, 25, 25, 25, 26, 26, 26, 26, 26, 26, 26, 26, 27, 27, 27, 27, 27, 27, 27, 27, 27, 27, 28, 28, 28, 28, 28, 28, 28, 28, 28, 28, 29, 29, 29, 29, 29, 29, 29, 29, 29, 29, 29, 29, 30, 30, 30, 30, 30, 30, 30, 30, 30, 30, 30, 30, 30, 30, 31};

DEV int score_bin(float sc) {
    const unsigned u = __builtin_bit_cast(unsigned, sc);
    int e = (int)((u >> 18) & 0x1FFFu) - 119 * 32; e = e < 0 ? 0 : (e > 383 ? 383 : e);
    return (u >> 31) ? 383 - e : 384 + e;
}
DEV unsigned score_key(float sc) { const unsigned u = __builtin_bit_cast(unsigned, sc); return (u >> 31) ? ~u : (u | 0x80000000u); }
DEV unsigned score_code(float sc) {
    const unsigned u = __builtin_bit_cast(unsigned, sc);
    int e = (int)((u >> 18) & 0x1FFFu) - 119 * 32; e = e < 0 ? 0 : (e > 383 ? 383 : e);
    return ((u >> 16) & 0x8000u) | ((unsigned)e << 6) | ((u >> 12) & 63u);
}
DEV int code_bin(unsigned c) { const int e = (int)((c >> 6) & 0x1FFu); return (c & 0x8000u) ? 383 - e : 384 + e; }
DEV unsigned code_key(unsigned c) { return (c & 0x8000u) ? 63u - (c & 63u) : (c & 63u); }


DEV f32x4 dsa_score_tile(const bf16x8 A, const bf16x8 (&QS)[2], const bf16x8 (&Bq)[8], const float (&wq)[8]) {
    f32x4 sc = (f32x4){0.f, 0.f, 0.f, 0.f};
#pragma unroll
    for (int h = 0; h < 8; ++h) { const f32x4 d = MFMA16(A, Bq[h], (f32x4){0.f, 0.f, 0.f, 0.f});
#pragma unroll
        for (int r = 0; r < 4; ++r) sc[r] += wq[h] * RELU(d[r]); }
    return sc;
}
DEV void ph_dsa(const Ctx& F, int l) {
    const int tid = F.tid, lane = F.lane, w = F.wave, i16 = lane & 15, g = lane >> 4;
    unsigned* HIST = (unsigned*)(F.lds + DS_HIST); unsigned* MASK = (unsigned*)(F.lds + DS_MASK); u32x2* CAND = (u32x2*)(F.lds + DS_CAND);
    unsigned short* SELL = (unsigned short*)(F.lds + DS_SELL); int* BST = (int*)(F.lds + DS_META); int* NAB = BST + 32; int* NCAND = BST + 64; int* NSEL = BST + 96;
    float* RB = (float*)(F.lds + DS_RB);
    const bf16* QIDX = (const bf16*)(F.ws + WS_QIDX); const bf16* KIDX = (const bf16*)(F.ws + WS_KIDX); const float* WI = (const float*)(F.ws + WS_WI);
    const bf16* QABS = (const bf16*)(F.ws + WS_QABS); const bf16* CKV = (const bf16*)(F.ws + WS_CKV); bf16* CAT = (bf16*)(F.ws + WS_CAT);
    const bf16* WUVT = (const bf16*)(F.ws + WS_WUVT) + (size_t)l * 4 * 64 * 128; float* SS = (float*)(F.lds + DS_SS);
    for (int e = tid; e < 114 * 4; e += 512) RB[e] = PIN(F, I_RELB)[T5B[e >> 2] * 4 + (e & 3)] * 1.4426950408889634f;
    SYNC();
    for (int ui = F.bid; ui < BATCH * 128; ui += F.G) {
        int b, qt; { const int wv = ui & 255, k = ui >> 8, r = wv & 15; b = wv >> 4; qt = (k & 1) ? (32 * (k >> 1) + 31 - r) : (32 * (k >> 1) + r); }
        const int t0 = 32 * qt, nkt = 2 * qt + 2; const size_t mb = (size_t)b * SEQ;
        const GAS char* const ckvb = UNIP(CKV + mb * 128);
        const int nt = w & 1;
        u32x2* sw = (u32x2*)(F.ws + (F.bid < 128 ? WS_QL + (size_t)F.bid * 262144 : WS_SCR2 + (size_t)(F.bid - 128) * 262144) + (size_t)w * 32768) + lane;
        bf16x8 Bq[8]; float wq[8];
        { const size_t mq = mb + t0 + 16 * nt + i16;
#pragma unroll
            for (int h = 0; h < 8; ++h) { Bq[h] = *(const bf16x8*)(QIDX + mq * 256 + 32 * h + 8 * g); wq[h] = WI[mq * 8 + h]; } }
        bf16x8 QS[2];
#pragma unroll
        for (int j = 0; j < 8; ++j) { float s = 0.f;
#pragma unroll
            for (int h = 0; h < 8; ++h) s += wq[h] * bf2f((unsigned)(unsigned short)Bq[h][j]);
            const unsigned hi = f2bf(s); QS[0][j] = (short)hi; QS[1][j] = (short)f2bf(s - bf2f(hi)); }
        for (int e = tid; e < 16 * NBIN; e += 512) HIST[e] = 0u;
        for (int e = tid; e < 32 * 128; e += 512) MASK[e] = 0u;
        if (tid < 32) NCAND[tid] = 0;
        SYNC();
        bf16x8 Apre = *(const bf16x8*)(KIDX + (mb + 16 * (w >> 1) + i16) * 32 + 8 * g);
        for (int kt = w >> 1; kt < nkt; kt += 4) {
            const bf16x8 A = Apre;
            { const int kn = kt + 4 < nkt ? kt + 4 : kt; Apre = *(const bf16x8*)(KIDX + (mb + 16 * kn + i16) * 32 + 8 * g); }
            const f32x4 sc = dsa_score_tile(A, QS, Bq, wq);
            unsigned cd[4];
#pragma unroll
            for (int r = 0; r < 4; ++r) cd[r] = score_code(sc[r] + 0.0f);
            { u32x2 pk; pk.x = cd[0] | (cd[1] << 16); pk.y = cd[2] | (cd[3] << 16); sw[(size_t)((kt - (w >> 1)) >> 2) * 64] = pk; }
            const unsigned inc = nt ? 65536u : 1u;
            if (kt < 2 * qt) {
#pragma unroll
                for (int r = 0; r < 4; ++r) atomicAdd(&HIST[i16 * NBIN + code_bin(cd[r])], inc);
            } else {
                const int t = t0 + 16 * nt + i16;
#pragma unroll
                for (int r = 0; r < 4; ++r) { const int s = 16 * kt + 4 * g + r;
                    if (s <= t) atomicAdd(&HIST[i16 * NBIN + code_bin(cd[r])], inc); }
            }
        }
        SYNC();
#pragma unroll 1
        for (int rr = 0; rr < 4; ++rr) {
            const int row = 4 * w + rr, t = t0 + row;
            if (t < 256) { if (lane == 0) { BST[row] = -1; NAB[row] = t + 1; } continue; }
            const int sh = (row >> 4) * 16; const unsigned* hp = HIST + (row & 15) * NBIN + 12 * lane;
            int cnt[12]; int tot = 0;
#pragma unroll
            for (int i = 0; i < 12; ++i) { cnt[i] = (int)((hp[i] >> sh) & 0xFFFFu); tot += cnt[i]; }
            int suf = tot;
#pragma unroll
            for (int o = 1; o < 64; o <<= 1) { const int v = SHFL_DOWN(suf, o); if (lane + o < 64) suf += v; }
            const int above = suf - tot;
            if (above < 256 && above + tot >= 256) {
                int run = above, bs = -1, na = 0; bool done = false;
#pragma unroll
                for (int i = 11; i >= 0; --i) { if (!done) { if (run + cnt[i] >= 256) { bs = 12 * lane + i; na = run; done = true; } else run += cnt[i]; } }
                BST[row] = bs; NAB[row] = na;
            }
        }
        SYNC();
        { const int row = 16 * nt + i16, t = t0 + row, bs = BST[row];
        const int ntl = nkt > (w >> 1) ? ((nkt - 1 - (w >> 1)) >> 2) + 1 : 0;
        u32x2 P0 = sw[0], P1 = sw[(size_t)(1 < ntl ? 1 : 0) * 64];
        for (int j = 0; j < ntl; ++j) { const int kt = (w >> 1) + 4 * j;
            const u32x2 pc = P0; P0 = P1; P1 = sw[(size_t)(j + 2 < ntl ? j + 2 : j) * 64];
            const bool full = kt < 2 * qt;
#pragma unroll
            for (int r = 0; r < 4; ++r) { const int s = 16 * kt + 4 * g + r;
                if (full || s <= t) { const unsigned wd = r < 2 ? pc.x : pc.y; const unsigned c = (r & 1) ? (wd >> 16) : (wd & 0xffffu); const int bn = code_bin(c);
                    if (bn > bs) atomicOr(&MASK[row * 128 + (s >> 5)], 1u << (s & 31));
                    else if (bn == bs) { const int pos = (int)atomicAdd((unsigned*)&NCAND[row], 1u); if (pos < CAND_CAP) CAND[row * CAND_CAP + pos] = (u32x2){code_key(c), (unsigned)s}; } } }
        } }
        SYNC();
#pragma unroll 1
        for (int rr = 0; rr < 4; ++rr) {
            const int row = 4 * w + rr; if (BST[row] < 0) continue;
            const int n = NCAND[row] < CAND_CAP ? NCAND[row] : CAND_CAP, need = 256 - NAB[row];
            for (int i = lane; i < n; i += 64) { const u32x2 me = CAND[row * CAND_CAP + i]; int rank = 0;
                for (int j = 0; j < n; ++j) { const u32x2 o = CAND[row * CAND_CAP + j]; rank += (o.x > me.x || (o.x == me.x && o.y < me.y)) ? 1 : 0; }
#ifndef DSA_DBG_NOCAND
                if (rank < need) atomicOr(&MASK[row * 128 + (me.y >> 5)], 1u << (me.y & 31));
#endif
            }
        }
        SYNC();
#ifdef DSA_DBG_SEL
        for (int e = tid; e < 32 * 128; e += 512) { const int row = e >> 7, wi = e & 127, t = t0 + row, lo = t - 255 < 0 ? 0 : t - 255; unsigned m = 0u;
            for (int bq = 0; bq < 32; ++bq) { const int s = 32 * wi + bq; if (s >= lo && s <= t) m |= 1u << bq; }
            MASK[e] = m; }
        SYNC();
#endif
#pragma unroll 1
        for (int rr = 0; rr < 4; ++rr) {
            const int row = 4 * w + rr;
            unsigned w0 = MASK[row * 128 + 2 * lane], w1 = MASK[row * 128 + 2 * lane + 1];
            const int c = __builtin_popcount(w0) + __builtin_popcount(w1);
            int inc = c;
#pragma unroll
            for (int o = 1; o < 64; o <<= 1) { const int v = SHFL_UP(inc, o); if (lane >= o) inc += v; }
            int pos = inc - c;
            while (w0) { const int bt = __builtin_ctz(w0); w0 &= w0 - 1; if (pos < 256) SELL[row * 256 + pos] = (unsigned short)(64 * lane + bt); ++pos; }
            while (w1) { const int bt = __builtin_ctz(w1); w1 &= w1 - 1; if (pos < 256) SELL[row * 256 + pos] = (unsigned short)(64 * lane + 32 + bt); ++pos; }
            if (lane == 63) NSEL[row] = inc < 256 ? inc : 256;
        }
        SYNC();
        bf16* TL = (bf16*)(F.lds + w * DS_SLOT); bf16* OLw = (bf16*)(F.lds + w * DS_SLOT + 8704);
#pragma unroll 1
        for (int rr = 0; rr < 4; ++rr) {
            const int row = 4 * w + rr, t = t0 + row, ns = UNI(NSEL[row]); const size_t mt = mb + t;
            const unsigned short* sl = SELL + row * 256;
            bf16x8 Bh[4];
#pragma unroll
            for (int ks = 0; ks < 4; ++ks) Bh[ks] = i16 < 4 ? *(const bf16x8*)(QABS + mt * 512 + i16 * 128 + 32 * ks + 8 * g) : (bf16x8){0, 0, 0, 0, 0, 0, 0, 0};
            f32x4 O[8];
#pragma unroll
            for (int nt = 0; nt < 8; ++nt) O[nt] = (f32x4){0.f, 0.f, 0.f, 0.f};
            float mrun = -1e30f, lrun = 0.f;
            const float bfar = RB[113 * 4 + (i16 & 3)];
            const int nch = (ns + 31) >> 5;
            u32x4 gvA[8];
#ifndef HOST_EMU
#define ATT_KEEP8(A) asm volatile("" :: "v"(A[0][0]), "v"(A[0][1]), "v"(A[0][2]), "v"(A[0][3]), "v"(A[1][0]), "v"(A[1][1]), "v"(A[1][2]), "v"(A[1][3]))
#else
#define ATT_KEEP8(A) (void)0
#endif
#define ATT_LOAD(GV, CK, FULL) do { int sidx[8]; \
                _Pragma("unroll") for (int i = 0; i < 8; ++i) sidx[i] = (int)sl[32 * (CK) + 4 * i + g];            \
                _Pragma("unroll") for (int i = 0; i < 8; ++i) { const int kp = 32 * (CK) + 4 * i + g; sidx[i] = (FULL || kp < ns) ? sidx[i] : 0; } \
                _Pragma("unroll") for (int i = 0; i < 8; ++i) GV[i] = *(const GAS u32x4*)(ckvb + (((unsigned)sidx[i] << 8) + 16u * (unsigned)i16)); } while (0)
#define ATT_STEP(GV, CK, FULL) do { const int ck = (CK); \
                _Pragma("unroll") for (int i = 0; i < 8; ++i) *(u32x4*)(TL + (4 * i + g) * 136 + 8 * i16) = GV[i]; \
                const u32x2 sk0 = *(const u32x2*)(sl + 32 * ck + 4 * g), sk1 = *(const u32x2*)(sl + 32 * ck + 16 + 4 * g); \
                WAVE_LDS_FENCE(); \
                if (ck + 1 < nch) ATT_LOAD(GV, ck + 1, FULL); \
                float bia[2][4]; \
                if (FULL && t - UNI((int)sl[32 * ck + 31]) >= 113) {                   \
                _Pragma("unroll") for (int kt = 0; kt < 2; ++kt) \
                _Pragma("unroll") for (int r = 0; r < 4; ++r) bia[kt][r] = bfar; \
                } else { \
                _Pragma("unroll") for (int kt = 0; kt < 2; ++kt) \
                _Pragma("unroll") for (int r = 0; r < 4; ++r) { const unsigned wd = kt ? (r < 2 ? sk1.x : sk1.y) : (r < 2 ? sk0.x : sk0.y); \
                        int dist = t - (int)((wd >> (16 * (r & 1))) & 0xffffu); dist = dist < 0 ? 0 : (dist > 113 ? 113 : dist); \
                        bia[kt][r] = RB[dist * 4 + (i16 & 3)]; } } \
                f32x4 lg[2]; \
                { bf16x8 Af[2][4];                                    \
                _Pragma("unroll") for (int kt = 0; kt < 2; ++kt) _Pragma("unroll") for (int ks = 0; ks < 4; ++ks) Af[kt][ks] = *(const bf16x8*)(TL + (16 * kt + i16) * 136 + 32 * ks + 8 * g); \
                ATT_KEEP8(Af); \
                _Pragma("unroll") for (int kt = 0; kt < 2; ++kt) { lg[kt] = (f32x4){0.f, 0.f, 0.f, 0.f}; \
                _Pragma("unroll") for (int ks = 0; ks < 4; ++ks) lg[kt] = MFMA16(Af[kt][ks], Bh[ks], lg[kt]); } } \
                float cm = -1e30f; \
                _Pragma("unroll") for (int kt = 0; kt < 2; ++kt) \
                _Pragma("unroll") for (int r = 0; r < 4; ++r) { const int kp = 32 * ck + 16 * kt + 4 * g + r; \
                        lg[kt][r] = (FULL || kp < ns) ? lg[kt][r] + bia[kt][r] : -1e30f; cm = fmaxf(cm, lg[kt][r]); } \
                if (ck == 0) { cm = fmaxf(cm, SHFL_XOR(cm, 16)); cm = fmaxf(cm, SHFL_XOR(cm, 32)); mrun = cm; } \
                float p[2][4]; \
                _Pragma("unroll") for (int kt = 0; kt < 2; ++kt) \
                _Pragma("unroll") for (int r = 0; r < 4; ++r) { p[kt][r] = (FULL || lg[kt][r] > -1e29f) ? FEXP2(lg[kt][r] - mrun) : 0.f; lrun += p[kt][r]; } \
                u32x4 aw = (u32x4){0u, 0u, 0u, 0u}; \
                if (i16 < 4) aw = (u32x4){pk2(p[0][0], p[0][1]), pk2(p[0][2], p[0][3]), pk2(p[1][0], p[1][1]), pk2(p[1][2], p[1][3])}; \
                const bf16x8 A = __builtin_bit_cast(bf16x8, aw); \
                _Pragma("unroll") for (int nt = 0; nt < 8; ++nt) { \
                    const s16x4 lo = TR16(TL + (4 * g + (i16 >> 2)) * 136 + 16 * nt + 4 * (i16 & 3)); \
                    const s16x4 hi = TR16(TL + (16 + 4 * g + (i16 >> 2)) * 136 + 16 * nt + 4 * (i16 & 3)); \
                    const bf16x8 B = (bf16x8){lo[0], lo[1], lo[2], lo[3], hi[0], hi[1], hi[2], hi[3]}; \
                    O[nt] = MFMA16(A, B, O[nt]); } \
                WAVE_LDS_FENCE(); } while (0)
            if (ns == 256) { ATT_LOAD(gvA, 0, true); for (int ck2 = 0; ck2 < 8; ++ck2) ATT_STEP(gvA, ck2, true); }
            else { ATT_LOAD(gvA, 0, false); for (int ck2 = 0; ck2 < nch; ++ck2) ATT_STEP(gvA, ck2, false); }
#undef ATT_STEP
#undef ATT_LOAD
            lrun += SHFL_XOR(lrun, 16); lrun += SHFL_XOR(lrun, 32);
            float li[4];
#pragma unroll
            for (int r = 0; r < 4; ++r) li[r] = FRCP(SHFL(lrun, r));
            if (g == 0) {
#pragma unroll
                for (int nt = 0; nt < 8; ++nt)
#pragma unroll
                    for (int r = 0; r < 4; ++r) OLw[(rr * 4 + r) * 128 + 16 * nt + i16] = (bf16)f2bf(O[nt][r] * li[r]);
            }
        }
        bf16x8 Wf[4][4];
#pragma unroll
        for (int ks = 0; ks < 4; ++ks)
#pragma unroll
            for (int nt = 0; nt < 4; ++nt) Wf[ks][nt] = *(const bf16x8*)(WUVT + ((size_t)((w >> 1) * 64 + 16 * nt + i16)) * 128 + 32 * ks + 8 * g);
        SYNC();
        {
            const int h = w >> 1, mtile = w & 1, q = 16 * mtile + i16;
            const bf16* olq = (const bf16*)(F.lds + (q >> 2) * DS_SLOT + 8704) + ((q & 3) * 4 + h) * 128;
            float gaw[4];
#pragma unroll
            for (int nt = 0; nt < 4; ++nt) gaw[nt] = PIN(F, I_GNW)[l * DM + 768 + h * 64 + 16 * nt + i16];
            f32x4 acc[4];
#pragma unroll
            for (int nt = 0; nt < 4; ++nt) acc[nt] = (f32x4){0.f, 0.f, 0.f, 0.f};
#pragma unroll
            for (int ks = 0; ks < 4; ++ks) { const bf16x8 A = *(const bf16x8*)(olq + 32 * ks + 8 * g);
#pragma unroll
                for (int nt = 0; nt < 4; ++nt) acc[nt] = MFMA16(A, Wf[ks][nt], acc[nt]); }
#pragma unroll
            for (int r = 0; r < 4; ++r) { float s = (acc[0][r] * acc[0][r] + acc[1][r] * acc[1][r]) + (acc[2][r] * acc[2][r] + acc[3][r] * acc[3][r]);
                s += SHFL_XOR(s, 1); s += SHFL_XOR(s, 2); s += SHFL_XOR(s, 4); s += SHFL_XOR(s, 8);
                if (i16 == 0) SS[(16 * mtile + 4 * g + r) * 4 + h] = s; }
            SYNC();
#pragma unroll
            for (int r = 0; r < 4; ++r) { const int qq = 16 * mtile + 4 * g + r; const f32x4 s4 = *(const f32x4*)(SS + qq * 4);
                const float rs = RSQ(((s4.x + s4.y) + (s4.z + s4.w)) * (1.0f / 256.0f) + NORM_EPS);
                bf16* dst = CAT + (mb + t0 + qq) * DM + 768 + h * 64 + i16;
#pragma unroll
                for (int nt = 0; nt < 4; ++nt) dst[16 * nt] = (bf16)f2bf(acc[nt][r] * rs * gaw[nt]); }
        }
        SYNC();
    }
}
#ifndef HOST_EMU
namespace pg8 {
#define PG8_LAS __attribute__((address_space(3)))
typedef unsigned short bf16_t;
typedef short bf16x8 __attribute__((ext_vector_type(8)));
typedef float f32x4 __attribute__((ext_vector_type(4)));
typedef unsigned u32x4 __attribute__((ext_vector_type(4)));
constexpr int BM = 256, BK = 64, HALF = 128, HTB = HALF * BK * 2  , STAGE_BYTES = 8 * HTB, NXCD = 8, WGM = 8;

__host__ __device__ __forceinline__ int lds_byte(int r, int c) { const int st = (r >> 4) * 2 + (c >> 5), rr = r & 15, cc = c & 31, ob = rr * 64 + cc * 2; return st * 1024 + (ob ^ (((ob >> 9) & 1) << 5)); }
__host__ __device__ __forceinline__ void stage_rc(int b, int& R, int& C) { const int st = b / 1024, sb = b % 1024, swz = sb ^ (((sb >> 9) & 1) << 5); R = (st >> 1) * 16 + swz / 64; C = (st & 1) * 32 + (swz % 64) / 2; }
__host__ __device__ __forceinline__ int perm32(int rho) { const int n = rho >> 4, i = rho & 15; return 8 * (i >> 2) + 4 * n + (i & 3); }

struct Unit { int pm, pn; };
struct Gemm { const bf16_t* A; const bf16_t* Bt; int M, N, K; };

struct StaticOrder {
    int nM, nN, nwg, G, c;
    __host__ __device__ void init(int M, int N, int G_, int c_) { nM = M / BM; nN = N / BM; nwg = nM * nN; G = G_; c = c_; }
    __host__ __device__ bool next(int i, Unit& u) const {
        const long L = (long)i * G + c; if (L >= nwg) return false;
        int wgid = (int)L; { const int q = nwg / NXCD, r = nwg % NXCD, xcd = wgid % NXCD, off = wgid / NXCD; wgid = (xcd < r ? xcd * (q + 1) : r * (q + 1) + (xcd - r) * q) + off; }
        const int nig = WGM * nN, gid = wgid / nig, fm = gid * WGM, gsz = (nM - fm) < WGM ? (nM - fm) : WGM;
        u.pm = fm + ((wgid % nig) % gsz); u.pn = (wgid % nig) / gsz; return true;
    }
    __device__ __forceinline__ void a_ready(const Unit&) const {}
    __device__ __forceinline__ void done(const Unit&) const {}
};
__device__ __forceinline__ unsigned cvt_pk_bf16(float lo, float hi) { unsigned r; asm volatile("v_cvt_pk_bf16_f32 %0, %1, %2" : "=v"(r) : "v"(lo), "v"(hi)); return r; }
template <class Epi, class Sched, bool ALIGN_EPI = false, bool SP2 = false>
__device__ __forceinline__ void gemm_phase(PG8_LAS unsigned char* lds, const Gemm g, const Sched& S, const Epi& E, const int tid_in) {
    const int tid = tid_in, wid = __builtin_amdgcn_readfirstlane(tid >> 6), lane = tid & 63, wr = wid >> 2, wc = wid & 3, fr = lane & 15, fq = lane >> 4;
    const int K = g.K, nt = K / BK;
    unsigned voffA[2], voffB[2];
#pragma unroll
    for (int i = 0; i < 2; ++i) { int R, C; stage_rc(tid * 16 + i * 8192, R, C); const int Rb = Epi::PERM ? ((R & ~31) + perm32(R & 31)) : R;
        voffA[i] = (unsigned)(R * K + C) * 2u; voffB[i] = (unsigned)(Rb * K + C) * 2u; }
    const size_t kstep = (size_t)(BK * 2);
    const size_t hstep = (size_t)HALF * K * 2;
    const size_t tstep = 2 * hstep;
    const unsigned ldsw = (unsigned)wid * 1024u;
    const int aoff = lds_byte(wr * 64 + fr, fq * 8), boff = lds_byte(wc * 32 + fr, fq * 8);
#define PG8_SA(b, h) (((b) * 2 + (h)) * HTB)
#define PG8_SB(b, h) ((4 + (b) * 2 + (h)) * HTB)
#define PG8_STAGE(bufoff, gbase, voff) do { _Pragma("unroll") for (int _i = 0; _i < 2; ++_i) \
        __builtin_amdgcn_global_load_lds((const unsigned*)((const char*)(gbase) + (voff)[_i]), (PG8_LAS unsigned*)(lds + (bufoff) + ldsw + _i * 8192), 16, 0, 0); } while (0)
#define PG8_LDA(dst, b, h) do { _Pragma("unroll") for (int m = 0; m < 4; ++m) _Pragma("unroll") for (int k = 0; k < 2; ++k) dst[m][k] = *(const PG8_LAS bf16x8*)(lds + PG8_SA(b, h) + aoff + m * 2048 + k * 1024); } while (0)
#define PG8_LDB(dst, b, h) do { _Pragma("unroll") for (int n = 0; n < 2; ++n) _Pragma("unroll") for (int k = 0; k < 2; ++k) dst[n][k] = *(const PG8_LAS bf16x8*)(lds + PG8_SB(b, h) + boff + n * 2048 + k * 1024); } while (0)
#define PG8_MMA(ai, bj, At, Bt) do { __builtin_amdgcn_s_setprio(1); _Pragma("unroll") for (int m = 0; m < 4; ++m) _Pragma("unroll") for (int n = 0; n < 2; ++n) _Pragma("unroll") for (int k = 0; k < 2; ++k) \
        acc[ai][bj][m][n] = __builtin_amdgcn_mfma_f32_16x16x32_bf16(Bt[n][k], At[m][k], acc[ai][bj][m][n], 0, 0, 0); __builtin_amdgcn_s_setprio(0); } while (0)
#define PG8_WAIT_V(n) asm volatile("s_waitcnt vmcnt(" #n ")" ::: "memory")
#define PG8_WAIT_L(n) asm volatile("s_waitcnt lgkmcnt(" #n ")" ::: "memory")
#define PG8_BAR __builtin_amdgcn_s_barrier()
#define PG8_SCHED __builtin_amdgcn_sched_barrier(0)
    Unit cur, nxt; int ui = 0;
    if (!S.next(0, cur)) return;
    f32x4 acc[2][2][4][2];
#pragma unroll
    for (int a = 0; a < 2; ++a)
#pragma unroll
        for (int b = 0; b < 2; ++b)
#pragma unroll
            for (int m = 0; m < 4; ++m)
#pragma unroll
                for (int n = 0; n < 2; ++n) acc[a][b][m][n] = (f32x4){0.f, 0.f, 0.f, 0.f};
    bf16x8 At[4][2], B0[2][2], B1[2][2];
    const char* cA = (const char*)g.A + (size_t)cur.pm * tstep; const char* cB = (const char*)g.Bt + (size_t)cur.pn * tstep;
    S.a_ready(cur);
    if constexpr (SP2) {
        PG8_STAGE(PG8_SB(0, 0), cB, voffB); PG8_STAGE(PG8_SB(0, 1), cB + hstep, voffB); PG8_STAGE(PG8_SA(0, 0), cA, voffA); PG8_STAGE(PG8_SA(0, 1), cA + hstep, voffA);
        if (wr == 1) PG8_BAR;
        PG8_WAIT_V(2); PG8_BAR;
        PG8_STAGE(PG8_SB(1, 0), cB + kstep, voffB); PG8_STAGE(PG8_SA(1, 0), cA + kstep, voffA); PG8_STAGE(PG8_SB(1, 1), cB + hstep + kstep, voffB);
        PG8_WAIT_V(6); PG8_BAR;
    } else {
        PG8_STAGE(PG8_SB(0, 0), cB, voffB); PG8_STAGE(PG8_SA(0, 0), cA, voffA); PG8_STAGE(PG8_SB(0, 1), cB + hstep, voffB); PG8_STAGE(PG8_SA(0, 1), cA + hstep, voffA);
        if (wr == 1) PG8_BAR;
        PG8_WAIT_V(4); PG8_BAR;
        PG8_STAGE(PG8_SB(1, 0), cB + kstep, voffB); PG8_STAGE(PG8_SA(1, 0), cA + kstep, voffA); PG8_STAGE(PG8_SB(1, 1), cB + hstep + kstep, voffB);
        PG8_WAIT_V(6); PG8_BAR;
    }
    for (;;) {
        const bool has_next = S.next(ui + 1, nxt);
        const char* nA = has_next ? (const char*)g.A + (size_t)nxt.pm * tstep : cA; const char* nB = has_next ? (const char*)g.Bt + (size_t)nxt.pn * tstep : cB;
#pragma unroll 1
        for (int t = 0; t < nt; t += 2) {
            const bool last = (t == nt - 2);
            const char* a1 = cA + (size_t)(t + 1) * kstep;
            const char* a2 = last ? nA : cA + (size_t)(t + 2) * kstep; const char* b2 = last ? nB : cB + (size_t)(t + 2) * kstep;
            const char* a3 = a2 + kstep; const char* b3 = b2 + kstep;
            if (last && has_next) S.a_ready(nxt);
            if constexpr (Epi::NORM) { if (t == 2) E.prefetch(cur, tid, wid); if (t == 4) E.reduce_rs(tid); }
            if constexpr (SP2) {
            PG8_LDB(B0, 0, 0); PG8_LDB(B1, 0, 1); PG8_SCHED; PG8_LDA(At, 0, 0); PG8_STAGE(PG8_SA(1, 1), a1 + hstep, voffA);
            PG8_WAIT_V(8); PG8_WAIT_L(0); PG8_BAR; PG8_MMA(0, 0, At, B0); PG8_MMA(0, 1, At, B1); PG8_BAR; PG8_SCHED;
            PG8_LDA(At, 0, 1); PG8_STAGE(PG8_SB(0, 0), b2, voffB); PG8_STAGE(PG8_SB(0, 1), b2 + hstep, voffB); PG8_STAGE(PG8_SA(0, 0), a2, voffA);
            PG8_WAIT_V(8); PG8_WAIT_L(0); PG8_BAR; PG8_MMA(1, 0, At, B0); PG8_MMA(1, 1, At, B1); PG8_BAR; PG8_SCHED;
            PG8_LDB(B0, 1, 0); PG8_LDB(B1, 1, 1); PG8_SCHED; PG8_LDA(At, 1, 0); PG8_STAGE(PG8_SA(0, 1), a2 + hstep, voffA);
            PG8_WAIT_V(8); PG8_WAIT_L(0); PG8_BAR; PG8_MMA(0, 0, At, B0); PG8_MMA(0, 1, At, B1); PG8_BAR; PG8_SCHED;
            PG8_LDA(At, 1, 1); PG8_STAGE(PG8_SB(1, 0), b3, voffB); PG8_STAGE(PG8_SB(1, 1), b3 + hstep, voffB); PG8_STAGE(PG8_SA(1, 0), a3, voffA);
            PG8_WAIT_V(8); PG8_WAIT_L(0); PG8_BAR; PG8_MMA(1, 0, At, B0); PG8_MMA(1, 1, At, B1); PG8_BAR; PG8_SCHED;
            } else {
            PG8_LDB(B0, 0, 0); PG8_SCHED; PG8_LDA(At, 0, 0); PG8_STAGE(PG8_SA(1, 1), a1 + hstep, voffA);
            PG8_WAIT_L(8); PG8_BAR; PG8_WAIT_L(0); PG8_MMA(0, 0, At, B0); PG8_BAR; PG8_SCHED;
            PG8_LDB(B1, 0, 1); PG8_STAGE(PG8_SB(0, 0), b2, voffB);
            PG8_BAR; PG8_WAIT_L(0); PG8_MMA(0, 1, At, B1); PG8_BAR;
            PG8_LDA(At, 0, 1); PG8_STAGE(PG8_SA(0, 0), a2, voffA);
            PG8_BAR; PG8_WAIT_L(0); PG8_MMA(1, 0, At, B0); PG8_BAR; PG8_SCHED;
            PG8_STAGE(PG8_SB(0, 1), b2 + hstep, voffB);
            PG8_WAIT_V(6); PG8_BAR; PG8_MMA(1, 1, At, B1); PG8_BAR;
            PG8_LDB(B0, 1, 0); PG8_SCHED; PG8_LDA(At, 1, 0); PG8_STAGE(PG8_SA(0, 1), a2 + hstep, voffA);
            PG8_WAIT_L(8); PG8_BAR; PG8_WAIT_L(0); PG8_MMA(0, 0, At, B0); PG8_BAR; PG8_SCHED;
            PG8_LDB(B1, 1, 1); PG8_STAGE(PG8_SB(1, 0), b3, voffB);
            PG8_BAR; PG8_WAIT_L(0); PG8_MMA(0, 1, At, B1); PG8_BAR;
            PG8_LDA(At, 1, 1); PG8_STAGE(PG8_SA(1, 0), a3, voffA);
            PG8_BAR; PG8_WAIT_L(0); PG8_MMA(1, 0, At, B0); PG8_BAR; PG8_SCHED;
            PG8_STAGE(PG8_SB(1, 1), b3 + hstep, voffB);
            PG8_WAIT_V(6); PG8_BAR; PG8_MMA(1, 1, At, B1); PG8_BAR;
            }
        }
        if constexpr (ALIGN_EPI) { if (wr == 0) PG8_BAR; }
        if constexpr (!Epi::AFTER_DRAIN) { E(acc, cur, wr, wc, fr, fq); S.done(cur); }
        if (!has_next) break;
#pragma unroll
        for (int a = 0; a < 2; ++a)
#pragma unroll
            for (int b = 0; b < 2; ++b)
#pragma unroll
                for (int m = 0; m < 4; ++m)
#pragma unroll
                    for (int n = 0; n < 2; ++n) acc[a][b][m][n] = (f32x4){0.f, 0.f, 0.f, 0.f};
        cur = nxt; cA = nA; cB = nB; ++ui;
        if constexpr (ALIGN_EPI) { if (wr == 1) PG8_BAR; }
    }
    PG8_WAIT_V(0);
    if constexpr (!ALIGN_EPI) { if (wr == 0) PG8_BAR; }
    PG8_BAR;
    if constexpr (Epi::AFTER_DRAIN) { E.fused(acc, cur, wr, wc, fr, fq, lds, wid, lane); S.done(cur); }
#undef PG8_SA
#undef PG8_SB
#undef PG8_STAGE
#undef PG8_LDA
#undef PG8_LDB
#undef PG8_MMA
#undef PG8_WAIT_V
#undef PG8_WAIT_L
#undef PG8_BAR
#undef PG8_SCHED
}
}
namespace pg8 {
template <int ACT  > struct EpiRoute {
    static constexpr bool PERM = true, AFTER_DRAIN = false, NORM = false;
    bf16_t* O0; int ld0; bf16_t* O1; int ld1; int split;
    __device__ __forceinline__ void operator()(const f32x4 (&acc)[2][2][4][2], const Unit& u, int wr, int wc, int fr, int fq) const {
        const int row0 = u.pm * BM + wr * 64 + fr; const bool first = u.pn < split;
        bf16_t* base = first ? O0 : O1; const int ld = first ? ld0 : ld1; const int col0 = (first ? u.pn : u.pn - split) * BM + wc * 32 + 8 * fq;
#pragma unroll
        for (int ai = 0; ai < 2; ++ai)
#pragma unroll
            for (int m = 0; m < 4; ++m) { bf16_t* rowp = base + (size_t)(row0 + ai * HALF + m * 16) * ld + col0;
#pragma unroll
                for (int bj = 0; bj < 2; ++bj) { f32x4 v0 = acc[ai][bj][m][0], v1 = acc[ai][bj][m][1];
                    if (ACT == 1) {
#pragma unroll
                        for (int e = 0; e < 4; ++e) { const float a = fmaxf(v0[e], 0.f), b = fmaxf(v1[e], 0.f); v0[e] = a * a; v1[e] = b * b; } }
                    u32x4 w; w.x = cvt_pk_bf16(v0[0], v0[1]); w.y = cvt_pk_bf16(v0[2], v0[3]); w.z = cvt_pk_bf16(v1[0], v1[1]); w.w = cvt_pk_bf16(v1[2], v1[3]);
                    *(u32x4*)(rowp + bj * HALF) = w; } }
    }
};
struct EpiResid {
    static constexpr bool PERM = true, AFTER_DRAIN = false, NORM = false;
    const float* xsrc; float* xdst; const float* gate;
    __device__ __forceinline__ void operator()(const f32x4 (&acc)[2][2][4][2], const Unit& u, int wr, int wc, int fr, int fq) const {
        const int row0 = u.pm * BM + wr * 64 + fr, col0 = u.pn * BM + wc * 32 + 8 * fq, b = (u.pm * BM) >> 12;
        f32x4 gv[2][2];
#pragma unroll
        for (int bj = 0; bj < 2; ++bj)
#pragma unroll
            for (int n = 0; n < 2; ++n) gv[bj][n] = *(const f32x4*)(gate + (size_t)b * 6144 + col0 + bj * HALF + 4 * n);
#pragma unroll
        for (int ai = 0; ai < 2; ++ai)
#pragma unroll
            for (int m = 0; m < 4; ++m) { const size_t off = (size_t)(row0 + ai * HALF + m * 16) * 1024 + col0;
#pragma unroll
                for (int bj = 0; bj < 2; ++bj)
#pragma unroll
                    for (int n = 0; n < 2; ++n) { const f32x4 xs = *(const f32x4*)(xsrc + off + bj * HALF + 4 * n);
                        *(f32x4*)(xdst + off + bj * HALF + 4 * n) = xs + gv[bj][n] * acc[ai][bj][m][n]; }
                if (m & 1) asm volatile("" ::: "memory"); }
    }
};
constexpr int EPI_OFF = 133120;
template <int ACT  > struct EpiRouteN {
    static constexpr bool PERM = true, AFTER_DRAIN = false, NORM = true;
    bf16_t* O; int ld; const float* RSP; const float* shw; PG8_LAS unsigned char* lds;
    __device__ __forceinline__ void prefetch(const Unit& u, int tid, int wid) const {
        const char* src = (const char*)RSP + (size_t)u.pm * (BM * 64) + (size_t)tid * 16;
#pragma unroll
        for (int i = 0; i < 2; ++i) __builtin_amdgcn_global_load_lds((const unsigned*)(src + i * 8192), (PG8_LAS unsigned*)(lds + EPI_OFF + wid * 1024 + i * 8192), 16, 0, 0);
        if (wid == 0) { const char* s2 = (const char*)(shw + (size_t)((u.pm * BM) >> 12) * NSHW + u.pn * BM) + (size_t)(tid & 63) * 16;
            __builtin_amdgcn_global_load_lds((const unsigned*)s2, (PG8_LAS unsigned*)(lds + EPI_OFF + 16384), 16, 0, 0); }
    }
    __device__ __forceinline__ void reduce_rs(int tid) const {
        if (tid < 256) { const PG8_LAS f32x4* p = (const PG8_LAS f32x4*)(lds + EPI_OFF + tid * 64); const f32x4 a = p[0], b = p[1], c = p[2], d = p[3];
            const float s = (((a.x + a.y) + (a.z + a.w)) + ((b.x + b.y) + (b.z + b.w))) + (((c.x + c.y) + (c.z + c.w)) + ((d.x + d.y) + (d.z + d.w)));
            *(PG8_LAS float*)(lds + EPI_OFF + 17408 + tid * 4) = __builtin_amdgcn_rsqf(s * (1.0f / 1024.0f) + 1e-6f); }
    }
    __device__ __forceinline__ void operator()(const f32x4 (&acc)[2][2][4][2], const Unit& u, int wr, int wc, int fr, int fq) const {
        const int row0 = u.pm * BM + wr * 64 + fr, col0 = u.pn * BM + wc * 32 + 8 * fq;
        const PG8_LAS unsigned char* ep = lds + EPI_OFF;
        float rs[2][4];
#pragma unroll
        for (int ai = 0; ai < 2; ++ai)
#pragma unroll
            for (int m = 0; m < 4; ++m) rs[ai][m] = *(const PG8_LAS float*)(ep + 17408 + (wr * 64 + fr + ai * HALF + m * 16) * 4);
        f32x4 sv[2][2];
#pragma unroll
        for (int bj = 0; bj < 2; ++bj)
#pragma unroll
            for (int n = 0; n < 2; ++n) sv[bj][n] = *(const PG8_LAS f32x4*)(ep + 16384 + (bj * HALF + wc * 32 + 8 * fq + 4 * n) * 4);
#pragma unroll
        for (int ai = 0; ai < 2; ++ai)
#pragma unroll
            for (int m = 0; m < 4; ++m) { bf16_t* rowp = O + (size_t)(row0 + ai * HALF + m * 16) * ld + col0;
#pragma unroll
                for (int bj = 0; bj < 2; ++bj) { f32x4 v0 = acc[ai][bj][m][0] * rs[ai][m] + sv[bj][0], v1 = acc[ai][bj][m][1] * rs[ai][m] + sv[bj][1];
                    if (ACT == 1) {
#pragma unroll
                        for (int e = 0; e < 4; ++e) { const float a = fmaxf(v0[e], 0.f), b = fmaxf(v1[e], 0.f); v0[e] = a * a; v1[e] = b * b; } }
                    u32x4 w; w.x = cvt_pk_bf16(v0[0], v0[1]); w.y = cvt_pk_bf16(v0[2], v0[3]); w.z = cvt_pk_bf16(v1[0], v1[1]); w.w = cvt_pk_bf16(v1[2], v1[3]);
                    *(u32x4*)(rowp + bj * HALF) = w; } }
    }
};
template <bool MAYSKIP> struct EpiResidXS {
    static constexpr bool PERM = true, AFTER_DRAIN = false, NORM = false;
    const bf16_t* xsrc; bf16_t* xdst; const float* gate; const float* wp; bf16_t* XS; float* RSP; int doxs;
    template <bool DOXS> __device__ __forceinline__ void body(const f32x4 (&acc)[2][2][4][2], const Unit& u, int wr, int wc, int fr, int fq) const {
        const int row0 = u.pm * BM + wr * 64 + fr, col0 = u.pn * BM + wc * 32 + 8 * fq, b = (u.pm * BM) >> 12;
        f32x4 gv[2][2], wv[2][2]; float ssv[2][4];
#pragma unroll
        for (int bj = 0; bj < 2; ++bj)
#pragma unroll
            for (int n = 0; n < 2; ++n) { gv[bj][n] = *(const f32x4*)(gate + (size_t)b * 6144 + col0 + bj * HALF + 4 * n);
                if (DOXS) wv[bj][n] = *(const f32x4*)(wp + (size_t)b * 1024 + col0 + bj * HALF + 4 * n); }
#pragma unroll
        for (int aim = 0; aim < 4; ++aim) { const int ai = aim >> 1, m0_ = (aim & 1) * 2;
            u32x4 xr[4][2];
#pragma unroll
            for (int m = m0_; m < m0_ + 2; ++m)
#pragma unroll
                for (int bj = 0; bj < 2; ++bj) xr[m][bj] = *(const u32x4*)(xsrc + (size_t)(row0 + ai * HALF + m * 16) * 1024 + col0 + bj * HALF);
#pragma unroll
            for (int m = m0_; m < m0_ + 2; ++m) { const size_t off = (size_t)(row0 + ai * HALF + m * 16) * 1024 + col0; float ss = 0.f;
#pragma unroll
                for (int bj = 0; bj < 2; ++bj) { const u32x4 r = xr[m][bj];
                    const f32x4 x0 = (f32x4){bflo(r.x), bfhi(r.x), bflo(r.y), bfhi(r.y)}, x1 = (f32x4){bflo(r.z), bfhi(r.z), bflo(r.w), bfhi(r.w)};
                    const f32x4 y0 = x0 + gv[bj][0] * acc[ai][bj][m][0], y1 = x1 + gv[bj][1] * acc[ai][bj][m][1];
                    u32x4 w; w.x = cvt_pk_bf16(y0[0], y0[1]); w.y = cvt_pk_bf16(y0[2], y0[3]); w.z = cvt_pk_bf16(y1[0], y1[1]); w.w = cvt_pk_bf16(y1[2], y1[3]);
                    *(u32x4*)(xdst + off + bj * HALF) = w;
                    if (DOXS) { const f32x4 a = y0 * wv[bj][0], c = y1 * wv[bj][1];
                        u32x4 v; v.x = cvt_pk_bf16(a[0], a[1]); v.y = cvt_pk_bf16(a[2], a[3]); v.z = cvt_pk_bf16(c[0], c[1]); v.w = cvt_pk_bf16(c[2], c[3]);
                        *(u32x4*)(XS + off + bj * HALF) = v;
                        ss += ((y0.x * y0.x + y0.y * y0.y) + (y0.z * y0.z + y0.w * y0.w)) + ((y1.x * y1.x + y1.y * y1.y) + (y1.z * y1.z + y1.w * y1.w)); } }
                ssv[ai][m] = ss; }
            asm volatile("" ::: "memory"); }
        if (DOXS) { float t1[2][4];
#pragma unroll
            for (int ai = 0; ai < 2; ++ai)
#pragma unroll
                for (int m = 0; m < 4; ++m) t1[ai][m] = __shfl_xor(ssv[ai][m], 16);
#pragma unroll
            for (int ai = 0; ai < 2; ++ai)
#pragma unroll
                for (int m = 0; m < 4; ++m) { ssv[ai][m] += t1[ai][m]; t1[ai][m] = __shfl_xor(ssv[ai][m], 32); }
            if (fq == 0) {
#pragma unroll
                for (int ai = 0; ai < 2; ++ai)
#pragma unroll
                    for (int m = 0; m < 4; ++m) RSP[(size_t)(row0 + ai * HALF + m * 16) * 16 + u.pn * 4 + wc] = ssv[ai][m] + t1[ai][m]; } }
    }
    __device__ __forceinline__ void operator()(const f32x4 (&acc)[2][2][4][2], const Unit& u, int wr, int wc, int fr, int fq) const {
        if (!MAYSKIP || doxs) body<true>(acc, u, wr, wc, fr, fq); else body<false>(acc, u, wr, wc, fr, fq);
    }
};
}

#define RLX_AGENT __ATOMIC_RELAXED, __HIP_MEMORY_SCOPE_AGENT
#define XB_TMO      128
#define XB_XCNT(j)  (256  + 64 * (j))
#define XB_XSUB(j)  (1280 + 64 * (j))
#define XB_XGEN(j)  (2304 + 64 * (j))
#define XB_TOP      3328
#define XB_TOPGEN   3392
#define XCD_BAR_WORDS 3456
#define XB_SPIN_CAP (1u << 24)

__device__ __forceinline__ unsigned xb_ld(unsigned* p)              { return __hip_atomic_load(p, __ATOMIC_RELAXED, __HIP_MEMORY_SCOPE_AGENT); }
__device__ __forceinline__ unsigned xb_add(unsigned* p, unsigned v) { return __hip_atomic_fetch_add(p, v, __ATOMIC_RELAXED, __HIP_MEMORY_SCOPE_AGENT); }
__device__ __forceinline__ unsigned xb_xcc_id() { return (unsigned)__builtin_amdgcn_s_getreg((3 << 11) | 20) & 0xFu; }
#define XB_SPIN(cond, bar) do { unsigned _sp = 0; while (cond) { __builtin_amdgcn_s_sleep(1); \
    if ((++_sp & 255u) == 0u) { if (xb_ld(&(bar)[XB_TMO])) break; if (_sp > XB_SPIN_CAP) { atomicAdd(&(bar)[XB_TMO], 1u); break; } } } } while (0)

struct XcdBarrier {
    unsigned* bar; unsigned x;
    volatile LAS unsigned* st;
};

__device__ __forceinline__ XcdBarrier xcd_barrier_post(unsigned* bar, volatile LAS unsigned* st) {
    XcdBarrier b; b.bar = bar; b.x = xb_xcc_id(); b.st = st;
    if (threadIdx.x == 0) (void)xb_add(&bar[XB_XCNT(b.x)], 1u);
    return b;
}
__device__ __forceinline__ void xcd_barrier_complete(unsigned* bar, unsigned x, unsigned& nloc, unsigned& nx) {
    const unsigned G = gridDim.x * gridDim.y * gridDim.z;
    unsigned sum, cnt, mine, sp = 0u;
    for (;;) {
        sum = 0u; cnt = 0u; mine = 0u;
#pragma unroll
        for (unsigned j = 0; j < 16; ++j) { const unsigned c = xb_ld(&bar[XB_XCNT(j)]); sum += c; cnt += (c > 0u) ? 1u : 0u; mine = (j == x) ? c : mine; }
        if (sum == G) break;
        __builtin_amdgcn_s_sleep(1);
        if ((++sp & 255u) == 0u) { if (xb_ld(&bar[XB_TMO])) break; if (sp > XB_SPIN_CAP) { atomicAdd(&bar[XB_TMO], 1u); break; } }
    }
    nloc = mine > 0u ? mine : 1u; nx = cnt > 0u ? cnt : 1u;
}

__device__ __forceinline__ void xcd_barrier(const XcdBarrier& b) {
    asm volatile("s_waitcnt vmcnt(0)" ::: "memory");
    __syncthreads();
    if (threadIdx.x == 0) {
        unsigned* bar = b.bar;
        __builtin_amdgcn_s_waitcnt(0);
        unsigned nloc = b.st[0], nx = b.st[1];
        if (nloc == 0u) { xcd_barrier_complete(bar, b.x, nloc, nx); b.st[0] = nloc; b.st[1] = nx; }
        const unsigned old = xb_add(&bar[XB_XSUB(b.x)], 1u);
        const unsigned gen = old / nloc;
        if (old + 1u == (gen + 1u) * nloc) {
            __builtin_amdgcn_fence(__ATOMIC_RELEASE, "agent");
            asm volatile("s_waitcnt vmcnt(0)" ::: "memory");
            const unsigned og = xb_add(&bar[XB_TOP], 1u);
            const unsigned tg = og / nx;
            if (og + 1u == (tg + 1u) * nx) xb_add(&bar[XB_TOPGEN], 1u);
            else XB_SPIN(xb_ld(&bar[XB_TOPGEN]) == tg, bar);
            __builtin_amdgcn_fence(__ATOMIC_ACQUIRE, "agent");
            xb_add(&bar[XB_XGEN(b.x)], 1u);
            asm volatile("s_waitcnt vmcnt(0)" ::: "memory");
        } else {
            XB_SPIN(xb_ld(&bar[XB_XGEN(b.x)]) == gen, bar);
            __builtin_amdgcn_fence(__ATOMIC_ACQUIRE, "agent");
            asm volatile("s_waitcnt vmcnt(0)" ::: "memory");
        }
    }
    __syncthreads();
}

#ifndef PH_MASK
#define PH_MASK 0xFFFFF
#endif
#define EN(b) if constexpr ((PH_MASK >> (b)) & 1)
#ifndef DUP_MASK
#define DUP_MASK 0
#endif
#define DUP(b) if constexpr ((DUP_MASK >> (b)) & 1)
#define DBG_DIGEST_N 256
#define DBG_DIGEST_VAL(m, c) bf2f(((const bf16*)(wsp + WS_CAT))[(size_t)(m) * DM + 768 + (c)])
#ifndef DBG_PH_HI
#define DBG_PH_HI NPHASE
#endif
#ifndef MK_MULTI
#define MK_MULTI 0
#endif
constexpr int LDS_BYTES = 151552, MISC_OFF = 131072 + 320;
#ifndef DBG_LAYERS
#define DBG_LAYERS 4
#define DBG_L0 0
#endif
constexpr int NPHASE = 3 + 7 * DBG_LAYERS;
__global__ void __launch_bounds__(512, 2) hymba_fwd(Args a) {
    extern __shared__ __attribute__((aligned(16))) unsigned char lds[];
    Ctx F0;
    Ctx& F = F0;
    F.lds = (char*)lds; F.tid = threadIdx.x; F.lane = F.tid & 63; F.wave = __builtin_amdgcn_readfirstlane(F.tid >> 6); F.G = gridDim.x; F.bid = blockIdx.x;
    F.A = nullptr; F.ws = a.ws;
    if (F.tid < 29) ((unsigned long long*)(lds + PTR_OFF))[F.tid] = F.tid < 28 ? (unsigned long long)a.in[F.tid] : (unsigned long long)a.out;
    volatile LAS unsigned* MISC = (volatile LAS unsigned*)((LAS unsigned char*)lds + MISC_OFF);
    if (F.tid < 32) MISC[F.tid] = 0u;
    __syncthreads();
    unsigned* ctl = (unsigned*)(a.ws + WS_CTL);
    XcdBarrier bar; bar.bar = ctl + CW_BAR; bar.x = 0; bar.st = nullptr;
    if (!MK_MULTI) bar = xcd_barrier_post(ctl + CW_BAR, MISC + 8);
    const int lo = a.ph_lo, hi = a.ph_hi;
    int ph = 0;
#define PH_BEGIN if (lo <= ph && ph < hi) { Ctx F = F0; unsigned long long wsl_ = (unsigned long long)F0.ws; asm volatile("" : "+v"(F.tid), "+s"(F.bid), "+s"(F.G), "+s"(wsl_)); F.ws = (unsigned char*)(__attribute__((address_space(1))) unsigned char*)wsl_; F.lane = F.tid & 63; F.wave = __builtin_amdgcn_readfirstlane(F.tid >> 6); unsigned char* const wsp = F.ws; (void)wsp;
#define PH_END   if (!MK_MULTI && ph + 1 < hi) { XcdBarrier bb = bar; asm volatile("" : "+s"(bb.bar), "+s"(bb.x)); xcd_barrier(bb); } else __syncthreads(); } ++ph;
    PG8_LAS unsigned char* glds = (PG8_LAS unsigned char*)lds;
#define XN ((bf16*)(wsp + WS_XN))
#define PROJ ((bf16*)(wsp + WS_PROJ))
#define CAT ((bf16*)(wsp + WS_CAT))
#define HB ((bf16*)(wsp + WS_HB))
    PH_BEGIN EN(0) ph_prologue(F); DUP(0) { __syncthreads(); ph_prologue(F); } PH_END
    PH_BEGIN EN(1) { ph_shw(F); ph_xs0(F, PIN(F, I_X), PIN(F, I_N1W) + DBG_L0 * DM, (const float*)(wsp + WS_MOD) + (size_t)DBG_L0 * BATCH * NADA, DM, XN, (float*)(wsp + WS_RSP), (bf16*)POUT(F)); } PH_END
    for (int l_ = 0; l_ < DBG_LAYERS; ++l_) { const int l = l_ + DBG_L0;
        #define modl ((const float*)(wsp + WS_MOD) + (size_t)l * BATCH * NADA)
        #define xsrc (l_ == 0 ? PIN(F, I_X) : (const float*)POUT(F))
        PH_BEGIN
#if defined(PROBE_GA)
            { pg8::Gemm g{XN, (const bf16*)(wsp + WS_WIN) + (size_t)l * NPROJ * DM, MTOK, NPROJ, DM}; pg8::StaticOrder S; S.init(MTOK, NPROJ, F.G, F.bid);
            pg8::EpiRoute<0> E{PROJ, NPROJ, PROJ, NPROJ, 1 << 20};
            pg8::gemm_phase<pg8::EpiRoute<0>, pg8::StaticOrder, true, true>(glds, g, S, E, F.tid); } __syncthreads();
#elif defined(PROBE_GB)
            { pg8::Gemm g{XN, (const bf16*)(wsp + WS_WIN) + (size_t)l * NPROJ * DM, MTOK, NPROJ, DM}; pg8::StaticOrder S; S.init(MTOK, NPROJ, F.G, F.bid);
            pg8::EpiRouteN<0> E{PROJ, NPROJ, (const float*)(wsp + WS_RSP), (const float*)(wsp + WS_SHW) + (size_t)l * BATCH * NSHW, glds};
            pg8::gemm_phase<pg8::EpiRouteN<0>, pg8::StaticOrder, true, true>(glds, g, S, E, F.tid); } __syncthreads();
#endif
        EN(2) { pg8::Gemm g{XN, (const bf16*)(wsp + WS_WIN) + (size_t)l * NPROJ * DM, MTOK, NPROJ, DM}; pg8::StaticOrder S; S.init(MTOK, NPROJ, F.G, F.bid);
            pg8::EpiRouteN<0> E{PROJ, NPROJ, (const float*)(wsp + WS_RSP), (const float*)(wsp + WS_SHW) + (size_t)l * BATCH * NSHW, glds};
            pg8::gemm_phase<pg8::EpiRouteN<0>, pg8::StaticOrder, true, true>(glds, g, S, E, F.tid); } PH_END
        PH_BEGIN EN(3) ph_prep(F, l); DUP(3) ph_prep(F, l); EN(4) ph_lru1(F, l); DUP(4) ph_lru1(F, l); EN(5) ph_mlstm(F, l); DUP(5) ph_mlstm(F, l); PH_END
        PH_BEGIN EN(6) { ph_carry(F); pg8::Gemm g{(const bf16*)(wsp + WS_QL), (const bf16*)(wsp + WS_WQC) + (size_t)l * 768 * 256, MTOK, 768, 256}; pg8::StaticOrder S; S.init(MTOK, 768, F.G, F.bid);
            pg8::EpiRoute<0> E{(bf16*)(wsp + WS_QABS), 512, (bf16*)(wsp + WS_QIDX), 256, 2};
            pg8::gemm_phase<pg8::EpiRoute<0>, pg8::StaticOrder, true, true>(glds, g, S, E, F.tid); } PH_END
        PH_BEGIN EN(7) ph_dsa(F, l); DUP(7) ph_dsa(F, l); EN(8) ph_lru2(F, l); DUP(8) ph_lru2(F, l); EN(9) ph_mfin(F, l); DUP(9) ph_mfin(F, l); PH_END
        PH_BEGIN EN(10) { pg8::Gemm g{CAT, (const bf16*)(wsp + WS_WO) + (size_t)l * DM * DM, MTOK, DM, DM}; pg8::StaticOrder S; S.init(MTOK, DM, F.G, F.bid);
            pg8::EpiResidXS<false> E{(const pg8::bf16_t*)POUT(F), (pg8::bf16_t*)POUT(F), modl + 2 * DM, (const float*)(wsp + WS_WP) + (size_t)(l * 2 + 1) * BATCH * DM, XN, (float*)(wsp + WS_RSP), 1};
            pg8::gemm_phase<pg8::EpiResidXS<false>, pg8::StaticOrder, true, true>(glds, g, S, E, F.tid); } PH_END
        PH_BEGIN EN(12) { pg8::Gemm g{XN, (const bf16*)(wsp + WS_W1) + (size_t)l * DFF * DM, MTOK, DFF, DM}; pg8::StaticOrder S; S.init(MTOK, DFF, F.G, F.bid);
            pg8::EpiRouteN<1> E{HB, DFF, (const float*)(wsp + WS_RSP), (const float*)(wsp + WS_SHW) + (size_t)l * BATCH * NSHW + NPROJ, glds};
            pg8::gemm_phase<pg8::EpiRouteN<1>, pg8::StaticOrder, true, true>(glds, g, S, E, F.tid); } PH_END
        PH_BEGIN EN(13) { pg8::Gemm g{HB, (const bf16*)(wsp + WS_W2) + (size_t)l * DM * DFF, MTOK, DM, DFF}; pg8::StaticOrder S; S.init(MTOK, DM, F.G, F.bid);
            const int nl = l + 1 < DEPTH ? l + 1 : l;
            const bool lastl = l_ + 1 >= DBG_LAYERS;
            pg8::EpiResidXS<true> E{(const pg8::bf16_t*)POUT(F), lastl ? (pg8::bf16_t*)XN : (pg8::bf16_t*)POUT(F), modl + 5 * DM, (const float*)(wsp + WS_WP) + (size_t)(nl * 2) * BATCH * DM, XN, (float*)(wsp + WS_RSP), lastl ? 0 : 1};
            pg8::gemm_phase<pg8::EpiResidXS<true>, pg8::StaticOrder, true, true>(glds, g, S, E, F.tid); } PH_END
    }
#ifdef DBG_DIGEST
    PH_BEGIN { const int gw = F.bid * 8 + F.wave, NGW = F.G * 8; float* o = POUT(F);
        for (int m = gw; m < MTOK; m += NGW) for (int j = 0; j < 16; ++j) { const int c = F.lane + 64 * j; float v = 0.f;
            if (c < DBG_DIGEST_N) { v = DBG_DIGEST_VAL(m, c) * 4096.0f; v = v - floorf(v); }
            o[(size_t)m * DM + c] = v; } } PH_END
#else
    PH_BEGIN EN(14) ph_finalnorm16(F, XN, PIN(F, I_FNW), POUT(F)); PH_END
#endif
}

extern "C" void kernel_launch(void* const* d_in, const int* in_sizes, int n_in, void* d_out, int out_size, void* d_ws, size_t ws_size, hipStream_t stream) {
    static int grid = 0;
    if (grid == 0) {
        if (n_in != 28 || in_sizes[0] != MTOK * DM || out_size != MTOK * DM || ws_size < WS_END) { fprintf(stderr, "kernel_launch: unexpected shapes (n_in %d, in0 %d, out %d, ws %zu)\n", n_in, n_in > 0 ? in_sizes[0] : -1, out_size, ws_size); grid = -1; return; }
        int dev = 0, cus = 0, per_cu = 0;
        if (hipGetDevice(&dev) != hipSuccess || hipDeviceGetAttribute(&cus, hipDeviceAttributeMultiprocessorCount, dev) != hipSuccess) { grid = -1; return; }
        if (hipFuncSetAttribute((const void*)hymba_fwd, hipFuncAttributeMaxDynamicSharedMemorySize, LDS_BYTES) != hipSuccess) { fprintf(stderr, "kernel_launch: hipFuncSetAttribute failed\n"); grid = -1; return; }
        if (hipOccupancyMaxActiveBlocksPerMultiprocessor(&per_cu, (const void*)hymba_fwd, 512, LDS_BYTES) != hipSuccess || per_cu < 1) { fprintf(stderr, "kernel_launch: occupancy query says %d\n", per_cu); }
        (void)hipGetLastError();
        grid = cus;
    }
    if (grid < 0) return;
    if (hipMemsetAsync((char*)d_ws + WS_CTL, 0, CTL_ZERO_BYTES, stream) != hipSuccess) return;
    Args a{};
    for (int i = 0; i < 28; ++i) a.in[i] = (const float*)d_in[i];
    a.out = (float*)d_out; a.ws = (unsigned char*)d_ws;
#if MK_MULTI
    for (int p = 0; p < NPHASE; ++p) { a.ph_lo = p; a.ph_hi = p + 1; hipLaunchKernelGGL(hymba_fwd, dim3(grid), dim3(512), LDS_BYTES, stream, a); }
#else
    a.ph_lo = 0; a.ph_hi = DBG_PH_HI; hipLaunchKernelGGL(hymba_fwd, dim3(grid), dim3(512), LDS_BYTES, stream, a);
#endif
}
#endif
```

```cpp
#ifndef HOST_EMU
#include <hip/hip_runtime.h>
#include <cstdio>
#include <cstdint>
#define DEV __device__ __forceinline__
#define LAS __attribute__((address_space(3)))
#else
#include "emu.h"
#endif

#ifndef HOST_EMU
#define SYNC() __syncthreads()
#define KEEP4(a, b, c, d) asm volatile("" :: "v"(a), "v"(b), "v"(c), "v"(d))
#define LAUNDER_V(x) asm volatile("" : "+v"(x))
#define WAVE_LDS_FENCE() asm volatile("s_waitcnt lgkmcnt(0)" ::: "memory")
template <class T> DEV T SHFL(T v, int s) { return __shfl(v, s); }
template <class T> DEV T SHFL_XOR(T v, int m) { return __shfl_xor(v, m); }
template <class T> DEV T SHFL_UP(T v, int d) { return __shfl_up(v, d); }
template <class T> DEV T SHFL_DOWN(T v, int d) { return __shfl_down(v, d); }
typedef short bf16x8_ __attribute__((ext_vector_type(8)));
typedef float f32x4_ __attribute__((ext_vector_type(4)));
typedef short v4i16_t __attribute__((ext_vector_type(4)));
DEV f32x4_ MFMA16(bf16x8_ a, bf16x8_ b, f32x4_ c) { return __builtin_amdgcn_mfma_f32_16x16x32_bf16(a, b, c, 0, 0, 0); }
DEV v4i16_t TR16(const void* p) { return __builtin_amdgcn_ds_read_tr16_b64_v4i16((LAS v4i16_t*)(p)); }
#endif


typedef unsigned short bf16;
typedef short bf16x8 __attribute__((ext_vector_type(8)));
typedef short s16x4 __attribute__((ext_vector_type(4)));
typedef float f32x4 __attribute__((ext_vector_type(4)));
typedef unsigned u32x4 __attribute__((ext_vector_type(4)));
typedef unsigned u32x2 __attribute__((ext_vector_type(2)));

constexpr int BATCH = 16, SEQ = 4096, DM = 1024, DEPTH = 4, MTOK = BATCH * SEQ;
constexpr int NPROJ = 3072, DFF = 4096, NADA = 6 * DM;
constexpr int PC_LX = 0, PC_LY = 256, PC_MQ = 512, PC_MK = 1024, PC_MV = 1536, PC_MO = 2048, PC_AQ = 2560, PC_AKV = 2816, PC_IK = 2944, PC_IW = 2976, PC_MI = 2984, PC_MF = 2988;
constexpr float NORM_EPS = 1e-6f;

constexpr size_t MiB = 1u << 20;
constexpr size_t WS_CTL = 0, CTL_ZERO_BYTES = 1 * MiB;
constexpr size_t WS_MOD = 1 * MiB;
constexpr size_t WS_WQC = 3 * MiB;
constexpr size_t WS_WG = 5 * MiB;
constexpr size_t WS_WUVT = 6 * MiB;
constexpr size_t WS_WIN = 8 * MiB;
constexpr size_t WS_WO = 32 * MiB;
constexpr size_t WS_W1 = 40 * MiB;
constexpr size_t WS_W2 = 72 * MiB;
constexpr size_t WS_XN = 104 * MiB;
constexpr size_t WS_QL = WS_XN, WS_CKV = WS_XN + 32 * MiB, WS_QIDX = WS_XN + 48 * MiB, WS_KIDX = WS_XN + 80 * MiB, WS_WI = WS_XN + 84 * MiB, WS_GT = WS_XN + 86 * MiB;
constexpr size_t WS_CAT = 232 * MiB;
constexpr size_t WS_PROJ = 360 * MiB;
constexpr size_t WS_HB = 360 * MiB;
constexpr size_t WS_QABS = 744 * MiB;
constexpr size_t WS_HLOC = 808 * MiB, WS_CPA = 840 * MiB;
constexpr size_t WS_LSUM = 872 * MiB;
constexpr size_t WS_HM = 874 * MiB;
constexpr size_t WS_MG = 940 * MiB;
constexpr size_t WS_WP = 2 * MiB + 512 * 1024;
constexpr size_t WS_SHW = 6 * MiB + 256 * 1024;
constexpr size_t WS_RSP = 1000 * MiB;
constexpr size_t WS_CARRY = 948 * MiB;
constexpr size_t WS_SCR2 = 949 * MiB;
constexpr int NSHW = NPROJ + DFF;
constexpr size_t WS_END = 1024 * MiB;
static_assert(WS_HM + (size_t)MTOK * 512 * 2 <= WS_END && WS_HB + (size_t)MTOK * DFF * 2 <= WS_HLOC + 64 * MiB, "ws map");

constexpr int CW_TMO = 0, CW_BAR = 4096;

#ifndef HOST_EMU
typedef __bf16 hwbf2_t __attribute__((ext_vector_type(2)));
typedef float hwf2_t __attribute__((ext_vector_type(2)));
DEV unsigned f2bf(float f) { return (unsigned)__builtin_bit_cast(unsigned short, (__bf16)f); }
DEV unsigned pk2(float lo, float hi) { const hwf2_t v = {lo, hi}; return __builtin_bit_cast(unsigned, __builtin_convertvector(v, hwbf2_t)); }
#else
DEV unsigned f2bf(float f) { unsigned u = __builtin_bit_cast(unsigned, f); return (u + 0x7fffu + ((u >> 16) & 1u)) >> 16; }
DEV unsigned pk2(float lo, float hi) { return f2bf(lo) | (f2bf(hi) << 16); }
#endif
DEV float bf2f(unsigned h) { return __builtin_bit_cast(float, h << 16); }
DEV float bflo(unsigned w) { return __builtin_bit_cast(float, w << 16); }
DEV float bfhi(unsigned w) { return __builtin_bit_cast(float, w & 0xffff0000u); }
DEV float wave_sum(float v) {
#pragma unroll
    for (int o = 1; o < 64; o <<= 1) v += SHFL_XOR(v, o);
    return v;
}
#ifndef HOST_EMU
DEV float FEXP(float x) { return __expf(x); }
DEV float FEXP2(float x) { return __builtin_amdgcn_exp2f(x); }
DEV float FRCP(float x) { return __builtin_amdgcn_rcpf(x); }
DEV float FSQRT(float x) { return __builtin_amdgcn_sqrtf(x); }
DEV float RSQ(float x) { return __builtin_amdgcn_rsqf(x); }
DEV float FLOG(float x) { return __logf(x); }
#else
DEV float FEXP(float x) { return expf(x); }
DEV float FEXP2(float x) { return exp2f(x); }
DEV float FRCP(float x) { return 1.0f / x; }
DEV float FSQRT(float x) { return sqrtf(x); }
DEV float RSQ(float x) { return 1.0f / sqrtf(x); }
DEV float FLOG(float x) { return logf(x); }
#endif
#ifndef HOST_EMU
DEV int UNI(int x) { return __builtin_amdgcn_readfirstlane(x); }
#else
DEV int UNI(int x) { return x; }
#endif
#ifndef HOST_EMU
#define GAS __attribute__((address_space(1)))
DEV const GAS char* UNIP(const void* p) { const unsigned long long v = (unsigned long long)p; const unsigned lo = __builtin_amdgcn_readfirstlane((unsigned)v), hi = __builtin_amdgcn_readfirstlane((unsigned)(v >> 32));
    return (const GAS char*)(((unsigned long long)hi << 32) | lo); }
#else
#define GAS
DEV const char* UNIP(const void* p) { return (const char*)p; }
#endif
DEV float RELU(float x) { const int b = __builtin_bit_cast(int, x); return __builtin_bit_cast(float, b > 0 ? b : 0); }
DEV float sigmoidf_(float z) { return 1.0f / (1.0f + expf(-z)); }
DEV float fsigmoid(float z) { return FRCP(1.0f + FEXP(-z)); }
DEV float one_minus_exp(float x) {
    const float s = -x * (1.0f + x * (0.5f + x * (0.16666667f + x * 0.041666668f)));
    return x > -0.05f ? s : 1.0f - FEXP(x);
}

struct Args { const float* in[28]; float* out; unsigned char* ws; int ph_lo, ph_hi; };
struct Ctx {
    char* lds; int tid, lane, wave, G, bid;
    const Args* A;
    unsigned char* ws;
};

constexpr int PTR_OFF = 131072 + 512;
#ifndef HOST_EMU
DEV const float* PIN(const Ctx& F, int i) { const unsigned long long v = ((const unsigned long long*)(F.lds + PTR_OFF))[i];
    const unsigned lo = __builtin_amdgcn_readfirstlane((unsigned)v), hi = __builtin_amdgcn_readfirstlane((unsigned)(v >> 32)); return (const float*)(const __attribute__((address_space(1))) float*)(((unsigned long long)hi << 32) | lo); }
DEV float* POUT(const Ctx& F) { return (float*)PIN(F, 28); }
#else
DEV const float* PIN(const Ctx& F, int i) { return F.A->in[i]; }
DEV float* POUT(const Ctx& F) { return POUT(F); }
#endif
enum { I_X = 0, I_C, I_WIN, I_CONVW, I_CONVB, I_WA, I_BA, I_WX, I_BX, I_LAM, I_BI, I_BF, I_WQUP, I_WQIDX, I_WUK, I_WUV, I_QNW, I_KVNW, I_RELB, I_GNW, I_WO, I_WADA, I_BADA, I_N1W, I_N2W, I_W1, I_W2, I_FNW };

DEV int win_srccol(int n) {
    if (n < 2560) return n;
    if (n < PC_AKV) return 2568 + (n - PC_AQ);
    if (n < PC_IK) return 2824 + (n - PC_AKV);
    if (n < PC_IW) return 2952 + (n - PC_IK);
    if (n < PC_MI) return 2984 + (n - PC_IW);
    if (n < PC_MF) return 2560 + (n - PC_MI);
    if (n < 2992) return 2564 + (n - PC_MF);
    return -1;
}
template <bool MAPPED>
DEV void p0_transpose_item(const float* W, int K, int N, int NT, bf16* WT, float* scr, int item, int lane) {
    const int nblk = NT / 32, kb = item / nblk, nb = item % nblk, k0 = 64 * kb, n0 = 32 * nb;
    int sc = n0 + (lane & 31); if (MAPPED) sc = win_srccol(sc);
#pragma unroll 8
    for (int i = 0; i < 32; ++i) { const int kk = 2 * i + (lane >> 5); const float v = W[(size_t)(k0 + kk) * N + (sc >= 0 ? sc : 0)]; scr[kk * 33 + (lane & 31)] = sc >= 0 ? v : 0.f; }
    WAVE_LDS_FENCE();
    const int c = lane & 7;
#pragma unroll
    for (int j = 0; j < 4; ++j) { const int n = (lane >> 3) + 8 * j; const float* s = scr + (8 * c) * 33 + n;
        u32x4 o; o.x = pk2(s[0 * 33], s[1 * 33]); o.y = pk2(s[2 * 33], s[3 * 33]); o.z = pk2(s[4 * 33], s[5 * 33]); o.w = pk2(s[6 * 33], s[7 * 33]);
        *(u32x4*)(WT + (size_t)(n0 + n) * K + k0 + 8 * c) = o; }
    WAVE_LDS_FENCE();
}

DEV void ph_prologue(const Ctx& F) {
    const int gt = F.bid * 512 + F.tid, NGT = F.G * 512;
    float* CACT = (float*)F.lds;
    for (int i = F.tid; i < BATCH * DM; i += 512) { const float cv = PIN(F, I_C)[i]; CACT[i] = cv * sigmoidf_(cv); }
    SYNC();
    for (int e = gt; e < DEPTH * NADA * 4; e += NGT) {
        const int j = e % NADA, bq = (e / NADA) & 3, l = e / (NADA * 4);
        const float* w = PIN(F, I_WADA) + (size_t)l * DM * NADA + j;
        const float* c = CACT + bq * 4 * DM;
        float a0 = 0.f, a1 = 0.f, a2 = 0.f, a3 = 0.f;
#pragma unroll 32
        for (int k = 0; k < DM; ++k) { const float wv = w[(size_t)k * NADA];
            a0 += c[k] * wv; a1 += c[DM + k] * wv; a2 += c[2 * DM + k] * wv; a3 += c[3 * DM + k] * wv; }
        const float bb = PIN(F, I_BADA)[(size_t)l * NADA + j];
        float* mo = (float*)(F.ws + WS_MOD) + ((size_t)l * BATCH + bq * 4) * NADA + j;
        mo[0] = a0 + bb; mo[NADA] = a1 + bb; mo[2 * NADA] = a2 + bb; mo[3 * NADA] = a3 + bb;
    }
    for (int e = gt; e < DEPTH * 2 * 4 * 64 * 64; e += NGT) {
        const int i = e & 63, j = (e >> 6) & 63, blk = (e >> 12) & 3, g = (e >> 14) & 1, l = e >> 15;
        const float* src = PIN(F, g ? I_WX : I_WA) + (((size_t)l * 4 + blk) * 64 + i) * 64 + j;
        ((bf16*)(F.ws + WS_WG))[e] = (bf16)f2bf(*src);
    }
    for (int e = gt; e < DEPTH * 4 * 64 * 128; e += NGT) {
        const int r = e & 127, d = (e >> 7) & 63, h = (e >> 13) & 3, l = e >> 15;
        ((bf16*)(F.ws + WS_WUVT))[e] = (bf16)f2bf(PIN(F, I_WUV)[(((size_t)l * 128 + r) * 4 + h) * 64 + d]);
    }
    for (int e = gt; e < DEPTH * 768 * 256; e += NGT) {
        const int r = e & 255, n = (e >> 8) % 768, l = e / (768 * 256);
        float v;
        if (n < 512) { const int h = n >> 7, c = n & 127; const f32x4* q = (const f32x4*)(PIN(F, I_WQUP) + ((size_t)l * 256 + r) * 256 + h * 64); const f32x4* k = (const f32x4*)(PIN(F, I_WUK) + ((size_t)l * 128 + c) * 256 + h * 64);
            float s = 0.f;
#pragma unroll
            for (int d = 0; d < 16; ++d) { const f32x4 a = q[d], bq4 = k[d]; s += (a.x * bq4.x + a.y * bq4.y) + (a.z * bq4.z + a.w * bq4.w); }
            v = s * (0.125f * 1.4426950408889634f); }
        else v = PIN(F, I_WQIDX)[((size_t)l * 256 + r) * 256 + (n - 512)] * 0.17677669529663687f;
        ((bf16*)(F.ws + WS_WQC))[e] = (bf16)f2bf(v);
    }
    SYNC();
    float* scr = (float*)(F.lds + F.wave * 16384);
    const int gw = F.bid * 8 + F.wave, NGW = F.G * 8;
    constexpr int I_IN = (DM / 64) * (NPROJ / 32), I_O = (DM / 64) * (DM / 32), I_1 = (DM / 64) * (DFF / 32), I_2 = (DFF / 64) * (DM / 32);
    constexpr int PER_L = I_IN + I_O + I_1 + I_2;
    for (int it = gw; it < DEPTH * PER_L; it += NGW) {
        const int l = it / PER_L; int r = it % PER_L;
        if (r < I_IN) { p0_transpose_item<true>(PIN(F, I_WIN) + (size_t)l * DM * 2992, DM, 2992, NPROJ, (bf16*)(F.ws + WS_WIN) + (size_t)l * NPROJ * DM, scr, r, F.lane); continue; } r -= I_IN;
        if (r < I_O) { p0_transpose_item<false>(PIN(F, I_WO) + (size_t)l * DM * DM, DM, DM, DM, (bf16*)(F.ws + WS_WO) + (size_t)l * DM * DM, scr, r, F.lane); continue; } r -= I_O;
        if (r < I_1) { p0_transpose_item<false>(PIN(F, I_W1) + (size_t)l * DM * DFF, DM, DFF, DFF, (bf16*)(F.ws + WS_W1) + (size_t)l * DFF * DM, scr, r, F.lane); continue; } r -= I_1;
        p0_transpose_item<false>(PIN(F, I_W2) + (size_t)l * DFF * DM, DFF, DM, DM, (bf16*)(F.ws + WS_W2) + (size_t)l * DM * DFF, scr, r, F.lane);
    }
}

DEV void ph_xs0(const Ctx& F, const float* xsrc, const float* nw, const float* modl, int sc_off, bf16* XS, float* RSP, bf16* X16) {
    const int gw = F.bid * 8 + F.wave, NGW = F.G * 8;
    f32x4 wv[4];
#pragma unroll
    for (int j = 0; j < 4; ++j) wv[j] = *(const f32x4*)(nw + 4 * F.lane + 256 * j);
    f32x4 v[2][4], vn[2][4];
#pragma unroll
    for (int q = 0; q < 2; ++q) { const int m = gw + q * NGW; const f32x4* xr = (const f32x4*)(xsrc + (size_t)(m < MTOK ? m : 0) * DM) + F.lane;
#pragma unroll
        for (int j = 0; j < 4; ++j) v[q][j] = xr[64 * j]; }
    for (int m0 = gw; m0 < MTOK; m0 += 2 * NGW) {
        f32x4 sc[2][4];
#pragma unroll
        for (int q = 0; q < 2; ++q) { const int m = m0 + q * NGW; const float* mb = modl + (size_t)((m < MTOK ? m : 0) >> 12) * NADA + 4 * F.lane;
#pragma unroll
            for (int j = 0; j < 4; ++j) sc[q][j] = *(const f32x4*)(mb + sc_off + 256 * j); }
#pragma unroll
        for (int q = 0; q < 2; ++q) { const int m = m0 + (2 + q) * NGW; const f32x4* xr = (const f32x4*)(xsrc + (size_t)(m < MTOK ? m : 0) * DM) + F.lane;
#pragma unroll
            for (int j = 0; j < 4; ++j) vn[q][j] = xr[64 * j]; }
        float s[2];
#pragma unroll
        for (int q = 0; q < 2; ++q) { float a = 0.f;
#pragma unroll
            for (int j = 0; j < 4; ++j) a += (v[q][j].x * v[q][j].x + v[q][j].y * v[q][j].y) + (v[q][j].z * v[q][j].z + v[q][j].w * v[q][j].w);
            s[q] = a; }
#pragma unroll
        for (int o = 1; o < 64; o <<= 1) { s[0] += SHFL_XOR(s[0], o); s[1] += SHFL_XOR(s[1], o); }
#pragma unroll
        for (int q = 0; q < 2; ++q) { const int m = m0 + q * NGW; if (m >= MTOK) break;
            if (F.lane < 16) RSP[(size_t)m * 16 + F.lane] = F.lane == 0 ? s[q] : 0.f;
            u32x2* o8 = (u32x2*)(XS + (size_t)m * DM) + F.lane; u32x2* x8 = (u32x2*)(X16 + (size_t)m * DM) + F.lane;
#pragma unroll
            for (int j = 0; j < 4; ++j) { const f32x4 y = v[q][j] * (wv[j] * (1.0f + sc[q][j]));
                u32x2 p; p.x = pk2(y.x, y.y); p.y = pk2(y.z, y.w); o8[64 * j] = p;
                u32x2 c; c.x = pk2(v[q][j].x, v[q][j].y); c.y = pk2(v[q][j].z, v[q][j].w); x8[64 * j] = c; } }
#pragma unroll
        for (int q = 0; q < 2; ++q)
#pragma unroll
            for (int j = 0; j < 4; ++j) v[q][j] = vn[q][j];
    }
}
DEV void ph_shw(const Ctx& F) {
    const int gt = F.bid * 512 + F.tid, NGT = F.G * 512;
    for (int e = gt; e < DEPTH * 2 * BATCH * (DM / 4); e += NGT) {
        const int c4 = e & 255, b = (e >> 8) & 15, w = (e >> 12) & 1, l = e >> 13;
        const f32x4 nwv = *(const f32x4*)(PIN(F, w ? I_N2W : I_N1W) + l * DM + 4 * c4);
        const f32x4 sc = *(const f32x4*)((const float*)(F.ws + WS_MOD) + ((size_t)l * BATCH + b) * NADA + (w ? 4 * DM : DM) + 4 * c4);
        ((f32x4*)(F.ws + WS_WP))[e] = nwv * (1.0f + sc);
    }
    const int gw = F.bid * 8 + F.wave, NGW = F.G * 8, i16 = F.lane & 15, kq = 8 * (F.lane >> 4);
    for (int it = gw; it < DEPTH * (NSHW / 16); it += NGW) {
        const int l = it / (NSHW / 16), n0 = (it % (NSHW / 16)) * 16;
        const bool mlp = n0 >= NPROJ;
        const bf16* Wr = mlp ? (const bf16*)(F.ws + WS_W1) + ((size_t)l * DFF + (n0 - NPROJ) + i16) * DM : (const bf16*)(F.ws + WS_WIN) + ((size_t)l * NPROJ + n0 + i16) * DM;
        const float* sh = (const float*)(F.ws + WS_MOD) + ((size_t)l * BATCH + i16) * NADA + (mlp ? 3 * DM : 0);
        f32x4 acc0 = {0.f, 0.f, 0.f, 0.f}, acc1 = {0.f, 0.f, 0.f, 0.f};
#pragma unroll 4
        for (int s = 0; s < DM / 32; ++s) {
            const bf16x8 B = *(const bf16x8*)(Wr + 32 * s + kq);
            const f32x4 a0 = *(const f32x4*)(sh + 32 * s + kq), a1 = *(const f32x4*)(sh + 32 * s + kq + 4);
            bf16x8 Ah, Al;
#pragma unroll
            for (int j = 0; j < 8; ++j) { const float a = j < 4 ? a0[j] : a1[j - 4]; const unsigned h = f2bf(a); Ah[j] = (short)h; Al[j] = (short)f2bf(a - bf2f(h)); }
            acc0 = MFMA16(Ah, B, acc0); acc1 = MFMA16(Al, B, acc1);
        }
        float* o = (float*)(F.ws + WS_SHW) + ((size_t)l * BATCH + 4 * (F.lane >> 4)) * NSHW + n0 + i16;
#pragma unroll
        for (int r = 0; r < 4; ++r) o[(size_t)r * NSHW] = acc0[r] + acc1[r];
    }
}
DEV void ph_normmod(const Ctx& F, const float* xsrc, const float* nw, const float* modl, int sh_off, int sc_off, bf16* XN) {
    const int gw = F.bid * 8 + F.wave, NGW = F.G * 8;
    f32x4 wv[4];
#pragma unroll
    for (int j = 0; j < 4; ++j) wv[j] = *(const f32x4*)(nw + 4 * F.lane + 256 * j);
    f32x4 v[2][4], vn[2][4];
#pragma unroll
    for (int q = 0; q < 2; ++q) { const int m = gw + q * NGW; const f32x4* xr = (const f32x4*)(xsrc + (size_t)(m < MTOK ? m : 0) * DM) + F.lane;
#pragma unroll
        for (int j = 0; j < 4; ++j) v[q][j] = xr[64 * j]; }
    for (int m0 = gw; m0 < MTOK; m0 += 2 * NGW) {
        f32x4 sc[2][4], sh[2][4];
#pragma unroll
        for (int q = 0; q < 2; ++q) { const int m = m0 + q * NGW; const float* mb = modl + (size_t)((m < MTOK ? m : 0) >> 12) * NADA + 4 * F.lane;
#pragma unroll
            for (int j = 0; j < 4; ++j) { sc[q][j] = *(const f32x4*)(mb + sc_off + 256 * j); sh[q][j] = *(const f32x4*)(mb + sh_off + 256 * j); } }
#pragma unroll
        for (int q = 0; q < 2; ++q) { const int m = m0 + (2 + q) * NGW; const f32x4* xr = (const f32x4*)(xsrc + (size_t)(m < MTOK ? m : 0) * DM) + F.lane;
#pragma unroll
            for (int j = 0; j < 4; ++j) vn[q][j] = xr[64 * j]; }
        float s[2];
#pragma unroll
        for (int q = 0; q < 2; ++q) { float a = 0.f;
#pragma unroll
            for (int j = 0; j < 4; ++j) a += (v[q][j].x * v[q][j].x + v[q][j].y * v[q][j].y) + (v[q][j].z * v[q][j].z + v[q][j].w * v[q][j].w);
            s[q] = a; }
#pragma unroll
        for (int o = 1; o < 64; o <<= 1) { s[0] += SHFL_XOR(s[0], o); s[1] += SHFL_XOR(s[1], o); }
#pragma unroll
        for (int q = 0; q < 2; ++q) { const int m = m0 + q * NGW; if (m >= MTOK) break;
            const float rs = RSQ(s[q] * (1.0f / DM) + NORM_EPS);
            u32x2* o8 = (u32x2*)(XN + (size_t)m * DM) + F.lane;
#pragma unroll
            for (int j = 0; j < 4; ++j) { const f32x4 y = v[q][j] * rs * wv[j] * (1.0f + sc[q][j]) + sh[q][j];
                u32x2 p; p.x = pk2(y.x, y.y); p.y = pk2(y.z, y.w); o8[64 * j] = p; } }
#pragma unroll
        for (int q = 0; q < 2; ++q)
#pragma unroll
            for (int j = 0; j < 4; ++j) v[q][j] = vn[q][j];
    }
}
DEV void ph_finalnorm(const Ctx& F, const float* xsrc, const float* nw, float* out) {
    const int gw = F.bid * 8 + F.wave, NGW = F.G * 8;
    f32x4 wv[4];
#pragma unroll
    for (int j = 0; j < 4; ++j) wv[j] = *(const f32x4*)(nw + 4 * F.lane + 256 * j);
    f32x4 v[2][4], vn[2][4];
#pragma unroll
    for (int q = 0; q < 2; ++q) { const int m = gw + q * NGW; const f32x4* xr = (const f32x4*)(xsrc + (size_t)(m < MTOK ? m : 0) * DM) + F.lane;
#pragma unroll
        for (int j = 0; j < 4; ++j) v[q][j] = xr[64 * j]; }
    for (int m0 = gw; m0 < MTOK; m0 += 2 * NGW) {
#pragma unroll
        for (int q = 0; q < 2; ++q) { const int m = m0 + (2 + q) * NGW; const f32x4* xr = (const f32x4*)(xsrc + (size_t)(m < MTOK ? m : 0) * DM) + F.lane;
#pragma unroll
            for (int j = 0; j < 4; ++j) vn[q][j] = xr[64 * j]; }
        float s[2];
#pragma unroll
        for (int q = 0; q < 2; ++q) { float a = 0.f;
#pragma unroll
            for (int j = 0; j < 4; ++j) a += (v[q][j].x * v[q][j].x + v[q][j].y * v[q][j].y) + (v[q][j].z * v[q][j].z + v[q][j].w * v[q][j].w);
            s[q] = a; }
#pragma unroll
        for (int o = 1; o < 64; o <<= 1) { s[0] += SHFL_XOR(s[0], o); s[1] += SHFL_XOR(s[1], o); }
#pragma unroll
        for (int q = 0; q < 2; ++q) { const int m = m0 + q * NGW; if (m >= MTOK) break;
            const float rs = RSQ(s[q] * (1.0f / DM) + NORM_EPS);
            f32x4* o = (f32x4*)(out + (size_t)m * DM) + F.lane;
#pragma unroll
            for (int j = 0; j < 4; ++j) o[64 * j] = v[q][j] * rs * wv[j]; }
#pragma unroll
        for (int q = 0; q < 2; ++q)
#pragma unroll
            for (int j = 0; j < 4; ++j) v[q][j] = vn[q][j];
    }
}
DEV void ph_finalnorm16(const Ctx& F, const bf16* x16, const float* nw, float* out) {
    const int gw = F.bid * 8 + F.wave, NGW = F.G * 8;
    f32x4 wv[2][2];
#pragma unroll
    for (int j = 0; j < 2; ++j) { wv[j][0] = *(const f32x4*)(nw + 8 * F.lane + 512 * j); wv[j][1] = *(const f32x4*)(nw + 8 * F.lane + 512 * j + 4); }
    u32x4 v[4][2], vn[4][2];
#pragma unroll
    for (int q = 0; q < 4; ++q) { const int m = gw + q * NGW; const bf16* xr = x16 + (size_t)(m < MTOK ? m : 0) * DM + 8 * F.lane;
        v[q][0] = *(const u32x4*)xr; v[q][1] = *(const u32x4*)(xr + 512); }
    for (int m0 = gw; m0 < MTOK; m0 += 4 * NGW) {
#pragma unroll
        for (int q = 0; q < 4; ++q) { const int m = m0 + (4 + q) * NGW; const bf16* xr = x16 + (size_t)(m < MTOK ? m : 0) * DM + 8 * F.lane;
            vn[q][0] = *(const u32x4*)xr; vn[q][1] = *(const u32x4*)(xr + 512); }
        float s[4];
#pragma unroll
        for (int q = 0; q < 4; ++q) { float a = 0.f;
#pragma unroll
            for (int j = 0; j < 2; ++j) { const u32x4 r = v[q][j];
                a += ((bflo(r.x) * bflo(r.x) + bfhi(r.x) * bfhi(r.x)) + (bflo(r.y) * bflo(r.y) + bfhi(r.y) * bfhi(r.y))) + ((bflo(r.z) * bflo(r.z) + bfhi(r.z) * bfhi(r.z)) + (bflo(r.w) * bflo(r.w) + bfhi(r.w) * bfhi(r.w))); }
            s[q] = a; }
#pragma unroll
        for (int o = 1; o < 64; o <<= 1) {
#pragma unroll
            for (int q = 0; q < 4; ++q) s[q] += SHFL_XOR(s[q], o); }
#pragma unroll
        for (int q = 0; q < 4; ++q) { const int m = m0 + q * NGW; if (m >= MTOK) break;
            const float rs = RSQ(s[q] * (1.0f / DM) + NORM_EPS);
            float* o = out + (size_t)m * DM + 8 * F.lane;
#pragma unroll
            for (int j = 0; j < 2; ++j) { const u32x4 r = v[q][j];
                *(f32x4*)(o + 512 * j) = (f32x4){bflo(r.x), bfhi(r.x), bflo(r.y), bfhi(r.y)} * rs * wv[j][0];
                *(f32x4*)(o + 512 * j + 4) = (f32x4){bflo(r.z), bfhi(r.z), bflo(r.w), bfhi(r.w)} * rs * wv[j][1]; } }
#pragma unroll
        for (int q = 0; q < 4; ++q) { v[q][0] = vn[q][0]; v[q][1] = vn[q][1]; }
    }
}
DEV void ph_zero_cat(const Ctx& F, int c0, int nq) {
    const int gw = F.bid * 8 + F.wave, NGW = F.G * 8;
    bf16* CAT = (bf16*)(F.ws + WS_CAT);
    for (int m = gw; m < MTOK; m += NGW) for (int q = 0; q < nq; ++q) *(u32x2*)(CAT + (size_t)m * DM + c0 + 256 * q + 4 * F.lane) = (u32x2){0u, 0u};
}
DEV float softcap15(float z) { return 15.0f * tanhf(z * (1.0f / 15.0f)); }
DEV float logsigmoidf_(float x) { return x >= 0.f ? -log1pf(expf(-x)) : x - log1pf(expf(x)); }
DEV void ph_prep(const Ctx& F, int l) {
    const int gw = F.bid * 8 + F.wave, NGW = F.G * 8, lane = F.lane;
    const bf16* PROJ = (const bf16*)(F.ws + WS_PROJ);
    bf16* QL = (bf16*)(F.ws + WS_QL); bf16* CKV = (bf16*)(F.ws + WS_CKV); bf16* KIDX = (bf16*)(F.ws + WS_KIDX);
    float* WI = (float*)(F.ws + WS_WI);
    const f32x4 qn = *(const f32x4*)(PIN(F, I_QNW) + l * 256 + 4 * lane);
    const float kn0 = PIN(F, I_KVNW)[l * 128 + 2 * lane], kn1 = PIN(F, I_KVNW)[l * 128 + 2 * lane + 1];
    u32x2 ra4[4], ran[4]; unsigned rk4[4], rx4[4], rkn[4], rxn[4];
#define PREP_LOAD(RA, RK, RX, M0) do { _Pragma("unroll") for (int q = 0; q < 4; ++q) { const int mm = (M0) + q * NGW; const bf16* pr = PROJ + (size_t)(mm < MTOK ? mm : 0) * NPROJ; \
            RA[q] = *(const u32x2*)(pr + PC_AQ + 4 * lane); RK[q] = *(const unsigned*)(pr + PC_AKV + 2 * lane); \
            RX[q] = lane < 16 ? *(const unsigned*)(pr + PC_IK + 2 * lane) : (lane < 24 ? (unsigned)pr[PC_IW + (lane - 16)] : 0u); } } while (0)
    PREP_LOAD(ra4, rk4, rx4, gw);
    for (int m0 = gw; m0 < MTOK; m0 += 4 * NGW) {
        PREP_LOAD(ran, rkn, rxn, m0 + 4 * NGW);
#pragma unroll
        for (int q = 0; q < 4; ++q) { const int m = m0 + q * NGW; if (m >= MTOK) break;
            const u32x2 ra = ra4[q]; const unsigned rk = rk4[q];
            const float a0 = bflo(ra.x), a1 = bfhi(ra.x), a2 = bflo(ra.y), a3 = bfhi(ra.y);
            const float k0 = bflo(rk), k1 = bfhi(rk);
            const float sq = wave_sum((a0 * a0 + a1 * a1) + (a2 * a2 + a3 * a3)), sk = wave_sum(k0 * k0 + k1 * k1);
            const float rq = RSQ(sq * (1.0f / 256.0f) + NORM_EPS), rk2 = RSQ(sk * (1.0f / 128.0f) + NORM_EPS);
            u32x2 oq; oq.x = pk2(a0 * rq * qn.x, a1 * rq * qn.y); oq.y = pk2(a2 * rq * qn.z, a3 * rq * qn.w);
            *(u32x2*)(QL + (size_t)m * 256 + 4 * lane) = oq;
            *(unsigned*)(CKV + (size_t)m * 128 + 2 * lane) = pk2(k0 * rk2 * kn0, k1 * rk2 * kn1);
            if (lane < 16) *(unsigned*)(KIDX + (size_t)m * 32 + 2 * lane) = rx4[q];
            else if (lane < 24) WI[(size_t)m * 8 + (lane - 16)] = bf2f(rx4[q]); }
#pragma unroll
        for (int q = 0; q < 4; ++q) { ra4[q] = ran[q]; rk4[q] = rkn[q]; rx4[q] = rxn[q]; }
    }
#undef PREP_LOAD
}

constexpr int XB_STRIDE = 264;
DEV void ph_lru1(const Ctx& F, int l) {
    const int tid = F.tid, lane = F.lane, w = F.wave, i16 = lane & 15, g = lane >> 4;
    bf16* XB = (bf16*)F.lds;
    float* XF = (float*)(F.lds + 64 * XB_STRIDE * 2);
    const bf16* PROJ = (const bf16*)(F.ws + WS_PROJ);
    bf16* HLOC = (bf16*)(F.ws + WS_HLOC); bf16* CPA = (bf16*)(F.ws + WS_CPA); float* LSUM = (float*)(F.ws + WS_LSUM);
    const int blk = w & 3, nh = w >> 2;
    const bf16* WG = (const bf16*)(F.ws + WS_WG) + (size_t)l * 2 * 4 * 4096;
    bf16x8 Bf[2][2][2];
#pragma unroll
    for (int gg = 0; gg < 2; ++gg)
#pragma unroll
        for (int nt = 0; nt < 2; ++nt)
#pragma unroll
            for (int ks = 0; ks < 2; ++ks) Bf[gg][nt][ks] = *(const bf16x8*)(WG + ((size_t)(gg * 4 + blk) * 64 + nh * 32 + 2 * i16 + nt) * 64 + ks * 32 + 8 * g);
    float ba[2], bx[2], sp[2];
#pragma unroll
    for (int nt = 0; nt < 2; ++nt) { const int ch = blk * 64 + nh * 32 + 2 * i16 + nt;
        ba[nt] = PIN(F, I_BA)[l * 256 + ch]; bx[nt] = PIN(F, I_BX)[l * 256 + ch];
        const float lam = PIN(F, I_LAM)[l * 256 + ch]; sp[nt] = lam > 0.f ? log1pf(expf(-lam)) : -lam + log1pf(expf(lam)); }
    const int ch2 = tid & 127, tg = tid >> 7;
    float cw[4][2], cb[2];
#pragma unroll
    for (int j = 0; j < 4; ++j) { cw[j][0] = PIN(F, I_CONVW)[(l * 4 + j) * 256 + 2 * ch2]; cw[j][1] = PIN(F, I_CONVW)[(l * 4 + j) * 256 + 2 * ch2 + 1]; }
    cb[0] = PIN(F, I_CONVB)[l * 256 + 2 * ch2]; cb[1] = PIN(F, I_CONVB)[l * 256 + 2 * ch2 + 1];

    for (int u = F.bid; u < BATCH * 64; u += F.G) {
        const int b = u >> 6, c = u & 63, t0 = c * 64; const size_t m0 = (size_t)b * SEQ + t0;
        {
            const int tl0 = tg * 16;
            unsigned rv[19];
#pragma unroll
            for (int j = 0; j < 3; ++j) { const int t = t0 + tl0 - 3 + j; rv[j] = t >= 0 ? *(const unsigned*)(PROJ + ((size_t)b * SEQ + t) * NPROJ + PC_LX + 2 * ch2) : 0u; }
#pragma unroll
            for (int tt = 0; tt < 16; ++tt) rv[3 + tt] = *(const unsigned*)(PROJ + (m0 + tl0 + tt) * NPROJ + PC_LX + 2 * ch2);
#pragma unroll
            for (int tt = 0; tt < 16; ++tt) { const int tl = tl0 + tt;
                const float x0 = cw[0][0] * bflo(rv[tt]) + cw[1][0] * bflo(rv[tt + 1]) + cw[2][0] * bflo(rv[tt + 2]) + cw[3][0] * bflo(rv[tt + 3]) + cb[0];
                const float x1 = cw[0][1] * bfhi(rv[tt]) + cw[1][1] * bfhi(rv[tt + 1]) + cw[2][1] * bfhi(rv[tt + 2]) + cw[3][1] * bfhi(rv[tt + 3]) + cb[1];
                *(unsigned*)(XB + tl * XB_STRIDE + 2 * ch2) = pk2(x0, x1);
                XF[tl * 256 + 2 * ch2] = x0; XF[tl * 256 + 2 * ch2 + 1] = x1; }
        }
        SYNC();
        float CA[2] = {1.f, 1.f}, CU[2] = {0.f, 0.f};
#pragma unroll 1
        for (int m = 0; m < 4; ++m) {
            f32x4 acc[2][2];
#pragma unroll
            for (int gg = 0; gg < 2; ++gg)
#pragma unroll
                for (int nt = 0; nt < 2; ++nt) acc[gg][nt] = (f32x4){0.f, 0.f, 0.f, 0.f};
#pragma unroll
            for (int ks = 0; ks < 2; ++ks) { const bf16x8 A = *(const bf16x8*)(XB + (m * 16 + i16) * XB_STRIDE + blk * 64 + ks * 32 + 8 * g);
#pragma unroll
                for (int gg = 0; gg < 2; ++gg)
#pragma unroll
                    for (int nt = 0; nt < 2; ++nt) acc[gg][nt] = MFMA16(A, Bf[gg][nt][ks], acc[gg][nt]); }
            float HL[2][4], CP[2][4];
            const int chb = blk * 64 + nh * 32 + 2 * i16;
            float xf[4][2];
#pragma unroll
            for (int r = 0; r < 4; ++r) { const float* xp = XF + (m * 16 + 4 * g + r) * 256 + chb; xf[r][0] = xp[0]; xf[r][1] = xp[1]; }
#pragma unroll
            for (int nt = 0; nt < 2; ++nt) {
                float P[4], H[4]; float pa = 1.f, hu = 0.f;
#pragma unroll
                for (int r = 0; r < 4; ++r) {
                    const float rg = fsigmoid(acc[0][nt][r] + ba[nt]), gi = fsigmoid(acc[1][nt][r] + bx[nt]);
                    const float la = -8.0f * rg * sp[nt], a = FEXP(la), uu = FSQRT((1.0f - a) * (1.0f + a)) * (gi * xf[r][nt]);
                    pa = a * pa; hu = a * hu + uu; P[r] = pa; H[r] = hu;
                    }
                float EA = 1.f, EU = 0.f, TA = 1.f, TU = 0.f;
#pragma unroll
                for (int gg = 0; gg < 4; ++gg) { const float ta = SHFL(pa, i16 + 16 * gg), tu = SHFL(hu, i16 + 16 * gg);
                    if (gg < g) { EU = ta * EU + tu; EA = ta * EA; }
                    TU = ta * TU + tu; TA = ta * TA; }
                const float XA = EA * CA[nt], XU = EA * CU[nt] + EU;
#pragma unroll
                for (int r = 0; r < 4; ++r) { HL[nt][r] = P[r] * XU + H[r]; CP[nt][r] = P[r] * XA; }
                CU[nt] = TA * CU[nt] + TU; CA[nt] = TA * CA[nt];
            }
#pragma unroll
            for (int r = 0; r < 4; ++r) { const size_t o = (m0 + m * 16 + 4 * g + r) * 256 + chb;
                *(unsigned*)(HLOC + o) = pk2(HL[0][r], HL[1][r]); *(unsigned*)(CPA + o) = pk2(CP[0][r], CP[1][r]); }
        }
        if (g == 0) {
#pragma unroll
            for (int nt = 0; nt < 2; ++nt) { const int ch = blk * 64 + nh * 32 + 2 * i16 + nt;
                LSUM[((size_t)b * 64 + c) * 256 + ch] = CA[nt]; LSUM[(size_t)BATCH * 64 * 256 + ((size_t)b * 64 + c) * 256 + ch] = CU[nt]; }
        }
        SYNC();
    }
}

DEV float gelu_tanh(float x) { const float z = 0.7978845608028654f * (x + 0.044715f * x * x * x); return x * FRCP(1.0f + FEXP(-2.0f * z)); }
DEV void ph_carry(const Ctx& F) {
    if (F.wave != 0) return;
    const float* LSUM = (const float*)(F.ws + WS_LSUM); float* CARRY = (float*)(F.ws + WS_CARRY);
    const int seg = F.lane & 3;
    for (int chain = F.bid * 16 + (F.lane >> 2); chain < BATCH * 256; chain += F.G * 16) {
        const int b = chain >> 8, ch = chain & 255; const size_t o0 = ((size_t)b * 64 + seg * 16) * 256 + ch;
        float a[16], hb[16];
#pragma unroll
        for (int i = 0; i < 16; ++i) { a[i] = LSUM[o0 + (size_t)i * 256]; hb[i] = LSUM[(size_t)BATCH * 64 * 256 + o0 + (size_t)i * 256]; }
        float hp[16], ap[16], hl = 0.f, al = 1.f;
#pragma unroll
        for (int i = 0; i < 16; ++i) { hp[i] = hl; ap[i] = al; hl = a[i] * hl + hb[i]; al = a[i] * al; }
        float cin = 0.f;
#pragma unroll
        for (int s2 = 0; s2 < 3; ++s2) { const float as = SHFL(al, (F.lane & ~3) + s2), hs = SHFL(hl, (F.lane & ~3) + s2); if (s2 < seg) cin = as * cin + hs; }
#pragma unroll
        for (int i = 0; i < 16; ++i) CARRY[o0 + (size_t)i * 256] = ap[i] * cin + hp[i];
    }
}
DEV void ph_lru2(const Ctx& F, int l) {
    const int tid = F.tid, lane = F.lane, w = F.wave;
    const bf16* PROJ = (const bf16*)(F.ws + WS_PROJ); const bf16* HLOC = (const bf16*)(F.ws + WS_HLOC); const bf16* CPA = (const bf16*)(F.ws + WS_CPA);
    const float* CARRY = (const float*)(F.ws + WS_CARRY); bf16* CAT = (bf16*)(F.ws + WS_CAT);
    const f32x4 gw4 = *(const f32x4*)(PIN(F, I_GNW) + l * DM + 4 * lane);
    for (int u = F.bid; u < BATCH * 64; u += F.G) {
        const int b = u >> 6, c = u & 63; const size_t m0 = (size_t)b * SEQ + c * 64;
        const f32x4 car = *(const f32x4*)(CARRY + (size_t)u * 256 + 4 * lane);
        u32x2 hl8[8], cp8[8], ly8[8];
#pragma unroll
        for (int tt = 0; tt < 8; ++tt) { const size_t m = m0 + w * 8 + tt;
            hl8[tt] = *(const u32x2*)(HLOC + m * 256 + 4 * lane); cp8[tt] = *(const u32x2*)(CPA + m * 256 + 4 * lane); ly8[tt] = *(const u32x2*)(PROJ + m * NPROJ + PC_LY + 4 * lane); }
#pragma unroll
        for (int tt = 0; tt < 8; ++tt) { const size_t m = m0 + w * 8 + tt; const u32x2 hl = hl8[tt], cp = cp8[tt], ly = ly8[tt];
            float v0 = (bflo(hl.x) + bflo(cp.x) * car.x) * gelu_tanh(bflo(ly.x));
            float v1 = (bfhi(hl.x) + bfhi(cp.x) * car.y) * gelu_tanh(bfhi(ly.x));
            float v2 = (bflo(hl.y) + bflo(cp.y) * car.z) * gelu_tanh(bflo(ly.y));
            float v3 = (bfhi(hl.y) + bfhi(cp.y) * car.w) * gelu_tanh(bfhi(ly.y));
            const float rs = RSQ(wave_sum((v0 * v0 + v1 * v1) + (v2 * v2 + v3 * v3)) * (1.0f / 256.0f) + NORM_EPS);
            u32x2 o; o.x = pk2(v0 * rs * gw4.x, v1 * rs * gw4.y); o.y = pk2(v2 * rs * gw4.z, v3 * rs * gw4.w);
            *(u32x2*)(CAT + m * DM + 4 * lane) = o; }
    }
}

constexpr int QS_STRIDE = 136, VE_STRIDE = 56;
DEV void ph_mlstm(const Ctx& F, int l) {
    const int tid = F.tid, lane = F.lane, w = F.wave, i16 = lane & 15, g = lane >> 4;
    bf16* QsB = (bf16*)F.lds;
    bf16* KsB = QsB + 2 * 64 * QS_STRIDE;
    bf16* VE = KsB + 2 * 64 * QS_STRIDE;
    bf16* VW = VE + 64 * VE_STRIDE;
    bf16* CsB = VW + 64 * VE_STRIDE;
    float* BCB = (float*)(CsB + 2 * 128 * VE_STRIDE);
    float* BIB = BCB + 128;
    const bf16* PROJ = (const bf16*)(F.ws + WS_PROJ); bf16* HM = (bf16*)(F.ws + WS_HM);
    const float qscale = 0.08838834764831845f;
    const int half = w >> 2, jt = half ? 3 - (w & 3) : (w & 3);
    for (int u = F.bid; u < BATCH * 4 * 4; u += F.G) {
        const int b = u >> 4, h = (u >> 2) & 3, vs = u & 3;
        const float gbi = PIN(F, I_BI)[l * 4 + h], gbf = PIN(F, I_BF)[l * 4 + h];
        f32x4 accC[3];
#pragma unroll
        for (int nt = 0; nt < 3; ++nt) accC[nt] = (f32x4){0.f, 0.f, 0.f, 0.f};
        float* BCg = (float*)(F.ws + WS_MG) + (size_t)u * 8192; float* BIg = BCg + 4096;
        unsigned gri[8], grf[8];
#pragma unroll
        for (int k = 0; k < 8; ++k) { const bf16* pr = PROJ + ((size_t)b * SEQ + (8 * k + w) * 64 + lane) * NPROJ; gri[k] = pr[PC_MI + h]; grf[k] = pr[PC_MF + h]; }
#pragma unroll
        for (int k = 0; k < 8; ++k) { const int tok = (8 * k + w) * 64 + lane;
            const float zi = (bf2f(gri[k]) + gbi) * (1.0f / 15.0f), zf = (bf2f(grf[k]) + gbf) * (1.0f / 15.0f);
            const float ig = 15.0f - 30.0f * FRCP(FEXP(2.0f * zi) + 1.0f), fg = 15.0f - 30.0f * FRCP(FEXP(2.0f * zf) + 1.0f);
            float s = -FLOG(1.0f + FEXP(-fg));
#pragma unroll
            for (int o = 1; o < 64; o <<= 1) { const float t = SHFL_UP(s, o); if (lane >= o) s += t; }
            BCg[tok] = s; BIg[tok] = s - ig; }
        SYNC();
        u32x4 rq[2], rk[2]; u32x2 rvv; float rgc = 0.f, rgb = 0.f;
        {
            const size_t m0 = (size_t)b * SEQ;
#pragma unroll
            for (int i = 0; i < 2; ++i) { const int idx = tid + 512 * i, row = idx >> 4, ck = idx & 15;
                rq[i] = *(const u32x4*)(PROJ + (m0 + row) * NPROJ + PC_MQ + h * 128 + 8 * ck); rk[i] = *(const u32x4*)(PROJ + (m0 + row) * NPROJ + PC_MK + h * 128 + 8 * ck); }
            rvv = *(const u32x2*)(PROJ + (m0 + (tid >> 3)) * NPROJ + PC_MV + h * 128 + vs * 32 + 4 * (tid & 7));
            if (tid < 64) { rgc = BCg[tid]; rgb = BIg[tid]; }
        }
        for (int c = 0; c < 64; ++c) {
            const size_t m0 = (size_t)b * SEQ + c * 64; const int buf = c & 1;
            bf16* Qs = QsB + buf * 64 * QS_STRIDE; bf16* Ks = KsB + buf * 64 * QS_STRIDE; const bf16* Cs = CsB + buf * 128 * VE_STRIDE; bf16* Cn = CsB + (buf ^ 1) * 128 * VE_STRIDE;
            float* BC = BCB + buf * 64; float* BI = BIB + buf * 64;
#pragma unroll
            for (int i = 0; i < 2; ++i) { const int idx = tid + 512 * i, row = idx >> 4, ck = idx & 15;
                *(u32x4*)(Qs + row * QS_STRIDE + 8 * ck) = rq[i]; *(u32x4*)(Ks + row * QS_STRIDE + 8 * ck) = rk[i]; }
            if (tid < 64) { BC[tid] = rgc; BI[tid] = rgb; }
            SYNC();
            {
                const int row = tid >> 3, cg = tid & 7;
                const u32x2 rv = rvv;
                const float wt = FEXP(BC[63] - BI[row]);
                *(u32x2*)(VE + row * VE_STRIDE + 4 * cg) = rv;
                u32x2 sv; sv.x = pk2(bflo(rv.x) * wt, bfhi(rv.x) * wt); sv.y = pk2(bflo(rv.y) * wt, bfhi(rv.y) * wt);
                *(u32x2*)(VW + row * VE_STRIDE + 4 * cg) = sv;
                if (cg == 0) { unsigned one_ = 0x3f80u; LAUNDER_V(one_); u32x4 z = (u32x4){one_, 0u, 0u, 0u}; *(u32x4*)(VE + row * VE_STRIDE + 32) = z; *(u32x4*)(VE + row * VE_STRIDE + 40) = (u32x4){0u, 0u, 0u, 0u};
                    z.x = f2bf(wt); *(u32x4*)(VW + row * VE_STRIDE + 32) = z; *(u32x4*)(VW + row * VE_STRIDE + 40) = (u32x4){0u, 0u, 0u, 0u}; }
            }
            if (c + 1 < 64) {
                const size_t m1 = m0 + 64;
#pragma unroll
                for (int i = 0; i < 2; ++i) { const int idx = tid + 512 * i, row = idx >> 4, ck = idx & 15;
                    rq[i] = *(const u32x4*)(PROJ + (m1 + row) * NPROJ + PC_MQ + h * 128 + 8 * ck); rk[i] = *(const u32x4*)(PROJ + (m1 + row) * NPROJ + PC_MK + h * 128 + 8 * ck); }
                rvv = *(const u32x2*)(PROJ + (m1 + (tid >> 3)) * NPROJ + PC_MV + h * 128 + vs * 32 + 4 * (tid & 7));
                if (tid < 64) { rgc = BCg[(c + 1) * 64 + tid]; rgb = BIg[(c + 1) * 64 + tid]; }
            }
            SYNC();
            f32x4 Z[2] = {(f32x4){0.f, 0.f, 0.f, 0.f}, (f32x4){0.f, 0.f, 0.f, 0.f}};
            {
                bf16x8 Bq[4];
#pragma unroll
                for (int ks = 0; ks < 4; ++ks) Bq[ks] = *(const bf16x8*)(Qs + (16 * jt + i16) * QS_STRIDE + 32 * ks + 8 * g);
                const float bj = BC[16 * jt + i16];
                unsigned pk[4][2];
#pragma unroll
                for (int tt = 0; tt < 4; ++tt) {
                    if (tt <= jt) {
                        f32x4 X = (f32x4){0.f, 0.f, 0.f, 0.f};
                        bf16x8 Ak[4];
#pragma unroll
                        for (int ks = 0; ks < 4; ++ks) Ak[ks] = *(const bf16x8*)(Ks + (16 * tt + i16) * QS_STRIDE + 32 * ks + 8 * g);
                        KEEP4(Ak[0], Ak[1], Ak[2], Ak[3]);
#pragma unroll
                        for (int ks = 0; ks < 4; ++ks) X = MFMA16(Ak[ks], Bq[ks], X);
                        float p[4]; const f32x4 bi4 = *(const f32x4*)(BI + 16 * tt + 4 * g);
#pragma unroll
                        for (int r = 0; r < 4; ++r) { const float pv = X[r] * qscale * FEXP(fminf(bj - bi4[r], 60.0f));
                            p[r] = (tt < jt || 4 * g + r <= i16) ? pv : 0.f; }
                        pk[tt][0] = pk2(p[0], p[1]); pk[tt][1] = pk2(p[2], p[3]);
                    } else { pk[tt][0] = 0u; pk[tt][1] = 0u; }
                }
#pragma unroll
                for (int pr = 0; pr < 2; ++pr) {
                    if (2 * pr <= jt) {
                        u32x4 aw = (u32x4){pk[2 * pr][0], pk[2 * pr][1], pk[2 * pr + 1][0], pk[2 * pr + 1][1]};
                        const bf16x8 A = __builtin_bit_cast(bf16x8, aw);
#pragma unroll
                        for (int n = 0; n < 2; ++n) { const int ntc = n ? 2 : half;
                            const s16x4 lo = TR16(VE + (32 * pr + 4 * g + (i16 >> 2)) * VE_STRIDE + 16 * ntc + 4 * (i16 & 3));
                            const s16x4 hi = TR16(VE + (32 * pr + 16 + 4 * g + (i16 >> 2)) * VE_STRIDE + 16 * ntc + 4 * (i16 & 3));
                            const bf16x8 B = (bf16x8){lo[0], lo[1], lo[2], lo[3], hi[0], hi[1], hi[2], hi[3]};
                            Z[n] = MFMA16(A, B, Z[n]); }
#ifndef HOST_EMU
                        asm volatile("" :: "v"(aw));
#endif
                    }
                }
            }
            if (c > 0) {
                f32x4 Z2[2] = {(f32x4){0.f, 0.f, 0.f, 0.f}, (f32x4){0.f, 0.f, 0.f, 0.f}};
#pragma unroll
                for (int kh = 0; kh < 2; ++kh) {
                    bf16x8 Aq[2], Bc[2][2];
#pragma unroll
                    for (int k2 = 0; k2 < 2; ++k2) { const int ks = 2 * kh + k2; Aq[k2] = *(const bf16x8*)(Qs + (16 * jt + i16) * QS_STRIDE + 32 * ks + 8 * g);
#pragma unroll
                        for (int n = 0; n < 2; ++n) { const int ntc = n ? 2 : half;
                            const s16x4 lo = TR16(Cs + (32 * ks + 8 * g + (i16 >> 2)) * VE_STRIDE + 16 * ntc + 4 * (i16 & 3));
                            const s16x4 hi = TR16(Cs + (32 * ks + 8 * g + 4 + (i16 >> 2)) * VE_STRIDE + 16 * ntc + 4 * (i16 & 3));
                            Bc[k2][n] = (bf16x8){lo[0], lo[1], lo[2], lo[3], hi[0], hi[1], hi[2], hi[3]}; } }
                    KEEP4(Bc[0][0], Bc[0][1], Bc[1][0], Bc[1][1]);
#pragma unroll
                    for (int k2 = 0; k2 < 2; ++k2)
#pragma unroll
                        for (int n = 0; n < 2; ++n) Z2[n] = MFMA16(Aq[k2], Bc[k2][n], Z2[n]); }
                const f32x4 bc4 = *(const f32x4*)(BC + 16 * jt + 4 * g);
#pragma unroll
                for (int r = 0; r < 4; ++r) { const float f = qscale * FEXP(bc4[r]); Z[0][r] += f * Z2[0][r]; Z[1][r] += f * Z2[1][r]; }
            }
#pragma unroll
            for (int r = 0; r < 4; ++r) { const int j = 16 * jt + 4 * g + r; const float dn = FRCP(fmaxf(fabsf(SHFL(Z[1][r], lane & 48)), 1.0f));
                HM[(m0 + j) * 512 + h * 128 + vs * 32 + 16 * half + i16] = (bf16)f2bf(Z[0][r] * dn); }
            {
                const float dec = FEXP(BC[63]);
#pragma unroll
                for (int nt = 0; nt < 3; ++nt) accC[nt] = accC[nt] * dec;
#pragma unroll
                for (int ks = 0; ks < 2; ++ks) {
                    const s16x4 alo = TR16(Ks + (32 * ks + 8 * g + (i16 >> 2)) * QS_STRIDE + 16 * w + 4 * (i16 & 3));
                    const s16x4 ahi = TR16(Ks + (32 * ks + 8 * g + 4 + (i16 >> 2)) * QS_STRIDE + 16 * w + 4 * (i16 & 3));
                    const bf16x8 A = (bf16x8){alo[0], alo[1], alo[2], alo[3], ahi[0], ahi[1], ahi[2], ahi[3]};
                    bf16x8 Bv[3];
#pragma unroll
                    for (int nt = 0; nt < 3; ++nt) {
                        const s16x4 lo = TR16(VW + (32 * ks + 8 * g + (i16 >> 2)) * VE_STRIDE + 16 * nt + 4 * (i16 & 3));
                        const s16x4 hi = TR16(VW + (32 * ks + 8 * g + 4 + (i16 >> 2)) * VE_STRIDE + 16 * nt + 4 * (i16 & 3));
                        Bv[nt] = (bf16x8){lo[0], lo[1], lo[2], lo[3], hi[0], hi[1], hi[2], hi[3]}; }
                    KEEP4(A, Bv[0], Bv[1], Bv[2]);
#pragma unroll
                    for (int nt = 0; nt < 3; ++nt) { const bf16x8 B = Bv[nt];
                        const f32x4 cold = accC[nt]; accC[nt] = MFMA16(A, B, cold);
#ifndef HOST_EMU
                        asm volatile("" :: "v"(cold), "v"(A), "v"(B));
#endif
                    }
                }
#pragma unroll
                for (int nt = 0; nt < 3; ++nt)
#pragma unroll
                    for (int r = 0; r < 4; ++r) Cn[(16 * w + 4 * g + r) * VE_STRIDE + 16 * nt + i16] = (bf16)f2bf(accC[nt][r]);
            }
        }
        SYNC();
    }
}

DEV void ph_mfin(const Ctx& F, int l) {
    const int gw = F.bid * 8 + F.wave, NGW = F.G * 8, lane = F.lane;
    const bf16* PROJ = (const bf16*)(F.ws + WS_PROJ); const bf16* HM = (const bf16*)(F.ws + WS_HM); bf16* CAT = (bf16*)(F.ws + WS_CAT);
    float gm[8];
#pragma unroll
    for (int j = 0; j < 8; ++j) gm[j] = PIN(F, I_GNW)[l * DM + 256 + 8 * lane + j];
    u32x4 hv4[4], ov4[4], hvn[4], ovn[4];
#define MFIN_LOAD(HV, OV, M0) do { _Pragma("unroll") for (int q = 0; q < 4; ++q) { const int mm = (M0) + q * NGW; const size_t ms = (size_t)(mm < MTOK ? mm : 0); \
            HV[q] = *(const u32x4*)(HM + ms * 512 + 8 * lane); OV[q] = *(const u32x4*)(PROJ + ms * NPROJ + PC_MO + 8 * lane); } } while (0)
    MFIN_LOAD(hv4, ov4, gw);
    for (int m0 = gw; m0 < MTOK; m0 += 4 * NGW) {
        MFIN_LOAD(hvn, ovn, m0 + 4 * NGW);
#pragma unroll
        for (int q = 0; q < 4; ++q) { const int m = m0 + q * NGW; if (m >= MTOK) break;
            const u32x4 hv = hv4[q], ov = ov4[q];
            float v[8] = {bflo(hv.x), bfhi(hv.x), bflo(hv.y), bfhi(hv.y), bflo(hv.z), bfhi(hv.z), bflo(hv.w), bfhi(hv.w)};
            const float o[8] = {bflo(ov.x), bfhi(ov.x), bflo(ov.y), bfhi(ov.y), bflo(ov.z), bfhi(ov.z), bflo(ov.w), bfhi(ov.w)};
            float s = 0.f;
#pragma unroll
            for (int j = 0; j < 8; ++j) s += v[j] * v[j];
            s += SHFL_XOR(s, 1); s += SHFL_XOR(s, 2); s += SHFL_XOR(s, 4); s += SHFL_XOR(s, 8);
            const float rs = RSQ(s * (1.0f / 128.0f) + NORM_EPS);
            u32x4 r;
            r.x = pk2(v[0] * rs * gm[0] * fsigmoid(o[0]), v[1] * rs * gm[1] * fsigmoid(o[1]));
            r.y = pk2(v[2] * rs * gm[2] * fsigmoid(o[2]), v[3] * rs * gm[3] * fsigmoid(o[3]));
            r.z = pk2(v[4] * rs * gm[4] * fsigmoid(o[4]), v[5] * rs * gm[5] * fsigmoid(o[5]));
            r.w = pk2(v[6] * rs * gm[6] * fsigmoid(o[6]), v[7] * rs * gm[7] * fsigmoid(o[7]));
            *(u32x4*)(CAT + (size_t)m * DM + 256 + 8 * lane) = r; }
#pragma unroll
        for (int q = 0; q < 4; ++q) { hv4[q] = hvn[q]; ov4[q] = ovn[q]; }
    }
#undef MFIN_LOAD
}

constexpr int DS_HIST = 0;
constexpr int DS_MASK = 49152;
constexpr int DS_CAND = 65536;
constexpr int DS_SELL = 102400;
constexpr int DS_META = 118784;
constexpr int DS_RB = DS_META + 512;
constexpr int DS_SS = DS_RB + 2048;
constexpr int DS_SLOT = 12800;
constexpr int NBIN = 768, CAND_CAP = 128;
__device__ const unsigned char T5B[114] = {0, 1, 2, 3, 4, 5, 6, 7, 8, 9, 10, 11, 12, 13, 14, 15, 16, 16, 16, 17, 17, 18, 18, 18, 19, 19, 19, 20, 20, 20, 20, 21, 21, 21, 21, 22, 22, 22, 22, 22, 23, 23, 23, 23, 23, 23, 24, 24, 24, 24, 24, 24, 25, 25, 25, 25, 25, 25, 25, 26, 26, 26, 26, 26, 26, 26, 26, 27, 27, 27, 27, 27, 27, 27, 27, 27, 27, 28, 28, 28, 28, 28, 28, 28, 28, 28, 28, 29, 29, 29, 29, 29, 29, 29, 29, 29, 29, 29, 29, 30, 30, 30, 30, 30, 30, 30, 30, 30, 30, 30, 30, 30, 30, 31};

DEV int score_bin(float sc) {
    const unsigned u = __builtin_bit_cast(unsigned, sc);
    int e = (int)((u >> 18) & 0x1FFFu) - 119 * 32; e = e < 0 ? 0 : (e > 383 ? 383 : e);
    return (u >> 31) ? 383 - e : 384 + e;
}
DEV unsigned score_key(float sc) { const unsigned u = __builtin_bit_cast(unsigned, sc); return (u >> 31) ? ~u : (u | 0x80000000u); }
DEV unsigned score_code(float sc) {
    const unsigned u = __builtin_bit_cast(unsigned, sc);
    int e = (int)((u >> 18) & 0x1FFFu) - 119 * 32; e = e < 0 ? 0 : (e > 383 ? 383 : e);
    return ((u >> 16) & 0x8000u) | ((unsigned)e << 6) | ((u >> 12) & 63u);
}
DEV int code_bin(unsigned c) { const int e = (int)((c >> 6) & 0x1FFu); return (c & 0x8000u) ? 383 - e : 384 + e; }
DEV unsigned code_key(unsigned c) { return (c & 0x8000u) ? 63u - (c & 63u) : (c & 63u); }


DEV f32x4 dsa_score_tile(const bf16x8 A, const bf16x8 (&QS)[2], const bf16x8 (&Bq)[8], const float (&wq)[8]) {
    f32x4 sc = (f32x4){0.f, 0.f, 0.f, 0.f};
#pragma unroll
    for (int h = 0; h < 8; ++h) { const f32x4 d = MFMA16(A, Bq[h], (f32x4){0.f, 0.f, 0.f, 0.f});
#pragma unroll
        for (int r = 0; r < 4; ++r) sc[r] += wq[h] * RELU(d[r]); }
    return sc;
}
DEV void ph_dsa(const Ctx& F, int l) {
    const int tid = F.tid, lane = F.lane, w = F.wave, i16 = lane & 15, g = lane >> 4;
    unsigned* HIST = (unsigned*)(F.lds + DS_HIST); unsigned* MASK = (unsigned*)(F.lds + DS_MASK); u32x2* CAND = (u32x2*)(F.lds + DS_CAND);
    unsigned short* SELL = (unsigned short*)(F.lds + DS_SELL); int* BST = (int*)(F.lds + DS_META); int* NAB = BST + 32; int* NCAND = BST + 64; int* NSEL = BST + 96;
    float* RB = (float*)(F.lds + DS_RB);
    const bf16* QIDX = (const bf16*)(F.ws + WS_QIDX); const bf16* KIDX = (const bf16*)(F.ws + WS_KIDX); const float* WI = (const float*)(F.ws + WS_WI);
    const bf16* QABS = (const bf16*)(F.ws + WS_QABS); const bf16* CKV = (const bf16*)(F.ws + WS_CKV); bf16* CAT = (bf16*)(F.ws + WS_CAT);
    const bf16* WUVT = (const bf16*)(F.ws + WS_WUVT) + (size_t)l * 4 * 64 * 128; float* SS = (float*)(F.lds + DS_SS);
    for (int e = tid; e < 114 * 4; e += 512) RB[e] = PIN(F, I_RELB)[T5B[e >> 2] * 4 + (e & 3)] * 1.4426950408889634f;
    SYNC();
    for (int ui = F.bid; ui < BATCH * 128; ui += F.G) {
        int b, qt; { const int wv = ui & 255, k = ui >> 8, r = wv & 15; b = wv >> 4; qt = (k & 1) ? (32 * (k >> 1) + 31 - r) : (32 * (k >> 1) + r); }
        const int t0 = 32 * qt, nkt = 2 * qt + 2; const size_t mb = (size_t)b * SEQ;
        const GAS char* const ckvb = UNIP(CKV + mb * 128);
        const int nt = w & 1;
        u32x2* sw = (u32x2*)(F.ws + (F.bid < 128 ? WS_QL + (size_t)F.bid * 262144 : WS_SCR2 + (size_t)(F.bid - 128) * 262144) + (size_t)w * 32768) + lane;
        bf16x8 Bq[8]; float wq[8];
        { const size_t mq = mb + t0 + 16 * nt + i16;
#pragma unroll
            for (int h = 0; h < 8; ++h) { Bq[h] = *(const bf16x8*)(QIDX + mq * 256 + 32 * h + 8 * g); wq[h] = WI[mq * 8 + h]; } }
        bf16x8 QS[2];
#pragma unroll
        for (int j = 0; j < 8; ++j) { float s = 0.f;
#pragma unroll
            for (int h = 0; h < 8; ++h) s += wq[h] * bf2f((unsigned)(unsigned short)Bq[h][j]);
            const unsigned hi = f2bf(s); QS[0][j] = (short)hi; QS[1][j] = (short)f2bf(s - bf2f(hi)); }
        for (int e = tid; e < 16 * NBIN; e += 512) HIST[e] = 0u;
        for (int e = tid; e < 32 * 128; e += 512) MASK[e] = 0u;
        if (tid < 32) NCAND[tid] = 0;
        SYNC();
        bf16x8 Apre = *(const bf16x8*)(KIDX + (mb + 16 * (w >> 1) + i16) * 32 + 8 * g);
        for (int kt = w >> 1; kt < nkt; kt += 4) {
            const bf16x8 A = Apre;
            { const int kn = kt + 4 < nkt ? kt + 4 : kt; Apre = *(const bf16x8*)(KIDX + (mb + 16 * kn + i16) * 32 + 8 * g); }
            const f32x4 sc = dsa_score_tile(A, QS, Bq, wq);
            unsigned cd[4];
#pragma unroll
            for (int r = 0; r < 4; ++r) cd[r] = score_code(sc[r] + 0.0f);
            { u32x2 pk; pk.x = cd[0] | (cd[1] << 16); pk.y = cd[2] | (cd[3] << 16); sw[(size_t)((kt - (w >> 1)) >> 2) * 64] = pk; }
            const unsigned inc = nt ? 65536u : 1u;
            if (kt < 2 * qt) {
#pragma unroll
                for (int r = 0; r < 4; ++r) atomicAdd(&HIST[i16 * NBIN + code_bin(cd[r])], inc);
            } else {
                const int t = t0 + 16 * nt + i16;
#pragma unroll
                for (int r = 0; r < 4; ++r) { const int s = 16 * kt + 4 * g + r;
                    if (s <= t) atomicAdd(&HIST[i16 * NBIN + code_bin(cd[r])], inc); }
            }
        }
        SYNC();
#pragma unroll 1
        for (int rr = 0; rr < 4; ++rr) {
            const int row = 4 * w + rr, t = t0 + row;
            if (t < 256) { if (lane == 0) { BST[row] = -1; NAB[row] = t + 1; } continue; }
            const int sh = (row >> 4) * 16; const unsigned* hp = HIST + (row & 15) * NBIN + 12 * lane;
            int cnt[12]; int tot = 0;
#pragma unroll
            for (int i = 0; i < 12; ++i) { cnt[i] = (int)((hp[i] >> sh) & 0xFFFFu); tot += cnt[i]; }
            int suf = tot;
#pragma unroll
            for (int o = 1; o < 64; o <<= 1) { const int v = SHFL_DOWN(suf, o); if (lane + o < 64) suf += v; }
            const int above = suf - tot;
            if (above < 256 && above + tot >= 256) {
                int run = above, bs = -1, na = 0; bool done = false;
#pragma unroll
                for (int i = 11; i >= 0; --i) { if (!done) { if (run + cnt[i] >= 256) { bs = 12 * lane + i; na = run; done = true; } else run += cnt[i]; } }
                BST[row] = bs; NAB[row] = na;
            }
        }
        SYNC();
        { const int row = 16 * nt + i16, t = t0 + row, bs = BST[row];
        const int ntl = nkt > (w >> 1) ? ((nkt - 1 - (w >> 1)) >> 2) + 1 : 0;
        u32x2 P0 = sw[0], P1 = sw[(size_t)(1 < ntl ? 1 : 0) * 64];
        for (int j = 0; j < ntl; ++j) { const int kt = (w >> 1) + 4 * j;
            const u32x2 pc = P0; P0 = P1; P1 = sw[(size_t)(j + 2 < ntl ? j + 2 : j) * 64];
            const bool full = kt < 2 * qt;
#pragma unroll
            for (int r = 0; r < 4; ++r) { const int s = 16 * kt + 4 * g + r;
                if (full || s <= t) { const unsigned wd = r < 2 ? pc.x : pc.y; const unsigned c = (r & 1) ? (wd >> 16) : (wd & 0xffffu); const int bn = code_bin(c);
                    if (bn > bs) atomicOr(&MASK[row * 128 + (s >> 5)], 1u << (s & 31));
                    else if (bn == bs) { const int pos = (int)atomicAdd((unsigned*)&NCAND[row], 1u); if (pos < CAND_CAP) CAND[row * CAND_CAP + pos] = (u32x2){code_key(c), (unsigned)s}; } } }
        } }
        SYNC();
#pragma unroll 1
        for (int rr = 0; rr < 4; ++rr) {
            const int row = 4 * w + rr; if (BST[row] < 0) continue;
            const int n = NCAND[row] < CAND_CAP ? NCAND[row] : CAND_CAP, need = 256 - NAB[row];
            for (int i = lane; i < n; i += 64) { const u32x2 me = CAND[row * CAND_CAP + i]; int rank = 0;
                for (int j = 0; j < n; ++j) { const u32x2 o = CAND[row * CAND_CAP + j]; rank += (o.x > me.x || (o.x == me.x && o.y < me.y)) ? 1 : 0; }
#ifndef DSA_DBG_NOCAND
                if (rank < need) atomicOr(&MASK[row * 128 + (me.y >> 5)], 1u << (me.y & 31));
#endif
            }
        }
        SYNC();
#ifdef DSA_DBG_SEL
        for (int e = tid; e < 32 * 128; e += 512) { const int row = e >> 7, wi = e & 127, t = t0 + row, lo = t - 255 < 0 ? 0 : t - 255; unsigned m = 0u;
            for (int bq = 0; bq < 32; ++bq) { const int s = 32 * wi + bq; if (s >= lo && s <= t) m |= 1u << bq; }
            MASK[e] = m; }
        SYNC();
#endif
#pragma unroll 1
        for (int rr = 0; rr < 4; ++rr) {
            const int row = 4 * w + rr;
            unsigned w0 = MASK[row * 128 + 2 * lane], w1 = MASK[row * 128 + 2 * lane + 1];
            const int c = __builtin_popcount(w0) + __builtin_popcount(w1);
            int inc = c;
#pragma unroll
            for (int o = 1; o < 64; o <<= 1) { const int v = SHFL_UP(inc, o); if (lane >= o) inc += v; }
            int pos = inc - c;
            while (w0) { const int bt = __builtin_ctz(w0); w0 &= w0 - 1; if (pos < 256) SELL[row * 256 + pos] = (unsigned short)(64 * lane + bt); ++pos; }
            while (w1) { const int bt = __builtin_ctz(w1); w1 &= w1 - 1; if (pos < 256) SELL[row * 256 + pos] = (unsigned short)(64 * lane + 32 + bt); ++pos; }
            if (lane == 63) NSEL[row] = inc < 256 ? inc : 256;
        }
        SYNC();
        bf16* TL = (bf16*)(F.lds + w * DS_SLOT); bf16* OLw = (bf16*)(F.lds + w * DS_SLOT + 8704);
#pragma unroll 1
        for (int rr = 0; rr < 4; ++rr) {
            const int row = 4 * w + rr, t = t0 + row, ns = UNI(NSEL[row]); const size_t mt = mb + t;
            const unsigned short* sl = SELL + row * 256;
            bf16x8 Bh[4];
#pragma unroll
            for (int ks = 0; ks < 4; ++ks) Bh[ks] = i16 < 4 ? *(const bf16x8*)(QABS + mt * 512 + i16 * 128 + 32 * ks + 8 * g) : (bf16x8){0, 0, 0, 0, 0, 0, 0, 0};
            f32x4 O[8];
#pragma unroll
            for (int nt = 0; nt < 8; ++nt) O[nt] = (f32x4){0.f, 0.f, 0.f, 0.f};
            float mrun = -1e30f, lrun = 0.f;
            const float bfar = RB[113 * 4 + (i16 & 3)];
            const int nch = (ns + 31) >> 5;
            u32x4 gvA[8];
#ifndef HOST_EMU
#define ATT_KEEP8(A) asm volatile("" :: "v"(A[0][0]), "v"(A[0][1]), "v"(A[0][2]), "v"(A[0][3]), "v"(A[1][0]), "v"(A[1][1]), "v"(A[1][2]), "v"(A[1][3]))
#else
#define ATT_KEEP8(A) (void)0
#endif
#define ATT_LOAD(GV, CK, FULL) do { int sidx[8]; \
                _Pragma("unroll") for (int i = 0; i < 8; ++i) sidx[i] = (int)sl[32 * (CK) + 4 * i + g];            \
                _Pragma("unroll") for (int i = 0; i < 8; ++i) { const int kp = 32 * (CK) + 4 * i + g; sidx[i] = (FULL || kp < ns) ? sidx[i] : 0; } \
                _Pragma("unroll") for (int i = 0; i < 8; ++i) GV[i] = *(const GAS u32x4*)(ckvb + (((unsigned)sidx[i] << 8) + 16u * (unsigned)i16)); } while (0)
#define ATT_STEP(GV, CK, FULL) do { const int ck = (CK); \
                _Pragma("unroll") for (int i = 0; i < 8; ++i) *(u32x4*)(TL + (4 * i + g) * 136 + 8 * i16) = GV[i]; \
                const u32x2 sk0 = *(const u32x2*)(sl + 32 * ck + 4 * g), sk1 = *(const u32x2*)(sl + 32 * ck + 16 + 4 * g); \
                WAVE_LDS_FENCE(); \
                if (ck + 1 < nch) ATT_LOAD(GV, ck + 1, FULL); \
                float bia[2][4]; \
                if (FULL && t - UNI((int)sl[32 * ck + 31]) >= 113) {                   \
                _Pragma("unroll") for (int kt = 0; kt < 2; ++kt) \
                _Pragma("unroll") for (int r = 0; r < 4; ++r) bia[kt][r] = bfar; \
                } else { \
                _Pragma("unroll") for (int kt = 0; kt < 2; ++kt) \
                _Pragma("unroll") for (int r = 0; r < 4; ++r) { const unsigned wd = kt ? (r < 2 ? sk1.x : sk1.y) : (r < 2 ? sk0.x : sk0.y); \
                        int dist = t - (int)((wd >> (16 * (r & 1))) & 0xffffu); dist = dist < 0 ? 0 : (dist > 113 ? 113 : dist); \
                        bia[kt][r] = RB[dist * 4 + (i16 & 3)]; } } \
                f32x4 lg[2]; \
                { bf16x8 Af[2][4];                                    \
                _Pragma("unroll") for (int kt = 0; kt < 2; ++kt) _Pragma("unroll") for (int ks = 0; ks < 4; ++ks) Af[kt][ks] = *(const bf16x8*)(TL + (16 * kt + i16) * 136 + 32 * ks + 8 * g); \
                ATT_KEEP8(Af); \
                _Pragma("unroll") for (int kt = 0; kt < 2; ++kt) { lg[kt] = (f32x4){0.f, 0.f, 0.f, 0.f}; \
                _Pragma("unroll") for (int ks = 0; ks < 4; ++ks) lg[kt] = MFMA16(Af[kt][ks], Bh[ks], lg[kt]); } } \
                float cm = -1e30f; \
                _Pragma("unroll") for (int kt = 0; kt < 2; ++kt) \
                _Pragma("unroll") for (int r = 0; r < 4; ++r) { const int kp = 32 * ck + 16 * kt + 4 * g + r; \
                        lg[kt][r] = (FULL || kp < ns) ? lg[kt][r] + bia[kt][r] : -1e30f; cm = fmaxf(cm, lg[kt][r]); } \
                if (ck == 0) { cm = fmaxf(cm, SHFL_XOR(cm, 16)); cm = fmaxf(cm, SHFL_XOR(cm, 32)); mrun = cm; } \
                float p[2][4]; \
                _Pragma("unroll") for (int kt = 0; kt < 2; ++kt) \
                _Pragma("unroll") for (int r = 0; r < 4; ++r) { p[kt][r] = (FULL || lg[kt][r] > -1e29f) ? FEXP2(lg[kt][r] - mrun) : 0.f; lrun += p[kt][r]; } \
                u32x4 aw = (u32x4){0u, 0u, 0u, 0u}; \
                if (i16 < 4) aw = (u32x4){pk2(p[0][0], p[0][1]), pk2(p[0][2], p[0][3]), pk2(p[1][0], p[1][1]), pk2(p[1][2], p[1][3])}; \
                const bf16x8 A = __builtin_bit_cast(bf16x8, aw); \
                _Pragma("unroll") for (int nt = 0; nt < 8; ++nt) { \
                    const s16x4 lo = TR16(TL + (4 * g + (i16 >> 2)) * 136 + 16 * nt + 4 * (i16 & 3)); \
                    const s16x4 hi = TR16(TL + (16 + 4 * g + (i16 >> 2)) * 136 + 16 * nt + 4 * (i16 & 3)); \
                    const bf16x8 B = (bf16x8){lo[0], lo[1], lo[2], lo[3], hi[0], hi[1], hi[2], hi[3]}; \
                    O[nt] = MFMA16(A, B, O[nt]); } \
                WAVE_LDS_FENCE(); } while (0)
            if (ns == 256) { ATT_LOAD(gvA, 0, true); for (int ck2 = 0; ck2 < 8; ++ck2) ATT_STEP(gvA, ck2, true); }
            else { ATT_LOAD(gvA, 0, false); for (int ck2 = 0; ck2 < nch; ++ck2) ATT_STEP(gvA, ck2, false); }
#undef ATT_STEP
#undef ATT_LOAD
            lrun += SHFL_XOR(lrun, 16); lrun += SHFL_XOR(lrun, 32);
            float li[4];
#pragma unroll
            for (int r = 0; r < 4; ++r) li[r] = FRCP(SHFL(lrun, r));
            if (g == 0) {
#pragma unroll
                for (int nt = 0; nt < 8; ++nt)
#pragma unroll
                    for (int r = 0; r < 4; ++r) OLw[(rr * 4 + r) * 128 + 16 * nt + i16] = (bf16)f2bf(O[nt][r] * li[r]);
            }
        }
        bf16x8 Wf[4][4];
#pragma unroll
        for (int ks = 0; ks < 4; ++ks)
#pragma unroll
            for (int nt = 0; nt < 4; ++nt) Wf[ks][nt] = *(const bf16x8*)(WUVT + ((size_t)((w >> 1) * 64 + 16 * nt + i16)) * 128 + 32 * ks + 8 * g);
        SYNC();
        {
            const int h = w >> 1, mtile = w & 1, q = 16 * mtile + i16;
            const bf16* olq = (const bf16*)(F.lds + (q >> 2) * DS_SLOT + 8704) + ((q & 3) * 4 + h) * 128;
            float gaw[4];
#pragma unroll
            for (int nt = 0; nt < 4; ++nt) gaw[nt] = PIN(F, I_GNW)[l * DM + 768 + h * 64 + 16 * nt + i16];
            f32x4 acc[4];
#pragma unroll
            for (int nt = 0; nt < 4; ++nt) acc[nt] = (f32x4){0.f, 0.f, 0.f, 0.f};
#pragma unroll
            for (int ks = 0; ks < 4; ++ks) { const bf16x8 A = *(const bf16x8*)(olq + 32 * ks + 8 * g);
#pragma unroll
                for (int nt = 0; nt < 4; ++nt) acc[nt] = MFMA16(A, Wf[ks][nt], acc[nt]); }
#pragma unroll
            for (int r = 0; r < 4; ++r) { float s = (acc[0][r] * acc[0][r] + acc[1][r] * acc[1][r]) + (acc[2][r] * acc[2][r] + acc[3][r] * acc[3][r]);
                s += SHFL_XOR(s, 1); s += SHFL_XOR(s, 2); s += SHFL_XOR(s, 4); s += SHFL_XOR(s, 8);
                if (i16 == 0) SS[(16 * mtile + 4 * g + r) * 4 + h] = s; }
            SYNC();
#pragma unroll
            for (int r = 0; r < 4; ++r) { const int qq = 16 * mtile + 4 * g + r; const f32x4 s4 = *(const f32x4*)(SS + qq * 4);
                const float rs = RSQ(((s4.x + s4.y) + (s4.z + s4.w)) * (1.0f / 256.0f) + NORM_EPS);
                bf16* dst = CAT + (mb + t0 + qq) * DM + 768 + h * 64 + i16;
#pragma unroll
                for (int nt = 0; nt < 4; ++nt) dst[16 * nt] = (bf16)f2bf(acc[nt][r] * rs * gaw[nt]); }
        }
        SYNC();
    }
}
#ifndef HOST_EMU
namespace pg8 {
#define PG8_LAS __attribute__((address_space(3)))
typedef unsigned short bf16_t;
typedef short bf16x8 __attribute__((ext_vector_type(8)));
typedef float f32x4 __attribute__((ext_vector_type(4)));
typedef unsigned u32x4 __attribute__((ext_vector_type(4)));
constexpr int BM = 256, BK = 64, HALF = 128, HTB = HALF * BK * 2  , STAGE_BYTES = 8 * HTB, NXCD = 8, WGM = 8;

__host__ __device__ __forceinline__ int lds_byte(int r, int c) { const int st = (r >> 4) * 2 + (c >> 5), rr = r & 15, cc = c & 31, ob = rr * 64 + cc * 2; return st * 1024 + (ob ^ (((ob >> 9) & 1) << 5)); }
__host__ __device__ __forceinline__ void stage_rc(int b, int& R, int& C) { const int st = b / 1024, sb = b % 1024, swz = sb ^ (((sb >> 9) & 1) << 5); R = (st >> 1) * 16 + swz / 64; C = (st & 1) * 32 + (swz % 64) / 2; }
__host__ __device__ __forceinline__ int perm32(int rho) { const int n = rho >> 4, i = rho & 15; return 8 * (i >> 2) + 4 * n + (i & 3); }

struct Unit { int pm, pn; };
struct Gemm { const bf16_t* A; const bf16_t* Bt; int M, N, K; };

struct StaticOrder {
    int nM, nN, nwg, G, c;
    __host__ __device__ void init(int M, int N, int G_, int c_) { nM = M / BM; nN = N / BM; nwg = nM * nN; G = G_; c = c_; }
    __host__ __device__ bool next(int i, Unit& u) const {
        const long L = (long)i * G + c; if (L >= nwg) return false;
        int wgid = (int)L; { const int q = nwg / NXCD, r = nwg % NXCD, xcd = wgid % NXCD, off = wgid / NXCD; wgid = (xcd < r ? xcd * (q + 1) : r * (q + 1) + (xcd - r) * q) + off; }
        const int nig = WGM * nN, gid = wgid / nig, fm = gid * WGM, gsz = (nM - fm) < WGM ? (nM - fm) : WGM;
        u.pm = fm + ((wgid % nig) % gsz); u.pn = (wgid % nig) / gsz; return true;
    }
    __device__ __forceinline__ void a_ready(const Unit&) const {}
    __device__ __forceinline__ void done(const Unit&) const {}
};
__device__ __forceinline__ unsigned cvt_pk_bf16(float lo, float hi) { unsigned r; asm volatile("v_cvt_pk_bf16_f32 %0, %1, %2" : "=v"(r) : "v"(lo), "v"(hi)); return r; }
template <class Epi, class Sched, bool ALIGN_EPI = false, bool SP2 = false>
__device__ __forceinline__ void gemm_phase(PG8_LAS unsigned char* lds, const Gemm g, const Sched& S, const Epi& E, const int tid_in) {
    const int tid = tid_in, wid = __builtin_amdgcn_readfirstlane(tid >> 6), lane = tid & 63, wr = wid >> 2, wc = wid & 3, fr = lane & 15, fq = lane >> 4;
    const int K = g.K, nt = K / BK;
    unsigned voffA[2], voffB[2];
#pragma unroll
    for (int i = 0; i < 2; ++i) { int R, C; stage_rc(tid * 16 + i * 8192, R, C); const int Rb = Epi::PERM ? ((R & ~31) + perm32(R & 31)) : R;
        voffA[i] = (unsigned)(R * K + C) * 2u; voffB[i] = (unsigned)(Rb * K + C) * 2u; }
    const size_t kstep = (size_t)(BK * 2);
    const size_t hstep = (size_t)HALF * K * 2;
    const size_t tstep = 2 * hstep;
    const unsigned ldsw = (unsigned)wid * 1024u;
    const int aoff = lds_byte(wr * 64 + fr, fq * 8), boff = lds_byte(wc * 32 + fr, fq * 8);
#define PG8_SA(b, h) (((b) * 2 + (h)) * HTB)
#define PG8_SB(b, h) ((4 + (b) * 2 + (h)) * HTB)
#define PG8_STAGE(bufoff, gbase, voff) do { _Pragma("unroll") for (int _i = 0; _i < 2; ++_i) \
        __builtin_amdgcn_global_load_lds((const unsigned*)((const char*)(gbase) + (voff)[_i]), (PG8_LAS unsigned*)(lds + (bufoff) + ldsw + _i * 8192), 16, 0, 0); } while (0)
#define PG8_LDA(dst, b, h) do { _Pragma("unroll") for (int m = 0; m < 4; ++m) _Pragma("unroll") for (int k = 0; k < 2; ++k) dst[m][k] = *(const PG8_LAS bf16x8*)(lds + PG8_SA(b, h) + aoff + m * 2048 + k * 1024); } while (0)
#define PG8_LDB(dst, b, h) do { _Pragma("unroll") for (int n = 0; n < 2; ++n) _Pragma("unroll") for (int k = 0; k < 2; ++k) dst[n][k] = *(const PG8_LAS bf16x8*)(lds + PG8_SB(b, h) + boff + n * 2048 + k * 1024); } while (0)
#define PG8_MMA(ai, bj, At, Bt) do { __builtin_amdgcn_s_setprio(1); _Pragma("unroll") for (int m = 0; m < 4; ++m) _Pragma("unroll") for (int n = 0; n < 2; ++n) _Pragma("unroll") for (int k = 0; k < 2; ++k) \
        acc[ai][bj][m][n] = __builtin_amdgcn_mfma_f32_16x16x32_bf16(Bt[n][k], At[m][k], acc[ai][bj][m][n], 0, 0, 0); __builtin_amdgcn_s_setprio(0); } while (0)
#define PG8_WAIT_V(n) asm volatile("s_waitcnt vmcnt(" #n ")" ::: "memory")
#define PG8_WAIT_L(n) asm volatile("s_waitcnt lgkmcnt(" #n ")" ::: "memory")
#define PG8_BAR __builtin_amdgcn_s_barrier()
#define PG8_SCHED __builtin_amdgcn_sched_barrier(0)
    Unit cur, nxt; int ui = 0;
    if (!S.next(0, cur)) return;
    f32x4 acc[2][2][4][2];
#pragma unroll
    for (int a = 0; a < 2; ++a)
#pragma unroll
        for (int b = 0; b < 2; ++b)
#pragma unroll
            for (int m = 0; m < 4; ++m)
#pragma unroll
                for (int n = 0; n < 2; ++n) acc[a][b][m][n] = (f32x4){0.f, 0.f, 0.f, 0.f};
    bf16x8 At[4][2], B0[2][2], B1[2][2];
    const char* cA = (const char*)g.A + (size_t)cur.pm * tstep; const char* cB = (const char*)g.Bt + (size_t)cur.pn * tstep;
    S.a_ready(cur);
    if constexpr (SP2) {
        PG8_STAGE(PG8_SB(0, 0), cB, voffB); PG8_STAGE(PG8_SB(0, 1), cB + hstep, voffB); PG8_STAGE(PG8_SA(0, 0), cA, voffA); PG8_STAGE(PG8_SA(0, 1), cA + hstep, voffA);
        if (wr == 1) PG8_BAR;
        PG8_WAIT_V(2); PG8_BAR;
        PG8_STAGE(PG8_SB(1, 0), cB + kstep, voffB); PG8_STAGE(PG8_SA(1, 0), cA + kstep, voffA); PG8_STAGE(PG8_SB(1, 1), cB + hstep + kstep, voffB);
        PG8_WAIT_V(6); PG8_BAR;
    } else {
        PG8_STAGE(PG8_SB(0, 0), cB, voffB); PG8_STAGE(PG8_SA(0, 0), cA, voffA); PG8_STAGE(PG8_SB(0, 1), cB + hstep, voffB); PG8_STAGE(PG8_SA(0, 1), cA + hstep, voffA);
        if (wr == 1) PG8_BAR;
        PG8_WAIT_V(4); PG8_BAR;
        PG8_STAGE(PG8_SB(1, 0), cB + kstep, voffB); PG8_STAGE(PG8_SA(1, 0), cA + kstep, voffA); PG8_STAGE(PG8_SB(1, 1), cB + hstep + kstep, voffB);
        PG8_WAIT_V(6); PG8_BAR;
    }
    for (;;) {
        const bool has_next = S.next(ui + 1, nxt);
        const char* nA = has_next ? (const char*)g.A + (size_t)nxt.pm * tstep : cA; const char* nB = has_next ? (const char*)g.Bt + (size_t)nxt.pn * tstep : cB;
#pragma unroll 1
        for (int t = 0; t < nt; t += 2) {
            const bool last = (t == nt - 2);
            const char* a1 = cA + (size_t)(t + 1) * kstep;
            const char* a2 = last ? nA : cA + (size_t)(t + 2) * kstep; const char* b2 = last ? nB : cB + (size_t)(t + 2) * kstep;
            const char* a3 = a2 + kstep; const char* b3 = b2 + kstep;
            if (last && has_next) S.a_ready(nxt);
            if constexpr (Epi::NORM) { if (t == 2) E.prefetch(cur, tid, wid); if (t == 4) E.reduce_rs(tid); }
            if constexpr (SP2) {
            PG8_LDB(B0, 0, 0); PG8_LDB(B1, 0, 1); PG8_SCHED; PG8_LDA(At, 0, 0); PG8_STAGE(PG8_SA(1, 1), a1 + hstep, voffA);
            PG8_WAIT_V(8); PG8_WAIT_L(0); PG8_BAR; PG8_MMA(0, 0, At, B0); PG8_MMA(0, 1, At, B1); PG8_BAR; PG8_SCHED;
            PG8_LDA(At, 0, 1); PG8_STAGE(PG8_SB(0, 0), b2, voffB); PG8_STAGE(PG8_SB(0, 1), b2 + hstep, voffB); PG8_STAGE(PG8_SA(0, 0), a2, voffA);
            PG8_WAIT_V(8); PG8_WAIT_L(0); PG8_BAR; PG8_MMA(1, 0, At, B0); PG8_MMA(1, 1, At, B1); PG8_BAR; PG8_SCHED;
            PG8_LDB(B0, 1, 0); PG8_LDB(B1, 1, 1); PG8_SCHED; PG8_LDA(At, 1, 0); PG8_STAGE(PG8_SA(0, 1), a2 + hstep, voffA);
            PG8_WAIT_V(8); PG8_WAIT_L(0); PG8_BAR; PG8_MMA(0, 0, At, B0); PG8_MMA(0, 1, At, B1); PG8_BAR; PG8_SCHED;
            PG8_LDA(At, 1, 1); PG8_STAGE(PG8_SB(1, 0), b3, voffB); PG8_STAGE(PG8_SB(1, 1), b3 + hstep, voffB); PG8_STAGE(PG8_SA(1, 0), a3, voffA);
            PG8_WAIT_V(8); PG8_WAIT_L(0); PG8_BAR; PG8_MMA(1, 0, At, B0); PG8_MMA(1, 1, At, B1); PG8_BAR; PG8_SCHED;
            } else {
            PG8_LDB(B0, 0, 0); PG8_SCHED; PG8_LDA(At, 0, 0); PG8_STAGE(PG8_SA(1, 1), a1 + hstep, voffA);
            PG8_WAIT_L(8); PG8_BAR; PG8_WAIT_L(0); PG8_MMA(0, 0, At, B0); PG8_BAR; PG8_SCHED;
            PG8_LDB(B1, 0, 1); PG8_STAGE(PG8_SB(0, 0), b2, voffB);
            PG8_BAR; PG8_WAIT_L(0); PG8_MMA(0, 1, At, B1); PG8_BAR;
            PG8_LDA(At, 0, 1); PG8_STAGE(PG8_SA(0, 0), a2, voffA);
            PG8_BAR; PG8_WAIT_L(0); PG8_MMA(1, 0, At, B0); PG8_BAR; PG8_SCHED;
            PG8_STAGE(PG8_SB(0, 1), b2 + hstep, voffB);
            PG8_WAIT_V(6); PG8_BAR; PG8_MMA(1, 1, At, B1); PG8_BAR;
            PG8_LDB(B0, 1, 0); PG8_SCHED; PG8_LDA(At, 1, 0); PG8_STAGE(PG8_SA(0, 1), a2 + hstep, voffA);
            PG8_WAIT_L(8); PG8_BAR; PG8_WAIT_L(0); PG8_MMA(0, 0, At, B0); PG8_BAR; PG8_SCHED;
            PG8_LDB(B1, 1, 1); PG8_STAGE(PG8_SB(1, 0), b3, voffB);
            PG8_BAR; PG8_WAIT_L(0); PG8_MMA(0, 1, At, B1); PG8_BAR;
            PG8_LDA(At, 1, 1); PG8_STAGE(PG8_SA(1, 0), a3, voffA);
            PG8_BAR; PG8_WAIT_L(0); PG8_MMA(1, 0, At, B0); PG8_BAR; PG8_SCHED;
            PG8_STAGE(PG8_SB(1, 1), b3 + hstep, voffB);
            PG8_WAIT_V(6); PG8_BAR; PG8_MMA(1, 1, At, B1); PG8_BAR;
            }
        }
        if constexpr (ALIGN_EPI) { if (wr == 0) PG8_BAR; }
        if constexpr (!Epi::AFTER_DRAIN) { E(acc, cur, wr, wc, fr, fq); S.done(cur); }
        if (!has_next) break;
#pragma unroll
        for (int a = 0; a < 2; ++a)
#pragma unroll
            for (int b = 0; b < 2; ++b)
#pragma unroll
                for (int m = 0; m < 4; ++m)
#pragma unroll
                    for (int n = 0; n < 2; ++n) acc[a][b][m][n] = (f32x4){0.f, 0.f, 0.f, 0.f};
        cur = nxt; cA = nA; cB = nB; ++ui;
        if constexpr (ALIGN_EPI) { if (wr == 1) PG8_BAR; }
    }
    PG8_WAIT_V(0);
    if constexpr (!ALIGN_EPI) { if (wr == 0) PG8_BAR; }
    PG8_BAR;
    if constexpr (Epi::AFTER_DRAIN) { E.fused(acc, cur, wr, wc, fr, fq, lds, wid, lane); S.done(cur); }
#undef PG8_SA
#undef PG8_SB
#undef PG8_STAGE
#undef PG8_LDA
#undef PG8_LDB
#undef PG8_MMA
#undef PG8_WAIT_V
#undef PG8_WAIT_L
#undef PG8_BAR
#undef PG8_SCHED
}
}
namespace pg8 {
template <int ACT  > struct EpiRoute {
    static constexpr bool PERM = true, AFTER_DRAIN = false, NORM = false;
    bf16_t* O0; int ld0; bf16_t* O1; int ld1; int split;
    __device__ __forceinline__ void operator()(const f32x4 (&acc)[2][2][4][2], const Unit& u, int wr, int wc, int fr, int fq) const {
        const int row0 = u.pm * BM + wr * 64 + fr; const bool first = u.pn < split;
        bf16_t* base = first ? O0 : O1; const int ld = first ? ld0 : ld1; const int col0 = (first ? u.pn : u.pn - split) * BM + wc * 32 + 8 * fq;
#pragma unroll
        for (int ai = 0; ai < 2; ++ai)
#pragma unroll
            for (int m = 0; m < 4; ++m) { bf16_t* rowp = base + (size_t)(row0 + ai * HALF + m * 16) * ld + col0;
#pragma unroll
                for (int bj = 0; bj < 2; ++bj) { f32x4 v0 = acc[ai][bj][m][0], v1 = acc[ai][bj][m][1];
                    if (ACT == 1) {
#pragma unroll
                        for (int e = 0; e < 4; ++e) { const float a = fmaxf(v0[e], 0.f), b = fmaxf(v1[e], 0.f); v0[e] = a * a; v1[e] = b * b; } }
                    u32x4 w; w.x = cvt_pk_bf16(v0[0], v0[1]); w.y = cvt_pk_bf16(v0[2], v0[3]); w.z = cvt_pk_bf16(v1[0], v1[1]); w.w = cvt_pk_bf16(v1[2], v1[3]);
                    *(u32x4*)(rowp + bj * HALF) = w; } }
    }
};
struct EpiResid {
    static constexpr bool PERM = true, AFTER_DRAIN = false, NORM = false;
    const float* xsrc; float* xdst; const float* gate;
    __device__ __forceinline__ void operator()(const f32x4 (&acc)[2][2][4][2], const Unit& u, int wr, int wc, int fr, int fq) const {
        const int row0 = u.pm * BM + wr * 64 + fr, col0 = u.pn * BM + wc * 32 + 8 * fq, b = (u.pm * BM) >> 12;
        f32x4 gv[2][2];
#pragma unroll
        for (int bj = 0; bj < 2; ++bj)
#pragma unroll
            for (int n = 0; n < 2; ++n) gv[bj][n] = *(const f32x4*)(gate + (size_t)b * 6144 + col0 + bj * HALF + 4 * n);
#pragma unroll
        for (int ai = 0; ai < 2; ++ai)
#pragma unroll
            for (int m = 0; m < 4; ++m) { const size_t off = (size_t)(row0 + ai * HALF + m * 16) * 1024 + col0;
#pragma unroll
                for (int bj = 0; bj < 2; ++bj)
#pragma unroll
                    for (int n = 0; n < 2; ++n) { const f32x4 xs = *(const f32x4*)(xsrc + off + bj * HALF + 4 * n);
                        *(f32x4*)(xdst + off + bj * HALF + 4 * n) = xs + gv[bj][n] * acc[ai][bj][m][n]; }
                if (m & 1) asm volatile("" ::: "memory"); }
    }
};
constexpr int EPI_OFF = 133120;
template <int ACT  > struct EpiRouteN {
    static constexpr bool PERM = true, AFTER_DRAIN = false, NORM = true;
    bf16_t* O; int ld; const float* RSP; const float* shw; PG8_LAS unsigned char* lds;
    __device__ __forceinline__ void prefetch(const Unit& u, int tid, int wid) const {
        const char* src = (const char*)RSP + (size_t)u.pm * (BM * 64) + (size_t)tid * 16;
#pragma unroll
        for (int i = 0; i < 2; ++i) __builtin_amdgcn_global_load_lds((const unsigned*)(src + i * 8192), (PG8_LAS unsigned*)(lds + EPI_OFF + wid * 1024 + i * 8192), 16, 0, 0);
        if (wid == 0) { const char* s2 = (const char*)(shw + (size_t)((u.pm * BM) >> 12) * NSHW + u.pn * BM) + (size_t)(tid & 63) * 16;
            __builtin_amdgcn_global_load_lds((const unsigned*)s2, (PG8_LAS unsigned*)(lds + EPI_OFF + 16384), 16, 0, 0); }
    }
    __device__ __forceinline__ void reduce_rs(int tid) const {
        if (tid < 256) { const PG8_LAS f32x4* p = (const PG8_LAS f32x4*)(lds + EPI_OFF + tid * 64); const f32x4 a = p[0], b = p[1], c = p[2], d = p[3];
            const float s = (((a.x + a.y) + (a.z + a.w)) + ((b.x + b.y) + (b.z + b.w))) + (((c.x + c.y) + (c.z + c.w)) + ((d.x + d.y) + (d.z + d.w)));
            *(PG8_LAS float*)(lds + EPI_OFF + 17408 + tid * 4) = __builtin_amdgcn_rsqf(s * (1.0f / 1024.0f) + 1e-6f); }
    }
    __device__ __forceinline__ void operator()(const f32x4 (&acc)[2][2][4][2], const Unit& u, int wr, int wc, int fr, int fq) const {
        const int row0 = u.pm * BM + wr * 64 + fr, col0 = u.pn * BM + wc * 32 + 8 * fq;
        const PG8_LAS unsigned char* ep = lds + EPI_OFF;
        float rs[2][4];
#pragma unroll
        for (int ai = 0; ai < 2; ++ai)
#pragma unroll
            for (int m = 0; m < 4; ++m) rs[ai][m] = *(const PG8_LAS float*)(ep + 17408 + (wr * 64 + fr + ai * HALF + m * 16) * 4);
        f32x4 sv[2][2];
#pragma unroll
        for (int bj = 0; bj < 2; ++bj)
#pragma unroll
            for (int n = 0; n < 2; ++n) sv[bj][n] = *(const PG8_LAS f32x4*)(ep + 16384 + (bj * HALF + wc * 32 + 8 * fq + 4 * n) * 4);
#pragma unroll
        for (int ai = 0; ai < 2; ++ai)
#pragma unroll
            for (int m = 0; m < 4; ++m) { bf16_t* rowp = O + (size_t)(row0 + ai * HALF + m * 16) * ld + col0;
#pragma unroll
                for (int bj = 0; bj < 2; ++bj) { f32x4 v0 = acc[ai][bj][m][0] * rs[ai][m] + sv[bj][0], v1 = acc[ai][bj][m][1] * rs[ai][m] + sv[bj][1];
                    if (ACT == 1) {
#pragma unroll
                        for (int e = 0; e < 4; ++e) { const float a = fmaxf(v0[e], 0.f), b = fmaxf(v1[e], 0.f); v0[e] = a * a; v1[e] = b * b; } }
                    u32x4 w; w.x = cvt_pk_bf16(v0[0], v0[1]); w.y = cvt_pk_bf16(v0[2], v0[3]); w.z = cvt_pk_bf16(v1[0], v1[1]); w.w = cvt_pk_bf16(v1[2], v1[3]);
                    *(u32x4*)(rowp + bj * HALF) = w; } }
    }
};
template <bool MAYSKIP> struct EpiResidXS {
    static constexpr bool PERM = true, AFTER_DRAIN = false, NORM = false;
    const bf16_t* xsrc; bf16_t* xdst; const float* gate; const float* wp; bf16_t* XS; float* RSP; int doxs;
    template <bool DOXS> __device__ __forceinline__ void body(const f32x4 (&acc)[2][2][4][2], const Unit& u, int wr, int wc, int fr, int fq) const {
        const int row0 = u.pm * BM + wr * 64 + fr, col0 = u.pn * BM + wc * 32 + 8 * fq, b = (u.pm * BM) >> 12;
        f32x4 gv[2][2], wv[2][2]; float ssv[2][4];
#pragma unroll
        for (int bj = 0; bj < 2; ++bj)
#pragma unroll
            for (int n = 0; n < 2; ++n) { gv[bj][n] = *(const f32x4*)(gate + (size_t)b * 6144 + col0 + bj * HALF + 4 * n);
                if (DOXS) wv[bj][n] = *(const f32x4*)(wp + (size_t)b * 1024 + col0 + bj * HALF + 4 * n); }
#pragma unroll
        for (int aim = 0; aim < 4; ++aim) { const int ai = aim >> 1, m0_ = (aim & 1) * 2;
            u32x4 xr[4][2];
#pragma unroll
            for (int m = m0_; m < m0_ + 2; ++m)
#pragma unroll
                for (int bj = 0; bj < 2; ++bj) xr[m][bj] = *(const u32x4*)(xsrc + (size_t)(row0 + ai * HALF + m * 16) * 1024 + col0 + bj * HALF);
#pragma unroll
            for (int m = m0_; m < m0_ + 2; ++m) { const size_t off = (size_t)(row0 + ai * HALF + m * 16) * 1024 + col0; float ss = 0.f;
#pragma unroll
                for (int bj = 0; bj < 2; ++bj) { const u32x4 r = xr[m][bj];
                    const f32x4 x0 = (f32x4){bflo(r.x), bfhi(r.x), bflo(r.y), bfhi(r.y)}, x1 = (f32x4){bflo(r.z), bfhi(r.z), bflo(r.w), bfhi(r.w)};
                    const f32x4 y0 = x0 + gv[bj][0] * acc[ai][bj][m][0], y1 = x1 + gv[bj][1] * acc[ai][bj][m][1];
                    u32x4 w; w.x = cvt_pk_bf16(y0[0], y0[1]); w.y = cvt_pk_bf16(y0[2], y0[3]); w.z = cvt_pk_bf16(y1[0], y1[1]); w.w = cvt_pk_bf16(y1[2], y1[3]);
                    *(u32x4*)(xdst + off + bj * HALF) = w;
                    if (DOXS) { const f32x4 a = y0 * wv[bj][0], c = y1 * wv[bj][1];
                        u32x4 v; v.x = cvt_pk_bf16(a[0], a[1]); v.y = cvt_pk_bf16(a[2], a[3]); v.z = cvt_pk_bf16(c[0], c[1]); v.w = cvt_pk_bf16(c[2], c[3]);
                        *(u32x4*)(XS + off + bj * HALF) = v;
                        ss += ((y0.x * y0.x + y0.y * y0.y) + (y0.z * y0.z + y0.w * y0.w)) + ((y1.x * y1.x + y1.y * y1.y) + (y1.z * y1.z + y1.w * y1.w)); } }
                ssv[ai][m] = ss; }
            asm volatile("" ::: "memory"); }
        if (DOXS) { float t1[2][4];
#pragma unroll
            for (int ai = 0; ai < 2; ++ai)
#pragma unroll
                for (int m = 0; m < 4; ++m) t1[ai][m] = __shfl_xor(ssv[ai][m], 16);
#pragma unroll
            for (int ai = 0; ai < 2; ++ai)
#pragma unroll
                for (int m = 0; m < 4; ++m) { ssv[ai][m] += t1[ai][m]; t1[ai][m] = __shfl_xor(ssv[ai][m], 32); }
            if (fq == 0) {
#pragma unroll
                for (int ai = 0; ai < 2; ++ai)
#pragma unroll
                    for (int m = 0; m < 4; ++m) RSP[(size_t)(row0 + ai * HALF + m * 16) * 16 + u.pn * 4 + wc] = ssv[ai][m] + t1[ai][m]; } }
    }
    __device__ __forceinline__ void operator()(const f32x4 (&acc)[2][2][4][2], const Unit& u, int wr, int wc, int fr, int fq) const {
        if (!MAYSKIP || doxs) body<true>(acc, u, wr, wc, fr, fq); else body<false>(acc, u, wr, wc, fr, fq);
    }
};
}

#define RLX_AGENT __ATOMIC_RELAXED, __HIP_MEMORY_SCOPE_AGENT
#define XB_TMO      128
#define XB_XCNT(j)  (256  + 64 * (j))
#define XB_XSUB(j)  (1280 + 64 * (j))
#define XB_XGEN(j)  (2304 + 64 * (j))
#define XB_TOP      3328
#define XB_TOPGEN   3392
#define XCD_BAR_WORDS 3456
#define XB_SPIN_CAP (1u << 24)

__device__ __forceinline__ unsigned xb_ld(unsigned* p)              { return __hip_atomic_load(p, __ATOMIC_RELAXED, __HIP_MEMORY_SCOPE_AGENT); }
__device__ __forceinline__ unsigned xb_add(unsigned* p, unsigned v) { return __hip_atomic_fetch_add(p, v, __ATOMIC_RELAXED, __HIP_MEMORY_SCOPE_AGENT); }
__device__ __forceinline__ unsigned xb_xcc_id() { return (unsigned)__builtin_amdgcn_s_getreg((3 << 11) | 20) & 0xFu; }
#define XB_SPIN(cond, bar) do { unsigned _sp = 0; while (cond) { __builtin_amdgcn_s_sleep(1); \
    if ((++_sp & 255u) == 0u) { if (xb_ld(&(bar)[XB_TMO])) break; if (_sp > XB_SPIN_CAP) { atomicAdd(&(bar)[XB_TMO], 1u); break; } } } } while (0)

struct XcdBarrier {
    unsigned* bar; unsigned x;
    volatile LAS unsigned* st;
};

__device__ __forceinline__ XcdBarrier xcd_barrier_post(unsigned* bar, volatile LAS unsigned* st) {
    XcdBarrier b; b.bar = bar; b.x = xb_xcc_id(); b.st = st;
    if (threadIdx.x == 0) (void)xb_add(&bar[XB_XCNT(b.x)], 1u);
    return b;
}
__device__ __forceinline__ void xcd_barrier_complete(unsigned* bar, unsigned x, unsigned& nloc, unsigned& nx) {
    const unsigned G = gridDim.x * gridDim.y * gridDim.z;
    unsigned sum, cnt, mine, sp = 0u;
    for (;;) {
        sum = 0u; cnt = 0u; mine = 0u;
#pragma unroll
        for (unsigned j = 0; j < 16; ++j) { const unsigned c = xb_ld(&bar[XB_XCNT(j)]); sum += c; cnt += (c > 0u) ? 1u : 0u; mine = (j == x) ? c : mine; }
        if (sum == G) break;
        __builtin_amdgcn_s_sleep(1);
        if ((++sp & 255u) == 0u) { if (xb_ld(&bar[XB_TMO])) break; if (sp > XB_SPIN_CAP) { atomicAdd(&bar[XB_TMO], 1u); break; } }
    }
    nloc = mine > 0u ? mine : 1u; nx = cnt > 0u ? cnt : 1u;
}

__device__ __forceinline__ void xcd_barrier(const XcdBarrier& b) {
    asm volatile("s_waitcnt vmcnt(0)" ::: "memory");
    __syncthreads();
    if (threadIdx.x == 0) {
        unsigned* bar = b.bar;
        __builtin_amdgcn_s_waitcnt(0);
        unsigned nloc = b.st[0], nx = b.st[1];
        if (nloc == 0u) { xcd_barrier_complete(bar, b.x, nloc, nx); b.st[0] = nloc; b.st[1] = nx; }
        const unsigned old = xb_add(&bar[XB_XSUB(b.x)], 1u);
        const unsigned gen = old / nloc;
        if (old + 1u == (gen + 1u) * nloc) {
            __builtin_amdgcn_fence(__ATOMIC_RELEASE, "agent");
            asm volatile("s_waitcnt vmcnt(0)" ::: "memory");
            const unsigned og = xb_add(&bar[XB_TOP], 1u);
            const unsigned tg = og / nx;
            if (og + 1u == (tg + 1u) * nx) xb_add(&bar[XB_TOPGEN], 1u);
            else XB_SPIN(xb_ld(&bar[XB_TOPGEN]) == tg, bar);
            __builtin_amdgcn_fence(__ATOMIC_ACQUIRE, "agent");
            xb_add(&bar[XB_XGEN(b.x)], 1u);
            asm volatile("s_waitcnt vmcnt(0)" ::: "memory");
        } else {
            XB_SPIN(xb_ld(&bar[XB_XGEN(b.x)]) == gen, bar);
            __builtin_amdgcn_fence(__ATOMIC_ACQUIRE, "agent");
            asm volatile("s_waitcnt vmcnt(0)" ::: "memory");
        }
    }
    __syncthreads();
}

#ifndef PH_MASK
#define PH_MASK 0xFFFFF
#endif
#define EN(b) if constexpr ((PH_MASK >> (b)) & 1)
#ifndef DUP_MASK
#define DUP_MASK 0
#endif
#define DUP(b) if constexpr ((DUP_MASK >> (b)) & 1)
#define DBG_DIGEST_N 256
#define DBG_DIGEST_VAL(m, c) bf2f(((const bf16*)(wsp + WS_CAT))[(size_t)(m) * DM + 768 + (c)])
#ifndef DBG_PH_HI
#define DBG_PH_HI NPHASE
#endif
#ifndef MK_MULTI
#define MK_MULTI 0
#endif
constexpr int LDS_BYTES = 151552, MISC_OFF = 131072 + 320;
#ifndef DBG_LAYERS
#define DBG_LAYERS 4
#define DBG_L0 0
#endif
constexpr int NPHASE = 3 + 7 * DBG_LAYERS;
__global__ void __launch_bounds__(512, 2) hymba_fwd(Args a) {
    extern __shared__ __attribute__((aligned(16))) unsigned char lds[];
    Ctx F0;
    Ctx& F = F0;
    F.lds = (char*)lds; F.tid = threadIdx.x; F.lane = F.tid & 63; F.wave = __builtin_amdgcn_readfirstlane(F.tid >> 6); F.G = gridDim.x; F.bid = blockIdx.x;
    F.A = nullptr; F.ws = a.ws;
    if (F.tid < 29) ((unsigned long long*)(lds + PTR_OFF))[F.tid] = F.tid < 28 ? (unsigned long long)a.in[F.tid] : (unsigned long long)a.out;
    volatile LAS unsigned* MISC = (volatile LAS unsigned*)((LAS unsigned char*)lds + MISC_OFF);
    if (F.tid < 32) MISC[F.tid] = 0u;
    __syncthreads();
    unsigned* ctl = (unsigned*)(a.ws + WS_CTL);
    XcdBarrier bar; bar.bar = ctl + CW_BAR; bar.x = 0; bar.st = nullptr;
    if (!MK_MULTI) bar = xcd_barrier_post(ctl + CW_BAR, MISC + 8);
    const int lo = a.ph_lo, hi = a.ph_hi;
    int ph = 0;
#define PH_BEGIN if (lo <= ph && ph < hi) { Ctx F = F0; unsigned long long wsl_ = (unsigned long long)F0.ws; asm volatile("" : "+v"(F.tid), "+s"(F.bid), "+s"(F.G), "+s"(wsl_)); F.ws = (unsigned char*)(__attribute__((address_space(1))) unsigned char*)wsl_; F.lane = F.tid & 63; F.wave = __builtin_amdgcn_readfirstlane(F.tid >> 6); unsigned char* const wsp = F.ws; (void)wsp;
#define PH_END   if (!MK_MULTI && ph + 1 < hi) { XcdBarrier bb = bar; asm volatile("" : "+s"(bb.bar), "+s"(bb.x)); xcd_barrier(bb); } else __syncthreads(); } ++ph;
    PG8_LAS unsigned char* glds = (PG8_LAS unsigned char*)lds;
#define XN ((bf16*)(wsp + WS_XN))
#define PROJ ((bf16*)(wsp + WS_PROJ))
#define CAT ((bf16*)(wsp + WS_CAT))
#define HB ((bf16*)(wsp + WS_HB))
    PH_BEGIN EN(0) ph_prologue(F); DUP(0) { __syncthreads(); ph_prologue(F); } PH_END
    PH_BEGIN EN(1) { ph_shw(F); ph_xs0(F, PIN(F, I_X), PIN(F, I_N1W) + DBG_L0 * DM, (const float*)(wsp + WS_MOD) + (size_t)DBG_L0 * BATCH * NADA, DM, XN, (float*)(wsp + WS_RSP), (bf16*)POUT(F)); } PH_END
    for (int l_ = 0; l_ < DBG_LAYERS; ++l_) { const int l = l_ + DBG_L0;
        #define modl ((const float*)(wsp + WS_MOD) + (size_t)l * BATCH * NADA)
        #define xsrc (l_ == 0 ? PIN(F, I_X) : (const float*)POUT(F))
        PH_BEGIN
#if defined(PROBE_GA)
            { pg8::Gemm g{XN, (const bf16*)(wsp + WS_WIN) + (size_t)l * NPROJ * DM, MTOK, NPROJ, DM}; pg8::StaticOrder S; S.init(MTOK, NPROJ, F.G, F.bid);
            pg8::EpiRoute<0> E{PROJ, NPROJ, PROJ, NPROJ, 1 << 20};
            pg8::gemm_phase<pg8::EpiRoute<0>, pg8::StaticOrder, true, true>(glds, g, S, E, F.tid); } __syncthreads();
#elif defined(PROBE_GB)
            { pg8::Gemm g{XN, (const bf16*)(wsp + WS_WIN) + (size_t)l * NPROJ * DM, MTOK, NPROJ, DM}; pg8::StaticOrder S; S.init(MTOK, NPROJ, F.G, F.bid);
            pg8::EpiRouteN<0> E{PROJ, NPROJ, (const float*)(wsp + WS_RSP), (const float*)(wsp + WS_SHW) + (size_t)l * BATCH * NSHW, glds};
            pg8::gemm_phase<pg8::EpiRouteN<0>, pg8::StaticOrder, true, true>(glds, g, S, E, F.tid); } __syncthreads();
#endif
        EN(2) { pg8::Gemm g{XN, (const bf16*)(wsp + WS_WIN) + (size_t)l * NPROJ * DM, MTOK, NPROJ, DM}; pg8::StaticOrder S; S.init(MTOK, NPROJ, F.G, F.bid);
            pg8::EpiRouteN<0> E{PROJ, NPROJ, (const float*)(wsp + WS_RSP), (const float*)(wsp + WS_SHW) + (size_t)l * BATCH * NSHW, glds};
            pg8::gemm_phase<pg8::EpiRouteN<0>, pg8::StaticOrder, true, true>(glds, g, S, E, F.tid); } PH_END
        PH_BEGIN EN(3) ph_prep(F, l); DUP(3) ph_prep(F, l); EN(4) ph_lru1(F, l); DUP(4) ph_lru1(F, l); EN(5) ph_mlstm(F, l); DUP(5) ph_mlstm(F, l); PH_END
        PH_BEGIN EN(6) { ph_carry(F); pg8::Gemm g{(const bf16*)(wsp + WS_QL), (const bf16*)(wsp + WS_WQC) + (size_t)l * 768 * 256, MTOK, 768, 256}; pg8::StaticOrder S; S.init(MTOK, 768, F.G, F.bid);
            pg8::EpiRoute<0> E{(bf16*)(wsp + WS_QABS), 512, (bf16*)(wsp + WS_QIDX), 256, 2};
            pg8::gemm_phase<pg8::EpiRoute<0>, pg8::StaticOrder, true, true>(glds, g, S, E, F.tid); } PH_END
        PH_BEGIN EN(7) ph_dsa(F, l); DUP(7) ph_dsa(F, l); EN(8) ph_lru2(F, l); DUP(8) ph_lru2(F, l); EN(9) ph_mfin(F, l); DUP(9) ph_mfin(F, l); PH_END
        PH_BEGIN EN(10) { pg8::Gemm g{CAT, (const bf16*)(wsp + WS_WO) + (size_t)l * DM * DM, MTOK, DM, DM}; pg8::StaticOrder S; S.init(MTOK, DM, F.G, F.bid);
            pg8::EpiResidXS<false> E{(const pg8::bf16_t*)POUT(F), (pg8::bf16_t*)POUT(F), modl + 2 * DM, (const float*)(wsp + WS_WP) + (size_t)(l * 2 + 1) * BATCH * DM, XN, (float*)(wsp + WS_RSP), 1};
            pg8::gemm_phase<pg8::EpiResidXS<false>, pg8::StaticOrder, true, true>(glds, g, S, E, F.tid); } PH_END
        PH_BEGIN EN(12) { pg8::Gemm g{XN, (const bf16*)(wsp + WS_W1) + (size_t)l * DFF * DM, MTOK, DFF, DM}; pg8::StaticOrder S; S.init(MTOK, DFF, F.G, F.bid);
            pg8::EpiRouteN<1> E{HB, DFF, (const float*)(wsp + WS_RSP), (const float*)(wsp + WS_SHW) + (size_t)l * BATCH * NSHW + NPROJ, glds};
            pg8::gemm_phase<pg8::EpiRouteN<1>, pg8::StaticOrder, true, true>(glds, g, S, E, F.tid); } PH_END
        PH_BEGIN EN(13) { pg8::Gemm g{HB, (const bf16*)(wsp + WS_W2) + (size_t)l * DM * DFF, MTOK, DM, DFF}; pg8::StaticOrder S; S.init(MTOK, DM, F.G, F.bid);
            const int nl = l + 1 < DEPTH ? l + 1 : l;
            const bool lastl = l_ + 1 >= DBG_LAYERS;
            pg8::EpiResidXS<true> E{(const pg8::bf16_t*)POUT(F), lastl ? (pg8::bf16_t*)XN : (pg8::bf16_t*)POUT(F), modl + 5 * DM, (const float*)(wsp + WS_WP) + (size_t)(nl * 2) * BATCH * DM, XN, (float*)(wsp + WS_RSP), lastl ? 0 : 1};
            pg8::gemm_phase<pg8::EpiResidXS<true>, pg8::StaticOrder, true, true>(glds, g, S, E, F.tid); } PH_END
    }
#ifdef DBG_DIGEST
    PH_BEGIN { const int gw = F.bid * 8 + F.wave, NGW = F.G * 8; float* o = POUT(F);
        for (int m = gw; m < MTOK; m += NGW) for (int j = 0; j < 16; ++j) { const int c = F.lane + 64 * j; float v = 0.f;
            if (c < DBG_DIGEST_N) { v = DBG_DIGEST_VAL(m, c) * 4096.0f; v = v - floorf(v); }
            o[(size_t)m * DM + c] = v; } } PH_END
#else
    PH_BEGIN EN(14) ph_finalnorm16(F, XN, PIN(F, I_FNW), POUT(F)); PH_END
#endif
}

extern "C" void kernel_launch(void* const* d_in, const int* in_sizes, int n_in, void* d_out, int out_size, void* d_ws, size_t ws_size, hipStream_t stream) {
    static int grid = 0;
    if (grid == 0) {
        if (n_in != 28 || in_sizes[0] != MTOK * DM || out_size != MTOK * DM || ws_size < WS_END) { fprintf(stderr, "kernel_launch: unexpected shapes (n_in %d, in0 %d, out %d, ws %zu)\n", n_in, n_in > 0 ? in_sizes[0] : -1, out_size, ws_size); grid = -1; return; }
        int dev = 0, cus = 0, per_cu = 0;
        if (hipGetDevice(&dev) != hipSuccess || hipDeviceGetAttribute(&cus, hipDeviceAttributeMultiprocessorCount, dev) != hipSuccess) { grid = -1; return; }
        if (hipFuncSetAttribute((const void*)hymba_fwd, hipFuncAttributeMaxDynamicSharedMemorySize, LDS_BYTES) != hipSuccess) { fprintf(stderr, "kernel_launch: hipFuncSetAttribute failed\n"); grid = -1; return; }
        if (hipOccupancyMaxActiveBlocksPerMultiprocessor(&per_cu, (const void*)hymba_fwd, 512, LDS_BYTES) != hipSuccess || per_cu < 1) { fprintf(stderr, "kernel_launch: occupancy query says %d\n", per_cu); }
        (void)hipGetLastError();
        grid = cus;
    }
    if (grid < 0) return;
    if (hipMemsetAsync((char*)d_ws + WS_CTL, 0, CTL_ZERO_BYTES, stream) != hipSuccess) return;
    Args a{};
    for (int i = 0; i < 28; ++i) a.in[i] = (const float*)d_in[i];
    a.out = (float*)d_out; a.ws = (unsigned char*)d_ws;
#if MK_MULTI
    for (int p = 0; p < NPHASE; ++p) { a.ph_lo = p; a.ph_hi = p + 1; hipLaunchKernelGGL(hymba_fwd, dim3(grid), dim3(512), LDS_BYTES, stream, a); }
#else
    a.ph_lo = 0; a.ph_hi = DBG_PH_HI; hipLaunchKernelGGL(hymba_fwd, dim3(grid), dim3(512), LDS_BYTES, stream, a);
#endif
}
#endif
```

```cpp
#ifndef HOST_EMU
#include <hip/hip_runtime.h>
#include <cstdio>
#include <cstdint>
#define DEV __device__ __forceinline__
#define LAS __attribute__((address_space(3)))
#else
#include "emu.h"
#endif

#ifndef HOST_EMU
#define SYNC() __syncthreads()
#define KEEP4(a, b, c, d) asm volatile("" :: "v"(a), "v"(b), "v"(c), "v"(d))
#define LAUNDER_V(x) asm volatile("" : "+v"(x))
#define WAVE_LDS_FENCE() asm volatile("s_waitcnt lgkmcnt(0)" ::: "memory")
template <class T> DEV T SHFL(T v, int s) { return __shfl(v, s); }
template <class T> DEV T SHFL_XOR(T v, int m) { return __shfl_xor(v, m); }
template <class T> DEV T SHFL_UP(T v, int d) { return __shfl_up(v, d); }
template <class T> DEV T SHFL_DOWN(T v, int d) { return __shfl_down(v, d); }
typedef short bf16x8_ __attribute__((ext_vector_type(8)));
typedef float f32x4_ __attribute__((ext_vector_type(4)));
typedef short v4i16_t __attribute__((ext_vector_type(4)));
DEV f32x4_ MFMA16(bf16x8_ a, bf16x8_ b, f32x4_ c) { return __builtin_amdgcn_mfma_f32_16x16x32_bf16(a, b, c, 0, 0, 0); }
DEV v4i16_t TR16(const void* p) { return __builtin_amdgcn_ds_read_tr16_b64_v4i16((LAS v4i16_t*)(p)); }
#endif


typedef unsigned short bf16;
typedef short bf16x8 __attribute__((ext_vector_type(8)));
typedef short s16x4 __attribute__((ext_vector_type(4)));
typedef float f32x4 __attribute__((ext_vector_type(4)));
typedef unsigned u32x4 __attribute__((ext_vector_type(4)));
typedef unsigned u32x2 __attribute__((ext_vector_type(2)));

constexpr int BATCH = 16, SEQ = 4096, DM = 1024, DEPTH = 4, MTOK = BATCH * SEQ;
constexpr int NPROJ = 3072, DFF = 4096, NADA = 6 * DM;
constexpr int PC_LX = 0, PC_LY = 256, PC_MQ = 512, PC_MK = 1024, PC_MV = 1536, PC_MO = 2048, PC_AQ = 2560, PC_AKV = 2816, PC_IK = 2944, PC_IW = 2976, PC_MI = 2984, PC_MF = 2988;
constexpr float NORM_EPS = 1e-6f;

constexpr size_t MiB = 1u << 20;
constexpr size_t WS_CTL = 0, CTL_ZERO_BYTES = 1 * MiB;
constexpr size_t WS_MOD = 1 * MiB;
constexpr size_t WS_WQC = 3 * MiB;
constexpr size_t WS_WG = 5 * MiB;
constexpr size_t WS_WUVT = 6 * MiB;
constexpr size_t WS_WIN = 8 * MiB;
constexpr size_t WS_WO = 32 * MiB;
constexpr size_t WS_W1 = 40 * MiB;
constexpr size_t WS_W2 = 72 * MiB;
constexpr size_t WS_XN = 104 * MiB;
constexpr size_t WS_QL = WS_XN, WS_CKV = WS_XN + 32 * MiB, WS_QIDX = WS_XN + 48 * MiB, WS_KIDX = WS_XN + 80 * MiB, WS_WI = WS_XN + 84 * MiB, WS_GT = WS_XN + 86 * MiB;
constexpr size_t WS_CAT = 232 * MiB;
constexpr size_t WS_PROJ = 360 * MiB;
constexpr size_t WS_HB = 360 * MiB;
constexpr size_t WS_QABS = 744 * MiB;
constexpr size_t WS_HLOC = 808 * MiB, WS_CPA = 840 * MiB;
constexpr size_t WS_LSUM = 872 * MiB;
constexpr size_t WS_HM = 874 * MiB;
constexpr size_t WS_MG = 940 * MiB;
constexpr size_t WS_WP = 2 * MiB + 512 * 1024;
constexpr size_t WS_SHW = 6 * MiB + 256 * 1024;
constexpr size_t WS_RSP = 1000 * MiB;
constexpr size_t WS_CARRY = 948 * MiB;
constexpr size_t WS_SCR2 = 949 * MiB;
constexpr int NSHW = NPROJ + DFF;
constexpr size_t WS_END = 1024 * MiB;
static_assert(WS_HM + (size_t)MTOK * 512 * 2 <= WS_END && WS_HB + (size_t)MTOK * DFF * 2 <= WS_HLOC + 64 * MiB, "ws map");

constexpr int CW_TMO = 0, CW_BAR = 4096;

#ifndef HOST_EMU
typedef __bf16 hwbf2_t __attribute__((ext_vector_type(2)));
typedef float hwf2_t __attribute__((ext_vector_type(2)));
DEV unsigned f2bf(float f) { return (unsigned)__builtin_bit_cast(unsigned short, (__bf16)f); }
DEV unsigned pk2(float lo, float hi) { const hwf2_t v = {lo, hi}; return __builtin_bit_cast(unsigned, __builtin_convertvector(v, hwbf2_t)); }
#else
DEV unsigned f2bf(float f) { unsigned u = __builtin_bit_cast(unsigned, f); return (u + 0x7fffu + ((u >> 16) & 1u)) >> 16; }
DEV unsigned pk2(float lo, float hi) { return f2bf(lo) | (f2bf(hi) << 16); }
#endif
DEV float bf2f(unsigned h) { return __builtin_bit_cast(float, h << 16); }
DEV float bflo(unsigned w) { return __builtin_bit_cast(float, w << 16); }
DEV float bfhi(unsigned w) { return __builtin_bit_cast(float, w & 0xffff0000u); }
DEV float wave_sum(float v) {
#pragma unroll
    for (int o = 1; o < 64; o <<= 1) v += SHFL_XOR(v, o);
    return v;
}
#ifndef HOST_EMU
DEV float FEXP(float x) { return __expf(x); }
DEV float FEXP2(float x) { return __builtin_amdgcn_exp2f(x); }
DEV float FRCP(float x) { return __builtin_amdgcn_rcpf(x); }
DEV float FSQRT(float x) { return __builtin_amdgcn_sqrtf(x); }
DEV float RSQ(float x) { return __builtin_amdgcn_rsqf(x); }
DEV float FLOG(float x) { return __logf(x); }
#else
DEV float FEXP(float x) { return expf(x); }
DEV float FEXP2(float x) { return exp2f(x); }
DEV float FRCP(float x) { return 1.0f / x; }
DEV float FSQRT(float x) { return sqrtf(x); }
DEV float RSQ(float x) { return 1.0f / sqrtf(x); }
DEV float FLOG(float x) { return logf(x); }
#endif
#ifndef HOST_EMU
DEV int UNI(int x) { return __builtin_amdgcn_readfirstlane(x); }
#else
DEV int UNI(int x) { return x; }
#endif
#ifndef HOST_EMU
#define GAS __attribute__((address_space(1)))
DEV const GAS char* UNIP(const void* p) { const unsigned long long v = (unsigned long long)p; const unsigned lo = __builtin_amdgcn_readfirstlane((unsigned)v), hi = __builtin_amdgcn_readfirstlane((unsigned)(v >> 32));
    return (const GAS char*)(((unsigned long long)hi << 32) | lo); }
#else
#define GAS
DEV const char* UNIP(const void* p) { return (const char*)p; }
#endif
DEV float RELU(float x) { const int b = __builtin_bit_cast(int, x); return __builtin_bit_cast(float, b > 0 ? b : 0); }
DEV float sigmoidf_(float z) { return 1.0f / (1.0f + expf(-z)); }
DEV float fsigmoid(float z) { return FRCP(1.0f + FEXP(-z)); }
DEV float one_minus_exp(float x) {
    const float s = -x * (1.0f + x * (0.5f + x * (0.16666667f + x * 0.041666668f)));
    return x > -0.05f ? s : 1.0f - FEXP(x);
}

struct Args { const float* in[28]; float* out; unsigned char* ws; int ph_lo, ph_hi; };
struct Ctx {
    char* lds; int tid, lane, wave, G, bid;
    const Args* A;
    unsigned char* ws;
};

constexpr int PTR_OFF = 131072 + 512;
#ifndef HOST_EMU
DEV const float* PIN(const Ctx& F, int i) { const unsigned long long v = ((const unsigned long long*)(F.lds + PTR_OFF))[i];
    const unsigned lo = __builtin_amdgcn_readfirstlane((unsigned)v), hi = __builtin_amdgcn_readfirstlane((unsigned)(v >> 32)); return (const float*)(const __attribute__((address_space(1))) float*)(((unsigned long long)hi << 32) | lo); }
DEV float* POUT(const Ctx& F) { return (float*)PIN(F, 28); }
#else
DEV const float* PIN(const Ctx& F, int i) { return F.A->in[i]; }
DEV float* POUT(const Ctx& F) { return POUT(F); }
#endif
enum { I_X = 0, I_C, I_WIN, I_CONVW, I_CONVB, I_WA, I_BA, I_WX, I_BX, I_LAM, I_BI, I_BF, I_WQUP, I_WQIDX, I_WUK, I_WUV, I_QNW, I_KVNW, I_RELB, I_GNW, I_WO, I_WADA, I_BADA, I_N1W, I_N2W, I_W1, I_W2, I_FNW };

DEV int win_srccol(int n) {
    if (n < 2560) return n;
    if (n < PC_AKV) return 2568 + (n - PC_AQ);
    if (n < PC_IK) return 2824 + (n - PC_AKV);
    if (n < PC_IW) return 2952 + (n - PC_IK);
    if (n < PC_MI) return 2984 + (n - PC_IW);
    if (n < PC_MF) return 2560 + (n - PC_MI);
    if (n < 2992) return 2564 + (n - PC_MF);
    return -1;
}
template <bool MAPPED>
DEV void p0_transpose_item(const float* W, int K, int N, int NT, bf16* WT, float* scr, int item, int lane) {
    const int nblk = NT / 32, kb = item / nblk, nb = item % nblk, k0 = 64 * kb, n0 = 32 * nb;
    int sc = n0 + (lane & 31); if (MAPPED) sc = win_srccol(sc);
#pragma unroll 8
    for (int i = 0; i < 32; ++i) { const int kk = 2 * i + (lane >> 5); const float v = W[(size_t)(k0 + kk) * N + (sc >= 0 ? sc : 0)]; scr[kk * 33 + (lane & 31)] = sc >= 0 ? v : 0.f; }
    WAVE_LDS_FENCE();
    const int c = lane & 7;
#pragma unroll
    for (int j = 0; j < 4; ++j) { const int n = (lane >> 3) + 8 * j; const float* s = scr + (8 * c) * 33 + n;
        u32x4 o; o.x = pk2(s[0 * 33], s[1 * 33]); o.y = pk2(s[2 * 33], s[3 * 33]); o.z = pk2(s[4 * 33], s[5 * 33]); o.w = pk2(s[6 * 33], s[7 * 33]);
        *(u32x4*)(WT + (size_t)(n0 + n) * K + k0 + 8 * c) = o; }
    WAVE_LDS_FENCE();
}

DEV void ph_prologue(const Ctx& F) {
    const int gt = F.bid * 512 + F.tid, NGT = F.G * 512;
    float* CACT = (float*)F.lds;
    for (int i = F.tid; i < BATCH * DM; i += 512) { const float cv = PIN(F, I_C)[i]; CACT[i] = cv * sigmoidf_(cv); }
    SYNC();
    for (int e = gt; e < DEPTH * NADA * 4; e += NGT) {
        const int j = e % NADA, bq = (e / NADA) & 3, l = e / (NADA * 4);
        const float* w = PIN(F, I_WADA) + (size_t)l * DM * NADA + j;
        const float* c = CACT + bq * 4 * DM;
        float a0 = 0.f, a1 = 0.f, a2 = 0.f, a3 = 0.f;
#pragma unroll 8
        for (int k = 0; k < DM; k += 4) {
            const float w0 = w[(size_t)k * NADA], w1 = w[(size_t)(k + 1) * NADA], w2 = w[(size_t)(k + 2) * NADA], w3 = w[(size_t)(k + 3) * NADA];
            const f32x4 c0 = *(const f32x4*)(c + k), c1 = *(const f32x4*)(c + DM + k), c2 = *(const f32x4*)(c + 2 * DM + k), c3 = *(const f32x4*)(c + 3 * DM + k);
            a0 += (c0.x * w0 + c0.y * w1) + (c0.z * w2 + c0.w * w3); a1 += (c1.x * w0 + c1.y * w1) + (c1.z * w2 + c1.w * w3);
            a2 += (c2.x * w0 + c2.y * w1) + (c2.z * w2 + c2.w * w3); a3 += (c3.x * w0 + c3.y * w1) + (c3.z * w2 + c3.w * w3); }
        const float bb = PIN(F, I_BADA)[(size_t)l * NADA + j];
        float* mo = (float*)(F.ws + WS_MOD) + ((size_t)l * BATCH + bq * 4) * NADA + j;
        mo[0] = a0 + bb; mo[NADA] = a1 + bb; mo[2 * NADA] = a2 + bb; mo[3 * NADA] = a3 + bb;
    }
    for (int e = gt; e < DEPTH * 2 * 4 * 64 * 64; e += NGT) {
        const int i = e & 63, j = (e >> 6) & 63, blk = (e >> 12) & 3, g = (e >> 14) & 1, l = e >> 15;
        const float* src = PIN(F, g ? I_WX : I_WA) + (((size_t)l * 4 + blk) * 64 + i) * 64 + j;
        ((bf16*)(F.ws + WS_WG))[e] = (bf16)f2bf(*src);
    }
    for (int e = gt; e < DEPTH * 4 * 64 * 128; e += NGT) {
        const int r = e & 127, d = (e >> 7) & 63, h = (e >> 13) & 3, l = e >> 15;
        ((bf16*)(F.ws + WS_WUVT))[e] = (bf16)f2bf(PIN(F, I_WUV)[(((size_t)l * 128 + r) * 4 + h) * 64 + d]);
    }
    for (int e = gt; e < DEPTH * 768 * 256; e += NGT) {
        const int r = e & 255, n = (e >> 8) % 768, l = e / (768 * 256);
        float v;
        if (n < 512) { const int h = n >> 7, c = n & 127; const f32x4* q = (const f32x4*)(PIN(F, I_WQUP) + ((size_t)l * 256 + r) * 256 + h * 64); const f32x4* k = (const f32x4*)(PIN(F, I_WUK) + ((size_t)l * 128 + c) * 256 + h * 64);
            float s = 0.f;
#pragma unroll
            for (int d = 0; d < 16; ++d) { const f32x4 a = q[d], bq4 = k[d]; s += (a.x * bq4.x + a.y * bq4.y) + (a.z * bq4.z + a.w * bq4.w); }
            v = s * (0.125f * 1.4426950408889634f); }
        else v = PIN(F, I_WQIDX)[((size_t)l * 256 + r) * 256 + (n - 512)] * 0.17677669529663687f;
        ((bf16*)(F.ws + WS_WQC))[e] = (bf16)f2bf(v);
    }
    SYNC();
    float* scr = (float*)(F.lds + F.wave * 16384);
    const int gw = F.bid * 8 + F.wave, NGW = F.G * 8;
    constexpr int I_IN = (DM / 64) * (NPROJ / 32), I_O = (DM / 64) * (DM / 32), I_1 = (DM / 64) * (DFF / 32), I_2 = (DFF / 64) * (DM / 32);
    constexpr int PER_L = I_IN + I_O + I_1 + I_2;
    for (int it = gw; it < DEPTH * PER_L; it += NGW) {
        const int l = it / PER_L; int r = it % PER_L;
        if (r < I_IN) { p0_transpose_item<true>(PIN(F, I_WIN) + (size_t)l * DM * 2992, DM, 2992, NPROJ, (bf16*)(F.ws + WS_WIN) + (size_t)l * NPROJ * DM, scr, r, F.lane); continue; } r -= I_IN;
        if (r < I_O) { p0_transpose_item<false>(PIN(F, I_WO) + (size_t)l * DM * DM, DM, DM, DM, (bf16*)(F.ws + WS_WO) + (size_t)l * DM * DM, scr, r, F.lane); continue; } r -= I_O;
        if (r < I_1) { p0_transpose_item<false>(PIN(F, I_W1) + (size_t)l * DM * DFF, DM, DFF, DFF, (bf16*)(F.ws + WS_W1) + (size_t)l * DFF * DM, scr, r, F.lane); continue; } r -= I_1;
        p0_transpose_item<false>(PIN(F, I_W2) + (size_t)l * DFF * DM, DFF, DM, DM, (bf16*)(F.ws + WS_W2) + (size_t)l * DM * DFF, scr, r, F.lane);
    }
}

DEV void ph_xs0(const Ctx& F, const float* xsrc, const float* nw, const float* modl, int sc_off, bf16* XS, float* RSP, bf16* X16) {
    const int gw = F.bid * 8 + F.wave, NGW = F.G * 8;
    f32x4 wv[4];
#pragma unroll
    for (int j = 0; j < 4; ++j) wv[j] = *(const f32x4*)(nw + 4 * F.lane + 256 * j);
    f32x4 v[2][4], vn[2][4];
#pragma unroll
    for (int q = 0; q < 2; ++q) { const int m = gw + q * NGW; const f32x4* xr = (const f32x4*)(xsrc + (size_t)(m < MTOK ? m : 0) * DM) + F.lane;
#pragma unroll
        for (int j = 0; j < 4; ++j) v[q][j] = xr[64 * j]; }
    for (int m0 = gw; m0 < MTOK; m0 += 2 * NGW) {
        f32x4 sc[2][4];
#pragma unroll
        for (int q = 0; q < 2; ++q) { const int m = m0 + q * NGW; const float* mb = modl + (size_t)((m < MTOK ? m : 0) >> 12) * NADA + 4 * F.lane;
#pragma unroll
            for (int j = 0; j < 4; ++j) sc[q][j] = *(const f32x4*)(mb + sc_off + 256 * j); }
#pragma unroll
        for (int q = 0; q < 2; ++q) { const int m = m0 + (2 + q) * NGW; const f32x4* xr = (const f32x4*)(xsrc + (size_t)(m < MTOK ? m : 0) * DM) + F.lane;
#pragma unroll
            for (int j = 0; j < 4; ++j) vn[q][j] = xr[64 * j]; }
        float s[2];
#pragma unroll
        for (int q = 0; q < 2; ++q) { float a = 0.f;
#pragma unroll
            for (int j = 0; j < 4; ++j) a += (v[q][j].x * v[q][j].x + v[q][j].y * v[q][j].y) + (v[q][j].z * v[q][j].z + v[q][j].w * v[q][j].w);
            s[q] = a; }
#pragma unroll
        for (int o = 1; o < 64; o <<= 1) { s[0] += SHFL_XOR(s[0], o); s[1] += SHFL_XOR(s[1], o); }
#pragma unroll
        for (int q = 0; q < 2; ++q) { const int m = m0 + q * NGW; if (m >= MTOK) break;
            if (F.lane < 16) RSP[(size_t)m * 16 + F.lane] = F.lane == 0 ? s[q] : 0.f;
            u32x2* o8 = (u32x2*)(XS + (size_t)m * DM) + F.lane; u32x2* x8 = (u32x2*)(X16 + (size_t)m * DM) + F.lane;
#pragma unroll
            for (int j = 0; j < 4; ++j) { const f32x4 y = v[q][j] * (wv[j] * (1.0f + sc[q][j]));
                u32x2 p; p.x = pk2(y.x, y.y); p.y = pk2(y.z, y.w); o8[64 * j] = p;
                u32x2 c; c.x = pk2(v[q][j].x, v[q][j].y); c.y = pk2(v[q][j].z, v[q][j].w); x8[64 * j] = c; } }
#pragma unroll
        for (int q = 0; q < 2; ++q)
#pragma unroll
            for (int j = 0; j < 4; ++j) v[q][j] = vn[q][j];
    }
}
DEV void ph_shw(const Ctx& F) {
    const int gt = F.bid * 512 + F.tid, NGT = F.G * 512;
    for (int e = gt; e < DEPTH * 2 * BATCH * (DM / 4); e += NGT) {
        const int c4 = e & 255, b = (e >> 8) & 15, w = (e >> 12) & 1, l = e >> 13;
        const f32x4 nwv = *(const f32x4*)(PIN(F, w ? I_N2W : I_N1W) + l * DM + 4 * c4);
        const f32x4 sc = *(const f32x4*)((const float*)(F.ws + WS_MOD) + ((size_t)l * BATCH + b) * NADA + (w ? 4 * DM : DM) + 4 * c4);
        ((f32x4*)(F.ws + WS_WP))[e] = nwv * (1.0f + sc);
    }
    const int gw = F.bid * 8 + F.wave, NGW = F.G * 8, i16 = F.lane & 15, kq = 8 * (F.lane >> 4);
    for (int it = gw; it < DEPTH * (NSHW / 16); it += NGW) {
        const int l = it / (NSHW / 16), n0 = (it % (NSHW / 16)) * 16;
        const bool mlp = n0 >= NPROJ;
        const bf16* Wr = mlp ? (const bf16*)(F.ws + WS_W1) + ((size_t)l * DFF + (n0 - NPROJ) + i16) * DM : (const bf16*)(F.ws + WS_WIN) + ((size_t)l * NPROJ + n0 + i16) * DM;
        const float* sh = (const float*)(F.ws + WS_MOD) + ((size_t)l * BATCH + i16) * NADA + (mlp ? 3 * DM : 0);
        f32x4 acc0 = {0.f, 0.f, 0.f, 0.f}, acc1 = {0.f, 0.f, 0.f, 0.f};
#pragma unroll 4
        for (int s = 0; s < DM / 32; ++s) {
            const bf16x8 B = *(const bf16x8*)(Wr + 32 * s + kq);
            const f32x4 a0 = *(const f32x4*)(sh + 32 * s + kq), a1 = *(const f32x4*)(sh + 32 * s + kq + 4);
            bf16x8 Ah, Al;
#pragma unroll
            for (int j = 0; j < 8; ++j) { const float a = j < 4 ? a0[j] : a1[j - 4]; const unsigned h = f2bf(a); Ah[j] = (short)h; Al[j] = (short)f2bf(a - bf2f(h)); }
            acc0 = MFMA16(Ah, B, acc0); acc1 = MFMA16(Al, B, acc1);
        }
        float* o = (float*)(F.ws + WS_SHW) + ((size_t)l * BATCH + 4 * (F.lane >> 4)) * NSHW + n0 + i16;
#pragma unroll
        for (int r = 0; r < 4; ++r) o[(size_t)r * NSHW] = acc0[r] + acc1[r];
    }
}
DEV void ph_normmod(const Ctx& F, const float* xsrc, const float* nw, const float* modl, int sh_off, int sc_off, bf16* XN) {
    const int gw = F.bid * 8 + F.wave, NGW = F.G * 8;
    f32x4 wv[4];
#pragma unroll
    for (int j = 0; j < 4; ++j) wv[j] = *(const f32x4*)(nw + 4 * F.lane + 256 * j);
    f32x4 v[2][4], vn[2][4];
#pragma unroll
    for (int q = 0; q < 2; ++q) { const int m = gw + q * NGW; const f32x4* xr = (const f32x4*)(xsrc + (size_t)(m < MTOK ? m : 0) * DM) + F.lane;
#pragma unroll
        for (int j = 0; j < 4; ++j) v[q][j] = xr[64 * j]; }
    for (int m0 = gw; m0 < MTOK; m0 += 2 * NGW) {
        f32x4 sc[2][4], sh[2][4];
#pragma unroll
        for (int q = 0; q < 2; ++q) { const int m = m0 + q * NGW; const float* mb = modl + (size_t)((m < MTOK ? m : 0) >> 12) * NADA + 4 * F.lane;
#pragma unroll
            for (int j = 0; j < 4; ++j) { sc[q][j] = *(const f32x4*)(mb + sc_off + 256 * j); sh[q][j] = *(const f32x4*)(mb + sh_off + 256 * j); } }
#pragma unroll
        for (int q = 0; q < 2; ++q) { const int m = m0 + (2 + q) * NGW; const f32x4* xr = (const f32x4*)(xsrc + (size_t)(m < MTOK ? m : 0) * DM) + F.lane;
#pragma unroll
            for (int j = 0; j < 4; ++j) vn[q][j] = xr[64 * j]; }
        float s[2];
#pragma unroll
        for (int q = 0; q < 2; ++q) { float a = 0.f;
#pragma unroll
            for (int j = 0; j < 4; ++j) a += (v[q][j].x * v[q][j].x + v[q][j].y * v[q][j].y) + (v[q][j].z * v[q][j].z + v[q][j].w * v[q][j].w);
            s[q] = a; }
#pragma unroll
        for (int o = 1; o < 64; o <<= 1) { s[0] += SHFL_XOR(s[0], o); s[1] += SHFL_XOR(s[1], o); }
#pragma unroll
        for (int q = 0; q < 2; ++q) { const int m = m0 + q * NGW; if (m >= MTOK) break;
            const float rs = RSQ(s[q] * (1.0f / DM) + NORM_EPS);
            u32x2* o8 = (u32x2*)(XN + (size_t)m * DM) + F.lane;
#pragma unroll
            for (int j = 0; j < 4; ++j) { const f32x4 y = v[q][j] * rs * wv[j] * (1.0f + sc[q][j]) + sh[q][j];
                u32x2 p; p.x = pk2(y.x, y.y); p.y = pk2(y.z, y.w); o8[64 * j] = p; } }
#pragma unroll
        for (int q = 0; q < 2; ++q)
#pragma unroll
            for (int j = 0; j < 4; ++j) v[q][j] = vn[q][j];
    }
}
DEV void ph_finalnorm(const Ctx& F, const float* xsrc, const float* nw, float* out) {
    const int gw = F.bid * 8 + F.wave, NGW = F.G * 8;
    f32x4 wv[4];
#pragma unroll
    for (int j = 0; j < 4; ++j) wv[j] = *(const f32x4*)(nw + 4 * F.lane + 256 * j);
    f32x4 v[2][4], vn[2][4];
#pragma unroll
    for (int q = 0; q < 2; ++q) { const int m = gw + q * NGW; const f32x4* xr = (const f32x4*)(xsrc + (size_t)(m < MTOK ? m : 0) * DM) + F.lane;
#pragma unroll
        for (int j = 0; j < 4; ++j) v[q][j] = xr[64 * j]; }
    for (int m0 = gw; m0 < MTOK; m0 += 2 * NGW) {
#pragma unroll
        for (int q = 0; q < 2; ++q) { const int m = m0 + (2 + q) * NGW; const f32x4* xr = (const f32x4*)(xsrc + (size_t)(m < MTOK ? m : 0) * DM) + F.lane;
#pragma unroll
            for (int j = 0; j < 4; ++j) vn[q][j] = xr[64 * j]; }
        float s[2];
#pragma unroll
        for (int q = 0; q < 2; ++q) { float a = 0.f;
#pragma unroll
            for (int j = 0; j < 4; ++j) a += (v[q][j].x * v[q][j].x + v[q][j].y * v[q][j].y) + (v[q][j].z * v[q][j].z + v[q][j].w * v[q][j].w);
            s[q] = a; }
#pragma unroll
        for (int o = 1; o < 64; o <<= 1) { s[0] += SHFL_XOR(s[0], o); s[1] += SHFL_XOR(s[1], o); }
#pragma unroll
        for (int q = 0; q < 2; ++q) { const int m = m0 + q * NGW; if (m >= MTOK) break;
            const float rs = RSQ(s[q] * (1.0f / DM) + NORM_EPS);
            f32x4* o = (f32x4*)(out + (size_t)m * DM) + F.lane;
#pragma unroll
            for (int j = 0; j < 4; ++j) o[64 * j] = v[q][j] * rs * wv[j]; }
#pragma unroll
        for (int q = 0; q < 2; ++q)
#pragma unroll
            for (int j = 0; j < 4; ++j) v[q][j] = vn[q][j];
    }
}
DEV void ph_finalnorm16(const Ctx& F, const bf16* x16, const float* nw, float* out) {
    const int gw = F.bid * 8 + F.wave, NGW = F.G * 8;
    f32x4 wv[2][2];
#pragma unroll
    for (int j = 0; j < 2; ++j) { wv[j][0] = *(const f32x4*)(nw + 8 * F.lane + 512 * j); wv[j][1] = *(const f32x4*)(nw + 8 * F.lane + 512 * j + 4); }
    u32x4 v[4][2], vn[4][2];
#pragma unroll
    for (int q = 0; q < 4; ++q) { const int m = gw + q * NGW; const bf16* xr = x16 + (size_t)(m < MTOK ? m : 0) * DM + 8 * F.lane;
        v[q][0] = *(const u32x4*)xr; v[q][1] = *(const u32x4*)(xr + 512); }
    for (int m0 = gw; m0 < MTOK; m0 += 4 * NGW) {
#pragma unroll
        for (int q = 0; q < 4; ++q) { const int m = m0 + (4 + q) * NGW; const bf16* xr = x16 + (size_t)(m < MTOK ? m : 0) * DM + 8 * F.lane;
            vn[q][0] = *(const u32x4*)xr; vn[q][1] = *(const u32x4*)(xr + 512); }
        float s[4];
#pragma unroll
        for (int q = 0; q < 4; ++q) { float a = 0.f;
#pragma unroll
            for (int j = 0; j < 2; ++j) { const u32x4 r = v[q][j];
                a += ((bflo(r.x) * bflo(r.x) + bfhi(r.x) * bfhi(r.x)) + (bflo(r.y) * bflo(r.y) + bfhi(r.y) * bfhi(r.y))) + ((bflo(r.z) * bflo(r.z) + bfhi(r.z) * bfhi(r.z)) + (bflo(r.w) * bflo(r.w) + bfhi(r.w) * bfhi(r.w))); }
            s[q] = a; }
#pragma unroll
        for (int o = 1; o < 64; o <<= 1) {
#pragma unroll
            for (int q = 0; q < 4; ++q) s[q] += SHFL_XOR(s[q], o); }
#pragma unroll
        for (int q = 0; q < 4; ++q) { const int m = m0 + q * NGW; if (m >= MTOK) break;
            const float rs = RSQ(s[q] * (1.0f / DM) + NORM_EPS);
            float* o = out + (size_t)m * DM + 8 * F.lane;
#pragma unroll
            for (int j = 0; j < 2; ++j) { const u32x4 r = v[q][j];
                *(f32x4*)(o + 512 * j) = (f32x4){bflo(r.x), bfhi(r.x), bflo(r.y), bfhi(r.y)} * rs * wv[j][0];
                *(f32x4*)(o + 512 * j + 4) = (f32x4){bflo(r.z), bfhi(r.z), bflo(r.w), bfhi(r.w)} * rs * wv[j][1]; } }
#pragma unroll
        for (int q = 0; q < 4; ++q) { v[q][0] = vn[q][0]; v[q][1] = vn[q][1]; }
    }
}
DEV void ph_zero_cat(const Ctx& F, int c0, int nq) {
    const int gw = F.bid * 8 + F.wave, NGW = F.G * 8;
    bf16* CAT = (bf16*)(F.ws + WS_CAT);
    for (int m = gw; m < MTOK; m += NGW) for (int q = 0; q < nq; ++q) *(u32x2*)(CAT + (size_t)m * DM + c0 + 256 * q + 4 * F.lane) = (u32x2){0u, 0u};
}
DEV float softcap15(float z) { return 15.0f * tanhf(z * (1.0f / 15.0f)); }
DEV float logsigmoidf_(float x) { return x >= 0.f ? -log1pf(expf(-x)) : x - log1pf(expf(x)); }
DEV void ph_prep(const Ctx& F, int l) {
    const int gw = F.bid * 8 + F.wave, NGW = F.G * 8, lane = F.lane;
    const bf16* PROJ = (const bf16*)(F.ws + WS_PROJ);
    bf16* QL = (bf16*)(F.ws + WS_QL); bf16* CKV = (bf16*)(F.ws + WS_CKV); bf16* KIDX = (bf16*)(F.ws + WS_KIDX);
    float* WI = (float*)(F.ws + WS_WI);
    const f32x4 qn = *(const f32x4*)(PIN(F, I_QNW) + l * 256 + 4 * lane);
    const float kn0 = PIN(F, I_KVNW)[l * 128 + 2 * lane], kn1 = PIN(F, I_KVNW)[l * 128 + 2 * lane + 1];
    u32x2 ra4[4], ran[4]; unsigned rk4[4], rx4[4], rkn[4], rxn[4];
#define PREP_LOAD(RA, RK, RX, M0) do { _Pragma("unroll") for (int q = 0; q < 4; ++q) { const int mm = (M0) + q * NGW; const bf16* pr = PROJ + (size_t)(mm < MTOK ? mm : 0) * NPROJ; \
            RA[q] = *(const u32x2*)(pr + PC_AQ + 4 * lane); RK[q] = *(const unsigned*)(pr + PC_AKV + 2 * lane); \
            RX[q] = lane < 16 ? *(const unsigned*)(pr + PC_IK + 2 * lane) : (lane < 24 ? (unsigned)pr[PC_IW + (lane - 16)] : 0u); } } while (0)
    PREP_LOAD(ra4, rk4, rx4, gw);
    for (int m0 = gw; m0 < MTOK; m0 += 4 * NGW) {
        PREP_LOAD(ran, rkn, rxn, m0 + 4 * NGW);
#pragma unroll
        for (int q = 0; q < 4; ++q) { const int m = m0 + q * NGW; if (m >= MTOK) break;
            const u32x2 ra = ra4[q]; const unsigned rk = rk4[q];
            const float a0 = bflo(ra.x), a1 = bfhi(ra.x), a2 = bflo(ra.y), a3 = bfhi(ra.y);
            const float k0 = bflo(rk), k1 = bfhi(rk);
            const float sq = wave_sum((a0 * a0 + a1 * a1) + (a2 * a2 + a3 * a3)), sk = wave_sum(k0 * k0 + k1 * k1);
            const float rq = RSQ(sq * (1.0f / 256.0f) + NORM_EPS), rk2 = RSQ(sk * (1.0f / 128.0f) + NORM_EPS);
            u32x2 oq; oq.x = pk2(a0 * rq * qn.x, a1 * rq * qn.y); oq.y = pk2(a2 * rq * qn.z, a3 * rq * qn.w);
            *(u32x2*)(QL + (size_t)m * 256 + 4 * lane) = oq;
            *(unsigned*)(CKV + (size_t)m * 128 + 2 * lane) = pk2(k0 * rk2 * kn0, k1 * rk2 * kn1);
            if (lane < 16) *(unsigned*)(KIDX + (size_t)m * 32 + 2 * lane) = rx4[q];
            else if (lane < 24) WI[(size_t)m * 8 + (lane - 16)] = bf2f(rx4[q]); }
#pragma unroll
        for (int q = 0; q < 4; ++q) { ra4[q] = ran[q]; rk4[q] = rkn[q]; rx4[q] = rxn[q]; }
    }
#undef PREP_LOAD
}

constexpr int XB_STRIDE = 264;
DEV void ph_lru1(const Ctx& F, int l) {
    const int tid = F.tid, lane = F.lane, w = F.wave, i16 = lane & 15, g = lane >> 4;
    bf16* XB = (bf16*)F.lds;
    float* XF = (float*)(F.lds + 64 * XB_STRIDE * 2);
    const bf16* PROJ = (const bf16*)(F.ws + WS_PROJ);
    bf16* HLOC = (bf16*)(F.ws + WS_HLOC); bf16* CPA = (bf16*)(F.ws + WS_CPA); float* LSUM = (float*)(F.ws + WS_LSUM);
    const int blk = w & 3, nh = w >> 2;
    const bf16* WG = (const bf16*)(F.ws + WS_WG) + (size_t)l * 2 * 4 * 4096;
    bf16x8 Bf[2][2][2];
#pragma unroll
    for (int gg = 0; gg < 2; ++gg)
#pragma unroll
        for (int nt = 0; nt < 2; ++nt)
#pragma unroll
            for (int ks = 0; ks < 2; ++ks) Bf[gg][nt][ks] = *(const bf16x8*)(WG + ((size_t)(gg * 4 + blk) * 64 + nh * 32 + 2 * i16 + nt) * 64 + ks * 32 + 8 * g);
    float ba[2], bx[2], sp[2];
#pragma unroll
    for (int nt = 0; nt < 2; ++nt) { const int ch = blk * 64 + nh * 32 + 2 * i16 + nt;
        ba[nt] = PIN(F, I_BA)[l * 256 + ch]; bx[nt] = PIN(F, I_BX)[l * 256 + ch];
        const float lam = PIN(F, I_LAM)[l * 256 + ch]; sp[nt] = lam > 0.f ? log1pf(expf(-lam)) : -lam + log1pf(expf(lam)); }
    const int ch2 = tid & 127, tg = tid >> 7;
    float cw[4][2], cb[2];
#pragma unroll
    for (int j = 0; j < 4; ++j) { cw[j][0] = PIN(F, I_CONVW)[(l * 4 + j) * 256 + 2 * ch2]; cw[j][1] = PIN(F, I_CONVW)[(l * 4 + j) * 256 + 2 * ch2 + 1]; }
    cb[0] = PIN(F, I_CONVB)[l * 256 + 2 * ch2]; cb[1] = PIN(F, I_CONVB)[l * 256 + 2 * ch2 + 1];

    for (int u = F.bid; u < BATCH * 64; u += F.G) {
        const int b = u >> 6, c = u & 63, t0 = c * 64; const size_t m0 = (size_t)b * SEQ + t0;
        {
            const int tl0 = tg * 16;
            unsigned rv[19];
#pragma unroll
            for (int j = 0; j < 3; ++j) { const int t = t0 + tl0 - 3 + j; rv[j] = t >= 0 ? *(const unsigned*)(PROJ + ((size_t)b * SEQ + t) * NPROJ + PC_LX + 2 * ch2) : 0u; }
#pragma unroll
            for (int tt = 0; tt < 16; ++tt) rv[3 + tt] = *(const unsigned*)(PROJ + (m0 + tl0 + tt) * NPROJ + PC_LX + 2 * ch2);
#pragma unroll
            for (int tt = 0; tt < 16; ++tt) { const int tl = tl0 + tt;
                const float x0 = cw[0][0] * bflo(rv[tt]) + cw[1][0] * bflo(rv[tt + 1]) + cw[2][0] * bflo(rv[tt + 2]) + cw[3][0] * bflo(rv[tt + 3]) + cb[0];
                const float x1 = cw[0][1] * bfhi(rv[tt]) + cw[1][1] * bfhi(rv[tt + 1]) + cw[2][1] * bfhi(rv[tt + 2]) + cw[3][1] * bfhi(rv[tt + 3]) + cb[1];
                *(unsigned*)(XB + tl * XB_STRIDE + 2 * ch2) = pk2(x0, x1);
                XF[tl * 256 + 2 * ch2] = x0; XF[tl * 256 + 2 * ch2 + 1] = x1; }
        }
        SYNC();
        float CA[2] = {1.f, 1.f}, CU[2] = {0.f, 0.f};
#pragma unroll 1
        for (int m = 0; m < 4; ++m) {
            f32x4 acc[2][2];
#pragma unroll
            for (int gg = 0; gg < 2; ++gg)
#pragma unroll
                for (int nt = 0; nt < 2; ++nt) acc[gg][nt] = (f32x4){0.f, 0.f, 0.f, 0.f};
#pragma unroll
            for (int ks = 0; ks < 2; ++ks) { const bf16x8 A = *(const bf16x8*)(XB + (m * 16 + i16) * XB_STRIDE + blk * 64 + ks * 32 + 8 * g);
#pragma unroll
                for (int gg = 0; gg < 2; ++gg)
#pragma unroll
                    for (int nt = 0; nt < 2; ++nt) acc[gg][nt] = MFMA16(A, Bf[gg][nt][ks], acc[gg][nt]); }
            float HL[2][4], CP[2][4];
            const int chb = blk * 64 + nh * 32 + 2 * i16;
            float xf[4][2];
#pragma unroll
            for (int r = 0; r < 4; ++r) { const float* xp = XF + (m * 16 + 4 * g + r) * 256 + chb; xf[r][0] = xp[0]; xf[r][1] = xp[1]; }
#pragma unroll
            for (int nt = 0; nt < 2; ++nt) {
                float P[4], H[4]; float pa = 1.f, hu = 0.f;
#pragma unroll
                for (int r = 0; r < 4; ++r) {
                    const float rg = fsigmoid(acc[0][nt][r] + ba[nt]), gi = fsigmoid(acc[1][nt][r] + bx[nt]);
                    const float la = -8.0f * rg * sp[nt], a = FEXP(la), uu = FSQRT((1.0f - a) * (1.0f + a)) * (gi * xf[r][nt]);
                    pa = a * pa; hu = a * hu + uu; P[r] = pa; H[r] = hu;
                    }
                float EA = 1.f, EU = 0.f, TA = 1.f, TU = 0.f;
#pragma unroll
                for (int gg = 0; gg < 4; ++gg) { const float ta = SHFL(pa, i16 + 16 * gg), tu = SHFL(hu, i16 + 16 * gg);
                    if (gg < g) { EU = ta * EU + tu; EA = ta * EA; }
                    TU = ta * TU + tu; TA = ta * TA; }
                const float XA = EA * CA[nt], XU = EA * CU[nt] + EU;
#pragma unroll
                for (int r = 0; r < 4; ++r) { HL[nt][r] = P[r] * XU + H[r]; CP[nt][r] = P[r] * XA; }
                CU[nt] = TA * CU[nt] + TU; CA[nt] = TA * CA[nt];
            }
#pragma unroll
            for (int r = 0; r < 4; ++r) { const size_t o = (m0 + m * 16 + 4 * g + r) * 256 + chb;
                *(unsigned*)(HLOC + o) = pk2(HL[0][r], HL[1][r]); *(unsigned*)(CPA + o) = pk2(CP[0][r], CP[1][r]); }
        }
        if (g == 0) {
#pragma unroll
            for (int nt = 0; nt < 2; ++nt) { const int ch = blk * 64 + nh * 32 + 2 * i16 + nt;
                LSUM[((size_t)b * 64 + c) * 256 + ch] = CA[nt]; LSUM[(size_t)BATCH * 64 * 256 + ((size_t)b * 64 + c) * 256 + ch] = CU[nt]; }
        }
        SYNC();
    }
}

DEV float gelu_tanh(float x) { const float z = 0.7978845608028654f * (x + 0.044715f * x * x * x); return x * FRCP(1.0f + FEXP(-2.0f * z)); }
DEV void ph_carry(const Ctx& F) {
    if (F.wave != 0) return;
    const float* LSUM = (const float*)(F.ws + WS_LSUM); float* CARRY = (float*)(F.ws + WS_CARRY);
    const int seg = F.lane & 3;
    for (int chain = F.bid * 16 + (F.lane >> 2); chain < BATCH * 256; chain += F.G * 16) {
        const int b = chain >> 8, ch = chain & 255; const size_t o0 = ((size_t)b * 64 + seg * 16) * 256 + ch;
        float a[16], hb[16];
#pragma unroll
        for (int i = 0; i < 16; ++i) { a[i] = LSUM[o0 + (size_t)i * 256]; hb[i] = LSUM[(size_t)BATCH * 64 * 256 + o0 + (size_t)i * 256]; }
        float hp[16], ap[16], hl = 0.f, al = 1.f;
#pragma unroll
        for (int i = 0; i < 16; ++i) { hp[i] = hl; ap[i] = al; hl = a[i] * hl + hb[i]; al = a[i] * al; }
        float cin = 0.f;
#pragma unroll
        for (int s2 = 0; s2 < 3; ++s2) { const float as = SHFL(al, (F.lane & ~3) + s2), hs = SHFL(hl, (F.lane & ~3) + s2); if (s2 < seg) cin = as * cin + hs; }
#pragma unroll
        for (int i = 0; i < 16; ++i) CARRY[o0 + (size_t)i * 256] = ap[i] * cin + hp[i];
    }
}
DEV void ph_lru2(const Ctx& F, int l) {
    const int tid = F.tid, lane = F.lane, w = F.wave;
    const bf16* PROJ = (const bf16*)(F.ws + WS_PROJ); const bf16* HLOC = (const bf16*)(F.ws + WS_HLOC); const bf16* CPA = (const bf16*)(F.ws + WS_CPA);
    const float* CARRY = (const float*)(F.ws + WS_CARRY); bf16* CAT = (bf16*)(F.ws + WS_CAT);
    const f32x4 gw4 = *(const f32x4*)(PIN(F, I_GNW) + l * DM + 4 * lane);
    for (int u = F.bid; u < BATCH * 64; u += F.G) {
        const int b = u >> 6, c = u & 63; const size_t m0 = (size_t)b * SEQ + c * 64;
        const f32x4 car = *(const f32x4*)(CARRY + (size_t)u * 256 + 4 * lane);
        u32x2 hl8[8], cp8[8], ly8[8];
#pragma unroll
        for (int tt = 0; tt < 8; ++tt) { const size_t m = m0 + w * 8 + tt;
            hl8[tt] = *(const u32x2*)(HLOC + m * 256 + 4 * lane); cp8[tt] = *(const u32x2*)(CPA + m * 256 + 4 * lane); ly8[tt] = *(const u32x2*)(PROJ + m * NPROJ + PC_LY + 4 * lane); }
#pragma unroll
        for (int tt = 0; tt < 8; ++tt) { const size_t m = m0 + w * 8 + tt; const u32x2 hl = hl8[tt], cp = cp8[tt], ly = ly8[tt];
            float v0 = (bflo(hl.x) + bflo(cp.x) * car.x) * gelu_tanh(bflo(ly.x));
            float v1 = (bfhi(hl.x) + bfhi(cp.x) * car.y) * gelu_tanh(bfhi(ly.x));
            float v2 = (bflo(hl.y) + bflo(cp.y) * car.z) * gelu_tanh(bflo(ly.y));
            float v3 = (bfhi(hl.y) + bfhi(cp.y) * car.w) * gelu_tanh(bfhi(ly.y));
            const float rs = RSQ(wave_sum((v0 * v0 + v1 * v1) + (v2 * v2 + v3 * v3)) * (1.0f / 256.0f) + NORM_EPS);
            u32x2 o; o.x = pk2(v0 * rs * gw4.x, v1 * rs * gw4.y); o.y = pk2(v2 * rs * gw4.z, v3 * rs * gw4.w);
            *(u32x2*)(CAT + m * DM + 4 * lane) = o; }
    }
}

constexpr int QS_STRIDE = 136, VE_STRIDE = 56;
DEV void ph_mlstm(const Ctx& F, int l) {
    const int tid = F.tid, lane = F.lane, w = F.wave, i16 = lane & 15, g = lane >> 4;
    bf16* QsB = (bf16*)F.lds;
    bf16* KsB = QsB + 2 * 64 * QS_STRIDE;
    bf16* VE = KsB + 2 * 64 * QS_STRIDE;
    bf16* VW = VE + 64 * VE_STRIDE;
    bf16* CsB = VW + 64 * VE_STRIDE;
    float* BCB = (float*)(CsB + 2 * 128 * VE_STRIDE);
    float* BIB = BCB + 128;
    const bf16* PROJ = (const bf16*)(F.ws + WS_PROJ); bf16* HM = (bf16*)(F.ws + WS_HM);
    const float qscale = 0.08838834764831845f;
    const int half = w >> 2, jt = half ? 3 - (w & 3) : (w & 3);
    for (int u = F.bid; u < BATCH * 4 * 4; u += F.G) {
        const int b = u >> 4, h = (u >> 2) & 3, vs = u & 3;
        const float gbi = PIN(F, I_BI)[l * 4 + h], gbf = PIN(F, I_BF)[l * 4 + h];
        f32x4 accC[3];
#pragma unroll
        for (int nt = 0; nt < 3; ++nt) accC[nt] = (f32x4){0.f, 0.f, 0.f, 0.f};
        float* BCg = (float*)(F.ws + WS_MG) + (size_t)u * 8192; float* BIg = BCg + 4096;
        unsigned gri[8], grf[8];
#pragma unroll
        for (int k = 0; k < 8; ++k) { const bf16* pr = PROJ + ((size_t)b * SEQ + (8 * k + w) * 64 + lane) * NPROJ; gri[k] = pr[PC_MI + h]; grf[k] = pr[PC_MF + h]; }
#pragma unroll
        for (int k = 0; k < 8; ++k) { const int tok = (8 * k + w) * 64 + lane;
            const float zi = (bf2f(gri[k]) + gbi) * (1.0f / 15.0f), zf = (bf2f(grf[k]) + gbf) * (1.0f / 15.0f);
            const float ig = 15.0f - 30.0f * FRCP(FEXP(2.0f * zi) + 1.0f), fg = 15.0f - 30.0f * FRCP(FEXP(2.0f * zf) + 1.0f);
            float s = -FLOG(1.0f + FEXP(-fg));
#pragma unroll
            for (int o = 1; o < 64; o <<= 1) { const float t = SHFL_UP(s, o); if (lane >= o) s += t; }
            BCg[tok] = s; BIg[tok] = s - ig; }
        SYNC();
        u32x4 rq[2], rk[2]; u32x2 rvv; float rgc = 0.f, rgb = 0.f;
        {
            const size_t m0 = (size_t)b * SEQ;
#pragma unroll
            for (int i = 0; i < 2; ++i) { const int idx = tid + 512 * i, row = idx >> 4, ck = idx & 15;
                rq[i] = *(const u32x4*)(PROJ + (m0 + row) * NPROJ + PC_MQ + h * 128 + 8 * ck); rk[i] = *(const u32x4*)(PROJ + (m0 + row) * NPROJ + PC_MK + h * 128 + 8 * ck); }
            rvv = *(const u32x2*)(PROJ + (m0 + (tid >> 3)) * NPROJ + PC_MV + h * 128 + vs * 32 + 4 * (tid & 7));
            if (tid < 64) { rgc = BCg[tid]; rgb = BIg[tid]; }
        }
        for (int c = 0; c < 64; ++c) {
            const size_t m0 = (size_t)b * SEQ + c * 64; const int buf = c & 1;
            bf16* Qs = QsB + buf * 64 * QS_STRIDE; bf16* Ks = KsB + buf * 64 * QS_STRIDE; const bf16* Cs = CsB + buf * 128 * VE_STRIDE; bf16* Cn = CsB + (buf ^ 1) * 128 * VE_STRIDE;
            float* BC = BCB + buf * 64; float* BI = BIB + buf * 64;
#pragma unroll
            for (int i = 0; i < 2; ++i) { const int idx = tid + 512 * i, row = idx >> 4, ck = idx & 15;
                *(u32x4*)(Qs + row * QS_STRIDE + 8 * ck) = rq[i]; *(u32x4*)(Ks + row * QS_STRIDE + 8 * ck) = rk[i]; }
            if (tid < 64) { BC[tid] = rgc; BI[tid] = rgb; }
            SYNC();
            {
                const int row = tid >> 3, cg = tid & 7;
                const u32x2 rv = rvv;
                const float wt = FEXP(BC[63] - BI[row]);
                *(u32x2*)(VE + row * VE_STRIDE + 4 * cg) = rv;
                u32x2 sv; sv.x = pk2(bflo(rv.x) * wt, bfhi(rv.x) * wt); sv.y = pk2(bflo(rv.y) * wt, bfhi(rv.y) * wt);
                *(u32x2*)(VW + row * VE_STRIDE + 4 * cg) = sv;
                if (cg == 0) { unsigned one_ = 0x3f80u; LAUNDER_V(one_); u32x4 z = (u32x4){one_, 0u, 0u, 0u}; *(u32x4*)(VE + row * VE_STRIDE + 32) = z; *(u32x4*)(VE + row * VE_STRIDE + 40) = (u32x4){0u, 0u, 0u, 0u};
                    z.x = f2bf(wt); *(u32x4*)(VW + row * VE_STRIDE + 32) = z; *(u32x4*)(VW + row * VE_STRIDE + 40) = (u32x4){0u, 0u, 0u, 0u}; }
            }
            if (c + 1 < 64) {
                const size_t m1 = m0 + 64;
#pragma unroll
                for (int i = 0; i < 2; ++i) { const int idx = tid + 512 * i, row = idx >> 4, ck = idx & 15;
                    rq[i] = *(const u32x4*)(PROJ + (m1 + row) * NPROJ + PC_MQ + h * 128 + 8 * ck); rk[i] = *(const u32x4*)(PROJ + (m1 + row) * NPROJ + PC_MK + h * 128 + 8 * ck); }
                rvv = *(const u32x2*)(PROJ + (m1 + (tid >> 3)) * NPROJ + PC_MV + h * 128 + vs * 32 + 4 * (tid & 7));
                if (tid < 64) { rgc = BCg[(c + 1) * 64 + tid]; rgb = BIg[(c + 1) * 64 + tid]; }
            }
            SYNC();
            f32x4 Z[2] = {(f32x4){0.f, 0.f, 0.f, 0.f}, (f32x4){0.f, 0.f, 0.f, 0.f}};
            {
                bf16x8 Bq[4];
#pragma unroll
                for (int ks = 0; ks < 4; ++ks) Bq[ks] = *(const bf16x8*)(Qs + (16 * jt + i16) * QS_STRIDE + 32 * ks + 8 * g);
                const float bj = BC[16 * jt + i16];
                unsigned pk[4][2];
#pragma unroll
                for (int tt = 0; tt < 4; ++tt) {
                    if (tt <= jt) {
                        f32x4 X = (f32x4){0.f, 0.f, 0.f, 0.f};
                        bf16x8 Ak[4];
#pragma unroll
                        for (int ks = 0; ks < 4; ++ks) Ak[ks] = *(const bf16x8*)(Ks + (16 * tt + i16) * QS_STRIDE + 32 * ks + 8 * g);
                        KEEP4(Ak[0], Ak[1], Ak[2], Ak[3]);
#pragma unroll
                        for (int ks = 0; ks < 4; ++ks) X = MFMA16(Ak[ks], Bq[ks], X);
                        float p[4]; const f32x4 bi4 = *(const f32x4*)(BI + 16 * tt + 4 * g);
#pragma unroll
                        for (int r = 0; r < 4; ++r) { const float pv = X[r] * qscale * FEXP(fminf(bj - bi4[r], 60.0f));
                            p[r] = (tt < jt || 4 * g + r <= i16) ? pv : 0.f; }
                        pk[tt][0] = pk2(p[0], p[1]); pk[tt][1] = pk2(p[2], p[3]);
                    } else { pk[tt][0] = 0u; pk[tt][1] = 0u; }
                }
#pragma unroll
                for (int pr = 0; pr < 2; ++pr) {
                    if (2 * pr <= jt) {
                        u32x4 aw = (u32x4){pk[2 * pr][0], pk[2 * pr][1], pk[2 * pr + 1][0], pk[2 * pr + 1][1]};
                        const bf16x8 A = __builtin_bit_cast(bf16x8, aw);
#pragma unroll
                        for (int n = 0; n < 2; ++n) { const int ntc = n ? 2 : half;
                            const s16x4 lo = TR16(VE + (32 * pr + 4 * g + (i16 >> 2)) * VE_STRIDE + 16 * ntc + 4 * (i16 & 3));
                            const s16x4 hi = TR16(VE + (32 * pr + 16 + 4 * g + (i16 >> 2)) * VE_STRIDE + 16 * ntc + 4 * (i16 & 3));
                            const bf16x8 B = (bf16x8){lo[0], lo[1], lo[2], lo[3], hi[0], hi[1], hi[2], hi[3]};
                            Z[n] = MFMA16(A, B, Z[n]); }
#ifndef HOST_EMU
                        asm volatile("" :: "v"(aw));
#endif
                    }
                }
            }
            if (c > 0) {
                f32x4 Z2[2] = {(f32x4){0.f, 0.f, 0.f, 0.f}, (f32x4){0.f, 0.f, 0.f, 0.f}};
#pragma unroll
                for (int kh = 0; kh < 2; ++kh) {
                    bf16x8 Aq[2], Bc[2][2];
#pragma unroll
                    for (int k2 = 0; k2 < 2; ++k2) { const int ks = 2 * kh + k2; Aq[k2] = *(const bf16x8*)(Qs + (16 * jt + i16) * QS_STRIDE + 32 * ks + 8 * g);
#pragma unroll
                        for (int n = 0; n < 2; ++n) { const int ntc = n ? 2 : half;
                            const s16x4 lo = TR16(Cs + (32 * ks + 8 * g + (i16 >> 2)) * VE_STRIDE + 16 * ntc + 4 * (i16 & 3));
                            const s16x4 hi = TR16(Cs + (32 * ks + 8 * g + 4 + (i16 >> 2)) * VE_STRIDE + 16 * ntc + 4 * (i16 & 3));
                            Bc[k2][n] = (bf16x8){lo[0], lo[1], lo[2], lo[3], hi[0], hi[1], hi[2], hi[3]}; } }
                    KEEP4(Bc[0][0], Bc[0][1], Bc[1][0], Bc[1][1]);
#pragma unroll
                    for (int k2 = 0; k2 < 2; ++k2)
#pragma unroll
                        for (int n = 0; n < 2; ++n) Z2[n] = MFMA16(Aq[k2], Bc[k2][n], Z2[n]); }
                const f32x4 bc4 = *(const f32x4*)(BC + 16 * jt + 4 * g);
#pragma unroll
                for (int r = 0; r < 4; ++r) { const float f = qscale * FEXP(bc4[r]); Z[0][r] += f * Z2[0][r]; Z[1][r] += f * Z2[1][r]; }
            }
#pragma unroll
            for (int r = 0; r < 4; ++r) { const int j = 16 * jt + 4 * g + r; const float dn = FRCP(fmaxf(fabsf(SHFL(Z[1][r], lane & 48)), 1.0f));
                HM[(m0 + j) * 512 + h * 128 + vs * 32 + 16 * half + i16] = (bf16)f2bf(Z[0][r] * dn); }
            {
                const float dec = FEXP(BC[63]);
#pragma unroll
                for (int nt = 0; nt < 3; ++nt) accC[nt] = accC[nt] * dec;
#pragma unroll
                for (int ks = 0; ks < 2; ++ks) {
                    const s16x4 alo = TR16(Ks + (32 * ks + 8 * g + (i16 >> 2)) * QS_STRIDE + 16 * w + 4 * (i16 & 3));
                    const s16x4 ahi = TR16(Ks + (32 * ks + 8 * g + 4 + (i16 >> 2)) * QS_STRIDE + 16 * w + 4 * (i16 & 3));
                    const bf16x8 A = (bf16x8){alo[0], alo[1], alo[2], alo[3], ahi[0], ahi[1], ahi[2], ahi[3]};
                    bf16x8 Bv[3];
#pragma unroll
                    for (int nt = 0; nt < 3; ++nt) {
                        const s16x4 lo = TR16(VW + (32 * ks + 8 * g + (i16 >> 2)) * VE_STRIDE + 16 * nt + 4 * (i16 & 3));
                        const s16x4 hi = TR16(VW + (32 * ks + 8 * g + 4 + (i16 >> 2)) * VE_STRIDE + 16 * nt + 4 * (i16 & 3));
                        Bv[nt] = (bf16x8){lo[0], lo[1], lo[2], lo[3], hi[0], hi[1], hi[2], hi[3]}; }
                    KEEP4(A, Bv[0], Bv[1], Bv[2]);
#pragma unroll
                    for (int nt = 0; nt < 3; ++nt) { const bf16x8 B = Bv[nt];
                        const f32x4 cold = accC[nt]; accC[nt] = MFMA16(A, B, cold);
#ifndef HOST_EMU
                        asm volatile("" :: "v"(cold), "v"(A), "v"(B));
#endif
                    }
                }
#pragma unroll
                for (int nt = 0; nt < 3; ++nt)
#pragma unroll
                    for (int r = 0; r < 4; ++r) Cn[(16 * w + 4 * g + r) * VE_STRIDE + 16 * nt + i16] = (bf16)f2bf(accC[nt][r]);
            }
        }
        SYNC();
    }
}

DEV void ph_mfin(const Ctx& F, int l) {
    const int gw = F.bid * 8 + F.wave, NGW = F.G * 8, lane = F.lane;
    const bf16* PROJ = (const bf16*)(F.ws + WS_PROJ); const bf16* HM = (const bf16*)(F.ws + WS_HM); bf16* CAT = (bf16*)(F.ws + WS_CAT);
    float gm[8];
#pragma unroll
    for (int j = 0; j < 8; ++j) gm[j] = PIN(F, I_GNW)[l * DM + 256 + 8 * lane + j];
    u32x4 hv4[4], ov4[4], hvn[4], ovn[4];
#define MFIN_LOAD(HV, OV, M0) do { _Pragma("unroll") for (int q = 0; q < 4; ++q) { const int mm = (M0) + q * NGW; const size_t ms = (size_t)(mm < MTOK ? mm : 0); \
            HV[q] = *(const u32x4*)(HM + ms * 512 + 8 * lane); OV[q] = *(const u32x4*)(PROJ + ms * NPROJ + PC_MO + 8 * lane); } } while (0)
    MFIN_LOAD(hv4, ov4, gw);
    for (int m0 = gw; m0 < MTOK; m0 += 4 * NGW) {
        MFIN_LOAD(hvn, ovn, m0 + 4 * NGW);
#pragma unroll
        for (int q = 0; q < 4; ++q) { const int m = m0 + q * NGW; if (m >= MTOK) break;
            const u32x4 hv = hv4[q], ov = ov4[q];
            float v[8] = {bflo(hv.x), bfhi(hv.x), bflo(hv.y), bfhi(hv.y), bflo(hv.z), bfhi(hv.z), bflo(hv.w), bfhi(hv.w)};
            const float o[8] = {bflo(ov.x), bfhi(ov.x), bflo(ov.y), bfhi(ov.y), bflo(ov.z), bfhi(ov.z), bflo(ov.w), bfhi(ov.w)};
            float s = 0.f;
#pragma unroll
            for (int j = 0; j < 8; ++j) s += v[j] * v[j];
            s += SHFL_XOR(s, 1); s += SHFL_XOR(s, 2); s += SHFL_XOR(s, 4); s += SHFL_XOR(s, 8);
            const float rs = RSQ(s * (1.0f / 128.0f) + NORM_EPS);
            u32x4 r;
            r.x = pk2(v[0] * rs * gm[0] * fsigmoid(o[0]), v[1] * rs * gm[1] * fsigmoid(o[1]));
            r.y = pk2(v[2] * rs * gm[2] * fsigmoid(o[2]), v[3] * rs * gm[3] * fsigmoid(o[3]));
            r.z = pk2(v[4] * rs * gm[4] * fsigmoid(o[4]), v[5] * rs * gm[5] * fsigmoid(o[5]));
            r.w = pk2(v[6] * rs * gm[6] * fsigmoid(o[6]), v[7] * rs * gm[7] * fsigmoid(o[7]));
            *(u32x4*)(CAT + (size_t)m * DM + 256 + 8 * lane) = r; }
#pragma unroll
        for (int q = 0; q < 4; ++q) { hv4[q] = hvn[q]; ov4[q] = ovn[q]; }
    }
#undef MFIN_LOAD
}

constexpr int DS_HIST = 0;
constexpr int DS_MASK = 49152;
constexpr int DS_CAND = 65536;
constexpr int DS_SELL = 102400;
constexpr int DS_META = 118784;
constexpr int DS_RB = DS_META + 512;
constexpr int DS_SS = DS_RB + 2048;
constexpr int DS_SLOT = 12800;
constexpr int NBIN = 768, CAND_CAP = 128;
__device__ const unsigned char T5B[114] = {0, 1, 2, 3, 4, 5, 6, 7, 8, 9, 10, 11, 12, 13, 14, 15, 16, 16, 16, 17, 17, 18, 18, 18, 19, 19, 19, 20, 20, 20, 20, 21, 21, 21, 21, 22, 22, 22, 22, 22, 23, 23, 23, 23, 23, 23, 24, 24, 24, 24, 24, 24, 25, 25, 25, 25, 25, 25, 25, 26, 26, 26, 26, 26, 26, 26, 26, 27, 27, 27, 27, 27, 27, 27, 27, 27, 27, 28, 28, 28, 28, 28, 28, 28, 28, 28, 28, 29, 29, 29, 29, 29, 29, 29, 29, 29, 29, 29, 29, 30, 30, 30, 30, 30, 30, 30, 30, 30, 30, 30, 30, 30, 30, 31};

DEV int score_bin(float sc) {
    const unsigned u = __builtin_bit_cast(unsigned, sc);
    int e = (int)((u >> 18) & 0x1FFFu) - 119 * 32; e = e < 0 ? 0 : (e > 383 ? 383 : e);
    return (u >> 31) ? 383 - e : 384 + e;
}
DEV unsigned score_key(float sc) { const unsigned u = __builtin_bit_cast(unsigned, sc); return (u >> 31) ? ~u : (u | 0x80000000u); }
DEV unsigned score_code(float sc) {
    const unsigned u = __builtin_bit_cast(unsigned, sc);
    int e = (int)((u >> 18) & 0x1FFFu) - 119 * 32; e = e < 0 ? 0 : (e > 383 ? 383 : e);
    return ((u >> 16) & 0x8000u) | ((unsigned)e << 6) | ((u >> 12) & 63u);
}
DEV int code_bin(unsigned c) { const int e = (int)((c >> 6) & 0x1FFu); return (c & 0x8000u) ? 383 - e : 384 + e; }
DEV unsigned code_key(unsigned c) { return (c & 0x8000u) ? 63u - (c & 63u) : (c & 63u); }


DEV f32x4 dsa_score_tile(const bf16x8 A, const bf16x8 (&QS)[2], const bf16x8 (&Bq)[8], const float (&wq)[8]) {
    f32x4 sc = (f32x4){0.f, 0.f, 0.f, 0.f};
#pragma unroll
    for (int h = 0; h < 8; ++h) { const f32x4 d = MFMA16(A, Bq[h], (f32x4){0.f, 0.f, 0.f, 0.f});
#pragma unroll
        for (int r = 0; r < 4; ++r) sc[r] += wq[h] * RELU(d[r]); }
    return sc;
}
DEV void ph_dsa(const Ctx& F, int l) {
    const int tid = F.tid, lane = F.lane, w = F.wave, i16 = lane & 15, g = lane >> 4;
    unsigned* HIST = (unsigned*)(F.lds + DS_HIST); unsigned* MASK = (unsigned*)(F.lds + DS_MASK); u32x2* CAND = (u32x2*)(F.lds + DS_CAND);
    unsigned short* SELL = (unsigned short*)(F.lds + DS_SELL); int* BST = (int*)(F.lds + DS_META); int* NAB = BST + 32; int* NCAND = BST + 64; int* NSEL = BST + 96;
    float* RB = (float*)(F.lds + DS_RB);
    const bf16* QIDX = (const bf16*)(F.ws + WS_QIDX); const bf16* KIDX = (const bf16*)(F.ws + WS_KIDX); const float* WI = (const float*)(F.ws + WS_WI);
    const bf16* QABS = (const bf16*)(F.ws + WS_QABS); const bf16* CKV = (const bf16*)(F.ws + WS_CKV); bf16* CAT = (bf16*)(F.ws + WS_CAT);
    const bf16* WUVT = (const bf16*)(F.ws + WS_WUVT) + (size_t)l * 4 * 64 * 128; float* SS = (float*)(F.lds + DS_SS);
    for (int e = tid; e < 114 * 4; e += 512) RB[e] = PIN(F, I_RELB)[T5B[e >> 2] * 4 + (e & 3)] * 1.4426950408889634f;
    SYNC();
    for (int ui = F.bid; ui < BATCH * 128; ui += F.G) {
        int b, qt; { const int wv = ui & 255, k = ui >> 8, r = wv & 15; b = wv >> 4; qt = (k & 1) ? (32 * (k >> 1) + 31 - r) : (32 * (k >> 1) + r); }
        const int t0 = 32 * qt, nkt = 2 * qt + 2; const size_t mb = (size_t)b * SEQ;
        const GAS char* const ckvb = UNIP(CKV + mb * 128);
        const int nt = w & 1;
        u32x2* sw = (u32x2*)(F.ws + (F.bid < 128 ? WS_QL + (size_t)F.bid * 262144 : WS_SCR2 + (size_t)(F.bid - 128) * 262144) + (size_t)w * 32768) + lane;
        bf16x8 Bq[8]; float wq[8];
        { const size_t mq = mb + t0 + 16 * nt + i16;
#pragma unroll
            for (int h = 0; h < 8; ++h) { Bq[h] = *(const bf16x8*)(QIDX + mq * 256 + 32 * h + 8 * g); wq[h] = WI[mq * 8 + h]; } }
        bf16x8 QS[2];
#pragma unroll
        for (int j = 0; j < 8; ++j) { float s = 0.f;
#pragma unroll
            for (int h = 0; h < 8; ++h) s += wq[h] * bf2f((unsigned)(unsigned short)Bq[h][j]);
            const unsigned hi = f2bf(s); QS[0][j] = (short)hi; QS[1][j] = (short)f2bf(s - bf2f(hi)); }
        for (int e = tid; e < 16 * NBIN; e += 512) HIST[e] = 0u;
        for (int e = tid; e < 32 * 128; e += 512) MASK[e] = 0u;
        if (tid < 32) NCAND[tid] = 0;
        SYNC();
        bf16x8 Apre = *(const bf16x8*)(KIDX + (mb + 16 * (w >> 1) + i16) * 32 + 8 * g);
        for (int kt = w >> 1; kt < nkt; kt += 4) {
            const bf16x8 A = Apre;
            { const int kn = kt + 4 < nkt ? kt + 4 : kt; Apre = *(const bf16x8*)(KIDX + (mb + 16 * kn + i16) * 32 + 8 * g); }
            const f32x4 sc = dsa_score_tile(A, QS, Bq, wq);
            unsigned cd[4];
#pragma unroll
            for (int r = 0; r < 4; ++r) cd[r] = score_code(sc[r] + 0.0f);
            { u32x2 pk; pk.x = cd[0] | (cd[1] << 16); pk.y = cd[2] | (cd[3] << 16); sw[(size_t)((kt - (w >> 1)) >> 2) * 64] = pk; }
            const unsigned inc = nt ? 65536u : 1u;
            if (kt < 2 * qt) {
#pragma unroll
                for (int r = 0; r < 4; ++r) atomicAdd(&HIST[i16 * NBIN + code_bin(cd[r])], inc);
            } else {
                const int t = t0 + 16 * nt + i16;
#pragma unroll
                for (int r = 0; r < 4; ++r) { const int s = 16 * kt + 4 * g + r;
                    if (s <= t) atomicAdd(&HIST[i16 * NBIN + code_bin(cd[r])], inc); }
            }
        }
        SYNC();
#pragma unroll 1
        for (int rr = 0; rr < 4; ++rr) {
            const int row = 4 * w + rr, t = t0 + row;
            if (t < 256) { if (lane == 0) { BST[row] = -1; NAB[row] = t + 1; } continue; }
            const int sh = (row >> 4) * 16; const unsigned* hp = HIST + (row & 15) * NBIN + 12 * lane;
            int cnt[12]; int tot = 0;
#pragma unroll
            for (int i = 0; i < 12; ++i) { cnt[i] = (int)((hp[i] >> sh) & 0xFFFFu); tot += cnt[i]; }
            int suf = tot;
#pragma unroll
            for (int o = 1; o < 64; o <<= 1) { const int v = SHFL_DOWN(suf, o); if (lane + o < 64) suf += v; }
            const int above = suf - tot;
            if (above < 256 && above + tot >= 256) {
                int run = above, bs = -1, na = 0; bool done = false;
#pragma unroll
                for (int i = 11; i >= 0; --i) { if (!done) { if (run + cnt[i] >= 256) { bs = 12 * lane + i; na = run; done = true; } else run += cnt[i]; } }
                BST[row] = bs; NAB[row] = na;
            }
        }
        SYNC();
        { const int row = 16 * nt + i16, t = t0 + row, bs = BST[row];
        const int ntl = nkt > (w >> 1) ? ((nkt - 1 - (w >> 1)) >> 2) + 1 : 0;
        u32x2 P0 = sw[0], P1 = sw[(size_t)(1 < ntl ? 1 : 0) * 64];
        for (int j = 0; j < ntl; ++j) { const int kt = (w >> 1) + 4 * j;
            const u32x2 pc = P0; P0 = P1; P1 = sw[(size_t)(j + 2 < ntl ? j + 2 : j) * 64];
            const bool full = kt < 2 * qt;
#pragma unroll
            for (int r = 0; r < 4; ++r) { const int s = 16 * kt + 4 * g + r;
                if (full || s <= t) { const unsigned wd = r < 2 ? pc.x : pc.y; const unsigned c = (r & 1) ? (wd >> 16) : (wd & 0xffffu); const int bn = code_bin(c);
                    if (bn > bs) atomicOr(&MASK[row * 128 + (s >> 5)], 1u << (s & 31));
                    else if (bn == bs) { const int pos = (int)atomicAdd((unsigned*)&NCAND[row], 1u); if (pos < CAND_CAP) CAND[row * CAND_CAP + pos] = (u32x2){code_key(c), (unsigned)s}; } } }
        } }
        SYNC();
#pragma unroll 1
        for (int rr = 0; rr < 4; ++rr) {
            const int row = 4 * w + rr; if (BST[row] < 0) continue;
            const int n = NCAND[row] < CAND_CAP ? NCAND[row] : CAND_CAP, need = 256 - NAB[row];
            for (int i = lane; i < n; i += 64) { const u32x2 me = CAND[row * CAND_CAP + i]; int rank = 0;
                for (int j = 0; j < n; ++j) { const u32x2 o = CAND[row * CAND_CAP + j]; rank += (o.x > me.x || (o.x == me.x && o.y < me.y)) ? 1 : 0; }
#ifndef DSA_DBG_NOCAND
                if (rank < need) atomicOr(&MASK[row * 128 + (me.y >> 5)], 1u << (me.y & 31));
#endif
            }
        }
        SYNC();
#ifdef DSA_DBG_SEL
        for (int e = tid; e < 32 * 128; e += 512) { const int row = e >> 7, wi = e & 127, t = t0 + row, lo = t - 255 < 0 ? 0 : t - 255; unsigned m = 0u;
            for (int bq = 0; bq < 32; ++bq) { const int s = 32 * wi + bq; if (s >= lo && s <= t) m |= 1u << bq; }
            MASK[e] = m; }
        SYNC();
#endif
#pragma unroll 1
        for (int rr = 0; rr < 4; ++rr) {
            const int row = 4 * w + rr;
            unsigned w0 = MASK[row * 128 + 2 * lane], w1 = MASK[row * 128 + 2 * lane + 1];
            const int c = __builtin_popcount(w0) + __builtin_popcount(w1);
            int inc = c;
#pragma unroll
            for (int o = 1; o < 64; o <<= 1) { const int v = SHFL_UP(inc, o); if (lane >= o) inc += v; }
            int pos = inc - c;
            while (w0) { const int bt = __builtin_ctz(w0); w0 &= w0 - 1; if (pos < 256) SELL[row * 256 + pos] = (unsigned short)(64 * lane + bt); ++pos; }
            while (w1) { const int bt = __builtin_ctz(w1); w1 &= w1 - 1; if (pos < 256) SELL[row * 256 + pos] = (unsigned short)(64 * lane + 32 + bt); ++pos; }
            if (lane == 63) NSEL[row] = inc < 256 ? inc : 256;
        }
        SYNC();
        bf16* TL = (bf16*)(F.lds + w * DS_SLOT); bf16* OLw = (bf16*)(F.lds + w * DS_SLOT + 8704);
#pragma unroll 1
        for (int rr = 0; rr < 4; ++rr) {
            const int row = 4 * w + rr, t = t0 + row, ns = UNI(NSEL[row]); const size_t mt = mb + t;
            const unsigned short* sl = SELL + row * 256;
            bf16x8 Bh[4];
#pragma unroll
            for (int ks = 0; ks < 4; ++ks) Bh[ks] = i16 < 4 ? *(const bf16x8*)(QABS + mt * 512 + i16 * 128 + 32 * ks + 8 * g) : (bf16x8){0, 0, 0, 0, 0, 0, 0, 0};
            f32x4 O[8];
#pragma unroll
            for (int nt = 0; nt < 8; ++nt) O[nt] = (f32x4){0.f, 0.f, 0.f, 0.f};
            float mrun = -1e30f, lrun = 0.f;
            const float bfar = RB[113 * 4 + (i16 & 3)];
            const int nch = (ns + 31) >> 5;
            u32x4 gvA[8];
#ifndef HOST_EMU
#define ATT_KEEP8(A) asm volatile("" :: "v"(A[0][0]), "v"(A[0][1]), "v"(A[0][2]), "v"(A[0][3]), "v"(A[1][0]), "v"(A[1][1]), "v"(A[1][2]), "v"(A[1][3]))
#else
#define ATT_KEEP8(A) (void)0
#endif
#define ATT_LOAD(GV, CK, FULL) do { int sidx[8]; \
                _Pragma("unroll") for (int i = 0; i < 8; ++i) sidx[i] = (int)sl[32 * (CK) + 4 * i + g];            \
                _Pragma("unroll") for (int i = 0; i < 8; ++i) { const int kp = 32 * (CK) + 4 * i + g; sidx[i] = (FULL || kp < ns) ? sidx[i] : 0; } \
                _Pragma("unroll") for (int i = 0; i < 8; ++i) GV[i] = *(const GAS u32x4*)(ckvb + (((unsigned)sidx[i] << 8) + 16u * (unsigned)i16)); } while (0)
#define ATT_STEP(GV, CK, FULL) do { const int ck = (CK); \
                _Pragma("unroll") for (int i = 0; i < 8; ++i) *(u32x4*)(TL + (4 * i + g) * 136 + 8 * i16) = GV[i]; \
                const u32x2 sk0 = *(const u32x2*)(sl + 32 * ck + 4 * g), sk1 = *(const u32x2*)(sl + 32 * ck + 16 + 4 * g); \
                WAVE_LDS_FENCE(); \
                if (ck + 1 < nch) ATT_LOAD(GV, ck + 1, FULL); \
                float bia[2][4]; \
                if (FULL && t - UNI((int)sl[32 * ck + 31]) >= 113) {                   \
                _Pragma("unroll") for (int kt = 0; kt < 2; ++kt) \
                _Pragma("unroll") for (int r = 0; r < 4; ++r) bia[kt][r] = bfar; \
                } else { \
                _Pragma("unroll") for (int kt = 0; kt < 2; ++kt) \
                _Pragma("unroll") for (int r = 0; r < 4; ++r) { const unsigned wd = kt ? (r < 2 ? sk1.x : sk1.y) : (r < 2 ? sk0.x : sk0.y); \
                        int dist = t - (int)((wd >> (16 * (r & 1))) & 0xffffu); dist = dist < 0 ? 0 : (dist > 113 ? 113 : dist); \
                        bia[kt][r] = RB[dist * 4 + (i16 & 3)]; } } \
                f32x4 lg[2]; \
                { bf16x8 Af[2][4];                                    \
                _Pragma("unroll") for (int kt = 0; kt < 2; ++kt) _Pragma("unroll") for (int ks = 0; ks < 4; ++ks) Af[kt][ks] = *(const bf16x8*)(TL + (16 * kt + i16) * 136 + 32 * ks + 8 * g); \
                ATT_KEEP8(Af); \
                _Pragma("unroll") for (int kt = 0; kt < 2; ++kt) { lg[kt] = (f32x4){0.f, 0.f, 0.f, 0.f}; \
                _Pragma("unroll") for (int ks = 0; ks < 4; ++ks) lg[kt] = MFMA16(Af[kt][ks], Bh[ks], lg[kt]); } } \
                float cm = -1e30f; \
                _Pragma("unroll") for (int kt = 0; kt < 2; ++kt) \
                _Pragma("unroll") for (int r = 0; r < 4; ++r) { const int kp = 32 * ck + 16 * kt + 4 * g + r; \
                        lg[kt][r] = (FULL || kp < ns) ? lg[kt][r] + bia[kt][r] : -1e30f; cm = fmaxf(cm, lg[kt][r]); } \
                if (ck == 0) { cm = fmaxf(cm, SHFL_XOR(cm, 16)); cm = fmaxf(cm, SHFL_XOR(cm, 32)); mrun = cm; } \
                float p[2][4]; \
                _Pragma("unroll") for (int kt = 0; kt < 2; ++kt) \
                _Pragma("unroll") for (int r = 0; r < 4; ++r) { p[kt][r] = (FULL || lg[kt][r] > -1e29f) ? FEXP2(lg[kt][r] - mrun) : 0.f; lrun += p[kt][r]; } \
                u32x4 aw = (u32x4){0u, 0u, 0u, 0u}; \
                if (i16 < 4) aw = (u32x4){pk2(p[0][0], p[0][1]), pk2(p[0][2], p[0][3]), pk2(p[1][0], p[1][1]), pk2(p[1][2], p[1][3])}; \
                const bf16x8 A = __builtin_bit_cast(bf16x8, aw); \
                _Pragma("unroll") for (int nt = 0; nt < 8; ++nt) { \
                    const s16x4 lo = TR16(TL + (4 * g + (i16 >> 2)) * 136 + 16 * nt + 4 * (i16 & 3)); \
                    const s16x4 hi = TR16(TL + (16 + 4 * g + (i16 >> 2)) * 136 + 16 * nt + 4 * (i16 & 3)); \
                    const bf16x8 B = (bf16x8){lo[0], lo[1], lo[2], lo[3], hi[0], hi[1], hi[2], hi[3]}; \
                    O[nt] = MFMA16(A, B, O[nt]); } \
                WAVE_LDS_FENCE(); } while (0)
            if (ns == 256) { ATT_LOAD(gvA, 0, true); for (int ck2 = 0; ck2 < 8; ++ck2) ATT_STEP(gvA, ck2, true); }
            else { ATT_LOAD(gvA, 0, false); for (int ck2 = 0; ck2 < nch; ++ck2) ATT_STEP(gvA, ck2, false); }
#undef ATT_STEP
#undef ATT_LOAD
            lrun += SHFL_XOR(lrun, 16); lrun += SHFL_XOR(lrun, 32);
            float li[4];
#pragma unroll
            for (int r = 0; r < 4; ++r) li[r] = FRCP(SHFL(lrun, r));
            if (g == 0) {
#pragma unroll
                for (int nt = 0; nt < 8; ++nt)
#pragma unroll
                    for (int r = 0; r < 4; ++r) OLw[(rr * 4 + r) * 128 + 16 * nt + i16] = (bf16)f2bf(O[nt][r] * li[r]);
            }
        }
        bf16x8 Wf[4][4];
#pragma unroll
        for (int ks = 0; ks < 4; ++ks)
#pragma unroll
            for (int nt = 0; nt < 4; ++nt) Wf[ks][nt] = *(const bf16x8*)(WUVT + ((size_t)((w >> 1) * 64 + 16 * nt + i16)) * 128 + 32 * ks + 8 * g);
        SYNC();
        {
            const int h = w >> 1, mtile = w & 1, q = 16 * mtile + i16;
            const bf16* olq = (const bf16*)(F.lds + (q >> 2) * DS_SLOT + 8704) + ((q & 3) * 4 + h) * 128;
            float gaw[4];
#pragma unroll
            for (int nt = 0; nt < 4; ++nt) gaw[nt] = PIN(F, I_GNW)[l * DM + 768 + h * 64 + 16 * nt + i16];
            f32x4 acc[4];
#pragma unroll
            for (int nt = 0; nt < 4; ++nt) acc[nt] = (f32x4){0.f, 0.f, 0.f, 0.f};
#pragma unroll
            for (int ks = 0; ks < 4; ++ks) { const bf16x8 A = *(const bf16x8*)(olq + 32 * ks + 8 * g);
#pragma unroll
                for (int nt = 0; nt < 4; ++nt) acc[nt] = MFMA16(A, Wf[ks][nt], acc[nt]); }
#pragma unroll
            for (int r = 0; r < 4; ++r) { float s = (acc[0][r] * acc[0][r] + acc[1][r] * acc[1][r]) + (acc[2][r] * acc[2][r] + acc[3][r] * acc[3][r]);
                s += SHFL_XOR(s, 1); s += SHFL_XOR(s, 2); s += SHFL_XOR(s, 4); s += SHFL_XOR(s, 8);
                if (i16 == 0) SS[(16 * mtile + 4 * g + r) * 4 + h] = s; }
            SYNC();
#pragma unroll
            for (int r = 0; r < 4; ++r) { const int qq = 16 * mtile + 4 * g + r; const f32x4 s4 = *(const f32x4*)(SS + qq * 4);
                const float rs = RSQ(((s4.x + s4.y) + (s4.z + s4.w)) * (1.0f / 256.0f) + NORM_EPS);
                bf16* dst = CAT + (mb + t0 + qq) * DM + 768 + h * 64 + i16;
#pragma unroll
                for (int nt = 0; nt < 4; ++nt) dst[16 * nt] = (bf16)f2bf(acc[nt][r] * rs * gaw[nt]); }
        }
        SYNC();
    }
}
#ifndef HOST_EMU
namespace pg8 {
#define PG8_LAS __attribute__((address_space(3)))
typedef unsigned short bf16_t;
typedef short bf16x8 __attribute__((ext_vector_type(8)));
typedef float f32x4 __attribute__((ext_vector_type(4)));
typedef unsigned u32x4 __attribute__((ext_vector_type(4)));
constexpr int BM = 256, BK = 64, HALF = 128, HTB = HALF * BK * 2  , STAGE_BYTES = 8 * HTB, NXCD = 8, WGM = 8;

__host__ __device__ __forceinline__ int lds_byte(int r, int c) { const int st = (r >> 4) * 2 + (c >> 5), rr = r & 15, cc = c & 31, ob = rr * 64 + cc * 2; return st * 1024 + (ob ^ (((ob >> 9) & 1) << 5)); }
__host__ __device__ __forceinline__ void stage_rc(int b, int& R, int& C) { const int st = b / 1024, sb = b % 1024, swz = sb ^ (((sb >> 9) & 1) << 5); R = (st >> 1) * 16 + swz / 64; C = (st & 1) * 32 + (swz % 64) / 2; }
__host__ __device__ __forceinline__ int perm32(int rho) { const int n = rho >> 4, i = rho & 15; return 8 * (i >> 2) + 4 * n + (i & 3); }

struct Unit { int pm, pn; };
struct Gemm { const bf16_t* A; const bf16_t* Bt; int M, N, K; };

struct StaticOrder {
    int nM, nN, nwg, G, c;
    __host__ __device__ void init(int M, int N, int G_, int c_) { nM = M / BM; nN = N / BM; nwg = nM * nN; G = G_; c = c_; }
    __host__ __device__ bool next(int i, Unit& u) const {
        const long L = (long)i * G + c; if (L >= nwg) return false;
        int wgid = (int)L; { const int q = nwg / NXCD, r = nwg % NXCD, xcd = wgid % NXCD, off = wgid / NXCD; wgid = (xcd < r ? xcd * (q + 1) : r * (q + 1) + (xcd - r) * q) + off; }
        const int nig = WGM * nN, gid = wgid / nig, fm = gid * WGM, gsz = (nM - fm) < WGM ? (nM - fm) : WGM;
        u.pm = fm + ((wgid % nig) % gsz); u.pn = (wgid % nig) / gsz; return true;
    }
    __device__ __forceinline__ void a_ready(const Unit&) const {}
    __device__ __forceinline__ void done(const Unit&) const {}
};
__device__ __forceinline__ unsigned cvt_pk_bf16(float lo, float hi) { unsigned r; asm volatile("v_cvt_pk_bf16_f32 %0, %1, %2" : "=v"(r) : "v"(lo), "v"(hi)); return r; }
template <class Epi, class Sched, bool ALIGN_EPI = false, bool SP2 = false>
__device__ __forceinline__ void gemm_phase(PG8_LAS unsigned char* lds, const Gemm g, const Sched& S, const Epi& E, const int tid_in) {
    const int tid = tid_in, wid = __builtin_amdgcn_readfirstlane(tid >> 6), lane = tid & 63, wr = wid >> 2, wc = wid & 3, fr = lane & 15, fq = lane >> 4;
    const int K = g.K, nt = K / BK;
    unsigned voffA[2], voffB[2];
#pragma unroll
    for (int i = 0; i < 2; ++i) { int R, C; stage_rc(tid * 16 + i * 8192, R, C); const int Rb = Epi::PERM ? ((R & ~31) + perm32(R & 31)) : R;
        voffA[i] = (unsigned)(R * K + C) * 2u; voffB[i] = (unsigned)(Rb * K + C) * 2u; }
    const size_t kstep = (size_t)(BK * 2);
    const size_t hstep = (size_t)HALF * K * 2;
    const size_t tstep = 2 * hstep;
    const unsigned ldsw = (unsigned)wid * 1024u;
    const int aoff = lds_byte(wr * 64 + fr, fq * 8), boff = lds_byte(wc * 32 + fr, fq * 8);
#define PG8_SA(b, h) (((b) * 2 + (h)) * HTB)
#define PG8_SB(b, h) ((4 + (b) * 2 + (h)) * HTB)
#define PG8_STAGE(bufoff, gbase, voff) do { _Pragma("unroll") for (int _i = 0; _i < 2; ++_i) \
        __builtin_amdgcn_global_load_lds((const unsigned*)((const char*)(gbase) + (voff)[_i]), (PG8_LAS unsigned*)(lds + (bufoff) + ldsw + _i * 8192), 16, 0, 0); } while (0)
#define PG8_LDA(dst, b, h) do { _Pragma("unroll") for (int m = 0; m < 4; ++m) _Pragma("unroll") for (int k = 0; k < 2; ++k) dst[m][k] = *(const PG8_LAS bf16x8*)(lds + PG8_SA(b, h) + aoff + m * 2048 + k * 1024); } while (0)
#define PG8_LDB(dst, b, h) do { _Pragma("unroll") for (int n = 0; n < 2; ++n) _Pragma("unroll") for (int k = 0; k < 2; ++k) dst[n][k] = *(const PG8_LAS bf16x8*)(lds + PG8_SB(b, h) + boff + n * 2048 + k * 1024); } while (0)
#define PG8_MMA(ai, bj, At, Bt) do { __builtin_amdgcn_s_setprio(1); _Pragma("unroll") for (int m = 0; m < 4; ++m) _Pragma("unroll") for (int n = 0; n < 2; ++n) _Pragma("unroll") for (int k = 0; k < 2; ++k) \
        acc[ai][bj][m][n] = __builtin_amdgcn_mfma_f32_16x16x32_bf16(Bt[n][k], At[m][k], acc[ai][bj][m][n], 0, 0, 0); __builtin_amdgcn_s_setprio(0); } while (0)
#define PG8_WAIT_V(n) asm volatile("s_waitcnt vmcnt(" #n ")" ::: "memory")
#define PG8_WAIT_L(n) asm volatile("s_waitcnt lgkmcnt(" #n ")" ::: "memory")
#define PG8_BAR __builtin_amdgcn_s_barrier()
#define PG8_SCHED __builtin_amdgcn_sched_barrier(0)
    Unit cur, nxt; int ui = 0;
    if (!S.next(0, cur)) return;
    f32x4 acc[2][2][4][2];
#pragma unroll
    for (int a = 0; a < 2; ++a)
#pragma unroll
        for (int b = 0; b < 2; ++b)
#pragma unroll
            for (int m = 0; m < 4; ++m)
#pragma unroll
                for (int n = 0; n < 2; ++n) acc[a][b][m][n] = (f32x4){0.f, 0.f, 0.f, 0.f};
    bf16x8 At[4][2], B0[2][2], B1[2][2];
    const char* cA = (const char*)g.A + (size_t)cur.pm * tstep; const char* cB = (const char*)g.Bt + (size_t)cur.pn * tstep;
    S.a_ready(cur);
    if constexpr (SP2) {
        PG8_STAGE(PG8_SB(0, 0), cB, voffB); PG8_STAGE(PG8_SB(0, 1), cB + hstep, voffB); PG8_STAGE(PG8_SA(0, 0), cA, voffA); PG8_STAGE(PG8_SA(0, 1), cA + hstep, voffA);
        if (wr == 1) PG8_BAR;
        PG8_WAIT_V(2); PG8_BAR;
        PG8_STAGE(PG8_SB(1, 0), cB + kstep, voffB); PG8_STAGE(PG8_SA(1, 0), cA + kstep, voffA); PG8_STAGE(PG8_SB(1, 1), cB + hstep + kstep, voffB);
        PG8_WAIT_V(6); PG8_BAR;
    } else {
        PG8_STAGE(PG8_SB(0, 0), cB, voffB); PG8_STAGE(PG8_SA(0, 0), cA, voffA); PG8_STAGE(PG8_SB(0, 1), cB + hstep, voffB); PG8_STAGE(PG8_SA(0, 1), cA + hstep, voffA);
        if (wr == 1) PG8_BAR;
        PG8_WAIT_V(4); PG8_BAR;
        PG8_STAGE(PG8_SB(1, 0), cB + kstep, voffB); PG8_STAGE(PG8_SA(1, 0), cA + kstep, voffA); PG8_STAGE(PG8_SB(1, 1), cB + hstep + kstep, voffB);
        PG8_WAIT_V(6); PG8_BAR;
    }
    for (;;) {
        const bool has_next = S.next(ui + 1, nxt);
        const char* nA = has_next ? (const char*)g.A + (size_t)nxt.pm * tstep : cA; const char* nB = has_next ? (const char*)g.Bt + (size_t)nxt.pn * tstep : cB;
#pragma unroll 1
        for (int t = 0; t < nt; t += 2) {
            const bool last = (t == nt - 2);
            const char* a1 = cA + (size_t)(t + 1) * kstep;
            const char* a2 = last ? nA : cA + (size_t)(t + 2) * kstep; const char* b2 = last ? nB : cB + (size_t)(t + 2) * kstep;
            const char* a3 = a2 + kstep; const char* b3 = b2 + kstep;
            if (last && has_next) S.a_ready(nxt);
            if constexpr (Epi::NORM) { if (t == 2) E.prefetch(cur, tid, wid); if (t == 4) E.reduce_rs(tid); }
            if constexpr (SP2) {
            PG8_LDB(B0, 0, 0); PG8_LDB(B1, 0, 1); PG8_SCHED; PG8_LDA(At, 0, 0); PG8_STAGE(PG8_SA(1, 1), a1 + hstep, voffA);
            PG8_WAIT_V(8); PG8_WAIT_L(0); PG8_BAR; PG8_MMA(0, 0, At, B0); PG8_MMA(0, 1, At, B1); PG8_BAR; PG8_SCHED;
            PG8_LDA(At, 0, 1); PG8_STAGE(PG8_SB(0, 0), b2, voffB); PG8_STAGE(PG8_SB(0, 1), b2 + hstep, voffB); PG8_STAGE(PG8_SA(0, 0), a2, voffA);
            PG8_WAIT_V(8); PG8_WAIT_L(0); PG8_BAR; PG8_MMA(1, 0, At, B0); PG8_MMA(1, 1, At, B1); PG8_BAR; PG8_SCHED;
            PG8_LDB(B0, 1, 0); PG8_LDB(B1, 1, 1); PG8_SCHED; PG8_LDA(At, 1, 0); PG8_STAGE(PG8_SA(0, 1), a2 + hstep, voffA);
            PG8_WAIT_V(8); PG8_WAIT_L(0); PG8_BAR; PG8_MMA(0, 0, At, B0); PG8_MMA(0, 1, At, B1); PG8_BAR; PG8_SCHED;
            PG8_LDA(At, 1, 1); PG8_STAGE(PG8_SB(1, 0), b3, voffB); PG8_STAGE(PG8_SB(1, 1), b3 + hstep, voffB); PG8_STAGE(PG8_SA(1, 0), a3, voffA);
            PG8_WAIT_V(8); PG8_WAIT_L(0); PG8_BAR; PG8_MMA(1, 0, At, B0); PG8_MMA(1, 1, At, B1); PG8_BAR; PG8_SCHED;
            } else {
            PG8_LDB(B0, 0, 0); PG8_SCHED; PG8_LDA(At, 0, 0); PG8_STAGE(PG8_SA(1, 1), a1 + hstep, voffA);
            PG8_WAIT_L(8); PG8_BAR; PG8_WAIT_L(0); PG8_MMA(0, 0, At, B0); PG8_BAR; PG8_SCHED;
            PG8_LDB(B1, 0, 1); PG8_STAGE(PG8_SB(0, 0), b2, voffB);
            PG8_BAR; PG8_WAIT_L(0); PG8_MMA(0, 1, At, B1); PG8_BAR;
            PG8_LDA(At, 0, 1); PG8_STAGE(PG8_SA(0, 0), a2, voffA);
            PG8_BAR; PG8_WAIT_L(0); PG8_MMA(1, 0, At, B0); PG8_BAR; PG8_SCHED;
            PG8_STAGE(PG8_SB(0, 1), b2 + hstep, voffB);
            PG8_WAIT_V(6); PG8_BAR; PG8_MMA(1, 1, At, B1); PG8_BAR;
            PG8_LDB(B0, 1, 0); PG8_SCHED; PG8_LDA(At, 1, 0); PG8_STAGE(PG8_SA(0, 1), a2 + hstep, voffA);
            PG8_WAIT_L(8); PG8_BAR; PG8_WAIT_L(0); PG8_MMA(0, 0, At, B0); PG8_BAR; PG8_SCHED;
            PG8_LDB(B1, 1, 1); PG8_STAGE(PG8_SB(1, 0), b3, voffB);
            PG8_BAR; PG8_WAIT_L(0); PG8_MMA(0, 1, At, B1); PG8_BAR;
            PG8_LDA(At, 1, 1); PG8_STAGE(PG8_SA(1, 0), a3, voffA);
            PG8_BAR; PG8_WAIT_L(0); PG8_MMA(1, 0, At, B0); PG8_BAR; PG8_SCHED;
            PG8_STAGE(PG8_SB(1, 1), b3 + hstep, voffB);
            PG8_WAIT_V(6); PG8_BAR; PG8_MMA(1, 1, At, B1); PG8_BAR;
            }
        }
        if constexpr (ALIGN_EPI) { if (wr == 0) PG8_BAR; }
        if constexpr (!Epi::AFTER_DRAIN) { E(acc, cur, wr, wc, fr, fq); S.done(cur); }
        if (!has_next) break;
#pragma unroll
        for (int a = 0; a < 2; ++a)
#pragma unroll
            for (int b = 0; b < 2; ++b)
#pragma unroll
                for (int m = 0; m < 4; ++m)
#pragma unroll
                    for (int n = 0; n < 2; ++n) acc[a][b][m][n] = (f32x4){0.f, 0.f, 0.f, 0.f};
        cur = nxt; cA = nA; cB = nB; ++ui;
        if constexpr (ALIGN_EPI) { if (wr == 1) PG8_BAR; }
    }
    PG8_WAIT_V(0);
    if constexpr (!ALIGN_EPI) { if (wr == 0) PG8_BAR; }
    PG8_BAR;
    if constexpr (Epi::AFTER_DRAIN) { E.fused(acc, cur, wr, wc, fr, fq, lds, wid, lane); S.done(cur); }
#undef PG8_SA
#undef PG8_SB
#undef PG8_STAGE
#undef PG8_LDA
#undef PG8_LDB
#undef PG8_MMA
#undef PG8_WAIT_V
#undef PG8_WAIT_L
#undef PG8_BAR
#undef PG8_SCHED
}
}
namespace pg8 {
template <int ACT  > struct EpiRoute {
    static constexpr bool PERM = true, AFTER_DRAIN = false, NORM = false;
    bf16_t* O0; int ld0; bf16_t* O1; int ld1; int split;
    __device__ __forceinline__ void operator()(const f32x4 (&acc)[2][2][4][2], const Unit& u, int wr, int wc, int fr, int fq) const {
        const int row0 = u.pm * BM + wr * 64 + fr; const bool first = u.pn < split;
        bf16_t* base = first ? O0 : O1; const int ld = first ? ld0 : ld1; const int col0 = (first ? u.pn : u.pn - split) * BM + wc * 32 + 8 * fq;
#pragma unroll
        for (int ai = 0; ai < 2; ++ai)
#pragma unroll
            for (int m = 0; m < 4; ++m) { bf16_t* rowp = base + (size_t)(row0 + ai * HALF + m * 16) * ld + col0;
#pragma unroll
                for (int bj = 0; bj < 2; ++bj) { f32x4 v0 = acc[ai][bj][m][0], v1 = acc[ai][bj][m][1];
                    if (ACT == 1) {
#pragma unroll
                        for (int e = 0; e < 4; ++e) { const float a = fmaxf(v0[e], 0.f), b = fmaxf(v1[e], 0.f); v0[e] = a * a; v1[e] = b * b; } }
                    u32x4 w; w.x = cvt_pk_bf16(v0[0], v0[1]); w.y = cvt_pk_bf16(v0[2], v0[3]); w.z = cvt_pk_bf16(v1[0], v1[1]); w.w = cvt_pk_bf16(v1[2], v1[3]);
                    *(u32x4*)(rowp + bj * HALF) = w; } }
    }
};
struct EpiResid {
    static constexpr bool PERM = true, AFTER_DRAIN = false, NORM = false;
    const float* xsrc; float* xdst; const float* gate;
    __device__ __forceinline__ void operator()(const f32x4 (&acc)[2][2][4][2], const Unit& u, int wr, int wc, int fr, int fq) const {
        const int row0 = u.pm * BM + wr * 64 + fr, col0 = u.pn * BM + wc * 32 + 8 * fq, b = (u.pm * BM) >> 12;
        f32x4 gv[2][2];
#pragma unroll
        for (int bj = 0; bj < 2; ++bj)
#pragma unroll
            for (int n = 0; n < 2; ++n) gv[bj][n] = *(const f32x4*)(gate + (size_t)b * 6144 + col0 + bj * HALF + 4 * n);
#pragma unroll
        for (int ai = 0; ai < 2; ++ai)
#pragma unroll
            for (int m = 0; m < 4; ++m) { const size_t off = (size_t)(row0 + ai * HALF + m * 16) * 1024 + col0;
#pragma unroll
                for (int bj = 0; bj < 2; ++bj)
#pragma unroll
                    for (int n = 0; n < 2; ++n) { const f32x4 xs = *(const f32x4*)(xsrc + off + bj * HALF + 4 * n);
                        *(f32x4*)(xdst + off + bj * HALF + 4 * n) = xs + gv[bj][n] * acc[ai][bj][m][n]; }
                if (m & 1) asm volatile("" ::: "memory"); }
    }
};
constexpr int EPI_OFF = 133120;
template <int ACT  > struct EpiRouteN {
    static constexpr bool PERM = true, AFTER_DRAIN = false, NORM = true;
    bf16_t* O; int ld; const float* RSP; const float* shw; PG8_LAS unsigned char* lds;
    __device__ __forceinline__ void prefetch(const Unit& u, int tid, int wid) const {
        const char* src = (const char*)RSP + (size_t)u.pm * (BM * 64) + (size_t)tid * 16;
#pragma unroll
        for (int i = 0; i < 2; ++i) __builtin_amdgcn_global_load_lds((const unsigned*)(src + i * 8192), (PG8_LAS unsigned*)(lds + EPI_OFF + wid * 1024 + i * 8192), 16, 0, 0);
        if (wid == 0) { const char* s2 = (const char*)(shw + (size_t)((u.pm * BM) >> 12) * NSHW + u.pn * BM) + (size_t)(tid & 63) * 16;
            __builtin_amdgcn_global_load_lds((const unsigned*)s2, (PG8_LAS unsigned*)(lds + EPI_OFF + 16384), 16, 0, 0); }
    }
    __device__ __forceinline__ void reduce_rs(int tid) const {
        if (tid < 256) { const PG8_LAS f32x4* p = (const PG8_LAS f32x4*)(lds + EPI_OFF + tid * 64); const f32x4 a = p[0], b = p[1], c = p[2], d = p[3];
            const float s = (((a.x + a.y) + (a.z + a.w)) + ((b.x + b.y) + (b.z + b.w))) + (((c.x + c.y) + (c.z + c.w)) + ((d.x + d.y) + (d.z + d.w)));
            *(PG8_LAS float*)(lds + EPI_OFF + 17408 + tid * 4) = __builtin_amdgcn_rsqf(s * (1.0f / 1024.0f) + 1e-6f); }
    }
    __device__ __forceinline__ void operator()(const f32x4 (&acc)[2][2][4][2], const Unit& u, int wr, int wc, int fr, int fq) const {
        const int row0 = u.pm * BM + wr * 64 + fr, col0 = u.pn * BM + wc * 32 + 8 * fq;
        const PG8_LAS unsigned char* ep = lds + EPI_OFF;
        float rs[2][4];
#pragma unroll
        for (int ai = 0; ai < 2; ++ai)
#pragma unroll
            for (int m = 0; m < 4; ++m) rs[ai][m] = *(const PG8_LAS float*)(ep + 17408 + (wr * 64 + fr + ai * HALF + m * 16) * 4);
        f32x4 sv[2][2];
#pragma unroll
        for (int bj = 0; bj < 2; ++bj)
#pragma unroll
            for (int n = 0; n < 2; ++n) sv[bj][n] = *(const PG8_LAS f32x4*)(ep + 16384 + (bj * HALF + wc * 32 + 8 * fq + 4 * n) * 4);
#pragma unroll
        for (int ai = 0; ai < 2; ++ai)
#pragma unroll
            for (int m = 0; m < 4; ++m) { bf16_t* rowp = O + (size_t)(row0 + ai * HALF + m * 16) * ld + col0;
#pragma unroll
                for (int bj = 0; bj < 2; ++bj) { f32x4 v0 = acc[ai][bj][m][0] * rs[ai][m] + sv[bj][0], v1 = acc[ai][bj][m][1] * rs[ai][m] + sv[bj][1];
                    if (ACT == 1) {
#pragma unroll
                        for (int e = 0; e < 4; ++e) { const float a = fmaxf(v0[e], 0.f), b = fmaxf(v1[e], 0.f); v0[e] = a * a; v1[e] = b * b; } }
                    u32x4 w; w.x = cvt_pk_bf16(v0[0], v0[1]); w.y = cvt_pk_bf16(v0[2], v0[3]); w.z = cvt_pk_bf16(v1[0], v1[1]); w.w = cvt_pk_bf16(v1[2], v1[3]);
                    *(u32x4*)(rowp + bj * HALF) = w; } }
    }
};
template <bool MAYSKIP> struct EpiResidXS {
    static constexpr bool PERM = true, AFTER_DRAIN = false, NORM = false;
    const bf16_t* xsrc; bf16_t* xdst; const float* gate; const float* wp; bf16_t* XS; float* RSP; int doxs;
    template <bool DOXS> __device__ __forceinline__ void body(const f32x4 (&acc)[2][2][4][2], const Unit& u, int wr, int wc, int fr, int fq) const {
        const int row0 = u.pm * BM + wr * 64 + fr, col0 = u.pn * BM + wc * 32 + 8 * fq, b = (u.pm * BM) >> 12;
        f32x4 gv[2][2], wv[2][2]; float ssv[2][4];
#pragma unroll
        for (int bj = 0; bj < 2; ++bj)
#pragma unroll
            for (int n = 0; n < 2; ++n) { gv[bj][n] = *(const f32x4*)(gate + (size_t)b * 6144 + col0 + bj * HALF + 4 * n);
                if (DOXS) wv[bj][n] = *(const f32x4*)(wp + (size_t)b * 1024 + col0 + bj * HALF + 4 * n); }
#pragma unroll
        for (int aim = 0; aim < 4; ++aim) { const int ai = aim >> 1, m0_ = (aim & 1) * 2;
            u32x4 xr[4][2];
#pragma unroll
            for (int m = m0_; m < m0_ + 2; ++m)
#pragma unroll
                for (int bj = 0; bj < 2; ++bj) xr[m][bj] = *(const u32x4*)(xsrc + (size_t)(row0 + ai * HALF + m * 16) * 1024 + col0 + bj * HALF);
#pragma unroll
            for (int m = m0_; m < m0_ + 2; ++m) { const size_t off = (size_t)(row0 + ai * HALF + m * 16) * 1024 + col0; float ss = 0.f;
#pragma unroll
                for (int bj = 0; bj < 2; ++bj) { const u32x4 r = xr[m][bj];
                    const f32x4 x0 = (f32x4){bflo(r.x), bfhi(r.x), bflo(r.y), bfhi(r.y)}, x1 = (f32x4){bflo(r.z), bfhi(r.z), bflo(r.w), bfhi(r.w)};
                    const f32x4 y0 = x0 + gv[bj][0] * acc[ai][bj][m][0], y1 = x1 + gv[bj][1] * acc[ai][bj][m][1];
                    u32x4 w; w.x = cvt_pk_bf16(y0[0], y0[1]); w.y = cvt_pk_bf16(y0[2], y0[3]); w.z = cvt_pk_bf16(y1[0], y1[1]); w.w = cvt_pk_bf16(y1[2], y1[3]);
                    *(u32x4*)(xdst + off + bj * HALF) = w;
                    if (DOXS) { const f32x4 a = y0 * wv[bj][0], c = y1 * wv[bj][1];
                        u32x4 v; v.x = cvt_pk_bf16(a[0], a[1]); v.y = cvt_pk_bf16(a[2], a[3]); v.z = cvt_pk_bf16(c[0], c[1]); v.w = cvt_pk_bf16(c[2], c[3]);
                        *(u32x4*)(XS + off + bj * HALF) = v;
                        ss += ((y0.x * y0.x + y0.y * y0.y) + (y0.z * y0.z + y0.w * y0.w)) + ((y1.x * y1.x + y1.y * y1.y) + (y1.z * y1.z + y1.w * y1.w)); } }
                ssv[ai][m] = ss; }
            asm volatile("" ::: "memory"); }
        if (DOXS) { float t1[2][4];
#pragma unroll
            for (int ai = 0; ai < 2; ++ai)
#pragma unroll
                for (int m = 0; m < 4; ++m) t1[ai][m] = __shfl_xor(ssv[ai][m], 16);
#pragma unroll
            for (int ai = 0; ai < 2; ++ai)
#pragma unroll
                for (int m = 0; m < 4; ++m) { ssv[ai][m] += t1[ai][m]; t1[ai][m] = __shfl_xor(ssv[ai][m], 32); }
            if (fq == 0) {
#pragma unroll
                for (int ai = 0; ai < 2; ++ai)
#pragma unroll
                    for (int m = 0; m < 4; ++m) RSP[(size_t)(row0 + ai * HALF + m * 16) * 16 + u.pn * 4 + wc] = ssv[ai][m] + t1[ai][m]; } }
    }
    __device__ __forceinline__ void operator()(const f32x4 (&acc)[2][2][4][2], const Unit& u, int wr, int wc, int fr, int fq) const {
        if (!MAYSKIP || doxs) body<true>(acc, u, wr, wc, fr, fq); else body<false>(acc, u, wr, wc, fr, fq);
    }
};
}

#define RLX_AGENT __ATOMIC_RELAXED, __HIP_MEMORY_SCOPE_AGENT
#define XB_TMO      128
#define XB_XCNT(j)  (256  + 64 * (j))
#define XB_XSUB(j)  (1280 + 64 * (j))
#define XB_XGEN(j)  (2304 + 64 * (j))
#define XB_TOP      3328
#define XB_TOPGEN   3392
#define XCD_BAR_WORDS 3456
#define XB_SPIN_CAP (1u << 24)

__device__ __forceinline__ unsigned xb_ld(unsigned* p)              { return __hip_atomic_load(p, __ATOMIC_RELAXED, __HIP_MEMORY_SCOPE_AGENT); }
__device__ __forceinline__ unsigned xb_add(unsigned* p, unsigned v) { return __hip_atomic_fetch_add(p, v, __ATOMIC_RELAXED, __HIP_MEMORY_SCOPE_AGENT); }
__device__ __forceinline__ unsigned xb_xcc_id() { return (unsigned)__builtin_amdgcn_s_getreg((3 << 11) | 20) & 0xFu; }
#define XB_SPIN(cond, bar) do { unsigned _sp = 0; while (cond) { __builtin_amdgcn_s_sleep(1); \
    if ((++_sp & 255u) == 0u) { if (xb_ld(&(bar)[XB_TMO])) break; if (_sp > XB_SPIN_CAP) { atomicAdd(&(bar)[XB_TMO], 1u); break; } } } } while (0)

struct XcdBarrier {
    unsigned* bar; unsigned x;
    volatile LAS unsigned* st;
};

__device__ __forceinline__ XcdBarrier xcd_barrier_post(unsigned* bar, volatile LAS unsigned* st) {
    XcdBarrier b; b.bar = bar; b.x = xb_xcc_id(); b.st = st;
    if (threadIdx.x == 0) (void)xb_add(&bar[XB_XCNT(b.x)], 1u);
    return b;
}
__device__ __forceinline__ void xcd_barrier_complete(unsigned* bar, unsigned x, unsigned& nloc, unsigned& nx) {
    const unsigned G = gridDim.x * gridDim.y * gridDim.z;
    unsigned sum, cnt, mine, sp = 0u;
    for (;;) {
        sum = 0u; cnt = 0u; mine = 0u;
#pragma unroll
        for (unsigned j = 0; j < 16; ++j) { const unsigned c = xb_ld(&bar[XB_XCNT(j)]); sum += c; cnt += (c > 0u) ? 1u : 0u; mine = (j == x) ? c : mine; }
        if (sum == G) break;
        __builtin_amdgcn_s_sleep(1);
        if ((++sp & 255u) == 0u) { if (xb_ld(&bar[XB_TMO])) break; if (sp > XB_SPIN_CAP) { atomicAdd(&bar[XB_TMO], 1u); break; } }
    }
    nloc = mine > 0u ? mine : 1u; nx = cnt > 0u ? cnt : 1u;
}

__device__ __forceinline__ void xcd_barrier(const XcdBarrier& b) {
    asm volatile("s_waitcnt vmcnt(0)" ::: "memory");
    __syncthreads();
    if (threadIdx.x == 0) {
        unsigned* bar = b.bar;
        __builtin_amdgcn_s_waitcnt(0);
        unsigned nloc = b.st[0], nx = b.st[1];
        if (nloc == 0u) { xcd_barrier_complete(bar, b.x, nloc, nx); b.st[0] = nloc; b.st[1] = nx; }
        const unsigned old = xb_add(&bar[XB_XSUB(b.x)], 1u);
        const unsigned gen = old / nloc;
        if (old + 1u == (gen + 1u) * nloc) {
            __builtin_amdgcn_fence(__ATOMIC_RELEASE, "agent");
            asm volatile("s_waitcnt vmcnt(0)" ::: "memory");
            const unsigned og = xb_add(&bar[XB_TOP], 1u);
            const unsigned tg = og / nx;
            if (og + 1u == (tg + 1u) * nx) xb_add(&bar[XB_TOPGEN], 1u);
            else XB_SPIN(xb_ld(&bar[XB_TOPGEN]) == tg, bar);
            __builtin_amdgcn_fence(__ATOMIC_ACQUIRE, "agent");
            xb_add(&bar[XB_XGEN(b.x)], 1u);
            asm volatile("s_waitcnt vmcnt(0)" ::: "memory");
        } else {
            XB_SPIN(xb_ld(&bar[XB_XGEN(b.x)]) == gen, bar);
            __builtin_amdgcn_fence(__ATOMIC_ACQUIRE, "agent");
            asm volatile("s_waitcnt vmcnt(0)" ::: "memory");
        }
    }
    __syncthreads();
}

#ifndef PH_MASK
#define PH_MASK 0xFFFFF
#endif
#define EN(b) if constexpr ((PH_MASK >> (b)) & 1)
#ifndef DUP_MASK
#define DUP_MASK 0
#endif
#define DUP(b) if constexpr ((DUP_MASK >> (b)) & 1)
#define DBG_DIGEST_N 256
#define DBG_DIGEST_VAL(m, c) bf2f(((const bf16*)(wsp + WS_CAT))[(size_t)(m) * DM + 768 + (c)])
#ifndef DBG_PH_HI
#define DBG_PH_HI NPHASE
#endif
#ifndef MK_MULTI
#define MK_MULTI 0
#endif
constexpr int LDS_BYTES = 151552, MISC_OFF = 131072 + 320;
#ifndef DBG_LAYERS
#define DBG_LAYERS 4
#define DBG_L0 0
#endif
constexpr int NPHASE = 3 + 7 * DBG_LAYERS;
__global__ void __launch_bounds__(512, 2) hymba_fwd(Args a) {
    extern __shared__ __attribute__((aligned(16))) unsigned char lds[];
    Ctx F0;
    Ctx& F = F0;
    F.lds = (char*)lds; F.tid = threadIdx.x; F.lane = F.tid & 63; F.wave = __builtin_amdgcn_readfirstlane(F.tid >> 6); F.G = gridDim.x; F.bid = blockIdx.x;
    F.A = nullptr; F.ws = a.ws;
    if (F.tid < 29) ((unsigned long long*)(lds + PTR_OFF))[F.tid] = F.tid < 28 ? (unsigned long long)a.in[F.tid] : (unsigned long long)a.out;
    volatile LAS unsigned* MISC = (volatile LAS unsigned*)((LAS unsigned char*)lds + MISC_OFF);
    if (F.tid < 32) MISC[F.tid] = 0u;
    __syncthreads();
    unsigned* ctl = (unsigned*)(a.ws + WS_CTL);
    XcdBarrier bar; bar.bar = ctl + CW_BAR; bar.x = 0; bar.st = nullptr;
    if (!MK_MULTI) bar = xcd_barrier_post(ctl + CW_BAR, MISC + 8);
    const int lo = a.ph_lo, hi = a.ph_hi;
    int ph = 0;
#define PH_BEGIN if (lo <= ph && ph < hi) { Ctx F = F0; unsigned long long wsl_ = (unsigned long long)F0.ws; asm volatile("" : "+v"(F.tid), "+s"(F.bid), "+s"(F.G), "+s"(wsl_)); F.ws = (unsigned char*)(__attribute__((address_space(1))) unsigned char*)wsl_; F.lane = F.tid & 63; F.wave = __builtin_amdgcn_readfirstlane(F.tid >> 6); unsigned char* const wsp = F.ws; (void)wsp;
#define PH_END   if (!MK_MULTI && ph + 1 < hi) { XcdBarrier bb = bar; asm volatile("" : "+s"(bb.bar), "+s"(bb.x)); xcd_barrier(bb); } else __syncthreads(); } ++ph;
    PG8_LAS unsigned char* glds = (PG8_LAS unsigned char*)lds;
#define XN ((bf16*)(wsp + WS_XN))
#define PROJ ((bf16*)(wsp + WS_PROJ))
#define CAT ((bf16*)(wsp + WS_CAT))
#define HB ((bf16*)(wsp + WS_HB))
    PH_BEGIN EN(0) ph_prologue(F); DUP(0) { __syncthreads(); ph_prologue(F); } PH_END
    PH_BEGIN EN(1) { ph_shw(F); ph_xs0(F, PIN(F, I_X), PIN(F, I_N1W) + DBG_L0 * DM, (const float*)(wsp + WS_MOD) + (size_t)DBG_L0 * BATCH * NADA, DM, XN, (float*)(wsp + WS_RSP), (bf16*)POUT(F)); } PH_END
    for (int l_ = 0; l_ < DBG_LAYERS; ++l_) { const int l = l_ + DBG_L0;
        #define modl ((const float*)(wsp + WS_MOD) + (size_t)l * BATCH * NADA)
        #define xsrc (l_ == 0 ? PIN(F, I_X) : (const float*)POUT(F))
        PH_BEGIN
#if defined(PROBE_GA)
            { pg8::Gemm g{XN, (const bf16*)(wsp + WS_WIN) + (size_t)l * NPROJ * DM, MTOK, NPROJ, DM}; pg8::StaticOrder S; S.init(MTOK, NPROJ, F.G, F.bid);
            pg8::EpiRoute<0> E{PROJ, NPROJ, PROJ, NPROJ, 1 << 20};
            pg8::gemm_phase<pg8::EpiRoute<0>, pg8::StaticOrder, true, true>(glds, g, S, E, F.tid); } __syncthreads();
#elif defined(PROBE_GB)
            { pg8::Gemm g{XN, (const bf16*)(wsp + WS_WIN) + (size_t)l * NPROJ * DM, MTOK, NPROJ, DM}; pg8::StaticOrder S; S.init(MTOK, NPROJ, F.G, F.bid);
            pg8::EpiRouteN<0> E{PROJ, NPROJ, (const float*)(wsp + WS_RSP), (const float*)(wsp + WS_SHW) + (size_t)l * BATCH * NSHW, glds};
            pg8::gemm_phase<pg8::EpiRouteN<0>, pg8::StaticOrder, true, true>(glds, g, S, E, F.tid); } __syncthreads();
#endif
        EN(2) { pg8::Gemm g{XN, (const bf16*)(wsp + WS_WIN) + (size_t)l * NPROJ * DM, MTOK, NPROJ, DM}; pg8::StaticOrder S; S.init(MTOK, NPROJ, F.G, F.bid);
            pg8::EpiRouteN<0> E{PROJ, NPROJ, (const float*)(wsp + WS_RSP), (const float*)(wsp + WS_SHW) + (size_t)l * BATCH * NSHW, glds};
            pg8::gemm_phase<pg8::EpiRouteN<0>, pg8::StaticOrder, true, true>(glds, g, S, E, F.tid); } PH_END
        PH_BEGIN EN(3) ph_prep(F, l); DUP(3) ph_prep(F, l); EN(4) ph_lru1(F, l); DUP(4) ph_lru1(F, l); EN(5) ph_mlstm(F, l); DUP(5) ph_mlstm(F, l); PH_END
        PH_BEGIN EN(6) { ph_carry(F); pg8::Gemm g{(const bf16*)(wsp + WS_QL), (const bf16*)(wsp + WS_WQC) + (size_t)l * 768 * 256, MTOK, 768, 256}; pg8::StaticOrder S; S.init(MTOK, 768, F.G, F.bid);
            pg8::EpiRoute<0> E{(bf16*)(wsp + WS_QABS), 512, (bf16*)(wsp + WS_QIDX), 256, 2};
            pg8::gemm_phase<pg8::EpiRoute<0>, pg8::StaticOrder, true, true>(glds, g, S, E, F.tid); } PH_END
        PH_BEGIN EN(7) ph_dsa(F, l); DUP(7) ph_dsa(F, l); EN(8) ph_lru2(F, l); DUP(8) ph_lru2(F, l); EN(9) ph_mfin(F, l); DUP(9) ph_mfin(F, l); PH_END
        PH_BEGIN EN(10) { pg8::Gemm g{CAT, (const bf16*)(wsp + WS_WO) + (size_t)l * DM * DM, MTOK, DM, DM}; pg8::StaticOrder S; S.init(MTOK, DM, F.G, F.bid);
            pg8::EpiResidXS<false> E{(const pg8::bf16_t*)POUT(F), (pg8::bf16_t*)POUT(F), modl + 2 * DM, (const float*)(wsp + WS_WP) + (size_t)(l * 2 + 1) * BATCH * DM, XN, (float*)(wsp + WS_RSP), 1};
            pg8::gemm_phase<pg8::EpiResidXS<false>, pg8::StaticOrder, true, true>(glds, g, S, E, F.tid); } PH_END
        PH_BEGIN EN(12) { pg8::Gemm g{XN, (const bf16*)(wsp + WS_W1) + (size_t)l * DFF * DM, MTOK, DFF, DM}; pg8::StaticOrder S; S.init(MTOK, DFF, F.G, F.bid);
            pg8::EpiRouteN<1> E{HB, DFF, (const float*)(wsp + WS_RSP), (const float*)(wsp + WS_SHW) + (size_t)l * BATCH * NSHW + NPROJ, glds};
            pg8::gemm_phase<pg8::EpiRouteN<1>, pg8::StaticOrder, true, true>(glds, g, S, E, F.tid); } PH_END
        PH_BEGIN EN(13) { pg8::Gemm g{HB, (const bf16*)(wsp + WS_W2) + (size_t)l * DM * DFF, MTOK, DM, DFF}; pg8::StaticOrder S; S.init(MTOK, DM, F.G, F.bid);
            const int nl = l + 1 < DEPTH ? l + 1 : l;
            const bool lastl = l_ + 1 >= DBG_LAYERS;
            pg8::EpiResidXS<true> E{(const pg8::bf16_t*)POUT(F), lastl ? (pg8::bf16_t*)XN : (pg8::bf16_t*)POUT(F), modl + 5 * DM, (const float*)(wsp + WS_WP) + (size_t)(nl * 2) * BATCH * DM, XN, (float*)(wsp + WS_RSP), lastl ? 0 : 1};
            pg8::gemm_phase<pg8::EpiResidXS<true>, pg8::StaticOrder, true, true>(glds, g, S, E, F.tid); } PH_END
    }
#ifdef DBG_DIGEST
    PH_BEGIN { const int gw = F.bid * 8 + F.wave, NGW = F.G * 8; float* o = POUT(F);
        for (int m = gw; m < MTOK; m += NGW) for (int j = 0; j < 16; ++j) { const int c = F.lane + 64 * j; float v = 0.f;
            if (c < DBG_DIGEST_N) { v = DBG_DIGEST_VAL(m, c) * 4096.0f; v = v - floorf(v); }
            o[(size_t)m * DM + c] = v; } } PH_END
#else
    PH_BEGIN EN(14) ph_finalnorm16(F, XN, PIN(F, I_FNW), POUT(F)); PH_END
#endif
}

extern "C" void kernel_launch(void* const* d_in, const int* in_sizes, int n_in, void* d_out, int out_size, void* d_ws, size_t ws_size, hipStream_t stream) {
    static int grid = 0;
    if (grid == 0) {
        if (n_in != 28 || in_sizes[0] != MTOK * DM || out_size != MTOK * DM || ws_size < WS_END) { fprintf(stderr, "kernel_launch: unexpected shapes (n_in %d, in0 %d, out %d, ws %zu)\n", n_in, n_in > 0 ? in_sizes[0] : -1, out_size, ws_size); grid = -1; return; }
        int dev = 0, cus = 0, per_cu = 0;
        if (hipGetDevice(&dev) != hipSuccess || hipDeviceGetAttribute(&cus, hipDeviceAttributeMultiprocessorCount, dev) != hipSuccess) { grid = -1; return; }
        if (hipFuncSetAttribute((const void*)hymba_fwd, hipFuncAttributeMaxDynamicSharedMemorySize, LDS_BYTES) != hipSuccess) { fprintf(stderr, "kernel_launch: hipFuncSetAttribute failed\n"); grid = -1; return; }
        if (hipOccupancyMaxActiveBlocksPerMultiprocessor(&per_cu, (const void*)hymba_fwd, 512, LDS_BYTES) != hipSuccess || per_cu < 1) { fprintf(stderr, "kernel_launch: occupancy query says %d\n", per_cu); }
        (void)hipGetLastError();
        grid = cus;
    }
    if (grid < 0) return;
    if (hipMemsetAsync((char*)d_ws + WS_CTL, 0, CTL_ZERO_BYTES, stream) != hipSuccess) return;
    Args a{};
    for (int i = 0; i < 28; ++i) a.in[i] = (const float*)d_in[i];
    a.out = (float*)d_out; a.ws = (unsigned char*)d_ws;
#if MK_MULTI
    for (int p = 0; p < NPHASE; ++p) { a.ph_lo = p; a.ph_hi = p + 1; hipLaunchKernelGGL(hymba_fwd, dim3(grid), dim3(512), LDS_BYTES, stream, a); }
#else
    a.ph_lo = 0; a.ph_hi = DBG_PH_HI; hipLaunchKernelGGL(hymba_fwd, dim3(grid), dim3(512), LDS_BYTES, stream, a);
#endif
}
#endif
```

```cpp
#ifndef HOST_EMU
#include <hip/hip_runtime.h>
#include <cstdio>
#include <cstdint>
#define DEV __device__ __forceinline__
#define LAS __attribute__((address_space(3)))
#else
#include "emu.h"
#endif

#ifndef HOST_EMU
#define SYNC() __syncthreads()
#define KEEP4(a, b, c, d) asm volatile("" :: "v"(a), "v"(b), "v"(c), "v"(d))
#define LAUNDER_V(x) asm volatile("" : "+v"(x))
#define WAVE_LDS_FENCE() asm volatile("s_waitcnt lgkmcnt(0)" ::: "memory")
template <class T> DEV T SHFL(T v, int s) { return __shfl(v, s); }
template <class T> DEV T SHFL_XOR(T v, int m) { return __shfl_xor(v, m); }
template <class T> DEV T SHFL_UP(T v, int d) { return __shfl_up(v, d); }
template <class T> DEV T SHFL_DOWN(T v, int d) { return __shfl_down(v, d); }
typedef short bf16x8_ __attribute__((ext_vector_type(8)));
typedef float f32x4_ __attribute__((ext_vector_type(4)));
typedef short v4i16_t __attribute__((ext_vector_type(4)));
DEV f32x4_ MFMA16(bf16x8_ a, bf16x8_ b, f32x4_ c) { return __builtin_amdgcn_mfma_f32_16x16x32_bf16(a, b, c, 0, 0, 0); }
DEV v4i16_t TR16(const void* p) { return __builtin_amdgcn_ds_read_tr16_b64_v4i16((LAS v4i16_t*)(p)); }
#endif


typedef unsigned short bf16;
typedef short bf16x8 __attribute__((ext_vector_type(8)));
typedef short s16x4 __attribute__((ext_vector_type(4)));
typedef float f32x4 __attribute__((ext_vector_type(4)));
typedef unsigned u32x4 __attribute__((ext_vector_type(4)));
typedef unsigned u32x2 __attribute__((ext_vector_type(2)));

constexpr int BATCH = 16, SEQ = 4096, DM = 1024, DEPTH = 4, MTOK = BATCH * SEQ;
constexpr int NPROJ = 3072, DFF = 4096, NADA = 6 * DM;
constexpr int PC_LX = 0, PC_LY = 256, PC_MQ = 512, PC_MK = 1024, PC_MV = 1536, PC_MO = 2048, PC_AQ = 2560, PC_AKV = 2816, PC_IK = 2944, PC_IW = 2976, PC_MI = 2984, PC_MF = 2988;
constexpr float NORM_EPS = 1e-6f;

constexpr size_t MiB = 1u << 20;
constexpr size_t WS_CTL = 0, CTL_ZERO_BYTES = 1 * MiB;
constexpr size_t WS_MOD = 1 * MiB;
constexpr size_t WS_WQC = 3 * MiB;
constexpr size_t WS_WG = 5 * MiB;
constexpr size_t WS_WUVT = 6 * MiB;
constexpr size_t WS_WIN = 8 * MiB;
constexpr size_t WS_WO = 32 * MiB;
constexpr size_t WS_W1 = 40 * MiB;
constexpr size_t WS_W2 = 72 * MiB;
constexpr size_t WS_XN = 104 * MiB;
constexpr size_t WS_QL = WS_XN, WS_CKV = WS_XN + 32 * MiB, WS_QIDX = WS_XN + 48 * MiB, WS_KIDX = WS_XN + 80 * MiB, WS_WI = WS_XN + 84 * MiB, WS_GT = WS_XN + 86 * MiB;
constexpr size_t WS_CAT = 232 * MiB;
constexpr size_t WS_PROJ = 360 * MiB;
constexpr size_t WS_HB = 360 * MiB;
constexpr size_t WS_QABS = 744 * MiB;
constexpr size_t WS_HLOC = 808 * MiB, WS_CPA = 840 * MiB;
constexpr size_t WS_LSUM = 872 * MiB;
constexpr size_t WS_HM = 874 * MiB;
constexpr size_t WS_MG = 940 * MiB;
constexpr size_t WS_WP = 2 * MiB + 512 * 1024;
constexpr size_t WS_SHW = 6 * MiB + 256 * 1024;
constexpr size_t WS_RSP = 1000 * MiB;
constexpr size_t WS_CARRY = 948 * MiB;
constexpr size_t WS_SCR2 = 949 * MiB;
constexpr int NSHW = NPROJ + DFF;
constexpr size_t WS_END = 1024 * MiB;
static_assert(WS_HM + (size_t)MTOK * 512 * 2 <= WS_END && WS_HB + (size_t)MTOK * DFF * 2 <= WS_HLOC + 64 * MiB, "ws map");

constexpr int CW_TMO = 0, CW_BAR = 4096;

#ifndef HOST_EMU
typedef __bf16 hwbf2_t __attribute__((ext_vector_type(2)));
typedef float hwf2_t __attribute__((ext_vector_type(2)));
DEV unsigned f2bf(float f) { return (unsigned)__builtin_bit_cast(unsigned short, (__bf16)f); }
DEV unsigned pk2(float lo, float hi) { const hwf2_t v = {lo, hi}; return __builtin_bit_cast(unsigned, __builtin_convertvector(v, hwbf2_t)); }
#else
DEV unsigned f2bf(float f) { unsigned u = __builtin_bit_cast(unsigned, f); return (u + 0x7fffu + ((u >> 16) & 1u)) >> 16; }
DEV unsigned pk2(float lo, float hi) { return f2bf(lo) | (f2bf(hi) << 16); }
#endif
DEV float bf2f(unsigned h) { return __builtin_bit_cast(float, h << 16); }
DEV float bflo(unsigned w) { return __builtin_bit_cast(float, w << 16); }
DEV float bfhi(unsigned w) { return __builtin_bit_cast(float, w & 0xffff0000u); }
DEV float wave_sum(float v) {
#pragma unroll
    for (int o = 1; o < 64; o <<= 1) v += SHFL_XOR(v, o);
    return v;
}
#ifndef HOST_EMU
DEV float FEXP(float x) { return __expf(x); }
DEV float FEXP2(float x) { return __builtin_amdgcn_exp2f(x); }
DEV float FRCP(float x) { return __builtin_amdgcn_rcpf(x); }
DEV float FSQRT(float x) { return __builtin_amdgcn_sqrtf(x); }
DEV float RSQ(float x) { return __builtin_amdgcn_rsqf(x); }
DEV float FLOG(float x) { return __logf(x); }
#else
DEV float FEXP(float x) { return expf(x); }
DEV float FEXP2(float x) { return exp2f(x); }
DEV float FRCP(float x) { return 1.0f / x; }
DEV float FSQRT(float x) { return sqrtf(x); }
DEV float RSQ(float x) { return 1.0f / sqrtf(x); }
DEV float FLOG(float x) { return logf(x); }
#endif
#ifndef HOST_EMU
DEV int UNI(int x) { return __builtin_amdgcn_readfirstlane(x); }
#else
DEV int UNI(int x) { return x; }
#endif
#ifndef HOST_EMU
#define GAS __attribute__((address_space(1)))
DEV const GAS char* UNIP(const void* p) { const unsigned long long v = (unsigned long long)p; const unsigned lo = __builtin_amdgcn_readfirstlane((unsigned)v), hi = __builtin_amdgcn_readfirstlane((unsigned)(v >> 32));
    return (const GAS char*)(((unsigned long long)hi << 32) | lo); }
#else
#define GAS
DEV const char* UNIP(const void* p) { return (const char*)p; }
#endif
DEV float RELU(float x) { const int b = __builtin_bit_cast(int, x); return __builtin_bit_cast(float, b > 0 ? b : 0); }
DEV float sigmoidf_(float z) { return 1.0f / (1.0f + expf(-z)); }
DEV float fsigmoid(float z) { return FRCP(1.0f + FEXP(-z)); }
DEV float one_minus_exp(float x) {
    const float s = -x * (1.0f + x * (0.5f + x * (0.16666667f + x * 0.041666668f)));
    return x > -0.05f ? s : 1.0f - FEXP(x);
}

struct Args { const float* in[28]; float* out; unsigned char* ws; int ph_lo, ph_hi; };
struct Ctx {
    char* lds; int tid, lane, wave, G, bid;
    const Args* A;
    unsigned char* ws;
};

constexpr int PTR_OFF = 131072 + 512;
#ifndef HOST_EMU
DEV const float* PIN(const Ctx& F, int i) { const unsigned long long v = ((const unsigned long long*)(F.lds + PTR_OFF))[i];
    const unsigned lo = __builtin_amdgcn_readfirstlane((unsigned)v), hi = __builtin_amdgcn_readfirstlane((unsigned)(v >> 32)); return (const float*)(const __attribute__((address_space(1))) float*)(((unsigned long long)hi << 32) | lo); }
DEV float* POUT(const Ctx& F) { return (float*)PIN(F, 28); }
#else
DEV const float* PIN(const Ctx& F, int i) { return F.A->in[i]; }
DEV float* POUT(const Ctx& F) { return POUT(F); }
#endif
enum { I_X = 0, I_C, I_WIN, I_CONVW, I_CONVB, I_WA, I_BA, I_WX, I_BX, I_LAM, I_BI, I_BF, I_WQUP, I_WQIDX, I_WUK, I_WUV, I_QNW, I_KVNW, I_RELB, I_GNW, I_WO, I_WADA, I_BADA, I_N1W, I_N2W, I_W1, I_W2, I_FNW };

DEV int win_srccol(int n) {
    if (n < 2560) return n;
    if (n < PC_AKV) return 2568 + (n - PC_AQ);
    if (n < PC_IK) return 2824 + (n - PC_AKV);
    if (n < PC_IW) return 2952 + (n - PC_IK);
    if (n < PC_MI) return 2984 + (n - PC_IW);
    if (n < PC_MF) return 2560 + (n - PC_MI);
    if (n < 2992) return 2564 + (n - PC_MF);
    return -1;
}
template <bool MAPPED>
DEV void p0_transpose_item(const float* W, int K, int N, int NT, bf16* WT, float* scr, int item, int lane) {
    const int nblk = NT / 32, kb = item / nblk, nb = item % nblk, k0 = 64 * kb, n0 = 32 * nb;
    int sc = n0 + (lane & 31); if (MAPPED) sc = win_srccol(sc);
#pragma unroll 8
    for (int i = 0; i < 32; ++i) { const int kk = 2 * i + (lane >> 5); const float v = W[(size_t)(k0 + kk) * N + (sc >= 0 ? sc : 0)]; scr[kk * 33 + (lane & 31)] = sc >= 0 ? v : 0.f; }
    WAVE_LDS_FENCE();
    const int c = lane & 7;
#pragma unroll
    for (int j = 0; j < 4; ++j) { const int n = (lane >> 3) + 8 * j; const float* s = scr + (8 * c) * 33 + n;
        u32x4 o; o.x = pk2(s[0 * 33], s[1 * 33]); o.y = pk2(s[2 * 33], s[3 * 33]); o.z = pk2(s[4 * 33], s[5 * 33]); o.w = pk2(s[6 * 33], s[7 * 33]);
        *(u32x4*)(WT + (size_t)(n0 + n) * K + k0 + 8 * c) = o; }
    WAVE_LDS_FENCE();
}

DEV void ph_prologue(const Ctx& F) {
    const int gt = F.bid * 512 + F.tid, NGT = F.G * 512;
    float* CACT = (float*)F.lds;
    for (int i = F.tid; i < BATCH * DM; i += 512) { const float cv = PIN(F, I_C)[i]; CACT[i] = cv * sigmoidf_(cv); }
    SYNC();
    for (int e = gt; e < DEPTH * NADA * 4; e += NGT) {
        const int j = e % NADA, bq = (e / NADA) & 3, l = e / (NADA * 4);
        const float* w = PIN(F, I_WADA) + (size_t)l * DM * NADA + j;
        const float* c = CACT + bq * 4 * DM;
        float a0 = 0.f, a1 = 0.f, a2 = 0.f, a3 = 0.f;
#pragma unroll 8
        for (int k = 0; k < DM; k += 4) {
            const float w0 = w[(size_t)k * NADA], w1 = w[(size_t)(k + 1) * NADA], w2 = w[(size_t)(k + 2) * NADA], w3 = w[(size_t)(k + 3) * NADA];
            const f32x4 c0 = *(const f32x4*)(c + k), c1 = *(const f32x4*)(c + DM + k), c2 = *(const f32x4*)(c + 2 * DM + k), c3 = *(const f32x4*)(c + 3 * DM + k);
            a0 += (c0.x * w0 + c0.y * w1) + (c0.z * w2 + c0.w * w3); a1 += (c1.x * w0 + c1.y * w1) + (c1.z * w2 + c1.w * w3);
            a2 += (c2.x * w0 + c2.y * w1) + (c2.z * w2 + c2.w * w3); a3 += (c3.x * w0 + c3.y * w1) + (c3.z * w2 + c3.w * w3); }
        const float bb = PIN(F, I_BADA)[(size_t)l * NADA + j];
        float* mo = (float*)(F.ws + WS_MOD) + ((size_t)l * BATCH + bq * 4) * NADA + j;
        mo[0] = a0 + bb; mo[NADA] = a1 + bb; mo[2 * NADA] = a2 + bb; mo[3 * NADA] = a3 + bb;
    }
    for (int e = gt; e < DEPTH * 2 * 4 * 64 * 64; e += NGT) {
        const int i = e & 63, j = (e >> 6) & 63, blk = (e >> 12) & 3, g = (e >> 14) & 1, l = e >> 15;
        const float* src = PIN(F, g ? I_WX : I_WA) + (((size_t)l * 4 + blk) * 64 + i) * 64 + j;
        ((bf16*)(F.ws + WS_WG))[e] = (bf16)f2bf(*src);
    }
    for (int e = gt; e < DEPTH * 4 * 64 * 128; e += NGT) {
        const int r = e & 127, d = (e >> 7) & 63, h = (e >> 13) & 3, l = e >> 15;
        ((bf16*)(F.ws + WS_WUVT))[e] = (bf16)f2bf(PIN(F, I_WUV)[(((size_t)l * 128 + r) * 4 + h) * 64 + d]);
    }
    for (int e = gt; e < DEPTH * 768 * 256; e += NGT) {
        const int r = e & 255, n = (e >> 8) % 768, l = e / (768 * 256);
        float v;
        if (n < 512) { const int h = n >> 7, c = n & 127; const f32x4* q = (const f32x4*)(PIN(F, I_WQUP) + ((size_t)l * 256 + r) * 256 + h * 64); const f32x4* k = (const f32x4*)(PIN(F, I_WUK) + ((size_t)l * 128 + c) * 256 + h * 64);
            float s = 0.f;
#pragma unroll
            for (int d = 0; d < 16; ++d) { const f32x4 a = q[d], bq4 = k[d]; s += (a.x * bq4.x + a.y * bq4.y) + (a.z * bq4.z + a.w * bq4.w); }
            v = s * (0.125f * 1.4426950408889634f); }
        else v = PIN(F, I_WQIDX)[((size_t)l * 256 + r) * 256 + (n - 512)] * 0.17677669529663687f;
        ((bf16*)(F.ws + WS_WQC))[e] = (bf16)f2bf(v);
    }
    SYNC();
    float* scr = (float*)(F.lds + F.wave * 16384);
    const int gw = F.bid * 8 + F.wave, NGW = F.G * 8;
    constexpr int I_IN = (DM / 64) * (NPROJ / 32), I_O = (DM / 64) * (DM / 32), I_1 = (DM / 64) * (DFF / 32), I_2 = (DFF / 64) * (DM / 32);
    constexpr int PER_L = I_IN + I_O + I_1 + I_2;
    for (int it = gw; it < DEPTH * PER_L; it += NGW) {
        const int l = it / PER_L; int r = it % PER_L;
        if (r < I_IN) { p0_transpose_item<true>(PIN(F, I_WIN) + (size_t)l * DM * 2992, DM, 2992, NPROJ, (bf16*)(F.ws + WS_WIN) + (size_t)l * NPROJ * DM, scr, r, F.lane); continue; } r -= I_IN;
        if (r < I_O) { p0_transpose_item<false>(PIN(F, I_WO) + (size_t)l * DM * DM, DM, DM, DM, (bf16*)(F.ws + WS_WO) + (size_t)l * DM * DM, scr, r, F.lane); continue; } r -= I_O;
        if (r < I_1) { p0_transpose_item<false>(PIN(F, I_W1) + (size_t)l * DM * DFF, DM, DFF, DFF, (bf16*)(F.ws + WS_W1) + (size_t)l * DFF * DM, scr, r, F.lane); continue; } r -= I_1;
        p0_transpose_item<false>(PIN(F, I_W2) + (size_t)l * DFF * DM, DFF, DM, DM, (bf16*)(F.ws + WS_W2) + (size_t)l * DM * DFF, scr, r, F.lane);
    }
}

DEV void ph_xs0(const Ctx& F, const float* xsrc, const float* nw, const float* modl, int sc_off, bf16* XS, float* RSP, bf16* X16) {
    const int gw = F.bid * 8 + F.wave, NGW = F.G * 8;
    f32x4 wv[4];
#pragma unroll
    for (int j = 0; j < 4; ++j) wv[j] = *(const f32x4*)(nw + 4 * F.lane + 256 * j);
    f32x4 v[2][4], vn[2][4];
#pragma unroll
    for (int q = 0; q < 2; ++q) { const int m = gw + q * NGW; const f32x4* xr = (const f32x4*)(xsrc + (size_t)(m < MTOK ? m : 0) * DM) + F.lane;
#pragma unroll
        for (int j = 0; j < 4; ++j) v[q][j] = xr[64 * j]; }
    for (int m0 = gw; m0 < MTOK; m0 += 2 * NGW) {
        f32x4 sc[2][4];
#pragma unroll
        for (int q = 0; q < 2; ++q) { const int m = m0 + q * NGW; const float* mb = modl + (size_t)((m < MTOK ? m : 0) >> 12) * NADA + 4 * F.lane;
#pragma unroll
            for (int j = 0; j < 4; ++j) sc[q][j] = *(const f32x4*)(mb + sc_off + 256 * j); }
#pragma unroll
        for (int q = 0; q < 2; ++q) { const int m = m0 + (2 + q) * NGW; const f32x4* xr = (const f32x4*)(xsrc + (size_t)(m < MTOK ? m : 0) * DM) + F.lane;
#pragma unroll
            for (int j = 0; j < 4; ++j) vn[q][j] = xr[64 * j]; }
        float s[2];
#pragma unroll
        for (int q = 0; q < 2; ++q) { float a = 0.f;
#pragma unroll
            for (int j = 0; j < 4; ++j) a += (v[q][j].x * v[q][j].x + v[q][j].y * v[q][j].y) + (v[q][j].z * v[q][j].z + v[q][j].w * v[q][j].w);
            s[q] = a; }
#pragma unroll
        for (int o = 1; o < 64; o <<= 1) { s[0] += SHFL_XOR(s[0], o); s[1] += SHFL_XOR(s[1], o); }
#pragma unroll
        for (int q = 0; q < 2; ++q) { const int m = m0 + q * NGW; if (m >= MTOK) break;
            if (F.lane < 16) RSP[(size_t)m * 16 + F.lane] = F.lane == 0 ? s[q] : 0.f;
            u32x2* o8 = (u32x2*)(XS + (size_t)m * DM) + F.lane; u32x2* x8 = (u32x2*)(X16 + (size_t)m * DM) + F.lane;
#pragma unroll
            for (int j = 0; j < 4; ++j) { const f32x4 y = v[q][j] * (wv[j] * (1.0f + sc[q][j]));
                u32x2 p; p.x = pk2(y.x, y.y); p.y = pk2(y.z, y.w); o8[64 * j] = p;
                u32x2 c; c.x = pk2(v[q][j].x, v[q][j].y); c.y = pk2(v[q][j].z, v[q][j].w); x8[64 * j] = c; } }
#pragma unroll
        for (int q = 0; q < 2; ++q)
#pragma unroll
            for (int j = 0; j < 4; ++j) v[q][j] = vn[q][j];
    }
}
DEV void ph_shw(const Ctx& F) {
    const int gt = F.bid * 512 + F.tid, NGT = F.G * 512;
    for (int e = gt; e < DEPTH * 2 * BATCH * (DM / 4); e += NGT) {
        const int c4 = e & 255, b = (e >> 8) & 15, w = (e >> 12) & 1, l = e >> 13;
        const f32x4 nwv = *(const f32x4*)(PIN(F, w ? I_N2W : I_N1W) + l * DM + 4 * c4);
        const f32x4 sc = *(const f32x4*)((const float*)(F.ws + WS_MOD) + ((size_t)l * BATCH + b) * NADA + (w ? 4 * DM : DM) + 4 * c4);
        ((f32x4*)(F.ws + WS_WP))[e] = nwv * (1.0f + sc);
    }
    const int gw = F.bid * 8 + F.wave, NGW = F.G * 8, i16 = F.lane & 15, kq = 8 * (F.lane >> 4);
    for (int it = gw; it < DEPTH * (NSHW / 16); it += NGW) {
        const int l = it / (NSHW / 16), n0 = (it % (NSHW / 16)) * 16;
        const bool mlp = n0 >= NPROJ;
        const bf16* Wr = mlp ? (const bf16*)(F.ws + WS_W1) + ((size_t)l * DFF + (n0 - NPROJ) + i16) * DM : (const bf16*)(F.ws + WS_WIN) + ((size_t)l * NPROJ + n0 + i16) * DM;
        const float* sh = (const float*)(F.ws + WS_MOD) + ((size_t)l * BATCH + i16) * NADA + (mlp ? 3 * DM : 0);
        f32x4 acc0 = {0.f, 0.f, 0.f, 0.f}, acc1 = {0.f, 0.f, 0.f, 0.f};
#pragma unroll 4
        for (int s = 0; s < DM / 32; ++s) {
            const bf16x8 B = *(const bf16x8*)(Wr + 32 * s + kq);
            const f32x4 a0 = *(const f32x4*)(sh + 32 * s + kq), a1 = *(const f32x4*)(sh + 32 * s + kq + 4);
            bf16x8 Ah, Al;
#pragma unroll
            for (int j = 0; j < 8; ++j) { const float a = j < 4 ? a0[j] : a1[j - 4]; const unsigned h = f2bf(a); Ah[j] = (short)h; Al[j] = (short)f2bf(a - bf2f(h)); }
            acc0 = MFMA16(Ah, B, acc0); acc1 = MFMA16(Al, B, acc1);
        }
        float* o = (float*)(F.ws + WS_SHW) + ((size_t)l * BATCH + 4 * (F.lane >> 4)) * NSHW + n0 + i16;
#pragma unroll
        for (int r = 0; r < 4; ++r) o[(size_t)r * NSHW] = acc0[r] + acc1[r];
    }
}
DEV void ph_normmod(const Ctx& F, const float* xsrc, const float* nw, const float* modl, int sh_off, int sc_off, bf16* XN) {
    const int gw = F.bid * 8 + F.wave, NGW = F.G * 8;
    f32x4 wv[4];
#pragma unroll
    for (int j = 0; j < 4; ++j) wv[j] = *(const f32x4*)(nw + 4 * F.lane + 256 * j);
    f32x4 v[2][4], vn[2][4];
#pragma unroll
    for (int q = 0; q < 2; ++q) { const int m = gw + q * NGW; const f32x4* xr = (const f32x4*)(xsrc + (size_t)(m < MTOK ? m : 0) * DM) + F.lane;
#pragma unroll
        for (int j = 0; j < 4; ++j) v[q][j] = xr[64 * j]; }
    for (int m0 = gw; m0 < MTOK; m0 += 2 * NGW) {
        f32x4 sc[2][4], sh[2][4];
#pragma unroll
        for (int q = 0; q < 2; ++q) { const int m = m0 + q * NGW; const float* mb = modl + (size_t)((m < MTOK ? m : 0) >> 12) * NADA + 4 * F.lane;
#pragma unroll
            for (int j = 0; j < 4; ++j) { sc[q][j] = *(const f32x4*)(mb + sc_off + 256 * j); sh[q][j] = *(const f32x4*)(mb + sh_off + 256 * j); } }
#pragma unroll
        for (int q = 0; q < 2; ++q) { const int m = m0 + (2 + q) * NGW; const f32x4* xr = (const f32x4*)(xsrc + (size_t)(m < MTOK ? m : 0) * DM) + F.lane;
#pragma unroll
            for (int j = 0; j < 4; ++j) vn[q][j] = xr[64 * j]; }
        float s[2];
#pragma unroll
        for (int q = 0; q < 2; ++q) { float a = 0.f;
#pragma unroll
            for (int j = 0; j < 4; ++j) a += (v[q][j].x * v[q][j].x + v[q][j].y * v[q][j].y) + (v[q][j].z * v[q][j].z + v[q][j].w * v[q][j].w);
            s[q] = a; }
#pragma unroll
        for (int o = 1; o < 64; o <<= 1) { s[0] += SHFL_XOR(s[0], o); s[1] += SHFL_XOR(s[1], o); }
#pragma unroll
        for (int q = 0; q < 2; ++q) { const int m = m0 + q * NGW; if (m >= MTOK) break;
            const float rs = RSQ(s[q] * (1.0f / DM) + NORM_EPS);
            u32x2* o8 = (u32x2*)(XN + (size_t)m * DM) + F.lane;
#pragma unroll
            for (int j = 0; j < 4; ++j) { const f32x4 y = v[q][j] * rs * wv[j] * (1.0f + sc[q][j]) + sh[q][j];
                u32x2 p; p.x = pk2(y.x, y.y); p.y = pk2(y.z, y.w); o8[64 * j] = p; } }
#pragma unroll
        for (int q = 0; q < 2; ++q)
#pragma unroll
            for (int j = 0; j < 4; ++j) v[q][j] = vn[q][j];
    }
}
DEV void ph_finalnorm(const Ctx& F, const float* xsrc, const float* nw, float* out) {
    const int gw = F.bid * 8 + F.wave, NGW = F.G * 8;
    f32x4 wv[4];
#pragma unroll
    for (int j = 0; j < 4; ++j) wv[j] = *(const f32x4*)(nw + 4 * F.lane + 256 * j);
    f32x4 v[2][4], vn[2][4];
#pragma unroll
    for (int q = 0; q < 2; ++q) { const int m = gw + q * NGW; const f32x4* xr = (const f32x4*)(xsrc + (size_t)(m < MTOK ? m : 0) * DM) + F.lane;
#pragma unroll
        for (int j = 0; j < 4; ++j) v[q][j] = xr[64 * j]; }
    for (int m0 = gw; m0 < MTOK; m0 += 2 * NGW) {
#pragma unroll
        for (int q = 0; q < 2; ++q) { const int m = m0 + (2 + q) * NGW; const f32x4* xr = (const f32x4*)(xsrc + (size_t)(m < MTOK ? m : 0) * DM) + F.lane;
#pragma unroll
            for (int j = 0; j < 4; ++j) vn[q][j] = xr[64 * j]; }
        float s[2];
#pragma unroll
        for (int q = 0; q < 2; ++q) { float a = 0.f;
#pragma unroll
            for (int j = 0; j < 4; ++j) a += (v[q][j].x * v[q][j].x + v[q][j].y * v[q][j].y) + (v[q][j].z * v[q][j].z + v[q][j].w * v[q][j].w);
            s[q] = a; }
#pragma unroll
        for (int o = 1; o < 64; o <<= 1) { s[0] += SHFL_XOR(s[0], o); s[1] += SHFL_XOR(s[1], o); }
#pragma unroll
        for (int q = 0; q < 2; ++q) { const int m = m0 + q * NGW; if (m >= MTOK) break;
            const float rs = RSQ(s[q] * (1.0f / DM) + NORM_EPS);
            f32x4* o = (f32x4*)(out + (size_t)m * DM) + F.lane;
#pragma unroll
            for (int j = 0; j < 4; ++j) o[64 * j] = v[q][j] * rs * wv[j]; }
#pragma unroll
        for (int q = 0; q < 2; ++q)
#pragma unroll
            for (int j = 0; j < 4; ++j) v[q][j] = vn[q][j];
    }
}
DEV void ph_finalnorm16(const Ctx& F, const bf16* x16, const float* nw, float* out) {
    const int gw = F.bid * 8 + F.wave, NGW = F.G * 8;
    f32x4 wv[2][2];
#pragma unroll
    for (int j = 0; j < 2; ++j) { wv[j][0] = *(const f32x4*)(nw + 8 * F.lane + 512 * j); wv[j][1] = *(const f32x4*)(nw + 8 * F.lane + 512 * j + 4); }
    u32x4 v[4][2], vn[4][2];
#pragma unroll
    for (int q = 0; q < 4; ++q) { const int m = gw + q * NGW; const bf16* xr = x16 + (size_t)(m < MTOK ? m : 0) * DM + 8 * F.lane;
        v[q][0] = *(const u32x4*)xr; v[q][1] = *(const u32x4*)(xr + 512); }
    for (int m0 = gw; m0 < MTOK; m0 += 4 * NGW) {
#pragma unroll
        for (int q = 0; q < 4; ++q) { const int m = m0 + (4 + q) * NGW; const bf16* xr = x16 + (size_t)(m < MTOK ? m : 0) * DM + 8 * F.lane;
            vn[q][0] = *(const u32x4*)xr; vn[q][1] = *(const u32x4*)(xr + 512); }
        float s[4];
#pragma unroll
        for (int q = 0; q < 4; ++q) { float a = 0.f;
#pragma unroll
            for (int j = 0; j < 2; ++j) { const u32x4 r = v[q][j];
                a += ((bflo(r.x) * bflo(r.x) + bfhi(r.x) * bfhi(r.x)) + (bflo(r.y) * bflo(r.y) + bfhi(r.y) * bfhi(r.y))) + ((bflo(r.z) * bflo(r.z) + bfhi(r.z) * bfhi(r.z)) + (bflo(r.w) * bflo(r.w) + bfhi(r.w) * bfhi(r.w))); }
            s[q] = a; }
#pragma unroll
        for (int o = 1; o < 64; o <<= 1) {
#pragma unroll
            for (int q = 0; q < 4; ++q) s[q] += SHFL_XOR(s[q], o); }
#pragma unroll
        for (int q = 0; q < 4; ++q) { const int m = m0 + q * NGW; if (m >= MTOK) break;
            const float rs = RSQ(s[q] * (1.0f / DM) + NORM_EPS);
            float* o = out + (size_t)m * DM + 8 * F.lane;
#pragma unroll
            for (int j = 0; j < 2; ++j) { const u32x4 r = v[q][j];
                *(f32x4*)(o + 512 * j) = (f32x4){bflo(r.x), bfhi(r.x), bflo(r.y), bfhi(r.y)} * rs * wv[j][0];
                *(f32x4*)(o + 512 * j + 4) = (f32x4){bflo(r.z), bfhi(r.z), bflo(r.w), bfhi(r.w)} * rs * wv[j][1]; } }
#pragma unroll
        for (int q = 0; q < 4; ++q) { v[q][0] = vn[q][0]; v[q][1] = vn[q][1]; }
    }
}
DEV void ph_zero_cat(const Ctx& F, int c0, int nq) {
    const int gw = F.bid * 8 + F.wave, NGW = F.G * 8;
    bf16* CAT = (bf16*)(F.ws + WS_CAT);
    for (int m = gw; m < MTOK; m += NGW) for (int q = 0; q < nq; ++q) *(u32x2*)(CAT + (size_t)m * DM + c0 + 256 * q + 4 * F.lane) = (u32x2){0u, 0u};
}
DEV float softcap15(float z) { return 15.0f * tanhf(z * (1.0f / 15.0f)); }
DEV float logsigmoidf_(float x) { return x >= 0.f ? -log1pf(expf(-x)) : x - log1pf(expf(x)); }
DEV void ph_prep(const Ctx& F, int l) {
    const int gw = F.bid * 8 + F.wave, NGW = F.G * 8, lane = F.lane;
    const bf16* PROJ = (const bf16*)(F.ws + WS_PROJ);
    bf16* QL = (bf16*)(F.ws + WS_QL); bf16* CKV = (bf16*)(F.ws + WS_CKV); bf16* KIDX = (bf16*)(F.ws + WS_KIDX);
    float* WI = (float*)(F.ws + WS_WI);
    const f32x4 qn = *(const f32x4*)(PIN(F, I_QNW) + l * 256 + 4 * lane);
    const float kn0 = PIN(F, I_KVNW)[l * 128 + 2 * lane], kn1 = PIN(F, I_KVNW)[l * 128 + 2 * lane + 1];
    u32x2 ra4[4], ran[4]; unsigned rk4[4], rx4[4], rkn[4], rxn[4];
#define PREP_LOAD(RA, RK, RX, M0) do { _Pragma("unroll") for (int q = 0; q < 4; ++q) { const int mm = (M0) + q * NGW; const bf16* pr = PROJ + (size_t)(mm < MTOK ? mm : 0) * NPROJ; \
            RA[q] = *(const u32x2*)(pr + PC_AQ + 4 * lane); RK[q] = *(const unsigned*)(pr + PC_AKV + 2 * lane); \
            RX[q] = lane < 16 ? *(const unsigned*)(pr + PC_IK + 2 * lane) : (lane < 24 ? (unsigned)pr[PC_IW + (lane - 16)] : 0u); } } while (0)
    PREP_LOAD(ra4, rk4, rx4, gw);
    for (int m0 = gw; m0 < MTOK; m0 += 4 * NGW) {
        PREP_LOAD(ran, rkn, rxn, m0 + 4 * NGW);
#pragma unroll
        for (int q = 0; q < 4; ++q) { const int m = m0 + q * NGW; if (m >= MTOK) break;
            const u32x2 ra = ra4[q]; const unsigned rk = rk4[q];
            const float a0 = bflo(ra.x), a1 = bfhi(ra.x), a2 = bflo(ra.y), a3 = bfhi(ra.y);
            const float k0 = bflo(rk), k1 = bfhi(rk);
            const float sq = wave_sum((a0 * a0 + a1 * a1) + (a2 * a2 + a3 * a3)), sk = wave_sum(k0 * k0 + k1 * k1);
            const float rq = RSQ(sq * (1.0f / 256.0f) + NORM_EPS), rk2 = RSQ(sk * (1.0f / 128.0f) + NORM_EPS);
            u32x2 oq; oq.x = pk2(a0 * rq * qn.x, a1 * rq * qn.y); oq.y = pk2(a2 * rq * qn.z, a3 * rq * qn.w);
            *(u32x2*)(QL + (size_t)m * 256 + 4 * lane) = oq;
            *(unsigned*)(CKV + (size_t)m * 128 + 2 * lane) = pk2(k0 * rk2 * kn0, k1 * rk2 * kn1);
            if (lane < 16) *(unsigned*)(KIDX + (size_t)m * 32 + 2 * lane) = rx4[q];
            else if (lane < 24) WI[(size_t)m * 8 + (lane - 16)] = bf2f(rx4[q]); }
#pragma unroll
        for (int q = 0; q < 4; ++q) { ra4[q] = ran[q]; rk4[q] = rkn[q]; rx4[q] = rxn[q]; }
    }
#undef PREP_LOAD
}

constexpr int XB_STRIDE = 264;
DEV void ph_lru1(const Ctx& F, int l) {
    const int tid = F.tid, lane = F.lane, w = F.wave, i16 = lane & 15, g = lane >> 4;
    bf16* XB = (bf16*)F.lds;
    float* XF = (float*)(F.lds + 64 * XB_STRIDE * 2);
    const bf16* PROJ = (const bf16*)(F.ws + WS_PROJ);
    bf16* HLOC = (bf16*)(F.ws + WS_HLOC); bf16* CPA = (bf16*)(F.ws + WS_CPA); float* LSUM = (float*)(F.ws + WS_LSUM);
    const int blk = w & 3, nh = w >> 2;
    const bf16* WG = (const bf16*)(F.ws + WS_WG) + (size_t)l * 2 * 4 * 4096;
    bf16x8 Bf[2][2][2];
#pragma unroll
    for (int gg = 0; gg < 2; ++gg)
#pragma unroll
        for (int nt = 0; nt < 2; ++nt)
#pragma unroll
            for (int ks = 0; ks < 2; ++ks) Bf[gg][nt][ks] = *(const bf16x8*)(WG + ((size_t)(gg * 4 + blk) * 64 + nh * 32 + 2 * i16 + nt) * 64 + ks * 32 + 8 * g);
    float ba[2], bx[2], sp[2];
#pragma unroll
    for (int nt = 0; nt < 2; ++nt) { const int ch = blk * 64 + nh * 32 + 2 * i16 + nt;
        ba[nt] = PIN(F, I_BA)[l * 256 + ch]; bx[nt] = PIN(F, I_BX)[l * 256 + ch];
        const float lam = PIN(F, I_LAM)[l * 256 + ch]; sp[nt] = lam > 0.f ? log1pf(expf(-lam)) : -lam + log1pf(expf(lam)); }
    const int ch2 = tid & 127, tg = tid >> 7;
    float cw[4][2], cb[2];
#pragma unroll
    for (int j = 0; j < 4; ++j) { cw[j][0] = PIN(F, I_CONVW)[(l * 4 + j) * 256 + 2 * ch2]; cw[j][1] = PIN(F, I_CONVW)[(l * 4 + j) * 256 + 2 * ch2 + 1]; }
    cb[0] = PIN(F, I_CONVB)[l * 256 + 2 * ch2]; cb[1] = PIN(F, I_CONVB)[l * 256 + 2 * ch2 + 1];

    for (int u = F.bid; u < BATCH * 64; u += F.G) {
        const int b = u >> 6, c = u & 63, t0 = c * 64; const size_t m0 = (size_t)b * SEQ + t0;
        {
            const int tl0 = tg * 16;
            unsigned rv[19];
#pragma unroll
            for (int j = 0; j < 3; ++j) { const int t = t0 + tl0 - 3 + j; rv[j] = t >= 0 ? *(const unsigned*)(PROJ + ((size_t)b * SEQ + t) * NPROJ + PC_LX + 2 * ch2) : 0u; }
#pragma unroll
            for (int tt = 0; tt < 16; ++tt) rv[3 + tt] = *(const unsigned*)(PROJ + (m0 + tl0 + tt) * NPROJ + PC_LX + 2 * ch2);
#pragma unroll
            for (int tt = 0; tt < 16; ++tt) { const int tl = tl0 + tt;
                const float x0 = cw[0][0] * bflo(rv[tt]) + cw[1][0] * bflo(rv[tt + 1]) + cw[2][0] * bflo(rv[tt + 2]) + cw[3][0] * bflo(rv[tt + 3]) + cb[0];
                const float x1 = cw[0][1] * bfhi(rv[tt]) + cw[1][1] * bfhi(rv[tt + 1]) + cw[2][1] * bfhi(rv[tt + 2]) + cw[3][1] * bfhi(rv[tt + 3]) + cb[1];
                *(unsigned*)(XB + tl * XB_STRIDE + 2 * ch2) = pk2(x0, x1);
                XF[tl * 256 + 2 * ch2] = x0; XF[tl * 256 + 2 * ch2 + 1] = x1; }
        }
        SYNC();
        float CA[2] = {1.f, 1.f}, CU[2] = {0.f, 0.f};
#pragma unroll 1
        for (int m = 0; m < 4; ++m) {
            f32x4 acc[2][2];
#pragma unroll
            for (int gg = 0; gg < 2; ++gg)
#pragma unroll
                for (int nt = 0; nt < 2; ++nt) acc[gg][nt] = (f32x4){0.f, 0.f, 0.f, 0.f};
#pragma unroll
            for (int ks = 0; ks < 2; ++ks) { const bf16x8 A = *(const bf16x8*)(XB + (m * 16 + i16) * XB_STRIDE + blk * 64 + ks * 32 + 8 * g);
#pragma unroll
                for (int gg = 0; gg < 2; ++gg)
#pragma unroll
                    for (int nt = 0; nt < 2; ++nt) acc[gg][nt] = MFMA16(A, Bf[gg][nt][ks], acc[gg][nt]); }
            float HL[2][4], CP[2][4];
            const int chb = blk * 64 + nh * 32 + 2 * i16;
            float xf[4][2];
#pragma unroll
            for (int r = 0; r < 4; ++r) { const float* xp = XF + (m * 16 + 4 * g + r) * 256 + chb; xf[r][0] = xp[0]; xf[r][1] = xp[1]; }
#pragma unroll
            for (int nt = 0; nt < 2; ++nt) {
                float P[4], H[4]; float pa = 1.f, hu = 0.f;
#pragma unroll
                for (int r = 0; r < 4; ++r) {
                    const float rg = fsigmoid(acc[0][nt][r] + ba[nt]), gi = fsigmoid(acc[1][nt][r] + bx[nt]);
                    const float la = -8.0f * rg * sp[nt], a = FEXP(la), uu = FSQRT((1.0f - a) * (1.0f + a)) * (gi * xf[r][nt]);
                    pa = a * pa; hu = a * hu + uu; P[r] = pa; H[r] = hu;
                    }
                float EA = 1.f, EU = 0.f, TA = 1.f, TU = 0.f;
#pragma unroll
                for (int gg = 0; gg < 4; ++gg) { const float ta = SHFL(pa, i16 + 16 * gg), tu = SHFL(hu, i16 + 16 * gg);
                    if (gg < g) { EU = ta * EU + tu; EA = ta * EA; }
                    TU = ta * TU + tu; TA = ta * TA; }
                const float XA = EA * CA[nt], XU = EA * CU[nt] + EU;
#pragma unroll
                for (int r = 0; r < 4; ++r) { HL[nt][r] = P[r] * XU + H[r]; CP[nt][r] = P[r] * XA; }
                CU[nt] = TA * CU[nt] + TU; CA[nt] = TA * CA[nt];
            }
#pragma unroll
            for (int r = 0; r < 4; ++r) { const size_t o = (m0 + m * 16 + 4 * g + r) * 256 + chb;
                *(unsigned*)(HLOC + o) = pk2(HL[0][r], HL[1][r]); *(unsigned*)(CPA + o) = pk2(CP[0][r], CP[1][r]); }
        }
        if (g == 0) {
#pragma unroll
            for (int nt = 0; nt < 2; ++nt) { const int ch = blk * 64 + nh * 32 + 2 * i16 + nt;
                LSUM[((size_t)b * 64 + c) * 256 + ch] = CA[nt]; LSUM[(size_t)BATCH * 64 * 256 + ((size_t)b * 64 + c) * 256 + ch] = CU[nt]; }
        }
        SYNC();
    }
}

DEV float gelu_tanh(float x) { const float z = 0.7978845608028654f * (x + 0.044715f * x * x * x); return x * FRCP(1.0f + FEXP(-2.0f * z)); }
DEV void ph_carry(const Ctx& F) {
    if (F.wave != 0) return;
    const float* LSUM = (const float*)(F.ws + WS_LSUM); float* CARRY = (float*)(F.ws + WS_CARRY);
    const int seg = F.lane & 3;
    for (int chain = F.bid * 16 + (F.lane >> 2); chain < BATCH * 256; chain += F.G * 16) {
        const int b = chain >> 8, ch = chain & 255; const size_t o0 = ((size_t)b * 64 + seg * 16) * 256 + ch;
        float a[16], hb[16];
#pragma unroll
        for (int i = 0; i < 16; ++i) { a[i] = LSUM[o0 + (size_t)i * 256]; hb[i] = LSUM[(size_t)BATCH * 64 * 256 + o0 + (size_t)i * 256]; }
        float hp[16], ap[16], hl = 0.f, al = 1.f;
#pragma unroll
        for (int i = 0; i < 16; ++i) { hp[i] = hl; ap[i] = al; hl = a[i] * hl + hb[i]; al = a[i] * al; }
        float cin = 0.f;
#pragma unroll
        for (int s2 = 0; s2 < 3; ++s2) { const float as = SHFL(al, (F.lane & ~3) + s2), hs = SHFL(hl, (F.lane & ~3) + s2); if (s2 < seg) cin = as * cin + hs; }
#pragma unroll
        for (int i = 0; i < 16; ++i) CARRY[o0 + (size_t)i * 256] = ap[i] * cin + hp[i];
    }
}
DEV void ph_lru2(const Ctx& F, int l) {
    const int tid = F.tid, lane = F.lane, w = F.wave;
    const bf16* PROJ = (const bf16*)(F.ws + WS_PROJ); const bf16* HLOC = (const bf16*)(F.ws + WS_HLOC); const bf16* CPA = (const bf16*)(F.ws + WS_CPA);
    const float* CARRY = (const float*)(F.ws + WS_CARRY); bf16* CAT = (bf16*)(F.ws + WS_CAT);
    const f32x4 gw4 = *(const f32x4*)(PIN(F, I_GNW) + l * DM + 4 * lane);
    for (int u = F.bid; u < BATCH * 64; u += F.G) {
        const int b = u >> 6, c = u & 63; const size_t m0 = (size_t)b * SEQ + c * 64;
        const f32x4 car = *(const f32x4*)(CARRY + (size_t)u * 256 + 4 * lane);
        u32x2 hl8[8], cp8[8], ly8[8];
#pragma unroll
        for (int tt = 0; tt < 8; ++tt) { const size_t m = m0 + w * 8 + tt;
            hl8[tt] = *(const u32x2*)(HLOC + m * 256 + 4 * lane); cp8[tt] = *(const u32x2*)(CPA + m * 256 + 4 * lane); ly8[tt] = *(const u32x2*)(PROJ + m * NPROJ + PC_LY + 4 * lane); }
#pragma unroll
        for (int tt = 0; tt < 8; ++tt) { const size_t m = m0 + w * 8 + tt; const u32x2 hl = hl8[tt], cp = cp8[tt], ly = ly8[tt];
            float v0 = (bflo(hl.x) + bflo(cp.x) * car.x) * gelu_tanh(bflo(ly.x));
            float v1 = (bfhi(hl.x) + bfhi(cp.x) * car.y) * gelu_tanh(bfhi(ly.x));
            float v2 = (bflo(hl.y) + bflo(cp.y) * car.z) * gelu_tanh(bflo(ly.y));
            float v3 = (bfhi(hl.y) + bfhi(cp.y) * car.w) * gelu_tanh(bfhi(ly.y));
            const float rs = RSQ(wave_sum((v0 * v0 + v1 * v1) + (v2 * v2 + v3 * v3)) * (1.0f / 256.0f) + NORM_EPS);
            u32x2 o; o.x = pk2(v0 * rs * gw4.x, v1 * rs * gw4.y); o.y = pk2(v2 * rs * gw4.z, v3 * rs * gw4.w);
            *(u32x2*)(CAT + m * DM + 4 * lane) = o; }
    }
}

constexpr int QS_STRIDE = 136, VE_STRIDE = 56;
DEV void ph_mlstm(const Ctx& F, int l) {
    const int tid = F.tid, lane = F.lane, w = F.wave, i16 = lane & 15, g = lane >> 4;
    bf16* QsB = (bf16*)F.lds;
    bf16* KsB = QsB + 2 * 64 * QS_STRIDE;
    bf16* VE = KsB + 2 * 64 * QS_STRIDE;
    bf16* VW = VE + 64 * VE_STRIDE;
    bf16* CsB = VW + 64 * VE_STRIDE;
    float* BCB = (float*)(CsB + 2 * 128 * VE_STRIDE);
    float* BIB = BCB + 128;
    const bf16* PROJ = (const bf16*)(F.ws + WS_PROJ); bf16* HM = (bf16*)(F.ws + WS_HM);
    const float qscale = 0.08838834764831845f;
    const int half = w >> 2, jt = half ? 3 - (w & 3) : (w & 3);
    for (int u0 = F.bid; u0 < BATCH * 4 * 4; u0 += F.G) {
        const int u = 4 * ((u0 & 7) * 8 + ((u0 >> 3) >> 2)) + ((u0 >> 3) & 3);
        const int b = u >> 4, h = (u >> 2) & 3, vs = u & 3;
        const float gbi = PIN(F, I_BI)[l * 4 + h], gbf = PIN(F, I_BF)[l * 4 + h];
        f32x4 accC[3];
#pragma unroll
        for (int nt = 0; nt < 3; ++nt) accC[nt] = (f32x4){0.f, 0.f, 0.f, 0.f};
        float* BCg = (float*)(F.ws + WS_MG) + (size_t)u * 8192; float* BIg = BCg + 4096;
        unsigned gri[8], grf[8];
#pragma unroll
        for (int k = 0; k < 8; ++k) { const bf16* pr = PROJ + ((size_t)b * SEQ + (8 * k + w) * 64 + lane) * NPROJ; gri[k] = pr[PC_MI + h]; grf[k] = pr[PC_MF + h]; }
#pragma unroll
        for (int k = 0; k < 8; ++k) { const int tok = (8 * k + w) * 64 + lane;
            const float zi = (bf2f(gri[k]) + gbi) * (1.0f / 15.0f), zf = (bf2f(grf[k]) + gbf) * (1.0f / 15.0f);
            const float ig = 15.0f - 30.0f * FRCP(FEXP(2.0f * zi) + 1.0f), fg = 15.0f - 30.0f * FRCP(FEXP(2.0f * zf) + 1.0f);
            float s = -FLOG(1.0f + FEXP(-fg));
#pragma unroll
            for (int o = 1; o < 64; o <<= 1) { const float t = SHFL_UP(s, o); if (lane >= o) s += t; }
            BCg[tok] = s; BIg[tok] = s - ig; }
        SYNC();
        u32x4 rq[2], rk[2]; u32x2 rvv; float rgc = 0.f, rgb = 0.f;
        {
            const size_t m0 = (size_t)b * SEQ;
#pragma unroll
            for (int i = 0; i < 2; ++i) { const int idx = tid + 512 * i, row = idx >> 4, ck = idx & 15;
                rq[i] = *(const u32x4*)(PROJ + (m0 + row) * NPROJ + PC_MQ + h * 128 + 8 * ck); rk[i] = *(const u32x4*)(PROJ + (m0 + row) * NPROJ + PC_MK + h * 128 + 8 * ck); }
            rvv = *(const u32x2*)(PROJ + (m0 + (tid >> 3)) * NPROJ + PC_MV + h * 128 + vs * 32 + 4 * (tid & 7));
            if (tid < 64) { rgc = BCg[tid]; rgb = BIg[tid]; }
        }
        for (int c = 0; c < 64; ++c) {
            const size_t m0 = (size_t)b * SEQ + c * 64; const int buf = c & 1;
            bf16* Qs = QsB + buf * 64 * QS_STRIDE; bf16* Ks = KsB + buf * 64 * QS_STRIDE; const bf16* Cs = CsB + buf * 128 * VE_STRIDE; bf16* Cn = CsB + (buf ^ 1) * 128 * VE_STRIDE;
            float* BC = BCB + buf * 64; float* BI = BIB + buf * 64;
#pragma unroll
            for (int i = 0; i < 2; ++i) { const int idx = tid + 512 * i, row = idx >> 4, ck = idx & 15;
                *(u32x4*)(Qs + row * QS_STRIDE + 8 * ck) = rq[i]; *(u32x4*)(Ks + row * QS_STRIDE + 8 * ck) = rk[i]; }
            if (tid < 64) { BC[tid] = rgc; BI[tid] = rgb; }
            SYNC();
            {
                const int row = tid >> 3, cg = tid & 7;
                const u32x2 rv = rvv;
                const float wt = FEXP(BC[63] - BI[row]);
                *(u32x2*)(VE + row * VE_STRIDE + 4 * cg) = rv;
                u32x2 sv; sv.x = pk2(bflo(rv.x) * wt, bfhi(rv.x) * wt); sv.y = pk2(bflo(rv.y) * wt, bfhi(rv.y) * wt);
                *(u32x2*)(VW + row * VE_STRIDE + 4 * cg) = sv;
                if (cg == 0) { unsigned one_ = 0x3f80u; LAUNDER_V(one_); u32x4 z = (u32x4){one_, 0u, 0u, 0u}; *(u32x4*)(VE + row * VE_STRIDE + 32) = z; *(u32x4*)(VE + row * VE_STRIDE + 40) = (u32x4){0u, 0u, 0u, 0u};
                    z.x = f2bf(wt); *(u32x4*)(VW + row * VE_STRIDE + 32) = z; *(u32x4*)(VW + row * VE_STRIDE + 40) = (u32x4){0u, 0u, 0u, 0u}; }
            }
            if (c + 1 < 64) {
                const size_t m1 = m0 + 64;
#pragma unroll
                for (int i = 0; i < 2; ++i) { const int idx = tid + 512 * i, row = idx >> 4, ck = idx & 15;
                    rq[i] = *(const u32x4*)(PROJ + (m1 + row) * NPROJ + PC_MQ + h * 128 + 8 * ck); rk[i] = *(const u32x4*)(PROJ + (m1 + row) * NPROJ + PC_MK + h * 128 + 8 * ck); }
                rvv = *(const u32x2*)(PROJ + (m1 + (tid >> 3)) * NPROJ + PC_MV + h * 128 + vs * 32 + 4 * (tid & 7));
                if (tid < 64) { rgc = BCg[(c + 1) * 64 + tid]; rgb = BIg[(c + 1) * 64 + tid]; }
            }
            SYNC();
            f32x4 Z[2] = {(f32x4){0.f, 0.f, 0.f, 0.f}, (f32x4){0.f, 0.f, 0.f, 0.f}};
            {
                bf16x8 Bq[4];
#pragma unroll
                for (int ks = 0; ks < 4; ++ks) Bq[ks] = *(const bf16x8*)(Qs + (16 * jt + i16) * QS_STRIDE + 32 * ks + 8 * g);
                const float bj = BC[16 * jt + i16];
                unsigned pk[4][2];
#pragma unroll
                for (int tt = 0; tt < 4; ++tt) {
                    if (tt <= jt) {
                        f32x4 X = (f32x4){0.f, 0.f, 0.f, 0.f};
                        bf16x8 Ak[4];
#pragma unroll
                        for (int ks = 0; ks < 4; ++ks) Ak[ks] = *(const bf16x8*)(Ks + (16 * tt + i16) * QS_STRIDE + 32 * ks + 8 * g);
                        KEEP4(Ak[0], Ak[1], Ak[2], Ak[3]);
#pragma unroll
                        for (int ks = 0; ks < 4; ++ks) X = MFMA16(Ak[ks], Bq[ks], X);
                        float p[4]; const f32x4 bi4 = *(const f32x4*)(BI + 16 * tt + 4 * g);
#pragma unroll
                        for (int r = 0; r < 4; ++r) { const float pv = X[r] * qscale * FEXP(fminf(bj - bi4[r], 60.0f));
                            p[r] = (tt < jt || 4 * g + r <= i16) ? pv : 0.f; }
                        pk[tt][0] = pk2(p[0], p[1]); pk[tt][1] = pk2(p[2], p[3]);
                    } else { pk[tt][0] = 0u; pk[tt][1] = 0u; }
                }
#pragma unroll
                for (int pr = 0; pr < 2; ++pr) {
                    if (2 * pr <= jt) {
                        u32x4 aw = (u32x4){pk[2 * pr][0], pk[2 * pr][1], pk[2 * pr + 1][0], pk[2 * pr + 1][1]};
                        const bf16x8 A = __builtin_bit_cast(bf16x8, aw);
#pragma unroll
                        for (int n = 0; n < 2; ++n) { const int ntc = n ? 2 : half;
                            const s16x4 lo = TR16(VE + (32 * pr + 4 * g + (i16 >> 2)) * VE_STRIDE + 16 * ntc + 4 * (i16 & 3));
                            const s16x4 hi = TR16(VE + (32 * pr + 16 + 4 * g + (i16 >> 2)) * VE_STRIDE + 16 * ntc + 4 * (i16 & 3));
                            const bf16x8 B = (bf16x8){lo[0], lo[1], lo[2], lo[3], hi[0], hi[1], hi[2], hi[3]};
                            Z[n] = MFMA16(A, B, Z[n]); }
#ifndef HOST_EMU
                        asm volatile("" :: "v"(aw));
#endif
                    }
                }
            }
            if (c > 0) {
                f32x4 Z2[2] = {(f32x4){0.f, 0.f, 0.f, 0.f}, (f32x4){0.f, 0.f, 0.f, 0.f}};
#pragma unroll
                for (int kh = 0; kh < 2; ++kh) {
                    bf16x8 Aq[2], Bc[2][2];
#pragma unroll
                    for (int k2 = 0; k2 < 2; ++k2) { const int ks = 2 * kh + k2; Aq[k2] = *(const bf16x8*)(Qs + (16 * jt + i16) * QS_STRIDE + 32 * ks + 8 * g);
#pragma unroll
                        for (int n = 0; n < 2; ++n) { const int ntc = n ? 2 : half;
                            const s16x4 lo = TR16(Cs + (32 * ks + 8 * g + (i16 >> 2)) * VE_STRIDE + 16 * ntc + 4 * (i16 & 3));
                            const s16x4 hi = TR16(Cs + (32 * ks + 8 * g + 4 + (i16 >> 2)) * VE_STRIDE + 16 * ntc + 4 * (i16 & 3));
                            Bc[k2][n] = (bf16x8){lo[0], lo[1], lo[2], lo[3], hi[0], hi[1], hi[2], hi[3]}; } }
                    KEEP4(Bc[0][0], Bc[0][1], Bc[1][0], Bc[1][1]);
#pragma unroll
                    for (int k2 = 0; k2 < 2; ++k2)
#pragma unroll
                        for (int n = 0; n < 2; ++n) Z2[n] = MFMA16(Aq[k2], Bc[k2][n], Z2[n]); }
                const f32x4 bc4 = *(const f32x4*)(BC + 16 * jt + 4 * g);
#pragma unroll
                for (int r = 0; r < 4; ++r) { const float f = qscale * FEXP(bc4[r]); Z[0][r] += f * Z2[0][r]; Z[1][r] += f * Z2[1][r]; }
            }
#pragma unroll
            for (int r = 0; r < 4; ++r) { const int j = 16 * jt + 4 * g + r; const float dn = FRCP(fmaxf(fabsf(SHFL(Z[1][r], lane & 48)), 1.0f));
                HM[(m0 + j) * 512 + h * 128 + vs * 32 + 16 * half + i16] = (bf16)f2bf(Z[0][r] * dn); }
            {
                const float dec = FEXP(BC[63]);
#pragma unroll
                for (int nt = 0; nt < 3; ++nt) accC[nt] = accC[nt] * dec;
#pragma unroll
                for (int ks = 0; ks < 2; ++ks) {
                    const s16x4 alo = TR16(Ks + (32 * ks + 8 * g + (i16 >> 2)) * QS_STRIDE + 16 * w + 4 * (i16 & 3));
                    const s16x4 ahi = TR16(Ks + (32 * ks + 8 * g + 4 + (i16 >> 2)) * QS_STRIDE + 16 * w + 4 * (i16 & 3));
                    const bf16x8 A = (bf16x8){alo[0], alo[1], alo[2], alo[3], ahi[0], ahi[1], ahi[2], ahi[3]};
                    bf16x8 Bv[3];
#pragma unroll
                    for (int nt = 0; nt < 3; ++nt) {
                        const s16x4 lo = TR16(VW + (32 * ks + 8 * g + (i16 >> 2)) * VE_STRIDE + 16 * nt + 4 * (i16 & 3));
                        const s16x4 hi = TR16(VW + (32 * ks + 8 * g + 4 + (i16 >> 2)) * VE_STRIDE + 16 * nt + 4 * (i16 & 3));
                        Bv[nt] = (bf16x8){lo[0], lo[1], lo[2], lo[3], hi[0], hi[1], hi[2], hi[3]}; }
                    KEEP4(A, Bv[0], Bv[1], Bv[2]);
#pragma unroll
                    for (int nt = 0; nt < 3; ++nt) { const bf16x8 B = Bv[nt];
                        const f32x4 cold = accC[nt]; accC[nt] = MFMA16(A, B, cold);
#ifndef HOST_EMU
                        asm volatile("" :: "v"(cold), "v"(A), "v"(B));
#endif
                    }
                }
#pragma unroll
                for (int nt = 0; nt < 3; ++nt)
#pragma unroll
                    for (int r = 0; r < 4; ++r) Cn[(16 * w + 4 * g + r) * VE_STRIDE + 16 * nt + i16] = (bf16)f2bf(accC[nt][r]);
            }
        }
        SYNC();
    }
}

DEV void ph_mfin(const Ctx& F, int l) {
    const int gw = F.bid * 8 + F.wave, NGW = F.G * 8, lane = F.lane;
    const bf16* PROJ = (const bf16*)(F.ws + WS_PROJ); const bf16* HM = (const bf16*)(F.ws + WS_HM); bf16* CAT = (bf16*)(F.ws + WS_CAT);
    float gm[8];
#pragma unroll
    for (int j = 0; j < 8; ++j) gm[j] = PIN(F, I_GNW)[l * DM + 256 + 8 * lane + j];
    u32x4 hv4[4], ov4[4], hvn[4], ovn[4];
#define MFIN_LOAD(HV, OV, M0) do { _Pragma("unroll") for (int q = 0; q < 4; ++q) { const int mm = (M0) + q * NGW; const size_t ms = (size_t)(mm < MTOK ? mm : 0); \
            HV[q] = *(const u32x4*)(HM + ms * 512 + 8 * lane); OV[q] = *(const u32x4*)(PROJ + ms * NPROJ + PC_MO + 8 * lane); } } while (0)
    MFIN_LOAD(hv4, ov4, gw);
    for (int m0 = gw; m0 < MTOK; m0 += 4 * NGW) {
        MFIN_LOAD(hvn, ovn, m0 + 4 * NGW);
#pragma unroll
        for (int q = 0; q < 4; ++q) { const int m = m0 + q * NGW; if (m >= MTOK) break;
            const u32x4 hv = hv4[q], ov = ov4[q];
            float v[8] = {bflo(hv.x), bfhi(hv.x), bflo(hv.y), bfhi(hv.y), bflo(hv.z), bfhi(hv.z), bflo(hv.w), bfhi(hv.w)};
            const float o[8] = {bflo(ov.x), bfhi(ov.x), bflo(ov.y), bfhi(ov.y), bflo(ov.z), bfhi(ov.z), bflo(ov.w), bfhi(ov.w)};
            float s = 0.f;
#pragma unroll
            for (int j = 0; j < 8; ++j) s += v[j] * v[j];
            s += SHFL_XOR(s, 1); s += SHFL_XOR(s, 2); s += SHFL_XOR(s, 4); s += SHFL_XOR(s, 8);
            const float rs = RSQ(s * (1.0f / 128.0f) + NORM_EPS);
            u32x4 r;
            r.x = pk2(v[0] * rs * gm[0] * fsigmoid(o[0]), v[1] * rs * gm[1] * fsigmoid(o[1]));
            r.y = pk2(v[2] * rs * gm[2] * fsigmoid(o[2]), v[3] * rs * gm[3] * fsigmoid(o[3]));
            r.z = pk2(v[4] * rs * gm[4] * fsigmoid(o[4]), v[5] * rs * gm[5] * fsigmoid(o[5]));
            r.w = pk2(v[6] * rs * gm[6] * fsigmoid(o[6]), v[7] * rs * gm[7] * fsigmoid(o[7]));
            *(u32x4*)(CAT + (size_t)m * DM + 256 + 8 * lane) = r; }
#pragma unroll
        for (int q = 0; q < 4; ++q) { hv4[q] = hvn[q]; ov4[q] = ovn[q]; }
    }
#undef MFIN_LOAD
}

constexpr int DS_HIST = 0;
constexpr int DS_MASK = 49152;
constexpr int DS_CAND = 65536;
constexpr int DS_SELL = 102400;
constexpr int DS_META = 118784;
constexpr int DS_RB = DS_META + 512;
constexpr int DS_SS = DS_RB + 2048;
constexpr int DS_SLOT = 12800;
constexpr int NBIN = 768, CAND_CAP = 128;
__device__ const unsigned char T5B[114] = {0, 1, 2, 3, 4, 5, 6, 7, 8, 9, 10, 11, 12, 13, 14, 15, 16, 16, 16, 17, 17, 18, 18, 18, 19, 19, 19, 20, 20, 20, 20, 21, 21, 21, 21, 22, 22, 22, 22, 22, 23, 23, 23, 23, 23, 23, 24, 24, 24, 24, 24, 24, 25, 25, 25, 25, 25, 25, 25, 26, 26, 26, 26, 26, 26, 26, 26, 27, 27, 27, 27, 27, 27, 27, 27, 27, 27, 28, 28, 28, 28, 28, 28, 28, 28, 28, 28, 29, 29, 29, 29, 29, 29, 29, 29, 29, 29, 29, 29, 30, 30, 30, 30, 30, 30, 30, 30, 30, 30, 30, 30, 30, 30, 31};

DEV int score_bin(float sc) {
    const unsigned u = __builtin_bit_cast(unsigned, sc);
    int e = (int)((u >> 18) & 0x1FFFu) - 119 * 32; e = e < 0 ? 0 : (e > 383 ? 383 : e);
    return (u >> 31) ? 383 - e : 384 + e;
}
DEV unsigned score_key(float sc) { const unsigned u = __builtin_bit_cast(unsigned, sc); return (u >> 31) ? ~u : (u | 0x80000000u); }
DEV unsigned score_code(float sc) {
    const unsigned u = __builtin_bit_cast(unsigned, sc);
    int e = (int)((u >> 18) & 0x1FFFu) - 119 * 32; e = e < 0 ? 0 : (e > 383 ? 383 : e);
    return ((u >> 16) & 0x8000u) | ((unsigned)e << 6) | ((u >> 12) & 63u);
}
DEV int code_bin(unsigned c) { const int e = (int)((c >> 6) & 0x1FFu); return (c & 0x8000u) ? 383 - e : 384 + e; }
DEV unsigned code_key(unsigned c) { return (c & 0x8000u) ? 63u - (c & 63u) : (c & 63u); }


DEV f32x4 dsa_score_tile(const bf16x8 A, const bf16x8 (&QS)[2], const bf16x8 (&Bq)[8], const float (&wq)[8]) {
    f32x4 sc = (f32x4){0.f, 0.f, 0.f, 0.f};
#pragma unroll
    for (int h = 0; h < 8; ++h) { const f32x4 d = MFMA16(A, Bq[h], (f32x4){0.f, 0.f, 0.f, 0.f});
#pragma unroll
        for (int r = 0; r < 4; ++r) sc[r] += wq[h] * RELU(d[r]); }
    return sc;
}
DEV void ph_dsa(const Ctx& F, int l) {
    const int tid = F.tid, lane = F.lane, w = F.wave, i16 = lane & 15, g = lane >> 4;
    unsigned* HIST = (unsigned*)(F.lds + DS_HIST); unsigned* MASK = (unsigned*)(F.lds + DS_MASK); u32x2* CAND = (u32x2*)(F.lds + DS_CAND);
    unsigned short* SELL = (unsigned short*)(F.lds + DS_SELL); int* BST = (int*)(F.lds + DS_META); int* NAB = BST + 32; int* NCAND = BST + 64; int* NSEL = BST + 96;
    float* RB = (float*)(F.lds + DS_RB);
    const bf16* QIDX = (const bf16*)(F.ws + WS_QIDX); const bf16* KIDX = (const bf16*)(F.ws + WS_KIDX); const float* WI = (const float*)(F.ws + WS_WI);
    const bf16* QABS = (const bf16*)(F.ws + WS_QABS); const bf16* CKV = (const bf16*)(F.ws + WS_CKV); bf16* CAT = (bf16*)(F.ws + WS_CAT);
    const bf16* WUVT = (const bf16*)(F.ws + WS_WUVT) + (size_t)l * 4 * 64 * 128; float* SS = (float*)(F.lds + DS_SS);
    for (int e = tid; e < 114 * 4; e += 512) RB[e] = PIN(F, I_RELB)[T5B[e >> 2] * 4 + (e & 3)] * 1.4426950408889634f;
    SYNC();
    for (int ui = F.bid; ui < BATCH * 128; ui += F.G) {
        int b, qt; { const int wv = ui & 255, k = ui >> 8, xj = wv >> 3, r = xj & 15; b = 2 * (wv & 7) + (xj >> 4);
            qt = (k & 1) ? (32 * (k >> 1) + 31 - r) : (32 * (k >> 1) + r); }
        const int t0 = 32 * qt, nkt = 2 * qt + 2; const size_t mb = (size_t)b * SEQ;
        const GAS char* const ckvb = UNIP(CKV + mb * 128);
        const int nt = w & 1;
        u32x2* sw = (u32x2*)(F.ws + (F.bid < 128 ? WS_QL + (size_t)F.bid * 262144 : WS_SCR2 + (size_t)(F.bid - 128) * 262144) + (size_t)w * 32768) + lane;
        bf16x8 Bq[8]; float wq[8];
        { const size_t mq = mb + t0 + 16 * nt + i16;
#pragma unroll
            for (int h = 0; h < 8; ++h) { Bq[h] = *(const bf16x8*)(QIDX + mq * 256 + 32 * h + 8 * g); wq[h] = WI[mq * 8 + h]; } }
        bf16x8 QS[2];
#pragma unroll
        for (int j = 0; j < 8; ++j) { float s = 0.f;
#pragma unroll
            for (int h = 0; h < 8; ++h) s += wq[h] * bf2f((unsigned)(unsigned short)Bq[h][j]);
            const unsigned hi = f2bf(s); QS[0][j] = (short)hi; QS[1][j] = (short)f2bf(s - bf2f(hi)); }
        for (int e = tid; e < 16 * NBIN; e += 512) HIST[e] = 0u;
        for (int e = tid; e < 32 * 128; e += 512) MASK[e] = 0u;
        if (tid < 32) NCAND[tid] = 0;
        SYNC();
        bf16x8 Apre = *(const bf16x8*)(KIDX + (mb + 16 * (w >> 1) + i16) * 32 + 8 * g);
        for (int kt = w >> 1; kt < nkt; kt += 4) {
            const bf16x8 A = Apre;
            { const int kn = kt + 4 < nkt ? kt + 4 : kt; Apre = *(const bf16x8*)(KIDX + (mb + 16 * kn + i16) * 32 + 8 * g); }
            const f32x4 sc = dsa_score_tile(A, QS, Bq, wq);
            unsigned cd[4];
#pragma unroll
            for (int r = 0; r < 4; ++r) cd[r] = score_code(sc[r] + 0.0f);
            { u32x2 pk; pk.x = cd[0] | (cd[1] << 16); pk.y = cd[2] | (cd[3] << 16); sw[(size_t)((kt - (w >> 1)) >> 2) * 64] = pk; }
            const unsigned inc = nt ? 65536u : 1u;
            if (kt < 2 * qt) {
#pragma unroll
                for (int r = 0; r < 4; ++r) atomicAdd(&HIST[i16 * NBIN + code_bin(cd[r])], inc);
            } else {
                const int t = t0 + 16 * nt + i16;
#pragma unroll
                for (int r = 0; r < 4; ++r) { const int s = 16 * kt + 4 * g + r;
                    if (s <= t) atomicAdd(&HIST[i16 * NBIN + code_bin(cd[r])], inc); }
            }
        }
        SYNC();
#pragma unroll 1
        for (int rr = 0; rr < 4; ++rr) {
            const int row = 4 * w + rr, t = t0 + row;
            if (t < 256) { if (lane == 0) { BST[row] = -1; NAB[row] = t + 1; } continue; }
            const int sh = (row >> 4) * 16; const unsigned* hp = HIST + (row & 15) * NBIN + 12 * lane;
            int cnt[12]; int tot = 0;
#pragma unroll
            for (int i = 0; i < 12; ++i) { cnt[i] = (int)((hp[i] >> sh) & 0xFFFFu); tot += cnt[i]; }
            int suf = tot;
#pragma unroll
            for (int o = 1; o < 64; o <<= 1) { const int v = SHFL_DOWN(suf, o); if (lane + o < 64) suf += v; }
            const int above = suf - tot;
            if (above < 256 && above + tot >= 256) {
                int run = above, bs = -1, na = 0; bool done = false;
#pragma unroll
                for (int i = 11; i >= 0; --i) { if (!done) { if (run + cnt[i] >= 256) { bs = 12 * lane + i; na = run; done = true; } else run += cnt[i]; } }
                BST[row] = bs; NAB[row] = na;
            }
        }
        SYNC();
        { const int row = 16 * nt + i16, t = t0 + row, bs = BST[row];
        const int ntl = nkt > (w >> 1) ? ((nkt - 1 - (w >> 1)) >> 2) + 1 : 0;
        u32x2 P0 = sw[0], P1 = sw[(size_t)(1 < ntl ? 1 : 0) * 64];
        for (int j = 0; j < ntl; ++j) { const int kt = (w >> 1) + 4 * j;
            const u32x2 pc = P0; P0 = P1; P1 = sw[(size_t)(j + 2 < ntl ? j + 2 : j) * 64];
            const bool full = kt < 2 * qt;
#pragma unroll
            for (int r = 0; r < 4; ++r) { const int s = 16 * kt + 4 * g + r;
                if (full || s <= t) { const unsigned wd = r < 2 ? pc.x : pc.y; const unsigned c = (r & 1) ? (wd >> 16) : (wd & 0xffffu); const int bn = code_bin(c);
                    if (bn > bs) atomicOr(&MASK[row * 128 + (s >> 5)], 1u << (s & 31));
                    else if (bn == bs) { const int pos = (int)atomicAdd((unsigned*)&NCAND[row], 1u); if (pos < CAND_CAP) CAND[row * CAND_CAP + pos] = (u32x2){code_key(c), (unsigned)s}; } } }
        } }
        SYNC();
#pragma unroll 1
        for (int rr = 0; rr < 4; ++rr) {
            const int row = 4 * w + rr; if (BST[row] < 0) continue;
            const int n = NCAND[row] < CAND_CAP ? NCAND[row] : CAND_CAP, need = 256 - NAB[row];
            for (int i = lane; i < n; i += 64) { const u32x2 me = CAND[row * CAND_CAP + i]; int rank = 0;
                for (int j = 0; j < n; ++j) { const u32x2 o = CAND[row * CAND_CAP + j]; rank += (o.x > me.x || (o.x == me.x && o.y < me.y)) ? 1 : 0; }
#ifndef DSA_DBG_NOCAND
                if (rank < need) atomicOr(&MASK[row * 128 + (me.y >> 5)], 1u << (me.y & 31));
#endif
            }
        }
        SYNC();
#ifdef DSA_DBG_SEL
        for (int e = tid; e < 32 * 128; e += 512) { const int row = e >> 7, wi = e & 127, t = t0 + row, lo = t - 255 < 0 ? 0 : t - 255; unsigned m = 0u;
            for (int bq = 0; bq < 32; ++bq) { const int s = 32 * wi + bq; if (s >= lo && s <= t) m |= 1u << bq; }
            MASK[e] = m; }
        SYNC();
#endif
#pragma unroll 1
        for (int rr = 0; rr < 4; ++rr) {
            const int row = 4 * w + rr;
            unsigned w0 = MASK[row * 128 + 2 * lane], w1 = MASK[row * 128 + 2 * lane + 1];
            const int c = __builtin_popcount(w0) + __builtin_popcount(w1);
            int inc = c;
#pragma unroll
            for (int o = 1; o < 64; o <<= 1) { const int v = SHFL_UP(inc, o); if (lane >= o) inc += v; }
            int pos = inc - c;
            while (w0) { const int bt = __builtin_ctz(w0); w0 &= w0 - 1; if (pos < 256) SELL[row * 256 + pos] = (unsigned short)(64 * lane + bt); ++pos; }
            while (w1) { const int bt = __builtin_ctz(w1); w1 &= w1 - 1; if (pos < 256) SELL[row * 256 + pos] = (unsigned short)(64 * lane + 32 + bt); ++pos; }
            if (lane == 63) NSEL[row] = inc < 256 ? inc : 256;
        }
        SYNC();
        bf16* TL = (bf16*)(F.lds + w * DS_SLOT); bf16* OLw = (bf16*)(F.lds + w * DS_SLOT + 8704);
#pragma unroll 1
        for (int rr = 0; rr < 4; ++rr) {
            const int row = 4 * w + rr, t = t0 + row, ns = UNI(NSEL[row]); const size_t mt = mb + t;
            const unsigned short* sl = SELL + row * 256;
            bf16x8 Bh[4];
#pragma unroll
            for (int ks = 0; ks < 4; ++ks) Bh[ks] = i16 < 4 ? *(const bf16x8*)(QABS + mt * 512 + i16 * 128 + 32 * ks + 8 * g) : (bf16x8){0, 0, 0, 0, 0, 0, 0, 0};
            f32x4 O[8];
#pragma unroll
            for (int nt = 0; nt < 8; ++nt) O[nt] = (f32x4){0.f, 0.f, 0.f, 0.f};
            float mrun = -1e30f, lrun = 0.f;
            const float bfar = RB[113 * 4 + (i16 & 3)];
            const int nch = (ns + 31) >> 5;
            u32x4 gvA[8];
#ifndef HOST_EMU
#define ATT_KEEP8(A) asm volatile("" :: "v"(A[0][0]), "v"(A[0][1]), "v"(A[0][2]), "v"(A[0][3]), "v"(A[1][0]), "v"(A[1][1]), "v"(A[1][2]), "v"(A[1][3]))
#else
#define ATT_KEEP8(A) (void)0
#endif
#define ATT_LOAD(GV, CK, FULL) do { int sidx[8]; \
                _Pragma("unroll") for (int i = 0; i < 8; ++i) sidx[i] = (int)sl[32 * (CK) + 4 * i + g];            \
                _Pragma("unroll") for (int i = 0; i < 8; ++i) { const int kp = 32 * (CK) + 4 * i + g; sidx[i] = (FULL || kp < ns) ? sidx[i] : 0; } \
                _Pragma("unroll") for (int i = 0; i < 8; ++i) GV[i] = *(const GAS u32x4*)(ckvb + (((unsigned)sidx[i] << 8) + 16u * (unsigned)i16)); } while (0)
#define ATT_STEP(GV, CK, FULL) do { const int ck = (CK); \
                _Pragma("unroll") for (int i = 0; i < 8; ++i) *(u32x4*)(TL + (4 * i + g) * 136 + 8 * i16) = GV[i]; \
                const u32x2 sk0 = *(const u32x2*)(sl + 32 * ck + 4 * g), sk1 = *(const u32x2*)(sl + 32 * ck + 16 + 4 * g); \
                WAVE_LDS_FENCE(); \
                if (ck + 1 < nch) ATT_LOAD(GV, ck + 1, FULL); \
                float bia[2][4]; \
                if (FULL && t - UNI((int)sl[32 * ck + 31]) >= 113) {                   \
                _Pragma("unroll") for (int kt = 0; kt < 2; ++kt) \
                _Pragma("unroll") for (int r = 0; r < 4; ++r) bia[kt][r] = bfar; \
                } else { \
                _Pragma("unroll") for (int kt = 0; kt < 2; ++kt) \
                _Pragma("unroll") for (int r = 0; r < 4; ++r) { const unsigned wd = kt ? (r < 2 ? sk1.x : sk1.y) : (r < 2 ? sk0.x : sk0.y); \
                        int dist = t - (int)((wd >> (16 * (r & 1))) & 0xffffu); dist = dist < 0 ? 0 : (dist > 113 ? 113 : dist); \
                        bia[kt][r] = RB[dist * 4 + (i16 & 3)]; } } \
                f32x4 lg[2]; \
                { bf16x8 Af[2][4];                                    \
                _Pragma("unroll") for (int kt = 0; kt < 2; ++kt) _Pragma("unroll") for (int ks = 0; ks < 4; ++ks) Af[kt][ks] = *(const bf16x8*)(TL + (16 * kt + i16) * 136 + 32 * ks + 8 * g); \
                ATT_KEEP8(Af); \
                _Pragma("unroll") for (int kt = 0; kt < 2; ++kt) { lg[kt] = (f32x4){0.f, 0.f, 0.f, 0.f}; \
                _Pragma("unroll") for (int ks = 0; ks < 4; ++ks) lg[kt] = MFMA16(Af[kt][ks], Bh[ks], lg[kt]); } } \
                float cm = -1e30f; \
                _Pragma("unroll") for (int kt = 0; kt < 2; ++kt) \
                _Pragma("unroll") for (int r = 0; r < 4; ++r) { const int kp = 32 * ck + 16 * kt + 4 * g + r; \
                        lg[kt][r] = (FULL || kp < ns) ? lg[kt][r] + bia[kt][r] : -1e30f; cm = fmaxf(cm, lg[kt][r]); } \
                if (ck == 0) { cm = fmaxf(cm, SHFL_XOR(cm, 16)); cm = fmaxf(cm, SHFL_XOR(cm, 32)); mrun = cm; } \
                float p[2][4]; \
                _Pragma("unroll") for (int kt = 0; kt < 2; ++kt) \
                _Pragma("unroll") for (int r = 0; r < 4; ++r) { p[kt][r] = (FULL || lg[kt][r] > -1e29f) ? FEXP2(lg[kt][r] - mrun) : 0.f; lrun += p[kt][r]; } \
                u32x4 aw = (u32x4){0u, 0u, 0u, 0u}; \
                if (i16 < 4) aw = (u32x4){pk2(p[0][0], p[0][1]), pk2(p[0][2], p[0][3]), pk2(p[1][0], p[1][1]), pk2(p[1][2], p[1][3])}; \
                const bf16x8 A = __builtin_bit_cast(bf16x8, aw); \
                _Pragma("unroll") for (int nt = 0; nt < 8; ++nt) { \
                    const s16x4 lo = TR16(TL + (4 * g + (i16 >> 2)) * 136 + 16 * nt + 4 * (i16 & 3)); \
                    const s16x4 hi = TR16(TL + (16 + 4 * g + (i16 >> 2)) * 136 + 16 * nt + 4 * (i16 & 3)); \
                    const bf16x8 B = (bf16x8){lo[0], lo[1], lo[2], lo[3], hi[0], hi[1], hi[2], hi[3]}; \
                    O[nt] = MFMA16(A, B, O[nt]); } \
                WAVE_LDS_FENCE(); } while (0)
            if (ns == 256) { ATT_LOAD(gvA, 0, true); for (int ck2 = 0; ck2 < 8; ++ck2) ATT_STEP(gvA, ck2, true); }
            else { ATT_LOAD(gvA, 0, false); for (int ck2 = 0; ck2 < nch; ++ck2) ATT_STEP(gvA, ck2, false); }
#undef ATT_STEP
#undef ATT_LOAD
            lrun += SHFL_XOR(lrun, 16); lrun += SHFL_XOR(lrun, 32);
            float li[4];
#pragma unroll
            for (int r = 0; r < 4; ++r) li[r] = FRCP(SHFL(lrun, r));
            if (g == 0) {
#pragma unroll
                for (int nt = 0; nt < 8; ++nt)
#pragma unroll
                    for (int r = 0; r < 4; ++r) OLw[(rr * 4 + r) * 128 + 16 * nt + i16] = (bf16)f2bf(O[nt][r] * li[r]);
            }
        }
        bf16x8 Wf[4][4];
#pragma unroll
        for (int ks = 0; ks < 4; ++ks)
#pragma unroll
            for (int nt = 0; nt < 4; ++nt) Wf[ks][nt] = *(const bf16x8*)(WUVT + ((size_t)((w >> 1) * 64 + 16 * nt + i16)) * 128 + 32 * ks + 8 * g);
        SYNC();
        {
            const int h = w >> 1, mtile = w & 1, q = 16 * mtile + i16;
            const bf16* olq = (const bf16*)(F.lds + (q >> 2) * DS_SLOT + 8704) + ((q & 3) * 4 + h) * 128;
            float gaw[4];
#pragma unroll
            for (int nt = 0; nt < 4; ++nt) gaw[nt] = PIN(F, I_GNW)[l * DM + 768 + h * 64 + 16 * nt + i16];
            f32x4 acc[4];
#pragma unroll
            for (int nt = 0; nt < 4; ++nt) acc[nt] = (f32x4){0.f, 0.f, 0.f, 0.f};
#pragma unroll
            for (int ks = 0; ks < 4; ++ks) { const bf16x8 A = *(const bf16x8*)(olq + 32 * ks + 8 * g);
#pragma unroll
                for (int nt = 0; nt < 4; ++nt) acc[nt] = MFMA16(A, Wf[ks][nt], acc[nt]); }
#pragma unroll
            for (int r = 0; r < 4; ++r) { float s = (acc[0][r] * acc[0][r] + acc[1][r] * acc[1][r]) + (acc[2][r] * acc[2][r] + acc[3][r] * acc[3][r]);
                s += SHFL_XOR(s, 1); s += SHFL_XOR(s, 2); s += SHFL_XOR(s, 4); s += SHFL_XOR(s, 8);
                if (i16 == 0) SS[(16 * mtile + 4 * g + r) * 4 + h] = s; }
            SYNC();
#pragma unroll
            for (int r = 0; r < 4; ++r) { const int qq = 16 * mtile + 4 * g + r; const f32x4 s4 = *(const f32x4*)(SS + qq * 4);
                const float rs = RSQ(((s4.x + s4.y) + (s4.z + s4.w)) * (1.0f / 256.0f) + NORM_EPS);
                bf16* dst = CAT + (mb + t0 + qq) * DM + 768 + h * 64 + i16;
#pragma unroll
                for (int nt = 0; nt < 4; ++nt) dst[16 * nt] = (bf16)f2bf(acc[nt][r] * rs * gaw[nt]); }
        }
        SYNC();
    }
}
#ifndef HOST_EMU
namespace pg8 {
#define PG8_LAS __attribute__((address_space(3)))
typedef unsigned short bf16_t;
typedef short bf16x8 __attribute__((ext_vector_type(8)));
typedef float f32x4 __attribute__((ext_vector_type(4)));
typedef unsigned u32x4 __attribute__((ext_vector_type(4)));
constexpr int BM = 256, BK = 64, HALF = 128, HTB = HALF * BK * 2  , STAGE_BYTES = 8 * HTB, NXCD = 8, WGM = 8;

__host__ __device__ __forceinline__ int lds_byte(int r, int c) { const int st = (r >> 4) * 2 + (c >> 5), rr = r & 15, cc = c & 31, ob = rr * 64 + cc * 2; return st * 1024 + (ob ^ (((ob >> 9) & 1) << 5)); }
__host__ __device__ __forceinline__ void stage_rc(int b, int& R, int& C) { const int st = b / 1024, sb = b % 1024, swz = sb ^ (((sb >> 9) & 1) << 5); R = (st >> 1) * 16 + swz / 64; C = (st & 1) * 32 + (swz % 64) / 2; }
__host__ __device__ __forceinline__ int perm32(int rho) { const int n = rho >> 4, i = rho & 15; return 8 * (i >> 2) + 4 * n + (i & 3); }

struct Unit { int pm, pn; };
struct Gemm { const bf16_t* A; const bf16_t* Bt; int M, N, K; };

struct StaticOrder {
    int nM, nN, nwg, G, c;
    __host__ __device__ void init(int M, int N, int G_, int c_) { nM = M / BM; nN = N / BM; nwg = nM * nN; G = G_; c = c_; }
    __host__ __device__ bool next(int i, Unit& u) const {
        const long L = (long)i * G + c; if (L >= nwg) return false;
        int wgid = (int)L; { const int q = nwg / NXCD, r = nwg % NXCD, xcd = wgid % NXCD, off = wgid / NXCD; wgid = (xcd < r ? xcd * (q + 1) : r * (q + 1) + (xcd - r) * q) + off; }
        const int nig = WGM * nN, gid = wgid / nig, fm = gid * WGM, gsz = (nM - fm) < WGM ? (nM - fm) : WGM;
        u.pm = fm + ((wgid % nig) % gsz); u.pn = (wgid % nig) / gsz; return true;
    }
    __device__ __forceinline__ void a_ready(const Unit&) const {}
    __device__ __forceinline__ void done(const Unit&) const {}
};
__device__ __forceinline__ unsigned cvt_pk_bf16(float lo, float hi) { unsigned r; asm volatile("v_cvt_pk_bf16_f32 %0, %1, %2" : "=v"(r) : "v"(lo), "v"(hi)); return r; }
template <class Epi, class Sched, bool ALIGN_EPI = false, bool SP2 = false>
__device__ __forceinline__ void gemm_phase(PG8_LAS unsigned char* lds, const Gemm g, const Sched& S, const Epi& E, const int tid_in) {
    const int tid = tid_in, wid = __builtin_amdgcn_readfirstlane(tid >> 6), lane = tid & 63, wr = wid >> 2, wc = wid & 3, fr = lane & 15, fq = lane >> 4;
    const int K = g.K, nt = K / BK;
    unsigned voffA[2], voffB[2];
#pragma unroll
    for (int i = 0; i < 2; ++i) { int R, C; stage_rc(tid * 16 + i * 8192, R, C); const int Rb = Epi::PERM ? ((R & ~31) + perm32(R & 31)) : R;
        voffA[i] = (unsigned)(R * K + C) * 2u; voffB[i] = (unsigned)(Rb * K + C) * 2u; }
    const size_t kstep = (size_t)(BK * 2);
    const size_t hstep = (size_t)HALF * K * 2;
    const size_t tstep = 2 * hstep;
    const unsigned ldsw = (unsigned)wid * 1024u;
    const int aoff = lds_byte(wr * 64 + fr, fq * 8), boff = lds_byte(wc * 32 + fr, fq * 8);
#define PG8_SA(b, h) (((b) * 2 + (h)) * HTB)
#define PG8_SB(b, h) ((4 + (b) * 2 + (h)) * HTB)
#define PG8_STAGE(bufoff, gbase, voff) do { _Pragma("unroll") for (int _i = 0; _i < 2; ++_i) \
        __builtin_amdgcn_global_load_lds((const unsigned*)((const char*)(gbase) + (voff)[_i]), (PG8_LAS unsigned*)(lds + (bufoff) + ldsw + _i * 8192), 16, 0, 0); } while (0)
#define PG8_LDA(dst, b, h) do { _Pragma("unroll") for (int m = 0; m < 4; ++m) _Pragma("unroll") for (int k = 0; k < 2; ++k) dst[m][k] = *(const PG8_LAS bf16x8*)(lds + PG8_SA(b, h) + aoff + m * 2048 + k * 1024); } while (0)
#define PG8_LDB(dst, b, h) do { _Pragma("unroll") for (int n = 0; n < 2; ++n) _Pragma("unroll") for (int k = 0; k < 2; ++k) dst[n][k] = *(const PG8_LAS bf16x8*)(lds + PG8_SB(b, h) + boff + n * 2048 + k * 1024); } while (0)
#define PG8_MMA(ai, bj, At, Bt) do { __builtin_amdgcn_s_setprio(1); _Pragma("unroll") for (int m = 0; m < 4; ++m) _Pragma("unroll") for (int n = 0; n < 2; ++n) _Pragma("unroll") for (int k = 0; k < 2; ++k) \
        acc[ai][bj][m][n] = __builtin_amdgcn_mfma_f32_16x16x32_bf16(Bt[n][k], At[m][k], acc[ai][bj][m][n], 0, 0, 0); __builtin_amdgcn_s_setprio(0); } while (0)
#define PG8_WAIT_V(n) asm volatile("s_waitcnt vmcnt(" #n ")" ::: "memory")
#define PG8_WAIT_L(n) asm volatile("s_waitcnt lgkmcnt(" #n ")" ::: "memory")
#define PG8_BAR __builtin_amdgcn_s_barrier()
#define PG8_SCHED __builtin_amdgcn_sched_barrier(0)
    Unit cur, nxt; int ui = 0;
    if (!S.next(0, cur)) return;
    f32x4 acc[2][2][4][2];
#pragma unroll
    for (int a = 0; a < 2; ++a)
#pragma unroll
        for (int b = 0; b < 2; ++b)
#pragma unroll
            for (int m = 0; m < 4; ++m)
#pragma unroll
                for (int n = 0; n < 2; ++n) acc[a][b][m][n] = (f32x4){0.f, 0.f, 0.f, 0.f};
    bf16x8 At[4][2], B0[2][2], B1[2][2];
    const char* cA = (const char*)g.A + (size_t)cur.pm * tstep; const char* cB = (const char*)g.Bt + (size_t)cur.pn * tstep;
    S.a_ready(cur);
    if constexpr (SP2) {
        PG8_STAGE(PG8_SB(0, 0), cB, voffB); PG8_STAGE(PG8_SB(0, 1), cB + hstep, voffB); PG8_STAGE(PG8_SA(0, 0), cA, voffA); PG8_STAGE(PG8_SA(0, 1), cA + hstep, voffA);
        if (wr == 1) PG8_BAR;
        PG8_WAIT_V(2); PG8_BAR;
        PG8_STAGE(PG8_SB(1, 0), cB + kstep, voffB); PG8_STAGE(PG8_SA(1, 0), cA + kstep, voffA); PG8_STAGE(PG8_SB(1, 1), cB + hstep + kstep, voffB);
        PG8_WAIT_V(6); PG8_BAR;
    } else {
        PG8_STAGE(PG8_SB(0, 0), cB, voffB); PG8_STAGE(PG8_SA(0, 0), cA, voffA); PG8_STAGE(PG8_SB(0, 1), cB + hstep, voffB); PG8_STAGE(PG8_SA(0, 1), cA + hstep, voffA);
        if (wr == 1) PG8_BAR;
        PG8_WAIT_V(4); PG8_BAR;
        PG8_STAGE(PG8_SB(1, 0), cB + kstep, voffB); PG8_STAGE(PG8_SA(1, 0), cA + kstep, voffA); PG8_STAGE(PG8_SB(1, 1), cB + hstep + kstep, voffB);
        PG8_WAIT_V(6); PG8_BAR;
    }
    for (;;) {
        const bool has_next = S.next(ui + 1, nxt);
        const char* nA = has_next ? (const char*)g.A + (size_t)nxt.pm * tstep : cA; const char* nB = has_next ? (const char*)g.Bt + (size_t)nxt.pn * tstep : cB;
#pragma unroll 1
        for (int t = 0; t < nt; t += 2) {
            const bool last = (t == nt - 2);
            const char* a1 = cA + (size_t)(t + 1) * kstep;
            const char* a2 = last ? nA : cA + (size_t)(t + 2) * kstep; const char* b2 = last ? nB : cB + (size_t)(t + 2) * kstep;
            const char* a3 = a2 + kstep; const char* b3 = b2 + kstep;
            if (last && has_next) S.a_ready(nxt);
            if constexpr (Epi::NORM) { if (t == 2) E.prefetch(cur, tid, wid); if (t == 4) E.reduce_rs(tid); }
            if constexpr (SP2) {
            PG8_LDB(B0, 0, 0); PG8_LDB(B1, 0, 1); PG8_SCHED; PG8_LDA(At, 0, 0); PG8_STAGE(PG8_SA(1, 1), a1 + hstep, voffA);
            PG8_WAIT_V(8); PG8_WAIT_L(0); PG8_BAR; PG8_MMA(0, 0, At, B0); PG8_MMA(0, 1, At, B1); PG8_BAR; PG8_SCHED;
            PG8_LDA(At, 0, 1); PG8_STAGE(PG8_SB(0, 0), b2, voffB); PG8_STAGE(PG8_SB(0, 1), b2 + hstep, voffB); PG8_STAGE(PG8_SA(0, 0), a2, voffA);
            PG8_WAIT_V(8); PG8_WAIT_L(0); PG8_BAR; PG8_MMA(1, 0, At, B0); PG8_MMA(1, 1, At, B1); PG8_BAR; PG8_SCHED;
            PG8_LDB(B0, 1, 0); PG8_LDB(B1, 1, 1); PG8_SCHED; PG8_LDA(At, 1, 0); PG8_STAGE(PG8_SA(0, 1), a2 + hstep, voffA);
            PG8_WAIT_V(8); PG8_WAIT_L(0); PG8_BAR; PG8_MMA(0, 0, At, B0); PG8_MMA(0, 1, At, B1); PG8_BAR; PG8_SCHED;
            PG8_LDA(At, 1, 1); PG8_STAGE(PG8_SB(1, 0), b3, voffB); PG8_STAGE(PG8_SB(1, 1), b3 + hstep, voffB); PG8_STAGE(PG8_SA(1, 0), a3, voffA);
            PG8_WAIT_V(8); PG8_WAIT_L(0); PG8_BAR; PG8_MMA(1, 0, At, B0); PG8_MMA(1, 1, At, B1); PG8_BAR; PG8_SCHED;
            } else {
            PG8_LDB(B0, 0, 0); PG8_SCHED; PG8_LDA(At, 0, 0); PG8_STAGE(PG8_SA(1, 1), a1 + hstep, voffA);
            PG8_WAIT_L(8); PG8_BAR; PG8_WAIT_L(0); PG8_MMA(0, 0, At, B0); PG8_BAR; PG8_SCHED;
            PG8_LDB(B1, 0, 1); PG8_STAGE(PG8_SB(0, 0), b2, voffB);
            PG8_BAR; PG8_WAIT_L(0); PG8_MMA(0, 1, At, B1); PG8_BAR;
            PG8_LDA(At, 0, 1); PG8_STAGE(PG8_SA(0, 0), a2, voffA);
            PG8_BAR; PG8_WAIT_L(0); PG8_MMA(1, 0, At, B0); PG8_BAR; PG8_SCHED;
            PG8_STAGE(PG8_SB(0, 1), b2 + hstep, voffB);
            PG8_WAIT_V(6); PG8_BAR; PG8_MMA(1, 1, At, B1); PG8_BAR;
            PG8_LDB(B0, 1, 0); PG8_SCHED; PG8_LDA(At, 1, 0); PG8_STAGE(PG8_SA(0, 1), a2 + hstep, voffA);
            PG8_WAIT_L(8); PG8_BAR; PG8_WAIT_L(0); PG8_MMA(0, 0, At, B0); PG8_BAR; PG8_SCHED;
            PG8_LDB(B1, 1, 1); PG8_STAGE(PG8_SB(1, 0), b3, voffB);
            PG8_BAR; PG8_WAIT_L(0); PG8_MMA(0, 1, At, B1); PG8_BAR;
            PG8_LDA(At, 1, 1); PG8_STAGE(PG8_SA(1, 0), a3, voffA);
            PG8_BAR; PG8_WAIT_L(0); PG8_MMA(1, 0, At, B0); PG8_BAR; PG8_SCHED;
            PG8_STAGE(PG8_SB(1, 1), b3 + hstep, voffB);
            PG8_WAIT_V(6); PG8_BAR; PG8_MMA(1, 1, At, B1); PG8_BAR;
            }
        }
        if constexpr (ALIGN_EPI) { if (wr == 0) PG8_BAR; }
        if constexpr (!Epi::AFTER_DRAIN) { E(acc, cur, wr, wc, fr, fq); S.done(cur); }
        if (!has_next) break;
#pragma unroll
        for (int a = 0; a < 2; ++a)
#pragma unroll
            for (int b = 0; b < 2; ++b)
#pragma unroll
                for (int m = 0; m < 4; ++m)
#pragma unroll
                    for (int n = 0; n < 2; ++n) acc[a][b][m][n] = (f32x4){0.f, 0.f, 0.f, 0.f};
        cur = nxt; cA = nA; cB = nB; ++ui;
        if constexpr (ALIGN_EPI) { if (wr == 1) PG8_BAR; }
    }
    PG8_WAIT_V(0);
    if constexpr (!ALIGN_EPI) { if (wr == 0) PG8_BAR; }
    PG8_BAR;
    if constexpr (Epi::AFTER_DRAIN) { E.fused(acc, cur, wr, wc, fr, fq, lds, wid, lane); S.done(cur); }
#undef PG8_SA
#undef PG8_SB
#undef PG8_STAGE
#undef PG8_LDA
#undef PG8_LDB
#undef PG8_MMA
#undef PG8_WAIT_V
#undef PG8_WAIT_L
#undef PG8_BAR
#undef PG8_SCHED
}
}
namespace pg8 {
template <int ACT  > struct EpiRoute {
    static constexpr bool PERM = true, AFTER_DRAIN = false, NORM = false;
    bf16_t* O0; int ld0; bf16_t* O1; int ld1; int split;
    __device__ __forceinline__ void operator()(const f32x4 (&acc)[2][2][4][2], const Unit& u, int wr, int wc, int fr, int fq) const {
        const int row0 = u.pm * BM + wr * 64 + fr; const bool first = u.pn < split;
        bf16_t* base = first ? O0 : O1; const int ld = first ? ld0 : ld1; const int col0 = (first ? u.pn : u.pn - split) * BM + wc * 32 + 8 * fq;
#pragma unroll
        for (int ai = 0; ai < 2; ++ai)
#pragma unroll
            for (int m = 0; m < 4; ++m) { bf16_t* rowp = base + (size_t)(row0 + ai * HALF + m * 16) * ld + col0;
#pragma unroll
                for (int bj = 0; bj < 2; ++bj) { f32x4 v0 = acc[ai][bj][m][0], v1 = acc[ai][bj][m][1];
                    if (ACT == 1) {
#pragma unroll
                        for (int e = 0; e < 4; ++e) { const float a = fmaxf(v0[e], 0.f), b = fmaxf(v1[e], 0.f); v0[e] = a * a; v1[e] = b * b; } }
                    u32x4 w; w.x = cvt_pk_bf16(v0[0], v0[1]); w.y = cvt_pk_bf16(v0[2], v0[3]); w.z = cvt_pk_bf16(v1[0], v1[1]); w.w = cvt_pk_bf16(v1[2], v1[3]);
                    *(u32x4*)(rowp + bj * HALF) = w; } }
    }
};
struct EpiResid {
    static constexpr bool PERM = true, AFTER_DRAIN = false, NORM = false;
    const float* xsrc; float* xdst; const float* gate;
    __device__ __forceinline__ void operator()(const f32x4 (&acc)[2][2][4][2], const Unit& u, int wr, int wc, int fr, int fq) const {
        const int row0 = u.pm * BM + wr * 64 + fr, col0 = u.pn * BM + wc * 32 + 8 * fq, b = (u.pm * BM) >> 12;
        f32x4 gv[2][2];
#pragma unroll
        for (int bj = 0; bj < 2; ++bj)
#pragma unroll
            for (int n = 0; n < 2; ++n) gv[bj][n] = *(const f32x4*)(gate + (size_t)b * 6144 + col0 + bj * HALF + 4 * n);
#pragma unroll
        for (int ai = 0; ai < 2; ++ai)
#pragma unroll
            for (int m = 0; m < 4; ++m) { const size_t off = (size_t)(row0 + ai * HALF + m * 16) * 1024 + col0;
#pragma unroll
                for (int bj = 0; bj < 2; ++bj)
#pragma unroll
                    for (int n = 0; n < 2; ++n) { const f32x4 xs = *(const f32x4*)(xsrc + off + bj * HALF + 4 * n);
                        *(f32x4*)(xdst + off + bj * HALF + 4 * n) = xs + gv[bj][n] * acc[ai][bj][m][n]; }
                if (m & 1) asm volatile("" ::: "memory"); }
    }
};
constexpr int EPI_OFF = 133120;
template <int ACT  > struct EpiRouteN {
    static constexpr bool PERM = true, AFTER_DRAIN = false, NORM = true;
    bf16_t* O; int ld; const float* RSP; const float* shw; PG8_LAS unsigned char* lds;
    __device__ __forceinline__ void prefetch(const Unit& u, int tid, int wid) const {
        const char* src = (const char*)RSP + (size_t)u.pm * (BM * 64) + (size_t)tid * 16;
#pragma unroll
        for (int i = 0; i < 2; ++i) __builtin_amdgcn_global_load_lds((const unsigned*)(src + i * 8192), (PG8_LAS unsigned*)(lds + EPI_OFF + wid * 1024 + i * 8192), 16, 0, 0);
        if (wid == 0) { const char* s2 = (const char*)(shw + (size_t)((u.pm * BM) >> 12) * NSHW + u.pn * BM) + (size_t)(tid & 63) * 16;
            __builtin_amdgcn_global_load_lds((const unsigned*)s2, (PG8_LAS unsigned*)(lds + EPI_OFF + 16384), 16, 0, 0); }
    }
    __device__ __forceinline__ void reduce_rs(int tid) const {
        if (tid < 256) { const PG8_LAS f32x4* p = (const PG8_LAS f32x4*)(lds + EPI_OFF + tid * 64); const f32x4 a = p[0], b = p[1], c = p[2], d = p[3];
            const float s = (((a.x + a.y) + (a.z + a.w)) + ((b.x + b.y) + (b.z + b.w))) + (((c.x + c.y) + (c.z + c.w)) + ((d.x + d.y) + (d.z + d.w)));
            *(PG8_LAS float*)(lds + EPI_OFF + 17408 + tid * 4) = __builtin_amdgcn_rsqf(s * (1.0f / 1024.0f) + 1e-6f); }
    }
    __device__ __forceinline__ void operator()(const f32x4 (&acc)[2][2][4][2], const Unit& u, int wr, int wc, int fr, int fq) const {
        const int row0 = u.pm * BM + wr * 64 + fr, col0 = u.pn * BM + wc * 32 + 8 * fq;
        const PG8_LAS unsigned char* ep = lds + EPI_OFF;
        float rs[2][4];
#pragma unroll
        for (int ai = 0; ai < 2; ++ai)
#pragma unroll
            for (int m = 0; m < 4; ++m) rs[ai][m] = *(const PG8_LAS float*)(ep + 17408 + (wr * 64 + fr + ai * HALF + m * 16) * 4);
        f32x4 sv[2][2];
#pragma unroll
        for (int bj = 0; bj < 2; ++bj)
#pragma unroll
            for (int n = 0; n < 2; ++n) sv[bj][n] = *(const PG8_LAS f32x4*)(ep + 16384 + (bj * HALF + wc * 32 + 8 * fq + 4 * n) * 4);
#pragma unroll
        for (int ai = 0; ai < 2; ++ai)
#pragma unroll
            for (int m = 0; m < 4; ++m) { bf16_t* rowp = O + (size_t)(row0 + ai * HALF + m * 16) * ld + col0;
#pragma unroll
                for (int bj = 0; bj < 2; ++bj) { f32x4 v0 = acc[ai][bj][m][0] * rs[ai][m] + sv[bj][0], v1 = acc[ai][bj][m][1] * rs[ai][m] + sv[bj][1];
                    if (ACT == 1) {
#pragma unroll
                        for (int e = 0; e < 4; ++e) { const float a = fmaxf(v0[e], 0.f), b = fmaxf(v1[e], 0.f); v0[e] = a * a; v1[e] = b * b; } }
                    u32x4 w; w.x = cvt_pk_bf16(v0[0], v0[1]); w.y = cvt_pk_bf16(v0[2], v0[3]); w.z = cvt_pk_bf16(v1[0], v1[1]); w.w = cvt_pk_bf16(v1[2], v1[3]);
                    *(u32x4*)(rowp + bj * HALF) = w; } }
    }
};
template <bool MAYSKIP> struct EpiResidXS {
    static constexpr bool PERM = true, AFTER_DRAIN = false, NORM = false;
    const bf16_t* xsrc; bf16_t* xdst; const float* gate; const float* wp; bf16_t* XS; float* RSP; int doxs;
    template <bool DOXS> __device__ __forceinline__ void body(const f32x4 (&acc)[2][2][4][2], const Unit& u, int wr, int wc, int fr, int fq) const {
        const int row0 = u.pm * BM + wr * 64 + fr, col0 = u.pn * BM + wc * 32 + 8 * fq, b = (u.pm * BM) >> 12;
        f32x4 gv[2][2], wv[2][2]; float ssv[2][4];
#pragma unroll
        for (int bj = 0; bj < 2; ++bj)
#pragma unroll
            for (int n = 0; n < 2; ++n) { gv[bj][n] = *(const f32x4*)(gate + (size_t)b * 6144 + col0 + bj * HALF + 4 * n);
                if (DOXS) wv[bj][n] = *(const f32x4*)(wp + (size_t)b * 1024 + col0 + bj * HALF + 4 * n); }
#pragma unroll
        for (int aim = 0; aim < 4; ++aim) { const int ai = aim >> 1, m0_ = (aim & 1) * 2;
            u32x4 xr[4][2];
#pragma unroll
            for (int m = m0_; m < m0_ + 2; ++m)
#pragma unroll
                for (int bj = 0; bj < 2; ++bj) xr[m][bj] = *(const u32x4*)(xsrc + (size_t)(row0 + ai * HALF + m * 16) * 1024 + col0 + bj * HALF);
#pragma unroll
            for (int m = m0_; m < m0_ + 2; ++m) { const size_t off = (size_t)(row0 + ai * HALF + m * 16) * 1024 + col0; float ss = 0.f;
#pragma unroll
                for (int bj = 0; bj < 2; ++bj) { const u32x4 r = xr[m][bj];
                    const f32x4 x0 = (f32x4){bflo(r.x), bfhi(r.x), bflo(r.y), bfhi(r.y)}, x1 = (f32x4){bflo(r.z), bfhi(r.z), bflo(r.w), bfhi(r.w)};
                    const f32x4 y0 = x0 + gv[bj][0] * acc[ai][bj][m][0], y1 = x1 + gv[bj][1] * acc[ai][bj][m][1];
                    u32x4 w; w.x = cvt_pk_bf16(y0[0], y0[1]); w.y = cvt_pk_bf16(y0[2], y0[3]); w.z = cvt_pk_bf16(y1[0], y1[1]); w.w = cvt_pk_bf16(y1[2], y1[3]);
                    *(u32x4*)(xdst + off + bj * HALF) = w;
                    if (DOXS) { const f32x4 a = y0 * wv[bj][0], c = y1 * wv[bj][1];
                        u32x4 v; v.x = cvt_pk_bf16(a[0], a[1]); v.y = cvt_pk_bf16(a[2], a[3]); v.z = cvt_pk_bf16(c[0], c[1]); v.w = cvt_pk_bf16(c[2], c[3]);
                        *(u32x4*)(XS + off + bj * HALF) = v;
                        ss += ((y0.x * y0.x + y0.y * y0.y) + (y0.z * y0.z + y0.w * y0.w)) + ((y1.x * y1.x + y1.y * y1.y) + (y1.z * y1.z + y1.w * y1.w)); } }
                ssv[ai][m] = ss; }
            asm volatile("" ::: "memory"); }
        if (DOXS) { float t1[2][4];
#pragma unroll
            for (int ai = 0; ai < 2; ++ai)
#pragma unroll
                for (int m = 0; m < 4; ++m) t1[ai][m] = __shfl_xor(ssv[ai][m], 16);
#pragma unroll
            for (int ai = 0; ai < 2; ++ai)
#pragma unroll
                for (int m = 0; m < 4; ++m) { ssv[ai][m] += t1[ai][m]; t1[ai][m] = __shfl_xor(ssv[ai][m], 32); }
            if (fq == 0) {
#pragma unroll
                for (int ai = 0; ai < 2; ++ai)
#pragma unroll
                    for (int m = 0; m < 4; ++m) RSP[(size_t)(row0 + ai * HALF + m * 16) * 16 + u.pn * 4 + wc] = ssv[ai][m] + t1[ai][m]; } }
    }
    __device__ __forceinline__ void operator()(const f32x4 (&acc)[2][2][4][2], const Unit& u, int wr, int wc, int fr, int fq) const {
        if (!MAYSKIP || doxs) body<true>(acc, u, wr, wc, fr, fq); else body<false>(acc, u, wr, wc, fr, fq);
    }
};
}

#define RLX_AGENT __ATOMIC_RELAXED, __HIP_MEMORY_SCOPE_AGENT
#define XB_TMO      128
#define XB_XCNT(j)  (256  + 64 * (j))
#define XB_XSUB(j)  (1280 + 64 * (j))
#define XB_XGEN(j)  (2304 + 64 * (j))
#define XB_TOP      3328
#define XB_TOPGEN   3392
#define XCD_BAR_WORDS 3456
#define XB_SPIN_CAP (1u << 24)

__device__ __forceinline__ unsigned xb_ld(unsigned* p)              { return __hip_atomic_load(p, __ATOMIC_RELAXED, __HIP_MEMORY_SCOPE_AGENT); }
__device__ __forceinline__ unsigned xb_add(unsigned* p, unsigned v) { return __hip_atomic_fetch_add(p, v, __ATOMIC_RELAXED, __HIP_MEMORY_SCOPE_AGENT); }
__device__ __forceinline__ unsigned xb_xcc_id() { return (unsigned)__builtin_amdgcn_s_getreg((3 << 11) | 20) & 0xFu; }
#define XB_SPIN(cond, bar) do { unsigned _sp = 0; while (cond) { __builtin_amdgcn_s_sleep(1); \
    if ((++_sp & 255u) == 0u) { if (xb_ld(&(bar)[XB_TMO])) break; if (_sp > XB_SPIN_CAP) { atomicAdd(&(bar)[XB_TMO], 1u); break; } } } } while (0)

struct XcdBarrier {
    unsigned* bar; unsigned x;
    volatile LAS unsigned* st;
};

__device__ __forceinline__ XcdBarrier xcd_barrier_post(unsigned* bar, volatile LAS unsigned* st) {
    XcdBarrier b; b.bar = bar; b.x = xb_xcc_id(); b.st = st;
    if (threadIdx.x == 0) (void)xb_add(&bar[XB_XCNT(b.x)], 1u);
    return b;
}
__device__ __forceinline__ void xcd_barrier_complete(unsigned* bar, unsigned x, unsigned& nloc, unsigned& nx) {
    const unsigned G = gridDim.x * gridDim.y * gridDim.z;
    unsigned sum, cnt, mine, sp = 0u;
    for (;;) {
        sum = 0u; cnt = 0u; mine = 0u;
#pragma unroll
        for (unsigned j = 0; j < 16; ++j) { const unsigned c = xb_ld(&bar[XB_XCNT(j)]); sum += c; cnt += (c > 0u) ? 1u : 0u; mine = (j == x) ? c : mine; }
        if (sum == G) break;
        __builtin_amdgcn_s_sleep(1);
        if ((++sp & 255u) == 0u) { if (xb_ld(&bar[XB_TMO])) break; if (sp > XB_SPIN_CAP) { atomicAdd(&bar[XB_TMO], 1u); break; } }
    }
    nloc = mine > 0u ? mine : 1u; nx = cnt > 0u ? cnt : 1u;
}

__device__ __forceinline__ void xcd_barrier(const XcdBarrier& b) {
    asm volatile("s_waitcnt vmcnt(0)" ::: "memory");
    __syncthreads();
    if (threadIdx.x == 0) {
        unsigned* bar = b.bar;
        __builtin_amdgcn_s_waitcnt(0);
        unsigned nloc = b.st[0], nx = b.st[1];
        if (nloc == 0u) { xcd_barrier_complete(bar, b.x, nloc, nx); b.st[0] = nloc; b.st[1] = nx; }
        const unsigned old = xb_add(&bar[XB_XSUB(b.x)], 1u);
        const unsigned gen = old / nloc;
        if (old + 1u == (gen + 1u) * nloc) {
            __builtin_amdgcn_fence(__ATOMIC_RELEASE, "agent");
            asm volatile("s_waitcnt vmcnt(0)" ::: "memory");
            const unsigned og = xb_add(&bar[XB_TOP], 1u);
            const unsigned tg = og / nx;
            if (og + 1u == (tg + 1u) * nx) xb_add(&bar[XB_TOPGEN], 1u);
            else XB_SPIN(xb_ld(&bar[XB_TOPGEN]) == tg, bar);
            __builtin_amdgcn_fence(__ATOMIC_ACQUIRE, "agent");
            xb_add(&bar[XB_XGEN(b.x)], 1u);
            asm volatile("s_waitcnt vmcnt(0)" ::: "memory");
        } else {
            XB_SPIN(xb_ld(&bar[XB_XGEN(b.x)]) == gen, bar);
            __builtin_amdgcn_fence(__ATOMIC_ACQUIRE, "agent");
            asm volatile("s_waitcnt vmcnt(0)" ::: "memory");
        }
    }
    __syncthreads();
}

#ifndef PH_MASK
#define PH_MASK 0xFFFFF
#endif
#define EN(b) if constexpr ((PH_MASK >> (b)) & 1)
#ifndef DUP_MASK
#define DUP_MASK 0
#endif
#define DUP(b) if constexpr ((DUP_MASK >> (b)) & 1)
#define DBG_DIGEST_N 256
#define DBG_DIGEST_VAL(m, c) bf2f(((const bf16*)(wsp + WS_CAT))[(size_t)(m) * DM + 768 + (c)])
#ifndef DBG_PH_HI
#define DBG_PH_HI NPHASE
#endif
#ifndef MK_MULTI
#define MK_MULTI 0
#endif
constexpr int LDS_BYTES = 151552, MISC_OFF = 131072 + 320;
#ifndef DBG_LAYERS
#define DBG_LAYERS 4
#define DBG_L0 0
#endif
constexpr int NPHASE = 3 + 7 * DBG_LAYERS;
__global__ void __launch_bounds__(512, 2) hymba_fwd(Args a) {
    extern __shared__ __attribute__((aligned(16))) unsigned char lds[];
    Ctx F0;
    Ctx& F = F0;
    F.lds = (char*)lds; F.tid = threadIdx.x; F.lane = F.tid & 63; F.wave = __builtin_amdgcn_readfirstlane(F.tid >> 6); F.G = gridDim.x; F.bid = blockIdx.x;
    F.A = nullptr; F.ws = a.ws;
    if (F.tid < 29) ((unsigned long long*)(lds + PTR_OFF))[F.tid] = F.tid < 28 ? (unsigned long long)a.in[F.tid] : (unsigned long long)a.out;
    volatile LAS unsigned* MISC = (volatile LAS unsigned*)((LAS unsigned char*)lds + MISC_OFF);
    if (F.tid < 32) MISC[F.tid] = 0u;
    __syncthreads();
    unsigned* ctl = (unsigned*)(a.ws + WS_CTL);
    XcdBarrier bar; bar.bar = ctl + CW_BAR; bar.x = 0; bar.st = nullptr;
    if (!MK_MULTI) bar = xcd_barrier_post(ctl + CW_BAR, MISC + 8);
    const int lo = a.ph_lo, hi = a.ph_hi;
    int ph = 0;
#define PH_BEGIN if (lo <= ph && ph < hi) { Ctx F = F0; unsigned long long wsl_ = (unsigned long long)F0.ws; asm volatile("" : "+v"(F.tid), "+s"(F.bid), "+s"(F.G), "+s"(wsl_)); F.ws = (unsigned char*)(__attribute__((address_space(1))) unsigned char*)wsl_; F.lane = F.tid & 63; F.wave = __builtin_amdgcn_readfirstlane(F.tid >> 6); unsigned char* const wsp = F.ws; (void)wsp;
#define PH_END   if (!MK_MULTI && ph + 1 < hi) { XcdBarrier bb = bar; asm volatile("" : "+s"(bb.bar), "+s"(bb.x)); xcd_barrier(bb); } else __syncthreads(); } ++ph;
    PG8_LAS unsigned char* glds = (PG8_LAS unsigned char*)lds;
#define XN ((bf16*)(wsp + WS_XN))
#define PROJ ((bf16*)(wsp + WS_PROJ))
#define CAT ((bf16*)(wsp + WS_CAT))
#define HB ((bf16*)(wsp + WS_HB))
    PH_BEGIN EN(0) ph_prologue(F); DUP(0) { __syncthreads(); ph_prologue(F); } PH_END
    PH_BEGIN EN(1) { ph_shw(F); ph_xs0(F, PIN(F, I_X), PIN(F, I_N1W) + DBG_L0 * DM, (const float*)(wsp + WS_MOD) + (size_t)DBG_L0 * BATCH * NADA, DM, XN, (float*)(wsp + WS_RSP), (bf16*)POUT(F)); } PH_END
    for (int l_ = 0; l_ < DBG_LAYERS; ++l_) { const int l = l_ + DBG_L0;
        #define modl ((const float*)(wsp + WS_MOD) + (size_t)l * BATCH * NADA)
        #define xsrc (l_ == 0 ? PIN(F, I_X) : (const float*)POUT(F))
        PH_BEGIN
#if defined(PROBE_GA)
            { pg8::Gemm g{XN, (const bf16*)(wsp + WS_WIN) + (size_t)l * NPROJ * DM, MTOK, NPROJ, DM}; pg8::StaticOrder S; S.init(MTOK, NPROJ, F.G, F.bid);
            pg8::EpiRoute<0> E{PROJ, NPROJ, PROJ, NPROJ, 1 << 20};
            pg8::gemm_phase<pg8::EpiRoute<0>, pg8::StaticOrder, true, true>(glds, g, S, E, F.tid); } __syncthreads();
#elif defined(PROBE_GB)
            { pg8::Gemm g{XN, (const bf16*)(wsp + WS_WIN) + (size_t)l * NPROJ * DM, MTOK, NPROJ, DM}; pg8::StaticOrder S; S.init(MTOK, NPROJ, F.G, F.bid);
            pg8::EpiRouteN<0> E{PROJ, NPROJ, (const float*)(wsp + WS_RSP), (const float*)(wsp + WS_SHW) + (size_t)l * BATCH * NSHW, glds};
            pg8::gemm_phase<pg8::EpiRouteN<0>, pg8::StaticOrder, true, true>(glds, g, S, E, F.tid); } __syncthreads();
#endif
        EN(2) { pg8::Gemm g{XN, (const bf16*)(wsp + WS_WIN) + (size_t)l * NPROJ * DM, MTOK, NPROJ, DM}; pg8::StaticOrder S; S.init(MTOK, NPROJ, F.G, F.bid);
            pg8::EpiRouteN<0> E{PROJ, NPROJ, (const float*)(wsp + WS_RSP), (const float*)(wsp + WS_SHW) + (size_t)l * BATCH * NSHW, glds};
            pg8::gemm_phase<pg8::EpiRouteN<0>, pg8::StaticOrder, true, true>(glds, g, S, E, F.tid); } PH_END
        PH_BEGIN EN(3) ph_prep(F, l); DUP(3) ph_prep(F, l); EN(4) ph_lru1(F, l); DUP(4) ph_lru1(F, l); EN(5) ph_mlstm(F, l); DUP(5) ph_mlstm(F, l); PH_END
        PH_BEGIN EN(6) { ph_carry(F); pg8::Gemm g{(const bf16*)(wsp + WS_QL), (const bf16*)(wsp + WS_WQC) + (size_t)l * 768 * 256, MTOK, 768, 256}; pg8::StaticOrder S; S.init(MTOK, 768, F.G, F.bid);
            pg8::EpiRoute<0> E{(bf16*)(wsp + WS_QABS), 512, (bf16*)(wsp + WS_QIDX), 256, 2};
            pg8::gemm_phase<pg8::EpiRoute<0>, pg8::StaticOrder, true, true>(glds, g, S, E, F.tid); } PH_END
        PH_BEGIN EN(7) ph_dsa(F, l); DUP(7) ph_dsa(F, l); EN(8) ph_lru2(F, l); DUP(8) ph_lru2(F, l); EN(9) ph_mfin(F, l); DUP(9) ph_mfin(F, l); PH_END
        PH_BEGIN EN(10) { pg8::Gemm g{CAT, (const bf16*)(wsp + WS_WO) + (size_t)l * DM * DM, MTOK, DM, DM}; pg8::StaticOrder S; S.init(MTOK, DM, F.G, F.bid);
            pg8::EpiResidXS<false> E{(const pg8::bf16_t*)POUT(F), (pg8::bf16_t*)POUT(F), modl + 2 * DM, (const float*)(wsp + WS_WP) + (size_t)(l * 2 + 1) * BATCH * DM, XN, (float*)(wsp + WS_RSP), 1};
            pg8::gemm_phase<pg8::EpiResidXS<false>, pg8::StaticOrder, true, true>(glds, g, S, E, F.tid); } PH_END
        PH_BEGIN EN(12) { pg8::Gemm g{XN, (const bf16*)(wsp + WS_W1) + (size_t)l * DFF * DM, MTOK, DFF, DM}; pg8::StaticOrder S; S.init(MTOK, DFF, F.G, F.bid);
            pg8::EpiRouteN<1> E{HB, DFF, (const float*)(wsp + WS_RSP), (const float*)(wsp + WS_SHW) + (size_t)l * BATCH * NSHW + NPROJ, glds};
            pg8::gemm_phase<pg8::EpiRouteN<1>, pg8::StaticOrder, true, true>(glds, g, S, E, F.tid); } PH_END
        PH_BEGIN EN(13) { pg8::Gemm g{HB, (const bf16*)(wsp + WS_W2) + (size_t)l * DM * DFF, MTOK, DM, DFF}; pg8::StaticOrder S; S.init(MTOK, DM, F.G, F.bid);
            const int nl = l + 1 < DEPTH ? l + 1 : l;
            const bool lastl = l_ + 1 >= DBG_LAYERS;
            pg8::EpiResidXS<true> E{(const pg8::bf16_t*)POUT(F), lastl ? (pg8::bf16_t*)XN : (pg8::bf16_t*)POUT(F), modl + 5 * DM, (const float*)(wsp + WS_WP) + (size_t)(nl * 2) * BATCH * DM, XN, (float*)(wsp + WS_RSP), lastl ? 0 : 1};
            pg8::gemm_phase<pg8::EpiResidXS<true>, pg8::StaticOrder, true, true>(glds, g, S, E, F.tid); } PH_END
    }
#ifdef DBG_DIGEST
    PH_BEGIN { const int gw = F.bid * 8 + F.wave, NGW = F.G * 8; float* o = POUT(F);
        for (int m = gw; m < MTOK; m += NGW) for (int j = 0; j < 16; ++j) { const int c = F.lane + 64 * j; float v = 0.f;
            if (c < DBG_DIGEST_N) { v = DBG_DIGEST_VAL(m, c) * 4096.0f; v = v - floorf(v); }
            o[(size_t)m * DM + c] = v; } } PH_END
#else
    PH_BEGIN EN(14) ph_finalnorm16(F, XN, PIN(F, I_FNW), POUT(F)); PH_END
#endif
}

extern "C" void kernel_launch(void* const* d_in, const int* in_sizes, int n_in, void* d_out, int out_size, void* d_ws, size_t ws_size, hipStream_t stream) {
    static int grid = 0;
    if (grid == 0) {
        if (n_in != 28 || in_sizes[0] != MTOK * DM || out_size != MTOK * DM || ws_size < WS_END) { fprintf(stderr, "kernel_launch: unexpected shapes (n_in %d, in0 %d, out %d, ws %zu)\n", n_in, n_in > 0 ? in_sizes[0] : -1, out_size, ws_size); grid = -1; return; }
        int dev = 0, cus = 0, per_cu = 0;
        if (hipGetDevice(&dev) != hipSuccess || hipDeviceGetAttribute(&cus, hipDeviceAttributeMultiprocessorCount, dev) != hipSuccess) { grid = -1; return; }
        if (hipFuncSetAttribute((const void*)hymba_fwd, hipFuncAttributeMaxDynamicSharedMemorySize, LDS_BYTES) != hipSuccess) { fprintf(stderr, "kernel_launch: hipFuncSetAttribute failed\n"); grid = -1; return; }
        if (hipOccupancyMaxActiveBlocksPerMultiprocessor(&per_cu, (const void*)hymba_fwd, 512, LDS_BYTES) != hipSuccess || per_cu < 1) { fprintf(stderr, "kernel_launch: occupancy query says %d\n", per_cu); }
        (void)hipGetLastError();
        grid = cus;
    }
    if (grid < 0) return;
    if (hipMemsetAsync((char*)d_ws + WS_CTL, 0, CTL_ZERO_BYTES, stream) != hipSuccess) return;
    Args a{};
    for (int i = 0; i < 28; ++i) a.in[i] = (const float*)d_in[i];
    a.out = (float*)d_out; a.ws = (unsigned char*)d_ws;
#if MK_MULTI
    for (int p = 0; p < NPHASE; ++p) { a.ph_lo = p; a.ph_hi = p + 1; hipLaunchKernelGGL(hymba_fwd, dim3(grid), dim3(512), LDS_BYTES, stream, a); }
#else
    a.ph_lo = 0; a.ph_hi = DBG_PH_HI; hipLaunchKernelGGL(hymba_fwd, dim3(grid), dim3(512), LDS_BYTES, stream, a);
#endif
}
#endif
```

```cpp
#ifndef HOST_EMU
#include <hip/hip_runtime.h>
#include <cstdio>
#include <cstdint>
#define DEV __device__ __forceinline__
#define LAS __attribute__((address_space(3)))
#else
#include "emu.h"
#endif

#ifndef HOST_EMU
#define SYNC() __syncthreads()
#define KEEP4(a, b, c, d) asm volatile("" :: "v"(a), "v"(b), "v"(c), "v"(d))
#define LAUNDER_V(x) asm volatile("" : "+v"(x))
#define WAVE_LDS_FENCE() asm volatile("s_waitcnt lgkmcnt(0)" ::: "memory")
template <class T> DEV T SHFL(T v, int s) { return __shfl(v, s); }
template <class T> DEV T SHFL_XOR(T v, int m) { return __shfl_xor(v, m); }
template <class T> DEV T SHFL_UP(T v, int d) { return __shfl_up(v, d); }
template <class T> DEV T SHFL_DOWN(T v, int d) { return __shfl_down(v, d); }
typedef short bf16x8_ __attribute__((ext_vector_type(8)));
typedef float f32x4_ __attribute__((ext_vector_type(4)));
typedef short v4i16_t __attribute__((ext_vector_type(4)));
DEV f32x4_ MFMA16(bf16x8_ a, bf16x8_ b, f32x4_ c) { return __builtin_amdgcn_mfma_f32_16x16x32_bf16(a, b, c, 0, 0, 0); }
DEV v4i16_t TR16(const void* p) { return __builtin_amdgcn_ds_read_tr16_b64_v4i16((LAS v4i16_t*)(p)); }
#endif


typedef unsigned short bf16;
typedef short bf16x8 __attribute__((ext_vector_type(8)));
typedef short s16x4 __attribute__((ext_vector_type(4)));
typedef float f32x4 __attribute__((ext_vector_type(4)));
typedef unsigned u32x4 __attribute__((ext_vector_type(4)));
typedef unsigned u32x2 __attribute__((ext_vector_type(2)));

constexpr int BATCH = 16, SEQ = 4096, DM = 1024, DEPTH = 4, MTOK = BATCH * SEQ;
constexpr int NPROJ = 3072, DFF = 4096, NADA = 6 * DM;
constexpr int PC_LX = 0, PC_LY = 256, PC_MQ = 512, PC_MK = 1024, PC_MV = 1536, PC_MO = 2048, PC_AQ = 2560, PC_AKV = 2816, PC_IK = 2944, PC_IW = 2976, PC_MI = 2984, PC_MF = 2988;
constexpr float NORM_EPS = 1e-6f;

constexpr size_t MiB = 1u << 20;
constexpr size_t WS_CTL = 0, CTL_ZERO_BYTES = 1 * MiB;
constexpr size_t WS_MOD = 1 * MiB;
constexpr size_t WS_WQC = 3 * MiB;
constexpr size_t WS_WG = 5 * MiB;
constexpr size_t WS_WUVT = 6 * MiB;
constexpr size_t WS_WIN = 8 * MiB;
constexpr size_t WS_WO = 32 * MiB;
constexpr size_t WS_W1 = 40 * MiB;
constexpr size_t WS_W2 = 72 * MiB;
constexpr size_t WS_XN = 104 * MiB;
constexpr size_t WS_QL = WS_XN, WS_CKV = WS_XN + 32 * MiB, WS_QIDX = WS_XN + 48 * MiB, WS_KIDX = WS_XN + 80 * MiB, WS_WI = WS_XN + 84 * MiB, WS_GT = WS_XN + 86 * MiB;
constexpr size_t WS_CAT = 232 * MiB;
constexpr size_t WS_PROJ = 360 * MiB;
constexpr size_t WS_HB = 360 * MiB;
constexpr size_t WS_QABS = 744 * MiB;
constexpr size_t WS_HLOC = 808 * MiB, WS_CPA = 840 * MiB;
constexpr size_t WS_LSUM = 872 * MiB;
constexpr size_t WS_HM = 874 * MiB;
constexpr size_t WS_MG = 940 * MiB;
constexpr size_t WS_WP = 2 * MiB + 512 * 1024;
constexpr size_t WS_SHW = 6 * MiB + 256 * 1024;
constexpr size_t WS_RSP = 1000 * MiB;
constexpr size_t WS_CARRY = 948 * MiB;
constexpr size_t WS_SCR2 = 949 * MiB;
constexpr int NSHW = NPROJ + DFF;
constexpr size_t WS_END = 1024 * MiB;
static_assert(WS_HM + (size_t)MTOK * 512 * 2 <= WS_END && WS_HB + (size_t)MTOK * DFF * 2 <= WS_HLOC + 64 * MiB, "ws map");

constexpr int CW_TMO = 0, CW_BAR = 4096;

#ifndef HOST_EMU
typedef __bf16 hwbf2_t __attribute__((ext_vector_type(2)));
typedef float hwf2_t __attribute__((ext_vector_type(2)));
DEV unsigned f2bf(float f) { return (unsigned)__builtin_bit_cast(unsigned short, (__bf16)f); }
DEV unsigned pk2(float lo, float hi) { const hwf2_t v = {lo, hi}; return __builtin_bit_cast(unsigned, __builtin_convertvector(v, hwbf2_t)); }
#else
DEV unsigned f2bf(float f) { unsigned u = __builtin_bit_cast(unsigned, f); return (u + 0x7fffu + ((u >> 16) & 1u)) >> 16; }
DEV unsigned pk2(float lo, float hi) { return f2bf(lo) | (f2bf(hi) << 16); }
#endif
DEV float bf2f(unsigned h) { return __builtin_bit_cast(float, h << 16); }
DEV float bflo(unsigned w) { return __builtin_bit_cast(float, w << 16); }
DEV float bfhi(unsigned w) { return __builtin_bit_cast(float, w & 0xffff0000u); }
DEV float wave_sum(float v) {
#pragma unroll
    for (int o = 1; o < 64; o <<= 1) v += SHFL_XOR(v, o);
    return v;
}
#ifndef HOST_EMU
DEV float FEXP(float x) { return __expf(x); }
DEV float FEXP2(float x) { return __builtin_amdgcn_exp2f(x); }
DEV float FRCP(float x) { return __builtin_amdgcn_rcpf(x); }
DEV float FSQRT(float x) { return __builtin_amdgcn_sqrtf(x); }
DEV float RSQ(float x) { return __builtin_amdgcn_rsqf(x); }
DEV float FLOG(float x) { return __logf(x); }
#else
DEV float FEXP(float x) { return expf(x); }
DEV float FEXP2(float x) { return exp2f(x); }
DEV float FRCP(float x) { return 1.0f / x; }
DEV float FSQRT(float x) { return sqrtf(x); }
DEV float RSQ(float x) { return 1.0f / sqrtf(x); }
DEV float FLOG(float x) { return logf(x); }
#endif
#ifndef HOST_EMU
DEV int UNI(int x) { return __builtin_amdgcn_readfirstlane(x); }
#else
DEV int UNI(int x) { return x; }
#endif
#ifndef HOST_EMU
#define GAS __attribute__((address_space(1)))
DEV const GAS char* UNIP(const void* p) { const unsigned long long v = (unsigned long long)p; const unsigned lo = __builtin_amdgcn_readfirstlane((unsigned)v), hi = __builtin_amdgcn_readfirstlane((unsigned)(v >> 32));
    return (const GAS char*)(((unsigned long long)hi << 32) | lo); }
#else
#define GAS
DEV const char* UNIP(const void* p) { return (const char*)p; }
#endif
DEV float RELU(float x) { const int b = __builtin_bit_cast(int, x); return __builtin_bit_cast(float, b > 0 ? b : 0); }
DEV float sigmoidf_(float z) { return 1.0f / (1.0f + expf(-z)); }
DEV float fsigmoid(float z) { return FRCP(1.0f + FEXP(-z)); }
DEV float one_minus_exp(float x) {
    const float s = -x * (1.0f + x * (0.5f + x * (0.16666667f + x * 0.041666668f)));
    return x > -0.05f ? s : 1.0f - FEXP(x);
}

struct Args { const float* in[28]; float* out; unsigned char* ws; int ph_lo, ph_hi; };
struct Ctx {
    char* lds; int tid, lane, wave, G, bid;
    const Args* A;
    unsigned char* ws;
};

constexpr int PTR_OFF = 131072 + 512;
#ifndef HOST_EMU
DEV const float* PIN(const Ctx& F, int i) { const unsigned long long v = ((const unsigned long long*)(F.lds + PTR_OFF))[i];
    const unsigned lo = __builtin_amdgcn_readfirstlane((unsigned)v), hi = __builtin_amdgcn_readfirstlane((unsigned)(v >> 32)); return (const float*)(const __attribute__((address_space(1))) float*)(((unsigned long long)hi << 32) | lo); }
DEV float* POUT(const Ctx& F) { return (float*)PIN(F, 28); }
#else
DEV const float* PIN(const Ctx& F, int i) { return F.A->in[i]; }
DEV float* POUT(const Ctx& F) { return POUT(F); }
#endif
enum { I_X = 0, I_C, I_WIN, I_CONVW, I_CONVB, I_WA, I_BA, I_WX, I_BX, I_LAM, I_BI, I_BF, I_WQUP, I_WQIDX, I_WUK, I_WUV, I_QNW, I_KVNW, I_RELB, I_GNW, I_WO, I_WADA, I_BADA, I_N1W, I_N2W, I_W1, I_W2, I_FNW };

DEV int win_srccol(int n) {
    if (n < 2560) return n;
    if (n < PC_AKV) return 2568 + (n - PC_AQ);
    if (n < PC_IK) return 2824 + (n - PC_AKV);
    if (n < PC_IW) return 2952 + (n - PC_IK);
    if (n < PC_MI) return 2984 + (n - PC_IW);
    if (n < PC_MF) return 2560 + (n - PC_MI);
    if (n < 2992) return 2564 + (n - PC_MF);
    return -1;
}
template <bool MAPPED>
DEV void p0_transpose_item(const float* W, int K, int N, int NT, bf16* WT, float* scr, int item, int lane) {
    const int nblk = NT / 32, kb = item / nblk, nb = item % nblk, k0 = 64 * kb, n0 = 32 * nb;
    int sc = n0 + (lane & 31); if (MAPPED) sc = win_srccol(sc);
#pragma unroll 8
    for (int i = 0; i < 32; ++i) { const int kk = 2 * i + (lane >> 5); const float v = W[(size_t)(k0 + kk) * N + (sc >= 0 ? sc : 0)]; scr[kk * 33 + (lane & 31)] = sc >= 0 ? v : 0.f; }
    WAVE_LDS_FENCE();
    const int c = lane & 7;
#pragma unroll
    for (int j = 0; j < 4; ++j) { const int n = (lane >> 3) + 8 * j; const float* s = scr + (8 * c) * 33 + n;
        u32x4 o; o.x = pk2(s[0 * 33], s[1 * 33]); o.y = pk2(s[2 * 33], s[3 * 33]); o.z = pk2(s[4 * 33], s[5 * 33]); o.w = pk2(s[6 * 33], s[7 * 33]);
        *(u32x4*)(WT + (size_t)(n0 + n) * K + k0 + 8 * c) = o; }
    WAVE_LDS_FENCE();
}

DEV void ph_prologue(const Ctx& F) {
    const int gt = F.bid * 512 + F.tid, NGT = F.G * 512;
    float* CACT = (float*)F.lds;
    for (int i = F.tid; i < BATCH * DM; i += 512) { const float cv = PIN(F, I_C)[i]; CACT[i] = cv * sigmoidf_(cv); }
    SYNC();
    for (int e = gt; e < DEPTH * NADA * 4; e += NGT) {
        const int j = e % NADA, bq = (e / NADA) & 3, l = e / (NADA * 4);
        const float* w = PIN(F, I_WADA) + (size_t)l * DM * NADA + j;
        const float* c = CACT + bq * 4 * DM;
        float a0 = 0.f, a1 = 0.f, a2 = 0.f, a3 = 0.f;
#pragma unroll 8
        for (int k = 0; k < DM; k += 4) {
            const float w0 = w[(size_t)k * NADA], w1 = w[(size_t)(k + 1) * NADA], w2 = w[(size_t)(k + 2) * NADA], w3 = w[(size_t)(k + 3) * NADA];
            const f32x4 c0 = *(const f32x4*)(c + k), c1 = *(const f32x4*)(c + DM + k), c2 = *(const f32x4*)(c + 2 * DM + k), c3 = *(const f32x4*)(c + 3 * DM + k);
            a0 += (c0.x * w0 + c0.y * w1) + (c0.z * w2 + c0.w * w3); a1 += (c1.x * w0 + c1.y * w1) + (c1.z * w2 + c1.w * w3);
            a2 += (c2.x * w0 + c2.y * w1) + (c2.z * w2 + c2.w * w3); a3 += (c3.x * w0 + c3.y * w1) + (c3.z * w2 + c3.w * w3); }
        const float bb = PIN(F, I_BADA)[(size_t)l * NADA + j];
        float* mo = (float*)(F.ws + WS_MOD) + ((size_t)l * BATCH + bq * 4) * NADA + j;
        mo[0] = a0 + bb; mo[NADA] = a1 + bb; mo[2 * NADA] = a2 + bb; mo[3 * NADA] = a3 + bb;
    }
    for (int e = gt; e < DEPTH * 2 * 4 * 64 * 64; e += NGT) {
        const int i = e & 63, j = (e >> 6) & 63, blk = (e >> 12) & 3, g = (e >> 14) & 1, l = e >> 15;
        const float* src = PIN(F, g ? I_WX : I_WA) + (((size_t)l * 4 + blk) * 64 + i) * 64 + j;
        ((bf16*)(F.ws + WS_WG))[e] = (bf16)f2bf(*src);
    }
    for (int e = gt; e < DEPTH * 4 * 64 * 128; e += NGT) {
        const int r = e & 127, d = (e >> 7) & 63, h = (e >> 13) & 3, l = e >> 15;
        ((bf16*)(F.ws + WS_WUVT))[e] = (bf16)f2bf(PIN(F, I_WUV)[(((size_t)l * 128 + r) * 4 + h) * 64 + d]);
    }
    for (int e = gt; e < DEPTH * 768 * 256; e += NGT) {
        const int r = e & 255, n = (e >> 8) % 768, l = e / (768 * 256);
        float v;
        if (n < 512) { const int h = n >> 7, c = n & 127; const f32x4* q = (const f32x4*)(PIN(F, I_WQUP) + ((size_t)l * 256 + r) * 256 + h * 64); const f32x4* k = (const f32x4*)(PIN(F, I_WUK) + ((size_t)l * 128 + c) * 256 + h * 64);
            float s = 0.f;
#pragma unroll
            for (int d = 0; d < 16; ++d) { const f32x4 a = q[d], bq4 = k[d]; s += (a.x * bq4.x + a.y * bq4.y) + (a.z * bq4.z + a.w * bq4.w); }
            v = s * (0.125f * 1.4426950408889634f); }
        else v = PIN(F, I_WQIDX)[((size_t)l * 256 + r) * 256 + (n - 512)] * 0.17677669529663687f;
        ((bf16*)(F.ws + WS_WQC))[e] = (bf16)f2bf(v);
    }
    SYNC();
    float* scr = (float*)(F.lds + F.wave * 16384);
    const int gw = F.bid * 8 + F.wave, NGW = F.G * 8;
    constexpr int I_IN = (DM / 64) * (NPROJ / 32), I_O = (DM / 64) * (DM / 32), I_1 = (DM / 64) * (DFF / 32), I_2 = (DFF / 64) * (DM / 32);
    constexpr int PER_L = I_IN + I_O + I_1 + I_2;
    for (int it = gw; it < DEPTH * PER_L; it += NGW) {
        const int l = it / PER_L; int r = it % PER_L;
        if (r < I_IN) { p0_transpose_item<true>(PIN(F, I_WIN) + (size_t)l * DM * 2992, DM, 2992, NPROJ, (bf16*)(F.ws + WS_WIN) + (size_t)l * NPROJ * DM, scr, r, F.lane); continue; } r -= I_IN;
        if (r < I_O) { p0_transpose_item<false>(PIN(F, I_WO) + (size_t)l * DM * DM, DM, DM, DM, (bf16*)(F.ws + WS_WO) + (size_t)l * DM * DM, scr, r, F.lane); continue; } r -= I_O;
        if (r < I_1) { p0_transpose_item<false>(PIN(F, I_W1) + (size_t)l * DM * DFF, DM, DFF, DFF, (bf16*)(F.ws + WS_W1) + (size_t)l * DFF * DM, scr, r, F.lane); continue; } r -= I_1;
        p0_transpose_item<false>(PIN(F, I_W2) + (size_t)l * DFF * DM, DFF, DM, DM, (bf16*)(F.ws + WS_W2) + (size_t)l * DM * DFF, scr, r, F.lane);
    }
}

DEV void ph_xs0(const Ctx& F, const float* xsrc, const float* nw, const float* modl, int sc_off, bf16* XS, float* RSP, bf16* X16) {
    const int gw = F.bid * 8 + F.wave, NGW = F.G * 8;
    f32x4 wv[4];
#pragma unroll
    for (int j = 0; j < 4; ++j) wv[j] = *(const f32x4*)(nw + 4 * F.lane + 256 * j);
    f32x4 v[2][4], vn[2][4];
#pragma unroll
    for (int q = 0; q < 2; ++q) { const int m = gw + q * NGW; const f32x4* xr = (const f32x4*)(xsrc + (size_t)(m < MTOK ? m : 0) * DM) + F.lane;
#pragma unroll
        for (int j = 0; j < 4; ++j) v[q][j] = xr[64 * j]; }
    for (int m0 = gw; m0 < MTOK; m0 += 2 * NGW) {
        f32x4 sc[2][4];
#pragma unroll
        for (int q = 0; q < 2; ++q) { const int m = m0 + q * NGW; const float* mb = modl + (size_t)((m < MTOK ? m : 0) >> 12) * NADA + 4 * F.lane;
#pragma unroll
            for (int j = 0; j < 4; ++j) sc[q][j] = *(const f32x4*)(mb + sc_off + 256 * j); }
#pragma unroll
        for (int q = 0; q < 2; ++q) { const int m = m0 + (2 + q) * NGW; const f32x4* xr = (const f32x4*)(xsrc + (size_t)(m < MTOK ? m : 0) * DM) + F.lane;
#pragma unroll
            for (int j = 0; j < 4; ++j) vn[q][j] = xr[64 * j]; }
        float s[2];
#pragma unroll
        for (int q = 0; q < 2; ++q) { float a = 0.f;
#pragma unroll
            for (int j = 0; j < 4; ++j) a += (v[q][j].x * v[q][j].x + v[q][j].y * v[q][j].y) + (v[q][j].z * v[q][j].z + v[q][j].w * v[q][j].w);
            s[q] = a; }
#pragma unroll
        for (int o = 1; o < 64; o <<= 1) { s[0] += SHFL_XOR(s[0], o); s[1] += SHFL_XOR(s[1], o); }
#pragma unroll
        for (int q = 0; q < 2; ++q) { const int m = m0 + q * NGW; if (m >= MTOK) break;
            if (F.lane < 16) RSP[(size_t)m * 16 + F.lane] = F.lane == 0 ? s[q] : 0.f;
            u32x2* o8 = (u32x2*)(XS + (size_t)m * DM) + F.lane; u32x2* x8 = (u32x2*)(X16 + (size_t)m * DM) + F.lane;
#pragma unroll
            for (int j = 0; j < 4; ++j) { const f32x4 y = v[q][j] * (wv[j] * (1.0f + sc[q][j]));
                u32x2 p; p.x = pk2(y.x, y.y); p.y = pk2(y.z, y.w); o8[64 * j] = p;
                u32x2 c; c.x = pk2(v[q][j].x, v[q][j].y); c.y = pk2(v[q][j].z, v[q][j].w); x8[64 * j] = c; } }
#pragma unroll
        for (int q = 0; q < 2; ++q)
#pragma unroll
            for (int j = 0; j < 4; ++j) v[q][j] = vn[q][j];
    }
}
DEV void ph_shw(const Ctx& F) {
    const int gt = F.bid * 512 + F.tid, NGT = F.G * 512;
    for (int e = gt; e < DEPTH * 2 * BATCH * (DM / 4); e += NGT) {
        const int c4 = e & 255, b = (e >> 8) & 15, w = (e >> 12) & 1, l = e >> 13;
        const f32x4 nwv = *(const f32x4*)(PIN(F, w ? I_N2W : I_N1W) + l * DM + 4 * c4);
        const f32x4 sc = *(const f32x4*)((const float*)(F.ws + WS_MOD) + ((size_t)l * BATCH + b) * NADA + (w ? 4 * DM : DM) + 4 * c4);
        ((f32x4*)(F.ws + WS_WP))[e] = nwv * (1.0f + sc);
    }
    const int gw = F.bid * 8 + F.wave, NGW = F.G * 8, i16 = F.lane & 15, kq = 8 * (F.lane >> 4);
    for (int it = gw; it < DEPTH * (NSHW / 16); it += NGW) {
        const int l = it / (NSHW / 16), n0 = (it % (NSHW / 16)) * 16;
        const bool mlp = n0 >= NPROJ;
        const bf16* Wr = mlp ? (const bf16*)(F.ws + WS_W1) + ((size_t)l * DFF + (n0 - NPROJ) + i16) * DM : (const bf16*)(F.ws + WS_WIN) + ((size_t)l * NPROJ + n0 + i16) * DM;
        const float* sh = (const float*)(F.ws + WS_MOD) + ((size_t)l * BATCH + i16) * NADA + (mlp ? 3 * DM : 0);
        f32x4 acc0 = {0.f, 0.f, 0.f, 0.f}, acc1 = {0.f, 0.f, 0.f, 0.f};
#pragma unroll 4
        for (int s = 0; s < DM / 32; ++s) {
            const bf16x8 B = *(const bf16x8*)(Wr + 32 * s + kq);
            const f32x4 a0 = *(const f32x4*)(sh + 32 * s + kq), a1 = *(const f32x4*)(sh + 32 * s + kq + 4);
            bf16x8 Ah, Al;
#pragma unroll
            for (int j = 0; j < 8; ++j) { const float a = j < 4 ? a0[j] : a1[j - 4]; const unsigned h = f2bf(a); Ah[j] = (short)h; Al[j] = (short)f2bf(a - bf2f(h)); }
            acc0 = MFMA16(Ah, B, acc0); acc1 = MFMA16(Al, B, acc1);
        }
        float* o = (float*)(F.ws + WS_SHW) + ((size_t)l * BATCH + 4 * (F.lane >> 4)) * NSHW + n0 + i16;
#pragma unroll
        for (int r = 0; r < 4; ++r) o[(size_t)r * NSHW] = acc0[r] + acc1[r];
    }
}
DEV void ph_normmod(const Ctx& F, const float* xsrc, const float* nw, const float* modl, int sh_off, int sc_off, bf16* XN) {
    const int gw = F.bid * 8 + F.wave, NGW = F.G * 8;
    f32x4 wv[4];
#pragma unroll
    for (int j = 0; j < 4; ++j) wv[j] = *(const f32x4*)(nw + 4 * F.lane + 256 * j);
    f32x4 v[2][4], vn[2][4];
#pragma unroll
    for (int q = 0; q < 2; ++q) { const int m = gw + q * NGW; const f32x4* xr = (const f32x4*)(xsrc + (size_t)(m < MTOK ? m : 0) * DM) + F.lane;
#pragma unroll
        for (int j = 0; j < 4; ++j) v[q][j] = xr[64 * j]; }
    for (int m0 = gw; m0 < MTOK; m0 += 2 * NGW) {
        f32x4 sc[2][4], sh[2][4];
#pragma unroll
        for (int q = 0; q < 2; ++q) { const int m = m0 + q * NGW; const float* mb = modl + (size_t)((m < MTOK ? m : 0) >> 12) * NADA + 4 * F.lane;
#pragma unroll
            for (int j = 0; j < 4; ++j) { sc[q][j] = *(const f32x4*)(mb + sc_off + 256 * j); sh[q][j] = *(const f32x4*)(mb + sh_off + 256 * j); } }
#pragma unroll
        for (int q = 0; q < 2; ++q) { const int m = m0 + (2 + q) * NGW; const f32x4* xr = (const f32x4*)(xsrc + (size_t)(m < MTOK ? m : 0) * DM) + F.lane;
#pragma unroll
            for (int j = 0; j < 4; ++j) vn[q][j] = xr[64 * j]; }
        float s[2];
#pragma unroll
        for (int q = 0; q < 2; ++q) { float a = 0.f;
#pragma unroll
            for (int j = 0; j < 4; ++j) a += (v[q][j].x * v[q][j].x + v[q][j].y * v[q][j].y) + (v[q][j].z * v[q][j].z + v[q][j].w * v[q][j].w);
            s[q] = a; }
#pragma unroll
        for (int o = 1; o < 64; o <<= 1) { s[0] += SHFL_XOR(s[0], o); s[1] += SHFL_XOR(s[1], o); }
#pragma unroll
        for (int q = 0; q < 2; ++q) { const int m = m0 + q * NGW; if (m >= MTOK) break;
            const float rs = RSQ(s[q] * (1.0f / DM) + NORM_EPS);
            u32x2* o8 = (u32x2*)(XN + (size_t)m * DM) + F.lane;
#pragma unroll
            for (int j = 0; j < 4; ++j) { const f32x4 y = v[q][j] * rs * wv[j] * (1.0f + sc[q][j]) + sh[q][j];
                u32x2 p; p.x = pk2(y.x, y.y); p.y = pk2(y.z, y.w); o8[64 * j] = p; } }
#pragma unroll
        for (int q = 0; q < 2; ++q)
#pragma unroll
            for (int j = 0; j < 4; ++j) v[q][j] = vn[q][j];
    }
}
DEV void ph_finalnorm(const Ctx& F, const float* xsrc, const float* nw, float* out) {
    const int gw = F.bid * 8 + F.wave, NGW = F.G * 8;
    f32x4 wv[4];
#pragma unroll
    for (int j = 0; j < 4; ++j) wv[j] = *(const f32x4*)(nw + 4 * F.lane + 256 * j);
    f32x4 v[2][4], vn[2][4];
#pragma unroll
    for (int q = 0; q < 2; ++q) { const int m = gw + q * NGW; const f32x4* xr = (const f32x4*)(xsrc + (size_t)(m < MTOK ? m : 0) * DM) + F.lane;
#pragma unroll
        for (int j = 0; j < 4; ++j) v[q][j] = xr[64 * j]; }
    for (int m0 = gw; m0 < MTOK; m0 += 2 * NGW) {
#pragma unroll
        for (int q = 0; q < 2; ++q) { const int m = m0 + (2 + q) * NGW; const f32x4* xr = (const f32x4*)(xsrc + (size_t)(m < MTOK ? m : 0) * DM) + F.lane;
#pragma unroll
            for (int j = 0; j < 4; ++j) vn[q][j] = xr[64 * j]; }
        float s[2];
#pragma unroll
        for (int q = 0; q < 2; ++q) { float a = 0.f;
#pragma unroll
            for (int j = 0; j < 4; ++j) a += (v[q][j].x * v[q][j].x + v[q][j].y * v[q][j].y) + (v[q][j].z * v[q][j].z + v[q][j].w * v[q][j].w);
            s[q] = a; }
#pragma unroll
        for (int o = 1; o < 64; o <<= 1) { s[0] += SHFL_XOR(s[0], o); s[1] += SHFL_XOR(s[1], o); }
#pragma unroll
        for (int q = 0; q < 2; ++q) { const int m = m0 + q * NGW; if (m >= MTOK) break;
            const float rs = RSQ(s[q] * (1.0f / DM) + NORM_EPS);
            f32x4* o = (f32x4*)(out + (size_t)m * DM) + F.lane;
#pragma unroll
            for (int j = 0; j < 4; ++j) o[64 * j] = v[q][j] * rs * wv[j]; }
#pragma unroll
        for (int q = 0; q < 2; ++q)
#pragma unroll
            for (int j = 0; j < 4; ++j) v[q][j] = vn[q][j];
    }
}
DEV void ph_finalnorm16(const Ctx& F, const bf16* x16, const float* nw, float* out) {
    const int gw = F.bid * 8 + F.wave, NGW = F.G * 8;
    f32x4 wv[2][2];
#pragma unroll
    for (int j = 0; j < 2; ++j) { wv[j][0] = *(const f32x4*)(nw + 8 * F.lane + 512 * j); wv[j][1] = *(const f32x4*)(nw + 8 * F.lane + 512 * j + 4); }
    u32x4 v[4][2], vn[4][2];
#pragma unroll
    for (int q = 0; q < 4; ++q) { const int m = gw + q * NGW; const bf16* xr = x16 + (size_t)(m < MTOK ? m : 0) * DM + 8 * F.lane;
        v[q][0] = *(const u32x4*)xr; v[q][1] = *(const u32x4*)(xr + 512); }
    for (int m0 = gw; m0 < MTOK; m0 += 4 * NGW) {
#pragma unroll
        for (int q = 0; q < 4; ++q) { const int m = m0 + (4 + q) * NGW; const bf16* xr = x16 + (size_t)(m < MTOK ? m : 0) * DM + 8 * F.lane;
            vn[q][0] = *(const u32x4*)xr; vn[q][1] = *(const u32x4*)(xr + 512); }
        float s[4];
#pragma unroll
        for (int q = 0; q < 4; ++q) { float a = 0.f;
#pragma unroll
            for (int j = 0; j < 2; ++j) { const u32x4 r = v[q][j];
                a += ((bflo(r.x) * bflo(r.x) + bfhi(r.x) * bfhi(r.x)) + (bflo(r.y) * bflo(r.y) + bfhi(r.y) * bfhi(r.y))) + ((bflo(r.z) * bflo(r.z) + bfhi(r.z) * bfhi(r.z)) + (bflo(r.w) * bflo(r.w) + bfhi(r.w) * bfhi(r.w))); }
            s[q] = a; }
#pragma unroll
        for (int o = 1; o < 64; o <<= 1) {
#pragma unroll
            for (int q = 0; q < 4; ++q) s[q] += SHFL_XOR(s[q], o); }
#pragma unroll
        for (int q = 0; q < 4; ++q) { const int m = m0 + q * NGW; if (m >= MTOK) break;
            const float rs = RSQ(s[q] * (1.0f / DM) + NORM_EPS);
            float* o = out + (size_t)m * DM + 8 * F.lane;
#pragma unroll
            for (int j = 0; j < 2; ++j) { const u32x4 r = v[q][j];
                *(f32x4*)(o + 512 * j) = (f32x4){bflo(r.x), bfhi(r.x), bflo(r.y), bfhi(r.y)} * rs * wv[j][0];
                *(f32x4*)(o + 512 * j + 4) = (f32x4){bflo(r.z), bfhi(r.z), bflo(r.w), bfhi(r.w)} * rs * wv[j][1]; } }
#pragma unroll
        for (int q = 0; q < 4; ++q) { v[q][0] = vn[q][0]; v[q][1] = vn[q][1]; }
    }
}
DEV void ph_zero_cat(const Ctx& F, int c0, int nq) {
    const int gw = F.bid * 8 + F.wave, NGW = F.G * 8;
    bf16* CAT = (bf16*)(F.ws + WS_CAT);
    for (int m = gw; m < MTOK; m += NGW) for (int q = 0; q < nq; ++q) *(u32x2*)(CAT + (size_t)m * DM + c0 + 256 * q + 4 * F.lane) = (u32x2){0u, 0u};
}
DEV float softcap15(float z) { return 15.0f * tanhf(z * (1.0f / 15.0f)); }
DEV float logsigmoidf_(float x) { return x >= 0.f ? -log1pf(expf(-x)) : x - log1pf(expf(x)); }
DEV void ph_prep(const Ctx& F, int l) {
    const int gw = F.bid * 8 + F.wave, NGW = F.G * 8, lane = F.lane;
    const bf16* PROJ = (const bf16*)(F.ws + WS_PROJ);
    bf16* QL = (bf16*)(F.ws + WS_QL); bf16* CKV = (bf16*)(F.ws + WS_CKV); bf16* KIDX = (bf16*)(F.ws + WS_KIDX);
    float* WI = (float*)(F.ws + WS_WI);
    const f32x4 qn = *(const f32x4*)(PIN(F, I_QNW) + l * 256 + 4 * lane);
    const float kn0 = PIN(F, I_KVNW)[l * 128 + 2 * lane], kn1 = PIN(F, I_KVNW)[l * 128 + 2 * lane + 1];
    u32x2 ra4[4], ran[4]; unsigned rk4[4], rx4[4], rkn[4], rxn[4];
#define PREP_LOAD(RA, RK, RX, M0) do { _Pragma("unroll") for (int q = 0; q < 4; ++q) { const int mm = (M0) + q * NGW; const bf16* pr = PROJ + (size_t)(mm < MTOK ? mm : 0) * NPROJ; \
            RA[q] = *(const u32x2*)(pr + PC_AQ + 4 * lane); RK[q] = *(const unsigned*)(pr + PC_AKV + 2 * lane); \
            RX[q] = lane < 16 ? *(const unsigned*)(pr + PC_IK + 2 * lane) : (lane < 24 ? (unsigned)pr[PC_IW + (lane - 16)] : 0u); } } while (0)
    PREP_LOAD(ra4, rk4, rx4, gw);
    for (int m0 = gw; m0 < MTOK; m0 += 4 * NGW) {
        PREP_LOAD(ran, rkn, rxn, m0 + 4 * NGW);
#pragma unroll
        for (int q = 0; q < 4; ++q) { const int m = m0 + q * NGW; if (m >= MTOK) break;
            const u32x2 ra = ra4[q]; const unsigned rk = rk4[q];
            const float a0 = bflo(ra.x), a1 = bfhi(ra.x), a2 = bflo(ra.y), a3 = bfhi(ra.y);
            const float k0 = bflo(rk), k1 = bfhi(rk);
            const float sq = wave_sum((a0 * a0 + a1 * a1) + (a2 * a2 + a3 * a3)), sk = wave_sum(k0 * k0 + k1 * k1);
            const float rq = RSQ(sq * (1.0f / 256.0f) + NORM_EPS), rk2 = RSQ(sk * (1.0f / 128.0f) + NORM_EPS);
            u32x2 oq; oq.x = pk2(a0 * rq * qn.x, a1 * rq * qn.y); oq.y = pk2(a2 * rq * qn.z, a3 * rq * qn.w);
            *(u32x2*)(QL + (size_t)m * 256 + 4 * lane) = oq;
            *(unsigned*)(CKV + (size_t)m * 128 + 2 * lane) = pk2(k0 * rk2 * kn0, k1 * rk2 * kn1);
            if (lane < 16) *(unsigned*)(KIDX + (size_t)m * 32 + 2 * lane) = rx4[q];
            else if (lane < 24) WI[(size_t)m * 8 + (lane - 16)] = bf2f(rx4[q]); }
#pragma unroll
        for (int q = 0; q < 4; ++q) { ra4[q] = ran[q]; rk4[q] = rkn[q]; rx4[q] = rxn[q]; }
    }
#undef PREP_LOAD
}

constexpr int XB_STRIDE = 264;
DEV void ph_lru1(const Ctx& F, int l) {
    const int tid = F.tid, lane = F.lane, w = F.wave, i16 = lane & 15, g = lane >> 4;
    bf16* XB = (bf16*)F.lds;
    float* XF = (float*)(F.lds + 64 * XB_STRIDE * 2);
    const bf16* PROJ = (const bf16*)(F.ws + WS_PROJ);
    bf16* HLOC = (bf16*)(F.ws + WS_HLOC); bf16* CPA = (bf16*)(F.ws + WS_CPA); float* LSUM = (float*)(F.ws + WS_LSUM);
    const int blk = w & 3, nh = w >> 2;
    const bf16* WG = (const bf16*)(F.ws + WS_WG) + (size_t)l * 2 * 4 * 4096;
    bf16x8 Bf[2][2][2];
#pragma unroll
    for (int gg = 0; gg < 2; ++gg)
#pragma unroll
        for (int nt = 0; nt < 2; ++nt)
#pragma unroll
            for (int ks = 0; ks < 2; ++ks) Bf[gg][nt][ks] = *(const bf16x8*)(WG + ((size_t)(gg * 4 + blk) * 64 + nh * 32 + 2 * i16 + nt) * 64 + ks * 32 + 8 * g);
    float ba[2], bx[2], sp[2];
#pragma unroll
    for (int nt = 0; nt < 2; ++nt) { const int ch = blk * 64 + nh * 32 + 2 * i16 + nt;
        ba[nt] = PIN(F, I_BA)[l * 256 + ch]; bx[nt] = PIN(F, I_BX)[l * 256 + ch];
        const float lam = PIN(F, I_LAM)[l * 256 + ch]; sp[nt] = lam > 0.f ? log1pf(expf(-lam)) : -lam + log1pf(expf(lam)); }
    const int ch2 = tid & 127, tg = tid >> 7;
    float cw[4][2], cb[2];
#pragma unroll
    for (int j = 0; j < 4; ++j) { cw[j][0] = PIN(F, I_CONVW)[(l * 4 + j) * 256 + 2 * ch2]; cw[j][1] = PIN(F, I_CONVW)[(l * 4 + j) * 256 + 2 * ch2 + 1]; }
    cb[0] = PIN(F, I_CONVB)[l * 256 + 2 * ch2]; cb[1] = PIN(F, I_CONVB)[l * 256 + 2 * ch2 + 1];

    for (int u = F.bid; u < BATCH * 64; u += F.G) {
        const int b = u >> 6, c = u & 63, t0 = c * 64; const size_t m0 = (size_t)b * SEQ + t0;
        {
            const int tl0 = tg * 16;
            unsigned rv[19];
#pragma unroll
            for (int j = 0; j < 3; ++j) { const int t = t0 + tl0 - 3 + j; rv[j] = t >= 0 ? *(const unsigned*)(PROJ + ((size_t)b * SEQ + t) * NPROJ + PC_LX + 2 * ch2) : 0u; }
#pragma unroll
            for (int tt = 0; tt < 16; ++tt) rv[3 + tt] = *(const unsigned*)(PROJ + (m0 + tl0 + tt) * NPROJ + PC_LX + 2 * ch2);
#pragma unroll
            for (int tt = 0; tt < 16; ++tt) { const int tl = tl0 + tt;
                const float x0 = cw[0][0] * bflo(rv[tt]) + cw[1][0] * bflo(rv[tt + 1]) + cw[2][0] * bflo(rv[tt + 2]) + cw[3][0] * bflo(rv[tt + 3]) + cb[0];
                const float x1 = cw[0][1] * bfhi(rv[tt]) + cw[1][1] * bfhi(rv[tt + 1]) + cw[2][1] * bfhi(rv[tt + 2]) + cw[3][1] * bfhi(rv[tt + 3]) + cb[1];
                *(unsigned*)(XB + tl * XB_STRIDE + 2 * ch2) = pk2(x0, x1);
                XF[tl * 256 + 2 * ch2] = x0; XF[tl * 256 + 2 * ch2 + 1] = x1; }
        }
        SYNC();
        float CA[2] = {1.f, 1.f}, CU[2] = {0.f, 0.f};
#pragma unroll 1
        for (int m = 0; m < 4; ++m) {
            f32x4 acc[2][2];
#pragma unroll
            for (int gg = 0; gg < 2; ++gg)
#pragma unroll
                for (int nt = 0; nt < 2; ++nt) acc[gg][nt] = (f32x4){0.f, 0.f, 0.f, 0.f};
#pragma unroll
            for (int ks = 0; ks < 2; ++ks) { const bf16x8 A = *(const bf16x8*)(XB + (m * 16 + i16) * XB_STRIDE + blk * 64 + ks * 32 + 8 * g);
#pragma unroll
                for (int gg = 0; gg < 2; ++gg)
#pragma unroll
                    for (int nt = 0; nt < 2; ++nt) acc[gg][nt] = MFMA16(A, Bf[gg][nt][ks], acc[gg][nt]); }
            float HL[2][4], CP[2][4];
            const int chb = blk * 64 + nh * 32 + 2 * i16;
            float xf[4][2];
#pragma unroll
            for (int r = 0; r < 4; ++r) { const float* xp = XF + (m * 16 + 4 * g + r) * 256 + chb; xf[r][0] = xp[0]; xf[r][1] = xp[1]; }
#pragma unroll
            for (int nt = 0; nt < 2; ++nt) {
                float P[4], H[4]; float pa = 1.f, hu = 0.f;
#pragma unroll
                for (int r = 0; r < 4; ++r) {
                    const float rg = fsigmoid(acc[0][nt][r] + ba[nt]), gi = fsigmoid(acc[1][nt][r] + bx[nt]);
                    const float la = -8.0f * rg * sp[nt], a = FEXP(la), uu = FSQRT((1.0f - a) * (1.0f + a)) * (gi * xf[r][nt]);
                    pa = a * pa; hu = a * hu + uu; P[r] = pa; H[r] = hu;
                    }
                float EA = 1.f, EU = 0.f, TA = 1.f, TU = 0.f;
#pragma unroll
                for (int gg = 0; gg < 4; ++gg) { const float ta = SHFL(pa, i16 + 16 * gg), tu = SHFL(hu, i16 + 16 * gg);
                    if (gg < g) { EU = ta * EU + tu; EA = ta * EA; }
                    TU = ta * TU + tu; TA = ta * TA; }
                const float XA = EA * CA[nt], XU = EA * CU[nt] + EU;
#pragma unroll
                for (int r = 0; r < 4; ++r) { HL[nt][r] = P[r] * XU + H[r]; CP[nt][r] = P[r] * XA; }
                CU[nt] = TA * CU[nt] + TU; CA[nt] = TA * CA[nt];
            }
#pragma unroll
            for (int r = 0; r < 4; ++r) { const size_t o = (m0 + m * 16 + 4 * g + r) * 256 + chb;
                *(unsigned*)(HLOC + o) = pk2(HL[0][r], HL[1][r]); *(unsigned*)(CPA + o) = pk2(CP[0][r], CP[1][r]); }
        }
        if (g == 0) {
#pragma unroll
            for (int nt = 0; nt < 2; ++nt) { const int ch = blk * 64 + nh * 32 + 2 * i16 + nt;
                LSUM[((size_t)b * 64 + c) * 256 + ch] = CA[nt]; LSUM[(size_t)BATCH * 64 * 256 + ((size_t)b * 64 + c) * 256 + ch] = CU[nt]; }
        }
        SYNC();
    }
}

DEV float gelu_tanh(float x) { const float z = 0.7978845608028654f * (x + 0.044715f * x * x * x); return x * FRCP(1.0f + FEXP(-2.0f * z)); }
DEV void ph_carry(const Ctx& F) {
    if (F.wave != 0) return;
    const float* LSUM = (const float*)(F.ws + WS_LSUM); float* CARRY = (float*)(F.ws + WS_CARRY);
    const int seg = F.lane & 3;
    for (int chain = F.bid * 16 + (F.lane >> 2); chain < BATCH * 256; chain += F.G * 16) {
        const int b = chain >> 8, ch = chain & 255; const size_t o0 = ((size_t)b * 64 + seg * 16) * 256 + ch;
        float a[16], hb[16];
#pragma unroll
        for (int i = 0; i < 16; ++i) { a[i] = LSUM[o0 + (size_t)i * 256]; hb[i] = LSUM[(size_t)BATCH * 64 * 256 + o0 + (size_t)i * 256]; }
        float hp[16], ap[16], hl = 0.f, al = 1.f;
#pragma unroll
        for (int i = 0; i < 16; ++i) { hp[i] = hl; ap[i] = al; hl = a[i] * hl + hb[i]; al = a[i] * al; }
        float cin = 0.f;
#pragma unroll
        for (int s2 = 0; s2 < 3; ++s2) { const float as = SHFL(al, (F.lane & ~3) + s2), hs = SHFL(hl, (F.lane & ~3) + s2); if (s2 < seg) cin = as * cin + hs; }
#pragma unroll
        for (int i = 0; i < 16; ++i) CARRY[o0 + (size_t)i * 256] = ap[i] * cin + hp[i];
    }
}
DEV void ph_lru2(const Ctx& F, int l) {
    const int tid = F.tid, lane = F.lane, w = F.wave;
    const bf16* PROJ = (const bf16*)(F.ws + WS_PROJ); const bf16* HLOC = (const bf16*)(F.ws + WS_HLOC); const bf16* CPA = (const bf16*)(F.ws + WS_CPA);
    const float* CARRY = (const float*)(F.ws + WS_CARRY); bf16* CAT = (bf16*)(F.ws + WS_CAT);
    const f32x4 gw4 = *(const f32x4*)(PIN(F, I_GNW) + l * DM + 4 * lane);
    for (int u = F.bid; u < BATCH * 64; u += F.G) {
        const int b = u >> 6, c = u & 63; const size_t m0 = (size_t)b * SEQ + c * 64;
        const f32x4 car = *(const f32x4*)(CARRY + (size_t)u * 256 + 4 * lane);
        u32x2 hl8[8], cp8[8], ly8[8];
#pragma unroll
        for (int tt = 0; tt < 8; ++tt) { const size_t m = m0 + w * 8 + tt;
            hl8[tt] = *(const u32x2*)(HLOC + m * 256 + 4 * lane); cp8[tt] = *(const u32x2*)(CPA + m * 256 + 4 * lane); ly8[tt] = *(const u32x2*)(PROJ + m * NPROJ + PC_LY + 4 * lane); }
#pragma unroll
        for (int tt = 0; tt < 8; ++tt) { const size_t m = m0 + w * 8 + tt; const u32x2 hl = hl8[tt], cp = cp8[tt], ly = ly8[tt];
            float v0 = (bflo(hl.x) + bflo(cp.x) * car.x) * gelu_tanh(bflo(ly.x));
            float v1 = (bfhi(hl.x) + bfhi(cp.x) * car.y) * gelu_tanh(bfhi(ly.x));
            float v2 = (bflo(hl.y) + bflo(cp.y) * car.z) * gelu_tanh(bflo(ly.y));
            float v3 = (bfhi(hl.y) + bfhi(cp.y) * car.w) * gelu_tanh(bfhi(ly.y));
            const float rs = RSQ(wave_sum((v0 * v0 + v1 * v1) + (v2 * v2 + v3 * v3)) * (1.0f / 256.0f) + NORM_EPS);
            u32x2 o; o.x = pk2(v0 * rs * gw4.x, v1 * rs * gw4.y); o.y = pk2(v2 * rs * gw4.z, v3 * rs * gw4.w);
            *(u32x2*)(CAT + m * DM + 4 * lane) = o; }
    }
}

constexpr int QS_STRIDE = 136, VE_STRIDE = 56;
DEV void ph_mlstm(const Ctx& F, int l) {
    const int tid = F.tid, lane = F.lane, w = F.wave, i16 = lane & 15, g = lane >> 4;
    bf16* QsB = (bf16*)F.lds;
    bf16* KsB = QsB + 2 * 64 * QS_STRIDE;
    bf16* VE = KsB + 2 * 64 * QS_STRIDE;
    bf16* VW = VE + 64 * VE_STRIDE;
    bf16* CsB = VW + 64 * VE_STRIDE;
    float* BCB = (float*)(CsB + 2 * 128 * VE_STRIDE);
    float* BIB = BCB + 128;
    const bf16* PROJ = (const bf16*)(F.ws + WS_PROJ); bf16* HM = (bf16*)(F.ws + WS_HM);
    const float qscale = 0.08838834764831845f;
    const int half = w >> 2, jt = half ? 3 - (w & 3) : (w & 3);
    for (int u0 = F.bid; u0 < BATCH * 4 * 4; u0 += F.G) {
        const int u = 4 * ((u0 & 7) * 8 + ((u0 >> 3) >> 2)) + ((u0 >> 3) & 3);
        const int b = u >> 4, h = (u >> 2) & 3, vs = u & 3;
        const float gbi = PIN(F, I_BI)[l * 4 + h], gbf = PIN(F, I_BF)[l * 4 + h];
        f32x4 accC[3];
#pragma unroll
        for (int nt = 0; nt < 3; ++nt) accC[nt] = (f32x4){0.f, 0.f, 0.f, 0.f};
        float* BCg = (float*)(F.ws + WS_MG) + (size_t)u * 8192; float* BIg = BCg + 4096;
        unsigned gri[8], grf[8];
#pragma unroll
        for (int k = 0; k < 8; ++k) { const bf16* pr = PROJ + ((size_t)b * SEQ + (8 * k + w) * 64 + lane) * NPROJ; gri[k] = pr[PC_MI + h]; grf[k] = pr[PC_MF + h]; }
#pragma unroll
        for (int k = 0; k < 8; ++k) { const int tok = (8 * k + w) * 64 + lane;
            const float zi = (bf2f(gri[k]) + gbi) * (1.0f / 15.0f), zf = (bf2f(grf[k]) + gbf) * (1.0f / 15.0f);
            const float ig = 15.0f - 30.0f * FRCP(FEXP(2.0f * zi) + 1.0f), fg = 15.0f - 30.0f * FRCP(FEXP(2.0f * zf) + 1.0f);
            float s = -FLOG(1.0f + FEXP(-fg));
#pragma unroll
            for (int o = 1; o < 64; o <<= 1) { const float t = SHFL_UP(s, o); if (lane >= o) s += t; }
            BCg[tok] = s; BIg[tok] = s - ig; }
        SYNC();
        u32x4 rq[2], rk[2]; u32x2 rvv; float rgc = 0.f, rgb = 0.f;
        {
            const size_t m0 = (size_t)b * SEQ;
#pragma unroll
            for (int i = 0; i < 2; ++i) { const int idx = tid + 512 * i, row = idx >> 4, ck = idx & 15;
                rq[i] = *(const u32x4*)(PROJ + (m0 + row) * NPROJ + PC_MQ + h * 128 + 8 * ck); rk[i] = *(const u32x4*)(PROJ + (m0 + row) * NPROJ + PC_MK + h * 128 + 8 * ck); }
            rvv = *(const u32x2*)(PROJ + (m0 + (tid >> 3)) * NPROJ + PC_MV + h * 128 + vs * 32 + 4 * (tid & 7));
            if (tid < 64) { rgc = BCg[tid]; rgb = BIg[tid]; }
        }
        for (int c = 0; c < 64; ++c) {
            const size_t m0 = (size_t)b * SEQ + c * 64; const int buf = c & 1;
            bf16* Qs = QsB + buf * 64 * QS_STRIDE; bf16* Ks = KsB + buf * 64 * QS_STRIDE; const bf16* Cs = CsB + buf * 128 * VE_STRIDE; bf16* Cn = CsB + (buf ^ 1) * 128 * VE_STRIDE;
            float* BC = BCB + buf * 64; float* BI = BIB + buf * 64;
#pragma unroll
            for (int i = 0; i < 2; ++i) { const int idx = tid + 512 * i, row = idx >> 4, ck = idx & 15;
                *(u32x4*)(Qs + row * QS_STRIDE + 8 * ck) = rq[i]; *(u32x4*)(Ks + row * QS_STRIDE + 8 * ck) = rk[i]; }
            if (tid < 64) { BC[tid] = rgc; BI[tid] = rgb; }
            SYNC();
            {
                const int row = tid >> 3, cg = tid & 7;
                const u32x2 rv = rvv;
                const float wt = FEXP(BC[63] - BI[row]);
                *(u32x2*)(VE + row * VE_STRIDE + 4 * cg) = rv;
                u32x2 sv; sv.x = pk2(bflo(rv.x) * wt, bfhi(rv.x) * wt); sv.y = pk2(bflo(rv.y) * wt, bfhi(rv.y) * wt);
                *(u32x2*)(VW + row * VE_STRIDE + 4 * cg) = sv;
                if (cg == 0) { unsigned one_ = 0x3f80u; LAUNDER_V(one_); u32x4 z = (u32x4){one_, 0u, 0u, 0u}; *(u32x4*)(VE + row * VE_STRIDE + 32) = z; *(u32x4*)(VE + row * VE_STRIDE + 40) = (u32x4){0u, 0u, 0u, 0u};
                    z.x = f2bf(wt); *(u32x4*)(VW + row * VE_STRIDE + 32) = z; *(u32x4*)(VW + row * VE_STRIDE + 40) = (u32x4){0u, 0u, 0u, 0u}; }
            }
            if (c + 1 < 64) {
                const size_t m1 = m0 + 64;
#pragma unroll
                for (int i = 0; i < 2; ++i) { const int idx = tid + 512 * i, row = idx >> 4, ck = idx & 15;
                    rq[i] = *(const u32x4*)(PROJ + (m1 + row) * NPROJ + PC_MQ + h * 128 + 8 * ck); rk[i] = *(const u32x4*)(PROJ + (m1 + row) * NPROJ + PC_MK + h * 128 + 8 * ck); }
                rvv = *(const u32x2*)(PROJ + (m1 + (tid >> 3)) * NPROJ + PC_MV + h * 128 + vs * 32 + 4 * (tid & 7));
                if (tid < 64) { rgc = BCg[(c + 1) * 64 + tid]; rgb = BIg[(c + 1) * 64 + tid]; }
            }
            SYNC();
            f32x4 Z[2] = {(f32x4){0.f, 0.f, 0.f, 0.f}, (f32x4){0.f, 0.f, 0.f, 0.f}};
            {
                bf16x8 Bq[4];
#pragma unroll
                for (int ks = 0; ks < 4; ++ks) Bq[ks] = *(const bf16x8*)(Qs + (16 * jt + i16) * QS_STRIDE + 32 * ks + 8 * g);
                const float bj = BC[16 * jt + i16];
                unsigned pk[4][2];
#pragma unroll
                for (int tt = 0; tt < 4; ++tt) {
                    if (tt <= jt) {
                        f32x4 X = (f32x4){0.f, 0.f, 0.f, 0.f};
                        bf16x8 Ak[4];
#pragma unroll
                        for (int ks = 0; ks < 4; ++ks) Ak[ks] = *(const bf16x8*)(Ks + (16 * tt + i16) * QS_STRIDE + 32 * ks + 8 * g);
                        KEEP4(Ak[0], Ak[1], Ak[2], Ak[3]);
#pragma unroll
                        for (int ks = 0; ks < 4; ++ks) X = MFMA16(Ak[ks], Bq[ks], X);
                        float p[4]; const f32x4 bi4 = *(const f32x4*)(BI + 16 * tt + 4 * g);
#pragma unroll
                        for (int r = 0; r < 4; ++r) { const float pv = X[r] * qscale * FEXP(fminf(bj - bi4[r], 60.0f));
                            p[r] = (tt < jt || 4 * g + r <= i16) ? pv : 0.f; }
                        pk[tt][0] = pk2(p[0], p[1]); pk[tt][1] = pk2(p[2], p[3]);
                    } else { pk[tt][0] = 0u; pk[tt][1] = 0u; }
                }
#pragma unroll
                for (int pr = 0; pr < 2; ++pr) {
                    if (2 * pr <= jt) {
                        u32x4 aw = (u32x4){pk[2 * pr][0], pk[2 * pr][1], pk[2 * pr + 1][0], pk[2 * pr + 1][1]};
                        const bf16x8 A = __builtin_bit_cast(bf16x8, aw);
#pragma unroll
                        for (int n = 0; n < 2; ++n) { const int ntc = n ? 2 : half;
                            const s16x4 lo = TR16(VE + (32 * pr + 4 * g + (i16 >> 2)) * VE_STRIDE + 16 * ntc + 4 * (i16 & 3));
                            const s16x4 hi = TR16(VE + (32 * pr + 16 + 4 * g + (i16 >> 2)) * VE_STRIDE + 16 * ntc + 4 * (i16 & 3));
                            const bf16x8 B = (bf16x8){lo[0], lo[1], lo[2], lo[3], hi[0], hi[1], hi[2], hi[3]};
                            Z[n] = MFMA16(A, B, Z[n]); }
#ifndef HOST_EMU
                        asm volatile("" :: "v"(aw));
#endif
                    }
                }
            }
            if (c > 0) {
                f32x4 Z2[2] = {(f32x4){0.f, 0.f, 0.f, 0.f}, (f32x4){0.f, 0.f, 0.f, 0.f}};
#pragma unroll
                for (int kh = 0; kh < 2; ++kh) {
                    bf16x8 Aq[2], Bc[2][2];
#pragma unroll
                    for (int k2 = 0; k2 < 2; ++k2) { const int ks = 2 * kh + k2; Aq[k2] = *(const bf16x8*)(Qs + (16 * jt + i16) * QS_STRIDE + 32 * ks + 8 * g);
#pragma unroll
                        for (int n = 0; n < 2; ++n) { const int ntc = n ? 2 : half;
                            const s16x4 lo = TR16(Cs + (32 * ks + 8 * g + (i16 >> 2)) * VE_STRIDE + 16 * ntc + 4 * (i16 & 3));
                            const s16x4 hi = TR16(Cs + (32 * ks + 8 * g + 4 + (i16 >> 2)) * VE_STRIDE + 16 * ntc + 4 * (i16 & 3));
                            Bc[k2][n] = (bf16x8){lo[0], lo[1], lo[2], lo[3], hi[0], hi[1], hi[2], hi[3]}; } }
                    KEEP4(Bc[0][0], Bc[0][1], Bc[1][0], Bc[1][1]);
#pragma unroll
                    for (int k2 = 0; k2 < 2; ++k2)
#pragma unroll
                        for (int n = 0; n < 2; ++n) Z2[n] = MFMA16(Aq[k2], Bc[k2][n], Z2[n]); }
                const f32x4 bc4 = *(const f32x4*)(BC + 16 * jt + 4 * g);
#pragma unroll
                for (int r = 0; r < 4; ++r) { const float f = qscale * FEXP(bc4[r]); Z[0][r] += f * Z2[0][r]; Z[1][r] += f * Z2[1][r]; }
            }
#pragma unroll
            for (int r = 0; r < 4; ++r) { const int j = 16 * jt + 4 * g + r; const float dn = FRCP(fmaxf(fabsf(SHFL(Z[1][r], lane & 48)), 1.0f));
                HM[(m0 + j) * 512 + h * 128 + vs * 32 + 16 * half + i16] = (bf16)f2bf(Z[0][r] * dn); }
            {
                const float dec = FEXP(BC[63]);
#pragma unroll
                for (int nt = 0; nt < 3; ++nt) accC[nt] = accC[nt] * dec;
#pragma unroll
                for (int ks = 0; ks < 2; ++ks) {
                    const s16x4 alo = TR16(Ks + (32 * ks + 8 * g + (i16 >> 2)) * QS_STRIDE + 16 * w + 4 * (i16 & 3));
                    const s16x4 ahi = TR16(Ks + (32 * ks + 8 * g + 4 + (i16 >> 2)) * QS_STRIDE + 16 * w + 4 * (i16 & 3));
                    const bf16x8 A = (bf16x8){alo[0], alo[1], alo[2], alo[3], ahi[0], ahi[1], ahi[2], ahi[3]};
                    bf16x8 Bv[3];
#pragma unroll
                    for (int nt = 0; nt < 3; ++nt) {
                        const s16x4 lo = TR16(VW + (32 * ks + 8 * g + (i16 >> 2)) * VE_STRIDE + 16 * nt + 4 * (i16 & 3));
                        const s16x4 hi = TR16(VW + (32 * ks + 8 * g + 4 + (i16 >> 2)) * VE_STRIDE + 16 * nt + 4 * (i16 & 3));
                        Bv[nt] = (bf16x8){lo[0], lo[1], lo[2], lo[3], hi[0], hi[1], hi[2], hi[3]}; }
                    KEEP4(A, Bv[0], Bv[1], Bv[2]);
#pragma unroll
                    for (int nt = 0; nt < 3; ++nt) { const bf16x8 B = Bv[nt];
                        const f32x4 cold = accC[nt]; accC[nt] = MFMA16(A, B, cold);
#ifndef HOST_EMU
                        asm volatile("" :: "v"(cold), "v"(A), "v"(B));
#endif
                    }
                }
#pragma unroll
                for (int nt = 0; nt < 3; ++nt)
#pragma unroll
                    for (int r = 0; r < 4; ++r) Cn[(16 * w + 4 * g + r) * VE_STRIDE + 16 * nt + i16] = (bf16)f2bf(accC[nt][r]);
            }
        }
        SYNC();
    }
}

DEV void ph_mfin(const Ctx& F, int l) {
    const int gw = F.bid * 8 + F.wave, NGW = F.G * 8, lane = F.lane;
    const bf16* PROJ = (const bf16*)(F.ws + WS_PROJ); const bf16* HM = (const bf16*)(F.ws + WS_HM); bf16* CAT = (bf16*)(F.ws + WS_CAT);
    float gm[8];
#pragma unroll
    for (int j = 0; j < 8; ++j) gm[j] = PIN(F, I_GNW)[l * DM + 256 + 8 * lane + j];
    u32x4 hv4[4], ov4[4], hvn[4], ovn[4];
#define MFIN_LOAD(HV, OV, M0) do { _Pragma("unroll") for (int q = 0; q < 4; ++q) { const int mm = (M0) + q * NGW; const size_t ms = (size_t)(mm < MTOK ? mm : 0); \
            HV[q] = *(const u32x4*)(HM + ms * 512 + 8 * lane); OV[q] = *(const u32x4*)(PROJ + ms * NPROJ + PC_MO + 8 * lane); } } while (0)
    MFIN_LOAD(hv4, ov4, gw);
    for (int m0 = gw; m0 < MTOK; m0 += 4 * NGW) {
        MFIN_LOAD(hvn, ovn, m0 + 4 * NGW);
#pragma unroll
        for (int q = 0; q < 4; ++q) { const int m = m0 + q * NGW; if (m >= MTOK) break;
            const u32x4 hv = hv4[q], ov = ov4[q];
            float v[8] = {bflo(hv.x), bfhi(hv.x), bflo(hv.y), bfhi(hv.y), bflo(hv.z), bfhi(hv.z), bflo(hv.w), bfhi(hv.w)};
            const float o[8] = {bflo(ov.x), bfhi(ov.x), bflo(ov.y), bfhi(ov.y), bflo(ov.z), bfhi(ov.z), bflo(ov.w), bfhi(ov.w)};
            float s = 0.f;
#pragma unroll
            for (int j = 0; j < 8; ++j) s += v[j] * v[j];
            s += SHFL_XOR(s, 1); s += SHFL_XOR(s, 2); s += SHFL_XOR(s, 4); s += SHFL_XOR(s, 8);
            const float rs = RSQ(s * (1.0f / 128.0f) + NORM_EPS);
            u32x4 r;
            r.x = pk2(v[0] * rs * gm[0] * fsigmoid(o[0]), v[1] * rs * gm[1] * fsigmoid(o[1]));
            r.y = pk2(v[2] * rs * gm[2] * fsigmoid(o[2]), v[3] * rs * gm[3] * fsigmoid(o[3]));
            r.z = pk2(v[4] * rs * gm[4] * fsigmoid(o[4]), v[5] * rs * gm[5] * fsigmoid(o[5]));
            r.w = pk2(v[6] * rs * gm[6] * fsigmoid(o[6]), v[7] * rs * gm[7] * fsigmoid(o[7]));
            *(u32x4*)(CAT + (size_t)m * DM + 256 + 8 * lane) = r; }
#pragma unroll
        for (int q = 0; q < 4; ++q) { hv4[q] = hvn[q]; ov4[q] = ovn[q]; }
    }
#undef MFIN_LOAD
}

constexpr int DS_HIST = 0;
constexpr int DS_MASK = 49152;
constexpr int DS_CAND = 65536;
constexpr int DS_SELL = 102400;
constexpr int DS_META = 118784;
constexpr int DS_RB = DS_META + 512;
constexpr int DS_SS = DS_RB + 2048;
constexpr int DS_SLOT = 12800;
constexpr int NBIN = 768, CAND_CAP = 128;
__device__ const unsigned char T5B[114] = {0, 1, 2, 3, 4, 5, 6, 7, 8, 9, 10, 11, 12, 13, 14, 15, 16, 16, 16, 17, 17, 18, 18, 18, 19, 19, 19, 20, 20, 20, 20, 21, 21, 21, 21, 22, 22, 22, 22, 22, 23, 23, 23, 23, 23, 23, 24, 24, 24, 24, 24, 24, 25, 25, 25, 25, 25, 25, 25, 26, 26, 26, 26, 26, 26, 26, 26, 27, 27, 27, 27, 27, 27, 27, 27, 27, 27, 28, 28, 28, 28, 28, 28, 28, 28, 28, 28, 29, 29, 29, 29, 29, 29, 29, 29, 29, 29, 29, 29, 30, 30, 30, 30, 30, 30, 30, 30, 30, 30, 30, 30, 30, 30, 31};

DEV int score_bin(float sc) {
    const unsigned u = __builtin_bit_cast(unsigned, sc);
    int e = (int)((u >> 18) & 0x1FFFu) - 119 * 32; e = e < 0 ? 0 : (e > 383 ? 383 : e);
    return (u >> 31) ? 383 - e : 384 + e;
}
DEV unsigned score_key(float sc) { const unsigned u = __builtin_bit_cast(unsigned, sc); return (u >> 31) ? ~u : (u | 0x80000000u); }
DEV unsigned score_code(float sc) {
    const unsigned u = __builtin_bit_cast(unsigned, sc);
    int e = (int)((u >> 18) & 0x1FFFu) - 119 * 32; e = e < 0 ? 0 : (e > 383 ? 383 : e);
    return ((u >> 16) & 0x8000u) | ((unsigned)e << 6) | ((u >> 12) & 63u);
}
DEV int code_bin(unsigned c) { const int e = (int)((c >> 6) & 0x1FFu); return (c & 0x8000u) ? 383 - e : 384 + e; }
DEV unsigned code_key(unsigned c) { return (c & 0x8000u) ? 63u - (c & 63u) : (c & 63u); }


DEV f32x4 dsa_score_tile(const bf16x8 A, const bf16x8 (&QS)[2], const bf16x8 (&Bq)[8], const float (&wq)[8]) {
    f32x4 sc = (f32x4){0.f, 0.f, 0.f, 0.f};
#pragma unroll
    for (int h = 0; h < 8; ++h) { const f32x4 d = MFMA16(A, Bq[h], (f32x4){0.f, 0.f, 0.f, 0.f});
#pragma unroll
        for (int r = 0; r < 4; ++r) sc[r] += wq[h] * RELU(d[r]); }
    return sc;
}
DEV void ph_dsa(const Ctx& F, int l) {
    const int tid = F.tid, lane = F.lane, w = F.wave, i16 = lane & 15, g = lane >> 4;
    unsigned* HIST = (unsigned*)(F.lds + DS_HIST); unsigned* MASK = (unsigned*)(F.lds + DS_MASK); u32x2* CAND = (u32x2*)(F.lds + DS_CAND);
    unsigned short* SELL = (unsigned short*)(F.lds + DS_SELL); int* BST = (int*)(F.lds + DS_META); int* NAB = BST + 32; int* NCAND = BST + 64; int* NSEL = BST + 96;
    float* RB = (float*)(F.lds + DS_RB);
    const bf16* QIDX = (const bf16*)(F.ws + WS_QIDX); const bf16* KIDX = (const bf16*)(F.ws + WS_KIDX); const float* WI = (const float*)(F.ws + WS_WI);
    const bf16* QABS = (const bf16*)(F.ws + WS_QABS); const bf16* CKV = (const bf16*)(F.ws + WS_CKV); bf16* CAT = (bf16*)(F.ws + WS_CAT);
    const bf16* WUVT = (const bf16*)(F.ws + WS_WUVT) + (size_t)l * 4 * 64 * 128; float* SS = (float*)(F.lds + DS_SS);
    for (int e = tid; e < 114 * 4; e += 512) RB[e] = PIN(F, I_RELB)[T5B[e >> 2] * 4 + (e & 3)] * 1.4426950408889634f;
    SYNC();
    for (int ui = F.bid; ui < BATCH * 128; ui += F.G) {
#ifdef HOST_EMU
        int b, qt; { const int wv = ui & 255, k = ui >> 8, r = wv & 15; b = wv >> 4; qt = (k & 1) ? (32 * (k >> 1) + 31 - r) : (32 * (k >> 1) + r); }
#else
        int b, qt; { const int wv = ui & 255, k = ui >> 8, xj = wv >> 3, r = xj & 15; b = 2 * (wv & 7) + (xj >> 4);
            qt = (k & 1) ? (32 * (k >> 1) + 31 - r) : (32 * (k >> 1) + r); }
#endif
        const int t0 = 32 * qt, nkt = 2 * qt + 2; const size_t mb = (size_t)b * SEQ;
        const GAS char* const ckvb = UNIP(CKV + mb * 128);
        const int nt = w & 1;
        u32x2* sw = (u32x2*)(F.ws + (F.bid < 128 ? WS_QL + (size_t)F.bid * 262144 : WS_SCR2 + (size_t)(F.bid - 128) * 262144) + (size_t)w * 32768) + lane;
        bf16x8 Bq[8]; float wq[8];
        { const size_t mq = mb + t0 + 16 * nt + i16;
#pragma unroll
            for (int h = 0; h < 8; ++h) { Bq[h] = *(const bf16x8*)(QIDX + mq * 256 + 32 * h + 8 * g); wq[h] = WI[mq * 8 + h]; } }
        bf16x8 QS[2];
#pragma unroll
        for (int j = 0; j < 8; ++j) { float s = 0.f;
#pragma unroll
            for (int h = 0; h < 8; ++h) s += wq[h] * bf2f((unsigned)(unsigned short)Bq[h][j]);
            const unsigned hi = f2bf(s); QS[0][j] = (short)hi; QS[1][j] = (short)f2bf(s - bf2f(hi)); }
        for (int e = tid; e < 16 * NBIN; e += 512) HIST[e] = 0u;
        for (int e = tid; e < 32 * 128; e += 512) MASK[e] = 0u;
        if (tid < 32) NCAND[tid] = 0;
        SYNC();
        bf16x8 Apre = *(const bf16x8*)(KIDX + (mb + 16 * (w >> 1) + i16) * 32 + 8 * g);
        for (int kt = w >> 1; kt < nkt; kt += 4) {
            const bf16x8 A = Apre;
            { const int kn = kt + 4 < nkt ? kt + 4 : kt; Apre = *(const bf16x8*)(KIDX + (mb + 16 * kn + i16) * 32 + 8 * g); }
            const f32x4 sc = dsa_score_tile(A, QS, Bq, wq);
            unsigned cd[4];
#pragma unroll
            for (int r = 0; r < 4; ++r) cd[r] = score_code(sc[r] + 0.0f);
            { u32x2 pk; pk.x = cd[0] | (cd[1] << 16); pk.y = cd[2] | (cd[3] << 16); sw[(size_t)((kt - (w >> 1)) >> 2) * 64] = pk; }
            const unsigned inc = nt ? 65536u : 1u;
            if (kt < 2 * qt) {
#pragma unroll
                for (int r = 0; r < 4; ++r) atomicAdd(&HIST[i16 * NBIN + code_bin(cd[r])], inc);
            } else {
                const int t = t0 + 16 * nt + i16;
#pragma unroll
                for (int r = 0; r < 4; ++r) { const int s = 16 * kt + 4 * g + r;
                    if (s <= t) atomicAdd(&HIST[i16 * NBIN + code_bin(cd[r])], inc); }
            }
        }
        SYNC();
        {
            int cnt4[4][12], tot4[4], suf4[4];
#pragma unroll
            for (int rr = 0; rr < 4; ++rr) { const int row = 4 * w + rr, sh = (row >> 4) * 16; const unsigned* hp = HIST + (row & 15) * NBIN + 12 * lane; int tot = 0;
#pragma unroll
                for (int i = 0; i < 12; ++i) { cnt4[rr][i] = (int)((hp[i] >> sh) & 0xFFFFu); tot += cnt4[rr][i]; }
                tot4[rr] = tot; suf4[rr] = tot; }
#pragma unroll
            for (int o = 1; o < 64; o <<= 1) {
#pragma unroll
                for (int rr = 0; rr < 4; ++rr) { const int v = SHFL_DOWN(suf4[rr], o); if (lane + o < 64) suf4[rr] += v; } }
#pragma unroll
            for (int rr = 0; rr < 4; ++rr) { const int row = 4 * w + rr, t = t0 + row;
                if (t < 256) { if (lane == 0) { BST[row] = -1; NAB[row] = t + 1; } }
                else { const int above = suf4[rr] - tot4[rr];
                    if (above < 256 && above + tot4[rr] >= 256) {
                        int run = above, bs = -1, na = 0; bool done = false;
#pragma unroll
                        for (int i = 11; i >= 0; --i) { if (!done) { if (run + cnt4[rr][i] >= 256) { bs = 12 * lane + i; na = run; done = true; } else run += cnt4[rr][i]; } }
                        BST[row] = bs; NAB[row] = na; } } }
        }
        SYNC();
        { const int row = 16 * nt + i16, t = t0 + row, bs = BST[row];
        const int ntl = nkt > (w >> 1) ? ((nkt - 1 - (w >> 1)) >> 2) + 1 : 0;
        u32x2 Pc[8], Pn[8];
#pragma unroll
        for (int q = 0; q < 8; ++q) Pc[q] = sw[(size_t)(q < 64 ? q : 63) * 64];
        for (int jb = 0; jb < ntl; jb += 8) {
#pragma unroll
            for (int q = 0; q < 8; ++q) { const int jn = jb + 8 + q; Pn[q] = sw[(size_t)(jn < 64 ? jn : 63) * 64]; }
#pragma unroll
            for (int q = 0; q < 8; ++q) { const int j = jb + q; if (j < ntl) { const int kt = (w >> 1) + 4 * j; const u32x2 pc = Pc[q];
            const bool full = kt < 2 * qt;
            const int s0 = 16 * kt + 4 * g; unsigned nib = 0u, cnd = 0u, cc[4];
#pragma unroll
            for (int r = 0; r < 4; ++r) { const unsigned wd = r < 2 ? pc.x : pc.y; cc[r] = (r & 1) ? (wd >> 16) : (wd & 0xffffu);
                const int bn = code_bin(cc[r]); const bool ok = full || s0 + r <= t;
                nib |= (ok && bn > bs) ? (1u << r) : 0u; cnd |= (ok && bn == bs) ? (1u << r) : 0u; }
            if (nib) atomicOr(&MASK[row * 128 + (s0 >> 5)], nib << (s0 & 31));
            if (cnd) {
#pragma unroll
                for (int r = 0; r < 4; ++r) if ((cnd >> r) & 1u) { const int pos = (int)atomicAdd((unsigned*)&NCAND[row], 1u); if (pos < CAND_CAP) CAND[row * CAND_CAP + pos] = (u32x2){code_key(cc[r]), (unsigned)(s0 + r)}; } }
            } }
#pragma unroll
            for (int q = 0; q < 8; ++q) Pc[q] = Pn[q];
        } }
        SYNC();
#pragma unroll 1
        for (int rr = 0; rr < 4; ++rr) {
            const int row = 4 * w + rr; if (BST[row] < 0) continue;
            const int n = NCAND[row] < CAND_CAP ? NCAND[row] : CAND_CAP, need = 256 - NAB[row];
            for (int i = lane; i < n; i += 64) { const u32x2 me = CAND[row * CAND_CAP + i]; int rank = 0;
                for (int j0 = 0; j0 < n; j0 += 8) { u32x2 o8[8];
#pragma unroll
                    for (int q = 0; q < 8; ++q) o8[q] = CAND[row * CAND_CAP + (j0 + q < CAND_CAP ? j0 + q : CAND_CAP - 1)];
#pragma unroll
                    for (int q = 0; q < 8; ++q) rank += (j0 + q < n && (o8[q].x > me.x || (o8[q].x == me.x && o8[q].y < me.y))) ? 1 : 0; }
#ifndef DSA_DBG_NOCAND
                if (rank < need) atomicOr(&MASK[row * 128 + (me.y >> 5)], 1u << (me.y & 31));
#endif
            }
        }
        SYNC();
#ifdef DSA_DBG_SEL
        for (int e = tid; e < 32 * 128; e += 512) { const int row = e >> 7, wi = e & 127, t = t0 + row, lo = t - 255 < 0 ? 0 : t - 255; unsigned m = 0u;
            for (int bq = 0; bq < 32; ++bq) { const int s = 32 * wi + bq; if (s >= lo && s <= t) m |= 1u << bq; }
            MASK[e] = m; }
        SYNC();
#endif
        {
            unsigned w04[4], w14[4]; int c4[4], inc4[4];
#pragma unroll
            for (int rr = 0; rr < 4; ++rr) { const int row = 4 * w + rr; w04[rr] = MASK[row * 128 + 2 * lane]; w14[rr] = MASK[row * 128 + 2 * lane + 1];
                c4[rr] = __builtin_popcount(w04[rr]) + __builtin_popcount(w14[rr]); inc4[rr] = c4[rr]; }
#pragma unroll
            for (int o = 1; o < 64; o <<= 1) {
#pragma unroll
                for (int rr = 0; rr < 4; ++rr) { const int v = SHFL_UP(inc4[rr], o); if (lane >= o) inc4[rr] += v; } }
#pragma unroll
            for (int rr = 0; rr < 4; ++rr) { const int row = 4 * w + rr; unsigned w0 = w04[rr], w1 = w14[rr]; int pos = inc4[rr] - c4[rr];
                while (w0) { const int bt = __builtin_ctz(w0); w0 &= w0 - 1; if (pos < 256) SELL[row * 256 + pos] = (unsigned short)(64 * lane + bt); ++pos; }
                while (w1) { const int bt = __builtin_ctz(w1); w1 &= w1 - 1; if (pos < 256) SELL[row * 256 + pos] = (unsigned short)(64 * lane + 32 + bt); ++pos; }
                if (lane == 63) NSEL[row] = inc4[rr] < 256 ? inc4[rr] : 256; }
        }
        SYNC();
        bf16* TL = (bf16*)(F.lds + w * DS_SLOT); bf16* OLw = (bf16*)(F.lds + w * DS_SLOT + 8704);
#pragma unroll 1
        for (int rr = 0; rr < 4; ++rr) {
            const int row = 4 * w + rr, t = t0 + row, ns = UNI(NSEL[row]); const size_t mt = mb + t;
            const unsigned short* sl = SELL + row * 256;
            bf16x8 Bh[4];
#pragma unroll
            for (int ks = 0; ks < 4; ++ks) Bh[ks] = i16 < 4 ? *(const bf16x8*)(QABS + mt * 512 + i16 * 128 + 32 * ks + 8 * g) : (bf16x8){0, 0, 0, 0, 0, 0, 0, 0};
            f32x4 O[8];
#pragma unroll
            for (int nt = 0; nt < 8; ++nt) O[nt] = (f32x4){0.f, 0.f, 0.f, 0.f};
            float mrun = -1e30f, lrun = 0.f;
            const float bfar = RB[113 * 4 + (i16 & 3)];
            const int nch = (ns + 31) >> 5;
            u32x4 gvA[8];
#ifndef HOST_EMU
#define ATT_KEEP8(A) asm volatile("" :: "v"(A[0][0]), "v"(A[0][1]), "v"(A[0][2]), "v"(A[0][3]), "v"(A[1][0]), "v"(A[1][1]), "v"(A[1][2]), "v"(A[1][3]))
#else
#define ATT_KEEP8(A) (void)0
#endif
#define ATT_LOAD(GV, CK, FULL) do { int sidx[8]; \
                _Pragma("unroll") for (int i = 0; i < 8; ++i) sidx[i] = (int)sl[32 * (CK) + 4 * i + g];            \
                _Pragma("unroll") for (int i = 0; i < 8; ++i) { const int kp = 32 * (CK) + 4 * i + g; sidx[i] = (FULL || kp < ns) ? sidx[i] : 0; } \
                _Pragma("unroll") for (int i = 0; i < 8; ++i) GV[i] = *(const GAS u32x4*)(ckvb + (((unsigned)sidx[i] << 8) + 16u * (unsigned)i16)); } while (0)
#define ATT_STEP(GV, CK, FULL) do { const int ck = (CK); \
                _Pragma("unroll") for (int i = 0; i < 8; ++i) *(u32x4*)(TL + (4 * i + g) * 136 + 8 * i16) = GV[i]; \
                const u32x2 sk0 = *(const u32x2*)(sl + 32 * ck + 4 * g), sk1 = *(const u32x2*)(sl + 32 * ck + 16 + 4 * g); \
                WAVE_LDS_FENCE(); \
                if (ck + 1 < nch) ATT_LOAD(GV, ck + 1, FULL); \
                float bia[2][4]; \
                if (FULL && t - UNI((int)sl[32 * ck + 31]) >= 113) {                   \
                _Pragma("unroll") for (int kt = 0; kt < 2; ++kt) \
                _Pragma("unroll") for (int r = 0; r < 4; ++r) bia[kt][r] = bfar; \
                } else { \
                _Pragma("unroll") for (int kt = 0; kt < 2; ++kt) \
                _Pragma("unroll") for (int r = 0; r < 4; ++r) { const unsigned wd = kt ? (r < 2 ? sk1.x : sk1.y) : (r < 2 ? sk0.x : sk0.y); \
                        int dist = t - (int)((wd >> (16 * (r & 1))) & 0xffffu); dist = dist < 0 ? 0 : (dist > 113 ? 113 : dist); \
                        bia[kt][r] = RB[dist * 4 + (i16 & 3)]; } } \
                f32x4 lg[2]; \
                { bf16x8 Af[2][4];                                    \
                _Pragma("unroll") for (int kt = 0; kt < 2; ++kt) _Pragma("unroll") for (int ks = 0; ks < 4; ++ks) Af[kt][ks] = *(const bf16x8*)(TL + (16 * kt + i16) * 136 + 32 * ks + 8 * g); \
                ATT_KEEP8(Af); \
                _Pragma("unroll") for (int kt = 0; kt < 2; ++kt) { lg[kt] = (f32x4){0.f, 0.f, 0.f, 0.f}; \
                _Pragma("unroll") for (int ks = 0; ks < 4; ++ks) lg[kt] = MFMA16(Af[kt][ks], Bh[ks], lg[kt]); } } \
                float cm = -1e30f; \
                _Pragma("unroll") for (int kt = 0; kt < 2; ++kt) \
                _Pragma("unroll") for (int r = 0; r < 4; ++r) { const int kp = 32 * ck + 16 * kt + 4 * g + r; \
                        lg[kt][r] = (FULL || kp < ns) ? lg[kt][r] + bia[kt][r] : -1e30f; cm = fmaxf(cm, lg[kt][r]); } \
                if (ck == 0) { cm = fmaxf(cm, SHFL_XOR(cm, 16)); cm = fmaxf(cm, SHFL_XOR(cm, 32)); mrun = cm; } \
                float p[2][4]; \
                _Pragma("unroll") for (int kt = 0; kt < 2; ++kt) \
                _Pragma("unroll") for (int r = 0; r < 4; ++r) { p[kt][r] = (FULL || lg[kt][r] > -1e29f) ? FEXP2(lg[kt][r] - mrun) : 0.f; lrun += p[kt][r]; } \
                u32x4 aw = (u32x4){0u, 0u, 0u, 0u}; \
                if (i16 < 4) aw = (u32x4){pk2(p[0][0], p[0][1]), pk2(p[0][2], p[0][3]), pk2(p[1][0], p[1][1]), pk2(p[1][2], p[1][3])}; \
                const bf16x8 A = __builtin_bit_cast(bf16x8, aw); \
                _Pragma("unroll") for (int nt = 0; nt < 8; ++nt) { \
                    const s16x4 lo = TR16(TL + (4 * g + (i16 >> 2)) * 136 + 16 * nt + 4 * (i16 & 3)); \
                    const s16x4 hi = TR16(TL + (16 + 4 * g + (i16 >> 2)) * 136 + 16 * nt + 4 * (i16 & 3)); \
                    const bf16x8 B = (bf16x8){lo[0], lo[1], lo[2], lo[3], hi[0], hi[1], hi[2], hi[3]}; \
                    O[nt] = MFMA16(A, B, O[nt]); } \
                WAVE_LDS_FENCE(); } while (0)
            if (ns == 256) { ATT_LOAD(gvA, 0, true); for (int ck2 = 0; ck2 < 8; ++ck2) ATT_STEP(gvA, ck2, true); }
            else { ATT_LOAD(gvA, 0, false); for (int ck2 = 0; ck2 < nch; ++ck2) ATT_STEP(gvA, ck2, false); }
#undef ATT_STEP
#undef ATT_LOAD
            lrun += SHFL_XOR(lrun, 16); lrun += SHFL_XOR(lrun, 32);
            float li[4];
#pragma unroll
            for (int r = 0; r < 4; ++r) li[r] = FRCP(SHFL(lrun, r));
            if (g == 0) {
#pragma unroll
                for (int nt = 0; nt < 8; ++nt)
#pragma unroll
                    for (int r = 0; r < 4; ++r) OLw[(rr * 4 + r) * 128 + 16 * nt + i16] = (bf16)f2bf(O[nt][r] * li[r]);
            }
        }
        bf16x8 Wf[4][4];
#pragma unroll
        for (int ks = 0; ks < 4; ++ks)
#pragma unroll
            for (int nt = 0; nt < 4; ++nt) Wf[ks][nt] = *(const bf16x8*)(WUVT + ((size_t)((w >> 1) * 64 + 16 * nt + i16)) * 128 + 32 * ks + 8 * g);
        SYNC();
        {
            const int h = w >> 1, mtile = w & 1, q = 16 * mtile + i16;
            const bf16* olq = (const bf16*)(F.lds + (q >> 2) * DS_SLOT + 8704) + ((q & 3) * 4 + h) * 128;
            float gaw[4];
#pragma unroll
            for (int nt = 0; nt < 4; ++nt) gaw[nt] = PIN(F, I_GNW)[l * DM + 768 + h * 64 + 16 * nt + i16];
            f32x4 acc[4];
#pragma unroll
            for (int nt = 0; nt < 4; ++nt) acc[nt] = (f32x4){0.f, 0.f, 0.f, 0.f};
#pragma unroll
            for (int ks = 0; ks < 4; ++ks) { const bf16x8 A = *(const bf16x8*)(olq + 32 * ks + 8 * g);
#pragma unroll
                for (int nt = 0; nt < 4; ++nt) acc[nt] = MFMA16(A, Wf[ks][nt], acc[nt]); }
#pragma unroll
            for (int r = 0; r < 4; ++r) { float s = (acc[0][r] * acc[0][r] + acc[1][r] * acc[1][r]) + (acc[2][r] * acc[2][r] + acc[3][r] * acc[3][r]);
                s += SHFL_XOR(s, 1); s += SHFL_XOR(s, 2); s += SHFL_XOR(s, 4); s += SHFL_XOR(s, 8);
                if (i16 == 0) SS[(16 * mtile + 4 * g + r) * 4 + h] = s; }
            SYNC();
#pragma unroll
            for (int r = 0; r < 4; ++r) { const int qq = 16 * mtile + 4 * g + r; const f32x4 s4 = *(const f32x4*)(SS + qq * 4);
                const float rs = RSQ(((s4.x + s4.y) + (s4.z + s4.w)) * (1.0f / 256.0f) + NORM_EPS);
                bf16* dst = CAT + (mb + t0 + qq) * DM + 768 + h * 64 + i16;
#pragma unroll
                for (int nt = 0; nt < 4; ++nt) dst[16 * nt] = (bf16)f2bf(acc[nt][r] * rs * gaw[nt]); }
        }
        SYNC();
    }
}
#ifndef HOST_EMU
namespace pg8 {
#define PG8_LAS __attribute__((address_space(3)))
typedef unsigned short bf16_t;
typedef short bf16x8 __attribute__((ext_vector_type(8)));
typedef float f32x4 __attribute__((ext_vector_type(4)));
typedef unsigned u32x4 __attribute__((ext_vector_type(4)));
constexpr int BM = 256, BK = 64, HALF = 128, HTB = HALF * BK * 2  , STAGE_BYTES = 8 * HTB, NXCD = 8, WGM = 8;

__host__ __device__ __forceinline__ int lds_byte(int r, int c) { const int st = (r >> 4) * 2 + (c >> 5), rr = r & 15, cc = c & 31, ob = rr * 64 + cc * 2; return st * 1024 + (ob ^ (((ob >> 9) & 1) << 5)); }
__host__ __device__ __forceinline__ void stage_rc(int b, int& R, int& C) { const int st = b / 1024, sb = b % 1024, swz = sb ^ (((sb >> 9) & 1) << 5); R = (st >> 1) * 16 + swz / 64; C = (st & 1) * 32 + (swz % 64) / 2; }
__host__ __device__ __forceinline__ int perm32(int rho) { const int n = rho >> 4, i = rho & 15; return 8 * (i >> 2) + 4 * n + (i & 3); }

struct Unit { int pm, pn; };
struct Gemm { const bf16_t* A; const bf16_t* Bt; int M, N, K; };

struct StaticOrder {
    int nM, nN, nwg, G, c;
    __host__ __device__ void init(int M, int N, int G_, int c_) { nM = M / BM; nN = N / BM; nwg = nM * nN; G = G_; c = c_; }
    __host__ __device__ bool next(int i, Unit& u) const {
        const long L = (long)i * G + c; if (L >= nwg) return false;
        int wgid = (int)L; { const int q = nwg / NXCD, r = nwg % NXCD, xcd = wgid % NXCD, off = wgid / NXCD; wgid = (xcd < r ? xcd * (q + 1) : r * (q + 1) + (xcd - r) * q) + off; }
        const int nig = WGM * nN, gid = wgid / nig, fm = gid * WGM, gsz = (nM - fm) < WGM ? (nM - fm) : WGM;
        u.pm = fm + ((wgid % nig) % gsz); u.pn = (wgid % nig) / gsz; return true;
    }
    __device__ __forceinline__ void a_ready(const Unit&) const {}
    __device__ __forceinline__ void done(const Unit&) const {}
};
__device__ __forceinline__ unsigned cvt_pk_bf16(float lo, float hi) { unsigned r; asm volatile("v_cvt_pk_bf16_f32 %0, %1, %2" : "=v"(r) : "v"(lo), "v"(hi)); return r; }
template <class Epi, class Sched, bool ALIGN_EPI = false, bool SP2 = false>
__device__ __forceinline__ void gemm_phase(PG8_LAS unsigned char* lds, const Gemm g, const Sched& S, const Epi& E, const int tid_in) {
    const int tid = tid_in, wid = __builtin_amdgcn_readfirstlane(tid >> 6), lane = tid & 63, wr = wid >> 2, wc = wid & 3, fr = lane & 15, fq = lane >> 4;
    const int K = g.K, nt = K / BK;
    unsigned voffA[2], voffB[2];
#pragma unroll
    for (int i = 0; i < 2; ++i) { int R, C; stage_rc(tid * 16 + i * 8192, R, C); const int Rb = Epi::PERM ? ((R & ~31) + perm32(R & 31)) : R;
        voffA[i] = (unsigned)(R * K + C) * 2u; voffB[i] = (unsigned)(Rb * K + C) * 2u; }
    const size_t kstep = (size_t)(BK * 2);
    const size_t hstep = (size_t)HALF * K * 2;
    const size_t tstep = 2 * hstep;
    const unsigned ldsw = (unsigned)wid * 1024u;
    const int aoff = lds_byte(wr * 64 + fr, fq * 8), boff = lds_byte(wc * 32 + fr, fq * 8);
#define PG8_SA(b, h) (((b) * 2 + (h)) * HTB)
#define PG8_SB(b, h) ((4 + (b) * 2 + (h)) * HTB)
#define PG8_STAGE(bufoff, gbase, voff) do { _Pragma("unroll") for (int _i = 0; _i < 2; ++_i) \
        __builtin_amdgcn_global_load_lds((const unsigned*)((const char*)(gbase) + (voff)[_i]), (PG8_LAS unsigned*)(lds + (bufoff) + ldsw + _i * 8192), 16, 0, 0); } while (0)
#define PG8_LDA(dst, b, h) do { _Pragma("unroll") for (int m = 0; m < 4; ++m) _Pragma("unroll") for (int k = 0; k < 2; ++k) dst[m][k] = *(const PG8_LAS bf16x8*)(lds + PG8_SA(b, h) + aoff + m * 2048 + k * 1024); } while (0)
#define PG8_LDB(dst, b, h) do { _Pragma("unroll") for (int n = 0; n < 2; ++n) _Pragma("unroll") for (int k = 0; k < 2; ++k) dst[n][k] = *(const PG8_LAS bf16x8*)(lds + PG8_SB(b, h) + boff + n * 2048 + k * 1024); } while (0)
#define PG8_MMA(ai, bj, At, Bt) do { __builtin_amdgcn_s_setprio(1); _Pragma("unroll") for (int m = 0; m < 4; ++m) _Pragma("unroll") for (int n = 0; n < 2; ++n) _Pragma("unroll") for (int k = 0; k < 2; ++k) \
        acc[ai][bj][m][n] = __builtin_amdgcn_mfma_f32_16x16x32_bf16(Bt[n][k], At[m][k], acc[ai][bj][m][n], 0, 0, 0); __builtin_amdgcn_s_setprio(0); } while (0)
#define PG8_WAIT_V(n) asm volatile("s_waitcnt vmcnt(" #n ")" ::: "memory")
#define PG8_WAIT_L(n) asm volatile("s_waitcnt lgkmcnt(" #n ")" ::: "memory")
#define PG8_BAR __builtin_amdgcn_s_barrier()
#define PG8_SCHED __builtin_amdgcn_sched_barrier(0)
    Unit cur, nxt; int ui = 0;
    if (!S.next(0, cur)) return;
    f32x4 acc[2][2][4][2];
#pragma unroll
    for (int a = 0; a < 2; ++a)
#pragma unroll
        for (int b = 0; b < 2; ++b)
#pragma unroll
            for (int m = 0; m < 4; ++m)
#pragma unroll
                for (int n = 0; n < 2; ++n) acc[a][b][m][n] = (f32x4){0.f, 0.f, 0.f, 0.f};
    bf16x8 At[4][2], B0[2][2], B1[2][2];
    const char* cA = (const char*)g.A + (size_t)cur.pm * tstep; const char* cB = (const char*)g.Bt + (size_t)cur.pn * tstep;
    S.a_ready(cur);
    if constexpr (SP2) {
        PG8_STAGE(PG8_SB(0, 0), cB, voffB); PG8_STAGE(PG8_SB(0, 1), cB + hstep, voffB); PG8_STAGE(PG8_SA(0, 0), cA, voffA); PG8_STAGE(PG8_SA(0, 1), cA + hstep, voffA);
        if (wr == 1) PG8_BAR;
        PG8_WAIT_V(2); PG8_BAR;
        PG8_STAGE(PG8_SB(1, 0), cB + kstep, voffB); PG8_STAGE(PG8_SA(1, 0), cA + kstep, voffA); PG8_STAGE(PG8_SB(1, 1), cB + hstep + kstep, voffB);
        PG8_WAIT_V(6); PG8_BAR;
    } else {
        PG8_STAGE(PG8_SB(0, 0), cB, voffB); PG8_STAGE(PG8_SA(0, 0), cA, voffA); PG8_STAGE(PG8_SB(0, 1), cB + hstep, voffB); PG8_STAGE(PG8_SA(0, 1), cA + hstep, voffA);
        if (wr == 1) PG8_BAR;
        PG8_WAIT_V(4); PG8_BAR;
        PG8_STAGE(PG8_SB(1, 0), cB + kstep, voffB); PG8_STAGE(PG8_SA(1, 0), cA + kstep, voffA); PG8_STAGE(PG8_SB(1, 1), cB + hstep + kstep, voffB);
        PG8_WAIT_V(6); PG8_BAR;
    }
    for (;;) {
        const bool has_next = S.next(ui + 1, nxt);
        const char* nA = has_next ? (const char*)g.A + (size_t)nxt.pm * tstep : cA; const char* nB = has_next ? (const char*)g.Bt + (size_t)nxt.pn * tstep : cB;
#pragma unroll 1
        for (int t = 0; t < nt; t += 2) {
            const bool last = (t == nt - 2);
            const char* a1 = cA + (size_t)(t + 1) * kstep;
            const char* a2 = last ? nA : cA + (size_t)(t + 2) * kstep; const char* b2 = last ? nB : cB + (size_t)(t + 2) * kstep;
            const char* a3 = a2 + kstep; const char* b3 = b2 + kstep;
            if (last && has_next) S.a_ready(nxt);
            if constexpr (Epi::NORM) { if (t == 2) E.prefetch(cur, tid, wid); if (t == 4) E.reduce_rs(tid); }
            if constexpr (SP2) {
            PG8_LDB(B0, 0, 0); PG8_LDB(B1, 0, 1); PG8_SCHED; PG8_LDA(At, 0, 0); PG8_STAGE(PG8_SA(1, 1), a1 + hstep, voffA);
            PG8_WAIT_V(8); PG8_WAIT_L(0); PG8_BAR; PG8_MMA(0, 0, At, B0); PG8_MMA(0, 1, At, B1); PG8_BAR; PG8_SCHED;
            PG8_LDA(At, 0, 1); PG8_STAGE(PG8_SB(0, 0), b2, voffB); PG8_STAGE(PG8_SB(0, 1), b2 + hstep, voffB); PG8_STAGE(PG8_SA(0, 0), a2, voffA);
            PG8_WAIT_V(8); PG8_WAIT_L(0); PG8_BAR; PG8_MMA(1, 0, At, B0); PG8_MMA(1, 1, At, B1); PG8_BAR; PG8_SCHED;
            PG8_LDB(B0, 1, 0); PG8_LDB(B1, 1, 1); PG8_SCHED; PG8_LDA(At, 1, 0); PG8_STAGE(PG8_SA(0, 1), a2 + hstep, voffA);
            PG8_WAIT_V(8); PG8_WAIT_L(0); PG8_BAR; PG8_MMA(0, 0, At, B0); PG8_MMA(0, 1, At, B1); PG8_BAR; PG8_SCHED;
            PG8_LDA(At, 1, 1); PG8_STAGE(PG8_SB(1, 0), b3, voffB); PG8_STAGE(PG8_SB(1, 1), b3 + hstep, voffB); PG8_STAGE(PG8_SA(1, 0), a3, voffA);
            PG8_WAIT_V(8); PG8_WAIT_L(0); PG8_BAR; PG8_MMA(1, 0, At, B0); PG8_MMA(1, 1, At, B1); PG8_BAR; PG8_SCHED;
            } else {
            PG8_LDB(B0, 0, 0); PG8_SCHED; PG8_LDA(At, 0, 0); PG8_STAGE(PG8_SA(1, 1), a1 + hstep, voffA);
            PG8_WAIT_L(8); PG8_BAR; PG8_WAIT_L(0); PG8_MMA(0, 0, At, B0); PG8_BAR; PG8_SCHED;
            PG8_LDB(B1, 0, 1); PG8_STAGE(PG8_SB(0, 0), b2, voffB);
            PG8_BAR; PG8_WAIT_L(0); PG8_MMA(0, 1, At, B1); PG8_BAR;
            PG8_LDA(At, 0, 1); PG8_STAGE(PG8_SA(0, 0), a2, voffA);
            PG8_BAR; PG8_WAIT_L(0); PG8_MMA(1, 0, At, B0); PG8_BAR; PG8_SCHED;
            PG8_STAGE(PG8_SB(0, 1), b2 + hstep, voffB);
            PG8_WAIT_V(6); PG8_BAR; PG8_MMA(1, 1, At, B1); PG8_BAR;
            PG8_LDB(B0, 1, 0); PG8_SCHED; PG8_LDA(At, 1, 0); PG8_STAGE(PG8_SA(0, 1), a2 + hstep, voffA);
            PG8_WAIT_L(8); PG8_BAR; PG8_WAIT_L(0); PG8_MMA(0, 0, At, B0); PG8_BAR; PG8_SCHED;
            PG8_LDB(B1, 1, 1); PG8_STAGE(PG8_SB(1, 0), b3, voffB);
            PG8_BAR; PG8_WAIT_L(0); PG8_MMA(0, 1, At, B1); PG8_BAR;
            PG8_LDA(At, 1, 1); PG8_STAGE(PG8_SA(1, 0), a3, voffA);
            PG8_BAR; PG8_WAIT_L(0); PG8_MMA(1, 0, At, B0); PG8_BAR; PG8_SCHED;
            PG8_STAGE(PG8_SB(1, 1), b3 + hstep, voffB);
            PG8_WAIT_V(6); PG8_BAR; PG8_MMA(1, 1, At, B1); PG8_BAR;
            }
        }
        if constexpr (ALIGN_EPI) { if (wr == 0) PG8_BAR; }
        if constexpr (!Epi::AFTER_DRAIN) { E(acc, cur, wr, wc, fr, fq); S.done(cur); }
        if (!has_next) break;
#pragma unroll
        for (int a = 0; a < 2; ++a)
#pragma unroll
            for (int b = 0; b < 2; ++b)
#pragma unroll
                for (int m = 0; m < 4; ++m)
#pragma unroll
                    for (int n = 0; n < 2; ++n) acc[a][b][m][n] = (f32x4){0.f, 0.f, 0.f, 0.f};
        cur = nxt; cA = nA; cB = nB; ++ui;
        if constexpr (ALIGN_EPI) { if (wr == 1) PG8_BAR; }
    }
    PG8_WAIT_V(0);
    if constexpr (!ALIGN_EPI) { if (wr == 0) PG8_BAR; }
    PG8_BAR;
    if constexpr (Epi::AFTER_DRAIN) { E.fused(acc, cur, wr, wc, fr, fq, lds, wid, lane); S.done(cur); }
#undef PG8_SA
#undef PG8_SB
#undef PG8_STAGE
#undef PG8_LDA
#undef PG8_LDB
#undef PG8_MMA
#undef PG8_WAIT_V
#undef PG8_WAIT_L
#undef PG8_BAR
#undef PG8_SCHED
}
}
namespace pg8 {
template <int ACT  > struct EpiRoute {
    static constexpr bool PERM = true, AFTER_DRAIN = false, NORM = false;
    bf16_t* O0; int ld0; bf16_t* O1; int ld1; int split;
    __device__ __forceinline__ void operator()(const f32x4 (&acc)[2][2][4][2], const Unit& u, int wr, int wc, int fr, int fq) const {
        const int row0 = u.pm * BM + wr * 64 + fr; const bool first = u.pn < split;
        bf16_t* base = first ? O0 : O1; const int ld = first ? ld0 : ld1; const int col0 = (first ? u.pn : u.pn - split) * BM + wc * 32 + 8 * fq;
#pragma unroll
        for (int ai = 0; ai < 2; ++ai)
#pragma unroll
            for (int m = 0; m < 4; ++m) { bf16_t* rowp = base + (size_t)(row0 + ai * HALF + m * 16) * ld + col0;
#pragma unroll
                for (int bj = 0; bj < 2; ++bj) { f32x4 v0 = acc[ai][bj][m][0], v1 = acc[ai][bj][m][1];
                    if (ACT == 1) {
#pragma unroll
                        for (int e = 0; e < 4; ++e) { const float a = fmaxf(v0[e], 0.f), b = fmaxf(v1[e], 0.f); v0[e] = a * a; v1[e] = b * b; } }
                    u32x4 w; w.x = cvt_pk_bf16(v0[0], v0[1]); w.y = cvt_pk_bf16(v0[2], v0[3]); w.z = cvt_pk_bf16(v1[0], v1[1]); w.w = cvt_pk_bf16(v1[2], v1[3]);
                    *(u32x4*)(rowp + bj * HALF) = w; } }
    }
};
struct EpiResid {
    static constexpr bool PERM = true, AFTER_DRAIN = false, NORM = false;
    const float* xsrc; float* xdst; const float* gate;
    __device__ __forceinline__ void operator()(const f32x4 (&acc)[2][2][4][2], const Unit& u, int wr, int wc, int fr, int fq) const {
        const int row0 = u.pm * BM + wr * 64 + fr, col0 = u.pn * BM + wc * 32 + 8 * fq, b = (u.pm * BM) >> 12;
        f32x4 gv[2][2];
#pragma unroll
        for (int bj = 0; bj < 2; ++bj)
#pragma unroll
            for (int n = 0; n < 2; ++n) gv[bj][n] = *(const f32x4*)(gate + (size_t)b * 6144 + col0 + bj * HALF + 4 * n);
#pragma unroll
        for (int ai = 0; ai < 2; ++ai)
#pragma unroll
            for (int m = 0; m < 4; ++m) { const size_t off = (size_t)(row0 + ai * HALF + m * 16) * 1024 + col0;
#pragma unroll
                for (int bj = 0; bj < 2; ++bj)
#pragma unroll
                    for (int n = 0; n < 2; ++n) { const f32x4 xs = *(const f32x4*)(xsrc + off + bj * HALF + 4 * n);
                        *(f32x4*)(xdst + off + bj * HALF + 4 * n) = xs + gv[bj][n] * acc[ai][bj][m][n]; }
                if (m & 1) asm volatile("" ::: "memory"); }
    }
};
constexpr int EPI_OFF = 133120;
template <int ACT  > struct EpiRouteN {
    static constexpr bool PERM = true, AFTER_DRAIN = false, NORM = true;
    bf16_t* O; int ld; const float* RSP; const float* shw; PG8_LAS unsigned char* lds;
    __device__ __forceinline__ void prefetch(const Unit& u, int tid, int wid) const {
        const char* src = (const char*)RSP + (size_t)u.pm * (BM * 64) + (size_t)tid * 16;
#pragma unroll
        for (int i = 0; i < 2; ++i) __builtin_amdgcn_global_load_lds((const unsigned*)(src + i * 8192), (PG8_LAS unsigned*)(lds + EPI_OFF + wid * 1024 + i * 8192), 16, 0, 0);
        if (wid == 0) { const char* s2 = (const char*)(shw + (size_t)((u.pm * BM) >> 12) * NSHW + u.pn * BM) + (size_t)(tid & 63) * 16;
            __builtin_amdgcn_global_load_lds((const unsigned*)s2, (PG8_LAS unsigned*)(lds + EPI_OFF + 16384), 16, 0, 0); }
    }
    __device__ __forceinline__ void reduce_rs(int tid) const {
        if (tid < 256) { const PG8_LAS f32x4* p = (const PG8_LAS f32x4*)(lds + EPI_OFF + tid * 64); const f32x4 a = p[0], b = p[1], c = p[2], d = p[3];
            const float s = (((a.x + a.y) + (a.z + a.w)) + ((b.x + b.y) + (b.z + b.w))) + (((c.x + c.y) + (c.z + c.w)) + ((d.x + d.y) + (d.z + d.w)));
            *(PG8_LAS float*)(lds + EPI_OFF + 17408 + tid * 4) = __builtin_amdgcn_rsqf(s * (1.0f / 1024.0f) + 1e-6f); }
    }
    __device__ __forceinline__ void operator()(const f32x4 (&acc)[2][2][4][2], const Unit& u, int wr, int wc, int fr, int fq) const {
        const int row0 = u.pm * BM + wr * 64 + fr, col0 = u.pn * BM + wc * 32 + 8 * fq;
        const PG8_LAS unsigned char* ep = lds + EPI_OFF;
        float rs[2][4];
#pragma unroll
        for (int ai = 0; ai < 2; ++ai)
#pragma unroll
            for (int m = 0; m < 4; ++m) rs[ai][m] = *(const PG8_LAS float*)(ep + 17408 + (wr * 64 + fr + ai * HALF + m * 16) * 4);
        f32x4 sv[2][2];
#pragma unroll
        for (int bj = 0; bj < 2; ++bj)
#pragma unroll
            for (int n = 0; n < 2; ++n) sv[bj][n] = *(const PG8_LAS f32x4*)(ep + 16384 + (bj * HALF + wc * 32 + 8 * fq + 4 * n) * 4);
#pragma unroll
        for (int ai = 0; ai < 2; ++ai)
#pragma unroll
            for (int m = 0; m < 4; ++m) { bf16_t* rowp = O + (size_t)(row0 + ai * HALF + m * 16) * ld + col0;
#pragma unroll
                for (int bj = 0; bj < 2; ++bj) { f32x4 v0 = acc[ai][bj][m][0] * rs[ai][m] + sv[bj][0], v1 = acc[ai][bj][m][1] * rs[ai][m] + sv[bj][1];
                    if (ACT == 1) {
#pragma unroll
                        for (int e = 0; e < 4; ++e) { const float a = fmaxf(v0[e], 0.f), b = fmaxf(v1[e], 0.f); v0[e] = a * a; v1[e] = b * b; } }
                    u32x4 w; w.x = cvt_pk_bf16(v0[0], v0[1]); w.y = cvt_pk_bf16(v0[2], v0[3]); w.z = cvt_pk_bf16(v1[0], v1[1]); w.w = cvt_pk_bf16(v1[2], v1[3]);
                    *(u32x4*)(rowp + bj * HALF) = w; } }
    }
};
template <bool MAYSKIP> struct EpiResidXS {
    static constexpr bool PERM = true, AFTER_DRAIN = false, NORM = false;
    const bf16_t* xsrc; bf16_t* xdst; const float* gate; const float* wp; bf16_t* XS; float* RSP; int doxs;
    template <bool DOXS> __device__ __forceinline__ void body(const f32x4 (&acc)[2][2][4][2], const Unit& u, int wr, int wc, int fr, int fq) const {
        const int row0 = u.pm * BM + wr * 64 + fr, col0 = u.pn * BM + wc * 32 + 8 * fq, b = (u.pm * BM) >> 12;
        f32x4 gv[2][2], wv[2][2]; float ssv[2][4];
#pragma unroll
        for (int bj = 0; bj < 2; ++bj)
#pragma unroll
            for (int n = 0; n < 2; ++n) { gv[bj][n] = *(const f32x4*)(gate + (size_t)b * 6144 + col0 + bj * HALF + 4 * n);
                if (DOXS) wv[bj][n] = *(const f32x4*)(wp + (size_t)b * 1024 + col0 + bj * HALF + 4 * n); }
#pragma unroll
        for (int aim = 0; aim < 4; ++aim) { const int ai = aim >> 1, m0_ = (aim & 1) * 2;
            u32x4 xr[4][2];
#pragma unroll
            for (int m = m0_; m < m0_ + 2; ++m)
#pragma unroll
                for (int bj = 0; bj < 2; ++bj) xr[m][bj] = *(const u32x4*)(xsrc + (size_t)(row0 + ai * HALF + m * 16) * 1024 + col0 + bj * HALF);
#pragma unroll
            for (int m = m0_; m < m0_ + 2; ++m) { const size_t off = (size_t)(row0 + ai * HALF + m * 16) * 1024 + col0; float ss = 0.f;
#pragma unroll
                for (int bj = 0; bj < 2; ++bj) { const u32x4 r = xr[m][bj];
                    const f32x4 x0 = (f32x4){bflo(r.x), bfhi(r.x), bflo(r.y), bfhi(r.y)}, x1 = (f32x4){bflo(r.z), bfhi(r.z), bflo(r.w), bfhi(r.w)};
                    const f32x4 y0 = x0 + gv[bj][0] * acc[ai][bj][m][0], y1 = x1 + gv[bj][1] * acc[ai][bj][m][1];
                    u32x4 w; w.x = cvt_pk_bf16(y0[0], y0[1]); w.y = cvt_pk_bf16(y0[2], y0[3]); w.z = cvt_pk_bf16(y1[0], y1[1]); w.w = cvt_pk_bf16(y1[2], y1[3]);
                    *(u32x4*)(xdst + off + bj * HALF) = w;
                    if (DOXS) { const f32x4 a = y0 * wv[bj][0], c = y1 * wv[bj][1];
                        u32x4 v; v.x = cvt_pk_bf16(a[0], a[1]); v.y = cvt_pk_bf16(a[2], a[3]); v.z = cvt_pk_bf16(c[0], c[1]); v.w = cvt_pk_bf16(c[2], c[3]);
                        *(u32x4*)(XS + off + bj * HALF) = v;
                        ss += ((y0.x * y0.x + y0.y * y0.y) + (y0.z * y0.z + y0.w * y0.w)) + ((y1.x * y1.x + y1.y * y1.y) + (y1.z * y1.z + y1.w * y1.w)); } }
                ssv[ai][m] = ss; }
            asm volatile("" ::: "memory"); }
        if (DOXS) { float t1[2][4];
#pragma unroll
            for (int ai = 0; ai < 2; ++ai)
#pragma unroll
                for (int m = 0; m < 4; ++m) t1[ai][m] = __shfl_xor(ssv[ai][m], 16);
#pragma unroll
            for (int ai = 0; ai < 2; ++ai)
#pragma unroll
                for (int m = 0; m < 4; ++m) { ssv[ai][m] += t1[ai][m]; t1[ai][m] = __shfl_xor(ssv[ai][m], 32); }
            if (fq == 0) {
#pragma unroll
                for (int ai = 0; ai < 2; ++ai)
#pragma unroll
                    for (int m = 0; m < 4; ++m) RSP[(size_t)(row0 + ai * HALF + m * 16) * 16 + u.pn * 4 + wc] = ssv[ai][m] + t1[ai][m]; } }
    }
    __device__ __forceinline__ void operator()(const f32x4 (&acc)[2][2][4][2], const Unit& u, int wr, int wc, int fr, int fq) const {
        if (!MAYSKIP || doxs) body<true>(acc, u, wr, wc, fr, fq); else body<false>(acc, u, wr, wc, fr, fq);
    }
};
}

#define RLX_AGENT __ATOMIC_RELAXED, __HIP_MEMORY_SCOPE_AGENT
#define XB_TMO      128
#define XB_XCNT(j)  (256  + 64 * (j))
#define XB_XSUB(j)  (1280 + 64 * (j))
#define XB_XGEN(j)  (2304 + 64 * (j))
#define XB_TOP      3328
#define XB_TOPGEN   3392
#define XCD_BAR_WORDS 3456
#define XB_SPIN_CAP (1u << 24)

__device__ __forceinline__ unsigned xb_ld(unsigned* p)              { return __hip_atomic_load(p, __ATOMIC_RELAXED, __HIP_MEMORY_SCOPE_AGENT); }
__device__ __forceinline__ unsigned xb_add(unsigned* p, unsigned v) { return __hip_atomic_fetch_add(p, v, __ATOMIC_RELAXED, __HIP_MEMORY_SCOPE_AGENT); }
__device__ __forceinline__ unsigned xb_xcc_id() { return (unsigned)__builtin_amdgcn_s_getreg((3 << 11) | 20) & 0xFu; }
#define XB_SPIN(cond, bar) do { unsigned _sp = 0; while (cond) { __builtin_amdgcn_s_sleep(1); \
    if ((++_sp & 255u) == 0u) { if (xb_ld(&(bar)[XB_TMO])) break; if (_sp > XB_SPIN_CAP) { atomicAdd(&(bar)[XB_TMO], 1u); break; } } } } while (0)

struct XcdBarrier {
    unsigned* bar; unsigned x;
    volatile LAS unsigned* st;
};

__device__ __forceinline__ XcdBarrier xcd_barrier_post(unsigned* bar, volatile LAS unsigned* st) {
    XcdBarrier b; b.bar = bar; b.x = xb_xcc_id(); b.st = st;
    if (threadIdx.x == 0) (void)xb_add(&bar[XB_XCNT(b.x)], 1u);
    return b;
}
__device__ __forceinline__ void xcd_barrier_complete(unsigned* bar, unsigned x, unsigned& nloc, unsigned& nx) {
    const unsigned G = gridDim.x * gridDim.y * gridDim.z;
    unsigned sum, cnt, mine, sp = 0u;
    for (;;) {
        sum = 0u; cnt = 0u; mine = 0u;
#pragma unroll
        for (unsigned j = 0; j < 16; ++j) { const unsigned c = xb_ld(&bar[XB_XCNT(j)]); sum += c; cnt += (c > 0u) ? 1u : 0u; mine = (j == x) ? c : mine; }
        if (sum == G) break;
        __builtin_amdgcn_s_sleep(1);
        if ((++sp & 255u) == 0u) { if (xb_ld(&bar[XB_TMO])) break; if (sp > XB_SPIN_CAP) { atomicAdd(&bar[XB_TMO], 1u); break; } }
    }
    nloc = mine > 0u ? mine : 1u; nx = cnt > 0u ? cnt : 1u;
}

__device__ __forceinline__ void xcd_barrier(const XcdBarrier& b) {
    asm volatile("s_waitcnt vmcnt(0)" ::: "memory");
    __syncthreads();
    if (threadIdx.x == 0) {
        unsigned* bar = b.bar;
        __builtin_amdgcn_s_waitcnt(0);
        unsigned nloc = b.st[0], nx = b.st[1];
        if (nloc == 0u) { xcd_barrier_complete(bar, b.x, nloc, nx); b.st[0] = nloc; b.st[1] = nx; }
        const unsigned old = xb_add(&bar[XB_XSUB(b.x)], 1u);
        const unsigned gen = old / nloc;
        if (old + 1u == (gen + 1u) * nloc) {
            __builtin_amdgcn_fence(__ATOMIC_RELEASE, "agent");
            asm volatile("s_waitcnt vmcnt(0)" ::: "memory");
            const unsigned og = xb_add(&bar[XB_TOP], 1u);
            const unsigned tg = og / nx;
            if (og + 1u == (tg + 1u) * nx) xb_add(&bar[XB_TOPGEN], 1u);
            else XB_SPIN(xb_ld(&bar[XB_TOPGEN]) == tg, bar);
            __builtin_amdgcn_fence(__ATOMIC_ACQUIRE, "agent");
            xb_add(&bar[XB_XGEN(b.x)], 1u);
            asm volatile("s_waitcnt vmcnt(0)" ::: "memory");
        } else {
            XB_SPIN(xb_ld(&bar[XB_XGEN(b.x)]) == gen, bar);
            __builtin_amdgcn_fence(__ATOMIC_ACQUIRE, "agent");
            asm volatile("s_waitcnt vmcnt(0)" ::: "memory");
        }
    }
    __syncthreads();
}

#ifndef PH_MASK
#define PH_MASK 0xFFFFF
#endif
#define EN(b) if constexpr ((PH_MASK >> (b)) & 1)
#ifndef DUP_MASK
#define DUP_MASK 0
#endif
#define DUP(b) if constexpr ((DUP_MASK >> (b)) & 1)
#define DBG_DIGEST_N 256
#define DBG_DIGEST_VAL(m, c) bf2f(((const bf16*)(wsp + WS_CAT))[(size_t)(m) * DM + 768 + (c)])
#ifndef DBG_PH_HI
#define DBG_PH_HI NPHASE
#endif
#ifndef MK_MULTI
#define MK_MULTI 0
#endif
constexpr int LDS_BYTES = 151552, MISC_OFF = 131072 + 320;
#ifndef DBG_LAYERS
#define DBG_LAYERS 4
#define DBG_L0 0
#endif
constexpr int NPHASE = 3 + 7 * DBG_LAYERS;
__global__ void __launch_bounds__(512, 2) hymba_fwd(Args a) {
    extern __shared__ __attribute__((aligned(16))) unsigned char lds[];
    Ctx F0;
    Ctx& F = F0;
    F.lds = (char*)lds; F.tid = threadIdx.x; F.lane = F.tid & 63; F.wave = __builtin_amdgcn_readfirstlane(F.tid >> 6); F.G = gridDim.x; F.bid = blockIdx.x;
    F.A = nullptr; F.ws = a.ws;
    if (F.tid < 29) ((unsigned long long*)(lds + PTR_OFF))[F.tid] = F.tid < 28 ? (unsigned long long)a.in[F.tid] : (unsigned long long)a.out;
    volatile LAS unsigned* MISC = (volatile LAS unsigned*)((LAS unsigned char*)lds + MISC_OFF);
    if (F.tid < 32) MISC[F.tid] = 0u;
    __syncthreads();
    unsigned* ctl = (unsigned*)(a.ws + WS_CTL);
    XcdBarrier bar; bar.bar = ctl + CW_BAR; bar.x = 0; bar.st = nullptr;
    if (!MK_MULTI) bar = xcd_barrier_post(ctl + CW_BAR, MISC + 8);
    const int lo = a.ph_lo, hi = a.ph_hi;
    int ph = 0;
#define PH_BEGIN if (lo <= ph && ph < hi) { Ctx F = F0; unsigned long long wsl_ = (unsigned long long)F0.ws; asm volatile("" : "+v"(F.tid), "+s"(F.bid), "+s"(F.G), "+s"(wsl_)); F.ws = (unsigned char*)(__attribute__((address_space(1))) unsigned char*)wsl_; F.lane = F.tid & 63; F.wave = __builtin_amdgcn_readfirstlane(F.tid >> 6); unsigned char* const wsp = F.ws; (void)wsp;
#define PH_END   if (!MK_MULTI && ph + 1 < hi) { XcdBarrier bb = bar; asm volatile("" : "+s"(bb.bar), "+s"(bb.x)); xcd_barrier(bb); } else __syncthreads(); } ++ph;
    PG8_LAS unsigned char* glds = (PG8_LAS unsigned char*)lds;
#define XN ((bf16*)(wsp + WS_XN))
#define PROJ ((bf16*)(wsp + WS_PROJ))
#define CAT ((bf16*)(wsp + WS_CAT))
#define HB ((bf16*)(wsp + WS_HB))
    PH_BEGIN EN(0) ph_prologue(F); DUP(0) { __syncthreads(); ph_prologue(F); } PH_END
    PH_BEGIN EN(1) { ph_shw(F); ph_xs0(F, PIN(F, I_X), PIN(F, I_N1W) + DBG_L0 * DM, (const float*)(wsp + WS_MOD) + (size_t)DBG_L0 * BATCH * NADA, DM, XN, (float*)(wsp + WS_RSP), (bf16*)POUT(F)); } PH_END
    for (int l_ = 0; l_ < DBG_LAYERS; ++l_) { const int l = l_ + DBG_L0;
        #define modl ((const float*)(wsp + WS_MOD) + (size_t)l * BATCH * NADA)
        #define xsrc (l_ == 0 ? PIN(F, I_X) : (const float*)POUT(F))
        PH_BEGIN
#if defined(PROBE_GA)
            { pg8::Gemm g{XN, (const bf16*)(wsp + WS_WIN) + (size_t)l * NPROJ * DM, MTOK, NPROJ, DM}; pg8::StaticOrder S; S.init(MTOK, NPROJ, F.G, F.bid);
            pg8::EpiRoute<0> E{PROJ, NPROJ, PROJ, NPROJ, 1 << 20};
            pg8::gemm_phase<pg8::EpiRoute<0>, pg8::StaticOrder, true, true>(glds, g, S, E, F.tid); } __syncthreads();
#elif defined(PROBE_GB)
            { pg8::Gemm g{XN, (const bf16*)(wsp + WS_WIN) + (size_t)l * NPROJ * DM, MTOK, NPROJ, DM}; pg8::StaticOrder S; S.init(MTOK, NPROJ, F.G, F.bid);
            pg8::EpiRouteN<0> E{PROJ, NPROJ, (const float*)(wsp + WS_RSP), (const float*)(wsp + WS_SHW) + (size_t)l * BATCH * NSHW, glds};
            pg8::gemm_phase<pg8::EpiRouteN<0>, pg8::StaticOrder, true, true>(glds, g, S, E, F.tid); } __syncthreads();
#endif
        EN(2) { pg8::Gemm g{XN, (const bf16*)(wsp + WS_WIN) + (size_t)l * NPROJ * DM, MTOK, NPROJ, DM}; pg8::StaticOrder S; S.init(MTOK, NPROJ, F.G, F.bid);
            pg8::EpiRouteN<0> E{PROJ, NPROJ, (const float*)(wsp + WS_RSP), (const float*)(wsp + WS_SHW) + (size_t)l * BATCH * NSHW, glds};
            pg8::gemm_phase<pg8::EpiRouteN<0>, pg8::StaticOrder, true, true>(glds, g, S, E, F.tid); } PH_END
        PH_BEGIN EN(3) ph_prep(F, l); DUP(3) ph_prep(F, l); EN(4) ph_lru1(F, l); DUP(4) ph_lru1(F, l); EN(5) ph_mlstm(F, l); DUP(5) ph_mlstm(F, l); PH_END
        PH_BEGIN EN(6) { ph_carry(F); pg8::Gemm g{(const bf16*)(wsp + WS_QL), (const bf16*)(wsp + WS_WQC) + (size_t)l * 768 * 256, MTOK, 768, 256}; pg8::StaticOrder S; S.init(MTOK, 768, F.G, F.bid);
            pg8::EpiRoute<0> E{(bf16*)(wsp + WS_QABS), 512, (bf16*)(wsp + WS_QIDX), 256, 2};
            pg8::gemm_phase<pg8::EpiRoute<0>, pg8::StaticOrder, true, true>(glds, g, S, E, F.tid); } PH_END
#ifndef DSA_REP
#define DSA_REP 1
#endif
        PH_BEGIN EN(7) { for (int rep_ = 0; rep_ < DSA_REP; ++rep_) { ph_dsa(F, l); if (DSA_REP > 1) __syncthreads(); } } DUP(7) ph_dsa(F, l); EN(8) ph_lru2(F, l); DUP(8) ph_lru2(F, l); EN(9) ph_mfin(F, l); DUP(9) ph_mfin(F, l); PH_END
        PH_BEGIN EN(10) { pg8::Gemm g{CAT, (const bf16*)(wsp + WS_WO) + (size_t)l * DM * DM, MTOK, DM, DM}; pg8::StaticOrder S; S.init(MTOK, DM, F.G, F.bid);
            pg8::EpiResidXS<false> E{(const pg8::bf16_t*)POUT(F), (pg8::bf16_t*)POUT(F), modl + 2 * DM, (const float*)(wsp + WS_WP) + (size_t)(l * 2 + 1) * BATCH * DM, XN, (float*)(wsp + WS_RSP), 1};
            pg8::gemm_phase<pg8::EpiResidXS<false>, pg8::StaticOrder, true, true>(glds, g, S, E, F.tid); } PH_END
        PH_BEGIN EN(12) { pg8::Gemm g{XN, (const bf16*)(wsp + WS_W1) + (size_t)l * DFF * DM, MTOK, DFF, DM}; pg8::StaticOrder S; S.init(MTOK, DFF, F.G, F.bid);
            pg8::EpiRouteN<1> E{HB, DFF, (const float*)(wsp + WS_RSP), (const float*)(wsp + WS_SHW) + (size_t)l * BATCH * NSHW + NPROJ, glds};
            pg8::gemm_phase<pg8::EpiRouteN<1>, pg8::StaticOrder, true, true>(glds, g, S, E, F.tid); } PH_END
        PH_BEGIN EN(13) { pg8::Gemm g{HB, (const bf16*)(wsp + WS_W2) + (size_t)l * DM * DFF, MTOK, DM, DFF}; pg8::StaticOrder S; S.init(MTOK, DM, F.G, F.bid);
            const int nl = l + 1 < DEPTH ? l + 1 : l;
            const bool lastl = l_ + 1 >= DBG_LAYERS;
            pg8::EpiResidXS<true> E{(const pg8::bf16_t*)POUT(F), lastl ? (pg8::bf16_t*)XN : (pg8::bf16_t*)POUT(F), modl + 5 * DM, (const float*)(wsp + WS_WP) + (size_t)(nl * 2) * BATCH * DM, XN, (float*)(wsp + WS_RSP), lastl ? 0 : 1};
            pg8::gemm_phase<pg8::EpiResidXS<true>, pg8::StaticOrder, true, true>(glds, g, S, E, F.tid); } PH_END
    }
#ifdef DBG_DIGEST
    PH_BEGIN { const int gw = F.bid * 8 + F.wave, NGW = F.G * 8; float* o = POUT(F);
        for (int m = gw; m < MTOK; m += NGW) for (int j = 0; j < 16; ++j) { const int c = F.lane + 64 * j; float v = 0.f;
            if (c < DBG_DIGEST_N) { v = DBG_DIGEST_VAL(m, c) * 4096.0f; v = v - floorf(v); }
            o[(size_t)m * DM + c] = v; } } PH_END
#else
    PH_BEGIN EN(14) ph_finalnorm16(F, XN, PIN(F, I_FNW), POUT(F)); PH_END
#endif
}

extern "C" void kernel_launch(void* const* d_in, const int* in_sizes, int n_in, void* d_out, int out_size, void* d_ws, size_t ws_size, hipStream_t stream) {
    static int grid = 0;
    if (grid == 0) {
        if (n_in != 28 || in_sizes[0] != MTOK * DM || out_size != MTOK * DM || ws_size < WS_END) { fprintf(stderr, "kernel_launch: unexpected shapes (n_in %d, in0 %d, out %d, ws %zu)\n", n_in, n_in > 0 ? in_sizes[0] : -1, out_size, ws_size); grid = -1; return; }
        int dev = 0, cus = 0, per_cu = 0;
        if (hipGetDevice(&dev) != hipSuccess || hipDeviceGetAttribute(&cus, hipDeviceAttributeMultiprocessorCount, dev) != hipSuccess) { grid = -1; return; }
        if (hipFuncSetAttribute((const void*)hymba_fwd, hipFuncAttributeMaxDynamicSharedMemorySize, LDS_BYTES) != hipSuccess) { fprintf(stderr, "kernel_launch: hipFuncSetAttribute failed\n"); grid = -1; return; }
        if (hipOccupancyMaxActiveBlocksPerMultiprocessor(&per_cu, (const void*)hymba_fwd, 512, LDS_BYTES) != hipSuccess || per_cu < 1) { fprintf(stderr, "kernel_launch: occupancy query says %d\n", per_cu); }
        (void)hipGetLastError();
        grid = cus;
    }
    if (grid < 0) return;
    if (hipMemsetAsync((char*)d_ws + WS_CTL, 0, CTL_ZERO_BYTES, stream) != hipSuccess) return;
    Args a{};
    for (int i = 0; i < 28; ++i) a.in[i] = (const float*)d_in[i];
    a.out = (float*)d_out; a.ws = (unsigned char*)d_ws;
#if MK_MULTI
    for (int p = 0; p < NPHASE; ++p) { a.ph_lo = p; a.ph_hi = p + 1; hipLaunchKernelGGL(hymba_fwd, dim3(grid), dim3(512), LDS_BYTES, stream, a); }
#else
    a.ph_lo = 0; a.ph_hi = DBG_PH_HI; hipLaunchKernelGGL(hymba_fwd, dim3(grid), dim3(512), LDS_BYTES, stream, a);
#endif
}
#endif
```

```cpp
#ifndef HOST_EMU
#include <hip/hip_runtime.h>
#include <cstdio>
#include <cstdint>
#define DEV __device__ __forceinline__
#define LAS __attribute__((address_space(3)))
#else
#include "emu.h"
#endif

#ifndef HOST_EMU
#define SYNC() __syncthreads()
#define KEEP4(a, b, c, d) asm volatile("" :: "v"(a), "v"(b), "v"(c), "v"(d))
#define LAUNDER_V(x) asm volatile("" : "+v"(x))
#define WAVE_LDS_FENCE() asm volatile("s_waitcnt lgkmcnt(0)" ::: "memory")
template <class T> DEV T SHFL(T v, int s) { return __shfl(v, s); }
template <class T> DEV T SHFL_XOR(T v, int m) { return __shfl_xor(v, m); }
template <class T> DEV T SHFL_UP(T v, int d) { return __shfl_up(v, d); }
template <class T> DEV T SHFL_DOWN(T v, int d) { return __shfl_down(v, d); }
typedef short bf16x8_ __attribute__((ext_vector_type(8)));
typedef float f32x4_ __attribute__((ext_vector_type(4)));
typedef short v4i16_t __attribute__((ext_vector_type(4)));
DEV f32x4_ MFMA16(bf16x8_ a, bf16x8_ b, f32x4_ c) { return __builtin_amdgcn_mfma_f32_16x16x32_bf16(a, b, c, 0, 0, 0); }
DEV v4i16_t TR16(const void* p) { return __builtin_amdgcn_ds_read_tr16_b64_v4i16((LAS v4i16_t*)(p)); }
#endif


typedef unsigned short bf16;
typedef short bf16x8 __attribute__((ext_vector_type(8)));
typedef short s16x4 __attribute__((ext_vector_type(4)));
typedef float f32x4 __attribute__((ext_vector_type(4)));
typedef unsigned u32x4 __attribute__((ext_vector_type(4)));
typedef unsigned u32x2 __attribute__((ext_vector_type(2)));

constexpr int BATCH = 16, SEQ = 4096, DM = 1024, DEPTH = 4, MTOK = BATCH * SEQ;
constexpr int NPROJ = 3072, DFF = 4096, NADA = 6 * DM;
constexpr int PC_LX = 0, PC_LY = 256, PC_MQ = 512, PC_MK = 1024, PC_MV = 1536, PC_MO = 2048, PC_AQ = 2560, PC_AKV = 2816, PC_IK = 2944, PC_IW = 2976, PC_MI = 2984, PC_MF = 2988;
constexpr float NORM_EPS = 1e-6f;

constexpr size_t MiB = 1u << 20;
constexpr size_t WS_CTL = 0, CTL_ZERO_BYTES = 1 * MiB;
constexpr size_t WS_MOD = 1 * MiB;
constexpr size_t WS_WQC = 3 * MiB;
constexpr size_t WS_WG = 5 * MiB;
constexpr size_t WS_WUVT = 6 * MiB;
constexpr size_t WS_WIN = 8 * MiB;
constexpr size_t WS_WO = 32 * MiB;
constexpr size_t WS_W1 = 40 * MiB;
constexpr size_t WS_W2 = 72 * MiB;
constexpr size_t WS_XN = 104 * MiB;
constexpr size_t WS_QL = WS_XN, WS_CKV = WS_XN + 32 * MiB, WS_QIDX = WS_XN + 48 * MiB, WS_KIDX = WS_XN + 80 * MiB, WS_WI = WS_XN + 84 * MiB, WS_GT = WS_XN + 86 * MiB;
constexpr size_t WS_CAT = 232 * MiB;
constexpr size_t WS_PROJ = 360 * MiB;
constexpr size_t WS_HB = 360 * MiB;
constexpr size_t WS_QABS = 744 * MiB;
constexpr size_t WS_HLOC = 808 * MiB, WS_CPA = 840 * MiB;
constexpr size_t WS_LSUM = 872 * MiB;
constexpr size_t WS_HM = 874 * MiB;
constexpr size_t WS_MG = 940 * MiB;
constexpr size_t WS_WP = 2 * MiB + 512 * 1024;
constexpr size_t WS_SHW = 6 * MiB + 256 * 1024;
constexpr size_t WS_RSP = 1000 * MiB;
constexpr size_t WS_CARRY = 948 * MiB;
constexpr size_t WS_SCR2 = 949 * MiB;
constexpr int NSHW = NPROJ + DFF;
constexpr size_t WS_END = 1024 * MiB;
static_assert(WS_HM + (size_t)MTOK * 512 * 2 <= WS_END && WS_HB + (size_t)MTOK * DFF * 2 <= WS_HLOC + 64 * MiB, "ws map");

constexpr int CW_TMO = 0, CW_BAR = 4096;

#ifndef HOST_EMU
typedef __bf16 hwbf2_t __attribute__((ext_vector_type(2)));
typedef float hwf2_t __attribute__((ext_vector_type(2)));
DEV unsigned f2bf(float f) { return (unsigned)__builtin_bit_cast(unsigned short, (__bf16)f); }
DEV unsigned pk2(float lo, float hi) { const hwf2_t v = {lo, hi}; return __builtin_bit_cast(unsigned, __builtin_convertvector(v, hwbf2_t)); }
#else
DEV unsigned f2bf(float f) { unsigned u = __builtin_bit_cast(unsigned, f); return (u + 0x7fffu + ((u >> 16) & 1u)) >> 16; }
DEV unsigned pk2(float lo, float hi) { return f2bf(lo) | (f2bf(hi) << 16); }
#endif
DEV float bf2f(unsigned h) { return __builtin_bit_cast(float, h << 16); }
DEV float bflo(unsigned w) { return __builtin_bit_cast(float, w << 16); }
DEV float bfhi(unsigned w) { return __builtin_bit_cast(float, w & 0xffff0000u); }
DEV float wave_sum(float v) {
#pragma unroll
    for (int o = 1; o < 64; o <<= 1) v += SHFL_XOR(v, o);
    return v;
}
#ifndef HOST_EMU
DEV float FEXP(float x) { return __expf(x); }
DEV float FEXP2(float x) { return __builtin_amdgcn_exp2f(x); }
DEV float FRCP(float x) { return __builtin_amdgcn_rcpf(x); }
DEV float FSQRT(float x) { return __builtin_amdgcn_sqrtf(x); }
DEV float RSQ(float x) { return __builtin_amdgcn_rsqf(x); }
DEV float FLOG(float x) { return __logf(x); }
#else
DEV float FEXP(float x) { return expf(x); }
DEV float FEXP2(float x) { return exp2f(x); }
DEV float FRCP(float x) { return 1.0f / x; }
DEV float FSQRT(float x) { return sqrtf(x); }
DEV float RSQ(float x) { return 1.0f / sqrtf(x); }
DEV float FLOG(float x) { return logf(x); }
#endif
#ifndef HOST_EMU
DEV int UNI(int x) { return __builtin_amdgcn_readfirstlane(x); }
#else
DEV int UNI(int x) { return x; }
#endif
#ifndef HOST_EMU
#define GAS __attribute__((address_space(1)))
DEV const GAS char* UNIP(const void* p) { const unsigned long long v = (unsigned long long)p; const unsigned lo = __builtin_amdgcn_readfirstlane((unsigned)v), hi = __builtin_amdgcn_readfirstlane((unsigned)(v >> 32));
    return (const GAS char*)(((unsigned long long)hi << 32) | lo); }
#else
#define GAS
DEV const char* UNIP(const void* p) { return (const char*)p; }
#endif
DEV float RELU(float x) { const int b = __builtin_bit_cast(int, x); return __builtin_bit_cast(float, b > 0 ? b : 0); }
DEV float sigmoidf_(float z) { return 1.0f / (1.0f + expf(-z)); }
DEV float fsigmoid(float z) { return FRCP(1.0f + FEXP(-z)); }
DEV float one_minus_exp(float x) {
    const float s = -x * (1.0f + x * (0.5f + x * (0.16666667f + x * 0.041666668f)));
    return x > -0.05f ? s : 1.0f - FEXP(x);
}

struct Args { const float* in[28]; float* out; unsigned char* ws; int ph_lo, ph_hi; };
struct Ctx {
    char* lds; int tid, lane, wave, G, bid;
    const Args* A;
    unsigned char* ws;
};

constexpr int PTR_OFF = 131072 + 512;
#ifndef HOST_EMU
DEV const float* PIN(const Ctx& F, int i) { const unsigned long long v = ((const unsigned long long*)(F.lds + PTR_OFF))[i];
    const unsigned lo = __builtin_amdgcn_readfirstlane((unsigned)v), hi = __builtin_amdgcn_readfirstlane((unsigned)(v >> 32)); return (const float*)(const __attribute__((address_space(1))) float*)(((unsigned long long)hi << 32) | lo); }
DEV float* POUT(const Ctx& F) { return (float*)PIN(F, 28); }
#else
DEV const float* PIN(const Ctx& F, int i) { return F.A->in[i]; }
DEV float* POUT(const Ctx& F) { return POUT(F); }
#endif
enum { I_X = 0, I_C, I_WIN, I_CONVW, I_CONVB, I_WA, I_BA, I_WX, I_BX, I_LAM, I_BI, I_BF, I_WQUP, I_WQIDX, I_WUK, I_WUV, I_QNW, I_KVNW, I_RELB, I_GNW, I_WO, I_WADA, I_BADA, I_N1W, I_N2W, I_W1, I_W2, I_FNW };

DEV int win_srccol(int n) {
    if (n < 2560) return n;
    if (n < PC_AKV) return 2568 + (n - PC_AQ);
    if (n < PC_IK) return 2824 + (n - PC_AKV);
    if (n < PC_IW) return 2952 + (n - PC_IK);
    if (n < PC_MI) return 2984 + (n - PC_IW);
    if (n < PC_MF) return 2560 + (n - PC_MI);
    if (n < 2992) return 2564 + (n - PC_MF);
    return -1;
}
template <bool MAPPED>
DEV void p0_transpose_item(const float* W, int K, int N, int NT, bf16* WT, float* scr, int item, int lane) {
    const int nblk = NT / 32, kb = item / nblk, nb = item % nblk, k0 = 64 * kb, n0 = 32 * nb;
    int sc = n0 + (lane & 31); if (MAPPED) sc = win_srccol(sc);
#pragma unroll 8
    for (int i = 0; i < 32; ++i) { const int kk = 2 * i + (lane >> 5); const float v = W[(size_t)(k0 + kk) * N + (sc >= 0 ? sc : 0)]; scr[kk * 33 + (lane & 31)] = sc >= 0 ? v : 0.f; }
    WAVE_LDS_FENCE();
    const int c = lane & 7;
#pragma unroll
    for (int j = 0; j < 4; ++j) { const int n = (lane >> 3) + 8 * j; const float* s = scr + (8 * c) * 33 + n;
        u32x4 o; o.x = pk2(s[0 * 33], s[1 * 33]); o.y = pk2(s[2 * 33], s[3 * 33]); o.z = pk2(s[4 * 33], s[5 * 33]); o.w = pk2(s[6 * 33], s[7 * 33]);
        *(u32x4*)(WT + (size_t)(n0 + n) * K + k0 + 8 * c) = o; }
    WAVE_LDS_FENCE();
}

DEV void ph_prologue(const Ctx& F) {
    const int gt = F.bid * 512 + F.tid, NGT = F.G * 512;
    float* CACT = (float*)F.lds;
    for (int i = F.tid; i < BATCH * DM; i += 512) { const float cv = PIN(F, I_C)[i]; CACT[i] = cv * sigmoidf_(cv); }
    SYNC();
    for (int e = gt; e < DEPTH * NADA * 4; e += NGT) {
        const int j = e % NADA, bq = (e / NADA) & 3, l = e / (NADA * 4);
        const float* w = PIN(F, I_WADA) + (size_t)l * DM * NADA + j;
        const float* c = CACT + bq * 4 * DM;
        float a0 = 0.f, a1 = 0.f, a2 = 0.f, a3 = 0.f;
#pragma unroll 8
        for (int k = 0; k < DM; k += 4) {
            const float w0 = w[(size_t)k * NADA], w1 = w[(size_t)(k + 1) * NADA], w2 = w[(size_t)(k + 2) * NADA], w3 = w[(size_t)(k + 3) * NADA];
            const f32x4 c0 = *(const f32x4*)(c + k), c1 = *(const f32x4*)(c + DM + k), c2 = *(const f32x4*)(c + 2 * DM + k), c3 = *(const f32x4*)(c + 3 * DM + k);
            a0 += (c0.x * w0 + c0.y * w1) + (c0.z * w2 + c0.w * w3); a1 += (c1.x * w0 + c1.y * w1) + (c1.z * w2 + c1.w * w3);
            a2 += (c2.x * w0 + c2.y * w1) + (c2.z * w2 + c2.w * w3); a3 += (c3.x * w0 + c3.y * w1) + (c3.z * w2 + c3.w * w3); }
        const float bb = PIN(F, I_BADA)[(size_t)l * NADA + j];
        float* mo = (float*)(F.ws + WS_MOD) + ((size_t)l * BATCH + bq * 4) * NADA + j;
        mo[0] = a0 + bb; mo[NADA] = a1 + bb; mo[2 * NADA] = a2 + bb; mo[3 * NADA] = a3 + bb;
    }
    for (int e = gt; e < DEPTH * 2 * 4 * 64 * 64; e += NGT) {
        const int i = e & 63, j = (e >> 6) & 63, blk = (e >> 12) & 3, g = (e >> 14) & 1, l = e >> 15;
        const float* src = PIN(F, g ? I_WX : I_WA) + (((size_t)l * 4 + blk) * 64 + i) * 64 + j;
        ((bf16*)(F.ws + WS_WG))[e] = (bf16)f2bf(*src);
    }
    for (int e = gt; e < DEPTH * 4 * 64 * 128; e += NGT) {
        const int r = e & 127, d = (e >> 7) & 63, h = (e >> 13) & 3, l = e >> 15;
        ((bf16*)(F.ws + WS_WUVT))[e] = (bf16)f2bf(PIN(F, I_WUV)[(((size_t)l * 128 + r) * 4 + h) * 64 + d]);
    }
    for (int e = gt; e < DEPTH * 768 * 256; e += NGT) {
        const int r = e & 255, n = (e >> 8) % 768, l = e / (768 * 256);
        float v;
        if (n < 512) { const int h = n >> 7, c = n & 127; const f32x4* q = (const f32x4*)(PIN(F, I_WQUP) + ((size_t)l * 256 + r) * 256 + h * 64); const f32x4* k = (const f32x4*)(PIN(F, I_WUK) + ((size_t)l * 128 + c) * 256 + h * 64);
            float s = 0.f;
#pragma unroll
            for (int d = 0; d < 16; ++d) { const f32x4 a = q[d], bq4 = k[d]; s += (a.x * bq4.x + a.y * bq4.y) + (a.z * bq4.z + a.w * bq4.w); }
            v = s * (0.125f * 1.4426950408889634f); }
        else v = PIN(F, I_WQIDX)[((size_t)l * 256 + r) * 256 + (n - 512)] * 0.17677669529663687f;
        ((bf16*)(F.ws + WS_WQC))[e] = (bf16)f2bf(v);
    }
    SYNC();
    float* scr = (float*)(F.lds + F.wave * 16384);
    const int gw = F.bid * 8 + F.wave, NGW = F.G * 8;
    constexpr int I_IN = (DM / 64) * (NPROJ / 32), I_O = (DM / 64) * (DM / 32), I_1 = (DM / 64) * (DFF / 32), I_2 = (DFF / 64) * (DM / 32);
    constexpr int PER_L = I_IN + I_O + I_1 + I_2;
    for (int it = gw; it < DEPTH * PER_L; it += NGW) {
        const int l = it / PER_L; int r = it % PER_L;
        if (r < I_IN) { p0_transpose_item<true>(PIN(F, I_WIN) + (size_t)l * DM * 2992, DM, 2992, NPROJ, (bf16*)(F.ws + WS_WIN) + (size_t)l * NPROJ * DM, scr, r, F.lane); continue; } r -= I_IN;
        if (r < I_O) { p0_transpose_item<false>(PIN(F, I_WO) + (size_t)l * DM * DM, DM, DM, DM, (bf16*)(F.ws + WS_WO) + (size_t)l * DM * DM, scr, r, F.lane); continue; } r -= I_O;
        if (r < I_1) { p0_transpose_item<false>(PIN(F, I_W1) + (size_t)l * DM * DFF, DM, DFF, DFF, (bf16*)(F.ws + WS_W1) + (size_t)l * DFF * DM, scr, r, F.lane); continue; } r -= I_1;
        p0_transpose_item<false>(PIN(F, I_W2) + (size_t)l * DFF * DM, DFF, DM, DM, (bf16*)(F.ws + WS_W2) + (size_t)l * DM * DFF, scr, r, F.lane);
    }
}

DEV void ph_xs0(const Ctx& F, const float* xsrc, const float* nw, const float* modl, int sc_off, bf16* XS, float* RSP, bf16* X16) {
    const int gw = F.bid * 8 + F.wave, NGW = F.G * 8;
    f32x4 wv[4];
#pragma unroll
    for (int j = 0; j < 4; ++j) wv[j] = *(const f32x4*)(nw + 4 * F.lane + 256 * j);
    f32x4 v[2][4], vn[2][4];
#pragma unroll
    for (int q = 0; q < 2; ++q) { const int m = gw + q * NGW; const f32x4* xr = (const f32x4*)(xsrc + (size_t)(m < MTOK ? m : 0) * DM) + F.lane;
#pragma unroll
        for (int j = 0; j < 4; ++j) v[q][j] = xr[64 * j]; }
    for (int m0 = gw; m0 < MTOK; m0 += 2 * NGW) {
        f32x4 sc[2][4];
#pragma unroll
        for (int q = 0; q < 2; ++q) { const int m = m0 + q * NGW; const float* mb = modl + (size_t)((m < MTOK ? m : 0) >> 12) * NADA + 4 * F.lane;
#pragma unroll
            for (int j = 0; j < 4; ++j) sc[q][j] = *(const f32x4*)(mb + sc_off + 256 * j); }
#pragma unroll
        for (int q = 0; q < 2; ++q) { const int m = m0 + (2 + q) * NGW; const f32x4* xr = (const f32x4*)(xsrc + (size_t)(m < MTOK ? m : 0) * DM) + F.lane;
#pragma unroll
            for (int j = 0; j < 4; ++j) vn[q][j] = xr[64 * j]; }
        float s[2];
#pragma unroll
        for (int q = 0; q < 2; ++q) { float a = 0.f;
#pragma unroll
            for (int j = 0; j < 4; ++j) a += (v[q][j].x * v[q][j].x + v[q][j].y * v[q][j].y) + (v[q][j].z * v[q][j].z + v[q][j].w * v[q][j].w);
            s[q] = a; }
#pragma unroll
        for (int o = 1; o < 64; o <<= 1) { s[0] += SHFL_XOR(s[0], o); s[1] += SHFL_XOR(s[1], o); }
#pragma unroll
        for (int q = 0; q < 2; ++q) { const int m = m0 + q * NGW; if (m >= MTOK) break;
            if (F.lane < 16) RSP[(size_t)m * 16 + F.lane] = F.lane == 0 ? s[q] : 0.f;
            u32x2* o8 = (u32x2*)(XS + (size_t)m * DM) + F.lane; u32x2* x8 = (u32x2*)(X16 + (size_t)m * DM) + F.lane;
#pragma unroll
            for (int j = 0; j < 4; ++j) { const f32x4 y = v[q][j] * (wv[j] * (1.0f + sc[q][j]));
                u32x2 p; p.x = pk2(y.x, y.y); p.y = pk2(y.z, y.w); o8[64 * j] = p;
                u32x2 c; c.x = pk2(v[q][j].x, v[q][j].y); c.y = pk2(v[q][j].z, v[q][j].w); x8[64 * j] = c; } }
#pragma unroll
        for (int q = 0; q < 2; ++q)
#pragma unroll
            for (int j = 0; j < 4; ++j) v[q][j] = vn[q][j];
    }
}
DEV void ph_shw(const Ctx& F) {
    const int gt = F.bid * 512 + F.tid, NGT = F.G * 512;
    for (int e = gt; e < DEPTH * 2 * BATCH * (DM / 4); e += NGT) {
        const int c4 = e & 255, b = (e >> 8) & 15, w = (e >> 12) & 1, l = e >> 13;
        const f32x4 nwv = *(const f32x4*)(PIN(F, w ? I_N2W : I_N1W) + l * DM + 4 * c4);
        const f32x4 sc = *(const f32x4*)((const float*)(F.ws + WS_MOD) + ((size_t)l * BATCH + b) * NADA + (w ? 4 * DM : DM) + 4 * c4);
        ((f32x4*)(F.ws + WS_WP))[e] = nwv * (1.0f + sc);
    }
    const int gw = F.bid * 8 + F.wave, NGW = F.G * 8, i16 = F.lane & 15, kq = 8 * (F.lane >> 4);
    for (int it = gw; it < DEPTH * (NSHW / 16); it += NGW) {
        const int l = it / (NSHW / 16), n0 = (it % (NSHW / 16)) * 16;
        const bool mlp = n0 >= NPROJ;
        const bf16* Wr = mlp ? (const bf16*)(F.ws + WS_W1) + ((size_t)l * DFF + (n0 - NPROJ) + i16) * DM : (const bf16*)(F.ws + WS_WIN) + ((size_t)l * NPROJ + n0 + i16) * DM;
        const float* sh = (const float*)(F.ws + WS_MOD) + ((size_t)l * BATCH + i16) * NADA + (mlp ? 3 * DM : 0);
        f32x4 acc0 = {0.f, 0.f, 0.f, 0.f}, acc1 = {0.f, 0.f, 0.f, 0.f};
#pragma unroll 4
        for (int s = 0; s < DM / 32; ++s) {
            const bf16x8 B = *(const bf16x8*)(Wr + 32 * s + kq);
            const f32x4 a0 = *(const f32x4*)(sh + 32 * s + kq), a1 = *(const f32x4*)(sh + 32 * s + kq + 4);
            bf16x8 Ah, Al;
#pragma unroll
            for (int j = 0; j < 8; ++j) { const float a = j < 4 ? a0[j] : a1[j - 4]; const unsigned h = f2bf(a); Ah[j] = (short)h; Al[j] = (short)f2bf(a - bf2f(h)); }
            acc0 = MFMA16(Ah, B, acc0); acc1 = MFMA16(Al, B, acc1);
        }
        float* o = (float*)(F.ws + WS_SHW) + ((size_t)l * BATCH + 4 * (F.lane >> 4)) * NSHW + n0 + i16;
#pragma unroll
        for (int r = 0; r < 4; ++r) o[(size_t)r * NSHW] = acc0[r] + acc1[r];
    }
}
DEV void ph_normmod(const Ctx& F, const float* xsrc, const float* nw, const float* modl, int sh_off, int sc_off, bf16* XN) {
    const int gw = F.bid * 8 + F.wave, NGW = F.G * 8;
    f32x4 wv[4];
#pragma unroll
    for (int j = 0; j < 4; ++j) wv[j] = *(const f32x4*)(nw + 4 * F.lane + 256 * j);
    f32x4 v[2][4], vn[2][4];
#pragma unroll
    for (int q = 0; q < 2; ++q) { const int m = gw + q * NGW; const f32x4* xr = (const f32x4*)(xsrc + (size_t)(m < MTOK ? m : 0) * DM) + F.lane;
#pragma unroll
        for (int j = 0; j < 4; ++j) v[q][j] = xr[64 * j]; }
    for (int m0 = gw; m0 < MTOK; m0 += 2 * NGW) {
        f32x4 sc[2][4], sh[2][4];
#pragma unroll
        for (int q = 0; q < 2; ++q) { const int m = m0 + q * NGW; const float* mb = modl + (size_t)((m < MTOK ? m : 0) >> 12) * NADA + 4 * F.lane;
#pragma unroll
            for (int j = 0; j < 4; ++j) { sc[q][j] = *(const f32x4*)(mb + sc_off + 256 * j); sh[q][j] = *(const f32x4*)(mb + sh_off + 256 * j); } }
#pragma unroll
        for (int q = 0; q < 2; ++q) { const int m = m0 + (2 + q) * NGW; const f32x4* xr = (const f32x4*)(xsrc + (size_t)(m < MTOK ? m : 0) * DM) + F.lane;
#pragma unroll
            for (int j = 0; j < 4; ++j) vn[q][j] = xr[64 * j]; }
        float s[2];
#pragma unroll
        for (int q = 0; q < 2; ++q) { float a = 0.f;
#pragma unroll
            for (int j = 0; j < 4; ++j) a += (v[q][j].x * v[q][j].x + v[q][j].y * v[q][j].y) + (v[q][j].z * v[q][j].z + v[q][j].w * v[q][j].w);
            s[q] = a; }
#pragma unroll
        for (int o = 1; o < 64; o <<= 1) { s[0] += SHFL_XOR(s[0], o); s[1] += SHFL_XOR(s[1], o); }
#pragma unroll
        for (int q = 0; q < 2; ++q) { const int m = m0 + q * NGW; if (m >= MTOK) break;
            const float rs = RSQ(s[q] * (1.0f / DM) + NORM_EPS);
            u32x2* o8 = (u32x2*)(XN + (size_t)m * DM) + F.lane;
#pragma unroll
            for (int j = 0; j < 4; ++j) { const f32x4 y = v[q][j] * rs * wv[j] * (1.0f + sc[q][j]) + sh[q][j];
                u32x2 p; p.x = pk2(y.x, y.y); p.y = pk2(y.z, y.w); o8[64 * j] = p; } }
#pragma unroll
        for (int q = 0; q < 2; ++q)
#pragma unroll
            for (int j = 0; j < 4; ++j) v[q][j] = vn[q][j];
    }
}
DEV void ph_finalnorm(const Ctx& F, const float* xsrc, const float* nw, float* out) {
    const int gw = F.bid * 8 + F.wave, NGW = F.G * 8;
    f32x4 wv[4];
#pragma unroll
    for (int j = 0; j < 4; ++j) wv[j] = *(const f32x4*)(nw + 4 * F.lane + 256 * j);
    f32x4 v[2][4], vn[2][4];
#pragma unroll
    for (int q = 0; q < 2; ++q) { const int m = gw + q * NGW; const f32x4* xr = (const f32x4*)(xsrc + (size_t)(m < MTOK ? m : 0) * DM) + F.lane;
#pragma unroll
        for (int j = 0; j < 4; ++j) v[q][j] = xr[64 * j]; }
    for (int m0 = gw; m0 < MTOK; m0 += 2 * NGW) {
#pragma unroll
        for (int q = 0; q < 2; ++q) { const int m = m0 + (2 + q) * NGW; const f32x4* xr = (const f32x4*)(xsrc + (size_t)(m < MTOK ? m : 0) * DM) + F.lane;
#pragma unroll
            for (int j = 0; j < 4; ++j) vn[q][j] = xr[64 * j]; }
        float s[2];
#pragma unroll
        for (int q = 0; q < 2; ++q) { float a = 0.f;
#pragma unroll
            for (int j = 0; j < 4; ++j) a += (v[q][j].x * v[q][j].x + v[q][j].y * v[q][j].y) + (v[q][j].z * v[q][j].z + v[q][j].w * v[q][j].w);
            s[q] = a; }
#pragma unroll
        for (int o = 1; o < 64; o <<= 1) { s[0] += SHFL_XOR(s[0], o); s[1] += SHFL_XOR(s[1], o); }
#pragma unroll
        for (int q = 0; q < 2; ++q) { const int m = m0 + q * NGW; if (m >= MTOK) break;
            const float rs = RSQ(s[q] * (1.0f / DM) + NORM_EPS);
            f32x4* o = (f32x4*)(out + (size_t)m * DM) + F.lane;
#pragma unroll
            for (int j = 0; j < 4; ++j) o[64 * j] = v[q][j] * rs * wv[j]; }
#pragma unroll
        for (int q = 0; q < 2; ++q)
#pragma unroll
            for (int j = 0; j < 4; ++j) v[q][j] = vn[q][j];
    }
}
DEV void ph_finalnorm16(const Ctx& F, const bf16* x16, const float* nw, float* out) {
    const int gw = F.bid * 8 + F.wave, NGW = F.G * 8;
    f32x4 wv[2][2];
#pragma unroll
    for (int j = 0; j < 2; ++j) { wv[j][0] = *(const f32x4*)(nw + 8 * F.lane + 512 * j); wv[j][1] = *(const f32x4*)(nw + 8 * F.lane + 512 * j + 4); }
    u32x4 v[4][2], vn[4][2];
#pragma unroll
    for (int q = 0; q < 4; ++q) { const int m = gw + q * NGW; const bf16* xr = x16 + (size_t)(m < MTOK ? m : 0) * DM + 8 * F.lane;
        v[q][0] = *(const u32x4*)xr; v[q][1] = *(const u32x4*)(xr + 512); }
    for (int m0 = gw; m0 < MTOK; m0 += 4 * NGW) {
#pragma unroll
        for (int q = 0; q < 4; ++q) { const int m = m0 + (4 + q) * NGW; const bf16* xr = x16 + (size_t)(m < MTOK ? m : 0) * DM + 8 * F.lane;
            vn[q][0] = *(const u32x4*)xr; vn[q][1] = *(const u32x4*)(xr + 512); }
        float s[4];
#pragma unroll
        for (int q = 0; q < 4; ++q) { float a = 0.f;
#pragma unroll
            for (int j = 0; j < 2; ++j) { const u32x4 r = v[q][j];
                a += ((bflo(r.x) * bflo(r.x) + bfhi(r.x) * bfhi(r.x)) + (bflo(r.y) * bflo(r.y) + bfhi(r.y) * bfhi(r.y))) + ((bflo(r.z) * bflo(r.z) + bfhi(r.z) * bfhi(r.z)) + (bflo(r.w) * bflo(r.w) + bfhi(r.w) * bfhi(r.w))); }
            s[q] = a; }
#pragma unroll
        for (int o = 1; o < 64; o <<= 1) {
#pragma unroll
            for (int q = 0; q < 4; ++q) s[q] += SHFL_XOR(s[q], o); }
#pragma unroll
        for (int q = 0; q < 4; ++q) { const int m = m0 + q * NGW; if (m >= MTOK) break;
            const float rs = RSQ(s[q] * (1.0f / DM) + NORM_EPS);
            float* o = out + (size_t)m * DM + 8 * F.lane;
#pragma unroll
            for (int j = 0; j < 2; ++j) { const u32x4 r = v[q][j];
                *(f32x4*)(o + 512 * j) = (f32x4){bflo(r.x), bfhi(r.x), bflo(r.y), bfhi(r.y)} * rs * wv[j][0];
                *(f32x4*)(o + 512 * j + 4) = (f32x4){bflo(r.z), bfhi(r.z), bflo(r.w), bfhi(r.w)} * rs * wv[j][1]; } }
#pragma unroll
        for (int q = 0; q < 4; ++q) { v[q][0] = vn[q][0]; v[q][1] = vn[q][1]; }
    }
}
DEV void ph_zero_cat(const Ctx& F, int c0, int nq) {
    const int gw = F.bid * 8 + F.wave, NGW = F.G * 8;
    bf16* CAT = (bf16*)(F.ws + WS_CAT);
    for (int m = gw; m < MTOK; m += NGW) for (int q = 0; q < nq; ++q) *(u32x2*)(CAT + (size_t)m * DM + c0 + 256 * q + 4 * F.lane) = (u32x2){0u, 0u};
}
DEV float softcap15(float z) { return 15.0f * tanhf(z * (1.0f / 15.0f)); }
DEV float logsigmoidf_(float x) { return x >= 0.f ? -log1pf(expf(-x)) : x - log1pf(expf(x)); }
DEV void ph_prep(const Ctx& F, int l) {
    const int gw = F.bid * 8 + F.wave, NGW = F.G * 8, lane = F.lane;
    const bf16* PROJ = (const bf16*)(F.ws + WS_PROJ);
    bf16* QL = (bf16*)(F.ws + WS_QL); bf16* CKV = (bf16*)(F.ws + WS_CKV); bf16* KIDX = (bf16*)(F.ws + WS_KIDX);
    float* WI = (float*)(F.ws + WS_WI);
    const f32x4 qn = *(const f32x4*)(PIN(F, I_QNW) + l * 256 + 4 * lane);
    const float kn0 = PIN(F, I_KVNW)[l * 128 + 2 * lane], kn1 = PIN(F, I_KVNW)[l * 128 + 2 * lane + 1];
    u32x2 ra4[4], ran[4]; unsigned rk4[4], rx4[4], rkn[4], rxn[4];
#define PREP_LOAD(RA, RK, RX, M0) do { _Pragma("unroll") for (int q = 0; q < 4; ++q) { const int mm = (M0) + q * NGW; const bf16* pr = PROJ + (size_t)(mm < MTOK ? mm : 0) * NPROJ; \
            RA[q] = *(const u32x2*)(pr + PC_AQ + 4 * lane); RK[q] = *(const unsigned*)(pr + PC_AKV + 2 * lane); \
            RX[q] = lane < 16 ? *(const unsigned*)(pr + PC_IK + 2 * lane) : (lane < 24 ? (unsigned)pr[PC_IW + (lane - 16)] : 0u); } } while (0)
    PREP_LOAD(ra4, rk4, rx4, gw);
    for (int m0 = gw; m0 < MTOK; m0 += 4 * NGW) {
        PREP_LOAD(ran, rkn, rxn, m0 + 4 * NGW);
#pragma unroll
        for (int q = 0; q < 4; ++q) { const int m = m0 + q * NGW; if (m >= MTOK) break;
            const u32x2 ra = ra4[q]; const unsigned rk = rk4[q];
            const float a0 = bflo(ra.x), a1 = bfhi(ra.x), a2 = bflo(ra.y), a3 = bfhi(ra.y);
            const float k0 = bflo(rk), k1 = bfhi(rk);
            const float sq = wave_sum((a0 * a0 + a1 * a1) + (a2 * a2 + a3 * a3)), sk = wave_sum(k0 * k0 + k1 * k1);
            const float rq = RSQ(sq * (1.0f / 256.0f) + NORM_EPS), rk2 = RSQ(sk * (1.0f / 128.0f) + NORM_EPS);
            u32x2 oq; oq.x = pk2(a0 * rq * qn.x, a1 * rq * qn.y); oq.y = pk2(a2 * rq * qn.z, a3 * rq * qn.w);
            *(u32x2*)(QL + (size_t)m * 256 + 4 * lane) = oq;
            *(unsigned*)(CKV + (size_t)m * 128 + 2 * lane) = pk2(k0 * rk2 * kn0, k1 * rk2 * kn1);
            if (lane < 16) *(unsigned*)(KIDX + (size_t)m * 32 + 2 * lane) = rx4[q];
            else if (lane < 24) WI[(size_t)m * 8 + (lane - 16)] = bf2f(rx4[q]); }
#pragma unroll
        for (int q = 0; q < 4; ++q) { ra4[q] = ran[q]; rk4[q] = rkn[q]; rx4[q] = rxn[q]; }
    }
#undef PREP_LOAD
}

constexpr int XB_STRIDE = 264;
DEV void ph_lru1(const Ctx& F, int l) {
    const int tid = F.tid, lane = F.lane, w = F.wave, i16 = lane & 15, g = lane >> 4;
    bf16* XB = (bf16*)F.lds;
    float* XF = (float*)(F.lds + 64 * XB_STRIDE * 2);
    const bf16* PROJ = (const bf16*)(F.ws + WS_PROJ);
    bf16* HLOC = (bf16*)(F.ws + WS_HLOC); bf16* CPA = (bf16*)(F.ws + WS_CPA); float* LSUM = (float*)(F.ws + WS_LSUM);
    const int blk = w & 3, nh = w >> 2;
    const bf16* WG = (const bf16*)(F.ws + WS_WG) + (size_t)l * 2 * 4 * 4096;
    bf16x8 Bf[2][2][2];
#pragma unroll
    for (int gg = 0; gg < 2; ++gg)
#pragma unroll
        for (int nt = 0; nt < 2; ++nt)
#pragma unroll
            for (int ks = 0; ks < 2; ++ks) Bf[gg][nt][ks] = *(const bf16x8*)(WG + ((size_t)(gg * 4 + blk) * 64 + nh * 32 + 2 * i16 + nt) * 64 + ks * 32 + 8 * g);
    float ba[2], bx[2], sp[2];
#pragma unroll
    for (int nt = 0; nt < 2; ++nt) { const int ch = blk * 64 + nh * 32 + 2 * i16 + nt;
        ba[nt] = PIN(F, I_BA)[l * 256 + ch]; bx[nt] = PIN(F, I_BX)[l * 256 + ch];
        const float lam = PIN(F, I_LAM)[l * 256 + ch]; sp[nt] = lam > 0.f ? log1pf(expf(-lam)) : -lam + log1pf(expf(lam)); }
    const int ch2 = tid & 127, tg = tid >> 7;
    float cw[4][2], cb[2];
#pragma unroll
    for (int j = 0; j < 4; ++j) { cw[j][0] = PIN(F, I_CONVW)[(l * 4 + j) * 256 + 2 * ch2]; cw[j][1] = PIN(F, I_CONVW)[(l * 4 + j) * 256 + 2 * ch2 + 1]; }
    cb[0] = PIN(F, I_CONVB)[l * 256 + 2 * ch2]; cb[1] = PIN(F, I_CONVB)[l * 256 + 2 * ch2 + 1];

    for (int u = F.bid; u < BATCH * 64; u += F.G) {
        const int b = u >> 6, c = u & 63, t0 = c * 64; const size_t m0 = (size_t)b * SEQ + t0;
        {
            const int tl0 = tg * 16;
            unsigned rv[19];
#pragma unroll
            for (int j = 0; j < 3; ++j) { const int t = t0 + tl0 - 3 + j; rv[j] = t >= 0 ? *(const unsigned*)(PROJ + ((size_t)b * SEQ + t) * NPROJ + PC_LX + 2 * ch2) : 0u; }
#pragma unroll
            for (int tt = 0; tt < 16; ++tt) rv[3 + tt] = *(const unsigned*)(PROJ + (m0 + tl0 + tt) * NPROJ + PC_LX + 2 * ch2);
#pragma unroll
            for (int tt = 0; tt < 16; ++tt) { const int tl = tl0 + tt;
                const float x0 = cw[0][0] * bflo(rv[tt]) + cw[1][0] * bflo(rv[tt + 1]) + cw[2][0] * bflo(rv[tt + 2]) + cw[3][0] * bflo(rv[tt + 3]) + cb[0];
                const float x1 = cw[0][1] * bfhi(rv[tt]) + cw[1][1] * bfhi(rv[tt + 1]) + cw[2][1] * bfhi(rv[tt + 2]) + cw[3][1] * bfhi(rv[tt + 3]) + cb[1];
                *(unsigned*)(XB + tl * XB_STRIDE + 2 * ch2) = pk2(x0, x1);
                XF[tl * 256 + 2 * ch2] = x0; XF[tl * 256 + 2 * ch2 + 1] = x1; }
        }
        SYNC();
        float CA[2] = {1.f, 1.f}, CU[2] = {0.f, 0.f};
#pragma unroll 1
        for (int m = 0; m < 4; ++m) {
            f32x4 acc[2][2];
#pragma unroll
            for (int gg = 0; gg < 2; ++gg)
#pragma unroll
                for (int nt = 0; nt < 2; ++nt) acc[gg][nt] = (f32x4){0.f, 0.f, 0.f, 0.f};
#pragma unroll
            for (int ks = 0; ks < 2; ++ks) { const bf16x8 A = *(const bf16x8*)(XB + (m * 16 + i16) * XB_STRIDE + blk * 64 + ks * 32 + 8 * g);
#pragma unroll
                for (int gg = 0; gg < 2; ++gg)
#pragma unroll
                    for (int nt = 0; nt < 2; ++nt) acc[gg][nt] = MFMA16(A, Bf[gg][nt][ks], acc[gg][nt]); }
            float HL[2][4], CP[2][4];
            const int chb = blk * 64 + nh * 32 + 2 * i16;
            float xf[4][2];
#pragma unroll
            for (int r = 0; r < 4; ++r) { const float* xp = XF + (m * 16 + 4 * g + r) * 256 + chb; xf[r][0] = xp[0]; xf[r][1] = xp[1]; }
#pragma unroll
            for (int nt = 0; nt < 2; ++nt) {
                float P[4], H[4]; float pa = 1.f, hu = 0.f;
#pragma unroll
                for (int r = 0; r < 4; ++r) {
                    const float rg = fsigmoid(acc[0][nt][r] + ba[nt]), gi = fsigmoid(acc[1][nt][r] + bx[nt]);
                    const float la = -8.0f * rg * sp[nt], a = FEXP(la), uu = FSQRT((1.0f - a) * (1.0f + a)) * (gi * xf[r][nt]);
                    pa = a * pa; hu = a * hu + uu; P[r] = pa; H[r] = hu;
                    }
                float EA = 1.f, EU = 0.f, TA = 1.f, TU = 0.f;
#pragma unroll
                for (int gg = 0; gg < 4; ++gg) { const float ta = SHFL(pa, i16 + 16 * gg), tu = SHFL(hu, i16 + 16 * gg);
                    if (gg < g) { EU = ta * EU + tu; EA = ta * EA; }
                    TU = ta * TU + tu; TA = ta * TA; }
                const float XA = EA * CA[nt], XU = EA * CU[nt] + EU;
#pragma unroll
                for (int r = 0; r < 4; ++r) { HL[nt][r] = P[r] * XU + H[r]; CP[nt][r] = P[r] * XA; }
                CU[nt] = TA * CU[nt] + TU; CA[nt] = TA * CA[nt];
            }
#pragma unroll
            for (int r = 0; r < 4; ++r) { const size_t o = (m0 + m * 16 + 4 * g + r) * 256 + chb;
                *(unsigned*)(HLOC + o) = pk2(HL[0][r], HL[1][r]); *(unsigned*)(CPA + o) = pk2(CP[0][r], CP[1][r]); }
        }
        if (g == 0) {
#pragma unroll
            for (int nt = 0; nt < 2; ++nt) { const int ch = blk * 64 + nh * 32 + 2 * i16 + nt;
                LSUM[((size_t)b * 64 + c) * 256 + ch] = CA[nt]; LSUM[(size_t)BATCH * 64 * 256 + ((size_t)b * 64 + c) * 256 + ch] = CU[nt]; }
        }
        SYNC();
    }
}

DEV float gelu_tanh(float x) { const float z = 0.7978845608028654f * (x + 0.044715f * x * x * x); return x * FRCP(1.0f + FEXP(-2.0f * z)); }
DEV void ph_carry(const Ctx& F) {
    if (F.wave != 0) return;
    const float* LSUM = (const float*)(F.ws + WS_LSUM); float* CARRY = (float*)(F.ws + WS_CARRY);
    const int seg = F.lane & 3;
    for (int chain = F.bid * 16 + (F.lane >> 2); chain < BATCH * 256; chain += F.G * 16) {
        const int b = chain >> 8, ch = chain & 255; const size_t o0 = ((size_t)b * 64 + seg * 16) * 256 + ch;
        float a[16], hb[16];
#pragma unroll
        for (int i = 0; i < 16; ++i) { a[i] = LSUM[o0 + (size_t)i * 256]; hb[i] = LSUM[(size_t)BATCH * 64 * 256 + o0 + (size_t)i * 256]; }
        float hp[16], ap[16], hl = 0.f, al = 1.f;
#pragma unroll
        for (int i = 0; i < 16; ++i) { hp[i] = hl; ap[i] = al; hl = a[i] * hl + hb[i]; al = a[i] * al; }
        float cin = 0.f;
#pragma unroll
        for (int s2 = 0; s2 < 3; ++s2) { const float as = SHFL(al, (F.lane & ~3) + s2), hs = SHFL(hl, (F.lane & ~3) + s2); if (s2 < seg) cin = as * cin + hs; }
#pragma unroll
        for (int i = 0; i < 16; ++i) CARRY[o0 + (size_t)i * 256] = ap[i] * cin + hp[i];
    }
}
DEV void ph_lru2(const Ctx& F, int l) {
    const int tid = F.tid, lane = F.lane, w = F.wave;
    const bf16* PROJ = (const bf16*)(F.ws + WS_PROJ); const bf16* HLOC = (const bf16*)(F.ws + WS_HLOC); const bf16* CPA = (const bf16*)(F.ws + WS_CPA);
    const float* CARRY = (const float*)(F.ws + WS_CARRY); bf16* CAT = (bf16*)(F.ws + WS_CAT);
    const f32x4 gw4 = *(const f32x4*)(PIN(F, I_GNW) + l * DM + 4 * lane);
    for (int u = F.bid; u < BATCH * 64; u += F.G) {
        const int b = u >> 6, c = u & 63; const size_t m0 = (size_t)b * SEQ + c * 64;
        const f32x4 car = *(const f32x4*)(CARRY + (size_t)u * 256 + 4 * lane);
        u32x2 hl8[8], cp8[8], ly8[8];
#pragma unroll
        for (int tt = 0; tt < 8; ++tt) { const size_t m = m0 + w * 8 + tt;
            hl8[tt] = *(const u32x2*)(HLOC + m * 256 + 4 * lane); cp8[tt] = *(const u32x2*)(CPA + m * 256 + 4 * lane); ly8[tt] = *(const u32x2*)(PROJ + m * NPROJ + PC_LY + 4 * lane); }
#pragma unroll
        for (int tt = 0; tt < 8; ++tt) { const size_t m = m0 + w * 8 + tt; const u32x2 hl = hl8[tt], cp = cp8[tt], ly = ly8[tt];
            float v0 = (bflo(hl.x) + bflo(cp.x) * car.x) * gelu_tanh(bflo(ly.x));
            float v1 = (bfhi(hl.x) + bfhi(cp.x) * car.y) * gelu_tanh(bfhi(ly.x));
            float v2 = (bflo(hl.y) + bflo(cp.y) * car.z) * gelu_tanh(bflo(ly.y));
            float v3 = (bfhi(hl.y) + bfhi(cp.y) * car.w) * gelu_tanh(bfhi(ly.y));
            const float rs = RSQ(wave_sum((v0 * v0 + v1 * v1) + (v2 * v2 + v3 * v3)) * (1.0f / 256.0f) + NORM_EPS);
            u32x2 o; o.x = pk2(v0 * rs * gw4.x, v1 * rs * gw4.y); o.y = pk2(v2 * rs * gw4.z, v3 * rs * gw4.w);
            *(u32x2*)(CAT + m * DM + 4 * lane) = o; }
    }
}

constexpr int QS_STRIDE = 136, VE_STRIDE = 56;
DEV void ph_mlstm(const Ctx& F, int l) {
    const int tid = F.tid, lane = F.lane, w = F.wave, i16 = lane & 15, g = lane >> 4;
    bf16* QsB = (bf16*)F.lds;
    bf16* KsB = QsB + 2 * 64 * QS_STRIDE;
    bf16* VE = KsB + 2 * 64 * QS_STRIDE;
    bf16* VW = VE + 64 * VE_STRIDE;
    bf16* CsB = VW + 64 * VE_STRIDE;
    float* BCB = (float*)(CsB + 2 * 128 * VE_STRIDE);
    float* BIB = BCB + 128;
    const bf16* PROJ = (const bf16*)(F.ws + WS_PROJ); bf16* HM = (bf16*)(F.ws + WS_HM);
    const float qscale = 0.08838834764831845f;
    const int half = w >> 2, jt = half ? 3 - (w & 3) : (w & 3);
    for (int u0 = F.bid; u0 < BATCH * 4 * 4; u0 += F.G) {
        const int u = 4 * ((u0 & 7) * 8 + ((u0 >> 3) >> 2)) + ((u0 >> 3) & 3);
        const int b = u >> 4, h = (u >> 2) & 3, vs = u & 3;
        const float gbi = PIN(F, I_BI)[l * 4 + h], gbf = PIN(F, I_BF)[l * 4 + h];
        f32x4 accC[3];
#pragma unroll
        for (int nt = 0; nt < 3; ++nt) accC[nt] = (f32x4){0.f, 0.f, 0.f, 0.f};
        float* BCg = (float*)(F.ws + WS_MG) + (size_t)u * 8192; float* BIg = BCg + 4096;
        unsigned gri[8], grf[8];
#pragma unroll
        for (int k = 0; k < 8; ++k) { const bf16* pr = PROJ + ((size_t)b * SEQ + (8 * k + w) * 64 + lane) * NPROJ; gri[k] = pr[PC_MI + h]; grf[k] = pr[PC_MF + h]; }
#pragma unroll
        for (int k = 0; k < 8; ++k) { const int tok = (8 * k + w) * 64 + lane;
            const float zi = (bf2f(gri[k]) + gbi) * (1.0f / 15.0f), zf = (bf2f(grf[k]) + gbf) * (1.0f / 15.0f);
            const float ig = 15.0f - 30.0f * FRCP(FEXP(2.0f * zi) + 1.0f), fg = 15.0f - 30.0f * FRCP(FEXP(2.0f * zf) + 1.0f);
            float s = -FLOG(1.0f + FEXP(-fg));
#pragma unroll
            for (int o = 1; o < 64; o <<= 1) { const float t = SHFL_UP(s, o); if (lane >= o) s += t; }
            BCg[tok] = s; BIg[tok] = s - ig; }
        SYNC();
        u32x4 rq[2], rk[2]; u32x2 rvv; float rgc = 0.f, rgb = 0.f;
        {
            const size_t m0 = (size_t)b * SEQ;
#pragma unroll
            for (int i = 0; i < 2; ++i) { const int idx = tid + 512 * i, row = idx >> 4, ck = idx & 15;
                rq[i] = *(const u32x4*)(PROJ + (m0 + row) * NPROJ + PC_MQ + h * 128 + 8 * ck); rk[i] = *(const u32x4*)(PROJ + (m0 + row) * NPROJ + PC_MK + h * 128 + 8 * ck); }
            rvv = *(const u32x2*)(PROJ + (m0 + (tid >> 3)) * NPROJ + PC_MV + h * 128 + vs * 32 + 4 * (tid & 7));
            if (tid < 64) { rgc = BCg[tid]; rgb = BIg[tid]; }
        }
        for (int c = 0; c < 64; ++c) {
            const size_t m0 = (size_t)b * SEQ + c * 64; const int buf = c & 1;
            bf16* Qs = QsB + buf * 64 * QS_STRIDE; bf16* Ks = KsB + buf * 64 * QS_STRIDE; const bf16* Cs = CsB + buf * 128 * VE_STRIDE; bf16* Cn = CsB + (buf ^ 1) * 128 * VE_STRIDE;
            float* BC = BCB + buf * 64; float* BI = BIB + buf * 64;
#pragma unroll
            for (int i = 0; i < 2; ++i) { const int idx = tid + 512 * i, row = idx >> 4, ck = idx & 15;
                *(u32x4*)(Qs + row * QS_STRIDE + 8 * ck) = rq[i]; *(u32x4*)(Ks + row * QS_STRIDE + 8 * ck) = rk[i]; }
            if (tid < 64) { BC[tid] = rgc; BI[tid] = rgb; }
            SYNC();
            {
                const int row = tid >> 3, cg = tid & 7;
                const u32x2 rv = rvv;
                const float wt = FEXP(BC[63] - BI[row]);
                *(u32x2*)(VE + row * VE_STRIDE + 4 * cg) = rv;
                u32x2 sv; sv.x = pk2(bflo(rv.x) * wt, bfhi(rv.x) * wt); sv.y = pk2(bflo(rv.y) * wt, bfhi(rv.y) * wt);
                *(u32x2*)(VW + row * VE_STRIDE + 4 * cg) = sv;
                if (cg == 0) { unsigned one_ = 0x3f80u; LAUNDER_V(one_); u32x4 z = (u32x4){one_, 0u, 0u, 0u}; *(u32x4*)(VE + row * VE_STRIDE + 32) = z; *(u32x4*)(VE + row * VE_STRIDE + 40) = (u32x4){0u, 0u, 0u, 0u};
                    z.x = f2bf(wt); *(u32x4*)(VW + row * VE_STRIDE + 32) = z; *(u32x4*)(VW + row * VE_STRIDE + 40) = (u32x4){0u, 0u, 0u, 0u}; }
            }
            if (c + 1 < 64) {
                const size_t m1 = m0 + 64;
#pragma unroll
                for (int i = 0; i < 2; ++i) { const int idx = tid + 512 * i, row = idx >> 4, ck = idx & 15;
                    rq[i] = *(const u32x4*)(PROJ + (m1 + row) * NPROJ + PC_MQ + h * 128 + 8 * ck); rk[i] = *(const u32x4*)(PROJ + (m1 + row) * NPROJ + PC_MK + h * 128 + 8 * ck); }
                rvv = *(const u32x2*)(PROJ + (m1 + (tid >> 3)) * NPROJ + PC_MV + h * 128 + vs * 32 + 4 * (tid & 7));
                if (tid < 64) { rgc = BCg[(c + 1) * 64 + tid]; rgb = BIg[(c + 1) * 64 + tid]; }
            }
            SYNC();
            f32x4 Z[2] = {(f32x4){0.f, 0.f, 0.f, 0.f}, (f32x4){0.f, 0.f, 0.f, 0.f}};
            {
                bf16x8 Bq[4];
#pragma unroll
                for (int ks = 0; ks < 4; ++ks) Bq[ks] = *(const bf16x8*)(Qs + (16 * jt + i16) * QS_STRIDE + 32 * ks + 8 * g);
                const float bj = BC[16 * jt + i16];
                unsigned pk[4][2];
#pragma unroll
                for (int tt = 0; tt < 4; ++tt) {
                    if (tt <= jt) {
                        f32x4 X = (f32x4){0.f, 0.f, 0.f, 0.f};
                        bf16x8 Ak[4];
#pragma unroll
                        for (int ks = 0; ks < 4; ++ks) Ak[ks] = *(const bf16x8*)(Ks + (16 * tt + i16) * QS_STRIDE + 32 * ks + 8 * g);
                        KEEP4(Ak[0], Ak[1], Ak[2], Ak[3]);
#pragma unroll
                        for (int ks = 0; ks < 4; ++ks) X = MFMA16(Ak[ks], Bq[ks], X);
                        float p[4]; const f32x4 bi4 = *(const f32x4*)(BI + 16 * tt + 4 * g);
#pragma unroll
                        for (int r = 0; r < 4; ++r) { const float pv = X[r] * qscale * FEXP(fminf(bj - bi4[r], 60.0f));
                            p[r] = (tt < jt || 4 * g + r <= i16) ? pv : 0.f; }
                        pk[tt][0] = pk2(p[0], p[1]); pk[tt][1] = pk2(p[2], p[3]);
                    } else { pk[tt][0] = 0u; pk[tt][1] = 0u; }
                }
#pragma unroll
                for (int pr = 0; pr < 2; ++pr) {
                    if (2 * pr <= jt) {
                        u32x4 aw = (u32x4){pk[2 * pr][0], pk[2 * pr][1], pk[2 * pr + 1][0], pk[2 * pr + 1][1]};
                        const bf16x8 A = __builtin_bit_cast(bf16x8, aw);
#pragma unroll
                        for (int n = 0; n < 2; ++n) { const int ntc = n ? 2 : half;
                            const s16x4 lo = TR16(VE + (32 * pr + 4 * g + (i16 >> 2)) * VE_STRIDE + 16 * ntc + 4 * (i16 & 3));
                            const s16x4 hi = TR16(VE + (32 * pr + 16 + 4 * g + (i16 >> 2)) * VE_STRIDE + 16 * ntc + 4 * (i16 & 3));
                            const bf16x8 B = (bf16x8){lo[0], lo[1], lo[2], lo[3], hi[0], hi[1], hi[2], hi[3]};
                            Z[n] = MFMA16(A, B, Z[n]); }
#ifndef HOST_EMU
                        asm volatile("" :: "v"(aw));
#endif
                    }
                }
            }
            if (c > 0) {
                f32x4 Z2[2] = {(f32x4){0.f, 0.f, 0.f, 0.f}, (f32x4){0.f, 0.f, 0.f, 0.f}};
#pragma unroll
                for (int kh = 0; kh < 2; ++kh) {
                    bf16x8 Aq[2], Bc[2][2];
#pragma unroll
                    for (int k2 = 0; k2 < 2; ++k2) { const int ks = 2 * kh + k2; Aq[k2] = *(const bf16x8*)(Qs + (16 * jt + i16) * QS_STRIDE + 32 * ks + 8 * g);
#pragma unroll
                        for (int n = 0; n < 2; ++n) { const int ntc = n ? 2 : half;
                            const s16x4 lo = TR16(Cs + (32 * ks + 8 * g + (i16 >> 2)) * VE_STRIDE + 16 * ntc + 4 * (i16 & 3));
                            const s16x4 hi = TR16(Cs + (32 * ks + 8 * g + 4 + (i16 >> 2)) * VE_STRIDE + 16 * ntc + 4 * (i16 & 3));
                            Bc[k2][n] = (bf16x8){lo[0], lo[1], lo[2], lo[3], hi[0], hi[1], hi[2], hi[3]}; } }
                    KEEP4(Bc[0][0], Bc[0][1], Bc[1][0], Bc[1][1]);
#pragma unroll
                    for (int k2 = 0; k2 < 2; ++k2)
#pragma unroll
                        for (int n = 0; n < 2; ++n) Z2[n] = MFMA16(Aq[k2], Bc[k2][n], Z2[n]); }
                const f32x4 bc4 = *(const f32x4*)(BC + 16 * jt + 4 * g);
#pragma unroll
                for (int r = 0; r < 4; ++r) { const float f = qscale * FEXP(bc4[r]); Z[0][r] += f * Z2[0][r]; Z[1][r] += f * Z2[1][r]; }
            }
#pragma unroll
            for (int r = 0; r < 4; ++r) { const int j = 16 * jt + 4 * g + r; const float dn = FRCP(fmaxf(fabsf(SHFL(Z[1][r], lane & 48)), 1.0f));
                HM[(m0 + j) * 512 + h * 128 + vs * 32 + 16 * half + i16] = (bf16)f2bf(Z[0][r] * dn); }
            {
                const float dec = FEXP(BC[63]);
#pragma unroll
                for (int nt = 0; nt < 3; ++nt) accC[nt] = accC[nt] * dec;
#pragma unroll
                for (int ks = 0; ks < 2; ++ks) {
                    const s16x4 alo = TR16(Ks + (32 * ks + 8 * g + (i16 >> 2)) * QS_STRIDE + 16 * w + 4 * (i16 & 3));
                    const s16x4 ahi = TR16(Ks + (32 * ks + 8 * g + 4 + (i16 >> 2)) * QS_STRIDE + 16 * w + 4 * (i16 & 3));
                    const bf16x8 A = (bf16x8){alo[0], alo[1], alo[2], alo[3], ahi[0], ahi[1], ahi[2], ahi[3]};
                    bf16x8 Bv[3];
#pragma unroll
                    for (int nt = 0; nt < 3; ++nt) {
                        const s16x4 lo = TR16(VW + (32 * ks + 8 * g + (i16 >> 2)) * VE_STRIDE + 16 * nt + 4 * (i16 & 3));
                        const s16x4 hi = TR16(VW + (32 * ks + 8 * g + 4 + (i16 >> 2)) * VE_STRIDE + 16 * nt + 4 * (i16 & 3));
                        Bv[nt] = (bf16x8){lo[0], lo[1], lo[2], lo[3], hi[0], hi[1], hi[2], hi[3]}; }
                    KEEP4(A, Bv[0], Bv[1], Bv[2]);
#pragma unroll
                    for (int nt = 0; nt < 3; ++nt) { const bf16x8 B = Bv[nt];
                        const f32x4 cold = accC[nt]; accC[nt] = MFMA16(A, B, cold);
#ifndef HOST_EMU
                        asm volatile("" :: "v"(cold), "v"(A), "v"(B));
#endif
                    }
                }
#pragma unroll
                for (int nt = 0; nt < 3; ++nt)
#pragma unroll
                    for (int r = 0; r < 4; ++r) Cn[(16 * w + 4 * g + r) * VE_STRIDE + 16 * nt + i16] = (bf16)f2bf(accC[nt][r]);
            }
        }
        SYNC();
    }
}

DEV void ph_mfin(const Ctx& F, int l) {
    const int gw = F.bid * 8 + F.wave, NGW = F.G * 8, lane = F.lane;
    const bf16* PROJ = (const bf16*)(F.ws + WS_PROJ); const bf16* HM = (const bf16*)(F.ws + WS_HM); bf16* CAT = (bf16*)(F.ws + WS_CAT);
    float gm[8];
#pragma unroll
    for (int j = 0; j < 8; ++j) gm[j] = PIN(F, I_GNW)[l * DM + 256 + 8 * lane + j];
    u32x4 hv4[4], ov4[4], hvn[4], ovn[4];
#define MFIN_LOAD(HV, OV, M0) do { _Pragma("unroll") for (int q = 0; q < 4; ++q) { const int mm = (M0) + q * NGW; const size_t ms = (size_t)(mm < MTOK ? mm : 0); \
            HV[q] = *(const u32x4*)(HM + ms * 512 + 8 * lane); OV[q] = *(const u32x4*)(PROJ + ms * NPROJ + PC_MO + 8 * lane); } } while (0)
    MFIN_LOAD(hv4, ov4, gw);
    for (int m0 = gw; m0 < MTOK; m0 += 4 * NGW) {
        MFIN_LOAD(hvn, ovn, m0 + 4 * NGW);
#pragma unroll
        for (int q = 0; q < 4; ++q) { const int m = m0 + q * NGW; if (m >= MTOK) break;
            const u32x4 hv = hv4[q], ov = ov4[q];
            float v[8] = {bflo(hv.x), bfhi(hv.x), bflo(hv.y), bfhi(hv.y), bflo(hv.z), bfhi(hv.z), bflo(hv.w), bfhi(hv.w)};
            const float o[8] = {bflo(ov.x), bfhi(ov.x), bflo(ov.y), bfhi(ov.y), bflo(ov.z), bfhi(ov.z), bflo(ov.w), bfhi(ov.w)};
            float s = 0.f;
#pragma unroll
            for (int j = 0; j < 8; ++j) s += v[j] * v[j];
            s += SHFL_XOR(s, 1); s += SHFL_XOR(s, 2); s += SHFL_XOR(s, 4); s += SHFL_XOR(s, 8);
            const float rs = RSQ(s * (1.0f / 128.0f) + NORM_EPS);
            u32x4 r;
            r.x = pk2(v[0] * rs * gm[0] * fsigmoid(o[0]), v[1] * rs * gm[1] * fsigmoid(o[1]));
            r.y = pk2(v[2] * rs * gm[2] * fsigmoid(o[2]), v[3] * rs * gm[3] * fsigmoid(o[3]));
            r.z = pk2(v[4] * rs * gm[4] * fsigmoid(o[4]), v[5] * rs * gm[5] * fsigmoid(o[5]));
            r.w = pk2(v[6] * rs * gm[6] * fsigmoid(o[6]), v[7] * rs * gm[7] * fsigmoid(o[7]));
            *(u32x4*)(CAT + (size_t)m * DM + 256 + 8 * lane) = r; }
#pragma unroll
        for (int q = 0; q < 4; ++q) { hv4[q] = hvn[q]; ov4[q] = ovn[q]; }
    }
#undef MFIN_LOAD
}

constexpr int DS_HIST = 0;
constexpr int DS_MASK = 49152;
constexpr int DS_CAND = 65536;
constexpr int DS_SELL = 102400;
constexpr int DS_META = 118784;
constexpr int DS_RB = DS_META + 512;
constexpr int DS_SS = DS_RB + 2048;
constexpr int DS_SLOT = 12800;
constexpr int NBIN = 768, CAND_CAP = 128;
__device__ const unsigned char T5B[114] = {0, 1, 2, 3, 4, 5, 6, 7, 8, 9, 10, 11, 12, 13, 14, 15, 16, 16, 16, 17, 17, 18, 18, 18, 19, 19, 19, 20, 20, 20, 20, 21, 21, 21, 21, 22, 22, 22, 22, 22, 23, 23, 23, 23, 23, 23, 24, 24, 24, 24, 24, 24, 25, 25, 25, 25, 25, 25, 25, 26, 26, 26, 26, 26, 26, 26, 26, 27, 27, 27, 27, 27, 27, 27, 27, 27, 27, 28, 28, 28, 28, 28, 28, 28, 28, 28, 28, 29, 29, 29, 29, 29, 29, 29, 29, 29, 29, 29, 29, 30, 30, 30, 30, 30, 30, 30, 30, 30, 30, 30, 30, 30, 30, 31};

DEV int score_bin(float sc) {
    const unsigned u = __builtin_bit_cast(unsigned, sc);
    int e = (int)((u >> 18) & 0x1FFFu) - 119 * 32; e = e < 0 ? 0 : (e > 383 ? 383 : e);
    return (u >> 31) ? 383 - e : 384 + e;
}
DEV unsigned score_key(float sc) { const unsigned u = __builtin_bit_cast(unsigned, sc); return (u >> 31) ? ~u : (u | 0x80000000u); }
DEV unsigned score_code(float sc) {
    const unsigned u = __builtin_bit_cast(unsigned, sc);
    int e = (int)((u >> 18) & 0x1FFFu) - 119 * 32; e = e < 0 ? 0 : (e > 383 ? 383 : e);
    const int v = (e << 6) | (int)((u >> 12) & 63u), sm = (int)u >> 31;
    return (unsigned)(0x6000 + (v ^ sm));
}
DEV int code_bin(unsigned c) { return (int)(c >> 6); }
DEV unsigned code_key(unsigned c) { return c & 63u; }


DEV f32x4 dsa_score_tile(const bf16x8 A, const bf16x8 (&QS)[2], const bf16x8 (&Bq)[8], const float (&wq)[8]) {
    f32x4 sc = (f32x4){0.f, 0.f, 0.f, 0.f};
#pragma unroll
    for (int h = 0; h < 8; ++h) { const f32x4 d = MFMA16(A, Bq[h], (f32x4){0.f, 0.f, 0.f, 0.f});
#pragma unroll
        for (int r = 0; r < 4; ++r) sc[r] += wq[h] * RELU(d[r]); }
    return sc;
}
DEV void ph_dsa(const Ctx& F, int l) {
    const int tid = F.tid, lane = F.lane, w = F.wave, i16 = lane & 15, g = lane >> 4;
    unsigned* HIST = (unsigned*)(F.lds + DS_HIST); unsigned* MASK = (unsigned*)(F.lds + DS_MASK); u32x2* CAND = (u32x2*)(F.lds + DS_CAND);
    unsigned short* SELL = (unsigned short*)(F.lds + DS_SELL); int* BST = (int*)(F.lds + DS_META); int* NAB = BST + 32; int* NCAND = BST + 64; int* NSEL = BST + 96;
    float* RB = (float*)(F.lds + DS_RB);
    const bf16* QIDX = (const bf16*)(F.ws + WS_QIDX); const bf16* KIDX = (const bf16*)(F.ws + WS_KIDX); const float* WI = (const float*)(F.ws + WS_WI);
    const bf16* QABS = (const bf16*)(F.ws + WS_QABS); const bf16* CKV = (const bf16*)(F.ws + WS_CKV); bf16* CAT = (bf16*)(F.ws + WS_CAT);
    const bf16* WUVT = (const bf16*)(F.ws + WS_WUVT) + (size_t)l * 4 * 64 * 128; float* SS = (float*)(F.lds + DS_SS);
    for (int e = tid; e < 114 * 4; e += 512) RB[e] = PIN(F, I_RELB)[T5B[e >> 2] * 4 + (e & 3)] * 1.4426950408889634f;
    SYNC();
    for (int ui = F.bid; ui < BATCH * 128; ui += F.G) {
#ifdef HOST_EMU
        int b, qt; { const int wv = ui & 255, k = ui >> 8, r = wv & 15; b = wv >> 4; qt = (k & 1) ? (32 * (k >> 1) + 31 - r) : (32 * (k >> 1) + r); }
#else
        int b, qt; { const int wv = ui & 255, k = ui >> 8, xj = wv >> 3, r = xj & 15; b = 2 * (wv & 7) + (xj >> 4);
            qt = (k & 1) ? (32 * (k >> 1) + 31 - r) : (32 * (k >> 1) + r); }
#endif
        const int t0 = 32 * qt, nkt = 2 * qt + 2; const size_t mb = (size_t)b * SEQ;
        const GAS char* const ckvb = UNIP(CKV + mb * 128);
        const int nt = w & 1;
        u32x2* sw = (u32x2*)(F.ws + (F.bid < 128 ? WS_QL + (size_t)F.bid * 262144 : WS_SCR2 + (size_t)(F.bid - 128) * 262144) + (size_t)w * 32768) + lane;
        bf16x8 Bq[8]; float wq[8];
        { const size_t mq = mb + t0 + 16 * nt + i16;
#pragma unroll
            for (int h = 0; h < 8; ++h) { Bq[h] = *(const bf16x8*)(QIDX + mq * 256 + 32 * h + 8 * g); wq[h] = WI[mq * 8 + h]; } }
        bf16x8 QS[2];
#pragma unroll
        for (int j = 0; j < 8; ++j) { float s = 0.f;
#pragma unroll
            for (int h = 0; h < 8; ++h) s += wq[h] * bf2f((unsigned)(unsigned short)Bq[h][j]);
            const unsigned hi = f2bf(s); QS[0][j] = (short)hi; QS[1][j] = (short)f2bf(s - bf2f(hi)); }
        for (int e = tid; e < 16 * NBIN; e += 512) HIST[e] = 0u;
        for (int e = tid; e < 32 * 128; e += 512) MASK[e] = 0u;
        if (tid < 32) NCAND[tid] = 0;
        SYNC();
        bf16x8 Apre = *(const bf16x8*)(KIDX + (mb + 16 * (w >> 1) + i16) * 32 + 8 * g);
        for (int kt = w >> 1; kt < nkt; kt += 4) {
            const bf16x8 A = Apre;
            { const int kn = kt + 4 < nkt ? kt + 4 : kt; Apre = *(const bf16x8*)(KIDX + (mb + 16 * kn + i16) * 32 + 8 * g); }
            const f32x4 sc = dsa_score_tile(A, QS, Bq, wq);
            unsigned cd[4];
#pragma unroll
            for (int r = 0; r < 4; ++r) cd[r] = score_code(sc[r] + 0.0f);
            { u32x2 pk; pk.x = cd[0] | (cd[1] << 16); pk.y = cd[2] | (cd[3] << 16); sw[(size_t)((kt - (w >> 1)) >> 2) * 64] = pk; }
            const unsigned inc = nt ? 65536u : 1u;
            if (kt < 2 * qt) {
#pragma unroll
                for (int r = 0; r < 4; ++r) atomicAdd(&HIST[i16 * NBIN + code_bin(cd[r])], inc);
            } else {
                const int t = t0 + 16 * nt + i16;
#pragma unroll
                for (int r = 0; r < 4; ++r) { const int s = 16 * kt + 4 * g + r;
                    if (s <= t) atomicAdd(&HIST[i16 * NBIN + code_bin(cd[r])], inc); }
            }
        }
        SYNC();
        {
            int cnt4[4][12], tot4[4], suf4[4];
#pragma unroll
            for (int rr = 0; rr < 4; ++rr) { const int row = 4 * w + rr, sh = (row >> 4) * 16; const unsigned* hp = HIST + (row & 15) * NBIN + 12 * lane; int tot = 0;
#pragma unroll
                for (int i = 0; i < 12; ++i) { cnt4[rr][i] = (int)((hp[i] >> sh) & 0xFFFFu); tot += cnt4[rr][i]; }
                tot4[rr] = tot; suf4[rr] = tot; }
#pragma unroll
            for (int o = 1; o < 64; o <<= 1) {
#pragma unroll
                for (int rr = 0; rr < 4; ++rr) { const int v = SHFL_DOWN(suf4[rr], o); if (lane + o < 64) suf4[rr] += v; } }
#pragma unroll
            for (int rr = 0; rr < 4; ++rr) { const int row = 4 * w + rr, t = t0 + row;
                if (t < 256) { if (lane == 0) { BST[row] = -1; NAB[row] = t + 1; } }
                else { const int above = suf4[rr] - tot4[rr];
                    if (above < 256 && above + tot4[rr] >= 256) {
                        int run = above, bs = -1, na = 0; bool done = false;
#pragma unroll
                        for (int i = 11; i >= 0; --i) { if (!done) { if (run + cnt4[rr][i] >= 256) { bs = 12 * lane + i; na = run; done = true; } else run += cnt4[rr][i]; } }
                        BST[row] = bs; NAB[row] = na; } } }
        }
        SYNC();
        { const int row = 16 * nt + i16, t = t0 + row, bs = BST[row];
        const int ntl = nkt > (w >> 1) ? ((nkt - 1 - (w >> 1)) >> 2) + 1 : 0;
        u32x2 Pc[8], Pn[8];
#pragma unroll
        for (int q = 0; q < 8; ++q) Pc[q] = sw[(size_t)(q < 64 ? q : 63) * 64];
        for (int jb = 0; jb < ntl; jb += 8) {
#pragma unroll
            for (int q = 0; q < 8; ++q) { const int jn = jb + 8 + q; Pn[q] = sw[(size_t)(jn < 64 ? jn : 63) * 64]; }
#pragma unroll
            for (int q = 0; q < 8; ++q) { const int j = jb + q; if (j < ntl) { const int kt = (w >> 1) + 4 * j; const u32x2 pc = Pc[q];
            const bool full = kt < 2 * qt;
            const int s0 = 16 * kt + 4 * g; unsigned nib = 0u, cnd = 0u, cc[4];
#pragma unroll
            for (int r = 0; r < 4; ++r) { const unsigned wd = r < 2 ? pc.x : pc.y; cc[r] = (r & 1) ? (wd >> 16) : (wd & 0xffffu);
                const int bn = code_bin(cc[r]); const bool ok = full || s0 + r <= t;
                nib |= (ok && bn > bs) ? (1u << r) : 0u; cnd |= (ok && bn == bs) ? (1u << r) : 0u; }
            if (nib) atomicOr(&MASK[row * 128 + (s0 >> 5)], nib << (s0 & 31));
            if (cnd) {
#pragma unroll
                for (int r = 0; r < 4; ++r) if ((cnd >> r) & 1u) { const int pos = (int)atomicAdd((unsigned*)&NCAND[row], 1u); if (pos < CAND_CAP) CAND[row * CAND_CAP + pos] = (u32x2){code_key(cc[r]), (unsigned)(s0 + r)}; } }
            } }
#pragma unroll
            for (int q = 0; q < 8; ++q) Pc[q] = Pn[q];
        } }
        SYNC();
#pragma unroll 1
        for (int rr = 0; rr < 4; ++rr) {
            const int row = 4 * w + rr; if (BST[row] < 0) continue;
            const int n = NCAND[row] < CAND_CAP ? NCAND[row] : CAND_CAP, need = 256 - NAB[row];
            for (int i = lane; i < n; i += 64) { const u32x2 me = CAND[row * CAND_CAP + i]; int rank = 0;
                for (int j0 = 0; j0 < n; j0 += 8) { u32x2 o8[8];
#pragma unroll
                    for (int q = 0; q < 8; ++q) o8[q] = CAND[row * CAND_CAP + (j0 + q < CAND_CAP ? j0 + q : CAND_CAP - 1)];
#pragma unroll
                    for (int q = 0; q < 8; ++q) rank += (j0 + q < n && (o8[q].x > me.x || (o8[q].x == me.x && o8[q].y < me.y))) ? 1 : 0; }
#ifndef DSA_DBG_NOCAND
                if (rank < need) atomicOr(&MASK[row * 128 + (me.y >> 5)], 1u << (me.y & 31));
#endif
            }
        }
        SYNC();
#ifdef DSA_DBG_SEL
        for (int e = tid; e < 32 * 128; e += 512) { const int row = e >> 7, wi = e & 127, t = t0 + row, lo = t - 255 < 0 ? 0 : t - 255; unsigned m = 0u;
            for (int bq = 0; bq < 32; ++bq) { const int s = 32 * wi + bq; if (s >= lo && s <= t) m |= 1u << bq; }
            MASK[e] = m; }
        SYNC();
#endif
        {
            unsigned w04[4], w14[4]; int c4[4], inc4[4];
#pragma unroll
            for (int rr = 0; rr < 4; ++rr) { const int row = 4 * w + rr; w04[rr] = MASK[row * 128 + 2 * lane]; w14[rr] = MASK[row * 128 + 2 * lane + 1];
                c4[rr] = __builtin_popcount(w04[rr]) + __builtin_popcount(w14[rr]); inc4[rr] = c4[rr]; }
#pragma unroll
            for (int o = 1; o < 64; o <<= 1) {
#pragma unroll
                for (int rr = 0; rr < 4; ++rr) { const int v = SHFL_UP(inc4[rr], o); if (lane >= o) inc4[rr] += v; } }
#pragma unroll
            for (int rr = 0; rr < 4; ++rr) { const int row = 4 * w + rr; unsigned w0 = w04[rr], w1 = w14[rr]; int pos = inc4[rr] - c4[rr];
                while (w0) { const int bt = __builtin_ctz(w0); w0 &= w0 - 1; if (pos < 256) SELL[row * 256 + pos] = (unsigned short)(64 * lane + bt); ++pos; }
                while (w1) { const int bt = __builtin_ctz(w1); w1 &= w1 - 1; if (pos < 256) SELL[row * 256 + pos] = (unsigned short)(64 * lane + 32 + bt); ++pos; }
                if (lane == 63) NSEL[row] = inc4[rr] < 256 ? inc4[rr] : 256; }
        }
        SYNC();
        bf16* TL = (bf16*)(F.lds + w * DS_SLOT); bf16* OLw = (bf16*)(F.lds + w * DS_SLOT + 8704);
#pragma unroll 1
        for (int rr = 0; rr < 4; ++rr) {
            const int row = 4 * w + rr, t = t0 + row, ns = UNI(NSEL[row]); const size_t mt = mb + t;
            const unsigned short* sl = SELL + row * 256;
            bf16x8 Bh[4];
#pragma unroll
            for (int ks = 0; ks < 4; ++ks) Bh[ks] = i16 < 4 ? *(const bf16x8*)(QABS + mt * 512 + i16 * 128 + 32 * ks + 8 * g) : (bf16x8){0, 0, 0, 0, 0, 0, 0, 0};
            f32x4 O[8];
#pragma unroll
            for (int nt = 0; nt < 8; ++nt) O[nt] = (f32x4){0.f, 0.f, 0.f, 0.f};
            float mrun = -1e30f, lrun = 0.f;
            const float bfar = RB[113 * 4 + (i16 & 3)];
            const int nch = (ns + 31) >> 5;
            u32x4 gvA[8];
#ifndef HOST_EMU
#define ATT_KEEP8(A) asm volatile("" :: "v"(A[0][0]), "v"(A[0][1]), "v"(A[0][2]), "v"(A[0][3]), "v"(A[1][0]), "v"(A[1][1]), "v"(A[1][2]), "v"(A[1][3]))
#else
#define ATT_KEEP8(A) (void)0
#endif
#define ATT_LOAD(GV, CK, FULL) do { int sidx[8]; \
                _Pragma("unroll") for (int i = 0; i < 8; ++i) sidx[i] = (int)sl[32 * (CK) + 4 * i + g];            \
                _Pragma("unroll") for (int i = 0; i < 8; ++i) { const int kp = 32 * (CK) + 4 * i + g; sidx[i] = (FULL || kp < ns) ? sidx[i] : 0; } \
                _Pragma("unroll") for (int i = 0; i < 8; ++i) GV[i] = *(const GAS u32x4*)(ckvb + (((unsigned)sidx[i] << 8) + 16u * (unsigned)i16)); } while (0)
#define ATT_STEP(GV, CK, FULL) do { const int ck = (CK); \
                _Pragma("unroll") for (int i = 0; i < 8; ++i) *(u32x4*)(TL + (4 * i + g) * 136 + 8 * i16) = GV[i]; \
                const u32x2 sk0 = *(const u32x2*)(sl + 32 * ck + 4 * g), sk1 = *(const u32x2*)(sl + 32 * ck + 16 + 4 * g); \
                WAVE_LDS_FENCE(); \
                if (ck + 1 < nch) ATT_LOAD(GV, ck + 1, FULL); \
                float bia[2][4]; \
                if (FULL && t - UNI((int)sl[32 * ck + 31]) >= 113) {                   \
                _Pragma("unroll") for (int kt = 0; kt < 2; ++kt) \
                _Pragma("unroll") for (int r = 0; r < 4; ++r) bia[kt][r] = bfar; \
                } else { \
                _Pragma("unroll") for (int kt = 0; kt < 2; ++kt) \
                _Pragma("unroll") for (int r = 0; r < 4; ++r) { const unsigned wd = kt ? (r < 2 ? sk1.x : sk1.y) : (r < 2 ? sk0.x : sk0.y); \
                        int dist = t - (int)((wd >> (16 * (r & 1))) & 0xffffu); dist = dist < 0 ? 0 : (dist > 113 ? 113 : dist); \
                        bia[kt][r] = RB[dist * 4 + (i16 & 3)]; } } \
                f32x4 lg[2]; \
                { bf16x8 Af[2][4];                                    \
                _Pragma("unroll") for (int kt = 0; kt < 2; ++kt) _Pragma("unroll") for (int ks = 0; ks < 4; ++ks) Af[kt][ks] = *(const bf16x8*)(TL + (16 * kt + i16) * 136 + 32 * ks + 8 * g); \
                ATT_KEEP8(Af); \
                _Pragma("unroll") for (int kt = 0; kt < 2; ++kt) { lg[kt] = (f32x4){0.f, 0.f, 0.f, 0.f}; \
                _Pragma("unroll") for (int ks = 0; ks < 4; ++ks) lg[kt] = MFMA16(Af[kt][ks], Bh[ks], lg[kt]); } } \
                float cm = -1e30f; \
                _Pragma("unroll") for (int kt = 0; kt < 2; ++kt) \
                _Pragma("unroll") for (int r = 0; r < 4; ++r) { const int kp = 32 * ck + 16 * kt + 4 * g + r; \
                        lg[kt][r] = (FULL || kp < ns) ? lg[kt][r] + bia[kt][r] : -1e30f; cm = fmaxf(cm, lg[kt][r]); } \
                if (ck == 0) { cm = fmaxf(cm, SHFL_XOR(cm, 16)); cm = fmaxf(cm, SHFL_XOR(cm, 32)); mrun = cm; } \
                float p[2][4]; \
                _Pragma("unroll") for (int kt = 0; kt < 2; ++kt) \
                _Pragma("unroll") for (int r = 0; r < 4; ++r) { p[kt][r] = (FULL || lg[kt][r] > -1e29f) ? FEXP2(lg[kt][r] - mrun) : 0.f; lrun += p[kt][r]; } \
                u32x4 aw = (u32x4){0u, 0u, 0u, 0u}; \
                if (i16 < 4) aw = (u32x4){pk2(p[0][0], p[0][1]), pk2(p[0][2], p[0][3]), pk2(p[1][0], p[1][1]), pk2(p[1][2], p[1][3])}; \
                const bf16x8 A = __builtin_bit_cast(bf16x8, aw); \
                _Pragma("unroll") for (int nt = 0; nt < 8; ++nt) { \
                    const s16x4 lo = TR16(TL + (4 * g + (i16 >> 2)) * 136 + 16 * nt + 4 * (i16 & 3)); \
                    const s16x4 hi = TR16(TL + (16 + 4 * g + (i16 >> 2)) * 136 + 16 * nt + 4 * (i16 & 3)); \
                    const bf16x8 B = (bf16x8){lo[0], lo[1], lo[2], lo[3], hi[0], hi[1], hi[2], hi[3]}; \
                    O[nt] = MFMA16(A, B, O[nt]); } \
                WAVE_LDS_FENCE(); } while (0)
            if (ns == 256) { ATT_LOAD(gvA, 0, true); for (int ck2 = 0; ck2 < 8; ++ck2) ATT_STEP(gvA, ck2, true); }
            else { ATT_LOAD(gvA, 0, false); for (int ck2 = 0; ck2 < nch; ++ck2) ATT_STEP(gvA, ck2, false); }
#undef ATT_STEP
#undef ATT_LOAD
            lrun += SHFL_XOR(lrun, 16); lrun += SHFL_XOR(lrun, 32);
            float li[4];
#pragma unroll
            for (int r = 0; r < 4; ++r) li[r] = FRCP(SHFL(lrun, r));
            if (g == 0) {
#pragma unroll
                for (int nt = 0; nt < 8; ++nt)
#pragma unroll
                    for (int r = 0; r < 4; ++r) OLw[(rr * 4 + r) * 128 + 16 * nt + i16] = (bf16)f2bf(O[nt][r] * li[r]);
            }
        }
        bf16x8 Wf[4][4];
#pragma unroll
        for (int ks = 0; ks < 4; ++ks)
#pragma unroll
            for (int nt = 0; nt < 4; ++nt) Wf[ks][nt] = *(const bf16x8*)(WUVT + ((size_t)((w >> 1) * 64 + 16 * nt + i16)) * 128 + 32 * ks + 8 * g);
        SYNC();
        {
            const int h = w >> 1, mtile = w & 1, q = 16 * mtile + i16;
            const bf16* olq = (const bf16*)(F.lds + (q >> 2) * DS_SLOT + 8704) + ((q & 3) * 4 + h) * 128;
            float gaw[4];
#pragma unroll
            for (int nt = 0; nt < 4; ++nt) gaw[nt] = PIN(F, I_GNW)[l * DM + 768 + h * 64 + 16 * nt + i16];
            f32x4 acc[4];
#pragma unroll
            for (int nt = 0; nt < 4; ++nt) acc[nt] = (f32x4){0.f, 0.f, 0.f, 0.f};
#pragma unroll
            for (int ks = 0; ks < 4; ++ks) { const bf16x8 A = *(const bf16x8*)(olq + 32 * ks + 8 * g);
#pragma unroll
                for (int nt = 0; nt < 4; ++nt) acc[nt] = MFMA16(A, Wf[ks][nt], acc[nt]); }
#pragma unroll
            for (int r = 0; r < 4; ++r) { float s = (acc[0][r] * acc[0][r] + acc[1][r] * acc[1][r]) + (acc[2][r] * acc[2][r] + acc[3][r] * acc[3][r]);
                s += SHFL_XOR(s, 1); s += SHFL_XOR(s, 2); s += SHFL_XOR(s, 4); s += SHFL_XOR(s, 8);
                if (i16 == 0) SS[(16 * mtile + 4 * g + r) * 4 + h] = s; }
            SYNC();
#pragma unroll
            for (int r = 0; r < 4; ++r) { const int qq = 16 * mtile + 4 * g + r; const f32x4 s4 = *(const f32x4*)(SS + qq * 4);
                const float rs = RSQ(((s4.x + s4.y) + (s4.z + s4.w)) * (1.0f / 256.0f) + NORM_EPS);
                bf16* dst = CAT + (mb + t0 + qq) * DM + 768 + h * 64 + i16;
#pragma unroll
                for (int nt = 0; nt < 4; ++nt) dst[16 * nt] = (bf16)f2bf(acc[nt][r] * rs * gaw[nt]); }
        }
        SYNC();
    }
}
#ifndef HOST_EMU
namespace pg8 {
#define PG8_LAS __attribute__((address_space(3)))
typedef unsigned short bf16_t;
typedef short bf16x8 __attribute__((ext_vector_type(8)));
typedef float f32x4 __attribute__((ext_vector_type(4)));
typedef unsigned u32x4 __attribute__((ext_vector_type(4)));
constexpr int BM = 256, BK = 64, HALF = 128, HTB = HALF * BK * 2  , STAGE_BYTES = 8 * HTB, NXCD = 8, WGM = 8;

__host__ __device__ __forceinline__ int lds_byte(int r, int c) { const int st = (r >> 4) * 2 + (c >> 5), rr = r & 15, cc = c & 31, ob = rr * 64 + cc * 2; return st * 1024 + (ob ^ (((ob >> 9) & 1) << 5)); }
__host__ __device__ __forceinline__ void stage_rc(int b, int& R, int& C) { const int st = b / 1024, sb = b % 1024, swz = sb ^ (((sb >> 9) & 1) << 5); R = (st >> 1) * 16 + swz / 64; C = (st & 1) * 32 + (swz % 64) / 2; }
__host__ __device__ __forceinline__ int perm32(int rho) { const int n = rho >> 4, i = rho & 15; return 8 * (i >> 2) + 4 * n + (i & 3); }

struct Unit { int pm, pn; };
struct Gemm { const bf16_t* A; const bf16_t* Bt; int M, N, K; };

struct StaticOrder {
    int nM, nN, nwg, G, c;
    __host__ __device__ void init(int M, int N, int G_, int c_) { nM = M / BM; nN = N / BM; nwg = nM * nN; G = G_; c = c_; }
    __host__ __device__ bool next(int i, Unit& u) const {
        const long L = (long)i * G + c; if (L >= nwg) return false;
        int wgid = (int)L; { const int q = nwg / NXCD, r = nwg % NXCD, xcd = wgid % NXCD, off = wgid / NXCD; wgid = (xcd < r ? xcd * (q + 1) : r * (q + 1) + (xcd - r) * q) + off; }
        const int nig = WGM * nN, gid = wgid / nig, fm = gid * WGM, gsz = (nM - fm) < WGM ? (nM - fm) : WGM;
        u.pm = fm + ((wgid % nig) % gsz); u.pn = (wgid % nig) / gsz; return true;
    }
    __device__ __forceinline__ void a_ready(const Unit&) const {}
    __device__ __forceinline__ void done(const Unit&) const {}
};
__device__ __forceinline__ unsigned cvt_pk_bf16(float lo, float hi) { unsigned r; asm volatile("v_cvt_pk_bf16_f32 %0, %1, %2" : "=v"(r) : "v"(lo), "v"(hi)); return r; }
template <class Epi, class Sched, bool ALIGN_EPI = false, bool SP2 = false>
__device__ __forceinline__ void gemm_phase(PG8_LAS unsigned char* lds, const Gemm g, const Sched& S, const Epi& E, const int tid_in) {
    const int tid = tid_in, wid = __builtin_amdgcn_readfirstlane(tid >> 6), lane = tid & 63, wr = wid >> 2, wc = wid & 3, fr = lane & 15, fq = lane >> 4;
    const int K = g.K, nt = K / BK;
    unsigned voffA[2], voffB[2];
#pragma unroll
    for (int i = 0; i < 2; ++i) { int R, C; stage_rc(tid * 16 + i * 8192, R, C); const int Rb = Epi::PERM ? ((R & ~31) + perm32(R & 31)) : R;
        voffA[i] = (unsigned)(R * K + C) * 2u; voffB[i] = (unsigned)(Rb * K + C) * 2u; }
    const size_t kstep = (size_t)(BK * 2);
    const size_t hstep = (size_t)HALF * K * 2;
    const size_t tstep = 2 * hstep;
    const unsigned ldsw = (unsigned)wid * 1024u;
    const int aoff = lds_byte(wr * 64 + fr, fq * 8), boff = lds_byte(wc * 32 + fr, fq * 8);
#define PG8_SA(b, h) (((b) * 2 + (h)) * HTB)
#define PG8_SB(b, h) ((4 + (b) * 2 + (h)) * HTB)
#define PG8_STAGE(bufoff, gbase, voff) do { _Pragma("unroll") for (int _i = 0; _i < 2; ++_i) \
        __builtin_amdgcn_global_load_lds((const unsigned*)((const char*)(gbase) + (voff)[_i]), (PG8_LAS unsigned*)(lds + (bufoff) + ldsw + _i * 8192), 16, 0, 0); } while (0)
#define PG8_LDA(dst, b, h) do { _Pragma("unroll") for (int m = 0; m < 4; ++m) _Pragma("unroll") for (int k = 0; k < 2; ++k) dst[m][k] = *(const PG8_LAS bf16x8*)(lds + PG8_SA(b, h) + aoff + m * 2048 + k * 1024); } while (0)
#define PG8_LDB(dst, b, h) do { _Pragma("unroll") for (int n = 0; n < 2; ++n) _Pragma("unroll") for (int k = 0; k < 2; ++k) dst[n][k] = *(const PG8_LAS bf16x8*)(lds + PG8_SB(b, h) + boff + n * 2048 + k * 1024); } while (0)
#define PG8_MMA(ai, bj, At, Bt) do { __builtin_amdgcn_s_setprio(1); _Pragma("unroll") for (int m = 0; m < 4; ++m) _Pragma("unroll") for (int n = 0; n < 2; ++n) _Pragma("unroll") for (int k = 0; k < 2; ++k) \
        acc[ai][bj][m][n] = __builtin_amdgcn_mfma_f32_16x16x32_bf16(Bt[n][k], At[m][k], acc[ai][bj][m][n], 0, 0, 0); __builtin_amdgcn_s_setprio(0); } while (0)
#define PG8_WAIT_V(n) asm volatile("s_waitcnt vmcnt(" #n ")" ::: "memory")
#define PG8_WAIT_L(n) asm volatile("s_waitcnt lgkmcnt(" #n ")" ::: "memory")
#define PG8_BAR __builtin_amdgcn_s_barrier()
#define PG8_SCHED __builtin_amdgcn_sched_barrier(0)
    Unit cur, nxt; int ui = 0;
    if (!S.next(0, cur)) return;
    f32x4 acc[2][2][4][2];
#pragma unroll
    for (int a = 0; a < 2; ++a)
#pragma unroll
        for (int b = 0; b < 2; ++b)
#pragma unroll
            for (int m = 0; m < 4; ++m)
#pragma unroll
                for (int n = 0; n < 2; ++n) acc[a][b][m][n] = (f32x4){0.f, 0.f, 0.f, 0.f};
    bf16x8 At[4][2], B0[2][2], B1[2][2];
    const char* cA = (const char*)g.A + (size_t)cur.pm * tstep; const char* cB = (const char*)g.Bt + (size_t)cur.pn * tstep;
    S.a_ready(cur);
    if constexpr (SP2) {
        PG8_STAGE(PG8_SB(0, 0), cB, voffB); PG8_STAGE(PG8_SB(0, 1), cB + hstep, voffB); PG8_STAGE(PG8_SA(0, 0), cA, voffA); PG8_STAGE(PG8_SA(0, 1), cA + hstep, voffA);
        if (wr == 1) PG8_BAR;
        PG8_WAIT_V(2); PG8_BAR;
        PG8_STAGE(PG8_SB(1, 0), cB + kstep, voffB); PG8_STAGE(PG8_SA(1, 0), cA + kstep, voffA); PG8_STAGE(PG8_SB(1, 1), cB + hstep + kstep, voffB);
        PG8_WAIT_V(6); PG8_BAR;
    } else {
        PG8_STAGE(PG8_SB(0, 0), cB, voffB); PG8_STAGE(PG8_SA(0, 0), cA, voffA); PG8_STAGE(PG8_SB(0, 1), cB + hstep, voffB); PG8_STAGE(PG8_SA(0, 1), cA + hstep, voffA);
        if (wr == 1) PG8_BAR;
        PG8_WAIT_V(4); PG8_BAR;
        PG8_STAGE(PG8_SB(1, 0), cB + kstep, voffB); PG8_STAGE(PG8_SA(1, 0), cA + kstep, voffA); PG8_STAGE(PG8_SB(1, 1), cB + hstep + kstep, voffB);
        PG8_WAIT_V(6); PG8_BAR;
    }
    for (;;) {
        const bool has_next = S.next(ui + 1, nxt);
        const char* nA = has_next ? (const char*)g.A + (size_t)nxt.pm * tstep : cA; const char* nB = has_next ? (const char*)g.Bt + (size_t)nxt.pn * tstep : cB;
#pragma unroll 1
        for (int t = 0; t < nt; t += 2) {
            const bool last = (t == nt - 2);
            const char* a1 = cA + (size_t)(t + 1) * kstep;
            const char* a2 = last ? nA : cA + (size_t)(t + 2) * kstep; const char* b2 = last ? nB : cB + (size_t)(t + 2) * kstep;
            const char* a3 = a2 + kstep; const char* b3 = b2 + kstep;
            if (last && has_next) S.a_ready(nxt);
            if constexpr (Epi::NORM) { if (t == 2) E.prefetch(cur, tid, wid); if (t == 4) E.reduce_rs(tid); }
            if constexpr (SP2) {
            PG8_LDB(B0, 0, 0); PG8_LDB(B1, 0, 1); PG8_SCHED; PG8_LDA(At, 0, 0); PG8_STAGE(PG8_SA(1, 1), a1 + hstep, voffA);
            PG8_WAIT_V(8); PG8_WAIT_L(0); PG8_BAR; PG8_MMA(0, 0, At, B0); PG8_MMA(0, 1, At, B1); PG8_BAR; PG8_SCHED;
            PG8_LDA(At, 0, 1); PG8_STAGE(PG8_SB(0, 0), b2, voffB); PG8_STAGE(PG8_SB(0, 1), b2 + hstep, voffB); PG8_STAGE(PG8_SA(0, 0), a2, voffA);
            PG8_WAIT_V(8); PG8_WAIT_L(0); PG8_BAR; PG8_MMA(1, 0, At, B0); PG8_MMA(1, 1, At, B1); PG8_BAR; PG8_SCHED;
            PG8_LDB(B0, 1, 0); PG8_LDB(B1, 1, 1); PG8_SCHED; PG8_LDA(At, 1, 0); PG8_STAGE(PG8_SA(0, 1), a2 + hstep, voffA);
            PG8_WAIT_V(8); PG8_WAIT_L(0); PG8_BAR; PG8_MMA(0, 0, At, B0); PG8_MMA(0, 1, At, B1); PG8_BAR; PG8_SCHED;
            PG8_LDA(At, 1, 1); PG8_STAGE(PG8_SB(1, 0), b3, voffB); PG8_STAGE(PG8_SB(1, 1), b3 + hstep, voffB); PG8_STAGE(PG8_SA(1, 0), a3, voffA);
            PG8_WAIT_V(8); PG8_WAIT_L(0); PG8_BAR; PG8_MMA(1, 0, At, B0); PG8_MMA(1, 1, At, B1); PG8_BAR; PG8_SCHED;
            } else {
            PG8_LDB(B0, 0, 0); PG8_SCHED; PG8_LDA(At, 0, 0); PG8_STAGE(PG8_SA(1, 1), a1 + hstep, voffA);
            PG8_WAIT_L(8); PG8_BAR; PG8_WAIT_L(0); PG8_MMA(0, 0, At, B0); PG8_BAR; PG8_SCHED;
            PG8_LDB(B1, 0, 1); PG8_STAGE(PG8_SB(0, 0), b2, voffB);
            PG8_BAR; PG8_WAIT_L(0); PG8_MMA(0, 1, At, B1); PG8_BAR;
            PG8_LDA(At, 0, 1); PG8_STAGE(PG8_SA(0, 0), a2, voffA);
            PG8_BAR; PG8_WAIT_L(0); PG8_MMA(1, 0, At, B0); PG8_BAR; PG8_SCHED;
            PG8_STAGE(PG8_SB(0, 1), b2 + hstep, voffB);
            PG8_WAIT_V(6); PG8_BAR; PG8_MMA(1, 1, At, B1); PG8_BAR;
            PG8_LDB(B0, 1, 0); PG8_SCHED; PG8_LDA(At, 1, 0); PG8_STAGE(PG8_SA(0, 1), a2 + hstep, voffA);
            PG8_WAIT_L(8); PG8_BAR; PG8_WAIT_L(0); PG8_MMA(0, 0, At, B0); PG8_BAR; PG8_SCHED;
            PG8_LDB(B1, 1, 1); PG8_STAGE(PG8_SB(1, 0), b3, voffB);
            PG8_BAR; PG8_WAIT_L(0); PG8_MMA(0, 1, At, B1); PG8_BAR;
            PG8_LDA(At, 1, 1); PG8_STAGE(PG8_SA(1, 0), a3, voffA);
            PG8_BAR; PG8_WAIT_L(0); PG8_MMA(1, 0, At, B0); PG8_BAR; PG8_SCHED;
            PG8_STAGE(PG8_SB(1, 1), b3 + hstep, voffB);
            PG8_WAIT_V(6); PG8_BAR; PG8_MMA(1, 1, At, B1); PG8_BAR;
            }
        }
        if constexpr (ALIGN_EPI) { if (wr == 0) PG8_BAR; }
        if constexpr (!Epi::AFTER_DRAIN) { E(acc, cur, wr, wc, fr, fq); S.done(cur); }
        if (!has_next) break;
#pragma unroll
        for (int a = 0; a < 2; ++a)
#pragma unroll
            for (int b = 0; b < 2; ++b)
#pragma unroll
                for (int m = 0; m < 4; ++m)
#pragma unroll
                    for (int n = 0; n < 2; ++n) acc[a][b][m][n] = (f32x4){0.f, 0.f, 0.f, 0.f};
        cur = nxt; cA = nA; cB = nB; ++ui;
        if constexpr (ALIGN_EPI) { if (wr == 1) PG8_BAR; }
    }
    PG8_WAIT_V(0);
    if constexpr (!ALIGN_EPI) { if (wr == 0) PG8_BAR; }
    PG8_BAR;
    if constexpr (Epi::AFTER_DRAIN) { E.fused(acc, cur, wr, wc, fr, fq, lds, wid, lane); S.done(cur); }
#undef PG8_SA
#undef PG8_SB
#undef PG8_STAGE
#undef PG8_LDA
#undef PG8_LDB
#undef PG8_MMA
#undef PG8_WAIT_V
#undef PG8_WAIT_L
#undef PG8_BAR
#undef PG8_SCHED
}
}
namespace pg8 {
template <int ACT  > struct EpiRoute {
    static constexpr bool PERM = true, AFTER_DRAIN = false, NORM = false;
    bf16_t* O0; int ld0; bf16_t* O1; int ld1; int split;
    __device__ __forceinline__ void operator()(const f32x4 (&acc)[2][2][4][2], const Unit& u, int wr, int wc, int fr, int fq) const {
        const int row0 = u.pm * BM + wr * 64 + fr; const bool first = u.pn < split;
        bf16_t* base = first ? O0 : O1; const int ld = first ? ld0 : ld1; const int col0 = (first ? u.pn : u.pn - split) * BM + wc * 32 + 8 * fq;
#pragma unroll
        for (int ai = 0; ai < 2; ++ai)
#pragma unroll
            for (int m = 0; m < 4; ++m) { bf16_t* rowp = base + (size_t)(row0 + ai * HALF + m * 16) * ld + col0;
#pragma unroll
                for (int bj = 0; bj < 2; ++bj) { f32x4 v0 = acc[ai][bj][m][0], v1 = acc[ai][bj][m][1];
                    if (ACT == 1) {
#pragma unroll
                        for (int e = 0; e < 4; ++e) { const float a = fmaxf(v0[e], 0.f), b = fmaxf(v1[e], 0.f); v0[e] = a * a; v1[e] = b * b; } }
                    u32x4 w; w.x = cvt_pk_bf16(v0[0], v0[1]); w.y = cvt_pk_bf16(v0[2], v0[3]); w.z = cvt_pk_bf16(v1[0], v1[1]); w.w = cvt_pk_bf16(v1[2], v1[3]);
                    *(u32x4*)(rowp + bj * HALF) = w; } }
    }
};
struct EpiResid {
    static constexpr bool PERM = true, AFTER_DRAIN = false, NORM = false;
    const float* xsrc; float* xdst; const float* gate;
    __device__ __forceinline__ void operator()(const f32x4 (&acc)[2][2][4][2], const Unit& u, int wr, int wc, int fr, int fq) const {
        const int row0 = u.pm * BM + wr * 64 + fr, col0 = u.pn * BM + wc * 32 + 8 * fq, b = (u.pm * BM) >> 12;
        f32x4 gv[2][2];
#pragma unroll
        for (int bj = 0; bj < 2; ++bj)
#pragma unroll
            for (int n = 0; n < 2; ++n) gv[bj][n] = *(const f32x4*)(gate + (size_t)b * 6144 + col0 + bj * HALF + 4 * n);
#pragma unroll
        for (int ai = 0; ai < 2; ++ai)
#pragma unroll
            for (int m = 0; m < 4; ++m) { const size_t off = (size_t)(row0 + ai * HALF + m * 16) * 1024 + col0;
#pragma unroll
                for (int bj = 0; bj < 2; ++bj)
#pragma unroll
                    for (int n = 0; n < 2; ++n) { const f32x4 xs = *(const f32x4*)(xsrc + off + bj * HALF + 4 * n);
                        *(f32x4*)(xdst + off + bj * HALF + 4 * n) = xs + gv[bj][n] * acc[ai][bj][m][n]; }
                if (m & 1) asm volatile("" ::: "memory"); }
    }
};
constexpr int EPI_OFF = 133120;
template <int ACT  > struct EpiRouteN {
    static constexpr bool PERM = true, AFTER_DRAIN = false, NORM = true;
    bf16_t* O; int ld; const float* RSP; const float* shw; PG8_LAS unsigned char* lds;
    __device__ __forceinline__ void prefetch(const Unit& u, int tid, int wid) const {
        const char* src = (const char*)RSP + (size_t)u.pm * (BM * 64) + (size_t)tid * 16;
#pragma unroll
        for (int i = 0; i < 2; ++i) __builtin_amdgcn_global_load_lds((const unsigned*)(src + i * 8192), (PG8_LAS unsigned*)(lds + EPI_OFF + wid * 1024 + i * 8192), 16, 0, 0);
        if (wid == 0) { const char* s2 = (const char*)(shw + (size_t)((u.pm * BM) >> 12) * NSHW + u.pn * BM) + (size_t)(tid & 63) * 16;
            __builtin_amdgcn_global_load_lds((const unsigned*)s2, (PG8_LAS unsigned*)(lds + EPI_OFF + 16384), 16, 0, 0); }
    }
    __device__ __forceinline__ void reduce_rs(int tid) const {
        if (tid < 256) { const PG8_LAS f32x4* p = (const PG8_LAS f32x4*)(lds + EPI_OFF + tid * 64); const f32x4 a = p[0], b = p[1], c = p[2], d = p[3];
            const float s = (((a.x + a.y) + (a.z + a.w)) + ((b.x + b.y) + (b.z + b.w))) + (((c.x + c.y) + (c.z + c.w)) + ((d.x + d.y) + (d.z + d.w)));
            *(PG8_LAS float*)(lds + EPI_OFF + 17408 + tid * 4) = __builtin_amdgcn_rsqf(s * (1.0f / 1024.0f) + 1e-6f); }
    }
    __device__ __forceinline__ void operator()(const f32x4 (&acc)[2][2][4][2], const Unit& u, int wr, int wc, int fr, int fq) const {
        const int row0 = u.pm * BM + wr * 64 + fr, col0 = u.pn * BM + wc * 32 + 8 * fq;
        const PG8_LAS unsigned char* ep = lds + EPI_OFF;
        float rs[2][4];
#pragma unroll
        for (int ai = 0; ai < 2; ++ai)
#pragma unroll
            for (int m = 0; m < 4; ++m) rs[ai][m] = *(const PG8_LAS float*)(ep + 17408 + (wr * 64 + fr + ai * HALF + m * 16) * 4);
        f32x4 sv[2][2];
#pragma unroll
        for (int bj = 0; bj < 2; ++bj)
#pragma unroll
            for (int n = 0; n < 2; ++n) sv[bj][n] = *(const PG8_LAS f32x4*)(ep + 16384 + (bj * HALF + wc * 32 + 8 * fq + 4 * n) * 4);
#pragma unroll
        for (int ai = 0; ai < 2; ++ai)
#pragma unroll
            for (int m = 0; m < 4; ++m) { bf16_t* rowp = O + (size_t)(row0 + ai * HALF + m * 16) * ld + col0;
#pragma unroll
                for (int bj = 0; bj < 2; ++bj) { f32x4 v0 = acc[ai][bj][m][0] * rs[ai][m] + sv[bj][0], v1 = acc[ai][bj][m][1] * rs[ai][m] + sv[bj][1];
                    if (ACT == 1) {
#pragma unroll
                        for (int e = 0; e < 4; ++e) { const float a = fmaxf(v0[e], 0.f), b = fmaxf(v1[e], 0.f); v0[e] = a * a; v1[e] = b * b; } }
                    u32x4 w; w.x = cvt_pk_bf16(v0[0], v0[1]); w.y = cvt_pk_bf16(v0[2], v0[3]); w.z = cvt_pk_bf16(v1[0], v1[1]); w.w = cvt_pk_bf16(v1[2], v1[3]);
                    *(u32x4*)(rowp + bj * HALF) = w; } }
    }
};
template <bool MAYSKIP> struct EpiResidXS {
    static constexpr bool PERM = true, AFTER_DRAIN = false, NORM = false;
    const bf16_t* xsrc; bf16_t* xdst; const float* gate; const float* wp; bf16_t* XS; float* RSP; int doxs;
    template <bool DOXS> __device__ __forceinline__ void body(const f32x4 (&acc)[2][2][4][2], const Unit& u, int wr, int wc, int fr, int fq) const {
        const int row0 = u.pm * BM + wr * 64 + fr, col0 = u.pn * BM + wc * 32 + 8 * fq, b = (u.pm * BM) >> 12;
        f32x4 gv[2][2], wv[2][2]; float ssv[2][4];
#pragma unroll
        for (int bj = 0; bj < 2; ++bj)
#pragma unroll
            for (int n = 0; n < 2; ++n) { gv[bj][n] = *(const f32x4*)(gate + (size_t)b * 6144 + col0 + bj * HALF + 4 * n);
                if (DOXS) wv[bj][n] = *(const f32x4*)(wp + (size_t)b * 1024 + col0 + bj * HALF + 4 * n); }
#pragma unroll
        for (int aim = 0; aim < 4; ++aim) { const int ai = aim >> 1, m0_ = (aim & 1) * 2;
            u32x4 xr[4][2];
#pragma unroll
            for (int m = m0_; m < m0_ + 2; ++m)
#pragma unroll
                for (int bj = 0; bj < 2; ++bj) xr[m][bj] = *(const u32x4*)(xsrc + (size_t)(row0 + ai * HALF + m * 16) * 1024 + col0 + bj * HALF);
#pragma unroll
            for (int m = m0_; m < m0_ + 2; ++m) { const size_t off = (size_t)(row0 + ai * HALF + m * 16) * 1024 + col0; float ss = 0.f;
#pragma unroll
                for (int bj = 0; bj < 2; ++bj) { const u32x4 r = xr[m][bj];
                    const f32x4 x0 = (f32x4){bflo(r.x), bfhi(r.x), bflo(r.y), bfhi(r.y)}, x1 = (f32x4){bflo(r.z), bfhi(r.z), bflo(r.w), bfhi(r.w)};
                    const f32x4 y0 = x0 + gv[bj][0] * acc[ai][bj][m][0], y1 = x1 + gv[bj][1] * acc[ai][bj][m][1];
                    u32x4 w; w.x = cvt_pk_bf16(y0[0], y0[1]); w.y = cvt_pk_bf16(y0[2], y0[3]); w.z = cvt_pk_bf16(y1[0], y1[1]); w.w = cvt_pk_bf16(y1[2], y1[3]);
                    *(u32x4*)(xdst + off + bj * HALF) = w;
                    if (DOXS) { const f32x4 a = y0 * wv[bj][0], c = y1 * wv[bj][1];
                        u32x4 v; v.x = cvt_pk_bf16(a[0], a[1]); v.y = cvt_pk_bf16(a[2], a[3]); v.z = cvt_pk_bf16(c[0], c[1]); v.w = cvt_pk_bf16(c[2], c[3]);
                        *(u32x4*)(XS + off + bj * HALF) = v;
                        ss += ((y0.x * y0.x + y0.y * y0.y) + (y0.z * y0.z + y0.w * y0.w)) + ((y1.x * y1.x + y1.y * y1.y) + (y1.z * y1.z + y1.w * y1.w)); } }
                ssv[ai][m] = ss; }
            asm volatile("" ::: "memory"); }
        if (DOXS) { float t1[2][4];
#pragma unroll
            for (int ai = 0; ai < 2; ++ai)
#pragma unroll
                for (int m = 0; m < 4; ++m) t1[ai][m] = __shfl_xor(ssv[ai][m], 16);
#pragma unroll
            for (int ai = 0; ai < 2; ++ai)
#pragma unroll
                for (int m = 0; m < 4; ++m) { ssv[ai][m] += t1[ai][m]; t1[ai][m] = __shfl_xor(ssv[ai][m], 32); }
            if (fq == 0) {
#pragma unroll
                for (int ai = 0; ai < 2; ++ai)
#pragma unroll
                    for (int m = 0; m < 4; ++m) RSP[(size_t)(row0 + ai * HALF + m * 16) * 16 + u.pn * 4 + wc] = ssv[ai][m] + t1[ai][m]; } }
    }
    __device__ __forceinline__ void operator()(const f32x4 (&acc)[2][2][4][2], const Unit& u, int wr, int wc, int fr, int fq) const {
        if (!MAYSKIP || doxs) body<true>(acc, u, wr, wc, fr, fq); else body<false>(acc, u, wr, wc, fr, fq);
    }
};
}

#define RLX_AGENT __ATOMIC_RELAXED, __HIP_MEMORY_SCOPE_AGENT
#define XB_TMO      128
#define XB_XCNT(j)  (256  + 64 * (j))
#define XB_XSUB(j)  (1280 + 64 * (j))
#define XB_XGEN(j)  (2304 + 64 * (j))
#define XB_TOP      3328
#define XB_TOPGEN   3392
#define XCD_BAR_WORDS 3456
#define XB_SPIN_CAP (1u << 24)

__device__ __forceinline__ unsigned xb_ld(unsigned* p)              { return __hip_atomic_load(p, __ATOMIC_RELAXED, __HIP_MEMORY_SCOPE_AGENT); }
__device__ __forceinline__ unsigned xb_add(unsigned* p, unsigned v) { return __hip_atomic_fetch_add(p, v, __ATOMIC_RELAXED, __HIP_MEMORY_SCOPE_AGENT); }
__device__ __forceinline__ unsigned xb_xcc_id() { return (unsigned)__builtin_amdgcn_s_getreg((3 << 11) | 20) & 0xFu; }
#define XB_SPIN(cond, bar) do { unsigned _sp = 0; while (cond) { __builtin_amdgcn_s_sleep(1); \
    if ((++_sp & 255u) == 0u) { if (xb_ld(&(bar)[XB_TMO])) break; if (_sp > XB_SPIN_CAP) { atomicAdd(&(bar)[XB_TMO], 1u); break; } } } } while (0)

struct XcdBarrier {
    unsigned* bar; unsigned x;
    volatile LAS unsigned* st;
};

__device__ __forceinline__ XcdBarrier xcd_barrier_post(unsigned* bar, volatile LAS unsigned* st) {
    XcdBarrier b; b.bar = bar; b.x = xb_xcc_id(); b.st = st;
    if (threadIdx.x == 0) (void)xb_add(&bar[XB_XCNT(b.x)], 1u);
    return b;
}
__device__ __forceinline__ void xcd_barrier_complete(unsigned* bar, unsigned x, unsigned& nloc, unsigned& nx) {
    const unsigned G = gridDim.x * gridDim.y * gridDim.z;
    unsigned sum, cnt, mine, sp = 0u;
    for (;;) {
        sum = 0u; cnt = 0u; mine = 0u;
#pragma unroll
        for (unsigned j = 0; j < 16; ++j) { const unsigned c = xb_ld(&bar[XB_XCNT(j)]); sum += c; cnt += (c > 0u) ? 1u : 0u; mine = (j == x) ? c : mine; }
        if (sum == G) break;
        __builtin_amdgcn_s_sleep(1);
        if ((++sp & 255u) == 0u) { if (xb_ld(&bar[XB_TMO])) break; if (sp > XB_SPIN_CAP) { atomicAdd(&bar[XB_TMO], 1u); break; } }
    }
    nloc = mine > 0u ? mine : 1u; nx = cnt > 0u ? cnt : 1u;
}

__device__ __forceinline__ void xcd_barrier(const XcdBarrier& b) {
    asm volatile("s_waitcnt vmcnt(0)" ::: "memory");
    __syncthreads();
    if (threadIdx.x == 0) {
        unsigned* bar = b.bar;
        __builtin_amdgcn_s_waitcnt(0);
        unsigned nloc = b.st[0], nx = b.st[1];
        if (nloc == 0u) { xcd_barrier_complete(bar, b.x, nloc, nx); b.st[0] = nloc; b.st[1] = nx; }
        const unsigned old = xb_add(&bar[XB_XSUB(b.x)], 1u);
        const unsigned gen = old / nloc;
        if (old + 1u == (gen + 1u) * nloc) {
            __builtin_amdgcn_fence(__ATOMIC_RELEASE, "agent");
            asm volatile("s_waitcnt vmcnt(0)" ::: "memory");
            const unsigned og = xb_add(&bar[XB_TOP], 1u);
            const unsigned tg = og / nx;
            if (og + 1u == (tg + 1u) * nx) xb_add(&bar[XB_TOPGEN], 1u);
            else XB_SPIN(xb_ld(&bar[XB_TOPGEN]) == tg, bar);
            __builtin_amdgcn_fence(__ATOMIC_ACQUIRE, "agent");
            xb_add(&bar[XB_XGEN(b.x)], 1u);
            asm volatile("s_waitcnt vmcnt(0)" ::: "memory");
        } else {
            XB_SPIN(xb_ld(&bar[XB_XGEN(b.x)]) == gen, bar);
            __builtin_amdgcn_fence(__ATOMIC_ACQUIRE, "agent");
            asm volatile("s_waitcnt vmcnt(0)" ::: "memory");
        }
    }
    __syncthreads();
}

#ifndef PH_MASK
#define PH_MASK 0xFFFFF
#endif
#define EN(b) if constexpr ((PH_MASK >> (b)) & 1)
#ifndef DUP_MASK
#define DUP_MASK 0
#endif
#define DUP(b) if constexpr ((DUP_MASK >> (b)) & 1)
#define DBG_DIGEST_N 256
#define DBG_DIGEST_VAL(m, c) bf2f(((const bf16*)(wsp + WS_CAT))[(size_t)(m) * DM + 768 + (c)])
#ifndef DBG_PH_HI
#define DBG_PH_HI NPHASE
#endif
#ifndef MK_MULTI
#define MK_MULTI 0
#endif
constexpr int LDS_BYTES = 151552, MISC_OFF = 131072 + 320;
#ifndef DBG_LAYERS
#define DBG_LAYERS 4
#define DBG_L0 0
#endif
constexpr int NPHASE = 3 + 7 * DBG_LAYERS;
__global__ void __launch_bounds__(512, 2) hymba_fwd(Args a) {
    extern __shared__ __attribute__((aligned(16))) unsigned char lds[];
    Ctx F0;
    Ctx& F = F0;
    F.lds = (char*)lds; F.tid = threadIdx.x; F.lane = F.tid & 63; F.wave = __builtin_amdgcn_readfirstlane(F.tid >> 6); F.G = gridDim.x; F.bid = blockIdx.x;
    F.A = nullptr; F.ws = a.ws;
    if (F.tid < 29) ((unsigned long long*)(lds + PTR_OFF))[F.tid] = F.tid < 28 ? (unsigned long long)a.in[F.tid] : (unsigned long long)a.out;
    volatile LAS unsigned* MISC = (volatile LAS unsigned*)((LAS unsigned char*)lds + MISC_OFF);
    if (F.tid < 32) MISC[F.tid] = 0u;
    __syncthreads();
    unsigned* ctl = (unsigned*)(a.ws + WS_CTL);
    XcdBarrier bar; bar.bar = ctl + CW_BAR; bar.x = 0; bar.st = nullptr;
    if (!MK_MULTI) bar = xcd_barrier_post(ctl + CW_BAR, MISC + 8);
    const int lo = a.ph_lo, hi = a.ph_hi;
    int ph = 0;
#define PH_BEGIN if (lo <= ph && ph < hi) { Ctx F = F0; unsigned long long wsl_ = (unsigned long long)F0.ws; asm volatile("" : "+v"(F.tid), "+s"(F.bid), "+s"(F.G), "+s"(wsl_)); F.ws = (unsigned char*)(__attribute__((address_space(1))) unsigned char*)wsl_; F.lane = F.tid & 63; F.wave = __builtin_amdgcn_readfirstlane(F.tid >> 6); unsigned char* const wsp = F.ws; (void)wsp;
#define PH_END   if (!MK_MULTI && ph + 1 < hi) { XcdBarrier bb = bar; asm volatile("" : "+s"(bb.bar), "+s"(bb.x)); xcd_barrier(bb); } else __syncthreads(); } ++ph;
    PG8_LAS unsigned char* glds = (PG8_LAS unsigned char*)lds;
#define XN ((bf16*)(wsp + WS_XN))
#define PROJ ((bf16*)(wsp + WS_PROJ))
#define CAT ((bf16*)(wsp + WS_CAT))
#define HB ((bf16*)(wsp + WS_HB))
    PH_BEGIN EN(0) ph_prologue(F); DUP(0) { __syncthreads(); ph_prologue(F); } PH_END
    PH_BEGIN EN(1) { ph_shw(F); ph_xs0(F, PIN(F, I_X), PIN(F, I_N1W) + DBG_L0 * DM, (const float*)(wsp + WS_MOD) + (size_t)DBG_L0 * BATCH * NADA, DM, XN, (float*)(wsp + WS_RSP), (bf16*)POUT(F)); } PH_END
    for (int l_ = 0; l_ < DBG_LAYERS; ++l_) { const int l = l_ + DBG_L0;
        #define modl ((const float*)(wsp + WS_MOD) + (size_t)l * BATCH * NADA)
        #define xsrc (l_ == 0 ? PIN(F, I_X) : (const float*)POUT(F))
        PH_BEGIN
#if defined(PROBE_GA)
            { pg8::Gemm g{XN, (const bf16*)(wsp + WS_WIN) + (size_t)l * NPROJ * DM, MTOK, NPROJ, DM}; pg8::StaticOrder S; S.init(MTOK, NPROJ, F.G, F.bid);
            pg8::EpiRoute<0> E{PROJ, NPROJ, PROJ, NPROJ, 1 << 20};
            pg8::gemm_phase<pg8::EpiRoute<0>, pg8::StaticOrder, true, true>(glds, g, S, E, F.tid); } __syncthreads();
#elif defined(PROBE_GB)
            { pg8::Gemm g{XN, (const bf16*)(wsp + WS_WIN) + (size_t)l * NPROJ * DM, MTOK, NPROJ, DM}; pg8::StaticOrder S; S.init(MTOK, NPROJ, F.G, F.bid);
            pg8::EpiRouteN<0> E{PROJ, NPROJ, (const float*)(wsp + WS_RSP), (const float*)(wsp + WS_SHW) + (size_t)l * BATCH * NSHW, glds};
            pg8::gemm_phase<pg8::EpiRouteN<0>, pg8::StaticOrder, true, true>(glds, g, S, E, F.tid); } __syncthreads();
#endif
        EN(2) { pg8::Gemm g{XN, (const bf16*)(wsp + WS_WIN) + (size_t)l * NPROJ * DM, MTOK, NPROJ, DM}; pg8::StaticOrder S; S.init(MTOK, NPROJ, F.G, F.bid);
            pg8::EpiRouteN<0> E{PROJ, NPROJ, (const float*)(wsp + WS_RSP), (const float*)(wsp + WS_SHW) + (size_t)l * BATCH * NSHW, glds};
            pg8::gemm_phase<pg8::EpiRouteN<0>, pg8::StaticOrder, true, true>(glds, g, S, E, F.tid); } PH_END
        PH_BEGIN EN(3) ph_prep(F, l); DUP(3) ph_prep(F, l); EN(4) ph_lru1(F, l); DUP(4) ph_lru1(F, l); EN(5) ph_mlstm(F, l); DUP(5) ph_mlstm(F, l); PH_END
        PH_BEGIN EN(6) { ph_carry(F); pg8::Gemm g{(const bf16*)(wsp + WS_QL), (const bf16*)(wsp + WS_WQC) + (size_t)l * 768 * 256, MTOK, 768, 256}; pg8::StaticOrder S; S.init(MTOK, 768, F.G, F.bid);
            pg8::EpiRoute<0> E{(bf16*)(wsp + WS_QABS), 512, (bf16*)(wsp + WS_QIDX), 256, 2};
            pg8::gemm_phase<pg8::EpiRoute<0>, pg8::StaticOrder, true, true>(glds, g, S, E, F.tid); } PH_END
#ifndef DSA_REP
#define DSA_REP 1
#endif
        PH_BEGIN EN(7) { for (int rep_ = 0; rep_ < DSA_REP; ++rep_) { ph_dsa(F, l); if (DSA_REP > 1) __syncthreads(); } } DUP(7) ph_dsa(F, l); EN(8) ph_lru2(F, l); DUP(8) ph_lru2(F, l); EN(9) ph_mfin(F, l); DUP(9) ph_mfin(F, l); PH_END
        PH_BEGIN EN(10) { pg8::Gemm g{CAT, (const bf16*)(wsp + WS_WO) + (size_t)l * DM * DM, MTOK, DM, DM}; pg8::StaticOrder S; S.init(MTOK, DM, F.G, F.bid);
            pg8::EpiResidXS<false> E{(const pg8::bf16_t*)POUT(F), (pg8::bf16_t*)POUT(F), modl + 2 * DM, (const float*)(wsp + WS_WP) + (size_t)(l * 2 + 1) * BATCH * DM, XN, (float*)(wsp + WS_RSP), 1};
            pg8::gemm_phase<pg8::EpiResidXS<false>, pg8::StaticOrder, true, true>(glds, g, S, E, F.tid); } PH_END
        PH_BEGIN EN(12) { pg8::Gemm g{XN, (const bf16*)(wsp + WS_W1) + (size_t)l * DFF * DM, MTOK, DFF, DM}; pg8::StaticOrder S; S.init(MTOK, DFF, F.G, F.bid);
            pg8::EpiRouteN<1> E{HB, DFF, (const float*)(wsp + WS_RSP), (const float*)(wsp + WS_SHW) + (size_t)l * BATCH * NSHW + NPROJ, glds};
            pg8::gemm_phase<pg8::EpiRouteN<1>, pg8::StaticOrder, true, true>(glds, g, S, E, F.tid); } PH_END
        PH_BEGIN EN(13) { pg8::Gemm g{HB, (const bf16*)(wsp + WS_W2) + (size_t)l * DM * DFF, MTOK, DM, DFF}; pg8::StaticOrder S; S.init(MTOK, DM, F.G, F.bid);
            const int nl = l + 1 < DEPTH ? l + 1 : l;
            const bool lastl = l_ + 1 >= DBG_LAYERS;
            pg8::EpiResidXS<true> E{(const pg8::bf16_t*)POUT(F), lastl ? (pg8::bf16_t*)XN : (pg8::bf16_t*)POUT(F), modl + 5 * DM, (const float*)(wsp + WS_WP) + (size_t)(nl * 2) * BATCH * DM, XN, (float*)(wsp + WS_RSP), lastl ? 0 : 1};
            pg8::gemm_phase<pg8::EpiResidXS<true>, pg8::StaticOrder, true, true>(glds, g, S, E, F.tid); } PH_END
    }
#ifdef DBG_DIGEST
    PH_BEGIN { const int gw = F.bid * 8 + F.wave, NGW = F.G * 8; float* o = POUT(F);
        for (int m = gw; m < MTOK; m += NGW) for (int j = 0; j < 16; ++j) { const int c = F.lane + 64 * j; float v = 0.f;
            if (c < DBG_DIGEST_N) { v = DBG_DIGEST_VAL(m, c) * 4096.0f; v = v - floorf(v); }
            o[(size_t)m * DM + c] = v; } } PH_END
#else
    PH_BEGIN EN(14) ph_finalnorm16(F, XN, PIN(F, I_FNW), POUT(F)); PH_END
#endif
}

extern "C" void kernel_launch(void* const* d_in, const int* in_sizes, int n_in, void* d_out, int out_size, void* d_ws, size_t ws_size, hipStream_t stream) {
    static int grid = 0;
    if (grid == 0) {
        if (n_in != 28 || in_sizes[0] != MTOK * DM || out_size != MTOK * DM || ws_size < WS_END) { fprintf(stderr, "kernel_launch: unexpected shapes (n_in %d, in0 %d, out %d, ws %zu)\n", n_in, n_in > 0 ? in_sizes[0] : -1, out_size, ws_size); grid = -1; return; }
        int dev = 0, cus = 0, per_cu = 0;
        if (hipGetDevice(&dev) != hipSuccess || hipDeviceGetAttribute(&cus, hipDeviceAttributeMultiprocessorCount, dev) != hipSuccess) { grid = -1; return; }
        if (hipFuncSetAttribute((const void*)hymba_fwd, hipFuncAttributeMaxDynamicSharedMemorySize, LDS_BYTES) != hipSuccess) { fprintf(stderr, "kernel_launch: hipFuncSetAttribute failed\n"); grid = -1; return; }
        if (hipOccupancyMaxActiveBlocksPerMultiprocessor(&per_cu, (const void*)hymba_fwd, 512, LDS_BYTES) != hipSuccess || per_cu < 1) { fprintf(stderr, "kernel_launch: occupancy query says %d\n", per_cu); }
        (void)hipGetLastError();
        grid = cus;
    }
    if (grid < 0) return;
    if (hipMemsetAsync((char*)d_ws + WS_CTL, 0, CTL_ZERO_BYTES, stream) != hipSuccess) return;
    Args a{};
    for (int i = 0; i < 28; ++i) a.in[i] = (const float*)d_in[i];
    a.out = (float*)d_out; a.ws = (unsigned char*)d_ws;
#if MK_MULTI
    for (int p = 0; p < NPHASE; ++p) { a.ph_lo = p; a.ph_hi = p + 1; hipLaunchKernelGGL(hymba_fwd, dim3(grid), dim3(512), LDS_BYTES, stream, a); }
#else
    a.ph_lo = 0; a.ph_hi = DBG_PH_HI; hipLaunchKernelGGL(hymba_fwd, dim3(grid), dim3(512), LDS_BYTES, stream, a);
#endif
}
#endif
```

```cpp
#ifndef HOST_EMU
#include <hip/hip_runtime.h>
#include <cstdio>
#include <cstdint>
#define DEV __device__ __forceinline__
#define LAS __attribute__((address_space(3)))
#else
#include "emu.h"
#endif

#ifndef HOST_EMU
#define SYNC() __syncthreads()
#define KEEP4(a, b, c, d) asm volatile("" :: "v"(a), "v"(b), "v"(c), "v"(d))
#define NOPACK(x) asm("" : "+v"(x))
#define LAUNDER_V(x) asm volatile("" : "+v"(x))
#define WAVE_LDS_FENCE() asm volatile("s_waitcnt lgkmcnt(0)" ::: "memory")
template <class T> DEV T SHFL(T v, int s) { return __shfl(v, s); }
template <class T> DEV T SHFL_XOR(T v, int m) { return __shfl_xor(v, m); }
template <class T> DEV T SHFL_UP(T v, int d) { return __shfl_up(v, d); }
template <class T> DEV T SHFL_DOWN(T v, int d) { return __shfl_down(v, d); }
typedef short bf16x8_ __attribute__((ext_vector_type(8)));
typedef float f32x4_ __attribute__((ext_vector_type(4)));
typedef short v4i16_t __attribute__((ext_vector_type(4)));
DEV f32x4_ MFMA16(bf16x8_ a, bf16x8_ b, f32x4_ c) { return __builtin_amdgcn_mfma_f32_16x16x32_bf16(a, b, c, 0, 0, 0); }
DEV v4i16_t TR16(const void* p) { return __builtin_amdgcn_ds_read_tr16_b64_v4i16((LAS v4i16_t*)(p)); }
#endif


typedef unsigned short bf16;
typedef short bf16x8 __attribute__((ext_vector_type(8)));
typedef short s16x4 __attribute__((ext_vector_type(4)));
typedef float f32x4 __attribute__((ext_vector_type(4)));
typedef unsigned u32x4 __attribute__((ext_vector_type(4)));
typedef unsigned u32x2 __attribute__((ext_vector_type(2)));

constexpr int BATCH = 16, SEQ = 4096, DM = 1024, DEPTH = 4, MTOK = BATCH * SEQ;
constexpr int NPROJ = 3072, DFF = 4096, NADA = 6 * DM;
constexpr int PC_LX = 0, PC_LY = 256, PC_MQ = 512, PC_MK = 1024, PC_MV = 1536, PC_MO = 2048, PC_AQ = 2560, PC_AKV = 2816, PC_IK = 2944, PC_IW = 2976, PC_MI = 2984, PC_MF = 2988;
constexpr float NORM_EPS = 1e-6f;

constexpr size_t MiB = 1u << 20;
constexpr size_t WS_CTL = 0, CTL_ZERO_BYTES = 1 * MiB;
constexpr size_t WS_MOD = 1 * MiB;
constexpr size_t WS_WQC = 3 * MiB;
constexpr size_t WS_WG = 5 * MiB;
constexpr size_t WS_WUVT = 6 * MiB;
constexpr size_t WS_WIN = 8 * MiB;
constexpr size_t WS_WO = 32 * MiB;
constexpr size_t WS_W1 = 40 * MiB;
constexpr size_t WS_W2 = 72 * MiB;
constexpr size_t WS_XN = 104 * MiB;
constexpr size_t WS_QL = WS_XN, WS_CKV = WS_XN + 32 * MiB, WS_QIDX = WS_XN + 48 * MiB, WS_KIDX = WS_XN + 80 * MiB, WS_WI = WS_XN + 84 * MiB, WS_GT = WS_XN + 86 * MiB;
constexpr size_t WS_CAT = 232 * MiB;
constexpr size_t WS_PROJ = 360 * MiB;
constexpr size_t WS_HB = 360 * MiB;
constexpr size_t WS_QABS = 744 * MiB;
constexpr size_t WS_HLOC = 808 * MiB, WS_CPA = 840 * MiB;
constexpr size_t WS_LSUM = 872 * MiB;
constexpr size_t WS_HM = 874 * MiB;
constexpr size_t WS_MG = 940 * MiB;
constexpr size_t WS_WP = 2 * MiB + 512 * 1024;
constexpr size_t WS_SHW = 6 * MiB + 256 * 1024;
constexpr size_t WS_RSP = 1000 * MiB;
constexpr size_t WS_CARRY = 948 * MiB;
constexpr size_t WS_SCR2 = 949 * MiB;
constexpr int NSHW = NPROJ + DFF;
constexpr size_t WS_END = 1024 * MiB;
static_assert(WS_HM + (size_t)MTOK * 512 * 2 <= WS_END && WS_HB + (size_t)MTOK * DFF * 2 <= WS_HLOC + 64 * MiB, "ws map");

constexpr int CW_TMO = 0, CW_BAR = 4096;

#ifndef HOST_EMU
typedef __bf16 hwbf2_t __attribute__((ext_vector_type(2)));
typedef float hwf2_t __attribute__((ext_vector_type(2)));
DEV unsigned f2bf(float f) { return (unsigned)__builtin_bit_cast(unsigned short, (__bf16)f); }
DEV unsigned pk2(float lo, float hi) { const hwf2_t v = {lo, hi}; return __builtin_bit_cast(unsigned, __builtin_convertvector(v, hwbf2_t)); }
#else
DEV unsigned f2bf(float f) { unsigned u = __builtin_bit_cast(unsigned, f); return (u + 0x7fffu + ((u >> 16) & 1u)) >> 16; }
DEV unsigned pk2(float lo, float hi) { return f2bf(lo) | (f2bf(hi) << 16); }
#endif
DEV float bf2f(unsigned h) { return __builtin_bit_cast(float, h << 16); }
DEV float bflo(unsigned w) { return __builtin_bit_cast(float, w << 16); }
DEV float bfhi(unsigned w) { return __builtin_bit_cast(float, w & 0xffff0000u); }
DEV float wave_sum(float v) {
#pragma unroll
    for (int o = 1; o < 64; o <<= 1) v += SHFL_XOR(v, o);
    return v;
}
#ifndef HOST_EMU
DEV float FEXP(float x) { return __expf(x); }
DEV float FEXP2(float x) { return __builtin_amdgcn_exp2f(x); }
DEV float FRCP(float x) { return __builtin_amdgcn_rcpf(x); }
DEV float FSQRT(float x) { return __builtin_amdgcn_sqrtf(x); }
DEV float RSQ(float x) { return __builtin_amdgcn_rsqf(x); }
DEV float FLOG(float x) { return __logf(x); }
#else
DEV float FEXP(float x) { return expf(x); }
DEV float FEXP2(float x) { return exp2f(x); }
DEV float FRCP(float x) { return 1.0f / x; }
DEV float FSQRT(float x) { return sqrtf(x); }
DEV float RSQ(float x) { return 1.0f / sqrtf(x); }
DEV float FLOG(float x) { return logf(x); }
#endif
#ifndef HOST_EMU
DEV int UNI(int x) { return __builtin_amdgcn_readfirstlane(x); }
#else
DEV int UNI(int x) { return x; }
#endif
#ifndef HOST_EMU
#define GAS __attribute__((address_space(1)))
DEV const GAS char* UNIP(const void* p) { const unsigned long long v = (unsigned long long)p; const unsigned lo = __builtin_amdgcn_readfirstlane((unsigned)v), hi = __builtin_amdgcn_readfirstlane((unsigned)(v >> 32));
    return (const GAS char*)(((unsigned long long)hi << 32) | lo); }
#else
#define GAS
DEV const char* UNIP(const void* p) { return (const char*)p; }
#endif
DEV float RELU(float x) { const int b = __builtin_bit_cast(int, x); return __builtin_bit_cast(float, b > 0 ? b : 0); }
DEV float sigmoidf_(float z) { return 1.0f / (1.0f + expf(-z)); }
DEV float fsigmoid(float z) { return FRCP(1.0f + FEXP(-z)); }
DEV float one_minus_exp(float x) {
    const float s = -x * (1.0f + x * (0.5f + x * (0.16666667f + x * 0.041666668f)));
    return x > -0.05f ? s : 1.0f - FEXP(x);
}

struct Args { const float* in[28]; float* out; unsigned char* ws; int ph_lo, ph_hi; };
struct Ctx {
    char* lds; int tid, lane, wave, G, bid;
    const Args* A;
    unsigned char* ws;
};

constexpr int PTR_OFF = 131072 + 512;
#ifndef HOST_EMU
DEV const float* PIN(const Ctx& F, int i) { const unsigned long long v = ((const unsigned long long*)(F.lds + PTR_OFF))[i];
    const unsigned lo = __builtin_amdgcn_readfirstlane((unsigned)v), hi = __builtin_amdgcn_readfirstlane((unsigned)(v >> 32)); return (const float*)(const __attribute__((address_space(1))) float*)(((unsigned long long)hi << 32) | lo); }
DEV float* POUT(const Ctx& F) { return (float*)PIN(F, 28); }
#else
DEV const float* PIN(const Ctx& F, int i) { return F.A->in[i]; }
DEV float* POUT(const Ctx& F) { return POUT(F); }
#endif
enum { I_X = 0, I_C, I_WIN, I_CONVW, I_CONVB, I_WA, I_BA, I_WX, I_BX, I_LAM, I_BI, I_BF, I_WQUP, I_WQIDX, I_WUK, I_WUV, I_QNW, I_KVNW, I_RELB, I_GNW, I_WO, I_WADA, I_BADA, I_N1W, I_N2W, I_W1, I_W2, I_FNW };

DEV int win_srccol(int n) {
    if (n < 2560) return n;
    if (n < PC_AKV) return 2568 + (n - PC_AQ);
    if (n < PC_IK) return 2824 + (n - PC_AKV);
    if (n < PC_IW) return 2952 + (n - PC_IK);
    if (n < PC_MI) return 2984 + (n - PC_IW);
    if (n < PC_MF) return 2560 + (n - PC_MI);
    if (n < 2992) return 2564 + (n - PC_MF);
    return -1;
}
template <bool MAPPED>
DEV void p0_transpose_item(const float* W, int K, int N, int NT, bf16* WT, float* scr, int item, int lane) {
    const int nblk = NT / 32, kb = item / nblk, nb = item % nblk, k0 = 64 * kb, n0 = 32 * nb;
    int sc = n0 + (lane & 31); if (MAPPED) sc = win_srccol(sc);
#pragma unroll 8
    for (int i = 0; i < 32; ++i) { const int kk = 2 * i + (lane >> 5); const float v = W[(size_t)(k0 + kk) * N + (sc >= 0 ? sc : 0)]; scr[kk * 33 + (lane & 31)] = sc >= 0 ? v : 0.f; }
    WAVE_LDS_FENCE();
    const int c = lane & 7;
#pragma unroll
    for (int j = 0; j < 4; ++j) { const int n = (lane >> 3) + 8 * j; const float* s = scr + (8 * c) * 33 + n;
        u32x4 o; o.x = pk2(s[0 * 33], s[1 * 33]); o.y = pk2(s[2 * 33], s[3 * 33]); o.z = pk2(s[4 * 33], s[5 * 33]); o.w = pk2(s[6 * 33], s[7 * 33]);
        *(u32x4*)(WT + (size_t)(n0 + n) * K + k0 + 8 * c) = o; }
    WAVE_LDS_FENCE();
}

DEV void ph_prologue(const Ctx& F) {
    const int gt = F.bid * 512 + F.tid, NGT = F.G * 512;
    float* CACT = (float*)F.lds;
    for (int i = F.tid; i < BATCH * DM; i += 512) { const float cv = PIN(F, I_C)[i]; CACT[i] = cv * sigmoidf_(cv); }
    SYNC();
    for (int e = gt; e < DEPTH * NADA * 4; e += NGT) {
        const int j = e % NADA, bq = (e / NADA) & 3, l = e / (NADA * 4);
        const float* w = PIN(F, I_WADA) + (size_t)l * DM * NADA + j;
        const float* c = CACT + bq * 4 * DM;
        float a0 = 0.f, a1 = 0.f, a2 = 0.f, a3 = 0.f;
#pragma unroll 8
        for (int k = 0; k < DM; k += 4) {
            const float w0 = w[(size_t)k * NADA], w1 = w[(size_t)(k + 1) * NADA], w2 = w[(size_t)(k + 2) * NADA], w3 = w[(size_t)(k + 3) * NADA];
            const f32x4 c0 = *(const f32x4*)(c + k), c1 = *(const f32x4*)(c + DM + k), c2 = *(const f32x4*)(c + 2 * DM + k), c3 = *(const f32x4*)(c + 3 * DM + k);
            a0 += (c0.x * w0 + c0.y * w1) + (c0.z * w2 + c0.w * w3); a1 += (c1.x * w0 + c1.y * w1) + (c1.z * w2 + c1.w * w3);
            a2 += (c2.x * w0 + c2.y * w1) + (c2.z * w2 + c2.w * w3); a3 += (c3.x * w0 + c3.y * w1) + (c3.z * w2 + c3.w * w3); }
        const float bb = PIN(F, I_BADA)[(size_t)l * NADA + j];
        float* mo = (float*)(F.ws + WS_MOD) + ((size_t)l * BATCH + bq * 4) * NADA + j;
        mo[0] = a0 + bb; mo[NADA] = a1 + bb; mo[2 * NADA] = a2 + bb; mo[3 * NADA] = a3 + bb;
    }
    for (int e = gt; e < DEPTH * 2 * 4 * 64 * 64; e += NGT) {
        const int i = e & 63, j = (e >> 6) & 63, blk = (e >> 12) & 3, g = (e >> 14) & 1, l = e >> 15;
        const float* src = PIN(F, g ? I_WX : I_WA) + (((size_t)l * 4 + blk) * 64 + i) * 64 + j;
        ((bf16*)(F.ws + WS_WG))[e] = (bf16)f2bf(*src);
    }
    for (int e = gt; e < DEPTH * 4 * 64 * 128; e += NGT) {
        const int r = e & 127, d = (e >> 7) & 63, h = (e >> 13) & 3, l = e >> 15;
        ((bf16*)(F.ws + WS_WUVT))[e] = (bf16)f2bf(PIN(F, I_WUV)[(((size_t)l * 128 + r) * 4 + h) * 64 + d]);
    }
    for (int e = gt; e < DEPTH * 768 * 256; e += NGT) {
        const int r = e & 255, n = (e >> 8) % 768, l = e / (768 * 256);
        float v;
        if (n < 512) { const int h = n >> 7, c = n & 127; const f32x4* q = (const f32x4*)(PIN(F, I_WQUP) + ((size_t)l * 256 + r) * 256 + h * 64); const f32x4* k = (const f32x4*)(PIN(F, I_WUK) + ((size_t)l * 128 + c) * 256 + h * 64);
            float s = 0.f;
#pragma unroll
            for (int d = 0; d < 16; ++d) { const f32x4 a = q[d], bq4 = k[d]; s += (a.x * bq4.x + a.y * bq4.y) + (a.z * bq4.z + a.w * bq4.w); }
            v = s * (0.125f * 1.4426950408889634f); }
        else v = PIN(F, I_WQIDX)[((size_t)l * 256 + r) * 256 + (n - 512)] * 0.17677669529663687f;
        ((bf16*)(F.ws + WS_WQC))[e] = (bf16)f2bf(v);
    }
    SYNC();
    float* scr = (float*)(F.lds + F.wave * 16384);
    const int gw = F.bid * 8 + F.wave, NGW = F.G * 8;
    constexpr int I_IN = (DM / 64) * (NPROJ / 32), I_O = (DM / 64) * (DM / 32), I_1 = (DM / 64) * (DFF / 32), I_2 = (DFF / 64) * (DM / 32);
    constexpr int PER_L = I_IN + I_O + I_1 + I_2;
    for (int it = gw; it < DEPTH * PER_L; it += NGW) {
        const int l = it / PER_L; int r = it % PER_L;
        if (r < I_IN) { p0_transpose_item<true>(PIN(F, I_WIN) + (size_t)l * DM * 2992, DM, 2992, NPROJ, (bf16*)(F.ws + WS_WIN) + (size_t)l * NPROJ * DM, scr, r, F.lane); continue; } r -= I_IN;
        if (r < I_O) { p0_transpose_item<false>(PIN(F, I_WO) + (size_t)l * DM * DM, DM, DM, DM, (bf16*)(F.ws + WS_WO) + (size_t)l * DM * DM, scr, r, F.lane); continue; } r -= I_O;
        if (r < I_1) { p0_transpose_item<false>(PIN(F, I_W1) + (size_t)l * DM * DFF, DM, DFF, DFF, (bf16*)(F.ws + WS_W1) + (size_t)l * DFF * DM, scr, r, F.lane); continue; } r -= I_1;
        p0_transpose_item<false>(PIN(F, I_W2) + (size_t)l * DFF * DM, DFF, DM, DM, (bf16*)(F.ws + WS_W2) + (size_t)l * DM * DFF, scr, r, F.lane);
    }
}

DEV void ph_xs0(const Ctx& F, const float* xsrc, const float* nw, const float* modl, int sc_off, bf16* XS, float* RSP, bf16* X16) {
    const int gw = F.bid * 8 + F.wave, NGW = F.G * 8;
    f32x4 wv[4];
#pragma unroll
    for (int j = 0; j < 4; ++j) wv[j] = *(const f32x4*)(nw + 4 * F.lane + 256 * j);
    f32x4 v[2][4], vn[2][4];
#pragma unroll
    for (int q = 0; q < 2; ++q) { const int m = gw + q * NGW; const f32x4* xr = (const f32x4*)(xsrc + (size_t)(m < MTOK ? m : 0) * DM) + F.lane;
#pragma unroll
        for (int j = 0; j < 4; ++j) v[q][j] = xr[64 * j]; }
    for (int m0 = gw; m0 < MTOK; m0 += 2 * NGW) {
        f32x4 sc[2][4];
#pragma unroll
        for (int q = 0; q < 2; ++q) { const int m = m0 + q * NGW; const float* mb = modl + (size_t)((m < MTOK ? m : 0) >> 12) * NADA + 4 * F.lane;
#pragma unroll
            for (int j = 0; j < 4; ++j) sc[q][j] = *(const f32x4*)(mb + sc_off + 256 * j); }
#pragma unroll
        for (int q = 0; q < 2; ++q) { const int m = m0 + (2 + q) * NGW; const f32x4* xr = (const f32x4*)(xsrc + (size_t)(m < MTOK ? m : 0) * DM) + F.lane;
#pragma unroll
            for (int j = 0; j < 4; ++j) vn[q][j] = xr[64 * j]; }
        float s[2];
#pragma unroll
        for (int q = 0; q < 2; ++q) { float a = 0.f;
#pragma unroll
            for (int j = 0; j < 4; ++j) a += (v[q][j].x * v[q][j].x + v[q][j].y * v[q][j].y) + (v[q][j].z * v[q][j].z + v[q][j].w * v[q][j].w);
            s[q] = a; }
#pragma unroll
        for (int o = 1; o < 64; o <<= 1) { s[0] += SHFL_XOR(s[0], o); s[1] += SHFL_XOR(s[1], o); }
#pragma unroll
        for (int q = 0; q < 2; ++q) { const int m = m0 + q * NGW; if (m >= MTOK) break;
            if (F.lane < 16) RSP[(size_t)m * 16 + F.lane] = F.lane == 0 ? s[q] : 0.f;
            u32x2* o8 = (u32x2*)(XS + (size_t)m * DM) + F.lane; u32x2* x8 = (u32x2*)(X16 + (size_t)m * DM) + F.lane;
#pragma unroll
            for (int j = 0; j < 4; ++j) { const f32x4 y = v[q][j] * (wv[j] * (1.0f + sc[q][j]));
                u32x2 p; p.x = pk2(y.x, y.y); p.y = pk2(y.z, y.w); o8[64 * j] = p;
                u32x2 c; c.x = pk2(v[q][j].x, v[q][j].y); c.y = pk2(v[q][j].z, v[q][j].w); x8[64 * j] = c; } }
#pragma unroll
        for (int q = 0; q < 2; ++q)
#pragma unroll
            for (int j = 0; j < 4; ++j) v[q][j] = vn[q][j];
    }
}
DEV void ph_shw(const Ctx& F) {
    const int gt = F.bid * 512 + F.tid, NGT = F.G * 512;
    for (int e = gt; e < DEPTH * 2 * BATCH * (DM / 4); e += NGT) {
        const int c4 = e & 255, b = (e >> 8) & 15, w = (e >> 12) & 1, l = e >> 13;
        const f32x4 nwv = *(const f32x4*)(PIN(F, w ? I_N2W : I_N1W) + l * DM + 4 * c4);
        const f32x4 sc = *(const f32x4*)((const float*)(F.ws + WS_MOD) + ((size_t)l * BATCH + b) * NADA + (w ? 4 * DM : DM) + 4 * c4);
        ((f32x4*)(F.ws + WS_WP))[e] = nwv * (1.0f + sc);
    }
    const int gw = F.bid * 8 + F.wave, NGW = F.G * 8, i16 = F.lane & 15, kq = 8 * (F.lane >> 4);
    for (int it = gw; it < DEPTH * (NSHW / 16); it += NGW) {
        const int l = it / (NSHW / 16), n0 = (it % (NSHW / 16)) * 16;
        const bool mlp = n0 >= NPROJ;
        const bf16* Wr = mlp ? (const bf16*)(F.ws + WS_W1) + ((size_t)l * DFF + (n0 - NPROJ) + i16) * DM : (const bf16*)(F.ws + WS_WIN) + ((size_t)l * NPROJ + n0 + i16) * DM;
        const float* sh = (const float*)(F.ws + WS_MOD) + ((size_t)l * BATCH + i16) * NADA + (mlp ? 3 * DM : 0);
        f32x4 acc0 = {0.f, 0.f, 0.f, 0.f}, acc1 = {0.f, 0.f, 0.f, 0.f};
#pragma unroll 4
        for (int s = 0; s < DM / 32; ++s) {
            const bf16x8 B = *(const bf16x8*)(Wr + 32 * s + kq);
            const f32x4 a0 = *(const f32x4*)(sh + 32 * s + kq), a1 = *(const f32x4*)(sh + 32 * s + kq + 4);
            bf16x8 Ah, Al;
#pragma unroll
            for (int j = 0; j < 8; ++j) { const float a = j < 4 ? a0[j] : a1[j - 4]; const unsigned h = f2bf(a); Ah[j] = (short)h; Al[j] = (short)f2bf(a - bf2f(h)); }
            acc0 = MFMA16(Ah, B, acc0); acc1 = MFMA16(Al, B, acc1);
        }
        float* o = (float*)(F.ws + WS_SHW) + ((size_t)l * BATCH + 4 * (F.lane >> 4)) * NSHW + n0 + i16;
#pragma unroll
        for (int r = 0; r < 4; ++r) o[(size_t)r * NSHW] = acc0[r] + acc1[r];
    }
}
DEV void ph_normmod(const Ctx& F, const float* xsrc, const float* nw, const float* modl, int sh_off, int sc_off, bf16* XN) {
    const int gw = F.bid * 8 + F.wave, NGW = F.G * 8;
    f32x4 wv[4];
#pragma unroll
    for (int j = 0; j < 4; ++j) wv[j] = *(const f32x4*)(nw + 4 * F.lane + 256 * j);
    f32x4 v[2][4], vn[2][4];
#pragma unroll
    for (int q = 0; q < 2; ++q) { const int m = gw + q * NGW; const f32x4* xr = (const f32x4*)(xsrc + (size_t)(m < MTOK ? m : 0) * DM) + F.lane;
#pragma unroll
        for (int j = 0; j < 4; ++j) v[q][j] = xr[64 * j]; }
    for (int m0 = gw; m0 < MTOK; m0 += 2 * NGW) {
        f32x4 sc[2][4], sh[2][4];
#pragma unroll
        for (int q = 0; q < 2; ++q) { const int m = m0 + q * NGW; const float* mb = modl + (size_t)((m < MTOK ? m : 0) >> 12) * NADA + 4 * F.lane;
#pragma unroll
            for (int j = 0; j < 4; ++j) { sc[q][j] = *(const f32x4*)(mb + sc_off + 256 * j); sh[q][j] = *(const f32x4*)(mb + sh_off + 256 * j); } }
#pragma unroll
        for (int q = 0; q < 2; ++q) { const int m = m0 + (2 + q) * NGW; const f32x4* xr = (const f32x4*)(xsrc + (size_t)(m < MTOK ? m : 0) * DM) + F.lane;
#pragma unroll
            for (int j = 0; j < 4; ++j) vn[q][j] = xr[64 * j]; }
        float s[2];
#pragma unroll
        for (int q = 0; q < 2; ++q) { float a = 0.f;
#pragma unroll
            for (int j = 0; j < 4; ++j) a += (v[q][j].x * v[q][j].x + v[q][j].y * v[q][j].y) + (v[q][j].z * v[q][j].z + v[q][j].w * v[q][j].w);
            s[q] = a; }
#pragma unroll
        for (int o = 1; o < 64; o <<= 1) { s[0] += SHFL_XOR(s[0], o); s[1] += SHFL_XOR(s[1], o); }
#pragma unroll
        for (int q = 0; q < 2; ++q) { const int m = m0 + q * NGW; if (m >= MTOK) break;
            const float rs = RSQ(s[q] * (1.0f / DM) + NORM_EPS);
            u32x2* o8 = (u32x2*)(XN + (size_t)m * DM) + F.lane;
#pragma unroll
            for (int j = 0; j < 4; ++j) { const f32x4 y = v[q][j] * rs * wv[j] * (1.0f + sc[q][j]) + sh[q][j];
                u32x2 p; p.x = pk2(y.x, y.y); p.y = pk2(y.z, y.w); o8[64 * j] = p; } }
#pragma unroll
        for (int q = 0; q < 2; ++q)
#pragma unroll
            for (int j = 0; j < 4; ++j) v[q][j] = vn[q][j];
    }
}
DEV void ph_finalnorm(const Ctx& F, const float* xsrc, const float* nw, float* out) {
    const int gw = F.bid * 8 + F.wave, NGW = F.G * 8;
    f32x4 wv[4];
#pragma unroll
    for (int j = 0; j < 4; ++j) wv[j] = *(const f32x4*)(nw + 4 * F.lane + 256 * j);
    f32x4 v[2][4], vn[2][4];
#pragma unroll
    for (int q = 0; q < 2; ++q) { const int m = gw + q * NGW; const f32x4* xr = (const f32x4*)(xsrc + (size_t)(m < MTOK ? m : 0) * DM) + F.lane;
#pragma unroll
        for (int j = 0; j < 4; ++j) v[q][j] = xr[64 * j]; }
    for (int m0 = gw; m0 < MTOK; m0 += 2 * NGW) {
#pragma unroll
        for (int q = 0; q < 2; ++q) { const int m = m0 + (2 + q) * NGW; const f32x4* xr = (const f32x4*)(xsrc + (size_t)(m < MTOK ? m : 0) * DM) + F.lane;
#pragma unroll
            for (int j = 0; j < 4; ++j) vn[q][j] = xr[64 * j]; }
        float s[2];
#pragma unroll
        for (int q = 0; q < 2; ++q) { float a = 0.f;
#pragma unroll
            for (int j = 0; j < 4; ++j) a += (v[q][j].x * v[q][j].x + v[q][j].y * v[q][j].y) + (v[q][j].z * v[q][j].z + v[q][j].w * v[q][j].w);
            s[q] = a; }
#pragma unroll
        for (int o = 1; o < 64; o <<= 1) { s[0] += SHFL_XOR(s[0], o); s[1] += SHFL_XOR(s[1], o); }
#pragma unroll
        for (int q = 0; q < 2; ++q) { const int m = m0 + q * NGW; if (m >= MTOK) break;
            const float rs = RSQ(s[q] * (1.0f / DM) + NORM_EPS);
            f32x4* o = (f32x4*)(out + (size_t)m * DM) + F.lane;
#pragma unroll
            for (int j = 0; j < 4; ++j) o[64 * j] = v[q][j] * rs * wv[j]; }
#pragma unroll
        for (int q = 0; q < 2; ++q)
#pragma unroll
            for (int j = 0; j < 4; ++j) v[q][j] = vn[q][j];
    }
}
DEV void ph_finalnorm16(const Ctx& F, const bf16* x16, const float* nw, float* out) {
    const int gw = F.bid * 8 + F.wave, NGW = F.G * 8;
    f32x4 wv[2][2];
#pragma unroll
    for (int j = 0; j < 2; ++j) { wv[j][0] = *(const f32x4*)(nw + 8 * F.lane + 512 * j); wv[j][1] = *(const f32x4*)(nw + 8 * F.lane + 512 * j + 4); }
    u32x4 v[4][2], vn[4][2];
#pragma unroll
    for (int q = 0; q < 4; ++q) { const int m = gw + q * NGW; const bf16* xr = x16 + (size_t)(m < MTOK ? m : 0) * DM + 8 * F.lane;
        v[q][0] = *(const u32x4*)xr; v[q][1] = *(const u32x4*)(xr + 512); }
    for (int m0 = gw; m0 < MTOK; m0 += 4 * NGW) {
#pragma unroll
        for (int q = 0; q < 4; ++q) { const int m = m0 + (4 + q) * NGW; const bf16* xr = x16 + (size_t)(m < MTOK ? m : 0) * DM + 8 * F.lane;
            vn[q][0] = *(const u32x4*)xr; vn[q][1] = *(const u32x4*)(xr + 512); }
        float s[4];
#pragma unroll
        for (int q = 0; q < 4; ++q) { float a = 0.f;
#pragma unroll
            for (int j = 0; j < 2; ++j) { const u32x4 r = v[q][j];
                a += ((bflo(r.x) * bflo(r.x) + bfhi(r.x) * bfhi(r.x)) + (bflo(r.y) * bflo(r.y) + bfhi(r.y) * bfhi(r.y))) + ((bflo(r.z) * bflo(r.z) + bfhi(r.z) * bfhi(r.z)) + (bflo(r.w) * bflo(r.w) + bfhi(r.w) * bfhi(r.w))); }
            s[q] = a; }
#pragma unroll
        for (int o = 1; o < 64; o <<= 1) {
#pragma unroll
            for (int q = 0; q < 4; ++q) s[q] += SHFL_XOR(s[q], o); }
#pragma unroll
        for (int q = 0; q < 4; ++q) { const int m = m0 + q * NGW; if (m >= MTOK) break;
            const float rs = RSQ(s[q] * (1.0f / DM) + NORM_EPS);
            float* o = out + (size_t)m * DM + 8 * F.lane;
#pragma unroll
            for (int j = 0; j < 2; ++j) { const u32x4 r = v[q][j];
                *(f32x4*)(o + 512 * j) = (f32x4){bflo(r.x), bfhi(r.x), bflo(r.y), bfhi(r.y)} * rs * wv[j][0];
                *(f32x4*)(o + 512 * j + 4) = (f32x4){bflo(r.z), bfhi(r.z), bflo(r.w), bfhi(r.w)} * rs * wv[j][1]; } }
#pragma unroll
        for (int q = 0; q < 4; ++q) { v[q][0] = vn[q][0]; v[q][1] = vn[q][1]; }
    }
}
DEV void ph_zero_cat(const Ctx& F, int c0, int nq) {
    const int gw = F.bid * 8 + F.wave, NGW = F.G * 8;
    bf16* CAT = (bf16*)(F.ws + WS_CAT);
    for (int m = gw; m < MTOK; m += NGW) for (int q = 0; q < nq; ++q) *(u32x2*)(CAT + (size_t)m * DM + c0 + 256 * q + 4 * F.lane) = (u32x2){0u, 0u};
}
DEV float softcap15(float z) { return 15.0f * tanhf(z * (1.0f / 15.0f)); }
DEV float logsigmoidf_(float x) { return x >= 0.f ? -log1pf(expf(-x)) : x - log1pf(expf(x)); }
DEV void ph_prep(const Ctx& F, int l) {
    const int gw = F.bid * 8 + F.wave, NGW = F.G * 8, lane = F.lane;
    const bf16* PROJ = (const bf16*)(F.ws + WS_PROJ);
    bf16* QL = (bf16*)(F.ws + WS_QL); bf16* CKV = (bf16*)(F.ws + WS_CKV); bf16* KIDX = (bf16*)(F.ws + WS_KIDX);
    float* WI = (float*)(F.ws + WS_WI);
    const f32x4 qn = *(const f32x4*)(PIN(F, I_QNW) + l * 256 + 4 * lane);
    const float kn0 = PIN(F, I_KVNW)[l * 128 + 2 * lane], kn1 = PIN(F, I_KVNW)[l * 128 + 2 * lane + 1];
    u32x2 ra4[4], ran[4]; unsigned rk4[4], rx4[4], rkn[4], rxn[4];
#define PREP_LOAD(RA, RK, RX, M0) do { _Pragma("unroll") for (int q = 0; q < 4; ++q) { const int mm = (M0) + q * NGW; const bf16* pr = PROJ + (size_t)(mm < MTOK ? mm : 0) * NPROJ; \
            RA[q] = *(const u32x2*)(pr + PC_AQ + 4 * lane); RK[q] = *(const unsigned*)(pr + PC_AKV + 2 * lane); \
            RX[q] = lane < 16 ? *(const unsigned*)(pr + PC_IK + 2 * lane) : (lane < 24 ? (unsigned)pr[PC_IW + (lane - 16)] : 0u); } } while (0)
    PREP_LOAD(ra4, rk4, rx4, gw);
    for (int m0 = gw; m0 < MTOK; m0 += 4 * NGW) {
        PREP_LOAD(ran, rkn, rxn, m0 + 4 * NGW);
#pragma unroll
        for (int q = 0; q < 4; ++q) { const int m = m0 + q * NGW; if (m >= MTOK) break;
            const u32x2 ra = ra4[q]; const unsigned rk = rk4[q];
            const float a0 = bflo(ra.x), a1 = bfhi(ra.x), a2 = bflo(ra.y), a3 = bfhi(ra.y);
            const float k0 = bflo(rk), k1 = bfhi(rk);
            const float sq = wave_sum((a0 * a0 + a1 * a1) + (a2 * a2 + a3 * a3)), sk = wave_sum(k0 * k0 + k1 * k1);
            const float rq = RSQ(sq * (1.0f / 256.0f) + NORM_EPS), rk2 = RSQ(sk * (1.0f / 128.0f) + NORM_EPS);
            u32x2 oq; oq.x = pk2(a0 * rq * qn.x, a1 * rq * qn.y); oq.y = pk2(a2 * rq * qn.z, a3 * rq * qn.w);
            *(u32x2*)(QL + (size_t)m * 256 + 4 * lane) = oq;
            *(unsigned*)(CKV + (size_t)m * 128 + 2 * lane) = pk2(k0 * rk2 * kn0, k1 * rk2 * kn1);
            if (lane < 16) *(unsigned*)(KIDX + (size_t)m * 32 + 2 * lane) = rx4[q];
            else if (lane < 24) WI[(size_t)m * 8 + (lane - 16)] = bf2f(rx4[q]); }
#pragma unroll
        for (int q = 0; q < 4; ++q) { ra4[q] = ran[q]; rk4[q] = rkn[q]; rx4[q] = rxn[q]; }
    }
#undef PREP_LOAD
}

constexpr int XB_STRIDE = 264;
DEV void ph_lru1(const Ctx& F, int l) {
    const int tid = F.tid, lane = F.lane, w = F.wave, i16 = lane & 15, g = lane >> 4;
    bf16* XB = (bf16*)F.lds;
    float* XF = (float*)(F.lds + 64 * XB_STRIDE * 2);
    const bf16* PROJ = (const bf16*)(F.ws + WS_PROJ);
    bf16* HLOC = (bf16*)(F.ws + WS_HLOC); bf16* CPA = (bf16*)(F.ws + WS_CPA); float* LSUM = (float*)(F.ws + WS_LSUM);
    const int blk = w & 3, nh = w >> 2;
    const bf16* WG = (const bf16*)(F.ws + WS_WG) + (size_t)l * 2 * 4 * 4096;
    bf16x8 Bf[2][2][2];
#pragma unroll
    for (int gg = 0; gg < 2; ++gg)
#pragma unroll
        for (int nt = 0; nt < 2; ++nt)
#pragma unroll
            for (int ks = 0; ks < 2; ++ks) Bf[gg][nt][ks] = *(const bf16x8*)(WG + ((size_t)(gg * 4 + blk) * 64 + nh * 32 + 2 * i16 + nt) * 64 + ks * 32 + 8 * g);
    float ba[2], bx[2], sp[2];
#pragma unroll
    for (int nt = 0; nt < 2; ++nt) { const int ch = blk * 64 + nh * 32 + 2 * i16 + nt;
        ba[nt] = PIN(F, I_BA)[l * 256 + ch]; bx[nt] = PIN(F, I_BX)[l * 256 + ch];
        const float lam = PIN(F, I_LAM)[l * 256 + ch]; sp[nt] = lam > 0.f ? log1pf(expf(-lam)) : -lam + log1pf(expf(lam)); }
    const int ch2 = tid & 127, tg = tid >> 7;
    float cw[4][2], cb[2];
#pragma unroll
    for (int j = 0; j < 4; ++j) { cw[j][0] = PIN(F, I_CONVW)[(l * 4 + j) * 256 + 2 * ch2]; cw[j][1] = PIN(F, I_CONVW)[(l * 4 + j) * 256 + 2 * ch2 + 1]; }
    cb[0] = PIN(F, I_CONVB)[l * 256 + 2 * ch2]; cb[1] = PIN(F, I_CONVB)[l * 256 + 2 * ch2 + 1];

    for (int u = F.bid; u < BATCH * 64; u += F.G) {
        const int b = u >> 6, c = u & 63, t0 = c * 64; const size_t m0 = (size_t)b * SEQ + t0;
        {
            const int tl0 = tg * 16;
            unsigned rv[19];
#pragma unroll
            for (int j = 0; j < 3; ++j) { const int t = t0 + tl0 - 3 + j; rv[j] = t >= 0 ? *(const unsigned*)(PROJ + ((size_t)b * SEQ + t) * NPROJ + PC_LX + 2 * ch2) : 0u; }
#pragma unroll
            for (int tt = 0; tt < 16; ++tt) rv[3 + tt] = *(const unsigned*)(PROJ + (m0 + tl0 + tt) * NPROJ + PC_LX + 2 * ch2);
#pragma unroll
            for (int tt = 0; tt < 16; ++tt) { const int tl = tl0 + tt;
                const float x0 = cw[0][0] * bflo(rv[tt]) + cw[1][0] * bflo(rv[tt + 1]) + cw[2][0] * bflo(rv[tt + 2]) + cw[3][0] * bflo(rv[tt + 3]) + cb[0];
                const float x1 = cw[0][1] * bfhi(rv[tt]) + cw[1][1] * bfhi(rv[tt + 1]) + cw[2][1] * bfhi(rv[tt + 2]) + cw[3][1] * bfhi(rv[tt + 3]) + cb[1];
                *(unsigned*)(XB + tl * XB_STRIDE + 2 * ch2) = pk2(x0, x1);
                XF[tl * 256 + 2 * ch2] = x0; XF[tl * 256 + 2 * ch2 + 1] = x1; }
        }
        SYNC();
        float CA[2] = {1.f, 1.f}, CU[2] = {0.f, 0.f};
#pragma unroll 1
        for (int m = 0; m < 4; ++m) {
            f32x4 acc[2][2];
#pragma unroll
            for (int gg = 0; gg < 2; ++gg)
#pragma unroll
                for (int nt = 0; nt < 2; ++nt) acc[gg][nt] = (f32x4){0.f, 0.f, 0.f, 0.f};
#pragma unroll
            for (int ks = 0; ks < 2; ++ks) { const bf16x8 A = *(const bf16x8*)(XB + (m * 16 + i16) * XB_STRIDE + blk * 64 + ks * 32 + 8 * g);
#pragma unroll
                for (int gg = 0; gg < 2; ++gg)
#pragma unroll
                    for (int nt = 0; nt < 2; ++nt) acc[gg][nt] = MFMA16(A, Bf[gg][nt][ks], acc[gg][nt]); }
            float HL[2][4], CP[2][4];
            const int chb = blk * 64 + nh * 32 + 2 * i16;
            float xf[4][2];
#pragma unroll
            for (int r = 0; r < 4; ++r) { const float* xp = XF + (m * 16 + 4 * g + r) * 256 + chb; xf[r][0] = xp[0]; xf[r][1] = xp[1]; }
#pragma unroll
            for (int nt = 0; nt < 2; ++nt) {
                float P[4], H[4]; float pa = 1.f, hu = 0.f;
#pragma unroll
                for (int r = 0; r < 4; ++r) {
                    const float rg = fsigmoid(acc[0][nt][r] + ba[nt]), gi = fsigmoid(acc[1][nt][r] + bx[nt]);
                    const float la = -8.0f * rg * sp[nt], a = FEXP(la), uu = FSQRT((1.0f - a) * (1.0f + a)) * (gi * xf[r][nt]);
                    pa = a * pa; hu = a * hu + uu; P[r] = pa; H[r] = hu;
                    }
                float EA = 1.f, EU = 0.f, TA = 1.f, TU = 0.f;
#pragma unroll
                for (int gg = 0; gg < 4; ++gg) { const float ta = SHFL(pa, i16 + 16 * gg), tu = SHFL(hu, i16 + 16 * gg);
                    if (gg < g) { EU = ta * EU + tu; EA = ta * EA; }
                    TU = ta * TU + tu; TA = ta * TA; }
                const float XA = EA * CA[nt], XU = EA * CU[nt] + EU;
#pragma unroll
                for (int r = 0; r < 4; ++r) { HL[nt][r] = P[r] * XU + H[r]; CP[nt][r] = P[r] * XA; }
                CU[nt] = TA * CU[nt] + TU; CA[nt] = TA * CA[nt];
            }
#pragma unroll
            for (int r = 0; r < 4; ++r) { const size_t o = (m0 + m * 16 + 4 * g + r) * 256 + chb;
                *(unsigned*)(HLOC + o) = pk2(HL[0][r], HL[1][r]); *(unsigned*)(CPA + o) = pk2(CP[0][r], CP[1][r]); }
        }
        if (g == 0) {
#pragma unroll
            for (int nt = 0; nt < 2; ++nt) { const int ch = blk * 64 + nh * 32 + 2 * i16 + nt;
                LSUM[((size_t)b * 64 + c) * 256 + ch] = CA[nt]; LSUM[(size_t)BATCH * 64 * 256 + ((size_t)b * 64 + c) * 256 + ch] = CU[nt]; }
        }
        SYNC();
    }
}

DEV float gelu_tanh(float x) { const float z = 0.7978845608028654f * (x + 0.044715f * x * x * x); return x * FRCP(1.0f + FEXP(-2.0f * z)); }
DEV void ph_carry(const Ctx& F) {
    if (F.wave != 0) return;
    const float* LSUM = (const float*)(F.ws + WS_LSUM); float* CARRY = (float*)(F.ws + WS_CARRY);
    const int seg = F.lane & 3;
    for (int chain = F.bid * 16 + (F.lane >> 2); chain < BATCH * 256; chain += F.G * 16) {
        const int b = chain >> 8, ch = chain & 255; const size_t o0 = ((size_t)b * 64 + seg * 16) * 256 + ch;
        float a[16], hb[16];
#pragma unroll
        for (int i = 0; i < 16; ++i) { a[i] = LSUM[o0 + (size_t)i * 256]; hb[i] = LSUM[(size_t)BATCH * 64 * 256 + o0 + (size_t)i * 256]; }
        float hp[16], ap[16], hl = 0.f, al = 1.f;
#pragma unroll
        for (int i = 0; i < 16; ++i) { hp[i] = hl; ap[i] = al; hl = a[i] * hl + hb[i]; al = a[i] * al; }
        float cin = 0.f;
#pragma unroll
        for (int s2 = 0; s2 < 3; ++s2) { const float as = SHFL(al, (F.lane & ~3) + s2), hs = SHFL(hl, (F.lane & ~3) + s2); if (s2 < seg) cin = as * cin + hs; }
#pragma unroll
        for (int i = 0; i < 16; ++i) CARRY[o0 + (size_t)i * 256] = ap[i] * cin + hp[i];
    }
}
DEV void ph_lru2(const Ctx& F, int l) {
    const int tid = F.tid, lane = F.lane, w = F.wave;
    const bf16* PROJ = (const bf16*)(F.ws + WS_PROJ); const bf16* HLOC = (const bf16*)(F.ws + WS_HLOC); const bf16* CPA = (const bf16*)(F.ws + WS_CPA);
    const float* CARRY = (const float*)(F.ws + WS_CARRY); bf16* CAT = (bf16*)(F.ws + WS_CAT);
    const f32x4 gw4 = *(const f32x4*)(PIN(F, I_GNW) + l * DM + 4 * lane);
    for (int u = F.bid; u < BATCH * 64; u += F.G) {
        const int b = u >> 6, c = u & 63; const size_t m0 = (size_t)b * SEQ + c * 64;
        const f32x4 car = *(const f32x4*)(CARRY + (size_t)u * 256 + 4 * lane);
        u32x2 hl8[8], cp8[8], ly8[8];
#pragma unroll
        for (int tt = 0; tt < 8; ++tt) { const size_t m = m0 + w * 8 + tt;
            hl8[tt] = *(const u32x2*)(HLOC + m * 256 + 4 * lane); cp8[tt] = *(const u32x2*)(CPA + m * 256 + 4 * lane); ly8[tt] = *(const u32x2*)(PROJ + m * NPROJ + PC_LY + 4 * lane); }
#pragma unroll
        for (int tt = 0; tt < 8; ++tt) { const size_t m = m0 + w * 8 + tt; const u32x2 hl = hl8[tt], cp = cp8[tt], ly = ly8[tt];
            float v0 = (bflo(hl.x) + bflo(cp.x) * car.x) * gelu_tanh(bflo(ly.x));
            float v1 = (bfhi(hl.x) + bfhi(cp.x) * car.y) * gelu_tanh(bfhi(ly.x));
            float v2 = (bflo(hl.y) + bflo(cp.y) * car.z) * gelu_tanh(bflo(ly.y));
            float v3 = (bfhi(hl.y) + bfhi(cp.y) * car.w) * gelu_tanh(bfhi(ly.y));
            const float rs = RSQ(wave_sum((v0 * v0 + v1 * v1) + (v2 * v2 + v3 * v3)) * (1.0f / 256.0f) + NORM_EPS);
            u32x2 o; o.x = pk2(v0 * rs * gw4.x, v1 * rs * gw4.y); o.y = pk2(v2 * rs * gw4.z, v3 * rs * gw4.w);
            *(u32x2*)(CAT + m * DM + 4 * lane) = o; }
    }
}

constexpr int QS_STRIDE = 136, VE_STRIDE = 56;
DEV void ph_mlstm(const Ctx& F, int l) {
    const int tid = F.tid, lane = F.lane, w = F.wave, i16 = lane & 15, g = lane >> 4;
    bf16* QsB = (bf16*)F.lds;
    bf16* KsB = QsB + 2 * 64 * QS_STRIDE;
    bf16* VE = KsB + 2 * 64 * QS_STRIDE;
    bf16* VW = VE + 64 * VE_STRIDE;
    bf16* CsB = VW + 64 * VE_STRIDE;
    float* BCB = (float*)(CsB + 2 * 128 * VE_STRIDE);
    float* BIB = BCB + 128;
    const bf16* PROJ = (const bf16*)(F.ws + WS_PROJ); bf16* HM = (bf16*)(F.ws + WS_HM);
    const float qscale = 0.08838834764831845f;
    const int half = w >> 2, jt = half ? 3 - (w & 3) : (w & 3);
    for (int u0 = F.bid; u0 < BATCH * 4 * 4; u0 += F.G) {
        const int u = 4 * ((u0 & 7) * 8 + ((u0 >> 3) >> 2)) + ((u0 >> 3) & 3);
        const int b = u >> 4, h = (u >> 2) & 3, vs = u & 3;
        const float gbi = PIN(F, I_BI)[l * 4 + h], gbf = PIN(F, I_BF)[l * 4 + h];
        f32x4 accC[3];
#pragma unroll
        for (int nt = 0; nt < 3; ++nt) accC[nt] = (f32x4){0.f, 0.f, 0.f, 0.f};
        float* BCg = (float*)(F.ws + WS_MG) + (size_t)u * 8192; float* BIg = BCg + 4096;
        unsigned gri[8], grf[8];
#pragma unroll
        for (int k = 0; k < 8; ++k) { const bf16* pr = PROJ + ((size_t)b * SEQ + (8 * k + w) * 64 + lane) * NPROJ; gri[k] = pr[PC_MI + h]; grf[k] = pr[PC_MF + h]; }
#pragma unroll
        for (int k = 0; k < 8; ++k) { const int tok = (8 * k + w) * 64 + lane;
            const float zi = (bf2f(gri[k]) + gbi) * (1.0f / 15.0f), zf = (bf2f(grf[k]) + gbf) * (1.0f / 15.0f);
            const float ig = 15.0f - 30.0f * FRCP(FEXP(2.0f * zi) + 1.0f), fg = 15.0f - 30.0f * FRCP(FEXP(2.0f * zf) + 1.0f);
            float s = -FLOG(1.0f + FEXP(-fg));
#pragma unroll
            for (int o = 1; o < 64; o <<= 1) { const float t = SHFL_UP(s, o); if (lane >= o) s += t; }
            BCg[tok] = s; BIg[tok] = s - ig; }
        SYNC();
        u32x4 rq[2], rk[2]; u32x2 rvv; float rgc = 0.f, rgb = 0.f;
        {
            const size_t m0 = (size_t)b * SEQ;
#pragma unroll
            for (int i = 0; i < 2; ++i) { const int idx = tid + 512 * i, row = idx >> 4, ck = idx & 15;
                rq[i] = *(const u32x4*)(PROJ + (m0 + row) * NPROJ + PC_MQ + h * 128 + 8 * ck); rk[i] = *(const u32x4*)(PROJ + (m0 + row) * NPROJ + PC_MK + h * 128 + 8 * ck); }
            rvv = *(const u32x2*)(PROJ + (m0 + (tid >> 3)) * NPROJ + PC_MV + h * 128 + vs * 32 + 4 * (tid & 7));
            if (tid < 64) { rgc = BCg[tid]; rgb = BIg[tid]; }
        }
        for (int c = 0; c < 64; ++c) {
            const size_t m0 = (size_t)b * SEQ + c * 64; const int buf = c & 1;
            bf16* Qs = QsB + buf * 64 * QS_STRIDE; bf16* Ks = KsB + buf * 64 * QS_STRIDE; const bf16* Cs = CsB + buf * 128 * VE_STRIDE; bf16* Cn = CsB + (buf ^ 1) * 128 * VE_STRIDE;
            float* BC = BCB + buf * 64; float* BI = BIB + buf * 64;
#pragma unroll
            for (int i = 0; i < 2; ++i) { const int idx = tid + 512 * i, row = idx >> 4, ck = idx & 15;
                *(u32x4*)(Qs + row * QS_STRIDE + 8 * ck) = rq[i]; *(u32x4*)(Ks + row * QS_STRIDE + 8 * ck) = rk[i]; }
            if (tid < 64) { BC[tid] = rgc; BI[tid] = rgb; }
            SYNC();
            {
                const int row = tid >> 3, cg = tid & 7;
                const u32x2 rv = rvv;
                const float wt = FEXP(BC[63] - BI[row]);
                *(u32x2*)(VE + row * VE_STRIDE + 4 * cg) = rv;
                u32x2 sv; sv.x = pk2(bflo(rv.x) * wt, bfhi(rv.x) * wt); sv.y = pk2(bflo(rv.y) * wt, bfhi(rv.y) * wt);
                *(u32x2*)(VW + row * VE_STRIDE + 4 * cg) = sv;
                if (cg == 0) { unsigned one_ = 0x3f80u; LAUNDER_V(one_); u32x4 z = (u32x4){one_, 0u, 0u, 0u}; *(u32x4*)(VE + row * VE_STRIDE + 32) = z; *(u32x4*)(VE + row * VE_STRIDE + 40) = (u32x4){0u, 0u, 0u, 0u};
                    z.x = f2bf(wt); *(u32x4*)(VW + row * VE_STRIDE + 32) = z; *(u32x4*)(VW + row * VE_STRIDE + 40) = (u32x4){0u, 0u, 0u, 0u}; }
            }
            if (c + 1 < 64) {
                const size_t m1 = m0 + 64;
#pragma unroll
                for (int i = 0; i < 2; ++i) { const int idx = tid + 512 * i, row = idx >> 4, ck = idx & 15;
                    rq[i] = *(const u32x4*)(PROJ + (m1 + row) * NPROJ + PC_MQ + h * 128 + 8 * ck); rk[i] = *(const u32x4*)(PROJ + (m1 + row) * NPROJ + PC_MK + h * 128 + 8 * ck); }
                rvv = *(const u32x2*)(PROJ + (m1 + (tid >> 3)) * NPROJ + PC_MV + h * 128 + vs * 32 + 4 * (tid & 7));
                if (tid < 64) { rgc = BCg[(c + 1) * 64 + tid]; rgb = BIg[(c + 1) * 64 + tid]; }
            }
            SYNC();
            f32x4 Z[2] = {(f32x4){0.f, 0.f, 0.f, 0.f}, (f32x4){0.f, 0.f, 0.f, 0.f}};
            {
                bf16x8 Bq[4];
#pragma unroll
                for (int ks = 0; ks < 4; ++ks) Bq[ks] = *(const bf16x8*)(Qs + (16 * jt + i16) * QS_STRIDE + 32 * ks + 8 * g);
                const float bj = BC[16 * jt + i16];
                unsigned pk[4][2];
#pragma unroll
                for (int tt = 0; tt < 4; ++tt) {
                    if (tt <= jt) {
                        f32x4 X = (f32x4){0.f, 0.f, 0.f, 0.f};
                        bf16x8 Ak[4];
#pragma unroll
                        for (int ks = 0; ks < 4; ++ks) Ak[ks] = *(const bf16x8*)(Ks + (16 * tt + i16) * QS_STRIDE + 32 * ks + 8 * g);
                        KEEP4(Ak[0], Ak[1], Ak[2], Ak[3]);
#pragma unroll
                        for (int ks = 0; ks < 4; ++ks) X = MFMA16(Ak[ks], Bq[ks], X);
                        float p[4]; const f32x4 bi4 = *(const f32x4*)(BI + 16 * tt + 4 * g);
#pragma unroll
                        for (int r = 0; r < 4; ++r) { const float pv = X[r] * qscale * FEXP(fminf(bj - bi4[r], 60.0f));
                            p[r] = (tt < jt || 4 * g + r <= i16) ? pv : 0.f; }
                        pk[tt][0] = pk2(p[0], p[1]); pk[tt][1] = pk2(p[2], p[3]);
                    } else { pk[tt][0] = 0u; pk[tt][1] = 0u; }
                }
#pragma unroll
                for (int pr = 0; pr < 2; ++pr) {
                    if (2 * pr <= jt) {
                        u32x4 aw = (u32x4){pk[2 * pr][0], pk[2 * pr][1], pk[2 * pr + 1][0], pk[2 * pr + 1][1]};
                        const bf16x8 A = __builtin_bit_cast(bf16x8, aw);
#pragma unroll
                        for (int n = 0; n < 2; ++n) { const int ntc = n ? 2 : half;
                            const s16x4 lo = TR16(VE + (32 * pr + 4 * g + (i16 >> 2)) * VE_STRIDE + 16 * ntc + 4 * (i16 & 3));
                            const s16x4 hi = TR16(VE + (32 * pr + 16 + 4 * g + (i16 >> 2)) * VE_STRIDE + 16 * ntc + 4 * (i16 & 3));
                            const bf16x8 B = (bf16x8){lo[0], lo[1], lo[2], lo[3], hi[0], hi[1], hi[2], hi[3]};
                            Z[n] = MFMA16(A, B, Z[n]); }
#ifndef HOST_EMU
                        asm volatile("" :: "v"(aw));
#endif
                    }
                }
            }
            if (c > 0) {
                f32x4 Z2[2] = {(f32x4){0.f, 0.f, 0.f, 0.f}, (f32x4){0.f, 0.f, 0.f, 0.f}};
#pragma unroll
                for (int kh = 0; kh < 2; ++kh) {
                    bf16x8 Aq[2], Bc[2][2];
#pragma unroll
                    for (int k2 = 0; k2 < 2; ++k2) { const int ks = 2 * kh + k2; Aq[k2] = *(const bf16x8*)(Qs + (16 * jt + i16) * QS_STRIDE + 32 * ks + 8 * g);
#pragma unroll
                        for (int n = 0; n < 2; ++n) { const int ntc = n ? 2 : half;
                            const s16x4 lo = TR16(Cs + (32 * ks + 8 * g + (i16 >> 2)) * VE_STRIDE + 16 * ntc + 4 * (i16 & 3));
                            const s16x4 hi = TR16(Cs + (32 * ks + 8 * g + 4 + (i16 >> 2)) * VE_STRIDE + 16 * ntc + 4 * (i16 & 3));
                            Bc[k2][n] = (bf16x8){lo[0], lo[1], lo[2], lo[3], hi[0], hi[1], hi[2], hi[3]}; } }
                    KEEP4(Bc[0][0], Bc[0][1], Bc[1][0], Bc[1][1]);
#pragma unroll
                    for (int k2 = 0; k2 < 2; ++k2)
#pragma unroll
                        for (int n = 0; n < 2; ++n) Z2[n] = MFMA16(Aq[k2], Bc[k2][n], Z2[n]); }
                const f32x4 bc4 = *(const f32x4*)(BC + 16 * jt + 4 * g);
#pragma unroll
                for (int r = 0; r < 4; ++r) { const float f = qscale * FEXP(bc4[r]); Z[0][r] += f * Z2[0][r]; Z[1][r] += f * Z2[1][r]; }
            }
#pragma unroll
            for (int r = 0; r < 4; ++r) { const int j = 16 * jt + 4 * g + r; const float dn = FRCP(fmaxf(fabsf(SHFL(Z[1][r], lane & 48)), 1.0f));
                HM[(m0 + j) * 512 + h * 128 + vs * 32 + 16 * half + i16] = (bf16)f2bf(Z[0][r] * dn); }
            {
                const float dec = FEXP(BC[63]);
#pragma unroll
                for (int nt = 0; nt < 3; ++nt) accC[nt] = accC[nt] * dec;
#pragma unroll
                for (int ks = 0; ks < 2; ++ks) {
                    const s16x4 alo = TR16(Ks + (32 * ks + 8 * g + (i16 >> 2)) * QS_STRIDE + 16 * w + 4 * (i16 & 3));
                    const s16x4 ahi = TR16(Ks + (32 * ks + 8 * g + 4 + (i16 >> 2)) * QS_STRIDE + 16 * w + 4 * (i16 & 3));
                    const bf16x8 A = (bf16x8){alo[0], alo[1], alo[2], alo[3], ahi[0], ahi[1], ahi[2], ahi[3]};
                    bf16x8 Bv[3];
#pragma unroll
                    for (int nt = 0; nt < 3; ++nt) {
                        const s16x4 lo = TR16(VW + (32 * ks + 8 * g + (i16 >> 2)) * VE_STRIDE + 16 * nt + 4 * (i16 & 3));
                        const s16x4 hi = TR16(VW + (32 * ks + 8 * g + 4 + (i16 >> 2)) * VE_STRIDE + 16 * nt + 4 * (i16 & 3));
                        Bv[nt] = (bf16x8){lo[0], lo[1], lo[2], lo[3], hi[0], hi[1], hi[2], hi[3]}; }
                    KEEP4(A, Bv[0], Bv[1], Bv[2]);
#pragma unroll
                    for (int nt = 0; nt < 3; ++nt) { const bf16x8 B = Bv[nt];
                        const f32x4 cold = accC[nt]; accC[nt] = MFMA16(A, B, cold);
#ifndef HOST_EMU
                        asm volatile("" :: "v"(cold), "v"(A), "v"(B));
#endif
                    }
                }
#pragma unroll
                for (int nt = 0; nt < 3; ++nt)
#pragma unroll
                    for (int r = 0; r < 4; ++r) Cn[(16 * w + 4 * g + r) * VE_STRIDE + 16 * nt + i16] = (bf16)f2bf(accC[nt][r]);
            }
        }
        SYNC();
    }
}

DEV void ph_mfin(const Ctx& F, int l) {
    const int gw = F.bid * 8 + F.wave, NGW = F.G * 8, lane = F.lane;
    const bf16* PROJ = (const bf16*)(F.ws + WS_PROJ); const bf16* HM = (const bf16*)(F.ws + WS_HM); bf16* CAT = (bf16*)(F.ws + WS_CAT);
    float gm[8];
#pragma unroll
    for (int j = 0; j < 8; ++j) gm[j] = PIN(F, I_GNW)[l * DM + 256 + 8 * lane + j];
    u32x4 hv4[4], ov4[4], hvn[4], ovn[4];
#define MFIN_LOAD(HV, OV, M0) do { _Pragma("unroll") for (int q = 0; q < 4; ++q) { const int mm = (M0) + q * NGW; const size_t ms = (size_t)(mm < MTOK ? mm : 0); \
            HV[q] = *(const u32x4*)(HM + ms * 512 + 8 * lane); OV[q] = *(const u32x4*)(PROJ + ms * NPROJ + PC_MO + 8 * lane); } } while (0)
    MFIN_LOAD(hv4, ov4, gw);
    for (int m0 = gw; m0 < MTOK; m0 += 4 * NGW) {
        MFIN_LOAD(hvn, ovn, m0 + 4 * NGW);
#pragma unroll
        for (int q = 0; q < 4; ++q) { const int m = m0 + q * NGW; if (m >= MTOK) break;
            const u32x4 hv = hv4[q], ov = ov4[q];
            float v[8] = {bflo(hv.x), bfhi(hv.x), bflo(hv.y), bfhi(hv.y), bflo(hv.z), bfhi(hv.z), bflo(hv.w), bfhi(hv.w)};
            const float o[8] = {bflo(ov.x), bfhi(ov.x), bflo(ov.y), bfhi(ov.y), bflo(ov.z), bfhi(ov.z), bflo(ov.w), bfhi(ov.w)};
            float s = 0.f;
#pragma unroll
            for (int j = 0; j < 8; ++j) s += v[j] * v[j];
            s += SHFL_XOR(s, 1); s += SHFL_XOR(s, 2); s += SHFL_XOR(s, 4); s += SHFL_XOR(s, 8);
            const float rs = RSQ(s * (1.0f / 128.0f) + NORM_EPS);
            u32x4 r;
            r.x = pk2(v[0] * rs * gm[0] * fsigmoid(o[0]), v[1] * rs * gm[1] * fsigmoid(o[1]));
            r.y = pk2(v[2] * rs * gm[2] * fsigmoid(o[2]), v[3] * rs * gm[3] * fsigmoid(o[3]));
            r.z = pk2(v[4] * rs * gm[4] * fsigmoid(o[4]), v[5] * rs * gm[5] * fsigmoid(o[5]));
            r.w = pk2(v[6] * rs * gm[6] * fsigmoid(o[6]), v[7] * rs * gm[7] * fsigmoid(o[7]));
            *(u32x4*)(CAT + (size_t)m * DM + 256 + 8 * lane) = r; }
#pragma unroll
        for (int q = 0; q < 4; ++q) { hv4[q] = hvn[q]; ov4[q] = ovn[q]; }
    }
#undef MFIN_LOAD
}

constexpr int DS_HIST = 0;
constexpr int DS_MASK = 49152;
constexpr int DS_CAND = 65536;
constexpr int DS_SELL = 102400;
constexpr int DS_META = 118784;
constexpr int DS_RB = DS_META + 512;
constexpr int DS_SS = DS_RB + 2048;
constexpr int DS_SLOT = 12800;
constexpr int NBIN = 768, CAND_CAP = 128;
__device__ const unsigned char T5B[114] = {0, 1, 2, 3, 4, 5, 6, 7, 8, 9, 10, 11, 12, 13, 14, 15, 16, 16, 16, 17, 17, 18, 18, 18, 19, 19, 19, 20, 20, 20, 20, 21, 21, 21, 21, 22, 22, 22, 22, 22, 23, 23, 23, 23, 23, 23, 24, 24, 24, 24, 24, 24, 25, 25, 25, 25, 25, 25, 25, 26, 26, 26, 26, 26, 26, 26, 26, 27, 27, 27, 27, 27, 27, 27, 27, 27, 27, 28, 28, 28, 28, 28, 28, 28, 28, 28, 28, 29, 29, 29, 29, 29, 29, 29, 29, 29, 29, 29, 29, 30, 30, 30, 30, 30, 30, 30, 30, 30, 30, 30, 30, 30, 30, 31};

DEV int score_bin(float sc) {
    const unsigned u = __builtin_bit_cast(unsigned, sc);
    int e = (int)((u >> 18) & 0x1FFFu) - 119 * 32; e = e < 0 ? 0 : (e > 383 ? 383 : e);
    return (u >> 31) ? 383 - e : 384 + e;
}
DEV unsigned score_key(float sc) { const unsigned u = __builtin_bit_cast(unsigned, sc); return (u >> 31) ? ~u : (u | 0x80000000u); }
DEV unsigned score_code(float sc) {
    const unsigned u = __builtin_bit_cast(unsigned, sc);
    int e = (int)((u >> 18) & 0x1FFFu) - 119 * 32; e = e < 0 ? 0 : (e > 383 ? 383 : e);
    const int v = (e << 6) | (int)((u >> 12) & 63u), sm = (int)u >> 31;
    return (unsigned)(0x6000 + (v ^ sm));
}
DEV int code_bin(unsigned c) { return (int)(c >> 6); }
DEV unsigned code_key(unsigned c) { return c & 63u; }


DEV f32x4 dsa_score_tile(const bf16x8 A, const bf16x8 (&QS)[2], const bf16x8 (&Bq)[8], const float (&wq)[8]) {
    f32x4 sc = (f32x4){0.f, 0.f, 0.f, 0.f};
#pragma unroll
    for (int h = 0; h < 8; ++h) { const f32x4 d = MFMA16(A, Bq[h], (f32x4){0.f, 0.f, 0.f, 0.f});
#pragma unroll
        for (int r = 0; r < 4; ++r) { sc[r] = __builtin_fmaf(wq[h], RELU(d[r]), sc[r]); NOPACK(sc[r]); } }
    return sc;
}
DEV void ph_dsa(const Ctx& F, int l) {
    const int tid = F.tid, lane = F.lane, w = F.wave, i16 = lane & 15, g = lane >> 4;
    unsigned* HIST = (unsigned*)(F.lds + DS_HIST); unsigned* MASK = (unsigned*)(F.lds + DS_MASK); u32x2* CAND = (u32x2*)(F.lds + DS_CAND);
    unsigned short* SELL = (unsigned short*)(F.lds + DS_SELL); int* BST = (int*)(F.lds + DS_META); int* NAB = BST + 32; int* NCAND = BST + 64; int* NSEL = BST + 96;
    float* RB = (float*)(F.lds + DS_RB);
    const bf16* QIDX = (const bf16*)(F.ws + WS_QIDX); const bf16* KIDX = (const bf16*)(F.ws + WS_KIDX); const float* WI = (const float*)(F.ws + WS_WI);
    const bf16* QABS = (const bf16*)(F.ws + WS_QABS); const bf16* CKV = (const bf16*)(F.ws + WS_CKV); bf16* CAT = (bf16*)(F.ws + WS_CAT);
    const bf16* WUVT = (const bf16*)(F.ws + WS_WUVT) + (size_t)l * 4 * 64 * 128; float* SS = (float*)(F.lds + DS_SS);
    for (int e = tid; e < 114 * 4; e += 512) RB[e] = PIN(F, I_RELB)[T5B[e >> 2] * 4 + (e & 3)] * 1.4426950408889634f;
    SYNC();
    for (int ui = F.bid; ui < BATCH * 128; ui += F.G) {
#ifdef HOST_EMU
        int b, qt; { const int wv = ui & 255, k = ui >> 8, r = wv & 15; b = wv >> 4; qt = (k & 1) ? (32 * (k >> 1) + 31 - r) : (32 * (k >> 1) + r); }
#else
        int b, qt; { const int wv = ui & 255, k = ui >> 8, xj = wv >> 3, r = xj & 15; b = 2 * (wv & 7) + (xj >> 4);
            qt = (k & 1) ? (32 * (k >> 1) + 31 - r) : (32 * (k >> 1) + r); }
#endif
        const int t0 = 32 * qt, nkt = 2 * qt + 2; const size_t mb = (size_t)b * SEQ;
        const GAS char* const ckvb = UNIP(CKV + mb * 128);
        const int nt = w & 1;
        u32x2* sw = (u32x2*)(F.ws + (F.bid < 128 ? WS_QL + (size_t)F.bid * 262144 : WS_SCR2 + (size_t)(F.bid - 128) * 262144) + (size_t)w * 32768) + lane;
        bf16x8 Bq[8]; float wq[8];
        { const size_t mq = mb + t0 + 16 * nt + i16;
#pragma unroll
            for (int h = 0; h < 8; ++h) { Bq[h] = *(const bf16x8*)(QIDX + mq * 256 + 32 * h + 8 * g); wq[h] = WI[mq * 8 + h]; } }
        bf16x8 QS[2];
#pragma unroll
        for (int j = 0; j < 8; ++j) { float s = 0.f;
#pragma unroll
            for (int h = 0; h < 8; ++h) s += wq[h] * bf2f((unsigned)(unsigned short)Bq[h][j]);
            const unsigned hi = f2bf(s); QS[0][j] = (short)hi; QS[1][j] = (short)f2bf(s - bf2f(hi)); }
        for (int e = tid; e < 16 * NBIN; e += 512) HIST[e] = 0u;
        for (int e = tid; e < 32 * 128; e += 512) MASK[e] = 0u;
        if (tid < 32) NCAND[tid] = 0;
        SYNC();
        const GAS char* const kidb = UNIP(KIDX + mb * 32); const unsigned kidl = (unsigned)(i16 * 64 + g * 16);
        bf16x8 Apre = *(const GAS bf16x8*)(kidb + ((unsigned)(16 * (w >> 1)) * 64u + kidl));
        for (int kt = w >> 1; kt < nkt; kt += 4) {
            const bf16x8 A = Apre;
            { const int kn = kt + 4 < nkt ? kt + 4 : kt; Apre = *(const GAS bf16x8*)(kidb + ((unsigned)(16 * kn) * 64u + kidl)); }
            const f32x4 sc = dsa_score_tile(A, QS, Bq, wq);
            unsigned cd[4];
#pragma unroll
            for (int r = 0; r < 4; ++r) cd[r] = score_code(sc[r]);
            { u32x2 pk; pk.x = cd[0] | (cd[1] << 16); pk.y = cd[2] | (cd[3] << 16); sw[(size_t)((kt - (w >> 1)) >> 2) * 64] = pk; }
            const unsigned inc = nt ? 65536u : 1u;
            if (kt < 2 * qt) {
#pragma unroll
                for (int r = 0; r < 4; ++r) atomicAdd(&HIST[i16 * NBIN + code_bin(cd[r])], inc);
            } else {
                const int t = t0 + 16 * nt + i16;
#pragma unroll
                for (int r = 0; r < 4; ++r) { const int s = 16 * kt + 4 * g + r;
                    if (s <= t) atomicAdd(&HIST[i16 * NBIN + code_bin(cd[r])], inc); }
            }
        }
        SYNC();
        {
            int cnt4[4][12], tot4[4], suf4[4];
#pragma unroll
            for (int rr = 0; rr < 4; ++rr) { const int row = 4 * w + rr, sh = (row >> 4) * 16; const unsigned* hp = HIST + (row & 15) * NBIN + 12 * lane; int tot = 0;
#pragma unroll
                for (int i = 0; i < 12; ++i) { cnt4[rr][i] = (int)((hp[i] >> sh) & 0xFFFFu); tot += cnt4[rr][i]; }
                tot4[rr] = tot; suf4[rr] = tot; }
#pragma unroll
            for (int o = 1; o < 64; o <<= 1) {
#pragma unroll
                for (int rr = 0; rr < 4; ++rr) { const int v = SHFL_DOWN(suf4[rr], o); if (lane + o < 64) suf4[rr] += v; } }
#pragma unroll
            for (int rr = 0; rr < 4; ++rr) { const int row = 4 * w + rr, t = t0 + row;
                if (t < 256) { if (lane == 0) { BST[row] = -1; NAB[row] = t + 1; } }
                else { const int above = suf4[rr] - tot4[rr];
                    if (above < 256 && above + tot4[rr] >= 256) {
                        int run = above, bs = -1, na = 0; bool done = false;
#pragma unroll
                        for (int i = 11; i >= 0; --i) { if (!done) { if (run + cnt4[rr][i] >= 256) { bs = 12 * lane + i; na = run; done = true; } else run += cnt4[rr][i]; } }
                        BST[row] = bs; NAB[row] = na; } } }
        }
        SYNC();
        { const int row = 16 * nt + i16, t = t0 + row, bs = BST[row];
        const int ntl = nkt > (w >> 1) ? ((nkt - 1 - (w >> 1)) >> 2) + 1 : 0;
        u32x2 Pc[8], Pn[8];
#pragma unroll
        for (int q = 0; q < 8; ++q) Pc[q] = sw[(size_t)(q < 64 ? q : 63) * 64];
        for (int jb = 0; jb < ntl; jb += 8) {
#pragma unroll
            for (int q = 0; q < 8; ++q) { const int jn = jb + 8 + q; Pn[q] = sw[(size_t)(jn < 64 ? jn : 63) * 64]; }
#pragma unroll
            for (int q = 0; q < 8; ++q) { const int j = jb + q; if (j < ntl) { const int kt = (w >> 1) + 4 * j; const u32x2 pc = Pc[q];
            const bool full = kt < 2 * qt;
            const int s0 = 16 * kt + 4 * g; unsigned nib = 0u, cnd = 0u, cc[4];
#pragma unroll
            for (int r = 0; r < 4; ++r) { const unsigned wd = r < 2 ? pc.x : pc.y; cc[r] = (r & 1) ? (wd >> 16) : (wd & 0xffffu);
                const int bn = code_bin(cc[r]); const bool ok = full || s0 + r <= t;
                nib |= (ok && bn > bs) ? (1u << r) : 0u; cnd |= (ok && bn == bs) ? (1u << r) : 0u; }
            if (nib) atomicOr(&MASK[row * 128 + (s0 >> 5)], nib << (s0 & 31));
            if (cnd) {
#pragma unroll
                for (int r = 0; r < 4; ++r) if ((cnd >> r) & 1u) { const int pos = (int)atomicAdd((unsigned*)&NCAND[row], 1u); if (pos < CAND_CAP) CAND[row * CAND_CAP + pos] = (u32x2){code_key(cc[r]), (unsigned)(s0 + r)}; } }
            } }
#pragma unroll
            for (int q = 0; q < 8; ++q) Pc[q] = Pn[q];
        } }
        SYNC();
#pragma unroll 1
        for (int rr = 0; rr < 4; ++rr) {
            const int row = 4 * w + rr; if (BST[row] < 0) continue;
            const int n = NCAND[row] < CAND_CAP ? NCAND[row] : CAND_CAP, need = 256 - NAB[row];
            for (int i = lane; i < n; i += 64) { const u32x2 me = CAND[row * CAND_CAP + i]; int rank = 0;
                for (int j0 = 0; j0 < n; j0 += 8) { u32x2 o8[8];
#pragma unroll
                    for (int q = 0; q < 8; ++q) o8[q] = CAND[row * CAND_CAP + (j0 + q < CAND_CAP ? j0 + q : CAND_CAP - 1)];
#pragma unroll
                    for (int q = 0; q < 8; ++q) rank += (j0 + q < n && (o8[q].x > me.x || (o8[q].x == me.x && o8[q].y < me.y))) ? 1 : 0; }
#ifndef DSA_DBG_NOCAND
                if (rank < need) atomicOr(&MASK[row * 128 + (me.y >> 5)], 1u << (me.y & 31));
#endif
            }
        }
        SYNC();
#ifdef DSA_DBG_SEL
        for (int e = tid; e < 32 * 128; e += 512) { const int row = e >> 7, wi = e & 127, t = t0 + row, lo = t - 255 < 0 ? 0 : t - 255; unsigned m = 0u;
            for (int bq = 0; bq < 32; ++bq) { const int s = 32 * wi + bq; if (s >= lo && s <= t) m |= 1u << bq; }
            MASK[e] = m; }
        SYNC();
#endif
        {
            unsigned w04[4], w14[4]; int c4[4], inc4[4];
#pragma unroll
            for (int rr = 0; rr < 4; ++rr) { const int row = 4 * w + rr; w04[rr] = MASK[row * 128 + 2 * lane]; w14[rr] = MASK[row * 128 + 2 * lane + 1];
                c4[rr] = __builtin_popcount(w04[rr]) + __builtin_popcount(w14[rr]); inc4[rr] = c4[rr]; }
#pragma unroll
            for (int o = 1; o < 64; o <<= 1) {
#pragma unroll
                for (int rr = 0; rr < 4; ++rr) { const int v = SHFL_UP(inc4[rr], o); if (lane >= o) inc4[rr] += v; } }
#pragma unroll
            for (int rr = 0; rr < 4; ++rr) { const int row = 4 * w + rr; unsigned w0 = w04[rr], w1 = w14[rr]; int pos = inc4[rr] - c4[rr];
                while (w0) { const int bt = __builtin_ctz(w0); w0 &= w0 - 1; if (pos < 256) SELL[row * 256 + pos] = (unsigned short)(64 * lane + bt); ++pos; }
                while (w1) { const int bt = __builtin_ctz(w1); w1 &= w1 - 1; if (pos < 256) SELL[row * 256 + pos] = (unsigned short)(64 * lane + 32 + bt); ++pos; }
                if (lane == 63) NSEL[row] = inc4[rr] < 256 ? inc4[rr] : 256; }
        }
        SYNC();
        bf16* TL = (bf16*)(F.lds + w * DS_SLOT); bf16* OLw = (bf16*)(F.lds + w * DS_SLOT + 8704);
#pragma unroll 1
        for (int rr = 0; rr < 4; ++rr) {
            const int row = 4 * w + rr, t = t0 + row, ns = UNI(NSEL[row]); const size_t mt = mb + t;
            const unsigned short* sl = SELL + row * 256;
            bf16x8 Bh[4];
#pragma unroll
            for (int ks = 0; ks < 4; ++ks) Bh[ks] = i16 < 4 ? *(const bf16x8*)(QABS + mt * 512 + i16 * 128 + 32 * ks + 8 * g) : (bf16x8){0, 0, 0, 0, 0, 0, 0, 0};
            f32x4 O[8];
#pragma unroll
            for (int nt = 0; nt < 8; ++nt) O[nt] = (f32x4){0.f, 0.f, 0.f, 0.f};
            float mrun = -1e30f, lrun = 0.f;
            const float bfar = RB[113 * 4 + (i16 & 3)];
            const int nch = (ns + 31) >> 5;
            u32x4 gvA[8];
#ifndef HOST_EMU
#define ATT_KEEP8(A) asm volatile("" :: "v"(A[0][0]), "v"(A[0][1]), "v"(A[0][2]), "v"(A[0][3]), "v"(A[1][0]), "v"(A[1][1]), "v"(A[1][2]), "v"(A[1][3]))
#else
#define ATT_KEEP8(A) (void)0
#endif
#define ATT_LOAD(GV, CK, FULL) do { int sidx[8]; \
                _Pragma("unroll") for (int i = 0; i < 8; ++i) sidx[i] = (int)sl[32 * (CK) + 4 * i + g];            \
                _Pragma("unroll") for (int i = 0; i < 8; ++i) { const int kp = 32 * (CK) + 4 * i + g; sidx[i] = (FULL || kp < ns) ? sidx[i] : 0; } \
                _Pragma("unroll") for (int i = 0; i < 8; ++i) GV[i] = *(const GAS u32x4*)(ckvb + (((unsigned)sidx[i] << 8) + 16u * (unsigned)i16)); } while (0)
#define ATT_STEP(GV, CK, FULL) do { const int ck = (CK); \
                _Pragma("unroll") for (int i = 0; i < 8; ++i) *(u32x4*)(TL + (4 * i + g) * 136 + 8 * i16) = GV[i]; \
                const u32x2 sk0 = *(const u32x2*)(sl + 32 * ck + 4 * g), sk1 = *(const u32x2*)(sl + 32 * ck + 16 + 4 * g); \
                WAVE_LDS_FENCE(); \
                if (ck + 1 < nch) ATT_LOAD(GV, ck + 1, FULL); \
                float bia[2][4]; \
                if (FULL && t - UNI((int)sl[32 * ck + 31]) >= 113) {                   \
                _Pragma("unroll") for (int kt = 0; kt < 2; ++kt) \
                _Pragma("unroll") for (int r = 0; r < 4; ++r) bia[kt][r] = bfar; \
                } else { \
                _Pragma("unroll") for (int kt = 0; kt < 2; ++kt) \
                _Pragma("unroll") for (int r = 0; r < 4; ++r) { const unsigned wd = kt ? (r < 2 ? sk1.x : sk1.y) : (r < 2 ? sk0.x : sk0.y); \
                        int dist = t - (int)((wd >> (16 * (r & 1))) & 0xffffu); dist = dist < 0 ? 0 : (dist > 113 ? 113 : dist); \
                        bia[kt][r] = RB[dist * 4 + (i16 & 3)]; } } \
                f32x4 lg[2]; \
                { bf16x8 Af[2][4];                                    \
                _Pragma("unroll") for (int kt = 0; kt < 2; ++kt) _Pragma("unroll") for (int ks = 0; ks < 4; ++ks) Af[kt][ks] = *(const bf16x8*)(TL + (16 * kt + i16) * 136 + 32 * ks + 8 * g); \
                ATT_KEEP8(Af); \
                _Pragma("unroll") for (int kt = 0; kt < 2; ++kt) { lg[kt] = (f32x4){0.f, 0.f, 0.f, 0.f}; \
                _Pragma("unroll") for (int ks = 0; ks < 4; ++ks) lg[kt] = MFMA16(Af[kt][ks], Bh[ks], lg[kt]); } } \
                float cm = -1e30f; \
                _Pragma("unroll") for (int kt = 0; kt < 2; ++kt) \
                _Pragma("unroll") for (int r = 0; r < 4; ++r) { const int kp = 32 * ck + 16 * kt + 4 * g + r; \
                        lg[kt][r] = (FULL || kp < ns) ? lg[kt][r] + bia[kt][r] : -1e30f; cm = fmaxf(cm, lg[kt][r]); } \
                if (ck == 0) { cm = fmaxf(cm, SHFL_XOR(cm, 16)); cm = fmaxf(cm, SHFL_XOR(cm, 32)); mrun = cm; } \
                float p[2][4]; \
                _Pragma("unroll") for (int kt = 0; kt < 2; ++kt) \
                _Pragma("unroll") for (int r = 0; r < 4; ++r) { p[kt][r] = (FULL || lg[kt][r] > -1e29f) ? FEXP2(lg[kt][r] - mrun) : 0.f; lrun += p[kt][r]; } \
                u32x4 aw = (u32x4){0u, 0u, 0u, 0u}; \
                if (i16 < 4) aw = (u32x4){pk2(p[0][0], p[0][1]), pk2(p[0][2], p[0][3]), pk2(p[1][0], p[1][1]), pk2(p[1][2], p[1][3])}; \
                const bf16x8 A = __builtin_bit_cast(bf16x8, aw); \
                _Pragma("unroll") for (int nt = 0; nt < 8; ++nt) { \
                    const s16x4 lo = TR16(TL + (4 * g + (i16 >> 2)) * 136 + 16 * nt + 4 * (i16 & 3)); \
                    const s16x4 hi = TR16(TL + (16 + 4 * g + (i16 >> 2)) * 136 + 16 * nt + 4 * (i16 & 3)); \
                    const bf16x8 B = (bf16x8){lo[0], lo[1], lo[2], lo[3], hi[0], hi[1], hi[2], hi[3]}; \
                    O[nt] = MFMA16(A, B, O[nt]); } \
                WAVE_LDS_FENCE(); } while (0)
            if (ns == 256) { ATT_LOAD(gvA, 0, true); for (int ck2 = 0; ck2 < 8; ++ck2) ATT_STEP(gvA, ck2, true); }
            else { ATT_LOAD(gvA, 0, false); for (int ck2 = 0; ck2 < nch; ++ck2) ATT_STEP(gvA, ck2, false); }
#undef ATT_STEP
#undef ATT_LOAD
            lrun += SHFL_XOR(lrun, 16); lrun += SHFL_XOR(lrun, 32);
            float li[4];
#pragma unroll
            for (int r = 0; r < 4; ++r) li[r] = FRCP(SHFL(lrun, r));
            if (g == 0) {
#pragma unroll
                for (int nt = 0; nt < 8; ++nt)
#pragma unroll
                    for (int r = 0; r < 4; ++r) OLw[(rr * 4 + r) * 128 + 16 * nt + i16] = (bf16)f2bf(O[nt][r] * li[r]);
            }
        }
        bf16x8 Wf[4][4];
#pragma unroll
        for (int ks = 0; ks < 4; ++ks)
#pragma unroll
            for (int nt = 0; nt < 4; ++nt) Wf[ks][nt] = *(const bf16x8*)(WUVT + ((size_t)((w >> 1) * 64 + 16 * nt + i16)) * 128 + 32 * ks + 8 * g);
        SYNC();
        {
            const int h = w >> 1, mtile = w & 1, q = 16 * mtile + i16;
            const bf16* olq = (const bf16*)(F.lds + (q >> 2) * DS_SLOT + 8704) + ((q & 3) * 4 + h) * 128;
            float gaw[4];
#pragma unroll
            for (int nt = 0; nt < 4; ++nt) gaw[nt] = PIN(F, I_GNW)[l * DM + 768 + h * 64 + 16 * nt + i16];
            f32x4 acc[4];
#pragma unroll
            for (int nt = 0; nt < 4; ++nt) acc[nt] = (f32x4){0.f, 0.f, 0.f, 0.f};
#pragma unroll
            for (int ks = 0; ks < 4; ++ks) { const bf16x8 A = *(const bf16x8*)(olq + 32 * ks + 8 * g);
#pragma unroll
                for (int nt = 0; nt < 4; ++nt) acc[nt] = MFMA16(A, Wf[ks][nt], acc[nt]); }
#pragma unroll
            for (int r = 0; r < 4; ++r) { float s = (acc[0][r] * acc[0][r] + acc[1][r] * acc[1][r]) + (acc[2][r] * acc[2][r] + acc[3][r] * acc[3][r]);
                s += SHFL_XOR(s, 1); s += SHFL_XOR(s, 2); s += SHFL_XOR(s, 4); s += SHFL_XOR(s, 8);
                if (i16 == 0) SS[(16 * mtile + 4 * g + r) * 4 + h] = s; }
            SYNC();
#pragma unroll
            for (int r = 0; r < 4; ++r) { const int qq = 16 * mtile + 4 * g + r; const f32x4 s4 = *(const f32x4*)(SS + qq * 4);
                const float rs = RSQ(((s4.x + s4.y) + (s4.z + s4.w)) * (1.0f / 256.0f) + NORM_EPS);
                bf16* dst = CAT + (mb + t0 + qq) * DM + 768 + h * 64 + i16;
#pragma unroll
                for (int nt = 0; nt < 4; ++nt) dst[16 * nt] = (bf16)f2bf(acc[nt][r] * rs * gaw[nt]); }
        }
        SYNC();
    }
}
#ifndef HOST_EMU
namespace pg8 {
#define PG8_LAS __attribute__((address_space(3)))
typedef unsigned short bf16_t;
typedef short bf16x8 __attribute__((ext_vector_type(8)));
typedef float f32x4 __attribute__((ext_vector_type(4)));
typedef unsigned u32x4 __attribute__((ext_vector_type(4)));
constexpr int BM = 256, BK = 64, HALF = 128, HTB = HALF * BK * 2  , STAGE_BYTES = 8 * HTB, NXCD = 8, WGM = 8;

__host__ __device__ __forceinline__ int lds_byte(int r, int c) { const int st = (r >> 4) * 2 + (c >> 5), rr = r & 15, cc = c & 31, ob = rr * 64 + cc * 2; return st * 1024 + (ob ^ (((ob >> 9) & 1) << 5)); }
__host__ __device__ __forceinline__ void stage_rc(int b, int& R, int& C) { const int st = b / 1024, sb = b % 1024, swz = sb ^ (((sb >> 9) & 1) << 5); R = (st >> 1) * 16 + swz / 64; C = (st & 1) * 32 + (swz % 64) / 2; }
__host__ __device__ __forceinline__ int perm32(int rho) { const int n = rho >> 4, i = rho & 15; return 8 * (i >> 2) + 4 * n + (i & 3); }

struct Unit { int pm, pn; };
struct Gemm { const bf16_t* A; const bf16_t* Bt; int M, N, K; };

struct StaticOrder {
    int nM, nN, nwg, G, c;
    __host__ __device__ void init(int M, int N, int G_, int c_) { nM = M / BM; nN = N / BM; nwg = nM * nN; G = G_; c = c_; }
    __host__ __device__ bool next(int i, Unit& u) const {
        const long L = (long)i * G + c; if (L >= nwg) return false;
        int wgid = (int)L; { const int q = nwg / NXCD, r = nwg % NXCD, xcd = wgid % NXCD, off = wgid / NXCD; wgid = (xcd < r ? xcd * (q + 1) : r * (q + 1) + (xcd - r) * q) + off; }
        const int nig = WGM * nN, gid = wgid / nig, fm = gid * WGM, gsz = (nM - fm) < WGM ? (nM - fm) : WGM;
        u.pm = fm + ((wgid % nig) % gsz); u.pn = (wgid % nig) / gsz; return true;
    }
    __device__ __forceinline__ void a_ready(const Unit&) const {}
    __device__ __forceinline__ void done(const Unit&) const {}
};
__device__ __forceinline__ unsigned cvt_pk_bf16(float lo, float hi) { unsigned r; asm volatile("v_cvt_pk_bf16_f32 %0, %1, %2" : "=v"(r) : "v"(lo), "v"(hi)); return r; }
template <class Epi, class Sched, bool ALIGN_EPI = false, bool SP2 = false>
__device__ __forceinline__ void gemm_phase(PG8_LAS unsigned char* lds, const Gemm g, const Sched& S, const Epi& E, const int tid_in) {
    const int tid = tid_in, wid = __builtin_amdgcn_readfirstlane(tid >> 6), lane = tid & 63, wr = wid >> 2, wc = wid & 3, fr = lane & 15, fq = lane >> 4;
    const int K = g.K, nt = K / BK;
    unsigned voffA[2], voffB[2];
#pragma unroll
    for (int i = 0; i < 2; ++i) { int R, C; stage_rc(tid * 16 + i * 8192, R, C); const int Rb = Epi::PERM ? ((R & ~31) + perm32(R & 31)) : R;
        voffA[i] = (unsigned)(R * K + C) * 2u; voffB[i] = (unsigned)(Rb * K + C) * 2u; }
    const size_t kstep = (size_t)(BK * 2);
    const size_t hstep = (size_t)HALF * K * 2;
    const size_t tstep = 2 * hstep;
    const unsigned ldsw = (unsigned)wid * 1024u;
    const int aoff = lds_byte(wr * 64 + fr, fq * 8), boff = lds_byte(wc * 32 + fr, fq * 8);
#define PG8_SA(b, h) (((b) * 2 + (h)) * HTB)
#define PG8_SB(b, h) ((4 + (b) * 2 + (h)) * HTB)
#define PG8_STAGE(bufoff, gbase, voff) do { _Pragma("unroll") for (int _i = 0; _i < 2; ++_i) \
        __builtin_amdgcn_global_load_lds((const unsigned*)((const char*)(gbase) + (voff)[_i]), (PG8_LAS unsigned*)(lds + (bufoff) + ldsw + _i * 8192), 16, 0, 0); } while (0)
#define PG8_LDA(dst, b, h) do { _Pragma("unroll") for (int m = 0; m < 4; ++m) _Pragma("unroll") for (int k = 0; k < 2; ++k) dst[m][k] = *(const PG8_LAS bf16x8*)(lds + PG8_SA(b, h) + aoff + m * 2048 + k * 1024); } while (0)
#define PG8_LDB(dst, b, h) do { _Pragma("unroll") for (int n = 0; n < 2; ++n) _Pragma("unroll") for (int k = 0; k < 2; ++k) dst[n][k] = *(const PG8_LAS bf16x8*)(lds + PG8_SB(b, h) + boff + n * 2048 + k * 1024); } while (0)
#define PG8_MMA(ai, bj, At, Bt) do { __builtin_amdgcn_s_setprio(1); _Pragma("unroll") for (int m = 0; m < 4; ++m) _Pragma("unroll") for (int n = 0; n < 2; ++n) _Pragma("unroll") for (int k = 0; k < 2; ++k) \
        acc[ai][bj][m][n] = __builtin_amdgcn_mfma_f32_16x16x32_bf16(Bt[n][k], At[m][k], acc[ai][bj][m][n], 0, 0, 0); __builtin_amdgcn_s_setprio(0); } while (0)
#define PG8_WAIT_V(n) asm volatile("s_waitcnt vmcnt(" #n ")" ::: "memory")
#define PG8_WAIT_L(n) asm volatile("s_waitcnt lgkmcnt(" #n ")" ::: "memory")
#define PG8_BAR __builtin_amdgcn_s_barrier()
#define PG8_SCHED __builtin_amdgcn_sched_barrier(0)
    Unit cur, nxt; int ui = 0;
    if (!S.next(0, cur)) return;
    f32x4 acc[2][2][4][2];
#pragma unroll
    for (int a = 0; a < 2; ++a)
#pragma unroll
        for (int b = 0; b < 2; ++b)
#pragma unroll
            for (int m = 0; m < 4; ++m)
#pragma unroll
                for (int n = 0; n < 2; ++n) acc[a][b][m][n] = (f32x4){0.f, 0.f, 0.f, 0.f};
    bf16x8 At[4][2], B0[2][2], B1[2][2];
    const char* cA = (const char*)g.A + (size_t)cur.pm * tstep; const char* cB = (const char*)g.Bt + (size_t)cur.pn * tstep;
    S.a_ready(cur);
    if constexpr (SP2) {
        PG8_STAGE(PG8_SB(0, 0), cB, voffB); PG8_STAGE(PG8_SB(0, 1), cB + hstep, voffB); PG8_STAGE(PG8_SA(0, 0), cA, voffA); PG8_STAGE(PG8_SA(0, 1), cA + hstep, voffA);
        if (wr == 1) PG8_BAR;
        PG8_WAIT_V(2); PG8_BAR;
        PG8_STAGE(PG8_SB(1, 0), cB + kstep, voffB); PG8_STAGE(PG8_SA(1, 0), cA + kstep, voffA); PG8_STAGE(PG8_SB(1, 1), cB + hstep + kstep, voffB);
        PG8_WAIT_V(6); PG8_BAR;
    } else {
        PG8_STAGE(PG8_SB(0, 0), cB, voffB); PG8_STAGE(PG8_SA(0, 0), cA, voffA); PG8_STAGE(PG8_SB(0, 1), cB + hstep, voffB); PG8_STAGE(PG8_SA(0, 1), cA + hstep, voffA);
        if (wr == 1) PG8_BAR;
        PG8_WAIT_V(4); PG8_BAR;
        PG8_STAGE(PG8_SB(1, 0), cB + kstep, voffB); PG8_STAGE(PG8_SA(1, 0), cA + kstep, voffA); PG8_STAGE(PG8_SB(1, 1), cB + hstep + kstep, voffB);
        PG8_WAIT_V(6); PG8_BAR;
    }
    for (;;) {
        const bool has_next = S.next(ui + 1, nxt);
        const char* nA = has_next ? (const char*)g.A + (size_t)nxt.pm * tstep : cA; const char* nB = has_next ? (const char*)g.Bt + (size_t)nxt.pn * tstep : cB;
#pragma unroll 1
        for (int t = 0; t < nt; t += 2) {
            const bool last = (t == nt - 2);
            const char* a1 = cA + (size_t)(t + 1) * kstep;
            const char* a2 = last ? nA : cA + (size_t)(t + 2) * kstep; const char* b2 = last ? nB : cB + (size_t)(t + 2) * kstep;
            const char* a3 = a2 + kstep; const char* b3 = b2 + kstep;
            if (last && has_next) S.a_ready(nxt);
            if constexpr (Epi::NORM) { if (t == 2) E.prefetch(cur, tid, wid); if (t == 4) E.reduce_rs(tid); }
            if constexpr (SP2) {
            PG8_LDB(B0, 0, 0); PG8_LDB(B1, 0, 1); PG8_SCHED; PG8_LDA(At, 0, 0); PG8_STAGE(PG8_SA(1, 1), a1 + hstep, voffA);
            PG8_WAIT_V(8); PG8_WAIT_L(0); PG8_BAR; PG8_MMA(0, 0, At, B0); PG8_MMA(0, 1, At, B1); PG8_BAR; PG8_SCHED;
            PG8_LDA(At, 0, 1); PG8_STAGE(PG8_SB(0, 0), b2, voffB); PG8_STAGE(PG8_SB(0, 1), b2 + hstep, voffB); PG8_STAGE(PG8_SA(0, 0), a2, voffA);
            PG8_WAIT_V(8); PG8_WAIT_L(0); PG8_BAR; PG8_MMA(1, 0, At, B0); PG8_MMA(1, 1, At, B1); PG8_BAR; PG8_SCHED;
            PG8_LDB(B0, 1, 0); PG8_LDB(B1, 1, 1); PG8_SCHED; PG8_LDA(At, 1, 0); PG8_STAGE(PG8_SA(0, 1), a2 + hstep, voffA);
            PG8_WAIT_V(8); PG8_WAIT_L(0); PG8_BAR; PG8_MMA(0, 0, At, B0); PG8_MMA(0, 1, At, B1); PG8_BAR; PG8_SCHED;
            PG8_LDA(At, 1, 1); PG8_STAGE(PG8_SB(1, 0), b3, voffB); PG8_STAGE(PG8_SB(1, 1), b3 + hstep, voffB); PG8_STAGE(PG8_SA(1, 0), a3, voffA);
            PG8_WAIT_V(8); PG8_WAIT_L(0); PG8_BAR; PG8_MMA(1, 0, At, B0); PG8_MMA(1, 1, At, B1); PG8_BAR; PG8_SCHED;
            } else {
            PG8_LDB(B0, 0, 0); PG8_SCHED; PG8_LDA(At, 0, 0); PG8_STAGE(PG8_SA(1, 1), a1 + hstep, voffA);
            PG8_WAIT_L(8); PG8_BAR; PG8_WAIT_L(0); PG8_MMA(0, 0, At, B0); PG8_BAR; PG8_SCHED;
            PG8_LDB(B1, 0, 1); PG8_STAGE(PG8_SB(0, 0), b2, voffB);
            PG8_BAR; PG8_WAIT_L(0); PG8_MMA(0, 1, At, B1); PG8_BAR;
            PG8_LDA(At, 0, 1); PG8_STAGE(PG8_SA(0, 0), a2, voffA);
            PG8_BAR; PG8_WAIT_L(0); PG8_MMA(1, 0, At, B0); PG8_BAR; PG8_SCHED;
            PG8_STAGE(PG8_SB(0, 1), b2 + hstep, voffB);
            PG8_WAIT_V(6); PG8_BAR; PG8_MMA(1, 1, At, B1); PG8_BAR;
            PG8_LDB(B0, 1, 0); PG8_SCHED; PG8_LDA(At, 1, 0); PG8_STAGE(PG8_SA(0, 1), a2 + hstep, voffA);
            PG8_WAIT_L(8); PG8_BAR; PG8_WAIT_L(0); PG8_MMA(0, 0, At, B0); PG8_BAR; PG8_SCHED;
            PG8_LDB(B1, 1, 1); PG8_STAGE(PG8_SB(1, 0), b3, voffB);
            PG8_BAR; PG8_WAIT_L(0); PG8_MMA(0, 1, At, B1); PG8_BAR;
            PG8_LDA(At, 1, 1); PG8_STAGE(PG8_SA(1, 0), a3, voffA);
            PG8_BAR; PG8_WAIT_L(0); PG8_MMA(1, 0, At, B0); PG8_BAR; PG8_SCHED;
            PG8_STAGE(PG8_SB(1, 1), b3 + hstep, voffB);
            PG8_WAIT_V(6); PG8_BAR; PG8_MMA(1, 1, At, B1); PG8_BAR;
            }
        }
        if constexpr (ALIGN_EPI) { if (wr == 0) PG8_BAR; }
        if constexpr (!Epi::AFTER_DRAIN) { E(acc, cur, wr, wc, fr, fq); S.done(cur); }
        if (!has_next) break;
#pragma unroll
        for (int a = 0; a < 2; ++a)
#pragma unroll
            for (int b = 0; b < 2; ++b)
#pragma unroll
                for (int m = 0; m < 4; ++m)
#pragma unroll
                    for (int n = 0; n < 2; ++n) acc[a][b][m][n] = (f32x4){0.f, 0.f, 0.f, 0.f};
        cur = nxt; cA = nA; cB = nB; ++ui;
        if constexpr (ALIGN_EPI) { if (wr == 1) PG8_BAR; }
    }
    PG8_WAIT_V(0);
    if constexpr (!ALIGN_EPI) { if (wr == 0) PG8_BAR; }
    PG8_BAR;
    if constexpr (Epi::AFTER_DRAIN) { E.fused(acc, cur, wr, wc, fr, fq, lds, wid, lane); S.done(cur); }
#undef PG8_SA
#undef PG8_SB
#undef PG8_STAGE
#undef PG8_LDA
#undef PG8_LDB
#undef PG8_MMA
#undef PG8_WAIT_V
#undef PG8_WAIT_L
#undef PG8_BAR
#undef PG8_SCHED
}
}
namespace pg8 {
template <int ACT  > struct EpiRoute {
    static constexpr bool PERM = true, AFTER_DRAIN = false, NORM = false;
    bf16_t* O0; int ld0; bf16_t* O1; int ld1; int split;
    __device__ __forceinline__ void operator()(const f32x4 (&acc)[2][2][4][2], const Unit& u, int wr, int wc, int fr, int fq) const {
        const int row0 = u.pm * BM + wr * 64 + fr; const bool first = u.pn < split;
        bf16_t* base = first ? O0 : O1; const int ld = first ? ld0 : ld1; const int col0 = (first ? u.pn : u.pn - split) * BM + wc * 32 + 8 * fq;
#pragma unroll
        for (int ai = 0; ai < 2; ++ai)
#pragma unroll
            for (int m = 0; m < 4; ++m) { bf16_t* rowp = base + (size_t)(row0 + ai * HALF + m * 16) * ld + col0;
#pragma unroll
                for (int bj = 0; bj < 2; ++bj) { f32x4 v0 = acc[ai][bj][m][0], v1 = acc[ai][bj][m][1];
                    if (ACT == 1) {
#pragma unroll
                        for (int e = 0; e < 4; ++e) { const float a = fmaxf(v0[e], 0.f), b = fmaxf(v1[e], 0.f); v0[e] = a * a; v1[e] = b * b; } }
                    u32x4 w; w.x = cvt_pk_bf16(v0[0], v0[1]); w.y = cvt_pk_bf16(v0[2], v0[3]); w.z = cvt_pk_bf16(v1[0], v1[1]); w.w = cvt_pk_bf16(v1[2], v1[3]);
                    *(u32x4*)(rowp + bj * HALF) = w; } }
    }
};
struct EpiResid {
    static constexpr bool PERM = true, AFTER_DRAIN = false, NORM = false;
    const float* xsrc; float* xdst; const float* gate;
    __device__ __forceinline__ void operator()(const f32x4 (&acc)[2][2][4][2], const Unit& u, int wr, int wc, int fr, int fq) const {
        const int row0 = u.pm * BM + wr * 64 + fr, col0 = u.pn * BM + wc * 32 + 8 * fq, b = (u.pm * BM) >> 12;
        f32x4 gv[2][2];
#pragma unroll
        for (int bj = 0; bj < 2; ++bj)
#pragma unroll
            for (int n = 0; n < 2; ++n) gv[bj][n] = *(const f32x4*)(gate + (size_t)b * 6144 + col0 + bj * HALF + 4 * n);
#pragma unroll
        for (int ai = 0; ai < 2; ++ai)
#pragma unroll
            for (int m = 0; m < 4; ++m) { const size_t off = (size_t)(row0 + ai * HALF + m * 16) * 1024 + col0;
#pragma unroll
                for (int bj = 0; bj < 2; ++bj)
#pragma unroll
                    for (int n = 0; n < 2; ++n) { const f32x4 xs = *(const f32x4*)(xsrc + off + bj * HALF + 4 * n);
                        *(f32x4*)(xdst + off + bj * HALF + 4 * n) = xs + gv[bj][n] * acc[ai][bj][m][n]; }
                if (m & 1) asm volatile("" ::: "memory"); }
    }
};
constexpr int EPI_OFF = 133120;
template <int ACT  > struct EpiRouteN {
    static constexpr bool PERM = true, AFTER_DRAIN = false, NORM = true;
    bf16_t* O; int ld; const float* RSP; const float* shw; PG8_LAS unsigned char* lds;
    __device__ __forceinline__ void prefetch(const Unit& u, int tid, int wid) const {
        const char* src = (const char*)RSP + (size_t)u.pm * (BM * 64) + (size_t)tid * 16;
#pragma unroll
        for (int i = 0; i < 2; ++i) __builtin_amdgcn_global_load_lds((const unsigned*)(src + i * 8192), (PG8_LAS unsigned*)(lds + EPI_OFF + wid * 1024 + i * 8192), 16, 0, 0);
        if (wid == 0) { const char* s2 = (const char*)(shw + (size_t)((u.pm * BM) >> 12) * NSHW + u.pn * BM) + (size_t)(tid & 63) * 16;
            __builtin_amdgcn_global_load_lds((const unsigned*)s2, (PG8_LAS unsigned*)(lds + EPI_OFF + 16384), 16, 0, 0); }
    }
    __device__ __forceinline__ void reduce_rs(int tid) const {
        if (tid < 256) { const PG8_LAS f32x4* p = (const PG8_LAS f32x4*)(lds + EPI_OFF + tid * 64); const f32x4 a = p[0], b = p[1], c = p[2], d = p[3];
            const float s = (((a.x + a.y) + (a.z + a.w)) + ((b.x + b.y) + (b.z + b.w))) + (((c.x + c.y) + (c.z + c.w)) + ((d.x + d.y) + (d.z + d.w)));
            *(PG8_LAS float*)(lds + EPI_OFF + 17408 + tid * 4) = __builtin_amdgcn_rsqf(s * (1.0f / 1024.0f) + 1e-6f); }
    }
    __device__ __forceinline__ void operator()(const f32x4 (&acc)[2][2][4][2], const Unit& u, int wr, int wc, int fr, int fq) const {
        const int row0 = u.pm * BM + wr * 64 + fr, col0 = u.pn * BM + wc * 32 + 8 * fq;
        const PG8_LAS unsigned char* ep = lds + EPI_OFF;
        float rs[2][4];
#pragma unroll
        for (int ai = 0; ai < 2; ++ai)
#pragma unroll
            for (int m = 0; m < 4; ++m) rs[ai][m] = *(const PG8_LAS float*)(ep + 17408 + (wr * 64 + fr + ai * HALF + m * 16) * 4);
        f32x4 sv[2][2];
#pragma unroll
        for (int bj = 0; bj < 2; ++bj)
#pragma unroll
            for (int n = 0; n < 2; ++n) sv[bj][n] = *(const PG8_LAS f32x4*)(ep + 16384 + (bj * HALF + wc * 32 + 8 * fq + 4 * n) * 4);
#pragma unroll
        for (int ai = 0; ai < 2; ++ai)
#pragma unroll
            for (int m = 0; m < 4; ++m) { bf16_t* rowp = O + (size_t)(row0 + ai * HALF + m * 16) * ld + col0;
#pragma unroll
                for (int bj = 0; bj < 2; ++bj) { f32x4 v0 = acc[ai][bj][m][0] * rs[ai][m] + sv[bj][0], v1 = acc[ai][bj][m][1] * rs[ai][m] + sv[bj][1];
                    if (ACT == 1) {
#pragma unroll
                        for (int e = 0; e < 4; ++e) { const float a = fmaxf(v0[e], 0.f), b = fmaxf(v1[e], 0.f); v0[e] = a * a; v1[e] = b * b; } }
                    u32x4 w; w.x = cvt_pk_bf16(v0[0], v0[1]); w.y = cvt_pk_bf16(v0[2], v0[3]); w.z = cvt_pk_bf16(v1[0], v1[1]); w.w = cvt_pk_bf16(v1[2], v1[3]);
                    *(u32x4*)(rowp + bj * HALF) = w; } }
    }
};
template <bool MAYSKIP> struct EpiResidXS {
    static constexpr bool PERM = true, AFTER_DRAIN = false, NORM = false;
    const bf16_t* xsrc; bf16_t* xdst; const float* gate; const float* wp; bf16_t* XS; float* RSP; int doxs;
    template <bool DOXS> __device__ __forceinline__ void body(const f32x4 (&acc)[2][2][4][2], const Unit& u, int wr, int wc, int fr, int fq) const {
        const int row0 = u.pm * BM + wr * 64 + fr, col0 = u.pn * BM + wc * 32 + 8 * fq, b = (u.pm * BM) >> 12;
        f32x4 gv[2][2], wv[2][2]; float ssv[2][4];
#pragma unroll
        for (int bj = 0; bj < 2; ++bj)
#pragma unroll
            for (int n = 0; n < 2; ++n) { gv[bj][n] = *(const f32x4*)(gate + (size_t)b * 6144 + col0 + bj * HALF + 4 * n);
                if (DOXS) wv[bj][n] = *(const f32x4*)(wp + (size_t)b * 1024 + col0 + bj * HALF + 4 * n); }
#pragma unroll
        for (int aim = 0; aim < 4; ++aim) { const int ai = aim >> 1, m0_ = (aim & 1) * 2;
            u32x4 xr[4][2];
#pragma unroll
            for (int m = m0_; m < m0_ + 2; ++m)
#pragma unroll
                for (int bj = 0; bj < 2; ++bj) xr[m][bj] = *(const u32x4*)(xsrc + (size_t)(row0 + ai * HALF + m * 16) * 1024 + col0 + bj * HALF);
#pragma unroll
            for (int m = m0_; m < m0_ + 2; ++m) { const size_t off = (size_t)(row0 + ai * HALF + m * 16) * 1024 + col0; float ss = 0.f;
#pragma unroll
                for (int bj = 0; bj < 2; ++bj) { const u32x4 r = xr[m][bj];
                    const f32x4 x0 = (f32x4){bflo(r.x), bfhi(r.x), bflo(r.y), bfhi(r.y)}, x1 = (f32x4){bflo(r.z), bfhi(r.z), bflo(r.w), bfhi(r.w)};
                    const f32x4 y0 = x0 + gv[bj][0] * acc[ai][bj][m][0], y1 = x1 + gv[bj][1] * acc[ai][bj][m][1];
                    u32x4 w; w.x = cvt_pk_bf16(y0[0], y0[1]); w.y = cvt_pk_bf16(y0[2], y0[3]); w.z = cvt_pk_bf16(y1[0], y1[1]); w.w = cvt_pk_bf16(y1[2], y1[3]);
                    *(u32x4*)(xdst + off + bj * HALF) = w;
                    if (DOXS) { const f32x4 a = y0 * wv[bj][0], c = y1 * wv[bj][1];
                        u32x4 v; v.x = cvt_pk_bf16(a[0], a[1]); v.y = cvt_pk_bf16(a[2], a[3]); v.z = cvt_pk_bf16(c[0], c[1]); v.w = cvt_pk_bf16(c[2], c[3]);
                        *(u32x4*)(XS + off + bj * HALF) = v;
                        ss += ((y0.x * y0.x + y0.y * y0.y) + (y0.z * y0.z + y0.w * y0.w)) + ((y1.x * y1.x + y1.y * y1.y) + (y1.z * y1.z + y1.w * y1.w)); } }
                ssv[ai][m] = ss; }
            asm volatile("" ::: "memory"); }
        if (DOXS) { float t1[2][4];
#pragma unroll
            for (int ai = 0; ai < 2; ++ai)
#pragma unroll
                for (int m = 0; m < 4; ++m) t1[ai][m] = __shfl_xor(ssv[ai][m], 16);
#pragma unroll
            for (int ai = 0; ai < 2; ++ai)
#pragma unroll
                for (int m = 0; m < 4; ++m) { ssv[ai][m] += t1[ai][m]; t1[ai][m] = __shfl_xor(ssv[ai][m], 32); }
            if (fq == 0) {
#pragma unroll
                for (int ai = 0; ai < 2; ++ai)
#pragma unroll
                    for (int m = 0; m < 4; ++m) RSP[(size_t)(row0 + ai * HALF + m * 16) * 16 + u.pn * 4 + wc] = ssv[ai][m] + t1[ai][m]; } }
    }
    __device__ __forceinline__ void operator()(const f32x4 (&acc)[2][2][4][2], const Unit& u, int wr, int wc, int fr, int fq) const {
        if (!MAYSKIP || doxs) body<true>(acc, u, wr, wc, fr, fq); else body<false>(acc, u, wr, wc, fr, fq);
    }
};
}

#define RLX_AGENT __ATOMIC_RELAXED, __HIP_MEMORY_SCOPE_AGENT
#define XB_TMO      128
#define XB_XCNT(j)  (256  + 64 * (j))
#define XB_XSUB(j)  (1280 + 64 * (j))
#define XB_XGEN(j)  (2304 + 64 * (j))
#define XB_TOP      3328
#define XB_TOPGEN   3392
#define XCD_BAR_WORDS 3456
#define XB_SPIN_CAP (1u << 24)

__device__ __forceinline__ unsigned xb_ld(unsigned* p)              { return __hip_atomic_load(p, __ATOMIC_RELAXED, __HIP_MEMORY_SCOPE_AGENT); }
__device__ __forceinline__ unsigned xb_add(unsigned* p, unsigned v) { return __hip_atomic_fetch_add(p, v, __ATOMIC_RELAXED, __HIP_MEMORY_SCOPE_AGENT); }
__device__ __forceinline__ unsigned xb_xcc_id() { return (unsigned)__builtin_amdgcn_s_getreg((3 << 11) | 20) & 0xFu; }
#define XB_SPIN(cond, bar) do { unsigned _sp = 0; while (cond) { __builtin_amdgcn_s_sleep(1); \
    if ((++_sp & 255u) == 0u) { if (xb_ld(&(bar)[XB_TMO])) break; if (_sp > XB_SPIN_CAP) { atomicAdd(&(bar)[XB_TMO], 1u); break; } } } } while (0)

struct XcdBarrier {
    unsigned* bar; unsigned x;
    volatile LAS unsigned* st;
};

__device__ __forceinline__ XcdBarrier xcd_barrier_post(unsigned* bar, volatile LAS unsigned* st) {
    XcdBarrier b; b.bar = bar; b.x = xb_xcc_id(); b.st = st;
    if (threadIdx.x == 0) (void)xb_add(&bar[XB_XCNT(b.x)], 1u);
    return b;
}
__device__ __forceinline__ void xcd_barrier_complete(unsigned* bar, unsigned x, unsigned& nloc, unsigned& nx) {
    const unsigned G = gridDim.x * gridDim.y * gridDim.z;
    unsigned sum, cnt, mine, sp = 0u;
    for (;;) {
        sum = 0u; cnt = 0u; mine = 0u;
#pragma unroll
        for (unsigned j = 0; j < 16; ++j) { const unsigned c = xb_ld(&bar[XB_XCNT(j)]); sum += c; cnt += (c > 0u) ? 1u : 0u; mine = (j == x) ? c : mine; }
        if (sum == G) break;
        __builtin_amdgcn_s_sleep(1);
        if ((++sp & 255u) == 0u) { if (xb_ld(&bar[XB_TMO])) break; if (sp > XB_SPIN_CAP) { atomicAdd(&bar[XB_TMO], 1u); break; } }
    }
    nloc = mine > 0u ? mine : 1u; nx = cnt > 0u ? cnt : 1u;
}

__device__ __forceinline__ void xcd_barrier(const XcdBarrier& b) {
    asm volatile("s_waitcnt vmcnt(0)" ::: "memory");
    __syncthreads();
    if (threadIdx.x == 0) {
        unsigned* bar = b.bar;
        __builtin_amdgcn_s_waitcnt(0);
        unsigned nloc = b.st[0], nx = b.st[1];
        if (nloc == 0u) { xcd_barrier_complete(bar, b.x, nloc, nx); b.st[0] = nloc; b.st[1] = nx; }
        const unsigned old = xb_add(&bar[XB_XSUB(b.x)], 1u);
        const unsigned gen = old / nloc;
        if (old + 1u == (gen + 1u) * nloc) {
            __builtin_amdgcn_fence(__ATOMIC_RELEASE, "agent");
            asm volatile("s_waitcnt vmcnt(0)" ::: "memory");
            const unsigned og = xb_add(&bar[XB_TOP], 1u);
            const unsigned tg = og / nx;
            if (og + 1u == (tg + 1u) * nx) xb_add(&bar[XB_TOPGEN], 1u);
            else XB_SPIN(xb_ld(&bar[XB_TOPGEN]) == tg, bar);
            __builtin_amdgcn_fence(__ATOMIC_ACQUIRE, "agent");
            xb_add(&bar[XB_XGEN(b.x)], 1u);
            asm volatile("s_waitcnt vmcnt(0)" ::: "memory");
        } else {
            XB_SPIN(xb_ld(&bar[XB_XGEN(b.x)]) == gen, bar);
            __builtin_amdgcn_fence(__ATOMIC_ACQUIRE, "agent");
            asm volatile("s_waitcnt vmcnt(0)" ::: "memory");
        }
    }
    __syncthreads();
}

#ifndef PH_MASK
#define PH_MASK 0xFFFFF
#endif
#define EN(b) if constexpr ((PH_MASK >> (b)) & 1)
#ifndef DUP_MASK
#define DUP_MASK 0
#endif
#define DUP(b) if constexpr ((DUP_MASK >> (b)) & 1)
#define DBG_DIGEST_N 256
#define DBG_DIGEST_VAL(m, c) bf2f(((const bf16*)(wsp + WS_CAT))[(size_t)(m) * DM + 768 + (c)])
#ifndef DBG_PH_HI
#define DBG_PH_HI NPHASE
#endif
#ifndef MK_MULTI
#define MK_MULTI 0
#endif
constexpr int LDS_BYTES = 151552, MISC_OFF = 131072 + 320;
#ifndef DBG_LAYERS
#define DBG_LAYERS 4
#define DBG_L0 0
#endif
constexpr int NPHASE = 3 + 7 * DBG_LAYERS;
__global__ void __launch_bounds__(512, 2) hymba_fwd(Args a) {
    extern __shared__ __attribute__((aligned(16))) unsigned char lds[];
    Ctx F0;
    Ctx& F = F0;
    F.lds = (char*)lds; F.tid = threadIdx.x; F.lane = F.tid & 63; F.wave = __builtin_amdgcn_readfirstlane(F.tid >> 6); F.G = gridDim.x; F.bid = blockIdx.x;
    F.A = nullptr; F.ws = a.ws;
    if (F.tid < 29) ((unsigned long long*)(lds + PTR_OFF))[F.tid] = F.tid < 28 ? (unsigned long long)a.in[F.tid] : (unsigned long long)a.out;
    volatile LAS unsigned* MISC = (volatile LAS unsigned*)((LAS unsigned char*)lds + MISC_OFF);
    if (F.tid < 32) MISC[F.tid] = 0u;
    __syncthreads();
    unsigned* ctl = (unsigned*)(a.ws + WS_CTL);
    XcdBarrier bar; bar.bar = ctl + CW_BAR; bar.x = 0; bar.st = nullptr;
    if (!MK_MULTI) bar = xcd_barrier_post(ctl + CW_BAR, MISC + 8);
    const int lo = a.ph_lo, hi = a.ph_hi;
    int ph = 0;
#define PH_BEGIN if (lo <= ph && ph < hi) { Ctx F = F0; unsigned long long wsl_ = (unsigned long long)F0.ws; asm volatile("" : "+v"(F.tid), "+s"(F.bid), "+s"(F.G), "+s"(wsl_)); F.ws = (unsigned char*)(__attribute__((address_space(1))) unsigned char*)wsl_; F.lane = F.tid & 63; F.wave = __builtin_amdgcn_readfirstlane(F.tid >> 6); unsigned char* const wsp = F.ws; (void)wsp;
#define PH_END   if (!MK_MULTI && ph + 1 < hi) { XcdBarrier bb = bar; asm volatile("" : "+s"(bb.bar), "+s"(bb.x)); xcd_barrier(bb); } else __syncthreads(); } ++ph;
    PG8_LAS unsigned char* glds = (PG8_LAS unsigned char*)lds;
#define XN ((bf16*)(wsp + WS_XN))
#define PROJ ((bf16*)(wsp + WS_PROJ))
#define CAT ((bf16*)(wsp + WS_CAT))
#define HB ((bf16*)(wsp + WS_HB))
    PH_BEGIN EN(0) ph_prologue(F); DUP(0) { __syncthreads(); ph_prologue(F); } PH_END
    PH_BEGIN EN(1) { ph_shw(F); ph_xs0(F, PIN(F, I_X), PIN(F, I_N1W) + DBG_L0 * DM, (const float*)(wsp + WS_MOD) + (size_t)DBG_L0 * BATCH * NADA, DM, XN, (float*)(wsp + WS_RSP), (bf16*)POUT(F)); } PH_END
    for (int l_ = 0; l_ < DBG_LAYERS; ++l_) { const int l = l_ + DBG_L0;
        #define modl ((const float*)(wsp + WS_MOD) + (size_t)l * BATCH * NADA)
        #define xsrc (l_ == 0 ? PIN(F, I_X) : (const float*)POUT(F))
        PH_BEGIN
#if defined(PROBE_GA)
            { pg8::Gemm g{XN, (const bf16*)(wsp + WS_WIN) + (size_t)l * NPROJ * DM, MTOK, NPROJ, DM}; pg8::StaticOrder S; S.init(MTOK, NPROJ, F.G, F.bid);
            pg8::EpiRoute<0> E{PROJ, NPROJ, PROJ, NPROJ, 1 << 20};
            pg8::gemm_phase<pg8::EpiRoute<0>, pg8::StaticOrder, true, true>(glds, g, S, E, F.tid); } __syncthreads();
#elif defined(PROBE_GB)
            { pg8::Gemm g{XN, (const bf16*)(wsp + WS_WIN) + (size_t)l * NPROJ * DM, MTOK, NPROJ, DM}; pg8::StaticOrder S; S.init(MTOK, NPROJ, F.G, F.bid);
            pg8::EpiRouteN<0> E{PROJ, NPROJ, (const float*)(wsp + WS_RSP), (const float*)(wsp + WS_SHW) + (size_t)l * BATCH * NSHW, glds};
            pg8::gemm_phase<pg8::EpiRouteN<0>, pg8::StaticOrder, true, true>(glds, g, S, E, F.tid); } __syncthreads();
#endif
        EN(2) { pg8::Gemm g{XN, (const bf16*)(wsp + WS_WIN) + (size_t)l * NPROJ * DM, MTOK, NPROJ, DM}; pg8::StaticOrder S; S.init(MTOK, NPROJ, F.G, F.bid);
            pg8::EpiRouteN<0> E{PROJ, NPROJ, (const float*)(wsp + WS_RSP), (const float*)(wsp + WS_SHW) + (size_t)l * BATCH * NSHW, glds};
            pg8::gemm_phase<pg8::EpiRouteN<0>, pg8::StaticOrder, true, true>(glds, g, S, E, F.tid); } PH_END
        PH_BEGIN EN(3) ph_prep(F, l); DUP(3) ph_prep(F, l); EN(4) ph_lru1(F, l); DUP(4) ph_lru1(F, l); EN(5) ph_mlstm(F, l); DUP(5) ph_mlstm(F, l); PH_END
        PH_BEGIN EN(6) { ph_carry(F); pg8::Gemm g{(const bf16*)(wsp + WS_QL), (const bf16*)(wsp + WS_WQC) + (size_t)l * 768 * 256, MTOK, 768, 256}; pg8::StaticOrder S; S.init(MTOK, 768, F.G, F.bid);
            pg8::EpiRoute<0> E{(bf16*)(wsp + WS_QABS), 512, (bf16*)(wsp + WS_QIDX), 256, 2};
            pg8::gemm_phase<pg8::EpiRoute<0>, pg8::StaticOrder, true, true>(glds, g, S, E, F.tid); } PH_END
#ifndef DSA_REP
#define DSA_REP 1
#endif
        PH_BEGIN EN(7) { for (int rep_ = 0; rep_ < DSA_REP; ++rep_) { ph_dsa(F, l); if (DSA_REP > 1) __syncthreads(); } } DUP(7) ph_dsa(F, l); EN(8) ph_lru2(F, l); DUP(8) ph_lru2(F, l); EN(9) ph_mfin(F, l); DUP(9) ph_mfin(F, l); PH_END
        PH_BEGIN EN(10) { pg8::Gemm g{CAT, (const bf16*)(wsp + WS_WO) + (size_t)l * DM * DM, MTOK, DM, DM}; pg8::StaticOrder S; S.init(MTOK, DM, F.G, F.bid);
            pg8::EpiResidXS<false> E{(const pg8::bf16_t*)POUT(F), (pg8::bf16_t*)POUT(F), modl + 2 * DM, (const float*)(wsp + WS_WP) + (size_t)(l * 2 + 1) * BATCH * DM, XN, (float*)(wsp + WS_RSP), 1};
            pg8::gemm_phase<pg8::EpiResidXS<false>, pg8::StaticOrder, true, true>(glds, g, S, E, F.tid); } PH_END
        PH_BEGIN EN(12) { pg8::Gemm g{XN, (const bf16*)(wsp + WS_W1) + (size_t)l * DFF * DM, MTOK, DFF, DM}; pg8::StaticOrder S; S.init(MTOK, DFF, F.G, F.bid);
            pg8::EpiRouteN<1> E{HB, DFF, (const float*)(wsp + WS_RSP), (const float*)(wsp + WS_SHW) + (size_t)l * BATCH * NSHW + NPROJ, glds};
            pg8::gemm_phase<pg8::EpiRouteN<1>, pg8::StaticOrder, true, true>(glds, g, S, E, F.tid); } PH_END
        PH_BEGIN EN(13) { pg8::Gemm g{HB, (const bf16*)(wsp + WS_W2) + (size_t)l * DM * DFF, MTOK, DM, DFF}; pg8::StaticOrder S; S.init(MTOK, DM, F.G, F.bid);
            const int nl = l + 1 < DEPTH ? l + 1 : l;
            const bool lastl = l_ + 1 >= DBG_LAYERS;
            pg8::EpiResidXS<true> E{(const pg8::bf16_t*)POUT(F), lastl ? (pg8::bf16_t*)XN : (pg8::bf16_t*)POUT(F), modl + 5 * DM, (const float*)(wsp + WS_WP) + (size_t)(nl * 2) * BATCH * DM, XN, (float*)(wsp + WS_RSP), lastl ? 0 : 1};
            pg8::gemm_phase<pg8::EpiResidXS<true>, pg8::StaticOrder, true, true>(glds, g, S, E, F.tid); } PH_END
    }
#ifdef DBG_DIGEST
    PH_BEGIN { const int gw = F.bid * 8 + F.wave, NGW = F.G * 8; float* o = POUT(F);
        for (int m = gw; m < MTOK; m += NGW) for (int j = 0; j < 16; ++j) { const int c = F.lane + 64 * j; float v = 0.f;
            if (c < DBG_DIGEST_N) { v = DBG_DIGEST_VAL(m, c) * 4096.0f; v = v - floorf(v); }
            o[(size_t)m * DM + c] = v; } } PH_END
#else
    PH_BEGIN EN(14) ph_finalnorm16(F, XN, PIN(F, I_FNW), POUT(F)); PH_END
#endif
}

extern "C" void kernel_launch(void* const* d_in, const int* in_sizes, int n_in, void* d_out, int out_size, void* d_ws, size_t ws_size, hipStream_t stream) {
    static int grid = 0;
    if (grid == 0) {
        if (n_in != 28 || in_sizes[0] != MTOK * DM || out_size != MTOK * DM || ws_size < WS_END) { fprintf(stderr, "kernel_launch: unexpected shapes (n_in %d, in0 %d, out %d, ws %zu)\n", n_in, n_in > 0 ? in_sizes[0] : -1, out_size, ws_size); grid = -1; return; }
        int dev = 0, cus = 0, per_cu = 0;
        if (hipGetDevice(&dev) != hipSuccess || hipDeviceGetAttribute(&cus, hipDeviceAttributeMultiprocessorCount, dev) != hipSuccess) { grid = -1; return; }
        if (hipFuncSetAttribute((const void*)hymba_fwd, hipFuncAttributeMaxDynamicSharedMemorySize, LDS_BYTES) != hipSuccess) { fprintf(stderr, "kernel_launch: hipFuncSetAttribute failed\n"); grid = -1; return; }
        if (hipOccupancyMaxActiveBlocksPerMultiprocessor(&per_cu, (const void*)hymba_fwd, 512, LDS_BYTES) != hipSuccess || per_cu < 1) { fprintf(stderr, "kernel_launch: occupancy query says %d\n", per_cu); }
        (void)hipGetLastError();
        grid = cus;
    }
    if (grid < 0) return;
    if (hipMemsetAsync((char*)d_ws + WS_CTL, 0, CTL_ZERO_BYTES, stream) != hipSuccess) return;
    Args a{};
    for (int i = 0; i < 28; ++i) a.in[i] = (const float*)d_in[i];
    a.out = (float*)d_out; a.ws = (unsigned char*)d_ws;
#if MK_MULTI
    for (int p = 0; p < NPHASE; ++p) { a.ph_lo = p; a.ph_hi = p + 1; hipLaunchKernelGGL(hymba_fwd, dim3(grid), dim3(512), LDS_BYTES, stream, a); }
#else
    a.ph_lo = 0; a.ph_hi = DBG_PH_HI; hipLaunchKernelGGL(hymba_fwd, dim3(grid), dim3(512), LDS_BYTES, stream, a);
#endif
}
#endif
```

```cpp
#ifndef HOST_EMU
#include <hip/hip_runtime.h>
#include <cstdio>
#include <cstdint>
#define DEV __device__ __forceinline__
#define LAS __attribute__((address_space(3)))
#else
#include "emu.h"
#endif

#ifndef HOST_EMU
#define SYNC() __syncthreads()
#define KEEP4(a, b, c, d) asm volatile("" :: "v"(a), "v"(b), "v"(c), "v"(d))
#define NOPACK(x) asm("" : "+v"(x))
#define LAUNDER_V(x) asm volatile("" : "+v"(x))
#define WAVE_LDS_FENCE() asm volatile("s_waitcnt lgkmcnt(0)" ::: "memory")
template <class T> DEV T SHFL(T v, int s) { return __shfl(v, s); }
template <class T> DEV T SHFL_XOR(T v, int m) { return __shfl_xor(v, m); }
template <class T> DEV T SHFL_UP(T v, int d) { return __shfl_up(v, d); }
template <class T> DEV T SHFL_DOWN(T v, int d) { return __shfl_down(v, d); }
typedef short bf16x8_ __attribute__((ext_vector_type(8)));
typedef float f32x4_ __attribute__((ext_vector_type(4)));
typedef short v4i16_t __attribute__((ext_vector_type(4)));
DEV f32x4_ MFMA16(bf16x8_ a, bf16x8_ b, f32x4_ c) { return __builtin_amdgcn_mfma_f32_16x16x32_bf16(a, b, c, 0, 0, 0); }
DEV v4i16_t TR16(const void* p) { return __builtin_amdgcn_ds_read_tr16_b64_v4i16((LAS v4i16_t*)(p)); }
#endif


typedef unsigned short bf16;
typedef short bf16x8 __attribute__((ext_vector_type(8)));
typedef short s16x4 __attribute__((ext_vector_type(4)));
typedef float f32x4 __attribute__((ext_vector_type(4)));
typedef unsigned u32x4 __attribute__((ext_vector_type(4)));
typedef unsigned u32x2 __attribute__((ext_vector_type(2)));

constexpr int BATCH = 16, SEQ = 4096, DM = 1024, DEPTH = 4, MTOK = BATCH * SEQ;
constexpr int NPROJ = 3072, DFF = 4096, NADA = 6 * DM;
constexpr int PC_LX = 0, PC_LY = 256, PC_MQ = 512, PC_MK = 1024, PC_MV = 1536, PC_MO = 2048, PC_AQ = 2560, PC_AKV = 2816, PC_IK = 2944, PC_IW = 2976, PC_MI = 2984, PC_MF = 2988;
constexpr float NORM_EPS = 1e-6f;

constexpr size_t MiB = 1u << 20;
constexpr size_t WS_CTL = 0, CTL_ZERO_BYTES = 1 * MiB;
constexpr size_t WS_MOD = 1 * MiB;
constexpr size_t WS_WQC = 3 * MiB;
constexpr size_t WS_WG = 5 * MiB;
constexpr size_t WS_WUVT = 6 * MiB;
constexpr size_t WS_WIN = 8 * MiB;
constexpr size_t WS_WO = 32 * MiB;
constexpr size_t WS_W1 = 40 * MiB;
constexpr size_t WS_W2 = 72 * MiB;
constexpr size_t WS_XN = 104 * MiB;
constexpr size_t WS_QL = WS_XN, WS_CKV = WS_XN + 32 * MiB, WS_QIDX = WS_XN + 48 * MiB, WS_KIDX = WS_XN + 80 * MiB, WS_WI = WS_XN + 84 * MiB, WS_GT = WS_XN + 86 * MiB;
constexpr size_t WS_CAT = 232 * MiB;
constexpr size_t WS_PROJ = 360 * MiB;
constexpr size_t WS_HB = 360 * MiB;
constexpr size_t WS_QABS = 744 * MiB;
constexpr size_t WS_HLOC = 808 * MiB, WS_CPA = 840 * MiB;
constexpr size_t WS_LSUM = 872 * MiB;
constexpr size_t WS_HM = 874 * MiB;
constexpr size_t WS_MG = 940 * MiB;
constexpr size_t WS_WP = 2 * MiB + 512 * 1024;
constexpr size_t WS_SHW = 6 * MiB + 256 * 1024;
constexpr size_t WS_RSP = 1000 * MiB;
constexpr size_t WS_CARRY = 948 * MiB;
constexpr size_t WS_SCR2 = 949 * MiB;
constexpr int NSHW = NPROJ + DFF;
constexpr size_t WS_END = 1024 * MiB;
static_assert(WS_HM + (size_t)MTOK * 512 * 2 <= WS_END && WS_HB + (size_t)MTOK * DFF * 2 <= WS_HLOC + 64 * MiB, "ws map");

constexpr int CW_TMO = 0, CW_BAR = 4096;

#ifndef HOST_EMU
typedef __bf16 hwbf2_t __attribute__((ext_vector_type(2)));
typedef float hwf2_t __attribute__((ext_vector_type(2)));
DEV unsigned f2bf(float f) { return (unsigned)__builtin_bit_cast(unsigned short, (__bf16)f); }
DEV unsigned pk2(float lo, float hi) { const hwf2_t v = {lo, hi}; return __builtin_bit_cast(unsigned, __builtin_convertvector(v, hwbf2_t)); }
#else
DEV unsigned f2bf(float f) { unsigned u = __builtin_bit_cast(unsigned, f); return (u + 0x7fffu + ((u >> 16) & 1u)) >> 16; }
DEV unsigned pk2(float lo, float hi) { return f2bf(lo) | (f2bf(hi) << 16); }
#endif
DEV float bf2f(unsigned h) { return __builtin_bit_cast(float, h << 16); }
DEV float bflo(unsigned w) { return __builtin_bit_cast(float, w << 16); }
DEV float bfhi(unsigned w) { return __builtin_bit_cast(float, w & 0xffff0000u); }
DEV float wave_sum(float v) {
#pragma unroll
    for (int o = 1; o < 64; o <<= 1) v += SHFL_XOR(v, o);
    return v;
}
#ifndef HOST_EMU
DEV float FEXP(float x) { return __expf(x); }
DEV float FEXP2(float x) { return __builtin_amdgcn_exp2f(x); }
DEV float FRCP(float x) { return __builtin_amdgcn_rcpf(x); }
DEV float FSQRT(float x) { return __builtin_amdgcn_sqrtf(x); }
DEV float RSQ(float x) { return __builtin_amdgcn_rsqf(x); }
DEV float FLOG(float x) { return __logf(x); }
#else
DEV float FEXP(float x) { return expf(x); }
DEV float FEXP2(float x) { return exp2f(x); }
DEV float FRCP(float x) { return 1.0f / x; }
DEV float FSQRT(float x) { return sqrtf(x); }
DEV float RSQ(float x) { return 1.0f / sqrtf(x); }
DEV float FLOG(float x) { return logf(x); }
#endif
#ifndef HOST_EMU
DEV int UNI(int x) { return __builtin_amdgcn_readfirstlane(x); }
#else
DEV int UNI(int x) { return x; }
#endif
#ifndef HOST_EMU
#define GAS __attribute__((address_space(1)))
DEV const GAS char* UNIP(const void* p) { const unsigned long long v = (unsigned long long)p; const unsigned lo = __builtin_amdgcn_readfirstlane((unsigned)v), hi = __builtin_amdgcn_readfirstlane((unsigned)(v >> 32));
    return (const GAS char*)(((unsigned long long)hi << 32) | lo); }
#else
#define GAS
DEV const char* UNIP(const void* p) { return (const char*)p; }
#endif
DEV float RELU(float x) { const int b = __builtin_bit_cast(int, x); return __builtin_bit_cast(float, b > 0 ? b : 0); }
DEV float sigmoidf_(float z) { return 1.0f / (1.0f + expf(-z)); }
DEV float fsigmoid(float z) { return FRCP(1.0f + FEXP(-z)); }
DEV float one_minus_exp(float x) {
    const float s = -x * (1.0f + x * (0.5f + x * (0.16666667f + x * 0.041666668f)));
    return x > -0.05f ? s : 1.0f - FEXP(x);
}

struct Args { const float* in[28]; float* out; unsigned char* ws; int ph_lo, ph_hi; };
struct Ctx {
    char* lds; int tid, lane, wave, G, bid;
    const Args* A;
    unsigned char* ws;
};

constexpr int PTR_OFF = 131072 + 512;
#ifndef HOST_EMU
DEV const float* PIN(const Ctx& F, int i) { const unsigned long long v = ((const unsigned long long*)(F.lds + PTR_OFF))[i];
    const unsigned lo = __builtin_amdgcn_readfirstlane((unsigned)v), hi = __builtin_amdgcn_readfirstlane((unsigned)(v >> 32)); return (const float*)(const __attribute__((address_space(1))) float*)(((unsigned long long)hi << 32) | lo); }
DEV float* POUT(const Ctx& F) { return (float*)PIN(F, 28); }
#else
DEV const float* PIN(const Ctx& F, int i) { return F.A->in[i]; }
DEV float* POUT(const Ctx& F) { return POUT(F); }
#endif
enum { I_X = 0, I_C, I_WIN, I_CONVW, I_CONVB, I_WA, I_BA, I_WX, I_BX, I_LAM, I_BI, I_BF, I_WQUP, I_WQIDX, I_WUK, I_WUV, I_QNW, I_KVNW, I_RELB, I_GNW, I_WO, I_WADA, I_BADA, I_N1W, I_N2W, I_W1, I_W2, I_FNW };

DEV int win_srccol(int n) {
    if (n < 2560) return n;
    if (n < PC_AKV) return 2568 + (n - PC_AQ);
    if (n < PC_IK) return 2824 + (n - PC_AKV);
    if (n < PC_IW) return 2952 + (n - PC_IK);
    if (n < PC_MI) return 2984 + (n - PC_IW);
    if (n < PC_MF) return 2560 + (n - PC_MI);
    if (n < 2992) return 2564 + (n - PC_MF);
    return -1;
}
template <bool MAPPED>
DEV void p0_transpose_item(const float* W, int K, int N, int NT, bf16* WT, float* scr, int item, int lane) {
    const int nblk = NT / 32, kb = item / nblk, nb = item % nblk, k0 = 64 * kb, n0 = 32 * nb;
    int sc = n0 + (lane & 31); if (MAPPED) sc = win_srccol(sc);
#pragma unroll 8
    for (int i = 0; i < 32; ++i) { const int kk = 2 * i + (lane >> 5); const float v = W[(size_t)(k0 + kk) * N + (sc >= 0 ? sc : 0)]; scr[kk * 33 + (lane & 31)] = sc >= 0 ? v : 0.f; }
    WAVE_LDS_FENCE();
    const int c = lane & 7;
#pragma unroll
    for (int j = 0; j < 4; ++j) { const int n = (lane >> 3) + 8 * j; const float* s = scr + (8 * c) * 33 + n;
        u32x4 o; o.x = pk2(s[0 * 33], s[1 * 33]); o.y = pk2(s[2 * 33], s[3 * 33]); o.z = pk2(s[4 * 33], s[5 * 33]); o.w = pk2(s[6 * 33], s[7 * 33]);
        *(u32x4*)(WT + (size_t)(n0 + n) * K + k0 + 8 * c) = o; }
    WAVE_LDS_FENCE();
}

DEV void ph_prologue(const Ctx& F) {
    const int gt = F.bid * 512 + F.tid, NGT = F.G * 512;
    float* CACT = (float*)F.lds;
    for (int i = F.tid; i < BATCH * DM; i += 512) { const float cv = PIN(F, I_C)[i]; CACT[i] = cv * sigmoidf_(cv); }
    SYNC();
    for (int e = gt; e < DEPTH * NADA * 4; e += NGT) {
        const int j = e % NADA, bq = (e / NADA) & 3, l = e / (NADA * 4);
        const float* w = PIN(F, I_WADA) + (size_t)l * DM * NADA + j;
        const float* c = CACT + bq * 4 * DM;
        float a0 = 0.f, a1 = 0.f, a2 = 0.f, a3 = 0.f;
#pragma unroll 8
        for (int k = 0; k < DM; k += 4) {
            const float w0 = w[(size_t)k * NADA], w1 = w[(size_t)(k + 1) * NADA], w2 = w[(size_t)(k + 2) * NADA], w3 = w[(size_t)(k + 3) * NADA];
            const f32x4 c0 = *(const f32x4*)(c + k), c1 = *(const f32x4*)(c + DM + k), c2 = *(const f32x4*)(c + 2 * DM + k), c3 = *(const f32x4*)(c + 3 * DM + k);
            a0 += (c0.x * w0 + c0.y * w1) + (c0.z * w2 + c0.w * w3); a1 += (c1.x * w0 + c1.y * w1) + (c1.z * w2 + c1.w * w3);
            a2 += (c2.x * w0 + c2.y * w1) + (c2.z * w2 + c2.w * w3); a3 += (c3.x * w0 + c3.y * w1) + (c3.z * w2 + c3.w * w3); }
        const float bb = PIN(F, I_BADA)[(size_t)l * NADA + j];
        float* mo = (float*)(F.ws + WS_MOD) + ((size_t)l * BATCH + bq * 4) * NADA + j;
        mo[0] = a0 + bb; mo[NADA] = a1 + bb; mo[2 * NADA] = a2 + bb; mo[3 * NADA] = a3 + bb;
    }
    for (int e = gt; e < DEPTH * 2 * 4 * 64 * 64; e += NGT) {
        const int i = e & 63, j = (e >> 6) & 63, blk = (e >> 12) & 3, g = (e >> 14) & 1, l = e >> 15;
        const float* src = PIN(F, g ? I_WX : I_WA) + (((size_t)l * 4 + blk) * 64 + i) * 64 + j;
        ((bf16*)(F.ws + WS_WG))[e] = (bf16)f2bf(*src);
    }
    for (int e = gt; e < DEPTH * 4 * 64 * 128; e += NGT) {
        const int r = e & 127, d = (e >> 7) & 63, h = (e >> 13) & 3, l = e >> 15;
        ((bf16*)(F.ws + WS_WUVT))[e] = (bf16)f2bf(PIN(F, I_WUV)[(((size_t)l * 128 + r) * 4 + h) * 64 + d]);
    }
    for (int e = gt; e < DEPTH * 768 * 256; e += NGT) {
        const int r = e & 255, n = (e >> 8) % 768, l = e / (768 * 256);
        float v;
        if (n < 512) { const int h = n >> 7, c = n & 127; const f32x4* q = (const f32x4*)(PIN(F, I_WQUP) + ((size_t)l * 256 + r) * 256 + h * 64); const f32x4* k = (const f32x4*)(PIN(F, I_WUK) + ((size_t)l * 128 + c) * 256 + h * 64);
            float s = 0.f;
#pragma unroll
            for (int d = 0; d < 16; ++d) { const f32x4 a = q[d], bq4 = k[d]; s += (a.x * bq4.x + a.y * bq4.y) + (a.z * bq4.z + a.w * bq4.w); }
            v = s * (0.125f * 1.4426950408889634f); }
        else v = PIN(F, I_WQIDX)[((size_t)l * 256 + r) * 256 + (n - 512)] * 0.17677669529663687f;
        ((bf16*)(F.ws + WS_WQC))[e] = (bf16)f2bf(v);
    }
    SYNC();
    float* scr = (float*)(F.lds + F.wave * 16384);
    const int gw = F.bid * 8 + F.wave, NGW = F.G * 8;
    constexpr int I_IN = (DM / 64) * (NPROJ / 32), I_O = (DM / 64) * (DM / 32), I_1 = (DM / 64) * (DFF / 32), I_2 = (DFF / 64) * (DM / 32);
    constexpr int PER_L = I_IN + I_O + I_1 + I_2;
    for (int it = gw; it < DEPTH * PER_L; it += NGW) {
        const int l = it / PER_L; int r = it % PER_L;
        if (r < I_IN) { p0_transpose_item<true>(PIN(F, I_WIN) + (size_t)l * DM * 2992, DM, 2992, NPROJ, (bf16*)(F.ws + WS_WIN) + (size_t)l * NPROJ * DM, scr, r, F.lane); continue; } r -= I_IN;
        if (r < I_O) { p0_transpose_item<false>(PIN(F, I_WO) + (size_t)l * DM * DM, DM, DM, DM, (bf16*)(F.ws + WS_WO) + (size_t)l * DM * DM, scr, r, F.lane); continue; } r -= I_O;
        if (r < I_1) { p0_transpose_item<false>(PIN(F, I_W1) + (size_t)l * DM * DFF, DM, DFF, DFF, (bf16*)(F.ws + WS_W1) + (size_t)l * DFF * DM, scr, r, F.lane); continue; } r -= I_1;
        p0_transpose_item<false>(PIN(F, I_W2) + (size_t)l * DFF * DM, DFF, DM, DM, (bf16*)(F.ws + WS_W2) + (size_t)l * DM * DFF, scr, r, F.lane);
    }
}

DEV void ph_xs0(const Ctx& F, const float* xsrc, const float* nw, const float* modl, int sc_off, bf16* XS, float* RSP, bf16* X16) {
    const int gw = F.bid * 8 + F.wave, NGW = F.G * 8;
    f32x4 wv[4];
#pragma unroll
    for (int j = 0; j < 4; ++j) wv[j] = *(const f32x4*)(nw + 4 * F.lane + 256 * j);
    f32x4 v[2][4], vn[2][4];
#pragma unroll
    for (int q = 0; q < 2; ++q) { const int m = gw + q * NGW; const f32x4* xr = (const f32x4*)(xsrc + (size_t)(m < MTOK ? m : 0) * DM) + F.lane;
#pragma unroll
        for (int j = 0; j < 4; ++j) v[q][j] = xr[64 * j]; }
    for (int m0 = gw; m0 < MTOK; m0 += 2 * NGW) {
        f32x4 sc[2][4];
#pragma unroll
        for (int q = 0; q < 2; ++q) { const int m = m0 + q * NGW; const float* mb = modl + (size_t)((m < MTOK ? m : 0) >> 12) * NADA + 4 * F.lane;
#pragma unroll
            for (int j = 0; j < 4; ++j) sc[q][j] = *(const f32x4*)(mb + sc_off + 256 * j); }
#pragma unroll
        for (int q = 0; q < 2; ++q) { const int m = m0 + (2 + q) * NGW; const f32x4* xr = (const f32x4*)(xsrc + (size_t)(m < MTOK ? m : 0) * DM) + F.lane;
#pragma unroll
            for (int j = 0; j < 4; ++j) vn[q][j] = xr[64 * j]; }
        float s[2];
#pragma unroll
        for (int q = 0; q < 2; ++q) { float a = 0.f;
#pragma unroll
            for (int j = 0; j < 4; ++j) a += (v[q][j].x * v[q][j].x + v[q][j].y * v[q][j].y) + (v[q][j].z * v[q][j].z + v[q][j].w * v[q][j].w);
            s[q] = a; }
#pragma unroll
        for (int o = 1; o < 64; o <<= 1) { s[0] += SHFL_XOR(s[0], o); s[1] += SHFL_XOR(s[1], o); }
#pragma unroll
        for (int q = 0; q < 2; ++q) { const int m = m0 + q * NGW; if (m >= MTOK) break;
            if (F.lane < 16) RSP[(size_t)m * 16 + F.lane] = F.lane == 0 ? s[q] : 0.f;
            u32x2* o8 = (u32x2*)(XS + (size_t)m * DM) + F.lane; u32x2* x8 = (u32x2*)(X16 + (size_t)m * DM) + F.lane;
#pragma unroll
            for (int j = 0; j < 4; ++j) { const f32x4 y = v[q][j] * (wv[j] * (1.0f + sc[q][j]));
                u32x2 p; p.x = pk2(y.x, y.y); p.y = pk2(y.z, y.w); o8[64 * j] = p;
                u32x2 c; c.x = pk2(v[q][j].x, v[q][j].y); c.y = pk2(v[q][j].z, v[q][j].w); x8[64 * j] = c; } }
#pragma unroll
        for (int q = 0; q < 2; ++q)
#pragma unroll
            for (int j = 0; j < 4; ++j) v[q][j] = vn[q][j];
    }
}
DEV void ph_shw(const Ctx& F) {
    const int gt = F.bid * 512 + F.tid, NGT = F.G * 512;
    for (int e = gt; e < DEPTH * 2 * BATCH * (DM / 4); e += NGT) {
        const int c4 = e & 255, b = (e >> 8) & 15, w = (e >> 12) & 1, l = e >> 13;
        const f32x4 nwv = *(const f32x4*)(PIN(F, w ? I_N2W : I_N1W) + l * DM + 4 * c4);
        const f32x4 sc = *(const f32x4*)((const float*)(F.ws + WS_MOD) + ((size_t)l * BATCH + b) * NADA + (w ? 4 * DM : DM) + 4 * c4);
        ((f32x4*)(F.ws + WS_WP))[e] = nwv * (1.0f + sc);
    }
    const int gw = F.bid * 8 + F.wave, NGW = F.G * 8, i16 = F.lane & 15, kq = 8 * (F.lane >> 4);
    for (int it = gw; it < DEPTH * (NSHW / 16); it += NGW) {
        const int l = it / (NSHW / 16), n0 = (it % (NSHW / 16)) * 16;
        const bool mlp = n0 >= NPROJ;
        const bf16* Wr = mlp ? (const bf16*)(F.ws + WS_W1) + ((size_t)l * DFF + (n0 - NPROJ) + i16) * DM : (const bf16*)(F.ws + WS_WIN) + ((size_t)l * NPROJ + n0 + i16) * DM;
        const float* sh = (const float*)(F.ws + WS_MOD) + ((size_t)l * BATCH + i16) * NADA + (mlp ? 3 * DM : 0);
        f32x4 acc0 = {0.f, 0.f, 0.f, 0.f}, acc1 = {0.f, 0.f, 0.f, 0.f};
#pragma unroll 4
        for (int s = 0; s < DM / 32; ++s) {
            const bf16x8 B = *(const bf16x8*)(Wr + 32 * s + kq);
            const f32x4 a0 = *(const f32x4*)(sh + 32 * s + kq), a1 = *(const f32x4*)(sh + 32 * s + kq + 4);
            bf16x8 Ah, Al;
#pragma unroll
            for (int j = 0; j < 8; ++j) { const float a = j < 4 ? a0[j] : a1[j - 4]; const unsigned h = f2bf(a); Ah[j] = (short)h; Al[j] = (short)f2bf(a - bf2f(h)); }
            acc0 = MFMA16(Ah, B, acc0); acc1 = MFMA16(Al, B, acc1);
        }
        float* o = (float*)(F.ws + WS_SHW) + ((size_t)l * BATCH + 4 * (F.lane >> 4)) * NSHW + n0 + i16;
#pragma unroll
        for (int r = 0; r < 4; ++r) o[(size_t)r * NSHW] = acc0[r] + acc1[r];
    }
}
DEV void ph_normmod(const Ctx& F, const float* xsrc, const float* nw, const float* modl, int sh_off, int sc_off, bf16* XN) {
    const int gw = F.bid * 8 + F.wave, NGW = F.G * 8;
    f32x4 wv[4];
#pragma unroll
    for (int j = 0; j < 4; ++j) wv[j] = *(const f32x4*)(nw + 4 * F.lane + 256 * j);
    f32x4 v[2][4], vn[2][4];
#pragma unroll
    for (int q = 0; q < 2; ++q) { const int m = gw + q * NGW; const f32x4* xr = (const f32x4*)(xsrc + (size_t)(m < MTOK ? m : 0) * DM) + F.lane;
#pragma unroll
        for (int j = 0; j < 4; ++j) v[q][j] = xr[64 * j]; }
    for (int m0 = gw; m0 < MTOK; m0 += 2 * NGW) {
        f32x4 sc[2][4], sh[2][4];
#pragma unroll
        for (int q = 0; q < 2; ++q) { const int m = m0 + q * NGW; const float* mb = modl + (size_t)((m < MTOK ? m : 0) >> 12) * NADA + 4 * F.lane;
#pragma unroll
            for (int j = 0; j < 4; ++j) { sc[q][j] = *(const f32x4*)(mb + sc_off + 256 * j); sh[q][j] = *(const f32x4*)(mb + sh_off + 256 * j); } }
#pragma unroll
        for (int q = 0; q < 2; ++q) { const int m = m0 + (2 + q) * NGW; const f32x4* xr = (const f32x4*)(xsrc + (size_t)(m < MTOK ? m : 0) * DM) + F.lane;
#pragma unroll
            for (int j = 0; j < 4; ++j) vn[q][j] = xr[64 * j]; }
        float s[2];
#pragma unroll
        for (int q = 0; q < 2; ++q) { float a = 0.f;
#pragma unroll
            for (int j = 0; j < 4; ++j) a += (v[q][j].x * v[q][j].x + v[q][j].y * v[q][j].y) + (v[q][j].z * v[q][j].z + v[q][j].w * v[q][j].w);
            s[q] = a; }
#pragma unroll
        for (int o = 1; o < 64; o <<= 1) { s[0] += SHFL_XOR(s[0], o); s[1] += SHFL_XOR(s[1], o); }
#pragma unroll
        for (int q = 0; q < 2; ++q) { const int m = m0 + q * NGW; if (m >= MTOK) break;
            const float rs = RSQ(s[q] * (1.0f / DM) + NORM_EPS);
            u32x2* o8 = (u32x2*)(XN + (size_t)m * DM) + F.lane;
#pragma unroll
            for (int j = 0; j < 4; ++j) { const f32x4 y = v[q][j] * rs * wv[j] * (1.0f + sc[q][j]) + sh[q][j];
                u32x2 p; p.x = pk2(y.x, y.y); p.y = pk2(y.z, y.w); o8[64 * j] = p; } }
#pragma unroll
        for (int q = 0; q < 2; ++q)
#pragma unroll
            for (int j = 0; j < 4; ++j) v[q][j] = vn[q][j];
    }
}
DEV void ph_finalnorm(const Ctx& F, const float* xsrc, const float* nw, float* out) {
    const int gw = F.bid * 8 + F.wave, NGW = F.G * 8;
    f32x4 wv[4];
#pragma unroll
    for (int j = 0; j < 4; ++j) wv[j] = *(const f32x4*)(nw + 4 * F.lane + 256 * j);
    f32x4 v[2][4], vn[2][4];
#pragma unroll
    for (int q = 0; q < 2; ++q) { const int m = gw + q * NGW; const f32x4* xr = (const f32x4*)(xsrc + (size_t)(m < MTOK ? m : 0) * DM) + F.lane;
#pragma unroll
        for (int j = 0; j < 4; ++j) v[q][j] = xr[64 * j]; }
    for (int m0 = gw; m0 < MTOK; m0 += 2 * NGW) {
#pragma unroll
        for (int q = 0; q < 2; ++q) { const int m = m0 + (2 + q) * NGW; const f32x4* xr = (const f32x4*)(xsrc + (size_t)(m < MTOK ? m : 0) * DM) + F.lane;
#pragma unroll
            for (int j = 0; j < 4; ++j) vn[q][j] = xr[64 * j]; }
        float s[2];
#pragma unroll
        for (int q = 0; q < 2; ++q) { float a = 0.f;
#pragma unroll
            for (int j = 0; j < 4; ++j) a += (v[q][j].x * v[q][j].x + v[q][j].y * v[q][j].y) + (v[q][j].z * v[q][j].z + v[q][j].w * v[q][j].w);
            s[q] = a; }
#pragma unroll
        for (int o = 1; o < 64; o <<= 1) { s[0] += SHFL_XOR(s[0], o); s[1] += SHFL_XOR(s[1], o); }
#pragma unroll
        for (int q = 0; q < 2; ++q) { const int m = m0 + q * NGW; if (m >= MTOK) break;
            const float rs = RSQ(s[q] * (1.0f / DM) + NORM_EPS);
            f32x4* o = (f32x4*)(out + (size_t)m * DM) + F.lane;
#pragma unroll
            for (int j = 0; j < 4; ++j) o[64 * j] = v[q][j] * rs * wv[j]; }
#pragma unroll
        for (int q = 0; q < 2; ++q)
#pragma unroll
            for (int j = 0; j < 4; ++j) v[q][j] = vn[q][j];
    }
}
DEV void ph_finalnorm16(const Ctx& F, const bf16* x16, const float* nw, float* out) {
    const int gw = F.bid * 8 + F.wave, NGW = F.G * 8;
    f32x4 wv[2][2];
#pragma unroll
    for (int j = 0; j < 2; ++j) { wv[j][0] = *(const f32x4*)(nw + 8 * F.lane + 512 * j); wv[j][1] = *(const f32x4*)(nw + 8 * F.lane + 512 * j + 4); }
    u32x4 v[4][2], vn[4][2];
#pragma unroll
    for (int q = 0; q < 4; ++q) { const int m = gw + q * NGW; const bf16* xr = x16 + (size_t)(m < MTOK ? m : 0) * DM + 8 * F.lane;
        v[q][0] = *(const u32x4*)xr; v[q][1] = *(const u32x4*)(xr + 512); }
    for (int m0 = gw; m0 < MTOK; m0 += 4 * NGW) {
#pragma unroll
        for (int q = 0; q < 4; ++q) { const int m = m0 + (4 + q) * NGW; const bf16* xr = x16 + (size_t)(m < MTOK ? m : 0) * DM + 8 * F.lane;
            vn[q][0] = *(const u32x4*)xr; vn[q][1] = *(const u32x4*)(xr + 512); }
        float s[4];
#pragma unroll
        for (int q = 0; q < 4; ++q) { float a = 0.f;
#pragma unroll
            for (int j = 0; j < 2; ++j) { const u32x4 r = v[q][j];
                a += ((bflo(r.x) * bflo(r.x) + bfhi(r.x) * bfhi(r.x)) + (bflo(r.y) * bflo(r.y) + bfhi(r.y) * bfhi(r.y))) + ((bflo(r.z) * bflo(r.z) + bfhi(r.z) * bfhi(r.z)) + (bflo(r.w) * bflo(r.w) + bfhi(r.w) * bfhi(r.w))); }
            s[q] = a; }
#pragma unroll
        for (int o = 1; o < 64; o <<= 1) {
#pragma unroll
            for (int q = 0; q < 4; ++q) s[q] += SHFL_XOR(s[q], o); }
#pragma unroll
        for (int q = 0; q < 4; ++q) { const int m = m0 + q * NGW; if (m >= MTOK) break;
            const float rs = RSQ(s[q] * (1.0f / DM) + NORM_EPS);
            float* o = out + (size_t)m * DM + 8 * F.lane;
#pragma unroll
            for (int j = 0; j < 2; ++j) { const u32x4 r = v[q][j];
                *(f32x4*)(o + 512 * j) = (f32x4){bflo(r.x), bfhi(r.x), bflo(r.y), bfhi(r.y)} * rs * wv[j][0];
                *(f32x4*)(o + 512 * j + 4) = (f32x4){bflo(r.z), bfhi(r.z), bflo(r.w), bfhi(r.w)} * rs * wv[j][1]; } }
#pragma unroll
        for (int q = 0; q < 4; ++q) { v[q][0] = vn[q][0]; v[q][1] = vn[q][1]; }
    }
}
DEV void ph_zero_cat(const Ctx& F, int c0, int nq) {
    const int gw = F.bid * 8 + F.wave, NGW = F.G * 8;
    bf16* CAT = (bf16*)(F.ws + WS_CAT);
    for (int m = gw; m < MTOK; m += NGW) for (int q = 0; q < nq; ++q) *(u32x2*)(CAT + (size_t)m * DM + c0 + 256 * q + 4 * F.lane) = (u32x2){0u, 0u};
}
DEV float softcap15(float z) { return 15.0f * tanhf(z * (1.0f / 15.0f)); }
DEV float logsigmoidf_(float x) { return x >= 0.f ? -log1pf(expf(-x)) : x - log1pf(expf(x)); }
DEV void ph_prep(const Ctx& F, int l) {
    const int gw = F.bid * 8 + F.wave, NGW = F.G * 8, lane = F.lane;
    const bf16* PROJ = (const bf16*)(F.ws + WS_PROJ);
    bf16* QL = (bf16*)(F.ws + WS_QL); bf16* CKV = (bf16*)(F.ws + WS_CKV); bf16* KIDX = (bf16*)(F.ws + WS_KIDX);
    float* WI = (float*)(F.ws + WS_WI);
    const f32x4 qn = *(const f32x4*)(PIN(F, I_QNW) + l * 256 + 4 * lane);
    const float kn0 = PIN(F, I_KVNW)[l * 128 + 2 * lane], kn1 = PIN(F, I_KVNW)[l * 128 + 2 * lane + 1];
    u32x2 ra4[4], ran[4]; unsigned rk4[4], rx4[4], rkn[4], rxn[4];
#define PREP_LOAD(RA, RK, RX, M0) do { _Pragma("unroll") for (int q = 0; q < 4; ++q) { const int mm = (M0) + q * NGW; const bf16* pr = PROJ + (size_t)(mm < MTOK ? mm : 0) * NPROJ; \
            RA[q] = *(const u32x2*)(pr + PC_AQ + 4 * lane); RK[q] = *(const unsigned*)(pr + PC_AKV + 2 * lane); \
            RX[q] = lane < 16 ? *(const unsigned*)(pr + PC_IK + 2 * lane) : (lane < 24 ? (unsigned)pr[PC_IW + (lane - 16)] : 0u); } } while (0)
    PREP_LOAD(ra4, rk4, rx4, gw);
    for (int m0 = gw; m0 < MTOK; m0 += 4 * NGW) {
        PREP_LOAD(ran, rkn, rxn, m0 + 4 * NGW);
#pragma unroll
        for (int q = 0; q < 4; ++q) { const int m = m0 + q * NGW; if (m >= MTOK) break;
            const u32x2 ra = ra4[q]; const unsigned rk = rk4[q];
            const float a0 = bflo(ra.x), a1 = bfhi(ra.x), a2 = bflo(ra.y), a3 = bfhi(ra.y);
            const float k0 = bflo(rk), k1 = bfhi(rk);
            const float sq = wave_sum((a0 * a0 + a1 * a1) + (a2 * a2 + a3 * a3)), sk = wave_sum(k0 * k0 + k1 * k1);
            const float rq = RSQ(sq * (1.0f / 256.0f) + NORM_EPS), rk2 = RSQ(sk * (1.0f / 128.0f) + NORM_EPS);
            u32x2 oq; oq.x = pk2(a0 * rq * qn.x, a1 * rq * qn.y); oq.y = pk2(a2 * rq * qn.z, a3 * rq * qn.w);
            *(u32x2*)(QL + (size_t)m * 256 + 4 * lane) = oq;
            *(unsigned*)(CKV + (size_t)m * 128 + 2 * lane) = pk2(k0 * rk2 * kn0, k1 * rk2 * kn1);
            if (lane < 16) *(unsigned*)(KIDX + (size_t)m * 32 + 2 * lane) = rx4[q];
            else if (lane < 24) WI[(size_t)m * 8 + (lane - 16)] = bf2f(rx4[q]); }
#pragma unroll
        for (int q = 0; q < 4; ++q) { ra4[q] = ran[q]; rk4[q] = rkn[q]; rx4[q] = rxn[q]; }
    }
#undef PREP_LOAD
}

constexpr int XB_STRIDE = 264;
DEV void ph_lru1(const Ctx& F, int l) {
    const int tid = F.tid, lane = F.lane, w = F.wave, i16 = lane & 15, g = lane >> 4;
    bf16* XB = (bf16*)F.lds;
    float* XF = (float*)(F.lds + 64 * XB_STRIDE * 2);
    const bf16* PROJ = (const bf16*)(F.ws + WS_PROJ);
    bf16* HLOC = (bf16*)(F.ws + WS_HLOC); bf16* CPA = (bf16*)(F.ws + WS_CPA); float* LSUM = (float*)(F.ws + WS_LSUM);
    const int blk = w & 3, nh = w >> 2;
    const bf16* WG = (const bf16*)(F.ws + WS_WG) + (size_t)l * 2 * 4 * 4096;
    bf16x8 Bf[2][2][2];
#pragma unroll
    for (int gg = 0; gg < 2; ++gg)
#pragma unroll
        for (int nt = 0; nt < 2; ++nt)
#pragma unroll
            for (int ks = 0; ks < 2; ++ks) Bf[gg][nt][ks] = *(const bf16x8*)(WG + ((size_t)(gg * 4 + blk) * 64 + nh * 32 + 2 * i16 + nt) * 64 + ks * 32 + 8 * g);
    float ba[2], bx[2], sp[2];
#pragma unroll
    for (int nt = 0; nt < 2; ++nt) { const int ch = blk * 64 + nh * 32 + 2 * i16 + nt;
        ba[nt] = PIN(F, I_BA)[l * 256 + ch]; bx[nt] = PIN(F, I_BX)[l * 256 + ch];
        const float lam = PIN(F, I_LAM)[l * 256 + ch]; sp[nt] = lam > 0.f ? log1pf(expf(-lam)) : -lam + log1pf(expf(lam)); }
    const int ch2 = tid & 127, tg = tid >> 7;
    float cw[4][2], cb[2];
#pragma unroll
    for (int j = 0; j < 4; ++j) { cw[j][0] = PIN(F, I_CONVW)[(l * 4 + j) * 256 + 2 * ch2]; cw[j][1] = PIN(F, I_CONVW)[(l * 4 + j) * 256 + 2 * ch2 + 1]; }
    cb[0] = PIN(F, I_CONVB)[l * 256 + 2 * ch2]; cb[1] = PIN(F, I_CONVB)[l * 256 + 2 * ch2 + 1];

    for (int u = F.bid; u < BATCH * 64; u += F.G) {
        const int b = u >> 6, c = u & 63, t0 = c * 64; const size_t m0 = (size_t)b * SEQ + t0;
        {
            const int tl0 = tg * 16;
            unsigned rv[19];
#pragma unroll
            for (int j = 0; j < 3; ++j) { const int t = t0 + tl0 - 3 + j; rv[j] = t >= 0 ? *(const unsigned*)(PROJ + ((size_t)b * SEQ + t) * NPROJ + PC_LX + 2 * ch2) : 0u; }
#pragma unroll
            for (int tt = 0; tt < 16; ++tt) rv[3 + tt] = *(const unsigned*)(PROJ + (m0 + tl0 + tt) * NPROJ + PC_LX + 2 * ch2);
#pragma unroll
            for (int tt = 0; tt < 16; ++tt) { const int tl = tl0 + tt;
                const float x0 = cw[0][0] * bflo(rv[tt]) + cw[1][0] * bflo(rv[tt + 1]) + cw[2][0] * bflo(rv[tt + 2]) + cw[3][0] * bflo(rv[tt + 3]) + cb[0];
                const float x1 = cw[0][1] * bfhi(rv[tt]) + cw[1][1] * bfhi(rv[tt + 1]) + cw[2][1] * bfhi(rv[tt + 2]) + cw[3][1] * bfhi(rv[tt + 3]) + cb[1];
                *(unsigned*)(XB + tl * XB_STRIDE + 2 * ch2) = pk2(x0, x1);
                XF[tl * 256 + 2 * ch2] = x0; XF[tl * 256 + 2 * ch2 + 1] = x1; }
        }
        SYNC();
        float CA[2] = {1.f, 1.f}, CU[2] = {0.f, 0.f};
#pragma unroll 1
        for (int m = 0; m < 4; ++m) {
            f32x4 acc[2][2];
#pragma unroll
            for (int gg = 0; gg < 2; ++gg)
#pragma unroll
                for (int nt = 0; nt < 2; ++nt) acc[gg][nt] = (f32x4){0.f, 0.f, 0.f, 0.f};
#pragma unroll
            for (int ks = 0; ks < 2; ++ks) { const bf16x8 A = *(const bf16x8*)(XB + (m * 16 + i16) * XB_STRIDE + blk * 64 + ks * 32 + 8 * g);
#pragma unroll
                for (int gg = 0; gg < 2; ++gg)
#pragma unroll
                    for (int nt = 0; nt < 2; ++nt) acc[gg][nt] = MFMA16(A, Bf[gg][nt][ks], acc[gg][nt]); }
            float HL[2][4], CP[2][4];
            const int chb = blk * 64 + nh * 32 + 2 * i16;
            float xf[4][2];
#pragma unroll
            for (int r = 0; r < 4; ++r) { const float* xp = XF + (m * 16 + 4 * g + r) * 256 + chb; xf[r][0] = xp[0]; xf[r][1] = xp[1]; }
#pragma unroll
            for (int nt = 0; nt < 2; ++nt) {
                float P[4], H[4]; float pa = 1.f, hu = 0.f;
#pragma unroll
                for (int r = 0; r < 4; ++r) {
                    const float rg = fsigmoid(acc[0][nt][r] + ba[nt]), gi = fsigmoid(acc[1][nt][r] + bx[nt]);
                    const float la = -8.0f * rg * sp[nt], a = FEXP(la), uu = FSQRT((1.0f - a) * (1.0f + a)) * (gi * xf[r][nt]);
                    pa = a * pa; hu = a * hu + uu; P[r] = pa; H[r] = hu;
                    }
                float EA = 1.f, EU = 0.f, TA = 1.f, TU = 0.f;
#pragma unroll
                for (int gg = 0; gg < 4; ++gg) { const float ta = SHFL(pa, i16 + 16 * gg), tu = SHFL(hu, i16 + 16 * gg);
                    if (gg < g) { EU = ta * EU + tu; EA = ta * EA; }
                    TU = ta * TU + tu; TA = ta * TA; }
                const float XA = EA * CA[nt], XU = EA * CU[nt] + EU;
#pragma unroll
                for (int r = 0; r < 4; ++r) { HL[nt][r] = P[r] * XU + H[r]; CP[nt][r] = P[r] * XA; }
                CU[nt] = TA * CU[nt] + TU; CA[nt] = TA * CA[nt];
            }
#pragma unroll
            for (int r = 0; r < 4; ++r) { const size_t o = (m0 + m * 16 + 4 * g + r) * 256 + chb;
                *(unsigned*)(HLOC + o) = pk2(HL[0][r], HL[1][r]); *(unsigned*)(CPA + o) = pk2(CP[0][r], CP[1][r]); }
        }
        if (g == 0) {
#pragma unroll
            for (int nt = 0; nt < 2; ++nt) { const int ch = blk * 64 + nh * 32 + 2 * i16 + nt;
                LSUM[((size_t)b * 64 + c) * 256 + ch] = CA[nt]; LSUM[(size_t)BATCH * 64 * 256 + ((size_t)b * 64 + c) * 256 + ch] = CU[nt]; }
        }
        SYNC();
    }
}

DEV float gelu_tanh(float x) { const float z = 0.7978845608028654f * (x + 0.044715f * x * x * x); return x * FRCP(1.0f + FEXP(-2.0f * z)); }
DEV void ph_carry(const Ctx& F) {
    if (F.wave != 0) return;
    const float* LSUM = (const float*)(F.ws + WS_LSUM); float* CARRY = (float*)(F.ws + WS_CARRY);
    const int seg = F.lane & 3;
    for (int chain = F.bid * 16 + (F.lane >> 2); chain < BATCH * 256; chain += F.G * 16) {
        const int b = chain >> 8, ch = chain & 255; const size_t o0 = ((size_t)b * 64 + seg * 16) * 256 + ch;
        float a[16], hb[16];
#pragma unroll
        for (int i = 0; i < 16; ++i) { a[i] = LSUM[o0 + (size_t)i * 256]; hb[i] = LSUM[(size_t)BATCH * 64 * 256 + o0 + (size_t)i * 256]; }
        float hp[16], ap[16], hl = 0.f, al = 1.f;
#pragma unroll
        for (int i = 0; i < 16; ++i) { hp[i] = hl; ap[i] = al; hl = a[i] * hl + hb[i]; al = a[i] * al; }
        float cin = 0.f;
#pragma unroll
        for (int s2 = 0; s2 < 3; ++s2) { const float as = SHFL(al, (F.lane & ~3) + s2), hs = SHFL(hl, (F.lane & ~3) + s2); if (s2 < seg) cin = as * cin + hs; }
#pragma unroll
        for (int i = 0; i < 16; ++i) CARRY[o0 + (size_t)i * 256] = ap[i] * cin + hp[i];
    }
}
DEV void ph_lru2(const Ctx& F, int l) {
    const int tid = F.tid, lane = F.lane, w = F.wave;
    const bf16* PROJ = (const bf16*)(F.ws + WS_PROJ); const bf16* HLOC = (const bf16*)(F.ws + WS_HLOC); const bf16* CPA = (const bf16*)(F.ws + WS_CPA);
    const float* CARRY = (const float*)(F.ws + WS_CARRY); bf16* CAT = (bf16*)(F.ws + WS_CAT);
    const f32x4 gw4 = *(const f32x4*)(PIN(F, I_GNW) + l * DM + 4 * lane);
    for (int u = F.bid; u < BATCH * 64; u += F.G) {
        const int b = u >> 6, c = u & 63; const size_t m0 = (size_t)b * SEQ + c * 64;
        const f32x4 car = *(const f32x4*)(CARRY + (size_t)u * 256 + 4 * lane);
        u32x2 hl8[8], cp8[8], ly8[8];
#pragma unroll
        for (int tt = 0; tt < 8; ++tt) { const size_t m = m0 + w * 8 + tt;
            hl8[tt] = *(const u32x2*)(HLOC + m * 256 + 4 * lane); cp8[tt] = *(const u32x2*)(CPA + m * 256 + 4 * lane); ly8[tt] = *(const u32x2*)(PROJ + m * NPROJ + PC_LY + 4 * lane); }
#pragma unroll
        for (int tt = 0; tt < 8; ++tt) { const size_t m = m0 + w * 8 + tt; const u32x2 hl = hl8[tt], cp = cp8[tt], ly = ly8[tt];
            float v0 = (bflo(hl.x) + bflo(cp.x) * car.x) * gelu_tanh(bflo(ly.x));
            float v1 = (bfhi(hl.x) + bfhi(cp.x) * car.y) * gelu_tanh(bfhi(ly.x));
            float v2 = (bflo(hl.y) + bflo(cp.y) * car.z) * gelu_tanh(bflo(ly.y));
            float v3 = (bfhi(hl.y) + bfhi(cp.y) * car.w) * gelu_tanh(bfhi(ly.y));
            const float rs = RSQ(wave_sum((v0 * v0 + v1 * v1) + (v2 * v2 + v3 * v3)) * (1.0f / 256.0f) + NORM_EPS);
            u32x2 o; o.x = pk2(v0 * rs * gw4.x, v1 * rs * gw4.y); o.y = pk2(v2 * rs * gw4.z, v3 * rs * gw4.w);
            *(u32x2*)(CAT + m * DM + 4 * lane) = o; }
    }
}

constexpr int QS_STRIDE = 136, VE_STRIDE = 56;
DEV void ph_mlstm(const Ctx& F, int l) {
    const int tid = F.tid, lane = F.lane, w = F.wave, i16 = lane & 15, g = lane >> 4;
    bf16* QsB = (bf16*)F.lds;
    bf16* KsB = QsB + 2 * 64 * QS_STRIDE;
    bf16* VE = KsB + 2 * 64 * QS_STRIDE;
    bf16* VW = VE + 64 * VE_STRIDE;
    bf16* CsB = VW + 64 * VE_STRIDE;
    float* BCB = (float*)(CsB + 2 * 128 * VE_STRIDE);
    float* BIB = BCB + 128;
    const bf16* PROJ = (const bf16*)(F.ws + WS_PROJ); bf16* HM = (bf16*)(F.ws + WS_HM);
    const float qscale = 0.08838834764831845f;
    const int half = w >> 2, jt = half ? 3 - (w & 3) : (w & 3);
    for (int u0 = F.bid; u0 < BATCH * 4 * 4; u0 += F.G) {
        const int u = 4 * ((u0 & 7) * 8 + ((u0 >> 3) >> 2)) + ((u0 >> 3) & 3);
        const int b = u >> 4, h = (u >> 2) & 3, vs = u & 3;
        const float gbi = PIN(F, I_BI)[l * 4 + h], gbf = PIN(F, I_BF)[l * 4 + h];
        f32x4 accC[3];
#pragma unroll
        for (int nt = 0; nt < 3; ++nt) accC[nt] = (f32x4){0.f, 0.f, 0.f, 0.f};
        float* BCg = (float*)(F.ws + WS_MG) + (size_t)u * 8192; float* BIg = BCg + 4096;
        unsigned gri[8], grf[8];
#pragma unroll
        for (int k = 0; k < 8; ++k) { const bf16* pr = PROJ + ((size_t)b * SEQ + (8 * k + w) * 64 + lane) * NPROJ; gri[k] = pr[PC_MI + h]; grf[k] = pr[PC_MF + h]; }
#pragma unroll
        for (int k = 0; k < 8; ++k) { const int tok = (8 * k + w) * 64 + lane;
            const float zi = (bf2f(gri[k]) + gbi) * (1.0f / 15.0f), zf = (bf2f(grf[k]) + gbf) * (1.0f / 15.0f);
            const float ig = 15.0f - 30.0f * FRCP(FEXP(2.0f * zi) + 1.0f), fg = 15.0f - 30.0f * FRCP(FEXP(2.0f * zf) + 1.0f);
            float s = -FLOG(1.0f + FEXP(-fg));
#pragma unroll
            for (int o = 1; o < 64; o <<= 1) { const float t = SHFL_UP(s, o); if (lane >= o) s += t; }
            BCg[tok] = s; BIg[tok] = s - ig; }
        SYNC();
        u32x4 rq[2], rk[2]; u32x2 rvv; float rgc = 0.f, rgb = 0.f;
        {
            const size_t m0 = (size_t)b * SEQ;
#pragma unroll
            for (int i = 0; i < 2; ++i) { const int idx = tid + 512 * i, row = idx >> 4, ck = idx & 15;
                rq[i] = *(const u32x4*)(PROJ + (m0 + row) * NPROJ + PC_MQ + h * 128 + 8 * ck); rk[i] = *(const u32x4*)(PROJ + (m0 + row) * NPROJ + PC_MK + h * 128 + 8 * ck); }
            rvv = *(const u32x2*)(PROJ + (m0 + (tid >> 3)) * NPROJ + PC_MV + h * 128 + vs * 32 + 4 * (tid & 7));
            if (tid < 64) { rgc = BCg[tid]; rgb = BIg[tid]; }
        }
        for (int c = 0; c < 64; ++c) {
            const size_t m0 = (size_t)b * SEQ + c * 64; const int buf = c & 1;
            bf16* Qs = QsB + buf * 64 * QS_STRIDE; bf16* Ks = KsB + buf * 64 * QS_STRIDE; const bf16* Cs = CsB + buf * 128 * VE_STRIDE; bf16* Cn = CsB + (buf ^ 1) * 128 * VE_STRIDE;
            float* BC = BCB + buf * 64; float* BI = BIB + buf * 64;
#pragma unroll
            for (int i = 0; i < 2; ++i) { const int idx = tid + 512 * i, row = idx >> 4, ck = idx & 15;
                *(u32x4*)(Qs + row * QS_STRIDE + 8 * ck) = rq[i]; *(u32x4*)(Ks + row * QS_STRIDE + 8 * ck) = rk[i]; }
            if (tid < 64) { BC[tid] = rgc; BI[tid] = rgb; }
            SYNC();
            {
                const int row = tid >> 3, cg = tid & 7;
                const u32x2 rv = rvv;
                const float wt = FEXP(BC[63] - BI[row]);
                *(u32x2*)(VE + row * VE_STRIDE + 4 * cg) = rv;
                u32x2 sv; sv.x = pk2(bflo(rv.x) * wt, bfhi(rv.x) * wt); sv.y = pk2(bflo(rv.y) * wt, bfhi(rv.y) * wt);
                *(u32x2*)(VW + row * VE_STRIDE + 4 * cg) = sv;
                if (cg == 0) { unsigned one_ = 0x3f80u; LAUNDER_V(one_); u32x4 z = (u32x4){one_, 0u, 0u, 0u}; *(u32x4*)(VE + row * VE_STRIDE + 32) = z; *(u32x4*)(VE + row * VE_STRIDE + 40) = (u32x4){0u, 0u, 0u, 0u};
                    z.x = f2bf(wt); *(u32x4*)(VW + row * VE_STRIDE + 32) = z; *(u32x4*)(VW + row * VE_STRIDE + 40) = (u32x4){0u, 0u, 0u, 0u}; }
            }
            if (c + 1 < 64) {
                const size_t m1 = m0 + 64;
#pragma unroll
                for (int i = 0; i < 2; ++i) { const int idx = tid + 512 * i, row = idx >> 4, ck = idx & 15;
                    rq[i] = *(const u32x4*)(PROJ + (m1 + row) * NPROJ + PC_MQ + h * 128 + 8 * ck); rk[i] = *(const u32x4*)(PROJ + (m1 + row) * NPROJ + PC_MK + h * 128 + 8 * ck); }
                rvv = *(const u32x2*)(PROJ + (m1 + (tid >> 3)) * NPROJ + PC_MV + h * 128 + vs * 32 + 4 * (tid & 7));
                if (tid < 64) { rgc = BCg[(c + 1) * 64 + tid]; rgb = BIg[(c + 1) * 64 + tid]; }
            }
            SYNC();
            f32x4 Z[2] = {(f32x4){0.f, 0.f, 0.f, 0.f}, (f32x4){0.f, 0.f, 0.f, 0.f}};
            {
                bf16x8 Bq[4];
#pragma unroll
                for (int ks = 0; ks < 4; ++ks) Bq[ks] = *(const bf16x8*)(Qs + (16 * jt + i16) * QS_STRIDE + 32 * ks + 8 * g);
                const float bj = BC[16 * jt + i16];
                unsigned pk[4][2];
#pragma unroll
                for (int tt = 0; tt < 4; ++tt) {
                    if (tt <= jt) {
                        f32x4 X = (f32x4){0.f, 0.f, 0.f, 0.f};
                        bf16x8 Ak[4];
#pragma unroll
                        for (int ks = 0; ks < 4; ++ks) Ak[ks] = *(const bf16x8*)(Ks + (16 * tt + i16) * QS_STRIDE + 32 * ks + 8 * g);
                        KEEP4(Ak[0], Ak[1], Ak[2], Ak[3]);
#pragma unroll
                        for (int ks = 0; ks < 4; ++ks) X = MFMA16(Ak[ks], Bq[ks], X);
                        float p[4]; const f32x4 bi4 = *(const f32x4*)(BI + 16 * tt + 4 * g);
#pragma unroll
                        for (int r = 0; r < 4; ++r) { const float pv = X[r] * qscale * FEXP(fminf(bj - bi4[r], 60.0f));
                            p[r] = (tt < jt || 4 * g + r <= i16) ? pv : 0.f; }
                        pk[tt][0] = pk2(p[0], p[1]); pk[tt][1] = pk2(p[2], p[3]);
                    } else { pk[tt][0] = 0u; pk[tt][1] = 0u; }
                }
#pragma unroll
                for (int pr = 0; pr < 2; ++pr) {
                    if (2 * pr <= jt) {
                        u32x4 aw = (u32x4){pk[2 * pr][0], pk[2 * pr][1], pk[2 * pr + 1][0], pk[2 * pr + 1][1]};
                        const bf16x8 A = __builtin_bit_cast(bf16x8, aw);
#pragma unroll
                        for (int n = 0; n < 2; ++n) { const int ntc = n ? 2 : half;
                            const s16x4 lo = TR16(VE + (32 * pr + 4 * g + (i16 >> 2)) * VE_STRIDE + 16 * ntc + 4 * (i16 & 3));
                            const s16x4 hi = TR16(VE + (32 * pr + 16 + 4 * g + (i16 >> 2)) * VE_STRIDE + 16 * ntc + 4 * (i16 & 3));
                            const bf16x8 B = (bf16x8){lo[0], lo[1], lo[2], lo[3], hi[0], hi[1], hi[2], hi[3]};
                            Z[n] = MFMA16(A, B, Z[n]); }
#ifndef HOST_EMU
                        asm volatile("" :: "v"(aw));
#endif
                    }
                }
            }
            if (c > 0) {
                f32x4 Z2[2] = {(f32x4){0.f, 0.f, 0.f, 0.f}, (f32x4){0.f, 0.f, 0.f, 0.f}};
#pragma unroll
                for (int kh = 0; kh < 2; ++kh) {
                    bf16x8 Aq[2], Bc[2][2];
#pragma unroll
                    for (int k2 = 0; k2 < 2; ++k2) { const int ks = 2 * kh + k2; Aq[k2] = *(const bf16x8*)(Qs + (16 * jt + i16) * QS_STRIDE + 32 * ks + 8 * g);
#pragma unroll
                        for (int n = 0; n < 2; ++n) { const int ntc = n ? 2 : half;
                            const s16x4 lo = TR16(Cs + (32 * ks + 8 * g + (i16 >> 2)) * VE_STRIDE + 16 * ntc + 4 * (i16 & 3));
                            const s16x4 hi = TR16(Cs + (32 * ks + 8 * g + 4 + (i16 >> 2)) * VE_STRIDE + 16 * ntc + 4 * (i16 & 3));
                            Bc[k2][n] = (bf16x8){lo[0], lo[1], lo[2], lo[3], hi[0], hi[1], hi[2], hi[3]}; } }
                    KEEP4(Bc[0][0], Bc[0][1], Bc[1][0], Bc[1][1]);
#pragma unroll
                    for (int k2 = 0; k2 < 2; ++k2)
#pragma unroll
                        for (int n = 0; n < 2; ++n) Z2[n] = MFMA16(Aq[k2], Bc[k2][n], Z2[n]); }
                const f32x4 bc4 = *(const f32x4*)(BC + 16 * jt + 4 * g);
#pragma unroll
                for (int r = 0; r < 4; ++r) { const float f = qscale * FEXP(bc4[r]); Z[0][r] += f * Z2[0][r]; Z[1][r] += f * Z2[1][r]; }
            }
#pragma unroll
            for (int r = 0; r < 4; ++r) { const int j = 16 * jt + 4 * g + r; const float dn = FRCP(fmaxf(fabsf(SHFL(Z[1][r], lane & 48)), 1.0f));
                HM[(m0 + j) * 512 + h * 128 + vs * 32 + 16 * half + i16] = (bf16)f2bf(Z[0][r] * dn); }
            {
                const float dec = FEXP(BC[63]);
#pragma unroll
                for (int nt = 0; nt < 3; ++nt) accC[nt] = accC[nt] * dec;
#pragma unroll
                for (int ks = 0; ks < 2; ++ks) {
                    const s16x4 alo = TR16(Ks + (32 * ks + 8 * g + (i16 >> 2)) * QS_STRIDE + 16 * w + 4 * (i16 & 3));
                    const s16x4 ahi = TR16(Ks + (32 * ks + 8 * g + 4 + (i16 >> 2)) * QS_STRIDE + 16 * w + 4 * (i16 & 3));
                    const bf16x8 A = (bf16x8){alo[0], alo[1], alo[2], alo[3], ahi[0], ahi[1], ahi[2], ahi[3]};
                    bf16x8 Bv[3];
#pragma unroll
                    for (int nt = 0; nt < 3; ++nt) {
                        const s16x4 lo = TR16(VW + (32 * ks + 8 * g + (i16 >> 2)) * VE_STRIDE + 16 * nt + 4 * (i16 & 3));
                        const s16x4 hi = TR16(VW + (32 * ks + 8 * g + 4 + (i16 >> 2)) * VE_STRIDE + 16 * nt + 4 * (i16 & 3));
                        Bv[nt] = (bf16x8){lo[0], lo[1], lo[2], lo[3], hi[0], hi[1], hi[2], hi[3]}; }
                    KEEP4(A, Bv[0], Bv[1], Bv[2]);
#pragma unroll
                    for (int nt = 0; nt < 3; ++nt) { const bf16x8 B = Bv[nt];
                        const f32x4 cold = accC[nt]; accC[nt] = MFMA16(A, B, cold);
#ifndef HOST_EMU
                        asm volatile("" :: "v"(cold), "v"(A), "v"(B));
#endif
                    }
                }
#pragma unroll
                for (int nt = 0; nt < 3; ++nt)
#pragma unroll
                    for (int r = 0; r < 4; ++r) Cn[(16 * w + 4 * g + r) * VE_STRIDE + 16 * nt + i16] = (bf16)f2bf(accC[nt][r]);
            }
        }
        SYNC();
    }
}

DEV void ph_mfin(const Ctx& F, int l) {
    const int gw = F.bid * 8 + F.wave, NGW = F.G * 8, lane = F.lane;
    const bf16* PROJ = (const bf16*)(F.ws + WS_PROJ); const bf16* HM = (const bf16*)(F.ws + WS_HM); bf16* CAT = (bf16*)(F.ws + WS_CAT);
    float gm[8];
#pragma unroll
    for (int j = 0; j < 8; ++j) gm[j] = PIN(F, I_GNW)[l * DM + 256 + 8 * lane + j];
    u32x4 hv4[4], ov4[4], hvn[4], ovn[4];
#define MFIN_LOAD(HV, OV, M0) do { _Pragma("unroll") for (int q = 0; q < 4; ++q) { const int mm = (M0) + q * NGW; const size_t ms = (size_t)(mm < MTOK ? mm : 0); \
            HV[q] = *(const u32x4*)(HM + ms * 512 + 8 * lane); OV[q] = *(const u32x4*)(PROJ + ms * NPROJ + PC_MO + 8 * lane); } } while (0)
    MFIN_LOAD(hv4, ov4, gw);
    for (int m0 = gw; m0 < MTOK; m0 += 4 * NGW) {
        MFIN_LOAD(hvn, ovn, m0 + 4 * NGW);
#pragma unroll
        for (int q = 0; q < 4; ++q) { const int m = m0 + q * NGW; if (m >= MTOK) break;
            const u32x4 hv = hv4[q], ov = ov4[q];
            float v[8] = {bflo(hv.x), bfhi(hv.x), bflo(hv.y), bfhi(hv.y), bflo(hv.z), bfhi(hv.z), bflo(hv.w), bfhi(hv.w)};
            const float o[8] = {bflo(ov.x), bfhi(ov.x), bflo(ov.y), bfhi(ov.y), bflo(ov.z), bfhi(ov.z), bflo(ov.w), bfhi(ov.w)};
            float s = 0.f;
#pragma unroll
            for (int j = 0; j < 8; ++j) s += v[j] * v[j];
            s += SHFL_XOR(s, 1); s += SHFL_XOR(s, 2); s += SHFL_XOR(s, 4); s += SHFL_XOR(s, 8);
            const float rs = RSQ(s * (1.0f / 128.0f) + NORM_EPS);
            u32x4 r;
            r.x = pk2(v[0] * rs * gm[0] * fsigmoid(o[0]), v[1] * rs * gm[1] * fsigmoid(o[1]));
            r.y = pk2(v[2] * rs * gm[2] * fsigmoid(o[2]), v[3] * rs * gm[3] * fsigmoid(o[3]));
            r.z = pk2(v[4] * rs * gm[4] * fsigmoid(o[4]), v[5] * rs * gm[5] * fsigmoid(o[5]));
            r.w = pk2(v[6] * rs * gm[6] * fsigmoid(o[6]), v[7] * rs * gm[7] * fsigmoid(o[7]));
            *(u32x4*)(CAT + (size_t)m * DM + 256 + 8 * lane) = r; }
#pragma unroll
        for (int q = 0; q < 4; ++q) { hv4[q] = hvn[q]; ov4[q] = ovn[q]; }
    }
#undef MFIN_LOAD
}

constexpr int DS_HIST = 0;
constexpr int DS_MASK = 49152;
constexpr int DS_CAND = 65536;
constexpr int DS_SELL = 102400;
constexpr int DS_META = 118784;
constexpr int DS_RB = DS_META + 512;
constexpr int DS_SS = DS_RB + 2048;
constexpr int DS_SLOT = 12800;
constexpr int NBIN = 768, CAND_CAP = 128;
__device__ const unsigned char T5B[114] = {0, 1, 2, 3, 4, 5, 6, 7, 8, 9, 10, 11, 12, 13, 14, 15, 16, 16, 16, 17, 17, 18, 18, 18, 19, 19, 19, 20, 20, 20, 20, 21, 21, 21, 21, 22, 22, 22, 22, 22, 23, 23, 23, 23, 23, 23, 24, 24, 24, 24, 24, 24, 25, 25, 25, 25, 25, 25, 25, 26, 26, 26, 26, 26, 26, 26, 26, 27, 27, 27, 27, 27, 27, 27, 27, 27, 27, 28, 28, 28, 28, 28, 28, 28, 28, 28, 28, 29, 29, 29, 29, 29, 29, 29, 29, 29, 29, 29, 29, 30, 30, 30, 30, 30, 30, 30, 30, 30, 30, 30, 30, 30, 30, 31};

DEV int score_bin(float sc) {
    const unsigned u = __builtin_bit_cast(unsigned, sc);
    int e = (int)((u >> 18) & 0x1FFFu) - 119 * 32; e = e < 0 ? 0 : (e > 383 ? 383 : e);
    return (u >> 31) ? 383 - e : 384 + e;
}
DEV unsigned score_key(float sc) { const unsigned u = __builtin_bit_cast(unsigned, sc); return (u >> 31) ? ~u : (u | 0x80000000u); }
DEV unsigned score_code(float sc) {
    const unsigned u = __builtin_bit_cast(unsigned, sc);
    int e = (int)((u >> 18) & 0x1FFFu) - 119 * 32; e = e < 0 ? 0 : (e > 383 ? 383 : e);
    const int v = (e << 6) | (int)((u >> 12) & 63u), sm = (int)u >> 31;
    return (unsigned)(0x6000 + (v ^ sm));
}
DEV int code_bin(unsigned c) { return (int)(c >> 6); }
DEV unsigned code_key(unsigned c) { return c & 63u; }


DEV f32x4 dsa_score_tile(const bf16x8 A, const bf16x8 (&QS)[2], const bf16x8 (&Bq)[8], const float (&wq)[8]) {
    f32x4 d8[8];
#pragma unroll
    for (int h = 0; h < 8; ++h) d8[h] = MFMA16(A, Bq[h], (f32x4){0.f, 0.f, 0.f, 0.f});
#ifndef HOST_EMU
    asm volatile("" :: "v"(d8[0]), "v"(d8[1]), "v"(d8[2]), "v"(d8[3]), "v"(d8[4]), "v"(d8[5]), "v"(d8[6]), "v"(d8[7]));
#endif
    f32x4 sc = (f32x4){0.f, 0.f, 0.f, 0.f};
#pragma unroll
    for (int h = 0; h < 8; ++h)
#pragma unroll
        for (int r = 0; r < 4; ++r) { sc[r] = __builtin_fmaf(wq[h], RELU(d8[h][r]), sc[r]); NOPACK(sc[r]); }
    return sc;
}
DEV void ph_dsa(const Ctx& F, int l) {
    const int tid = F.tid, lane = F.lane, w = F.wave, i16 = lane & 15, g = lane >> 4;
    unsigned* HIST = (unsigned*)(F.lds + DS_HIST); unsigned* MASK = (unsigned*)(F.lds + DS_MASK); u32x2* CAND = (u32x2*)(F.lds + DS_CAND);
    unsigned short* SELL = (unsigned short*)(F.lds + DS_SELL); int* BST = (int*)(F.lds + DS_META); int* NAB = BST + 32; int* NCAND = BST + 64; int* NSEL = BST + 96;
    float* RB = (float*)(F.lds + DS_RB);
    const bf16* QIDX = (const bf16*)(F.ws + WS_QIDX); const bf16* KIDX = (const bf16*)(F.ws + WS_KIDX); const float* WI = (const float*)(F.ws + WS_WI);
    const bf16* QABS = (const bf16*)(F.ws + WS_QABS); const bf16* CKV = (const bf16*)(F.ws + WS_CKV); bf16* CAT = (bf16*)(F.ws + WS_CAT);
    const bf16* WUVT = (const bf16*)(F.ws + WS_WUVT) + (size_t)l * 4 * 64 * 128; float* SS = (float*)(F.lds + DS_SS);
    for (int e = tid; e < 114 * 4; e += 512) RB[e] = PIN(F, I_RELB)[T5B[e >> 2] * 4 + (e & 3)] * 1.4426950408889634f;
    SYNC();
    for (int ui = F.bid; ui < BATCH * 128; ui += F.G) {
#ifdef HOST_EMU
        int b, qt; { const int wv = ui & 255, k = ui >> 8, r = wv & 15; b = wv >> 4; qt = (k & 1) ? (32 * (k >> 1) + 31 - r) : (32 * (k >> 1) + r); }
#else
        int b, qt; { const int wv = ui & 255, k = ui >> 8, xj = wv >> 3, r = xj & 15; b = 2 * (wv & 7) + (xj >> 4);
            qt = (k & 1) ? (32 * (k >> 1) + 31 - r) : (32 * (k >> 1) + r); }
#endif
        const int t0 = 32 * qt, nkt = 2 * qt + 2; const size_t mb = (size_t)b * SEQ;
        const GAS char* const ckvb = UNIP(CKV + mb * 128);
        const int nt = w & 1;
        u32x2* sw = (u32x2*)(F.ws + (F.bid < 128 ? WS_QL + (size_t)F.bid * 262144 : WS_SCR2 + (size_t)(F.bid - 128) * 262144) + (size_t)w * 32768) + lane;
        bf16x8 Bq[8]; float wq[8];
        { const size_t mq = mb + t0 + 16 * nt + i16;
#pragma unroll
            for (int h = 0; h < 8; ++h) { Bq[h] = *(const bf16x8*)(QIDX + mq * 256 + 32 * h + 8 * g); wq[h] = WI[mq * 8 + h]; } }
        bf16x8 QS[2];
#pragma unroll
        for (int j = 0; j < 8; ++j) { float s = 0.f;
#pragma unroll
            for (int h = 0; h < 8; ++h) s += wq[h] * bf2f((unsigned)(unsigned short)Bq[h][j]);
            const unsigned hi = f2bf(s); QS[0][j] = (short)hi; QS[1][j] = (short)f2bf(s - bf2f(hi)); }
        for (int e = tid; e < 16 * NBIN; e += 512) HIST[e] = 0u;
        for (int e = tid; e < 32 * 128; e += 512) MASK[e] = 0u;
        if (tid < 32) NCAND[tid] = 0;
        SYNC();
        const GAS char* const kidb = UNIP(KIDX + mb * 32); const unsigned kidl = (unsigned)(i16 * 64 + g * 16);
        bf16x8 Apre = *(const GAS bf16x8*)(kidb + ((unsigned)(16 * (w >> 1)) * 64u + kidl));
        for (int kt = w >> 1; kt < nkt; kt += 4) {
            const bf16x8 A = Apre;
            { const int kn = kt + 4 < nkt ? kt + 4 : kt; Apre = *(const GAS bf16x8*)(kidb + ((unsigned)(16 * kn) * 64u + kidl)); }
            const f32x4 sc = dsa_score_tile(A, QS, Bq, wq);
            unsigned cd[4];
#pragma unroll
            for (int r = 0; r < 4; ++r) cd[r] = score_code(sc[r]);
            { u32x2 pk; pk.x = cd[0] | (cd[1] << 16); pk.y = cd[2] | (cd[3] << 16); sw[(size_t)((kt - (w >> 1)) >> 2) * 64] = pk; }
            const unsigned inc = nt ? 65536u : 1u;
            if (kt < 2 * qt) {
#pragma unroll
                for (int r = 0; r < 4; ++r) atomicAdd(&HIST[i16 * NBIN + code_bin(cd[r])], inc);
            } else {
                const int t = t0 + 16 * nt + i16;
#pragma unroll
                for (int r = 0; r < 4; ++r) { const int s = 16 * kt + 4 * g + r;
                    if (s <= t) atomicAdd(&HIST[i16 * NBIN + code_bin(cd[r])], inc); }
            }
        }
        SYNC();
        {
            int cnt4[4][12], tot4[4], suf4[4];
#pragma unroll
            for (int rr = 0; rr < 4; ++rr) { const int row = 4 * w + rr, sh = (row >> 4) * 16; const unsigned* hp = HIST + (row & 15) * NBIN + 12 * lane; int tot = 0;
#pragma unroll
                for (int i = 0; i < 12; ++i) { cnt4[rr][i] = (int)((hp[i] >> sh) & 0xFFFFu); tot += cnt4[rr][i]; }
                tot4[rr] = tot; suf4[rr] = tot; }
#pragma unroll
            for (int o = 1; o < 64; o <<= 1) {
#pragma unroll
                for (int rr = 0; rr < 4; ++rr) { const int v = SHFL_DOWN(suf4[rr], o); if (lane + o < 64) suf4[rr] += v; } }
#pragma unroll
            for (int rr = 0; rr < 4; ++rr) { const int row = 4 * w + rr, t = t0 + row;
                if (t < 256) { if (lane == 0) { BST[row] = -1; NAB[row] = t + 1; } }
                else { const int above = suf4[rr] - tot4[rr];
                    if (above < 256 && above + tot4[rr] >= 256) {
                        int run = above, bs = -1, na = 0; bool done = false;
#pragma unroll
                        for (int i = 11; i >= 0; --i) { if (!done) { if (run + cnt4[rr][i] >= 256) { bs = 12 * lane + i; na = run; done = true; } else run += cnt4[rr][i]; } }
                        BST[row] = bs; NAB[row] = na; } } }
        }
        SYNC();
        { const int row = 16 * nt + i16, t = t0 + row, bs = BST[row];
        const int ntl = nkt > (w >> 1) ? ((nkt - 1 - (w >> 1)) >> 2) + 1 : 0;
        u32x2 Pc[8], Pn[8];
#pragma unroll
        for (int q = 0; q < 8; ++q) Pc[q] = sw[(size_t)(q < 64 ? q : 63) * 64];
        for (int jb = 0; jb < ntl; jb += 8) {
#pragma unroll
            for (int q = 0; q < 8; ++q) { const int jn = jb + 8 + q; Pn[q] = sw[(size_t)(jn < 64 ? jn : 63) * 64]; }
#pragma unroll
            for (int q = 0; q < 8; ++q) { const int j = jb + q; if (j < ntl) { const int kt = (w >> 1) + 4 * j; const u32x2 pc = Pc[q];
            const bool full = kt < 2 * qt;
            const int s0 = 16 * kt + 4 * g; unsigned nib = 0u, cnd = 0u, cc[4];
#pragma unroll
            for (int r = 0; r < 4; ++r) { const unsigned wd = r < 2 ? pc.x : pc.y; cc[r] = (r & 1) ? (wd >> 16) : (wd & 0xffffu);
                const int bn = code_bin(cc[r]); const bool ok = full || s0 + r <= t;
                nib |= (ok && bn > bs) ? (1u << r) : 0u; cnd |= (ok && bn == bs) ? (1u << r) : 0u; }
            if (nib) atomicOr(&MASK[row * 128 + (s0 >> 5)], nib << (s0 & 31));
            if (cnd) {
#pragma unroll
                for (int r = 0; r < 4; ++r) if ((cnd >> r) & 1u) { const int pos = (int)atomicAdd((unsigned*)&NCAND[row], 1u); if (pos < CAND_CAP) CAND[row * CAND_CAP + pos] = (u32x2){code_key(cc[r]), (unsigned)(s0 + r)}; } }
            } }
#pragma unroll
            for (int q = 0; q < 8; ++q) Pc[q] = Pn[q];
        } }
        SYNC();
#pragma unroll 1
        for (int rr = 0; rr < 4; ++rr) {
            const int row = 4 * w + rr; if (BST[row] < 0) continue;
            const int n = NCAND[row] < CAND_CAP ? NCAND[row] : CAND_CAP, need = 256 - NAB[row];
            for (int i = lane; i < n; i += 64) { const u32x2 me = CAND[row * CAND_CAP + i]; int rank = 0;
                for (int j0 = 0; j0 < n; j0 += 8) { u32x2 o8[8];
#pragma unroll
                    for (int q = 0; q < 8; ++q) o8[q] = CAND[row * CAND_CAP + (j0 + q < CAND_CAP ? j0 + q : CAND_CAP - 1)];
#pragma unroll
                    for (int q = 0; q < 8; ++q) rank += (j0 + q < n && (o8[q].x > me.x || (o8[q].x == me.x && o8[q].y < me.y))) ? 1 : 0; }
#ifndef DSA_DBG_NOCAND
                if (rank < need) atomicOr(&MASK[row * 128 + (me.y >> 5)], 1u << (me.y & 31));
#endif
            }
        }
        SYNC();
#ifdef DSA_DBG_SEL
        for (int e = tid; e < 32 * 128; e += 512) { const int row = e >> 7, wi = e & 127, t = t0 + row, lo = t - 255 < 0 ? 0 : t - 255; unsigned m = 0u;
            for (int bq = 0; bq < 32; ++bq) { const int s = 32 * wi + bq; if (s >= lo && s <= t) m |= 1u << bq; }
            MASK[e] = m; }
        SYNC();
#endif
        {
            unsigned w04[4], w14[4]; int c4[4], inc4[4];
#pragma unroll
            for (int rr = 0; rr < 4; ++rr) { const int row = 4 * w + rr; w04[rr] = MASK[row * 128 + 2 * lane]; w14[rr] = MASK[row * 128 + 2 * lane + 1];
                c4[rr] = __builtin_popcount(w04[rr]) + __builtin_popcount(w14[rr]); inc4[rr] = c4[rr]; }
#pragma unroll
            for (int o = 1; o < 64; o <<= 1) {
#pragma unroll
                for (int rr = 0; rr < 4; ++rr) { const int v = SHFL_UP(inc4[rr], o); if (lane >= o) inc4[rr] += v; } }
#pragma unroll
            for (int rr = 0; rr < 4; ++rr) { const int row = 4 * w + rr; unsigned w0 = w04[rr], w1 = w14[rr]; int pos = inc4[rr] - c4[rr];
                while (w0) { const int bt = __builtin_ctz(w0); w0 &= w0 - 1; if (pos < 256) SELL[row * 256 + pos] = (unsigned short)(64 * lane + bt); ++pos; }
                while (w1) { const int bt = __builtin_ctz(w1); w1 &= w1 - 1; if (pos < 256) SELL[row * 256 + pos] = (unsigned short)(64 * lane + 32 + bt); ++pos; }
                if (lane == 63) NSEL[row] = inc4[rr] < 256 ? inc4[rr] : 256; }
        }
        SYNC();
        bf16* TL = (bf16*)(F.lds + w * DS_SLOT); bf16* OLw = (bf16*)(F.lds + w * DS_SLOT + 8704);
#pragma unroll 1
        for (int rr = 0; rr < 4; ++rr) {
            const int row = 4 * w + rr, t = t0 + row, ns = UNI(NSEL[row]); const size_t mt = mb + t;
            const unsigned short* sl = SELL + row * 256;
            bf16x8 Bh[4];
#pragma unroll
            for (int ks = 0; ks < 4; ++ks) Bh[ks] = i16 < 4 ? *(const bf16x8*)(QABS + mt * 512 + i16 * 128 + 32 * ks + 8 * g) : (bf16x8){0, 0, 0, 0, 0, 0, 0, 0};
            f32x4 O[8];
#pragma unroll
            for (int nt = 0; nt < 8; ++nt) O[nt] = (f32x4){0.f, 0.f, 0.f, 0.f};
            float mrun = -1e30f, lrun = 0.f;
            const float bfar = RB[113 * 4 + (i16 & 3)];
            const int nch = (ns + 31) >> 5;
            u32x4 gvA[8];
#ifndef HOST_EMU
#define ATT_KEEP8(A) asm volatile("" :: "v"(A[0][0]), "v"(A[0][1]), "v"(A[0][2]), "v"(A[0][3]), "v"(A[1][0]), "v"(A[1][1]), "v"(A[1][2]), "v"(A[1][3]))
#else
#define ATT_KEEP8(A) (void)0
#endif
#define ATT_LOAD(GV, CK, FULL) do { int sidx[8]; \
                _Pragma("unroll") for (int i = 0; i < 8; ++i) sidx[i] = (int)sl[32 * (CK) + 4 * i + g];            \
                _Pragma("unroll") for (int i = 0; i < 8; ++i) { const int kp = 32 * (CK) + 4 * i + g; sidx[i] = (FULL || kp < ns) ? sidx[i] : 0; } \
                _Pragma("unroll") for (int i = 0; i < 8; ++i) GV[i] = *(const GAS u32x4*)(ckvb + (((unsigned)sidx[i] << 8) + 16u * (unsigned)i16)); } while (0)
#define ATT_STEP(GV, CK, FULL) do { const int ck = (CK); \
                _Pragma("unroll") for (int i = 0; i < 8; ++i) *(u32x4*)(TL + (4 * i + g) * 136 + 8 * i16) = GV[i]; \
                const u32x2 sk0 = *(const u32x2*)(sl + 32 * ck + 4 * g), sk1 = *(const u32x2*)(sl + 32 * ck + 16 + 4 * g); \
                WAVE_LDS_FENCE(); \
                if (ck + 1 < nch) ATT_LOAD(GV, ck + 1, FULL); \
                float bia[2][4]; \
                if (FULL && t - UNI((int)sl[32 * ck + 31]) >= 113) {                   \
                _Pragma("unroll") for (int kt = 0; kt < 2; ++kt) \
                _Pragma("unroll") for (int r = 0; r < 4; ++r) bia[kt][r] = bfar; \
                } else { \
                _Pragma("unroll") for (int kt = 0; kt < 2; ++kt) \
                _Pragma("unroll") for (int r = 0; r < 4; ++r) { const unsigned wd = kt ? (r < 2 ? sk1.x : sk1.y) : (r < 2 ? sk0.x : sk0.y); \
                        int dist = t - (int)((wd >> (16 * (r & 1))) & 0xffffu); dist = dist < 0 ? 0 : (dist > 113 ? 113 : dist); \
                        bia[kt][r] = RB[dist * 4 + (i16 & 3)]; } } \
                f32x4 lg[2]; \
                { bf16x8 Af[2][4];                                    \
                _Pragma("unroll") for (int kt = 0; kt < 2; ++kt) _Pragma("unroll") for (int ks = 0; ks < 4; ++ks) Af[kt][ks] = *(const bf16x8*)(TL + (16 * kt + i16) * 136 + 32 * ks + 8 * g); \
                ATT_KEEP8(Af); \
                _Pragma("unroll") for (int kt = 0; kt < 2; ++kt) { lg[kt] = (f32x4){0.f, 0.f, 0.f, 0.f}; \
                _Pragma("unroll") for (int ks = 0; ks < 4; ++ks) lg[kt] = MFMA16(Af[kt][ks], Bh[ks], lg[kt]); } } \
                float cm = -1e30f; \
                _Pragma("unroll") for (int kt = 0; kt < 2; ++kt) \
                _Pragma("unroll") for (int r = 0; r < 4; ++r) { const int kp = 32 * ck + 16 * kt + 4 * g + r; \
                        lg[kt][r] = (FULL || kp < ns) ? lg[kt][r] + bia[kt][r] : -1e30f; cm = fmaxf(cm, lg[kt][r]); } \
                if (ck == 0) { cm = fmaxf(cm, SHFL_XOR(cm, 16)); cm = fmaxf(cm, SHFL_XOR(cm, 32)); mrun = cm; } \
                float p[2][4]; \
                _Pragma("unroll") for (int kt = 0; kt < 2; ++kt) \
                _Pragma("unroll") for (int r = 0; r < 4; ++r) { p[kt][r] = (FULL || lg[kt][r] > -1e29f) ? FEXP2(lg[kt][r] - mrun) : 0.f; lrun += p[kt][r]; } \
                u32x4 aw = (u32x4){0u, 0u, 0u, 0u}; \
                if (i16 < 4) aw = (u32x4){pk2(p[0][0], p[0][1]), pk2(p[0][2], p[0][3]), pk2(p[1][0], p[1][1]), pk2(p[1][2], p[1][3])}; \
                const bf16x8 A = __builtin_bit_cast(bf16x8, aw); \
                _Pragma("unroll") for (int nt = 0; nt < 8; ++nt) { \
                    const s16x4 lo = TR16(TL + (4 * g + (i16 >> 2)) * 136 + 16 * nt + 4 * (i16 & 3)); \
                    const s16x4 hi = TR16(TL + (16 + 4 * g + (i16 >> 2)) * 136 + 16 * nt + 4 * (i16 & 3)); \
                    const bf16x8 B = (bf16x8){lo[0], lo[1], lo[2], lo[3], hi[0], hi[1], hi[2], hi[3]}; \
                    O[nt] = MFMA16(A, B, O[nt]); } \
                WAVE_LDS_FENCE(); } while (0)
            if (ns == 256) { ATT_LOAD(gvA, 0, true); for (int ck2 = 0; ck2 < 8; ++ck2) ATT_STEP(gvA, ck2, true); }
            else { ATT_LOAD(gvA, 0, false); for (int ck2 = 0; ck2 < nch; ++ck2) ATT_STEP(gvA, ck2, false); }
#undef ATT_STEP
#undef ATT_LOAD
            lrun += SHFL_XOR(lrun, 16); lrun += SHFL_XOR(lrun, 32);
            float li[4];
#pragma unroll
            for (int r = 0; r < 4; ++r) li[r] = FRCP(SHFL(lrun, r));
            if (g == 0) {
#pragma unroll
                for (int nt = 0; nt < 8; ++nt)
#pragma unroll
                    for (int r = 0; r < 4; ++r) OLw[(rr * 4 + r) * 128 + 16 * nt + i16] = (bf16)f2bf(O[nt][r] * li[r]);
            }
        }
        bf16x8 Wf[4][4];
#pragma unroll
        for (int ks = 0; ks < 4; ++ks)
#pragma unroll
            for (int nt = 0; nt < 4; ++nt) Wf[ks][nt] = *(const bf16x8*)(WUVT + ((size_t)((w >> 1) * 64 + 16 * nt + i16)) * 128 + 32 * ks + 8 * g);
        SYNC();
        {
            const int h = w >> 1, mtile = w & 1, q = 16 * mtile + i16;
            const bf16* olq = (const bf16*)(F.lds + (q >> 2) * DS_SLOT + 8704) + ((q & 3) * 4 + h) * 128;
            float gaw[4];
#pragma unroll
            for (int nt = 0; nt < 4; ++nt) gaw[nt] = PIN(F, I_GNW)[l * DM + 768 + h * 64 + 16 * nt + i16];
            f32x4 acc[4];
#pragma unroll
            for (int nt = 0; nt < 4; ++nt) acc[nt] = (f32x4){0.f, 0.f, 0.f, 0.f};
#pragma unroll
            for (int ks = 0; ks < 4; ++ks) { const bf16x8 A = *(const bf16x8*)(olq + 32 * ks + 8 * g);
#pragma unroll
                for (int nt = 0; nt < 4; ++nt) acc[nt] = MFMA16(A, Wf[ks][nt], acc[nt]); }
#pragma unroll
            for (int r = 0; r < 4; ++r) { float s = (acc[0][r] * acc[0][r] + acc[1][r] * acc[1][r]) + (acc[2][r] * acc[2][r] + acc[3][r] * acc[3][r]);
                s += SHFL_XOR(s, 1); s += SHFL_XOR(s, 2); s += SHFL_XOR(s, 4); s += SHFL_XOR(s, 8);
                if (i16 == 0) SS[(16 * mtile + 4 * g + r) * 4 + h] = s; }
            SYNC();
#pragma unroll
            for (int r = 0; r < 4; ++r) { const int qq = 16 * mtile + 4 * g + r; const f32x4 s4 = *(const f32x4*)(SS + qq * 4);
                const float rs = RSQ(((s4.x + s4.y) + (s4.z + s4.w)) * (1.0f / 256.0f) + NORM_EPS);
                bf16* dst = CAT + (mb + t0 + qq) * DM + 768 + h * 64 + i16;
#pragma unroll
                for (int nt = 0; nt < 4; ++nt) dst[16 * nt] = (bf16)f2bf(acc[nt][r] * rs * gaw[nt]); }
        }
        SYNC();
    }
}
#ifndef HOST_EMU
namespace pg8 {
#define PG8_LAS __attribute__((address_space(3)))
typedef unsigned short bf16_t;
typedef short bf16x8 __attribute__((ext_vector_type(8)));
typedef float f32x4 __attribute__((ext_vector_type(4)));
typedef unsigned u32x4 __attribute__((ext_vector_type(4)));
constexpr int BM = 256, BK = 64, HALF = 128, HTB = HALF * BK * 2  , STAGE_BYTES = 8 * HTB, NXCD = 8, WGM = 8;

__host__ __device__ __forceinline__ int lds_byte(int r, int c) { const int st = (r >> 4) * 2 + (c >> 5), rr = r & 15, cc = c & 31, ob = rr * 64 + cc * 2; return st * 1024 + (ob ^ (((ob >> 9) & 1) << 5)); }
__host__ __device__ __forceinline__ void stage_rc(int b, int& R, int& C) { const int st = b / 1024, sb = b % 1024, swz = sb ^ (((sb >> 9) & 1) << 5); R = (st >> 1) * 16 + swz / 64; C = (st & 1) * 32 + (swz % 64) / 2; }
__host__ __device__ __forceinline__ int perm32(int rho) { const int n = rho >> 4, i = rho & 15; return 8 * (i >> 2) + 4 * n + (i & 3); }

struct Unit { int pm, pn; };
struct Gemm { const bf16_t* A; const bf16_t* Bt; int M, N, K; };

struct StaticOrder {
    int nM, nN, nwg, G, c;
    __host__ __device__ void init(int M, int N, int G_, int c_) { nM = M / BM; nN = N / BM; nwg = nM * nN; G = G_; c = c_; }
    __host__ __device__ bool next(int i, Unit& u) const {
        const long L = (long)i * G + c; if (L >= nwg) return false;
        int wgid = (int)L; { const int q = nwg / NXCD, r = nwg % NXCD, xcd = wgid % NXCD, off = wgid / NXCD; wgid = (xcd < r ? xcd * (q + 1) : r * (q + 1) + (xcd - r) * q) + off; }
        const int nig = WGM * nN, gid = wgid / nig, fm = gid * WGM, gsz = (nM - fm) < WGM ? (nM - fm) : WGM;
        u.pm = fm + ((wgid % nig) % gsz); u.pn = (wgid % nig) / gsz; return true;
    }
    __device__ __forceinline__ void a_ready(const Unit&) const {}
    __device__ __forceinline__ void done(const Unit&) const {}
};
__device__ __forceinline__ unsigned cvt_pk_bf16(float lo, float hi) { unsigned r; asm volatile("v_cvt_pk_bf16_f32 %0, %1, %2" : "=v"(r) : "v"(lo), "v"(hi)); return r; }
template <class Epi, class Sched, bool ALIGN_EPI = false, bool SP2 = false>
__device__ __forceinline__ void gemm_phase(PG8_LAS unsigned char* lds, const Gemm g, const Sched& S, const Epi& E, const int tid_in) {
    const int tid = tid_in, wid = __builtin_amdgcn_readfirstlane(tid >> 6), lane = tid & 63, wr = wid >> 2, wc = wid & 3, fr = lane & 15, fq = lane >> 4;
    const int K = g.K, nt = K / BK;
    unsigned voffA[2], voffB[2];
#pragma unroll
    for (int i = 0; i < 2; ++i) { int R, C; stage_rc(tid * 16 + i * 8192, R, C); const int Rb = Epi::PERM ? ((R & ~31) + perm32(R & 31)) : R;
        voffA[i] = (unsigned)(R * K + C) * 2u; voffB[i] = (unsigned)(Rb * K + C) * 2u; }
    const size_t kstep = (size_t)(BK * 2);
    const size_t hstep = (size_t)HALF * K * 2;
    const size_t tstep = 2 * hstep;
    const unsigned ldsw = (unsigned)wid * 1024u;
    const int aoff = lds_byte(wr * 64 + fr, fq * 8), boff = lds_byte(wc * 32 + fr, fq * 8);
#define PG8_SA(b, h) (((b) * 2 + (h)) * HTB)
#define PG8_SB(b, h) ((4 + (b) * 2 + (h)) * HTB)
#define PG8_STAGE(bufoff, gbase, voff) do { _Pragma("unroll") for (int _i = 0; _i < 2; ++_i) \
        __builtin_amdgcn_global_load_lds((const unsigned*)((const char*)(gbase) + (voff)[_i]), (PG8_LAS unsigned*)(lds + (bufoff) + ldsw + _i * 8192), 16, 0, 0); } while (0)
#define PG8_LDA(dst, b, h) do { _Pragma("unroll") for (int m = 0; m < 4; ++m) _Pragma("unroll") for (int k = 0; k < 2; ++k) dst[m][k] = *(const PG8_LAS bf16x8*)(lds + PG8_SA(b, h) + aoff + m * 2048 + k * 1024); } while (0)
#define PG8_LDB(dst, b, h) do { _Pragma("unroll") for (int n = 0; n < 2; ++n) _Pragma("unroll") for (int k = 0; k < 2; ++k) dst[n][k] = *(const PG8_LAS bf16x8*)(lds + PG8_SB(b, h) + boff + n * 2048 + k * 1024); } while (0)
#define PG8_MMA(ai, bj, At, Bt) do { __builtin_amdgcn_s_setprio(1); _Pragma("unroll") for (int m = 0; m < 4; ++m) _Pragma("unroll") for (int n = 0; n < 2; ++n) _Pragma("unroll") for (int k = 0; k < 2; ++k) \
        acc[ai][bj][m][n] = __builtin_amdgcn_mfma_f32_16x16x32_bf16(Bt[n][k], At[m][k], acc[ai][bj][m][n], 0, 0, 0); __builtin_amdgcn_s_setprio(0); } while (0)
#define PG8_WAIT_V(n) asm volatile("s_waitcnt vmcnt(" #n ")" ::: "memory")
#define PG8_WAIT_L(n) asm volatile("s_waitcnt lgkmcnt(" #n ")" ::: "memory")
#define PG8_BAR __builtin_amdgcn_s_barrier()
#define PG8_SCHED __builtin_amdgcn_sched_barrier(0)
    Unit cur, nxt; int ui = 0;
    if (!S.next(0, cur)) return;
    f32x4 acc[2][2][4][2];
#pragma unroll
    for (int a = 0; a < 2; ++a)
#pragma unroll
        for (int b = 0; b < 2; ++b)
#pragma unroll
            for (int m = 0; m < 4; ++m)
#pragma unroll
                for (int n = 0; n < 2; ++n) acc[a][b][m][n] = (f32x4){0.f, 0.f, 0.f, 0.f};
    bf16x8 At[4][2], B0[2][2], B1[2][2];
    const char* cA = (const char*)g.A + (size_t)cur.pm * tstep; const char* cB = (const char*)g.Bt + (size_t)cur.pn * tstep;
    S.a_ready(cur);
    if constexpr (SP2) {
        PG8_STAGE(PG8_SB(0, 0), cB, voffB); PG8_STAGE(PG8_SB(0, 1), cB + hstep, voffB); PG8_STAGE(PG8_SA(0, 0), cA, voffA); PG8_STAGE(PG8_SA(0, 1), cA + hstep, voffA);
        if (wr == 1) PG8_BAR;
        PG8_WAIT_V(2); PG8_BAR;
        PG8_STAGE(PG8_SB(1, 0), cB + kstep, voffB); PG8_STAGE(PG8_SA(1, 0), cA + kstep, voffA); PG8_STAGE(PG8_SB(1, 1), cB + hstep + kstep, voffB);
        PG8_WAIT_V(6); PG8_BAR;
    } else {
        PG8_STAGE(PG8_SB(0, 0), cB, voffB); PG8_STAGE(PG8_SA(0, 0), cA, voffA); PG8_STAGE(PG8_SB(0, 1), cB + hstep, voffB); PG8_STAGE(PG8_SA(0, 1), cA + hstep, voffA);
        if (wr == 1) PG8_BAR;
        PG8_WAIT_V(4); PG8_BAR;
        PG8_STAGE(PG8_SB(1, 0), cB + kstep, voffB); PG8_STAGE(PG8_SA(1, 0), cA + kstep, voffA); PG8_STAGE(PG8_SB(1, 1), cB + hstep + kstep, voffB);
        PG8_WAIT_V(6); PG8_BAR;
    }
    for (;;) {
        const bool has_next = S.next(ui + 1, nxt);
        const char* nA = has_next ? (const char*)g.A + (size_t)nxt.pm * tstep : cA; const char* nB = has_next ? (const char*)g.Bt + (size_t)nxt.pn * tstep : cB;
#pragma unroll 1
        for (int t = 0; t < nt; t += 2) {
            const bool last = (t == nt - 2);
            const char* a1 = cA + (size_t)(t + 1) * kstep;
            const char* a2 = last ? nA : cA + (size_t)(t + 2) * kstep; const char* b2 = last ? nB : cB + (size_t)(t + 2) * kstep;
            const char* a3 = a2 + kstep; const char* b3 = b2 + kstep;
            if (last && has_next) S.a_ready(nxt);
            if constexpr (Epi::NORM) { if (t == 2) E.prefetch(cur, tid, wid); if (t == 4) E.reduce_rs(tid); }
            if constexpr (SP2) {
            PG8_LDB(B0, 0, 0); PG8_LDB(B1, 0, 1); PG8_SCHED; PG8_LDA(At, 0, 0); PG8_STAGE(PG8_SA(1, 1), a1 + hstep, voffA);
            PG8_WAIT_V(8); PG8_WAIT_L(0); PG8_BAR; PG8_MMA(0, 0, At, B0); PG8_MMA(0, 1, At, B1); PG8_BAR; PG8_SCHED;
            PG8_LDA(At, 0, 1); PG8_STAGE(PG8_SB(0, 0), b2, voffB); PG8_STAGE(PG8_SB(0, 1), b2 + hstep, voffB); PG8_STAGE(PG8_SA(0, 0), a2, voffA);
            PG8_WAIT_V(8); PG8_WAIT_L(0); PG8_BAR; PG8_MMA(1, 0, At, B0); PG8_MMA(1, 1, At, B1); PG8_BAR; PG8_SCHED;
            PG8_LDB(B0, 1, 0); PG8_LDB(B1, 1, 1); PG8_SCHED; PG8_LDA(At, 1, 0); PG8_STAGE(PG8_SA(0, 1), a2 + hstep, voffA);
            PG8_WAIT_V(8); PG8_WAIT_L(0); PG8_BAR; PG8_MMA(0, 0, At, B0); PG8_MMA(0, 1, At, B1); PG8_BAR; PG8_SCHED;
            PG8_LDA(At, 1, 1); PG8_STAGE(PG8_SB(1, 0), b3, voffB); PG8_STAGE(PG8_SB(1, 1), b3 + hstep, voffB); PG8_STAGE(PG8_SA(1, 0), a3, voffA);
            PG8_WAIT_V(8); PG8_WAIT_L(0); PG8_BAR; PG8_MMA(1, 0, At, B0); PG8_MMA(1, 1, At, B1); PG8_BAR; PG8_SCHED;
            } else {
            PG8_LDB(B0, 0, 0); PG8_SCHED; PG8_LDA(At, 0, 0); PG8_STAGE(PG8_SA(1, 1), a1 + hstep, voffA);
            PG8_WAIT_L(8); PG8_BAR; PG8_WAIT_L(0); PG8_MMA(0, 0, At, B0); PG8_BAR; PG8_SCHED;
            PG8_LDB(B1, 0, 1); PG8_STAGE(PG8_SB(0, 0), b2, voffB);
            PG8_BAR; PG8_WAIT_L(0); PG8_MMA(0, 1, At, B1); PG8_BAR;
            PG8_LDA(At, 0, 1); PG8_STAGE(PG8_SA(0, 0), a2, voffA);
            PG8_BAR; PG8_WAIT_L(0); PG8_MMA(1, 0, At, B0); PG8_BAR; PG8_SCHED;
            PG8_STAGE(PG8_SB(0, 1), b2 + hstep, voffB);
            PG8_WAIT_V(6); PG8_BAR; PG8_MMA(1, 1, At, B1); PG8_BAR;
            PG8_LDB(B0, 1, 0); PG8_SCHED; PG8_LDA(At, 1, 0); PG8_STAGE(PG8_SA(0, 1), a2 + hstep, voffA);
            PG8_WAIT_L(8); PG8_BAR; PG8_WAIT_L(0); PG8_MMA(0, 0, At, B0); PG8_BAR; PG8_SCHED;
            PG8_LDB(B1, 1, 1); PG8_STAGE(PG8_SB(1, 0), b3, voffB);
            PG8_BAR; PG8_WAIT_L(0); PG8_MMA(0, 1, At, B1); PG8_BAR;
            PG8_LDA(At, 1, 1); PG8_STAGE(PG8_SA(1, 0), a3, voffA);
            PG8_BAR; PG8_WAIT_L(0); PG8_MMA(1, 0, At, B0); PG8_BAR; PG8_SCHED;
            PG8_STAGE(PG8_SB(1, 1), b3 + hstep, voffB);
            PG8_WAIT_V(6); PG8_BAR; PG8_MMA(1, 1, At, B1); PG8_BAR;
            }
        }
        if constexpr (ALIGN_EPI) { if (wr == 0) PG8_BAR; }
        if constexpr (!Epi::AFTER_DRAIN) { E(acc, cur, wr, wc, fr, fq); S.done(cur); }
        if (!has_next) break;
#pragma unroll
        for (int a = 0; a < 2; ++a)
#pragma unroll
            for (int b = 0; b < 2; ++b)
#pragma unroll
                for (int m = 0; m < 4; ++m)
#pragma unroll
                    for (int n = 0; n < 2; ++n) acc[a][b][m][n] = (f32x4){0.f, 0.f, 0.f, 0.f};
        cur = nxt; cA = nA; cB = nB; ++ui;
        if constexpr (ALIGN_EPI) { if (wr == 1) PG8_BAR; }
    }
    PG8_WAIT_V(0);
    if constexpr (!ALIGN_EPI) { if (wr == 0) PG8_BAR; }
    PG8_BAR;
    if constexpr (Epi::AFTER_DRAIN) { E.fused(acc, cur, wr, wc, fr, fq, lds, wid, lane); S.done(cur); }
#undef PG8_SA
#undef PG8_SB
#undef PG8_STAGE
#undef PG8_LDA
#undef PG8_LDB
#undef PG8_MMA
#undef PG8_WAIT_V
#undef PG8_WAIT_L
#undef PG8_BAR
#undef PG8_SCHED
}
}
namespace pg8 {
template <int ACT  > struct EpiRoute {
    static constexpr bool PERM = true, AFTER_DRAIN = false, NORM = false;
    bf16_t* O0; int ld0; bf16_t* O1; int ld1; int split;
    __device__ __forceinline__ void operator()(const f32x4 (&acc)[2][2][4][2], const Unit& u, int wr, int wc, int fr, int fq) const {
        const int row0 = u.pm * BM + wr * 64 + fr; const bool first = u.pn < split;
        bf16_t* base = first ? O0 : O1; const int ld = first ? ld0 : ld1; const int col0 = (first ? u.pn : u.pn - split) * BM + wc * 32 + 8 * fq;
#pragma unroll
        for (int ai = 0; ai < 2; ++ai)
#pragma unroll
            for (int m = 0; m < 4; ++m) { bf16_t* rowp = base + (size_t)(row0 + ai * HALF + m * 16) * ld + col0;
#pragma unroll
                for (int bj = 0; bj < 2; ++bj) { f32x4 v0 = acc[ai][bj][m][0], v1 = acc[ai][bj][m][1];
                    if (ACT == 1) {
#pragma unroll
                        for (int e = 0; e < 4; ++e) { const float a = fmaxf(v0[e], 0.f), b = fmaxf(v1[e], 0.f); v0[e] = a * a; v1[e] = b * b; } }
                    u32x4 w; w.x = cvt_pk_bf16(v0[0], v0[1]); w.y = cvt_pk_bf16(v0[2], v0[3]); w.z = cvt_pk_bf16(v1[0], v1[1]); w.w = cvt_pk_bf16(v1[2], v1[3]);
                    *(u32x4*)(rowp + bj * HALF) = w; } }
    }
};
struct EpiResid {
    static constexpr bool PERM = true, AFTER_DRAIN = false, NORM = false;
    const float* xsrc; float* xdst; const float* gate;
    __device__ __forceinline__ void operator()(const f32x4 (&acc)[2][2][4][2], const Unit& u, int wr, int wc, int fr, int fq) const {
        const int row0 = u.pm * BM + wr * 64 + fr, col0 = u.pn * BM + wc * 32 + 8 * fq, b = (u.pm * BM) >> 12;
        f32x4 gv[2][2];
#pragma unroll
        for (int bj = 0; bj < 2; ++bj)
#pragma unroll
            for (int n = 0; n < 2; ++n) gv[bj][n] = *(const f32x4*)(gate + (size_t)b * 6144 + col0 + bj * HALF + 4 * n);
#pragma unroll
        for (int ai = 0; ai < 2; ++ai)
#pragma unroll
            for (int m = 0; m < 4; ++m) { const size_t off = (size_t)(row0 + ai * HALF + m * 16) * 1024 + col0;
#pragma unroll
                for (int bj = 0; bj < 2; ++bj)
#pragma unroll
                    for (int n = 0; n < 2; ++n) { const f32x4 xs = *(const f32x4*)(xsrc + off + bj * HALF + 4 * n);
                        *(f32x4*)(xdst + off + bj * HALF + 4 * n) = xs + gv[bj][n] * acc[ai][bj][m][n]; }
                if (m & 1) asm volatile("" ::: "memory"); }
    }
};
constexpr int EPI_OFF = 133120;
template <int ACT  > struct EpiRouteN {
    static constexpr bool PERM = true, AFTER_DRAIN = false, NORM = true;
    bf16_t* O; int ld; const float* RSP; const float* shw; PG8_LAS unsigned char* lds;
    __device__ __forceinline__ void prefetch(const Unit& u, int tid, int wid) const {
        const char* src = (const char*)RSP + (size_t)u.pm * (BM * 64) + (size_t)tid * 16;
#pragma unroll
        for (int i = 0; i < 2; ++i) __builtin_amdgcn_global_load_lds((const unsigned*)(src + i * 8192), (PG8_LAS unsigned*)(lds + EPI_OFF + wid * 1024 + i * 8192), 16, 0, 0);
        if (wid == 0) { const char* s2 = (const char*)(shw + (size_t)((u.pm * BM) >> 12) * NSHW + u.pn * BM) + (size_t)(tid & 63) * 16;
            __builtin_amdgcn_global_load_lds((const unsigned*)s2, (PG8_LAS unsigned*)(lds + EPI_OFF + 16384), 16, 0, 0); }
    }
    __device__ __forceinline__ void reduce_rs(int tid) const {
        if (tid < 256) { const PG8_LAS f32x4* p = (const PG8_LAS f32x4*)(lds + EPI_OFF + tid * 64); const f32x4 a = p[0], b = p[1], c = p[2], d = p[3];
            const float s = (((a.x + a.y) + (a.z + a.w)) + ((b.x + b.y) + (b.z + b.w))) + (((c.x + c.y) + (c.z + c.w)) + ((d.x + d.y) + (d.z + d.w)));
            *(PG8_LAS float*)(lds + EPI_OFF + 17408 + tid * 4) = __builtin_amdgcn_rsqf(s * (1.0f / 1024.0f) + 1e-6f); }
    }
    __device__ __forceinline__ void operator()(const f32x4 (&acc)[2][2][4][2], const Unit& u, int wr, int wc, int fr, int fq) const {
        const int row0 = u.pm * BM + wr * 64 + fr, col0 = u.pn * BM + wc * 32 + 8 * fq;
        const PG8_LAS unsigned char* ep = lds + EPI_OFF;
        float rs[2][4];
#pragma unroll
        for (int ai = 0; ai < 2; ++ai)
#pragma unroll
            for (int m = 0; m < 4; ++m) rs[ai][m] = *(const PG8_LAS float*)(ep + 17408 + (wr * 64 + fr + ai * HALF + m * 16) * 4);
        f32x4 sv[2][2];
#pragma unroll
        for (int bj = 0; bj < 2; ++bj)
#pragma unroll
            for (int n = 0; n < 2; ++n) sv[bj][n] = *(const PG8_LAS f32x4*)(ep + 16384 + (bj * HALF + wc * 32 + 8 * fq + 4 * n) * 4);
#pragma unroll
        for (int ai = 0; ai < 2; ++ai)
#pragma unroll
            for (int m = 0; m < 4; ++m) { bf16_t* rowp = O + (size_t)(row0 + ai * HALF + m * 16) * ld + col0;
#pragma unroll
                for (int bj = 0; bj < 2; ++bj) { f32x4 v0 = acc[ai][bj][m][0] * rs[ai][m] + sv[bj][0], v1 = acc[ai][bj][m][1] * rs[ai][m] + sv[bj][1];
                    if (ACT == 1) {
#pragma unroll
                        for (int e = 0; e < 4; ++e) { const float a = fmaxf(v0[e], 0.f), b = fmaxf(v1[e], 0.f); v0[e] = a * a; v1[e] = b * b; } }
                    u32x4 w; w.x = cvt_pk_bf16(v0[0], v0[1]); w.y = cvt_pk_bf16(v0[2], v0[3]); w.z = cvt_pk_bf16(v1[0], v1[1]); w.w = cvt_pk_bf16(v1[2], v1[3]);
                    *(u32x4*)(rowp + bj * HALF) = w; } }
    }
};
template <bool MAYSKIP> struct EpiResidXS {
    static constexpr bool PERM = true, AFTER_DRAIN = false, NORM = false;
    const bf16_t* xsrc; bf16_t* xdst; const float* gate; const float* wp; bf16_t* XS; float* RSP; int doxs;
    template <bool DOXS> __device__ __forceinline__ void body(const f32x4 (&acc)[2][2][4][2], const Unit& u, int wr, int wc, int fr, int fq) const {
        const int row0 = u.pm * BM + wr * 64 + fr, col0 = u.pn * BM + wc * 32 + 8 * fq, b = (u.pm * BM) >> 12;
        f32x4 gv[2][2], wv[2][2]; float ssv[2][4];
#pragma unroll
        for (int bj = 0; bj < 2; ++bj)
#pragma unroll
            for (int n = 0; n < 2; ++n) { gv[bj][n] = *(const f32x4*)(gate + (size_t)b * 6144 + col0 + bj * HALF + 4 * n);
                if (DOXS) wv[bj][n] = *(const f32x4*)(wp + (size_t)b * 1024 + col0 + bj * HALF + 4 * n); }
#pragma unroll
        for (int aim = 0; aim < 4; ++aim) { const int ai = aim >> 1, m0_ = (aim & 1) * 2;
            u32x4 xr[4][2];
#pragma unroll
            for (int m = m0_; m < m0_ + 2; ++m)
#pragma unroll
                for (int bj = 0; bj < 2; ++bj) xr[m][bj] = *(const u32x4*)(xsrc + (size_t)(row0 + ai * HALF + m * 16) * 1024 + col0 + bj * HALF);
#pragma unroll
            for (int m = m0_; m < m0_ + 2; ++m) { const size_t off = (size_t)(row0 + ai * HALF + m * 16) * 1024 + col0; float ss = 0.f;
#pragma unroll
                for (int bj = 0; bj < 2; ++bj) { const u32x4 r = xr[m][bj];
                    const f32x4 x0 = (f32x4){bflo(r.x), bfhi(r.x), bflo(r.y), bfhi(r.y)}, x1 = (f32x4){bflo(r.z), bfhi(r.z), bflo(r.w), bfhi(r.w)};
                    const f32x4 y0 = x0 + gv[bj][0] * acc[ai][bj][m][0], y1 = x1 + gv[bj][1] * acc[ai][bj][m][1];
                    u32x4 w; w.x = cvt_pk_bf16(y0[0], y0[1]); w.y = cvt_pk_bf16(y0[2], y0[3]); w.z = cvt_pk_bf16(y1[0], y1[1]); w.w = cvt_pk_bf16(y1[2], y1[3]);
                    *(u32x4*)(xdst + off + bj * HALF) = w;
                    if (DOXS) { const f32x4 a = y0 * wv[bj][0], c = y1 * wv[bj][1];
                        u32x4 v; v.x = cvt_pk_bf16(a[0], a[1]); v.y = cvt_pk_bf16(a[2], a[3]); v.z = cvt_pk_bf16(c[0], c[1]); v.w = cvt_pk_bf16(c[2], c[3]);
                        *(u32x4*)(XS + off + bj * HALF) = v;
                        ss += ((y0.x * y0.x + y0.y * y0.y) + (y0.z * y0.z + y0.w * y0.w)) + ((y1.x * y1.x + y1.y * y1.y) + (y1.z * y1.z + y1.w * y1.w)); } }
                ssv[ai][m] = ss; }
            asm volatile("" ::: "memory"); }
        if (DOXS) { float t1[2][4];
#pragma unroll
            for (int ai = 0; ai < 2; ++ai)
#pragma unroll
                for (int m = 0; m < 4; ++m) t1[ai][m] = __shfl_xor(ssv[ai][m], 16);
#pragma unroll
            for (int ai = 0; ai < 2; ++ai)
#pragma unroll
                for (int m = 0; m < 4; ++m) { ssv[ai][m] += t1[ai][m]; t1[ai][m] = __shfl_xor(ssv[ai][m], 32); }
            if (fq == 0) {
#pragma unroll
                for (int ai = 0; ai < 2; ++ai)
#pragma unroll
                    for (int m = 0; m < 4; ++m) RSP[(size_t)(row0 + ai * HALF + m * 16) * 16 + u.pn * 4 + wc] = ssv[ai][m] + t1[ai][m]; } }
    }
    __device__ __forceinline__ void operator()(const f32x4 (&acc)[2][2][4][2], const Unit& u, int wr, int wc, int fr, int fq) const {
        if (!MAYSKIP || doxs) body<true>(acc, u, wr, wc, fr, fq); else body<false>(acc, u, wr, wc, fr, fq);
    }
};
}

#define RLX_AGENT __ATOMIC_RELAXED, __HIP_MEMORY_SCOPE_AGENT
#define XB_TMO      128
#define XB_XCNT(j)  (256  + 64 * (j))
#define XB_XSUB(j)  (1280 + 64 * (j))
#define XB_XGEN(j)  (2304 + 64 * (j))
#define XB_TOP      3328
#define XB_TOPGEN   3392
#define XCD_BAR_WORDS 3456
#define XB_SPIN_CAP (1u << 24)

__device__ __forceinline__ unsigned xb_ld(unsigned* p)              { return __hip_atomic_load(p, __ATOMIC_RELAXED, __HIP_MEMORY_SCOPE_AGENT); }
__device__ __forceinline__ unsigned xb_add(unsigned* p, unsigned v) { return __hip_atomic_fetch_add(p, v, __ATOMIC_RELAXED, __HIP_MEMORY_SCOPE_AGENT); }
__device__ __forceinline__ unsigned xb_xcc_id() { return (unsigned)__builtin_amdgcn_s_getreg((3 << 11) | 20) & 0xFu; }
#define XB_SPIN(cond, bar) do { unsigned _sp = 0; while (cond) { __builtin_amdgcn_s_sleep(1); \
    if ((++_sp & 255u) == 0u) { if (xb_ld(&(bar)[XB_TMO])) break; if (_sp > XB_SPIN_CAP) { atomicAdd(&(bar)[XB_TMO], 1u); break; } } } } while (0)

struct XcdBarrier {
    unsigned* bar; unsigned x;
    volatile LAS unsigned* st;
};

__device__ __forceinline__ XcdBarrier xcd_barrier_post(unsigned* bar, volatile LAS unsigned* st) {
    XcdBarrier b; b.bar = bar; b.x = xb_xcc_id(); b.st = st;
    if (threadIdx.x == 0) (void)xb_add(&bar[XB_XCNT(b.x)], 1u);
    return b;
}
__device__ __forceinline__ void xcd_barrier_complete(unsigned* bar, unsigned x, unsigned& nloc, unsigned& nx) {
    const unsigned G = gridDim.x * gridDim.y * gridDim.z;
    unsigned sum, cnt, mine, sp = 0u;
    for (;;) {
        sum = 0u; cnt = 0u; mine = 0u;
#pragma unroll
        for (unsigned j = 0; j < 16; ++j) { const unsigned c = xb_ld(&bar[XB_XCNT(j)]); sum += c; cnt += (c > 0u) ? 1u : 0u; mine = (j == x) ? c : mine; }
        if (sum == G) break;
        __builtin_amdgcn_s_sleep(1);
        if ((++sp & 255u) == 0u) { if (xb_ld(&bar[XB_TMO])) break; if (sp > XB_SPIN_CAP) { atomicAdd(&bar[XB_TMO], 1u); break; } }
    }
    nloc = mine > 0u ? mine : 1u; nx = cnt > 0u ? cnt : 1u;
}

__device__ __forceinline__ void xcd_barrier(const XcdBarrier& b) {
    asm volatile("s_waitcnt vmcnt(0)" ::: "memory");
    __syncthreads();
    if (threadIdx.x == 0) {
        unsigned* bar = b.bar;
        __builtin_amdgcn_s_waitcnt(0);
        unsigned nloc = b.st[0], nx = b.st[1];
        if (nloc == 0u) { xcd_barrier_complete(bar, b.x, nloc, nx); b.st[0] = nloc; b.st[1] = nx; }
        const unsigned old = xb_add(&bar[XB_XSUB(b.x)], 1u);
        const unsigned gen = old / nloc;
        if (old + 1u == (gen + 1u) * nloc) {
            __builtin_amdgcn_fence(__ATOMIC_RELEASE, "agent");
            asm volatile("s_waitcnt vmcnt(0)" ::: "memory");
            const unsigned og = xb_add(&bar[XB_TOP], 1u);
            const unsigned tg = og / nx;
            if (og + 1u == (tg + 1u) * nx) xb_add(&bar[XB_TOPGEN], 1u);
            else XB_SPIN(xb_ld(&bar[XB_TOPGEN]) == tg, bar);
            __builtin_amdgcn_fence(__ATOMIC_ACQUIRE, "agent");
            xb_add(&bar[XB_XGEN(b.x)], 1u);
            asm volatile("s_waitcnt vmcnt(0)" ::: "memory");
        } else {
            XB_SPIN(xb_ld(&bar[XB_XGEN(b.x)]) == gen, bar);
            __builtin_amdgcn_fence(__ATOMIC_ACQUIRE, "agent");
            asm volatile("s_waitcnt vmcnt(0)" ::: "memory");
        }
    }
    __syncthreads();
}

#ifndef PH_MASK
#define PH_MASK 0xFFFFF
#endif
#define EN(b) if constexpr ((PH_MASK >> (b)) & 1)
#ifndef DUP_MASK
#define DUP_MASK 0
#endif
#define DUP(b) if constexpr ((DUP_MASK >> (b)) & 1)
#define DBG_DIGEST_N 256
#define DBG_DIGEST_VAL(m, c) bf2f(((const bf16*)(wsp + WS_CAT))[(size_t)(m) * DM + 768 + (c)])
#ifndef DBG_PH_HI
#define DBG_PH_HI NPHASE
#endif
#ifndef MK_MULTI
#define MK_MULTI 0
#endif
constexpr int LDS_BYTES = 151552, MISC_OFF = 131072 + 320;
#ifndef DBG_LAYERS
#define DBG_LAYERS 4
#define DBG_L0 0
#endif
constexpr int NPHASE = 3 + 7 * DBG_LAYERS;
__global__ void __launch_bounds__(512, 2) hymba_fwd(Args a) {
    extern __shared__ __attribute__((aligned(16))) unsigned char lds[];
    Ctx F0;
    Ctx& F = F0;
    F.lds = (char*)lds; F.tid = threadIdx.x; F.lane = F.tid & 63; F.wave = __builtin_amdgcn_readfirstlane(F.tid >> 6); F.G = gridDim.x; F.bid = blockIdx.x;
    F.A = nullptr; F.ws = a.ws;
    if (F.tid < 29) ((unsigned long long*)(lds + PTR_OFF))[F.tid] = F.tid < 28 ? (unsigned long long)a.in[F.tid] : (unsigned long long)a.out;
    volatile LAS unsigned* MISC = (volatile LAS unsigned*)((LAS unsigned char*)lds + MISC_OFF);
    if (F.tid < 32) MISC[F.tid] = 0u;
    __syncthreads();
    unsigned* ctl = (unsigned*)(a.ws + WS_CTL);
    XcdBarrier bar; bar.bar = ctl + CW_BAR; bar.x = 0; bar.st = nullptr;
    if (!MK_MULTI) bar = xcd_barrier_post(ctl + CW_BAR, MISC + 8);
    const int lo = a.ph_lo, hi = a.ph_hi;
    int ph = 0;
#define PH_BEGIN if (lo <= ph && ph < hi) { Ctx F = F0; unsigned long long wsl_ = (unsigned long long)F0.ws; asm volatile("" : "+v"(F.tid), "+s"(F.bid), "+s"(F.G), "+s"(wsl_)); F.ws = (unsigned char*)(__attribute__((address_space(1))) unsigned char*)wsl_; F.lane = F.tid & 63; F.wave = __builtin_amdgcn_readfirstlane(F.tid >> 6); unsigned char* const wsp = F.ws; (void)wsp;
#define PH_END   if (!MK_MULTI && ph + 1 < hi) { XcdBarrier bb = bar; asm volatile("" : "+s"(bb.bar), "+s"(bb.x)); xcd_barrier(bb); } else __syncthreads(); } ++ph;
    PG8_LAS unsigned char* glds = (PG8_LAS unsigned char*)lds;
#define XN ((bf16*)(wsp + WS_XN))
#define PROJ ((bf16*)(wsp + WS_PROJ))
#define CAT ((bf16*)(wsp + WS_CAT))
#define HB ((bf16*)(wsp + WS_HB))
    PH_BEGIN EN(0) ph_prologue(F); DUP(0) { __syncthreads(); ph_prologue(F); } PH_END
    PH_BEGIN EN(1) { ph_shw(F); ph_xs0(F, PIN(F, I_X), PIN(F, I_N1W) + DBG_L0 * DM, (const float*)(wsp + WS_MOD) + (size_t)DBG_L0 * BATCH * NADA, DM, XN, (float*)(wsp + WS_RSP), (bf16*)POUT(F)); } PH_END
    for (int l_ = 0; l_ < DBG_LAYERS; ++l_) { const int l = l_ + DBG_L0;
        #define modl ((const float*)(wsp + WS_MOD) + (size_t)l * BATCH * NADA)
        #define xsrc (l_ == 0 ? PIN(F, I_X) : (const float*)POUT(F))
        PH_BEGIN
#if defined(PROBE_GA)
            { pg8::Gemm g{XN, (const bf16*)(wsp + WS_WIN) + (size_t)l * NPROJ * DM, MTOK, NPROJ, DM}; pg8::StaticOrder S; S.init(MTOK, NPROJ, F.G, F.bid);
            pg8::EpiRoute<0> E{PROJ, NPROJ, PROJ, NPROJ, 1 << 20};
            pg8::gemm_phase<pg8::EpiRoute<0>, pg8::StaticOrder, true, true>(glds, g, S, E, F.tid); } __syncthreads();
#elif defined(PROBE_GB)
            { pg8::Gemm g{XN, (const bf16*)(wsp + WS_WIN) + (size_t)l * NPROJ * DM, MTOK, NPROJ, DM}; pg8::StaticOrder S; S.init(MTOK, NPROJ, F.G, F.bid);
            pg8::EpiRouteN<0> E{PROJ, NPROJ, (const float*)(wsp + WS_RSP), (const float*)(wsp + WS_SHW) + (size_t)l * BATCH * NSHW, glds};
            pg8::gemm_phase<pg8::EpiRouteN<0>, pg8::StaticOrder, true, true>(glds, g, S, E, F.tid); } __syncthreads();
#endif
        EN(2) { pg8::Gemm g{XN, (const bf16*)(wsp + WS_WIN) + (size_t)l * NPROJ * DM, MTOK, NPROJ, DM}; pg8::StaticOrder S; S.init(MTOK, NPROJ, F.G, F.bid);
            pg8::EpiRouteN<0> E{PROJ, NPROJ, (const float*)(wsp + WS_RSP), (const float*)(wsp + WS_SHW) + (size_t)l * BATCH * NSHW, glds};
            pg8::gemm_phase<pg8::EpiRouteN<0>, pg8::StaticOrder, true, true>(glds, g, S, E, F.tid); } PH_END
        PH_BEGIN EN(3) ph_prep(F, l); DUP(3) ph_prep(F, l); EN(4) ph_lru1(F, l); DUP(4) ph_lru1(F, l); EN(5) ph_mlstm(F, l); DUP(5) ph_mlstm(F, l); PH_END
        PH_BEGIN EN(6) { ph_carry(F); pg8::Gemm g{(const bf16*)(wsp + WS_QL), (const bf16*)(wsp + WS_WQC) + (size_t)l * 768 * 256, MTOK, 768, 256}; pg8::StaticOrder S; S.init(MTOK, 768, F.G, F.bid);
            pg8::EpiRoute<0> E{(bf16*)(wsp + WS_QABS), 512, (bf16*)(wsp + WS_QIDX), 256, 2};
            pg8::gemm_phase<pg8::EpiRoute<0>, pg8::StaticOrder, true, true>(glds, g, S, E, F.tid); } PH_END
#ifndef DSA_REP
#define DSA_REP 1
#endif
        PH_BEGIN EN(7) { for (int rep_ = 0; rep_ < DSA_REP; ++rep_) { ph_dsa(F, l); if (DSA_REP > 1) __syncthreads(); } } DUP(7) ph_dsa(F, l); EN(8) ph_lru2(F, l); DUP(8) ph_lru2(F, l); EN(9) ph_mfin(F, l); DUP(9) ph_mfin(F, l); PH_END
        PH_BEGIN EN(10) { pg8::Gemm g{CAT, (const bf16*)(wsp + WS_WO) + (size_t)l * DM * DM, MTOK, DM, DM}; pg8::StaticOrder S; S.init(MTOK, DM, F.G, F.bid);
            pg8::EpiResidXS<false> E{(const pg8::bf16_t*)POUT(F), (pg8::bf16_t*)POUT(F), modl + 2 * DM, (const float*)(wsp + WS_WP) + (size_t)(l * 2 + 1) * BATCH * DM, XN, (float*)(wsp + WS_RSP), 1};
            pg8::gemm_phase<pg8::EpiResidXS<false>, pg8::StaticOrder, true, true>(glds, g, S, E, F.tid); } PH_END
        PH_BEGIN EN(12) { pg8::Gemm g{XN, (const bf16*)(wsp + WS_W1) + (size_t)l * DFF * DM, MTOK, DFF, DM}; pg8::StaticOrder S; S.init(MTOK, DFF, F.G, F.bid);
            pg8::EpiRouteN<1> E{HB, DFF, (const float*)(wsp + WS_RSP), (const float*)(wsp + WS_SHW) + (size_t)l * BATCH * NSHW + NPROJ, glds};
            pg8::gemm_phase<pg8::EpiRouteN<1>, pg8::StaticOrder, true, true>(glds, g, S, E, F.tid); } PH_END
        PH_BEGIN EN(13) { pg8::Gemm g{HB, (const bf16*)(wsp + WS_W2) + (size_t)l * DM * DFF, MTOK, DM, DFF}; pg8::StaticOrder S; S.init(MTOK, DM, F.G, F.bid);
            const int nl = l + 1 < DEPTH ? l + 1 : l;
            const bool lastl = l_ + 1 >= DBG_LAYERS;
            pg8::EpiResidXS<true> E{(const pg8::bf16_t*)POUT(F), lastl ? (pg8::bf16_t*)XN : (pg8::bf16_t*)POUT(F), modl + 5 * DM, (const float*)(wsp + WS_WP) + (size_t)(nl * 2) * BATCH * DM, XN, (float*)(wsp + WS_RSP), lastl ? 0 : 1};
            pg8::gemm_phase<pg8::EpiResidXS<true>, pg8::StaticOrder, true, true>(glds, g, S, E, F.tid); } PH_END
    }
#ifdef DBG_DIGEST
    PH_BEGIN { const int gw = F.bid * 8 + F.wave, NGW = F.G * 8; float* o = POUT(F);
        for (int m = gw; m < MTOK; m += NGW) for (int j = 0; j < 16; ++j) { const int c = F.lane + 64 * j; float v = 0.f;
            if (c < DBG_DIGEST_N) { v = DBG_DIGEST_VAL(m, c) * 4096.0f; v = v - floorf(v); }
            o[(size_t)m * DM + c] = v; } } PH_END
#else
    PH_BEGIN EN(14) ph_finalnorm16(F, XN, PIN(F, I_FNW), POUT(F)); PH_END
#endif
}

extern "C" void kernel_launch(void* const* d_in, const int* in_sizes, int n_in, void* d_out, int out_size, void* d_ws, size_t ws_size, hipStream_t stream) {
    static int grid = 0;
    if (grid == 0) {
        if (n_in != 28 || in_sizes[0] != MTOK * DM || out_size != MTOK * DM || ws_size < WS_END) { fprintf(stderr, "kernel_launch: unexpected shapes (n_in %d, in0 %d, out %d, ws %zu)\n", n_in, n_in > 0 ? in_sizes[0] : -1, out_size, ws_size); grid = -1; return; }
        int dev = 0, cus = 0, per_cu = 0;
        if (hipGetDevice(&dev) != hipSuccess || hipDeviceGetAttribute(&cus, hipDeviceAttributeMultiprocessorCount, dev) != hipSuccess) { grid = -1; return; }
        if (hipFuncSetAttribute((const void*)hymba_fwd, hipFuncAttributeMaxDynamicSharedMemorySize, LDS_BYTES) != hipSuccess) { fprintf(stderr, "kernel_launch: hipFuncSetAttribute failed\n"); grid = -1; return; }
        if (hipOccupancyMaxActiveBlocksPerMultiprocessor(&per_cu, (const void*)hymba_fwd, 512, LDS_BYTES) != hipSuccess || per_cu < 1) { fprintf(stderr, "kernel_launch: occupancy query says %d\n", per_cu); }
        (void)hipGetLastError();
        grid = cus;
    }
    if (grid < 0) return;
    if (hipMemsetAsync((char*)d_ws + WS_CTL, 0, CTL_ZERO_BYTES, stream) != hipSuccess) return;
    Args a{};
    for (int i = 0; i < 28; ++i) a.in[i] = (const float*)d_in[i];
    a.out = (float*)d_out; a.ws = (unsigned char*)d_ws;
#if MK_MULTI
    for (int p = 0; p < NPHASE; ++p) { a.ph_lo = p; a.ph_hi = p + 1; hipLaunchKernelGGL(hymba_fwd, dim3(grid), dim3(512), LDS_BYTES, stream, a); }
#else
    a.ph_lo = 0; a.ph_hi = DBG_PH_HI; hipLaunchKernelGGL(hymba_fwd, dim3(grid), dim3(512), LDS_BYTES, stream, a);
#endif
}
#endif
```

```cpp
#ifndef HOST_EMU
#include <hip/hip_runtime.h>
#include <cstdio>
#include <cstdint>
#define DEV __device__ __forceinline__
#define LAS __attribute__((address_space(3)))
#else
#include "emu.h"
#endif

#ifndef HOST_EMU
#define SYNC() __syncthreads()
#define KEEP4(a, b, c, d) asm volatile("" :: "v"(a), "v"(b), "v"(c), "v"(d))
#define NOPACK(x) asm("" : "+v"(x))
#define LAUNDER_V(x) asm volatile("" : "+v"(x))
#define WAVE_LDS_FENCE() asm volatile("s_waitcnt lgkmcnt(0)" ::: "memory")
#define ATT_FENCE() asm volatile("" ::: "memory")
template <class T> DEV T SHFL(T v, int s) { return __shfl(v, s); }
template <class T> DEV T SHFL_XOR(T v, int m) { return __shfl_xor(v, m); }
template <class T> DEV T SHFL_UP(T v, int d) { return __shfl_up(v, d); }
template <class T> DEV T SHFL_DOWN(T v, int d) { return __shfl_down(v, d); }
typedef short bf16x8_ __attribute__((ext_vector_type(8)));
typedef float f32x4_ __attribute__((ext_vector_type(4)));
typedef short v4i16_t __attribute__((ext_vector_type(4)));
DEV f32x4_ MFMA16(bf16x8_ a, bf16x8_ b, f32x4_ c) { return __builtin_amdgcn_mfma_f32_16x16x32_bf16(a, b, c, 0, 0, 0); }
DEV v4i16_t TR16(const void* p) { return __builtin_amdgcn_ds_read_tr16_b64_v4i16((LAS v4i16_t*)(p)); }
#endif


typedef unsigned short bf16;
typedef short bf16x8 __attribute__((ext_vector_type(8)));
typedef short s16x4 __attribute__((ext_vector_type(4)));
typedef float f32x4 __attribute__((ext_vector_type(4)));
typedef unsigned u32x4 __attribute__((ext_vector_type(4)));
typedef unsigned u32x2 __attribute__((ext_vector_type(2)));

constexpr int BATCH = 16, SEQ = 4096, DM = 1024, DEPTH = 4, MTOK = BATCH * SEQ;
constexpr int NPROJ = 3072, DFF = 4096, NADA = 6 * DM;
constexpr int PC_LX = 0, PC_LY = 256, PC_MQ = 512, PC_MK = 1024, PC_MV = 1536, PC_MO = 2048, PC_AQ = 2560, PC_AKV = 2816, PC_IK = 2944, PC_IW = 2976, PC_MI = 2984, PC_MF = 2988;
constexpr float NORM_EPS = 1e-6f;

constexpr size_t MiB = 1u << 20;
constexpr size_t WS_CTL = 0, CTL_ZERO_BYTES = 1 * MiB;
constexpr size_t WS_MOD = 1 * MiB;
constexpr size_t WS_WQC = 3 * MiB;
constexpr size_t WS_WG = 5 * MiB;
constexpr size_t WS_WUVT = 6 * MiB;
constexpr size_t WS_WIN = 8 * MiB;
constexpr size_t WS_WO = 32 * MiB;
constexpr size_t WS_W1 = 40 * MiB;
constexpr size_t WS_W2 = 72 * MiB;
constexpr size_t WS_XN = 104 * MiB;
constexpr size_t WS_QL = WS_XN, WS_CKV = WS_XN + 32 * MiB, WS_QIDX = WS_XN + 48 * MiB, WS_KIDX = WS_XN + 80 * MiB, WS_WI = WS_XN + 84 * MiB, WS_GT = WS_XN + 86 * MiB;
constexpr size_t WS_CAT = 232 * MiB;
constexpr size_t WS_PROJ = 360 * MiB;
constexpr size_t WS_HB = 360 * MiB;
constexpr size_t WS_QABS = 744 * MiB;
constexpr size_t WS_HLOC = 808 * MiB, WS_CPA = 840 * MiB;
constexpr size_t WS_LSUM = 872 * MiB;
constexpr size_t WS_HM = 874 * MiB;
constexpr size_t WS_MG = 940 * MiB;
constexpr size_t WS_WP = 2 * MiB + 512 * 1024;
constexpr size_t WS_SHW = 6 * MiB + 256 * 1024;
constexpr size_t WS_RSP = 1000 * MiB;
constexpr size_t WS_CARRY = 948 * MiB;
constexpr size_t WS_SCR2 = 949 * MiB;
constexpr int NSHW = NPROJ + DFF;
constexpr size_t WS_END = 1024 * MiB;
static_assert(WS_HM + (size_t)MTOK * 512 * 2 <= WS_END && WS_HB + (size_t)MTOK * DFF * 2 <= WS_HLOC + 64 * MiB, "ws map");

constexpr int CW_TMO = 0, CW_BAR = 4096;

#ifndef HOST_EMU
typedef __bf16 hwbf2_t __attribute__((ext_vector_type(2)));
typedef float hwf2_t __attribute__((ext_vector_type(2)));
DEV unsigned f2bf(float f) { return (unsigned)__builtin_bit_cast(unsigned short, (__bf16)f); }
DEV unsigned pk2(float lo, float hi) { const hwf2_t v = {lo, hi}; return __builtin_bit_cast(unsigned, __builtin_convertvector(v, hwbf2_t)); }
#else
DEV unsigned f2bf(float f) { unsigned u = __builtin_bit_cast(unsigned, f); return (u + 0x7fffu + ((u >> 16) & 1u)) >> 16; }
DEV unsigned pk2(float lo, float hi) { return f2bf(lo) | (f2bf(hi) << 16); }
#endif
DEV float bf2f(unsigned h) { return __builtin_bit_cast(float, h << 16); }
DEV float bflo(unsigned w) { return __builtin_bit_cast(float, w << 16); }
DEV float bfhi(unsigned w) { return __builtin_bit_cast(float, w & 0xffff0000u); }
DEV float wave_sum(float v) {
#pragma unroll
    for (int o = 1; o < 64; o <<= 1) v += SHFL_XOR(v, o);
    return v;
}
#ifndef HOST_EMU
DEV float FEXP(float x) { return __expf(x); }
DEV float FEXP2(float x) { return __builtin_amdgcn_exp2f(x); }
DEV float FRCP(float x) { return __builtin_amdgcn_rcpf(x); }
DEV float FSQRT(float x) { return __builtin_amdgcn_sqrtf(x); }
DEV float RSQ(float x) { return __builtin_amdgcn_rsqf(x); }
DEV float FLOG(float x) { return __logf(x); }
#else
DEV float FEXP(float x) { return expf(x); }
DEV float FEXP2(float x) { return exp2f(x); }
DEV float FRCP(float x) { return 1.0f / x; }
DEV float FSQRT(float x) { return sqrtf(x); }
DEV float RSQ(float x) { return 1.0f / sqrtf(x); }
DEV float FLOG(float x) { return logf(x); }
#endif
#ifndef HOST_EMU
DEV int UNI(int x) { return __builtin_amdgcn_readfirstlane(x); }
#else
DEV int UNI(int x) { return x; }
#endif
#ifndef HOST_EMU
#define GAS __attribute__((address_space(1)))
DEV const GAS char* UNIP(const void* p) { const unsigned long long v = (unsigned long long)p; const unsigned lo = __builtin_amdgcn_readfirstlane((unsigned)v), hi = __builtin_amdgcn_readfirstlane((unsigned)(v >> 32));
    return (const GAS char*)(((unsigned long long)hi << 32) | lo); }
#else
#define GAS
DEV const char* UNIP(const void* p) { return (const char*)p; }
#endif
DEV float RELU(float x) { const int b = __builtin_bit_cast(int, x); return __builtin_bit_cast(float, b > 0 ? b : 0); }
DEV float sigmoidf_(float z) { return 1.0f / (1.0f + expf(-z)); }
DEV float fsigmoid(float z) { return FRCP(1.0f + FEXP(-z)); }
DEV float one_minus_exp(float x) {
    const float s = -x * (1.0f + x * (0.5f + x * (0.16666667f + x * 0.041666668f)));
    return x > -0.05f ? s : 1.0f - FEXP(x);
}

struct Args { const float* in[28]; float* out; unsigned char* ws; int ph_lo, ph_hi; };
struct Ctx {
    char* lds; int tid, lane, wave, G, bid;
    const Args* A;
    unsigned char* ws;
};

constexpr int PTR_OFF = 131072 + 512;
#ifndef HOST_EMU
DEV const float* PIN(const Ctx& F, int i) { const unsigned long long v = ((const unsigned long long*)(F.lds + PTR_OFF))[i];
    const unsigned lo = __builtin_amdgcn_readfirstlane((unsigned)v), hi = __builtin_amdgcn_readfirstlane((unsigned)(v >> 32)); return (const float*)(const __attribute__((address_space(1))) float*)(((unsigned long long)hi << 32) | lo); }
DEV float* POUT(const Ctx& F) { return (float*)PIN(F, 28); }
#else
DEV const float* PIN(const Ctx& F, int i) { return F.A->in[i]; }
DEV float* POUT(const Ctx& F) { return POUT(F); }
#endif
enum { I_X = 0, I_C, I_WIN, I_CONVW, I_CONVB, I_WA, I_BA, I_WX, I_BX, I_LAM, I_BI, I_BF, I_WQUP, I_WQIDX, I_WUK, I_WUV, I_QNW, I_KVNW, I_RELB, I_GNW, I_WO, I_WADA, I_BADA, I_N1W, I_N2W, I_W1, I_W2, I_FNW };

DEV int win_srccol(int n) {
    if (n < 2560) return n;
    if (n < PC_AKV) return 2568 + (n - PC_AQ);
    if (n < PC_IK) return 2824 + (n - PC_AKV);
    if (n < PC_IW) return 2952 + (n - PC_IK);
    if (n < PC_MI) return 2984 + (n - PC_IW);
    if (n < PC_MF) return 2560 + (n - PC_MI);
    if (n < 2992) return 2564 + (n - PC_MF);
    return -1;
}
template <bool MAPPED>
DEV void p0_transpose_item(const float* W, int K, int N, int NT, bf16* WT, float* scr, int item, int lane) {
    const int nblk = NT / 32, kb = item / nblk, nb = item % nblk, k0 = 64 * kb, n0 = 32 * nb;
    int sc = n0 + (lane & 31); if (MAPPED) sc = win_srccol(sc);
#pragma unroll 8
    for (int i = 0; i < 32; ++i) { const int kk = 2 * i + (lane >> 5); const float v = W[(size_t)(k0 + kk) * N + (sc >= 0 ? sc : 0)]; scr[kk * 33 + (lane & 31)] = sc >= 0 ? v : 0.f; }
    WAVE_LDS_FENCE();
    const int c = lane & 7;
#pragma unroll
    for (int j = 0; j < 4; ++j) { const int n = (lane >> 3) + 8 * j; const float* s = scr + (8 * c) * 33 + n;
        u32x4 o; o.x = pk2(s[0 * 33], s[1 * 33]); o.y = pk2(s[2 * 33], s[3 * 33]); o.z = pk2(s[4 * 33], s[5 * 33]); o.w = pk2(s[6 * 33], s[7 * 33]);
        *(u32x4*)(WT + (size_t)(n0 + n) * K + k0 + 8 * c) = o; }
    WAVE_LDS_FENCE();
}

DEV void ph_prologue(const Ctx& F) {
    const int gt = F.bid * 512 + F.tid, NGT = F.G * 512;
    float* CACT = (float*)F.lds;
    for (int i = F.tid; i < BATCH * DM; i += 512) { const float cv = PIN(F, I_C)[i]; CACT[i] = cv * sigmoidf_(cv); }
    SYNC();
    for (int e = gt; e < DEPTH * NADA * 4; e += NGT) {
        const int j = e % NADA, bq = (e / NADA) & 3, l = e / (NADA * 4);
        const float* w = PIN(F, I_WADA) + (size_t)l * DM * NADA + j;
        const float* c = CACT + bq * 4 * DM;
        float a0 = 0.f, a1 = 0.f, a2 = 0.f, a3 = 0.f;
#pragma unroll 8
        for (int k = 0; k < DM; k += 4) {
            const float w0 = w[(size_t)k * NADA], w1 = w[(size_t)(k + 1) * NADA], w2 = w[(size_t)(k + 2) * NADA], w3 = w[(size_t)(k + 3) * NADA];
            const f32x4 c0 = *(const f32x4*)(c + k), c1 = *(const f32x4*)(c + DM + k), c2 = *(const f32x4*)(c + 2 * DM + k), c3 = *(const f32x4*)(c + 3 * DM + k);
            a0 += (c0.x * w0 + c0.y * w1) + (c0.z * w2 + c0.w * w3); a1 += (c1.x * w0 + c1.y * w1) + (c1.z * w2 + c1.w * w3);
            a2 += (c2.x * w0 + c2.y * w1) + (c2.z * w2 + c2.w * w3); a3 += (c3.x * w0 + c3.y * w1) + (c3.z * w2 + c3.w * w3); }
        const float bb = PIN(F, I_BADA)[(size_t)l * NADA + j];
        float* mo = (float*)(F.ws + WS_MOD) + ((size_t)l * BATCH + bq * 4) * NADA + j;
        mo[0] = a0 + bb; mo[NADA] = a1 + bb; mo[2 * NADA] = a2 + bb; mo[3 * NADA] = a3 + bb;
    }
    for (int e = gt; e < DEPTH * 2 * 4 * 64 * 64; e += NGT) {
        const int i = e & 63, j = (e >> 6) & 63, blk = (e >> 12) & 3, g = (e >> 14) & 1, l = e >> 15;
        const float* src = PIN(F, g ? I_WX : I_WA) + (((size_t)l * 4 + blk) * 64 + i) * 64 + j;
        ((bf16*)(F.ws + WS_WG))[e] = (bf16)f2bf(*src);
    }
    for (int e = gt; e < DEPTH * 4 * 64 * 128; e += NGT) {
        const int r = e & 127, d = (e >> 7) & 63, h = (e >> 13) & 3, l = e >> 15;
        ((bf16*)(F.ws + WS_WUVT))[e] = (bf16)f2bf(PIN(F, I_WUV)[(((size_t)l * 128 + r) * 4 + h) * 64 + d]);
    }
    for (int e = gt; e < DEPTH * 768 * 256; e += NGT) {
        const int r = e & 255, n = (e >> 8) % 768, l = e / (768 * 256);
        float v;
        if (n < 512) { const int h = n >> 7, c = n & 127; const f32x4* q = (const f32x4*)(PIN(F, I_WQUP) + ((size_t)l * 256 + r) * 256 + h * 64); const f32x4* k = (const f32x4*)(PIN(F, I_WUK) + ((size_t)l * 128 + c) * 256 + h * 64);
            float s = 0.f;
#pragma unroll
            for (int d = 0; d < 16; ++d) { const f32x4 a = q[d], bq4 = k[d]; s += (a.x * bq4.x + a.y * bq4.y) + (a.z * bq4.z + a.w * bq4.w); }
            v = s * (0.125f * 1.4426950408889634f); }
        else v = PIN(F, I_WQIDX)[((size_t)l * 256 + r) * 256 + (n - 512)] * 0.17677669529663687f;
        ((bf16*)(F.ws + WS_WQC))[e] = (bf16)f2bf(v);
    }
    SYNC();
    float* scr = (float*)(F.lds + F.wave * 16384);
    const int gw = F.bid * 8 + F.wave, NGW = F.G * 8;
    constexpr int I_IN = (DM / 64) * (NPROJ / 32), I_O = (DM / 64) * (DM / 32), I_1 = (DM / 64) * (DFF / 32), I_2 = (DFF / 64) * (DM / 32);
    constexpr int PER_L = I_IN + I_O + I_1 + I_2;
    for (int it = gw; it < DEPTH * PER_L; it += NGW) {
        const int l = it / PER_L; int r = it % PER_L;
        if (r < I_IN) { p0_transpose_item<true>(PIN(F, I_WIN) + (size_t)l * DM * 2992, DM, 2992, NPROJ, (bf16*)(F.ws + WS_WIN) + (size_t)l * NPROJ * DM, scr, r, F.lane); continue; } r -= I_IN;
        if (r < I_O) { p0_transpose_item<false>(PIN(F, I_WO) + (size_t)l * DM * DM, DM, DM, DM, (bf16*)(F.ws + WS_WO) + (size_t)l * DM * DM, scr, r, F.lane); continue; } r -= I_O;
        if (r < I_1) { p0_transpose_item<false>(PIN(F, I_W1) + (size_t)l * DM * DFF, DM, DFF, DFF, (bf16*)(F.ws + WS_W1) + (size_t)l * DFF * DM, scr, r, F.lane); continue; } r -= I_1;
        p0_transpose_item<false>(PIN(F, I_W2) + (size_t)l * DFF * DM, DFF, DM, DM, (bf16*)(F.ws + WS_W2) + (size_t)l * DM * DFF, scr, r, F.lane);
    }
}

DEV void ph_xs0(const Ctx& F, const float* xsrc, const float* nw, const float* modl, int sc_off, bf16* XS, float* RSP, bf16* X16) {
    const int gw = F.bid * 8 + F.wave, NGW = F.G * 8;
    f32x4 wv[4];
#pragma unroll
    for (int j = 0; j < 4; ++j) wv[j] = *(const f32x4*)(nw + 4 * F.lane + 256 * j);
    f32x4 v[2][4], vn[2][4];
#pragma unroll
    for (int q = 0; q < 2; ++q) { const int m = gw + q * NGW; const f32x4* xr = (const f32x4*)(xsrc + (size_t)(m < MTOK ? m : 0) * DM) + F.lane;
#pragma unroll
        for (int j = 0; j < 4; ++j) v[q][j] = xr[64 * j]; }
    for (int m0 = gw; m0 < MTOK; m0 += 2 * NGW) {
        f32x4 sc[2][4];
#pragma unroll
        for (int q = 0; q < 2; ++q) { const int m = m0 + q * NGW; const float* mb = modl + (size_t)((m < MTOK ? m : 0) >> 12) * NADA + 4 * F.lane;
#pragma unroll
            for (int j = 0; j < 4; ++j) sc[q][j] = *(const f32x4*)(mb + sc_off + 256 * j); }
#pragma unroll
        for (int q = 0; q < 2; ++q) { const int m = m0 + (2 + q) * NGW; const f32x4* xr = (const f32x4*)(xsrc + (size_t)(m < MTOK ? m : 0) * DM) + F.lane;
#pragma unroll
            for (int j = 0; j < 4; ++j) vn[q][j] = xr[64 * j]; }
        float s[2];
#pragma unroll
        for (int q = 0; q < 2; ++q) { float a = 0.f;
#pragma unroll
            for (int j = 0; j < 4; ++j) a += (v[q][j].x * v[q][j].x + v[q][j].y * v[q][j].y) + (v[q][j].z * v[q][j].z + v[q][j].w * v[q][j].w);
            s[q] = a; }
#pragma unroll
        for (int o = 1; o < 64; o <<= 1) { s[0] += SHFL_XOR(s[0], o); s[1] += SHFL_XOR(s[1], o); }
#pragma unroll
        for (int q = 0; q < 2; ++q) { const int m = m0 + q * NGW; if (m >= MTOK) break;
            if (F.lane < 16) RSP[(size_t)m * 16 + F.lane] = F.lane == 0 ? s[q] : 0.f;
            u32x2* o8 = (u32x2*)(XS + (size_t)m * DM) + F.lane; u32x2* x8 = (u32x2*)(X16 + (size_t)m * DM) + F.lane;
#pragma unroll
            for (int j = 0; j < 4; ++j) { const f32x4 y = v[q][j] * (wv[j] * (1.0f + sc[q][j]));
                u32x2 p; p.x = pk2(y.x, y.y); p.y = pk2(y.z, y.w); o8[64 * j] = p;
                u32x2 c; c.x = pk2(v[q][j].x, v[q][j].y); c.y = pk2(v[q][j].z, v[q][j].w); x8[64 * j] = c; } }
#pragma unroll
        for (int q = 0; q < 2; ++q)
#pragma unroll
            for (int j = 0; j < 4; ++j) v[q][j] = vn[q][j];
    }
}
DEV void ph_shw(const Ctx& F) {
    const int gt = F.bid * 512 + F.tid, NGT = F.G * 512;
    for (int e = gt; e < DEPTH * 2 * BATCH * (DM / 4); e += NGT) {
        const int c4 = e & 255, b = (e >> 8) & 15, w = (e >> 12) & 1, l = e >> 13;
        const f32x4 nwv = *(const f32x4*)(PIN(F, w ? I_N2W : I_N1W) + l * DM + 4 * c4);
        const f32x4 sc = *(const f32x4*)((const float*)(F.ws + WS_MOD) + ((size_t)l * BATCH + b) * NADA + (w ? 4 * DM : DM) + 4 * c4);
        ((f32x4*)(F.ws + WS_WP))[e] = nwv * (1.0f + sc);
    }
    const int gw = F.bid * 8 + F.wave, NGW = F.G * 8, i16 = F.lane & 15, kq = 8 * (F.lane >> 4);
    for (int it = gw; it < DEPTH * (NSHW / 16); it += NGW) {
        const int l = it / (NSHW / 16), n0 = (it % (NSHW / 16)) * 16;
        const bool mlp = n0 >= NPROJ;
        const bf16* Wr = mlp ? (const bf16*)(F.ws + WS_W1) + ((size_t)l * DFF + (n0 - NPROJ) + i16) * DM : (const bf16*)(F.ws + WS_WIN) + ((size_t)l * NPROJ + n0 + i16) * DM;
        const float* sh = (const float*)(F.ws + WS_MOD) + ((size_t)l * BATCH + i16) * NADA + (mlp ? 3 * DM : 0);
        f32x4 acc0 = {0.f, 0.f, 0.f, 0.f}, acc1 = {0.f, 0.f, 0.f, 0.f};
#pragma unroll 4
        for (int s = 0; s < DM / 32; ++s) {
            const bf16x8 B = *(const bf16x8*)(Wr + 32 * s + kq);
            const f32x4 a0 = *(const f32x4*)(sh + 32 * s + kq), a1 = *(const f32x4*)(sh + 32 * s + kq + 4);
            bf16x8 Ah, Al;
#pragma unroll
            for (int j = 0; j < 8; ++j) { const float a = j < 4 ? a0[j] : a1[j - 4]; const unsigned h = f2bf(a); Ah[j] = (short)h; Al[j] = (short)f2bf(a - bf2f(h)); }
            acc0 = MFMA16(Ah, B, acc0); acc1 = MFMA16(Al, B, acc1);
        }
        float* o = (float*)(F.ws + WS_SHW) + ((size_t)l * BATCH + 4 * (F.lane >> 4)) * NSHW + n0 + i16;
#pragma unroll
        for (int r = 0; r < 4; ++r) o[(size_t)r * NSHW] = acc0[r] + acc1[r];
    }
}
DEV void ph_normmod(const Ctx& F, const float* xsrc, const float* nw, const float* modl, int sh_off, int sc_off, bf16* XN) {
    const int gw = F.bid * 8 + F.wave, NGW = F.G * 8;
    f32x4 wv[4];
#pragma unroll
    for (int j = 0; j < 4; ++j) wv[j] = *(const f32x4*)(nw + 4 * F.lane + 256 * j);
    f32x4 v[2][4], vn[2][4];
#pragma unroll
    for (int q = 0; q < 2; ++q) { const int m = gw + q * NGW; const f32x4* xr = (const f32x4*)(xsrc + (size_t)(m < MTOK ? m : 0) * DM) + F.lane;
#pragma unroll
        for (int j = 0; j < 4; ++j) v[q][j] = xr[64 * j]; }
    for (int m0 = gw; m0 < MTOK; m0 += 2 * NGW) {
        f32x4 sc[2][4], sh[2][4];
#pragma unroll
        for (int q = 0; q < 2; ++q) { const int m = m0 + q * NGW; const float* mb = modl + (size_t)((m < MTOK ? m : 0) >> 12) * NADA + 4 * F.lane;
#pragma unroll
            for (int j = 0; j < 4; ++j) { sc[q][j] = *(const f32x4*)(mb + sc_off + 256 * j); sh[q][j] = *(const f32x4*)(mb + sh_off + 256 * j); } }
#pragma unroll
        for (int q = 0; q < 2; ++q) { const int m = m0 + (2 + q) * NGW; const f32x4* xr = (const f32x4*)(xsrc + (size_t)(m < MTOK ? m : 0) * DM) + F.lane;
#pragma unroll
            for (int j = 0; j < 4; ++j) vn[q][j] = xr[64 * j]; }
        float s[2];
#pragma unroll
        for (int q = 0; q < 2; ++q) { float a = 0.f;
#pragma unroll
            for (int j = 0; j < 4; ++j) a += (v[q][j].x * v[q][j].x + v[q][j].y * v[q][j].y) + (v[q][j].z * v[q][j].z + v[q][j].w * v[q][j].w);
            s[q] = a; }
#pragma unroll
        for (int o = 1; o < 64; o <<= 1) { s[0] += SHFL_XOR(s[0], o); s[1] += SHFL_XOR(s[1], o); }
#pragma unroll
        for (int q = 0; q < 2; ++q) { const int m = m0 + q * NGW; if (m >= MTOK) break;
            const float rs = RSQ(s[q] * (1.0f / DM) + NORM_EPS);
            u32x2* o8 = (u32x2*)(XN + (size_t)m * DM) + F.lane;
#pragma unroll
            for (int j = 0; j < 4; ++j) { const f32x4 y = v[q][j] * rs * wv[j] * (1.0f + sc[q][j]) + sh[q][j];
                u32x2 p; p.x = pk2(y.x, y.y); p.y = pk2(y.z, y.w); o8[64 * j] = p; } }
#pragma unroll
        for (int q = 0; q < 2; ++q)
#pragma unroll
            for (int j = 0; j < 4; ++j) v[q][j] = vn[q][j];
    }
}
DEV void ph_finalnorm(const Ctx& F, const float* xsrc, const float* nw, float* out) {
    const int gw = F.bid * 8 + F.wave, NGW = F.G * 8;
    f32x4 wv[4];
#pragma unroll
    for (int j = 0; j < 4; ++j) wv[j] = *(const f32x4*)(nw + 4 * F.lane + 256 * j);
    f32x4 v[2][4], vn[2][4];
#pragma unroll
    for (int q = 0; q < 2; ++q) { const int m = gw + q * NGW; const f32x4* xr = (const f32x4*)(xsrc + (size_t)(m < MTOK ? m : 0) * DM) + F.lane;
#pragma unroll
        for (int j = 0; j < 4; ++j) v[q][j] = xr[64 * j]; }
    for (int m0 = gw; m0 < MTOK; m0 += 2 * NGW) {
#pragma unroll
        for (int q = 0; q < 2; ++q) { const int m = m0 + (2 + q) * NGW; const f32x4* xr = (const f32x4*)(xsrc + (size_t)(m < MTOK ? m : 0) * DM) + F.lane;
#pragma unroll
            for (int j = 0; j < 4; ++j) vn[q][j] = xr[64 * j]; }
        float s[2];
#pragma unroll
        for (int q = 0; q < 2; ++q) { float a = 0.f;
#pragma unroll
            for (int j = 0; j < 4; ++j) a += (v[q][j].x * v[q][j].x + v[q][j].y * v[q][j].y) + (v[q][j].z * v[q][j].z + v[q][j].w * v[q][j].w);
            s[q] = a; }
#pragma unroll
        for (int o = 1; o < 64; o <<= 1) { s[0] += SHFL_XOR(s[0], o); s[1] += SHFL_XOR(s[1], o); }
#pragma unroll
        for (int q = 0; q < 2; ++q) { const int m = m0 + q * NGW; if (m >= MTOK) break;
            const float rs = RSQ(s[q] * (1.0f / DM) + NORM_EPS);
            f32x4* o = (f32x4*)(out + (size_t)m * DM) + F.lane;
#pragma unroll
            for (int j = 0; j < 4; ++j) o[64 * j] = v[q][j] * rs * wv[j]; }
#pragma unroll
        for (int q = 0; q < 2; ++q)
#pragma unroll
            for (int j = 0; j < 4; ++j) v[q][j] = vn[q][j];
    }
}
DEV void ph_finalnorm16(const Ctx& F, const bf16* x16, const float* nw, float* out) {
    const int gw = F.bid * 8 + F.wave, NGW = F.G * 8;
    f32x4 wv[2][2];
#pragma unroll
    for (int j = 0; j < 2; ++j) { wv[j][0] = *(const f32x4*)(nw + 8 * F.lane + 512 * j); wv[j][1] = *(const f32x4*)(nw + 8 * F.lane + 512 * j + 4); }
    u32x4 v[4][2], vn[4][2];
#pragma unroll
    for (int q = 0; q < 4; ++q) { const int m = gw + q * NGW; const bf16* xr = x16 + (size_t)(m < MTOK ? m : 0) * DM + 8 * F.lane;
        v[q][0] = *(const u32x4*)xr; v[q][1] = *(const u32x4*)(xr + 512); }
    for (int m0 = gw; m0 < MTOK; m0 += 4 * NGW) {
#pragma unroll
        for (int q = 0; q < 4; ++q) { const int m = m0 + (4 + q) * NGW; const bf16* xr = x16 + (size_t)(m < MTOK ? m : 0) * DM + 8 * F.lane;
            vn[q][0] = *(const u32x4*)xr; vn[q][1] = *(const u32x4*)(xr + 512); }
        float s[4];
#pragma unroll
        for (int q = 0; q < 4; ++q) { float a = 0.f;
#pragma unroll
            for (int j = 0; j < 2; ++j) { const u32x4 r = v[q][j];
                a += ((bflo(r.x) * bflo(r.x) + bfhi(r.x) * bfhi(r.x)) + (bflo(r.y) * bflo(r.y) + bfhi(r.y) * bfhi(r.y))) + ((bflo(r.z) * bflo(r.z) + bfhi(r.z) * bfhi(r.z)) + (bflo(r.w) * bflo(r.w) + bfhi(r.w) * bfhi(r.w))); }
            s[q] = a; }
#pragma unroll
        for (int o = 1; o < 64; o <<= 1) {
#pragma unroll
            for (int q = 0; q < 4; ++q) s[q] += SHFL_XOR(s[q], o); }
#pragma unroll
        for (int q = 0; q < 4; ++q) { const int m = m0 + q * NGW; if (m >= MTOK) break;
            const float rs = RSQ(s[q] * (1.0f / DM) + NORM_EPS);
            float* o = out + (size_t)m * DM + 8 * F.lane;
#pragma unroll
            for (int j = 0; j < 2; ++j) { const u32x4 r = v[q][j];
                *(f32x4*)(o + 512 * j) = (f32x4){bflo(r.x), bfhi(r.x), bflo(r.y), bfhi(r.y)} * rs * wv[j][0];
                *(f32x4*)(o + 512 * j + 4) = (f32x4){bflo(r.z), bfhi(r.z), bflo(r.w), bfhi(r.w)} * rs * wv[j][1]; } }
#pragma unroll
        for (int q = 0; q < 4; ++q) { v[q][0] = vn[q][0]; v[q][1] = vn[q][1]; }
    }
}
DEV void ph_zero_cat(const Ctx& F, int c0, int nq) {
    const int gw = F.bid * 8 + F.wave, NGW = F.G * 8;
    bf16* CAT = (bf16*)(F.ws + WS_CAT);
    for (int m = gw; m < MTOK; m += NGW) for (int q = 0; q < nq; ++q) *(u32x2*)(CAT + (size_t)m * DM + c0 + 256 * q + 4 * F.lane) = (u32x2){0u, 0u};
}
DEV float softcap15(float z) { return 15.0f * tanhf(z * (1.0f / 15.0f)); }
DEV float logsigmoidf_(float x) { return x >= 0.f ? -log1pf(expf(-x)) : x - log1pf(expf(x)); }
DEV void ph_prep(const Ctx& F, int l) {
    const int gw = F.bid * 8 + F.wave, NGW = F.G * 8, lane = F.lane;
    const bf16* PROJ = (const bf16*)(F.ws + WS_PROJ);
    bf16* QL = (bf16*)(F.ws + WS_QL); bf16* CKV = (bf16*)(F.ws + WS_CKV); bf16* KIDX = (bf16*)(F.ws + WS_KIDX);
    float* WI = (float*)(F.ws + WS_WI);
    const f32x4 qn = *(const f32x4*)(PIN(F, I_QNW) + l * 256 + 4 * lane);
    const float kn0 = PIN(F, I_KVNW)[l * 128 + 2 * lane], kn1 = PIN(F, I_KVNW)[l * 128 + 2 * lane + 1];
    u32x2 ra4[4], ran[4]; unsigned rk4[4], rx4[4], rkn[4], rxn[4];
#define PREP_LOAD(RA, RK, RX, M0) do { _Pragma("unroll") for (int q = 0; q < 4; ++q) { const int mm = (M0) + q * NGW; const bf16* pr = PROJ + (size_t)(mm < MTOK ? mm : 0) * NPROJ; \
            RA[q] = *(const u32x2*)(pr + PC_AQ + 4 * lane); RK[q] = *(const unsigned*)(pr + PC_AKV + 2 * lane); \
            RX[q] = lane < 16 ? *(const unsigned*)(pr + PC_IK + 2 * lane) : (lane < 24 ? (unsigned)pr[PC_IW + (lane - 16)] : 0u); } } while (0)
    PREP_LOAD(ra4, rk4, rx4, gw);
    for (int m0 = gw; m0 < MTOK; m0 += 4 * NGW) {
        PREP_LOAD(ran, rkn, rxn, m0 + 4 * NGW);
#pragma unroll
        for (int q = 0; q < 4; ++q) { const int m = m0 + q * NGW; if (m >= MTOK) break;
            const u32x2 ra = ra4[q]; const unsigned rk = rk4[q];
            const float a0 = bflo(ra.x), a1 = bfhi(ra.x), a2 = bflo(ra.y), a3 = bfhi(ra.y);
            const float k0 = bflo(rk), k1 = bfhi(rk);
            const float sq = wave_sum((a0 * a0 + a1 * a1) + (a2 * a2 + a3 * a3)), sk = wave_sum(k0 * k0 + k1 * k1);
            const float rq = RSQ(sq * (1.0f / 256.0f) + NORM_EPS), rk2 = RSQ(sk * (1.0f / 128.0f) + NORM_EPS);
            u32x2 oq; oq.x = pk2(a0 * rq * qn.x, a1 * rq * qn.y); oq.y = pk2(a2 * rq * qn.z, a3 * rq * qn.w);
            *(u32x2*)(QL + (size_t)m * 256 + 4 * lane) = oq;
            *(unsigned*)(CKV + (size_t)m * 128 + 2 * lane) = pk2(k0 * rk2 * kn0, k1 * rk2 * kn1);
            if (lane < 16) *(unsigned*)(KIDX + (size_t)m * 32 + 2 * lane) = rx4[q];
            else if (lane < 24) WI[(size_t)m * 8 + (lane - 16)] = bf2f(rx4[q]); }
#pragma unroll
        for (int q = 0; q < 4; ++q) { ra4[q] = ran[q]; rk4[q] = rkn[q]; rx4[q] = rxn[q]; }
    }
#undef PREP_LOAD
}

constexpr int XB_STRIDE = 264;
DEV void ph_lru1(const Ctx& F, int l) {
    const int tid = F.tid, lane = F.lane, w = F.wave, i16 = lane & 15, g = lane >> 4;
    bf16* XB = (bf16*)F.lds;
    float* XF = (float*)(F.lds + 64 * XB_STRIDE * 2);
    const bf16* PROJ = (const bf16*)(F.ws + WS_PROJ);
    bf16* HLOC = (bf16*)(F.ws + WS_HLOC); bf16* CPA = (bf16*)(F.ws + WS_CPA); float* LSUM = (float*)(F.ws + WS_LSUM);
    const int blk = w & 3, nh = w >> 2;
    const bf16* WG = (const bf16*)(F.ws + WS_WG) + (size_t)l * 2 * 4 * 4096;
    bf16x8 Bf[2][2][2];
#pragma unroll
    for (int gg = 0; gg < 2; ++gg)
#pragma unroll
        for (int nt = 0; nt < 2; ++nt)
#pragma unroll
            for (int ks = 0; ks < 2; ++ks) Bf[gg][nt][ks] = *(const bf16x8*)(WG + ((size_t)(gg * 4 + blk) * 64 + nh * 32 + 2 * i16 + nt) * 64 + ks * 32 + 8 * g);
    float ba[2], bx[2], sp[2];
#pragma unroll
    for (int nt = 0; nt < 2; ++nt) { const int ch = blk * 64 + nh * 32 + 2 * i16 + nt;
        ba[nt] = PIN(F, I_BA)[l * 256 + ch]; bx[nt] = PIN(F, I_BX)[l * 256 + ch];
        const float lam = PIN(F, I_LAM)[l * 256 + ch]; sp[nt] = lam > 0.f ? log1pf(expf(-lam)) : -lam + log1pf(expf(lam)); }
    const int ch2 = tid & 127, tg = tid >> 7;
    float cw[4][2], cb[2];
#pragma unroll
    for (int j = 0; j < 4; ++j) { cw[j][0] = PIN(F, I_CONVW)[(l * 4 + j) * 256 + 2 * ch2]; cw[j][1] = PIN(F, I_CONVW)[(l * 4 + j) * 256 + 2 * ch2 + 1]; }
    cb[0] = PIN(F, I_CONVB)[l * 256 + 2 * ch2]; cb[1] = PIN(F, I_CONVB)[l * 256 + 2 * ch2 + 1];

    for (int u = F.bid; u < BATCH * 64; u += F.G) {
        const int b = u >> 6, c = u & 63, t0 = c * 64; const size_t m0 = (size_t)b * SEQ + t0;
        {
            const int tl0 = tg * 16;
            unsigned rv[19];
#pragma unroll
            for (int j = 0; j < 3; ++j) { const int t = t0 + tl0 - 3 + j; rv[j] = t >= 0 ? *(const unsigned*)(PROJ + ((size_t)b * SEQ + t) * NPROJ + PC_LX + 2 * ch2) : 0u; }
#pragma unroll
            for (int tt = 0; tt < 16; ++tt) rv[3 + tt] = *(const unsigned*)(PROJ + (m0 + tl0 + tt) * NPROJ + PC_LX + 2 * ch2);
#pragma unroll
            for (int tt = 0; tt < 16; ++tt) { const int tl = tl0 + tt;
                const float x0 = cw[0][0] * bflo(rv[tt]) + cw[1][0] * bflo(rv[tt + 1]) + cw[2][0] * bflo(rv[tt + 2]) + cw[3][0] * bflo(rv[tt + 3]) + cb[0];
                const float x1 = cw[0][1] * bfhi(rv[tt]) + cw[1][1] * bfhi(rv[tt + 1]) + cw[2][1] * bfhi(rv[tt + 2]) + cw[3][1] * bfhi(rv[tt + 3]) + cb[1];
                *(unsigned*)(XB + tl * XB_STRIDE + 2 * ch2) = pk2(x0, x1);
                XF[tl * 256 + 2 * ch2] = x0; XF[tl * 256 + 2 * ch2 + 1] = x1; }
        }
        SYNC();
        float CA[2] = {1.f, 1.f}, CU[2] = {0.f, 0.f};
#pragma unroll 1
        for (int m = 0; m < 4; ++m) {
            f32x4 acc[2][2];
#pragma unroll
            for (int gg = 0; gg < 2; ++gg)
#pragma unroll
                for (int nt = 0; nt < 2; ++nt) acc[gg][nt] = (f32x4){0.f, 0.f, 0.f, 0.f};
#pragma unroll
            for (int ks = 0; ks < 2; ++ks) { const bf16x8 A = *(const bf16x8*)(XB + (m * 16 + i16) * XB_STRIDE + blk * 64 + ks * 32 + 8 * g);
#pragma unroll
                for (int gg = 0; gg < 2; ++gg)
#pragma unroll
                    for (int nt = 0; nt < 2; ++nt) acc[gg][nt] = MFMA16(A, Bf[gg][nt][ks], acc[gg][nt]); }
            float HL[2][4], CP[2][4];
            const int chb = blk * 64 + nh * 32 + 2 * i16;
            float xf[4][2];
#pragma unroll
            for (int r = 0; r < 4; ++r) { const float* xp = XF + (m * 16 + 4 * g + r) * 256 + chb; xf[r][0] = xp[0]; xf[r][1] = xp[1]; }
#pragma unroll
            for (int nt = 0; nt < 2; ++nt) {
                float P[4], H[4]; float pa = 1.f, hu = 0.f;
#pragma unroll
                for (int r = 0; r < 4; ++r) {
                    const float rg = fsigmoid(acc[0][nt][r] + ba[nt]), gi = fsigmoid(acc[1][nt][r] + bx[nt]);
                    const float la = -8.0f * rg * sp[nt], a = FEXP(la), uu = FSQRT((1.0f - a) * (1.0f + a)) * (gi * xf[r][nt]);
                    pa = a * pa; hu = a * hu + uu; P[r] = pa; H[r] = hu;
                    }
                float EA = 1.f, EU = 0.f, TA = 1.f, TU = 0.f;
#pragma unroll
                for (int gg = 0; gg < 4; ++gg) { const float ta = SHFL(pa, i16 + 16 * gg), tu = SHFL(hu, i16 + 16 * gg);
                    if (gg < g) { EU = ta * EU + tu; EA = ta * EA; }
                    TU = ta * TU + tu; TA = ta * TA; }
                const float XA = EA * CA[nt], XU = EA * CU[nt] + EU;
#pragma unroll
                for (int r = 0; r < 4; ++r) { HL[nt][r] = P[r] * XU + H[r]; CP[nt][r] = P[r] * XA; }
                CU[nt] = TA * CU[nt] + TU; CA[nt] = TA * CA[nt];
            }
#pragma unroll
            for (int r = 0; r < 4; ++r) { const size_t o = (m0 + m * 16 + 4 * g + r) * 256 + chb;
                *(unsigned*)(HLOC + o) = pk2(HL[0][r], HL[1][r]); *(unsigned*)(CPA + o) = pk2(CP[0][r], CP[1][r]); }
        }
        if (g == 0) {
#pragma unroll
            for (int nt = 0; nt < 2; ++nt) { const int ch = blk * 64 + nh * 32 + 2 * i16 + nt;
                LSUM[((size_t)b * 64 + c) * 256 + ch] = CA[nt]; LSUM[(size_t)BATCH * 64 * 256 + ((size_t)b * 64 + c) * 256 + ch] = CU[nt]; }
        }
        SYNC();
    }
}

DEV float gelu_tanh(float x) { const float z = 0.7978845608028654f * (x + 0.044715f * x * x * x); return x * FRCP(1.0f + FEXP(-2.0f * z)); }
DEV void ph_carry(const Ctx& F) {
    if (F.wave != 0) return;
    const float* LSUM = (const float*)(F.ws + WS_LSUM); float* CARRY = (float*)(F.ws + WS_CARRY);
    const int seg = F.lane & 3;
    for (int chain = F.bid * 16 + (F.lane >> 2); chain < BATCH * 256; chain += F.G * 16) {
        const int b = chain >> 8, ch = chain & 255; const size_t o0 = ((size_t)b * 64 + seg * 16) * 256 + ch;
        float a[16], hb[16];
#pragma unroll
        for (int i = 0; i < 16; ++i) { a[i] = LSUM[o0 + (size_t)i * 256]; hb[i] = LSUM[(size_t)BATCH * 64 * 256 + o0 + (size_t)i * 256]; }
        float hp[16], ap[16], hl = 0.f, al = 1.f;
#pragma unroll
        for (int i = 0; i < 16; ++i) { hp[i] = hl; ap[i] = al; hl = a[i] * hl + hb[i]; al = a[i] * al; }
        float cin = 0.f;
#pragma unroll
        for (int s2 = 0; s2 < 3; ++s2) { const float as = SHFL(al, (F.lane & ~3) + s2), hs = SHFL(hl, (F.lane & ~3) + s2); if (s2 < seg) cin = as * cin + hs; }
#pragma unroll
        for (int i = 0; i < 16; ++i) CARRY[o0 + (size_t)i * 256] = ap[i] * cin + hp[i];
    }
}
DEV void ph_lru2(const Ctx& F, int l) {
    const int tid = F.tid, lane = F.lane, w = F.wave;
    const bf16* PROJ = (const bf16*)(F.ws + WS_PROJ); const bf16* HLOC = (const bf16*)(F.ws + WS_HLOC); const bf16* CPA = (const bf16*)(F.ws + WS_CPA);
    const float* CARRY = (const float*)(F.ws + WS_CARRY); bf16* CAT = (bf16*)(F.ws + WS_CAT);
    const f32x4 gw4 = *(const f32x4*)(PIN(F, I_GNW) + l * DM + 4 * lane);
    for (int u = F.bid; u < BATCH * 64; u += F.G) {
        const int b = u >> 6, c = u & 63; const size_t m0 = (size_t)b * SEQ + c * 64;
        const f32x4 car = *(const f32x4*)(CARRY + (size_t)u * 256 + 4 * lane);
        u32x2 hl8[8], cp8[8], ly8[8];
#pragma unroll
        for (int tt = 0; tt < 8; ++tt) { const size_t m = m0 + w * 8 + tt;
            hl8[tt] = *(const u32x2*)(HLOC + m * 256 + 4 * lane); cp8[tt] = *(const u32x2*)(CPA + m * 256 + 4 * lane); ly8[tt] = *(const u32x2*)(PROJ + m * NPROJ + PC_LY + 4 * lane); }
#pragma unroll
        for (int tt = 0; tt < 8; ++tt) { const size_t m = m0 + w * 8 + tt; const u32x2 hl = hl8[tt], cp = cp8[tt], ly = ly8[tt];
            float v0 = (bflo(hl.x) + bflo(cp.x) * car.x) * gelu_tanh(bflo(ly.x));
            float v1 = (bfhi(hl.x) + bfhi(cp.x) * car.y) * gelu_tanh(bfhi(ly.x));
            float v2 = (bflo(hl.y) + bflo(cp.y) * car.z) * gelu_tanh(bflo(ly.y));
            float v3 = (bfhi(hl.y) + bfhi(cp.y) * car.w) * gelu_tanh(bfhi(ly.y));
            const float rs = RSQ(wave_sum((v0 * v0 + v1 * v1) + (v2 * v2 + v3 * v3)) * (1.0f / 256.0f) + NORM_EPS);
            u32x2 o; o.x = pk2(v0 * rs * gw4.x, v1 * rs * gw4.y); o.y = pk2(v2 * rs * gw4.z, v3 * rs * gw4.w);
            *(u32x2*)(CAT + m * DM + 4 * lane) = o; }
    }
}

constexpr int QS_STRIDE = 136, VE_STRIDE = 56;
DEV void ph_mlstm(const Ctx& F, int l) {
    const int tid = F.tid, lane = F.lane, w = F.wave, i16 = lane & 15, g = lane >> 4;
    bf16* QsB = (bf16*)F.lds;
    bf16* KsB = QsB + 2 * 64 * QS_STRIDE;
    bf16* VE = KsB + 2 * 64 * QS_STRIDE;
    bf16* VW = VE + 64 * VE_STRIDE;
    bf16* CsB = VW + 64 * VE_STRIDE;
    float* BCB = (float*)(CsB + 2 * 128 * VE_STRIDE);
    float* BIB = BCB + 128;
    const bf16* PROJ = (const bf16*)(F.ws + WS_PROJ); bf16* HM = (bf16*)(F.ws + WS_HM);
    const float qscale = 0.08838834764831845f;
    const int half = w >> 2, jt = half ? 3 - (w & 3) : (w & 3);
    for (int u0 = F.bid; u0 < BATCH * 4 * 4; u0 += F.G) {
        const int u = 4 * ((u0 & 7) * 8 + ((u0 >> 3) >> 2)) + ((u0 >> 3) & 3);
        const int b = u >> 4, h = (u >> 2) & 3, vs = u & 3;
        const float gbi = PIN(F, I_BI)[l * 4 + h], gbf = PIN(F, I_BF)[l * 4 + h];
        f32x4 accC[3];
#pragma unroll
        for (int nt = 0; nt < 3; ++nt) accC[nt] = (f32x4){0.f, 0.f, 0.f, 0.f};
        float* BCg = (float*)(F.ws + WS_MG) + (size_t)u * 8192; float* BIg = BCg + 4096;
        unsigned gri[8], grf[8];
#pragma unroll
        for (int k = 0; k < 8; ++k) { const bf16* pr = PROJ + ((size_t)b * SEQ + (8 * k + w) * 64 + lane) * NPROJ; gri[k] = pr[PC_MI + h]; grf[k] = pr[PC_MF + h]; }
#pragma unroll
        for (int k = 0; k < 8; ++k) { const int tok = (8 * k + w) * 64 + lane;
            const float zi = (bf2f(gri[k]) + gbi) * (1.0f / 15.0f), zf = (bf2f(grf[k]) + gbf) * (1.0f / 15.0f);
            const float ig = 15.0f - 30.0f * FRCP(FEXP(2.0f * zi) + 1.0f), fg = 15.0f - 30.0f * FRCP(FEXP(2.0f * zf) + 1.0f);
            float s = -FLOG(1.0f + FEXP(-fg));
#pragma unroll
            for (int o = 1; o < 64; o <<= 1) { const float t = SHFL_UP(s, o); if (lane >= o) s += t; }
            BCg[tok] = s; BIg[tok] = s - ig; }
        SYNC();
        u32x4 rq[2], rk[2]; u32x2 rvv; float rgc = 0.f, rgb = 0.f;
        {
            const size_t m0 = (size_t)b * SEQ;
#pragma unroll
            for (int i = 0; i < 2; ++i) { const int idx = tid + 512 * i, row = idx >> 4, ck = idx & 15;
                rq[i] = *(const u32x4*)(PROJ + (m0 + row) * NPROJ + PC_MQ + h * 128 + 8 * ck); rk[i] = *(const u32x4*)(PROJ + (m0 + row) * NPROJ + PC_MK + h * 128 + 8 * ck); }
            rvv = *(const u32x2*)(PROJ + (m0 + (tid >> 3)) * NPROJ + PC_MV + h * 128 + vs * 32 + 4 * (tid & 7));
            if (tid < 64) { rgc = BCg[tid]; rgb = BIg[tid]; }
        }
        for (int c = 0; c < 64; ++c) {
            const size_t m0 = (size_t)b * SEQ + c * 64; const int buf = c & 1;
            bf16* Qs = QsB + buf * 64 * QS_STRIDE; bf16* Ks = KsB + buf * 64 * QS_STRIDE; const bf16* Cs = CsB + buf * 128 * VE_STRIDE; bf16* Cn = CsB + (buf ^ 1) * 128 * VE_STRIDE;
            float* BC = BCB + buf * 64; float* BI = BIB + buf * 64;
#pragma unroll
            for (int i = 0; i < 2; ++i) { const int idx = tid + 512 * i, row = idx >> 4, ck = idx & 15;
                *(u32x4*)(Qs + row * QS_STRIDE + 8 * ck) = rq[i]; *(u32x4*)(Ks + row * QS_STRIDE + 8 * ck) = rk[i]; }
            if (tid < 64) { BC[tid] = rgc; BI[tid] = rgb; }
            SYNC();
            {
                const int row = tid >> 3, cg = tid & 7;
                const u32x2 rv = rvv;
                const float wt = FEXP(BC[63] - BI[row]);
                *(u32x2*)(VE + row * VE_STRIDE + 4 * cg) = rv;
                u32x2 sv; sv.x = pk2(bflo(rv.x) * wt, bfhi(rv.x) * wt); sv.y = pk2(bflo(rv.y) * wt, bfhi(rv.y) * wt);
                *(u32x2*)(VW + row * VE_STRIDE + 4 * cg) = sv;
                if (cg == 0) { unsigned one_ = 0x3f80u; LAUNDER_V(one_); u32x4 z = (u32x4){one_, 0u, 0u, 0u}; *(u32x4*)(VE + row * VE_STRIDE + 32) = z; *(u32x4*)(VE + row * VE_STRIDE + 40) = (u32x4){0u, 0u, 0u, 0u};
                    z.x = f2bf(wt); *(u32x4*)(VW + row * VE_STRIDE + 32) = z; *(u32x4*)(VW + row * VE_STRIDE + 40) = (u32x4){0u, 0u, 0u, 0u}; }
            }
            if (c + 1 < 64) {
                const size_t m1 = m0 + 64;
#pragma unroll
                for (int i = 0; i < 2; ++i) { const int idx = tid + 512 * i, row = idx >> 4, ck = idx & 15;
                    rq[i] = *(const u32x4*)(PROJ + (m1 + row) * NPROJ + PC_MQ + h * 128 + 8 * ck); rk[i] = *(const u32x4*)(PROJ + (m1 + row) * NPROJ + PC_MK + h * 128 + 8 * ck); }
                rvv = *(const u32x2*)(PROJ + (m1 + (tid >> 3)) * NPROJ + PC_MV + h * 128 + vs * 32 + 4 * (tid & 7));
                if (tid < 64) { rgc = BCg[(c + 1) * 64 + tid]; rgb = BIg[(c + 1) * 64 + tid]; }
            }
            SYNC();
            f32x4 Z[2] = {(f32x4){0.f, 0.f, 0.f, 0.f}, (f32x4){0.f, 0.f, 0.f, 0.f}};
            {
                bf16x8 Bq[4];
#pragma unroll
                for (int ks = 0; ks < 4; ++ks) Bq[ks] = *(const bf16x8*)(Qs + (16 * jt + i16) * QS_STRIDE + 32 * ks + 8 * g);
                const float bj = BC[16 * jt + i16];
                unsigned pk[4][2];
#pragma unroll
                for (int tt = 0; tt < 4; ++tt) {
                    if (tt <= jt) {
                        f32x4 X = (f32x4){0.f, 0.f, 0.f, 0.f};
                        bf16x8 Ak[4];
#pragma unroll
                        for (int ks = 0; ks < 4; ++ks) Ak[ks] = *(const bf16x8*)(Ks + (16 * tt + i16) * QS_STRIDE + 32 * ks + 8 * g);
                        KEEP4(Ak[0], Ak[1], Ak[2], Ak[3]);
#pragma unroll
                        for (int ks = 0; ks < 4; ++ks) X = MFMA16(Ak[ks], Bq[ks], X);
                        float p[4]; const f32x4 bi4 = *(const f32x4*)(BI + 16 * tt + 4 * g);
#pragma unroll
                        for (int r = 0; r < 4; ++r) { const float pv = X[r] * qscale * FEXP(fminf(bj - bi4[r], 60.0f));
                            p[r] = (tt < jt || 4 * g + r <= i16) ? pv : 0.f; }
                        pk[tt][0] = pk2(p[0], p[1]); pk[tt][1] = pk2(p[2], p[3]);
                    } else { pk[tt][0] = 0u; pk[tt][1] = 0u; }
                }
#pragma unroll
                for (int pr = 0; pr < 2; ++pr) {
                    if (2 * pr <= jt) {
                        u32x4 aw = (u32x4){pk[2 * pr][0], pk[2 * pr][1], pk[2 * pr + 1][0], pk[2 * pr + 1][1]};
                        const bf16x8 A = __builtin_bit_cast(bf16x8, aw);
#pragma unroll
                        for (int n = 0; n < 2; ++n) { const int ntc = n ? 2 : half;
                            const s16x4 lo = TR16(VE + (32 * pr + 4 * g + (i16 >> 2)) * VE_STRIDE + 16 * ntc + 4 * (i16 & 3));
                            const s16x4 hi = TR16(VE + (32 * pr + 16 + 4 * g + (i16 >> 2)) * VE_STRIDE + 16 * ntc + 4 * (i16 & 3));
                            const bf16x8 B = (bf16x8){lo[0], lo[1], lo[2], lo[3], hi[0], hi[1], hi[2], hi[3]};
                            Z[n] = MFMA16(A, B, Z[n]); }
#ifndef HOST_EMU
                        asm volatile("" :: "v"(aw));
#endif
                    }
                }
            }
            if (c > 0) {
                f32x4 Z2[2] = {(f32x4){0.f, 0.f, 0.f, 0.f}, (f32x4){0.f, 0.f, 0.f, 0.f}};
#pragma unroll
                for (int kh = 0; kh < 2; ++kh) {
                    bf16x8 Aq[2], Bc[2][2];
#pragma unroll
                    for (int k2 = 0; k2 < 2; ++k2) { const int ks = 2 * kh + k2; Aq[k2] = *(const bf16x8*)(Qs + (16 * jt + i16) * QS_STRIDE + 32 * ks + 8 * g);
#pragma unroll
                        for (int n = 0; n < 2; ++n) { const int ntc = n ? 2 : half;
                            const s16x4 lo = TR16(Cs + (32 * ks + 8 * g + (i16 >> 2)) * VE_STRIDE + 16 * ntc + 4 * (i16 & 3));
                            const s16x4 hi = TR16(Cs + (32 * ks + 8 * g + 4 + (i16 >> 2)) * VE_STRIDE + 16 * ntc + 4 * (i16 & 3));
                            Bc[k2][n] = (bf16x8){lo[0], lo[1], lo[2], lo[3], hi[0], hi[1], hi[2], hi[3]}; } }
                    KEEP4(Bc[0][0], Bc[0][1], Bc[1][0], Bc[1][1]);
#pragma unroll
                    for (int k2 = 0; k2 < 2; ++k2)
#pragma unroll
                        for (int n = 0; n < 2; ++n) Z2[n] = MFMA16(Aq[k2], Bc[k2][n], Z2[n]); }
                const f32x4 bc4 = *(const f32x4*)(BC + 16 * jt + 4 * g);
#pragma unroll
                for (int r = 0; r < 4; ++r) { const float f = qscale * FEXP(bc4[r]); Z[0][r] += f * Z2[0][r]; Z[1][r] += f * Z2[1][r]; }
            }
#pragma unroll
            for (int r = 0; r < 4; ++r) { const int j = 16 * jt + 4 * g + r; const float dn = FRCP(fmaxf(fabsf(SHFL(Z[1][r], lane & 48)), 1.0f));
                HM[(m0 + j) * 512 + h * 128 + vs * 32 + 16 * half + i16] = (bf16)f2bf(Z[0][r] * dn); }
            {
                const float dec = FEXP(BC[63]);
#pragma unroll
                for (int nt = 0; nt < 3; ++nt) accC[nt] = accC[nt] * dec;
#pragma unroll
                for (int ks = 0; ks < 2; ++ks) {
                    const s16x4 alo = TR16(Ks + (32 * ks + 8 * g + (i16 >> 2)) * QS_STRIDE + 16 * w + 4 * (i16 & 3));
                    const s16x4 ahi = TR16(Ks + (32 * ks + 8 * g + 4 + (i16 >> 2)) * QS_STRIDE + 16 * w + 4 * (i16 & 3));
                    const bf16x8 A = (bf16x8){alo[0], alo[1], alo[2], alo[3], ahi[0], ahi[1], ahi[2], ahi[3]};
                    bf16x8 Bv[3];
#pragma unroll
                    for (int nt = 0; nt < 3; ++nt) {
                        const s16x4 lo = TR16(VW + (32 * ks + 8 * g + (i16 >> 2)) * VE_STRIDE + 16 * nt + 4 * (i16 & 3));
                        const s16x4 hi = TR16(VW + (32 * ks + 8 * g + 4 + (i16 >> 2)) * VE_STRIDE + 16 * nt + 4 * (i16 & 3));
                        Bv[nt] = (bf16x8){lo[0], lo[1], lo[2], lo[3], hi[0], hi[1], hi[2], hi[3]}; }
                    KEEP4(A, Bv[0], Bv[1], Bv[2]);
#pragma unroll
                    for (int nt = 0; nt < 3; ++nt) { const bf16x8 B = Bv[nt];
                        const f32x4 cold = accC[nt]; accC[nt] = MFMA16(A, B, cold);
#ifndef HOST_EMU
                        asm volatile("" :: "v"(cold), "v"(A), "v"(B));
#endif
                    }
                }
#pragma unroll
                for (int nt = 0; nt < 3; ++nt)
#pragma unroll
                    for (int r = 0; r < 4; ++r) Cn[(16 * w + 4 * g + r) * VE_STRIDE + 16 * nt + i16] = (bf16)f2bf(accC[nt][r]);
            }
        }
        SYNC();
    }
}

DEV void ph_mfin(const Ctx& F, int l) {
    const int gw = F.bid * 8 + F.wave, NGW = F.G * 8, lane = F.lane;
    const bf16* PROJ = (const bf16*)(F.ws + WS_PROJ); const bf16* HM = (const bf16*)(F.ws + WS_HM); bf16* CAT = (bf16*)(F.ws + WS_CAT);
    float gm[8];
#pragma unroll
    for (int j = 0; j < 8; ++j) gm[j] = PIN(F, I_GNW)[l * DM + 256 + 8 * lane + j];
    u32x4 hv4[4], ov4[4], hvn[4], ovn[4];
#define MFIN_LOAD(HV, OV, M0) do { _Pragma("unroll") for (int q = 0; q < 4; ++q) { const int mm = (M0) + q * NGW; const size_t ms = (size_t)(mm < MTOK ? mm : 0); \
            HV[q] = *(const u32x4*)(HM + ms * 512 + 8 * lane); OV[q] = *(const u32x4*)(PROJ + ms * NPROJ + PC_MO + 8 * lane); } } while (0)
    MFIN_LOAD(hv4, ov4, gw);
    for (int m0 = gw; m0 < MTOK; m0 += 4 * NGW) {
        MFIN_LOAD(hvn, ovn, m0 + 4 * NGW);
#pragma unroll
        for (int q = 0; q < 4; ++q) { const int m = m0 + q * NGW; if (m >= MTOK) break;
            const u32x4 hv = hv4[q], ov = ov4[q];
            float v[8] = {bflo(hv.x), bfhi(hv.x), bflo(hv.y), bfhi(hv.y), bflo(hv.z), bfhi(hv.z), bflo(hv.w), bfhi(hv.w)};
            const float o[8] = {bflo(ov.x), bfhi(ov.x), bflo(ov.y), bfhi(ov.y), bflo(ov.z), bfhi(ov.z), bflo(ov.w), bfhi(ov.w)};
            float s = 0.f;
#pragma unroll
            for (int j = 0; j < 8; ++j) s += v[j] * v[j];
            s += SHFL_XOR(s, 1); s += SHFL_XOR(s, 2); s += SHFL_XOR(s, 4); s += SHFL_XOR(s, 8);
            const float rs = RSQ(s * (1.0f / 128.0f) + NORM_EPS);
            u32x4 r;
            r.x = pk2(v[0] * rs * gm[0] * fsigmoid(o[0]), v[1] * rs * gm[1] * fsigmoid(o[1]));
            r.y = pk2(v[2] * rs * gm[2] * fsigmoid(o[2]), v[3] * rs * gm[3] * fsigmoid(o[3]));
            r.z = pk2(v[4] * rs * gm[4] * fsigmoid(o[4]), v[5] * rs * gm[5] * fsigmoid(o[5]));
            r.w = pk2(v[6] * rs * gm[6] * fsigmoid(o[6]), v[7] * rs * gm[7] * fsigmoid(o[7]));
            *(u32x4*)(CAT + (size_t)m * DM + 256 + 8 * lane) = r; }
#pragma unroll
        for (int q = 0; q < 4; ++q) { hv4[q] = hvn[q]; ov4[q] = ovn[q]; }
    }
#undef MFIN_LOAD
}

constexpr int DS_HIST = 0;
constexpr int DS_MASK = 49152;
constexpr int DS_CAND = 65536;
constexpr int DS_SELL = 102400;
constexpr int DS_META = 118784;
constexpr int DS_RB = DS_META + 512;
constexpr int DS_SS = DS_RB + 2048;
constexpr int DS_SLOT = 12800;
constexpr int NBIN = 768, CAND_CAP = 128;
__device__ const unsigned char T5B[114] = {0, 1, 2, 3, 4, 5, 6, 7, 8, 9, 10, 11, 12, 13, 14, 15, 16, 16, 16, 17, 17, 18, 18, 18, 19, 19, 19, 20, 20, 20, 20, 21, 21, 21, 21, 22, 22, 22, 22, 22, 23, 23, 23, 23, 23, 23, 24, 24, 24, 24, 24, 24, 25, 25, 25, 25, 25, 25, 25, 26, 26, 26, 26, 26, 26, 26, 26, 27, 27, 27, 27, 27, 27, 27, 27, 27, 27, 28, 28, 28, 28, 28, 28, 28, 28, 28, 28, 29, 29, 29, 29, 29, 29, 29, 29, 29, 29, 29, 29, 30, 30, 30, 30, 30, 30, 30, 30, 30, 30, 30, 30, 30, 30, 31};

DEV int score_bin(float sc) {
    const unsigned u = __builtin_bit_cast(unsigned, sc);
    int e = (int)((u >> 18) & 0x1FFFu) - 119 * 32; e = e < 0 ? 0 : (e > 383 ? 383 : e);
    return (u >> 31) ? 383 - e : 384 + e;
}
DEV unsigned score_key(float sc) { const unsigned u = __builtin_bit_cast(unsigned, sc); return (u >> 31) ? ~u : (u | 0x80000000u); }
DEV unsigned score_code(float sc) {
    const unsigned u = __builtin_bit_cast(unsigned, sc);
    int e = (int)((u >> 18) & 0x1FFFu) - 119 * 32; e = e < 0 ? 0 : (e > 383 ? 383 : e);
    const int v = (e << 6) | (int)((u >> 12) & 63u), sm = (int)u >> 31;
    return (unsigned)(0x6000 + (v ^ sm));
}
DEV int code_bin(unsigned c) { return (int)(c >> 6); }
DEV unsigned code_key(unsigned c) { return c & 63u; }


DEV f32x4 dsa_score_tile(const bf16x8 A, const bf16x8 (&QS)[2], const bf16x8 (&Bq)[8], const float (&wq)[8]) {
    f32x4 d8[8];
#pragma unroll
    for (int h = 0; h < 8; ++h) d8[h] = MFMA16(A, Bq[h], (f32x4){0.f, 0.f, 0.f, 0.f});
#ifndef HOST_EMU
    asm volatile("" :: "v"(d8[0]), "v"(d8[1]), "v"(d8[2]), "v"(d8[3]), "v"(d8[4]), "v"(d8[5]), "v"(d8[6]), "v"(d8[7]));
#endif
    f32x4 sc = (f32x4){0.f, 0.f, 0.f, 0.f};
#pragma unroll
    for (int h = 0; h < 8; ++h)
#pragma unroll
        for (int r = 0; r < 4; ++r) { sc[r] = __builtin_fmaf(wq[h], RELU(d8[h][r]), sc[r]); NOPACK(sc[r]); }
    return sc;
}
DEV void ph_dsa(const Ctx& F, int l) {
    const int tid = F.tid, lane = F.lane, w = F.wave, i16 = lane & 15, g = lane >> 4;
    unsigned* HIST = (unsigned*)(F.lds + DS_HIST); unsigned* MASK = (unsigned*)(F.lds + DS_MASK); u32x2* CAND = (u32x2*)(F.lds + DS_CAND);
    unsigned short* SELL = (unsigned short*)(F.lds + DS_SELL); int* BST = (int*)(F.lds + DS_META); int* NAB = BST + 32; int* NCAND = BST + 64; int* NSEL = BST + 96;
    float* RB = (float*)(F.lds + DS_RB);
    const bf16* QIDX = (const bf16*)(F.ws + WS_QIDX); const bf16* KIDX = (const bf16*)(F.ws + WS_KIDX); const float* WI = (const float*)(F.ws + WS_WI);
    const bf16* QABS = (const bf16*)(F.ws + WS_QABS); const bf16* CKV = (const bf16*)(F.ws + WS_CKV); bf16* CAT = (bf16*)(F.ws + WS_CAT);
    const bf16* WUVT = (const bf16*)(F.ws + WS_WUVT) + (size_t)l * 4 * 64 * 128; float* SS = (float*)(F.lds + DS_SS);
    for (int e = tid; e < 114 * 4; e += 512) RB[e] = PIN(F, I_RELB)[T5B[e >> 2] * 4 + (e & 3)] * 1.4426950408889634f;
    SYNC();
    for (int ui = F.bid; ui < BATCH * 128; ui += F.G) {
#ifdef HOST_EMU
        int b, qt; { const int wv = ui & 255, k = ui >> 8, r = wv & 15; b = wv >> 4; qt = (k & 1) ? (32 * (k >> 1) + 31 - r) : (32 * (k >> 1) + r); }
#else
        int b, qt; { const int wv = ui & 255, k = ui >> 8, xj = wv >> 3, r = xj & 15; b = 2 * (wv & 7) + (xj >> 4);
            qt = (k & 1) ? (32 * (k >> 1) + 31 - r) : (32 * (k >> 1) + r); }
#endif
        const int t0 = 32 * qt, nkt = 2 * qt + 2; const size_t mb = (size_t)b * SEQ;
        const GAS char* const ckvb = UNIP(CKV + mb * 128);
        const int nt = w & 1;
        u32x2* sw = (u32x2*)(F.ws + (F.bid < 128 ? WS_QL + (size_t)F.bid * 262144 : WS_SCR2 + (size_t)(F.bid - 128) * 262144) + (size_t)w * 32768) + lane;
        bf16x8 Bq[8]; float wq[8];
        { const size_t mq = mb + t0 + 16 * nt + i16;
#pragma unroll
            for (int h = 0; h < 8; ++h) { Bq[h] = *(const bf16x8*)(QIDX + mq * 256 + 32 * h + 8 * g); wq[h] = WI[mq * 8 + h]; } }
        bf16x8 QS[2];
#pragma unroll
        for (int j = 0; j < 8; ++j) { float s = 0.f;
#pragma unroll
            for (int h = 0; h < 8; ++h) s += wq[h] * bf2f((unsigned)(unsigned short)Bq[h][j]);
            const unsigned hi = f2bf(s); QS[0][j] = (short)hi; QS[1][j] = (short)f2bf(s - bf2f(hi)); }
        for (int e = tid; e < 16 * NBIN; e += 512) HIST[e] = 0u;
        for (int e = tid; e < 32 * 128; e += 512) MASK[e] = 0u;
        if (tid < 32) NCAND[tid] = 0;
        SYNC();
        const GAS char* const kidb = UNIP(KIDX + mb * 32); const unsigned kidl = (unsigned)(i16 * 64 + g * 16);
        bf16x8 Apre = *(const GAS bf16x8*)(kidb + ((unsigned)(16 * (w >> 1)) * 64u + kidl));
        for (int kt = w >> 1; kt < nkt; kt += 4) {
            const bf16x8 A = Apre;
            { const int kn = kt + 4 < nkt ? kt + 4 : kt; Apre = *(const GAS bf16x8*)(kidb + ((unsigned)(16 * kn) * 64u + kidl)); }
            const f32x4 sc = dsa_score_tile(A, QS, Bq, wq);
            unsigned cd[4];
#pragma unroll
            for (int r = 0; r < 4; ++r) cd[r] = score_code(sc[r]);
            { u32x2 pk; pk.x = cd[0] | (cd[1] << 16); pk.y = cd[2] | (cd[3] << 16); sw[(size_t)((kt - (w >> 1)) >> 2) * 64] = pk; }
            const unsigned inc = nt ? 65536u : 1u;
            if (kt < 2 * qt) {
#pragma unroll
                for (int r = 0; r < 4; ++r) atomicAdd(&HIST[i16 * NBIN + code_bin(cd[r])], inc);
            } else {
                const int t = t0 + 16 * nt + i16;
#pragma unroll
                for (int r = 0; r < 4; ++r) { const int s = 16 * kt + 4 * g + r;
                    if (s <= t) atomicAdd(&HIST[i16 * NBIN + code_bin(cd[r])], inc); }
            }
        }
        SYNC();
        {
            int cnt4[4][12], tot4[4], suf4[4];
#pragma unroll
            for (int rr = 0; rr < 4; ++rr) { const int row = 4 * w + rr, sh = (row >> 4) * 16; const unsigned* hp = HIST + (row & 15) * NBIN + 12 * lane; int tot = 0;
#pragma unroll
                for (int i = 0; i < 12; ++i) { cnt4[rr][i] = (int)((hp[i] >> sh) & 0xFFFFu); tot += cnt4[rr][i]; }
                tot4[rr] = tot; suf4[rr] = tot; }
#pragma unroll
            for (int o = 1; o < 64; o <<= 1) {
#pragma unroll
                for (int rr = 0; rr < 4; ++rr) { const int v = SHFL_DOWN(suf4[rr], o); if (lane + o < 64) suf4[rr] += v; } }
#pragma unroll
            for (int rr = 0; rr < 4; ++rr) { const int row = 4 * w + rr, t = t0 + row;
                if (t < 256) { if (lane == 0) { BST[row] = -1; NAB[row] = t + 1; } }
                else { const int above = suf4[rr] - tot4[rr];
                    if (above < 256 && above + tot4[rr] >= 256) {
                        int run = above, bs = -1, na = 0; bool done = false;
#pragma unroll
                        for (int i = 11; i >= 0; --i) { if (!done) { if (run + cnt4[rr][i] >= 256) { bs = 12 * lane + i; na = run; done = true; } else run += cnt4[rr][i]; } }
                        BST[row] = bs; NAB[row] = na; } } }
        }
        SYNC();
        { const int row = 16 * nt + i16, t = t0 + row, bs = BST[row];
        const int ntl = nkt > (w >> 1) ? ((nkt - 1 - (w >> 1)) >> 2) + 1 : 0;
        u32x2 Pc[8], Pn[8];
#pragma unroll
        for (int q = 0; q < 8; ++q) Pc[q] = sw[(size_t)(q < 64 ? q : 63) * 64];
        for (int jb = 0; jb < ntl; jb += 8) {
#pragma unroll
            for (int q = 0; q < 8; ++q) { const int jn = jb + 8 + q; Pn[q] = sw[(size_t)(jn < 64 ? jn : 63) * 64]; }
#pragma unroll
            for (int q = 0; q < 8; ++q) { const int j = jb + q; if (j < ntl) { const int kt = (w >> 1) + 4 * j; const u32x2 pc = Pc[q];
            const bool full = kt < 2 * qt;
            const int s0 = 16 * kt + 4 * g; unsigned nib = 0u, cnd = 0u, cc[4];
#pragma unroll
            for (int r = 0; r < 4; ++r) { const unsigned wd = r < 2 ? pc.x : pc.y; cc[r] = (r & 1) ? (wd >> 16) : (wd & 0xffffu);
                const int bn = code_bin(cc[r]); const bool ok = full || s0 + r <= t;
                nib |= (ok && bn > bs) ? (1u << r) : 0u; cnd |= (ok && bn == bs) ? (1u << r) : 0u; }
            if (nib) atomicOr(&MASK[row * 128 + (s0 >> 5)], nib << (s0 & 31));
            if (cnd) {
#pragma unroll
                for (int r = 0; r < 4; ++r) if ((cnd >> r) & 1u) { const int pos = (int)atomicAdd((unsigned*)&NCAND[row], 1u); if (pos < CAND_CAP) CAND[row * CAND_CAP + pos] = (u32x2){code_key(cc[r]), (unsigned)(s0 + r)}; } }
            } }
#pragma unroll
            for (int q = 0; q < 8; ++q) Pc[q] = Pn[q];
        } }
        SYNC();
#pragma unroll 1
        for (int rr = 0; rr < 4; ++rr) {
            const int row = 4 * w + rr; if (BST[row] < 0) continue;
            const int n = NCAND[row] < CAND_CAP ? NCAND[row] : CAND_CAP, need = 256 - NAB[row];
            for (int i = lane; i < n; i += 64) { const u32x2 me = CAND[row * CAND_CAP + i]; int rank = 0;
                for (int j0 = 0; j0 < n; j0 += 8) { u32x2 o8[8];
#pragma unroll
                    for (int q = 0; q < 8; ++q) o8[q] = CAND[row * CAND_CAP + (j0 + q < CAND_CAP ? j0 + q : CAND_CAP - 1)];
#pragma unroll
                    for (int q = 0; q < 8; ++q) rank += (j0 + q < n && (o8[q].x > me.x || (o8[q].x == me.x && o8[q].y < me.y))) ? 1 : 0; }
#ifndef DSA_DBG_NOCAND
                if (rank < need) atomicOr(&MASK[row * 128 + (me.y >> 5)], 1u << (me.y & 31));
#endif
            }
        }
        SYNC();
#ifdef DSA_DBG_SEL
        for (int e = tid; e < 32 * 128; e += 512) { const int row = e >> 7, wi = e & 127, t = t0 + row, lo = t - 255 < 0 ? 0 : t - 255; unsigned m = 0u;
            for (int bq = 0; bq < 32; ++bq) { const int s = 32 * wi + bq; if (s >= lo && s <= t) m |= 1u << bq; }
            MASK[e] = m; }
        SYNC();
#endif
        {
            unsigned w04[4], w14[4]; int c4[4], inc4[4];
#pragma unroll
            for (int rr = 0; rr < 4; ++rr) { const int row = 4 * w + rr; w04[rr] = MASK[row * 128 + 2 * lane]; w14[rr] = MASK[row * 128 + 2 * lane + 1];
                c4[rr] = __builtin_popcount(w04[rr]) + __builtin_popcount(w14[rr]); inc4[rr] = c4[rr]; }
#pragma unroll
            for (int o = 1; o < 64; o <<= 1) {
#pragma unroll
                for (int rr = 0; rr < 4; ++rr) { const int v = SHFL_UP(inc4[rr], o); if (lane >= o) inc4[rr] += v; } }
#pragma unroll
            for (int rr = 0; rr < 4; ++rr) { const int row = 4 * w + rr; unsigned w0 = w04[rr], w1 = w14[rr]; int pos = inc4[rr] - c4[rr];
                while (w0) { const int bt = __builtin_ctz(w0); w0 &= w0 - 1; if (pos < 256) SELL[row * 256 + pos] = (unsigned short)(64 * lane + bt); ++pos; }
                while (w1) { const int bt = __builtin_ctz(w1); w1 &= w1 - 1; if (pos < 256) SELL[row * 256 + pos] = (unsigned short)(64 * lane + 32 + bt); ++pos; }
                if (lane == 63) NSEL[row] = inc4[rr] < 256 ? inc4[rr] : 256; }
        }
        SYNC();
        bf16* TL = (bf16*)(F.lds + w * DS_SLOT); bf16* OLw = (bf16*)(F.lds + w * DS_SLOT + 8704);
#pragma unroll 1
        for (int rr = 0; rr < 4; ++rr) {
            const int row = 4 * w + rr, t = t0 + row, ns = UNI(NSEL[row]); const size_t mt = mb + t;
            const unsigned short* sl = SELL + row * 256;
            bf16x8 Bh[4];
#pragma unroll
            for (int ks = 0; ks < 4; ++ks) Bh[ks] = i16 < 4 ? *(const bf16x8*)(QABS + mt * 512 + i16 * 128 + 32 * ks + 8 * g) : (bf16x8){0, 0, 0, 0, 0, 0, 0, 0};
            f32x4 O[8];
#pragma unroll
            for (int nt = 0; nt < 8; ++nt) O[nt] = (f32x4){0.f, 0.f, 0.f, 0.f};
            float mrun = -1e30f, lrun = 0.f;
            const float bfar = RB[113 * 4 + (i16 & 3)];
            const int nch = (ns + 31) >> 5;
            u32x4 gvA[8];
#ifndef HOST_EMU
#define ATT_KEEP8(A) asm volatile("" :: "v"(A[0][0]), "v"(A[0][1]), "v"(A[0][2]), "v"(A[0][3]), "v"(A[1][0]), "v"(A[1][1]), "v"(A[1][2]), "v"(A[1][3]))
#else
#define ATT_KEEP8(A) (void)0
#endif
#define ATT_LOAD(GV, CK, FULL) do { int sidx[8]; \
                _Pragma("unroll") for (int i = 0; i < 8; ++i) sidx[i] = (int)sl[32 * (CK) + 4 * i + g];            \
                _Pragma("unroll") for (int i = 0; i < 8; ++i) { const int kp = 32 * (CK) + 4 * i + g; sidx[i] = (FULL || kp < ns) ? sidx[i] : 0; } \
                _Pragma("unroll") for (int i = 0; i < 8; ++i) GV[i] = *(const GAS u32x4*)(ckvb + (((unsigned)sidx[i] << 8) + 16u * (unsigned)i16)); } while (0)
#define ATT_STEP(GV, CK, FULL) do { const int ck = (CK); \
                _Pragma("unroll") for (int i = 0; i < 8; ++i) *(u32x4*)(TL + (4 * i + g) * 136 + 8 * i16) = GV[i]; \
                const u32x2 sk0 = *(const u32x2*)(sl + 32 * ck + 4 * g), sk1 = *(const u32x2*)(sl + 32 * ck + 16 + 4 * g); \
                ATT_FENCE(); \
                if (ck + 1 < nch) ATT_LOAD(GV, ck + 1, FULL); \
                float bia[2][4]; \
                if (FULL && t - UNI((int)sl[32 * ck + 31]) >= 113) {                   \
                _Pragma("unroll") for (int kt = 0; kt < 2; ++kt) \
                _Pragma("unroll") for (int r = 0; r < 4; ++r) bia[kt][r] = bfar; \
                } else { \
                _Pragma("unroll") for (int kt = 0; kt < 2; ++kt) \
                _Pragma("unroll") for (int r = 0; r < 4; ++r) { const unsigned wd = kt ? (r < 2 ? sk1.x : sk1.y) : (r < 2 ? sk0.x : sk0.y); \
                        int dist = t - (int)((wd >> (16 * (r & 1))) & 0xffffu); dist = dist < 0 ? 0 : (dist > 113 ? 113 : dist); \
                        bia[kt][r] = RB[dist * 4 + (i16 & 3)]; } } \
                f32x4 lg[2]; \
                { bf16x8 Af[2][4];                                    \
                _Pragma("unroll") for (int kt = 0; kt < 2; ++kt) _Pragma("unroll") for (int ks = 0; ks < 4; ++ks) Af[kt][ks] = *(const bf16x8*)(TL + (16 * kt + i16) * 136 + 32 * ks + 8 * g); \
                ATT_KEEP8(Af); \
                _Pragma("unroll") for (int kt = 0; kt < 2; ++kt) { lg[kt] = (f32x4){0.f, 0.f, 0.f, 0.f}; \
                _Pragma("unroll") for (int ks = 0; ks < 4; ++ks) lg[kt] = MFMA16(Af[kt][ks], Bh[ks], lg[kt]); } } \
                float cm = -1e30f; \
                _Pragma("unroll") for (int kt = 0; kt < 2; ++kt) \
                _Pragma("unroll") for (int r = 0; r < 4; ++r) { const int kp = 32 * ck + 16 * kt + 4 * g + r; \
                        lg[kt][r] = (FULL || kp < ns) ? lg[kt][r] + bia[kt][r] : -1e30f; cm = fmaxf(cm, lg[kt][r]); } \
                if (ck == 0) { cm = fmaxf(cm, SHFL_XOR(cm, 16)); cm = fmaxf(cm, SHFL_XOR(cm, 32)); mrun = cm; } \
                float p[2][4]; \
                _Pragma("unroll") for (int kt = 0; kt < 2; ++kt) \
                _Pragma("unroll") for (int r = 0; r < 4; ++r) { p[kt][r] = (FULL || lg[kt][r] > -1e29f) ? FEXP2(lg[kt][r] - mrun) : 0.f; lrun += p[kt][r]; } \
                u32x4 aw = (u32x4){0u, 0u, 0u, 0u}; \
                if (i16 < 4) aw = (u32x4){pk2(p[0][0], p[0][1]), pk2(p[0][2], p[0][3]), pk2(p[1][0], p[1][1]), pk2(p[1][2], p[1][3])}; \
                const bf16x8 A = __builtin_bit_cast(bf16x8, aw); \
                _Pragma("unroll") for (int nt = 0; nt < 8; ++nt) { \
                    const s16x4 lo = TR16(TL + (4 * g + (i16 >> 2)) * 136 + 16 * nt + 4 * (i16 & 3)); \
                    const s16x4 hi = TR16(TL + (16 + 4 * g + (i16 >> 2)) * 136 + 16 * nt + 4 * (i16 & 3)); \
                    const bf16x8 B = (bf16x8){lo[0], lo[1], lo[2], lo[3], hi[0], hi[1], hi[2], hi[3]}; \
                    O[nt] = MFMA16(A, B, O[nt]); } \
                ATT_FENCE(); } while (0)
            if (ns == 256) { ATT_LOAD(gvA, 0, true); for (int ck2 = 0; ck2 < 8; ++ck2) ATT_STEP(gvA, ck2, true); }
            else { ATT_LOAD(gvA, 0, false); for (int ck2 = 0; ck2 < nch; ++ck2) ATT_STEP(gvA, ck2, false); }
#undef ATT_STEP
#undef ATT_LOAD
            lrun += SHFL_XOR(lrun, 16); lrun += SHFL_XOR(lrun, 32);
            float li[4];
#pragma unroll
            for (int r = 0; r < 4; ++r) li[r] = FRCP(SHFL(lrun, r));
            if (g == 0) {
#pragma unroll
                for (int nt = 0; nt < 8; ++nt)
#pragma unroll
                    for (int r = 0; r < 4; ++r) OLw[(rr * 4 + r) * 128 + 16 * nt + i16] = (bf16)f2bf(O[nt][r] * li[r]);
            }
        }
        bf16x8 Wf[4][4];
#pragma unroll
        for (int ks = 0; ks < 4; ++ks)
#pragma unroll
            for (int nt = 0; nt < 4; ++nt) Wf[ks][nt] = *(const bf16x8*)(WUVT + ((size_t)((w >> 1) * 64 + 16 * nt + i16)) * 128 + 32 * ks + 8 * g);
        SYNC();
        {
            const int h = w >> 1, mtile = w & 1, q = 16 * mtile + i16;
            const bf16* olq = (const bf16*)(F.lds + (q >> 2) * DS_SLOT + 8704) + ((q & 3) * 4 + h) * 128;
            float gaw[4];
#pragma unroll
            for (int nt = 0; nt < 4; ++nt) gaw[nt] = PIN(F, I_GNW)[l * DM + 768 + h * 64 + 16 * nt + i16];
            f32x4 acc[4];
#pragma unroll
            for (int nt = 0; nt < 4; ++nt) acc[nt] = (f32x4){0.f, 0.f, 0.f, 0.f};
#pragma unroll
            for (int ks = 0; ks < 4; ++ks) { const bf16x8 A = *(const bf16x8*)(olq + 32 * ks + 8 * g);
#pragma unroll
                for (int nt = 0; nt < 4; ++nt) acc[nt] = MFMA16(A, Wf[ks][nt], acc[nt]); }
#pragma unroll
            for (int r = 0; r < 4; ++r) { float s = (acc[0][r] * acc[0][r] + acc[1][r] * acc[1][r]) + (acc[2][r] * acc[2][r] + acc[3][r] * acc[3][r]);
                s += SHFL_XOR(s, 1); s += SHFL_XOR(s, 2); s += SHFL_XOR(s, 4); s += SHFL_XOR(s, 8);
                if (i16 == 0) SS[(16 * mtile + 4 * g + r) * 4 + h] = s; }
            SYNC();
#pragma unroll
            for (int r = 0; r < 4; ++r) { const int qq = 16 * mtile + 4 * g + r; const f32x4 s4 = *(const f32x4*)(SS + qq * 4);
                const float rs = RSQ(((s4.x + s4.y) + (s4.z + s4.w)) * (1.0f / 256.0f) + NORM_EPS);
                bf16* dst = CAT + (mb + t0 + qq) * DM + 768 + h * 64 + i16;
#pragma unroll
                for (int nt = 0; nt < 4; ++nt) dst[16 * nt] = (bf16)f2bf(acc[nt][r] * rs * gaw[nt]); }
        }
        SYNC();
    }
}
#ifndef HOST_EMU
namespace pg8 {
#define PG8_LAS __attribute__((address_space(3)))
typedef unsigned short bf16_t;
typedef short bf16x8 __attribute__((ext_vector_type(8)));
typedef float f32x4 __attribute__((ext_vector_type(4)));
typedef unsigned u32x4 __attribute__((ext_vector_type(4)));
constexpr int BM = 256, BK = 64, HALF = 128, HTB = HALF * BK * 2  , STAGE_BYTES = 8 * HTB, NXCD = 8, WGM = 8;

__host__ __device__ __forceinline__ int lds_byte(int r, int c) { const int st = (r >> 4) * 2 + (c >> 5), rr = r & 15, cc = c & 31, ob = rr * 64 + cc * 2; return st * 1024 + (ob ^ (((ob >> 9) & 1) << 5)); }
__host__ __device__ __forceinline__ void stage_rc(int b, int& R, int& C) { const int st = b / 1024, sb = b % 1024, swz = sb ^ (((sb >> 9) & 1) << 5); R = (st >> 1) * 16 + swz / 64; C = (st & 1) * 32 + (swz % 64) / 2; }
__host__ __device__ __forceinline__ int perm32(int rho) { const int n = rho >> 4, i = rho & 15; return 8 * (i >> 2) + 4 * n + (i & 3); }

struct Unit { int pm, pn; };
struct Gemm { const bf16_t* A; const bf16_t* Bt; int M, N, K; };

struct StaticOrder {
    int nM, nN, nwg, G, c;
    __host__ __device__ void init(int M, int N, int G_, int c_) { nM = M / BM; nN = N / BM; nwg = nM * nN; G = G_; c = c_; }
    __host__ __device__ bool next(int i, Unit& u) const {
        const long L = (long)i * G + c; if (L >= nwg) return false;
        int wgid = (int)L; { const int q = nwg / NXCD, r = nwg % NXCD, xcd = wgid % NXCD, off = wgid / NXCD; wgid = (xcd < r ? xcd * (q + 1) : r * (q + 1) + (xcd - r) * q) + off; }
        const int nig = WGM * nN, gid = wgid / nig, fm = gid * WGM, gsz = (nM - fm) < WGM ? (nM - fm) : WGM;
        u.pm = fm + ((wgid % nig) % gsz); u.pn = (wgid % nig) / gsz; return true;
    }
    __device__ __forceinline__ void a_ready(const Unit&) const {}
    __device__ __forceinline__ void done(const Unit&) const {}
};
__device__ __forceinline__ unsigned cvt_pk_bf16(float lo, float hi) { unsigned r; asm volatile("v_cvt_pk_bf16_f32 %0, %1, %2" : "=v"(r) : "v"(lo), "v"(hi)); return r; }
template <class Epi, class Sched, bool ALIGN_EPI = false, bool SP2 = false>
__device__ __forceinline__ void gemm_phase(PG8_LAS unsigned char* lds, const Gemm g, const Sched& S, const Epi& E, const int tid_in) {
    const int tid = tid_in, wid = __builtin_amdgcn_readfirstlane(tid >> 6), lane = tid & 63, wr = wid >> 2, wc = wid & 3, fr = lane & 15, fq = lane >> 4;
    const int K = g.K, nt = K / BK;
    unsigned voffA[2], voffB[2];
#pragma unroll
    for (int i = 0; i < 2; ++i) { int R, C; stage_rc(tid * 16 + i * 8192, R, C); const int Rb = Epi::PERM ? ((R & ~31) + perm32(R & 31)) : R;
        voffA[i] = (unsigned)(R * K + C) * 2u; voffB[i] = (unsigned)(Rb * K + C) * 2u; }
    const size_t kstep = (size_t)(BK * 2);
    const size_t hstep = (size_t)HALF * K * 2;
    const size_t tstep = 2 * hstep;
    const unsigned ldsw = (unsigned)wid * 1024u;
    const int aoff = lds_byte(wr * 64 + fr, fq * 8), boff = lds_byte(wc * 32 + fr, fq * 8);
#define PG8_SA(b, h) (((b) * 2 + (h)) * HTB)
#define PG8_SB(b, h) ((4 + (b) * 2 + (h)) * HTB)
#define PG8_STAGE(bufoff, gbase, voff) do { _Pragma("unroll") for (int _i = 0; _i < 2; ++_i) \
        __builtin_amdgcn_global_load_lds((const unsigned*)((const char*)(gbase) + (voff)[_i]), (PG8_LAS unsigned*)(lds + (bufoff) + ldsw + _i * 8192), 16, 0, 0); } while (0)
#define PG8_LDA(dst, b, h) do { _Pragma("unroll") for (int m = 0; m < 4; ++m) _Pragma("unroll") for (int k = 0; k < 2; ++k) dst[m][k] = *(const PG8_LAS bf16x8*)(lds + PG8_SA(b, h) + aoff + m * 2048 + k * 1024); } while (0)
#define PG8_LDB(dst, b, h) do { _Pragma("unroll") for (int n = 0; n < 2; ++n) _Pragma("unroll") for (int k = 0; k < 2; ++k) dst[n][k] = *(const PG8_LAS bf16x8*)(lds + PG8_SB(b, h) + boff + n * 2048 + k * 1024); } while (0)
#define PG8_MMA(ai, bj, At, Bt) do { __builtin_amdgcn_s_setprio(1); _Pragma("unroll") for (int m = 0; m < 4; ++m) _Pragma("unroll") for (int n = 0; n < 2; ++n) _Pragma("unroll") for (int k = 0; k < 2; ++k) \
        acc[ai][bj][m][n] = __builtin_amdgcn_mfma_f32_16x16x32_bf16(Bt[n][k], At[m][k], acc[ai][bj][m][n], 0, 0, 0); __builtin_amdgcn_s_setprio(0); } while (0)
#define PG8_WAIT_V(n) asm volatile("s_waitcnt vmcnt(" #n ")" ::: "memory")
#define PG8_WAIT_L(n) asm volatile("s_waitcnt lgkmcnt(" #n ")" ::: "memory")
#define PG8_BAR __builtin_amdgcn_s_barrier()
#define PG8_SCHED __builtin_amdgcn_sched_barrier(0)
    Unit cur, nxt; int ui = 0;
    if (!S.next(0, cur)) return;
    f32x4 acc[2][2][4][2];
#pragma unroll
    for (int a = 0; a < 2; ++a)
#pragma unroll
        for (int b = 0; b < 2; ++b)
#pragma unroll
            for (int m = 0; m < 4; ++m)
#pragma unroll
                for (int n = 0; n < 2; ++n) acc[a][b][m][n] = (f32x4){0.f, 0.f, 0.f, 0.f};
    bf16x8 At[4][2], B0[2][2], B1[2][2];
    const char* cA = (const char*)g.A + (size_t)cur.pm * tstep; const char* cB = (const char*)g.Bt + (size_t)cur.pn * tstep;
    S.a_ready(cur);
    if constexpr (SP2) {
        PG8_STAGE(PG8_SB(0, 0), cB, voffB); PG8_STAGE(PG8_SB(0, 1), cB + hstep, voffB); PG8_STAGE(PG8_SA(0, 0), cA, voffA); PG8_STAGE(PG8_SA(0, 1), cA + hstep, voffA);
        if (wr == 1) PG8_BAR;
        PG8_WAIT_V(2); PG8_BAR;
        PG8_STAGE(PG8_SB(1, 0), cB + kstep, voffB); PG8_STAGE(PG8_SA(1, 0), cA + kstep, voffA); PG8_STAGE(PG8_SB(1, 1), cB + hstep + kstep, voffB);
        PG8_WAIT_V(6); PG8_BAR;
    } else {
        PG8_STAGE(PG8_SB(0, 0), cB, voffB); PG8_STAGE(PG8_SA(0, 0), cA, voffA); PG8_STAGE(PG8_SB(0, 1), cB + hstep, voffB); PG8_STAGE(PG8_SA(0, 1), cA + hstep, voffA);
        if (wr == 1) PG8_BAR;
        PG8_WAIT_V(4); PG8_BAR;
        PG8_STAGE(PG8_SB(1, 0), cB + kstep, voffB); PG8_STAGE(PG8_SA(1, 0), cA + kstep, voffA); PG8_STAGE(PG8_SB(1, 1), cB + hstep + kstep, voffB);
        PG8_WAIT_V(6); PG8_BAR;
    }
    for (;;) {
        const bool has_next = S.next(ui + 1, nxt);
        const char* nA = has_next ? (const char*)g.A + (size_t)nxt.pm * tstep : cA; const char* nB = has_next ? (const char*)g.Bt + (size_t)nxt.pn * tstep : cB;
#pragma unroll 1
        for (int t = 0; t < nt; t += 2) {
            const bool last = (t == nt - 2);
            const char* a1 = cA + (size_t)(t + 1) * kstep;
            const char* a2 = last ? nA : cA + (size_t)(t + 2) * kstep; const char* b2 = last ? nB : cB + (size_t)(t + 2) * kstep;
            const char* a3 = a2 + kstep; const char* b3 = b2 + kstep;
            if (last && has_next) S.a_ready(nxt);
            if constexpr (Epi::NORM) { if (t == 2) E.prefetch(cur, tid, wid); if (t == 4) E.reduce_rs(tid); }
            if constexpr (SP2) {
            PG8_LDB(B0, 0, 0); PG8_LDB(B1, 0, 1); PG8_SCHED; PG8_LDA(At, 0, 0); PG8_STAGE(PG8_SA(1, 1), a1 + hstep, voffA);
            PG8_WAIT_V(8); PG8_WAIT_L(0); PG8_BAR; PG8_MMA(0, 0, At, B0); PG8_MMA(0, 1, At, B1); PG8_BAR; PG8_SCHED;
            PG8_LDA(At, 0, 1); PG8_STAGE(PG8_SB(0, 0), b2, voffB); PG8_STAGE(PG8_SB(0, 1), b2 + hstep, voffB); PG8_STAGE(PG8_SA(0, 0), a2, voffA);
            PG8_WAIT_V(8); PG8_WAIT_L(0); PG8_BAR; PG8_MMA(1, 0, At, B0); PG8_MMA(1, 1, At, B1); PG8_BAR; PG8_SCHED;
            PG8_LDB(B0, 1, 0); PG8_LDB(B1, 1, 1); PG8_SCHED; PG8_LDA(At, 1, 0); PG8_STAGE(PG8_SA(0, 1), a2 + hstep, voffA);
            PG8_WAIT_V(8); PG8_WAIT_L(0); PG8_BAR; PG8_MMA(0, 0, At, B0); PG8_MMA(0, 1, At, B1); PG8_BAR; PG8_SCHED;
            PG8_LDA(At, 1, 1); PG8_STAGE(PG8_SB(1, 0), b3, voffB); PG8_STAGE(PG8_SB(1, 1), b3 + hstep, voffB); PG8_STAGE(PG8_SA(1, 0), a3, voffA);
            PG8_WAIT_V(8); PG8_WAIT_L(0); PG8_BAR; PG8_MMA(1, 0, At, B0); PG8_MMA(1, 1, At, B1); PG8_BAR; PG8_SCHED;
            } else {
            PG8_LDB(B0, 0, 0); PG8_SCHED; PG8_LDA(At, 0, 0); PG8_STAGE(PG8_SA(1, 1), a1 + hstep, voffA);
            PG8_WAIT_L(8); PG8_BAR; PG8_WAIT_L(0); PG8_MMA(0, 0, At, B0); PG8_BAR; PG8_SCHED;
            PG8_LDB(B1, 0, 1); PG8_STAGE(PG8_SB(0, 0), b2, voffB);
            PG8_BAR; PG8_WAIT_L(0); PG8_MMA(0, 1, At, B1); PG8_BAR;
            PG8_LDA(At, 0, 1); PG8_STAGE(PG8_SA(0, 0), a2, voffA);
            PG8_BAR; PG8_WAIT_L(0); PG8_MMA(1, 0, At, B0); PG8_BAR; PG8_SCHED;
            PG8_STAGE(PG8_SB(0, 1), b2 + hstep, voffB);
            PG8_WAIT_V(6); PG8_BAR; PG8_MMA(1, 1, At, B1); PG8_BAR;
            PG8_LDB(B0, 1, 0); PG8_SCHED; PG8_LDA(At, 1, 0); PG8_STAGE(PG8_SA(0, 1), a2 + hstep, voffA);
            PG8_WAIT_L(8); PG8_BAR; PG8_WAIT_L(0); PG8_MMA(0, 0, At, B0); PG8_BAR; PG8_SCHED;
            PG8_LDB(B1, 1, 1); PG8_STAGE(PG8_SB(1, 0), b3, voffB);
            PG8_BAR; PG8_WAIT_L(0); PG8_MMA(0, 1, At, B1); PG8_BAR;
            PG8_LDA(At, 1, 1); PG8_STAGE(PG8_SA(1, 0), a3, voffA);
            PG8_BAR; PG8_WAIT_L(0); PG8_MMA(1, 0, At, B0); PG8_BAR; PG8_SCHED;
            PG8_STAGE(PG8_SB(1, 1), b3 + hstep, voffB);
            PG8_WAIT_V(6); PG8_BAR; PG8_MMA(1, 1, At, B1); PG8_BAR;
            }
        }
        if constexpr (ALIGN_EPI) { if (wr == 0) PG8_BAR; }
        if constexpr (!Epi::AFTER_DRAIN) { E(acc, cur, wr, wc, fr, fq); S.done(cur); }
        if (!has_next) break;
#pragma unroll
        for (int a = 0; a < 2; ++a)
#pragma unroll
            for (int b = 0; b < 2; ++b)
#pragma unroll
                for (int m = 0; m < 4; ++m)
#pragma unroll
                    for (int n = 0; n < 2; ++n) acc[a][b][m][n] = (f32x4){0.f, 0.f, 0.f, 0.f};
        cur = nxt; cA = nA; cB = nB; ++ui;
        if constexpr (ALIGN_EPI) { if (wr == 1) PG8_BAR; }
    }
    PG8_WAIT_V(0);
    if constexpr (!ALIGN_EPI) { if (wr == 0) PG8_BAR; }
    PG8_BAR;
    if constexpr (Epi::AFTER_DRAIN) { E.fused(acc, cur, wr, wc, fr, fq, lds, wid, lane); S.done(cur); }
#undef PG8_SA
#undef PG8_SB
#undef PG8_STAGE
#undef PG8_LDA
#undef PG8_LDB
#undef PG8_MMA
#undef PG8_WAIT_V
#undef PG8_WAIT_L
#undef PG8_BAR
#undef PG8_SCHED
}
}
namespace pg8 {
template <int ACT  > struct EpiRoute {
    static constexpr bool PERM = true, AFTER_DRAIN = false, NORM = false;
    bf16_t* O0; int ld0; bf16_t* O1; int ld1; int split;
    __device__ __forceinline__ void operator()(const f32x4 (&acc)[2][2][4][2], const Unit& u, int wr, int wc, int fr, int fq) const {
        const int row0 = u.pm * BM + wr * 64 + fr; const bool first = u.pn < split;
        bf16_t* base = first ? O0 : O1; const int ld = first ? ld0 : ld1; const int col0 = (first ? u.pn : u.pn - split) * BM + wc * 32 + 8 * fq;
#pragma unroll
        for (int ai = 0; ai < 2; ++ai)
#pragma unroll
            for (int m = 0; m < 4; ++m) { bf16_t* rowp = base + (size_t)(row0 + ai * HALF + m * 16) * ld + col0;
#pragma unroll
                for (int bj = 0; bj < 2; ++bj) { f32x4 v0 = acc[ai][bj][m][0], v1 = acc[ai][bj][m][1];
                    if (ACT == 1) {
#pragma unroll
                        for (int e = 0; e < 4; ++e) { const float a = fmaxf(v0[e], 0.f), b = fmaxf(v1[e], 0.f); v0[e] = a * a; v1[e] = b * b; } }
                    u32x4 w; w.x = cvt_pk_bf16(v0[0], v0[1]); w.y = cvt_pk_bf16(v0[2], v0[3]); w.z = cvt_pk_bf16(v1[0], v1[1]); w.w = cvt_pk_bf16(v1[2], v1[3]);
                    *(u32x4*)(rowp + bj * HALF) = w; } }
    }
};
struct EpiResid {
    static constexpr bool PERM = true, AFTER_DRAIN = false, NORM = false;
    const float* xsrc; float* xdst; const float* gate;
    __device__ __forceinline__ void operator()(const f32x4 (&acc)[2][2][4][2], const Unit& u, int wr, int wc, int fr, int fq) const {
        const int row0 = u.pm * BM + wr * 64 + fr, col0 = u.pn * BM + wc * 32 + 8 * fq, b = (u.pm * BM) >> 12;
        f32x4 gv[2][2];
#pragma unroll
        for (int bj = 0; bj < 2; ++bj)
#pragma unroll
            for (int n = 0; n < 2; ++n) gv[bj][n] = *(const f32x4*)(gate + (size_t)b * 6144 + col0 + bj * HALF + 4 * n);
#pragma unroll
        for (int ai = 0; ai < 2; ++ai)
#pragma unroll
            for (int m = 0; m < 4; ++m) { const size_t off = (size_t)(row0 + ai * HALF + m * 16) * 1024 + col0;
#pragma unroll
                for (int bj = 0; bj < 2; ++bj)
#pragma unroll
                    for (int n = 0; n < 2; ++n) { const f32x4 xs = *(const f32x4*)(xsrc + off + bj * HALF + 4 * n);
                        *(f32x4*)(xdst + off + bj * HALF + 4 * n) = xs + gv[bj][n] * acc[ai][bj][m][n]; }
                if (m & 1) asm volatile("" ::: "memory"); }
    }
};
constexpr int EPI_OFF = 133120;
template <int ACT  > struct EpiRouteN {
    static constexpr bool PERM = true, AFTER_DRAIN = false, NORM = true;
    bf16_t* O; int ld; const float* RSP; const float* shw; PG8_LAS unsigned char* lds;
    __device__ __forceinline__ void prefetch(const Unit& u, int tid, int wid) const {
        const char* src = (const char*)RSP + (size_t)u.pm * (BM * 64) + (size_t)tid * 16;
#pragma unroll
        for (int i = 0; i < 2; ++i) __builtin_amdgcn_global_load_lds((const unsigned*)(src + i * 8192), (PG8_LAS unsigned*)(lds + EPI_OFF + wid * 1024 + i * 8192), 16, 0, 0);
        if (wid == 0) { const char* s2 = (const char*)(shw + (size_t)((u.pm * BM) >> 12) * NSHW + u.pn * BM) + (size_t)(tid & 63) * 16;
            __builtin_amdgcn_global_load_lds((const unsigned*)s2, (PG8_LAS unsigned*)(lds + EPI_OFF + 16384), 16, 0, 0); }
    }
    __device__ __forceinline__ void reduce_rs(int tid) const {
        if (tid < 256) { const PG8_LAS f32x4* p = (const PG8_LAS f32x4*)(lds + EPI_OFF + tid * 64); const f32x4 a = p[0], b = p[1], c = p[2], d = p[3];
            const float s = (((a.x + a.y) + (a.z + a.w)) + ((b.x + b.y) + (b.z + b.w))) + (((c.x + c.y) + (c.z + c.w)) + ((d.x + d.y) + (d.z + d.w)));
            *(PG8_LAS float*)(lds + EPI_OFF + 17408 + tid * 4) = __builtin_amdgcn_rsqf(s * (1.0f / 1024.0f) + 1e-6f); }
    }
    __device__ __forceinline__ void operator()(const f32x4 (&acc)[2][2][4][2], const Unit& u, int wr, int wc, int fr, int fq) const {
        const int row0 = u.pm * BM + wr * 64 + fr, col0 = u.pn * BM + wc * 32 + 8 * fq;
        const PG8_LAS unsigned char* ep = lds + EPI_OFF;
        float rs[2][4];
#pragma unroll
        for (int ai = 0; ai < 2; ++ai)
#pragma unroll
            for (int m = 0; m < 4; ++m) rs[ai][m] = *(const PG8_LAS float*)(ep + 17408 + (wr * 64 + fr + ai * HALF + m * 16) * 4);
        f32x4 sv[2][2];
#pragma unroll
        for (int bj = 0; bj < 2; ++bj)
#pragma unroll
            for (int n = 0; n < 2; ++n) sv[bj][n] = *(const PG8_LAS f32x4*)(ep + 16384 + (bj * HALF + wc * 32 + 8 * fq + 4 * n) * 4);
#pragma unroll
        for (int ai = 0; ai < 2; ++ai)
#pragma unroll
            for (int m = 0; m < 4; ++m) { bf16_t* rowp = O + (size_t)(row0 + ai * HALF + m * 16) * ld + col0;
#pragma unroll
                for (int bj = 0; bj < 2; ++bj) { f32x4 v0 = acc[ai][bj][m][0] * rs[ai][m] + sv[bj][0], v1 = acc[ai][bj][m][1] * rs[ai][m] + sv[bj][1];
                    if (ACT == 1) {
#pragma unroll
                        for (int e = 0; e < 4; ++e) { const float a = fmaxf(v0[e], 0.f), b = fmaxf(v1[e], 0.f); v0[e] = a * a; v1[e] = b * b; } }
                    u32x4 w; w.x = cvt_pk_bf16(v0[0], v0[1]); w.y = cvt_pk_bf16(v0[2], v0[3]); w.z = cvt_pk_bf16(v1[0], v1[1]); w.w = cvt_pk_bf16(v1[2], v1[3]);
                    *(u32x4*)(rowp + bj * HALF) = w; } }
    }
};
template <bool MAYSKIP> struct EpiResidXS {
    static constexpr bool PERM = true, AFTER_DRAIN = false, NORM = false;
    const bf16_t* xsrc; bf16_t* xdst; const float* gate; const float* wp; bf16_t* XS; float* RSP; int doxs;
    template <bool DOXS> __device__ __forceinline__ void body(const f32x4 (&acc)[2][2][4][2], const Unit& u, int wr, int wc, int fr, int fq) const {
        const int row0 = u.pm * BM + wr * 64 + fr, col0 = u.pn * BM + wc * 32 + 8 * fq, b = (u.pm * BM) >> 12;
        f32x4 gv[2][2], wv[2][2]; float ssv[2][4];
#pragma unroll
        for (int bj = 0; bj < 2; ++bj)
#pragma unroll
            for (int n = 0; n < 2; ++n) { gv[bj][n] = *(const f32x4*)(gate + (size_t)b * 6144 + col0 + bj * HALF + 4 * n);
                if (DOXS) wv[bj][n] = *(const f32x4*)(wp + (size_t)b * 1024 + col0 + bj * HALF + 4 * n); }
#pragma unroll
        for (int aim = 0; aim < 4; ++aim) { const int ai = aim >> 1, m0_ = (aim & 1) * 2;
            u32x4 xr[4][2];
#pragma unroll
            for (int m = m0_; m < m0_ + 2; ++m)
#pragma unroll
                for (int bj = 0; bj < 2; ++bj) xr[m][bj] = *(const u32x4*)(xsrc + (size_t)(row0 + ai * HALF + m * 16) * 1024 + col0 + bj * HALF);
#pragma unroll
            for (int m = m0_; m < m0_ + 2; ++m) { const size_t off = (size_t)(row0 + ai * HALF + m * 16) * 1024 + col0; float ss = 0.f;
#pragma unroll
                for (int bj = 0; bj < 2; ++bj) { const u32x4 r = xr[m][bj];
                    const f32x4 x0 = (f32x4){bflo(r.x), bfhi(r.x), bflo(r.y), bfhi(r.y)}, x1 = (f32x4){bflo(r.z), bfhi(r.z), bflo(r.w), bfhi(r.w)};
                    const f32x4 y0 = x0 + gv[bj][0] * acc[ai][bj][m][0], y1 = x1 + gv[bj][1] * acc[ai][bj][m][1];
                    u32x4 w; w.x = cvt_pk_bf16(y0[0], y0[1]); w.y = cvt_pk_bf16(y0[2], y0[3]); w.z = cvt_pk_bf16(y1[0], y1[1]); w.w = cvt_pk_bf16(y1[2], y1[3]);
                    *(u32x4*)(xdst + off + bj * HALF) = w;
                    if (DOXS) { const f32x4 a = y0 * wv[bj][0], c = y1 * wv[bj][1];
                        u32x4 v; v.x = cvt_pk_bf16(a[0], a[1]); v.y = cvt_pk_bf16(a[2], a[3]); v.z = cvt_pk_bf16(c[0], c[1]); v.w = cvt_pk_bf16(c[2], c[3]);
                        *(u32x4*)(XS + off + bj * HALF) = v;
                        ss += ((y0.x * y0.x + y0.y * y0.y) + (y0.z * y0.z + y0.w * y0.w)) + ((y1.x * y1.x + y1.y * y1.y) + (y1.z * y1.z + y1.w * y1.w)); } }
                ssv[ai][m] = ss; }
            asm volatile("" ::: "memory"); }
        if (DOXS) { float t1[2][4];
#pragma unroll
            for (int ai = 0; ai < 2; ++ai)
#pragma unroll
                for (int m = 0; m < 4; ++m) t1[ai][m] = __shfl_xor(ssv[ai][m], 16);
#pragma unroll
            for (int ai = 0; ai < 2; ++ai)
#pragma unroll
                for (int m = 0; m < 4; ++m) { ssv[ai][m] += t1[ai][m]; t1[ai][m] = __shfl_xor(ssv[ai][m], 32); }
            if (fq == 0) {
#pragma unroll
                for (int ai = 0; ai < 2; ++ai)
#pragma unroll
                    for (int m = 0; m < 4; ++m) RSP[(size_t)(row0 + ai * HALF + m * 16) * 16 + u.pn * 4 + wc] = ssv[ai][m] + t1[ai][m]; } }
    }
    __device__ __forceinline__ void operator()(const f32x4 (&acc)[2][2][4][2], const Unit& u, int wr, int wc, int fr, int fq) const {
        if (!MAYSKIP || doxs) body<true>(acc, u, wr, wc, fr, fq); else body<false>(acc, u, wr, wc, fr, fq);
    }
};
}

#define RLX_AGENT __ATOMIC_RELAXED, __HIP_MEMORY_SCOPE_AGENT
#define XB_TMO      128
#define XB_XCNT(j)  (256  + 64 * (j))
#define XB_XSUB(j)  (1280 + 64 * (j))
#define XB_XGEN(j)  (2304 + 64 * (j))
#define XB_TOP      3328
#define XB_TOPGEN   3392
#define XCD_BAR_WORDS 3456
#define XB_SPIN_CAP (1u << 24)

__device__ __forceinline__ unsigned xb_ld(unsigned* p)              { return __hip_atomic_load(p, __ATOMIC_RELAXED, __HIP_MEMORY_SCOPE_AGENT); }
__device__ __forceinline__ unsigned xb_add(unsigned* p, unsigned v) { return __hip_atomic_fetch_add(p, v, __ATOMIC_RELAXED, __HIP_MEMORY_SCOPE_AGENT); }
__device__ __forceinline__ unsigned xb_xcc_id() { return (unsigned)__builtin_amdgcn_s_getreg((3 << 11) | 20) & 0xFu; }
#define XB_SPIN(cond, bar) do { unsigned _sp = 0; while (cond) { __builtin_amdgcn_s_sleep(1); \
    if ((++_sp & 255u) == 0u) { if (xb_ld(&(bar)[XB_TMO])) break; if (_sp > XB_SPIN_CAP) { atomicAdd(&(bar)[XB_TMO], 1u); break; } } } } while (0)

struct XcdBarrier {
    unsigned* bar; unsigned x;
    volatile LAS unsigned* st;
};

__device__ __forceinline__ XcdBarrier xcd_barrier_post(unsigned* bar, volatile LAS unsigned* st) {
    XcdBarrier b; b.bar = bar; b.x = xb_xcc_id(); b.st = st;
    if (threadIdx.x == 0) (void)xb_add(&bar[XB_XCNT(b.x)], 1u);
    return b;
}
__device__ __forceinline__ void xcd_barrier_complete(unsigned* bar, unsigned x, unsigned& nloc, unsigned& nx) {
    const unsigned G = gridDim.x * gridDim.y * gridDim.z;
    unsigned sum, cnt, mine, sp = 0u;
    for (;;) {
        sum = 0u; cnt = 0u; mine = 0u;
#pragma unroll
        for (unsigned j = 0; j < 16; ++j) { const unsigned c = xb_ld(&bar[XB_XCNT(j)]); sum += c; cnt += (c > 0u) ? 1u : 0u; mine = (j == x) ? c : mine; }
        if (sum == G) break;
        __builtin_amdgcn_s_sleep(1);
        if ((++sp & 255u) == 0u) { if (xb_ld(&bar[XB_TMO])) break; if (sp > XB_SPIN_CAP) { atomicAdd(&bar[XB_TMO], 1u); break; } }
    }
    nloc = mine > 0u ? mine : 1u; nx = cnt > 0u ? cnt : 1u;
}

__device__ __forceinline__ void xcd_barrier(const XcdBarrier& b) {
    asm volatile("s_waitcnt vmcnt(0)" ::: "memory");
    __syncthreads();
    if (threadIdx.x == 0) {
        unsigned* bar = b.bar;
        __builtin_amdgcn_s_waitcnt(0);
        unsigned nloc = b.st[0], nx = b.st[1];
        if (nloc == 0u) { xcd_barrier_complete(bar, b.x, nloc, nx); b.st[0] = nloc; b.st[1] = nx; }
        const unsigned old = xb_add(&bar[XB_XSUB(b.x)], 1u);
        const unsigned gen = old / nloc;
        if (old + 1u == (gen + 1u) * nloc) {
            __builtin_amdgcn_fence(__ATOMIC_RELEASE, "agent");
            asm volatile("s_waitcnt vmcnt(0)" ::: "memory");
            const unsigned og = xb_add(&bar[XB_TOP], 1u);
            const unsigned tg = og / nx;
            if (og + 1u == (tg + 1u) * nx) xb_add(&bar[XB_TOPGEN], 1u);
            else XB_SPIN(xb_ld(&bar[XB_TOPGEN]) == tg, bar);
            __builtin_amdgcn_fence(__ATOMIC_ACQUIRE, "agent");
            xb_add(&bar[XB_XGEN(b.x)], 1u);
            asm volatile("s_waitcnt vmcnt(0)" ::: "memory");
        } else {
            XB_SPIN(xb_ld(&bar[XB_XGEN(b.x)]) == gen, bar);
            __builtin_amdgcn_fence(__ATOMIC_ACQUIRE, "agent");
            asm volatile("s_waitcnt vmcnt(0)" ::: "memory");
        }
    }
    __syncthreads();
}

#ifndef PH_MASK
#define PH_MASK 0xFFFFF
#endif
#define EN(b) if constexpr ((PH_MASK >> (b)) & 1)
#ifndef DUP_MASK
#define DUP_MASK 0
#endif
#define DUP(b) if constexpr ((DUP_MASK >> (b)) & 1)
#define DBG_DIGEST_N 256
#define DBG_DIGEST_VAL(m, c) bf2f(((const bf16*)(wsp + WS_CAT))[(size_t)(m) * DM + 768 + (c)])
#ifndef DBG_PH_HI
#define DBG_PH_HI NPHASE
#endif
#ifndef MK_MULTI
#define MK_MULTI 0
#endif
constexpr int LDS_BYTES = 151552, MISC_OFF = 131072 + 320;
#ifndef DBG_LAYERS
#define DBG_LAYERS 4
#define DBG_L0 0
#endif
constexpr int NPHASE = 3 + 7 * DBG_LAYERS;
__global__ void __launch_bounds__(512, 2) hymba_fwd(Args a) {
    extern __shared__ __attribute__((aligned(16))) unsigned char lds[];
    Ctx F0;
    Ctx& F = F0;
    F.lds = (char*)lds; F.tid = threadIdx.x; F.lane = F.tid & 63; F.wave = __builtin_amdgcn_readfirstlane(F.tid >> 6); F.G = gridDim.x; F.bid = blockIdx.x;
    F.A = nullptr; F.ws = a.ws;
    if (F.tid < 29) ((unsigned long long*)(lds + PTR_OFF))[F.tid] = F.tid < 28 ? (unsigned long long)a.in[F.tid] : (unsigned long long)a.out;
    volatile LAS unsigned* MISC = (volatile LAS unsigned*)((LAS unsigned char*)lds + MISC_OFF);
    if (F.tid < 32) MISC[F.tid] = 0u;
    __syncthreads();
    unsigned* ctl = (unsigned*)(a.ws + WS_CTL);
    XcdBarrier bar; bar.bar = ctl + CW_BAR; bar.x = 0; bar.st = nullptr;
    if (!MK_MULTI) bar = xcd_barrier_post(ctl + CW_BAR, MISC + 8);
    const int lo = a.ph_lo, hi = a.ph_hi;
    int ph = 0;
#define PH_BEGIN if (lo <= ph && ph < hi) { Ctx F = F0; unsigned long long wsl_ = (unsigned long long)F0.ws; asm volatile("" : "+v"(F.tid), "+s"(F.bid), "+s"(F.G), "+s"(wsl_)); F.ws = (unsigned char*)(__attribute__((address_space(1))) unsigned char*)wsl_; F.lane = F.tid & 63; F.wave = __builtin_amdgcn_readfirstlane(F.tid >> 6); unsigned char* const wsp = F.ws; (void)wsp;
#define PH_END   if (!MK_MULTI && ph + 1 < hi) { XcdBarrier bb = bar; asm volatile("" : "+s"(bb.bar), "+s"(bb.x)); xcd_barrier(bb); } else __syncthreads(); } ++ph;
    PG8_LAS unsigned char* glds = (PG8_LAS unsigned char*)lds;
#define XN ((bf16*)(wsp + WS_XN))
#define PROJ ((bf16*)(wsp + WS_PROJ))
#define CAT ((bf16*)(wsp + WS_CAT))
#define HB ((bf16*)(wsp + WS_HB))
    PH_BEGIN EN(0) ph_prologue(F); DUP(0) { __syncthreads(); ph_prologue(F); } PH_END
    PH_BEGIN EN(1) { ph_shw(F); ph_xs0(F, PIN(F, I_X), PIN(F, I_N1W) + DBG_L0 * DM, (const float*)(wsp + WS_MOD) + (size_t)DBG_L0 * BATCH * NADA, DM, XN, (float*)(wsp + WS_RSP), (bf16*)POUT(F)); } PH_END
    for (int l_ = 0; l_ < DBG_LAYERS; ++l_) { const int l = l_ + DBG_L0;
        #define modl ((const float*)(wsp + WS_MOD) + (size_t)l * BATCH * NADA)
        #define xsrc (l_ == 0 ? PIN(F, I_X) : (const float*)POUT(F))
        PH_BEGIN
#if defined(PROBE_GA)
            { pg8::Gemm g{XN, (const bf16*)(wsp + WS_WIN) + (size_t)l * NPROJ * DM, MTOK, NPROJ, DM}; pg8::StaticOrder S; S.init(MTOK, NPROJ, F.G, F.bid);
            pg8::EpiRoute<0> E{PROJ, NPROJ, PROJ, NPROJ, 1 << 20};
            pg8::gemm_phase<pg8::EpiRoute<0>, pg8::StaticOrder, true, true>(glds, g, S, E, F.tid); } __syncthreads();
#elif defined(PROBE_GB)
            { pg8::Gemm g{XN, (const bf16*)(wsp + WS_WIN) + (size_t)l * NPROJ * DM, MTOK, NPROJ, DM}; pg8::StaticOrder S; S.init(MTOK, NPROJ, F.G, F.bid);
            pg8::EpiRouteN<0> E{PROJ, NPROJ, (const float*)(wsp + WS_RSP), (const float*)(wsp + WS_SHW) + (size_t)l * BATCH * NSHW, glds};
            pg8::gemm_phase<pg8::EpiRouteN<0>, pg8::StaticOrder, true, true>(glds, g, S, E, F.tid); } __syncthreads();
#endif
        EN(2) { pg8::Gemm g{XN, (const bf16*)(wsp + WS_WIN) + (size_t)l * NPROJ * DM, MTOK, NPROJ, DM}; pg8::StaticOrder S; S.init(MTOK, NPROJ, F.G, F.bid);
            pg8::EpiRouteN<0> E{PROJ, NPROJ, (const float*)(wsp + WS_RSP), (const float*)(wsp + WS_SHW) + (size_t)l * BATCH * NSHW, glds};
            pg8::gemm_phase<pg8::EpiRouteN<0>, pg8::StaticOrder, true, true>(glds, g, S, E, F.tid); } PH_END
        PH_BEGIN EN(3) ph_prep(F, l); DUP(3) ph_prep(F, l); EN(4) ph_lru1(F, l); DUP(4) ph_lru1(F, l); EN(5) ph_mlstm(F, l); DUP(5) ph_mlstm(F, l); PH_END
        PH_BEGIN EN(6) { ph_carry(F); pg8::Gemm g{(const bf16*)(wsp + WS_QL), (const bf16*)(wsp + WS_WQC) + (size_t)l * 768 * 256, MTOK, 768, 256}; pg8::StaticOrder S; S.init(MTOK, 768, F.G, F.bid);
            pg8::EpiRoute<0> E{(bf16*)(wsp + WS_QABS), 512, (bf16*)(wsp + WS_QIDX), 256, 2};
            pg8::gemm_phase<pg8::EpiRoute<0>, pg8::StaticOrder, true, true>(glds, g, S, E, F.tid); } PH_END
#ifndef DSA_REP
#define DSA_REP 1
#endif
        PH_BEGIN EN(7) { for (int rep_ = 0; rep_ < DSA_REP; ++rep_) { ph_dsa(F, l); if (DSA_REP > 1) __syncthreads(); } } DUP(7) ph_dsa(F, l); EN(8) ph_lru2(F, l); DUP(8) ph_lru2(F, l); EN(9) ph_mfin(F, l); DUP(9) ph_mfin(F, l); PH_END
        PH_BEGIN EN(10) { pg8::Gemm g{CAT, (const bf16*)(wsp + WS_WO) + (size_t)l * DM * DM, MTOK, DM, DM}; pg8::StaticOrder S; S.init(MTOK, DM, F.G, F.bid);
            pg8::EpiResidXS<false> E{(const pg8::bf16_t*)POUT(F), (pg8::bf16_t*)POUT(F), modl + 2 * DM, (const float*)(wsp + WS_WP) + (size_t)(l * 2 + 1) * BATCH * DM, XN, (float*)(wsp + WS_RSP), 1};
            pg8::gemm_phase<pg8::EpiResidXS<false>, pg8::StaticOrder, true, true>(glds, g, S, E, F.tid); } PH_END
        PH_BEGIN EN(12) { pg8::Gemm g{XN, (const bf16*)(wsp + WS_W1) + (size_t)l * DFF * DM, MTOK, DFF, DM}; pg8::StaticOrder S; S.init(MTOK, DFF, F.G, F.bid);
            pg8::EpiRouteN<1> E{HB, DFF, (const float*)(wsp + WS_RSP), (const float*)(wsp + WS_SHW) + (size_t)l * BATCH * NSHW + NPROJ, glds};
            pg8::gemm_phase<pg8::EpiRouteN<1>, pg8::StaticOrder, true, true>(glds, g, S, E, F.tid); } PH_END
        PH_BEGIN EN(13) { pg8::Gemm g{HB, (const bf16*)(wsp + WS_W2) + (size_t)l * DM * DFF, MTOK, DM, DFF}; pg8::StaticOrder S; S.init(MTOK, DM, F.G, F.bid);
            const int nl = l + 1 < DEPTH ? l + 1 : l;
            const bool lastl = l_ + 1 >= DBG_LAYERS;
            pg8::EpiResidXS<true> E{(const pg8::bf16_t*)POUT(F), lastl ? (pg8::bf16_t*)XN : (pg8::bf16_t*)POUT(F), modl + 5 * DM, (const float*)(wsp + WS_WP) + (size_t)(nl * 2) * BATCH * DM, XN, (float*)(wsp + WS_RSP), lastl ? 0 : 1};
            pg8::gemm_phase<pg8::EpiResidXS<true>, pg8::StaticOrder, true, true>(glds, g, S, E, F.tid); } PH_END
    }
#ifdef DBG_DIGEST
    PH_BEGIN { const int gw = F.bid * 8 + F.wave, NGW = F.G * 8; float* o = POUT(F);
        for (int m = gw; m < MTOK; m += NGW) for (int j = 0; j < 16; ++j) { const int c = F.lane + 64 * j; float v = 0.f;
            if (c < DBG_DIGEST_N) { v = DBG_DIGEST_VAL(m, c) * 4096.0f; v = v - floorf(v); }
            o[(size_t)m * DM + c] = v; } } PH_END
#else
    PH_BEGIN EN(14) ph_finalnorm16(F, XN, PIN(F, I_FNW), POUT(F)); PH_END
#endif
}

extern "C" void kernel_launch(void* const* d_in, const int* in_sizes, int n_in, void* d_out, int out_size, void* d_ws, size_t ws_size, hipStream_t stream) {
    static int grid = 0;
    if (grid == 0) {
        if (n_in != 28 || in_sizes[0] != MTOK * DM || out_size != MTOK * DM || ws_size < WS_END) { fprintf(stderr, "kernel_launch: unexpected shapes (n_in %d, in0 %d, out %d, ws %zu)\n", n_in, n_in > 0 ? in_sizes[0] : -1, out_size, ws_size); grid = -1; return; }
        int dev = 0, cus = 0, per_cu = 0;
        if (hipGetDevice(&dev) != hipSuccess || hipDeviceGetAttribute(&cus, hipDeviceAttributeMultiprocessorCount, dev) != hipSuccess) { grid = -1; return; }
        if (hipFuncSetAttribute((const void*)hymba_fwd, hipFuncAttributeMaxDynamicSharedMemorySize, LDS_BYTES) != hipSuccess) { fprintf(stderr, "kernel_launch: hipFuncSetAttribute failed\n"); grid = -1; return; }
        if (hipOccupancyMaxActiveBlocksPerMultiprocessor(&per_cu, (const void*)hymba_fwd, 512, LDS_BYTES) != hipSuccess || per_cu < 1) { fprintf(stderr, "kernel_launch: occupancy query says %d\n", per_cu); }
        (void)hipGetLastError();
        grid = cus;
    }
    if (grid < 0) return;
    if (hipMemsetAsync((char*)d_ws + WS_CTL, 0, CTL_ZERO_BYTES, stream) != hipSuccess) return;
    Args a{};
    for (int i = 0; i < 28; ++i) a.in[i] = (const float*)d_in[i];
    a.out = (float*)d_out; a.ws = (unsigned char*)d_ws;
#if MK_MULTI
    for (int p = 0; p < NPHASE; ++p) { a.ph_lo = p; a.ph_hi = p + 1; hipLaunchKernelGGL(hymba_fwd, dim3(grid), dim3(512), LDS_BYTES, stream, a); }
#else
    a.ph_lo = 0; a.ph_hi = DBG_PH_HI; hipLaunchKernelGGL(hymba_fwd, dim3(grid), dim3(512), LDS_BYTES, stream, a);
#endif
}
#endif
```
